# Optimizing an MI355X kernel written in HIP

```python
import math
import jax, jax.numpy as jnp
from jax import lax
import numpy as np

D_MODEL = 1024
BATCH = 8
SEQ = 8192
DEPTH = 2

PLE_DIM = 256
N_EVEN = (DEPTH + 1) // 2
N_ODD = DEPTH // 2
A_WIDTH = D_MODEL // 2
A_HEAD_DIM = 64
A_HEADS = A_WIDTH // (2 * A_HEAD_DIM)
A_SCALE = A_HEAD_DIM ** -0.5
Q_BLOCK = 128
REL_BUCKETS = 32
REL_MAX_DIST = 128
B_WIDTH = D_MODEL - A_WIDTH
LRU_BLOCKS = 8
LRU_BW = B_WIDTH // LRU_BLOCKS
CONV_W = 4
LRU_C = 8.0
AB_IN = 3 * A_WIDTH + 2 * B_WIDTH
RWKV_HEAD = 64
RWKV_HEADS = D_MODEL // RWKV_HEAD
DECAY_LORA = 64
AAA_LORA = 64
GATE_LORA = 160
RWKV_GN_EPS = 64e-5
MOE_GROUPS = 4
EXPERTS_PER_GROUP = 8
N_EXPERTS = MOE_GROUPS * EXPERTS_PER_GROUP
MOE_TOPK = 2
EXPERT_HIDDEN = 512
MOE_BLOCK = 512

kernel_name = "hybrid_diffattn_rglru_rwkv7_hmoe"


def _rmsnorm(x, g, eps=1e-6):
    x32 = x.astype(jnp.float32)
    y = x32 * lax.rsqrt(jnp.mean(x32 * x32, axis=-1, keepdims=True) + eps)
    return (y * g.astype(jnp.float32)).astype(x.dtype)


def _t5_bucket(rel):
    n = jnp.maximum(rel, 0)
    max_exact = REL_BUCKETS // 2
    large = max_exact + (jnp.log(jnp.maximum(n, 1).astype(jnp.float32) / max_exact)
                         / math.log(REL_MAX_DIST / max_exact)
                         * (REL_BUCKETS - max_exact)).astype(jnp.int32)
    large = jnp.minimum(large, REL_BUCKETS - 1)
    return jnp.where(n < max_exact, n, large)


def _diff_attention(q, k, v, rel_bias, lam, sub_g, lam_init):
    B, S = q.shape[:2]
    nblk = S // Q_BLOCK
    kt = k.transpose(0, 2, 3, 1, 4)
    vt = v.transpose(0, 2, 1, 3)
    qb = q.reshape(B, nblk, Q_BLOCK, A_HEADS, 2, A_HEAD_DIM).transpose(1, 0, 3, 4, 2, 5)
    kpos = jnp.arange(S)

    def block(args):
        qblk, bi = args
        qpos = bi * Q_BLOCK + jnp.arange(Q_BLOCK)
        rel = qpos[:, None] - kpos[None, :]
        bias = rel_bias[_t5_bucket(rel)].transpose(2, 0, 1).astype(jnp.float32)
        s = jnp.einsum('bhmqd,bhmkd->bhmqk', qblk, kt,
                       preferred_element_type=jnp.float32) * A_SCALE + bias[None, :, None]
        s = jnp.where(rel >= 0, s, -jnp.inf)
        pr = jax.nn.softmax(s, axis=-1)
        attn = pr[:, :, 0] - lam * pr[:, :, 1]
        return jnp.einsum('bhqk,bhkd->bhqd', attn.astype(vt.dtype), vt)

    o = lax.map(block, (qb, jnp.arange(nblk)))
    o = o.transpose(1, 0, 3, 2, 4).reshape(B, S, A_HEADS, 2 * A_HEAD_DIM)
    o = _rmsnorm(o, sub_g, eps=1e-5) * (1.0 - lam_init)
    return o.reshape(B, S, A_WIDTH)


def _rglru(u, wa, ba, wx, bx, lru_lambda):
    B, S, W = u.shape
    ub = u.reshape(B, S, LRU_BLOCKS, LRU_BW)
    r = jax.nn.sigmoid(jnp.einsum('bsnc,ncd->bsnd', ub, wa).reshape(B, S, W) + ba)
    ig = jax.nn.sigmoid(jnp.einsum('bsnc,ncd->bsnd', ub, wx).reshape(B, S, W) + bx)
    log_a = (-LRU_C * r.astype(jnp.float32)) * jax.nn.softplus(-lru_lambda.astype(jnp.float32))
    a = jnp.exp(log_a)
    b = jnp.sqrt(-jnp.expm1(2.0 * log_a)) * (ig * u).astype(jnp.float32)

    def combine(left, right):
        a1, b1 = left
        a2, b2 = right
        return a1 * a2, a2 * b1 + b2

    _, hs = lax.associative_scan(combine, (a, b), axis=1)
    return hs.astype(u.dtype)


def _mixer_ab(h, w_in, w_out, lq1, lk1, lq2, lk2, sub_g, conv_w, conv_b,
              wa, ba, wx, bx, lru_lambda, rel_bias, lam_init):
    B, S, _ = h.shape
    z = h @ w_in
    q, k, v, xb, gb = jnp.split(
        z, [A_WIDTH, 2 * A_WIDTH, 3 * A_WIDTH, 3 * A_WIDTH + B_WIDTH], axis=-1)
    q = q.reshape(B, S, A_HEADS, 2, A_HEAD_DIM)
    k = k.reshape(B, S, A_HEADS, 2, A_HEAD_DIM)
    v = v.reshape(B, S, A_HEADS, 2 * A_HEAD_DIM)
    lam = (jnp.exp(jnp.sum(lq1.astype(jnp.float32) * lk1.astype(jnp.float32)))
           - jnp.exp(jnp.sum(lq2.astype(jnp.float32) * lk2.astype(jnp.float32))) + lam_init)
    ya = _diff_attention(q, k, v, rel_bias, lam, sub_g, lam_init)
    u = lax.conv_general_dilated(
        xb, conv_w[:, None, :], window_strides=(1,), padding=[(CONV_W - 1, 0)],
        dimension_numbers=('NWC', 'WIO', 'NWC'), feature_group_count=B_WIDTH) + conv_b
    yb = _rglru(u, wa, ba, wx, bx, lru_lambda) * jax.nn.gelu(gb)
    return jnp.concatenate([ya, yb], axis=-1) @ w_out


def _rwkv7_scan(r, w, k, v, kk, a):
    B, S_len, H, N = r.shape
    tm = lambda t: jnp.moveaxis(t.astype(jnp.float32), 1, 0)

    def step(state, inp):
        r_t, w_t, k_t, v_t, kk_t, a_t = inp
        sa = jnp.einsum('bhij,bhj->bhi', state, -kk_t)
        state = (state * w_t[:, :, None, :] + sa[..., None] * (kk_t * a_t)[:, :, None, :]
                 + v_t[..., None] * k_t[:, :, None, :])
        return state, jnp.einsum('bhij,bhj->bhi', state, r_t)

    s0 = jnp.zeros((B, H, N, N), jnp.float32)
    _, ys = lax.scan(step, s0, (tm(r), tm(w), tm(k), tm(v), tm(kk), tm(a)))
    return jnp.moveaxis(ys, 0, 1)


def _mixer_rwkv(h, mu, wr, wk, wv, wo, w0, w1, w2, a0, a1, a2, g1, g2,
                k_k, k_a, r_k, ln_g, ln_b):
    B, S, D = h.shape
    H, N = RWKV_HEADS, RWKV_HEAD
    xx = jnp.pad(h, ((0, 0), (1, 0), (0, 0)))[:, :-1] - h
    xr, xw, xk, xv, xa, xg = [h + xx * mu[n] for n in range(6)]
    r = xr @ wr
    w_log = -jax.nn.softplus(-(w0 + jnp.tanh(xw @ w1) @ w2).astype(jnp.float32)) - 0.5
    decay = jnp.exp(-jnp.exp(w_log))
    k = xk @ wk
    v = xv @ wv
    a = jax.nn.sigmoid(a0 + (xa @ a1) @ a2)
    g = jax.nn.sigmoid(xg @ g1) @ g2
    hd = lambda t: t.reshape(B, S, H, N)
    kk = hd(k * k_k).astype(jnp.float32)
    kk = kk / jnp.maximum(jnp.sqrt(jnp.sum(kk * kk, axis=-1, keepdims=True)), 1e-12)
    k = k * (1 + (a - 1) * k_a)
    r4, k4, v4, a4 = hd(r), hd(k), hd(v), hd(a)
    y = _rwkv7_scan(r4, hd(decay), k4, v4, kk, a4)
    m = jnp.mean(y, axis=-1, keepdims=True)
    var = jnp.mean(jnp.square(y - m), axis=-1, keepdims=True)
    yn = ((y - m) * lax.rsqrt(var + RWKV_GN_EPS)).reshape(B, S, D)
    yn = (yn * ln_g.astype(jnp.float32) + ln_b.astype(jnp.float32)).astype(h.dtype)
    bonus = (jnp.sum(r4 * k4 * r_k, axis=-1, keepdims=True) * v4).reshape(B, S, D)
    return ((yn + bonus) * g) @ wo


def _hier_moe(h, wc, bc, wf, bf, w_gu, w_down):
    B, S, D = h.shape
    T = B * S
    M = T * MOE_TOPK
    n_blk = -(-(M + N_EXPERTS * (MOE_BLOCK - 1)) // MOE_BLOCK)
    xf = h.reshape(T, D)
    pc = jax.nn.softmax((xf @ wc + bc).astype(jnp.float32), axis=-1)
    gprob, gidx = lax.top_k(pc, 1)
    lf = (xf @ wf + bf).astype(jnp.float32).reshape(T, MOE_GROUPS, EXPERTS_PER_GROUP)
    lf = jnp.take_along_axis(lf, gidx[:, :, None], axis=1)[:, 0]
    fv, fi = lax.top_k(jax.nn.softmax(lf, axis=-1), MOE_TOPK)
    gate = gprob * fv / jnp.sum(fv, axis=-1, keepdims=True)
    eid = (gidx * EXPERTS_PER_GROUP + fi).reshape(-1)
    tok = jnp.repeat(jnp.arange(T, dtype=jnp.int32), MOE_TOPK)
    order = jnp.argsort(eid)
    e_s, tok_s, gate_s = eid[order], tok[order], gate.reshape(-1)[order]
    sizes = jnp.bincount(eid, length=N_EXPERTS)
    padded = (sizes + MOE_BLOCK - 1) // MOE_BLOCK * MOE_BLOCK
    pend = jnp.cumsum(padded)
    dest = (pend - padded)[e_s] + jnp.arange(M) - (jnp.cumsum(sizes) - sizes)[e_s]
    rows_tok = jnp.full((n_blk * MOE_BLOCK,), T, jnp.int32).at[dest].set(tok_s)
    rows_gate = jnp.zeros((n_blk * MOE_BLOCK,), jnp.float32).at[dest].set(gate_s)
    blk_e = jnp.minimum(jnp.searchsorted(pend, jnp.arange(n_blk) * MOE_BLOCK, side='right'),
                        N_EXPERTS - 1)
    xpad = jnp.concatenate([xf, jnp.zeros((1, D), xf.dtype)], axis=0)

    def expert_block(args):
        idx, e = args
        gpart, upart = jnp.split(xpad[idx] @ w_gu[e], 2, axis=-1)
        return (jax.nn.silu(gpart) * upart) @ w_down[e]

    ys = lax.map(expert_block, (rows_tok.reshape(n_blk, MOE_BLOCK), blk_e))
    ys = ys.reshape(-1, D) * rows_gate[:, None].astype(ys.dtype)
    out = jnp.zeros((T + 1, D), ys.dtype).at[rows_tok].add(ys)[:T]
    return out.reshape(B, S, D)


def _per_layer_embed(x, p_i, g_norm, w_gate, w_proj):
    gate = jax.nn.sigmoid(_rmsnorm(x, g_norm) @ w_gate)
    return (p_i @ w_proj) * gate


def setup_inputs(seed: int = 0) -> dict:
    key = jax.random.key(seed)
    ks = iter(jax.random.split(key, 64))
    f32 = jnp.float32
    nrm = lambda shape, fan_in, s=1.0: jax.random.normal(next(ks), shape, f32) * (s * fan_in ** -0.5)
    gain = lambda shape: 1.0 + 0.02 * jax.random.normal(next(ks), shape, f32)
    small = lambda shape, s=0.01: s * jax.random.normal(next(ks), shape, f32)
    unif = lambda shape, lo, hi: jax.random.uniform(next(ks), shape, f32, lo, hi)
    D = D_MODEL
    a_c = unif((N_EVEN, B_WIDTH), 0.9, 0.999)
    a_base = a_c ** (1.0 / LRU_C)
    lru_lambda = jnp.log(a_base) - jnp.log1p(-a_base)
    return {
        "x": jax.random.normal(next(ks), (BATCH, SEQ, D), f32),
        "p": jax.random.normal(next(ks), (DEPTH, BATCH, SEQ, PLE_DIM), f32),
        "rel_bias": small((REL_BUCKETS, A_HEADS), 0.5),
        "norm_mix": gain((DEPTH, D)),
        "ab_w_in": nrm((N_EVEN, D, AB_IN), D),
        "ab_w_out": nrm((N_EVEN, A_WIDTH + B_WIDTH, D), A_WIDTH + B_WIDTH),
        "lam_q1": small((N_EVEN, A_HEAD_DIM), 0.1),
        "lam_k1": small((N_EVEN, A_HEAD_DIM), 0.1),
        "lam_q2": small((N_EVEN, A_HEAD_DIM), 0.1),
        "lam_k2": small((N_EVEN, A_HEAD_DIM), 0.1),
        "sub_g": gain((N_EVEN, 2 * A_HEAD_DIM)),
        "conv_w": nrm((N_EVEN, CONV_W, B_WIDTH), CONV_W),
        "conv_b": small((N_EVEN, B_WIDTH)),
        "lru_wa": nrm((N_EVEN, LRU_BLOCKS, LRU_BW, LRU_BW), LRU_BW),
        "lru_ba": small((N_EVEN, B_WIDTH)),
        "lru_wx": nrm((N_EVEN, LRU_BLOCKS, LRU_BW, LRU_BW), LRU_BW),
        "lru_bx": small((N_EVEN, B_WIDTH)),
        "lru_lambda": lru_lambda,
        "rwkv_mu": unif((N_ODD, 6, D), 0.0, 1.0),
        "rwkv_wr": nrm((N_ODD, D, D), D),
        "rwkv_wk": nrm((N_ODD, D, D), D),
        "rwkv_wv": nrm((N_ODD, D, D), D),
        "rwkv_wo": nrm((N_ODD, D, D), D),
        "rwkv_w0": unif((N_ODD, D), -5.0, 0.0),
        "rwkv_w1": nrm((N_ODD, D, DECAY_LORA), D),
        "rwkv_w2": nrm((N_ODD, DECAY_LORA, D), DECAY_LORA, 0.5),
        "rwkv_a0": small((N_ODD, D), 0.1),
        "rwkv_a1": nrm((N_ODD, D, AAA_LORA), D),
        "rwkv_a2": nrm((N_ODD, AAA_LORA, D), AAA_LORA),
        "rwkv_g1": nrm((N_ODD, D, GATE_LORA), D),
        "rwkv_g2": nrm((N_ODD, GATE_LORA, D), GATE_LORA),
        "rwkv_kk": 0.85 * gain((N_ODD, D)),
        "rwkv_ka": gain((N_ODD, D)),
        "rwkv_rk": small((N_ODD, RWKV_HEADS, RWKV_HEAD), 0.1),
        "rwkv_ln_g": gain((N_ODD, D)),
        "rwkv_ln_b": small((N_ODD, D)),
        "norm_ffn": gain((DEPTH, D)),
        "moe_wc": nrm((DEPTH, D, MOE_GROUPS), D),
        "moe_bc": small((DEPTH, MOE_GROUPS)),
        "moe_wf": nrm((DEPTH, D, N_EXPERTS), D),
        "moe_bf": small((DEPTH, N_EXPERTS)),
        "moe_w_gu": nrm((DEPTH, N_EXPERTS, D, 2 * EXPERT_HIDDEN), D),
        "moe_w_down": nrm((DEPTH, N_EXPERTS, EXPERT_HIDDEN, D), EXPERT_HIDDEN),
        "ple_norm": gain((DEPTH, D)),
        "ple_gate": nrm((DEPTH, D, D), D),
        "ple_proj": nrm((DEPTH, PLE_DIM, D), PLE_DIM),
        "final_norm": gain((D,)),
    }


def reference(x, p, rel_bias, norm_mix, ab_w_in, ab_w_out, lam_q1, lam_k1, lam_q2, lam_k2,
              sub_g, conv_w, conv_b, lru_wa, lru_ba, lru_wx, lru_bx, lru_lambda,
              rwkv_mu, rwkv_wr, rwkv_wk, rwkv_wv, rwkv_wo, rwkv_w0, rwkv_w1, rwkv_w2,
              rwkv_a0, rwkv_a1, rwkv_a2, rwkv_g1, rwkv_g2, rwkv_kk, rwkv_ka, rwkv_rk,
              rwkv_ln_g, rwkv_ln_b, norm_ffn, moe_wc, moe_bc, moe_wf, moe_bf,
              moe_w_gu, moe_w_down, ple_norm, ple_gate, ple_proj, final_norm):
    for i in range(DEPTH):
        j = i // 2
        h = _rmsnorm(x, norm_mix[i])
        if i % 2 == 0:
            lam_init = 0.8 - 0.6 * math.exp(-0.3 * i)
            x = x + _mixer_ab(h, ab_w_in[j], ab_w_out[j], lam_q1[j], lam_k1[j], lam_q2[j],
                              lam_k2[j], sub_g[j], conv_w[j], conv_b[j], lru_wa[j], lru_ba[j],
                              lru_wx[j], lru_bx[j], lru_lambda[j], rel_bias, lam_init)
        else:
            x = x + _mixer_rwkv(h, rwkv_mu[j], rwkv_wr[j], rwkv_wk[j], rwkv_wv[j], rwkv_wo[j],
                                rwkv_w0[j], rwkv_w1[j], rwkv_w2[j], rwkv_a0[j], rwkv_a1[j],
                                rwkv_a2[j], rwkv_g1[j], rwkv_g2[j], rwkv_kk[j], rwkv_ka[j],
                                rwkv_rk[j], rwkv_ln_g[j], rwkv_ln_b[j])
        x = x + _hier_moe(_rmsnorm(x, norm_ffn[i]), moe_wc[i], moe_bc[i], moe_wf[i], moe_bf[i],
                          moe_w_gu[i], moe_w_down[i])
        x = x + _per_layer_embed(x, p[i], ple_norm[i], ple_gate[i], ple_proj[i])
    return _rmsnorm(x, final_norm)
```

```cpp
#include <hip/hip_runtime.h>
#include <hip/hip_bf16.h>
#include <cstdio>
#include <cstdint>
#include <cmath>

#ifndef MK_ONE_LAUNCH
#define MK_ONE_LAUNCH 1
#endif

#define GAS __attribute__((address_space(1)))
#define LAS __attribute__((address_space(3)))
typedef unsigned short bf16;
typedef unsigned v4u __attribute__((ext_vector_type(4)));
typedef unsigned v2u __attribute__((ext_vector_type(2)));
typedef float f32x4 __attribute__((ext_vector_type(4)));
typedef float f32x2 __attribute__((ext_vector_type(2)));
typedef short bf16x8 __attribute__((ext_vector_type(8)));
typedef GAS unsigned gu32;
#define RLX_AGENT __ATOMIC_RELAXED, __HIP_MEMORY_SCOPE_AGENT
#define LDS_WAIT() asm volatile("s_waitcnt lgkmcnt(0)" ::: "memory")
#define VM_WAIT() asm volatile("s_waitcnt vmcnt(0)" ::: "memory")
__device__ __forceinline__ unsigned f2bf(float f) { unsigned u = __builtin_bit_cast(unsigned, f); return (u + 0x7fffu + ((u >> 16) & 1u)) >> 16; }
__device__ __forceinline__ unsigned pk2(float lo, float hi) { return f2bf(lo) | (f2bf(hi) << 16); }
__device__ __forceinline__ float bflo(unsigned w) { return __uint_as_float(w << 16); }
__device__ __forceinline__ float bfhi(unsigned w) { return __uint_as_float(w & 0xffff0000u); }
__device__ __forceinline__ float bf1(bf16 h) { return __uint_as_float((unsigned)h << 16); }
__device__ __forceinline__ float sigmoidf_(float x) { return 1.0f / (1.0f + __expf(-x)); }
__device__ __forceinline__ void fmac_(float& acc, float a, float b) { asm("v_fmac_f32 %0, %1, %2" : "+v"(acc) : "v"(a), "v"(b)); }
__device__ __forceinline__ float fma_(float a, float b, float c) { float r; asm("v_fma_f32 %0, %1, %2, %3" : "=v"(r) : "v"(a), "v"(b), "v"(c)); return r; }
__device__ __forceinline__ float mul_(float a, float b) { float r; asm("v_mul_f32 %0, %1, %2" : "=v"(r) : "v"(a), "v"(b)); return r; }
__device__ __forceinline__ float wave_sum(float v) {
#pragma unroll
    for (int o = 1; o < 64; o <<= 1) v += __shfl_xor(v, o);
    return v;
}

constexpr int NB = 8, SEQ = 8192, D = 1024, T = NB * SEQ;
constexpr int AB_IN = 2560, PLE = 256;
constexpr int NEXP = 32, EH = 512;
constexpr int MAXSLOT = 2 * T + NEXP * 256;
constexpr int MAXTILES = MAXSLOT / 256;

namespace pg8 {
#define PG8_LAS __attribute__((address_space(3)))
typedef unsigned short bf16_t;
typedef unsigned u32x4 __attribute__((ext_vector_type(4)));
typedef unsigned u32x2 __attribute__((ext_vector_type(2)));
constexpr int BM = 256, BK = 64, HALF = 128, HTB = HALF * BK * 2, STAGE_BYTES = 8 * HTB, NXCD = 8, WGM = 8;
__host__ __device__ __forceinline__ int lds_byte(int r, int c) { const int st = (r >> 4) * 2 + (c >> 5), rr = r & 15, cc = c & 31, ob = rr * 64 + cc * 2; return st * 1024 + (ob ^ (((ob >> 9) & 1) << 5)); }
__host__ __device__ __forceinline__ void stage_rc(int b, int& R, int& C) { const int st = b / 1024, sb = b % 1024, swz = sb ^ (((sb >> 9) & 1) << 5); R = (st >> 1) * 16 + swz / 64; C = (st & 1) * 32 + (swz % 64) / 2; }
__host__ __device__ __forceinline__ int perm32(int rho) { const int n = rho >> 4, i = rho & 15; return 8 * (i >> 2) + 4 * n + (i & 3); }

struct Unit { int pm, pn, aux; const char* A; const char* B; };

struct DenseOrder {
    int nM, nN, nwg, G, c; const char* A; const char* B; size_t astep, bstep;
    __device__ void init(const void* A_, int lda, const void* B_, int K, int M, int N, int G_, int c_) { nM = M / BM; nN = N / BM; nwg = nM * nN; G = G_; c = c_; A = (const char*)A_; B = (const char*)B_; astep = (size_t)BM * lda * 2; bstep = (size_t)BM * K * 2; }
    __device__ bool next(int i, Unit& u) const {
        const long L = (long)i * G + c; if (L >= nwg) return false;
        int wgid = (int)L; { const int q = nwg / NXCD, r = nwg % NXCD, xcd = wgid % NXCD, off = wgid / NXCD; wgid = (xcd < r ? xcd * (q + 1) : r * (q + 1) + (xcd - r) * q) + off; }
        const int nig = WGM * nN, gid = wgid / nig, fm = gid * WGM, gsz = (nM - fm) < WGM ? (nM - fm) : WGM;
        u.pm = fm + ((wgid % nig) % gsz); u.pn = (wgid % nig) / gsz; u.aux = 0; u.A = A + (size_t)u.pm * astep; u.B = B + (size_t)u.pn * bstep; return true;
    }
};

__device__ __forceinline__ unsigned cvt_pk_bf16(float lo, float hi) { unsigned r; asm volatile("v_cvt_pk_bf16_f32 %0, %1, %2" : "=v"(r) : "v"(lo), "v"(hi)); return r; }

typedef f32x4 Acc[2][2][4][2];

struct EpiBf16 {
    static constexpr bool PERM = true;
    bf16_t* O; int ldc; int split_cols; size_t split_stride; float scale0;
    __device__ __forceinline__ void operator()(const Acc& acc, const Unit& u, int wr, int wc, int fr, int fq) const {
        const int row0 = u.pm * BM + wr * 64 + fr; int colt = u.pn * BM; bf16_t* base = O;
        float sc = 1.f; if (split_cols) { const int t = colt / split_cols; base += (size_t)t * split_stride; colt -= t * split_cols; if (t == 0) sc = scale0; }
        const int col0 = colt + wc * 32 + 8 * fq;
#pragma unroll
        for (int ai = 0; ai < 2; ++ai)
#pragma unroll
            for (int m = 0; m < 4; ++m) { bf16_t* rowp = base + (size_t)(row0 + ai * HALF + m * 16) * ldc + col0;
#pragma unroll
                for (int bj = 0; bj < 2; ++bj) { f32x4 v0 = acc[ai][bj][m][0] * sc, v1 = acc[ai][bj][m][1] * sc;
                    u32x4 w; w.x = cvt_pk_bf16(v0[0], v0[1]); w.y = cvt_pk_bf16(v0[2], v0[3]); w.z = cvt_pk_bf16(v1[0], v1[1]); w.w = cvt_pk_bf16(v1[2], v1[3]);
                    *(u32x4*)(rowp + bj * HALF) = w; } }
    }
};
struct EpiResF32 {
    static constexpr bool PERM = false;
    const float* base; float* out;
    __device__ __forceinline__ void operator()(const Acc& acc, const Unit& u, int wr, int wc, int fr, int fq) const {
        const int col0 = u.pn * BM + wc * 32 + 4 * fq;
#pragma unroll
        for (int ai = 0; ai < 2; ++ai)
#pragma unroll
            for (int m = 0; m < 4; ++m) { const size_t off = (size_t)(u.pm * BM + ai * HALF + wr * 64 + m * 16 + fr) * 1024 + col0;
#pragma unroll
                for (int bj = 0; bj < 2; ++bj)
#pragma unroll
                    for (int n = 0; n < 2; ++n) { const f32x4 bs = *(const f32x4*)(base + off + bj * HALF + n * 16); *(f32x4*)(out + off + bj * HALF + n * 16) = bs + acc[ai][bj][m][n]; } }
    }
};
struct EpiRouter {
    static constexpr bool PERM = false;
    float* out;
    __device__ __forceinline__ void operator()(const Acc& acc, const Unit& u, int wr, int wc, int fr, int fq) const {
        if (wc >= 2) return;
#pragma unroll
        for (int ai = 0; ai < 2; ++ai)
#pragma unroll
            for (int m = 0; m < 4; ++m) { const size_t off = (size_t)(u.pm * BM + ai * HALF + wr * 64 + m * 16 + fr) * 64 + wc * 32 + 4 * fq;
#pragma unroll
                for (int n = 0; n < 2; ++n) *(f32x4*)(out + off + n * 16) = acc[ai][0][m][n]; }
    }
};
struct EpiGU {
    static constexpr bool PERM = true;
    bf16_t* H;
    __device__ __forceinline__ void operator()(const Acc& acc, const Unit& u, int wr, int wc, int fr, int fq) const {
        const int col0 = u.pn * 128 + wc * 32 + 8 * fq;
#pragma unroll
        for (int ai = 0; ai < 2; ++ai)
#pragma unroll
            for (int m = 0; m < 4; ++m) { bf16_t* rowp = H + (size_t)(u.pm * BM + ai * HALF + wr * 64 + m * 16 + fr) * EH + col0;
                f32x4 g0 = acc[ai][0][m][0], g1 = acc[ai][0][m][1]; const f32x4 u0 = acc[ai][1][m][0], u1 = acc[ai][1][m][1];
#pragma unroll
                for (int e = 0; e < 4; ++e) { g0[e] = g0[e] * sigmoidf_(g0[e]) * u0[e]; g1[e] = g1[e] * sigmoidf_(g1[e]) * u1[e]; }
                u32x4 w; w.x = cvt_pk_bf16(g0[0], g0[1]); w.y = cvt_pk_bf16(g0[2], g0[3]); w.z = cvt_pk_bf16(g1[0], g1[1]); w.w = cvt_pk_bf16(g1[2], g1[3]);
                *(u32x4*)rowp = w; }
    }
};
struct EpiDown {
    static constexpr bool PERM = true;
    bf16_t* Y; const float* gate;
    __device__ __forceinline__ void operator()(const Acc& acc, const Unit& u, int wr, int wc, int fr, int fq) const {
        const int col0 = u.pn * BM + wc * 32 + 8 * fq;
#pragma unroll
        for (int ai = 0; ai < 2; ++ai)
#pragma unroll
            for (int m = 0; m < 4; ++m) { const int row = u.pm * BM + ai * HALF + wr * 64 + m * 16 + fr; const float sc = gate[row]; bf16_t* rowp = Y + (size_t)row * 1024 + col0;
#pragma unroll
                for (int bj = 0; bj < 2; ++bj) { const f32x4 v0 = acc[ai][bj][m][0] * sc, v1 = acc[ai][bj][m][1] * sc;
                    u32x4 w; w.x = cvt_pk_bf16(v0[0], v0[1]); w.y = cvt_pk_bf16(v0[2], v0[3]); w.z = cvt_pk_bf16(v1[0], v1[1]); w.w = cvt_pk_bf16(v1[2], v1[3]);
                    *(u32x4*)(rowp + bj * HALF) = w; } }
    }
};
struct EpiPle {
    static constexpr bool PERM = false;
    float* x; const bf16_t* pp;
    __device__ __forceinline__ void operator()(const Acc& acc, const Unit& u, int wr, int wc, int fr, int fq) const {
        const int col0 = u.pn * BM + wc * 32 + 4 * fq;
#pragma unroll
        for (int ai = 0; ai < 2; ++ai)
#pragma unroll
            for (int m = 0; m < 4; ++m) { const size_t off = (size_t)(u.pm * BM + ai * HALF + wr * 64 + m * 16 + fr) * 1024 + col0;
#pragma unroll
                for (int bj = 0; bj < 2; ++bj)
#pragma unroll
                    for (int n = 0; n < 2; ++n) { const size_t o = off + bj * HALF + n * 16; const f32x4 bs = *(const f32x4*)(x + o); const u32x2 pw = *(const u32x2*)(pp + o);
                        const f32x4 a = acc[ai][bj][m][n]; f32x4 r;
                        r[0] = bs[0] + bflo(pw.x) * sigmoidf_(a[0]); r[1] = bs[1] + bfhi(pw.x) * sigmoidf_(a[1]); r[2] = bs[2] + bflo(pw.y) * sigmoidf_(a[2]); r[3] = bs[3] + bfhi(pw.y) * sigmoidf_(a[3]);
                        *(f32x4*)(x + o) = r; } }
    }
};
struct EpiRwkv1 {
    static constexpr bool PERM = true;
    bf16_t* RKV; size_t stride; bf16_t* MID;
    __device__ __forceinline__ void operator()(const Acc& acc, const Unit& u, int wr, int wc, int fr, int fq) const {
        const int row0 = u.pm * BM + wr * 64 + fr;
        if (u.pn < 12) {
            const int t = u.pn >> 2; bf16_t* base = RKV + (size_t)t * stride; const int col0 = (u.pn & 3) * BM + wc * 32 + 8 * fq;
#pragma unroll
            for (int ai = 0; ai < 2; ++ai)
#pragma unroll
                for (int m = 0; m < 4; ++m) { bf16_t* rowp = base + (size_t)(row0 + ai * HALF + m * 16) * 1024 + col0;
#pragma unroll
                    for (int bj = 0; bj < 2; ++bj) { const f32x4 v0 = acc[ai][bj][m][0], v1 = acc[ai][bj][m][1];
                        u32x4 w; w.x = cvt_pk_bf16(v0[0], v0[1]); w.y = cvt_pk_bf16(v0[2], v0[3]); w.z = cvt_pk_bf16(v1[0], v1[1]); w.w = cvt_pk_bf16(v1[2], v1[3]);
                        *(u32x4*)(rowp + bj * HALF) = w; } }
        } else {
            const int mode = (u.pn == 13) ? 2 : 0;
            const int colbase = (u.pn - 12) * 256;
#pragma unroll
            for (int ai = 0; ai < 2; ++ai)
#pragma unroll
                for (int m = 0; m < 4; ++m) { bf16_t* rowp = MID + (size_t)(row0 + ai * HALF + m * 16) * 512 + colbase;
#pragma unroll
                    for (int bj = 0; bj < 2; ++bj) { const int lc = bj * HALF + wc * 32 + 8 * fq; f32x4 v0 = acc[ai][bj][m][0], v1 = acc[ai][bj][m][1];
#pragma unroll
                        for (int e = 0; e < 4; ++e) {
                            if (mode == 2) { v0[e] = sigmoidf_(v0[e]); v1[e] = sigmoidf_(v1[e]); }
                            else if (lc < 64) { v0[e] = tanhf(v0[e]); v1[e] = tanhf(v1[e]); } }
                        u32x4 w; w.x = cvt_pk_bf16(v0[0], v0[1]); w.y = cvt_pk_bf16(v0[2], v0[3]); w.z = cvt_pk_bf16(v1[0], v1[1]); w.w = cvt_pk_bf16(v1[2], v1[3]);
                        *(u32x4*)(rowp + lc) = w; } }
        }
    }
};
struct EpiRwkv2 {
    static constexpr bool PERM = true;
    bf16_t* O0; bf16_t* O1; const float* bias0; const float* bias1; int tybase;
    __device__ __forceinline__ void operator()(const Acc& acc, const Unit& u, int wr, int wc, int fr, int fq) const {
        const int ty = tybase + (u.pn >> 2); const int row0 = u.pm * BM + wr * 64 + fr; const int colt = (u.pn & 3) * BM + wc * 32 + 8 * fq;
        bf16_t* base = (u.pn >> 2) ? O1 : O0; const float* bias = (u.pn >> 2) ? bias1 : bias0;
#pragma unroll
        for (int bj = 0; bj < 2; ++bj) {
            f32x4 b0 = (f32x4){0.f, 0.f, 0.f, 0.f}, b1 = b0;
            if (ty < 2) { b0 = *(const f32x4*)(bias + colt + bj * HALF); b1 = *(const f32x4*)(bias + colt + bj * HALF + 4); }
#pragma unroll
            for (int ai = 0; ai < 2; ++ai)
#pragma unroll
                for (int m = 0; m < 4; ++m) { bf16_t* rowp = base + (size_t)(row0 + ai * HALF + m * 16) * 1024 + colt + bj * HALF;
                    f32x4 v0 = acc[ai][bj][m][0] + b0, v1 = acc[ai][bj][m][1] + b1;
                    if (ty < 2) { const float s = (ty == 0) ? 0.6065306597126334f : 1.0f;
#pragma unroll
                        for (int e = 0; e < 4; ++e) { v0[e] = s * sigmoidf_(v0[e]); v1[e] = s * sigmoidf_(v1[e]); } }
                    u32x4 w; w.x = cvt_pk_bf16(v0[0], v0[1]); w.y = cvt_pk_bf16(v0[2], v0[3]); w.z = cvt_pk_bf16(v1[0], v1[1]); w.w = cvt_pk_bf16(v1[2], v1[3]);
                    *(u32x4*)rowp = w; }
        }
    }
};

template <class Epi, class Sched, bool ALIGN_EPI, bool GATHER>
__device__ __forceinline__ void gemm_phase(PG8_LAS unsigned char* lds, const int K, const int lda, const Sched& S, const Epi& E, const int* __restrict__ rows) {
    const int tid = threadIdx.x, wid = __builtin_amdgcn_readfirstlane(tid >> 6), lane = tid & 63, wr = wid >> 2, wc = wid & 3, fr = lane & 15, fq = lane >> 4;
    const int nt = K / BK;
    unsigned voffA[2], voffB[2]; int RA[2];
#pragma unroll
    for (int i = 0; i < 2; ++i) { int R, C; stage_rc(tid * 16 + i * 8192, R, C); const int Rb = Epi::PERM ? ((R & ~31) + perm32(R & 31)) : R;
        RA[i] = R; voffA[i] = GATHER ? (unsigned)(C * 2) : (unsigned)(R * lda + C) * 2u; voffB[i] = (unsigned)(Rb * K + C) * 2u; }
    const size_t kstep = (size_t)(BK * 2);
    const size_t hstepA = GATHER ? 0 : (size_t)HALF * lda * 2, hstepB = (size_t)HALF * K * 2;
    const unsigned ldsw = (unsigned)wid * 1024u;
    const int aoff = lds_byte(wr * 64 + fr, fq * 8), boff = lds_byte(wc * 32 + fr, fq * 8);
#define PG8_SA(b, h) (((b) * 2 + (h)) * HTB)
#define PG8_SB(b, h) ((4 + (b) * 2 + (h)) * HTB)
#define PG8_ST2(bufoff, gbase, o0, o1) do { \
        __builtin_amdgcn_global_load_lds((const unsigned*)((const char*)(gbase) + (o0)), (PG8_LAS unsigned*)(lds + (bufoff) + ldsw), 16, 0, 0); \
        __builtin_amdgcn_global_load_lds((const unsigned*)((const char*)(gbase) + (o1)), (PG8_LAS unsigned*)(lds + (bufoff) + ldsw + 8192), 16, 0, 0); } while (0)
#define PG8_STB(bufoff, gbase) PG8_ST2(bufoff, gbase, voffB[0], voffB[1])
#define PG8_STA(bufoff, p, h, nx) do { if constexpr (GATHER) { const unsigned g0_ = (nx) ? gN[h][0] : gC[h][0], g1_ = (nx) ? gN[h][1] : gC[h][1]; PG8_ST2(bufoff, p, g0_, g1_); } \
        else { PG8_ST2(bufoff, (p) + (h) * hstepA, voffA[0], voffA[1]); } } while (0)
#define PG8_LDA(dst, b, h) do { _Pragma("unroll") for (int m = 0; m < 4; ++m) _Pragma("unroll") for (int k = 0; k < 2; ++k) dst[m][k] = *(const PG8_LAS bf16x8*)(lds + PG8_SA(b, h) + aoff + m * 2048 + k * 1024); } while (0)
#define PG8_LDB(dst, b, h) do { _Pragma("unroll") for (int n = 0; n < 2; ++n) _Pragma("unroll") for (int k = 0; k < 2; ++k) dst[n][k] = *(const PG8_LAS bf16x8*)(lds + PG8_SB(b, h) + boff + n * 2048 + k * 1024); } while (0)
#define PG8_MMA(ai, bj, At, Bt) do { __builtin_amdgcn_s_setprio(1); _Pragma("unroll") for (int m = 0; m < 4; ++m) _Pragma("unroll") for (int n = 0; n < 2; ++n) _Pragma("unroll") for (int k = 0; k < 2; ++k) \
        acc[ai][bj][m][n] = __builtin_amdgcn_mfma_f32_16x16x32_bf16(Bt[n][k], At[m][k], acc[ai][bj][m][n], 0, 0, 0); __builtin_amdgcn_s_setprio(0); } while (0)
#define PG8_WAIT_V(n) asm volatile("s_waitcnt vmcnt(" #n ")" ::: "memory")
#define PG8_WAIT_L(n) asm volatile("s_waitcnt lgkmcnt(" #n ")" ::: "memory")
#define PG8_BAR __builtin_amdgcn_s_barrier()
#define PG8_SCHED __builtin_amdgcn_sched_barrier(0)
#define PG8_GLOAD(dst, un) do { if constexpr (GATHER) { _Pragma("unroll") for (int h_ = 0; h_ < 2; ++h_) _Pragma("unroll") for (int i_ = 0; i_ < 2; ++i_) \
        dst[h_][i_] = (unsigned)rows[(un).pm * BM + h_ * HALF + RA[i_]] * (unsigned)(lda * 2) + voffA[i_]; } } while (0)
    Unit cur, nxt; int ui = 0;
    if (!S.next(0, cur)) return;
    unsigned gC[2][2] = {{0u, 0u}, {0u, 0u}}, gN[2][2] = {{0u, 0u}, {0u, 0u}};
    PG8_GLOAD(gC, cur);
    Acc acc;
#pragma unroll
    for (int a = 0; a < 2; ++a)
#pragma unroll
        for (int b = 0; b < 2; ++b)
#pragma unroll
            for (int m = 0; m < 4; ++m)
#pragma unroll
                for (int n = 0; n < 2; ++n) acc[a][b][m][n] = (f32x4){0.f, 0.f, 0.f, 0.f};
    bf16x8 At[4][2], B0[2][2], B1[2][2];
    const char* cA = cur.A; const char* cB = cur.B;
    PG8_STB(PG8_SB(0, 0), cB); PG8_STB(PG8_SB(0, 1), cB + hstepB); PG8_STA(PG8_SA(0, 0), cA, 0, false); PG8_STA(PG8_SA(0, 1), cA, 1, false);
    if (wr == 1) PG8_BAR;
    PG8_WAIT_V(2); PG8_BAR;
    PG8_STB(PG8_SB(1, 0), cB + kstep); PG8_STA(PG8_SA(1, 0), cA + kstep, 0, false); PG8_STB(PG8_SB(1, 1), cB + hstepB + kstep);
    PG8_WAIT_V(6); PG8_BAR;
    for (;;) {
        const bool has_next = S.next(ui + 1, nxt);
        if (has_next) { PG8_GLOAD(gN, nxt); }
        const char* nA = has_next ? nxt.A : cA; const char* nB = has_next ? nxt.B : cB;
#pragma unroll 1
        for (int t = 0; t < nt; t += 2) {
            const bool last = (t == nt - 2); const bool nx = last && has_next;
            const char* a1 = cA + (size_t)(t + 1) * kstep;
            const char* a2 = last ? nA : cA + (size_t)(t + 2) * kstep; const char* b2 = last ? nB : cB + (size_t)(t + 2) * kstep;
            const char* a3 = a2 + kstep; const char* b3 = b2 + kstep;
            PG8_LDB(B0, 0, 0); PG8_LDB(B1, 0, 1); PG8_SCHED; PG8_LDA(At, 0, 0); PG8_STA(PG8_SA(1, 1), a1, 1, false);
            PG8_WAIT_V(8); PG8_WAIT_L(0); PG8_BAR; PG8_MMA(0, 0, At, B0); PG8_MMA(0, 1, At, B1); PG8_BAR; PG8_SCHED;
            PG8_LDA(At, 0, 1); PG8_STB(PG8_SB(0, 0), b2); PG8_STB(PG8_SB(0, 1), b2 + hstepB); PG8_STA(PG8_SA(0, 0), a2, 0, nx);
            PG8_WAIT_V(8); PG8_WAIT_L(0); PG8_BAR; PG8_MMA(1, 0, At, B0); PG8_MMA(1, 1, At, B1); PG8_BAR; PG8_SCHED;
            PG8_LDB(B0, 1, 0); PG8_LDB(B1, 1, 1); PG8_SCHED; PG8_LDA(At, 1, 0); PG8_STA(PG8_SA(0, 1), a2, 1, nx);
            PG8_WAIT_V(8); PG8_WAIT_L(0); PG8_BAR; PG8_MMA(0, 0, At, B0); PG8_MMA(0, 1, At, B1); PG8_BAR; PG8_SCHED;
            PG8_LDA(At, 1, 1); PG8_STB(PG8_SB(1, 0), b3); PG8_STB(PG8_SB(1, 1), b3 + hstepB); PG8_STA(PG8_SA(1, 0), a3, 0, nx);
            PG8_WAIT_V(8); PG8_WAIT_L(0); PG8_BAR; PG8_MMA(1, 0, At, B0); PG8_MMA(1, 1, At, B1); PG8_BAR; PG8_SCHED;
        }
        if constexpr (ALIGN_EPI) { if (wr == 0) PG8_BAR; }
        E(acc, cur, wr, wc, fr, fq);
        if (!has_next) break;
#pragma unroll
        for (int a = 0; a < 2; ++a)
#pragma unroll
            for (int b = 0; b < 2; ++b)
#pragma unroll
                for (int m = 0; m < 4; ++m)
#pragma unroll
                    for (int n = 0; n < 2; ++n) acc[a][b][m][n] = (f32x4){0.f, 0.f, 0.f, 0.f};
        cur = nxt; cA = nA; cB = nB; ++ui;
        if constexpr (GATHER) {
#pragma unroll
            for (int h_ = 0; h_ < 2; ++h_)
#pragma unroll
                for (int i_ = 0; i_ < 2; ++i_) gC[h_][i_] = gN[h_][i_]; }
        if constexpr (ALIGN_EPI) { if (wr == 1) PG8_BAR; }
    }
    PG8_WAIT_V(0);
    if constexpr (!ALIGN_EPI) { if (wr == 0) PG8_BAR; }
    PG8_BAR;
#undef PG8_SA
#undef PG8_SB
#undef PG8_ST2
#undef PG8_STB
#undef PG8_STA
#undef PG8_LDA
#undef PG8_LDB
#undef PG8_MMA
#undef PG8_WAIT_V
#undef PG8_WAIT_L
#undef PG8_BAR
#undef PG8_SCHED
#undef PG8_GLOAD
}
}
namespace attn_body {
using bf16=__hip_bfloat16;
using bf16x8=__attribute__((ext_vector_type(8)))short;
using s16x4=__attribute__((ext_vector_type(4)))short;
using f32x16=__attribute__((ext_vector_type(16)))float;
using u32x4=__attribute__((ext_vector_type(4)))unsigned;
constexpr int BATCH=8,NHEAD=16,SEQ=8192,D=64,PQ=512,PO=1024;
constexpr int NW=8,QBLK=32,QB=QBLK*NW,KVBLK=64,NQB=SEQ/QB;
constexpr int ATTN_UNIT_ROWS=QB;
__device__ __forceinline__ int crow(int r,int hi){return (r&3)+8*(r>>2)+4*hi;}
#define SBAR() __builtin_amdgcn_sched_barrier(0)
__device__ __forceinline__ void cmask(f32x16&p0,f32x16&p1,int jb,int qrel,int hi){
  const float NEG=-INFINITY; int kb=64*jb+4*hi;
  #pragma unroll
  for(int r=0;r<16;++r){int kv=kb+(r&3)+8*(r>>2); if(kv>qrel)p0[r]=NEG; if(kv+32>qrel)p1[r]=NEG;}
}

__device__ __forceinline__ void cbias(f32x16&p0,f32x16&p1,int jb,int qrel,int hi,const __attribute__((address_space(3))) float*tb){
  const int kb=64*jb+4*hi;
  #pragma unroll
  for(int r=0;r<16;++r){const int rel=qrel-(kb+(r&3)+8*(r>>2)); const int i0=min(max(rel,0),127), i1=min(max(rel-32,0),127); p0[r]+=tb[i0]; p1[r]+=tb[i1];}
}
constexpr int NSLOT=3, SLOTB=8192;
constexpr int LDS_K=0, LDS_V=NSLOT*SLOTB, LDS_WS=2*NSLOT*SLOTB, LDS_OST=LDS_WS+NW*64*4, LDS_BYTES=LDS_OST+NW*4096;
constexpr float C2=0.125f*1.4426950408889634f;
__device__ __forceinline__ void glds16(const void*gsrc,unsigned lds_dst){unsigned keep;
  asm volatile("s_mov_b32 %0, m0\n\ts_mov_b32 m0, %2\n\ts_nop 0\n\tglobal_load_lds_dwordx4 %1, off\n\ts_mov_b32 m0, %0":"=&s"(keep):"v"(gsrc),"s"(lds_dst):"memory");}
__device__ __forceinline__ float max3f(float a,float b,float c){float r;asm("v_max3_f32 %0, %1, %2, %3":"=v"(r):"v"(a),"v"(b),"v"(c));return r;}
__device__ __forceinline__ float max2f(float a,float b){float r;asm("v_max_f32_e32 %0, %1, %2":"=v"(r):"v"(a),"v"(b));return r;}
__device__ __forceinline__ float fadd_s(float a,float b){float r;asm("v_add_f32_e32 %0, %1, %2":"=v"(r):"v"(a),"v"(b));return r;}
__device__ __forceinline__ float fsub_s(float a,float b){float r;asm("v_sub_f32_e32 %0, %1, %2":"=v"(r):"v"(a),"v"(b));return r;}
typedef float f32x2_t __attribute__((ext_vector_type(2))); typedef __bf16 bf16x2_t __attribute__((ext_vector_type(2)));
__device__ __forceinline__ unsigned cvtpk_s(float lo,float hi){f32x2_t v={lo,hi};bf16x2_t b=__builtin_convertvector(v,bf16x2_t);return __builtin_bit_cast(unsigned,b);}
#define WAIT_BAR(N) asm volatile("s_waitcnt vmcnt(" #N ") lgkmcnt(0)\n\ts_barrier":::"memory")

__device__ __forceinline__ void qkt(f32x16&p0,f32x16&p1,const char*Kslot,const bf16x8*qr,const f32x16&negm,int r32,int hi){
  const char*kb=Kslot+hi*1024+r32*16;
  #pragma unroll
  for(int d0=0;d0<4;++d0){
    const bf16x8 b0=*reinterpret_cast<const bf16x8*>(kb+d0*2048);
    const bf16x8 b1=*reinterpret_cast<const bf16x8*>(kb+d0*2048+512);
    if(d0==0){p0=__builtin_amdgcn_mfma_f32_32x32x16_bf16(b0,qr[0],negm,0,0,0);p1=__builtin_amdgcn_mfma_f32_32x32x16_bf16(b1,qr[0],negm,0,0,0);}
    else{p0=__builtin_amdgcn_mfma_f32_32x32x16_bf16(b0,qr[d0],p0,0,0,0);p1=__builtin_amdgcn_mfma_f32_32x32x16_bf16(b1,qr[d0],p1,0,0,0);}}
}
typedef __attribute__((address_space(3))) const char* lds_cptr;
typedef short v4i16_t __attribute__((ext_vector_type(4)));
__device__ __forceinline__ void kload8(bf16x8*kf,lds_cptr kp){
  kf[0]=*(const __attribute__((address_space(3))) bf16x8*)(kp);      kf[1]=*(const __attribute__((address_space(3))) bf16x8*)(kp+512);
  kf[2]=*(const __attribute__((address_space(3))) bf16x8*)(kp+2048); kf[3]=*(const __attribute__((address_space(3))) bf16x8*)(kp+2560);
  kf[4]=*(const __attribute__((address_space(3))) bf16x8*)(kp+4096); kf[5]=*(const __attribute__((address_space(3))) bf16x8*)(kp+4608);
  kf[6]=*(const __attribute__((address_space(3))) bf16x8*)(kp+6144); kf[7]=*(const __attribute__((address_space(3))) bf16x8*)(kp+6656);
}
__device__ __forceinline__ void kload2(bf16x8*kf,lds_cptr kp,int j){ kf[2*j]=*(const __attribute__((address_space(3))) bf16x8*)(kp+j*2048); kf[2*j+1]=*(const __attribute__((address_space(3))) bf16x8*)(kp+j*2048+512); }
__device__ __forceinline__ s16x4 vtr(lds_cptr p){ return __builtin_bit_cast(s16x4,__builtin_amdgcn_ds_read_tr16_b64_v4i16((__attribute__((address_space(3))) v4i16_t*)p)); }
__device__ __forceinline__ float rowmax(const f32x16&p0,const f32x16&p1){
  float a=max3f(p0[0],p0[1],p1[0]),b=max3f(p0[2],p0[3],p1[1]);a=max3f(a,p1[2],p1[3]);
  #pragma unroll
  for(int r=4;r<16;r+=4){a=max3f(a,p0[r],p0[r+1]);b=max3f(b,p0[r+2],p0[r+3]);a=max3f(a,p1[r],p1[r+1]);b=max3f(b,p1[r+2],p1[r+3]);}
  const float m=max2f(a,b);
  auto rr=__builtin_amdgcn_permlane32_swap(__float_as_uint(m),__float_as_uint(m),false,false);
  return max2f(__uint_as_float(rr[0]),__uint_as_float(rr[1]));
}
__device__ __forceinline__ void pv(f32x16*o,int vb,bf16x8 pa0,bf16x8 pa1,bf16x8 pa2,bf16x8 pa3){
  #pragma unroll
  for(int d0=0;d0<2;++d0){s16x4 lo[4],hi[4];
    #pragma unroll
    for(int ks=0;ks<4;++ks){
      asm volatile("ds_read_b64_tr_b16 %0,%1 offset:%c2":"=&v"(lo[ks]):"v"(vb),"i"(d0*4096+ks*1024):"memory");
      asm volatile("ds_read_b64_tr_b16 %0,%1 offset:%c2":"=&v"(hi[ks]):"v"(vb),"i"(d0*4096+ks*1024+512):"memory");}
    asm volatile("s_waitcnt lgkmcnt(0)":::"memory");SBAR();
    #define PK(k) (bf16x8){lo[k][0],lo[k][1],lo[k][2],lo[k][3],hi[k][0],hi[k][1],hi[k][2],hi[k][3]}
    o[d0]=__builtin_amdgcn_mfma_f32_32x32x16_bf16(pa0,PK(0),o[d0],0,0,0);
    o[d0]=__builtin_amdgcn_mfma_f32_32x32x16_bf16(pa1,PK(1),o[d0],0,0,0);
    o[d0]=__builtin_amdgcn_mfma_f32_32x32x16_bf16(pa2,PK(2),o[d0],0,0,0);
    o[d0]=__builtin_amdgcn_mfma_f32_32x32x16_bf16(pa3,PK(3),o[d0],0,0,0);
    #undef PK
  }
}

#ifndef ATTN_STORE16
#define ATTN_STORE16(p,v) (*(u32x4*)(p)=(v))
#endif
template<int THRL> __device__ __forceinline__ void attn_unit(int b,int vh,int qb,const bf16*Q,const bf16*__restrict__ K,const bf16*__restrict__ V,bf16*O,char*shm,const __attribute__((address_space(3))) float*tball){
  const int tid=threadIdx.x,lane=tid&63,r32=lane&31,hi=lane>>5; const int wid=__builtin_amdgcn_readfirstlane(tid>>6);
  const long rowbase=(long)b*SEQ; const int q0=qb*QB;
  const int hh=vh>>2, qcol=hh*128+((vh>>1)&1)*64, vcol=hh*128+(vh&1)*64;
  const __attribute__((address_space(3))) float*tb=tball+hh*128;
  const bf16*Qw=Q+(rowbase+q0+wid*QBLK)*PQ+qcol;
  const bf16*Kh=K+rowbase*PQ+qcol,*Vh=V+rowbase*PQ+vcol;
  const unsigned lds0=(unsigned)(uintptr_t)shm;
  float*wsf=(float*)(shm+LDS_WS)+wid*64;
  const bf16*ksrc=Kh+(long)lane*PQ+wid*8;
  const bf16*vsrc=Vh+(long)(16*(wid&3)+(lane>>2))*PQ+(wid>>2)*32+(lane&3)*8;
  const unsigned kdst=lds0+LDS_K+wid*1024, vdst=lds0+LDS_V+wid*1024;
  #define DMA_K(t,slot) glds16(ksrc+(long)(t)*KVBLK*PQ,(unsigned)__builtin_amdgcn_readfirstlane(kdst+(slot)))
  #define DMA_V(t,slot) glds16(vsrc+(long)(t)*KVBLK*PQ,(unsigned)__builtin_amdgcn_readfirstlane(vdst+(slot)))
  const int vb0=(int)(lds0+LDS_V)+((lane>>4)&1)*32+(lane&3)*8+(4*hi+((lane&15)>>2))*64;
  const char*Kbase=shm+LDS_K; bf16x8 kf[8];
  const lds_cptr shm3=(lds_cptr)shm; const lds_cptr kp0=shm3+LDS_K+hi*1024+r32*16; const lds_cptr vp0=shm3+LDS_V+((lane>>4)&1)*32+(lane&3)*8+(4*hi+((lane&15)>>2))*64;
  const int NT=(q0+QB)/KVBLK;
  DMA_K(0,0);DMA_V(0,0);DMA_K(1,SLOTB);
  bf16x8 qr[4];
  #pragma unroll
  for(int d0=0;d0<4;++d0)qr[d0]=*reinterpret_cast<const bf16x8*>(&Qw[(long)r32*PQ+d0*16+hi*8]);
  float mhat=0.f,l_reg=0.f;f32x16 o[2];o[0]=f32x16{};o[1]=f32x16{};f32x16 negm=f32x16{};asm volatile("":"+v"(negm));
  const int qrel=wid*QBLK+r32;
  #define CMASK(P0,P1,t) do{int jb_=(t)-(NT-4); if(jb_>=-2){cbias(P0,P1,jb_,qrel,hi,tb); if(jb_>=0)cmask(P0,P1,jb_,qrel,hi);}}while(0)
  bool resc=false;
  #define START(P0,P1) do{ const float rm=rowmax(P0,P1); resc=false; \
    { const float dl=rm; mhat=fadd_s(mhat,dl); \
      _Pragma("unroll") for(int r=0;r<16;++r){P0[r]=fsub_s(P0[r],dl);P1[r]=fsub_s(P1[r],dl);} \
      _Pragma("unroll") for(int r=0;r<16;++r)negm[r]=-mhat; asm volatile("":"+v"(negm)); } \
    _Pragma("unroll") for(int r=0;r<16;++r)P0[r]=__builtin_amdgcn_exp2f(P0[r]); }while(0)
  #define RESC() do{ if(resc){ asm volatile("s_waitcnt lgkmcnt(0)":::"memory"); \
      _Pragma("unroll") for(int d_=0;d_<2;++d_) _Pragma("unroll") for(int r=0;r<16;++r)o[d_][r]*=wsf[crow(r,hi)]; } }while(0)
  f32x16 pA0,pA1,pB0,pB1;
  int sl_prev=0,sl_cur=0,sl_next=SLOTB;
  #define ROT() do{sl_prev=sl_cur;sl_cur=sl_next;sl_next=(sl_next==(NSLOT-1)*SLOTB)?0:sl_next+SLOTB;}while(0)
  DMA_K(2,2*SLOTB);
  WAIT_BAR(3);
  qkt(pA0,pA1,Kbase,qr,negm,r32,hi);asm volatile("s_nop 15\n\ts_nop 7":"+v"(pA0),"+v"(pA1));CMASK(pA0,pA1,0);
  START(pA0,pA1);
  _Pragma("unroll") for(int r=0;r<16;++r)pA1[r]=__builtin_amdgcn_exp2f(pA1[r]);
  WAIT_BAR(0);
  DMA_K(3,0);DMA_V(1,SLOTB);
  ROT();
  kload8(kf,kp0+sl_cur);
  WAIT_BAR(2);
  s16x4 vlo[8],vhi[8]; u32x4 pw0,pw1,pw2,pw3;
  #define PKW(P,B) cvtpk_s(P[B],P[B+1])
  #define PAF(k) __builtin_bit_cast(bf16x8,pw##k)
  #define VFR(i) (bf16x8){vlo[i][0],vlo[i][1],vlo[i][2],vlo[i][3],vhi[i][0],vhi[i][1],vhi[i][2],vhi[i][3]}
  #define PIN(x) asm volatile("":"+v"(x))
  #define MX3(a,b,c) __builtin_fmaxf(__builtin_fmaxf((a),(b)),(c))
  #define GAPA(MF,A0,A1,A2,A3,W0,W1,PW) do{ MF; sacc+=A0; sacc+=A1; sacc+=A2; sacc+=A3; PIN(sacc); W0; W1; PIN(PW); SBAR(); }while(0)
  #define EX(v) __builtin_amdgcn_exp2f(v)
  #define GAPB(MF,X,B) do{ MF; X[B]=EX(X[B]); X[B+1]=EX(X[B+1]); X[B+2]=EX(X[B+2]); X[B+3]=EX(X[B+3]); PIN(X); SBAR(); }while(0)
  #define VRD(i) do{ vlo[i]=vtr(vp_+(((i)>>2)*4096+((i)&3)*1024)); vhi[i]=vtr(vp_+(((i)>>2)*4096+((i)&3)*1024+512)); }while(0)
  #define KRD(G,j) do{ if(G){ kload2(kf,kp0+sl_next,j); SBAR(); } }while(0)
  #define STEP(C0,C1,P0,P1,t,GK,GV,GL) do{ SBAR(); \
    const lds_cptr vp_=vp0+sl_prev; \
    VRD(0); SBAR(); float sacc=(P0[0]+P0[1]); \
    GAPA(C0=__builtin_amdgcn_mfma_f32_32x32x16_bf16(kf[0],qr[0],negm,0,0,0), P0[2],P0[3],P0[4],P0[5],     pw0[0]=PKW(P0,0), pw0[1]=PKW(P0,2), pw0); \
    VRD(4); SBAR(); GAPA(C1=__builtin_amdgcn_mfma_f32_32x32x16_bf16(kf[1],qr[0],negm,0,0,0), P0[6],P0[7],P0[8],P0[9],     pw0[2]=PKW(P0,4), pw0[3]=PKW(P0,6), pw0); \
    VRD(1); SBAR(); GAPA(C0=__builtin_amdgcn_mfma_f32_32x32x16_bf16(kf[2],qr[1],C0,0,0,0),   P0[10],P0[11],P0[12],P0[13], pw1[0]=PKW(P0,8), pw1[1]=PKW(P0,10), pw1); \
    VRD(5); SBAR(); GAPA(C1=__builtin_amdgcn_mfma_f32_32x32x16_bf16(kf[3],qr[1],C1,0,0,0),   P0[14],P0[15],P1[0],P1[1],   pw1[2]=PKW(P0,12),pw1[3]=PKW(P0,14), pw1); \
    VRD(2); SBAR(); GAPA(C0=__builtin_amdgcn_mfma_f32_32x32x16_bf16(kf[4],qr[2],C0,0,0,0),   P1[2],P1[3],P1[4],P1[5],     pw2[0]=PKW(P1,0), pw2[1]=PKW(P1,2), pw2); \
    VRD(6); SBAR(); GAPA(C1=__builtin_amdgcn_mfma_f32_32x32x16_bf16(kf[5],qr[2],C1,0,0,0),   P1[6],P1[7],P1[8],P1[9],     pw2[2]=PKW(P1,4), pw2[3]=PKW(P1,6), pw2); \
    VRD(3); SBAR(); GAPA(C0=__builtin_amdgcn_mfma_f32_32x32x16_bf16(kf[6],qr[3],C0,0,0,0),   P1[10],P1[11],P1[12],P1[13], pw3[0]=PKW(P1,8), pw3[1]=PKW(P1,10), pw3); \
    VRD(7); SBAR(); GAPA(C1=__builtin_amdgcn_mfma_f32_32x32x16_bf16(kf[7],qr[3],C1,0,0,0),   P1[14],P1[15],0.f,0.f,       pw3[2]=PKW(P1,12),pw3[3]=PKW(P1,14), pw3); \
    l_reg+=sacc; \
    if(GK){DMA_K((t)+3,sl_cur);} if(GV){DMA_V((t)+1,sl_next);} \
    CMASK(C0,C1,t); \
    { float a=MX3(C0[0],C0[1],C1[0]),b=MX3(C0[2],C0[3],C1[1]); a=MX3(a,C1[2],C1[3]); \
      _Pragma("unroll") for(int r=4;r<16;r+=4){a=MX3(a,C0[r],C0[r+1]);b=MX3(b,C0[r+2],C0[r+3]);a=MX3(a,C1[r],C1[r+1]);b=MX3(b,C1[r+2],C1[r+3]);} \
      float rm=__builtin_fmaxf(a,b); { auto rr=__builtin_amdgcn_permlane32_swap(__float_as_uint(rm),__float_as_uint(rm),false,false); rm=__builtin_fmaxf(__uint_as_float(rr[0]),__uint_as_float(rr[1])); } \
      resc=false; \
      if(__builtin_expect(__any(rm>(float)THRL),0)){ const float dl=__builtin_fmaxf(rm,0.f); mhat+=dl; \
        _Pragma("unroll") for(int r=0;r<16;++r){C0[r]-=dl;C1[r]-=dl;} \
        _Pragma("unroll") for(int r=0;r<16;++r)negm[r]=-mhat; asm volatile("":"+v"(negm)); \
        const float f=__builtin_amdgcn_exp2f(-dl); l_reg*=f; if(hi==0)wsf[r32]=f; resc=true; } } \
    SBAR(); \
    GAPB(o[0]=__builtin_amdgcn_mfma_f32_32x32x16_bf16(PAF(0),VFR(0),o[0],0,0,0), C0,0); \
    GAPB(o[1]=__builtin_amdgcn_mfma_f32_32x32x16_bf16(PAF(0),VFR(4),o[1],0,0,0), C0,4); \
    KRD(GL,0); GAPB(o[0]=__builtin_amdgcn_mfma_f32_32x32x16_bf16(PAF(1),VFR(1),o[0],0,0,0), C0,8); \
    KRD(GL,1); GAPB(o[1]=__builtin_amdgcn_mfma_f32_32x32x16_bf16(PAF(1),VFR(5),o[1],0,0,0), C0,12); \
    KRD(GL,2); GAPB(o[0]=__builtin_amdgcn_mfma_f32_32x32x16_bf16(PAF(2),VFR(2),o[0],0,0,0), C1,0); \
    KRD(GL,3); GAPB(o[1]=__builtin_amdgcn_mfma_f32_32x32x16_bf16(PAF(2),VFR(6),o[1],0,0,0), C1,4); \
    GAPB(o[0]=__builtin_amdgcn_mfma_f32_32x32x16_bf16(PAF(3),VFR(3),o[0],0,0,0), C1,8); \
    GAPB(o[1]=__builtin_amdgcn_mfma_f32_32x32x16_bf16(PAF(3),VFR(7),o[1],0,0,0), C1,12); \
    }while(0)
  int t=1;
  #undef CMASK
  #define CMASK(P0,P1,t) do{}while(0)
  for(;t+7<NT;t+=2){
    STEP(pB0,pB1,pA0,pA1,t,true,true,true);     WAIT_BAR(2); RESC(); ROT();
    STEP(pA0,pA1,pB0,pB1,t+1,true,true,true);   WAIT_BAR(2); RESC(); ROT();
  }
  #undef CMASK
  #define CMASK(P0,P1,t) do{int jb_=(t)-(NT-4); if(jb_>=-2){cbias(P0,P1,jb_,qrel,hi,tb); if(jb_>=0)cmask(P0,P1,jb_,qrel,hi);}}while(0)
  #define ENDW(tt) do{ if((tt)+3<NT){WAIT_BAR(2);} else if((tt)+2<NT){WAIT_BAR(1);} else {WAIT_BAR(0);} }while(0)
  for(;t+1<NT;t+=2){
    STEP(pB0,pB1,pA0,pA1,t,(t+3<NT),(t+1<NT),(t+1<NT));       ENDW(t);   RESC(); ROT();
    STEP(pA0,pA1,pB0,pB1,t+1,(t+4<NT),(t+2<NT),(t+2<NT));     ENDW(t+1); RESC(); ROT();
  }
  STEP(pB0,pB1,pA0,pA1,NT-1,false,false,false); RESC();
  { float sacc=pB0[0]+pB0[1]; _Pragma("unroll") for(int r=2;r<16;++r)sacc+=pB0[r]; _Pragma("unroll") for(int r=0;r<16;++r)sacc+=pB1[r]; l_reg+=sacc;
    pw0=(u32x4){PKW(pB0,0),PKW(pB0,2),PKW(pB0,4),PKW(pB0,6)};pw1=(u32x4){PKW(pB0,8),PKW(pB0,10),PKW(pB0,12),PKW(pB0,14)};pw2=(u32x4){PKW(pB1,0),PKW(pB1,2),PKW(pB1,4),PKW(pB1,6)};pw3=(u32x4){PKW(pB1,8),PKW(pB1,10),PKW(pB1,12),PKW(pB1,14)};
    SBAR(); pv(o,vb0+sl_cur,PAF(0),PAF(1),PAF(2),PAF(3)); }
  #undef PKW
  #undef PAF
  #undef VFR
  #undef PIN
  #undef MX3
  #undef GAPA
  #undef GAPB
  #undef EX
  #undef VRD
  #undef KRD
  #undef STEP
  #undef ENDW
  {auto rr=__builtin_amdgcn_permlane32_swap(__float_as_uint(l_reg),__float_as_uint(l_reg),false,false);l_reg=__uint_as_float(rr[0])+__uint_as_float(rr[1]);}
  if(hi==0)wsf[32+r32]=l_reg;asm volatile("s_waitcnt lgkmcnt(0)":::"memory");
  float rli[16];
  #pragma unroll
  for(int r=0;r<16;++r)rli[r]=__builtin_amdgcn_rcpf(wsf[32+crow(r,hi)]);
  bf16*Ow=O+(rowbase+q0+wid*QBLK)*PO+vh*D;
  { bf16*stg=(bf16*)(shm+LDS_OST)+wid*2048;
    #pragma unroll
    for(int r=0;r<16;++r){const int orow=crow(r,hi);
      #pragma unroll
      for(int d0=0;d0<2;++d0)stg[orow*64+d0*32+r32]=__float2bfloat16(o[d0][r]*rli[r]);}
    asm volatile("s_waitcnt lgkmcnt(0)":::"memory");
    #pragma unroll
    for(int i=0;i<4;++i){const int row=i*8+(lane>>3),ch=lane&7; const u32x4 v=*(const u32x4*)(stg+row*64+ch*8); ATTN_STORE16(Ow+(long)row*PO+ch*8,v);} }
  asm volatile("s_waitcnt lgkmcnt(0)\n\ts_barrier":::"memory");
  #undef DMA_K
  #undef DMA_V
  #undef CMASK
  #undef START
  #undef RESC
  #undef ROT
}
constexpr int ATTN_LDS_BYTES=LDS_BYTES;
struct AttnTensors { const bf16* Q; const bf16* K; const bf16* V; bf16* O; };
struct AttnUnit { int bh; int qb; };
__device__ __forceinline__ bool attn_next(int vcu,int i,AttnUnit&u){ if(i>=16)return false; const int s=vcu&7, j=i&3; u.bh=(vcu>>3)+32*(i>>2); u.qb=(j==0)?s:(j==1)?15-s:(j==2)?16+s:31-s; return true; }
template<int THRL=8> __device__ __forceinline__ void attn_phase(char*lds,const AttnTensors&T,int vcu,const __attribute__((address_space(3))) float*tball){
  AttnUnit u;
  for(int i=0;attn_next(vcu,i,u);++i){ attn_unit<THRL>(u.bh/NHEAD,u.bh%NHEAD,u.qb,T.Q,T.K,T.V,T.O,lds,tball); }
}
#undef SBAR
#undef WAIT_BAR
}

#define XB_TMO      128
#define XB_XCNT(j)  (256  + 64 * (j))
#define XB_XSUB(j)  (1280 + 64 * (j))
#define XB_XGEN(j)  (2304 + 64 * (j))
#define XB_TOP      3328
#define XB_TOPGEN   3392
#define XCD_BAR_WORDS 3456
#define XB_SPIN_CAP (1u << 18)

__device__ __forceinline__ unsigned xb_ld(unsigned* p)              { return __hip_atomic_load(p, __ATOMIC_RELAXED, __HIP_MEMORY_SCOPE_AGENT); }
__device__ __forceinline__ unsigned xb_add(unsigned* p, unsigned v) { return __hip_atomic_fetch_add(p, v, __ATOMIC_RELAXED, __HIP_MEMORY_SCOPE_AGENT); }
__device__ __forceinline__ unsigned xb_xcc_id() { return (unsigned)__builtin_amdgcn_s_getreg((3 << 11) | 20) & 0xFu; }
#define XB_SPIN(cond, bar) do { unsigned _sp = 0; while (cond) { __builtin_amdgcn_s_sleep(1); \
    if ((++_sp & 255u) == 0u) { if (xb_ld(&(bar)[XB_TMO])) break; if (_sp > XB_SPIN_CAP) { atomicAdd(&(bar)[XB_TMO], 1u); break; } } } } while (0)

struct XcdBarrier {
    unsigned* bar; unsigned x;
    volatile LAS unsigned* st;
};

__device__ __forceinline__ XcdBarrier xcd_barrier_post(unsigned* bar, volatile LAS unsigned* st) {
    XcdBarrier b; b.bar = bar; b.x = xb_xcc_id(); b.st = st;
    if (threadIdx.x == 0) (void)xb_add(&bar[XB_XCNT(b.x)], 1u);
    return b;
}
__device__ __forceinline__ void xcd_barrier_complete(unsigned* bar, unsigned x, unsigned& nloc, unsigned& nx) {
    const unsigned G = gridDim.x * gridDim.y * gridDim.z;
    unsigned sum, cnt, mine, sp = 0u;
    for (;;) {
        sum = 0u; cnt = 0u; mine = 0u;
#pragma unroll
        for (unsigned j = 0; j < 16; ++j) { const unsigned c = xb_ld(&bar[XB_XCNT(j)]); sum += c; cnt += (c > 0u) ? 1u : 0u; mine = (j == x) ? c : mine; }
        if (sum == G) break;
        __builtin_amdgcn_s_sleep(1);
        if ((++sp & 255u) == 0u) { if (xb_ld(&bar[XB_TMO])) break; if (sp > XB_SPIN_CAP) { atomicAdd(&bar[XB_TMO], 1u); break; } }
    }
    nloc = mine > 0u ? mine : 1u; nx = cnt > 0u ? cnt : 1u;
}

__device__ __forceinline__ void xcd_barrier(const XcdBarrier& b) {
    asm volatile("s_waitcnt vmcnt(0)" ::: "memory");
    __syncthreads();
    if (threadIdx.x == 0) {
        unsigned* bar = b.bar;
        __builtin_amdgcn_s_waitcnt(0);
        unsigned nloc = b.st[0], nx = b.st[1];
        if (nloc == 0u) { xcd_barrier_complete(bar, b.x, nloc, nx); b.st[0] = nloc; b.st[1] = nx; }
        const unsigned old = xb_add(&bar[XB_XSUB(b.x)], 1u);
        const unsigned gen = old / nloc;
        if (old + 1u == (gen + 1u) * nloc) {
            __builtin_amdgcn_fence(__ATOMIC_RELEASE, "agent");
            asm volatile("s_waitcnt vmcnt(0)" ::: "memory");
            const unsigned og = xb_add(&bar[XB_TOP], 1u);
            const unsigned tg = og / nx;
            if (og + 1u == (tg + 1u) * nx) xb_add(&bar[XB_TOPGEN], 1u);
            else XB_SPIN(xb_ld(&bar[XB_TOPGEN]) == tg, bar);
            __builtin_amdgcn_fence(__ATOMIC_ACQUIRE, "agent");
            xb_add(&bar[XB_XGEN(b.x)], 1u);
            asm volatile("s_waitcnt vmcnt(0)" ::: "memory");
        } else {
            XB_SPIN(xb_ld(&bar[XB_XGEN(b.x)]) == gen, bar);
            __builtin_amdgcn_fence(__ATOMIC_ACQUIRE, "agent");
            asm volatile("s_waitcnt vmcnt(0)" ::: "memory");
        }
    }
    __syncthreads();
}

constexpr size_t MiB = 1u << 20;
constexpr size_t WS_CTL = 0, CTL_ZERO_BYTES = 1 * MiB;
constexpr size_t WS_WIN = 2 * MiB;
constexpr size_t WS_WOUT = 7 * MiB;
constexpr size_t WS_PGATE = 9 * MiB;
constexpr size_t WS_PPROJ = 13 * MiB;
constexpr size_t WS_RCAT = 14 * MiB;
constexpr size_t WS_RS2 = 28 * MiB;
constexpr size_t WS_RWO = 30 * MiB;
constexpr size_t WS_ROUT = 32 * MiB;
constexpr size_t WS_LRUAGG = 33 * MiB;
constexpr size_t WS_MGU = 38 * MiB;
constexpr size_t WS_MDN = 102 * MiB;
constexpr size_t WS_PB = 134 * MiB;
constexpr size_t WS_ACT = 166 * MiB;
constexpr size_t WS_H0 = WS_ACT;
constexpr size_t WS_QKV = WS_ACT + 128 * MiB;
constexpr size_t WS_O = WS_ACT + 448 * MiB;
constexpr size_t WS_H2 = WS_ACT;
constexpr size_t WS_LOG = WS_ACT + 128 * MiB;
constexpr size_t WS_ROUTE = WS_ACT + 144 * MiB;
constexpr size_t WS_HID = WS_ACT + 152 * MiB;
constexpr size_t WS_YS = WS_ACT + 288 * MiB;
constexpr size_t WS_PP = WS_ACT + 128 * MiB;
constexpr size_t WS_HCAT = WS_ACT;
constexpr size_t WS_R = WS_ACT + 256 * MiB;
constexpr size_t WS_MID = WS_ACT + 640 * MiB;
constexpr size_t WS_EW = WS_ACT;
constexpr size_t WS_AA = WS_ACT + 128 * MiB;
constexpr size_t WS_Y = WS_ACT + 704 * MiB;
constexpr size_t WS_END = WS_ACT + 832 * MiB;
static_assert(WS_END <= 1024 * MiB, "workspace map");
constexpr size_t RT_EID = 0, RT_POS = 1 * MiB, RT_GATE = 2 * MiB, RT_ROWTOK = 3 * MiB, RT_ROWGATE = 4 * MiB, RT_SLOT = 5 * MiB;
constexpr int CW_BAR = 4096;
constexpr int CW_CNT0 = 16384, CW_CNT1 = 16384 + 64;

constexpr int RING_BYTES = 131072;
constexpr int LDSCTL_OFF = RING_BYTES, MISC_OFF = LDSCTL_OFF + 320;
constexpr int TB_OFF = RING_BYTES + 1024;
constexpr int RTE_OFF = TB_OFF + 2048;
constexpr int LDS_BYTES = 147456;

constexpr int NWAVES = 8;
__device__ __forceinline__ int tid_opaque() { int t = (int)threadIdx.x; asm volatile("" : "+v"(t)); return t; }
#define TID_ (tid_opaque())
#define LANE_ (tid_opaque() & 63)
struct Frame {
    LAS unsigned char* lds; volatile LAS unsigned* MISC; gu32* ctl;
    int wave, vcu, G;
};

__device__ __forceinline__ void load_row4(const float* xrow, int lane, f32x4 (&v)[4]) { const f32x4* p = (const f32x4*)xrow + lane;
#pragma unroll
    for (int j = 0; j < 4; ++j) v[j] = p[64 * j]; }
__device__ __forceinline__ float row_rstd(const f32x4 (&v)[4], float eps) { float s = 0.f;
#pragma unroll
    for (int j = 0; j < 4; ++j) s += (v[j].x * v[j].x + v[j].y * v[j].y) + (v[j].z * v[j].z + v[j].w * v[j].w);
    return 1.0f / sqrtf(wave_sum(s) * (1.0f / 1024.0f) + eps); }
__device__ __forceinline__ void store_row_bf16(bf16* orow, int lane, const f32x4 (&v)[4], float rstd, const float* g) {
    unsigned long long* o8 = (unsigned long long*)orow + lane;
#pragma unroll
    for (int j = 0; j < 4; ++j) { const f32x4 gg = ((const f32x4*)g)[lane + 64 * j];
        o8[64 * j] = (unsigned long long)pk2(v[j].x * rstd * gg.x, v[j].y * rstd * gg.y) | ((unsigned long long)pk2(v[j].z * rstd * gg.z, v[j].w * rstd * gg.w) << 32); }
}

template <int MODE>
__device__ __forceinline__ void transpose_item(const float* W, int K, int N, bf16* WT, int ldo, int row_off, const float* mu, LAS float* scr, int item, int lane) {
    const int nblk = N / 32, kb = item / nblk, nb = item % nblk, k0 = 64 * kb, n0 = 32 * nb;
#pragma unroll 8
    for (int i = 0; i < 32; ++i) { const int kk = 2 * i + (lane >> 5); scr[kk * 33 + (lane & 31)] = W[(size_t)(k0 + kk) * N + n0 + (lane & 31)]; }
    LDS_WAIT(); asm volatile("" ::: "memory");
    const int c = lane & 7;
    int rbase = row_off + n0;
    if (MODE == 2) { rbase = row_off + ((n0 < 512) ? ((n0 >> 7) * 256 + (n0 & 127)) : (((n0 - 512) >> 7) * 256 + 128 + ((n0 - 512) & 127))); }
    float m[8];
    if (MODE == 1) {
#pragma unroll
        for (int e = 0; e < 8; ++e) m[e] = mu[k0 + 8 * c + e]; }
#pragma unroll
    for (int j = 0; j < 4; ++j) { const int n = (lane >> 3) + 8 * j; const LAS float* s = scr + (8 * c) * 33 + n;
        float v[8];
#pragma unroll
        for (int e = 0; e < 8; ++e) v[e] = s[e * 33];
        bf16* dst = WT + (size_t)(rbase + n) * ldo + k0 + 8 * c;
        if (MODE == 1) {
            v4u o, o2;
            o.x = pk2(v[0] * (1.f - m[0]), v[1] * (1.f - m[1])); o.y = pk2(v[2] * (1.f - m[2]), v[3] * (1.f - m[3])); o.z = pk2(v[4] * (1.f - m[4]), v[5] * (1.f - m[5])); o.w = pk2(v[6] * (1.f - m[6]), v[7] * (1.f - m[7]));
            o2.x = pk2(v[0] * m[0], v[1] * m[1]); o2.y = pk2(v[2] * m[2], v[3] * m[3]); o2.z = pk2(v[4] * m[4], v[5] * m[5]); o2.w = pk2(v[6] * m[6], v[7] * m[7]);
            *(GAS v4u*)dst = o; *(GAS v4u*)(dst + 1024) = o2;
        } else {
            v4u o; o.x = pk2(v[0], v[1]); o.y = pk2(v[2], v[3]); o.z = pk2(v[4], v[5]); o.w = pk2(v[6], v[7]);
            *(GAS v4u*)dst = o; }
    }
    LDS_WAIT(); asm volatile("" ::: "memory");
}

struct In {
    const float *x, *p, *rel_bias, *norm_mix, *ab_w_in, *ab_w_out, *lam_q1, *lam_k1, *lam_q2, *lam_k2, *sub_g, *conv_w, *conv_b, *lru_wa, *lru_ba, *lru_wx, *lru_bx, *lru_lambda,
        *rwkv_mu, *rwkv_wr, *rwkv_wk, *rwkv_wv, *rwkv_wo, *rwkv_w0, *rwkv_w1, *rwkv_w2, *rwkv_a0, *rwkv_a1, *rwkv_a2, *rwkv_g1, *rwkv_g2, *rwkv_kk, *rwkv_ka, *rwkv_rk, *rwkv_ln_g, *rwkv_ln_b,
        *norm_ffn, *moe_wc, *moe_bc, *moe_wf, *moe_bf, *moe_w_gu, *moe_w_down, *ple_norm, *ple_gate, *ple_proj, *final_norm;
};

__device__ __forceinline__ void prep_dense_weights(Frame& F, const In& I, unsigned char* ws) {
    LAS float* scr = (LAS float*)(F.lds + F.wave * 16384);
    const int gw = F.vcu * NWAVES + F.wave, NGW = F.G * NWAVES;
    bf16* WIN = (bf16*)(ws + WS_WIN); bf16* WOUT = (bf16*)(ws + WS_WOUT); bf16* PG = (bf16*)(ws + WS_PGATE); bf16* PPJ = (bf16*)(ws + WS_PPROJ);
    bf16* RCAT = (bf16*)(ws + WS_RCAT); bf16* RWO = (bf16*)(ws + WS_RWO);
    constexpr int I_IN = (1024 / 64) * (2560 / 32), I_SQ = (1024 / 64) * (1024 / 32), I_PJ = (256 / 64) * (1024 / 32), I_L64 = (1024 / 64) * (64 / 32), I_L160 = (1024 / 64) * (160 / 32);
    int st = gw;
#define TJOB(MODE, NITEMS, W, K, N, WT, LDO, ROFF, MU) do { for (int it = st; it < (NITEMS); it += NGW) transpose_item<MODE>(W, K, N, WT, LDO, ROFF, MU, scr, it, LANE_); \
        st = (st + NGW - ((NITEMS) % NGW)) % NGW; asm volatile("" : "+s"(st)); } while (0)
    TJOB(0, I_IN, I.ab_w_in, 1024, 2560, WIN, 1024, 0, nullptr);
    TJOB(0, I_SQ, I.ab_w_out, 1024, 1024, WOUT, 1024, 0, nullptr);
    TJOB(0, I_SQ, I.ple_gate, 1024, 1024, PG, 1024, 0, nullptr);
    TJOB(0, I_SQ, I.ple_gate + 1024 * 1024, 1024, 1024, PG + 1024 * 1024, 1024, 0, nullptr);
    TJOB(0, I_SQ, I.rwkv_wo, 1024, 1024, RWO, 1024, 0, nullptr);
    TJOB(1, I_SQ, I.rwkv_wr, 1024, 1024, RCAT, 2048, 0, I.rwkv_mu + 0 * 1024);
    TJOB(1, I_SQ, I.rwkv_wk, 1024, 1024, RCAT, 2048, 1024, I.rwkv_mu + 2 * 1024);
    TJOB(1, I_SQ, I.rwkv_wv, 1024, 1024, RCAT, 2048, 2048, I.rwkv_mu + 3 * 1024);
    TJOB(0, I_PJ, I.ple_proj, 256, 1024, PPJ, 256, 0, nullptr);
    TJOB(0, I_PJ, I.ple_proj + 256 * 1024, 256, 1024, PPJ + 1024 * 256, 256, 0, nullptr);
    TJOB(1, I_L64, I.rwkv_w1, 1024, 64, RCAT, 2048, 3072, I.rwkv_mu + 1 * 1024);
    TJOB(1, I_L64, I.rwkv_a1, 1024, 64, RCAT, 2048, 3072 + 64, I.rwkv_mu + 4 * 1024);
    TJOB(1, I_L160, I.rwkv_g1, 1024, 160, RCAT, 2048, 3072 + 256, I.rwkv_mu + 5 * 1024);
#undef TJOB
    const int gt = F.vcu * 512 + TID_, NGT = F.G * 512;
    { v4u z = {0u, 0u, 0u, 0u}; const int per_row = 2048 / 8;
      for (int i = gt; i < (128 + 96) * per_row; i += NGT) { int rr = i / per_row, cc = i % per_row; rr = (rr < 128) ? (3200 + rr) : (3488 + rr - 128); *(GAS v4u*)(RCAT + (size_t)rr * 2048 + cc * 8) = z; } }
    { bf16* S2 = (bf16*)(ws + WS_RS2);
      for (int i = gt; i < 3 * 1024 * 256; i += NGT) { const int ty = i / (1024 * 256), n = (i / 256) & 1023, k = i & 255; float v = 0.f;
          if (ty == 0) { if (k < 64) v = I.rwkv_w2[k * 1024 + n]; } else if (ty == 1) { if (k >= 64 && k < 128) v = I.rwkv_a2[(k - 64) * 1024 + n]; } else { if (k < 160) v = I.rwkv_g2[k * 1024 + n]; }
          S2[i] = (bf16)f2bf(v); } }
    { bf16* RT = (bf16*)(ws + WS_ROUT);
      for (int i = gt; i < 2 * 256 * 1024; i += NGT) { const int l = i / (256 * 1024), n = (i / 1024) & 255, k = i & 1023; float v = 0.f;
          if (n < 4) v = I.moe_wc[(size_t)l * 1024 * 4 + k * 4 + n]; else if (n < 36) v = I.moe_wf[(size_t)l * 1024 * 32 + k * 32 + (n - 4)];
          RT[i] = (bf16)f2bf(v); } }
}
__device__ __forceinline__ void prep_layer_weights(Frame& F, const In& I, unsigned char* ws, int layer) {
    LAS float* scr = (LAS float*)(F.lds + F.wave * 16384);
    const int gw = F.vcu * NWAVES + F.wave, NGW = F.G * NWAVES;
    bf16* MGU = (bf16*)(ws + WS_MGU); bf16* MDN = (bf16*)(ws + WS_MDN);
    const float* wgu = I.moe_w_gu + (size_t)layer * NEXP * 1024 * 1024; const float* wdn = I.moe_w_down + (size_t)layer * NEXP * 512 * 1024;
    constexpr int I_GU = (1024 / 64) * (1024 / 32), I_DN = (512 / 64) * (1024 / 32);
    for (int it = gw; it < NEXP * (I_GU + I_DN); it += NGW) {
        const int e = it / (I_GU + I_DN); int r = it % (I_GU + I_DN);
        if (r < I_GU) transpose_item<2>(wgu + (size_t)e * 1024 * 1024, 1024, 1024, MGU + (size_t)e * 1024 * 1024, 1024, 0, nullptr, scr, r, LANE_);
        else transpose_item<0>(wdn + (size_t)e * 512 * 1024, 512, 1024, MDN + (size_t)e * 1024 * 512, 512, 0, nullptr, scr, r - I_GU, LANE_);
    }
    const int gt = F.vcu * 512 + TID_, NGT = F.G * 512;
    const f32x4* ps = (const f32x4*)(I.p + (size_t)layer * T * PLE); v2u* pd = (v2u*)(ws + WS_PB);
    for (int i = gt; i < T * PLE / 4; i += NGT) { const f32x4 v = ps[i]; v2u o; o.x = pk2(v.x, v.y); o.y = pk2(v.z, v.w); pd[i] = o; }
}

template <int MODE>
__device__ __forceinline__ void norm_pass(Frame& F, const float* x, const float* g, bf16* out) {
    const int gw = F.vcu * NWAVES + F.wave, NGW = F.G * NWAVES;
    for (int t = gw; t < T; t += NGW) {
        f32x4 v[4]; load_row4(x + (size_t)t * D, LANE_, v); const float rstd = row_rstd(v, 1e-6f);
        if (MODE == 0) store_row_bf16(out + (size_t)t * D, LANE_, v, rstd, g);
        else {
            store_row_bf16(out + (size_t)t * 2048, LANE_, v, rstd, g);
            if ((t & (SEQ - 1)) != SEQ - 1) store_row_bf16(out + (size_t)(t + 1) * 2048 + 1024, LANE_, v, rstd, g);
            if ((t & (SEQ - 1)) == 0) { unsigned long long* o8 = (unsigned long long*)(out + (size_t)t * 2048 + 1024) + LANE_;
#pragma unroll
                for (int j = 0; j < 4; ++j) o8[64 * j] = 0ull; }
        }
    }
}
__device__ __forceinline__ void combine_norm_pass(Frame& F, const float* xin, float* xout, const bf16* YS, const int* slot, const float* g, bf16* out) {
    const int gw = F.vcu * NWAVES + F.wave, NGW = F.G * NWAVES;
    for (int t = gw; t < T; t += NGW) {
        f32x4 v[4]; load_row4(xin + (size_t)t * D, LANE_, v);
        const int s0 = slot[2 * t], s1 = slot[2 * t + 1];
        const v2u* y0 = (const v2u*)(YS + (size_t)s0 * D) + LANE_; const v2u* y1 = (const v2u*)(YS + (size_t)s1 * D) + LANE_;
#pragma unroll
        for (int j = 0; j < 4; ++j) { const v2u a = y0[64 * j], b = y1[64 * j];
            v[j].x += bflo(a.x) + bflo(b.x); v[j].y += bfhi(a.x) + bfhi(b.x); v[j].z += bflo(a.y) + bflo(b.y); v[j].w += bfhi(a.y) + bfhi(b.y); }
        f32x4* xo = (f32x4*)(xout + (size_t)t * D) + LANE_;
#pragma unroll
        for (int j = 0; j < 4; ++j) xo[64 * j] = v[j];
        const float rstd = row_rstd(v, 1e-6f);
        store_row_bf16(out + (size_t)t * D, LANE_, v, rstd, g);
    }
}
__device__ __forceinline__ void final_norm_pass(Frame& F, float* x, const float* g) {
    const int gw = F.vcu * NWAVES + F.wave, NGW = F.G * NWAVES;
    for (int t = gw; t < T; t += NGW) {
        f32x4 v[4]; load_row4(x + (size_t)t * D, LANE_, v); const float rstd = row_rstd(v, 1e-6f);
        f32x4* xo = (f32x4*)(x + (size_t)t * D) + LANE_;
#pragma unroll
        for (int j = 0; j < 4; ++j) { const f32x4 gg = ((const f32x4*)g)[LANE_ + 64 * j]; xo[64 * j] = v[j] * rstd * gg; }
    }
}

__device__ __forceinline__ void diff_combine_pass(Frame& F, const In& I, const bf16* O, bf16* YCAT) {
    const int gw = F.vcu * NWAVES + F.wave, NGW = F.G * NWAVES;
    const float lam_init = 0.2f;
    const float d1 = wave_sum(I.lam_q1[LANE_] * I.lam_k1[LANE_]), d2 = wave_sum(I.lam_q2[LANE_] * I.lam_k2[LANE_]);
    const float lam = expf(d1) - expf(d2) + lam_init;
    const int h = LANE_ >> 4, q = LANE_ & 15;
    float sg[8];
#pragma unroll
    for (int e = 0; e < 8; ++e) sg[e] = I.sub_g[q * 8 + e] * (1.0f - lam_init);
    for (int t = gw; t < T; t += NGW) {
        const v4u a = *(const v4u*)(O + (size_t)t * 1024 + h * 256 + q * 8), b = *(const v4u*)(O + (size_t)t * 1024 + h * 256 + 128 + q * 8);
        float o[8];
        o[0] = bflo(a.x) - lam * bflo(b.x); o[1] = bfhi(a.x) - lam * bfhi(b.x); o[2] = bflo(a.y) - lam * bflo(b.y); o[3] = bfhi(a.y) - lam * bfhi(b.y);
        o[4] = bflo(a.z) - lam * bflo(b.z); o[5] = bfhi(a.z) - lam * bfhi(b.z); o[6] = bflo(a.w) - lam * bflo(b.w); o[7] = bfhi(a.w) - lam * bfhi(b.w);
        float s = 0.f;
#pragma unroll
        for (int e = 0; e < 8; ++e) s += o[e] * o[e];
        s += __shfl_xor(s, 1); s += __shfl_xor(s, 2); s += __shfl_xor(s, 4); s += __shfl_xor(s, 8);
        const float rstd = 1.0f / sqrtf(s * (1.0f / 128.0f) + 1e-5f);
        v4u w; w.x = pk2(o[0] * rstd * sg[0], o[1] * rstd * sg[1]); w.y = pk2(o[2] * rstd * sg[2], o[3] * rstd * sg[3]); w.z = pk2(o[4] * rstd * sg[4], o[5] * rstd * sg[5]); w.w = pk2(o[6] * rstd * sg[6], o[7] * rstd * sg[7]);
        *(v4u*)(YCAT + (size_t)t * 1024 + h * 128 + q * 8) = w;
    }
}

constexpr int LCT = 64, LNCH = SEQ / LCT;
__device__ __forceinline__ float gelu_tanh(float x) { const float u = 0.7978845608028654f * (x + 0.044715f * x * x * x); return 0.5f * x * (1.0f + tanhf(u)); }
template <bool FINAL>
__device__ __forceinline__ void lru_phase(Frame& F, const In& I, const bf16* XB, const bf16* GB, f32x2* AGG, bf16* YCAT) {
    const int ch = TID_, n = ch >> 6, d = ch & 63;
    LAS float* U = (LAS float*)F.lds;
    f32x2 wg[64];
#pragma unroll
    for (int c = 0; c < 64; ++c) { wg[c].x = I.lru_wa[n * 4096 + c * 64 + d]; wg[c].y = I.lru_wx[n * 4096 + c * 64 + d]; }
    const float cw0 = I.conv_w[0 * 512 + ch], cw1 = I.conv_w[1 * 512 + ch], cw2 = I.conv_w[2 * 512 + ch], cw3 = I.conv_w[3 * 512 + ch], cb = I.conv_b[ch];
    const float ba = I.lru_ba[ch], bx = I.lru_bx[ch];
    const float lam = I.lru_lambda[ch]; const float sp = (lam > 15.f) ? expf(-lam) : log1pf(expf(-lam));
    const float m8sp = -8.0f * sp;
    for (int un = blockIdx.x; un < NB * LNCH; un += F.G) {
        const int b = un / LNCH, c = un % LNCH; const size_t row0 = (size_t)b * SEQ + (size_t)c * LCT;
        float x3 = 0.f, x2 = 0.f, x1 = 0.f;
        if (c > 0) { x3 = bf1(XB[(row0 - 3) * 512 + ch]); x2 = bf1(XB[(row0 - 2) * 512 + ch]); x1 = bf1(XB[(row0 - 1) * 512 + ch]); }
#pragma unroll 8
        for (int tk = 0; tk < LCT; ++tk) { const float x0 = bf1(XB[(row0 + tk) * 512 + ch]); U[tk * 512 + ch] = cw0 * x3 + cw1 * x2 + cw2 * x1 + cw3 * x0 + cb; x3 = x2; x2 = x1; x1 = x0; }
        float h = 0.f, Ap = 1.f;
        if (FINAL) { for (int j = 0; j < c; ++j) { const f32x2 ag = AGG[((size_t)b * LNCH + j) * 512 + ch]; h = ag.x * h + ag.y; } }
        __syncthreads();
        for (int tk = 0; tk < LCT; ++tk) {
            const LAS f32x4* up = (const LAS f32x4*)(U + tk * 512 + n * 64);
            f32x2 acc = {ba, bx};
#pragma unroll
            for (int c4 = 0; c4 < 16; ++c4) { const f32x4 uu = up[c4];
                acc += wg[4 * c4 + 0] * uu.x; acc += wg[4 * c4 + 1] * uu.y; acc += wg[4 * c4 + 2] * uu.z; acc += wg[4 * c4 + 3] * uu.w; }
            const float r = sigmoidf_(acc.x), ig = sigmoidf_(acc.y);
            const float la = r * m8sp; const float a = __expf(la); const float bb = sqrtf(-expm1f(2.0f * la)) * (ig * U[tk * 512 + ch]);
            h = a * h + bb;
            if (FINAL) { const float gv = bf1(GB[(row0 + tk) * 512 + ch]); YCAT[(row0 + tk) * 1024 + 512 + ch] = (bf16)f2bf(h * gelu_tanh(gv)); }
            else Ap *= a;
        }
        if (!FINAL) { f32x2 ag; ag.x = Ap; ag.y = h; AGG[((size_t)b * LNCH + c) * 512 + ch] = ag; }
        __syncthreads();
    }
}

__device__ __forceinline__ void route_pass_a(Frame& F, const In& I, int layer, const float* LOG, unsigned char* rt, gu32* cnt) {
    LAS int* lcnt = (LAS int*)(F.lds + RTE_OFF); LAS int* lbase = lcnt + 32;
    int* EID = (int*)(rt + RT_EID); int* POS = (int*)(rt + RT_POS); float* GATE = (float*)(rt + RT_GATE);
    const float* bc = I.moe_bc + layer * 4; const float* bfb = I.moe_bf + layer * 32;
    for (int un = blockIdx.x; un < T / 512; un += F.G) {
        if (TID_ < 32) lcnt[TID_] = 0;
        __syncthreads();
        const int t = un * 512 + TID_; const float* lg = LOG + (size_t)t * 64;
        const f32x4 g4 = *(const f32x4*)lg;
        float gl[4] = {g4.x + bc[0], g4.y + bc[1], g4.z + bc[2], g4.w + bc[3]};
        int gi = 0; float gm = gl[0];
#pragma unroll
        for (int j = 1; j < 4; ++j) if (gl[j] > gm) { gm = gl[j]; gi = j; }
        float gs = 0.f;
#pragma unroll
        for (int j = 0; j < 4; ++j) gs += __expf(gl[j] - gm);
        const float gprob = 1.0f / gs;
        const f32x4 e0 = *(const f32x4*)(lg + 4 + gi * 8), e1 = *(const f32x4*)(lg + 8 + gi * 8);
        float el[8] = {e0.x, e0.y, e0.z, e0.w, e1.x, e1.y, e1.z, e1.w};
#pragma unroll
        for (int j = 0; j < 8; ++j) el[j] += bfb[gi * 8 + j];
        int i0 = 0; float m0 = el[0];
#pragma unroll
        for (int j = 1; j < 8; ++j) if (el[j] > m0) { m0 = el[j]; i0 = j; }
        int i1 = -1; float m1 = -INFINITY;
#pragma unroll
        for (int j = 0; j < 8; ++j) if (j != i0 && el[j] > m1) { m1 = el[j]; i1 = j; }
        const float r1 = __expf(m1 - m0); const float g0 = gprob / (1.0f + r1), g1 = gprob * r1 / (1.0f + r1);
        const int ex0 = gi * 8 + i0, ex1 = gi * 8 + i1;
        const int p0 = atomicAdd((int*)&lcnt[ex0], 1), p1 = atomicAdd((int*)&lcnt[ex1], 1);
        __syncthreads();
        if (TID_ < 32) lbase[TID_] = (int)__hip_atomic_fetch_add(cnt + TID_, (unsigned)lcnt[TID_], RLX_AGENT);
        __syncthreads();
        EID[2 * t] = ex0; EID[2 * t + 1] = ex1; POS[2 * t] = lbase[ex0] + p0; POS[2 * t + 1] = lbase[ex1] + p1; GATE[2 * t] = g0; GATE[2 * t + 1] = g1;
        __syncthreads();
    }
}
__device__ __forceinline__ void route_bases(Frame& F, gu32* cnt) {
    LAS int* eb = (LAS int*)(F.lds + RTE_OFF + 512);
    const int tid = TID_;
    if (tid < 64) {
        const int c = (tid < 32) ? (int)__hip_atomic_load(cnt + (tid & 31), RLX_AGENT) : 0; const int p = (c + 255) & ~255; int s = p;
#pragma unroll
        for (int o = 1; o < 32; o <<= 1) { const int t = __shfl_up(s, o); if ((tid & 63) >= o) s += t; }
        if (tid < 32) { eb[tid] = s - p; if (tid == 31) eb[32] = s; }
    }
    __syncthreads();
}
__device__ __forceinline__ void route_pass_b(Frame& F, unsigned char* rt, gu32* cnt) {
    route_bases(F, cnt);
    LAS int* eb = (LAS int*)(F.lds + RTE_OFF + 512);
    const int* EID = (const int*)(rt + RT_EID); const int* POS = (const int*)(rt + RT_POS); const float* GATE = (const float*)(rt + RT_GATE);
    int* ROWTOK = (int*)(rt + RT_ROWTOK); float* ROWGATE = (float*)(rt + RT_ROWGATE); int* SLOT = (int*)(rt + RT_SLOT);
    const int gt = F.vcu * 512 + TID_, NGT = F.G * 512;
    for (int i = gt; i < 2 * T; i += NGT) { const int dst = eb[EID[i]] + POS[i]; ROWTOK[dst] = i >> 1; ROWGATE[dst] = GATE[i]; SLOT[i] = dst; }
    for (int i = gt; i < 32 * 256; i += NGT) { const int e = i >> 8, j = i & 255; const int c = (int)__hip_atomic_load(cnt + e, RLX_AGENT); const int pad = ((c + 255) & ~255) - c;
        if (j < pad) { ROWTOK[eb[e] + c + j] = 0; ROWGATE[eb[e] + c + j] = 0.f; } }
    __syncthreads();
}
struct MoeOrder {
    int G, c, ntiles; const LAS int* eb; const char* A; const char* W; size_t astep, wexp, wtile; bool gather;
    __device__ bool next(int i, pg8::Unit& u) const {
        const int L = i * G + c; if (L >= ntiles * 4) return false;
        u.pm = L >> 2; u.pn = L & 3; const int s0 = u.pm * 256; int e = 0;
#pragma unroll 1
        for (int j = 1; j < 32; ++j) if (eb[j] <= s0) e = j;
        e = __builtin_amdgcn_readfirstlane(e); u.aux = e; u.A = gather ? A : A + (size_t)u.pm * astep; u.B = W + (size_t)e * wexp + (size_t)u.pn * wtile; return true;
    }
};

constexpr int RTC = 32, RNCH = SEQ / RTC, RTOK = 352;
#define LBAR() do { asm volatile("s_waitcnt lgkmcnt(0)" ::: "memory"); __builtin_amdgcn_s_barrier(); asm volatile("" ::: "memory"); } while (0)
template <int CTRL> __device__ __forceinline__ float dpp_f(float v) { return __builtin_bit_cast(float, __builtin_amdgcn_update_dpp(0, __builtin_bit_cast(int, v), CTRL, 0xf, 0xf, true)); }
__device__ __forceinline__ float red16(float v) { v += dpp_f<0xB1>(v); v += dpp_f<0x4E>(v); v += dpp_f<0x141>(v); v += dpp_f<0x140>(v); return v; }
__device__ __forceinline__ float red8(float v) { v += dpp_f<0xB1>(v); v += dpp_f<0x4E>(v); v += dpp_f<0x141>(v); return v; }
__device__ __forceinline__ void unpack8(const v4u w, float (&f)[8]) { f[0] = bflo(w.x); f[1] = bfhi(w.x); f[2] = bflo(w.y); f[3] = bfhi(w.y); f[4] = bflo(w.z); f[5] = bfhi(w.z); f[6] = bflo(w.w); f[7] = bfhi(w.w); }
__device__ __forceinline__ void rwkv_scan_phase(Frame& F, const In& I, const bf16* R, const bf16* Kt, const bf16* V, const bf16* AA, const bf16* EW, bf16* Y) {
    LAS float* buf = (LAS float*)F.lds;
    LAS float* ybuf = (LAS float*)(F.lds + 2 * RTC * RTOK * 4) + 32;
    const int tid = TID_, lane = tid & 63;
    const int seg = lane & 15, rl = F.wave * 4 + (lane >> 4);
    const int stk = tid >> 4, ssg = tid & 15;
    for (int un = blockIdx.x; un < NB * 16 * 2; un += F.G) {
        const int half = un & 1, h = (un >> 1) & 15, b = un >> 5;
        const size_t rowb = (size_t)b * SEQ;
        const int col = h * 64 + ssg * 4;
        const f32x4 kkw = *(const f32x4*)(I.rwkv_kk + col), kaw = *(const f32x4*)(I.rwkv_ka + col);
        v2u rr, kr, vr, ar, er;
#define RAW_LOAD(cc) do { const size_t off = (rowb + (size_t)(cc) * RTC + stk) * 1024 + col; rr = *(const v2u*)(R + off); kr = *(const v2u*)(Kt + off); vr = *(const v2u*)(V + off); ar = *(const v2u*)(AA + off); er = *(const v2u*)(EW + off); } while (0)
#define RAW_CONVERT(cc) do { LAS float* tp = buf + ((cc) & 1) * (RTC * RTOK) + stk * RTOK + ssg * 4; \
            const float r0 = bflo(rr.x), r1 = bfhi(rr.x), r2 = bflo(rr.y), r3 = bfhi(rr.y), k0 = bflo(kr.x), k1 = bfhi(kr.x), k2 = bflo(kr.y), k3 = bfhi(kr.y); \
            const float a0 = bflo(ar.x), a1 = bfhi(ar.x), a2 = bflo(ar.y), a3 = bfhi(ar.y); \
            const float x0 = k0 * kkw.x, x1 = k1 * kkw.y, x2 = k2 * kkw.z, x3 = k3 * kkw.w; \
            const float ss = red16((x0 * x0 + x1 * x1) + (x2 * x2 + x3 * x3)); const float inv = 1.0f / fmaxf(sqrtf(ss), 1e-12f); \
            *(LAS f32x4*)(tp) = (f32x4){__expf(-bflo(er.x)), __expf(-bfhi(er.x)), __expf(-bflo(er.y)), __expf(-bfhi(er.y))}; \
            const f32x4 kkv = (f32x4){x0 * inv, x1 * inv, x2 * inv, x3 * inv}; *(LAS f32x4*)(tp + 64) = kkv; \
            *(LAS f32x4*)(tp + 128) = (f32x4){kkv.x * a0, kkv.y * a1, kkv.z * a2, kkv.w * a3}; \
            *(LAS f32x4*)(tp + 192) = (f32x4){k0 * (1.0f + (a0 - 1.0f) * kaw.x), k1 * (1.0f + (a1 - 1.0f) * kaw.y), k2 * (1.0f + (a2 - 1.0f) * kaw.z), k3 * (1.0f + (a3 - 1.0f) * kaw.w)}; \
            *(LAS f32x4*)(tp + 256) = (f32x4){r0, r1, r2, r3}; \
            if ((ssg >> 3) == half) *(LAS f32x4*)(buf + ((cc) & 1) * (RTC * RTOK) + stk * RTOK + 320 + (ssg & 7) * 4) = (f32x4){bflo(vr.x), bfhi(vr.x), bflo(vr.y), bfhi(vr.y)}; } while (0)
#define Y_WRITE(cc) do { const LAS f32x2* yp = (const LAS f32x2*)(ybuf + ((cc) & 1) * (RTC * 32 + 32) + stk * 32 + ssg * 2); const f32x2 yv = *yp; \
            *(unsigned*)(Y + (rowb + (size_t)(cc) * RTC + stk) * 1024 + h * 64 + half * 32 + ssg * 2) = pk2(yv.x, yv.y); } while (0)
        RAW_LOAD(0); RAW_CONVERT(0); RAW_LOAD(1);
        f32x2 S0 = (f32x2){0.f, 0.f}, S1 = (f32x2){0.f, 0.f};
        LBAR();
        for (int c = 0; c < RNCH; ++c) {
            if (c + 1 < RNCH) { RAW_CONVERT(c + 1); }
            if (c + 2 < RNCH) { RAW_LOAD(c + 2); }
            if (c >= 1) { Y_WRITE(c - 1); }
            const LAS float* cb = buf + (c & 1) * (RTC * RTOK); LAS float* yb = ybuf + (c & 1) * (RTC * 32 + 32);
            const LAS float* tp0 = cb + seg * 4; const LAS float* vp0 = cb + 320 + rl;
#define SV_DECL(X) f32x4 X##w, X##q, X##b, X##k, X##r; float X##v
#define SV_LOAD(X, tk) do { const LAS float* tp = tp0 + (tk) * RTOK; \
                X##w = *(const LAS f32x4*)(tp); X##q = *(const LAS f32x4*)(tp + 64); X##b = *(const LAS f32x4*)(tp + 128); X##k = *(const LAS f32x4*)(tp + 192); X##r = *(const LAS f32x4*)(tp + 256); X##v = vp0[(tk) * RTOK]; } while (0)
#define SV_STEP(X, tk) do { \
                const f32x2 d = S0 * (f32x2){X##q.x, X##q.y} + S1 * (f32x2){X##q.z, X##q.w}; \
                const f32x2 t0 = S0 * (f32x2){X##w.x, X##w.y} + (f32x2){X##k.x, X##k.y} * X##v, t1 = S1 * (f32x2){X##w.z, X##w.w} + (f32x2){X##k.z, X##k.w} * X##v; \
                float ra = d.x + d.y, rb = epend;                   \
                ra += dpp_f<0xB1>(ra); rb += dpp_f<0xB1>(rb); ra += dpp_f<0x4E>(ra); rb += dpp_f<0x4E>(rb); ra += dpp_f<0x141>(ra); rb += dpp_f<0x141>(rb); ra += dpp_f<0x140>(ra); rb += dpp_f<0x140>(rb); \
                if (seg == 0) yb[((tk) - 1) * 32 + rl] = rb;        \
                const float sa = -ra; \
                S0 = t0 + (f32x2){X##b.x, X##b.y} * sa; S1 = t1 + (f32x2){X##b.z, X##b.w} * sa; \
                const f32x2 e = S0 * (f32x2){X##r.x, X##r.y} + S1 * (f32x2){X##r.z, X##r.w}; epend = e.x + e.y; } while (0)
            SV_DECL(A_); SV_DECL(B_); float epend = 0.f;
            SV_LOAD(A_, 0);
#pragma unroll 1
            for (int tk = 0; tk < RTC; tk += 2) {
                SV_LOAD(B_, tk + 1);
                SV_STEP(A_, tk);
                { const int t2 = (tk + 2 < RTC) ? tk + 2 : RTC - 1; SV_LOAD(A_, t2); }
                SV_STEP(B_, tk + 1);
            }
#undef SV_DECL
#undef SV_LOAD
#undef SV_STEP
            { const float rb = red16(epend); if (seg == 0) yb[(RTC - 1) * 32 + rl] = rb; }
            LBAR();
        }
        Y_WRITE(RNCH - 1);
        LBAR();
#undef RAW_LOAD
#undef RAW_CONVERT
#undef Y_WRITE
    }
}
__device__ __forceinline__ void rwkv_post_pass(Frame& F, const In& I, const bf16* R, const bf16* Kt, const bf16* V, const bf16* AA, const bf16* G, bf16* Y) {
    const int gw = F.vcu * NWAVES + F.wave, NGW = F.G * NWAVES; const int col = LANE_ * 16;
    for (int t = gw; t < T; t += NGW) {
        const size_t off = (size_t)t * 1024 + col;
        float y[16], r[16], k[16], v[16], a[16], g[16];
#pragma unroll
        for (int hf = 0; hf < 2; ++hf) {
            float t8[8];
            unpack8(*(const v4u*)(Y + off + hf * 8), t8);
#pragma unroll
            for (int e = 0; e < 8; ++e) y[hf * 8 + e] = t8[e];
            unpack8(*(const v4u*)(R + off + hf * 8), t8);
#pragma unroll
            for (int e = 0; e < 8; ++e) r[hf * 8 + e] = t8[e];
            unpack8(*(const v4u*)(Kt + off + hf * 8), t8);
#pragma unroll
            for (int e = 0; e < 8; ++e) k[hf * 8 + e] = t8[e];
            unpack8(*(const v4u*)(V + off + hf * 8), t8);
#pragma unroll
            for (int e = 0; e < 8; ++e) v[hf * 8 + e] = t8[e];
            unpack8(*(const v4u*)(AA + off + hf * 8), t8);
#pragma unroll
            for (int e = 0; e < 8; ++e) a[hf * 8 + e] = t8[e];
            unpack8(*(const v4u*)(G + off + hf * 8), t8);
#pragma unroll
            for (int e = 0; e < 8; ++e) g[hf * 8 + e] = t8[e];
        }
        float s = 0.f, bs = 0.f;
#pragma unroll
        for (int e = 0; e < 16; ++e) { s += y[e]; const float kp = k[e] * (1.0f + (a[e] - 1.0f) * I.rwkv_ka[col + e]); bs += r[e] * kp * I.rwkv_rk[col + e]; }
        s += __shfl_xor(s, 1); s += __shfl_xor(s, 2); bs += __shfl_xor(bs, 1); bs += __shfl_xor(bs, 2);
        const float mean = s * (1.0f / 64.0f); float q = 0.f;
#pragma unroll
        for (int e = 0; e < 16; ++e) { const float dd = y[e] - mean; q += dd * dd; }
        q += __shfl_xor(q, 1); q += __shfl_xor(q, 2);
        const float rstd = 1.0f / sqrtf(q * (1.0f / 64.0f) + 64e-5f);
        float o[16];
#pragma unroll
        for (int e = 0; e < 16; ++e) o[e] = ((y[e] - mean) * rstd * I.rwkv_ln_g[col + e] + I.rwkv_ln_b[col + e] + bs * v[e]) * g[e];
        v4u w0, w1; w0.x = pk2(o[0], o[1]); w0.y = pk2(o[2], o[3]); w0.z = pk2(o[4], o[5]); w0.w = pk2(o[6], o[7]); w1.x = pk2(o[8], o[9]); w1.y = pk2(o[10], o[11]); w1.z = pk2(o[12], o[13]); w1.w = pk2(o[14], o[15]);
        *(v4u*)(Y + off) = w0; *(v4u*)(Y + off + 8) = w1;
    }
}

#ifndef DUP_K
#define DUP_K (-1)
#endif
#ifndef DUP_K2
#define DUP_K2 (-1)
#endif
#define KARGS ((const __attribute__((address_space(4))) Args*)__builtin_amdgcn_kernarg_segment_ptr())
#define WSPTRS \
    bf16* H0 = (bf16*)(ws + WS_H0); bf16* QKV = (bf16*)(ws + WS_QKV); bf16* OB = (bf16*)(ws + WS_O); f32x2* AGG = (f32x2*)(ws + WS_LRUAGG); \
    bf16* H2 = (bf16*)(ws + WS_H2); float* LOG = (float*)(ws + WS_LOG); unsigned char* RTE = ws + WS_ROUTE; bf16* HID = (bf16*)(ws + WS_HID); bf16* YS = (bf16*)(ws + WS_YS); bf16* PP = (bf16*)(ws + WS_PP); \
    bf16* HCAT = (bf16*)(ws + WS_HCAT); bf16* RB = (bf16*)(ws + WS_R); bf16* MID = (bf16*)(ws + WS_MID); bf16* EWB = (bf16*)(ws + WS_EW); bf16* AAB = (bf16*)(ws + WS_AA); bf16* YB = (bf16*)(ws + WS_Y); \
    const size_t TD = (size_t)T * 1024; (void)H0; (void)QKV; (void)OB; (void)AGG; (void)H2; (void)LOG; (void)RTE; (void)HID; (void)YS; (void)PP; (void)HCAT; (void)RB; (void)MID; (void)EWB; (void)AAB; (void)YB; (void)TD;

struct Args { In in; float* out; unsigned char* ws; int ph_lo, ph_hi; };
constexpr int N_PHASES = 32;
__device__ __forceinline__ int nrep(int k) { int n = (k == DUP_K) ? 2 : 1; if (DUP_K >= 0) asm volatile("" : "+s"(n)); return n; }
#define REP_SYNC if (rep_) __syncthreads();
typedef const __attribute__((address_space(4))) unsigned long long* kp64;
__device__ __forceinline__ void load_in(In& I) { kp64 s = (kp64)__builtin_amdgcn_kernarg_segment_ptr(); unsigned long long* d = (unsigned long long*)&I;
#pragma unroll
    for (int i = 0; i < 47; ++i) d[i] = s[i]; }

__device__ __forceinline__ int t5_bucket(int n) { if (n < 16) return n; const float v = logf((float)n / 16.0f) / 2.0794415416798357f * 16.0f; const int l = 16 + (int)v; return l < 31 ? l : 31; }

template <class Epi>
__device__ __forceinline__ void dense_gemm(Frame& F, const void* A, int lda, const void* B, int K, int M, int N, const Epi& E) {
    pg8::DenseOrder S; S.init(A, lda, B, K, M, N, F.G, (int)blockIdx.x);
    pg8::gemm_phase<Epi, pg8::DenseOrder, true, false>(F.lds, K, lda, S, E, nullptr);
}

__global__ void __launch_bounds__(NWAVES * 64, 2) mk_fwd(Args args) {
    extern __shared__ __attribute__((aligned(16))) unsigned char lds[];
    Frame F;
    F.lds = (LAS unsigned char*)lds;
    F.MISC = (volatile LAS unsigned*)(F.lds + MISC_OFF);
    F.wave = __builtin_amdgcn_readfirstlane(TID_ >> 6);
    F.G = gridDim.x; { const int bx = blockIdx.x; F.vcu = (F.G % 8 == 0) ? (bx % 8) * (F.G / 8) + bx / 8 : bx; }
    F.ctl = (gu32*)(KARGS->ws + WS_CTL);
    for (int u = TID_; u < (LDS_BYTES - LDSCTL_OFF) / 4; u += NWAVES * 64) ((LAS unsigned*)(F.lds + LDSCTL_OFF))[u] = 0u;
    __syncthreads();
    {
        LAS float* tb = (LAS float*)(F.lds + TB_OFF); const int h = TID_ >> 7, i = TID_ & 127;
        const float* rb = KARGS->in.rel_bias;
        tb[h * 128 + i] = (rb[t5_bucket(i) * 4 + h] - rb[31 * 4 + h]) * 1.4426950408889634f;
    }
    __syncthreads();
    const int lo = KARGS->ph_lo, hi = KARGS->ph_hi;
    const bool multi = (hi - lo) > 1;
    XcdBarrier bar; bar.bar = (unsigned*)(F.ctl + CW_BAR); bar.x = 0; bar.st = nullptr;
    if (multi) bar = xcd_barrier_post((unsigned*)(F.ctl + CW_BAR), F.MISC + 8);
#define IN(k) (lo <= (k) && (k) < hi)
#define PH_BEGIN_ unsigned char* ws = KARGS->ws; float* X = KARGS->out; In I; load_in(I); (void)X; WSPTRS
#define SEAM(k) do { if (IN(k) && IN((k) + 1)) xcd_barrier(bar); } while (0)

    if (IN(0)) { PH_BEGIN_ prep_dense_weights(F, I, ws); prep_layer_weights(F, I, ws, 0); norm_pass<0>(F, I.x, I.norm_mix, H0);
#ifdef DUP_PREP
        __syncthreads(); prep_dense_weights(F, I, ws); prep_layer_weights(F, I, ws, 0);
#endif
    } SEAM(0);
    if (IN(1)) { PH_BEGIN_ pg8::EpiBf16 E{QKV, 512, 512, (size_t)T * 512, attn_body::C2}; dense_gemm(F, H0, 1024, ws + WS_WIN, 1024, T, AB_IN, E); } SEAM(1);
    if (IN(2)) { PH_BEGIN_ lru_phase<false>(F, I, QKV + 3 * (size_t)T * 512, QKV + 4 * (size_t)T * 512, AGG, H0); } SEAM(2);
    if (IN(3)) { PH_BEGIN_
        const attn_body::AttnTensors AT{(const attn_body::bf16*)QKV, (const attn_body::bf16*)(QKV + (size_t)T * 512), (const attn_body::bf16*)(QKV + 2 * (size_t)T * 512), (attn_body::bf16*)OB};
        if (F.G == 256) attn_body::attn_phase<8>((char*)lds, AT, F.vcu, (const LAS float*)(F.lds + TB_OFF));
#ifdef DUP_ATTN
        __syncthreads(); if (F.G == 256) attn_body::attn_phase<8>((char*)lds, AT, F.vcu, (const LAS float*)(F.lds + TB_OFF));
#endif
        __syncthreads();
        lru_phase<true>(F, I, QKV + 3 * (size_t)T * 512, QKV + 4 * (size_t)T * 512, AGG, H0);
    } SEAM(3);
    if (IN(4)) { PH_BEGIN_ diff_combine_pass(F, I, OB, H0); } SEAM(4);
    if (IN(5)) { PH_BEGIN_ pg8::EpiResF32 E{I.x, X}; dense_gemm(F, H0, 1024, ws + WS_WOUT, 1024, T, 1024, E); } SEAM(5);

#define MOE_PLE_PHASES(P, L) \
    if (IN(P + 0)) { PH_BEGIN_ norm_pass<0>(F, X, I.norm_ffn + (L) * 1024, H2); } SEAM(P + 0); \
    if (IN(P + 1)) { PH_BEGIN_ pg8::EpiRouter E{LOG}; dense_gemm(F, H2, 1024, ws + WS_ROUT + (size_t)(L) * 256 * 1024 * 2, 1024, T, 256, E); } SEAM(P + 1); \
    if (IN(P + 2)) { PH_BEGIN_ route_pass_a(F, I, (L), LOG, RTE, F.ctl + ((L) ? CW_CNT1 : CW_CNT0)); } SEAM(P + 2); \
    if (IN(P + 3)) { PH_BEGIN_ route_pass_b(F, RTE, F.ctl + ((L) ? CW_CNT1 : CW_CNT0)); } SEAM(P + 3); \
    if (IN(P + 4)) { PH_BEGIN_ route_bases(F, F.ctl + ((L) ? CW_CNT1 : CW_CNT0)); const LAS int* eb = (const LAS int*)(F.lds + RTE_OFF + 512); \
        MoeOrder S{F.G, (int)blockIdx.x, __builtin_amdgcn_readfirstlane(eb[32] >> 8), eb, (const char*)H2, (const char*)(ws + WS_MGU), 0, (size_t)1024 * 1024 * 2, (size_t)256 * 1024 * 2, true}; pg8::EpiGU E{HID}; \
        pg8::gemm_phase<pg8::EpiGU, MoeOrder, true, true>(F.lds, 1024, 1024, S, E, (const int*)(RTE + RT_ROWTOK)); } SEAM(P + 4); \
    if (IN(P + 5)) { PH_BEGIN_ route_bases(F, F.ctl + ((L) ? CW_CNT1 : CW_CNT0)); const LAS int* eb = (const LAS int*)(F.lds + RTE_OFF + 512); \
        MoeOrder S{F.G, (int)blockIdx.x, __builtin_amdgcn_readfirstlane(eb[32] >> 8), eb, (const char*)HID, (const char*)(ws + WS_MDN), (size_t)256 * 512 * 2, (size_t)1024 * 512 * 2, (size_t)256 * 512 * 2, false}; pg8::EpiDown E{YS, (const float*)(RTE + RT_ROWGATE)}; \
        pg8::gemm_phase<pg8::EpiDown, MoeOrder, true, false>(F.lds, 512, 512, S, E, nullptr); } SEAM(P + 5); \
    if (IN(P + 6)) { PH_BEGIN_ combine_norm_pass(F, X, X, YS, (const int*)(RTE + RT_SLOT), I.ple_norm + (L) * 1024, H2); } SEAM(P + 6); \
    if (IN(P + 7)) { PH_BEGIN_ pg8::EpiBf16 E{PP, 1024, 0, 0, 1.f}; dense_gemm(F, ws + WS_PB, 256, ws + WS_PPROJ + (size_t)(L) * 1024 * 256 * 2, 256, T, 1024, E); } SEAM(P + 7); \
    if (IN(P + 8)) { PH_BEGIN_ pg8::EpiPle E{X, PP}; dense_gemm(F, H2, 1024, ws + WS_PGATE + (size_t)(L) * 1024 * 1024 * 2, 1024, T, 1024, E); } SEAM(P + 8);

    MOE_PLE_PHASES(6, 0)
    if (IN(15)) { PH_BEGIN_ norm_pass<1>(F, X, I.norm_mix + 1024, HCAT); prep_layer_weights(F, I, ws, 1); } SEAM(15);
    if (IN(16)) { PH_BEGIN_ pg8::EpiRwkv1 E{RB, TD, MID}; dense_gemm(F, HCAT, 2048, ws + WS_RCAT, 2048, T, 3584, E); } SEAM(16);
    if (IN(17)) { PH_BEGIN_ pg8::EpiRwkv2 E{EWB, AAB, I.rwkv_w0, I.rwkv_a0, 0}; dense_gemm(F, MID, 512, ws + WS_RS2, 256, T, 2048, E); } SEAM(17);
    if (IN(18)) { PH_BEGIN_ rwkv_scan_phase(F, I, RB, RB + TD, RB + 2 * TD, AAB, EWB, YB);
#ifdef DUP_SCAN
        __syncthreads(); rwkv_scan_phase(F, I, RB, RB + TD, RB + 2 * TD, AAB, EWB, YB);
#endif
    } SEAM(18);
    if (IN(19)) { PH_BEGIN_ pg8::EpiRwkv2 E{EWB, EWB, nullptr, nullptr, 2}; dense_gemm(F, MID + 256, 512, ws + WS_RS2 + (size_t)2 * 1024 * 256 * 2, 256, T, 1024, E); } SEAM(19);
    if (IN(20)) { PH_BEGIN_ rwkv_post_pass(F, I, RB, RB + TD, RB + 2 * TD, AAB, EWB, YB); } SEAM(20);
    if (IN(21)) { PH_BEGIN_ pg8::EpiResF32 E{X, X}; dense_gemm(F, YB, 1024, ws + WS_RWO, 1024, T, 1024, E); } SEAM(21);
    MOE_PLE_PHASES(22, 1)
    if (IN(31)) { PH_BEGIN_ final_norm_pass(F, X, I.final_norm); }
#undef IN
#undef SEAM
}

extern "C" void kernel_launch(void* const* d_in, const int* in_sizes, int n_in, void* d_out, int out_size, void* d_ws, size_t ws_size, hipStream_t stream) {
    static int ok = 0;
    if (ok == 0) {
        if (n_in != 47 || out_size != T * D || ws_size < WS_END) { fprintf(stderr, "kernel_launch: unexpected problem shape (n_in %d out %d ws %zu)\n", n_in, out_size, ws_size); ok = -1; return; }
        if (hipFuncSetAttribute((const void*)mk_fwd, hipFuncAttributeMaxDynamicSharedMemorySize, LDS_BYTES) != hipSuccess) { fprintf(stderr, "kernel_launch: hipFuncSetAttribute failed\n"); ok = -1; return; }
        int per_cu = 0;
        if (hipOccupancyMaxActiveBlocksPerMultiprocessor(&per_cu, (const void*)mk_fwd, NWAVES * 64, LDS_BYTES) != hipSuccess || per_cu < 1) fprintf(stderr, "kernel_launch: occupancy query reports %d\n", per_cu);
        (void)hipGetLastError();
        ok = 1;
    }
    if (ok < 0) return;
    (void)hipMemsetAsync((char*)d_ws + WS_CTL, 0, CTL_ZERO_BYTES, stream);
    Args a{};
    const float** ip = (const float**)&a.in;
    for (int i = 0; i < 47; ++i) ip[i] = (const float*)d_in[i];
    a.out = (float*)d_out; a.ws = (unsigned char*)d_ws;
    const int grid = 256;
#if MK_ONE_LAUNCH
    a.ph_lo = 0; a.ph_hi = N_PHASES;
    hipLaunchKernelGGL(mk_fwd, dim3(grid), dim3(NWAVES * 64), LDS_BYTES, stream, a);
#else
    for (int k = 0; k < N_PHASES; ++k) { a.ph_lo = k; a.ph_hi = k + 1; hipLaunchKernelGGL(mk_fwd, dim3(grid), dim3(NWAVES * 64), LDS_BYTES, stream, a);
        if (k == DUP_K || k == DUP_K2) hipLaunchKernelGGL(mk_fwd, dim3(grid), dim3(NWAVES * 64), LDS_BYTES, stream, a); }
#endif
}
```

```cpp
#include <hip/hip_runtime.h>
#include <hip/hip_bf16.h>
#include <cstdio>
#include <cstdint>
#include <cmath>

#ifndef MK_ONE_LAUNCH
#define MK_ONE_LAUNCH 1
#endif

#define GAS __attribute__((address_space(1)))
#define LAS __attribute__((address_space(3)))
typedef unsigned short bf16;
typedef unsigned v4u __attribute__((ext_vector_type(4)));
typedef unsigned v2u __attribute__((ext_vector_type(2)));
typedef float f32x4 __attribute__((ext_vector_type(4)));
typedef float f32x2 __attribute__((ext_vector_type(2)));
typedef short bf16x8 __attribute__((ext_vector_type(8)));
typedef GAS unsigned gu32;
#define RLX_AGENT __ATOMIC_RELAXED, __HIP_MEMORY_SCOPE_AGENT
#define LDS_WAIT() asm volatile("s_waitcnt lgkmcnt(0)" ::: "memory")
#define VM_WAIT() asm volatile("s_waitcnt vmcnt(0)" ::: "memory")
__device__ __forceinline__ unsigned f2bf(float f) { unsigned u = __builtin_bit_cast(unsigned, f); return (u + 0x7fffu + ((u >> 16) & 1u)) >> 16; }
__device__ __forceinline__ unsigned pk2(float lo, float hi) { return f2bf(lo) | (f2bf(hi) << 16); }
__device__ __forceinline__ float bflo(unsigned w) { return __uint_as_float(w << 16); }
__device__ __forceinline__ float bfhi(unsigned w) { return __uint_as_float(w & 0xffff0000u); }
__device__ __forceinline__ float bf1(bf16 h) { return __uint_as_float((unsigned)h << 16); }
__device__ __forceinline__ float sigmoidf_(float x) { return 1.0f / (1.0f + __expf(-x)); }
__device__ __forceinline__ void fmac_(float& acc, float a, float b) { asm("v_fmac_f32 %0, %1, %2" : "+v"(acc) : "v"(a), "v"(b)); }
__device__ __forceinline__ float fma_(float a, float b, float c) { float r; asm("v_fma_f32 %0, %1, %2, %3" : "=v"(r) : "v"(a), "v"(b), "v"(c)); return r; }
__device__ __forceinline__ float mul_(float a, float b) { float r; asm("v_mul_f32 %0, %1, %2" : "=v"(r) : "v"(a), "v"(b)); return r; }
__device__ __forceinline__ float wave_sum(float v) {
#pragma unroll
    for (int o = 1; o < 64; o <<= 1) v += __shfl_xor(v, o);
    return v;
}

constexpr int NB = 8, SEQ = 8192, D = 1024, T = NB * SEQ;
constexpr int AB_IN = 2560, PLE = 256;
constexpr int NEXP = 32, EH = 512;
constexpr int MAXSLOT = 2 * T + NEXP * 256;
constexpr int MAXTILES = MAXSLOT / 256;

namespace pg8 {
#define PG8_LAS __attribute__((address_space(3)))
typedef unsigned short bf16_t;
typedef unsigned u32x4 __attribute__((ext_vector_type(4)));
typedef unsigned u32x2 __attribute__((ext_vector_type(2)));
constexpr int BM = 256, BK = 64, HALF = 128, HTB = HALF * BK * 2, STAGE_BYTES = 8 * HTB, NXCD = 8, WGM = 8;
__host__ __device__ __forceinline__ int lds_byte(int r, int c) { const int st = (r >> 4) * 2 + (c >> 5), rr = r & 15, cc = c & 31, ob = rr * 64 + cc * 2; return st * 1024 + (ob ^ (((ob >> 9) & 1) << 5)); }
__host__ __device__ __forceinline__ void stage_rc(int b, int& R, int& C) { const int st = b / 1024, sb = b % 1024, swz = sb ^ (((sb >> 9) & 1) << 5); R = (st >> 1) * 16 + swz / 64; C = (st & 1) * 32 + (swz % 64) / 2; }
__host__ __device__ __forceinline__ int perm32(int rho) { const int n = rho >> 4, i = rho & 15; return 8 * (i >> 2) + 4 * n + (i & 3); }

struct Unit { int pm, pn, aux; const char* A; const char* B; };

struct DenseOrder {
    int nM, nN, nwg, G, c; const char* A; const char* B; size_t astep, bstep;
    __device__ void init(const void* A_, int lda, const void* B_, int K, int M, int N, int G_, int c_) { nM = M / BM; nN = N / BM; nwg = nM * nN; G = G_; c = c_; A = (const char*)A_; B = (const char*)B_; astep = (size_t)BM * lda * 2; bstep = (size_t)BM * K * 2; }
    __device__ bool next(int i, Unit& u) const {
        const long L = (long)i * G + c; if (L >= nwg) return false;
        int wgid = (int)L; { const int q = nwg / NXCD, r = nwg % NXCD, xcd = wgid % NXCD, off = wgid / NXCD; wgid = (xcd < r ? xcd * (q + 1) : r * (q + 1) + (xcd - r) * q) + off; }
        const int nig = WGM * nN, gid = wgid / nig, fm = gid * WGM, gsz = (nM - fm) < WGM ? (nM - fm) : WGM;
        u.pm = fm + ((wgid % nig) % gsz); u.pn = (wgid % nig) / gsz; u.aux = 0; u.A = A + (size_t)u.pm * astep; u.B = B + (size_t)u.pn * bstep; return true;
    }
};

__device__ __forceinline__ unsigned cvt_pk_bf16(float lo, float hi) { unsigned r; asm volatile("v_cvt_pk_bf16_f32 %0, %1, %2" : "=v"(r) : "v"(lo), "v"(hi)); return r; }

typedef f32x4 Acc[2][2][4][2];

struct EpiBf16 {
    static constexpr bool PERM = true;
    bf16_t* O; int ldc; int split_cols; size_t split_stride; float scale0;
    __device__ __forceinline__ void operator()(const Acc& acc, const Unit& u, int wr, int wc, int fr, int fq) const {
        const int row0 = u.pm * BM + wr * 64 + fr; int colt = u.pn * BM; bf16_t* base = O;
        float sc = 1.f; if (split_cols) { const int t = colt / split_cols; base += (size_t)t * split_stride; colt -= t * split_cols; if (t == 0) sc = scale0; }
        const int col0 = colt + wc * 32 + 8 * fq;
#pragma unroll
        for (int ai = 0; ai < 2; ++ai)
#pragma unroll
            for (int m = 0; m < 4; ++m) { bf16_t* rowp = base + (size_t)(row0 + ai * HALF + m * 16) * ldc + col0;
#pragma unroll
                for (int bj = 0; bj < 2; ++bj) { f32x4 v0 = acc[ai][bj][m][0] * sc, v1 = acc[ai][bj][m][1] * sc;
                    u32x4 w; w.x = cvt_pk_bf16(v0[0], v0[1]); w.y = cvt_pk_bf16(v0[2], v0[3]); w.z = cvt_pk_bf16(v1[0], v1[1]); w.w = cvt_pk_bf16(v1[2], v1[3]);
                    *(u32x4*)(rowp + bj * HALF) = w; } }
    }
};
struct EpiResF32 {
    static constexpr bool PERM = false;
    const float* base; float* out;
    __device__ __forceinline__ void operator()(const Acc& acc, const Unit& u, int wr, int wc, int fr, int fq) const {
        const int col0 = u.pn * BM + wc * 32 + 4 * fq;
        const GAS float* bp = (const GAS float*)base; GAS float* op = (GAS float*)out;
#pragma unroll
        for (int ai = 0; ai < 2; ++ai) {
            f32x4 bs[4][2][2];
#pragma unroll
            for (int m = 0; m < 4; ++m) { const size_t off = (size_t)(u.pm * BM + ai * HALF + wr * 64 + m * 16 + fr) * 1024 + col0;
#pragma unroll
                for (int bj = 0; bj < 2; ++bj)
#pragma unroll
                    for (int n = 0; n < 2; ++n) bs[m][bj][n] = *(const GAS f32x4*)(bp + off + bj * HALF + n * 16); }
            asm volatile("" ::: "memory");
#pragma unroll
            for (int m = 0; m < 4; ++m) { const size_t off = (size_t)(u.pm * BM + ai * HALF + wr * 64 + m * 16 + fr) * 1024 + col0;
#pragma unroll
                for (int bj = 0; bj < 2; ++bj)
#pragma unroll
                    for (int n = 0; n < 2; ++n) *(GAS f32x4*)(op + off + bj * HALF + n * 16) = bs[m][bj][n] + acc[ai][bj][m][n]; }
            asm volatile("" ::: "memory");
        }
    }
};
struct EpiRouter {
    static constexpr bool PERM = false;
    float* out;
    __device__ __forceinline__ void operator()(const Acc& acc, const Unit& u, int wr, int wc, int fr, int fq) const {
        if (wc >= 2) return;
#pragma unroll
        for (int ai = 0; ai < 2; ++ai)
#pragma unroll
            for (int m = 0; m < 4; ++m) { const size_t off = (size_t)(u.pm * BM + ai * HALF + wr * 64 + m * 16 + fr) * 64 + wc * 32 + 4 * fq;
#pragma unroll
                for (int n = 0; n < 2; ++n) *(f32x4*)(out + off + n * 16) = acc[ai][0][m][n]; }
    }
};
struct EpiGU {
    static constexpr bool PERM = true;
    bf16_t* H;
    __device__ __forceinline__ void operator()(const Acc& acc, const Unit& u, int wr, int wc, int fr, int fq) const {
        const int col0 = u.pn * 128 + wc * 32 + 8 * fq;
#pragma unroll
        for (int ai = 0; ai < 2; ++ai)
#pragma unroll
            for (int m = 0; m < 4; ++m) { bf16_t* rowp = H + (size_t)(u.pm * BM + ai * HALF + wr * 64 + m * 16 + fr) * EH + col0;
                f32x4 g0 = acc[ai][0][m][0], g1 = acc[ai][0][m][1]; const f32x4 u0 = acc[ai][1][m][0], u1 = acc[ai][1][m][1];
#pragma unroll
                for (int e = 0; e < 4; ++e) { g0[e] = g0[e] * sigmoidf_(g0[e]) * u0[e]; g1[e] = g1[e] * sigmoidf_(g1[e]) * u1[e]; }
                u32x4 w; w.x = cvt_pk_bf16(g0[0], g0[1]); w.y = cvt_pk_bf16(g0[2], g0[3]); w.z = cvt_pk_bf16(g1[0], g1[1]); w.w = cvt_pk_bf16(g1[2], g1[3]);
                *(u32x4*)rowp = w; }
    }
};
struct EpiDown {
    static constexpr bool PERM = true;
    bf16_t* Y; const float* gate;
    __device__ __forceinline__ void operator()(const Acc& acc, const Unit& u, int wr, int wc, int fr, int fq) const {
        const int col0 = u.pn * BM + wc * 32 + 8 * fq;
#pragma unroll
        for (int ai = 0; ai < 2; ++ai)
#pragma unroll
            for (int m = 0; m < 4; ++m) { const int row = u.pm * BM + ai * HALF + wr * 64 + m * 16 + fr; const float sc = gate[row]; bf16_t* rowp = Y + (size_t)row * 1024 + col0;
#pragma unroll
                for (int bj = 0; bj < 2; ++bj) { const f32x4 v0 = acc[ai][bj][m][0] * sc, v1 = acc[ai][bj][m][1] * sc;
                    u32x4 w; w.x = cvt_pk_bf16(v0[0], v0[1]); w.y = cvt_pk_bf16(v0[2], v0[3]); w.z = cvt_pk_bf16(v1[0], v1[1]); w.w = cvt_pk_bf16(v1[2], v1[3]);
                    *(u32x4*)(rowp + bj * HALF) = w; } }
    }
};
struct EpiPle {
    static constexpr bool PERM = false;
    float* x; const bf16_t* pp;
    __device__ __forceinline__ void operator()(const Acc& acc, const Unit& u, int wr, int wc, int fr, int fq) const {
        const int col0 = u.pn * BM + wc * 32 + 4 * fq;
        GAS float* xp = (GAS float*)x; const GAS bf16_t* pq = (const GAS bf16_t*)pp;
#pragma unroll
        for (int ai = 0; ai < 2; ++ai)
#pragma unroll
            for (int mp = 0; mp < 2; ++mp) {
                f32x4 bs[2][2][2]; u32x2 pw[2][2][2];
#pragma unroll
                for (int mm = 0; mm < 2; ++mm) { const size_t off = (size_t)(u.pm * BM + ai * HALF + wr * 64 + (2 * mp + mm) * 16 + fr) * 1024 + col0;
#pragma unroll
                    for (int bj = 0; bj < 2; ++bj)
#pragma unroll
                        for (int n = 0; n < 2; ++n) { const size_t o = off + bj * HALF + n * 16; bs[mm][bj][n] = *(const GAS f32x4*)(xp + o); pw[mm][bj][n] = *(const GAS u32x2*)(pq + o); } }
                asm volatile("" ::: "memory");
#pragma unroll
                for (int mm = 0; mm < 2; ++mm) { const size_t off = (size_t)(u.pm * BM + ai * HALF + wr * 64 + (2 * mp + mm) * 16 + fr) * 1024 + col0;
#pragma unroll
                    for (int bj = 0; bj < 2; ++bj)
#pragma unroll
                        for (int n = 0; n < 2; ++n) { const size_t o = off + bj * HALF + n * 16; const f32x4 a = acc[ai][bj][2 * mp + mm][n]; const f32x4 b = bs[mm][bj][n]; const u32x2 p = pw[mm][bj][n]; f32x4 r;
                            r[0] = b[0] + bflo(p.x) * sigmoidf_(a[0]); r[1] = b[1] + bfhi(p.x) * sigmoidf_(a[1]); r[2] = b[2] + bflo(p.y) * sigmoidf_(a[2]); r[3] = b[3] + bfhi(p.y) * sigmoidf_(a[3]);
                            *(GAS f32x4*)(xp + o) = r; } }
                asm volatile("" ::: "memory");
            }
    }
};
struct EpiMid {
    static constexpr bool PERM = true;
    bf16_t* MID;
    __device__ __forceinline__ void operator()(const Acc& acc, const Unit& u, int wr, int wc, int fr, int fq) const {
        const int row0 = u.pm * BM + wr * 64 + fr;
        const int mode = (u.pn == 1) ? 2 : 0; const int colbase = u.pn * 256;
#pragma unroll
        for (int ai = 0; ai < 2; ++ai)
#pragma unroll
            for (int m = 0; m < 4; ++m) { bf16_t* rowp = MID + (size_t)(row0 + ai * HALF + m * 16) * 512 + colbase;
#pragma unroll
                for (int bj = 0; bj < 2; ++bj) { const int lc = bj * HALF + wc * 32 + 8 * fq; f32x4 v0 = acc[ai][bj][m][0], v1 = acc[ai][bj][m][1];
#pragma unroll
                    for (int e = 0; e < 4; ++e) {
                        if (mode == 2) { v0[e] = sigmoidf_(v0[e]); v1[e] = sigmoidf_(v1[e]); }
                        else if (lc < 64) { v0[e] = tanhf(v0[e]); v1[e] = tanhf(v1[e]); } }
                    u32x4 w; w.x = cvt_pk_bf16(v0[0], v0[1]); w.y = cvt_pk_bf16(v0[2], v0[3]); w.z = cvt_pk_bf16(v1[0], v1[1]); w.w = cvt_pk_bf16(v1[2], v1[3]);
                    *(u32x4*)(rowp + lc) = w; } }
    }
};
struct EpiRwkv2 {
    static constexpr bool PERM = true;
    bf16_t* O0; bf16_t* O1; const float* bias0; const float* bias1; int tybase;
    __device__ __forceinline__ void operator()(const Acc& acc, const Unit& u, int wr, int wc, int fr, int fq) const {
        const int ty = tybase + (u.pn >> 2); const int row0 = u.pm * BM + wr * 64 + fr; const int colt = (u.pn & 3) * BM + wc * 32 + 8 * fq;
        bf16_t* base = (u.pn >> 2) ? O1 : O0; const float* bias = (u.pn >> 2) ? bias1 : bias0;
#pragma unroll
        for (int bj = 0; bj < 2; ++bj) {
            f32x4 b0 = (f32x4){0.f, 0.f, 0.f, 0.f}, b1 = b0;
            if (ty < 2) { b0 = *(const f32x4*)(bias + colt + bj * HALF); b1 = *(const f32x4*)(bias + colt + bj * HALF + 4); }
#pragma unroll
            for (int ai = 0; ai < 2; ++ai)
#pragma unroll
                for (int m = 0; m < 4; ++m) { bf16_t* rowp = base + (size_t)(row0 + ai * HALF + m * 16) * 1024 + colt + bj * HALF;
                    f32x4 v0 = acc[ai][bj][m][0] + b0, v1 = acc[ai][bj][m][1] + b1;
                    if (ty < 2) { const float s = (ty == 0) ? 0.6065306597126334f : 1.0f;
#pragma unroll
                        for (int e = 0; e < 4; ++e) { v0[e] = s * sigmoidf_(v0[e]); v1[e] = s * sigmoidf_(v1[e]); } }
                    u32x4 w; w.x = cvt_pk_bf16(v0[0], v0[1]); w.y = cvt_pk_bf16(v0[2], v0[3]); w.z = cvt_pk_bf16(v1[0], v1[1]); w.w = cvt_pk_bf16(v1[2], v1[3]);
                    *(u32x4*)rowp = w; }
        }
    }
};

template <class Epi, class Sched, bool ALIGN_EPI, bool GATHER>
__device__ __forceinline__ void gemm_phase(PG8_LAS unsigned char* lds, const int K, const int lda, const Sched& S, const Epi& E, const int* __restrict__ rows) {
    const int tid = threadIdx.x, wid = __builtin_amdgcn_readfirstlane(tid >> 6), lane = tid & 63, wr = wid >> 2, wc = wid & 3, fr = lane & 15, fq = lane >> 4;
    const int nt = K / BK;
    unsigned voffA[2], voffB[2]; int RA[2];
#pragma unroll
    for (int i = 0; i < 2; ++i) { int R, C; stage_rc(tid * 16 + i * 8192, R, C); const int Rb = Epi::PERM ? ((R & ~31) + perm32(R & 31)) : R;
        RA[i] = R; voffA[i] = GATHER ? (unsigned)(C * 2) : (unsigned)(R * lda + C) * 2u; voffB[i] = (unsigned)(Rb * K + C) * 2u; }
    const size_t kstep = (size_t)(BK * 2);
    const size_t hstepA = GATHER ? 0 : (size_t)HALF * lda * 2, hstepB = (size_t)HALF * K * 2;
    const unsigned ldsw = (unsigned)wid * 1024u;
    const int aoff = lds_byte(wr * 64 + fr, fq * 8), boff = lds_byte(wc * 32 + fr, fq * 8);
#define PG8_SA(b, h) (((b) * 2 + (h)) * HTB)
#define PG8_SB(b, h) ((4 + (b) * 2 + (h)) * HTB)
#define PG8_ST2(bufoff, gbase, o0, o1) do { \
        __builtin_amdgcn_global_load_lds((const unsigned*)((const char*)(gbase) + (o0)), (PG8_LAS unsigned*)(lds + (bufoff) + ldsw), 16, 0, 0); \
        __builtin_amdgcn_global_load_lds((const unsigned*)((const char*)(gbase) + (o1)), (PG8_LAS unsigned*)(lds + (bufoff) + ldsw + 8192), 16, 0, 0); } while (0)
#define PG8_STB(bufoff, gbase) PG8_ST2(bufoff, gbase, voffB[0], voffB[1])
#define PG8_STA(bufoff, p, h, nx) do { if constexpr (GATHER) { const unsigned g0_ = (nx) ? gN[h][0] : gC[h][0], g1_ = (nx) ? gN[h][1] : gC[h][1]; PG8_ST2(bufoff, p, g0_, g1_); } \
        else { PG8_ST2(bufoff, (p) + (h) * hstepA, voffA[0], voffA[1]); } } while (0)
#define PG8_LDA(dst, b, h) do { _Pragma("unroll") for (int m = 0; m < 4; ++m) _Pragma("unroll") for (int k = 0; k < 2; ++k) dst[m][k] = *(const PG8_LAS bf16x8*)(lds + PG8_SA(b, h) + aoff + m * 2048 + k * 1024); } while (0)
#define PG8_LDB(dst, b, h) do { _Pragma("unroll") for (int n = 0; n < 2; ++n) _Pragma("unroll") for (int k = 0; k < 2; ++k) dst[n][k] = *(const PG8_LAS bf16x8*)(lds + PG8_SB(b, h) + boff + n * 2048 + k * 1024); } while (0)
#define PG8_MMA(ai, bj, At, Bt) do { __builtin_amdgcn_s_setprio(1); _Pragma("unroll") for (int m = 0; m < 4; ++m) _Pragma("unroll") for (int n = 0; n < 2; ++n) _Pragma("unroll") for (int k = 0; k < 2; ++k) \
        acc[ai][bj][m][n] = __builtin_amdgcn_mfma_f32_16x16x32_bf16(Bt[n][k], At[m][k], acc[ai][bj][m][n], 0, 0, 0); __builtin_amdgcn_s_setprio(0); } while (0)
#define PG8_WAIT_V(n) asm volatile("s_waitcnt vmcnt(" #n ")" ::: "memory")
#define PG8_WAIT_L(n) asm volatile("s_waitcnt lgkmcnt(" #n ")" ::: "memory")
#define PG8_BAR __builtin_amdgcn_s_barrier()
#define PG8_SCHED __builtin_amdgcn_sched_barrier(0)
#define PG8_GLOAD(dst, un) do { if constexpr (GATHER) { _Pragma("unroll") for (int h_ = 0; h_ < 2; ++h_) _Pragma("unroll") for (int i_ = 0; i_ < 2; ++i_) \
        dst[h_][i_] = (unsigned)rows[(un).pm * BM + h_ * HALF + RA[i_]] * (unsigned)(lda * 2) + voffA[i_]; } } while (0)
    Unit cur, nxt; int ui = 0;
    if (!S.next(0, cur)) return;
    unsigned gC[2][2] = {{0u, 0u}, {0u, 0u}}, gN[2][2] = {{0u, 0u}, {0u, 0u}};
    PG8_GLOAD(gC, cur);
    Acc acc;
#pragma unroll
    for (int a = 0; a < 2; ++a)
#pragma unroll
        for (int b = 0; b < 2; ++b)
#pragma unroll
            for (int m = 0; m < 4; ++m)
#pragma unroll
                for (int n = 0; n < 2; ++n) acc[a][b][m][n] = (f32x4){0.f, 0.f, 0.f, 0.f};
    bf16x8 At[4][2], B0[2][2], B1[2][2];
    const char* cA = cur.A; const char* cB = cur.B;
    PG8_STB(PG8_SB(0, 0), cB); PG8_STB(PG8_SB(0, 1), cB + hstepB); PG8_STA(PG8_SA(0, 0), cA, 0, false); PG8_STA(PG8_SA(0, 1), cA, 1, false);
    if (wr == 1) PG8_BAR;
    PG8_WAIT_V(2); PG8_BAR;
    PG8_STB(PG8_SB(1, 0), cB + kstep); PG8_STA(PG8_SA(1, 0), cA + kstep, 0, false); PG8_STB(PG8_SB(1, 1), cB + hstepB + kstep);
    PG8_WAIT_V(6); PG8_BAR;
    for (;;) {
        const bool has_next = S.next(ui + 1, nxt);
        if (has_next) { PG8_GLOAD(gN, nxt); }
        const char* nA = has_next ? nxt.A : cA; const char* nB = has_next ? nxt.B : cB;
#pragma unroll 1
        for (int t = 0; t < nt; t += 2) {
            const bool last = (t == nt - 2); const bool nx = last && has_next;
            const char* a1 = cA + (size_t)(t + 1) * kstep;
            const char* a2 = last ? nA : cA + (size_t)(t + 2) * kstep; const char* b2 = last ? nB : cB + (size_t)(t + 2) * kstep;
            const char* a3 = a2 + kstep; const char* b3 = b2 + kstep;
            PG8_LDB(B0, 0, 0); PG8_LDB(B1, 0, 1); PG8_SCHED; PG8_LDA(At, 0, 0); PG8_STA(PG8_SA(1, 1), a1, 1, false);
            PG8_WAIT_V(8); PG8_WAIT_L(0); PG8_BAR; PG8_MMA(0, 0, At, B0); PG8_MMA(0, 1, At, B1); PG8_BAR; PG8_SCHED;
            PG8_LDA(At, 0, 1); PG8_STB(PG8_SB(0, 0), b2); PG8_STB(PG8_SB(0, 1), b2 + hstepB); PG8_STA(PG8_SA(0, 0), a2, 0, nx);
            PG8_WAIT_V(8); PG8_WAIT_L(0); PG8_BAR; PG8_MMA(1, 0, At, B0); PG8_MMA(1, 1, At, B1); PG8_BAR; PG8_SCHED;
            PG8_LDB(B0, 1, 0); PG8_LDB(B1, 1, 1); PG8_SCHED; PG8_LDA(At, 1, 0); PG8_STA(PG8_SA(0, 1), a2, 1, nx);
            PG8_WAIT_V(8); PG8_WAIT_L(0); PG8_BAR; PG8_MMA(0, 0, At, B0); PG8_MMA(0, 1, At, B1); PG8_BAR; PG8_SCHED;
            PG8_LDA(At, 1, 1); PG8_STB(PG8_SB(1, 0), b3); PG8_STB(PG8_SB(1, 1), b3 + hstepB); PG8_STA(PG8_SA(1, 0), a3, 0, nx);
            PG8_WAIT_V(8); PG8_WAIT_L(0); PG8_BAR; PG8_MMA(1, 0, At, B0); PG8_MMA(1, 1, At, B1); PG8_BAR; PG8_SCHED;
        }
        if constexpr (ALIGN_EPI) { if (wr == 0) PG8_BAR; }
        E(acc, cur, wr, wc, fr, fq);
        if (!has_next) break;
#pragma unroll
        for (int a = 0; a < 2; ++a)
#pragma unroll
            for (int b = 0; b < 2; ++b)
#pragma unroll
                for (int m = 0; m < 4; ++m)
#pragma unroll
                    for (int n = 0; n < 2; ++n) acc[a][b][m][n] = (f32x4){0.f, 0.f, 0.f, 0.f};
        cur = nxt; cA = nA; cB = nB; ++ui;
        if constexpr (GATHER) {
#pragma unroll
            for (int h_ = 0; h_ < 2; ++h_)
#pragma unroll
                for (int i_ = 0; i_ < 2; ++i_) gC[h_][i_] = gN[h_][i_]; }
        if constexpr (ALIGN_EPI) { if (wr == 1) PG8_BAR; }
    }
    PG8_WAIT_V(0);
    if constexpr (!ALIGN_EPI) { if (wr == 0) PG8_BAR; }
    PG8_BAR;
#undef PG8_SA
#undef PG8_SB
#undef PG8_ST2
#undef PG8_STB
#undef PG8_STA
#undef PG8_LDA
#undef PG8_LDB
#undef PG8_MMA
#undef PG8_WAIT_V
#undef PG8_WAIT_L
#undef PG8_BAR
#undef PG8_SCHED
#undef PG8_GLOAD
}
}
namespace attn_body {
using bf16=__hip_bfloat16;
using bf16x8=__attribute__((ext_vector_type(8)))short;
using s16x4=__attribute__((ext_vector_type(4)))short;
using f32x16=__attribute__((ext_vector_type(16)))float;
using u32x4=__attribute__((ext_vector_type(4)))unsigned;
constexpr int BATCH=8,NHEAD=16,SEQ=8192,D=64,PQ=512,PO=1024;
constexpr int NW=8,QBLK=32,QB=QBLK*NW,KVBLK=64,NQB=SEQ/QB;
constexpr int ATTN_UNIT_ROWS=QB;
__device__ __forceinline__ int crow(int r,int hi){return (r&3)+8*(r>>2)+4*hi;}
#define SBAR() __builtin_amdgcn_sched_barrier(0)
__device__ __forceinline__ void cmask(f32x16&p0,f32x16&p1,int jb,int qrel,int hi){
  const float NEG=-INFINITY; int kb=64*jb+4*hi;
  #pragma unroll
  for(int r=0;r<16;++r){int kv=kb+(r&3)+8*(r>>2); if(kv>qrel)p0[r]=NEG; if(kv+32>qrel)p1[r]=NEG;}
}

__device__ __forceinline__ void cbias(f32x16&p0,f32x16&p1,int jb,int qrel,int hi,const __attribute__((address_space(3))) float*tb){
  const int kb=64*jb+4*hi;
  #pragma unroll
  for(int r=0;r<16;++r){const int rel=qrel-(kb+(r&3)+8*(r>>2)); const int i0=min(max(rel,0),127), i1=min(max(rel-32,0),127); p0[r]+=tb[i0]; p1[r]+=tb[i1];}
}
constexpr int NSLOT=3, SLOTB=8192;
constexpr int LDS_K=0, LDS_V=NSLOT*SLOTB, LDS_WS=2*NSLOT*SLOTB, LDS_OST=LDS_WS+NW*64*4, LDS_BYTES=LDS_OST+NW*4096;
constexpr float C2=0.125f*1.4426950408889634f;
__device__ __forceinline__ void glds16(const void*gsrc,unsigned lds_dst){unsigned keep;
  asm volatile("s_mov_b32 %0, m0\n\ts_mov_b32 m0, %2\n\ts_nop 0\n\tglobal_load_lds_dwordx4 %1, off\n\ts_mov_b32 m0, %0":"=&s"(keep):"v"(gsrc),"s"(lds_dst):"memory");}
__device__ __forceinline__ float max3f(float a,float b,float c){float r;asm("v_max3_f32 %0, %1, %2, %3":"=v"(r):"v"(a),"v"(b),"v"(c));return r;}
__device__ __forceinline__ float max2f(float a,float b){float r;asm("v_max_f32_e32 %0, %1, %2":"=v"(r):"v"(a),"v"(b));return r;}
__device__ __forceinline__ float fadd_s(float a,float b){float r;asm("v_add_f32_e32 %0, %1, %2":"=v"(r):"v"(a),"v"(b));return r;}
__device__ __forceinline__ float fsub_s(float a,float b){float r;asm("v_sub_f32_e32 %0, %1, %2":"=v"(r):"v"(a),"v"(b));return r;}
typedef float f32x2_t __attribute__((ext_vector_type(2))); typedef __bf16 bf16x2_t __attribute__((ext_vector_type(2)));
__device__ __forceinline__ unsigned cvtpk_s(float lo,float hi){f32x2_t v={lo,hi};bf16x2_t b=__builtin_convertvector(v,bf16x2_t);return __builtin_bit_cast(unsigned,b);}
#define WAIT_BAR(N) asm volatile("s_waitcnt vmcnt(" #N ") lgkmcnt(0)\n\ts_barrier":::"memory")

__device__ __forceinline__ void qkt(f32x16&p0,f32x16&p1,const char*Kslot,const bf16x8*qr,const f32x16&negm,int r32,int hi){
  const char*kb=Kslot+hi*1024+r32*16;
  #pragma unroll
  for(int d0=0;d0<4;++d0){
    const bf16x8 b0=*reinterpret_cast<const bf16x8*>(kb+d0*2048);
    const bf16x8 b1=*reinterpret_cast<const bf16x8*>(kb+d0*2048+512);
    if(d0==0){p0=__builtin_amdgcn_mfma_f32_32x32x16_bf16(b0,qr[0],negm,0,0,0);p1=__builtin_amdgcn_mfma_f32_32x32x16_bf16(b1,qr[0],negm,0,0,0);}
    else{p0=__builtin_amdgcn_mfma_f32_32x32x16_bf16(b0,qr[d0],p0,0,0,0);p1=__builtin_amdgcn_mfma_f32_32x32x16_bf16(b1,qr[d0],p1,0,0,0);}}
}
typedef __attribute__((address_space(3))) const char* lds_cptr;
typedef short v4i16_t __attribute__((ext_vector_type(4)));
__device__ __forceinline__ void kload8(bf16x8*kf,lds_cptr kp){
  kf[0]=*(const __attribute__((address_space(3))) bf16x8*)(kp);      kf[1]=*(const __attribute__((address_space(3))) bf16x8*)(kp+512);
  kf[2]=*(const __attribute__((address_space(3))) bf16x8*)(kp+2048); kf[3]=*(const __attribute__((address_space(3))) bf16x8*)(kp+2560);
  kf[4]=*(const __attribute__((address_space(3))) bf16x8*)(kp+4096); kf[5]=*(const __attribute__((address_space(3))) bf16x8*)(kp+4608);
  kf[6]=*(const __attribute__((address_space(3))) bf16x8*)(kp+6144); kf[7]=*(const __attribute__((address_space(3))) bf16x8*)(kp+6656);
}
__device__ __forceinline__ void kload2(bf16x8*kf,lds_cptr kp,int j){ kf[2*j]=*(const __attribute__((address_space(3))) bf16x8*)(kp+j*2048); kf[2*j+1]=*(const __attribute__((address_space(3))) bf16x8*)(kp+j*2048+512); }
__device__ __forceinline__ s16x4 vtr(lds_cptr p){ return __builtin_bit_cast(s16x4,__builtin_amdgcn_ds_read_tr16_b64_v4i16((__attribute__((address_space(3))) v4i16_t*)p)); }
__device__ __forceinline__ float rowmax(const f32x16&p0,const f32x16&p1){
  float a=max3f(p0[0],p0[1],p1[0]),b=max3f(p0[2],p0[3],p1[1]);a=max3f(a,p1[2],p1[3]);
  #pragma unroll
  for(int r=4;r<16;r+=4){a=max3f(a,p0[r],p0[r+1]);b=max3f(b,p0[r+2],p0[r+3]);a=max3f(a,p1[r],p1[r+1]);b=max3f(b,p1[r+2],p1[r+3]);}
  const float m=max2f(a,b);
  auto rr=__builtin_amdgcn_permlane32_swap(__float_as_uint(m),__float_as_uint(m),false,false);
  return max2f(__uint_as_float(rr[0]),__uint_as_float(rr[1]));
}
__device__ __forceinline__ void pv(f32x16*o,int vb,bf16x8 pa0,bf16x8 pa1,bf16x8 pa2,bf16x8 pa3){
  #pragma unroll
  for(int d0=0;d0<2;++d0){s16x4 lo[4],hi[4];
    #pragma unroll
    for(int ks=0;ks<4;++ks){
      asm volatile("ds_read_b64_tr_b16 %0,%1 offset:%c2":"=&v"(lo[ks]):"v"(vb),"i"(d0*4096+ks*1024):"memory");
      asm volatile("ds_read_b64_tr_b16 %0,%1 offset:%c2":"=&v"(hi[ks]):"v"(vb),"i"(d0*4096+ks*1024+512):"memory");}
    asm volatile("s_waitcnt lgkmcnt(0)":::"memory");SBAR();
    #define PK(k) (bf16x8){lo[k][0],lo[k][1],lo[k][2],lo[k][3],hi[k][0],hi[k][1],hi[k][2],hi[k][3]}
    o[d0]=__builtin_amdgcn_mfma_f32_32x32x16_bf16(pa0,PK(0),o[d0],0,0,0);
    o[d0]=__builtin_amdgcn_mfma_f32_32x32x16_bf16(pa1,PK(1),o[d0],0,0,0);
    o[d0]=__builtin_amdgcn_mfma_f32_32x32x16_bf16(pa2,PK(2),o[d0],0,0,0);
    o[d0]=__builtin_amdgcn_mfma_f32_32x32x16_bf16(pa3,PK(3),o[d0],0,0,0);
    #undef PK
  }
}

#ifndef ATTN_STORE16
#define ATTN_STORE16(p,v) (*(u32x4*)(p)=(v))
#endif
template<int THRL> __device__ __forceinline__ void attn_unit(int b,int vh,int qb,const bf16*Q,const bf16*__restrict__ K,const bf16*__restrict__ V,bf16*O,char*shm,const __attribute__((address_space(3))) float*tball){
  const int tid=threadIdx.x,lane=tid&63,r32=lane&31,hi=lane>>5; const int wid=__builtin_amdgcn_readfirstlane(tid>>6);
  const long rowbase=(long)b*SEQ; const int q0=qb*QB;
  const int hh=vh>>2, qcol=hh*128+((vh>>1)&1)*64, vcol=hh*128+(vh&1)*64;
  const __attribute__((address_space(3))) float*tb=tball+hh*128;
  const bf16*Qw=Q+(rowbase+q0+wid*QBLK)*PQ+qcol;
  const bf16*Kh=K+rowbase*PQ+qcol,*Vh=V+rowbase*PQ+vcol;
  const unsigned lds0=(unsigned)(uintptr_t)shm;
  float*wsf=(float*)(shm+LDS_WS)+wid*64;
  const bf16*ksrc=Kh+(long)lane*PQ+wid*8;
  const bf16*vsrc=Vh+(long)(16*(wid&3)+(lane>>2))*PQ+(wid>>2)*32+(lane&3)*8;
  const unsigned kdst=lds0+LDS_K+wid*1024, vdst=lds0+LDS_V+wid*1024;
  #define DMA_K(t,slot) glds16(ksrc+(long)(t)*KVBLK*PQ,(unsigned)__builtin_amdgcn_readfirstlane(kdst+(slot)))
  #define DMA_V(t,slot) glds16(vsrc+(long)(t)*KVBLK*PQ,(unsigned)__builtin_amdgcn_readfirstlane(vdst+(slot)))
  const int vb0=(int)(lds0+LDS_V)+((lane>>4)&1)*32+(lane&3)*8+(4*hi+((lane&15)>>2))*64;
  const char*Kbase=shm+LDS_K; bf16x8 kf[8];
  const lds_cptr shm3=(lds_cptr)shm; const lds_cptr kp0=shm3+LDS_K+hi*1024+r32*16; const lds_cptr vp0=shm3+LDS_V+((lane>>4)&1)*32+(lane&3)*8+(4*hi+((lane&15)>>2))*64;
  const int NT=(q0+QB)/KVBLK;
  DMA_K(0,0);DMA_V(0,0);DMA_K(1,SLOTB);
  bf16x8 qr[4];
  #pragma unroll
  for(int d0=0;d0<4;++d0)qr[d0]=*reinterpret_cast<const bf16x8*>(&Qw[(long)r32*PQ+d0*16+hi*8]);
  float mhat=0.f,l_reg=0.f;f32x16 o[2];o[0]=f32x16{};o[1]=f32x16{};f32x16 negm=f32x16{};asm volatile("":"+v"(negm));
  const int qrel=wid*QBLK+r32;
  #define CMASK(P0,P1,t) do{int jb_=(t)-(NT-4); if(jb_>=-2){cbias(P0,P1,jb_,qrel,hi,tb); if(jb_>=0)cmask(P0,P1,jb_,qrel,hi);}}while(0)
  bool resc=false;
  #define START(P0,P1) do{ const float rm=rowmax(P0,P1); resc=false; \
    { const float dl=rm; mhat=fadd_s(mhat,dl); \
      _Pragma("unroll") for(int r=0;r<16;++r){P0[r]=fsub_s(P0[r],dl);P1[r]=fsub_s(P1[r],dl);} \
      _Pragma("unroll") for(int r=0;r<16;++r)negm[r]=-mhat; asm volatile("":"+v"(negm)); } \
    _Pragma("unroll") for(int r=0;r<16;++r)P0[r]=__builtin_amdgcn_exp2f(P0[r]); }while(0)
  #define RESC() do{ if(resc){ asm volatile("s_waitcnt lgkmcnt(0)":::"memory"); \
      _Pragma("unroll") for(int d_=0;d_<2;++d_) _Pragma("unroll") for(int r=0;r<16;++r)o[d_][r]*=wsf[crow(r,hi)]; } }while(0)
  f32x16 pA0,pA1,pB0,pB1;
  int sl_prev=0,sl_cur=0,sl_next=SLOTB;
  #define ROT() do{sl_prev=sl_cur;sl_cur=sl_next;sl_next=(sl_next==(NSLOT-1)*SLOTB)?0:sl_next+SLOTB;}while(0)
  DMA_K(2,2*SLOTB);
  WAIT_BAR(3);
  qkt(pA0,pA1,Kbase,qr,negm,r32,hi);asm volatile("s_nop 15\n\ts_nop 7":"+v"(pA0),"+v"(pA1));CMASK(pA0,pA1,0);
  START(pA0,pA1);
  _Pragma("unroll") for(int r=0;r<16;++r)pA1[r]=__builtin_amdgcn_exp2f(pA1[r]);
  WAIT_BAR(0);
  DMA_K(3,0);DMA_V(1,SLOTB);
  ROT();
  kload8(kf,kp0+sl_cur);
  WAIT_BAR(2);
  s16x4 vlo[8],vhi[8]; u32x4 pw0,pw1,pw2,pw3;
  #define PKW(P,B) cvtpk_s(P[B],P[B+1])
  #define PAF(k) __builtin_bit_cast(bf16x8,pw##k)
  #define VFR(i) (bf16x8){vlo[i][0],vlo[i][1],vlo[i][2],vlo[i][3],vhi[i][0],vhi[i][1],vhi[i][2],vhi[i][3]}
  #define PIN(x) asm volatile("":"+v"(x))
  #define MX3(a,b,c) __builtin_fmaxf(__builtin_fmaxf((a),(b)),(c))
  #define GAPA(MF,A0,A1,A2,A3,W0,W1,PW) do{ MF; sacc+=A0; sacc+=A1; sacc+=A2; sacc+=A3; PIN(sacc); W0; W1; PIN(PW); SBAR(); }while(0)
  #define EX(v) __builtin_amdgcn_exp2f(v)
  #define GAPB(MF,X,B) do{ MF; X[B]=EX(X[B]); X[B+1]=EX(X[B+1]); X[B+2]=EX(X[B+2]); X[B+3]=EX(X[B+3]); PIN(X); SBAR(); }while(0)
  #define VRD(i) do{ vlo[i]=vtr(vp_+(((i)>>2)*4096+((i)&3)*1024)); vhi[i]=vtr(vp_+(((i)>>2)*4096+((i)&3)*1024+512)); }while(0)
  #define KRD(G,j) do{ if(G){ kload2(kf,kp0+sl_next,j); SBAR(); } }while(0)
  #define STEP(C0,C1,P0,P1,t,GK,GV,GL) do{ SBAR(); \
    const lds_cptr vp_=vp0+sl_prev; \
    VRD(0); SBAR(); float sacc=(P0[0]+P0[1]); \
    GAPA(C0=__builtin_amdgcn_mfma_f32_32x32x16_bf16(kf[0],qr[0],negm,0,0,0), P0[2],P0[3],P0[4],P0[5],     pw0[0]=PKW(P0,0), pw0[1]=PKW(P0,2), pw0); \
    VRD(4); SBAR(); GAPA(C1=__builtin_amdgcn_mfma_f32_32x32x16_bf16(kf[1],qr[0],negm,0,0,0), P0[6],P0[7],P0[8],P0[9],     pw0[2]=PKW(P0,4), pw0[3]=PKW(P0,6), pw0); \
    VRD(1); SBAR(); GAPA(C0=__builtin_amdgcn_mfma_f32_32x32x16_bf16(kf[2],qr[1],C0,0,0,0),   P0[10],P0[11],P0[12],P0[13], pw1[0]=PKW(P0,8), pw1[1]=PKW(P0,10), pw1); \
    VRD(5); SBAR(); GAPA(C1=__builtin_amdgcn_mfma_f32_32x32x16_bf16(kf[3],qr[1],C1,0,0,0),   P0[14],P0[15],P1[0],P1[1],   pw1[2]=PKW(P0,12),pw1[3]=PKW(P0,14), pw1); \
    VRD(2); SBAR(); GAPA(C0=__builtin_amdgcn_mfma_f32_32x32x16_bf16(kf[4],qr[2],C0,0,0,0),   P1[2],P1[3],P1[4],P1[5],     pw2[0]=PKW(P1,0), pw2[1]=PKW(P1,2), pw2); \
    VRD(6); SBAR(); GAPA(C1=__builtin_amdgcn_mfma_f32_32x32x16_bf16(kf[5],qr[2],C1,0,0,0),   P1[6],P1[7],P1[8],P1[9],     pw2[2]=PKW(P1,4), pw2[3]=PKW(P1,6), pw2); \
    VRD(3); SBAR(); GAPA(C0=__builtin_amdgcn_mfma_f32_32x32x16_bf16(kf[6],qr[3],C0,0,0,0),   P1[10],P1[11],P1[12],P1[13], pw3[0]=PKW(P1,8), pw3[1]=PKW(P1,10), pw3); \
    VRD(7); SBAR(); GAPA(C1=__builtin_amdgcn_mfma_f32_32x32x16_bf16(kf[7],qr[3],C1,0,0,0),   P1[14],P1[15],0.f,0.f,       pw3[2]=PKW(P1,12),pw3[3]=PKW(P1,14), pw3); \
    l_reg+=sacc; \
    if(GK){DMA_K((t)+3,sl_cur);} if(GV){DMA_V((t)+1,sl_next);} \
    CMASK(C0,C1,t); \
    { float a=MX3(C0[0],C0[1],C1[0]),b=MX3(C0[2],C0[3],C1[1]); a=MX3(a,C1[2],C1[3]); \
      _Pragma("unroll") for(int r=4;r<16;r+=4){a=MX3(a,C0[r],C0[r+1]);b=MX3(b,C0[r+2],C0[r+3]);a=MX3(a,C1[r],C1[r+1]);b=MX3(b,C1[r+2],C1[r+3]);} \
      float rm=__builtin_fmaxf(a,b); { auto rr=__builtin_amdgcn_permlane32_swap(__float_as_uint(rm),__float_as_uint(rm),false,false); rm=__builtin_fmaxf(__uint_as_float(rr[0]),__uint_as_float(rr[1])); } \
      resc=false; \
      if(__builtin_expect(__any(rm>(float)THRL),0)){ const float dl=__builtin_fmaxf(rm,0.f); mhat+=dl; \
        _Pragma("unroll") for(int r=0;r<16;++r){C0[r]-=dl;C1[r]-=dl;} \
        _Pragma("unroll") for(int r=0;r<16;++r)negm[r]=-mhat; asm volatile("":"+v"(negm)); \
        const float f=__builtin_amdgcn_exp2f(-dl); l_reg*=f; if(hi==0)wsf[r32]=f; resc=true; } } \
    SBAR(); \
    GAPB(o[0]=__builtin_amdgcn_mfma_f32_32x32x16_bf16(PAF(0),VFR(0),o[0],0,0,0), C0,0); \
    GAPB(o[1]=__builtin_amdgcn_mfma_f32_32x32x16_bf16(PAF(0),VFR(4),o[1],0,0,0), C0,4); \
    KRD(GL,0); GAPB(o[0]=__builtin_amdgcn_mfma_f32_32x32x16_bf16(PAF(1),VFR(1),o[0],0,0,0), C0,8); \
    KRD(GL,1); GAPB(o[1]=__builtin_amdgcn_mfma_f32_32x32x16_bf16(PAF(1),VFR(5),o[1],0,0,0), C0,12); \
    KRD(GL,2); GAPB(o[0]=__builtin_amdgcn_mfma_f32_32x32x16_bf16(PAF(2),VFR(2),o[0],0,0,0), C1,0); \
    KRD(GL,3); GAPB(o[1]=__builtin_amdgcn_mfma_f32_32x32x16_bf16(PAF(2),VFR(6),o[1],0,0,0), C1,4); \
    GAPB(o[0]=__builtin_amdgcn_mfma_f32_32x32x16_bf16(PAF(3),VFR(3),o[0],0,0,0), C1,8); \
    GAPB(o[1]=__builtin_amdgcn_mfma_f32_32x32x16_bf16(PAF(3),VFR(7),o[1],0,0,0), C1,12); \
    }while(0)
  int t=1;
  #undef CMASK
  #define CMASK(P0,P1,t) do{}while(0)
  for(;t+7<NT;t+=2){
    STEP(pB0,pB1,pA0,pA1,t,true,true,true);     WAIT_BAR(2); RESC(); ROT();
    STEP(pA0,pA1,pB0,pB1,t+1,true,true,true);   WAIT_BAR(2); RESC(); ROT();
  }
  #undef CMASK
  #define CMASK(P0,P1,t) do{int jb_=(t)-(NT-4); if(jb_>=-2){cbias(P0,P1,jb_,qrel,hi,tb); if(jb_>=0)cmask(P0,P1,jb_,qrel,hi);}}while(0)
  #define ENDW(tt) do{ if((tt)+3<NT){WAIT_BAR(2);} else if((tt)+2<NT){WAIT_BAR(1);} else {WAIT_BAR(0);} }while(0)
  for(;t+1<NT;t+=2){
    STEP(pB0,pB1,pA0,pA1,t,(t+3<NT),(t+1<NT),(t+1<NT));       ENDW(t);   RESC(); ROT();
    STEP(pA0,pA1,pB0,pB1,t+1,(t+4<NT),(t+2<NT),(t+2<NT));     ENDW(t+1); RESC(); ROT();
  }
  STEP(pB0,pB1,pA0,pA1,NT-1,false,false,false); RESC();
  { float sacc=pB0[0]+pB0[1]; _Pragma("unroll") for(int r=2;r<16;++r)sacc+=pB0[r]; _Pragma("unroll") for(int r=0;r<16;++r)sacc+=pB1[r]; l_reg+=sacc;
    pw0=(u32x4){PKW(pB0,0),PKW(pB0,2),PKW(pB0,4),PKW(pB0,6)};pw1=(u32x4){PKW(pB0,8),PKW(pB0,10),PKW(pB0,12),PKW(pB0,14)};pw2=(u32x4){PKW(pB1,0),PKW(pB1,2),PKW(pB1,4),PKW(pB1,6)};pw3=(u32x4){PKW(pB1,8),PKW(pB1,10),PKW(pB1,12),PKW(pB1,14)};
    SBAR(); pv(o,vb0+sl_cur,PAF(0),PAF(1),PAF(2),PAF(3)); }
  #undef PKW
  #undef PAF
  #undef VFR
  #undef PIN
  #undef MX3
  #undef GAPA
  #undef GAPB
  #undef EX
  #undef VRD
  #undef KRD
  #undef STEP
  #undef ENDW
  {auto rr=__builtin_amdgcn_permlane32_swap(__float_as_uint(l_reg),__float_as_uint(l_reg),false,false);l_reg=__uint_as_float(rr[0])+__uint_as_float(rr[1]);}
  if(hi==0)wsf[32+r32]=l_reg;asm volatile("s_waitcnt lgkmcnt(0)":::"memory");
  float rli[16];
  #pragma unroll
  for(int r=0;r<16;++r)rli[r]=__builtin_amdgcn_rcpf(wsf[32+crow(r,hi)]);
  bf16*Ow=O+(rowbase+q0+wid*QBLK)*PO+vh*D;
  { bf16*stg=(bf16*)(shm+LDS_OST)+wid*2048;
    #pragma unroll
    for(int r=0;r<16;++r){const int orow=crow(r,hi);
      #pragma unroll
      for(int d0=0;d0<2;++d0)stg[orow*64+d0*32+r32]=__float2bfloat16(o[d0][r]*rli[r]);}
    asm volatile("s_waitcnt lgkmcnt(0)":::"memory");
    #pragma unroll
    for(int i=0;i<4;++i){const int row=i*8+(lane>>3),ch=lane&7; const u32x4 v=*(const u32x4*)(stg+row*64+ch*8); ATTN_STORE16(Ow+(long)row*PO+ch*8,v);} }
  asm volatile("s_waitcnt lgkmcnt(0)\n\ts_barrier":::"memory");
  #undef DMA_K
  #undef DMA_V
  #undef CMASK
  #undef START
  #undef RESC
  #undef ROT
}
constexpr int ATTN_LDS_BYTES=LDS_BYTES;
struct AttnTensors { const bf16* Q; const bf16* K; const bf16* V; bf16* O; };
struct AttnUnit { int bh; int qb; };
__device__ __forceinline__ bool attn_next(int vcu,int i,AttnUnit&u){ if(i>=16)return false; const int s=vcu&7, j=i&3; u.bh=(vcu>>3)+32*(i>>2); u.qb=(j==0)?s:(j==1)?15-s:(j==2)?16+s:31-s; return true; }
template<int THRL=8> __device__ __forceinline__ void attn_phase(char*lds,const AttnTensors&T,int vcu,const __attribute__((address_space(3))) float*tball){
  AttnUnit u;
  for(int i=0;attn_next(vcu,i,u);++i){ attn_unit<THRL>(u.bh/NHEAD,u.bh%NHEAD,u.qb,T.Q,T.K,T.V,T.O,lds,tball); }
}
#undef SBAR
#undef WAIT_BAR
}

#define XB_TMO      128
#define XB_XCNT(j)  (256  + 64 * (j))
#define XB_XSUB(j)  (1280 + 64 * (j))
#define XB_XGEN(j)  (2304 + 64 * (j))
#define XB_TOP      3328
#define XB_TOPGEN   3392
#define XCD_BAR_WORDS 3456
#define XB_SPIN_CAP (1u << 18)

__device__ __forceinline__ unsigned xb_ld(unsigned* p)              { return __hip_atomic_load(p, __ATOMIC_RELAXED, __HIP_MEMORY_SCOPE_AGENT); }
__device__ __forceinline__ unsigned xb_add(unsigned* p, unsigned v) { return __hip_atomic_fetch_add(p, v, __ATOMIC_RELAXED, __HIP_MEMORY_SCOPE_AGENT); }
__device__ __forceinline__ unsigned xb_xcc_id() { return (unsigned)__builtin_amdgcn_s_getreg((3 << 11) | 20) & 0xFu; }
#define XB_SPIN(cond, bar) do { unsigned _sp = 0; while (cond) { __builtin_amdgcn_s_sleep(1); \
    if ((++_sp & 255u) == 0u) { if (xb_ld(&(bar)[XB_TMO])) break; if (_sp > XB_SPIN_CAP) { atomicAdd(&(bar)[XB_TMO], 1u); break; } } } } while (0)

struct XcdBarrier {
    unsigned* bar; unsigned x;
    volatile LAS unsigned* st;
};

__device__ __forceinline__ XcdBarrier xcd_barrier_post(unsigned* bar, volatile LAS unsigned* st) {
    XcdBarrier b; b.bar = bar; b.x = xb_xcc_id(); b.st = st;
    if (threadIdx.x == 0) (void)xb_add(&bar[XB_XCNT(b.x)], 1u);
    return b;
}
__device__ __forceinline__ void xcd_barrier_complete(unsigned* bar, unsigned x, unsigned& nloc, unsigned& nx) {
    const unsigned G = gridDim.x * gridDim.y * gridDim.z;
    unsigned sum, cnt, mine, sp = 0u;
    for (;;) {
        sum = 0u; cnt = 0u; mine = 0u;
#pragma unroll
        for (unsigned j = 0; j < 16; ++j) { const unsigned c = xb_ld(&bar[XB_XCNT(j)]); sum += c; cnt += (c > 0u) ? 1u : 0u; mine = (j == x) ? c : mine; }
        if (sum == G) break;
        __builtin_amdgcn_s_sleep(1);
        if ((++sp & 255u) == 0u) { if (xb_ld(&bar[XB_TMO])) break; if (sp > XB_SPIN_CAP) { atomicAdd(&bar[XB_TMO], 1u); break; } }
    }
    nloc = mine > 0u ? mine : 1u; nx = cnt > 0u ? cnt : 1u;
}

__device__ __forceinline__ void xcd_barrier(const XcdBarrier& b) {
    asm volatile("s_waitcnt vmcnt(0)" ::: "memory");
    __syncthreads();
    if (threadIdx.x == 0) {
        unsigned* bar = b.bar;
        __builtin_amdgcn_s_waitcnt(0);
        unsigned nloc = b.st[0], nx = b.st[1];
        if (nloc == 0u) { xcd_barrier_complete(bar, b.x, nloc, nx); b.st[0] = nloc; b.st[1] = nx; }
        const unsigned old = xb_add(&bar[XB_XSUB(b.x)], 1u);
        const unsigned gen = old / nloc;
        if (old + 1u == (gen + 1u) * nloc) {
            __builtin_amdgcn_fence(__ATOMIC_RELEASE, "agent");
            asm volatile("s_waitcnt vmcnt(0)" ::: "memory");
            const unsigned og = xb_add(&bar[XB_TOP], 1u);
            const unsigned tg = og / nx;
            if (og + 1u == (tg + 1u) * nx) xb_add(&bar[XB_TOPGEN], 1u);
            else XB_SPIN(xb_ld(&bar[XB_TOPGEN]) == tg, bar);
            __builtin_amdgcn_fence(__ATOMIC_ACQUIRE, "agent");
            xb_add(&bar[XB_XGEN(b.x)], 1u);
            asm volatile("s_waitcnt vmcnt(0)" ::: "memory");
        } else {
            XB_SPIN(xb_ld(&bar[XB_XGEN(b.x)]) == gen, bar);
            __builtin_amdgcn_fence(__ATOMIC_ACQUIRE, "agent");
            asm volatile("s_waitcnt vmcnt(0)" ::: "memory");
        }
    }
    __syncthreads();
}

constexpr size_t MiB = 1u << 20;
constexpr size_t WS_CTL = 0, CTL_ZERO_BYTES = 1 * MiB;
constexpr size_t WS_WIN = 2 * MiB;
constexpr size_t WS_WOUT = 7 * MiB;
constexpr size_t WS_PGATE = 9 * MiB;
constexpr size_t WS_PPROJ = 13 * MiB;
constexpr size_t WS_RCAT = 14 * MiB;
constexpr size_t WS_RL1 = 20 * MiB;
constexpr size_t WS_RS2 = 28 * MiB;
constexpr size_t WS_RWO = 30 * MiB;
constexpr size_t WS_ROUT = 32 * MiB;
constexpr size_t WS_LRUAGG = 33 * MiB;
constexpr size_t WS_MGU = 38 * MiB;
constexpr size_t WS_MDN = 102 * MiB;
constexpr size_t WS_PB = 134 * MiB;
constexpr size_t WS_ACT = 166 * MiB;
constexpr size_t WS_H0 = WS_ACT;
constexpr size_t WS_QKV = WS_ACT + 128 * MiB;
constexpr size_t WS_O = WS_ACT + 448 * MiB;
constexpr size_t WS_H2 = WS_ACT;
constexpr size_t WS_LOG = WS_ACT + 128 * MiB;
constexpr size_t WS_ROUTE = WS_ACT + 144 * MiB;
constexpr size_t WS_HID = WS_ACT + 152 * MiB;
constexpr size_t WS_YS = WS_ACT + 288 * MiB;
constexpr size_t WS_PP = WS_ACT + 128 * MiB;
constexpr size_t WS_HCAT = WS_ACT;
constexpr size_t WS_XR = WS_ACT + 256 * MiB, WS_XK = WS_ACT + 384 * MiB, WS_XV = WS_ACT + 512 * MiB;
constexpr size_t WS_R = WS_ACT + 640 * MiB, WS_K = WS_XR, WS_V = WS_XK;
constexpr size_t WS_MID = WS_ACT + 768 * MiB;
constexpr size_t WS_EW = WS_ACT;
constexpr size_t WS_AA = WS_ACT + 128 * MiB;
constexpr size_t WS_Y = WS_XV;
constexpr size_t WS_END = WS_ACT + 832 * MiB;
static_assert(WS_END <= 1024 * MiB, "workspace map");
constexpr size_t RT_EID = 0, RT_POS = 1 * MiB, RT_GATE = 2 * MiB, RT_ROWTOK = 3 * MiB, RT_ROWGATE = 4 * MiB, RT_SLOT = 5 * MiB;
constexpr int CW_BAR = 4096;
constexpr int CW_CNT0 = 16384, CW_CNT1 = 16384 + 64;

constexpr int RING_BYTES = 131072;
constexpr int LDSCTL_OFF = RING_BYTES, MISC_OFF = LDSCTL_OFF + 320;
constexpr int TB_OFF = RING_BYTES + 1024;
constexpr int RTE_OFF = TB_OFF + 2048;
constexpr int LDS_BYTES = 147456;

constexpr int NWAVES = 8;
__device__ __forceinline__ int tid_opaque() { int t = (int)threadIdx.x; asm volatile("" : "+v"(t)); return t; }
#define TID_ (tid_opaque())
#define LANE_ (tid_opaque() & 63)
struct Frame {
    LAS unsigned char* lds; volatile LAS unsigned* MISC; gu32* ctl;
    int wave, vcu, G;
};

__device__ __forceinline__ void load_row4(const float* xrow, int lane, f32x4 (&v)[4]) { const f32x4* p = (const f32x4*)xrow + lane;
#pragma unroll
    for (int j = 0; j < 4; ++j) v[j] = p[64 * j]; }
__device__ __forceinline__ float row_rstd(const f32x4 (&v)[4], float eps) { float s = 0.f;
#pragma unroll
    for (int j = 0; j < 4; ++j) s += (v[j].x * v[j].x + v[j].y * v[j].y) + (v[j].z * v[j].z + v[j].w * v[j].w);
    return 1.0f / sqrtf(wave_sum(s) * (1.0f / 1024.0f) + eps); }
__device__ __forceinline__ void store_row_bf16(bf16* orow, int lane, const f32x4 (&v)[4], float rstd, const float* g) {
    unsigned long long* o8 = (unsigned long long*)orow + lane;
#pragma unroll
    for (int j = 0; j < 4; ++j) { const f32x4 gg = ((const f32x4*)g)[lane + 64 * j];
        o8[64 * j] = (unsigned long long)pk2(v[j].x * rstd * gg.x, v[j].y * rstd * gg.y) | ((unsigned long long)pk2(v[j].z * rstd * gg.z, v[j].w * rstd * gg.w) << 32); }
}

template <int MODE>
__device__ __forceinline__ void transpose_item(const float* W, int K, int N, bf16* WT, int ldo, int row_off, const float* mu, LAS float* scr, int item, int lane) {
    const int nblk = N / 32, kb = item / nblk, nb = item % nblk, k0 = 64 * kb, n0 = 32 * nb;
    float ld[32];
#pragma unroll
    for (int i = 0; i < 32; ++i) { const int kk = 2 * i + (lane >> 5); ld[i] = W[(size_t)(k0 + kk) * N + n0 + (lane & 31)]; }
#pragma unroll
    for (int i = 0; i < 32; ++i) { const int kk = 2 * i + (lane >> 5); scr[kk * 33 + (lane & 31)] = ld[i]; }
    LDS_WAIT(); asm volatile("" ::: "memory");
    const int c = lane & 7;
    int rbase = row_off + n0;
    if (MODE == 2) { rbase = row_off + ((n0 < 512) ? ((n0 >> 7) * 256 + (n0 & 127)) : (((n0 - 512) >> 7) * 256 + 128 + ((n0 - 512) & 127))); }
    float m[8];
    if (MODE == 1) {
#pragma unroll
        for (int e = 0; e < 8; ++e) m[e] = mu[k0 + 8 * c + e]; }
#pragma unroll
    for (int j = 0; j < 4; ++j) { const int n = (lane >> 3) + 8 * j; const LAS float* s = scr + (8 * c) * 33 + n;
        float v[8];
#pragma unroll
        for (int e = 0; e < 8; ++e) v[e] = s[e * 33];
        bf16* dst = WT + (size_t)(rbase + n) * ldo + k0 + 8 * c;
        if (MODE == 1) {
            v4u o, o2;
            o.x = pk2(v[0] * (1.f - m[0]), v[1] * (1.f - m[1])); o.y = pk2(v[2] * (1.f - m[2]), v[3] * (1.f - m[3])); o.z = pk2(v[4] * (1.f - m[4]), v[5] * (1.f - m[5])); o.w = pk2(v[6] * (1.f - m[6]), v[7] * (1.f - m[7]));
            o2.x = pk2(v[0] * m[0], v[1] * m[1]); o2.y = pk2(v[2] * m[2], v[3] * m[3]); o2.z = pk2(v[4] * m[4], v[5] * m[5]); o2.w = pk2(v[6] * m[6], v[7] * m[7]);
            *(GAS v4u*)dst = o; *(GAS v4u*)(dst + 1024) = o2;
        } else {
            v4u o; o.x = pk2(v[0], v[1]); o.y = pk2(v[2], v[3]); o.z = pk2(v[4], v[5]); o.w = pk2(v[6], v[7]);
            *(GAS v4u*)dst = o; }
    }
    LDS_WAIT(); asm volatile("" ::: "memory");
}

struct In {
    const float *x, *p, *rel_bias, *norm_mix, *ab_w_in, *ab_w_out, *lam_q1, *lam_k1, *lam_q2, *lam_k2, *sub_g, *conv_w, *conv_b, *lru_wa, *lru_ba, *lru_wx, *lru_bx, *lru_lambda,
        *rwkv_mu, *rwkv_wr, *rwkv_wk, *rwkv_wv, *rwkv_wo, *rwkv_w0, *rwkv_w1, *rwkv_w2, *rwkv_a0, *rwkv_a1, *rwkv_a2, *rwkv_g1, *rwkv_g2, *rwkv_kk, *rwkv_ka, *rwkv_rk, *rwkv_ln_g, *rwkv_ln_b,
        *norm_ffn, *moe_wc, *moe_bc, *moe_wf, *moe_bf, *moe_w_gu, *moe_w_down, *ple_norm, *ple_gate, *ple_proj, *final_norm;
};

__device__ __forceinline__ void prep_dense_weights(Frame& F, const In& I, unsigned char* ws) {
    LAS float* scr = (LAS float*)(F.lds + F.wave * 16384);
    const int gw = F.vcu * NWAVES + F.wave, NGW = F.G * NWAVES;
    bf16* WIN = (bf16*)(ws + WS_WIN); bf16* WOUT = (bf16*)(ws + WS_WOUT); bf16* PG = (bf16*)(ws + WS_PGATE); bf16* PPJ = (bf16*)(ws + WS_PPROJ);
    bf16* RCAT = (bf16*)(ws + WS_RCAT); bf16* RL1 = (bf16*)(ws + WS_RL1); bf16* RWO = (bf16*)(ws + WS_RWO);
    constexpr int I_IN = (1024 / 64) * (2560 / 32), I_SQ = (1024 / 64) * (1024 / 32), I_PJ = (256 / 64) * (1024 / 32), I_L64 = (1024 / 64) * (64 / 32), I_L160 = (1024 / 64) * (160 / 32);
    int st = gw;
#define TJOB(MODE, NITEMS, W, K, N, WT, LDO, ROFF, MU) do { for (int it = st; it < (NITEMS); it += NGW) transpose_item<MODE>(W, K, N, WT, LDO, ROFF, MU, scr, it, LANE_); \
        st = (st + NGW - ((NITEMS) % NGW)) % NGW; asm volatile("" : "+s"(st)); } while (0)
    TJOB(0, I_IN, I.ab_w_in, 1024, 2560, WIN, 1024, 0, nullptr);
    TJOB(0, I_SQ, I.ab_w_out, 1024, 1024, WOUT, 1024, 0, nullptr);
    TJOB(0, I_SQ, I.ple_gate, 1024, 1024, PG, 1024, 0, nullptr);
    TJOB(0, I_SQ, I.ple_gate + 1024 * 1024, 1024, 1024, PG + 1024 * 1024, 1024, 0, nullptr);
    TJOB(0, I_SQ, I.rwkv_wo, 1024, 1024, RWO, 1024, 0, nullptr);
    TJOB(0, I_SQ, I.rwkv_wr, 1024, 1024, RCAT, 1024, 0, nullptr);
    TJOB(0, I_SQ, I.rwkv_wk, 1024, 1024, RCAT, 1024, 1024, nullptr);
    TJOB(0, I_SQ, I.rwkv_wv, 1024, 1024, RCAT, 1024, 2048, nullptr);
    TJOB(0, I_PJ, I.ple_proj, 256, 1024, PPJ, 256, 0, nullptr);
    TJOB(0, I_PJ, I.ple_proj + 256 * 1024, 256, 1024, PPJ + 1024 * 256, 256, 0, nullptr);
    TJOB(1, I_L64, I.rwkv_w1, 1024, 64, RL1, 2048, 0, I.rwkv_mu + 1 * 1024);
    TJOB(1, I_L64, I.rwkv_a1, 1024, 64, RL1, 2048, 64, I.rwkv_mu + 4 * 1024);
    TJOB(1, I_L160, I.rwkv_g1, 1024, 160, RL1, 2048, 256, I.rwkv_mu + 5 * 1024);
#undef TJOB
    const int gt = F.vcu * 512 + TID_, NGT = F.G * 512;
    { v4u z = {0u, 0u, 0u, 0u}; const int per_row = 2048 / 8;
      for (int i = gt; i < (128 + 96) * per_row; i += NGT) { int rr = i / per_row, cc = i % per_row; rr = (rr < 128) ? (128 + rr) : (416 + rr - 128); *(GAS v4u*)(RL1 + (size_t)rr * 2048 + cc * 8) = z; } }
    { bf16* S2 = (bf16*)(ws + WS_RS2);
      for (int i = gt; i < 3 * 1024 * 256; i += NGT) { const int ty = i / (1024 * 256), n = (i / 256) & 1023, k = i & 255; float v = 0.f;
          if (ty == 0) { if (k < 64) v = I.rwkv_w2[k * 1024 + n]; } else if (ty == 1) { if (k >= 64 && k < 128) v = I.rwkv_a2[(k - 64) * 1024 + n]; } else { if (k < 160) v = I.rwkv_g2[k * 1024 + n]; }
          S2[i] = (bf16)f2bf(v); } }
    { bf16* RT = (bf16*)(ws + WS_ROUT);
      for (int i = gt; i < 2 * 256 * 1024; i += NGT) { const int l = i / (256 * 1024), n = (i / 1024) & 255, k = i & 1023; float v = 0.f;
          if (n < 4) v = I.moe_wc[(size_t)l * 1024 * 4 + k * 4 + n]; else if (n < 36) v = I.moe_wf[(size_t)l * 1024 * 32 + k * 32 + (n - 4)];
          RT[i] = (bf16)f2bf(v); } }
}
__device__ __forceinline__ void prep_layer_weights(Frame& F, const In& I, unsigned char* ws, int layer) {
    LAS float* scr = (LAS float*)(F.lds + F.wave * 16384);
    const int gw = F.vcu * NWAVES + F.wave, NGW = F.G * NWAVES;
    bf16* MGU = (bf16*)(ws + WS_MGU); bf16* MDN = (bf16*)(ws + WS_MDN);
    const float* wgu = I.moe_w_gu + (size_t)layer * NEXP * 1024 * 1024; const float* wdn = I.moe_w_down + (size_t)layer * NEXP * 512 * 1024;
    constexpr int I_GU = (1024 / 64) * (1024 / 32), I_DN = (512 / 64) * (1024 / 32);
    for (int it = gw; it < NEXP * (I_GU + I_DN); it += NGW) {
        const int e = it / (I_GU + I_DN); int r = it % (I_GU + I_DN);
        if (r < I_GU) transpose_item<2>(wgu + (size_t)e * 1024 * 1024, 1024, 1024, MGU + (size_t)e * 1024 * 1024, 1024, 0, nullptr, scr, r, LANE_);
        else transpose_item<0>(wdn + (size_t)e * 512 * 1024, 512, 1024, MDN + (size_t)e * 1024 * 512, 512, 0, nullptr, scr, r - I_GU, LANE_);
    }
    const int gt = F.vcu * 512 + TID_, NGT = F.G * 512;
    const f32x4* ps = (const f32x4*)(I.p + (size_t)layer * T * PLE); v2u* pd = (v2u*)(ws + WS_PB);
    for (int i = gt; i < T * PLE / 4; i += 4 * NGT) { f32x4 v[4];
#pragma unroll
        for (int r = 0; r < 4; ++r) v[r] = ps[i + r * NGT];
#pragma unroll
        for (int r = 0; r < 4; ++r) { v2u o; o.x = pk2(v[r].x, v[r].y); o.y = pk2(v[r].z, v[r].w); pd[i + r * NGT] = o; } }
}

template <int MODE>
__device__ __forceinline__ void norm_pass(Frame& F, const float* x, const float* g, bf16* out) {
    const int gw = F.vcu * NWAVES + F.wave, NGW = F.G * NWAVES; const int lane = LANE_;
    for (int t = 4 * gw; t < T; t += 4 * NGW) {
        f32x4 v[4][4];
#pragma unroll
        for (int r = 0; r < 4; ++r) load_row4(x + (size_t)(t + r) * D, lane, v[r]);
#pragma unroll
        for (int r = 0; r < 4; ++r) { const float rs = row_rstd(v[r], 1e-6f); store_row_bf16(out + (size_t)(t + r) * D, lane, v[r], rs, g); }
    }
}
__device__ __forceinline__ void rwkv_input_pass(Frame& F, const float* x, const float* g, const float* mu, bf16* HCAT, bf16* XR, bf16* XK, bf16* XV) {
    const int gw = F.vcu * NWAVES + F.wave, NGW = F.G * NWAVES; const int lane = LANE_;
    f32x4 gg[4], mr[4], mk[4], mv[4];
#pragma unroll
    for (int j = 0; j < 4; ++j) { gg[j] = ((const f32x4*)g)[lane + 64 * j]; mr[j] = ((const f32x4*)(mu + 0 * 1024))[lane + 64 * j]; mk[j] = ((const f32x4*)(mu + 2 * 1024))[lane + 64 * j]; mv[j] = ((const f32x4*)(mu + 3 * 1024))[lane + 64 * j]; }
    for (int blk = gw; blk < T / 32; blk += NGW) {
        const int t0 = blk * 32; f32x4 hp[4];
        if ((t0 & (SEQ - 1)) == 0) {
#pragma unroll
            for (int j = 0; j < 4; ++j) hp[j] = (f32x4){0.f, 0.f, 0.f, 0.f};
        } else { f32x4 v[4]; load_row4(x + (size_t)(t0 - 1) * D, lane, v); const float rstd = row_rstd(v, 1e-6f);
#pragma unroll
            for (int j = 0; j < 4; ++j) hp[j] = v[j] * rstd * gg[j]; }
        f32x4 vn[4]; load_row4(x + (size_t)t0 * D, lane, vn);
        for (int t = t0; t < t0 + 32; ++t) {
            f32x4 v[4];
#pragma unroll
            for (int j = 0; j < 4; ++j) v[j] = vn[j];
            if (t + 1 < t0 + 32) load_row4(x + (size_t)(t + 1) * D, lane, vn);
            const float rstd = row_rstd(v, 1e-6f);
            unsigned long long* oh = (unsigned long long*)(HCAT + (size_t)t * 2048) + lane; unsigned long long* or_ = (unsigned long long*)(XR + (size_t)t * 1024) + lane;
            unsigned long long* ok = (unsigned long long*)(XK + (size_t)t * 1024) + lane; unsigned long long* ov = (unsigned long long*)(XV + (size_t)t * 1024) + lane;
#pragma unroll
            for (int j = 0; j < 4; ++j) { const f32x4 h = v[j] * rstd * gg[j], dd = hp[j] - h;
                oh[64 * j] = (unsigned long long)pk2(h.x, h.y) | ((unsigned long long)pk2(h.z, h.w) << 32);
                oh[256 + 64 * j] = (unsigned long long)pk2(hp[j].x, hp[j].y) | ((unsigned long long)pk2(hp[j].z, hp[j].w) << 32);
                const f32x4 a = h + dd * mr[j], b = h + dd * mk[j], c = h + dd * mv[j];
                or_[64 * j] = (unsigned long long)pk2(a.x, a.y) | ((unsigned long long)pk2(a.z, a.w) << 32);
                ok[64 * j] = (unsigned long long)pk2(b.x, b.y) | ((unsigned long long)pk2(b.z, b.w) << 32);
                ov[64 * j] = (unsigned long long)pk2(c.x, c.y) | ((unsigned long long)pk2(c.z, c.w) << 32);
                hp[j] = h; }
        }
    }
}
__device__ __forceinline__ void combine_norm_pass(Frame& F, const float* xin, float* xout, const bf16* YS, const int* slot, const float* g, bf16* out) {
    const int gw = F.vcu * NWAVES + F.wave, NGW = F.G * NWAVES; const int lane = LANE_;
    for (int t = 2 * gw; t < T; t += 2 * NGW) {
        f32x4 v[2][4]; v2u ya[2][4], yb[2][4];
#pragma unroll
        for (int r = 0; r < 2; ++r) { load_row4(xin + (size_t)(t + r) * D, lane, v[r]);
            const int s0 = slot[2 * (t + r)], s1 = slot[2 * (t + r) + 1];
            const v2u* y0 = (const v2u*)(YS + (size_t)s0 * D) + lane; const v2u* y1 = (const v2u*)(YS + (size_t)s1 * D) + lane;
#pragma unroll
            for (int j = 0; j < 4; ++j) { ya[r][j] = y0[64 * j]; yb[r][j] = y1[64 * j]; } }
#pragma unroll
        for (int r = 0; r < 2; ++r) {
#pragma unroll
            for (int j = 0; j < 4; ++j) { const v2u a = ya[r][j], b = yb[r][j];
                v[r][j].x += bflo(a.x) + bflo(b.x); v[r][j].y += bfhi(a.x) + bfhi(b.x); v[r][j].z += bflo(a.y) + bflo(b.y); v[r][j].w += bfhi(a.y) + bfhi(b.y); }
            f32x4* xo = (f32x4*)(xout + (size_t)(t + r) * D) + lane;
#pragma unroll
            for (int j = 0; j < 4; ++j) xo[64 * j] = v[r][j];
            const float rstd = row_rstd(v[r], 1e-6f);
            store_row_bf16(out + (size_t)(t + r) * D, lane, v[r], rstd, g); }
    }
}
__device__ __forceinline__ void final_norm_pass(Frame& F, float* x, const float* g) {
    const int gw = F.vcu * NWAVES + F.wave, NGW = F.G * NWAVES; const int lane = LANE_;
    for (int t = 4 * gw; t < T; t += 4 * NGW) {
        f32x4 v[4][4];
#pragma unroll
        for (int r = 0; r < 4; ++r) load_row4(x + (size_t)(t + r) * D, lane, v[r]);
#pragma unroll
        for (int r = 0; r < 4; ++r) { const float rs = row_rstd(v[r], 1e-6f); f32x4* xo = (f32x4*)(x + (size_t)(t + r) * D) + lane;
#pragma unroll
            for (int j = 0; j < 4; ++j) { const f32x4 gg = ((const f32x4*)g)[lane + 64 * j]; xo[64 * j] = v[r][j] * rs * gg; } }
    }
}

__device__ __forceinline__ void diff_combine_pass(Frame& F, const In& I, const bf16* O, bf16* YCAT) {
    const int gw = F.vcu * NWAVES + F.wave, NGW = F.G * NWAVES;
    const float lam_init = 0.2f;
    const float d1 = wave_sum(I.lam_q1[LANE_] * I.lam_k1[LANE_]), d2 = wave_sum(I.lam_q2[LANE_] * I.lam_k2[LANE_]);
    const float lam = expf(d1) - expf(d2) + lam_init;
    const int h = LANE_ >> 4, q = LANE_ & 15;
    float sg[8];
#pragma unroll
    for (int e = 0; e < 8; ++e) sg[e] = I.sub_g[q * 8 + e] * (1.0f - lam_init);
    for (int t0 = 4 * gw; t0 < T; t0 += 4 * NGW) {
        v4u av[4], bv[4];
#pragma unroll
        for (int r = 0; r < 4; ++r) { av[r] = *(const v4u*)(O + (size_t)(t0 + r) * 1024 + h * 256 + q * 8); bv[r] = *(const v4u*)(O + (size_t)(t0 + r) * 1024 + h * 256 + 128 + q * 8); }
#pragma unroll
        for (int r = 0; r < 4; ++r) { const v4u a = av[r], b = bv[r]; const int t = t0 + r;
        float o[8];
        o[0] = bflo(a.x) - lam * bflo(b.x); o[1] = bfhi(a.x) - lam * bfhi(b.x); o[2] = bflo(a.y) - lam * bflo(b.y); o[3] = bfhi(a.y) - lam * bfhi(b.y);
        o[4] = bflo(a.z) - lam * bflo(b.z); o[5] = bfhi(a.z) - lam * bfhi(b.z); o[6] = bflo(a.w) - lam * bflo(b.w); o[7] = bfhi(a.w) - lam * bfhi(b.w);
        float s = 0.f;
#pragma unroll
        for (int e = 0; e < 8; ++e) s += o[e] * o[e];
        s += __shfl_xor(s, 1); s += __shfl_xor(s, 2); s += __shfl_xor(s, 4); s += __shfl_xor(s, 8);
        const float rstd = 1.0f / sqrtf(s * (1.0f / 128.0f) + 1e-5f);
        v4u w; w.x = pk2(o[0] * rstd * sg[0], o[1] * rstd * sg[1]); w.y = pk2(o[2] * rstd * sg[2], o[3] * rstd * sg[3]); w.z = pk2(o[4] * rstd * sg[4], o[5] * rstd * sg[5]); w.w = pk2(o[6] * rstd * sg[6], o[7] * rstd * sg[7]);
        *(v4u*)(YCAT + (size_t)t * 1024 + h * 128 + q * 8) = w; }
    }
}

constexpr int LCT = 64, LNCH = SEQ / LCT;
__device__ __forceinline__ float gelu_tanh(float x) { const float u = 0.7978845608028654f * (x + 0.044715f * x * x * x); return 0.5f * x * (1.0f + tanhf(u)); }
template <bool FINAL>
__device__ __forceinline__ void lru_phase(Frame& F, const In& I, const bf16* XB, const bf16* GB, f32x2* AGG, bf16* YCAT) {
    const int ch = TID_, n = ch >> 6, d = ch & 63;
    LAS float* U = (LAS float*)F.lds;
    f32x2 wg[64];
#pragma unroll
    for (int c = 0; c < 64; ++c) { wg[c].x = I.lru_wa[n * 4096 + c * 64 + d]; wg[c].y = I.lru_wx[n * 4096 + c * 64 + d]; }
    const float cw0 = I.conv_w[0 * 512 + ch], cw1 = I.conv_w[1 * 512 + ch], cw2 = I.conv_w[2 * 512 + ch], cw3 = I.conv_w[3 * 512 + ch], cb = I.conv_b[ch];
    const float ba = I.lru_ba[ch], bx = I.lru_bx[ch];
    const float lam = I.lru_lambda[ch]; const float sp = (lam > 15.f) ? expf(-lam) : log1pf(expf(-lam));
    const float m8sp = -8.0f * sp;
    for (int un = blockIdx.x; un < NB * LNCH; un += F.G) {
        const int b = un / LNCH, c = un % LNCH; const size_t row0 = (size_t)b * SEQ + (size_t)c * LCT;
        float x3 = 0.f, x2 = 0.f, x1 = 0.f;
        if (c > 0) { x3 = bf1(XB[(row0 - 3) * 512 + ch]); x2 = bf1(XB[(row0 - 2) * 512 + ch]); x1 = bf1(XB[(row0 - 1) * 512 + ch]); }
#pragma unroll 8
        for (int tk = 0; tk < LCT; ++tk) { const float x0 = bf1(XB[(row0 + tk) * 512 + ch]); U[tk * 512 + ch] = cw0 * x3 + cw1 * x2 + cw2 * x1 + cw3 * x0 + cb; x3 = x2; x2 = x1; x1 = x0; }
        float h = 0.f, Ap = 1.f;
        if (FINAL) { for (int j = 0; j < c; ++j) { const f32x2 ag = AGG[((size_t)b * LNCH + j) * 512 + ch]; h = ag.x * h + ag.y; } }
        __syncthreads();
        for (int tk = 0; tk < LCT; ++tk) {
            const LAS f32x4* up = (const LAS f32x4*)(U + tk * 512 + n * 64);
            f32x2 acc = {ba, bx};
#pragma unroll
            for (int c4 = 0; c4 < 16; ++c4) { const f32x4 uu = up[c4];
                acc += wg[4 * c4 + 0] * uu.x; acc += wg[4 * c4 + 1] * uu.y; acc += wg[4 * c4 + 2] * uu.z; acc += wg[4 * c4 + 3] * uu.w; }
            const float r = sigmoidf_(acc.x), ig = sigmoidf_(acc.y);
            const float la = r * m8sp; const float a = __expf(la); const float bb = sqrtf(-expm1f(2.0f * la)) * (ig * U[tk * 512 + ch]);
            h = a * h + bb;
            if (FINAL) { const float gv = bf1(GB[(row0 + tk) * 512 + ch]); YCAT[(row0 + tk) * 1024 + 512 + ch] = (bf16)f2bf(h * gelu_tanh(gv)); }
            else Ap *= a;
        }
        if (!FINAL) { f32x2 ag; ag.x = Ap; ag.y = h; AGG[((size_t)b * LNCH + c) * 512 + ch] = ag; }
        __syncthreads();
    }
}

__device__ __forceinline__ void route_pass_a(Frame& F, const In& I, int layer, const float* LOG, unsigned char* rt, gu32* cnt) {
    LAS int* lcnt = (LAS int*)(F.lds + RTE_OFF); LAS int* lbase = lcnt + 32;
    int* EID = (int*)(rt + RT_EID); int* POS = (int*)(rt + RT_POS); float* GATE = (float*)(rt + RT_GATE);
    const float* bc = I.moe_bc + layer * 4; const float* bfb = I.moe_bf + layer * 32;
    for (int un = blockIdx.x; un < T / 512; un += F.G) {
        if (TID_ < 32) lcnt[TID_] = 0;
        __syncthreads();
        const int t = un * 512 + TID_; const float* lg = LOG + (size_t)t * 64;
        const f32x4 g4 = *(const f32x4*)lg;
        float gl[4] = {g4.x + bc[0], g4.y + bc[1], g4.z + bc[2], g4.w + bc[3]};
        int gi = 0; float gm = gl[0];
#pragma unroll
        for (int j = 1; j < 4; ++j) if (gl[j] > gm) { gm = gl[j]; gi = j; }
        float gs = 0.f;
#pragma unroll
        for (int j = 0; j < 4; ++j) gs += __expf(gl[j] - gm);
        const float gprob = 1.0f / gs;
        const f32x4 e0 = *(const f32x4*)(lg + 4 + gi * 8), e1 = *(const f32x4*)(lg + 8 + gi * 8);
        float el[8] = {e0.x, e0.y, e0.z, e0.w, e1.x, e1.y, e1.z, e1.w};
#pragma unroll
        for (int j = 0; j < 8; ++j) el[j] += bfb[gi * 8 + j];
        int i0 = 0; float m0 = el[0];
#pragma unroll
        for (int j = 1; j < 8; ++j) if (el[j] > m0) { m0 = el[j]; i0 = j; }
        int i1 = -1; float m1 = -INFINITY;
#pragma unroll
        for (int j = 0; j < 8; ++j) if (j != i0 && el[j] > m1) { m1 = el[j]; i1 = j; }
        const float r1 = __expf(m1 - m0); const float g0 = gprob / (1.0f + r1), g1 = gprob * r1 / (1.0f + r1);
        const int ex0 = gi * 8 + i0, ex1 = gi * 8 + i1;
        const int p0 = atomicAdd((int*)&lcnt[ex0], 1), p1 = atomicAdd((int*)&lcnt[ex1], 1);
        __syncthreads();
        if (TID_ < 32) lbase[TID_] = (int)__hip_atomic_fetch_add(cnt + TID_, (unsigned)lcnt[TID_], RLX_AGENT);
        __syncthreads();
        EID[2 * t] = ex0; EID[2 * t + 1] = ex1; POS[2 * t] = lbase[ex0] + p0; POS[2 * t + 1] = lbase[ex1] + p1; GATE[2 * t] = g0; GATE[2 * t + 1] = g1;
        __syncthreads();
    }
}
__device__ __forceinline__ void route_bases(Frame& F, gu32* cnt) {
    LAS int* eb = (LAS int*)(F.lds + RTE_OFF + 512);
    const int tid = TID_;
    if (tid < 64) {
        const int c = (tid < 32) ? (int)__hip_atomic_load(cnt + (tid & 31), RLX_AGENT) : 0; const int p = (c + 255) & ~255; int s = p;
#pragma unroll
        for (int o = 1; o < 32; o <<= 1) { const int t = __shfl_up(s, o); if ((tid & 63) >= o) s += t; }
        if (tid < 32) { eb[tid] = s - p; if (tid == 31) eb[32] = s; }
    }
    __syncthreads();
}
__device__ __forceinline__ void route_pass_b(Frame& F, unsigned char* rt, gu32* cnt) {
    route_bases(F, cnt);
    LAS int* eb = (LAS int*)(F.lds + RTE_OFF + 512);
    const int* EID = (const int*)(rt + RT_EID); const int* POS = (const int*)(rt + RT_POS); const float* GATE = (const float*)(rt + RT_GATE);
    int* ROWTOK = (int*)(rt + RT_ROWTOK); float* ROWGATE = (float*)(rt + RT_ROWGATE); int* SLOT = (int*)(rt + RT_SLOT);
    const int gt = F.vcu * 512 + TID_, NGT = F.G * 512;
    for (int i = gt; i < 2 * T; i += NGT) { const int dst = eb[EID[i]] + POS[i]; ROWTOK[dst] = i >> 1; ROWGATE[dst] = GATE[i]; SLOT[i] = dst; }
    for (int i = gt; i < 32 * 256; i += NGT) { const int e = i >> 8, j = i & 255; const int c = (int)__hip_atomic_load(cnt + e, RLX_AGENT); const int pad = ((c + 255) & ~255) - c;
        if (j < pad) { ROWTOK[eb[e] + c + j] = 0; ROWGATE[eb[e] + c + j] = 0.f; } }
    __syncthreads();
}
struct MoeOrder {
    int G, c, ntiles; const LAS int* eb; const char* A; const char* W; size_t astep, wexp, wtile; bool gather;
    __device__ bool next(int i, pg8::Unit& u) const {
        const int L = i * G + c; if (L >= ntiles * 4) return false;
        u.pm = L >> 2; u.pn = L & 3; const int s0 = u.pm * 256; int e = 0;
#pragma unroll 1
        for (int j = 1; j < 32; ++j) if (eb[j] <= s0) e = j;
        e = __builtin_amdgcn_readfirstlane(e); u.aux = e; u.A = gather ? A : A + (size_t)u.pm * astep; u.B = W + (size_t)e * wexp + (size_t)u.pn * wtile; return true;
    }
};

constexpr int RTC = 32, RNCH = SEQ / RTC, RTOK = 352;
#define LBAR() do { asm volatile("s_waitcnt lgkmcnt(0)" ::: "memory"); __builtin_amdgcn_s_barrier(); asm volatile("" ::: "memory"); } while (0)
template <int CTRL> __device__ __forceinline__ float dpp_f(float v) { return __builtin_bit_cast(float, __builtin_amdgcn_update_dpp(0, __builtin_bit_cast(int, v), CTRL, 0xf, 0xf, true)); }
__device__ __forceinline__ float red16(float v) { v += dpp_f<0xB1>(v); v += dpp_f<0x4E>(v); v += dpp_f<0x141>(v); v += dpp_f<0x140>(v); return v; }
__device__ __forceinline__ float red8(float v) { v += dpp_f<0xB1>(v); v += dpp_f<0x4E>(v); v += dpp_f<0x141>(v); return v; }
__device__ __forceinline__ void unpack8(const v4u w, float (&f)[8]) { f[0] = bflo(w.x); f[1] = bfhi(w.x); f[2] = bflo(w.y); f[3] = bfhi(w.y); f[4] = bflo(w.z); f[5] = bfhi(w.z); f[6] = bflo(w.w); f[7] = bfhi(w.w); }
__device__ __forceinline__ void rwkv_scan_phase(Frame& F, const In& I, const bf16* R, const bf16* Kt, const bf16* V, const bf16* AA, const bf16* EW, bf16* Y) {
    LAS float* buf = (LAS float*)F.lds;
    LAS float* ybuf = (LAS float*)(F.lds + 2 * RTC * RTOK * 4) + 32;
    const int tid = TID_, lane = tid & 63;
    const int seg = lane & 15, rl = F.wave * 4 + (lane >> 4);
    const int stk = tid >> 4, ssg = tid & 15;
    for (int un = blockIdx.x; un < NB * 16 * 2; un += F.G) {
        const int half = un & 1, h = (un >> 1) & 15, b = un >> 5;
        const size_t rowb = (size_t)b * SEQ;
        const int col = h * 64 + ssg * 4;
        const f32x4 kkw = *(const f32x4*)(I.rwkv_kk + col), kaw = *(const f32x4*)(I.rwkv_ka + col);
        v2u rr, kr, vr, ar, er;
#define RAW_LOAD(cc) do { const size_t off = (rowb + (size_t)(cc) * RTC + stk) * 1024 + col; rr = *(const v2u*)(R + off); kr = *(const v2u*)(Kt + off); vr = *(const v2u*)(V + off); ar = *(const v2u*)(AA + off); er = *(const v2u*)(EW + off); } while (0)
#define RAW_CONVERT(cc) do { LAS float* tp = buf + ((cc) & 1) * (RTC * RTOK) + stk * RTOK + ssg * 4; \
            const float r0 = bflo(rr.x), r1 = bfhi(rr.x), r2 = bflo(rr.y), r3 = bfhi(rr.y), k0 = bflo(kr.x), k1 = bfhi(kr.x), k2 = bflo(kr.y), k3 = bfhi(kr.y); \
            const float a0 = bflo(ar.x), a1 = bfhi(ar.x), a2 = bflo(ar.y), a3 = bfhi(ar.y); \
            const float x0 = k0 * kkw.x, x1 = k1 * kkw.y, x2 = k2 * kkw.z, x3 = k3 * kkw.w; \
            const float ss = red16((x0 * x0 + x1 * x1) + (x2 * x2 + x3 * x3)); const float inv = 1.0f / fmaxf(sqrtf(ss), 1e-12f); \
            *(LAS f32x4*)(tp) = (f32x4){__expf(-bflo(er.x)), __expf(-bfhi(er.x)), __expf(-bflo(er.y)), __expf(-bfhi(er.y))}; \
            const f32x4 kkv = (f32x4){x0 * inv, x1 * inv, x2 * inv, x3 * inv}; *(LAS f32x4*)(tp + 64) = kkv; \
            *(LAS f32x4*)(tp + 128) = (f32x4){kkv.x * a0, kkv.y * a1, kkv.z * a2, kkv.w * a3}; \
            *(LAS f32x4*)(tp + 192) = (f32x4){k0 * (1.0f + (a0 - 1.0f) * kaw.x), k1 * (1.0f + (a1 - 1.0f) * kaw.y), k2 * (1.0f + (a2 - 1.0f) * kaw.z), k3 * (1.0f + (a3 - 1.0f) * kaw.w)}; \
            *(LAS f32x4*)(tp + 256) = (f32x4){r0, r1, r2, r3}; \
            if ((ssg >> 3) == half) *(LAS f32x4*)(buf + ((cc) & 1) * (RTC * RTOK) + stk * RTOK + 320 + (ssg & 7) * 4) = (f32x4){bflo(vr.x), bfhi(vr.x), bflo(vr.y), bfhi(vr.y)}; } while (0)
#define Y_WRITE(cc) do { const LAS f32x2* yp = (const LAS f32x2*)(ybuf + ((cc) & 1) * (RTC * 32 + 32) + stk * 32 + ssg * 2); const f32x2 yv = *yp; \
            *(unsigned*)(Y + (rowb + (size_t)(cc) * RTC + stk) * 1024 + h * 64 + half * 32 + ssg * 2) = pk2(yv.x, yv.y); } while (0)
        RAW_LOAD(0); RAW_CONVERT(0); RAW_LOAD(1);
        f32x2 S0 = (f32x2){0.f, 0.f}, S1 = (f32x2){0.f, 0.f};
        LBAR();
        for (int c = 0; c < RNCH; ++c) {
            if (c + 1 < RNCH) { RAW_CONVERT(c + 1); }
            if (c + 2 < RNCH) { RAW_LOAD(c + 2); }
            if (c >= 1) { Y_WRITE(c - 1); }
            const LAS float* cb = buf + (c & 1) * (RTC * RTOK); LAS float* yb = ybuf + (c & 1) * (RTC * 32 + 32);
            const LAS float* tp0 = cb + seg * 4; const LAS float* vp0 = cb + 320 + rl;
#define SV_DECL(X) f32x4 X##w, X##q, X##b, X##k, X##r; float X##v
#define SV_LOAD(X, tk) do { const LAS float* tp = tp0 + (tk) * RTOK; \
                X##w = *(const LAS f32x4*)(tp); X##q = *(const LAS f32x4*)(tp + 64); X##b = *(const LAS f32x4*)(tp + 128); X##k = *(const LAS f32x4*)(tp + 192); X##r = *(const LAS f32x4*)(tp + 256); X##v = vp0[(tk) * RTOK]; } while (0)
#define SV_STEP(X, tk) do { \
                const f32x2 d = S0 * (f32x2){X##q.x, X##q.y} + S1 * (f32x2){X##q.z, X##q.w}; \
                const f32x2 t0 = S0 * (f32x2){X##w.x, X##w.y} + (f32x2){X##k.x, X##k.y} * X##v, t1 = S1 * (f32x2){X##w.z, X##w.w} + (f32x2){X##k.z, X##k.w} * X##v; \
                float ra = d.x + d.y, rb = epend;                   \
                ra += dpp_f<0xB1>(ra); rb += dpp_f<0xB1>(rb); ra += dpp_f<0x4E>(ra); rb += dpp_f<0x4E>(rb); ra += dpp_f<0x141>(ra); rb += dpp_f<0x141>(rb); ra += dpp_f<0x140>(ra); rb += dpp_f<0x140>(rb); \
                if (seg == 0) yb[((tk) - 1) * 32 + rl] = rb;        \
                const float sa = -ra; \
                S0 = t0 + (f32x2){X##b.x, X##b.y} * sa; S1 = t1 + (f32x2){X##b.z, X##b.w} * sa; \
                const f32x2 e = S0 * (f32x2){X##r.x, X##r.y} + S1 * (f32x2){X##r.z, X##r.w}; epend = e.x + e.y; } while (0)
            SV_DECL(A_); SV_DECL(B_); float epend = 0.f;
            SV_LOAD(A_, 0);
#pragma unroll 1
            for (int tk = 0; tk < RTC; tk += 2) {
                SV_LOAD(B_, tk + 1);
                SV_STEP(A_, tk);
                { const int t2 = (tk + 2 < RTC) ? tk + 2 : RTC - 1; SV_LOAD(A_, t2); }
                SV_STEP(B_, tk + 1);
            }
#undef SV_DECL
#undef SV_LOAD
#undef SV_STEP
            { const float rb = red16(epend); if (seg == 0) yb[(RTC - 1) * 32 + rl] = rb; }
            LBAR();
        }
        Y_WRITE(RNCH - 1);
        LBAR();
#undef RAW_LOAD
#undef RAW_CONVERT
#undef Y_WRITE
    }
}
__device__ __forceinline__ void rwkv_post_pass(Frame& F, const In& I, const bf16* R, const bf16* Kt, const bf16* V, const bf16* AA, const bf16* G, bf16* Y) {
    const int gw = F.vcu * NWAVES + F.wave, NGW = F.G * NWAVES; const int col = LANE_ * 16;
    float kaw[16], rkw[16], lng[16], lnb[16];
#pragma unroll
    for (int e = 0; e < 16; ++e) { kaw[e] = I.rwkv_ka[col + e]; rkw[e] = I.rwkv_rk[col + e]; lng[e] = I.rwkv_ln_g[col + e]; lnb[e] = I.rwkv_ln_b[col + e]; }
    for (int t0 = 2 * gw; t0 < T; t0 += 2 * NGW) {
        v4u py[2][2], pr[2][2], pk[2][2], pv[2][2], pa[2][2], pg[2][2];
#pragma unroll
        for (int rw = 0; rw < 2; ++rw) { const size_t off = (size_t)(t0 + rw) * 1024 + col;
#pragma unroll
            for (int hf = 0; hf < 2; ++hf) { py[rw][hf] = *(const v4u*)(Y + off + hf * 8); pr[rw][hf] = *(const v4u*)(R + off + hf * 8); pk[rw][hf] = *(const v4u*)(Kt + off + hf * 8);
                pv[rw][hf] = *(const v4u*)(V + off + hf * 8); pa[rw][hf] = *(const v4u*)(AA + off + hf * 8); pg[rw][hf] = *(const v4u*)(G + off + hf * 8); } }
#pragma unroll
        for (int rw = 0; rw < 2; ++rw) { const size_t off = (size_t)(t0 + rw) * 1024 + col;
            float y[16], r[16], k[16], v[16], a[16], g[16];
#pragma unroll
            for (int hf = 0; hf < 2; ++hf) { float t8[8];
                unpack8(py[rw][hf], t8);
#pragma unroll
                for (int e = 0; e < 8; ++e) y[hf * 8 + e] = t8[e];
                unpack8(pr[rw][hf], t8);
#pragma unroll
                for (int e = 0; e < 8; ++e) r[hf * 8 + e] = t8[e];
                unpack8(pk[rw][hf], t8);
#pragma unroll
                for (int e = 0; e < 8; ++e) k[hf * 8 + e] = t8[e];
                unpack8(pv[rw][hf], t8);
#pragma unroll
                for (int e = 0; e < 8; ++e) v[hf * 8 + e] = t8[e];
                unpack8(pa[rw][hf], t8);
#pragma unroll
                for (int e = 0; e < 8; ++e) a[hf * 8 + e] = t8[e];
                unpack8(pg[rw][hf], t8);
#pragma unroll
                for (int e = 0; e < 8; ++e) g[hf * 8 + e] = t8[e]; }
            float s = 0.f, bs = 0.f;
#pragma unroll
            for (int e = 0; e < 16; ++e) { s += y[e]; const float kp = k[e] * (1.0f + (a[e] - 1.0f) * kaw[e]); bs += r[e] * kp * rkw[e]; }
            s += __shfl_xor(s, 1); s += __shfl_xor(s, 2); bs += __shfl_xor(bs, 1); bs += __shfl_xor(bs, 2);
            const float mean = s * (1.0f / 64.0f); float q = 0.f;
#pragma unroll
            for (int e = 0; e < 16; ++e) { const float dd = y[e] - mean; q += dd * dd; }
            q += __shfl_xor(q, 1); q += __shfl_xor(q, 2);
            const float rstd = 1.0f / sqrtf(q * (1.0f / 64.0f) + 64e-5f);
            float o[16];
#pragma unroll
            for (int e = 0; e < 16; ++e) o[e] = ((y[e] - mean) * rstd * lng[e] + lnb[e] + bs * v[e]) * g[e];
            v4u w0, w1; w0.x = pk2(o[0], o[1]); w0.y = pk2(o[2], o[3]); w0.z = pk2(o[4], o[5]); w0.w = pk2(o[6], o[7]); w1.x = pk2(o[8], o[9]); w1.y = pk2(o[10], o[11]); w1.z = pk2(o[12], o[13]); w1.w = pk2(o[14], o[15]);
            *(v4u*)(Y + off) = w0; *(v4u*)(Y + off + 8) = w1; }
    }
}

#ifndef DUP_K
#define DUP_K (-1)
#endif
#ifndef DUP_K2
#define DUP_K2 (-1)
#endif
#define KARGS ((const __attribute__((address_space(4))) Args*)__builtin_amdgcn_kernarg_segment_ptr())
#define WSPTRS \
    bf16* H0 = (bf16*)(ws + WS_H0); bf16* QKV = (bf16*)(ws + WS_QKV); bf16* OB = (bf16*)(ws + WS_O); f32x2* AGG = (f32x2*)(ws + WS_LRUAGG); \
    bf16* H2 = (bf16*)(ws + WS_H2); float* LOG = (float*)(ws + WS_LOG); unsigned char* RTE = ws + WS_ROUTE; bf16* HID = (bf16*)(ws + WS_HID); bf16* YS = (bf16*)(ws + WS_YS); bf16* PP = (bf16*)(ws + WS_PP); \
    bf16* HCAT = (bf16*)(ws + WS_HCAT); bf16* RB = (bf16*)(ws + WS_R); bf16* KB = (bf16*)(ws + WS_K); bf16* VB = (bf16*)(ws + WS_V); bf16* XRB = (bf16*)(ws + WS_XR); bf16* XKB = (bf16*)(ws + WS_XK); bf16* XVB = (bf16*)(ws + WS_XV); bf16* MID = (bf16*)(ws + WS_MID); bf16* EWB = (bf16*)(ws + WS_EW); bf16* AAB = (bf16*)(ws + WS_AA); bf16* YB = (bf16*)(ws + WS_Y); \
    const size_t TD = (size_t)T * 1024; (void)H0; (void)QKV; (void)OB; (void)AGG; (void)H2; (void)LOG; (void)RTE; (void)HID; (void)YS; (void)PP; (void)HCAT; (void)RB; (void)KB; (void)VB; (void)XRB; (void)XKB; (void)XVB; (void)MID; (void)EWB; (void)AAB; (void)YB; (void)TD;

struct Args { In in; float* out; unsigned char* ws; int ph_lo, ph_hi; };
constexpr int N_PHASES = 34;
__device__ __forceinline__ int nrep(int k) { int n = (k == DUP_K) ? 2 : 1; if (DUP_K >= 0) asm volatile("" : "+s"(n)); return n; }
#define REP_SYNC if (rep_) __syncthreads();
typedef const __attribute__((address_space(4))) unsigned long long* kp64;
__device__ __forceinline__ void load_in(In& I) { kp64 s = (kp64)__builtin_amdgcn_kernarg_segment_ptr(); unsigned long long* d = (unsigned long long*)&I;
#pragma unroll
    for (int i = 0; i < 47; ++i) d[i] = s[i]; }

__device__ __forceinline__ int t5_bucket(int n) { if (n < 16) return n; const float v = logf((float)n / 16.0f) / 2.0794415416798357f * 16.0f; const int l = 16 + (int)v; return l < 31 ? l : 31; }

template <class Epi>
__device__ __forceinline__ void dense_gemm(Frame& F, const void* A, int lda, const void* B, int K, int M, int N, const Epi& E) {
    pg8::DenseOrder S; S.init(A, lda, B, K, M, N, F.G, (int)blockIdx.x);
    pg8::gemm_phase<Epi, pg8::DenseOrder, true, false>(F.lds, K, lda, S, E, nullptr);
}

__global__ void __launch_bounds__(NWAVES * 64, 2) mk_fwd(Args args) {
    extern __shared__ __attribute__((aligned(16))) unsigned char lds[];
    Frame F;
    F.lds = (LAS unsigned char*)lds;
    F.MISC = (volatile LAS unsigned*)(F.lds + MISC_OFF);
    F.wave = __builtin_amdgcn_readfirstlane(TID_ >> 6);
    F.G = gridDim.x; { const int bx = blockIdx.x; F.vcu = (F.G % 8 == 0) ? (bx % 8) * (F.G / 8) + bx / 8 : bx; }
    F.ctl = (gu32*)(KARGS->ws + WS_CTL);
    for (int u = TID_; u < (LDS_BYTES - LDSCTL_OFF) / 4; u += NWAVES * 64) ((LAS unsigned*)(F.lds + LDSCTL_OFF))[u] = 0u;
    __syncthreads();
    {
        LAS float* tb = (LAS float*)(F.lds + TB_OFF); const int h = TID_ >> 7, i = TID_ & 127;
        const float* rb = KARGS->in.rel_bias;
        tb[h * 128 + i] = (rb[t5_bucket(i) * 4 + h] - rb[31 * 4 + h]) * 1.4426950408889634f;
    }
    __syncthreads();
    const int lo = KARGS->ph_lo, hi = KARGS->ph_hi;
    const bool multi = (hi - lo) > 1;
    XcdBarrier bar; bar.bar = (unsigned*)(F.ctl + CW_BAR); bar.x = 0; bar.st = nullptr;
    if (multi) bar = xcd_barrier_post((unsigned*)(F.ctl + CW_BAR), F.MISC + 8);
#define IN(k) (lo <= (k) && (k) < hi)
#define PH_BEGIN_ unsigned char* ws = KARGS->ws; float* X = KARGS->out; In I; load_in(I); (void)X; WSPTRS
#define SEAM(k) do { if (IN(k) && IN((k) + 1)) xcd_barrier(bar); } while (0)

    if (IN(0)) { PH_BEGIN_ prep_dense_weights(F, I, ws); prep_layer_weights(F, I, ws, 0); norm_pass<0>(F, I.x, I.norm_mix, H0);
#ifdef DUP_PREP
        __syncthreads(); prep_dense_weights(F, I, ws); prep_layer_weights(F, I, ws, 0);
#endif
    } SEAM(0);
    if (IN(1)) { PH_BEGIN_ pg8::EpiBf16 E{QKV, 512, 512, (size_t)T * 512, attn_body::C2}; dense_gemm(F, H0, 1024, ws + WS_WIN, 1024, T, AB_IN, E); } SEAM(1);
    if (IN(2)) { PH_BEGIN_ lru_phase<false>(F, I, QKV + 3 * (size_t)T * 512, QKV + 4 * (size_t)T * 512, AGG, H0); } SEAM(2);
    if (IN(3)) { PH_BEGIN_
        const attn_body::AttnTensors AT{(const attn_body::bf16*)QKV, (const attn_body::bf16*)(QKV + (size_t)T * 512), (const attn_body::bf16*)(QKV + 2 * (size_t)T * 512), (attn_body::bf16*)OB};
        if (F.G == 256) attn_body::attn_phase<8>((char*)lds, AT, F.vcu, (const LAS float*)(F.lds + TB_OFF));
#ifdef DUP_ATTN
        __syncthreads(); if (F.G == 256) attn_body::attn_phase<8>((char*)lds, AT, F.vcu, (const LAS float*)(F.lds + TB_OFF));
#endif
        __syncthreads();
        lru_phase<true>(F, I, QKV + 3 * (size_t)T * 512, QKV + 4 * (size_t)T * 512, AGG, H0);
    } SEAM(3);
    if (IN(4)) { PH_BEGIN_ diff_combine_pass(F, I, OB, H0); } SEAM(4);
    if (IN(5)) { PH_BEGIN_ pg8::EpiResF32 E{I.x, X}; dense_gemm(F, H0, 1024, ws + WS_WOUT, 1024, T, 1024, E); } SEAM(5);

#define MOE_PLE_PHASES(P, L) \
    if (IN(P + 0)) { PH_BEGIN_ norm_pass<0>(F, X, I.norm_ffn + (L) * 1024, H2); } SEAM(P + 0); \
    if (IN(P + 1)) { PH_BEGIN_ pg8::EpiRouter E{LOG}; dense_gemm(F, H2, 1024, ws + WS_ROUT + (size_t)(L) * 256 * 1024 * 2, 1024, T, 256, E); } SEAM(P + 1); \
    if (IN(P + 2)) { PH_BEGIN_ route_pass_a(F, I, (L), LOG, RTE, F.ctl + ((L) ? CW_CNT1 : CW_CNT0)); } SEAM(P + 2); \
    if (IN(P + 3)) { PH_BEGIN_ route_pass_b(F, RTE, F.ctl + ((L) ? CW_CNT1 : CW_CNT0)); } SEAM(P + 3); \
    if (IN(P + 4)) { PH_BEGIN_ route_bases(F, F.ctl + ((L) ? CW_CNT1 : CW_CNT0)); const LAS int* eb = (const LAS int*)(F.lds + RTE_OFF + 512); \
        MoeOrder S{F.G, (int)blockIdx.x, __builtin_amdgcn_readfirstlane(eb[32] >> 8), eb, (const char*)H2, (const char*)(ws + WS_MGU), 0, (size_t)1024 * 1024 * 2, (size_t)256 * 1024 * 2, true}; pg8::EpiGU E{HID}; \
        pg8::gemm_phase<pg8::EpiGU, MoeOrder, true, true>(F.lds, 1024, 1024, S, E, (const int*)(RTE + RT_ROWTOK)); } SEAM(P + 4); \
    if (IN(P + 5)) { PH_BEGIN_ route_bases(F, F.ctl + ((L) ? CW_CNT1 : CW_CNT0)); const LAS int* eb = (const LAS int*)(F.lds + RTE_OFF + 512); \
        MoeOrder S{F.G, (int)blockIdx.x, __builtin_amdgcn_readfirstlane(eb[32] >> 8), eb, (const char*)HID, (const char*)(ws + WS_MDN), (size_t)256 * 512 * 2, (size_t)1024 * 512 * 2, (size_t)256 * 512 * 2, false}; pg8::EpiDown E{YS, (const float*)(RTE + RT_ROWGATE)}; \
        pg8::gemm_phase<pg8::EpiDown, MoeOrder, true, false>(F.lds, 512, 512, S, E, nullptr); } SEAM(P + 5); \
    if (IN(P + 6)) { PH_BEGIN_ combine_norm_pass(F, X, X, YS, (const int*)(RTE + RT_SLOT), I.ple_norm + (L) * 1024, H2); } SEAM(P + 6); \
    if (IN(P + 7)) { PH_BEGIN_ pg8::EpiBf16 E{PP, 1024, 0, 0, 1.f}; dense_gemm(F, ws + WS_PB, 256, ws + WS_PPROJ + (size_t)(L) * 1024 * 256 * 2, 256, T, 1024, E); } SEAM(P + 7); \
    if (IN(P + 8)) { PH_BEGIN_ pg8::EpiPle E{X, PP}; dense_gemm(F, H2, 1024, ws + WS_PGATE + (size_t)(L) * 1024 * 1024 * 2, 1024, T, 1024, E); } SEAM(P + 8);

    MOE_PLE_PHASES(6, 0)
    if (IN(15)) { PH_BEGIN_ rwkv_input_pass(F, X, I.norm_mix + 1024, I.rwkv_mu, HCAT, XRB, XKB, XVB); prep_layer_weights(F, I, ws, 1); } SEAM(15);
    if (IN(16)) { PH_BEGIN_ { pg8::EpiBf16 E{RB, 1024, 0, 0, 1.f}; dense_gemm(F, XRB, 1024, ws + WS_RCAT, 1024, T, 1024, E); }
        { pg8::EpiMid E{MID}; dense_gemm(F, HCAT, 2048, ws + WS_RL1, 2048, T, 512, E); } } SEAM(16);
    if (IN(17)) { PH_BEGIN_ pg8::EpiBf16 E{KB, 1024, 0, 0, 1.f}; dense_gemm(F, XKB, 1024, ws + WS_RCAT + (size_t)1024 * 1024 * 2, 1024, T, 1024, E); } SEAM(17);
    if (IN(18)) { PH_BEGIN_ pg8::EpiBf16 E{VB, 1024, 0, 0, 1.f}; dense_gemm(F, XVB, 1024, ws + WS_RCAT + (size_t)2 * 1024 * 1024 * 2, 1024, T, 1024, E); } SEAM(18);
    if (IN(19)) { PH_BEGIN_ pg8::EpiRwkv2 E{EWB, AAB, I.rwkv_w0, I.rwkv_a0, 0}; dense_gemm(F, MID, 512, ws + WS_RS2, 256, T, 2048, E); } SEAM(19);
    if (IN(20)) { PH_BEGIN_ rwkv_scan_phase(F, I, RB, KB, VB, AAB, EWB, YB); } SEAM(20);
    if (IN(21)) { PH_BEGIN_ pg8::EpiRwkv2 E{EWB, EWB, nullptr, nullptr, 2}; dense_gemm(F, MID + 256, 512, ws + WS_RS2 + (size_t)2 * 1024 * 256 * 2, 256, T, 1024, E); } SEAM(21);
    if (IN(22)) { PH_BEGIN_ rwkv_post_pass(F, I, RB, KB, VB, AAB, EWB, YB); } SEAM(22);
    if (IN(23)) { PH_BEGIN_ pg8::EpiResF32 E{X, X}; dense_gemm(F, YB, 1024, ws + WS_RWO, 1024, T, 1024, E); } SEAM(23);
    MOE_PLE_PHASES(24, 1)
    if (IN(33)) { PH_BEGIN_ final_norm_pass(F, X, I.final_norm); }
#undef IN
#undef SEAM
}

extern "C" void kernel_launch(void* const* d_in, const int* in_sizes, int n_in, void* d_out, int out_size, void* d_ws, size_t ws_size, hipStream_t stream) {
    static int ok = 0;
    if (ok == 0) {
        if (n_in != 47 || out_size != T * D || ws_size < WS_END) { fprintf(stderr, "kernel_launch: unexpected problem shape (n_in %d out %d ws %zu)\n", n_in, out_size, ws_size); ok = -1; return; }
        if (hipFuncSetAttribute((const void*)mk_fwd, hipFuncAttributeMaxDynamicSharedMemorySize, LDS_BYTES) != hipSuccess) { fprintf(stderr, "kernel_launch: hipFuncSetAttribute failed\n"); ok = -1; return; }
        int per_cu = 0;
        if (hipOccupancyMaxActiveBlocksPerMultiprocessor(&per_cu, (const void*)mk_fwd, NWAVES * 64, LDS_BYTES) != hipSuccess || per_cu < 1) fprintf(stderr, "kernel_launch: occupancy query reports %d\n", per_cu);
        (void)hipGetLastError();
        ok = 1;
    }
    if (ok < 0) return;
    (void)hipMemsetAsync((char*)d_ws + WS_CTL, 0, CTL_ZERO_BYTES, stream);
    Args a{};
    const float** ip = (const float**)&a.in;
    for (int i = 0; i < 47; ++i) ip[i] = (const float*)d_in[i];
    a.out = (float*)d_out; a.ws = (unsigned char*)d_ws;
    const int grid = 256;
#if MK_ONE_LAUNCH
    a.ph_lo = 0; a.ph_hi = N_PHASES;
    hipLaunchKernelGGL(mk_fwd, dim3(grid), dim3(NWAVES * 64), LDS_BYTES, stream, a);
#else
    for (int k = 0; k < N_PHASES; ++k) { a.ph_lo = k; a.ph_hi = k + 1; hipLaunchKernelGGL(mk_fwd, dim3(grid), dim3(NWAVES * 64), LDS_BYTES, stream, a);
        if (k == DUP_K || k == DUP_K2) hipLaunchKernelGGL(mk_fwd, dim3(grid), dim3(NWAVES * 64), LDS_BYTES, stream, a); }
#endif
}
```

```cpp
#include <hip/hip_runtime.h>
#include <hip/hip_bf16.h>
#include <cstdio>
#include <cstdint>
#include <cmath>

#ifndef MK_ONE_LAUNCH
#define MK_ONE_LAUNCH 1
#endif

#define GAS __attribute__((address_space(1)))
#define LAS __attribute__((address_space(3)))
typedef unsigned short bf16;
typedef unsigned v4u __attribute__((ext_vector_type(4)));
typedef unsigned v2u __attribute__((ext_vector_type(2)));
typedef float f32x4 __attribute__((ext_vector_type(4)));
typedef float f32x2 __attribute__((ext_vector_type(2)));
typedef short bf16x8 __attribute__((ext_vector_type(8)));
typedef GAS unsigned gu32;
#define RLX_AGENT __ATOMIC_RELAXED, __HIP_MEMORY_SCOPE_AGENT
#define LDS_WAIT() asm volatile("s_waitcnt lgkmcnt(0)" ::: "memory")
#define VM_WAIT() asm volatile("s_waitcnt vmcnt(0)" ::: "memory")
__device__ __forceinline__ unsigned f2bf(float f) { unsigned u = __builtin_bit_cast(unsigned, f); return (u + 0x7fffu + ((u >> 16) & 1u)) >> 16; }
__device__ __forceinline__ unsigned pk2(float lo, float hi) { unsigned r; asm("v_cvt_pk_bf16_f32 %0, %1, %2" : "=v"(r) : "v"(lo), "v"(hi)); return r; }
__device__ __forceinline__ float bflo(unsigned w) { return __uint_as_float(w << 16); }
__device__ __forceinline__ float bfhi(unsigned w) { return __uint_as_float(w & 0xffff0000u); }
__device__ __forceinline__ float bf1(bf16 h) { return __uint_as_float((unsigned)h << 16); }
__device__ __forceinline__ float sigmoidf_(float x) { return __builtin_amdgcn_rcpf(1.0f + __builtin_amdgcn_exp2f(-1.4426950408889634f * x)); }
__device__ __forceinline__ float tanhf_(float x) { return 1.0f - 2.0f * __builtin_amdgcn_rcpf(1.0f + __builtin_amdgcn_exp2f(2.885390081777927f * x)); }
__device__ __forceinline__ void fmac_(float& acc, float a, float b) { asm("v_fmac_f32 %0, %1, %2" : "+v"(acc) : "v"(a), "v"(b)); }
__device__ __forceinline__ float fma_(float a, float b, float c) { float r; asm("v_fma_f32 %0, %1, %2, %3" : "=v"(r) : "v"(a), "v"(b), "v"(c)); return r; }
__device__ __forceinline__ float mul_(float a, float b) { float r; asm("v_mul_f32 %0, %1, %2" : "=v"(r) : "v"(a), "v"(b)); return r; }
__device__ __forceinline__ float wave_sum(float v) {
#pragma unroll
    for (int o = 1; o < 64; o <<= 1) v += __shfl_xor(v, o);
    return v;
}

constexpr int NB = 8, SEQ = 8192, D = 1024, T = NB * SEQ;
constexpr int AB_IN = 2560, PLE = 256;
constexpr int NEXP = 32, EH = 512;
constexpr int MAXSLOT = 2 * T + NEXP * 256;
constexpr int MAXTILES = MAXSLOT / 256;

namespace pg8 {
#define PG8_LAS __attribute__((address_space(3)))
typedef unsigned short bf16_t;
typedef unsigned u32x4 __attribute__((ext_vector_type(4)));
typedef unsigned u32x2 __attribute__((ext_vector_type(2)));
constexpr int BM = 256, BK = 64, HALF = 128, HTB = HALF * BK * 2, STAGE_BYTES = 8 * HTB, NXCD = 8, WGM = 8;
__host__ __device__ __forceinline__ int lds_byte(int r, int c) { const int st = (r >> 4) * 2 + (c >> 5), rr = r & 15, cc = c & 31, ob = rr * 64 + cc * 2; return st * 1024 + (ob ^ (((ob >> 9) & 1) << 5)); }
__host__ __device__ __forceinline__ void stage_rc(int b, int& R, int& C) { const int st = b / 1024, sb = b % 1024, swz = sb ^ (((sb >> 9) & 1) << 5); R = (st >> 1) * 16 + swz / 64; C = (st & 1) * 32 + (swz % 64) / 2; }
__host__ __device__ __forceinline__ int perm32(int rho) { const int n = rho >> 4, i = rho & 15; return 8 * (i >> 2) + 4 * n + (i & 3); }

struct Unit { int pm, pn, aux; const char* A; const char* B; };

struct DenseOrder {
    int nM, nN, nwg, G, c; const char* A; const char* B; size_t astep, bstep;
    __device__ void init(const void* A_, int lda, const void* B_, int K, int M, int N, int G_, int c_) { nM = M / BM; nN = N / BM; nwg = nM * nN; G = G_; c = c_; A = (const char*)A_; B = (const char*)B_; astep = (size_t)BM * lda * 2; bstep = (size_t)BM * K * 2; }
    __device__ bool next(int i, Unit& u) const {
        const long L = (long)i * G + c; if (L >= nwg) return false;
        int wgid = (int)L; { const int q = nwg / NXCD, r = nwg % NXCD, xcd = wgid % NXCD, off = wgid / NXCD; wgid = (xcd < r ? xcd * (q + 1) : r * (q + 1) + (xcd - r) * q) + off; }
        const int nig = WGM * nN, gid = wgid / nig, fm = gid * WGM, gsz = (nM - fm) < WGM ? (nM - fm) : WGM;
        u.pm = fm + ((wgid % nig) % gsz); u.pn = (wgid % nig) / gsz; u.aux = 0; u.A = A + (size_t)u.pm * astep; u.B = B + (size_t)u.pn * bstep; return true;
    }
};

__device__ __forceinline__ unsigned cvt_pk_bf16(float lo, float hi) { unsigned r; asm volatile("v_cvt_pk_bf16_f32 %0, %1, %2" : "=v"(r) : "v"(lo), "v"(hi)); return r; }

typedef f32x4 Acc[2][2][4][2];

struct EpiBf16 {
    static constexpr bool PERM = true;
    bf16_t* O; int ldc; int split_cols; size_t split_stride; float scale0;
    __device__ __forceinline__ void operator()(const Acc& acc, const Unit& u, int wr, int wc, int fr, int fq) const {
        const int row0 = u.pm * BM + wr * 64 + fr; int colt = u.pn * BM; bf16_t* base = O;
        float sc = 1.f; if (split_cols) { const int t = colt / split_cols; base += (size_t)t * split_stride; colt -= t * split_cols; if (t == 0) sc = scale0; }
        const int col0 = colt + wc * 32 + 8 * fq;
#pragma unroll
        for (int ai = 0; ai < 2; ++ai)
#pragma unroll
            for (int m = 0; m < 4; ++m) { bf16_t* rowp = base + (size_t)(row0 + ai * HALF + m * 16) * ldc + col0;
#pragma unroll
                for (int bj = 0; bj < 2; ++bj) { f32x4 v0 = acc[ai][bj][m][0] * sc, v1 = acc[ai][bj][m][1] * sc;
                    u32x4 w; w.x = cvt_pk_bf16(v0[0], v0[1]); w.y = cvt_pk_bf16(v0[2], v0[3]); w.z = cvt_pk_bf16(v1[0], v1[1]); w.w = cvt_pk_bf16(v1[2], v1[3]);
                    *(u32x4*)(rowp + bj * HALF) = w; } }
    }
};
struct EpiResF32 {
    static constexpr bool PERM = false;
    const float* base; float* out;
    __device__ __forceinline__ void operator()(const Acc& acc, const Unit& u, int wr, int wc, int fr, int fq) const {
        const int col0 = u.pn * BM + wc * 32 + 4 * fq;
        const GAS float* bp = (const GAS float*)base; GAS float* op = (GAS float*)out;
#pragma unroll
        for (int ai = 0; ai < 2; ++ai) {
            f32x4 bs[4][2][2];
#pragma unroll
            for (int m = 0; m < 4; ++m) { const size_t off = (size_t)(u.pm * BM + ai * HALF + wr * 64 + m * 16 + fr) * 1024 + col0;
#pragma unroll
                for (int bj = 0; bj < 2; ++bj)
#pragma unroll
                    for (int n = 0; n < 2; ++n) bs[m][bj][n] = *(const GAS f32x4*)(bp + off + bj * HALF + n * 16); }
            asm volatile("" ::: "memory");
#pragma unroll
            for (int m = 0; m < 4; ++m) { const size_t off = (size_t)(u.pm * BM + ai * HALF + wr * 64 + m * 16 + fr) * 1024 + col0;
#pragma unroll
                for (int bj = 0; bj < 2; ++bj)
#pragma unroll
                    for (int n = 0; n < 2; ++n) *(GAS f32x4*)(op + off + bj * HALF + n * 16) = bs[m][bj][n] + acc[ai][bj][m][n]; }
            asm volatile("" ::: "memory");
        }
    }
};
struct EpiRouter {
    static constexpr bool PERM = false;
    float* out;
    __device__ __forceinline__ void operator()(const Acc& acc, const Unit& u, int wr, int wc, int fr, int fq) const {
        if (wc >= 2) return;
#pragma unroll
        for (int ai = 0; ai < 2; ++ai)
#pragma unroll
            for (int m = 0; m < 4; ++m) { const size_t off = (size_t)(u.pm * BM + ai * HALF + wr * 64 + m * 16 + fr) * 64 + wc * 32 + 4 * fq;
#pragma unroll
                for (int n = 0; n < 2; ++n) *(f32x4*)(out + off + n * 16) = acc[ai][0][m][n]; }
    }
};
struct EpiGU {
    static constexpr bool PERM = true;
    bf16_t* H;
    __device__ __forceinline__ void operator()(const Acc& acc, const Unit& u, int wr, int wc, int fr, int fq) const {
        const int col0 = u.pn * 128 + wc * 32 + 8 * fq;
#pragma unroll
        for (int ai = 0; ai < 2; ++ai)
#pragma unroll
            for (int m = 0; m < 4; ++m) { bf16_t* rowp = H + (size_t)(u.pm * BM + ai * HALF + wr * 64 + m * 16 + fr) * EH + col0;
                f32x4 g0 = acc[ai][0][m][0], g1 = acc[ai][0][m][1]; const f32x4 u0 = acc[ai][1][m][0], u1 = acc[ai][1][m][1];
#pragma unroll
                for (int e = 0; e < 4; ++e) { g0[e] = g0[e] * sigmoidf_(g0[e]) * u0[e]; g1[e] = g1[e] * sigmoidf_(g1[e]) * u1[e]; }
                u32x4 w; w.x = cvt_pk_bf16(g0[0], g0[1]); w.y = cvt_pk_bf16(g0[2], g0[3]); w.z = cvt_pk_bf16(g1[0], g1[1]); w.w = cvt_pk_bf16(g1[2], g1[3]);
                *(u32x4*)rowp = w; }
    }
};
struct EpiDown {
    static constexpr bool PERM = true;
    bf16_t* Y; const float* gate;
    __device__ __forceinline__ void operator()(const Acc& acc, const Unit& u, int wr, int wc, int fr, int fq) const {
        const int col0 = u.pn * BM + wc * 32 + 8 * fq;
#pragma unroll
        for (int ai = 0; ai < 2; ++ai)
#pragma unroll
            for (int m = 0; m < 4; ++m) { const int row = u.pm * BM + ai * HALF + wr * 64 + m * 16 + fr; const float sc = gate[row]; bf16_t* rowp = Y + (size_t)row * 1024 + col0;
#pragma unroll
                for (int bj = 0; bj < 2; ++bj) { const f32x4 v0 = acc[ai][bj][m][0] * sc, v1 = acc[ai][bj][m][1] * sc;
                    u32x4 w; w.x = cvt_pk_bf16(v0[0], v0[1]); w.y = cvt_pk_bf16(v0[2], v0[3]); w.z = cvt_pk_bf16(v1[0], v1[1]); w.w = cvt_pk_bf16(v1[2], v1[3]);
                    *(u32x4*)(rowp + bj * HALF) = w; } }
    }
};
struct EpiPle {
    static constexpr bool PERM = false;
    float* x; const bf16_t* pp;
    __device__ __forceinline__ void operator()(const Acc& acc, const Unit& u, int wr, int wc, int fr, int fq) const {
        const int col0 = u.pn * BM + wc * 32 + 4 * fq;
        GAS float* xp = (GAS float*)x; const GAS bf16_t* pq = (const GAS bf16_t*)pp;
#pragma unroll
        for (int ai = 0; ai < 2; ++ai)
#pragma unroll
            for (int mp = 0; mp < 2; ++mp) {
                f32x4 bs[2][2][2]; u32x2 pw[2][2][2];
#pragma unroll
                for (int mm = 0; mm < 2; ++mm) { const size_t off = (size_t)(u.pm * BM + ai * HALF + wr * 64 + (2 * mp + mm) * 16 + fr) * 1024 + col0;
#pragma unroll
                    for (int bj = 0; bj < 2; ++bj)
#pragma unroll
                        for (int n = 0; n < 2; ++n) { const size_t o = off + bj * HALF + n * 16; bs[mm][bj][n] = *(const GAS f32x4*)(xp + o); pw[mm][bj][n] = *(const GAS u32x2*)(pq + o); } }
                asm volatile("" ::: "memory");
#pragma unroll
                for (int mm = 0; mm < 2; ++mm) { const size_t off = (size_t)(u.pm * BM + ai * HALF + wr * 64 + (2 * mp + mm) * 16 + fr) * 1024 + col0;
#pragma unroll
                    for (int bj = 0; bj < 2; ++bj)
#pragma unroll
                        for (int n = 0; n < 2; ++n) { const size_t o = off + bj * HALF + n * 16; const f32x4 a = acc[ai][bj][2 * mp + mm][n]; const f32x4 b = bs[mm][bj][n]; const u32x2 p = pw[mm][bj][n]; f32x4 r;
                            r[0] = b[0] + bflo(p.x) * sigmoidf_(a[0]); r[1] = b[1] + bfhi(p.x) * sigmoidf_(a[1]); r[2] = b[2] + bflo(p.y) * sigmoidf_(a[2]); r[3] = b[3] + bfhi(p.y) * sigmoidf_(a[3]);
                            *(GAS f32x4*)(xp + o) = r; } }
                asm volatile("" ::: "memory");
            }
    }
};
struct EpiMid {
    static constexpr bool PERM = true;
    bf16_t* MID;
    __device__ __forceinline__ void operator()(const Acc& acc, const Unit& u, int wr, int wc, int fr, int fq) const {
        const int row0 = u.pm * BM + wr * 64 + fr;
        const int mode = (u.pn == 1) ? 2 : 0; const int colbase = u.pn * 256;
#pragma unroll
        for (int ai = 0; ai < 2; ++ai)
#pragma unroll
            for (int m = 0; m < 4; ++m) { bf16_t* rowp = MID + (size_t)(row0 + ai * HALF + m * 16) * 512 + colbase;
#pragma unroll
                for (int bj = 0; bj < 2; ++bj) { const int lc = bj * HALF + wc * 32 + 8 * fq; f32x4 v0 = acc[ai][bj][m][0], v1 = acc[ai][bj][m][1];
#pragma unroll
                    for (int e = 0; e < 4; ++e) {
                        if (mode == 2) { v0[e] = sigmoidf_(v0[e]); v1[e] = sigmoidf_(v1[e]); }
                        else if (lc < 64) { v0[e] = tanhf_(v0[e]); v1[e] = tanhf_(v1[e]); } }
                    u32x4 w; w.x = cvt_pk_bf16(v0[0], v0[1]); w.y = cvt_pk_bf16(v0[2], v0[3]); w.z = cvt_pk_bf16(v1[0], v1[1]); w.w = cvt_pk_bf16(v1[2], v1[3]);
                    *(u32x4*)(rowp + lc) = w; } }
    }
};
struct EpiRwkv2 {
    static constexpr bool PERM = true;
    bf16_t* O0; bf16_t* O1; const float* bias0; const float* bias1; int tybase;
    __device__ __forceinline__ void operator()(const Acc& acc, const Unit& u, int wr, int wc, int fr, int fq) const {
        const int ty = tybase + (u.pn >> 2); const int row0 = u.pm * BM + wr * 64 + fr; const int colt = (u.pn & 3) * BM + wc * 32 + 8 * fq;
        bf16_t* base = (u.pn >> 2) ? O1 : O0; const float* bias = (u.pn >> 2) ? bias1 : bias0;
#pragma unroll
        for (int bj = 0; bj < 2; ++bj) {
            f32x4 b0 = (f32x4){0.f, 0.f, 0.f, 0.f}, b1 = b0;
            if (ty < 2) { b0 = *(const f32x4*)(bias + colt + bj * HALF); b1 = *(const f32x4*)(bias + colt + bj * HALF + 4); }
#pragma unroll
            for (int ai = 0; ai < 2; ++ai)
#pragma unroll
                for (int m = 0; m < 4; ++m) { bf16_t* rowp = base + (size_t)(row0 + ai * HALF + m * 16) * 1024 + colt + bj * HALF;
                    f32x4 v0 = acc[ai][bj][m][0] + b0, v1 = acc[ai][bj][m][1] + b1;
                    if (ty < 2) { const float s = (ty == 0) ? 0.6065306597126334f : 1.0f;
#pragma unroll
                        for (int e = 0; e < 4; ++e) { v0[e] = s * sigmoidf_(v0[e]); v1[e] = s * sigmoidf_(v1[e]); } }
                    u32x4 w; w.x = cvt_pk_bf16(v0[0], v0[1]); w.y = cvt_pk_bf16(v0[2], v0[3]); w.z = cvt_pk_bf16(v1[0], v1[1]); w.w = cvt_pk_bf16(v1[2], v1[3]);
                    *(u32x4*)rowp = w; }
        }
    }
};

template <class Epi, class Sched, bool ALIGN_EPI, bool GATHER>
__device__ __forceinline__ void gemm_phase(PG8_LAS unsigned char* lds, const int K, const int lda, const Sched& S, const Epi& E, const int* __restrict__ rows, const int tid) {
    const int wid = __builtin_amdgcn_readfirstlane(tid >> 6), lane = tid & 63, wr = wid >> 2, wc = wid & 3, fr = lane & 15, fq = lane >> 4;
    const int nt = K / BK;
    unsigned voffA[2], voffB[2]; int RA[2];
#pragma unroll
    for (int i = 0; i < 2; ++i) { int R, C; stage_rc(tid * 16 + i * 8192, R, C); const int Rb = Epi::PERM ? ((R & ~31) + perm32(R & 31)) : R;
        RA[i] = R; voffA[i] = GATHER ? (unsigned)(C * 2) : (unsigned)(R * lda + C) * 2u; voffB[i] = (unsigned)(Rb * K + C) * 2u; }
    const size_t kstep = (size_t)(BK * 2);
    const size_t hstepA = GATHER ? 0 : (size_t)HALF * lda * 2, hstepB = (size_t)HALF * K * 2;
    const unsigned ldsw = (unsigned)wid * 1024u;
    const int aoff = lds_byte(wr * 64 + fr, fq * 8), boff = lds_byte(wc * 32 + fr, fq * 8);
#define PG8_SA(b, h) (((b) * 2 + (h)) * HTB)
#define PG8_SB(b, h) ((4 + (b) * 2 + (h)) * HTB)
#define PG8_ST2(bufoff, gbase, o0, o1) do { \
        __builtin_amdgcn_global_load_lds((const unsigned*)((const char*)(gbase) + (o0)), (PG8_LAS unsigned*)(lds + (bufoff) + ldsw), 16, 0, 0); \
        __builtin_amdgcn_global_load_lds((const unsigned*)((const char*)(gbase) + (o1)), (PG8_LAS unsigned*)(lds + (bufoff) + ldsw + 8192), 16, 0, 0); } while (0)
#define PG8_STB(bufoff, gbase) PG8_ST2(bufoff, gbase, voffB[0], voffB[1])
#define PG8_STA(bufoff, p, h, nx) do { if constexpr (GATHER) { const unsigned g0_ = (nx) ? gN[h][0] : gC[h][0], g1_ = (nx) ? gN[h][1] : gC[h][1]; PG8_ST2(bufoff, p, g0_, g1_); } \
        else { PG8_ST2(bufoff, (p) + (h) * hstepA, voffA[0], voffA[1]); } } while (0)
#define PG8_LDA(dst, b, h) do { _Pragma("unroll") for (int m = 0; m < 4; ++m) _Pragma("unroll") for (int k = 0; k < 2; ++k) dst[m][k] = *(const PG8_LAS bf16x8*)(lds + PG8_SA(b, h) + aoff + m * 2048 + k * 1024); } while (0)
#define PG8_LDB(dst, b, h) do { _Pragma("unroll") for (int n = 0; n < 2; ++n) _Pragma("unroll") for (int k = 0; k < 2; ++k) dst[n][k] = *(const PG8_LAS bf16x8*)(lds + PG8_SB(b, h) + boff + n * 2048 + k * 1024); } while (0)
#define PG8_MMA(ai, bj, At, Bt) do { __builtin_amdgcn_s_setprio(1); _Pragma("unroll") for (int m = 0; m < 4; ++m) _Pragma("unroll") for (int n = 0; n < 2; ++n) _Pragma("unroll") for (int k = 0; k < 2; ++k) \
        acc[ai][bj][m][n] = __builtin_amdgcn_mfma_f32_16x16x32_bf16(Bt[n][k], At[m][k], acc[ai][bj][m][n], 0, 0, 0); __builtin_amdgcn_s_setprio(0); } while (0)
#define PG8_WAIT_V(n) asm volatile("s_waitcnt vmcnt(" #n ")" ::: "memory")
#define PG8_WAIT_L(n) asm volatile("s_waitcnt lgkmcnt(" #n ")" ::: "memory")
#define PG8_BAR __builtin_amdgcn_s_barrier()
#define PG8_SCHED __builtin_amdgcn_sched_barrier(0)
#define PG8_GLOAD(dst, un) do { if constexpr (GATHER) { _Pragma("unroll") for (int h_ = 0; h_ < 2; ++h_) _Pragma("unroll") for (int i_ = 0; i_ < 2; ++i_) \
        dst[h_][i_] = (unsigned)rows[(un).pm * BM + h_ * HALF + RA[i_]] * (unsigned)(lda * 2) + voffA[i_]; } } while (0)
    Unit cur, nxt; int ui = 0;
    if (!S.next(0, cur)) return;
    unsigned gC[2][2] = {{0u, 0u}, {0u, 0u}}, gN[2][2] = {{0u, 0u}, {0u, 0u}};
    PG8_GLOAD(gC, cur);
    Acc acc;
#pragma unroll
    for (int a = 0; a < 2; ++a)
#pragma unroll
        for (int b = 0; b < 2; ++b)
#pragma unroll
            for (int m = 0; m < 4; ++m)
#pragma unroll
                for (int n = 0; n < 2; ++n) acc[a][b][m][n] = (f32x4){0.f, 0.f, 0.f, 0.f};
    bf16x8 At[4][2], B0[2][2], B1[2][2];
    const char* cA = cur.A; const char* cB = cur.B;
    PG8_STB(PG8_SB(0, 0), cB); PG8_STB(PG8_SB(0, 1), cB + hstepB); PG8_STA(PG8_SA(0, 0), cA, 0, false); PG8_STA(PG8_SA(0, 1), cA, 1, false);
    if (wr == 1) PG8_BAR;
    PG8_WAIT_V(2); PG8_BAR;
    PG8_STB(PG8_SB(1, 0), cB + kstep); PG8_STA(PG8_SA(1, 0), cA + kstep, 0, false); PG8_STB(PG8_SB(1, 1), cB + hstepB + kstep);
    PG8_WAIT_V(6); PG8_BAR;
    for (;;) {
        const bool has_next = S.next(ui + 1, nxt);
        if (has_next) { PG8_GLOAD(gN, nxt); }
        const char* nA = has_next ? nxt.A : cA; const char* nB = has_next ? nxt.B : cB;
#pragma unroll 1
        for (int t = 0; t < nt; t += 2) {
            const bool last = (t == nt - 2); const bool nx = last && has_next;
            const char* a1 = cA + (size_t)(t + 1) * kstep;
            const char* a2 = last ? nA : cA + (size_t)(t + 2) * kstep; const char* b2 = last ? nB : cB + (size_t)(t + 2) * kstep;
            const char* a3 = a2 + kstep; const char* b3 = b2 + kstep;
            PG8_LDB(B0, 0, 0); PG8_LDB(B1, 0, 1); PG8_SCHED; PG8_LDA(At, 0, 0); PG8_STA(PG8_SA(1, 1), a1, 1, false);
            PG8_WAIT_V(8); PG8_WAIT_L(0); PG8_BAR; PG8_MMA(0, 0, At, B0); PG8_MMA(0, 1, At, B1); PG8_BAR; PG8_SCHED;
            PG8_LDA(At, 0, 1); PG8_STB(PG8_SB(0, 0), b2); PG8_STB(PG8_SB(0, 1), b2 + hstepB); PG8_STA(PG8_SA(0, 0), a2, 0, nx);
            PG8_WAIT_V(8); PG8_WAIT_L(0); PG8_BAR; PG8_MMA(1, 0, At, B0); PG8_MMA(1, 1, At, B1); PG8_BAR; PG8_SCHED;
            PG8_LDB(B0, 1, 0); PG8_LDB(B1, 1, 1); PG8_SCHED; PG8_LDA(At, 1, 0); PG8_STA(PG8_SA(0, 1), a2, 1, nx);
            PG8_WAIT_V(8); PG8_WAIT_L(0); PG8_BAR; PG8_MMA(0, 0, At, B0); PG8_MMA(0, 1, At, B1); PG8_BAR; PG8_SCHED;
            PG8_LDA(At, 1, 1); PG8_STB(PG8_SB(1, 0), b3); PG8_STB(PG8_SB(1, 1), b3 + hstepB); PG8_STA(PG8_SA(1, 0), a3, 0, nx);
            PG8_WAIT_V(8); PG8_WAIT_L(0); PG8_BAR; PG8_MMA(1, 0, At, B0); PG8_MMA(1, 1, At, B1); PG8_BAR; PG8_SCHED;
        }
        if constexpr (ALIGN_EPI) { if (wr == 0) PG8_BAR; }
        E(acc, cur, wr, wc, fr, fq);
        if (!has_next) break;
#pragma unroll
        for (int a = 0; a < 2; ++a)
#pragma unroll
            for (int b = 0; b < 2; ++b)
#pragma unroll
                for (int m = 0; m < 4; ++m)
#pragma unroll
                    for (int n = 0; n < 2; ++n) acc[a][b][m][n] = (f32x4){0.f, 0.f, 0.f, 0.f};
        cur = nxt; cA = nA; cB = nB; ++ui;
        if constexpr (GATHER) {
#pragma unroll
            for (int h_ = 0; h_ < 2; ++h_)
#pragma unroll
                for (int i_ = 0; i_ < 2; ++i_) gC[h_][i_] = gN[h_][i_]; }
        if constexpr (ALIGN_EPI) { if (wr == 1) PG8_BAR; }
    }
    PG8_WAIT_V(0);
    if constexpr (!ALIGN_EPI) { if (wr == 0) PG8_BAR; }
    PG8_BAR;
#undef PG8_SA
#undef PG8_SB
#undef PG8_ST2
#undef PG8_STB
#undef PG8_STA
#undef PG8_LDA
#undef PG8_LDB
#undef PG8_MMA
#undef PG8_WAIT_V
#undef PG8_WAIT_L
#undef PG8_BAR
#undef PG8_SCHED
#undef PG8_GLOAD
}
}
namespace attn_body {
using bf16=__hip_bfloat16;
using bf16x8=__attribute__((ext_vector_type(8)))short;
using s16x4=__attribute__((ext_vector_type(4)))short;
using f32x16=__attribute__((ext_vector_type(16)))float;
using u32x4=__attribute__((ext_vector_type(4)))unsigned;
constexpr int BATCH=8,NHEAD=16,SEQ=8192,D=64,PQ=512,PO=1024;
constexpr int NW=8,QBLK=32,QB=QBLK*NW,KVBLK=64,NQB=SEQ/QB;
constexpr int ATTN_UNIT_ROWS=QB;
__device__ __forceinline__ int crow(int r,int hi){return (r&3)+8*(r>>2)+4*hi;}
#define SBAR() __builtin_amdgcn_sched_barrier(0)
__device__ __forceinline__ void cmask(f32x16&p0,f32x16&p1,int jb,int qrel,int hi){
  const float NEG=-INFINITY; int kb=64*jb+4*hi;
  #pragma unroll
  for(int r=0;r<16;++r){int kv=kb+(r&3)+8*(r>>2); if(kv>qrel)p0[r]=NEG; if(kv+32>qrel)p1[r]=NEG;}
}

__device__ __forceinline__ void cbias(f32x16&p0,f32x16&p1,int jb,int qrel,int hi,const __attribute__((address_space(3))) float*tb){
  const int kb=64*jb+4*hi;
  #pragma unroll
  for(int r=0;r<16;++r){const int rel=qrel-(kb+(r&3)+8*(r>>2)); const int i0=min(max(rel,0),127), i1=min(max(rel-32,0),127); p0[r]+=tb[i0]; p1[r]+=tb[i1];}
}
constexpr int NSLOT=3, SLOTB=8192;
constexpr int LDS_K=0, LDS_V=NSLOT*SLOTB, LDS_WS=2*NSLOT*SLOTB, LDS_OST=LDS_WS+NW*64*4, LDS_BYTES=LDS_OST+NW*4096;
constexpr float C2=0.125f*1.4426950408889634f;
__device__ __forceinline__ void glds16(const void*gsrc,unsigned lds_dst){unsigned keep;
  asm volatile("s_mov_b32 %0, m0\n\ts_mov_b32 m0, %2\n\ts_nop 0\n\tglobal_load_lds_dwordx4 %1, off\n\ts_mov_b32 m0, %0":"=&s"(keep):"v"(gsrc),"s"(lds_dst):"memory");}
__device__ __forceinline__ float max3f(float a,float b,float c){float r;asm("v_max3_f32 %0, %1, %2, %3":"=v"(r):"v"(a),"v"(b),"v"(c));return r;}
__device__ __forceinline__ float max2f(float a,float b){float r;asm("v_max_f32_e32 %0, %1, %2":"=v"(r):"v"(a),"v"(b));return r;}
__device__ __forceinline__ float fadd_s(float a,float b){float r;asm("v_add_f32_e32 %0, %1, %2":"=v"(r):"v"(a),"v"(b));return r;}
__device__ __forceinline__ float fsub_s(float a,float b){float r;asm("v_sub_f32_e32 %0, %1, %2":"=v"(r):"v"(a),"v"(b));return r;}
typedef float f32x2_t __attribute__((ext_vector_type(2))); typedef __bf16 bf16x2_t __attribute__((ext_vector_type(2)));
__device__ __forceinline__ unsigned cvtpk_s(float lo,float hi){f32x2_t v={lo,hi};bf16x2_t b=__builtin_convertvector(v,bf16x2_t);return __builtin_bit_cast(unsigned,b);}
#define WAIT_BAR(N) asm volatile("s_waitcnt vmcnt(" #N ") lgkmcnt(0)\n\ts_barrier":::"memory")

__device__ __forceinline__ void qkt(f32x16&p0,f32x16&p1,const char*Kslot,const bf16x8*qr,const f32x16&negm,int r32,int hi){
  const char*kb=Kslot+hi*1024+r32*16;
  #pragma unroll
  for(int d0=0;d0<4;++d0){
    const bf16x8 b0=*reinterpret_cast<const bf16x8*>(kb+d0*2048);
    const bf16x8 b1=*reinterpret_cast<const bf16x8*>(kb+d0*2048+512);
    if(d0==0){p0=__builtin_amdgcn_mfma_f32_32x32x16_bf16(b0,qr[0],negm,0,0,0);p1=__builtin_amdgcn_mfma_f32_32x32x16_bf16(b1,qr[0],negm,0,0,0);}
    else{p0=__builtin_amdgcn_mfma_f32_32x32x16_bf16(b0,qr[d0],p0,0,0,0);p1=__builtin_amdgcn_mfma_f32_32x32x16_bf16(b1,qr[d0],p1,0,0,0);}}
}
typedef __attribute__((address_space(3))) const char* lds_cptr;
typedef short v4i16_t __attribute__((ext_vector_type(4)));
__device__ __forceinline__ void kload8(bf16x8*kf,lds_cptr kp){
  kf[0]=*(const __attribute__((address_space(3))) bf16x8*)(kp);      kf[1]=*(const __attribute__((address_space(3))) bf16x8*)(kp+512);
  kf[2]=*(const __attribute__((address_space(3))) bf16x8*)(kp+2048); kf[3]=*(const __attribute__((address_space(3))) bf16x8*)(kp+2560);
  kf[4]=*(const __attribute__((address_space(3))) bf16x8*)(kp+4096); kf[5]=*(const __attribute__((address_space(3))) bf16x8*)(kp+4608);
  kf[6]=*(const __attribute__((address_space(3))) bf16x8*)(kp+6144); kf[7]=*(const __attribute__((address_space(3))) bf16x8*)(kp+6656);
}
__device__ __forceinline__ void kload2(bf16x8*kf,lds_cptr kp,int j){ kf[2*j]=*(const __attribute__((address_space(3))) bf16x8*)(kp+j*2048); kf[2*j+1]=*(const __attribute__((address_space(3))) bf16x8*)(kp+j*2048+512); }
__device__ __forceinline__ s16x4 vtr(lds_cptr p){ return __builtin_bit_cast(s16x4,__builtin_amdgcn_ds_read_tr16_b64_v4i16((__attribute__((address_space(3))) v4i16_t*)p)); }
__device__ __forceinline__ float rowmax(const f32x16&p0,const f32x16&p1){
  float a=max3f(p0[0],p0[1],p1[0]),b=max3f(p0[2],p0[3],p1[1]);a=max3f(a,p1[2],p1[3]);
  #pragma unroll
  for(int r=4;r<16;r+=4){a=max3f(a,p0[r],p0[r+1]);b=max3f(b,p0[r+2],p0[r+3]);a=max3f(a,p1[r],p1[r+1]);b=max3f(b,p1[r+2],p1[r+3]);}
  const float m=max2f(a,b);
  auto rr=__builtin_amdgcn_permlane32_swap(__float_as_uint(m),__float_as_uint(m),false,false);
  return max2f(__uint_as_float(rr[0]),__uint_as_float(rr[1]));
}
__device__ __forceinline__ void pv(f32x16*o,int vb,bf16x8 pa0,bf16x8 pa1,bf16x8 pa2,bf16x8 pa3){
  #pragma unroll
  for(int d0=0;d0<2;++d0){s16x4 lo[4],hi[4];
    #pragma unroll
    for(int ks=0;ks<4;++ks){
      asm volatile("ds_read_b64_tr_b16 %0,%1 offset:%c2":"=&v"(lo[ks]):"v"(vb),"i"(d0*4096+ks*1024):"memory");
      asm volatile("ds_read_b64_tr_b16 %0,%1 offset:%c2":"=&v"(hi[ks]):"v"(vb),"i"(d0*4096+ks*1024+512):"memory");}
    asm volatile("s_waitcnt lgkmcnt(0)":::"memory");SBAR();
    #define PK(k) (bf16x8){lo[k][0],lo[k][1],lo[k][2],lo[k][3],hi[k][0],hi[k][1],hi[k][2],hi[k][3]}
    o[d0]=__builtin_amdgcn_mfma_f32_32x32x16_bf16(pa0,PK(0),o[d0],0,0,0);
    o[d0]=__builtin_amdgcn_mfma_f32_32x32x16_bf16(pa1,PK(1),o[d0],0,0,0);
    o[d0]=__builtin_amdgcn_mfma_f32_32x32x16_bf16(pa2,PK(2),o[d0],0,0,0);
    o[d0]=__builtin_amdgcn_mfma_f32_32x32x16_bf16(pa3,PK(3),o[d0],0,0,0);
    #undef PK
  }
}

#ifndef ATTN_STORE16
#define ATTN_STORE16(p,v) (*(u32x4*)(p)=(v))
#endif
template<int THRL> __device__ __forceinline__ void attn_unit(int b,int vh,int qb,const bf16*Q,const bf16*__restrict__ K,const bf16*__restrict__ V,bf16*O,char*shm,const __attribute__((address_space(3))) float*tball,const int tid){
  const int lane=tid&63,r32=lane&31,hi=lane>>5; const int wid=__builtin_amdgcn_readfirstlane(tid>>6);
  const long rowbase=(long)b*SEQ; const int q0=qb*QB;
  const int hh=vh>>2, qcol=hh*128+((vh>>1)&1)*64, vcol=hh*128+(vh&1)*64;
  const __attribute__((address_space(3))) float*tb=tball+hh*128;
  const bf16*Qw=Q+(rowbase+q0+wid*QBLK)*PQ+qcol;
  const bf16*Kh=K+rowbase*PQ+qcol,*Vh=V+rowbase*PQ+vcol;
  const unsigned lds0=(unsigned)(uintptr_t)shm;
  float*wsf=(float*)(shm+LDS_WS)+wid*64;
  const bf16*ksrc=Kh+(long)lane*PQ+wid*8;
  const bf16*vsrc=Vh+(long)(16*(wid&3)+(lane>>2))*PQ+(wid>>2)*32+(lane&3)*8;
  const unsigned kdst=lds0+LDS_K+wid*1024, vdst=lds0+LDS_V+wid*1024;
  #define DMA_K(t,slot) glds16(ksrc+(long)(t)*KVBLK*PQ,(unsigned)__builtin_amdgcn_readfirstlane(kdst+(slot)))
  #define DMA_V(t,slot) glds16(vsrc+(long)(t)*KVBLK*PQ,(unsigned)__builtin_amdgcn_readfirstlane(vdst+(slot)))
  const int vb0=(int)(lds0+LDS_V)+((lane>>4)&1)*32+(lane&3)*8+(4*hi+((lane&15)>>2))*64;
  const char*Kbase=shm+LDS_K; bf16x8 kf[8];
  const lds_cptr shm3=(lds_cptr)shm; const lds_cptr kp0=shm3+LDS_K+hi*1024+r32*16; const lds_cptr vp0=shm3+LDS_V+((lane>>4)&1)*32+(lane&3)*8+(4*hi+((lane&15)>>2))*64;
  const int NT=(q0+QB)/KVBLK;
  DMA_K(0,0);DMA_V(0,0);DMA_K(1,SLOTB);
  bf16x8 qr[4];
  #pragma unroll
  for(int d0=0;d0<4;++d0)qr[d0]=*reinterpret_cast<const bf16x8*>(&Qw[(long)r32*PQ+d0*16+hi*8]);
  float mhat=0.f,l_reg=0.f;f32x16 o[2];o[0]=f32x16{};o[1]=f32x16{};f32x16 negm=f32x16{};asm volatile("":"+v"(negm));
  const int qrel=wid*QBLK+r32;
  #define CMASK(P0,P1,t) do{int jb_=(t)-(NT-4); if(jb_>=-2){cbias(P0,P1,jb_,qrel,hi,tb); if(jb_>=0)cmask(P0,P1,jb_,qrel,hi);}}while(0)
  bool resc=false;
  #define START(P0,P1) do{ const float rm=rowmax(P0,P1); resc=false; \
    { const float dl=rm; mhat=fadd_s(mhat,dl); \
      _Pragma("unroll") for(int r=0;r<16;++r){P0[r]=fsub_s(P0[r],dl);P1[r]=fsub_s(P1[r],dl);} \
      _Pragma("unroll") for(int r=0;r<16;++r)negm[r]=-mhat; asm volatile("":"+v"(negm)); } \
    _Pragma("unroll") for(int r=0;r<16;++r)P0[r]=__builtin_amdgcn_exp2f(P0[r]); }while(0)
  #define RESC() do{ if(resc){ asm volatile("s_waitcnt lgkmcnt(0)":::"memory"); \
      _Pragma("unroll") for(int d_=0;d_<2;++d_) _Pragma("unroll") for(int r=0;r<16;++r)o[d_][r]*=wsf[crow(r,hi)]; } }while(0)
  f32x16 pA0,pA1,pB0,pB1;
  int sl_prev=0,sl_cur=0,sl_next=SLOTB;
  #define ROT() do{sl_prev=sl_cur;sl_cur=sl_next;sl_next=(sl_next==(NSLOT-1)*SLOTB)?0:sl_next+SLOTB;}while(0)
  DMA_K(2,2*SLOTB);
  WAIT_BAR(3);
  qkt(pA0,pA1,Kbase,qr,negm,r32,hi);asm volatile("s_nop 15\n\ts_nop 7":"+v"(pA0),"+v"(pA1));CMASK(pA0,pA1,0);
  START(pA0,pA1);
  _Pragma("unroll") for(int r=0;r<16;++r)pA1[r]=__builtin_amdgcn_exp2f(pA1[r]);
  WAIT_BAR(0);
  DMA_K(3,0);DMA_V(1,SLOTB);
  ROT();
  kload8(kf,kp0+sl_cur);
  WAIT_BAR(2);
  s16x4 vlo[8],vhi[8]; u32x4 pw0,pw1,pw2,pw3;
  #define PKW(P,B) cvtpk_s(P[B],P[B+1])
  #define PAF(k) __builtin_bit_cast(bf16x8,pw##k)
  #define VFR(i) (bf16x8){vlo[i][0],vlo[i][1],vlo[i][2],vlo[i][3],vhi[i][0],vhi[i][1],vhi[i][2],vhi[i][3]}
  #define PIN(x) asm volatile("":"+v"(x))
  #define MX3(a,b,c) __builtin_fmaxf(__builtin_fmaxf((a),(b)),(c))
  #define GAPA(MF,A0,A1,A2,A3,W0,W1,PW) do{ MF; sacc+=A0; sacc+=A1; sacc+=A2; sacc+=A3; PIN(sacc); W0; W1; PIN(PW); SBAR(); }while(0)
  #define EX(v) __builtin_amdgcn_exp2f(v)
  #define GAPB(MF,X,B) do{ MF; X[B]=EX(X[B]); X[B+1]=EX(X[B+1]); X[B+2]=EX(X[B+2]); X[B+3]=EX(X[B+3]); PIN(X); SBAR(); }while(0)
  #define VRD(i) do{ vlo[i]=vtr(vp_+(((i)>>2)*4096+((i)&3)*1024)); vhi[i]=vtr(vp_+(((i)>>2)*4096+((i)&3)*1024+512)); }while(0)
  #define KRD(G,j) do{ if(G){ kload2(kf,kp0+sl_next,j); SBAR(); } }while(0)
  #define STEP(C0,C1,P0,P1,t,GK,GV,GL) do{ SBAR(); \
    const lds_cptr vp_=vp0+sl_prev; \
    VRD(0); SBAR(); float sacc=(P0[0]+P0[1]); \
    GAPA(C0=__builtin_amdgcn_mfma_f32_32x32x16_bf16(kf[0],qr[0],negm,0,0,0), P0[2],P0[3],P0[4],P0[5],     pw0[0]=PKW(P0,0), pw0[1]=PKW(P0,2), pw0); \
    VRD(4); SBAR(); GAPA(C1=__builtin_amdgcn_mfma_f32_32x32x16_bf16(kf[1],qr[0],negm,0,0,0), P0[6],P0[7],P0[8],P0[9],     pw0[2]=PKW(P0,4), pw0[3]=PKW(P0,6), pw0); \
    VRD(1); SBAR(); GAPA(C0=__builtin_amdgcn_mfma_f32_32x32x16_bf16(kf[2],qr[1],C0,0,0,0),   P0[10],P0[11],P0[12],P0[13], pw1[0]=PKW(P0,8), pw1[1]=PKW(P0,10), pw1); \
    VRD(5); SBAR(); GAPA(C1=__builtin_amdgcn_mfma_f32_32x32x16_bf16(kf[3],qr[1],C1,0,0,0),   P0[14],P0[15],P1[0],P1[1],   pw1[2]=PKW(P0,12),pw1[3]=PKW(P0,14), pw1); \
    VRD(2); SBAR(); GAPA(C0=__builtin_amdgcn_mfma_f32_32x32x16_bf16(kf[4],qr[2],C0,0,0,0),   P1[2],P1[3],P1[4],P1[5],     pw2[0]=PKW(P1,0), pw2[1]=PKW(P1,2), pw2); \
    VRD(6); SBAR(); GAPA(C1=__builtin_amdgcn_mfma_f32_32x32x16_bf16(kf[5],qr[2],C1,0,0,0),   P1[6],P1[7],P1[8],P1[9],     pw2[2]=PKW(P1,4), pw2[3]=PKW(P1,6), pw2); \
    VRD(3); SBAR(); GAPA(C0=__builtin_amdgcn_mfma_f32_32x32x16_bf16(kf[6],qr[3],C0,0,0,0),   P1[10],P1[11],P1[12],P1[13], pw3[0]=PKW(P1,8), pw3[1]=PKW(P1,10), pw3); \
    VRD(7); SBAR(); GAPA(C1=__builtin_amdgcn_mfma_f32_32x32x16_bf16(kf[7],qr[3],C1,0,0,0),   P1[14],P1[15],0.f,0.f,       pw3[2]=PKW(P1,12),pw3[3]=PKW(P1,14), pw3); \
    l_reg+=sacc; \
    if(GK){DMA_K((t)+3,sl_cur);} if(GV){DMA_V((t)+1,sl_next);} \
    CMASK(C0,C1,t); \
    { float a=MX3(C0[0],C0[1],C1[0]),b=MX3(C0[2],C0[3],C1[1]); a=MX3(a,C1[2],C1[3]); \
      _Pragma("unroll") for(int r=4;r<16;r+=4){a=MX3(a,C0[r],C0[r+1]);b=MX3(b,C0[r+2],C0[r+3]);a=MX3(a,C1[r],C1[r+1]);b=MX3(b,C1[r+2],C1[r+3]);} \
      float rm=__builtin_fmaxf(a,b); { auto rr=__builtin_amdgcn_permlane32_swap(__float_as_uint(rm),__float_as_uint(rm),false,false); rm=__builtin_fmaxf(__uint_as_float(rr[0]),__uint_as_float(rr[1])); } \
      resc=false; \
      if(__builtin_expect(__any(rm>(float)THRL),0)){ const float dl=__builtin_fmaxf(rm,0.f); mhat+=dl; \
        _Pragma("unroll") for(int r=0;r<16;++r){C0[r]-=dl;C1[r]-=dl;} \
        _Pragma("unroll") for(int r=0;r<16;++r)negm[r]=-mhat; asm volatile("":"+v"(negm)); \
        const float f=__builtin_amdgcn_exp2f(-dl); l_reg*=f; if(hi==0)wsf[r32]=f; resc=true; } } \
    SBAR(); \
    GAPB(o[0]=__builtin_amdgcn_mfma_f32_32x32x16_bf16(PAF(0),VFR(0),o[0],0,0,0), C0,0); \
    GAPB(o[1]=__builtin_amdgcn_mfma_f32_32x32x16_bf16(PAF(0),VFR(4),o[1],0,0,0), C0,4); \
    KRD(GL,0); GAPB(o[0]=__builtin_amdgcn_mfma_f32_32x32x16_bf16(PAF(1),VFR(1),o[0],0,0,0), C0,8); \
    KRD(GL,1); GAPB(o[1]=__builtin_amdgcn_mfma_f32_32x32x16_bf16(PAF(1),VFR(5),o[1],0,0,0), C0,12); \
    KRD(GL,2); GAPB(o[0]=__builtin_amdgcn_mfma_f32_32x32x16_bf16(PAF(2),VFR(2),o[0],0,0,0), C1,0); \
    KRD(GL,3); GAPB(o[1]=__builtin_amdgcn_mfma_f32_32x32x16_bf16(PAF(2),VFR(6),o[1],0,0,0), C1,4); \
    GAPB(o[0]=__builtin_amdgcn_mfma_f32_32x32x16_bf16(PAF(3),VFR(3),o[0],0,0,0), C1,8); \
    GAPB(o[1]=__builtin_amdgcn_mfma_f32_32x32x16_bf16(PAF(3),VFR(7),o[1],0,0,0), C1,12); \
    }while(0)
  int t=1;
  #undef CMASK
  #define CMASK(P0,P1,t) do{}while(0)
  for(;t+7<NT;t+=2){
    STEP(pB0,pB1,pA0,pA1,t,true,true,true);     WAIT_BAR(2); RESC(); ROT();
    STEP(pA0,pA1,pB0,pB1,t+1,true,true,true);   WAIT_BAR(2); RESC(); ROT();
  }
  #undef CMASK
  #define CMASK(P0,P1,t) do{int jb_=(t)-(NT-4); if(jb_>=-2){cbias(P0,P1,jb_,qrel,hi,tb); if(jb_>=0)cmask(P0,P1,jb_,qrel,hi);}}while(0)
  #define ENDW(tt) do{ if((tt)+3<NT){WAIT_BAR(2);} else if((tt)+2<NT){WAIT_BAR(1);} else {WAIT_BAR(0);} }while(0)
  for(;t+1<NT;t+=2){
    STEP(pB0,pB1,pA0,pA1,t,(t+3<NT),(t+1<NT),(t+1<NT));       ENDW(t);   RESC(); ROT();
    STEP(pA0,pA1,pB0,pB1,t+1,(t+4<NT),(t+2<NT),(t+2<NT));     ENDW(t+1); RESC(); ROT();
  }
  STEP(pB0,pB1,pA0,pA1,NT-1,false,false,false); RESC();
  { float sacc=pB0[0]+pB0[1]; _Pragma("unroll") for(int r=2;r<16;++r)sacc+=pB0[r]; _Pragma("unroll") for(int r=0;r<16;++r)sacc+=pB1[r]; l_reg+=sacc;
    pw0=(u32x4){PKW(pB0,0),PKW(pB0,2),PKW(pB0,4),PKW(pB0,6)};pw1=(u32x4){PKW(pB0,8),PKW(pB0,10),PKW(pB0,12),PKW(pB0,14)};pw2=(u32x4){PKW(pB1,0),PKW(pB1,2),PKW(pB1,4),PKW(pB1,6)};pw3=(u32x4){PKW(pB1,8),PKW(pB1,10),PKW(pB1,12),PKW(pB1,14)};
    SBAR(); pv(o,vb0+sl_cur,PAF(0),PAF(1),PAF(2),PAF(3)); }
  #undef PKW
  #undef PAF
  #undef VFR
  #undef PIN
  #undef MX3
  #undef GAPA
  #undef GAPB
  #undef EX
  #undef VRD
  #undef KRD
  #undef STEP
  #undef ENDW
  {auto rr=__builtin_amdgcn_permlane32_swap(__float_as_uint(l_reg),__float_as_uint(l_reg),false,false);l_reg=__uint_as_float(rr[0])+__uint_as_float(rr[1]);}
  if(hi==0)wsf[32+r32]=l_reg;asm volatile("s_waitcnt lgkmcnt(0)":::"memory");
  float rli[16];
  #pragma unroll
  for(int r=0;r<16;++r)rli[r]=__builtin_amdgcn_rcpf(wsf[32+crow(r,hi)]);
  bf16*Ow=O+(rowbase+q0+wid*QBLK)*PO+vh*D;
  { bf16*stg=(bf16*)(shm+LDS_OST)+wid*2048;
    #pragma unroll
    for(int r=0;r<16;++r){const int orow=crow(r,hi);
      #pragma unroll
      for(int d0=0;d0<2;++d0)stg[orow*64+d0*32+r32]=__float2bfloat16(o[d0][r]*rli[r]);}
    asm volatile("s_waitcnt lgkmcnt(0)":::"memory");
    #pragma unroll
    for(int i=0;i<4;++i){const int row=i*8+(lane>>3),ch=lane&7; const u32x4 v=*(const u32x4*)(stg+row*64+ch*8); ATTN_STORE16(Ow+(long)row*PO+ch*8,v);} }
  asm volatile("s_waitcnt lgkmcnt(0)\n\ts_barrier":::"memory");
  #undef DMA_K
  #undef DMA_V
  #undef CMASK
  #undef START
  #undef RESC
  #undef ROT
}
constexpr int ATTN_LDS_BYTES=LDS_BYTES;
struct AttnTensors { const bf16* Q; const bf16* K; const bf16* V; bf16* O; };
struct AttnUnit { int bh; int qb; };
__device__ __forceinline__ bool attn_next(int vcu,int i,AttnUnit&u){ if(i>=16)return false; const int s=vcu&7, j=i&3; u.bh=(vcu>>3)+32*(i>>2); u.qb=(j==0)?s:(j==1)?15-s:(j==2)?16+s:31-s; return true; }
template<int THRL=8> __device__ __forceinline__ void attn_phase(char*lds,const AttnTensors&T,int vcu,const __attribute__((address_space(3))) float*tball,const int tid){
  AttnUnit u;
  for(int i=0;attn_next(vcu,i,u);++i){ attn_unit<THRL>(u.bh/NHEAD,u.bh%NHEAD,u.qb,T.Q,T.K,T.V,T.O,lds,tball,tid); }
}
#undef SBAR
#undef WAIT_BAR
}

#define XB_TMO      128
#define XB_XCNT(j)  (256  + 64 * (j))
#define XB_XSUB(j)  (1280 + 64 * (j))
#define XB_XGEN(j)  (2304 + 64 * (j))
#define XB_TOP      3328
#define XB_TOPGEN   3392
#define XCD_BAR_WORDS 3456
#define XB_SPIN_CAP (1u << 18)

__device__ __forceinline__ unsigned xb_ld(unsigned* p)              { return __hip_atomic_load(p, __ATOMIC_RELAXED, __HIP_MEMORY_SCOPE_AGENT); }
__device__ __forceinline__ unsigned xb_add(unsigned* p, unsigned v) { return __hip_atomic_fetch_add(p, v, __ATOMIC_RELAXED, __HIP_MEMORY_SCOPE_AGENT); }
__device__ __forceinline__ unsigned xb_xcc_id() { return (unsigned)__builtin_amdgcn_s_getreg((3 << 11) | 20) & 0xFu; }
#define XB_SPIN(cond, bar) do { unsigned _sp = 0; while (cond) { __builtin_amdgcn_s_sleep(1); \
    if ((++_sp & 255u) == 0u) { if (xb_ld(&(bar)[XB_TMO])) break; if (_sp > XB_SPIN_CAP) { atomicAdd(&(bar)[XB_TMO], 1u); break; } } } } while (0)

struct XcdBarrier {
    unsigned* bar; unsigned x;
    volatile LAS unsigned* st;
};

__device__ __forceinline__ XcdBarrier xcd_barrier_post(unsigned* bar, volatile LAS unsigned* st, const bool leader  ) {
    XcdBarrier b; b.bar = bar; b.x = xb_xcc_id(); b.st = st;
    if (leader) (void)xb_add(&bar[XB_XCNT(b.x)], 1u);
    return b;
}
__device__ __forceinline__ void xcd_barrier_complete(unsigned* bar, unsigned x, unsigned& nloc, unsigned& nx) {
    const unsigned G = gridDim.x * gridDim.y * gridDim.z;
    unsigned sum, cnt, mine, sp = 0u;
    for (;;) {
        sum = 0u; cnt = 0u; mine = 0u;
#pragma unroll
        for (unsigned j = 0; j < 16; ++j) { const unsigned c = xb_ld(&bar[XB_XCNT(j)]); sum += c; cnt += (c > 0u) ? 1u : 0u; mine = (j == x) ? c : mine; }
        if (sum == G) break;
        __builtin_amdgcn_s_sleep(1);
        if ((++sp & 255u) == 0u) { if (xb_ld(&bar[XB_TMO])) break; if (sp > XB_SPIN_CAP) { atomicAdd(&bar[XB_TMO], 1u); break; } }
    }
    nloc = mine > 0u ? mine : 1u; nx = cnt > 0u ? cnt : 1u;
}

__device__ __forceinline__ void xcd_barrier(const XcdBarrier& b, const bool leader  ) {
    asm volatile("s_waitcnt vmcnt(0)" ::: "memory");
    __syncthreads();
    if (leader) {
        unsigned* bar = b.bar;
        __builtin_amdgcn_s_waitcnt(0);
        unsigned nloc = b.st[0], nx = b.st[1];
        if (nloc == 0u) { xcd_barrier_complete(bar, b.x, nloc, nx); b.st[0] = nloc; b.st[1] = nx; }
        const unsigned old = xb_add(&bar[XB_XSUB(b.x)], 1u);
        const unsigned gen = old / nloc;
        if (old + 1u == (gen + 1u) * nloc) {
            __builtin_amdgcn_fence(__ATOMIC_RELEASE, "agent");
            asm volatile("s_waitcnt vmcnt(0)" ::: "memory");
            const unsigned og = xb_add(&bar[XB_TOP], 1u);
            const unsigned tg = og / nx;
            if (og + 1u == (tg + 1u) * nx) xb_add(&bar[XB_TOPGEN], 1u);
            else XB_SPIN(xb_ld(&bar[XB_TOPGEN]) == tg, bar);
            __builtin_amdgcn_fence(__ATOMIC_ACQUIRE, "agent");
            xb_add(&bar[XB_XGEN(b.x)], 1u);
            asm volatile("s_waitcnt vmcnt(0)" ::: "memory");
        } else {
            XB_SPIN(xb_ld(&bar[XB_XGEN(b.x)]) == gen, bar);
            __builtin_amdgcn_fence(__ATOMIC_ACQUIRE, "agent");
            asm volatile("s_waitcnt vmcnt(0)" ::: "memory");
        }
    }
    __syncthreads();
}

constexpr size_t MiB = 1u << 20;
constexpr size_t WS_CTL = 0, CTL_ZERO_BYTES = 1 * MiB;
constexpr size_t WS_WIN = 2 * MiB;
constexpr size_t WS_WOUT = 7 * MiB;
constexpr size_t WS_PGATE = 9 * MiB;
constexpr size_t WS_PPROJ = 13 * MiB;
constexpr size_t WS_RCAT = 14 * MiB;
constexpr size_t WS_RL1 = 20 * MiB;
constexpr size_t WS_RS2 = 28 * MiB;
constexpr size_t WS_RWO = 30 * MiB;
constexpr size_t WS_ROUT = 32 * MiB;
constexpr size_t WS_LRUAGG = 33 * MiB;
constexpr size_t WS_MGU = 38 * MiB;
constexpr size_t WS_MDN = 102 * MiB;
constexpr size_t WS_PB = 134 * MiB;
constexpr size_t WS_ACT = 166 * MiB;
constexpr size_t WS_H0 = WS_ACT;
constexpr size_t WS_QKV = WS_ACT + 128 * MiB;
constexpr size_t WS_O = WS_ACT + 448 * MiB;
constexpr size_t WS_H2 = WS_ACT;
constexpr size_t WS_LOG = WS_ACT + 128 * MiB;
constexpr size_t WS_ROUTE = WS_ACT + 144 * MiB;
constexpr size_t WS_HID = WS_ACT + 152 * MiB;
constexpr size_t WS_YS = WS_ACT + 288 * MiB;
constexpr size_t WS_PP = WS_ACT + 128 * MiB;
constexpr size_t WS_HCAT = WS_ACT;
constexpr size_t WS_XR = WS_ACT + 256 * MiB, WS_XK = WS_ACT + 384 * MiB, WS_XV = WS_ACT + 512 * MiB;
constexpr size_t WS_R = WS_ACT + 640 * MiB, WS_K = WS_XR, WS_V = WS_XK;
constexpr size_t WS_MID = WS_ACT + 768 * MiB;
constexpr size_t WS_EW = WS_ACT;
constexpr size_t WS_AA = WS_ACT + 128 * MiB;
constexpr size_t WS_Y = WS_XV;
constexpr size_t WS_END = WS_ACT + 832 * MiB;
static_assert(WS_END <= 1024 * MiB, "workspace map");
constexpr size_t RT_EID = 0, RT_POS = 1 * MiB, RT_GATE = 2 * MiB, RT_ROWTOK = 3 * MiB, RT_ROWGATE = 4 * MiB, RT_SLOT = 5 * MiB;
constexpr int CW_BAR = 4096;
constexpr int CW_CNT0 = 16384, CW_CNT1 = 16384 + 64;

constexpr int RING_BYTES = 131072;
constexpr int LDSCTL_OFF = RING_BYTES, MISC_OFF = LDSCTL_OFF + 320;
constexpr int TB_OFF = RING_BYTES + 1024;
constexpr int RTE_OFF = TB_OFF + 2048;
constexpr int LDS_BYTES = 147456;

constexpr int NWAVES = 8;
__device__ __forceinline__ int lane_id_() { int l; asm volatile("v_mbcnt_lo_u32_b32 %0, -1, 0\n\tv_mbcnt_hi_u32_b32 %0, -1, %0" : "=v"(l)); return l; }
#define TID_ (F.wave * 64 + lane_id_())
#define LANE_ (lane_id_())
struct Frame {
    LAS unsigned char* lds; volatile LAS unsigned* MISC; gu32* ctl;
    int wave, vcu, G;
};

__device__ __forceinline__ void load_row4(const float* xrow, int lane, f32x4 (&v)[4]) { const f32x4* p = (const f32x4*)xrow + lane;
#pragma unroll
    for (int j = 0; j < 4; ++j) v[j] = p[64 * j]; }
__device__ __forceinline__ float row_rstd(const f32x4 (&v)[4], float eps) { float s = 0.f;
#pragma unroll
    for (int j = 0; j < 4; ++j) s += (v[j].x * v[j].x + v[j].y * v[j].y) + (v[j].z * v[j].z + v[j].w * v[j].w);
    return 1.0f / sqrtf(wave_sum(s) * (1.0f / 1024.0f) + eps); }
__device__ __forceinline__ void store_row_bf16(bf16* orow, int lane, const f32x4 (&v)[4], float rstd, const float* g) {
    unsigned long long* o8 = (unsigned long long*)orow + lane;
#pragma unroll
    for (int j = 0; j < 4; ++j) { const f32x4 gg = ((const f32x4*)g)[lane + 64 * j];
        o8[64 * j] = (unsigned long long)pk2(v[j].x * rstd * gg.x, v[j].y * rstd * gg.y) | ((unsigned long long)pk2(v[j].z * rstd * gg.z, v[j].w * rstd * gg.w) << 32); }
}

template <int MODE>
__device__ __forceinline__ void transpose_item(const float* W, int K, int N, bf16* WT, int ldo, int row_off, const float* mu, LAS float* scr, int item, int lane) {
    const int nblk = N / 32, kb = item / nblk, nb = item % nblk, k0 = 64 * kb, n0 = 32 * nb;
    float ld[32];
#pragma unroll
    for (int i = 0; i < 32; ++i) { const int kk = 2 * i + (lane >> 5); ld[i] = W[(size_t)(k0 + kk) * N + n0 + (lane & 31)]; }
#pragma unroll
    for (int i = 0; i < 32; ++i) { const int kk = 2 * i + (lane >> 5); scr[kk * 33 + (lane & 31)] = ld[i]; }
    LDS_WAIT(); asm volatile("" ::: "memory");
    const int c = lane & 7;
    int rbase = row_off + n0;
    if (MODE == 2) { rbase = row_off + ((n0 < 512) ? ((n0 >> 7) * 256 + (n0 & 127)) : (((n0 - 512) >> 7) * 256 + 128 + ((n0 - 512) & 127))); }
    float m[8];
    if (MODE == 1) {
#pragma unroll
        for (int e = 0; e < 8; ++e) m[e] = mu[k0 + 8 * c + e]; }
#pragma unroll
    for (int j = 0; j < 4; ++j) { const int n = (lane >> 3) + 8 * j; const LAS float* s = scr + (8 * c) * 33 + n;
        float v[8];
#pragma unroll
        for (int e = 0; e < 8; ++e) v[e] = s[e * 33];
        bf16* dst = WT + (size_t)(rbase + n) * ldo + k0 + 8 * c;
        if (MODE == 1) {
            v4u o, o2;
            o.x = pk2(v[0] * (1.f - m[0]), v[1] * (1.f - m[1])); o.y = pk2(v[2] * (1.f - m[2]), v[3] * (1.f - m[3])); o.z = pk2(v[4] * (1.f - m[4]), v[5] * (1.f - m[5])); o.w = pk2(v[6] * (1.f - m[6]), v[7] * (1.f - m[7]));
            o2.x = pk2(v[0] * m[0], v[1] * m[1]); o2.y = pk2(v[2] * m[2], v[3] * m[3]); o2.z = pk2(v[4] * m[4], v[5] * m[5]); o2.w = pk2(v[6] * m[6], v[7] * m[7]);
            *(GAS v4u*)dst = o; *(GAS v4u*)(dst + 1024) = o2;
        } else {
            v4u o; o.x = pk2(v[0], v[1]); o.y = pk2(v[2], v[3]); o.z = pk2(v[4], v[5]); o.w = pk2(v[6], v[7]);
            *(GAS v4u*)dst = o; }
    }
    LDS_WAIT(); asm volatile("" ::: "memory");
}

struct In {
    const float *x, *p, *rel_bias, *norm_mix, *ab_w_in, *ab_w_out, *lam_q1, *lam_k1, *lam_q2, *lam_k2, *sub_g, *conv_w, *conv_b, *lru_wa, *lru_ba, *lru_wx, *lru_bx, *lru_lambda,
        *rwkv_mu, *rwkv_wr, *rwkv_wk, *rwkv_wv, *rwkv_wo, *rwkv_w0, *rwkv_w1, *rwkv_w2, *rwkv_a0, *rwkv_a1, *rwkv_a2, *rwkv_g1, *rwkv_g2, *rwkv_kk, *rwkv_ka, *rwkv_rk, *rwkv_ln_g, *rwkv_ln_b,
        *norm_ffn, *moe_wc, *moe_bc, *moe_wf, *moe_bf, *moe_w_gu, *moe_w_down, *ple_norm, *ple_gate, *ple_proj, *final_norm;
};

__device__ __forceinline__ void prep_dense_weights(Frame& F, const In& I, unsigned char* ws) {
    LAS float* scr = (LAS float*)(F.lds + F.wave * 16384);
    const int gw = F.vcu * NWAVES + F.wave, NGW = F.G * NWAVES;
    bf16* WIN = (bf16*)(ws + WS_WIN); bf16* WOUT = (bf16*)(ws + WS_WOUT); bf16* PG = (bf16*)(ws + WS_PGATE); bf16* PPJ = (bf16*)(ws + WS_PPROJ);
    bf16* RCAT = (bf16*)(ws + WS_RCAT); bf16* RL1 = (bf16*)(ws + WS_RL1); bf16* RWO = (bf16*)(ws + WS_RWO);
    constexpr int I_IN = (1024 / 64) * (2560 / 32), I_SQ = (1024 / 64) * (1024 / 32), I_PJ = (256 / 64) * (1024 / 32), I_L64 = (1024 / 64) * (64 / 32), I_L160 = (1024 / 64) * (160 / 32);
    int st = gw;
#define TJOB(MODE, NITEMS, W, K, N, WT, LDO, ROFF, MU) do { for (int it = st; it < (NITEMS); it += NGW) transpose_item<MODE>(W, K, N, WT, LDO, ROFF, MU, scr, it, LANE_); \
        st = (st + NGW - ((NITEMS) % NGW)) % NGW; asm volatile("" : "+s"(st)); } while (0)
    TJOB(0, I_IN, I.ab_w_in, 1024, 2560, WIN, 1024, 0, nullptr);
    TJOB(0, I_SQ, I.ab_w_out, 1024, 1024, WOUT, 1024, 0, nullptr);
    TJOB(0, I_SQ, I.ple_gate, 1024, 1024, PG, 1024, 0, nullptr);
    TJOB(0, I_SQ, I.ple_gate + 1024 * 1024, 1024, 1024, PG + 1024 * 1024, 1024, 0, nullptr);
    TJOB(0, I_SQ, I.rwkv_wo, 1024, 1024, RWO, 1024, 0, nullptr);
    TJOB(0, I_SQ, I.rwkv_wr, 1024, 1024, RCAT, 1024, 0, nullptr);
    TJOB(0, I_SQ, I.rwkv_wk, 1024, 1024, RCAT, 1024, 1024, nullptr);
    TJOB(0, I_SQ, I.rwkv_wv, 1024, 1024, RCAT, 1024, 2048, nullptr);
    TJOB(0, I_PJ, I.ple_proj, 256, 1024, PPJ, 256, 0, nullptr);
    TJOB(0, I_PJ, I.ple_proj + 256 * 1024, 256, 1024, PPJ + 1024 * 256, 256, 0, nullptr);
    TJOB(1, I_L64, I.rwkv_w1, 1024, 64, RL1, 2048, 0, I.rwkv_mu + 1 * 1024);
    TJOB(1, I_L64, I.rwkv_a1, 1024, 64, RL1, 2048, 64, I.rwkv_mu + 4 * 1024);
    TJOB(1, I_L160, I.rwkv_g1, 1024, 160, RL1, 2048, 256, I.rwkv_mu + 5 * 1024);
#undef TJOB
    const int gt = F.vcu * 512 + TID_, NGT = F.G * 512;
    { v4u z = {0u, 0u, 0u, 0u}; const int per_row = 2048 / 8;
      for (int i = gt; i < (128 + 96) * per_row; i += NGT) { int rr = i / per_row, cc = i % per_row; rr = (rr < 128) ? (128 + rr) : (416 + rr - 128); *(GAS v4u*)(RL1 + (size_t)rr * 2048 + cc * 8) = z; } }
    { bf16* S2 = (bf16*)(ws + WS_RS2);
      for (int i = gt; i < 3 * 1024 * 256; i += NGT) { const int ty = i / (1024 * 256), n = (i / 256) & 1023, k = i & 255; float v = 0.f;
          if (ty == 0) { if (k < 64) v = I.rwkv_w2[k * 1024 + n]; } else if (ty == 1) { if (k >= 64 && k < 128) v = I.rwkv_a2[(k - 64) * 1024 + n]; } else { if (k < 160) v = I.rwkv_g2[k * 1024 + n]; }
          S2[i] = (bf16)f2bf(v); } }
    { bf16* RT = (bf16*)(ws + WS_ROUT);
      for (int i = gt; i < 2 * 256 * 1024; i += NGT) { const int l = i / (256 * 1024), n = (i / 1024) & 255, k = i & 1023; float v = 0.f;
          if (n < 4) v = I.moe_wc[(size_t)l * 1024 * 4 + k * 4 + n]; else if (n < 36) v = I.moe_wf[(size_t)l * 1024 * 32 + k * 32 + (n - 4)];
          RT[i] = (bf16)f2bf(v); } }
}
__device__ __forceinline__ void prep_layer_weights(Frame& F, const In& I, unsigned char* ws, int layer) {
    LAS float* scr = (LAS float*)(F.lds + F.wave * 16384);
    const int gw = F.vcu * NWAVES + F.wave, NGW = F.G * NWAVES;
    bf16* MGU = (bf16*)(ws + WS_MGU); bf16* MDN = (bf16*)(ws + WS_MDN);
    const float* wgu = I.moe_w_gu + (size_t)layer * NEXP * 1024 * 1024; const float* wdn = I.moe_w_down + (size_t)layer * NEXP * 512 * 1024;
    constexpr int I_GU = (1024 / 64) * (1024 / 32), I_DN = (512 / 64) * (1024 / 32);
    for (int it = gw; it < NEXP * (I_GU + I_DN); it += NGW) {
        const int e = it / (I_GU + I_DN); int r = it % (I_GU + I_DN);
        if (r < I_GU) transpose_item<2>(wgu + (size_t)e * 1024 * 1024, 1024, 1024, MGU + (size_t)e * 1024 * 1024, 1024, 0, nullptr, scr, r, LANE_);
        else transpose_item<0>(wdn + (size_t)e * 512 * 1024, 512, 1024, MDN + (size_t)e * 1024 * 512, 512, 0, nullptr, scr, r - I_GU, LANE_);
    }
    const int gt = F.vcu * 512 + TID_, NGT = F.G * 512;
    const f32x4* ps = (const f32x4*)(I.p + (size_t)layer * T * PLE); v2u* pd = (v2u*)(ws + WS_PB);
    for (int i = gt; i < T * PLE / 4; i += 4 * NGT) { f32x4 v[4];
#pragma unroll
        for (int r = 0; r < 4; ++r) v[r] = ps[i + r * NGT];
#pragma unroll
        for (int r = 0; r < 4; ++r) { v2u o; o.x = pk2(v[r].x, v[r].y); o.y = pk2(v[r].z, v[r].w); pd[i + r * NGT] = o; } }
}

template <int MODE>
__device__ __forceinline__ void norm_pass(Frame& F, const float* x, const float* g, bf16* out) {
    const int gw = F.vcu * NWAVES + F.wave, NGW = F.G * NWAVES; const int lane = LANE_;
    for (int t = 4 * gw; t < T; t += 4 * NGW) {
        f32x4 v[4][4];
#pragma unroll
        for (int r = 0; r < 4; ++r) load_row4(x + (size_t)(t + r) * D, lane, v[r]);
#pragma unroll
        for (int r = 0; r < 4; ++r) { const float rs = row_rstd(v[r], 1e-6f); store_row_bf16(out + (size_t)(t + r) * D, lane, v[r], rs, g); }
    }
}
__device__ __forceinline__ void rwkv_input_pass(Frame& F, const float* x, const float* g, const float* mu, bf16* HCAT, bf16* XR, bf16* XK, bf16* XV) {
    const int gw = F.vcu * NWAVES + F.wave, NGW = F.G * NWAVES; const int lane = LANE_;
    f32x4 gg[4], mr[4], mk[4], mv[4];
#pragma unroll
    for (int j = 0; j < 4; ++j) { gg[j] = ((const f32x4*)g)[lane + 64 * j]; mr[j] = ((const f32x4*)(mu + 0 * 1024))[lane + 64 * j]; mk[j] = ((const f32x4*)(mu + 2 * 1024))[lane + 64 * j]; mv[j] = ((const f32x4*)(mu + 3 * 1024))[lane + 64 * j]; }
    for (int blk = gw; blk < T / 32; blk += NGW) {
        const int t0 = blk * 32; f32x4 hp[4];
        if ((t0 & (SEQ - 1)) == 0) {
#pragma unroll
            for (int j = 0; j < 4; ++j) hp[j] = (f32x4){0.f, 0.f, 0.f, 0.f};
        } else { f32x4 v[4]; load_row4(x + (size_t)(t0 - 1) * D, lane, v); const float rstd = row_rstd(v, 1e-6f);
#pragma unroll
            for (int j = 0; j < 4; ++j) hp[j] = v[j] * rstd * gg[j]; }
        f32x4 vn[4]; load_row4(x + (size_t)t0 * D, lane, vn);
        for (int t = t0; t < t0 + 32; ++t) {
            f32x4 v[4];
#pragma unroll
            for (int j = 0; j < 4; ++j) v[j] = vn[j];
            if (t + 1 < t0 + 32) load_row4(x + (size_t)(t + 1) * D, lane, vn);
            const float rstd = row_rstd(v, 1e-6f);
            unsigned long long* oh = (unsigned long long*)(HCAT + (size_t)t * 2048) + lane; unsigned long long* or_ = (unsigned long long*)(XR + (size_t)t * 1024) + lane;
            unsigned long long* ok = (unsigned long long*)(XK + (size_t)t * 1024) + lane; unsigned long long* ov = (unsigned long long*)(XV + (size_t)t * 1024) + lane;
#pragma unroll
            for (int j = 0; j < 4; ++j) { const f32x4 h = v[j] * rstd * gg[j], dd = hp[j] - h;
                oh[64 * j] = (unsigned long long)pk2(h.x, h.y) | ((unsigned long long)pk2(h.z, h.w) << 32);
                oh[256 + 64 * j] = (unsigned long long)pk2(hp[j].x, hp[j].y) | ((unsigned long long)pk2(hp[j].z, hp[j].w) << 32);
                const f32x4 a = h + dd * mr[j], b = h + dd * mk[j], c = h + dd * mv[j];
                or_[64 * j] = (unsigned long long)pk2(a.x, a.y) | ((unsigned long long)pk2(a.z, a.w) << 32);
                ok[64 * j] = (unsigned long long)pk2(b.x, b.y) | ((unsigned long long)pk2(b.z, b.w) << 32);
                ov[64 * j] = (unsigned long long)pk2(c.x, c.y) | ((unsigned long long)pk2(c.z, c.w) << 32);
                hp[j] = h; }
        }
    }
}
__device__ __forceinline__ void combine_norm_pass(Frame& F, const float* xin, float* xout, const bf16* YS, const int* slot, const float* g, bf16* out) {
    const int gw = F.vcu * NWAVES + F.wave, NGW = F.G * NWAVES; const int lane = LANE_;
    for (int t = 2 * gw; t < T; t += 2 * NGW) {
        f32x4 v[2][4]; v2u ya[2][4], yb[2][4];
#pragma unroll
        for (int r = 0; r < 2; ++r) { load_row4(xin + (size_t)(t + r) * D, lane, v[r]);
            const int s0 = slot[2 * (t + r)], s1 = slot[2 * (t + r) + 1];
            const v2u* y0 = (const v2u*)(YS + (size_t)s0 * D) + lane; const v2u* y1 = (const v2u*)(YS + (size_t)s1 * D) + lane;
#pragma unroll
            for (int j = 0; j < 4; ++j) { ya[r][j] = y0[64 * j]; yb[r][j] = y1[64 * j]; } }
#pragma unroll
        for (int r = 0; r < 2; ++r) {
#pragma unroll
            for (int j = 0; j < 4; ++j) { const v2u a = ya[r][j], b = yb[r][j];
                v[r][j].x += bflo(a.x) + bflo(b.x); v[r][j].y += bfhi(a.x) + bfhi(b.x); v[r][j].z += bflo(a.y) + bflo(b.y); v[r][j].w += bfhi(a.y) + bfhi(b.y); }
            f32x4* xo = (f32x4*)(xout + (size_t)(t + r) * D) + lane;
#pragma unroll
            for (int j = 0; j < 4; ++j) xo[64 * j] = v[r][j];
            const float rstd = row_rstd(v[r], 1e-6f);
            store_row_bf16(out + (size_t)(t + r) * D, lane, v[r], rstd, g); }
    }
}
__device__ __forceinline__ void final_norm_pass(Frame& F, float* x, const float* g) {
    const int gw = F.vcu * NWAVES + F.wave, NGW = F.G * NWAVES; const int lane = LANE_;
    for (int t = 4 * gw; t < T; t += 4 * NGW) {
        f32x4 v[4][4];
#pragma unroll
        for (int r = 0; r < 4; ++r) load_row4(x + (size_t)(t + r) * D, lane, v[r]);
#pragma unroll
        for (int r = 0; r < 4; ++r) { const float rs = row_rstd(v[r], 1e-6f); f32x4* xo = (f32x4*)(x + (size_t)(t + r) * D) + lane;
#pragma unroll
            for (int j = 0; j < 4; ++j) { const f32x4 gg = ((const f32x4*)g)[lane + 64 * j]; xo[64 * j] = v[r][j] * rs * gg; } }
    }
}

__device__ __forceinline__ void diff_combine_pass(Frame& F, const In& I, const bf16* O, bf16* YCAT) {
    const int gw = F.vcu * NWAVES + F.wave, NGW = F.G * NWAVES;
    const float lam_init = 0.2f;
    const float d1 = wave_sum(I.lam_q1[LANE_] * I.lam_k1[LANE_]), d2 = wave_sum(I.lam_q2[LANE_] * I.lam_k2[LANE_]);
    const float lam = expf(d1) - expf(d2) + lam_init;
    const int h = LANE_ >> 4, q = LANE_ & 15;
    float sg[8];
#pragma unroll
    for (int e = 0; e < 8; ++e) sg[e] = I.sub_g[q * 8 + e] * (1.0f - lam_init);
    for (int t0 = 4 * gw; t0 < T; t0 += 4 * NGW) {
        v4u av[4], bv[4];
#pragma unroll
        for (int r = 0; r < 4; ++r) { av[r] = *(const v4u*)(O + (size_t)(t0 + r) * 1024 + h * 256 + q * 8); bv[r] = *(const v4u*)(O + (size_t)(t0 + r) * 1024 + h * 256 + 128 + q * 8); }
#pragma unroll
        for (int r = 0; r < 4; ++r) { const v4u a = av[r], b = bv[r]; const int t = t0 + r;
        float o[8];
        o[0] = bflo(a.x) - lam * bflo(b.x); o[1] = bfhi(a.x) - lam * bfhi(b.x); o[2] = bflo(a.y) - lam * bflo(b.y); o[3] = bfhi(a.y) - lam * bfhi(b.y);
        o[4] = bflo(a.z) - lam * bflo(b.z); o[5] = bfhi(a.z) - lam * bfhi(b.z); o[6] = bflo(a.w) - lam * bflo(b.w); o[7] = bfhi(a.w) - lam * bfhi(b.w);
        float s = 0.f;
#pragma unroll
        for (int e = 0; e < 8; ++e) s += o[e] * o[e];
        s += __shfl_xor(s, 1); s += __shfl_xor(s, 2); s += __shfl_xor(s, 4); s += __shfl_xor(s, 8);
        const float rstd = 1.0f / sqrtf(s * (1.0f / 128.0f) + 1e-5f);
        v4u w; w.x = pk2(o[0] * rstd * sg[0], o[1] * rstd * sg[1]); w.y = pk2(o[2] * rstd * sg[2], o[3] * rstd * sg[3]); w.z = pk2(o[4] * rstd * sg[4], o[5] * rstd * sg[5]); w.w = pk2(o[6] * rstd * sg[6], o[7] * rstd * sg[7]);
        *(v4u*)(YCAT + (size_t)t * 1024 + h * 128 + q * 8) = w; }
    }
}

constexpr int LCT = 64, LNCH = SEQ / LCT;
__device__ __forceinline__ float gelu_tanh(float x) { const float u = 0.7978845608028654f * (x + 0.044715f * x * x * x); return x * sigmoidf_(2.0f * u); }
template <bool FINAL>
__device__ __forceinline__ void lru_phase(Frame& F, const In& I, const bf16* XB, const bf16* GB, f32x2* AGG, bf16* YCAT) {
    const int ch = TID_, n = ch >> 6, d = ch & 63;
    LAS float* U = (LAS float*)F.lds;
    f32x2 wg[64];
#pragma unroll
    for (int c = 0; c < 64; ++c) { wg[c].x = I.lru_wa[n * 4096 + c * 64 + d]; wg[c].y = I.lru_wx[n * 4096 + c * 64 + d]; }
    const float cw0 = I.conv_w[0 * 512 + ch], cw1 = I.conv_w[1 * 512 + ch], cw2 = I.conv_w[2 * 512 + ch], cw3 = I.conv_w[3 * 512 + ch], cb = I.conv_b[ch];
    const float ba = I.lru_ba[ch], bx = I.lru_bx[ch];
    const float lam = I.lru_lambda[ch]; const float sp = (lam > 15.f) ? expf(-lam) : log1pf(expf(-lam));
    const float m8sp = -8.0f * sp;
    for (int un = blockIdx.x; un < NB * LNCH; un += F.G) {
        const int b = un / LNCH, c = un % LNCH; const size_t row0 = (size_t)b * SEQ + (size_t)c * LCT;
        unsigned short xraw[LCT + 3];
        if (c > 0) { xraw[0] = XB[(row0 - 3) * 512 + ch]; xraw[1] = XB[(row0 - 2) * 512 + ch]; xraw[2] = XB[(row0 - 1) * 512 + ch]; } else { xraw[0] = 0; xraw[1] = 0; xraw[2] = 0; }
#pragma unroll
        for (int tk = 0; tk < LCT; ++tk) xraw[3 + tk] = XB[(row0 + tk) * 512 + ch];
        float h = 0.f, Ap = 1.f;
        if (FINAL) { for (int j = 0; j < c; ++j) { const f32x2 ag = AGG[((size_t)b * LNCH + j) * 512 + ch]; h = ag.x * h + ag.y; } }
#pragma unroll
        for (int tk = 0; tk < LCT; ++tk) U[tk * 512 + ch] = cw0 * bf1(xraw[tk]) + cw1 * bf1(xraw[tk + 1]) + cw2 * bf1(xraw[tk + 2]) + cw3 * bf1(xraw[tk + 3]) + cb;
        __syncthreads();
        unsigned short gcur[8], gnxt[8];
        if (FINAL) {
#pragma unroll
            for (int j = 0; j < 8; ++j) gcur[j] = GB[(row0 + j) * 512 + ch]; }
#pragma unroll 1
        for (int tg = 0; tg < LCT / 8; ++tg) {
            if (FINAL) { const int tn = (tg + 1 < LCT / 8) ? (tg + 1) * 8 : tg * 8;
#pragma unroll
                for (int j = 0; j < 8; ++j) gnxt[j] = GB[(row0 + tn + j) * 512 + ch]; }
#pragma unroll
            for (int j = 0; j < 8; ++j) { const int tk = tg * 8 + j;
                const LAS f32x4* up = (const LAS f32x4*)(U + tk * 512 + n * 64);
                f32x2 acc = {ba, bx};
#pragma unroll
                for (int c4 = 0; c4 < 16; ++c4) { const f32x4 uu = up[c4];
                    acc += wg[4 * c4 + 0] * uu.x; acc += wg[4 * c4 + 1] * uu.y; acc += wg[4 * c4 + 2] * uu.z; acc += wg[4 * c4 + 3] * uu.w; }
                const float r = sigmoidf_(acc.x), ig = sigmoidf_(acc.y);
                const float la = r * m8sp; const float a = __expf(la); const float t2 = 2.0f * la; const float om = (t2 > -0.02f) ? -t2 * (1.0f + t2 * (0.5f + t2 * (0.16666667f + t2 * 0.041666668f))) : 1.0f - a * a; const float bb = __builtin_amdgcn_sqrtf(om) * (ig * U[tk * 512 + ch]);
                h = a * h + bb;
                if (FINAL) { YCAT[(row0 + tk) * 1024 + 512 + ch] = (bf16)f2bf(h * gelu_tanh(bf1(gcur[j]))); }
                else Ap *= a; }
            if (FINAL) {
#pragma unroll
                for (int j = 0; j < 8; ++j) gcur[j] = gnxt[j]; }
        }
        if (!FINAL) { f32x2 ag; ag.x = Ap; ag.y = h; AGG[((size_t)b * LNCH + c) * 512 + ch] = ag; }
        __syncthreads();
    }
}

__device__ __forceinline__ void route_pass_a(Frame& F, const In& I, int layer, const float* LOG, unsigned char* rt, gu32* cnt) {
    LAS int* lcnt = (LAS int*)(F.lds + RTE_OFF); LAS int* lbase = lcnt + 32;
    int* EID = (int*)(rt + RT_EID); int* POS = (int*)(rt + RT_POS); float* GATE = (float*)(rt + RT_GATE);
    const float* bc = I.moe_bc + layer * 4; const float* bfb = I.moe_bf + layer * 32;
    for (int un = blockIdx.x; un < T / 512; un += F.G) {
        if (TID_ < 32) lcnt[TID_] = 0;
        __syncthreads();
        const int t = un * 512 + TID_; const float* lg = LOG + (size_t)t * 64;
        const f32x4 g4 = *(const f32x4*)lg;
        float gl[4] = {g4.x + bc[0], g4.y + bc[1], g4.z + bc[2], g4.w + bc[3]};
        int gi = 0; float gm = gl[0];
#pragma unroll
        for (int j = 1; j < 4; ++j) if (gl[j] > gm) { gm = gl[j]; gi = j; }
        float gs = 0.f;
#pragma unroll
        for (int j = 0; j < 4; ++j) gs += __expf(gl[j] - gm);
        const float gprob = 1.0f / gs;
        const f32x4 e0 = *(const f32x4*)(lg + 4 + gi * 8), e1 = *(const f32x4*)(lg + 8 + gi * 8);
        float el[8] = {e0.x, e0.y, e0.z, e0.w, e1.x, e1.y, e1.z, e1.w};
#pragma unroll
        for (int j = 0; j < 8; ++j) el[j] += bfb[gi * 8 + j];
        int i0 = 0; float m0 = el[0];
#pragma unroll
        for (int j = 1; j < 8; ++j) if (el[j] > m0) { m0 = el[j]; i0 = j; }
        int i1 = -1; float m1 = -INFINITY;
#pragma unroll
        for (int j = 0; j < 8; ++j) if (j != i0 && el[j] > m1) { m1 = el[j]; i1 = j; }
        const float r1 = __expf(m1 - m0); const float g0 = gprob / (1.0f + r1), g1 = gprob * r1 / (1.0f + r1);
        const int ex0 = gi * 8 + i0, ex1 = gi * 8 + i1;
        const int p0 = atomicAdd((int*)&lcnt[ex0], 1), p1 = atomicAdd((int*)&lcnt[ex1], 1);
        __syncthreads();
        if (TID_ < 32) lbase[TID_] = (int)__hip_atomic_fetch_add(cnt + TID_, (unsigned)lcnt[TID_], RLX_AGENT);
        __syncthreads();
        EID[2 * t] = ex0; EID[2 * t + 1] = ex1; POS[2 * t] = lbase[ex0] + p0; POS[2 * t + 1] = lbase[ex1] + p1; GATE[2 * t] = g0; GATE[2 * t + 1] = g1;
        __syncthreads();
    }
}
__device__ __forceinline__ void route_bases(Frame& F, gu32* cnt) {
    LAS int* eb = (LAS int*)(F.lds + RTE_OFF + 512);
    const int tid = TID_;
    if (tid < 64) {
        const int c = (tid < 32) ? (int)__hip_atomic_load(cnt + (tid & 31), RLX_AGENT) : 0; const int p = (c + 255) & ~255; int s = p;
#pragma unroll
        for (int o = 1; o < 32; o <<= 1) { const int t = __shfl_up(s, o); if ((tid & 63) >= o) s += t; }
        if (tid < 32) { eb[tid] = s - p; if (tid == 31) eb[32] = s; }
    }
    __syncthreads();
}
__device__ __forceinline__ void route_pass_b(Frame& F, unsigned char* rt, gu32* cnt) {
    route_bases(F, cnt);
    LAS int* eb = (LAS int*)(F.lds + RTE_OFF + 512);
    const int* EID = (const int*)(rt + RT_EID); const int* POS = (const int*)(rt + RT_POS); const float* GATE = (const float*)(rt + RT_GATE);
    int* ROWTOK = (int*)(rt + RT_ROWTOK); float* ROWGATE = (float*)(rt + RT_ROWGATE); int* SLOT = (int*)(rt + RT_SLOT);
    const int gt = F.vcu * 512 + TID_, NGT = F.G * 512;
    for (int i = gt; i < 2 * T; i += NGT) { const int dst = eb[EID[i]] + POS[i]; ROWTOK[dst] = i >> 1; ROWGATE[dst] = GATE[i]; SLOT[i] = dst; }
    for (int i = gt; i < 32 * 256; i += NGT) { const int e = i >> 8, j = i & 255; const int c = (int)__hip_atomic_load(cnt + e, RLX_AGENT); const int pad = ((c + 255) & ~255) - c;
        if (j < pad) { ROWTOK[eb[e] + c + j] = 0; ROWGATE[eb[e] + c + j] = 0.f; } }
    __syncthreads();
}
struct MoeOrder {
    int G, c, ntiles; const LAS int* eb; const char* A; const char* W; size_t astep, wexp, wtile; bool gather;
    __device__ bool next(int i, pg8::Unit& u) const {
        const int L = i * G + c; if (L >= ntiles * 4) return false;
        u.pm = L >> 2; u.pn = L & 3; const int s0 = u.pm * 256; int e = 0;
#pragma unroll 1
        for (int j = 1; j < 32; ++j) if (eb[j] <= s0) e = j;
        e = __builtin_amdgcn_readfirstlane(e); u.aux = e; u.A = gather ? A : A + (size_t)u.pm * astep; u.B = W + (size_t)e * wexp + (size_t)u.pn * wtile; return true;
    }
};

constexpr int RTC = 32, RNCH = SEQ / RTC, RTOK = 352;
#define LBAR() do { asm volatile("s_waitcnt lgkmcnt(0)" ::: "memory"); __builtin_amdgcn_s_barrier(); asm volatile("" ::: "memory"); } while (0)
template <int CTRL> __device__ __forceinline__ float dpp_f(float v) { return __builtin_bit_cast(float, __builtin_amdgcn_update_dpp(0, __builtin_bit_cast(int, v), CTRL, 0xf, 0xf, true)); }
__device__ __forceinline__ float red16(float v) { v += dpp_f<0xB1>(v); v += dpp_f<0x4E>(v); v += dpp_f<0x141>(v); v += dpp_f<0x140>(v); return v; }
__device__ __forceinline__ float red8(float v) { v += dpp_f<0xB1>(v); v += dpp_f<0x4E>(v); v += dpp_f<0x141>(v); return v; }
__device__ __forceinline__ void unpack8(const v4u w, float (&f)[8]) { f[0] = bflo(w.x); f[1] = bfhi(w.x); f[2] = bflo(w.y); f[3] = bfhi(w.y); f[4] = bflo(w.z); f[5] = bfhi(w.z); f[6] = bflo(w.w); f[7] = bfhi(w.w); }
__device__ __forceinline__ void rwkv_scan_phase(Frame& F, const In& I, const bf16* R, const bf16* Kt, const bf16* V, const bf16* AA, const bf16* EW, bf16* Y) {
    LAS float* buf = (LAS float*)F.lds;
    LAS float* ybuf = (LAS float*)(F.lds + 2 * RTC * RTOK * 4) + 32;
    const int tid = TID_, lane = tid & 63;
    const int seg = lane & 15, rl = F.wave * 4 + (lane >> 4);
    const int stk = tid >> 4, ssg = tid & 15;
    for (int un = blockIdx.x; un < NB * 16 * 2; un += F.G) {
        const int half = un & 1, h = (un >> 1) & 15, b = un >> 5;
        const size_t rowb = (size_t)b * SEQ;
        const int col = h * 64 + ssg * 4;
        const f32x4 kkw = *(const f32x4*)(I.rwkv_kk + col), kaw = *(const f32x4*)(I.rwkv_ka + col);
        v2u rr, kr, vr, ar, er;
#define RAW_LOAD(cc) do { const size_t off = (rowb + (size_t)(cc) * RTC + stk) * 1024 + col; rr = *(const v2u*)(R + off); kr = *(const v2u*)(Kt + off); vr = *(const v2u*)(V + off); ar = *(const v2u*)(AA + off); er = *(const v2u*)(EW + off); } while (0)
#define RAW_CONVERT(cc) do { LAS float* tp = buf + ((cc) & 1) * (RTC * RTOK) + stk * RTOK + ssg * 4; \
            const float r0 = bflo(rr.x), r1 = bfhi(rr.x), r2 = bflo(rr.y), r3 = bfhi(rr.y), k0 = bflo(kr.x), k1 = bfhi(kr.x), k2 = bflo(kr.y), k3 = bfhi(kr.y); \
            const float a0 = bflo(ar.x), a1 = bfhi(ar.x), a2 = bflo(ar.y), a3 = bfhi(ar.y); \
            const float x0 = k0 * kkw.x, x1 = k1 * kkw.y, x2 = k2 * kkw.z, x3 = k3 * kkw.w; \
            const float ss = red16((x0 * x0 + x1 * x1) + (x2 * x2 + x3 * x3)); const float inv = __builtin_amdgcn_rsqf(fmaxf(ss, 1e-24f)); \
            *(LAS f32x4*)(tp) = (f32x4){__expf(-bflo(er.x)), __expf(-bfhi(er.x)), __expf(-bflo(er.y)), __expf(-bfhi(er.y))}; \
            const f32x4 kkv = (f32x4){x0 * inv, x1 * inv, x2 * inv, x3 * inv}; *(LAS f32x4*)(tp + 64) = kkv; \
            *(LAS f32x4*)(tp + 128) = (f32x4){kkv.x * a0, kkv.y * a1, kkv.z * a2, kkv.w * a3}; \
            *(LAS f32x4*)(tp + 192) = (f32x4){k0 * (1.0f + (a0 - 1.0f) * kaw.x), k1 * (1.0f + (a1 - 1.0f) * kaw.y), k2 * (1.0f + (a2 - 1.0f) * kaw.z), k3 * (1.0f + (a3 - 1.0f) * kaw.w)}; \
            *(LAS f32x4*)(tp + 256) = (f32x4){r0, r1, r2, r3}; \
            if ((ssg >> 3) == half) *(LAS f32x4*)(buf + ((cc) & 1) * (RTC * RTOK) + stk * RTOK + 320 + (ssg & 7) * 4) = (f32x4){bflo(vr.x), bfhi(vr.x), bflo(vr.y), bfhi(vr.y)}; } while (0)
#define Y_WRITE(cc) do { const LAS f32x2* yp = (const LAS f32x2*)(ybuf + ((cc) & 1) * (RTC * 32 + 32) + stk * 32 + ssg * 2); const f32x2 yv = *yp; \
            *(unsigned*)(Y + (rowb + (size_t)(cc) * RTC + stk) * 1024 + h * 64 + half * 32 + ssg * 2) = pk2(yv.x, yv.y); } while (0)
        RAW_LOAD(0); RAW_CONVERT(0); RAW_LOAD(1);
        f32x2 S0 = (f32x2){0.f, 0.f}, S1 = (f32x2){0.f, 0.f};
        LBAR();
        for (int c = 0; c < RNCH; ++c) {
            if (c + 1 < RNCH) { RAW_CONVERT(c + 1); }
            if (c + 2 < RNCH) { RAW_LOAD(c + 2); }
            if (c >= 1) { Y_WRITE(c - 1); }
            const LAS float* cb = buf + (c & 1) * (RTC * RTOK); LAS float* yb = ybuf + (c & 1) * (RTC * 32 + 32);
            const LAS float* tp0 = cb + seg * 4; const LAS float* vp0 = cb + 320 + rl;
#define SV_DECL(X) f32x4 X##w, X##q, X##b, X##k, X##r; float X##v
#define SV_LOAD(X, tk) do { const LAS float* tp = tp0 + (tk) * RTOK; \
                X##w = *(const LAS f32x4*)(tp); X##q = *(const LAS f32x4*)(tp + 64); X##b = *(const LAS f32x4*)(tp + 128); X##k = *(const LAS f32x4*)(tp + 192); X##r = *(const LAS f32x4*)(tp + 256); X##v = vp0[(tk) * RTOK]; } while (0)
#define SV_STEP(X, tk) do { \
                const f32x2 d = S0 * (f32x2){X##q.x, X##q.y} + S1 * (f32x2){X##q.z, X##q.w}; \
                const f32x2 t0 = S0 * (f32x2){X##w.x, X##w.y} + (f32x2){X##k.x, X##k.y} * X##v, t1 = S1 * (f32x2){X##w.z, X##w.w} + (f32x2){X##k.z, X##k.w} * X##v; \
                float ra = d.x + d.y, rb = epend;                   \
                ra += dpp_f<0xB1>(ra); rb += dpp_f<0xB1>(rb); ra += dpp_f<0x4E>(ra); rb += dpp_f<0x4E>(rb); ra += dpp_f<0x141>(ra); rb += dpp_f<0x141>(rb); ra += dpp_f<0x140>(ra); rb += dpp_f<0x140>(rb); \
                if (seg == 0) yb[((tk) - 1) * 32 + rl] = rb;        \
                const float sa = -ra; \
                S0 = t0 + (f32x2){X##b.x, X##b.y} * sa; S1 = t1 + (f32x2){X##b.z, X##b.w} * sa; \
                const f32x2 e = S0 * (f32x2){X##r.x, X##r.y} + S1 * (f32x2){X##r.z, X##r.w}; epend = e.x + e.y; } while (0)
            SV_DECL(A_); SV_DECL(B_); float epend = 0.f;
            SV_LOAD(A_, 0);
#pragma unroll 1
            for (int tk = 0; tk < RTC; tk += 2) {
                SV_LOAD(B_, tk + 1);
                SV_STEP(A_, tk);
                { const int t2 = (tk + 2 < RTC) ? tk + 2 : RTC - 1; SV_LOAD(A_, t2); }
                SV_STEP(B_, tk + 1);
            }
#undef SV_DECL
#undef SV_LOAD
#undef SV_STEP
            { const float rb = red16(epend); if (seg == 0) yb[(RTC - 1) * 32 + rl] = rb; }
            LBAR();
        }
        Y_WRITE(RNCH - 1);
        LBAR();
#undef RAW_LOAD
#undef RAW_CONVERT
#undef Y_WRITE
    }
}
__device__ __forceinline__ void rwkv_post_pass(Frame& F, const In& I, const bf16* R, const bf16* Kt, const bf16* V, const bf16* AA, const bf16* G, bf16* Y) {
    const int gw = F.vcu * NWAVES + F.wave, NGW = F.G * NWAVES; const int col = LANE_ * 16;
    for (int t0 = 2 * gw; t0 < T; t0 += 2 * NGW) {
        v4u py[2][2], pr[2][2], pk[2][2], pv[2][2], pa[2][2], pg[2][2];
#pragma unroll
        for (int rw = 0; rw < 2; ++rw) { const size_t off = (size_t)(t0 + rw) * 1024 + col;
#pragma unroll
            for (int hf = 0; hf < 2; ++hf) { py[rw][hf] = *(const v4u*)(Y + off + hf * 8); pr[rw][hf] = *(const v4u*)(R + off + hf * 8); pk[rw][hf] = *(const v4u*)(Kt + off + hf * 8);
                pv[rw][hf] = *(const v4u*)(V + off + hf * 8); pa[rw][hf] = *(const v4u*)(AA + off + hf * 8); pg[rw][hf] = *(const v4u*)(G + off + hf * 8); } }
#pragma unroll
        for (int rw = 0; rw < 2; ++rw) { const size_t off = (size_t)(t0 + rw) * 1024 + col;
            float kaw[16], rkw[16], lng[16], lnb[16];
#pragma unroll
            for (int e4 = 0; e4 < 4; ++e4) { const f32x4 c0 = *(const GAS f32x4*)(I.rwkv_ka + col + 4 * e4), c1 = *(const GAS f32x4*)(I.rwkv_rk + col + 4 * e4), c2 = *(const GAS f32x4*)(I.rwkv_ln_g + col + 4 * e4), c3 = *(const GAS f32x4*)(I.rwkv_ln_b + col + 4 * e4);
#pragma unroll
                for (int e = 0; e < 4; ++e) { kaw[4 * e4 + e] = c0[e]; rkw[4 * e4 + e] = c1[e]; lng[4 * e4 + e] = c2[e]; lnb[4 * e4 + e] = c3[e]; } }
            float y[16], r[16], k[16], v[16], a[16], g[16];
#pragma unroll
            for (int hf = 0; hf < 2; ++hf) { float t8[8];
                unpack8(py[rw][hf], t8);
#pragma unroll
                for (int e = 0; e < 8; ++e) y[hf * 8 + e] = t8[e];
                unpack8(pr[rw][hf], t8);
#pragma unroll
                for (int e = 0; e < 8; ++e) r[hf * 8 + e] = t8[e];
                unpack8(pk[rw][hf], t8);
#pragma unroll
                for (int e = 0; e < 8; ++e) k[hf * 8 + e] = t8[e];
                unpack8(pv[rw][hf], t8);
#pragma unroll
                for (int e = 0; e < 8; ++e) v[hf * 8 + e] = t8[e];
                unpack8(pa[rw][hf], t8);
#pragma unroll
                for (int e = 0; e < 8; ++e) a[hf * 8 + e] = t8[e];
                unpack8(pg[rw][hf], t8);
#pragma unroll
                for (int e = 0; e < 8; ++e) g[hf * 8 + e] = t8[e]; }
            float s = 0.f, bs = 0.f;
#pragma unroll
            for (int e = 0; e < 16; ++e) { s += y[e]; const float kp = k[e] * (1.0f + (a[e] - 1.0f) * kaw[e]); bs += r[e] * kp * rkw[e]; }
            s += __shfl_xor(s, 1); s += __shfl_xor(s, 2); bs += __shfl_xor(bs, 1); bs += __shfl_xor(bs, 2);
            const float mean = s * (1.0f / 64.0f); float q = 0.f;
#pragma unroll
            for (int e = 0; e < 16; ++e) { const float dd = y[e] - mean; q += dd * dd; }
            q += __shfl_xor(q, 1); q += __shfl_xor(q, 2);
            const float rstd = 1.0f / sqrtf(q * (1.0f / 64.0f) + 64e-5f);
            float o[16];
#pragma unroll
            for (int e = 0; e < 16; ++e) o[e] = ((y[e] - mean) * rstd * lng[e] + lnb[e] + bs * v[e]) * g[e];
            v4u w0, w1; w0.x = pk2(o[0], o[1]); w0.y = pk2(o[2], o[3]); w0.z = pk2(o[4], o[5]); w0.w = pk2(o[6], o[7]); w1.x = pk2(o[8], o[9]); w1.y = pk2(o[10], o[11]); w1.z = pk2(o[12], o[13]); w1.w = pk2(o[14], o[15]);
            *(v4u*)(Y + off) = w0; *(v4u*)(Y + off + 8) = w1; }
    }
}

#ifndef DUP_K
#define DUP_K (-1)
#endif
#ifndef DUP_K2
#define DUP_K2 (-1)
#endif
#define KARGS ((const __attribute__((address_space(4))) Args*)__builtin_amdgcn_kernarg_segment_ptr())
#define WSPTRS \
    bf16* H0 = (bf16*)(ws + WS_H0); bf16* QKV = (bf16*)(ws + WS_QKV); bf16* OB = (bf16*)(ws + WS_O); f32x2* AGG = (f32x2*)(ws + WS_LRUAGG); \
    bf16* H2 = (bf16*)(ws + WS_H2); float* LOG = (float*)(ws + WS_LOG); unsigned char* RTE = ws + WS_ROUTE; bf16* HID = (bf16*)(ws + WS_HID); bf16* YS = (bf16*)(ws + WS_YS); bf16* PP = (bf16*)(ws + WS_PP); \
    bf16* HCAT = (bf16*)(ws + WS_HCAT); bf16* RB = (bf16*)(ws + WS_R); bf16* KB = (bf16*)(ws + WS_K); bf16* VB = (bf16*)(ws + WS_V); bf16* XRB = (bf16*)(ws + WS_XR); bf16* XKB = (bf16*)(ws + WS_XK); bf16* XVB = (bf16*)(ws + WS_XV); bf16* MID = (bf16*)(ws + WS_MID); bf16* EWB = (bf16*)(ws + WS_EW); bf16* AAB = (bf16*)(ws + WS_AA); bf16* YB = (bf16*)(ws + WS_Y); \
    const size_t TD = (size_t)T * 1024; (void)H0; (void)QKV; (void)OB; (void)AGG; (void)H2; (void)LOG; (void)RTE; (void)HID; (void)YS; (void)PP; (void)HCAT; (void)RB; (void)KB; (void)VB; (void)XRB; (void)XKB; (void)XVB; (void)MID; (void)EWB; (void)AAB; (void)YB; (void)TD;

struct Args { In in; float* out; unsigned char* ws; int ph_lo, ph_hi; };
constexpr int N_PHASES = 34;
__device__ __forceinline__ int nrep(int k) { int n = (k == DUP_K) ? 2 : 1; if (DUP_K >= 0) asm volatile("" : "+s"(n)); return n; }
#define REP_SYNC if (rep_) __syncthreads();
typedef const __attribute__((address_space(4))) unsigned long long* kp64;
__device__ __forceinline__ void load_in(In& I) { kp64 s = (kp64)__builtin_amdgcn_kernarg_segment_ptr(); unsigned long long* d = (unsigned long long*)&I;
#pragma unroll
    for (int i = 0; i < 47; ++i) d[i] = s[i]; }

__device__ __forceinline__ int t5_bucket(int n) { if (n < 16) return n; const float v = logf((float)n / 16.0f) / 2.0794415416798357f * 16.0f; const int l = 16 + (int)v; return l < 31 ? l : 31; }

template <class Epi>
__device__ __forceinline__ void dense_gemm(Frame& F, const void* A, int lda, const void* B, int K, int M, int N, const Epi& E) {
    pg8::DenseOrder S; S.init(A, lda, B, K, M, N, F.G, (int)blockIdx.x);
    pg8::gemm_phase<Epi, pg8::DenseOrder, true, false>(F.lds, K, lda, S, E, nullptr, TID_);
}

__global__ void __launch_bounds__(NWAVES * 64, 2) mk_fwd(Args args) {
    extern __shared__ __attribute__((aligned(16))) unsigned char lds[];
    Frame F;
    F.lds = (LAS unsigned char*)lds;
    F.MISC = (volatile LAS unsigned*)(F.lds + MISC_OFF);
    { int w_ = __builtin_amdgcn_readfirstlane((int)threadIdx.x >> 6); asm volatile("" : "+s"(w_)); F.wave = w_; }
    F.G = gridDim.x; { const int bx = blockIdx.x; F.vcu = (F.G % 8 == 0) ? (bx % 8) * (F.G / 8) + bx / 8 : bx; }
    F.ctl = (gu32*)(KARGS->ws + WS_CTL);
    for (int u = TID_; u < (LDS_BYTES - LDSCTL_OFF) / 4; u += NWAVES * 64) ((LAS unsigned*)(F.lds + LDSCTL_OFF))[u] = 0u;
    __syncthreads();
    {
        LAS float* tb = (LAS float*)(F.lds + TB_OFF); const int h = TID_ >> 7, i = TID_ & 127;
        const float* rb = KARGS->in.rel_bias;
        tb[h * 128 + i] = (rb[t5_bucket(i) * 4 + h] - rb[31 * 4 + h]) * 1.4426950408889634f;
    }
    __syncthreads();
    const int lo = KARGS->ph_lo, hi = KARGS->ph_hi;
    const bool multi = (hi - lo) > 1;
    XcdBarrier bar; bar.bar = (unsigned*)(F.ctl + CW_BAR); bar.x = 0; bar.st = nullptr;
    if (multi) bar = xcd_barrier_post((unsigned*)(F.ctl + CW_BAR), F.MISC + 8, TID_ == 0);
#define IN(k) (lo <= (k) && (k) < hi)
#define PH_BEGIN_ unsigned char* ws = KARGS->ws; float* X = KARGS->out; In I; load_in(I); (void)X; WSPTRS
#define SEAM(k) do { if (IN(k) && IN((k) + 1)) xcd_barrier(bar, TID_ == 0); } while (0)

    if (IN(0)) { PH_BEGIN_ prep_dense_weights(F, I, ws); prep_layer_weights(F, I, ws, 0); norm_pass<0>(F, I.x, I.norm_mix, H0);
#ifdef DUP_PREP
        __syncthreads(); prep_dense_weights(F, I, ws); prep_layer_weights(F, I, ws, 0);
#endif
    } SEAM(0);
    if (IN(1)) { PH_BEGIN_ pg8::EpiBf16 E{QKV, 512, 512, (size_t)T * 512, attn_body::C2}; dense_gemm(F, H0, 1024, ws + WS_WIN, 1024, T, AB_IN, E); } SEAM(1);
    if (IN(2)) { PH_BEGIN_ lru_phase<false>(F, I, QKV + 3 * (size_t)T * 512, QKV + 4 * (size_t)T * 512, AGG, H0); } SEAM(2);
    if (IN(3)) { PH_BEGIN_
        const attn_body::AttnTensors AT{(const attn_body::bf16*)QKV, (const attn_body::bf16*)(QKV + (size_t)T * 512), (const attn_body::bf16*)(QKV + 2 * (size_t)T * 512), (attn_body::bf16*)OB};
        if (F.G == 256) attn_body::attn_phase<8>((char*)lds, AT, F.vcu, (const LAS float*)(F.lds + TB_OFF), (int)threadIdx.x);
#ifdef DUP_ATTN
        __syncthreads(); if (F.G == 256) attn_body::attn_phase<8>((char*)lds, AT, F.vcu, (const LAS float*)(F.lds + TB_OFF), (int)threadIdx.x);
#endif
        __syncthreads();
        lru_phase<true>(F, I, QKV + 3 * (size_t)T * 512, QKV + 4 * (size_t)T * 512, AGG, H0);
    } SEAM(3);
    if (IN(4)) { PH_BEGIN_ diff_combine_pass(F, I, OB, H0); } SEAM(4);
    if (IN(5)) { PH_BEGIN_ pg8::EpiResF32 E{I.x, X}; dense_gemm(F, H0, 1024, ws + WS_WOUT, 1024, T, 1024, E); } SEAM(5);

#define MOE_PLE_PHASES(P, L) \
    if (IN(P + 0)) { PH_BEGIN_ norm_pass<0>(F, X, I.norm_ffn + (L) * 1024, H2); } SEAM(P + 0); \
    if (IN(P + 1)) { PH_BEGIN_ pg8::EpiRouter E{LOG}; dense_gemm(F, H2, 1024, ws + WS_ROUT + (size_t)(L) * 256 * 1024 * 2, 1024, T, 256, E); } SEAM(P + 1); \
    if (IN(P + 2)) { PH_BEGIN_ route_pass_a(F, I, (L), LOG, RTE, F.ctl + ((L) ? CW_CNT1 : CW_CNT0)); } SEAM(P + 2); \
    if (IN(P + 3)) { PH_BEGIN_ route_pass_b(F, RTE, F.ctl + ((L) ? CW_CNT1 : CW_CNT0)); } SEAM(P + 3); \
    if (IN(P + 4)) { PH_BEGIN_ route_bases(F, F.ctl + ((L) ? CW_CNT1 : CW_CNT0)); const LAS int* eb = (const LAS int*)(F.lds + RTE_OFF + 512); \
        MoeOrder S{F.G, (int)blockIdx.x, __builtin_amdgcn_readfirstlane(eb[32] >> 8), eb, (const char*)H2, (const char*)(ws + WS_MGU), 0, (size_t)1024 * 1024 * 2, (size_t)256 * 1024 * 2, true}; pg8::EpiGU E{HID}; \
        pg8::gemm_phase<pg8::EpiGU, MoeOrder, true, true>(F.lds, 1024, 1024, S, E, (const int*)(RTE + RT_ROWTOK), TID_); } SEAM(P + 4); \
    if (IN(P + 5)) { PH_BEGIN_ route_bases(F, F.ctl + ((L) ? CW_CNT1 : CW_CNT0)); const LAS int* eb = (const LAS int*)(F.lds + RTE_OFF + 512); \
        MoeOrder S{F.G, (int)blockIdx.x, __builtin_amdgcn_readfirstlane(eb[32] >> 8), eb, (const char*)HID, (const char*)(ws + WS_MDN), (size_t)256 * 512 * 2, (size_t)1024 * 512 * 2, (size_t)256 * 512 * 2, false}; pg8::EpiDown E{YS, (const float*)(RTE + RT_ROWGATE)}; \
        pg8::gemm_phase<pg8::EpiDown, MoeOrder, true, false>(F.lds, 512, 512, S, E, nullptr, TID_); } SEAM(P + 5); \
    if (IN(P + 6)) { PH_BEGIN_ combine_norm_pass(F, X, X, YS, (const int*)(RTE + RT_SLOT), I.ple_norm + (L) * 1024, H2); } SEAM(P + 6); \
    if (IN(P + 7)) { PH_BEGIN_ pg8::EpiBf16 E{PP, 1024, 0, 0, 1.f}; dense_gemm(F, ws + WS_PB, 256, ws + WS_PPROJ + (size_t)(L) * 1024 * 256 * 2, 256, T, 1024, E); } SEAM(P + 7); \
    if (IN(P + 8)) { PH_BEGIN_ pg8::EpiPle E{X, PP}; dense_gemm(F, H2, 1024, ws + WS_PGATE + (size_t)(L) * 1024 * 1024 * 2, 1024, T, 1024, E); } SEAM(P + 8);

    MOE_PLE_PHASES(6, 0)
    if (IN(15)) { PH_BEGIN_ rwkv_input_pass(F, X, I.norm_mix + 1024, I.rwkv_mu, HCAT, XRB, XKB, XVB); prep_layer_weights(F, I, ws, 1); } SEAM(15);
    if (IN(16)) { PH_BEGIN_ { pg8::EpiBf16 E{RB, 1024, 0, 0, 1.f}; dense_gemm(F, XRB, 1024, ws + WS_RCAT, 1024, T, 1024, E); }
        { pg8::EpiMid E{MID}; dense_gemm(F, HCAT, 2048, ws + WS_RL1, 2048, T, 512, E); } } SEAM(16);
    if (IN(17)) { PH_BEGIN_ pg8::EpiBf16 E{KB, 1024, 0, 0, 1.f}; dense_gemm(F, XKB, 1024, ws + WS_RCAT + (size_t)1024 * 1024 * 2, 1024, T, 1024, E); } SEAM(17);
    if (IN(18)) { PH_BEGIN_ pg8::EpiBf16 E{VB, 1024, 0, 0, 1.f}; dense_gemm(F, XVB, 1024, ws + WS_RCAT + (size_t)2 * 1024 * 1024 * 2, 1024, T, 1024, E); } SEAM(18);
    if (IN(19)) { PH_BEGIN_ pg8::EpiRwkv2 E{EWB, AAB, I.rwkv_w0, I.rwkv_a0, 0}; dense_gemm(F, MID, 512, ws + WS_RS2, 256, T, 2048, E); } SEAM(19);
    if (IN(20)) { PH_BEGIN_ rwkv_scan_phase(F, I, RB, KB, VB, AAB, EWB, YB); } SEAM(20);
    if (IN(21)) { PH_BEGIN_ pg8::EpiRwkv2 E{EWB, EWB, nullptr, nullptr, 2}; dense_gemm(F, MID + 256, 512, ws + WS_RS2 + (size_t)2 * 1024 * 256 * 2, 256, T, 1024, E); } SEAM(21);
    if (IN(22)) { PH_BEGIN_ rwkv_post_pass(F, I, RB, KB, VB, AAB, EWB, YB); } SEAM(22);
    if (IN(23)) { PH_BEGIN_ pg8::EpiResF32 E{X, X}; dense_gemm(F, YB, 1024, ws + WS_RWO, 1024, T, 1024, E); } SEAM(23);
    MOE_PLE_PHASES(24, 1)
    if (IN(33)) { PH_BEGIN_ final_norm_pass(F, X, I.final_norm); }
#undef IN
#undef SEAM
}

extern "C" void kernel_launch(void* const* d_in, const int* in_sizes, int n_in, void* d_out, int out_size, void* d_ws, size_t ws_size, hipStream_t stream) {
    static int ok = 0;
    if (ok == 0) {
        if (n_in != 47 || out_size != T * D || ws_size < WS_END) { fprintf(stderr, "kernel_launch: unexpected problem shape (n_in %d out %d ws %zu)\n", n_in, out_size, ws_size); ok = -1; return; }
        if (hipFuncSetAttribute((const void*)mk_fwd, hipFuncAttributeMaxDynamicSharedMemorySize, LDS_BYTES) != hipSuccess) { fprintf(stderr, "kernel_launch: hipFuncSetAttribute failed\n"); ok = -1; return; }
        int per_cu = 0;
        if (hipOccupancyMaxActiveBlocksPerMultiprocessor(&per_cu, (const void*)mk_fwd, NWAVES * 64, LDS_BYTES) != hipSuccess || per_cu < 1) fprintf(stderr, "kernel_launch: occupancy query reports %d\n", per_cu);
        (void)hipGetLastError();
        ok = 1;
    }
    if (ok < 0) return;
    (void)hipMemsetAsync((char*)d_ws + WS_CTL, 0, CTL_ZERO_BYTES, stream);
    Args a{};
    const float** ip = (const float**)&a.in;
    for (int i = 0; i < 47; ++i) ip[i] = (const float*)d_in[i];
    a.out = (float*)d_out; a.ws = (unsigned char*)d_ws;
    const int grid = 256;
#if MK_ONE_LAUNCH
    a.ph_lo = 0; a.ph_hi = N_PHASES;
    hipLaunchKernelGGL(mk_fwd, dim3(grid), dim3(NWAVES * 64), LDS_BYTES, stream, a);
#else
    for (int k = 0; k < N_PHASES; ++k) { a.ph_lo = k; a.ph_hi = k + 1; hipLaunchKernelGGL(mk_fwd, dim3(grid), dim3(NWAVES * 64), LDS_BYTES, stream, a);
        if (k == DUP_K || k == DUP_K2) hipLaunchKernelGGL(mk_fwd, dim3(grid), dim3(NWAVES * 64), LDS_BYTES, stream, a); }
#endif
}
```

```cpp
#include <hip/hip_runtime.h>
#include <hip/hip_bf16.h>
#include <cstdio>
#include <cstdint>
#include <cmath>

#ifndef MK_ONE_LAUNCH
#define MK_ONE_LAUNCH 1
#endif

#define GAS __attribute__((address_space(1)))
#define LAS __attribute__((address_space(3)))
typedef unsigned short bf16;
typedef unsigned v4u __attribute__((ext_vector_type(4)));
typedef unsigned v2u __attribute__((ext_vector_type(2)));
typedef float f32x4 __attribute__((ext_vector_type(4)));
typedef float f32x2 __attribute__((ext_vector_type(2)));
typedef short bf16x8 __attribute__((ext_vector_type(8)));
typedef GAS unsigned gu32;
#define RLX_AGENT __ATOMIC_RELAXED, __HIP_MEMORY_SCOPE_AGENT
#define LDS_WAIT() asm volatile("s_waitcnt lgkmcnt(0)" ::: "memory")
#define VM_WAIT() asm volatile("s_waitcnt vmcnt(0)" ::: "memory")
__device__ __forceinline__ unsigned f2bf(float f) { unsigned u = __builtin_bit_cast(unsigned, f); return (u + 0x7fffu + ((u >> 16) & 1u)) >> 16; }
__device__ __forceinline__ unsigned pk2(float lo, float hi) { unsigned r; asm("v_cvt_pk_bf16_f32 %0, %1, %2" : "=v"(r) : "v"(lo), "v"(hi)); return r; }
__device__ __forceinline__ float bflo(unsigned w) { return __uint_as_float(w << 16); }
__device__ __forceinline__ float bfhi(unsigned w) { return __uint_as_float(w & 0xffff0000u); }
__device__ __forceinline__ float bf1(bf16 h) { return __uint_as_float((unsigned)h << 16); }
__device__ __forceinline__ float sigmoidf_(float x) { return __builtin_amdgcn_rcpf(1.0f + __builtin_amdgcn_exp2f(-1.4426950408889634f * x)); }
__device__ __forceinline__ float tanhf_(float x) { return 1.0f - 2.0f * __builtin_amdgcn_rcpf(1.0f + __builtin_amdgcn_exp2f(2.885390081777927f * x)); }
__device__ __forceinline__ void fmac_(float& acc, float a, float b) { asm("v_fmac_f32 %0, %1, %2" : "+v"(acc) : "v"(a), "v"(b)); }
__device__ __forceinline__ float fma_(float a, float b, float c) { float r; asm("v_fma_f32 %0, %1, %2, %3" : "=v"(r) : "v"(a), "v"(b), "v"(c)); return r; }
__device__ __forceinline__ float mul_(float a, float b) { float r; asm("v_mul_f32 %0, %1, %2" : "=v"(r) : "v"(a), "v"(b)); return r; }
__device__ __forceinline__ float wave_sum(float v) {
#pragma unroll
    for (int o = 1; o < 64; o <<= 1) v += __shfl_xor(v, o);
    return v;
}

constexpr int NB = 8, SEQ = 8192, D = 1024, T = NB * SEQ;
constexpr int AB_IN = 2560, PLE = 256;
constexpr int NEXP = 32, EH = 512;
constexpr int MAXSLOT = 2 * T + NEXP * 256;
constexpr int MAXTILES = MAXSLOT / 256;

namespace pg8 {
#define PG8_LAS __attribute__((address_space(3)))
typedef unsigned short bf16_t;
typedef unsigned u32x4 __attribute__((ext_vector_type(4)));
typedef unsigned u32x2 __attribute__((ext_vector_type(2)));
constexpr int BM = 256, BK = 64, HALF = 128, HTB = HALF * BK * 2, STAGE_BYTES = 8 * HTB, NXCD = 8, WGM = 8;
__host__ __device__ __forceinline__ int lds_byte(int r, int c) { const int st = (r >> 4) * 2 + (c >> 5), rr = r & 15, cc = c & 31, ob = rr * 64 + cc * 2; return st * 1024 + (ob ^ (((ob >> 9) & 1) << 5)); }
__host__ __device__ __forceinline__ void stage_rc(int b, int& R, int& C) { const int st = b / 1024, sb = b % 1024, swz = sb ^ (((sb >> 9) & 1) << 5); R = (st >> 1) * 16 + swz / 64; C = (st & 1) * 32 + (swz % 64) / 2; }
__host__ __device__ __forceinline__ int perm32(int rho) { const int n = rho >> 4, i = rho & 15; return 8 * (i >> 2) + 4 * n + (i & 3); }

struct Unit { int pm, pn, aux; const char* A; const char* B; };

struct DenseOrder {
    int nM, nN, nwg, G, c; const char* A; const char* B; size_t astep, bstep;
    __device__ void init(const void* A_, int lda, const void* B_, int K, int M, int N, int G_, int c_) { nM = M / BM; nN = N / BM; nwg = nM * nN; G = G_; c = c_; A = (const char*)A_; B = (const char*)B_; astep = (size_t)BM * lda * 2; bstep = (size_t)BM * K * 2; }
    __device__ bool next(int i, Unit& u) const {
        const long L = (long)i * G + c; if (L >= nwg) return false;
        int wgid = (int)L; { const int q = nwg / NXCD, r = nwg % NXCD, xcd = wgid % NXCD, off = wgid / NXCD; wgid = (xcd < r ? xcd * (q + 1) : r * (q + 1) + (xcd - r) * q) + off; }
        const int nig = WGM * nN, gid = wgid / nig, fm = gid * WGM, gsz = (nM - fm) < WGM ? (nM - fm) : WGM;
        u.pm = fm + ((wgid % nig) % gsz); u.pn = (wgid % nig) / gsz; u.aux = 0; u.A = A + (size_t)u.pm * astep; u.B = B + (size_t)u.pn * bstep; return true;
    }
};

__device__ __forceinline__ unsigned cvt_pk_bf16(float lo, float hi) { unsigned r; asm volatile("v_cvt_pk_bf16_f32 %0, %1, %2" : "=v"(r) : "v"(lo), "v"(hi)); return r; }

typedef f32x4 Acc[2][2][4][2];

struct EpiBf16 {
    static constexpr bool PERM = true;
    bf16_t* O; int ldc; int split_cols; size_t split_stride; float scale0;
    __device__ __forceinline__ void operator()(const Acc& acc, const Unit& u, int wr, int wc, int fr, int fq) const {
        const int row0 = u.pm * BM + wr * 64 + fr; int colt = u.pn * BM; bf16_t* base = O;
        float sc = 1.f; if (split_cols) { const int t = colt / split_cols; base += (size_t)t * split_stride; colt -= t * split_cols; if (t == 0) sc = scale0; }
        const int col0 = colt + wc * 32 + 8 * fq;
#pragma unroll
        for (int ai = 0; ai < 2; ++ai)
#pragma unroll
            for (int m = 0; m < 4; ++m) { bf16_t* rowp = base + (size_t)(row0 + ai * HALF + m * 16) * ldc + col0;
#pragma unroll
                for (int bj = 0; bj < 2; ++bj) { f32x4 v0 = acc[ai][bj][m][0] * sc, v1 = acc[ai][bj][m][1] * sc;
                    u32x4 w; w.x = cvt_pk_bf16(v0[0], v0[1]); w.y = cvt_pk_bf16(v0[2], v0[3]); w.z = cvt_pk_bf16(v1[0], v1[1]); w.w = cvt_pk_bf16(v1[2], v1[3]);
                    *(u32x4*)(rowp + bj * HALF) = w; } }
    }
};
__device__ __forceinline__ void unpack8f(const u32x4 w, f32x4& lo, f32x4& hi) { lo = (f32x4){bflo(w.x), bfhi(w.x), bflo(w.y), bfhi(w.y)}; hi = (f32x4){bflo(w.z), bfhi(w.z), bflo(w.w), bfhi(w.w)}; }
template <bool BASE_BF16>
struct EpiResX {
    static constexpr bool PERM = true;
    const void* base; bf16_t* out;
    __device__ __forceinline__ void operator()(const Acc& acc, const Unit& u, int wr, int wc, int fr, int fq) const {
        const int col0 = u.pn * BM + wc * 32 + 8 * fq; GAS bf16_t* op = (GAS bf16_t*)out;
#pragma unroll
        for (int ai = 0; ai < 2; ++ai) {
            f32x4 b0[4][2], b1[4][2];
#pragma unroll
            for (int m = 0; m < 4; ++m) { const size_t off = (size_t)(u.pm * BM + ai * HALF + wr * 64 + m * 16 + fr) * 1024 + col0;
#pragma unroll
                for (int bj = 0; bj < 2; ++bj) {
                    if (BASE_BF16) { const u32x4 w = *(const GAS u32x4*)((const GAS bf16_t*)base + off + bj * HALF); unpack8f(w, b0[m][bj], b1[m][bj]); }
                    else { b0[m][bj] = *(const GAS f32x4*)((const GAS float*)base + off + bj * HALF); b1[m][bj] = *(const GAS f32x4*)((const GAS float*)base + off + bj * HALF + 4); } } }
            asm volatile("" ::: "memory");
#pragma unroll
            for (int m = 0; m < 4; ++m) { const size_t off = (size_t)(u.pm * BM + ai * HALF + wr * 64 + m * 16 + fr) * 1024 + col0;
#pragma unroll
                for (int bj = 0; bj < 2; ++bj) { const f32x4 v0 = b0[m][bj] + acc[ai][bj][m][0], v1 = b1[m][bj] + acc[ai][bj][m][1];
                    u32x4 w; w.x = cvt_pk_bf16(v0[0], v0[1]); w.y = cvt_pk_bf16(v0[2], v0[3]); w.z = cvt_pk_bf16(v1[0], v1[1]); w.w = cvt_pk_bf16(v1[2], v1[3]);
                    *(GAS u32x4*)(op + off + bj * HALF) = w; } }
            asm volatile("" ::: "memory");
        }
    }
};
struct EpiRouter {
    static constexpr bool PERM = false;
    float* out;
    __device__ __forceinline__ void operator()(const Acc& acc, const Unit& u, int wr, int wc, int fr, int fq) const {
        if (wc >= 2) return;
#pragma unroll
        for (int ai = 0; ai < 2; ++ai)
#pragma unroll
            for (int m = 0; m < 4; ++m) { const size_t off = (size_t)(u.pm * BM + ai * HALF + wr * 64 + m * 16 + fr) * 64 + wc * 32 + 4 * fq;
#pragma unroll
                for (int n = 0; n < 2; ++n) *(f32x4*)(out + off + n * 16) = acc[ai][0][m][n]; }
    }
};
struct EpiGU {
    static constexpr bool PERM = true;
    bf16_t* H;
    __device__ __forceinline__ void operator()(const Acc& acc, const Unit& u, int wr, int wc, int fr, int fq) const {
        const int col0 = u.pn * 128 + wc * 32 + 8 * fq;
#pragma unroll
        for (int ai = 0; ai < 2; ++ai)
#pragma unroll
            for (int m = 0; m < 4; ++m) { bf16_t* rowp = H + (size_t)(u.pm * BM + ai * HALF + wr * 64 + m * 16 + fr) * EH + col0;
                f32x4 g0 = acc[ai][0][m][0], g1 = acc[ai][0][m][1]; const f32x4 u0 = acc[ai][1][m][0], u1 = acc[ai][1][m][1];
#pragma unroll
                for (int e = 0; e < 4; ++e) { g0[e] = g0[e] * sigmoidf_(g0[e]) * u0[e]; g1[e] = g1[e] * sigmoidf_(g1[e]) * u1[e]; }
                u32x4 w; w.x = cvt_pk_bf16(g0[0], g0[1]); w.y = cvt_pk_bf16(g0[2], g0[3]); w.z = cvt_pk_bf16(g1[0], g1[1]); w.w = cvt_pk_bf16(g1[2], g1[3]);
                *(u32x4*)rowp = w; }
    }
};
struct EpiDown {
    static constexpr bool PERM = true;
    bf16_t* Y; const float* gate;
    __device__ __forceinline__ void operator()(const Acc& acc, const Unit& u, int wr, int wc, int fr, int fq) const {
        const int col0 = u.pn * BM + wc * 32 + 8 * fq;
#pragma unroll
        for (int ai = 0; ai < 2; ++ai)
#pragma unroll
            for (int m = 0; m < 4; ++m) { const int row = u.pm * BM + ai * HALF + wr * 64 + m * 16 + fr; const float sc = gate[row]; bf16_t* rowp = Y + (size_t)row * 1024 + col0;
#pragma unroll
                for (int bj = 0; bj < 2; ++bj) { const f32x4 v0 = acc[ai][bj][m][0] * sc, v1 = acc[ai][bj][m][1] * sc;
                    u32x4 w; w.x = cvt_pk_bf16(v0[0], v0[1]); w.y = cvt_pk_bf16(v0[2], v0[3]); w.z = cvt_pk_bf16(v1[0], v1[1]); w.w = cvt_pk_bf16(v1[2], v1[3]);
                    *(u32x4*)(rowp + bj * HALF) = w; } }
    }
};
struct EpiPle {
    static constexpr bool PERM = true;
    const bf16_t* xin; bf16_t* xout; const bf16_t* pp;
    __device__ __forceinline__ void operator()(const Acc& acc, const Unit& u, int wr, int wc, int fr, int fq) const {
        const int col0 = u.pn * BM + wc * 32 + 8 * fq;
        const GAS bf16_t* xp = (const GAS bf16_t*)xin; GAS bf16_t* op = (GAS bf16_t*)xout; const GAS bf16_t* pq = (const GAS bf16_t*)pp;
#pragma unroll
        for (int ai = 0; ai < 2; ++ai) {
            u32x4 xw[4][2], pw[4][2];
#pragma unroll
            for (int m = 0; m < 4; ++m) { const size_t off = (size_t)(u.pm * BM + ai * HALF + wr * 64 + m * 16 + fr) * 1024 + col0;
#pragma unroll
                for (int bj = 0; bj < 2; ++bj) { xw[m][bj] = *(const GAS u32x4*)(xp + off + bj * HALF); pw[m][bj] = *(const GAS u32x4*)(pq + off + bj * HALF); } }
            asm volatile("" ::: "memory");
#pragma unroll
            for (int m = 0; m < 4; ++m) { const size_t off = (size_t)(u.pm * BM + ai * HALF + wr * 64 + m * 16 + fr) * 1024 + col0;
#pragma unroll
                for (int bj = 0; bj < 2; ++bj) { f32x4 x0, x1, p0, p1; unpack8f(xw[m][bj], x0, x1); unpack8f(pw[m][bj], p0, p1); const f32x4 a0 = acc[ai][bj][m][0], a1 = acc[ai][bj][m][1];
#pragma unroll
                    for (int e = 0; e < 4; ++e) { x0[e] += p0[e] * sigmoidf_(a0[e]); x1[e] += p1[e] * sigmoidf_(a1[e]); }
                    u32x4 w; w.x = cvt_pk_bf16(x0[0], x0[1]); w.y = cvt_pk_bf16(x0[2], x0[3]); w.z = cvt_pk_bf16(x1[0], x1[1]); w.w = cvt_pk_bf16(x1[2], x1[3]);
                    *(GAS u32x4*)(op + off + bj * HALF) = w; } }
            asm volatile("" ::: "memory");
        }
    }
};
struct EpiMid {
    static constexpr bool PERM = true;
    bf16_t* MID;
    __device__ __forceinline__ void operator()(const Acc& acc, const Unit& u, int wr, int wc, int fr, int fq) const {
        const int row0 = u.pm * BM + wr * 64 + fr;
        const int mode = (u.pn == 1) ? 2 : 0; const int colbase = u.pn * 256;
#pragma unroll
        for (int ai = 0; ai < 2; ++ai)
#pragma unroll
            for (int m = 0; m < 4; ++m) { bf16_t* rowp = MID + (size_t)(row0 + ai * HALF + m * 16) * 512 + colbase;
#pragma unroll
                for (int bj = 0; bj < 2; ++bj) { const int lc = bj * HALF + wc * 32 + 8 * fq; f32x4 v0 = acc[ai][bj][m][0], v1 = acc[ai][bj][m][1];
#pragma unroll
                    for (int e = 0; e < 4; ++e) {
                        if (mode == 2) { v0[e] = sigmoidf_(v0[e]); v1[e] = sigmoidf_(v1[e]); }
                        else if (lc < 64) { v0[e] = tanhf_(v0[e]); v1[e] = tanhf_(v1[e]); } }
                    u32x4 w; w.x = cvt_pk_bf16(v0[0], v0[1]); w.y = cvt_pk_bf16(v0[2], v0[3]); w.z = cvt_pk_bf16(v1[0], v1[1]); w.w = cvt_pk_bf16(v1[2], v1[3]);
                    *(u32x4*)(rowp + lc) = w; } }
    }
};
struct EpiRwkv2 {
    static constexpr bool PERM = true;
    bf16_t* O0; bf16_t* O1; const float* bias0; const float* bias1; int tybase;
    __device__ __forceinline__ void operator()(const Acc& acc, const Unit& u, int wr, int wc, int fr, int fq) const {
        const int ty = tybase + (u.pn >> 2); const int row0 = u.pm * BM + wr * 64 + fr; const int colt = (u.pn & 3) * BM + wc * 32 + 8 * fq;
        bf16_t* base = (u.pn >> 2) ? O1 : O0; const float* bias = (u.pn >> 2) ? bias1 : bias0;
#pragma unroll
        for (int bj = 0; bj < 2; ++bj) {
            f32x4 b0 = (f32x4){0.f, 0.f, 0.f, 0.f}, b1 = b0;
            if (ty < 2) { b0 = *(const f32x4*)(bias + colt + bj * HALF); b1 = *(const f32x4*)(bias + colt + bj * HALF + 4); }
#pragma unroll
            for (int ai = 0; ai < 2; ++ai)
#pragma unroll
                for (int m = 0; m < 4; ++m) { bf16_t* rowp = base + (size_t)(row0 + ai * HALF + m * 16) * 1024 + colt + bj * HALF;
                    f32x4 v0 = acc[ai][bj][m][0] + b0, v1 = acc[ai][bj][m][1] + b1;
                    if (ty < 2) { const float s = (ty == 0) ? 0.6065306597126334f : 1.0f;
#pragma unroll
                        for (int e = 0; e < 4; ++e) { v0[e] = s * sigmoidf_(v0[e]); v1[e] = s * sigmoidf_(v1[e]); } }
                    u32x4 w; w.x = cvt_pk_bf16(v0[0], v0[1]); w.y = cvt_pk_bf16(v0[2], v0[3]); w.z = cvt_pk_bf16(v1[0], v1[1]); w.w = cvt_pk_bf16(v1[2], v1[3]);
                    *(u32x4*)rowp = w; }
        }
    }
};

template <class Epi, class Sched, bool ALIGN_EPI, bool GATHER>
__device__ __forceinline__ void gemm_phase(PG8_LAS unsigned char* lds, const int K, const int lda, const Sched& S, const Epi& E, const int* __restrict__ rows, const int tid) {
    const int wid = __builtin_amdgcn_readfirstlane(tid >> 6), lane = tid & 63, wr = wid >> 2, wc = wid & 3, fr = lane & 15, fq = lane >> 4;
    const int nt = K / BK;
    unsigned voffA[2], voffB[2]; int RA[2];
#pragma unroll
    for (int i = 0; i < 2; ++i) { int R, C; stage_rc(tid * 16 + i * 8192, R, C); const int Rb = Epi::PERM ? ((R & ~31) + perm32(R & 31)) : R;
        RA[i] = R; voffA[i] = GATHER ? (unsigned)(C * 2) : (unsigned)(R * lda + C) * 2u; voffB[i] = (unsigned)(Rb * K + C) * 2u; }
    const size_t kstep = (size_t)(BK * 2);
    const size_t hstepA = GATHER ? 0 : (size_t)HALF * lda * 2, hstepB = (size_t)HALF * K * 2;
    const unsigned ldsw = (unsigned)wid * 1024u;
    const int aoff = lds_byte(wr * 64 + fr, fq * 8), boff = lds_byte(wc * 32 + fr, fq * 8);
#define PG8_SA(b, h) (((b) * 2 + (h)) * HTB)
#define PG8_SB(b, h) ((4 + (b) * 2 + (h)) * HTB)
#define PG8_ST2(bufoff, gbase, o0, o1) do { \
        __builtin_amdgcn_global_load_lds((const unsigned*)((const char*)(gbase) + (o0)), (PG8_LAS unsigned*)(lds + (bufoff) + ldsw), 16, 0, 0); \
        __builtin_amdgcn_global_load_lds((const unsigned*)((const char*)(gbase) + (o1)), (PG8_LAS unsigned*)(lds + (bufoff) + ldsw + 8192), 16, 0, 0); } while (0)
#define PG8_STB(bufoff, gbase) PG8_ST2(bufoff, gbase, voffB[0], voffB[1])
#define PG8_STA(bufoff, p, h, nx) do { if constexpr (GATHER) { const unsigned g0_ = (nx) ? gN[h][0] : gC[h][0], g1_ = (nx) ? gN[h][1] : gC[h][1]; PG8_ST2(bufoff, p, g0_, g1_); } \
        else { PG8_ST2(bufoff, (p) + (h) * hstepA, voffA[0], voffA[1]); } } while (0)
#define PG8_LDA(dst, b, h) do { _Pragma("unroll") for (int m = 0; m < 4; ++m) _Pragma("unroll") for (int k = 0; k < 2; ++k) dst[m][k] = *(const PG8_LAS bf16x8*)(lds + PG8_SA(b, h) + aoff + m * 2048 + k * 1024); } while (0)
#define PG8_LDB(dst, b, h) do { _Pragma("unroll") for (int n = 0; n < 2; ++n) _Pragma("unroll") for (int k = 0; k < 2; ++k) dst[n][k] = *(const PG8_LAS bf16x8*)(lds + PG8_SB(b, h) + boff + n * 2048 + k * 1024); } while (0)
#define PG8_MMA(ai, bj, At, Bt) do { __builtin_amdgcn_s_setprio(1); _Pragma("unroll") for (int m = 0; m < 4; ++m) _Pragma("unroll") for (int n = 0; n < 2; ++n) _Pragma("unroll") for (int k = 0; k < 2; ++k) \
        acc[ai][bj][m][n] = __builtin_amdgcn_mfma_f32_16x16x32_bf16(Bt[n][k], At[m][k], acc[ai][bj][m][n], 0, 0, 0); __builtin_amdgcn_s_setprio(0); } while (0)
#define PG8_WAIT_V(n) asm volatile("s_waitcnt vmcnt(" #n ")" ::: "memory")
#define PG8_WAIT_L(n) asm volatile("s_waitcnt lgkmcnt(" #n ")" ::: "memory")
#define PG8_BAR __builtin_amdgcn_s_barrier()
#define PG8_SCHED __builtin_amdgcn_sched_barrier(0)
#define PG8_GLOAD(dst, un) do { if constexpr (GATHER) { _Pragma("unroll") for (int h_ = 0; h_ < 2; ++h_) _Pragma("unroll") for (int i_ = 0; i_ < 2; ++i_) \
        dst[h_][i_] = (unsigned)rows[(un).pm * BM + h_ * HALF + RA[i_]] * (unsigned)(lda * 2) + voffA[i_]; } } while (0)
    Unit cur, nxt; int ui = 0;
    if (!S.next(0, cur)) return;
    unsigned gC[2][2] = {{0u, 0u}, {0u, 0u}}, gN[2][2] = {{0u, 0u}, {0u, 0u}};
    PG8_GLOAD(gC, cur);
    Acc acc;
#pragma unroll
    for (int a = 0; a < 2; ++a)
#pragma unroll
        for (int b = 0; b < 2; ++b)
#pragma unroll
            for (int m = 0; m < 4; ++m)
#pragma unroll
                for (int n = 0; n < 2; ++n) acc[a][b][m][n] = (f32x4){0.f, 0.f, 0.f, 0.f};
    bf16x8 At[4][2], B0[2][2], B1[2][2];
    const char* cA = cur.A; const char* cB = cur.B;
    PG8_STB(PG8_SB(0, 0), cB); PG8_STB(PG8_SB(0, 1), cB + hstepB); PG8_STA(PG8_SA(0, 0), cA, 0, false); PG8_STA(PG8_SA(0, 1), cA, 1, false);
    if (wr == 1) PG8_BAR;
    PG8_WAIT_V(2); PG8_BAR;
    PG8_STB(PG8_SB(1, 0), cB + kstep); PG8_STA(PG8_SA(1, 0), cA + kstep, 0, false); PG8_STB(PG8_SB(1, 1), cB + hstepB + kstep);
    PG8_WAIT_V(6); PG8_BAR;
    for (;;) {
        const bool has_next = S.next(ui + 1, nxt);
        if (has_next) { PG8_GLOAD(gN, nxt); }
        const char* nA = has_next ? nxt.A : cA; const char* nB = has_next ? nxt.B : cB;
#pragma unroll 1
        for (int t = 0; t < nt; t += 2) {
            const bool last = (t == nt - 2); const bool nx = last && has_next;
            const char* a1 = cA + (size_t)(t + 1) * kstep;
            const char* a2 = last ? nA : cA + (size_t)(t + 2) * kstep; const char* b2 = last ? nB : cB + (size_t)(t + 2) * kstep;
            const char* a3 = a2 + kstep; const char* b3 = b2 + kstep;
            PG8_LDB(B0, 0, 0); PG8_LDB(B1, 0, 1); PG8_SCHED; PG8_LDA(At, 0, 0); PG8_STA(PG8_SA(1, 1), a1, 1, false);
            PG8_WAIT_V(8); PG8_WAIT_L(0); PG8_BAR; PG8_MMA(0, 0, At, B0); PG8_MMA(0, 1, At, B1); PG8_BAR; PG8_SCHED;
            PG8_LDA(At, 0, 1); PG8_STB(PG8_SB(0, 0), b2); PG8_STB(PG8_SB(0, 1), b2 + hstepB); PG8_STA(PG8_SA(0, 0), a2, 0, nx);
            PG8_WAIT_V(8); PG8_WAIT_L(0); PG8_BAR; PG8_MMA(1, 0, At, B0); PG8_MMA(1, 1, At, B1); PG8_BAR; PG8_SCHED;
            PG8_LDB(B0, 1, 0); PG8_LDB(B1, 1, 1); PG8_SCHED; PG8_LDA(At, 1, 0); PG8_STA(PG8_SA(0, 1), a2, 1, nx);
            PG8_WAIT_V(8); PG8_WAIT_L(0); PG8_BAR; PG8_MMA(0, 0, At, B0); PG8_MMA(0, 1, At, B1); PG8_BAR; PG8_SCHED;
            PG8_LDA(At, 1, 1); PG8_STB(PG8_SB(1, 0), b3); PG8_STB(PG8_SB(1, 1), b3 + hstepB); PG8_STA(PG8_SA(1, 0), a3, 0, nx);
            PG8_WAIT_V(8); PG8_WAIT_L(0); PG8_BAR; PG8_MMA(1, 0, At, B0); PG8_MMA(1, 1, At, B1); PG8_BAR; PG8_SCHED;
        }
        if constexpr (ALIGN_EPI) { if (wr == 0) PG8_BAR; }
        E(acc, cur, wr, wc, fr, fq);
        if (!has_next) break;
#pragma unroll
        for (int a = 0; a < 2; ++a)
#pragma unroll
            for (int b = 0; b < 2; ++b)
#pragma unroll
                for (int m = 0; m < 4; ++m)
#pragma unroll
                    for (int n = 0; n < 2; ++n) acc[a][b][m][n] = (f32x4){0.f, 0.f, 0.f, 0.f};
        cur = nxt; cA = nA; cB = nB; ++ui;
        if constexpr (GATHER) {
#pragma unroll
            for (int h_ = 0; h_ < 2; ++h_)
#pragma unroll
                for (int i_ = 0; i_ < 2; ++i_) gC[h_][i_] = gN[h_][i_]; }
        if constexpr (ALIGN_EPI) { if (wr == 1) PG8_BAR; }
    }
    PG8_WAIT_V(0);
    if constexpr (!ALIGN_EPI) { if (wr == 0) PG8_BAR; }
    PG8_BAR;
#undef PG8_SA
#undef PG8_SB
#undef PG8_ST2
#undef PG8_STB
#undef PG8_STA
#undef PG8_LDA
#undef PG8_LDB
#undef PG8_MMA
#undef PG8_WAIT_V
#undef PG8_WAIT_L
#undef PG8_BAR
#undef PG8_SCHED
#undef PG8_GLOAD
}
}
namespace attn_body {
using bf16=__hip_bfloat16;
using bf16x8=__attribute__((ext_vector_type(8)))short;
using s16x4=__attribute__((ext_vector_type(4)))short;
using f32x16=__attribute__((ext_vector_type(16)))float;
using u32x4=__attribute__((ext_vector_type(4)))unsigned;
constexpr int BATCH=8,NHEAD=16,SEQ=8192,D=64,PQ=512,PO=1024;
constexpr int NW=8,QBLK=32,QB=QBLK*NW,KVBLK=64,NQB=SEQ/QB;
constexpr int ATTN_UNIT_ROWS=QB;
__device__ __forceinline__ int crow(int r,int hi){return (r&3)+8*(r>>2)+4*hi;}
#define SBAR() __builtin_amdgcn_sched_barrier(0)
__device__ __forceinline__ void cmask(f32x16&p0,f32x16&p1,int jb,int qrel,int hi){
  const float NEG=-INFINITY; int kb=64*jb+4*hi;
  #pragma unroll
  for(int r=0;r<16;++r){int kv=kb+(r&3)+8*(r>>2); if(kv>qrel)p0[r]=NEG; if(kv+32>qrel)p1[r]=NEG;}
}

__device__ __forceinline__ void cbias(f32x16&p0,f32x16&p1,int jb,int qrel,int hi,const __attribute__((address_space(3))) float*tb){
  const int kb=64*jb+4*hi;
  #pragma unroll
  for(int r=0;r<16;++r){const int rel=qrel-(kb+(r&3)+8*(r>>2)); const int i0=min(max(rel,0),127), i1=min(max(rel-32,0),127); p0[r]+=tb[i0]; p1[r]+=tb[i1];}
}
constexpr int NSLOT=3, SLOTB=8192;
constexpr int LDS_K=0, LDS_V=NSLOT*SLOTB, LDS_WS=2*NSLOT*SLOTB, LDS_OST=LDS_WS+NW*64*4, LDS_BYTES=LDS_OST+NW*4096;
constexpr float C2=0.125f*1.4426950408889634f;
__device__ __forceinline__ void glds16(const void*gsrc,unsigned lds_dst){unsigned keep;
  asm volatile("s_mov_b32 %0, m0\n\ts_mov_b32 m0, %2\n\ts_nop 0\n\tglobal_load_lds_dwordx4 %1, off\n\ts_mov_b32 m0, %0":"=&s"(keep):"v"(gsrc),"s"(lds_dst):"memory");}
__device__ __forceinline__ float max3f(float a,float b,float c){float r;asm("v_max3_f32 %0, %1, %2, %3":"=v"(r):"v"(a),"v"(b),"v"(c));return r;}
__device__ __forceinline__ float max2f(float a,float b){float r;asm("v_max_f32_e32 %0, %1, %2":"=v"(r):"v"(a),"v"(b));return r;}
__device__ __forceinline__ float fadd_s(float a,float b){float r;asm("v_add_f32_e32 %0, %1, %2":"=v"(r):"v"(a),"v"(b));return r;}
__device__ __forceinline__ float fsub_s(float a,float b){float r;asm("v_sub_f32_e32 %0, %1, %2":"=v"(r):"v"(a),"v"(b));return r;}
typedef float f32x2_t __attribute__((ext_vector_type(2))); typedef __bf16 bf16x2_t __attribute__((ext_vector_type(2)));
__device__ __forceinline__ unsigned cvtpk_s(float lo,float hi){f32x2_t v={lo,hi};bf16x2_t b=__builtin_convertvector(v,bf16x2_t);return __builtin_bit_cast(unsigned,b);}
#define WAIT_BAR(N) asm volatile("s_waitcnt vmcnt(" #N ") lgkmcnt(0)\n\ts_barrier":::"memory")

__device__ __forceinline__ void qkt(f32x16&p0,f32x16&p1,const char*Kslot,const bf16x8*qr,const f32x16&negm,int r32,int hi){
  const char*kb=Kslot+hi*1024+r32*16;
  #pragma unroll
  for(int d0=0;d0<4;++d0){
    const bf16x8 b0=*reinterpret_cast<const bf16x8*>(kb+d0*2048);
    const bf16x8 b1=*reinterpret_cast<const bf16x8*>(kb+d0*2048+512);
    if(d0==0){p0=__builtin_amdgcn_mfma_f32_32x32x16_bf16(b0,qr[0],negm,0,0,0);p1=__builtin_amdgcn_mfma_f32_32x32x16_bf16(b1,qr[0],negm,0,0,0);}
    else{p0=__builtin_amdgcn_mfma_f32_32x32x16_bf16(b0,qr[d0],p0,0,0,0);p1=__builtin_amdgcn_mfma_f32_32x32x16_bf16(b1,qr[d0],p1,0,0,0);}}
}
typedef __attribute__((address_space(3))) const char* lds_cptr;
typedef short v4i16_t __attribute__((ext_vector_type(4)));
__device__ __forceinline__ void kload8(bf16x8*kf,lds_cptr kp){
  kf[0]=*(const __attribute__((address_space(3))) bf16x8*)(kp);      kf[1]=*(const __attribute__((address_space(3))) bf16x8*)(kp+512);
  kf[2]=*(const __attribute__((address_space(3))) bf16x8*)(kp+2048); kf[3]=*(const __attribute__((address_space(3))) bf16x8*)(kp+2560);
  kf[4]=*(const __attribute__((address_space(3))) bf16x8*)(kp+4096); kf[5]=*(const __attribute__((address_space(3))) bf16x8*)(kp+4608);
  kf[6]=*(const __attribute__((address_space(3))) bf16x8*)(kp+6144); kf[7]=*(const __attribute__((address_space(3))) bf16x8*)(kp+6656);
}
__device__ __forceinline__ void kload2(bf16x8*kf,lds_cptr kp,int j){ kf[2*j]=*(const __attribute__((address_space(3))) bf16x8*)(kp+j*2048); kf[2*j+1]=*(const __attribute__((address_space(3))) bf16x8*)(kp+j*2048+512); }
__device__ __forceinline__ s16x4 vtr(lds_cptr p){ return __builtin_bit_cast(s16x4,__builtin_amdgcn_ds_read_tr16_b64_v4i16((__attribute__((address_space(3))) v4i16_t*)p)); }
__device__ __forceinline__ float rowmax(const f32x16&p0,const f32x16&p1){
  float a=max3f(p0[0],p0[1],p1[0]),b=max3f(p0[2],p0[3],p1[1]);a=max3f(a,p1[2],p1[3]);
  #pragma unroll
  for(int r=4;r<16;r+=4){a=max3f(a,p0[r],p0[r+1]);b=max3f(b,p0[r+2],p0[r+3]);a=max3f(a,p1[r],p1[r+1]);b=max3f(b,p1[r+2],p1[r+3]);}
  const float m=max2f(a,b);
  auto rr=__builtin_amdgcn_permlane32_swap(__float_as_uint(m),__float_as_uint(m),false,false);
  return max2f(__uint_as_float(rr[0]),__uint_as_float(rr[1]));
}
__device__ __forceinline__ void pv(f32x16*o,int vb,bf16x8 pa0,bf16x8 pa1,bf16x8 pa2,bf16x8 pa3){
  #pragma unroll
  for(int d0=0;d0<2;++d0){s16x4 lo[4],hi[4];
    #pragma unroll
    for(int ks=0;ks<4;++ks){
      asm volatile("ds_read_b64_tr_b16 %0,%1 offset:%c2":"=&v"(lo[ks]):"v"(vb),"i"(d0*4096+ks*1024):"memory");
      asm volatile("ds_read_b64_tr_b16 %0,%1 offset:%c2":"=&v"(hi[ks]):"v"(vb),"i"(d0*4096+ks*1024+512):"memory");}
    asm volatile("s_waitcnt lgkmcnt(0)":::"memory");SBAR();
    #define PK(k) (bf16x8){lo[k][0],lo[k][1],lo[k][2],lo[k][3],hi[k][0],hi[k][1],hi[k][2],hi[k][3]}
    o[d0]=__builtin_amdgcn_mfma_f32_32x32x16_bf16(pa0,PK(0),o[d0],0,0,0);
    o[d0]=__builtin_amdgcn_mfma_f32_32x32x16_bf16(pa1,PK(1),o[d0],0,0,0);
    o[d0]=__builtin_amdgcn_mfma_f32_32x32x16_bf16(pa2,PK(2),o[d0],0,0,0);
    o[d0]=__builtin_amdgcn_mfma_f32_32x32x16_bf16(pa3,PK(3),o[d0],0,0,0);
    #undef PK
  }
}

#ifndef ATTN_STORE16
#define ATTN_STORE16(p,v) (*(u32x4*)(p)=(v))
#endif
template<int THRL> __device__ __forceinline__ void attn_unit(int b,int vh,int qb,const bf16*Q,const bf16*__restrict__ K,const bf16*__restrict__ V,bf16*O,char*shm,const __attribute__((address_space(3))) float*tball,const int tid){
  const int lane=tid&63,r32=lane&31,hi=lane>>5; const int wid=__builtin_amdgcn_readfirstlane(tid>>6);
  const long rowbase=(long)b*SEQ; const int q0=qb*QB;
  const int hh=vh>>2, qcol=hh*128+((vh>>1)&1)*64, vcol=hh*128+(vh&1)*64;
  const __attribute__((address_space(3))) float*tb=tball+hh*128;
  const bf16*Qw=Q+(rowbase+q0+wid*QBLK)*PQ+qcol;
  const bf16*Kh=K+rowbase*PQ+qcol,*Vh=V+rowbase*PQ+vcol;
  const unsigned lds0=(unsigned)(uintptr_t)shm;
  float*wsf=(float*)(shm+LDS_WS)+wid*64;
  const bf16*ksrc=Kh+(long)lane*PQ+wid*8;
  const bf16*vsrc=Vh+(long)(16*(wid&3)+(lane>>2))*PQ+(wid>>2)*32+(lane&3)*8;
  const unsigned kdst=lds0+LDS_K+wid*1024, vdst=lds0+LDS_V+wid*1024;
  #define DMA_K(t,slot) glds16(ksrc+(long)(t)*KVBLK*PQ,(unsigned)__builtin_amdgcn_readfirstlane(kdst+(slot)))
  #define DMA_V(t,slot) glds16(vsrc+(long)(t)*KVBLK*PQ,(unsigned)__builtin_amdgcn_readfirstlane(vdst+(slot)))
  const int vb0=(int)(lds0+LDS_V)+((lane>>4)&1)*32+(lane&3)*8+(4*hi+((lane&15)>>2))*64;
  const char*Kbase=shm+LDS_K; bf16x8 kf[8];
  const lds_cptr shm3=(lds_cptr)shm; const lds_cptr kp0=shm3+LDS_K+hi*1024+r32*16; const lds_cptr vp0=shm3+LDS_V+((lane>>4)&1)*32+(lane&3)*8+(4*hi+((lane&15)>>2))*64;
  const int NT=(q0+QB)/KVBLK;
  DMA_K(0,0);DMA_V(0,0);DMA_K(1,SLOTB);
  bf16x8 qr[4];
  #pragma unroll
  for(int d0=0;d0<4;++d0)qr[d0]=*reinterpret_cast<const bf16x8*>(&Qw[(long)r32*PQ+d0*16+hi*8]);
  float mhat=0.f,l_reg=0.f;f32x16 o[2];o[0]=f32x16{};o[1]=f32x16{};f32x16 negm=f32x16{};asm volatile("":"+v"(negm));
  const int qrel=wid*QBLK+r32;
  #define CMASK(P0,P1,t) do{int jb_=(t)-(NT-4); if(jb_>=-2){cbias(P0,P1,jb_,qrel,hi,tb); if(jb_>=0)cmask(P0,P1,jb_,qrel,hi);}}while(0)
  bool resc=false;
  #define START(P0,P1) do{ const float rm=rowmax(P0,P1); resc=false; \
    { const float dl=rm; mhat=fadd_s(mhat,dl); \
      _Pragma("unroll") for(int r=0;r<16;++r){P0[r]=fsub_s(P0[r],dl);P1[r]=fsub_s(P1[r],dl);} \
      _Pragma("unroll") for(int r=0;r<16;++r)negm[r]=-mhat; asm volatile("":"+v"(negm)); } \
    _Pragma("unroll") for(int r=0;r<16;++r)P0[r]=__builtin_amdgcn_exp2f(P0[r]); }while(0)
  #define RESC() do{ if(resc){ asm volatile("s_waitcnt lgkmcnt(0)":::"memory"); \
      _Pragma("unroll") for(int d_=0;d_<2;++d_) _Pragma("unroll") for(int r=0;r<16;++r)o[d_][r]*=wsf[crow(r,hi)]; } }while(0)
  f32x16 pA0,pA1,pB0,pB1;
  int sl_prev=0,sl_cur=0,sl_next=SLOTB;
  #define ROT() do{sl_prev=sl_cur;sl_cur=sl_next;sl_next=(sl_next==(NSLOT-1)*SLOTB)?0:sl_next+SLOTB;}while(0)
  DMA_K(2,2*SLOTB);
  WAIT_BAR(3);
  qkt(pA0,pA1,Kbase,qr,negm,r32,hi);asm volatile("s_nop 15\n\ts_nop 7":"+v"(pA0),"+v"(pA1));CMASK(pA0,pA1,0);
  START(pA0,pA1);
  _Pragma("unroll") for(int r=0;r<16;++r)pA1[r]=__builtin_amdgcn_exp2f(pA1[r]);
  WAIT_BAR(0);
  DMA_K(3,0);DMA_V(1,SLOTB);
  ROT();
  kload8(kf,kp0+sl_cur);
  WAIT_BAR(2);
  s16x4 vlo[8],vhi[8]; u32x4 pw0,pw1,pw2,pw3;
  #define PKW(P,B) cvtpk_s(P[B],P[B+1])
  #define PAF(k) __builtin_bit_cast(bf16x8,pw##k)
  #define VFR(i) (bf16x8){vlo[i][0],vlo[i][1],vlo[i][2],vlo[i][3],vhi[i][0],vhi[i][1],vhi[i][2],vhi[i][3]}
  #define PIN(x) asm volatile("":"+v"(x))
  #define MX3(a,b,c) __builtin_fmaxf(__builtin_fmaxf((a),(b)),(c))
  #define GAPA(MF,A0,A1,A2,A3,W0,W1,PW) do{ MF; sacc+=A0; sacc+=A1; sacc+=A2; sacc+=A3; PIN(sacc); W0; W1; PIN(PW); SBAR(); }while(0)
  #define EX(v) __builtin_amdgcn_exp2f(v)
  #define GAPB(MF,X,B) do{ MF; X[B]=EX(X[B]); X[B+1]=EX(X[B+1]); X[B+2]=EX(X[B+2]); X[B+3]=EX(X[B+3]); PIN(X); SBAR(); }while(0)
  #define VRD(i) do{ vlo[i]=vtr(vp_+(((i)>>2)*4096+((i)&3)*1024)); vhi[i]=vtr(vp_+(((i)>>2)*4096+((i)&3)*1024+512)); }while(0)
  #define KRD(G,j) do{ if(G){ kload2(kf,kp0+sl_next,j); SBAR(); } }while(0)
  #define STEP(C0,C1,P0,P1,t,GK,GV,GL) do{ SBAR(); \
    const lds_cptr vp_=vp0+sl_prev; \
    VRD(0); SBAR(); float sacc=(P0[0]+P0[1]); \
    GAPA(C0=__builtin_amdgcn_mfma_f32_32x32x16_bf16(kf[0],qr[0],negm,0,0,0), P0[2],P0[3],P0[4],P0[5],     pw0[0]=PKW(P0,0), pw0[1]=PKW(P0,2), pw0); \
    VRD(4); SBAR(); GAPA(C1=__builtin_amdgcn_mfma_f32_32x32x16_bf16(kf[1],qr[0],negm,0,0,0), P0[6],P0[7],P0[8],P0[9],     pw0[2]=PKW(P0,4), pw0[3]=PKW(P0,6), pw0); \
    VRD(1); SBAR(); GAPA(C0=__builtin_amdgcn_mfma_f32_32x32x16_bf16(kf[2],qr[1],C0,0,0,0),   P0[10],P0[11],P0[12],P0[13], pw1[0]=PKW(P0,8), pw1[1]=PKW(P0,10), pw1); \
    VRD(5); SBAR(); GAPA(C1=__builtin_amdgcn_mfma_f32_32x32x16_bf16(kf[3],qr[1],C1,0,0,0),   P0[14],P0[15],P1[0],P1[1],   pw1[2]=PKW(P0,12),pw1[3]=PKW(P0,14), pw1); \
    VRD(2); SBAR(); GAPA(C0=__builtin_amdgcn_mfma_f32_32x32x16_bf16(kf[4],qr[2],C0,0,0,0),   P1[2],P1[3],P1[4],P1[5],     pw2[0]=PKW(P1,0), pw2[1]=PKW(P1,2), pw2); \
    VRD(6); SBAR(); GAPA(C1=__builtin_amdgcn_mfma_f32_32x32x16_bf16(kf[5],qr[2],C1,0,0,0),   P1[6],P1[7],P1[8],P1[9],     pw2[2]=PKW(P1,4), pw2[3]=PKW(P1,6), pw2); \
    VRD(3); SBAR(); GAPA(C0=__builtin_amdgcn_mfma_f32_32x32x16_bf16(kf[6],qr[3],C0,0,0,0),   P1[10],P1[11],P1[12],P1[13], pw3[0]=PKW(P1,8), pw3[1]=PKW(P1,10), pw3); \
    VRD(7); SBAR(); GAPA(C1=__builtin_amdgcn_mfma_f32_32x32x16_bf16(kf[7],qr[3],C1,0,0,0),   P1[14],P1[15],0.f,0.f,       pw3[2]=PKW(P1,12),pw3[3]=PKW(P1,14), pw3); \
    l_reg+=sacc; \
    if(GK){DMA_K((t)+3,sl_cur);} if(GV){DMA_V((t)+1,sl_next);} \
    CMASK(C0,C1,t); \
    { float a=MX3(C0[0],C0[1],C1[0]),b=MX3(C0[2],C0[3],C1[1]); a=MX3(a,C1[2],C1[3]); \
      _Pragma("unroll") for(int r=4;r<16;r+=4){a=MX3(a,C0[r],C0[r+1]);b=MX3(b,C0[r+2],C0[r+3]);a=MX3(a,C1[r],C1[r+1]);b=MX3(b,C1[r+2],C1[r+3]);} \
      float rm=__builtin_fmaxf(a,b); { auto rr=__builtin_amdgcn_permlane32_swap(__float_as_uint(rm),__float_as_uint(rm),false,false); rm=__builtin_fmaxf(__uint_as_float(rr[0]),__uint_as_float(rr[1])); } \
      resc=false; \
      if(__builtin_expect(__any(rm>(float)THRL),0)){ const float dl=__builtin_fmaxf(rm,0.f); mhat+=dl; \
        _Pragma("unroll") for(int r=0;r<16;++r){C0[r]-=dl;C1[r]-=dl;} \
        _Pragma("unroll") for(int r=0;r<16;++r)negm[r]=-mhat; asm volatile("":"+v"(negm)); \
        const float f=__builtin_amdgcn_exp2f(-dl); l_reg*=f; if(hi==0)wsf[r32]=f; resc=true; } } \
    SBAR(); \
    GAPB(o[0]=__builtin_amdgcn_mfma_f32_32x32x16_bf16(PAF(0),VFR(0),o[0],0,0,0), C0,0); \
    GAPB(o[1]=__builtin_amdgcn_mfma_f32_32x32x16_bf16(PAF(0),VFR(4),o[1],0,0,0), C0,4); \
    KRD(GL,0); GAPB(o[0]=__builtin_amdgcn_mfma_f32_32x32x16_bf16(PAF(1),VFR(1),o[0],0,0,0), C0,8); \
    KRD(GL,1); GAPB(o[1]=__builtin_amdgcn_mfma_f32_32x32x16_bf16(PAF(1),VFR(5),o[1],0,0,0), C0,12); \
    KRD(GL,2); GAPB(o[0]=__builtin_amdgcn_mfma_f32_32x32x16_bf16(PAF(2),VFR(2),o[0],0,0,0), C1,0); \
    KRD(GL,3); GAPB(o[1]=__builtin_amdgcn_mfma_f32_32x32x16_bf16(PAF(2),VFR(6),o[1],0,0,0), C1,4); \
    GAPB(o[0]=__builtin_amdgcn_mfma_f32_32x32x16_bf16(PAF(3),VFR(3),o[0],0,0,0), C1,8); \
    GAPB(o[1]=__builtin_amdgcn_mfma_f32_32x32x16_bf16(PAF(3),VFR(7),o[1],0,0,0), C1,12); \
    }while(0)
  int t=1;
  #undef CMASK
  #define CMASK(P0,P1,t) do{}while(0)
  for(;t+7<NT;t+=2){
    STEP(pB0,pB1,pA0,pA1,t,true,true,true);     WAIT_BAR(2); RESC(); ROT();
    STEP(pA0,pA1,pB0,pB1,t+1,true,true,true);   WAIT_BAR(2); RESC(); ROT();
  }
  #undef CMASK
  #define CMASK(P0,P1,t) do{int jb_=(t)-(NT-4); if(jb_>=-2){cbias(P0,P1,jb_,qrel,hi,tb); if(jb_>=0)cmask(P0,P1,jb_,qrel,hi);}}while(0)
  #define ENDW(tt) do{ if((tt)+3<NT){WAIT_BAR(2);} else if((tt)+2<NT){WAIT_BAR(1);} else {WAIT_BAR(0);} }while(0)
  for(;t+1<NT;t+=2){
    STEP(pB0,pB1,pA0,pA1,t,(t+3<NT),(t+1<NT),(t+1<NT));       ENDW(t);   RESC(); ROT();
    STEP(pA0,pA1,pB0,pB1,t+1,(t+4<NT),(t+2<NT),(t+2<NT));     ENDW(t+1); RESC(); ROT();
  }
  STEP(pB0,pB1,pA0,pA1,NT-1,false,false,false); RESC();
  { float sacc=pB0[0]+pB0[1]; _Pragma("unroll") for(int r=2;r<16;++r)sacc+=pB0[r]; _Pragma("unroll") for(int r=0;r<16;++r)sacc+=pB1[r]; l_reg+=sacc;
    pw0=(u32x4){PKW(pB0,0),PKW(pB0,2),PKW(pB0,4),PKW(pB0,6)};pw1=(u32x4){PKW(pB0,8),PKW(pB0,10),PKW(pB0,12),PKW(pB0,14)};pw2=(u32x4){PKW(pB1,0),PKW(pB1,2),PKW(pB1,4),PKW(pB1,6)};pw3=(u32x4){PKW(pB1,8),PKW(pB1,10),PKW(pB1,12),PKW(pB1,14)};
    SBAR(); pv(o,vb0+sl_cur,PAF(0),PAF(1),PAF(2),PAF(3)); }
  #undef PKW
  #undef PAF
  #undef VFR
  #undef PIN
  #undef MX3
  #undef GAPA
  #undef GAPB
  #undef EX
  #undef VRD
  #undef KRD
  #undef STEP
  #undef ENDW
  {auto rr=__builtin_amdgcn_permlane32_swap(__float_as_uint(l_reg),__float_as_uint(l_reg),false,false);l_reg=__uint_as_float(rr[0])+__uint_as_float(rr[1]);}
  if(hi==0)wsf[32+r32]=l_reg;asm volatile("s_waitcnt lgkmcnt(0)":::"memory");
  float rli[16];
  #pragma unroll
  for(int r=0;r<16;++r)rli[r]=__builtin_amdgcn_rcpf(wsf[32+crow(r,hi)]);
  bf16*Ow=O+(rowbase+q0+wid*QBLK)*PO+vh*D;
  { bf16*stg=(bf16*)(shm+LDS_OST)+wid*2048;
    #pragma unroll
    for(int r=0;r<16;++r){const int orow=crow(r,hi);
      #pragma unroll
      for(int d0=0;d0<2;++d0)stg[orow*64+d0*32+r32]=__float2bfloat16(o[d0][r]*rli[r]);}
    asm volatile("s_waitcnt lgkmcnt(0)":::"memory");
    #pragma unroll
    for(int i=0;i<4;++i){const int row=i*8+(lane>>3),ch=lane&7; const u32x4 v=*(const u32x4*)(stg+row*64+ch*8); ATTN_STORE16(Ow+(long)row*PO+ch*8,v);} }
  asm volatile("s_waitcnt lgkmcnt(0)\n\ts_barrier":::"memory");
  #undef DMA_K
  #undef DMA_V
  #undef CMASK
  #undef START
  #undef RESC
  #undef ROT
}
constexpr int ATTN_LDS_BYTES=LDS_BYTES;
struct AttnTensors { const bf16* Q; const bf16* K; const bf16* V; bf16* O; };
struct AttnUnit { int bh; int qb; };
__device__ __forceinline__ bool attn_next(int vcu,int i,AttnUnit&u){ if(i>=16)return false; const int s=vcu&7, j=i&3; u.bh=(vcu>>3)+32*(i>>2); u.qb=(j==0)?s:(j==1)?15-s:(j==2)?16+s:31-s; return true; }
template<int THRL=8> __device__ __forceinline__ void attn_phase(char*lds,const AttnTensors&T,int vcu,const __attribute__((address_space(3))) float*tball,const int tid){
  AttnUnit u;
  for(int i=0;attn_next(vcu,i,u);++i){ attn_unit<THRL>(u.bh/NHEAD,u.bh%NHEAD,u.qb,T.Q,T.K,T.V,T.O,lds,tball,tid); }
}
#undef SBAR
#undef WAIT_BAR
}

#define XB_TMO      128
#define XB_XCNT(j)  (256  + 64 * (j))
#define XB_XSUB(j)  (1280 + 64 * (j))
#define XB_XGEN(j)  (2304 + 64 * (j))
#define XB_TOP      3328
#define XB_TOPGEN   3392
#define XCD_BAR_WORDS 3456
#define XB_SPIN_CAP (1u << 18)

__device__ __forceinline__ unsigned xb_ld(unsigned* p)              { return __hip_atomic_load(p, __ATOMIC_RELAXED, __HIP_MEMORY_SCOPE_AGENT); }
__device__ __forceinline__ unsigned xb_add(unsigned* p, unsigned v) { return __hip_atomic_fetch_add(p, v, __ATOMIC_RELAXED, __HIP_MEMORY_SCOPE_AGENT); }
__device__ __forceinline__ unsigned xb_xcc_id() { return (unsigned)__builtin_amdgcn_s_getreg((3 << 11) | 20) & 0xFu; }
#define XB_SPIN(cond, bar) do { unsigned _sp = 0; while (cond) { __builtin_amdgcn_s_sleep(1); \
    if ((++_sp & 255u) == 0u) { if (xb_ld(&(bar)[XB_TMO])) break; if (_sp > XB_SPIN_CAP) { atomicAdd(&(bar)[XB_TMO], 1u); break; } } } } while (0)

struct XcdBarrier {
    unsigned* bar; unsigned x;
    volatile LAS unsigned* st;
};

__device__ __forceinline__ XcdBarrier xcd_barrier_post(unsigned* bar, volatile LAS unsigned* st, const bool leader  ) {
    XcdBarrier b; b.bar = bar; b.x = xb_xcc_id(); b.st = st;
    if (leader) (void)xb_add(&bar[XB_XCNT(b.x)], 1u);
    return b;
}
__device__ __forceinline__ void xcd_barrier_complete(unsigned* bar, unsigned x, unsigned& nloc, unsigned& nx) {
    const unsigned G = gridDim.x * gridDim.y * gridDim.z;
    unsigned sum, cnt, mine, sp = 0u;
    for (;;) {
        sum = 0u; cnt = 0u; mine = 0u;
#pragma unroll
        for (unsigned j = 0; j < 16; ++j) { const unsigned c = xb_ld(&bar[XB_XCNT(j)]); sum += c; cnt += (c > 0u) ? 1u : 0u; mine = (j == x) ? c : mine; }
        if (sum == G) break;
        __builtin_amdgcn_s_sleep(1);
        if ((++sp & 255u) == 0u) { if (xb_ld(&bar[XB_TMO])) break; if (sp > XB_SPIN_CAP) { atomicAdd(&bar[XB_TMO], 1u); break; } }
    }
    nloc = mine > 0u ? mine : 1u; nx = cnt > 0u ? cnt : 1u;
}

__device__ __forceinline__ void xcd_barrier(const XcdBarrier& b, const bool leader  ) {
    asm volatile("s_waitcnt vmcnt(0)" ::: "memory");
    __syncthreads();
    if (leader) {
        unsigned* bar = b.bar;
        __builtin_amdgcn_s_waitcnt(0);
        unsigned nloc = b.st[0], nx = b.st[1];
        if (nloc == 0u) { xcd_barrier_complete(bar, b.x, nloc, nx); b.st[0] = nloc; b.st[1] = nx; }
        const unsigned old = xb_add(&bar[XB_XSUB(b.x)], 1u);
        const unsigned gen = old / nloc;
        if (old + 1u == (gen + 1u) * nloc) {
            __builtin_amdgcn_fence(__ATOMIC_RELEASE, "agent");
            asm volatile("s_waitcnt vmcnt(0)" ::: "memory");
            const unsigned og = xb_add(&bar[XB_TOP], 1u);
            const unsigned tg = og / nx;
            if (og + 1u == (tg + 1u) * nx) xb_add(&bar[XB_TOPGEN], 1u);
            else XB_SPIN(xb_ld(&bar[XB_TOPGEN]) == tg, bar);
            __builtin_amdgcn_fence(__ATOMIC_ACQUIRE, "agent");
            xb_add(&bar[XB_XGEN(b.x)], 1u);
            asm volatile("s_waitcnt vmcnt(0)" ::: "memory");
        } else {
            XB_SPIN(xb_ld(&bar[XB_XGEN(b.x)]) == gen, bar);
            __builtin_amdgcn_fence(__ATOMIC_ACQUIRE, "agent");
            asm volatile("s_waitcnt vmcnt(0)" ::: "memory");
        }
    }
    __syncthreads();
}

constexpr size_t MiB = 1u << 20;
constexpr size_t WS_CTL = 0, CTL_ZERO_BYTES = 1 * MiB;
constexpr size_t WS_WIN = 2 * MiB;
constexpr size_t WS_WOUT = 7 * MiB;
constexpr size_t WS_PGATE = 9 * MiB;
constexpr size_t WS_PPROJ = 13 * MiB;
constexpr size_t WS_RCAT = 14 * MiB;
constexpr size_t WS_RL1 = 20 * MiB;
constexpr size_t WS_RS2 = 28 * MiB;
constexpr size_t WS_RWO = 30 * MiB;
constexpr size_t WS_ROUT = 32 * MiB;
constexpr size_t WS_LRUAGG = 33 * MiB;
constexpr size_t WS_MGU = 38 * MiB;
constexpr size_t WS_MDN = 102 * MiB;
constexpr size_t WS_PB = 134 * MiB;
constexpr size_t WS_ACT = 166 * MiB;
constexpr size_t WS_H0 = WS_ACT;
constexpr size_t WS_QKV = WS_ACT + 128 * MiB;
constexpr size_t WS_O = WS_ACT + 448 * MiB;
constexpr size_t WS_HL = WS_ACT + 576 * MiB, WS_CA = WS_ACT + 640 * MiB;
constexpr size_t WS_H2 = WS_ACT;
constexpr size_t WS_LOG = WS_ACT + 128 * MiB;
constexpr size_t WS_ROUTE = WS_ACT + 144 * MiB;
constexpr size_t WS_HID = WS_ACT + 152 * MiB;
constexpr size_t WS_YS = WS_ACT + 288 * MiB;
constexpr size_t WS_PP = WS_ACT + 128 * MiB;
constexpr size_t WS_HCAT = WS_ACT;
constexpr size_t WS_XR = WS_ACT + 256 * MiB, WS_XK = WS_ACT + 384 * MiB, WS_XV = WS_ACT + 512 * MiB;
constexpr size_t WS_R = WS_ACT + 640 * MiB, WS_K = WS_XR, WS_V = WS_XK;
constexpr size_t WS_MID = WS_ACT + 768 * MiB;
constexpr size_t WS_EW = WS_ACT;
constexpr size_t WS_AA = WS_ACT + 128 * MiB;
constexpr size_t WS_Y = WS_XV;
constexpr size_t WS_END = WS_ACT + 832 * MiB;
static_assert(WS_END <= 1024 * MiB, "workspace map");
constexpr size_t RT_EID = 0, RT_POS = 1 * MiB, RT_GATE = 2 * MiB, RT_ROWTOK = 3 * MiB, RT_ROWGATE = 4 * MiB, RT_SLOT = 5 * MiB;
constexpr int CW_BAR = 4096;
constexpr int CW_CNT0 = 16384, CW_CNT1 = 16384 + 64;

constexpr int RING_BYTES = 131072;
constexpr int LDSCTL_OFF = RING_BYTES, MISC_OFF = LDSCTL_OFF + 320;
constexpr int TB_OFF = RING_BYTES + 1024;
constexpr int RTE_OFF = TB_OFF + 2048;
constexpr int LDS_BYTES = 147456;

constexpr int NWAVES = 8;
__device__ __forceinline__ int lane_id_() { int l; asm volatile("v_mbcnt_lo_u32_b32 %0, -1, 0\n\tv_mbcnt_hi_u32_b32 %0, -1, %0" : "=v"(l)); return l; }
#define TID_ (F.wave * 64 + lane_id_())
#define LANE_ (lane_id_())
struct Frame {
    LAS unsigned char* lds; volatile LAS unsigned* MISC; gu32* ctl;
    int wave, vcu, G;
};

__device__ __forceinline__ void load_row4(const float* xrow, int lane, f32x4 (&v)[4]) { const f32x4* p = (const f32x4*)xrow + lane;
#pragma unroll
    for (int j = 0; j < 4; ++j) v[j] = p[64 * j]; }
__device__ __forceinline__ float row_rstd(const f32x4 (&v)[4], float eps) { float s = 0.f;
#pragma unroll
    for (int j = 0; j < 4; ++j) s += (v[j].x * v[j].x + v[j].y * v[j].y) + (v[j].z * v[j].z + v[j].w * v[j].w);
    return 1.0f / sqrtf(wave_sum(s) * (1.0f / 1024.0f) + eps); }
__device__ __forceinline__ void load_row4_bf(const bf16* xrow, int lane, f32x4 (&v)[4]) { const v2u* p = (const v2u*)xrow + lane;
#pragma unroll
    for (int j = 0; j < 4; ++j) { const v2u w = p[64 * j]; v[j] = (f32x4){bflo(w.x), bfhi(w.x), bflo(w.y), bfhi(w.y)}; } }
__device__ __forceinline__ void store_row4_bf(bf16* xrow, int lane, const f32x4 (&v)[4]) { v2u* p = (v2u*)xrow + lane;
#pragma unroll
    for (int j = 0; j < 4; ++j) { v2u o; o.x = pk2(v[j].x, v[j].y); o.y = pk2(v[j].z, v[j].w); p[64 * j] = o; } }
__device__ __forceinline__ void store_row_bf16(bf16* orow, int lane, const f32x4 (&v)[4], float rstd, const float* g) {
    unsigned long long* o8 = (unsigned long long*)orow + lane;
#pragma unroll
    for (int j = 0; j < 4; ++j) { const f32x4 gg = ((const f32x4*)g)[lane + 64 * j];
        o8[64 * j] = (unsigned long long)pk2(v[j].x * rstd * gg.x, v[j].y * rstd * gg.y) | ((unsigned long long)pk2(v[j].z * rstd * gg.z, v[j].w * rstd * gg.w) << 32); }
}

template <int MODE>
__device__ __forceinline__ void transpose_item(const float* W, int K, int N, bf16* WT, int ldo, int row_off, const float* mu, LAS float* scr, int item, int lane) {
    const int nblk = N / 32, kb = item / nblk, nb = item % nblk, k0 = 64 * kb, n0 = 32 * nb;
    float ld[32];
#pragma unroll
    for (int i = 0; i < 32; ++i) { const int kk = 2 * i + (lane >> 5); ld[i] = W[(size_t)(k0 + kk) * N + n0 + (lane & 31)]; }
#pragma unroll
    for (int i = 0; i < 32; ++i) { const int kk = 2 * i + (lane >> 5); scr[kk * 33 + (lane & 31)] = ld[i]; }
    LDS_WAIT(); asm volatile("" ::: "memory");
    const int c = lane & 7;
    int rbase = row_off + n0;
    if (MODE == 2) { rbase = row_off + ((n0 < 512) ? ((n0 >> 7) * 256 + (n0 & 127)) : (((n0 - 512) >> 7) * 256 + 128 + ((n0 - 512) & 127))); }
    float m[8];
    if (MODE == 1) {
#pragma unroll
        for (int e = 0; e < 8; ++e) m[e] = mu[k0 + 8 * c + e]; }
#pragma unroll
    for (int j = 0; j < 4; ++j) { const int n = (lane >> 3) + 8 * j; const LAS float* s = scr + (8 * c) * 33 + n;
        float v[8];
#pragma unroll
        for (int e = 0; e < 8; ++e) v[e] = s[e * 33];
        bf16* dst = WT + (size_t)(rbase + n) * ldo + k0 + 8 * c;
        if (MODE == 1) {
            v4u o, o2;
            o.x = pk2(v[0] * (1.f - m[0]), v[1] * (1.f - m[1])); o.y = pk2(v[2] * (1.f - m[2]), v[3] * (1.f - m[3])); o.z = pk2(v[4] * (1.f - m[4]), v[5] * (1.f - m[5])); o.w = pk2(v[6] * (1.f - m[6]), v[7] * (1.f - m[7]));
            o2.x = pk2(v[0] * m[0], v[1] * m[1]); o2.y = pk2(v[2] * m[2], v[3] * m[3]); o2.z = pk2(v[4] * m[4], v[5] * m[5]); o2.w = pk2(v[6] * m[6], v[7] * m[7]);
            *(GAS v4u*)dst = o; *(GAS v4u*)(dst + 1024) = o2;
        } else {
            v4u o; o.x = pk2(v[0], v[1]); o.y = pk2(v[2], v[3]); o.z = pk2(v[4], v[5]); o.w = pk2(v[6], v[7]);
            *(GAS v4u*)dst = o; }
    }
    LDS_WAIT(); asm volatile("" ::: "memory");
}

struct In {
    const float *x, *p, *rel_bias, *norm_mix, *ab_w_in, *ab_w_out, *lam_q1, *lam_k1, *lam_q2, *lam_k2, *sub_g, *conv_w, *conv_b, *lru_wa, *lru_ba, *lru_wx, *lru_bx, *lru_lambda,
        *rwkv_mu, *rwkv_wr, *rwkv_wk, *rwkv_wv, *rwkv_wo, *rwkv_w0, *rwkv_w1, *rwkv_w2, *rwkv_a0, *rwkv_a1, *rwkv_a2, *rwkv_g1, *rwkv_g2, *rwkv_kk, *rwkv_ka, *rwkv_rk, *rwkv_ln_g, *rwkv_ln_b,
        *norm_ffn, *moe_wc, *moe_bc, *moe_wf, *moe_bf, *moe_w_gu, *moe_w_down, *ple_norm, *ple_gate, *ple_proj, *final_norm;
};

__device__ __forceinline__ void prep_dense_weights(Frame& F, const In& I, unsigned char* ws) {
    LAS float* scr = (LAS float*)(F.lds + F.wave * 16384);
    const int gw = F.vcu * NWAVES + F.wave, NGW = F.G * NWAVES;
    bf16* WIN = (bf16*)(ws + WS_WIN); bf16* WOUT = (bf16*)(ws + WS_WOUT); bf16* PG = (bf16*)(ws + WS_PGATE); bf16* PPJ = (bf16*)(ws + WS_PPROJ);
    bf16* RCAT = (bf16*)(ws + WS_RCAT); bf16* RL1 = (bf16*)(ws + WS_RL1); bf16* RWO = (bf16*)(ws + WS_RWO);
    constexpr int I_IN = (1024 / 64) * (2560 / 32), I_SQ = (1024 / 64) * (1024 / 32), I_PJ = (256 / 64) * (1024 / 32), I_L64 = (1024 / 64) * (64 / 32), I_L160 = (1024 / 64) * (160 / 32);
    int st = gw;
#define TJOB(MODE, NITEMS, W, K, N, WT, LDO, ROFF, MU) do { for (int it = st; it < (NITEMS); it += NGW) transpose_item<MODE>(W, K, N, WT, LDO, ROFF, MU, scr, it, LANE_); \
        st = (st + NGW - ((NITEMS) % NGW)) % NGW; asm volatile("" : "+s"(st)); } while (0)
    TJOB(0, I_IN, I.ab_w_in, 1024, 2560, WIN, 1024, 0, nullptr);
    TJOB(0, I_SQ, I.ab_w_out, 1024, 1024, WOUT, 1024, 0, nullptr);
    TJOB(0, I_SQ, I.ple_gate, 1024, 1024, PG, 1024, 0, nullptr);
    TJOB(0, I_SQ, I.ple_gate + 1024 * 1024, 1024, 1024, PG + 1024 * 1024, 1024, 0, nullptr);
    TJOB(0, I_SQ, I.rwkv_wo, 1024, 1024, RWO, 1024, 0, nullptr);
    TJOB(0, I_SQ, I.rwkv_wr, 1024, 1024, RCAT, 1024, 0, nullptr);
    TJOB(0, I_SQ, I.rwkv_wk, 1024, 1024, RCAT, 1024, 1024, nullptr);
    TJOB(0, I_SQ, I.rwkv_wv, 1024, 1024, RCAT, 1024, 2048, nullptr);
    TJOB(0, I_PJ, I.ple_proj, 256, 1024, PPJ, 256, 0, nullptr);
    TJOB(0, I_PJ, I.ple_proj + 256 * 1024, 256, 1024, PPJ + 1024 * 256, 256, 0, nullptr);
    TJOB(1, I_L64, I.rwkv_w1, 1024, 64, RL1, 2048, 0, I.rwkv_mu + 1 * 1024);
    TJOB(1, I_L64, I.rwkv_a1, 1024, 64, RL1, 2048, 64, I.rwkv_mu + 4 * 1024);
    TJOB(1, I_L160, I.rwkv_g1, 1024, 160, RL1, 2048, 256, I.rwkv_mu + 5 * 1024);
#undef TJOB
    const int gt = F.vcu * 512 + TID_, NGT = F.G * 512;
    { v4u z = {0u, 0u, 0u, 0u}; const int per_row = 2048 / 8;
      for (int i = gt; i < (128 + 96) * per_row; i += NGT) { int rr = i / per_row, cc = i % per_row; rr = (rr < 128) ? (128 + rr) : (416 + rr - 128); *(GAS v4u*)(RL1 + (size_t)rr * 2048 + cc * 8) = z; } }
    { bf16* S2 = (bf16*)(ws + WS_RS2);
      for (int i = gt; i < 3 * 1024 * 256; i += NGT) { const int ty = i / (1024 * 256), n = (i / 256) & 1023, k = i & 255; float v = 0.f;
          if (ty == 0) { if (k < 64) v = I.rwkv_w2[k * 1024 + n]; } else if (ty == 1) { if (k >= 64 && k < 128) v = I.rwkv_a2[(k - 64) * 1024 + n]; } else { if (k < 160) v = I.rwkv_g2[k * 1024 + n]; }
          S2[i] = (bf16)f2bf(v); } }
    { bf16* RT = (bf16*)(ws + WS_ROUT);
      for (int i = gt; i < 2 * 256 * 1024; i += NGT) { const int l = i / (256 * 1024), n = (i / 1024) & 255, k = i & 1023; float v = 0.f;
          if (n < 4) v = I.moe_wc[(size_t)l * 1024 * 4 + k * 4 + n]; else if (n < 36) v = I.moe_wf[(size_t)l * 1024 * 32 + k * 32 + (n - 4)];
          RT[i] = (bf16)f2bf(v); } }
}
__device__ __forceinline__ void prep_layer_weights(Frame& F, const In& I, unsigned char* ws, int layer) {
    LAS float* scr = (LAS float*)(F.lds + F.wave * 16384);
    const int gw = F.vcu * NWAVES + F.wave, NGW = F.G * NWAVES;
    bf16* MGU = (bf16*)(ws + WS_MGU); bf16* MDN = (bf16*)(ws + WS_MDN);
    const float* wgu = I.moe_w_gu + (size_t)layer * NEXP * 1024 * 1024; const float* wdn = I.moe_w_down + (size_t)layer * NEXP * 512 * 1024;
    constexpr int I_GU = (1024 / 64) * (1024 / 32), I_DN = (512 / 64) * (1024 / 32);
    for (int it = gw; it < NEXP * (I_GU + I_DN); it += NGW) {
        const int e = it / (I_GU + I_DN); int r = it % (I_GU + I_DN);
        if (r < I_GU) transpose_item<2>(wgu + (size_t)e * 1024 * 1024, 1024, 1024, MGU + (size_t)e * 1024 * 1024, 1024, 0, nullptr, scr, r, LANE_);
        else transpose_item<0>(wdn + (size_t)e * 512 * 1024, 512, 1024, MDN + (size_t)e * 1024 * 512, 512, 0, nullptr, scr, r - I_GU, LANE_);
    }
    const int gt = F.vcu * 512 + TID_, NGT = F.G * 512;
    const f32x4* ps = (const f32x4*)(I.p + (size_t)layer * T * PLE); v2u* pd = (v2u*)(ws + WS_PB);
    for (int i = gt; i < T * PLE / 4; i += 4 * NGT) { f32x4 v[4];
#pragma unroll
        for (int r = 0; r < 4; ++r) v[r] = ps[i + r * NGT];
#pragma unroll
        for (int r = 0; r < 4; ++r) { v2u o; o.x = pk2(v[r].x, v[r].y); o.y = pk2(v[r].z, v[r].w); pd[i + r * NGT] = o; } }
}

template <bool XBF>
__device__ __forceinline__ void norm_pass(Frame& F, const void* x, const float* g, bf16* out) {
    const int gw = F.vcu * NWAVES + F.wave, NGW = F.G * NWAVES; const int lane = LANE_;
    for (int t = 4 * gw; t < T; t += 4 * NGW) {
        f32x4 v[4][4];
#pragma unroll
        for (int r = 0; r < 4; ++r) { if (XBF) load_row4_bf((const bf16*)x + (size_t)(t + r) * D, lane, v[r]); else load_row4((const float*)x + (size_t)(t + r) * D, lane, v[r]); }
#pragma unroll
        for (int r = 0; r < 4; ++r) { const float rs = row_rstd(v[r], 1e-6f); store_row_bf16(out + (size_t)(t + r) * D, lane, v[r], rs, g); }
    }
}
__device__ __forceinline__ void rwkv_input_pass(Frame& F, const bf16* x, const float* g, const float* mu, bf16* HCAT, bf16* XR, bf16* XK, bf16* XV) {
    const int gw = F.vcu * NWAVES + F.wave, NGW = F.G * NWAVES; const int lane = LANE_;
    f32x4 gg[4], mr[4], mk[4], mv[4];
#pragma unroll
    for (int j = 0; j < 4; ++j) { gg[j] = ((const f32x4*)g)[lane + 64 * j]; mr[j] = ((const f32x4*)(mu + 0 * 1024))[lane + 64 * j]; mk[j] = ((const f32x4*)(mu + 2 * 1024))[lane + 64 * j]; mv[j] = ((const f32x4*)(mu + 3 * 1024))[lane + 64 * j]; }
    for (int blk = gw; blk < T / 32; blk += NGW) {
        const int t0 = blk * 32; f32x4 hp[4];
        if ((t0 & (SEQ - 1)) == 0) {
#pragma unroll
            for (int j = 0; j < 4; ++j) hp[j] = (f32x4){0.f, 0.f, 0.f, 0.f};
        } else { f32x4 v[4]; load_row4_bf(x + (size_t)(t0 - 1) * D, lane, v); const float rstd = row_rstd(v, 1e-6f);
#pragma unroll
            for (int j = 0; j < 4; ++j) hp[j] = v[j] * rstd * gg[j]; }
        f32x4 vn[4]; load_row4_bf(x + (size_t)t0 * D, lane, vn);
        for (int t = t0; t < t0 + 32; ++t) {
            f32x4 v[4];
#pragma unroll
            for (int j = 0; j < 4; ++j) v[j] = vn[j];
            if (t + 1 < t0 + 32) load_row4_bf(x + (size_t)(t + 1) * D, lane, vn);
            const float rstd = row_rstd(v, 1e-6f);
            unsigned long long* oh = (unsigned long long*)(HCAT + (size_t)t * 2048) + lane; unsigned long long* or_ = (unsigned long long*)(XR + (size_t)t * 1024) + lane;
            unsigned long long* ok = (unsigned long long*)(XK + (size_t)t * 1024) + lane; unsigned long long* ov = (unsigned long long*)(XV + (size_t)t * 1024) + lane;
#pragma unroll
            for (int j = 0; j < 4; ++j) { const f32x4 h = v[j] * rstd * gg[j], dd = hp[j] - h;
                oh[64 * j] = (unsigned long long)pk2(h.x, h.y) | ((unsigned long long)pk2(h.z, h.w) << 32);
                oh[256 + 64 * j] = (unsigned long long)pk2(hp[j].x, hp[j].y) | ((unsigned long long)pk2(hp[j].z, hp[j].w) << 32);
                const f32x4 a = h + dd * mr[j], b = h + dd * mk[j], c = h + dd * mv[j];
                or_[64 * j] = (unsigned long long)pk2(a.x, a.y) | ((unsigned long long)pk2(a.z, a.w) << 32);
                ok[64 * j] = (unsigned long long)pk2(b.x, b.y) | ((unsigned long long)pk2(b.z, b.w) << 32);
                ov[64 * j] = (unsigned long long)pk2(c.x, c.y) | ((unsigned long long)pk2(c.z, c.w) << 32);
                hp[j] = h; }
        }
    }
}
__device__ __forceinline__ void combine_norm_pass(Frame& F, const bf16* xin, bf16* xout, const bf16* YS, const int* slot, const float* g, bf16* out) {
    const int gw = F.vcu * NWAVES + F.wave, NGW = F.G * NWAVES; const int lane = LANE_;
    for (int t = 2 * gw; t < T; t += 2 * NGW) {
        f32x4 v[2][4]; v2u ya[2][4], yb[2][4];
#pragma unroll
        for (int r = 0; r < 2; ++r) { load_row4_bf(xin + (size_t)(t + r) * D, lane, v[r]);
            const int s0 = slot[2 * (t + r)], s1 = slot[2 * (t + r) + 1];
            const v2u* y0 = (const v2u*)(YS + (size_t)s0 * D) + lane; const v2u* y1 = (const v2u*)(YS + (size_t)s1 * D) + lane;
#pragma unroll
            for (int j = 0; j < 4; ++j) { ya[r][j] = y0[64 * j]; yb[r][j] = y1[64 * j]; } }
#pragma unroll
        for (int r = 0; r < 2; ++r) {
#pragma unroll
            for (int j = 0; j < 4; ++j) { const v2u a = ya[r][j], b = yb[r][j];
                v[r][j].x += bflo(a.x) + bflo(b.x); v[r][j].y += bfhi(a.x) + bfhi(b.x); v[r][j].z += bflo(a.y) + bflo(b.y); v[r][j].w += bfhi(a.y) + bfhi(b.y); }
            store_row4_bf(xout + (size_t)(t + r) * D, lane, v[r]);
            const float rstd = row_rstd(v[r], 1e-6f);
            store_row_bf16(out + (size_t)(t + r) * D, lane, v[r], rstd, g); }
    }
}
__device__ __forceinline__ void final_norm_pass(Frame& F, const bf16* x, float* out, const float* g) {
    const int gw = F.vcu * NWAVES + F.wave, NGW = F.G * NWAVES; const int lane = LANE_;
    for (int t = 4 * gw; t < T; t += 4 * NGW) {
        f32x4 v[4][4];
#pragma unroll
        for (int r = 0; r < 4; ++r) load_row4_bf(x + (size_t)(t + r) * D, lane, v[r]);
#pragma unroll
        for (int r = 0; r < 4; ++r) { const float rs = row_rstd(v[r], 1e-6f); f32x4* xo = (f32x4*)(out + (size_t)(t + r) * D) + lane;
#pragma unroll
            for (int j = 0; j < 4; ++j) { const f32x4 gg = ((const f32x4*)g)[lane + 64 * j]; xo[64 * j] = v[r][j] * rs * gg; } }
    }
}

__device__ __forceinline__ void diff_combine_pass(Frame& F, const In& I, const bf16* O, bf16* YCAT) {
    const int gw = F.vcu * NWAVES + F.wave, NGW = F.G * NWAVES;
    const float lam_init = 0.2f;
    const float d1 = wave_sum(I.lam_q1[LANE_] * I.lam_k1[LANE_]), d2 = wave_sum(I.lam_q2[LANE_] * I.lam_k2[LANE_]);
    const float lam = expf(d1) - expf(d2) + lam_init;
    const int h = LANE_ >> 4, q = LANE_ & 15;
    float sg[8];
#pragma unroll
    for (int e = 0; e < 8; ++e) sg[e] = I.sub_g[q * 8 + e] * (1.0f - lam_init);
    for (int t0 = 4 * gw; t0 < T; t0 += 4 * NGW) {
        v4u av[4], bv[4];
#pragma unroll
        for (int r = 0; r < 4; ++r) { av[r] = *(const v4u*)(O + (size_t)(t0 + r) * 1024 + h * 256 + q * 8); bv[r] = *(const v4u*)(O + (size_t)(t0 + r) * 1024 + h * 256 + 128 + q * 8); }
#pragma unroll
        for (int r = 0; r < 4; ++r) { const v4u a = av[r], b = bv[r]; const int t = t0 + r;
        float o[8];
        o[0] = bflo(a.x) - lam * bflo(b.x); o[1] = bfhi(a.x) - lam * bfhi(b.x); o[2] = bflo(a.y) - lam * bflo(b.y); o[3] = bfhi(a.y) - lam * bfhi(b.y);
        o[4] = bflo(a.z) - lam * bflo(b.z); o[5] = bfhi(a.z) - lam * bfhi(b.z); o[6] = bflo(a.w) - lam * bflo(b.w); o[7] = bfhi(a.w) - lam * bfhi(b.w);
        float s = 0.f;
#pragma unroll
        for (int e = 0; e < 8; ++e) s += o[e] * o[e];
        s += __shfl_xor(s, 1); s += __shfl_xor(s, 2); s += __shfl_xor(s, 4); s += __shfl_xor(s, 8);
        const float rstd = 1.0f / sqrtf(s * (1.0f / 128.0f) + 1e-5f);
        v4u w; w.x = pk2(o[0] * rstd * sg[0], o[1] * rstd * sg[1]); w.y = pk2(o[2] * rstd * sg[2], o[3] * rstd * sg[3]); w.z = pk2(o[4] * rstd * sg[4], o[5] * rstd * sg[5]); w.w = pk2(o[6] * rstd * sg[6], o[7] * rstd * sg[7]);
        *(v4u*)(YCAT + (size_t)t * 1024 + h * 128 + q * 8) = w; }
    }
}

constexpr int LCT = 64, LNCH = SEQ / LCT;
__device__ __forceinline__ float gelu_tanh(float x) { const float u = 0.7978845608028654f * (x + 0.044715f * x * x * x); return x * sigmoidf_(2.0f * u); }
template <bool FINAL>
__device__ __forceinline__ void lru_phase(Frame& F, const In& I, const bf16* XB, const bf16* GB, f32x2* AGG, bf16* YCAT, bf16* HLp, bf16* CAp) {
    const int ch = TID_, n = ch >> 6, d = ch & 63;
    LAS float* U = (LAS float*)F.lds;
    f32x2 wg[64];
#pragma unroll
    for (int c = 0; c < 64; ++c) { wg[c].x = I.lru_wa[n * 4096 + c * 64 + d]; wg[c].y = I.lru_wx[n * 4096 + c * 64 + d]; }
    const float cw0 = I.conv_w[0 * 512 + ch], cw1 = I.conv_w[1 * 512 + ch], cw2 = I.conv_w[2 * 512 + ch], cw3 = I.conv_w[3 * 512 + ch], cb = I.conv_b[ch];
    const float ba = I.lru_ba[ch], bx = I.lru_bx[ch];
    const float lam = I.lru_lambda[ch]; const float sp = (lam > 15.f) ? expf(-lam) : log1pf(expf(-lam));
    const float m8sp = -8.0f * sp;
    for (int un = blockIdx.x; un < NB * LNCH; un += F.G) {
        const int b = un / LNCH, c = un % LNCH; const size_t row0 = (size_t)b * SEQ + (size_t)c * LCT;
        unsigned short xraw[LCT + 3];
        if (c > 0) { xraw[0] = XB[(row0 - 3) * 512 + ch]; xraw[1] = XB[(row0 - 2) * 512 + ch]; xraw[2] = XB[(row0 - 1) * 512 + ch]; } else { xraw[0] = 0; xraw[1] = 0; xraw[2] = 0; }
#pragma unroll
        for (int tk = 0; tk < LCT; ++tk) xraw[3 + tk] = XB[(row0 + tk) * 512 + ch];
        float h = 0.f, Ap = 1.f;
        if (FINAL) { for (int j = 0; j < c; ++j) { const f32x2 ag = AGG[((size_t)b * LNCH + j) * 512 + ch]; h = ag.x * h + ag.y; } }
#pragma unroll
        for (int tk = 0; tk < LCT; ++tk) U[tk * 512 + ch] = cw0 * bf1(xraw[tk]) + cw1 * bf1(xraw[tk + 1]) + cw2 * bf1(xraw[tk + 2]) + cw3 * bf1(xraw[tk + 3]) + cb;
        __syncthreads();
        unsigned short gcur[8], gnxt[8];
        if (FINAL) {
#pragma unroll
            for (int j = 0; j < 8; ++j) gcur[j] = GB[(row0 + j) * 512 + ch]; }
#pragma unroll 1
        for (int tg = 0; tg < LCT / 8; ++tg) {
            if (FINAL) { const int tn = (tg + 1 < LCT / 8) ? (tg + 1) * 8 : tg * 8;
#pragma unroll
                for (int j = 0; j < 8; ++j) gnxt[j] = GB[(row0 + tn + j) * 512 + ch]; }
#pragma unroll
            for (int j = 0; j < 8; ++j) { const int tk = tg * 8 + j;
                const LAS f32x4* up = (const LAS f32x4*)(U + tk * 512 + n * 64);
                f32x2 acc = {ba, bx};
#pragma unroll
                for (int c4 = 0; c4 < 16; ++c4) { const f32x4 uu = up[c4];
                    acc += wg[4 * c4 + 0] * uu.x; acc += wg[4 * c4 + 1] * uu.y; acc += wg[4 * c4 + 2] * uu.z; acc += wg[4 * c4 + 3] * uu.w; }
                const float r = sigmoidf_(acc.x), ig = sigmoidf_(acc.y);
                const float la = r * m8sp; const float a = __expf(la); const float t2 = 2.0f * la; const float om = (t2 > -0.02f) ? -t2 * (1.0f + t2 * (0.5f + t2 * (0.16666667f + t2 * 0.041666668f))) : 1.0f - a * a; const float bb = __builtin_amdgcn_sqrtf(om) * (ig * U[tk * 512 + ch]);
                h = a * h + bb;
                if (FINAL) { YCAT[(row0 + tk) * 1024 + 512 + ch] = (bf16)f2bf(h * gelu_tanh(bf1(gcur[j]))); }
                else { Ap *= a; HLp[(row0 + tk) * 512 + ch] = (bf16)f2bf(h); CAp[(row0 + tk) * 512 + ch] = (bf16)f2bf(Ap); } }
            if (FINAL) {
#pragma unroll
                for (int j = 0; j < 8; ++j) gcur[j] = gnxt[j]; }
        }
        if (!FINAL) { f32x2 ag; ag.x = Ap; ag.y = h; AGG[((size_t)b * LNCH + c) * 512 + ch] = ag; }
        __syncthreads();
    }
}

__device__ __forceinline__ void lru_agg_mfma(Frame& F, const In& I, const bf16* XB, f32x2* AGG, bf16* HLp, bf16* CAp) {
    const int tid = TID_, lane = tid & 63, fr = lane & 15, fq = lane >> 4, n = F.wave, ch = tid;
    constexpr int UP = 520;
    LAS bf16* U = (LAS bf16*)F.lds;
    bf16x8 Wr[4][2], Wi[4][2];
#pragma unroll
    for (int dd = 0; dd < 4; ++dd)
#pragma unroll
        for (int kh = 0; kh < 2; ++kh) { unsigned pr_[4], pi_[4];
#pragma unroll
            for (int j = 0; j < 4; ++j) { const int c0 = 32 * kh + 8 * fq + 2 * j, d = 16 * dd + fr;
                pr_[j] = pk2(I.lru_wa[n * 4096 + c0 * 64 + d], I.lru_wa[n * 4096 + (c0 + 1) * 64 + d]); pi_[j] = pk2(I.lru_wx[n * 4096 + c0 * 64 + d], I.lru_wx[n * 4096 + (c0 + 1) * 64 + d]); }
            Wr[dd][kh] = __builtin_bit_cast(bf16x8, (v4u){pr_[0], pr_[1], pr_[2], pr_[3]}); Wi[dd][kh] = __builtin_bit_cast(bf16x8, (v4u){pi_[0], pi_[1], pi_[2], pi_[3]}); }
    float cba[4], cbx[4], cm8[4];
#pragma unroll
    for (int dd = 0; dd < 4; ++dd) { const int chd = 64 * n + 16 * dd + fr; cba[dd] = I.lru_ba[chd]; cbx[dd] = I.lru_bx[chd];
        const float lam = I.lru_lambda[chd]; cm8[dd] = -8.0f * ((lam > 15.f) ? expf(-lam) : log1pf(expf(-lam))); }
    const float cw0 = I.conv_w[0 * 512 + ch], cw1 = I.conv_w[1 * 512 + ch], cw2 = I.conv_w[2 * 512 + ch], cw3 = I.conv_w[3 * 512 + ch], cb = I.conv_b[ch];
    for (int un = blockIdx.x; un < NB * LNCH; un += F.G) {
        const int b = un / LNCH, c = un % LNCH; const size_t row0 = (size_t)b * SEQ + (size_t)c * LCT;
        unsigned short xraw[LCT + 3];
        if (c > 0) { xraw[0] = XB[(row0 - 3) * 512 + ch]; xraw[1] = XB[(row0 - 2) * 512 + ch]; xraw[2] = XB[(row0 - 1) * 512 + ch]; } else { xraw[0] = 0; xraw[1] = 0; xraw[2] = 0; }
#pragma unroll
        for (int tk = 0; tk < LCT; ++tk) xraw[3 + tk] = XB[(row0 + tk) * 512 + ch];
#pragma unroll
        for (int tk = 0; tk < LCT; ++tk) U[tk * UP + ch] = (bf16)f2bf(cw0 * bf1(xraw[tk]) + cw1 * bf1(xraw[tk + 1]) + cw2 * bf1(xraw[tk + 2]) + cw3 * bf1(xraw[tk + 3]) + cb);
        __syncthreads();
        bf16x8 X[4][2];
#pragma unroll
        for (int tt = 0; tt < 4; ++tt)
#pragma unroll
            for (int kh = 0; kh < 2; ++kh) X[tt][kh] = *(const LAS bf16x8*)(U + (16 * tt + fr) * UP + 64 * n + 32 * kh + 8 * fq);
#pragma unroll 1
        for (int dd = 0; dd < 4; ++dd) {
            bf16x8 wr0, wr1, wi0, wi1; float kba, kbx, km8;
            if (dd == 0) { wr0 = Wr[0][0]; wr1 = Wr[0][1]; wi0 = Wi[0][0]; wi1 = Wi[0][1]; kba = cba[0]; kbx = cbx[0]; km8 = cm8[0]; }
            else if (dd == 1) { wr0 = Wr[1][0]; wr1 = Wr[1][1]; wi0 = Wi[1][0]; wi1 = Wi[1][1]; kba = cba[1]; kbx = cbx[1]; km8 = cm8[1]; }
            else if (dd == 2) { wr0 = Wr[2][0]; wr1 = Wr[2][1]; wi0 = Wi[2][0]; wi1 = Wi[2][1]; kba = cba[2]; kbx = cbx[2]; km8 = cm8[2]; }
            else { wr0 = Wr[3][0]; wr1 = Wr[3][1]; wi0 = Wi[3][0]; wi1 = Wi[3][1]; kba = cba[3]; kbx = cbx[3]; km8 = cm8[3]; }
            const int chd = 64 * n + 16 * dd + fr;
            float hc = 0.f, Ac = 1.f;
#pragma unroll
            for (int tt = 0; tt < 4; ++tt) {
                f32x4 pr = (f32x4){0.f, 0.f, 0.f, 0.f}, pi = pr;
                pr = __builtin_amdgcn_mfma_f32_16x16x32_bf16(X[tt][0], wr0, pr, 0, 0, 0); pr = __builtin_amdgcn_mfma_f32_16x16x32_bf16(X[tt][1], wr1, pr, 0, 0, 0);
                pi = __builtin_amdgcn_mfma_f32_16x16x32_bf16(X[tt][0], wi0, pi, 0, 0, 0); pi = __builtin_amdgcn_mfma_f32_16x16x32_bf16(X[tt][1], wi1, pi, 0, 0, 0);
                float a[4], bb[4];
#pragma unroll
                for (int e = 0; e < 4; ++e) { const int tok = 16 * tt + 4 * fq + e; const float u = bf1(U[tok * UP + chd]);
                    const float r = sigmoidf_(pr[e] + kba), ig = sigmoidf_(pi[e] + kbx); const float la = r * km8; a[e] = __expf(la); const float t2 = 2.0f * la;
                    const float om = (t2 > -0.02f) ? -t2 * (1.0f + t2 * (0.5f + t2 * (0.16666667f + t2 * 0.041666668f))) : 1.0f - a[e] * a[e]; bb[e] = __builtin_amdgcn_sqrtf(om) * (ig * u); }
                const float A4 = (a[0] * a[1]) * (a[2] * a[3]); const float B4 = ((bb[0] * a[1] + bb[1]) * a[2] + bb[2]) * a[3] + bb[3];
                float h = hc, Ap = Ac, hs = hc, As = Ac;
#pragma unroll
                for (int j = 0; j < 4; ++j) { const float Aj = __shfl(A4, fr + 16 * j), Bj = __shfl(B4, fr + 16 * j); if (j == fq) { hs = h; As = Ap; } h = Aj * h + Bj; Ap *= Aj; }
                hc = h; Ac = Ap; h = hs; Ap = As;
#pragma unroll
                for (int e = 0; e < 4; ++e) { h = a[e] * h + bb[e]; Ap *= a[e]; const size_t o = (row0 + 16 * tt + 4 * fq + e) * 512 + chd; HLp[o] = (bf16)f2bf(h); CAp[o] = (bf16)f2bf(Ap); }
            }
            if (fq == 0) { f32x2 ag; ag.x = Ac; ag.y = hc; AGG[((size_t)b * LNCH + c) * 512 + chd] = ag; }
        }
        __syncthreads();
    }
}

__device__ __forceinline__ void lru_final_pass(Frame& F, const bf16* HLp, const bf16* CAp, const bf16* GB, const f32x2* AGG, bf16* YCAT) {
    const int ch = TID_;
    for (int un = blockIdx.x; un < NB * LNCH; un += F.G) {
        const int b = un / LNCH, c = un % LNCH; const size_t row0 = (size_t)b * SEQ + (size_t)c * LCT;
        float carry = 0.f;
        for (int j = 0; j < c; ++j) { const f32x2 ag = AGG[((size_t)b * LNCH + j) * 512 + ch]; carry = ag.x * carry + ag.y; }
#pragma unroll 4
        for (int t8 = 0; t8 < LCT; t8 += 8) {
            bf16 hl[8], ca[8], gv[8];
#pragma unroll
            for (int j = 0; j < 8; ++j) { const size_t o = (row0 + t8 + j) * 512 + ch; hl[j] = HLp[o]; ca[j] = CAp[o]; gv[j] = GB[o]; }
#pragma unroll
            for (int j = 0; j < 8; ++j) { const float h = bf1(hl[j]) + bf1(ca[j]) * carry; YCAT[(row0 + t8 + j) * 1024 + 512 + ch] = (bf16)f2bf(h * gelu_tanh(bf1(gv[j]))); }
        }
    }
}

__device__ __forceinline__ void route_pass_a(Frame& F, const In& I, int layer, const float* LOG, unsigned char* rt, gu32* cnt) {
    LAS int* lcnt = (LAS int*)(F.lds + RTE_OFF); LAS int* lbase = lcnt + 32;
    int* EID = (int*)(rt + RT_EID); int* POS = (int*)(rt + RT_POS); float* GATE = (float*)(rt + RT_GATE);
    const float* bc = I.moe_bc + layer * 4; const float* bfb = I.moe_bf + layer * 32;
    for (int un = blockIdx.x; un < T / 512; un += F.G) {
        if (TID_ < 32) lcnt[TID_] = 0;
        __syncthreads();
        const int t = un * 512 + TID_; const float* lg = LOG + (size_t)t * 64;
        const f32x4 g4 = *(const f32x4*)lg;
        float gl[4] = {g4.x + bc[0], g4.y + bc[1], g4.z + bc[2], g4.w + bc[3]};
        int gi = 0; float gm = gl[0];
#pragma unroll
        for (int j = 1; j < 4; ++j) if (gl[j] > gm) { gm = gl[j]; gi = j; }
        float gs = 0.f;
#pragma unroll
        for (int j = 0; j < 4; ++j) gs += __expf(gl[j] - gm);
        const float gprob = 1.0f / gs;
        const f32x4 e0 = *(const f32x4*)(lg + 4 + gi * 8), e1 = *(const f32x4*)(lg + 8 + gi * 8);
        float el[8] = {e0.x, e0.y, e0.z, e0.w, e1.x, e1.y, e1.z, e1.w};
#pragma unroll
        for (int j = 0; j < 8; ++j) el[j] += bfb[gi * 8 + j];
        int i0 = 0; float m0 = el[0];
#pragma unroll
        for (int j = 1; j < 8; ++j) if (el[j] > m0) { m0 = el[j]; i0 = j; }
        int i1 = -1; float m1 = -INFINITY;
#pragma unroll
        for (int j = 0; j < 8; ++j) if (j != i0 && el[j] > m1) { m1 = el[j]; i1 = j; }
        const float r1 = __expf(m1 - m0); const float g0 = gprob / (1.0f + r1), g1 = gprob * r1 / (1.0f + r1);
        const int ex0 = gi * 8 + i0, ex1 = gi * 8 + i1;
        const int p0 = atomicAdd((int*)&lcnt[ex0], 1), p1 = atomicAdd((int*)&lcnt[ex1], 1);
        __syncthreads();
        if (TID_ < 32) lbase[TID_] = (int)__hip_atomic_fetch_add(cnt + TID_, (unsigned)lcnt[TID_], RLX_AGENT);
        __syncthreads();
        EID[2 * t] = ex0; EID[2 * t + 1] = ex1; POS[2 * t] = lbase[ex0] + p0; POS[2 * t + 1] = lbase[ex1] + p1; GATE[2 * t] = g0; GATE[2 * t + 1] = g1;
        __syncthreads();
    }
}
__device__ __forceinline__ void route_bases(Frame& F, gu32* cnt) {
    LAS int* eb = (LAS int*)(F.lds + RTE_OFF + 512);
    const int tid = TID_;
    if (tid < 64) {
        const int c = (tid < 32) ? (int)__hip_atomic_load(cnt + (tid & 31), RLX_AGENT) : 0; const int p = (c + 255) & ~255; int s = p;
#pragma unroll
        for (int o = 1; o < 32; o <<= 1) { const int t = __shfl_up(s, o); if ((tid & 63) >= o) s += t; }
        if (tid < 32) { eb[tid] = s - p; if (tid == 31) eb[32] = s; }
    }
    __syncthreads();
}
__device__ __forceinline__ void route_pass_b(Frame& F, unsigned char* rt, gu32* cnt) {
    route_bases(F, cnt);
    LAS int* eb = (LAS int*)(F.lds + RTE_OFF + 512);
    const int* EID = (const int*)(rt + RT_EID); const int* POS = (const int*)(rt + RT_POS); const float* GATE = (const float*)(rt + RT_GATE);
    int* ROWTOK = (int*)(rt + RT_ROWTOK); float* ROWGATE = (float*)(rt + RT_ROWGATE); int* SLOT = (int*)(rt + RT_SLOT);
    const int gt = F.vcu * 512 + TID_, NGT = F.G * 512;
    for (int i = gt; i < 2 * T; i += NGT) { const int dst = eb[EID[i]] + POS[i]; ROWTOK[dst] = i >> 1; ROWGATE[dst] = GATE[i]; SLOT[i] = dst; }
    for (int i = gt; i < 32 * 256; i += NGT) { const int e = i >> 8, j = i & 255; const int c = (int)__hip_atomic_load(cnt + e, RLX_AGENT); const int pad = ((c + 255) & ~255) - c;
        if (j < pad) { ROWTOK[eb[e] + c + j] = 0; ROWGATE[eb[e] + c + j] = 0.f; } }
    __syncthreads();
}
struct MoeOrder {
    int G, c, ntiles; const LAS int* eb; const char* A; const char* W; size_t astep, wexp, wtile; bool gather;
    __device__ bool next(int i, pg8::Unit& u) const {
        const int L = i * G + c; if (L >= ntiles * 4) return false;
        u.pm = L >> 2; u.pn = L & 3; const int s0 = u.pm * 256; int e = 0;
#pragma unroll 1
        for (int j = 1; j < 32; ++j) if (eb[j] <= s0) e = j;
        e = __builtin_amdgcn_readfirstlane(e); u.aux = e; u.A = gather ? A : A + (size_t)u.pm * astep; u.B = W + (size_t)e * wexp + (size_t)u.pn * wtile; return true;
    }
};

constexpr int RTC = 32, RNCH = SEQ / RTC, RTOK = 352;
#define LBAR() do { asm volatile("s_waitcnt lgkmcnt(0)" ::: "memory"); __builtin_amdgcn_s_barrier(); asm volatile("" ::: "memory"); } while (0)
template <int CTRL> __device__ __forceinline__ float dpp_f(float v) { return __builtin_bit_cast(float, __builtin_amdgcn_update_dpp(0, __builtin_bit_cast(int, v), CTRL, 0xf, 0xf, true)); }
__device__ __forceinline__ float red16(float v) { v += dpp_f<0xB1>(v); v += dpp_f<0x4E>(v); v += dpp_f<0x141>(v); v += dpp_f<0x140>(v); return v; }
__device__ __forceinline__ float red8(float v) { v += dpp_f<0xB1>(v); v += dpp_f<0x4E>(v); v += dpp_f<0x141>(v); return v; }
__device__ __forceinline__ void unpack8(const v4u w, float (&f)[8]) { f[0] = bflo(w.x); f[1] = bfhi(w.x); f[2] = bflo(w.y); f[3] = bfhi(w.y); f[4] = bflo(w.z); f[5] = bfhi(w.z); f[6] = bflo(w.w); f[7] = bfhi(w.w); }
__device__ __forceinline__ void rwkv_scan_phase(Frame& F, const In& I, const bf16* R, const bf16* Kt, const bf16* V, const bf16* AA, const bf16* EW, bf16* Y) {
    LAS float* buf = (LAS float*)F.lds;
    LAS float* ybuf = (LAS float*)(F.lds + 2 * RTC * RTOK * 4) + 32;
    const int tid = TID_, lane = tid & 63;
    const int seg = lane & 15, rl = F.wave * 4 + (lane >> 4);
    const int stk = tid >> 4, ssg = tid & 15;
    for (int un = blockIdx.x; un < NB * 16 * 2; un += F.G) {
        const int half = un & 1, h = (un >> 1) & 15, b = un >> 5;
        const size_t rowb = (size_t)b * SEQ;
        const int col = h * 64 + ssg * 4;
        const f32x4 kkw = *(const f32x4*)(I.rwkv_kk + col), kaw = *(const f32x4*)(I.rwkv_ka + col);
        v2u rr, kr, vr, ar, er;
#define RAW_LOAD(cc) do { const size_t off = (rowb + (size_t)(cc) * RTC + stk) * 1024 + col; rr = *(const v2u*)(R + off); kr = *(const v2u*)(Kt + off); vr = *(const v2u*)(V + off); ar = *(const v2u*)(AA + off); er = *(const v2u*)(EW + off); } while (0)
#define RAW_CONVERT(cc) do { LAS float* tp = buf + ((cc) & 1) * (RTC * RTOK) + stk * RTOK + ssg * 4; \
            const float r0 = bflo(rr.x), r1 = bfhi(rr.x), r2 = bflo(rr.y), r3 = bfhi(rr.y), k0 = bflo(kr.x), k1 = bfhi(kr.x), k2 = bflo(kr.y), k3 = bfhi(kr.y); \
            const float a0 = bflo(ar.x), a1 = bfhi(ar.x), a2 = bflo(ar.y), a3 = bfhi(ar.y); \
            const float x0 = k0 * kkw.x, x1 = k1 * kkw.y, x2 = k2 * kkw.z, x3 = k3 * kkw.w; \
            const float ss = red16((x0 * x0 + x1 * x1) + (x2 * x2 + x3 * x3)); const float inv = __builtin_amdgcn_rsqf(fmaxf(ss, 1e-24f)); \
            *(LAS f32x4*)(tp) = (f32x4){__expf(-bflo(er.x)), __expf(-bfhi(er.x)), __expf(-bflo(er.y)), __expf(-bfhi(er.y))}; \
            const f32x4 kkv = (f32x4){x0 * inv, x1 * inv, x2 * inv, x3 * inv}; *(LAS f32x4*)(tp + 64) = kkv; \
            *(LAS f32x4*)(tp + 128) = (f32x4){kkv.x * a0, kkv.y * a1, kkv.z * a2, kkv.w * a3}; \
            *(LAS f32x4*)(tp + 192) = (f32x4){k0 * (1.0f + (a0 - 1.0f) * kaw.x), k1 * (1.0f + (a1 - 1.0f) * kaw.y), k2 * (1.0f + (a2 - 1.0f) * kaw.z), k3 * (1.0f + (a3 - 1.0f) * kaw.w)}; \
            *(LAS f32x4*)(tp + 256) = (f32x4){r0, r1, r2, r3}; \
            if ((ssg >> 3) == half) *(LAS f32x4*)(buf + ((cc) & 1) * (RTC * RTOK) + stk * RTOK + 320 + (ssg & 7) * 4) = (f32x4){bflo(vr.x), bfhi(vr.x), bflo(vr.y), bfhi(vr.y)}; } while (0)
#define Y_WRITE(cc) do { const LAS f32x2* yp = (const LAS f32x2*)(ybuf + ((cc) & 1) * (RTC * 32 + 32) + stk * 32 + ssg * 2); const f32x2 yv = *yp; \
            *(unsigned*)(Y + (rowb + (size_t)(cc) * RTC + stk) * 1024 + h * 64 + half * 32 + ssg * 2) = pk2(yv.x, yv.y); } while (0)
        RAW_LOAD(0); RAW_CONVERT(0); RAW_LOAD(1);
        f32x2 S0 = (f32x2){0.f, 0.f}, S1 = (f32x2){0.f, 0.f};
        LBAR();
        for (int c = 0; c < RNCH; ++c) {
            if (c + 1 < RNCH) { RAW_CONVERT(c + 1); }
            if (c + 2 < RNCH) { RAW_LOAD(c + 2); }
            if (c >= 1) { Y_WRITE(c - 1); }
            const LAS float* cb = buf + (c & 1) * (RTC * RTOK); LAS float* yb = ybuf + (c & 1) * (RTC * 32 + 32);
            const LAS float* tp0 = cb + seg * 4; const LAS float* vp0 = cb + 320 + rl;
#define SV_DECL(X) f32x4 X##w, X##q, X##b, X##k, X##r; float X##v
#define SV_LOAD(X, tk) do { const LAS float* tp = tp0 + (tk) * RTOK; \
                X##w = *(const LAS f32x4*)(tp); X##q = *(const LAS f32x4*)(tp + 64); X##b = *(const LAS f32x4*)(tp + 128); X##k = *(const LAS f32x4*)(tp + 192); X##r = *(const LAS f32x4*)(tp + 256); X##v = vp0[(tk) * RTOK]; } while (0)
#define SV_STEP(X, tk) do { \
                const f32x2 d = S0 * (f32x2){X##q.x, X##q.y} + S1 * (f32x2){X##q.z, X##q.w}; \
                const f32x2 t0 = S0 * (f32x2){X##w.x, X##w.y} + (f32x2){X##k.x, X##k.y} * X##v, t1 = S1 * (f32x2){X##w.z, X##w.w} + (f32x2){X##k.z, X##k.w} * X##v; \
                float ra = d.x + d.y, rb = epend;                   \
                ra += dpp_f<0xB1>(ra); rb += dpp_f<0xB1>(rb); ra += dpp_f<0x4E>(ra); rb += dpp_f<0x4E>(rb); ra += dpp_f<0x141>(ra); rb += dpp_f<0x141>(rb); ra += dpp_f<0x140>(ra); rb += dpp_f<0x140>(rb); \
                if (seg == 0) yb[((tk) - 1) * 32 + rl] = rb;        \
                const float sa = -ra; \
                S0 = t0 + (f32x2){X##b.x, X##b.y} * sa; S1 = t1 + (f32x2){X##b.z, X##b.w} * sa; \
                const f32x2 e = S0 * (f32x2){X##r.x, X##r.y} + S1 * (f32x2){X##r.z, X##r.w}; epend = e.x + e.y; } while (0)
            SV_DECL(A_); SV_DECL(B_); float epend = 0.f;
            SV_LOAD(A_, 0);
#pragma unroll 1
            for (int tk = 0; tk < RTC; tk += 2) {
                SV_LOAD(B_, tk + 1);
                SV_STEP(A_, tk);
                { const int t2 = (tk + 2 < RTC) ? tk + 2 : RTC - 1; SV_LOAD(A_, t2); }
                SV_STEP(B_, tk + 1);
            }
#undef SV_DECL
#undef SV_LOAD
#undef SV_STEP
            { const float rb = red16(epend); if (seg == 0) yb[(RTC - 1) * 32 + rl] = rb; }
            LBAR();
        }
        Y_WRITE(RNCH - 1);
        LBAR();
#undef RAW_LOAD
#undef RAW_CONVERT
#undef Y_WRITE
    }
}
__device__ __forceinline__ void rwkv_post_pass(Frame& F, const In& I, const bf16* R, const bf16* Kt, const bf16* V, const bf16* AA, const bf16* G, bf16* Y) {
    const int gw = F.vcu * NWAVES + F.wave, NGW = F.G * NWAVES; const int col = LANE_ * 16;
    for (int t0 = 2 * gw; t0 < T; t0 += 2 * NGW) {
        v4u py[2][2], pr[2][2], pk[2][2], pv[2][2], pa[2][2], pg[2][2];
#pragma unroll
        for (int rw = 0; rw < 2; ++rw) { const size_t off = (size_t)(t0 + rw) * 1024 + col;
#pragma unroll
            for (int hf = 0; hf < 2; ++hf) { py[rw][hf] = *(const v4u*)(Y + off + hf * 8); pr[rw][hf] = *(const v4u*)(R + off + hf * 8); pk[rw][hf] = *(const v4u*)(Kt + off + hf * 8);
                pv[rw][hf] = *(const v4u*)(V + off + hf * 8); pa[rw][hf] = *(const v4u*)(AA + off + hf * 8); pg[rw][hf] = *(const v4u*)(G + off + hf * 8); } }
#pragma unroll
        for (int rw = 0; rw < 2; ++rw) { const size_t off = (size_t)(t0 + rw) * 1024 + col;
            float kaw[16], rkw[16], lng[16], lnb[16];
#pragma unroll
            for (int e4 = 0; e4 < 4; ++e4) { const f32x4 c0 = *(const GAS f32x4*)(I.rwkv_ka + col + 4 * e4), c1 = *(const GAS f32x4*)(I.rwkv_rk + col + 4 * e4), c2 = *(const GAS f32x4*)(I.rwkv_ln_g + col + 4 * e4), c3 = *(const GAS f32x4*)(I.rwkv_ln_b + col + 4 * e4);
#pragma unroll
                for (int e = 0; e < 4; ++e) { kaw[4 * e4 + e] = c0[e]; rkw[4 * e4 + e] = c1[e]; lng[4 * e4 + e] = c2[e]; lnb[4 * e4 + e] = c3[e]; } }
            float y[16], r[16], k[16], v[16], a[16], g[16];
#pragma unroll
            for (int hf = 0; hf < 2; ++hf) { float t8[8];
                unpack8(py[rw][hf], t8);
#pragma unroll
                for (int e = 0; e < 8; ++e) y[hf * 8 + e] = t8[e];
                unpack8(pr[rw][hf], t8);
#pragma unroll
                for (int e = 0; e < 8; ++e) r[hf * 8 + e] = t8[e];
                unpack8(pk[rw][hf], t8);
#pragma unroll
                for (int e = 0; e < 8; ++e) k[hf * 8 + e] = t8[e];
                unpack8(pv[rw][hf], t8);
#pragma unroll
                for (int e = 0; e < 8; ++e) v[hf * 8 + e] = t8[e];
                unpack8(pa[rw][hf], t8);
#pragma unroll
                for (int e = 0; e < 8; ++e) a[hf * 8 + e] = t8[e];
                unpack8(pg[rw][hf], t8);
#pragma unroll
                for (int e = 0; e < 8; ++e) g[hf * 8 + e] = t8[e]; }
            float s = 0.f, bs = 0.f;
#pragma unroll
            for (int e = 0; e < 16; ++e) { s += y[e]; const float kp = k[e] * (1.0f + (a[e] - 1.0f) * kaw[e]); bs += r[e] * kp * rkw[e]; }
            s += __shfl_xor(s, 1); s += __shfl_xor(s, 2); bs += __shfl_xor(bs, 1); bs += __shfl_xor(bs, 2);
            const float mean = s * (1.0f / 64.0f); float q = 0.f;
#pragma unroll
            for (int e = 0; e < 16; ++e) { const float dd = y[e] - mean; q += dd * dd; }
            q += __shfl_xor(q, 1); q += __shfl_xor(q, 2);
            const float rstd = 1.0f / sqrtf(q * (1.0f / 64.0f) + 64e-5f);
            float o[16];
#pragma unroll
            for (int e = 0; e < 16; ++e) o[e] = ((y[e] - mean) * rstd * lng[e] + lnb[e] + bs * v[e]) * g[e];
            v4u w0, w1; w0.x = pk2(o[0], o[1]); w0.y = pk2(o[2], o[3]); w0.z = pk2(o[4], o[5]); w0.w = pk2(o[6], o[7]); w1.x = pk2(o[8], o[9]); w1.y = pk2(o[10], o[11]); w1.z = pk2(o[12], o[13]); w1.w = pk2(o[14], o[15]);
            *(v4u*)(Y + off) = w0; *(v4u*)(Y + off + 8) = w1; }
    }
}

#ifndef DUP_K
#define DUP_K (-1)
#endif
#ifndef DUP_K2
#define DUP_K2 (-1)
#endif
#define KARGS ((const __attribute__((address_space(4))) Args*)__builtin_amdgcn_kernarg_segment_ptr())
#define WSPTRS \
    bf16* H0 = (bf16*)(ws + WS_H0); bf16* QKV = (bf16*)(ws + WS_QKV); bf16* OB = (bf16*)(ws + WS_O); f32x2* AGG = (f32x2*)(ws + WS_LRUAGG); \
    bf16* H2 = (bf16*)(ws + WS_H2); float* LOG = (float*)(ws + WS_LOG); unsigned char* RTE = ws + WS_ROUTE; bf16* HID = (bf16*)(ws + WS_HID); bf16* YS = (bf16*)(ws + WS_YS); bf16* PP = (bf16*)(ws + WS_PP); \
    bf16* HCAT = (bf16*)(ws + WS_HCAT); bf16* RB = (bf16*)(ws + WS_R); bf16* KB = (bf16*)(ws + WS_K); bf16* VB = (bf16*)(ws + WS_V); bf16* XRB = (bf16*)(ws + WS_XR); bf16* XKB = (bf16*)(ws + WS_XK); bf16* XVB = (bf16*)(ws + WS_XV); bf16* MID = (bf16*)(ws + WS_MID); bf16* EWB = (bf16*)(ws + WS_EW); bf16* AAB = (bf16*)(ws + WS_AA); bf16* YB = (bf16*)(ws + WS_Y); \
    const size_t TD = (size_t)T * 1024; (void)H0; (void)QKV; (void)OB; (void)AGG; (void)H2; (void)LOG; (void)RTE; (void)HID; (void)YS; (void)PP; (void)HCAT; (void)RB; (void)KB; (void)VB; (void)XRB; (void)XKB; (void)XVB; (void)MID; (void)EWB; (void)AAB; (void)YB; (void)TD;

struct Args { In in; float* out; unsigned char* ws; int ph_lo, ph_hi; };
constexpr int N_PHASES = 34;
__device__ __forceinline__ int nrep(int k) { int n = (k == DUP_K) ? 2 : 1; if (DUP_K >= 0) asm volatile("" : "+s"(n)); return n; }
#define REP_SYNC if (rep_) __syncthreads();
typedef const __attribute__((address_space(4))) unsigned long long* kp64;
__device__ __forceinline__ void load_in(In& I) { kp64 s = (kp64)__builtin_amdgcn_kernarg_segment_ptr(); unsigned long long* d = (unsigned long long*)&I;
#pragma unroll
    for (int i = 0; i < 47; ++i) d[i] = s[i]; }

__device__ __forceinline__ int t5_bucket(int n) { if (n < 16) return n; const float v = logf((float)n / 16.0f) / 2.0794415416798357f * 16.0f; const int l = 16 + (int)v; return l < 31 ? l : 31; }

template <class Epi>
__device__ __forceinline__ void dense_gemm(Frame& F, const void* A, int lda, const void* B, int K, int M, int N, const Epi& E) {
    pg8::DenseOrder S; S.init(A, lda, B, K, M, N, F.G, (int)blockIdx.x);
    pg8::gemm_phase<Epi, pg8::DenseOrder, true, false>(F.lds, K, lda, S, E, nullptr, TID_);
}

__global__ void __launch_bounds__(NWAVES * 64, 2) mk_fwd(Args args) {
    extern __shared__ __attribute__((aligned(16))) unsigned char lds[];
    Frame F;
    F.lds = (LAS unsigned char*)lds;
    F.MISC = (volatile LAS unsigned*)(F.lds + MISC_OFF);
    { int w_ = __builtin_amdgcn_readfirstlane((int)threadIdx.x >> 6); asm volatile("" : "+s"(w_)); F.wave = w_; }
    F.G = gridDim.x; { const int bx = blockIdx.x; F.vcu = (F.G % 8 == 0) ? (bx % 8) * (F.G / 8) + bx / 8 : bx; }
    F.ctl = (gu32*)(KARGS->ws + WS_CTL);
    for (int u = TID_; u < (LDS_BYTES - LDSCTL_OFF) / 4; u += NWAVES * 64) ((LAS unsigned*)(F.lds + LDSCTL_OFF))[u] = 0u;
    __syncthreads();
    {
        LAS float* tb = (LAS float*)(F.lds + TB_OFF); const int h = TID_ >> 7, i = TID_ & 127;
        const float* rb = KARGS->in.rel_bias;
        tb[h * 128 + i] = (rb[t5_bucket(i) * 4 + h] - rb[31 * 4 + h]) * 1.4426950408889634f;
    }
    __syncthreads();
    const int lo = KARGS->ph_lo, hi = KARGS->ph_hi;
    const bool multi = (hi - lo) > 1;
    XcdBarrier bar; bar.bar = (unsigned*)(F.ctl + CW_BAR); bar.x = 0; bar.st = nullptr;
    if (multi) bar = xcd_barrier_post((unsigned*)(F.ctl + CW_BAR), F.MISC + 8, TID_ == 0);
#define IN(k) (lo <= (k) && (k) < hi)
#define PH_BEGIN_ unsigned char* ws = KARGS->ws; bf16* X = (bf16*)KARGS->out; float* OUT = KARGS->out; (void)OUT; In I; load_in(I); (void)X; WSPTRS
#define SEAM(k) do { if (IN(k) && IN((k) + 1)) xcd_barrier(bar, TID_ == 0); } while (0)

    if (IN(0)) { PH_BEGIN_ prep_dense_weights(F, I, ws); prep_layer_weights(F, I, ws, 0); norm_pass<false>(F, I.x, I.norm_mix, H0);
#ifdef DUP_PREP
        __syncthreads(); prep_dense_weights(F, I, ws); prep_layer_weights(F, I, ws, 0);
#endif
    } SEAM(0);
    if (IN(1)) { PH_BEGIN_ pg8::EpiBf16 E{QKV, 512, 512, (size_t)T * 512, attn_body::C2}; dense_gemm(F, H0, 1024, ws + WS_WIN, 1024, T, AB_IN, E); } SEAM(1);
    if (IN(2)) { PH_BEGIN_ lru_agg_mfma(F, I, QKV + 3 * (size_t)T * 512, AGG, (bf16*)(ws + WS_HL), (bf16*)(ws + WS_CA)); } SEAM(2);
    if (IN(3)) { PH_BEGIN_
        const attn_body::AttnTensors AT{(const attn_body::bf16*)QKV, (const attn_body::bf16*)(QKV + (size_t)T * 512), (const attn_body::bf16*)(QKV + 2 * (size_t)T * 512), (attn_body::bf16*)OB};
        if (F.G == 256) attn_body::attn_phase<8>((char*)lds, AT, F.vcu, (const LAS float*)(F.lds + TB_OFF), (int)threadIdx.x);
#ifdef DUP_ATTN
        __syncthreads(); if (F.G == 256) attn_body::attn_phase<8>((char*)lds, AT, F.vcu, (const LAS float*)(F.lds + TB_OFF), (int)threadIdx.x);
#endif
        __syncthreads();
        lru_final_pass(F, (const bf16*)(ws + WS_HL), (const bf16*)(ws + WS_CA), QKV + 4 * (size_t)T * 512, AGG, H0);
    } SEAM(3);
    if (IN(4)) { PH_BEGIN_ diff_combine_pass(F, I, OB, H0); } SEAM(4);
    if (IN(5)) { PH_BEGIN_ pg8::EpiResX<false> E{I.x, X}; dense_gemm(F, H0, 1024, ws + WS_WOUT, 1024, T, 1024, E); } SEAM(5);

#define MOE_PLE_PHASES(P, L) \
    if (IN(P + 0)) { PH_BEGIN_ norm_pass<true>(F, X, I.norm_ffn + (L) * 1024, H2); } SEAM(P + 0); \
    if (IN(P + 1)) { PH_BEGIN_ pg8::EpiRouter E{LOG}; dense_gemm(F, H2, 1024, ws + WS_ROUT + (size_t)(L) * 256 * 1024 * 2, 1024, T, 256, E); } SEAM(P + 1); \
    if (IN(P + 2)) { PH_BEGIN_ route_pass_a(F, I, (L), LOG, RTE, F.ctl + ((L) ? CW_CNT1 : CW_CNT0)); } SEAM(P + 2); \
    if (IN(P + 3)) { PH_BEGIN_ route_pass_b(F, RTE, F.ctl + ((L) ? CW_CNT1 : CW_CNT0)); } SEAM(P + 3); \
    if (IN(P + 4)) { PH_BEGIN_ route_bases(F, F.ctl + ((L) ? CW_CNT1 : CW_CNT0)); const LAS int* eb = (const LAS int*)(F.lds + RTE_OFF + 512); \
        MoeOrder S{F.G, (int)blockIdx.x, __builtin_amdgcn_readfirstlane(eb[32] >> 8), eb, (const char*)H2, (const char*)(ws + WS_MGU), 0, (size_t)1024 * 1024 * 2, (size_t)256 * 1024 * 2, true}; pg8::EpiGU E{HID}; \
        pg8::gemm_phase<pg8::EpiGU, MoeOrder, true, true>(F.lds, 1024, 1024, S, E, (const int*)(RTE + RT_ROWTOK), TID_); } SEAM(P + 4); \
    if (IN(P + 5)) { PH_BEGIN_ route_bases(F, F.ctl + ((L) ? CW_CNT1 : CW_CNT0)); const LAS int* eb = (const LAS int*)(F.lds + RTE_OFF + 512); \
        MoeOrder S{F.G, (int)blockIdx.x, __builtin_amdgcn_readfirstlane(eb[32] >> 8), eb, (const char*)HID, (const char*)(ws + WS_MDN), (size_t)256 * 512 * 2, (size_t)1024 * 512 * 2, (size_t)256 * 512 * 2, false}; pg8::EpiDown E{YS, (const float*)(RTE + RT_ROWGATE)}; \
        pg8::gemm_phase<pg8::EpiDown, MoeOrder, true, false>(F.lds, 512, 512, S, E, nullptr, TID_); } SEAM(P + 5); \
    if (IN(P + 6)) { PH_BEGIN_ combine_norm_pass(F, X, X, YS, (const int*)(RTE + RT_SLOT), I.ple_norm + (L) * 1024, H2); } SEAM(P + 6); \
    if (IN(P + 7)) { PH_BEGIN_ pg8::EpiBf16 E{PP, 1024, 0, 0, 1.f}; dense_gemm(F, ws + WS_PB, 256, ws + WS_PPROJ + (size_t)(L) * 1024 * 256 * 2, 256, T, 1024, E); } SEAM(P + 7); \
    if (IN(P + 8)) { PH_BEGIN_ pg8::EpiPle E{X, (L) ? (bf16*)(ws + WS_YS) : X, PP}; dense_gemm(F, H2, 1024, ws + WS_PGATE + (size_t)(L) * 1024 * 1024 * 2, 1024, T, 1024, E); } SEAM(P + 8);

    MOE_PLE_PHASES(6, 0)
    if (IN(15)) { PH_BEGIN_ rwkv_input_pass(F, X, I.norm_mix + 1024, I.rwkv_mu, HCAT, XRB, XKB, XVB); prep_layer_weights(F, I, ws, 1); } SEAM(15);
    if (IN(16)) { PH_BEGIN_ { pg8::EpiBf16 E{RB, 1024, 0, 0, 1.f}; dense_gemm(F, XRB, 1024, ws + WS_RCAT, 1024, T, 1024, E); }
        { pg8::EpiMid E{MID}; dense_gemm(F, HCAT, 2048, ws + WS_RL1, 2048, T, 512, E); } } SEAM(16);
    if (IN(17)) { PH_BEGIN_ pg8::EpiBf16 E{KB, 1024, 0, 0, 1.f}; dense_gemm(F, XKB, 1024, ws + WS_RCAT + (size_t)1024 * 1024 * 2, 1024, T, 1024, E); } SEAM(17);
    if (IN(18)) { PH_BEGIN_ pg8::EpiBf16 E{VB, 1024, 0, 0, 1.f}; dense_gemm(F, XVB, 1024, ws + WS_RCAT + (size_t)2 * 1024 * 1024 * 2, 1024, T, 1024, E); } SEAM(18);
    if (IN(19)) { PH_BEGIN_ pg8::EpiRwkv2 E{EWB, AAB, I.rwkv_w0, I.rwkv_a0, 0}; dense_gemm(F, MID, 512, ws + WS_RS2, 256, T, 2048, E); } SEAM(19);
    if (IN(20)) { PH_BEGIN_ rwkv_scan_phase(F, I, RB, KB, VB, AAB, EWB, YB); } SEAM(20);
    if (IN(21)) { PH_BEGIN_ pg8::EpiRwkv2 E{EWB, EWB, nullptr, nullptr, 2}; dense_gemm(F, MID + 256, 512, ws + WS_RS2 + (size_t)2 * 1024 * 256 * 2, 256, T, 1024, E); } SEAM(21);
    if (IN(22)) { PH_BEGIN_ rwkv_post_pass(F, I, RB, KB, VB, AAB, EWB, YB); } SEAM(22);
    if (IN(23)) { PH_BEGIN_ pg8::EpiResX<true> E{X, X}; dense_gemm(F, YB, 1024, ws + WS_RWO, 1024, T, 1024, E); } SEAM(23);
    MOE_PLE_PHASES(24, 1)
    if (IN(33)) { PH_BEGIN_ final_norm_pass(F, (const bf16*)(ws + WS_YS), OUT, I.final_norm); }
#undef IN
#undef SEAM
}

extern "C" void kernel_launch(void* const* d_in, const int* in_sizes, int n_in, void* d_out, int out_size, void* d_ws, size_t ws_size, hipStream_t stream) {
    static int ok = 0;
    if (ok == 0) {
        if (n_in != 47 || out_size != T * D || ws_size < WS_END) { fprintf(stderr, "kernel_launch: unexpected problem shape (n_in %d out %d ws %zu)\n", n_in, out_size, ws_size); ok = -1; return; }
        if (hipFuncSetAttribute((const void*)mk_fwd, hipFuncAttributeMaxDynamicSharedMemorySize, LDS_BYTES) != hipSuccess) { fprintf(stderr, "kernel_launch: hipFuncSetAttribute failed\n"); ok = -1; return; }
        int per_cu = 0;
        if (hipOccupancyMaxActiveBlocksPerMultiprocessor(&per_cu, (const void*)mk_fwd, NWAVES * 64, LDS_BYTES) != hipSuccess || per_cu < 1) fprintf(stderr, "kernel_launch: occupancy query reports %d\n", per_cu);
        (void)hipGetLastError();
        ok = 1;
    }
    if (ok < 0) return;
    (void)hipMemsetAsync((char*)d_ws + WS_CTL, 0, CTL_ZERO_BYTES, stream);
    Args a{};
    const float** ip = (const float**)&a.in;
    for (int i = 0; i < 47; ++i) ip[i] = (const float*)d_in[i];
    a.out = (float*)d_out; a.ws = (unsigned char*)d_ws;
    const int grid = 256;
#if MK_ONE_LAUNCH
    a.ph_lo = 0; a.ph_hi = N_PHASES;
    hipLaunchKernelGGL(mk_fwd, dim3(grid), dim3(NWAVES * 64), LDS_BYTES, stream, a);
#else
    for (int k = 0; k < N_PHASES; ++k) { a.ph_lo = k; a.ph_hi = k + 1; hipLaunchKernelGGL(mk_fwd, dim3(grid), dim3(NWAVES * 64), LDS_BYTES, stream, a);
        if (k == DUP_K || k == DUP_K2) hipLaunchKernelGGL(mk_fwd, dim3(grid), dim3(NWAVES * 64), LDS_BYTES, stream, a); }
#endif
}
```

```cpp
#include <hip/hip_runtime.h>
#include <hip/hip_bf16.h>
#include <cstdio>
#include <cstdint>
#include <cmath>

#ifndef MK_ONE_LAUNCH
#define MK_ONE_LAUNCH 1
#endif

#define GAS __attribute__((address_space(1)))
#define LAS __attribute__((address_space(3)))
typedef unsigned short bf16;
typedef unsigned v4u __attribute__((ext_vector_type(4)));
typedef unsigned v2u __attribute__((ext_vector_type(2)));
typedef float f32x4 __attribute__((ext_vector_type(4)));
typedef float f32x2 __attribute__((ext_vector_type(2)));
typedef short bf16x8 __attribute__((ext_vector_type(8)));
typedef GAS unsigned gu32;
#define RLX_AGENT __ATOMIC_RELAXED, __HIP_MEMORY_SCOPE_AGENT
#define LDS_WAIT() asm volatile("s_waitcnt lgkmcnt(0)" ::: "memory")
#define VM_WAIT() asm volatile("s_waitcnt vmcnt(0)" ::: "memory")
__device__ __forceinline__ unsigned f2bf(float f) { unsigned u = __builtin_bit_cast(unsigned, f); return (u + 0x7fffu + ((u >> 16) & 1u)) >> 16; }
typedef float f32x2_cv __attribute__((ext_vector_type(2))); typedef __bf16 bf16x2_cv __attribute__((ext_vector_type(2)));
__device__ __forceinline__ unsigned pk2(float lo, float hi) { const f32x2_cv v = {lo, hi}; const bf16x2_cv b = __builtin_convertvector(v, bf16x2_cv); return __builtin_bit_cast(unsigned, b); }
__device__ __forceinline__ float bflo(unsigned w) { return __uint_as_float(w << 16); }
__device__ __forceinline__ float bfhi(unsigned w) { return __uint_as_float(w & 0xffff0000u); }
__device__ __forceinline__ float bf1(bf16 h) { return __uint_as_float((unsigned)h << 16); }
__device__ __forceinline__ float sigmoidf_(float x) { return __builtin_amdgcn_rcpf(1.0f + __builtin_amdgcn_exp2f(-1.4426950408889634f * x)); }
__device__ __forceinline__ float tanhf_(float x) { return 1.0f - 2.0f * __builtin_amdgcn_rcpf(1.0f + __builtin_amdgcn_exp2f(2.885390081777927f * x)); }
__device__ __forceinline__ void fmac_(float& acc, float a, float b) { asm("v_fmac_f32 %0, %1, %2" : "+v"(acc) : "v"(a), "v"(b)); }
__device__ __forceinline__ float fma_(float a, float b, float c) { float r; asm("v_fma_f32 %0, %1, %2, %3" : "=v"(r) : "v"(a), "v"(b), "v"(c)); return r; }
__device__ __forceinline__ float mul_(float a, float b) { float r; asm("v_mul_f32 %0, %1, %2" : "=v"(r) : "v"(a), "v"(b)); return r; }
__device__ __forceinline__ float wave_sum(float v) {
#pragma unroll
    for (int o = 1; o < 64; o <<= 1) v += __shfl_xor(v, o);
    return v;
}

constexpr int NB = 8, SEQ = 8192, D = 1024, T = NB * SEQ;
constexpr int AB_IN = 2560, PLE = 256;
constexpr int NEXP = 32, EH = 512;
constexpr int MAXSLOT = 2 * T + NEXP * 256;
constexpr int MAXTILES = MAXSLOT / 256;

namespace pg8 {
#define PG8_LAS __attribute__((address_space(3)))
typedef unsigned short bf16_t;
typedef unsigned u32x4 __attribute__((ext_vector_type(4)));
typedef unsigned u32x2 __attribute__((ext_vector_type(2)));
constexpr int BM = 256, BK = 64, HALF = 128, HTB = HALF * BK * 2, STAGE_BYTES = 8 * HTB, NXCD = 8, WGM = 8;
__host__ __device__ __forceinline__ int lds_byte(int r, int c) { const int st = (r >> 4) * 2 + (c >> 5), rr = r & 15, cc = c & 31, ob = rr * 64 + cc * 2; return st * 1024 + (ob ^ (((ob >> 9) & 1) << 5)); }
__host__ __device__ __forceinline__ void stage_rc(int b, int& R, int& C) { const int st = b / 1024, sb = b % 1024, swz = sb ^ (((sb >> 9) & 1) << 5); R = (st >> 1) * 16 + swz / 64; C = (st & 1) * 32 + (swz % 64) / 2; }
__host__ __device__ __forceinline__ int perm32(int rho) { const int n = rho >> 4, i = rho & 15; return 8 * (i >> 2) + 4 * n + (i & 3); }

struct Unit { int pm, pn, aux; const char* A; const char* B; };

struct DenseOrder {
    int nM, nN, nwg, G, c; const char* A; const char* B; size_t astep, bstep;
    __device__ void init(const void* A_, int lda, const void* B_, int K, int M, int N, int G_, int c_) { nM = M / BM; nN = N / BM; nwg = nM * nN; G = G_; c = c_; A = (const char*)A_; B = (const char*)B_; astep = (size_t)BM * lda * 2; bstep = (size_t)BM * K * 2; }
    __device__ bool next(int i, Unit& u) const {
        const long L = (long)i * G + c; if (L >= nwg) return false;
        int wgid = (int)L; { const int q = nwg / NXCD, r = nwg % NXCD, xcd = wgid % NXCD, off = wgid / NXCD; wgid = (xcd < r ? xcd * (q + 1) : r * (q + 1) + (xcd - r) * q) + off; }
        const int nig = WGM * nN, gid = wgid / nig, fm = gid * WGM, gsz = (nM - fm) < WGM ? (nM - fm) : WGM;
        u.pm = fm + ((wgid % nig) % gsz); u.pn = (wgid % nig) / gsz; u.aux = 0; u.A = A + (size_t)u.pm * astep; u.B = B + (size_t)u.pn * bstep; return true;
    }
};

__device__ __forceinline__ unsigned cvt_pk_bf16(float lo, float hi) { unsigned r; asm volatile("v_cvt_pk_bf16_f32 %0, %1, %2" : "=v"(r) : "v"(lo), "v"(hi)); return r; }

typedef f32x4 Acc[2][2][4][2];

struct EpiBf16 {
    static constexpr bool PERM = true;
    bf16_t* O; int ldc; int split_cols; size_t split_stride; float scale0;
    __device__ __forceinline__ void operator()(const Acc& acc, const Unit& u, int wr, int wc, int fr, int fq) const {
        const int row0 = u.pm * BM + wr * 64 + fr; int colt = u.pn * BM; bf16_t* base = O;
        float sc = 1.f; if (split_cols) { const int t = colt / split_cols; base += (size_t)t * split_stride; colt -= t * split_cols; if (t == 0) sc = scale0; }
        const int col0 = colt + wc * 32 + 8 * fq;
#pragma unroll
        for (int ai = 0; ai < 2; ++ai)
#pragma unroll
            for (int m = 0; m < 4; ++m) { bf16_t* rowp = base + (size_t)(row0 + ai * HALF + m * 16) * ldc + col0;
#pragma unroll
                for (int bj = 0; bj < 2; ++bj) { f32x4 v0 = acc[ai][bj][m][0] * sc, v1 = acc[ai][bj][m][1] * sc;
                    u32x4 w; w.x = cvt_pk_bf16(v0[0], v0[1]); w.y = cvt_pk_bf16(v0[2], v0[3]); w.z = cvt_pk_bf16(v1[0], v1[1]); w.w = cvt_pk_bf16(v1[2], v1[3]);
                    *(u32x4*)(rowp + bj * HALF) = w; } }
    }
};
__device__ __forceinline__ void unpack8f(const u32x4 w, f32x4& lo, f32x4& hi) { lo = (f32x4){bflo(w.x), bfhi(w.x), bflo(w.y), bfhi(w.y)}; hi = (f32x4){bflo(w.z), bfhi(w.z), bflo(w.w), bfhi(w.w)}; }
template <bool BASE_BF16>
struct EpiResX {
    static constexpr bool PERM = true;
    const void* base; bf16_t* out;
    __device__ __forceinline__ void operator()(const Acc& acc, const Unit& u, int wr, int wc, int fr, int fq) const {
        const int col0 = u.pn * BM + wc * 32 + 8 * fq; GAS bf16_t* op = (GAS bf16_t*)out;
#pragma unroll
        for (int ai = 0; ai < 2; ++ai) {
            f32x4 b0[4][2], b1[4][2];
#pragma unroll
            for (int m = 0; m < 4; ++m) { const size_t off = (size_t)(u.pm * BM + ai * HALF + wr * 64 + m * 16 + fr) * 1024 + col0;
#pragma unroll
                for (int bj = 0; bj < 2; ++bj) {
                    if (BASE_BF16) { const u32x4 w = *(const GAS u32x4*)((const GAS bf16_t*)base + off + bj * HALF); unpack8f(w, b0[m][bj], b1[m][bj]); }
                    else { b0[m][bj] = *(const GAS f32x4*)((const GAS float*)base + off + bj * HALF); b1[m][bj] = *(const GAS f32x4*)((const GAS float*)base + off + bj * HALF + 4); } } }
            asm volatile("" ::: "memory");
#pragma unroll
            for (int m = 0; m < 4; ++m) { const size_t off = (size_t)(u.pm * BM + ai * HALF + wr * 64 + m * 16 + fr) * 1024 + col0;
#pragma unroll
                for (int bj = 0; bj < 2; ++bj) { const f32x4 v0 = b0[m][bj] + acc[ai][bj][m][0], v1 = b1[m][bj] + acc[ai][bj][m][1];
                    u32x4 w; w.x = cvt_pk_bf16(v0[0], v0[1]); w.y = cvt_pk_bf16(v0[2], v0[3]); w.z = cvt_pk_bf16(v1[0], v1[1]); w.w = cvt_pk_bf16(v1[2], v1[3]);
                    *(GAS u32x4*)(op + off + bj * HALF) = w; } }
            asm volatile("" ::: "memory");
        }
    }
};
struct EpiRouter {
    static constexpr bool PERM = false;
    float* out;
    __device__ __forceinline__ void operator()(const Acc& acc, const Unit& u, int wr, int wc, int fr, int fq) const {
        if (wc >= 2) return;
#pragma unroll
        for (int ai = 0; ai < 2; ++ai)
#pragma unroll
            for (int m = 0; m < 4; ++m) { const size_t off = (size_t)(u.pm * BM + ai * HALF + wr * 64 + m * 16 + fr) * 64 + wc * 32 + 4 * fq;
#pragma unroll
                for (int n = 0; n < 2; ++n) *(f32x4*)(out + off + n * 16) = acc[ai][0][m][n]; }
    }
};
struct EpiGU {
    static constexpr bool PERM = true;
    bf16_t* H;
    __device__ __forceinline__ void operator()(const Acc& acc, const Unit& u, int wr, int wc, int fr, int fq) const {
        const int col0 = u.pn * 128 + wc * 32 + 8 * fq;
#pragma unroll
        for (int ai = 0; ai < 2; ++ai)
#pragma unroll
            for (int m = 0; m < 4; ++m) { bf16_t* rowp = H + (size_t)(u.pm * BM + ai * HALF + wr * 64 + m * 16 + fr) * EH + col0;
                f32x4 g0 = acc[ai][0][m][0], g1 = acc[ai][0][m][1]; const f32x4 u0 = acc[ai][1][m][0], u1 = acc[ai][1][m][1];
#pragma unroll
                for (int e = 0; e < 4; ++e) { g0[e] = g0[e] * sigmoidf_(g0[e]) * u0[e]; g1[e] = g1[e] * sigmoidf_(g1[e]) * u1[e]; }
                u32x4 w; w.x = cvt_pk_bf16(g0[0], g0[1]); w.y = cvt_pk_bf16(g0[2], g0[3]); w.z = cvt_pk_bf16(g1[0], g1[1]); w.w = cvt_pk_bf16(g1[2], g1[3]);
                *(u32x4*)rowp = w; }
    }
};
struct EpiDown {
    static constexpr bool PERM = true;
    bf16_t* Y; const float* gate;
    __device__ __forceinline__ void operator()(const Acc& acc, const Unit& u, int wr, int wc, int fr, int fq) const {
        const int col0 = u.pn * BM + wc * 32 + 8 * fq;
#pragma unroll
        for (int ai = 0; ai < 2; ++ai)
#pragma unroll
            for (int m = 0; m < 4; ++m) { const int row = u.pm * BM + ai * HALF + wr * 64 + m * 16 + fr; const float sc = gate[row]; bf16_t* rowp = Y + (size_t)row * 1024 + col0;
#pragma unroll
                for (int bj = 0; bj < 2; ++bj) { const f32x4 v0 = acc[ai][bj][m][0] * sc, v1 = acc[ai][bj][m][1] * sc;
                    u32x4 w; w.x = cvt_pk_bf16(v0[0], v0[1]); w.y = cvt_pk_bf16(v0[2], v0[3]); w.z = cvt_pk_bf16(v1[0], v1[1]); w.w = cvt_pk_bf16(v1[2], v1[3]);
                    *(u32x4*)(rowp + bj * HALF) = w; } }
    }
};
struct EpiPle {
    static constexpr bool PERM = true;
    const bf16_t* xin; bf16_t* xout; const bf16_t* pp;
    __device__ __forceinline__ void operator()(const Acc& acc, const Unit& u, int wr, int wc, int fr, int fq) const {
        const int col0 = u.pn * BM + wc * 32 + 8 * fq;
        const GAS bf16_t* xp = (const GAS bf16_t*)xin; GAS bf16_t* op = (GAS bf16_t*)xout; const GAS bf16_t* pq = (const GAS bf16_t*)pp;
#pragma unroll
        for (int ai = 0; ai < 2; ++ai) {
            u32x4 xw[4][2], pw[4][2];
#pragma unroll
            for (int m = 0; m < 4; ++m) { const size_t off = (size_t)(u.pm * BM + ai * HALF + wr * 64 + m * 16 + fr) * 1024 + col0;
#pragma unroll
                for (int bj = 0; bj < 2; ++bj) { xw[m][bj] = *(const GAS u32x4*)(xp + off + bj * HALF); pw[m][bj] = *(const GAS u32x4*)(pq + off + bj * HALF); } }
            asm volatile("" ::: "memory");
#pragma unroll
            for (int m = 0; m < 4; ++m) { const size_t off = (size_t)(u.pm * BM + ai * HALF + wr * 64 + m * 16 + fr) * 1024 + col0;
#pragma unroll
                for (int bj = 0; bj < 2; ++bj) { f32x4 x0, x1, p0, p1; unpack8f(xw[m][bj], x0, x1); unpack8f(pw[m][bj], p0, p1); const f32x4 a0 = acc[ai][bj][m][0], a1 = acc[ai][bj][m][1];
#pragma unroll
                    for (int e = 0; e < 4; ++e) { x0[e] += p0[e] * sigmoidf_(a0[e]); x1[e] += p1[e] * sigmoidf_(a1[e]); }
                    u32x4 w; w.x = cvt_pk_bf16(x0[0], x0[1]); w.y = cvt_pk_bf16(x0[2], x0[3]); w.z = cvt_pk_bf16(x1[0], x1[1]); w.w = cvt_pk_bf16(x1[2], x1[3]);
                    *(GAS u32x4*)(op + off + bj * HALF) = w; } }
            asm volatile("" ::: "memory");
        }
    }
};
struct EpiMid {
    static constexpr bool PERM = true;
    bf16_t* MID;
    __device__ __forceinline__ void operator()(const Acc& acc, const Unit& u, int wr, int wc, int fr, int fq) const {
        const int row0 = u.pm * BM + wr * 64 + fr;
        const int mode = (u.pn == 1) ? 2 : 0; const int colbase = u.pn * 256;
#pragma unroll
        for (int ai = 0; ai < 2; ++ai)
#pragma unroll
            for (int m = 0; m < 4; ++m) { bf16_t* rowp = MID + (size_t)(row0 + ai * HALF + m * 16) * 512 + colbase;
#pragma unroll
                for (int bj = 0; bj < 2; ++bj) { const int lc = bj * HALF + wc * 32 + 8 * fq; f32x4 v0 = acc[ai][bj][m][0], v1 = acc[ai][bj][m][1];
#pragma unroll
                    for (int e = 0; e < 4; ++e) {
                        if (mode == 2) { v0[e] = sigmoidf_(v0[e]); v1[e] = sigmoidf_(v1[e]); }
                        else if (lc < 64) { v0[e] = tanhf_(v0[e]); v1[e] = tanhf_(v1[e]); } }
                    u32x4 w; w.x = cvt_pk_bf16(v0[0], v0[1]); w.y = cvt_pk_bf16(v0[2], v0[3]); w.z = cvt_pk_bf16(v1[0], v1[1]); w.w = cvt_pk_bf16(v1[2], v1[3]);
                    *(u32x4*)(rowp + lc) = w; } }
    }
};
struct EpiRwkv2 {
    static constexpr bool PERM = true;
    bf16_t* O0; bf16_t* O1; const float* bias0; const float* bias1; int tybase;
    __device__ __forceinline__ void operator()(const Acc& acc, const Unit& u, int wr, int wc, int fr, int fq) const {
        const int ty = tybase + (u.pn >> 2); const int row0 = u.pm * BM + wr * 64 + fr; const int colt = (u.pn & 3) * BM + wc * 32 + 8 * fq;
        bf16_t* base = (u.pn >> 2) ? O1 : O0; const float* bias = (u.pn >> 2) ? bias1 : bias0;
#pragma unroll
        for (int bj = 0; bj < 2; ++bj) {
            f32x4 b0 = (f32x4){0.f, 0.f, 0.f, 0.f}, b1 = b0;
            if (ty < 2) { b0 = *(const f32x4*)(bias + colt + bj * HALF); b1 = *(const f32x4*)(bias + colt + bj * HALF + 4); }
#pragma unroll
            for (int ai = 0; ai < 2; ++ai)
#pragma unroll
                for (int m = 0; m < 4; ++m) { bf16_t* rowp = base + (size_t)(row0 + ai * HALF + m * 16) * 1024 + colt + bj * HALF;
                    f32x4 v0 = acc[ai][bj][m][0] + b0, v1 = acc[ai][bj][m][1] + b1;
                    if (ty < 2) { const float s = (ty == 0) ? 0.6065306597126334f : 1.0f;
#pragma unroll
                        for (int e = 0; e < 4; ++e) { v0[e] = s * sigmoidf_(v0[e]); v1[e] = s * sigmoidf_(v1[e]); } }
                    u32x4 w; w.x = cvt_pk_bf16(v0[0], v0[1]); w.y = cvt_pk_bf16(v0[2], v0[3]); w.z = cvt_pk_bf16(v1[0], v1[1]); w.w = cvt_pk_bf16(v1[2], v1[3]);
                    *(u32x4*)rowp = w; }
        }
    }
};

template <class Epi, class Sched, bool ALIGN_EPI, bool GATHER>
__device__ __forceinline__ void gemm_phase(PG8_LAS unsigned char* lds, const int K, const int lda, const Sched& S, const Epi& E, const int* __restrict__ rows, const int tid) {
    const int wid = __builtin_amdgcn_readfirstlane(tid >> 6), lane = tid & 63, wr = wid >> 2, wc = wid & 3, fr = lane & 15, fq = lane >> 4;
    const int nt = K / BK;
    unsigned voffA[2], voffB[2]; int RA[2];
#pragma unroll
    for (int i = 0; i < 2; ++i) { int R, C; stage_rc(tid * 16 + i * 8192, R, C); const int Rb = Epi::PERM ? ((R & ~31) + perm32(R & 31)) : R;
        RA[i] = R; voffA[i] = GATHER ? (unsigned)(C * 2) : (unsigned)(R * lda + C) * 2u; voffB[i] = (unsigned)(Rb * K + C) * 2u; }
    const size_t kstep = (size_t)(BK * 2);
    const size_t hstepA = GATHER ? 0 : (size_t)HALF * lda * 2, hstepB = (size_t)HALF * K * 2;
    const unsigned ldsw = (unsigned)wid * 1024u;
    const int aoff = lds_byte(wr * 64 + fr, fq * 8), boff = lds_byte(wc * 32 + fr, fq * 8);
#define PG8_SA(b, h) (((b) * 2 + (h)) * HTB)
#define PG8_SB(b, h) ((4 + (b) * 2 + (h)) * HTB)
#define PG8_ST2(bufoff, gbase, o0, o1) do { \
        __builtin_amdgcn_global_load_lds((const unsigned*)((const char*)(gbase) + (o0)), (PG8_LAS unsigned*)(lds + (bufoff) + ldsw), 16, 0, 0); \
        __builtin_amdgcn_global_load_lds((const unsigned*)((const char*)(gbase) + (o1)), (PG8_LAS unsigned*)(lds + (bufoff) + ldsw + 8192), 16, 0, 0); } while (0)
#define PG8_STB(bufoff, gbase) PG8_ST2(bufoff, gbase, voffB[0], voffB[1])
#define PG8_STA(bufoff, p, h, nx) do { if constexpr (GATHER) { const unsigned g0_ = (nx) ? gN[h][0] : gC[h][0], g1_ = (nx) ? gN[h][1] : gC[h][1]; PG8_ST2(bufoff, p, g0_, g1_); } \
        else { PG8_ST2(bufoff, (p) + (h) * hstepA, voffA[0], voffA[1]); } } while (0)
#define PG8_LDA(dst, b, h) do { _Pragma("unroll") for (int m = 0; m < 4; ++m) _Pragma("unroll") for (int k = 0; k < 2; ++k) dst[m][k] = *(const PG8_LAS bf16x8*)(lds + PG8_SA(b, h) + aoff + m * 2048 + k * 1024); } while (0)
#define PG8_LDB(dst, b, h) do { _Pragma("unroll") for (int n = 0; n < 2; ++n) _Pragma("unroll") for (int k = 0; k < 2; ++k) dst[n][k] = *(const PG8_LAS bf16x8*)(lds + PG8_SB(b, h) + boff + n * 2048 + k * 1024); } while (0)
#define PG8_MMA(ai, bj, At, Bt) do { __builtin_amdgcn_s_setprio(1); _Pragma("unroll") for (int m = 0; m < 4; ++m) _Pragma("unroll") for (int n = 0; n < 2; ++n) _Pragma("unroll") for (int k = 0; k < 2; ++k) \
        acc[ai][bj][m][n] = __builtin_amdgcn_mfma_f32_16x16x32_bf16(Bt[n][k], At[m][k], acc[ai][bj][m][n], 0, 0, 0); __builtin_amdgcn_s_setprio(0); } while (0)
#define PG8_WAIT_V(n) asm volatile("s_waitcnt vmcnt(" #n ")" ::: "memory")
#define PG8_WAIT_L(n) asm volatile("s_waitcnt lgkmcnt(" #n ")" ::: "memory")
#define PG8_BAR __builtin_amdgcn_s_barrier()
#define PG8_SCHED __builtin_amdgcn_sched_barrier(0)
#define PG8_GLOAD(dst, un) do { if constexpr (GATHER) { _Pragma("unroll") for (int h_ = 0; h_ < 2; ++h_) _Pragma("unroll") for (int i_ = 0; i_ < 2; ++i_) \
        dst[h_][i_] = (unsigned)rows[(un).pm * BM + h_ * HALF + RA[i_]] * (unsigned)(lda * 2) + voffA[i_]; } } while (0)
    Unit cur, nxt; int ui = 0;
    if (!S.next(0, cur)) return;
    unsigned gC[2][2] = {{0u, 0u}, {0u, 0u}}, gN[2][2] = {{0u, 0u}, {0u, 0u}};
    PG8_GLOAD(gC, cur);
    Acc acc;
#pragma unroll
    for (int a = 0; a < 2; ++a)
#pragma unroll
        for (int b = 0; b < 2; ++b)
#pragma unroll
            for (int m = 0; m < 4; ++m)
#pragma unroll
                for (int n = 0; n < 2; ++n) acc[a][b][m][n] = (f32x4){0.f, 0.f, 0.f, 0.f};
    bf16x8 At[4][2], B0[2][2], B1[2][2];
    const char* cA = cur.A; const char* cB = cur.B;
    PG8_STB(PG8_SB(0, 0), cB); PG8_STB(PG8_SB(0, 1), cB + hstepB); PG8_STA(PG8_SA(0, 0), cA, 0, false); PG8_STA(PG8_SA(0, 1), cA, 1, false);
    if (wr == 1) PG8_BAR;
    PG8_WAIT_V(2); PG8_BAR;
    PG8_STB(PG8_SB(1, 0), cB + kstep); PG8_STA(PG8_SA(1, 0), cA + kstep, 0, false); PG8_STB(PG8_SB(1, 1), cB + hstepB + kstep);
    PG8_WAIT_V(6); PG8_BAR;
    for (;;) {
        const bool has_next = S.next(ui + 1, nxt);
        if (has_next) { PG8_GLOAD(gN, nxt); }
        const char* nA = has_next ? nxt.A : cA; const char* nB = has_next ? nxt.B : cB;
#pragma unroll 1
        for (int t = 0; t < nt; t += 2) {
            const bool last = (t == nt - 2); const bool nx = last && has_next;
            const char* a1 = cA + (size_t)(t + 1) * kstep;
            const char* a2 = last ? nA : cA + (size_t)(t + 2) * kstep; const char* b2 = last ? nB : cB + (size_t)(t + 2) * kstep;
            const char* a3 = a2 + kstep; const char* b3 = b2 + kstep;
            PG8_LDB(B0, 0, 0); PG8_LDB(B1, 0, 1); PG8_SCHED; PG8_LDA(At, 0, 0); PG8_STA(PG8_SA(1, 1), a1, 1, false);
            PG8_WAIT_V(8); PG8_WAIT_L(0); PG8_BAR; PG8_MMA(0, 0, At, B0); PG8_MMA(0, 1, At, B1); PG8_BAR; PG8_SCHED;
            PG8_LDA(At, 0, 1); PG8_STB(PG8_SB(0, 0), b2); PG8_STB(PG8_SB(0, 1), b2 + hstepB); PG8_STA(PG8_SA(0, 0), a2, 0, nx);
            PG8_WAIT_V(8); PG8_WAIT_L(0); PG8_BAR; PG8_MMA(1, 0, At, B0); PG8_MMA(1, 1, At, B1); PG8_BAR; PG8_SCHED;
            PG8_LDB(B0, 1, 0); PG8_LDB(B1, 1, 1); PG8_SCHED; PG8_LDA(At, 1, 0); PG8_STA(PG8_SA(0, 1), a2, 1, nx);
            PG8_WAIT_V(8); PG8_WAIT_L(0); PG8_BAR; PG8_MMA(0, 0, At, B0); PG8_MMA(0, 1, At, B1); PG8_BAR; PG8_SCHED;
            PG8_LDA(At, 1, 1); PG8_STB(PG8_SB(1, 0), b3); PG8_STB(PG8_SB(1, 1), b3 + hstepB); PG8_STA(PG8_SA(1, 0), a3, 0, nx);
            PG8_WAIT_V(8); PG8_WAIT_L(0); PG8_BAR; PG8_MMA(1, 0, At, B0); PG8_MMA(1, 1, At, B1); PG8_BAR; PG8_SCHED;
        }
        if constexpr (ALIGN_EPI) { if (wr == 0) PG8_BAR; }
        E(acc, cur, wr, wc, fr, fq);
        if (!has_next) break;
#pragma unroll
        for (int a = 0; a < 2; ++a)
#pragma unroll
            for (int b = 0; b < 2; ++b)
#pragma unroll
                for (int m = 0; m < 4; ++m)
#pragma unroll
                    for (int n = 0; n < 2; ++n) acc[a][b][m][n] = (f32x4){0.f, 0.f, 0.f, 0.f};
        cur = nxt; cA = nA; cB = nB; ++ui;
        if constexpr (GATHER) {
#pragma unroll
            for (int h_ = 0; h_ < 2; ++h_)
#pragma unroll
                for (int i_ = 0; i_ < 2; ++i_) gC[h_][i_] = gN[h_][i_]; }
        if constexpr (ALIGN_EPI) { if (wr == 1) PG8_BAR; }
    }
    PG8_WAIT_V(0);
    if constexpr (!ALIGN_EPI) { if (wr == 0) PG8_BAR; }
    PG8_BAR;
#undef PG8_SA
#undef PG8_SB
#undef PG8_ST2
#undef PG8_STB
#undef PG8_STA
#undef PG8_LDA
#undef PG8_LDB
#undef PG8_MMA
#undef PG8_WAIT_V
#undef PG8_WAIT_L
#undef PG8_BAR
#undef PG8_SCHED
#undef PG8_GLOAD
}
}
namespace attn_body {
using bf16=__hip_bfloat16;
using bf16x8=__attribute__((ext_vector_type(8)))short;
using s16x4=__attribute__((ext_vector_type(4)))short;
using f32x16=__attribute__((ext_vector_type(16)))float;
using u32x4=__attribute__((ext_vector_type(4)))unsigned;
constexpr int BATCH=8,NHEAD=16,SEQ=8192,D=64,PQ=512,PO=1024;
constexpr int NW=8,QBLK=32,QB=QBLK*NW,KVBLK=64,NQB=SEQ/QB;
constexpr int ATTN_UNIT_ROWS=QB;
__device__ __forceinline__ int crow(int r,int hi){return (r&3)+8*(r>>2)+4*hi;}
#define SBAR() __builtin_amdgcn_sched_barrier(0)
__device__ __forceinline__ void cmask(f32x16&p0,f32x16&p1,int jb,int qrel,int hi){
  const float NEG=-INFINITY; int kb=64*jb+4*hi;
  #pragma unroll
  for(int r=0;r<16;++r){int kv=kb+(r&3)+8*(r>>2); if(kv>qrel)p0[r]=NEG; if(kv+32>qrel)p1[r]=NEG;}
}

__device__ __forceinline__ void cbias(f32x16&p0,f32x16&p1,int jb,int qrel,int hi,const __attribute__((address_space(3))) float*tb){
  const int kb=64*jb+4*hi;
  #pragma unroll
  for(int r=0;r<16;++r){const int rel=qrel-(kb+(r&3)+8*(r>>2)); const int i0=min(max(rel,0),127), i1=min(max(rel-32,0),127); p0[r]+=tb[i0]; p1[r]+=tb[i1];}
}
constexpr int NSLOT=3, SLOTB=8192;
constexpr int LDS_K=0, LDS_V=NSLOT*SLOTB, LDS_WS=2*NSLOT*SLOTB, LDS_OST=LDS_WS+NW*64*4, LDS_BYTES=LDS_OST+NW*4096;
constexpr float C2=0.125f*1.4426950408889634f;
__device__ __forceinline__ void glds16(const void*gsrc,unsigned lds_dst){unsigned keep;
  asm volatile("s_mov_b32 %0, m0\n\ts_mov_b32 m0, %2\n\ts_nop 0\n\tglobal_load_lds_dwordx4 %1, off\n\ts_mov_b32 m0, %0":"=&s"(keep):"v"(gsrc),"s"(lds_dst):"memory");}
__device__ __forceinline__ float max3f(float a,float b,float c){float r;asm("v_max3_f32 %0, %1, %2, %3":"=v"(r):"v"(a),"v"(b),"v"(c));return r;}
__device__ __forceinline__ float max2f(float a,float b){float r;asm("v_max_f32_e32 %0, %1, %2":"=v"(r):"v"(a),"v"(b));return r;}
__device__ __forceinline__ float fadd_s(float a,float b){float r;asm("v_add_f32_e32 %0, %1, %2":"=v"(r):"v"(a),"v"(b));return r;}
__device__ __forceinline__ float fsub_s(float a,float b){float r;asm("v_sub_f32_e32 %0, %1, %2":"=v"(r):"v"(a),"v"(b));return r;}
typedef float f32x2_t __attribute__((ext_vector_type(2))); typedef __bf16 bf16x2_t __attribute__((ext_vector_type(2)));
__device__ __forceinline__ unsigned cvtpk_s(float lo,float hi){f32x2_t v={lo,hi};bf16x2_t b=__builtin_convertvector(v,bf16x2_t);return __builtin_bit_cast(unsigned,b);}
#define WAIT_BAR(N) asm volatile("s_waitcnt vmcnt(" #N ") lgkmcnt(0)\n\ts_barrier":::"memory")

__device__ __forceinline__ void qkt(f32x16&p0,f32x16&p1,const char*Kslot,const bf16x8*qr,const f32x16&negm,int r32,int hi){
  const char*kb=Kslot+hi*1024+r32*16;
  #pragma unroll
  for(int d0=0;d0<4;++d0){
    const bf16x8 b0=*reinterpret_cast<const bf16x8*>(kb+d0*2048);
    const bf16x8 b1=*reinterpret_cast<const bf16x8*>(kb+d0*2048+512);
    if(d0==0){p0=__builtin_amdgcn_mfma_f32_32x32x16_bf16(b0,qr[0],negm,0,0,0);p1=__builtin_amdgcn_mfma_f32_32x32x16_bf16(b1,qr[0],negm,0,0,0);}
    else{p0=__builtin_amdgcn_mfma_f32_32x32x16_bf16(b0,qr[d0],p0,0,0,0);p1=__builtin_amdgcn_mfma_f32_32x32x16_bf16(b1,qr[d0],p1,0,0,0);}}
}
typedef __attribute__((address_space(3))) const char* lds_cptr;
typedef short v4i16_t __attribute__((ext_vector_type(4)));
__device__ __forceinline__ void kload8(bf16x8*kf,lds_cptr kp){
  kf[0]=*(const __attribute__((address_space(3))) bf16x8*)(kp);      kf[1]=*(const __attribute__((address_space(3))) bf16x8*)(kp+512);
  kf[2]=*(const __attribute__((address_space(3))) bf16x8*)(kp+2048); kf[3]=*(const __attribute__((address_space(3))) bf16x8*)(kp+2560);
  kf[4]=*(const __attribute__((address_space(3))) bf16x8*)(kp+4096); kf[5]=*(const __attribute__((address_space(3))) bf16x8*)(kp+4608);
  kf[6]=*(const __attribute__((address_space(3))) bf16x8*)(kp+6144); kf[7]=*(const __attribute__((address_space(3))) bf16x8*)(kp+6656);
}
__device__ __forceinline__ void kload2(bf16x8*kf,lds_cptr kp,int j){ kf[2*j]=*(const __attribute__((address_space(3))) bf16x8*)(kp+j*2048); kf[2*j+1]=*(const __attribute__((address_space(3))) bf16x8*)(kp+j*2048+512); }
__device__ __forceinline__ s16x4 vtr(lds_cptr p){ return __builtin_bit_cast(s16x4,__builtin_amdgcn_ds_read_tr16_b64_v4i16((__attribute__((address_space(3))) v4i16_t*)p)); }
__device__ __forceinline__ float rowmax(const f32x16&p0,const f32x16&p1){
  float a=max3f(p0[0],p0[1],p1[0]),b=max3f(p0[2],p0[3],p1[1]);a=max3f(a,p1[2],p1[3]);
  #pragma unroll
  for(int r=4;r<16;r+=4){a=max3f(a,p0[r],p0[r+1]);b=max3f(b,p0[r+2],p0[r+3]);a=max3f(a,p1[r],p1[r+1]);b=max3f(b,p1[r+2],p1[r+3]);}
  const float m=max2f(a,b);
  auto rr=__builtin_amdgcn_permlane32_swap(__float_as_uint(m),__float_as_uint(m),false,false);
  return max2f(__uint_as_float(rr[0]),__uint_as_float(rr[1]));
}
__device__ __forceinline__ void pv(f32x16*o,int vb,bf16x8 pa0,bf16x8 pa1,bf16x8 pa2,bf16x8 pa3){
  #pragma unroll
  for(int d0=0;d0<2;++d0){s16x4 lo[4],hi[4];
    #pragma unroll
    for(int ks=0;ks<4;++ks){
      asm volatile("ds_read_b64_tr_b16 %0,%1 offset:%c2":"=&v"(lo[ks]):"v"(vb),"i"(d0*4096+ks*1024):"memory");
      asm volatile("ds_read_b64_tr_b16 %0,%1 offset:%c2":"=&v"(hi[ks]):"v"(vb),"i"(d0*4096+ks*1024+512):"memory");}
    asm volatile("s_waitcnt lgkmcnt(0)":::"memory");SBAR();
    #define PK(k) (bf16x8){lo[k][0],lo[k][1],lo[k][2],lo[k][3],hi[k][0],hi[k][1],hi[k][2],hi[k][3]}
    o[d0]=__builtin_amdgcn_mfma_f32_32x32x16_bf16(pa0,PK(0),o[d0],0,0,0);
    o[d0]=__builtin_amdgcn_mfma_f32_32x32x16_bf16(pa1,PK(1),o[d0],0,0,0);
    o[d0]=__builtin_amdgcn_mfma_f32_32x32x16_bf16(pa2,PK(2),o[d0],0,0,0);
    o[d0]=__builtin_amdgcn_mfma_f32_32x32x16_bf16(pa3,PK(3),o[d0],0,0,0);
    #undef PK
  }
}

#ifndef ATTN_STORE16
#define ATTN_STORE16(p,v) (*(u32x4*)(p)=(v))
#endif
template<int THRL> __device__ __forceinline__ void attn_unit(int b,int vh,int qb,const bf16*Q,const bf16*__restrict__ K,const bf16*__restrict__ V,bf16*O,char*shm,const __attribute__((address_space(3))) float*tball,const int tid){
  const int lane=tid&63,r32=lane&31,hi=lane>>5; const int wid=__builtin_amdgcn_readfirstlane(tid>>6);
  const long rowbase=(long)b*SEQ; const int q0=qb*QB;
  const int hh=vh>>2, qcol=hh*128+((vh>>1)&1)*64, vcol=hh*128+(vh&1)*64;
  const __attribute__((address_space(3))) float*tb=tball+hh*128;
  const bf16*Qw=Q+(rowbase+q0+wid*QBLK)*PQ+qcol;
  const bf16*Kh=K+rowbase*PQ+qcol,*Vh=V+rowbase*PQ+vcol;
  const unsigned lds0=(unsigned)(uintptr_t)shm;
  float*wsf=(float*)(shm+LDS_WS)+wid*64;
  const bf16*ksrc=Kh+(long)lane*PQ+wid*8;
  const bf16*vsrc=Vh+(long)(16*(wid&3)+(lane>>2))*PQ+(wid>>2)*32+(lane&3)*8;
  const unsigned kdst=lds0+LDS_K+wid*1024, vdst=lds0+LDS_V+wid*1024;
  #define DMA_K(t,slot) glds16(ksrc+(long)(t)*KVBLK*PQ,(unsigned)__builtin_amdgcn_readfirstlane(kdst+(slot)))
  #define DMA_V(t,slot) glds16(vsrc+(long)(t)*KVBLK*PQ,(unsigned)__builtin_amdgcn_readfirstlane(vdst+(slot)))
  const int vb0=(int)(lds0+LDS_V)+((lane>>4)&1)*32+(lane&3)*8+(4*hi+((lane&15)>>2))*64;
  const char*Kbase=shm+LDS_K; bf16x8 kf[8];
  const lds_cptr shm3=(lds_cptr)shm; const lds_cptr kp0=shm3+LDS_K+hi*1024+r32*16; const lds_cptr vp0=shm3+LDS_V+((lane>>4)&1)*32+(lane&3)*8+(4*hi+((lane&15)>>2))*64;
  const int NT=(q0+QB)/KVBLK;
  DMA_K(0,0);DMA_V(0,0);DMA_K(1,SLOTB);
  bf16x8 qr[4];
  #pragma unroll
  for(int d0=0;d0<4;++d0)qr[d0]=*reinterpret_cast<const bf16x8*>(&Qw[(long)r32*PQ+d0*16+hi*8]);
  float mhat=0.f,l_reg=0.f;f32x16 o[2];o[0]=f32x16{};o[1]=f32x16{};f32x16 negm=f32x16{};asm volatile("":"+v"(negm));
  const int qrel=wid*QBLK+r32;
  #define CMASK(P0,P1,t) do{int jb_=(t)-(NT-4); if(jb_>=-2){cbias(P0,P1,jb_,qrel,hi,tb); if(jb_>=0)cmask(P0,P1,jb_,qrel,hi);}}while(0)
  bool resc=false;
  #define START(P0,P1) do{ const float rm=rowmax(P0,P1); resc=false; \
    { const float dl=rm; mhat=fadd_s(mhat,dl); \
      _Pragma("unroll") for(int r=0;r<16;++r){P0[r]=fsub_s(P0[r],dl);P1[r]=fsub_s(P1[r],dl);} \
      _Pragma("unroll") for(int r=0;r<16;++r)negm[r]=-mhat; asm volatile("":"+v"(negm)); } \
    _Pragma("unroll") for(int r=0;r<16;++r)P0[r]=__builtin_amdgcn_exp2f(P0[r]); }while(0)
  #define RESC() do{ if(resc){ asm volatile("s_waitcnt lgkmcnt(0)":::"memory"); \
      _Pragma("unroll") for(int d_=0;d_<2;++d_) _Pragma("unroll") for(int r=0;r<16;++r)o[d_][r]*=wsf[crow(r,hi)]; } }while(0)
  f32x16 pA0,pA1,pB0,pB1;
  int sl_prev=0,sl_cur=0,sl_next=SLOTB;
  #define ROT() do{sl_prev=sl_cur;sl_cur=sl_next;sl_next=(sl_next==(NSLOT-1)*SLOTB)?0:sl_next+SLOTB;}while(0)
  DMA_K(2,2*SLOTB);
  WAIT_BAR(3);
  qkt(pA0,pA1,Kbase,qr,negm,r32,hi);asm volatile("s_nop 15\n\ts_nop 7":"+v"(pA0),"+v"(pA1));CMASK(pA0,pA1,0);
  START(pA0,pA1);
  _Pragma("unroll") for(int r=0;r<16;++r)pA1[r]=__builtin_amdgcn_exp2f(pA1[r]);
  WAIT_BAR(0);
  DMA_K(3,0);DMA_V(1,SLOTB);
  ROT();
  kload8(kf,kp0+sl_cur);
  WAIT_BAR(2);
  s16x4 vlo[8],vhi[8]; u32x4 pw0,pw1,pw2,pw3;
  #define PKW(P,B) cvtpk_s(P[B],P[B+1])
  #define PAF(k) __builtin_bit_cast(bf16x8,pw##k)
  #define VFR(i) (bf16x8){vlo[i][0],vlo[i][1],vlo[i][2],vlo[i][3],vhi[i][0],vhi[i][1],vhi[i][2],vhi[i][3]}
  #define PIN(x) asm volatile("":"+v"(x))
  #define MX3(a,b,c) __builtin_fmaxf(__builtin_fmaxf((a),(b)),(c))
  #define GAPA(MF,A0,A1,A2,A3,W0,W1,PW) do{ MF; sacc+=A0; sacc+=A1; sacc+=A2; sacc+=A3; PIN(sacc); W0; W1; PIN(PW); SBAR(); }while(0)
  #define EX(v) __builtin_amdgcn_exp2f(v)
  #define GAPB(MF,X,B) do{ MF; X[B]=EX(X[B]); X[B+1]=EX(X[B+1]); X[B+2]=EX(X[B+2]); X[B+3]=EX(X[B+3]); PIN(X); SBAR(); }while(0)
  #define VRD(i) do{ vlo[i]=vtr(vp_+(((i)>>2)*4096+((i)&3)*1024)); vhi[i]=vtr(vp_+(((i)>>2)*4096+((i)&3)*1024+512)); }while(0)
  #define KRD(G,j) do{ if(G){ kload2(kf,kp0+sl_next,j); SBAR(); } }while(0)
  #define STEP(C0,C1,P0,P1,t,GK,GV,GL) do{ SBAR(); \
    const lds_cptr vp_=vp0+sl_prev; \
    VRD(0); SBAR(); float sacc=(P0[0]+P0[1]); \
    GAPA(C0=__builtin_amdgcn_mfma_f32_32x32x16_bf16(kf[0],qr[0],negm,0,0,0), P0[2],P0[3],P0[4],P0[5],     pw0[0]=PKW(P0,0), pw0[1]=PKW(P0,2), pw0); \
    VRD(4); SBAR(); GAPA(C1=__builtin_amdgcn_mfma_f32_32x32x16_bf16(kf[1],qr[0],negm,0,0,0), P0[6],P0[7],P0[8],P0[9],     pw0[2]=PKW(P0,4), pw0[3]=PKW(P0,6), pw0); \
    VRD(1); SBAR(); GAPA(C0=__builtin_amdgcn_mfma_f32_32x32x16_bf16(kf[2],qr[1],C0,0,0,0),   P0[10],P0[11],P0[12],P0[13], pw1[0]=PKW(P0,8), pw1[1]=PKW(P0,10), pw1); \
    VRD(5); SBAR(); GAPA(C1=__builtin_amdgcn_mfma_f32_32x32x16_bf16(kf[3],qr[1],C1,0,0,0),   P0[14],P0[15],P1[0],P1[1],   pw1[2]=PKW(P0,12),pw1[3]=PKW(P0,14), pw1); \
    VRD(2); SBAR(); GAPA(C0=__builtin_amdgcn_mfma_f32_32x32x16_bf16(kf[4],qr[2],C0,0,0,0),   P1[2],P1[3],P1[4],P1[5],     pw2[0]=PKW(P1,0), pw2[1]=PKW(P1,2), pw2); \
    VRD(6); SBAR(); GAPA(C1=__builtin_amdgcn_mfma_f32_32x32x16_bf16(kf[5],qr[2],C1,0,0,0),   P1[6],P1[7],P1[8],P1[9],     pw2[2]=PKW(P1,4), pw2[3]=PKW(P1,6), pw2); \
    VRD(3); SBAR(); GAPA(C0=__builtin_amdgcn_mfma_f32_32x32x16_bf16(kf[6],qr[3],C0,0,0,0),   P1[10],P1[11],P1[12],P1[13], pw3[0]=PKW(P1,8), pw3[1]=PKW(P1,10), pw3); \
    VRD(7); SBAR(); GAPA(C1=__builtin_amdgcn_mfma_f32_32x32x16_bf16(kf[7],qr[3],C1,0,0,0),   P1[14],P1[15],0.f,0.f,       pw3[2]=PKW(P1,12),pw3[3]=PKW(P1,14), pw3); \
    l_reg+=sacc; \
    if(GK){DMA_K((t)+3,sl_cur);} if(GV){DMA_V((t)+1,sl_next);} \
    CMASK(C0,C1,t); \
    { float a=MX3(C0[0],C0[1],C1[0]),b=MX3(C0[2],C0[3],C1[1]); a=MX3(a,C1[2],C1[3]); \
      _Pragma("unroll") for(int r=4;r<16;r+=4){a=MX3(a,C0[r],C0[r+1]);b=MX3(b,C0[r+2],C0[r+3]);a=MX3(a,C1[r],C1[r+1]);b=MX3(b,C1[r+2],C1[r+3]);} \
      float rm=__builtin_fmaxf(a,b); { auto rr=__builtin_amdgcn_permlane32_swap(__float_as_uint(rm),__float_as_uint(rm),false,false); rm=__builtin_fmaxf(__uint_as_float(rr[0]),__uint_as_float(rr[1])); } \
      resc=false; \
      if(__builtin_expect(__any(rm>(float)THRL),0)){ const float dl=__builtin_fmaxf(rm,0.f); mhat+=dl; \
        _Pragma("unroll") for(int r=0;r<16;++r){C0[r]-=dl;C1[r]-=dl;} \
        _Pragma("unroll") for(int r=0;r<16;++r)negm[r]=-mhat; asm volatile("":"+v"(negm)); \
        const float f=__builtin_amdgcn_exp2f(-dl); l_reg*=f; if(hi==0)wsf[r32]=f; resc=true; } } \
    SBAR(); \
    GAPB(o[0]=__builtin_amdgcn_mfma_f32_32x32x16_bf16(PAF(0),VFR(0),o[0],0,0,0), C0,0); \
    GAPB(o[1]=__builtin_amdgcn_mfma_f32_32x32x16_bf16(PAF(0),VFR(4),o[1],0,0,0), C0,4); \
    KRD(GL,0); GAPB(o[0]=__builtin_amdgcn_mfma_f32_32x32x16_bf16(PAF(1),VFR(1),o[0],0,0,0), C0,8); \
    KRD(GL,1); GAPB(o[1]=__builtin_amdgcn_mfma_f32_32x32x16_bf16(PAF(1),VFR(5),o[1],0,0,0), C0,12); \
    KRD(GL,2); GAPB(o[0]=__builtin_amdgcn_mfma_f32_32x32x16_bf16(PAF(2),VFR(2),o[0],0,0,0), C1,0); \
    KRD(GL,3); GAPB(o[1]=__builtin_amdgcn_mfma_f32_32x32x16_bf16(PAF(2),VFR(6),o[1],0,0,0), C1,4); \
    GAPB(o[0]=__builtin_amdgcn_mfma_f32_32x32x16_bf16(PAF(3),VFR(3),o[0],0,0,0), C1,8); \
    GAPB(o[1]=__builtin_amdgcn_mfma_f32_32x32x16_bf16(PAF(3),VFR(7),o[1],0,0,0), C1,12); \
    }while(0)
  int t=1;
  #undef CMASK
  #define CMASK(P0,P1,t) do{}while(0)
  for(;t+7<NT;t+=2){
    STEP(pB0,pB1,pA0,pA1,t,true,true,true);     WAIT_BAR(2); RESC(); ROT();
    STEP(pA0,pA1,pB0,pB1,t+1,true,true,true);   WAIT_BAR(2); RESC(); ROT();
  }
  #undef CMASK
  #define CMASK(P0,P1,t) do{int jb_=(t)-(NT-4); if(jb_>=-2){cbias(P0,P1,jb_,qrel,hi,tb); if(jb_>=0)cmask(P0,P1,jb_,qrel,hi);}}while(0)
  #define ENDW(tt) do{ if((tt)+3<NT){WAIT_BAR(2);} else if((tt)+2<NT){WAIT_BAR(1);} else {WAIT_BAR(0);} }while(0)
  for(;t+1<NT;t+=2){
    STEP(pB0,pB1,pA0,pA1,t,(t+3<NT),(t+1<NT),(t+1<NT));       ENDW(t);   RESC(); ROT();
    STEP(pA0,pA1,pB0,pB1,t+1,(t+4<NT),(t+2<NT),(t+2<NT));     ENDW(t+1); RESC(); ROT();
  }
  STEP(pB0,pB1,pA0,pA1,NT-1,false,false,false); RESC();
  { float sacc=pB0[0]+pB0[1]; _Pragma("unroll") for(int r=2;r<16;++r)sacc+=pB0[r]; _Pragma("unroll") for(int r=0;r<16;++r)sacc+=pB1[r]; l_reg+=sacc;
    pw0=(u32x4){PKW(pB0,0),PKW(pB0,2),PKW(pB0,4),PKW(pB0,6)};pw1=(u32x4){PKW(pB0,8),PKW(pB0,10),PKW(pB0,12),PKW(pB0,14)};pw2=(u32x4){PKW(pB1,0),PKW(pB1,2),PKW(pB1,4),PKW(pB1,6)};pw3=(u32x4){PKW(pB1,8),PKW(pB1,10),PKW(pB1,12),PKW(pB1,14)};
    SBAR(); pv(o,vb0+sl_cur,PAF(0),PAF(1),PAF(2),PAF(3)); }
  #undef PKW
  #undef PAF
  #undef VFR
  #undef PIN
  #undef MX3
  #undef GAPA
  #undef GAPB
  #undef EX
  #undef VRD
  #undef KRD
  #undef STEP
  #undef ENDW
  {auto rr=__builtin_amdgcn_permlane32_swap(__float_as_uint(l_reg),__float_as_uint(l_reg),false,false);l_reg=__uint_as_float(rr[0])+__uint_as_float(rr[1]);}
  if(hi==0)wsf[32+r32]=l_reg;asm volatile("s_waitcnt lgkmcnt(0)":::"memory");
  float rli[16];
  #pragma unroll
  for(int r=0;r<16;++r)rli[r]=__builtin_amdgcn_rcpf(wsf[32+crow(r,hi)]);
  bf16*Ow=O+(rowbase+q0+wid*QBLK)*PO+vh*D;
  { bf16*stg=(bf16*)(shm+LDS_OST)+wid*2048;
    #pragma unroll
    for(int r=0;r<16;++r){const int orow=crow(r,hi);
      #pragma unroll
      for(int d0=0;d0<2;++d0)stg[orow*64+d0*32+r32]=__float2bfloat16(o[d0][r]*rli[r]);}
    asm volatile("s_waitcnt lgkmcnt(0)":::"memory");
    #pragma unroll
    for(int i=0;i<4;++i){const int row=i*8+(lane>>3),ch=lane&7; const u32x4 v=*(const u32x4*)(stg+row*64+ch*8); ATTN_STORE16(Ow+(long)row*PO+ch*8,v);} }
  asm volatile("s_waitcnt lgkmcnt(0)\n\ts_barrier":::"memory");
  #undef DMA_K
  #undef DMA_V
  #undef CMASK
  #undef START
  #undef RESC
  #undef ROT
}
constexpr int ATTN_LDS_BYTES=LDS_BYTES;
struct AttnTensors { const bf16* Q; const bf16* K; const bf16* V; bf16* O; };
struct AttnUnit { int bh; int qb; };
__device__ __forceinline__ bool attn_next(int vcu,int i,AttnUnit&u){ if(i>=16)return false; const int s=vcu&7, j=i&3; u.bh=(vcu>>3)+32*(i>>2); u.qb=(j==0)?s:(j==1)?15-s:(j==2)?16+s:31-s; return true; }
template<int THRL=8> __device__ __forceinline__ void attn_phase(char*lds,const AttnTensors&T,int vcu,const __attribute__((address_space(3))) float*tball,const int tid){
  AttnUnit u;
  for(int i=0;attn_next(vcu,i,u);++i){ attn_unit<THRL>(u.bh/NHEAD,u.bh%NHEAD,u.qb,T.Q,T.K,T.V,T.O,lds,tball,tid); }
}
#undef SBAR
#undef WAIT_BAR
}

#define XB_TMO      128
#define XB_XCNT(j)  (256  + 64 * (j))
#define XB_XSUB(j)  (1280 + 64 * (j))
#define XB_XGEN(j)  (2304 + 64 * (j))
#define XB_TOP      3328
#define XB_TOPGEN   3392
#define XCD_BAR_WORDS 3456
#define XB_SPIN_CAP (1u << 18)

__device__ __forceinline__ unsigned xb_ld(unsigned* p)              { return __hip_atomic_load(p, __ATOMIC_RELAXED, __HIP_MEMORY_SCOPE_AGENT); }
__device__ __forceinline__ unsigned xb_add(unsigned* p, unsigned v) { return __hip_atomic_fetch_add(p, v, __ATOMIC_RELAXED, __HIP_MEMORY_SCOPE_AGENT); }
__device__ __forceinline__ unsigned xb_xcc_id() { return (unsigned)__builtin_amdgcn_s_getreg((3 << 11) | 20) & 0xFu; }
#define XB_SPIN(cond, bar) do { unsigned _sp = 0; while (cond) { __builtin_amdgcn_s_sleep(1); \
    if ((++_sp & 255u) == 0u) { if (xb_ld(&(bar)[XB_TMO])) break; if (_sp > XB_SPIN_CAP) { atomicAdd(&(bar)[XB_TMO], 1u); break; } } } } while (0)

struct XcdBarrier {
    unsigned* bar; unsigned x;
    volatile LAS unsigned* st;
};

__device__ __forceinline__ XcdBarrier xcd_barrier_post(unsigned* bar, volatile LAS unsigned* st, const bool leader  ) {
    XcdBarrier b; b.bar = bar; b.x = xb_xcc_id(); b.st = st;
    if (leader) (void)xb_add(&bar[XB_XCNT(b.x)], 1u);
    return b;
}
__device__ __forceinline__ void xcd_barrier_complete(unsigned* bar, unsigned x, unsigned& nloc, unsigned& nx) {
    const unsigned G = gridDim.x * gridDim.y * gridDim.z;
    unsigned sum, cnt, mine, sp = 0u;
    for (;;) {
        sum = 0u; cnt = 0u; mine = 0u;
#pragma unroll
        for (unsigned j = 0; j < 16; ++j) { const unsigned c = xb_ld(&bar[XB_XCNT(j)]); sum += c; cnt += (c > 0u) ? 1u : 0u; mine = (j == x) ? c : mine; }
        if (sum == G) break;
        __builtin_amdgcn_s_sleep(1);
        if ((++sp & 255u) == 0u) { if (xb_ld(&bar[XB_TMO])) break; if (sp > XB_SPIN_CAP) { atomicAdd(&bar[XB_TMO], 1u); break; } }
    }
    nloc = mine > 0u ? mine : 1u; nx = cnt > 0u ? cnt : 1u;
}

__device__ __forceinline__ void xcd_barrier(const XcdBarrier& b, const bool leader  ) {
    asm volatile("s_waitcnt vmcnt(0)" ::: "memory");
    __syncthreads();
    if (leader) {
        unsigned* bar = b.bar;
        __builtin_amdgcn_s_waitcnt(0);
        unsigned nloc = b.st[0], nx = b.st[1];
        if (nloc == 0u) { xcd_barrier_complete(bar, b.x, nloc, nx); b.st[0] = nloc; b.st[1] = nx; }
        const unsigned old = xb_add(&bar[XB_XSUB(b.x)], 1u);
        const unsigned gen = old / nloc;
        if (old + 1u == (gen + 1u) * nloc) {
            __builtin_amdgcn_fence(__ATOMIC_RELEASE, "agent");
            asm volatile("s_waitcnt vmcnt(0)" ::: "memory");
            const unsigned og = xb_add(&bar[XB_TOP], 1u);
            const unsigned tg = og / nx;
            if (og + 1u == (tg + 1u) * nx) xb_add(&bar[XB_TOPGEN], 1u);
            else XB_SPIN(xb_ld(&bar[XB_TOPGEN]) == tg, bar);
            __builtin_amdgcn_fence(__ATOMIC_ACQUIRE, "agent");
            xb_add(&bar[XB_XGEN(b.x)], 1u);
            asm volatile("s_waitcnt vmcnt(0)" ::: "memory");
        } else {
            XB_SPIN(xb_ld(&bar[XB_XGEN(b.x)]) == gen, bar);
            __builtin_amdgcn_fence(__ATOMIC_ACQUIRE, "agent");
            asm volatile("s_waitcnt vmcnt(0)" ::: "memory");
        }
    }
    __syncthreads();
}

constexpr size_t MiB = 1u << 20;
constexpr size_t WS_CTL = 0, CTL_ZERO_BYTES = 1 * MiB;
constexpr size_t WS_WIN = 2 * MiB;
constexpr size_t WS_WOUT = 7 * MiB;
constexpr size_t WS_PGATE = 9 * MiB;
constexpr size_t WS_PPROJ = 13 * MiB;
constexpr size_t WS_RCAT = 14 * MiB;
constexpr size_t WS_RL1 = 20 * MiB;
constexpr size_t WS_RS2 = 28 * MiB;
constexpr size_t WS_RWO = 30 * MiB;
constexpr size_t WS_ROUT = 32 * MiB;
constexpr size_t WS_LRUAGG = 33 * MiB;
constexpr size_t WS_MGU = 38 * MiB;
constexpr size_t WS_MDN = 102 * MiB;
constexpr size_t WS_PB = 134 * MiB;
constexpr size_t WS_ACT = 166 * MiB;
constexpr size_t WS_H0 = WS_ACT;
constexpr size_t WS_QKV = WS_ACT + 128 * MiB;
constexpr size_t WS_O = WS_ACT + 448 * MiB;
constexpr size_t WS_HL = WS_ACT + 576 * MiB, WS_CA = WS_ACT + 640 * MiB;
constexpr size_t WS_H2 = WS_ACT;
constexpr size_t WS_LOG = WS_ACT + 128 * MiB;
constexpr size_t WS_ROUTE = WS_ACT + 144 * MiB;
constexpr size_t WS_HID = WS_ACT + 152 * MiB;
constexpr size_t WS_YS = WS_ACT + 288 * MiB;
constexpr size_t WS_PP = WS_ACT + 128 * MiB;
constexpr size_t WS_HCAT = WS_ACT;
constexpr size_t WS_XR = WS_ACT + 256 * MiB, WS_XK = WS_ACT + 384 * MiB, WS_XV = WS_ACT + 512 * MiB;
constexpr size_t WS_R = WS_ACT + 640 * MiB, WS_K = WS_XR, WS_V = WS_XK;
constexpr size_t WS_MID = WS_ACT + 768 * MiB;
constexpr size_t WS_EW = WS_ACT;
constexpr size_t WS_AA = WS_ACT + 128 * MiB;
constexpr size_t WS_Y = WS_XV;
constexpr size_t WS_END = WS_ACT + 832 * MiB;
static_assert(WS_END <= 1024 * MiB, "workspace map");
constexpr size_t RT_EID = 0, RT_POS = 1 * MiB, RT_GATE = 2 * MiB, RT_ROWTOK = 3 * MiB, RT_ROWGATE = 4 * MiB, RT_SLOT = 5 * MiB;
constexpr int CW_BAR = 4096;
constexpr int CW_CNT0 = 16384, CW_CNT1 = 16384 + 64;

constexpr int RING_BYTES = 131072;
constexpr int LDSCTL_OFF = RING_BYTES, MISC_OFF = LDSCTL_OFF + 320;
constexpr int TB_OFF = RING_BYTES + 1024;
constexpr int RTE_OFF = TB_OFF + 2048;
constexpr int LDS_BYTES = 147456;

constexpr int NWAVES = 8;
__device__ __forceinline__ int lane_id_() { int l; asm volatile("v_mbcnt_lo_u32_b32 %0, -1, 0\n\tv_mbcnt_hi_u32_b32 %0, -1, %0" : "=v"(l)); return l; }
#define TID_ (F.wave * 64 + lane_id_())
#define LANE_ (lane_id_())
struct Frame {
    LAS unsigned char* lds; volatile LAS unsigned* MISC; gu32* ctl;
    int wave, vcu, G;
};

__device__ __forceinline__ void load_row4(const float* xrow, int lane, f32x4 (&v)[4]) { const f32x4* p = (const f32x4*)xrow + lane;
#pragma unroll
    for (int j = 0; j < 4; ++j) v[j] = p[64 * j]; }
__device__ __forceinline__ float row_rstd(const f32x4 (&v)[4], float eps) { float s = 0.f;
#pragma unroll
    for (int j = 0; j < 4; ++j) s += (v[j].x * v[j].x + v[j].y * v[j].y) + (v[j].z * v[j].z + v[j].w * v[j].w);
    return 1.0f / sqrtf(wave_sum(s) * (1.0f / 1024.0f) + eps); }
__device__ __forceinline__ void load_row4_bf(const bf16* xrow, int lane, f32x4 (&v)[4]) { const v2u* p = (const v2u*)xrow + lane;
#pragma unroll
    for (int j = 0; j < 4; ++j) { const v2u w = p[64 * j]; v[j] = (f32x4){bflo(w.x), bfhi(w.x), bflo(w.y), bfhi(w.y)}; } }
__device__ __forceinline__ void store_row4_bf(bf16* xrow, int lane, const f32x4 (&v)[4]) { v2u* p = (v2u*)xrow + lane;
#pragma unroll
    for (int j = 0; j < 4; ++j) { v2u o; o.x = pk2(v[j].x, v[j].y); o.y = pk2(v[j].z, v[j].w); p[64 * j] = o; } }
__device__ __forceinline__ void store_row_bf16(bf16* orow, int lane, const f32x4 (&v)[4], float rstd, const float* g) {
    unsigned long long* o8 = (unsigned long long*)orow + lane;
#pragma unroll
    for (int j = 0; j < 4; ++j) { const f32x4 gg = ((const f32x4*)g)[lane + 64 * j];
        o8[64 * j] = (unsigned long long)pk2(v[j].x * rstd * gg.x, v[j].y * rstd * gg.y) | ((unsigned long long)pk2(v[j].z * rstd * gg.z, v[j].w * rstd * gg.w) << 32); }
}

template <int MODE>
__device__ __forceinline__ void transpose_item(const float* W, int K, int N, bf16* WT, int ldo, int row_off, const float* mu, LAS float* scr, int item, int lane) {
    const int nblk = N / 32, kb = item / nblk, nb = item % nblk, k0 = 64 * kb, n0 = 32 * nb;
    float ld[32];
#pragma unroll
    for (int i = 0; i < 32; ++i) { const int kk = 2 * i + (lane >> 5); ld[i] = W[(size_t)(k0 + kk) * N + n0 + (lane & 31)]; }
#pragma unroll
    for (int i = 0; i < 32; ++i) { const int kk = 2 * i + (lane >> 5); scr[kk * 33 + (lane & 31)] = ld[i]; }
    LDS_WAIT(); asm volatile("" ::: "memory");
    const int c = lane & 7;
    int rbase = row_off + n0;
    if (MODE == 2) { rbase = row_off + ((n0 < 512) ? ((n0 >> 7) * 256 + (n0 & 127)) : (((n0 - 512) >> 7) * 256 + 128 + ((n0 - 512) & 127))); }
    float m[8];
    if (MODE == 1) {
#pragma unroll
        for (int e = 0; e < 8; ++e) m[e] = mu[k0 + 8 * c + e]; }
#pragma unroll
    for (int j = 0; j < 4; ++j) { const int n = (lane >> 3) + 8 * j; const LAS float* s = scr + (8 * c) * 33 + n;
        float v[8];
#pragma unroll
        for (int e = 0; e < 8; ++e) v[e] = s[e * 33];
        bf16* dst = WT + (size_t)(rbase + n) * ldo + k0 + 8 * c;
        if (MODE == 1) {
            v4u o, o2;
            o.x = pk2(v[0] * (1.f - m[0]), v[1] * (1.f - m[1])); o.y = pk2(v[2] * (1.f - m[2]), v[3] * (1.f - m[3])); o.z = pk2(v[4] * (1.f - m[4]), v[5] * (1.f - m[5])); o.w = pk2(v[6] * (1.f - m[6]), v[7] * (1.f - m[7]));
            o2.x = pk2(v[0] * m[0], v[1] * m[1]); o2.y = pk2(v[2] * m[2], v[3] * m[3]); o2.z = pk2(v[4] * m[4], v[5] * m[5]); o2.w = pk2(v[6] * m[6], v[7] * m[7]);
            *(GAS v4u*)dst = o; *(GAS v4u*)(dst + 1024) = o2;
        } else {
            v4u o; o.x = pk2(v[0], v[1]); o.y = pk2(v[2], v[3]); o.z = pk2(v[4], v[5]); o.w = pk2(v[6], v[7]);
            *(GAS v4u*)dst = o; }
    }
    LDS_WAIT(); asm volatile("" ::: "memory");
}

struct In {
    const float *x, *p, *rel_bias, *norm_mix, *ab_w_in, *ab_w_out, *lam_q1, *lam_k1, *lam_q2, *lam_k2, *sub_g, *conv_w, *conv_b, *lru_wa, *lru_ba, *lru_wx, *lru_bx, *lru_lambda,
        *rwkv_mu, *rwkv_wr, *rwkv_wk, *rwkv_wv, *rwkv_wo, *rwkv_w0, *rwkv_w1, *rwkv_w2, *rwkv_a0, *rwkv_a1, *rwkv_a2, *rwkv_g1, *rwkv_g2, *rwkv_kk, *rwkv_ka, *rwkv_rk, *rwkv_ln_g, *rwkv_ln_b,
        *norm_ffn, *moe_wc, *moe_bc, *moe_wf, *moe_bf, *moe_w_gu, *moe_w_down, *ple_norm, *ple_gate, *ple_proj, *final_norm;
};

__device__ __forceinline__ void prep_dense_weights(Frame& F, const In& I, unsigned char* ws) {
    LAS float* scr = (LAS float*)(F.lds + F.wave * 16384);
    const int gw = F.vcu * NWAVES + F.wave, NGW = F.G * NWAVES;
    bf16* WIN = (bf16*)(ws + WS_WIN); bf16* WOUT = (bf16*)(ws + WS_WOUT); bf16* PG = (bf16*)(ws + WS_PGATE); bf16* PPJ = (bf16*)(ws + WS_PPROJ);
    bf16* RCAT = (bf16*)(ws + WS_RCAT); bf16* RL1 = (bf16*)(ws + WS_RL1); bf16* RWO = (bf16*)(ws + WS_RWO);
    constexpr int I_IN = (1024 / 64) * (2560 / 32), I_SQ = (1024 / 64) * (1024 / 32), I_PJ = (256 / 64) * (1024 / 32), I_L64 = (1024 / 64) * (64 / 32), I_L160 = (1024 / 64) * (160 / 32);
    int st = gw;
#define TJOB(MODE, NITEMS, W, K, N, WT, LDO, ROFF, MU) do { for (int it = st; it < (NITEMS); it += NGW) transpose_item<MODE>(W, K, N, WT, LDO, ROFF, MU, scr, it, LANE_); \
        st = (st + NGW - ((NITEMS) % NGW)) % NGW; asm volatile("" : "+s"(st)); } while (0)
    TJOB(0, I_IN, I.ab_w_in, 1024, 2560, WIN, 1024, 0, nullptr);
    TJOB(0, I_SQ, I.ab_w_out, 1024, 1024, WOUT, 1024, 0, nullptr);
    TJOB(0, I_SQ, I.ple_gate, 1024, 1024, PG, 1024, 0, nullptr);
    TJOB(0, I_SQ, I.ple_gate + 1024 * 1024, 1024, 1024, PG + 1024 * 1024, 1024, 0, nullptr);
    TJOB(0, I_SQ, I.rwkv_wo, 1024, 1024, RWO, 1024, 0, nullptr);
    TJOB(0, I_SQ, I.rwkv_wr, 1024, 1024, RCAT, 1024, 0, nullptr);
    TJOB(0, I_SQ, I.rwkv_wk, 1024, 1024, RCAT, 1024, 1024, nullptr);
    TJOB(0, I_SQ, I.rwkv_wv, 1024, 1024, RCAT, 1024, 2048, nullptr);
    TJOB(0, I_PJ, I.ple_proj, 256, 1024, PPJ, 256, 0, nullptr);
    TJOB(0, I_PJ, I.ple_proj + 256 * 1024, 256, 1024, PPJ + 1024 * 256, 256, 0, nullptr);
    TJOB(1, I_L64, I.rwkv_w1, 1024, 64, RL1, 2048, 0, I.rwkv_mu + 1 * 1024);
    TJOB(1, I_L64, I.rwkv_a1, 1024, 64, RL1, 2048, 64, I.rwkv_mu + 4 * 1024);
    TJOB(1, I_L160, I.rwkv_g1, 1024, 160, RL1, 2048, 256, I.rwkv_mu + 5 * 1024);
#undef TJOB
    const int gt = F.vcu * 512 + TID_, NGT = F.G * 512;
    { v4u z = {0u, 0u, 0u, 0u}; const int per_row = 2048 / 8;
      for (int i = gt; i < (128 + 96) * per_row; i += NGT) { int rr = i / per_row, cc = i % per_row; rr = (rr < 128) ? (128 + rr) : (416 + rr - 128); *(GAS v4u*)(RL1 + (size_t)rr * 2048 + cc * 8) = z; } }
    { bf16* S2 = (bf16*)(ws + WS_RS2);
      for (int i = gt; i < 3 * 1024 * 256; i += NGT) { const int ty = i / (1024 * 256), n = (i / 256) & 1023, k = i & 255; float v = 0.f;
          if (ty == 0) { if (k < 64) v = I.rwkv_w2[k * 1024 + n]; } else if (ty == 1) { if (k >= 64 && k < 128) v = I.rwkv_a2[(k - 64) * 1024 + n]; } else { if (k < 160) v = I.rwkv_g2[k * 1024 + n]; }
          S2[i] = (bf16)f2bf(v); } }
    { bf16* RT = (bf16*)(ws + WS_ROUT);
      for (int i = gt; i < 2 * 256 * 1024; i += NGT) { const int l = i / (256 * 1024), n = (i / 1024) & 255, k = i & 1023; float v = 0.f;
          if (n < 4) v = I.moe_wc[(size_t)l * 1024 * 4 + k * 4 + n]; else if (n < 36) v = I.moe_wf[(size_t)l * 1024 * 32 + k * 32 + (n - 4)];
          RT[i] = (bf16)f2bf(v); } }
}
__device__ __forceinline__ void prep_layer_weights(Frame& F, const In& I, unsigned char* ws, int layer) {
    LAS float* scr = (LAS float*)(F.lds + F.wave * 16384);
    const int gw = F.vcu * NWAVES + F.wave, NGW = F.G * NWAVES;
    bf16* MGU = (bf16*)(ws + WS_MGU); bf16* MDN = (bf16*)(ws + WS_MDN);
    const float* wgu = I.moe_w_gu + (size_t)layer * NEXP * 1024 * 1024; const float* wdn = I.moe_w_down + (size_t)layer * NEXP * 512 * 1024;
    constexpr int I_GU = (1024 / 64) * (1024 / 32), I_DN = (512 / 64) * (1024 / 32);
    for (int it = gw; it < NEXP * (I_GU + I_DN); it += NGW) {
        const int e = it / (I_GU + I_DN); int r = it % (I_GU + I_DN);
        if (r < I_GU) transpose_item<2>(wgu + (size_t)e * 1024 * 1024, 1024, 1024, MGU + (size_t)e * 1024 * 1024, 1024, 0, nullptr, scr, r, LANE_);
        else transpose_item<0>(wdn + (size_t)e * 512 * 1024, 512, 1024, MDN + (size_t)e * 1024 * 512, 512, 0, nullptr, scr, r - I_GU, LANE_);
    }
    const int gt = F.vcu * 512 + TID_, NGT = F.G * 512;
    const f32x4* ps = (const f32x4*)(I.p + (size_t)layer * T * PLE); v2u* pd = (v2u*)(ws + WS_PB);
    for (int i = gt; i < T * PLE / 4; i += 4 * NGT) { f32x4 v[4];
#pragma unroll
        for (int r = 0; r < 4; ++r) v[r] = ps[i + r * NGT];
#pragma unroll
        for (int r = 0; r < 4; ++r) { v2u o; o.x = pk2(v[r].x, v[r].y); o.y = pk2(v[r].z, v[r].w); pd[i + r * NGT] = o; } }
}

template <bool XBF>
__device__ __forceinline__ void norm_pass(Frame& F, const void* x, const float* g, bf16* out) {
    const int gw = F.vcu * NWAVES + F.wave, NGW = F.G * NWAVES; const int lane = LANE_;
    for (int t = 4 * gw; t < T; t += 4 * NGW) {
        f32x4 v[4][4];
#pragma unroll
        for (int r = 0; r < 4; ++r) { if (XBF) load_row4_bf((const bf16*)x + (size_t)(t + r) * D, lane, v[r]); else load_row4((const float*)x + (size_t)(t + r) * D, lane, v[r]); }
#pragma unroll
        for (int r = 0; r < 4; ++r) { const float rs = row_rstd(v[r], 1e-6f); store_row_bf16(out + (size_t)(t + r) * D, lane, v[r], rs, g); }
    }
}
__device__ __forceinline__ void rwkv_input_pass(Frame& F, const bf16* x, const float* g, const float* mu, bf16* HCAT, bf16* XR, bf16* XK, bf16* XV) {
    const int gw = F.vcu * NWAVES + F.wave, NGW = F.G * NWAVES; const int lane = LANE_;
    f32x4 gg[4], mr[4], mk[4], mv[4];
#pragma unroll
    for (int j = 0; j < 4; ++j) { gg[j] = ((const f32x4*)g)[lane + 64 * j]; mr[j] = ((const f32x4*)(mu + 0 * 1024))[lane + 64 * j]; mk[j] = ((const f32x4*)(mu + 2 * 1024))[lane + 64 * j]; mv[j] = ((const f32x4*)(mu + 3 * 1024))[lane + 64 * j]; }
    for (int blk = gw; blk < T / 32; blk += NGW) {
        const int t0 = blk * 32; f32x4 hp[4];
        if ((t0 & (SEQ - 1)) == 0) {
#pragma unroll
            for (int j = 0; j < 4; ++j) hp[j] = (f32x4){0.f, 0.f, 0.f, 0.f};
        } else { f32x4 v[4]; load_row4_bf(x + (size_t)(t0 - 1) * D, lane, v); const float rstd = row_rstd(v, 1e-6f);
#pragma unroll
            for (int j = 0; j < 4; ++j) hp[j] = v[j] * rstd * gg[j]; }
        f32x4 vn[4]; load_row4_bf(x + (size_t)t0 * D, lane, vn);
        for (int t = t0; t < t0 + 32; ++t) {
            f32x4 v[4];
#pragma unroll
            for (int j = 0; j < 4; ++j) v[j] = vn[j];
            if (t + 1 < t0 + 32) load_row4_bf(x + (size_t)(t + 1) * D, lane, vn);
            const float rstd = row_rstd(v, 1e-6f);
            unsigned long long* oh = (unsigned long long*)(HCAT + (size_t)t * 2048) + lane; unsigned long long* or_ = (unsigned long long*)(XR + (size_t)t * 1024) + lane;
            unsigned long long* ok = (unsigned long long*)(XK + (size_t)t * 1024) + lane; unsigned long long* ov = (unsigned long long*)(XV + (size_t)t * 1024) + lane;
#pragma unroll
            for (int j = 0; j < 4; ++j) { const f32x4 h = v[j] * rstd * gg[j], dd = hp[j] - h;
                oh[64 * j] = (unsigned long long)pk2(h.x, h.y) | ((unsigned long long)pk2(h.z, h.w) << 32);
                oh[256 + 64 * j] = (unsigned long long)pk2(hp[j].x, hp[j].y) | ((unsigned long long)pk2(hp[j].z, hp[j].w) << 32);
                const f32x4 a = h + dd * mr[j], b = h + dd * mk[j], c = h + dd * mv[j];
                or_[64 * j] = (unsigned long long)pk2(a.x, a.y) | ((unsigned long long)pk2(a.z, a.w) << 32);
                ok[64 * j] = (unsigned long long)pk2(b.x, b.y) | ((unsigned long long)pk2(b.z, b.w) << 32);
                ov[64 * j] = (unsigned long long)pk2(c.x, c.y) | ((unsigned long long)pk2(c.z, c.w) << 32);
                hp[j] = h; }
        }
    }
}
__device__ __forceinline__ void combine_norm_pass(Frame& F, const bf16* xin, bf16* xout, const bf16* YS, const int* slot, const float* g, bf16* out) {
    const int gw = F.vcu * NWAVES + F.wave, NGW = F.G * NWAVES; const int lane = LANE_;
    for (int t = 2 * gw; t < T; t += 2 * NGW) {
        f32x4 v[2][4]; v2u ya[2][4], yb[2][4];
#pragma unroll
        for (int r = 0; r < 2; ++r) { load_row4_bf(xin + (size_t)(t + r) * D, lane, v[r]);
            const int s0 = slot[2 * (t + r)], s1 = slot[2 * (t + r) + 1];
            const v2u* y0 = (const v2u*)(YS + (size_t)s0 * D) + lane; const v2u* y1 = (const v2u*)(YS + (size_t)s1 * D) + lane;
#pragma unroll
            for (int j = 0; j < 4; ++j) { ya[r][j] = y0[64 * j]; yb[r][j] = y1[64 * j]; } }
#pragma unroll
        for (int r = 0; r < 2; ++r) {
#pragma unroll
            for (int j = 0; j < 4; ++j) { const v2u a = ya[r][j], b = yb[r][j];
                v[r][j].x += bflo(a.x) + bflo(b.x); v[r][j].y += bfhi(a.x) + bfhi(b.x); v[r][j].z += bflo(a.y) + bflo(b.y); v[r][j].w += bfhi(a.y) + bfhi(b.y); }
            store_row4_bf(xout + (size_t)(t + r) * D, lane, v[r]);
            const float rstd = row_rstd(v[r], 1e-6f);
            store_row_bf16(out + (size_t)(t + r) * D, lane, v[r], rstd, g); }
    }
}
__device__ __forceinline__ void final_norm_pass(Frame& F, const bf16* x, float* out, const float* g) {
    const int gw = F.vcu * NWAVES + F.wave, NGW = F.G * NWAVES; const int lane = LANE_;
    for (int t = 4 * gw; t < T; t += 4 * NGW) {
        f32x4 v[4][4];
#pragma unroll
        for (int r = 0; r < 4; ++r) load_row4_bf(x + (size_t)(t + r) * D, lane, v[r]);
#pragma unroll
        for (int r = 0; r < 4; ++r) { const float rs = row_rstd(v[r], 1e-6f); f32x4* xo = (f32x4*)(out + (size_t)(t + r) * D) + lane;
#pragma unroll
            for (int j = 0; j < 4; ++j) { const f32x4 gg = ((const f32x4*)g)[lane + 64 * j]; xo[64 * j] = v[r][j] * rs * gg; } }
    }
}

__device__ __forceinline__ void diff_combine_pass(Frame& F, const In& I, const bf16* O, bf16* YCAT) {
    const int gw = F.vcu * NWAVES + F.wave, NGW = F.G * NWAVES;
    const float lam_init = 0.2f;
    const float d1 = wave_sum(I.lam_q1[LANE_] * I.lam_k1[LANE_]), d2 = wave_sum(I.lam_q2[LANE_] * I.lam_k2[LANE_]);
    const float lam = expf(d1) - expf(d2) + lam_init;
    const int h = LANE_ >> 4, q = LANE_ & 15;
    float sg[8];
#pragma unroll
    for (int e = 0; e < 8; ++e) sg[e] = I.sub_g[q * 8 + e] * (1.0f - lam_init);
    for (int t0 = 4 * gw; t0 < T; t0 += 4 * NGW) {
        v4u av[4], bv[4];
#pragma unroll
        for (int r = 0; r < 4; ++r) { av[r] = *(const v4u*)(O + (size_t)(t0 + r) * 1024 + h * 256 + q * 8); bv[r] = *(const v4u*)(O + (size_t)(t0 + r) * 1024 + h * 256 + 128 + q * 8); }
#pragma unroll
        for (int r = 0; r < 4; ++r) { const v4u a = av[r], b = bv[r]; const int t = t0 + r;
        float o[8];
        o[0] = bflo(a.x) - lam * bflo(b.x); o[1] = bfhi(a.x) - lam * bfhi(b.x); o[2] = bflo(a.y) - lam * bflo(b.y); o[3] = bfhi(a.y) - lam * bfhi(b.y);
        o[4] = bflo(a.z) - lam * bflo(b.z); o[5] = bfhi(a.z) - lam * bfhi(b.z); o[6] = bflo(a.w) - lam * bflo(b.w); o[7] = bfhi(a.w) - lam * bfhi(b.w);
        float s = 0.f;
#pragma unroll
        for (int e = 0; e < 8; ++e) s += o[e] * o[e];
        s += __shfl_xor(s, 1); s += __shfl_xor(s, 2); s += __shfl_xor(s, 4); s += __shfl_xor(s, 8);
        const float rstd = 1.0f / sqrtf(s * (1.0f / 128.0f) + 1e-5f);
        v4u w; w.x = pk2(o[0] * rstd * sg[0], o[1] * rstd * sg[1]); w.y = pk2(o[2] * rstd * sg[2], o[3] * rstd * sg[3]); w.z = pk2(o[4] * rstd * sg[4], o[5] * rstd * sg[5]); w.w = pk2(o[6] * rstd * sg[6], o[7] * rstd * sg[7]);
        *(v4u*)(YCAT + (size_t)t * 1024 + h * 128 + q * 8) = w; }
    }
}

constexpr int LCT = 64, LNCH = SEQ / LCT;
__device__ __forceinline__ float gelu_tanh(float x) { const float u = 0.7978845608028654f * (x + 0.044715f * x * x * x); return x * sigmoidf_(2.0f * u); }
template <bool FINAL>
__device__ __forceinline__ void lru_phase(Frame& F, const In& I, const bf16* XB, const bf16* GB, f32x2* AGG, bf16* YCAT, bf16* HLp, bf16* CAp) {
    const int ch = TID_, n = ch >> 6, d = ch & 63;
    LAS float* U = (LAS float*)F.lds;
    f32x2 wg[64];
#pragma unroll
    for (int c = 0; c < 64; ++c) { wg[c].x = I.lru_wa[n * 4096 + c * 64 + d]; wg[c].y = I.lru_wx[n * 4096 + c * 64 + d]; }
    const float cw0 = I.conv_w[0 * 512 + ch], cw1 = I.conv_w[1 * 512 + ch], cw2 = I.conv_w[2 * 512 + ch], cw3 = I.conv_w[3 * 512 + ch], cb = I.conv_b[ch];
    const float ba = I.lru_ba[ch], bx = I.lru_bx[ch];
    const float lam = I.lru_lambda[ch]; const float sp = (lam > 15.f) ? expf(-lam) : log1pf(expf(-lam));
    const float m8sp = -8.0f * sp;
    for (int un = blockIdx.x; un < NB * LNCH; un += F.G) {
        const int b = un / LNCH, c = un % LNCH; const size_t row0 = (size_t)b * SEQ + (size_t)c * LCT;
        unsigned short xraw[LCT + 3];
        if (c > 0) { xraw[0] = XB[(row0 - 3) * 512 + ch]; xraw[1] = XB[(row0 - 2) * 512 + ch]; xraw[2] = XB[(row0 - 1) * 512 + ch]; } else { xraw[0] = 0; xraw[1] = 0; xraw[2] = 0; }
#pragma unroll
        for (int tk = 0; tk < LCT; ++tk) xraw[3 + tk] = XB[(row0 + tk) * 512 + ch];
        float h = 0.f, Ap = 1.f;
        if (FINAL) { for (int j = 0; j < c; ++j) { const f32x2 ag = AGG[((size_t)b * LNCH + j) * 512 + ch]; h = ag.x * h + ag.y; } }
#pragma unroll
        for (int tk = 0; tk < LCT; ++tk) U[tk * 512 + ch] = cw0 * bf1(xraw[tk]) + cw1 * bf1(xraw[tk + 1]) + cw2 * bf1(xraw[tk + 2]) + cw3 * bf1(xraw[tk + 3]) + cb;
        __syncthreads();
        unsigned short gcur[8], gnxt[8];
        if (FINAL) {
#pragma unroll
            for (int j = 0; j < 8; ++j) gcur[j] = GB[(row0 + j) * 512 + ch]; }
#pragma unroll 1
        for (int tg = 0; tg < LCT / 8; ++tg) {
            if (FINAL) { const int tn = (tg + 1 < LCT / 8) ? (tg + 1) * 8 : tg * 8;
#pragma unroll
                for (int j = 0; j < 8; ++j) gnxt[j] = GB[(row0 + tn + j) * 512 + ch]; }
#pragma unroll
            for (int j = 0; j < 8; ++j) { const int tk = tg * 8 + j;
                const LAS f32x4* up = (const LAS f32x4*)(U + tk * 512 + n * 64);
                f32x2 acc = {ba, bx};
#pragma unroll
                for (int c4 = 0; c4 < 16; ++c4) { const f32x4 uu = up[c4];
                    acc += wg[4 * c4 + 0] * uu.x; acc += wg[4 * c4 + 1] * uu.y; acc += wg[4 * c4 + 2] * uu.z; acc += wg[4 * c4 + 3] * uu.w; }
                const float r = sigmoidf_(acc.x), ig = sigmoidf_(acc.y);
                const float la = r * m8sp; const float a = __expf(la); const float t2 = 2.0f * la; const float om = (t2 > -0.02f) ? -t2 * (1.0f + t2 * (0.5f + t2 * (0.16666667f + t2 * 0.041666668f))) : 1.0f - a * a; const float bb = __builtin_amdgcn_sqrtf(om) * (ig * U[tk * 512 + ch]);
                h = a * h + bb;
                if (FINAL) { YCAT[(row0 + tk) * 1024 + 512 + ch] = (bf16)f2bf(h * gelu_tanh(bf1(gcur[j]))); }
                else { Ap *= a; HLp[(row0 + tk) * 512 + ch] = (bf16)f2bf(h); CAp[(row0 + tk) * 512 + ch] = (bf16)f2bf(Ap); } }
            if (FINAL) {
#pragma unroll
                for (int j = 0; j < 8; ++j) gcur[j] = gnxt[j]; }
        }
        if (!FINAL) { f32x2 ag; ag.x = Ap; ag.y = h; AGG[((size_t)b * LNCH + c) * 512 + ch] = ag; }
        __syncthreads();
    }
}

__device__ __forceinline__ void lru_agg_mfma(Frame& F, const In& I, const bf16* XB, f32x2* AGG, bf16* HLp, bf16* CAp) {
    const int tid = TID_, lane = tid & 63, fr = lane & 15, fq = lane >> 4, n = F.wave, ch = tid;
    constexpr int UP = 520;
    LAS bf16* U = (LAS bf16*)F.lds;
    bf16x8 Wr[4][2], Wi[4][2];
#pragma unroll
    for (int dd = 0; dd < 4; ++dd)
#pragma unroll
        for (int kh = 0; kh < 2; ++kh) { unsigned pr_[4], pi_[4];
#pragma unroll
            for (int j = 0; j < 4; ++j) { const int c0 = 32 * kh + 8 * fq + 2 * j, d = 16 * dd + fr;
                pr_[j] = pk2(I.lru_wa[n * 4096 + c0 * 64 + d], I.lru_wa[n * 4096 + (c0 + 1) * 64 + d]); pi_[j] = pk2(I.lru_wx[n * 4096 + c0 * 64 + d], I.lru_wx[n * 4096 + (c0 + 1) * 64 + d]); }
            Wr[dd][kh] = __builtin_bit_cast(bf16x8, (v4u){pr_[0], pr_[1], pr_[2], pr_[3]}); Wi[dd][kh] = __builtin_bit_cast(bf16x8, (v4u){pi_[0], pi_[1], pi_[2], pi_[3]}); }
    float cba[4], cbx[4], cm8[4];
#pragma unroll
    for (int dd = 0; dd < 4; ++dd) { const int chd = 64 * n + 16 * dd + fr; cba[dd] = I.lru_ba[chd]; cbx[dd] = I.lru_bx[chd];
        const float lam = I.lru_lambda[chd]; cm8[dd] = -8.0f * ((lam > 15.f) ? expf(-lam) : log1pf(expf(-lam))); }
    const float cw0 = I.conv_w[0 * 512 + ch], cw1 = I.conv_w[1 * 512 + ch], cw2 = I.conv_w[2 * 512 + ch], cw3 = I.conv_w[3 * 512 + ch], cb = I.conv_b[ch];
    for (int un = blockIdx.x; un < NB * LNCH; un += F.G) {
        const int b = un / LNCH, c = un % LNCH; const size_t row0 = (size_t)b * SEQ + (size_t)c * LCT;
        unsigned short xraw[LCT + 3];
        if (c > 0) { xraw[0] = XB[(row0 - 3) * 512 + ch]; xraw[1] = XB[(row0 - 2) * 512 + ch]; xraw[2] = XB[(row0 - 1) * 512 + ch]; } else { xraw[0] = 0; xraw[1] = 0; xraw[2] = 0; }
#pragma unroll
        for (int tk = 0; tk < LCT; ++tk) xraw[3 + tk] = XB[(row0 + tk) * 512 + ch];
#pragma unroll
        for (int tk = 0; tk < LCT; ++tk) U[tk * UP + ch] = (bf16)f2bf(cw0 * bf1(xraw[tk]) + cw1 * bf1(xraw[tk + 1]) + cw2 * bf1(xraw[tk + 2]) + cw3 * bf1(xraw[tk + 3]) + cb);
        __syncthreads();
        bf16x8 X[4][2];
#pragma unroll
        for (int tt = 0; tt < 4; ++tt)
#pragma unroll
            for (int kh = 0; kh < 2; ++kh) X[tt][kh] = *(const LAS bf16x8*)(U + (16 * tt + fr) * UP + 64 * n + 32 * kh + 8 * fq);
#pragma unroll 1
        for (int dd = 0; dd < 4; ++dd) {
            bf16x8 wr0, wr1, wi0, wi1; float kba, kbx, km8;
            if (dd == 0) { wr0 = Wr[0][0]; wr1 = Wr[0][1]; wi0 = Wi[0][0]; wi1 = Wi[0][1]; kba = cba[0]; kbx = cbx[0]; km8 = cm8[0]; }
            else if (dd == 1) { wr0 = Wr[1][0]; wr1 = Wr[1][1]; wi0 = Wi[1][0]; wi1 = Wi[1][1]; kba = cba[1]; kbx = cbx[1]; km8 = cm8[1]; }
            else if (dd == 2) { wr0 = Wr[2][0]; wr1 = Wr[2][1]; wi0 = Wi[2][0]; wi1 = Wi[2][1]; kba = cba[2]; kbx = cbx[2]; km8 = cm8[2]; }
            else { wr0 = Wr[3][0]; wr1 = Wr[3][1]; wi0 = Wi[3][0]; wi1 = Wi[3][1]; kba = cba[3]; kbx = cbx[3]; km8 = cm8[3]; }
            const int chd = 64 * n + 16 * dd + fr;
            float hc = 0.f, Ac = 1.f;
#pragma unroll
            for (int tt = 0; tt < 4; ++tt) {
                f32x4 pr = (f32x4){0.f, 0.f, 0.f, 0.f}, pi = pr;
                pr = __builtin_amdgcn_mfma_f32_16x16x32_bf16(X[tt][0], wr0, pr, 0, 0, 0); pr = __builtin_amdgcn_mfma_f32_16x16x32_bf16(X[tt][1], wr1, pr, 0, 0, 0);
                pi = __builtin_amdgcn_mfma_f32_16x16x32_bf16(X[tt][0], wi0, pi, 0, 0, 0); pi = __builtin_amdgcn_mfma_f32_16x16x32_bf16(X[tt][1], wi1, pi, 0, 0, 0);
                float a[4], bb[4];
#pragma unroll
                for (int e = 0; e < 4; ++e) { const int tok = 16 * tt + 4 * fq + e; const float u = bf1(U[tok * UP + chd]);
                    const float r = sigmoidf_(pr[e] + kba), ig = sigmoidf_(pi[e] + kbx); const float la = r * km8; a[e] = __expf(la); const float t2 = 2.0f * la;
                    const float om = (t2 > -0.02f) ? -t2 * (1.0f + t2 * (0.5f + t2 * (0.16666667f + t2 * 0.041666668f))) : 1.0f - a[e] * a[e]; bb[e] = __builtin_amdgcn_sqrtf(om) * (ig * u); }
                const float A4 = (a[0] * a[1]) * (a[2] * a[3]); const float B4 = ((bb[0] * a[1] + bb[1]) * a[2] + bb[2]) * a[3] + bb[3];
                float h = hc, Ap = Ac, hs = hc, As = Ac;
#pragma unroll
                for (int j = 0; j < 4; ++j) { const float Aj = __shfl(A4, fr + 16 * j), Bj = __shfl(B4, fr + 16 * j); if (j == fq) { hs = h; As = Ap; } h = Aj * h + Bj; Ap *= Aj; }
                hc = h; Ac = Ap; h = hs; Ap = As;
#pragma unroll
                for (int e = 0; e < 4; ++e) { h = a[e] * h + bb[e]; Ap *= a[e]; const size_t o = (row0 + 16 * tt + 4 * fq + e) * 512 + chd; HLp[o] = (bf16)f2bf(h); CAp[o] = (bf16)f2bf(Ap); }
            }
            if (fq == 0) { f32x2 ag; ag.x = Ac; ag.y = hc; AGG[((size_t)b * LNCH + c) * 512 + chd] = ag; }
        }
        __syncthreads();
    }
}

__device__ __forceinline__ void lru_final_pass(Frame& F, const bf16* HLp, const bf16* CAp, const bf16* GB, const f32x2* AGG, bf16* YCAT) {
    const int ch = TID_;
    for (int un = blockIdx.x; un < NB * LNCH; un += F.G) {
        const int b = un / LNCH, c = un % LNCH; const size_t row0 = (size_t)b * SEQ + (size_t)c * LCT;
        float carry = 0.f;
        for (int j = 0; j < c; ++j) { const f32x2 ag = AGG[((size_t)b * LNCH + j) * 512 + ch]; carry = ag.x * carry + ag.y; }
#pragma unroll 4
        for (int t8 = 0; t8 < LCT; t8 += 8) {
            bf16 hl[8], ca[8], gv[8];
#pragma unroll
            for (int j = 0; j < 8; ++j) { const size_t o = (row0 + t8 + j) * 512 + ch; hl[j] = HLp[o]; ca[j] = CAp[o]; gv[j] = GB[o]; }
#pragma unroll
            for (int j = 0; j < 8; ++j) { const float h = bf1(hl[j]) + bf1(ca[j]) * carry; YCAT[(row0 + t8 + j) * 1024 + 512 + ch] = (bf16)f2bf(h * gelu_tanh(bf1(gv[j]))); }
        }
    }
}

__device__ __forceinline__ void route_pass_a(Frame& F, const In& I, int layer, const float* LOG, unsigned char* rt, gu32* cnt) {
    LAS int* lcnt = (LAS int*)(F.lds + RTE_OFF); LAS int* lbase = lcnt + 32;
    int* EID = (int*)(rt + RT_EID); int* POS = (int*)(rt + RT_POS); float* GATE = (float*)(rt + RT_GATE);
    const float* bc = I.moe_bc + layer * 4; const float* bfb = I.moe_bf + layer * 32;
    for (int un = blockIdx.x; un < T / 512; un += F.G) {
        if (TID_ < 32) lcnt[TID_] = 0;
        __syncthreads();
        const int t = un * 512 + TID_; const float* lg = LOG + (size_t)t * 64;
        const f32x4 g4 = *(const f32x4*)lg;
        float gl[4] = {g4.x + bc[0], g4.y + bc[1], g4.z + bc[2], g4.w + bc[3]};
        int gi = 0; float gm = gl[0];
#pragma unroll
        for (int j = 1; j < 4; ++j) if (gl[j] > gm) { gm = gl[j]; gi = j; }
        float gs = 0.f;
#pragma unroll
        for (int j = 0; j < 4; ++j) gs += __expf(gl[j] - gm);
        const float gprob = 1.0f / gs;
        const f32x4 e0 = *(const f32x4*)(lg + 4 + gi * 8), e1 = *(const f32x4*)(lg + 8 + gi * 8);
        float el[8] = {e0.x, e0.y, e0.z, e0.w, e1.x, e1.y, e1.z, e1.w};
#pragma unroll
        for (int j = 0; j < 8; ++j) el[j] += bfb[gi * 8 + j];
        int i0 = 0; float m0 = el[0];
#pragma unroll
        for (int j = 1; j < 8; ++j) if (el[j] > m0) { m0 = el[j]; i0 = j; }
        int i1 = -1; float m1 = -INFINITY;
#pragma unroll
        for (int j = 0; j < 8; ++j) if (j != i0 && el[j] > m1) { m1 = el[j]; i1 = j; }
        const float r1 = __expf(m1 - m0); const float g0 = gprob / (1.0f + r1), g1 = gprob * r1 / (1.0f + r1);
        const int ex0 = gi * 8 + i0, ex1 = gi * 8 + i1;
        const int p0 = atomicAdd((int*)&lcnt[ex0], 1), p1 = atomicAdd((int*)&lcnt[ex1], 1);
        __syncthreads();
        if (TID_ < 32) lbase[TID_] = (int)__hip_atomic_fetch_add(cnt + TID_, (unsigned)lcnt[TID_], RLX_AGENT);
        __syncthreads();
        EID[2 * t] = ex0; EID[2 * t + 1] = ex1; POS[2 * t] = lbase[ex0] + p0; POS[2 * t + 1] = lbase[ex1] + p1; GATE[2 * t] = g0; GATE[2 * t + 1] = g1;
        __syncthreads();
    }
}
__device__ __forceinline__ void route_bases(Frame& F, gu32* cnt) {
    LAS int* eb = (LAS int*)(F.lds + RTE_OFF + 512);
    const int tid = TID_;
    if (tid < 64) {
        const int c = (tid < 32) ? (int)__hip_atomic_load(cnt + (tid & 31), RLX_AGENT) : 0; const int p = (c + 255) & ~255; int s = p;
#pragma unroll
        for (int o = 1; o < 32; o <<= 1) { const int t = __shfl_up(s, o); if ((tid & 63) >= o) s += t; }
        if (tid < 32) { eb[tid] = s - p; if (tid == 31) eb[32] = s; }
    }
    __syncthreads();
}
__device__ __forceinline__ void route_pass_b(Frame& F, unsigned char* rt, gu32* cnt) {
    route_bases(F, cnt);
    LAS int* eb = (LAS int*)(F.lds + RTE_OFF + 512);
    const int* EID = (const int*)(rt + RT_EID); const int* POS = (const int*)(rt + RT_POS); const float* GATE = (const float*)(rt + RT_GATE);
    int* ROWTOK = (int*)(rt + RT_ROWTOK); float* ROWGATE = (float*)(rt + RT_ROWGATE); int* SLOT = (int*)(rt + RT_SLOT);
    const int gt = F.vcu * 512 + TID_, NGT = F.G * 512;
    for (int i = gt; i < 2 * T; i += NGT) { const int dst = eb[EID[i]] + POS[i]; ROWTOK[dst] = i >> 1; ROWGATE[dst] = GATE[i]; SLOT[i] = dst; }
    for (int i = gt; i < 32 * 256; i += NGT) { const int e = i >> 8, j = i & 255; const int c = (int)__hip_atomic_load(cnt + e, RLX_AGENT); const int pad = ((c + 255) & ~255) - c;
        if (j < pad) { ROWTOK[eb[e] + c + j] = 0; ROWGATE[eb[e] + c + j] = 0.f; } }
    __syncthreads();
}
struct MoeOrder {
    int G, c, ntiles; const LAS int* eb; const char* A; const char* W; size_t astep, wexp, wtile; bool gather;
    __device__ bool next(int i, pg8::Unit& u) const {
        const int L = i * G + c; if (L >= ntiles * 4) return false;
        u.pm = L >> 2; u.pn = L & 3; const int s0 = u.pm * 256; int e = 0;
#pragma unroll 1
        for (int j = 1; j < 32; ++j) if (eb[j] <= s0) e = j;
        e = __builtin_amdgcn_readfirstlane(e); u.aux = e; u.A = gather ? A : A + (size_t)u.pm * astep; u.B = W + (size_t)e * wexp + (size_t)u.pn * wtile; return true;
    }
};

constexpr int RTC = 32, RNCH = SEQ / RTC, RTOK = 352;
#define LBAR() do { asm volatile("s_waitcnt lgkmcnt(0)" ::: "memory"); __builtin_amdgcn_s_barrier(); asm volatile("" ::: "memory"); } while (0)
template <int CTRL> __device__ __forceinline__ float dpp_f(float v) { return __builtin_bit_cast(float, __builtin_amdgcn_update_dpp(0, __builtin_bit_cast(int, v), CTRL, 0xf, 0xf, true)); }
__device__ __forceinline__ float red16(float v) { v += dpp_f<0xB1>(v); v += dpp_f<0x4E>(v); v += dpp_f<0x141>(v); v += dpp_f<0x140>(v); return v; }
__device__ __forceinline__ float red8(float v) { v += dpp_f<0xB1>(v); v += dpp_f<0x4E>(v); v += dpp_f<0x141>(v); return v; }
__device__ __forceinline__ void unpack8(const v4u w, float (&f)[8]) { f[0] = bflo(w.x); f[1] = bfhi(w.x); f[2] = bflo(w.y); f[3] = bfhi(w.y); f[4] = bflo(w.z); f[5] = bfhi(w.z); f[6] = bflo(w.w); f[7] = bfhi(w.w); }
__device__ __forceinline__ void rwkv_scan_phase(Frame& F, const In& I, const bf16* R, const bf16* Kt, const bf16* V, const bf16* AA, const bf16* EW, bf16* Y) {
    LAS float* buf = (LAS float*)F.lds;
    LAS float* ybuf = (LAS float*)(F.lds + 2 * RTC * RTOK * 4) + 32;
    const int tid = TID_, lane = tid & 63;
    const int seg = lane & 15, rl = F.wave * 4 + (lane >> 4);
    const int stk = tid >> 4, ssg = tid & 15;
    for (int un = blockIdx.x; un < NB * 16 * 2; un += F.G) {
        const int half = un & 1, h = (un >> 1) & 15, b = un >> 5;
        const size_t rowb = (size_t)b * SEQ;
        const int col = h * 64 + ssg * 4;
        const f32x4 kkw = *(const f32x4*)(I.rwkv_kk + col), kaw = *(const f32x4*)(I.rwkv_ka + col);
        v2u rr, kr, vr, ar, er;
#define RAW_LOAD(cc) do { const size_t off = (rowb + (size_t)(cc) * RTC + stk) * 1024 + col; rr = *(const v2u*)(R + off); kr = *(const v2u*)(Kt + off); vr = *(const v2u*)(V + off); ar = *(const v2u*)(AA + off); er = *(const v2u*)(EW + off); } while (0)
#define RAW_CONVERT(cc) do { LAS float* tp = buf + ((cc) & 1) * (RTC * RTOK) + stk * RTOK + ssg * 4; \
            const float r0 = bflo(rr.x), r1 = bfhi(rr.x), r2 = bflo(rr.y), r3 = bfhi(rr.y), k0 = bflo(kr.x), k1 = bfhi(kr.x), k2 = bflo(kr.y), k3 = bfhi(kr.y); \
            const float a0 = bflo(ar.x), a1 = bfhi(ar.x), a2 = bflo(ar.y), a3 = bfhi(ar.y); \
            const float x0 = k0 * kkw.x, x1 = k1 * kkw.y, x2 = k2 * kkw.z, x3 = k3 * kkw.w; \
            const float ss = red16((x0 * x0 + x1 * x1) + (x2 * x2 + x3 * x3)); const float inv = __builtin_amdgcn_rsqf(fmaxf(ss, 1e-24f)); \
            *(LAS f32x4*)(tp) = (f32x4){__expf(-bflo(er.x)), __expf(-bfhi(er.x)), __expf(-bflo(er.y)), __expf(-bfhi(er.y))}; \
            const f32x4 kkv = (f32x4){x0 * inv, x1 * inv, x2 * inv, x3 * inv}; *(LAS f32x4*)(tp + 64) = kkv; \
            *(LAS f32x4*)(tp + 128) = (f32x4){kkv.x * a0, kkv.y * a1, kkv.z * a2, kkv.w * a3}; \
            *(LAS f32x4*)(tp + 192) = (f32x4){k0 * (1.0f + (a0 - 1.0f) * kaw.x), k1 * (1.0f + (a1 - 1.0f) * kaw.y), k2 * (1.0f + (a2 - 1.0f) * kaw.z), k3 * (1.0f + (a3 - 1.0f) * kaw.w)}; \
            *(LAS f32x4*)(tp + 256) = (f32x4){r0, r1, r2, r3}; \
            if ((ssg >> 3) == half) *(LAS f32x4*)(buf + ((cc) & 1) * (RTC * RTOK) + stk * RTOK + 320 + (ssg & 7) * 4) = (f32x4){bflo(vr.x), bfhi(vr.x), bflo(vr.y), bfhi(vr.y)}; } while (0)
#define Y_WRITE(cc) do { const LAS f32x2* yp = (const LAS f32x2*)(ybuf + ((cc) & 1) * (RTC * 32 + 32) + stk * 32 + ssg * 2); const f32x2 yv = *yp; \
            *(unsigned*)(Y + (rowb + (size_t)(cc) * RTC + stk) * 1024 + h * 64 + half * 32 + ssg * 2) = pk2(yv.x, yv.y); } while (0)
        RAW_LOAD(0); RAW_CONVERT(0); RAW_LOAD(1);
        f32x2 S0 = (f32x2){0.f, 0.f}, S1 = (f32x2){0.f, 0.f};
        LBAR();
        for (int c = 0; c < RNCH; ++c) {
            if (c + 1 < RNCH) { RAW_CONVERT(c + 1); }
            if (c + 2 < RNCH) { RAW_LOAD(c + 2); }
            if (c >= 1) { Y_WRITE(c - 1); }
            const LAS float* cb = buf + (c & 1) * (RTC * RTOK); LAS float* yb = ybuf + (c & 1) * (RTC * 32 + 32);
            const LAS float* tp0 = cb + seg * 4; const LAS float* vp0 = cb + 320 + rl;
#define SV_DECL(X) f32x4 X##w, X##q, X##b, X##k, X##r; float X##v
#define SV_LOAD(X, tk) do { const LAS float* tp = tp0 + (tk) * RTOK; \
                X##w = *(const LAS f32x4*)(tp); X##q = *(const LAS f32x4*)(tp + 64); X##b = *(const LAS f32x4*)(tp + 128); X##k = *(const LAS f32x4*)(tp + 192); X##r = *(const LAS f32x4*)(tp + 256); X##v = vp0[(tk) * RTOK]; } while (0)
#define SV_STEP(X, tk) do { \
                const f32x2 d = S0 * (f32x2){X##q.x, X##q.y} + S1 * (f32x2){X##q.z, X##q.w}; \
                const f32x2 t0 = S0 * (f32x2){X##w.x, X##w.y} + (f32x2){X##k.x, X##k.y} * X##v, t1 = S1 * (f32x2){X##w.z, X##w.w} + (f32x2){X##k.z, X##k.w} * X##v; \
                float ra = d.x + d.y, rb = epend;                   \
                ra += dpp_f<0xB1>(ra); rb += dpp_f<0xB1>(rb); ra += dpp_f<0x4E>(ra); rb += dpp_f<0x4E>(rb); ra += dpp_f<0x141>(ra); rb += dpp_f<0x141>(rb); ra += dpp_f<0x140>(ra); rb += dpp_f<0x140>(rb); \
                if (seg == 0) yb[((tk) - 1) * 32 + rl] = rb;        \
                const float sa = -ra; \
                S0 = t0 + (f32x2){X##b.x, X##b.y} * sa; S1 = t1 + (f32x2){X##b.z, X##b.w} * sa; \
                const f32x2 e = S0 * (f32x2){X##r.x, X##r.y} + S1 * (f32x2){X##r.z, X##r.w}; epend = e.x + e.y; } while (0)
            SV_DECL(A_); SV_DECL(B_); float epend = 0.f;
            SV_LOAD(A_, 0);
#pragma unroll 1
            for (int tk = 0; tk < RTC; tk += 2) {
                SV_LOAD(B_, tk + 1);
                SV_STEP(A_, tk);
                { const int t2 = (tk + 2 < RTC) ? tk + 2 : RTC - 1; SV_LOAD(A_, t2); }
                SV_STEP(B_, tk + 1);
            }
#undef SV_DECL
#undef SV_LOAD
#undef SV_STEP
            { const float rb = red16(epend); if (seg == 0) yb[(RTC - 1) * 32 + rl] = rb; }
            LBAR();
        }
        Y_WRITE(RNCH - 1);
        LBAR();
#undef RAW_LOAD
#undef RAW_CONVERT
#undef Y_WRITE
    }
}
constexpr int CS_SLOT = 13056, CS_TL = 12544, CS_QT = 0, CS_RT = 2048, CS_BHT = 4096, CS_KHT = 6144, CS_VT = 8192, CS_TM = 10240, CS_MK = 10752, CS_NK = 11264, CS_NB = 11776, CS_DD = 12288;
constexpr int CS_TMP0 = 8 * CS_SLOT, CS_TMP = 5120, CS_KT = 0, CS_BT = 2048, CS_MB = 4096;
template <int N> __device__ __forceinline__ float dpp_shr(float v) { return __builtin_bit_cast(float, __builtin_amdgcn_update_dpp(0, __builtin_bit_cast(int, v), 0x110 + N, 0xf, 0xf, true)); }
__device__ __forceinline__ bf16x8 mk8(v2u a, v2u b) { return __builtin_bit_cast(bf16x8, (v4u){a.x, a.y, b.x, b.y}); }
__device__ __forceinline__ bf16x8 mk8z(v2u a) { return __builtin_bit_cast(bf16x8, (v4u){a.x, a.y, 0u, 0u}); }
__device__ __forceinline__ bf16x8 cvt8z(f32x4 v) { return __builtin_bit_cast(bf16x8, (v4u){pk2(v.x, v.y), pk2(v.z, v.w), 0u, 0u}); }
__device__ __forceinline__ void rwkv_scan_chunked(Frame& F, const In& I, const bf16* R, const bf16* Kt, const bf16* V, const bf16* AA, const bf16* EW, bf16* Y) {
    const int lane = LANE_, fr = lane & 15, fq = lane >> 4;
    LAS unsigned char* L = F.lds;
    const f32x4 zero4 = (f32x4){0.f, 0.f, 0.f, 0.f};
    for (int un = blockIdx.x; un < NB * 16; un += F.G) {
        const int h = un & 15, b = un >> 4; const size_t rowb = (size_t)b * SEQ;
        if (F.wave >= 4) {
            const int p = F.wave - 4; const int colb = h * 64 + 16 * fq;
            LAS unsigned char* tmp = L + CS_TMP0 + p * CS_TMP;
            float kkw[16], kaw[16];
#pragma unroll
            for (int e = 0; e < 16; ++e) { kkw[e] = I.rwkv_kk[colb + e]; kaw[e] = I.rwkv_ka[colb + e]; }
            v4u raw[10];
#define CK_LOAD(cidx) do { const size_t off = (rowb + (size_t)(cidx) * 16 + fr) * 1024 + colb; \
                raw[0] = *(const v4u*)(R + off); raw[1] = *(const v4u*)(R + off + 8); raw[2] = *(const v4u*)(Kt + off); raw[3] = *(const v4u*)(Kt + off + 8); raw[4] = *(const v4u*)(V + off); raw[5] = *(const v4u*)(V + off + 8); \
                raw[6] = *(const v4u*)(AA + off); raw[7] = *(const v4u*)(AA + off + 8); raw[8] = *(const v4u*)(EW + off); raw[9] = *(const v4u*)(EW + off + 8); } while (0)
            CK_LOAD(p);
            for (int rd = -1; rd < 127; ++rd) {
                const int cidx = 4 * (rd + 1) + p; LAS unsigned char* S = L + (((rd + 1) & 1) * 4 + p) * CS_SLOT;
                float r[16], k[16], v[16], a[16], ew[16];
                { float t8[8];
                  unpack8(raw[0], t8);
#pragma unroll
                  for (int e = 0; e < 8; ++e) r[e] = t8[e];
                  unpack8(raw[1], t8);
#pragma unroll
                  for (int e = 0; e < 8; ++e) r[8 + e] = t8[e];
                  unpack8(raw[2], t8);
#pragma unroll
                  for (int e = 0; e < 8; ++e) k[e] = t8[e];
                  unpack8(raw[3], t8);
#pragma unroll
                  for (int e = 0; e < 8; ++e) k[8 + e] = t8[e];
                  unpack8(raw[4], t8);
#pragma unroll
                  for (int e = 0; e < 8; ++e) v[e] = t8[e];
                  unpack8(raw[5], t8);
#pragma unroll
                  for (int e = 0; e < 8; ++e) v[8 + e] = t8[e];
                  unpack8(raw[6], t8);
#pragma unroll
                  for (int e = 0; e < 8; ++e) a[e] = t8[e];
                  unpack8(raw[7], t8);
#pragma unroll
                  for (int e = 0; e < 8; ++e) a[8 + e] = t8[e];
                  unpack8(raw[8], t8);
#pragma unroll
                  for (int e = 0; e < 8; ++e) ew[e] = t8[e];
                  unpack8(raw[9], t8);
#pragma unroll
                  for (int e = 0; e < 8; ++e) ew[8 + e] = t8[e]; }
                if (cidx + 4 < 512) CK_LOAD(cidx + 4);
                float kx[16], ss = 0.f;
#pragma unroll
                for (int e = 0; e < 16; ++e) { kx[e] = k[e] * kkw[e]; ss += kx[e] * kx[e]; }
                ss += __shfl_xor(ss, 16); ss += __shfl_xor(ss, 32);
                const float inv = __builtin_amdgcn_rsqf(fmaxf(ss, 1e-24f));
                unsigned qtw[8], rtw[8], ktw[8], btw[8];
#pragma unroll
                for (int e = 0; e < 16; e += 2) { float q2[2], r2[2], k2[2], b2[2];
#pragma unroll
                    for (int z = 0; z < 2; ++z) { const int ee = e + z;
                        float li = -ew[ee]; li += dpp_shr<1>(li); li += dpp_shr<2>(li); li += dpp_shr<4>(li); li += dpp_shr<8>(li);
                        const float l15 = __shfl(li, (lane & 48) | 15);
                        const float E1 = __builtin_amdgcn_exp2f(1.4426950408889634f * li), W1 = __builtin_amdgcn_exp2f(1.4426950408889634f * ew[ee]), E15 = __builtin_amdgcn_exp2f(1.4426950408889634f * l15);
                        const float Einv = __builtin_amdgcn_rcpf(E1);
                        const float kk = kx[ee] * inv, bb = a[ee] * kk, kp = k[ee] * (1.0f + (a[ee] - 1.0f) * kaw[ee]);
                        q2[z] = kk * (E1 * W1); k2[z] = kp * Einv; b2[z] = bb * Einv; r2[z] = r[ee] * E1;
                        const float eh = E15 * Einv; const int key = 16 * fq + ee;
                        ((LAS bf16*)(S + CS_BHT))[key * 16 + fr] = (bf16)f2bf(bb * eh); ((LAS bf16*)(S + CS_KHT))[key * 16 + fr] = (bf16)f2bf(kp * eh); ((LAS bf16*)(S + CS_VT))[key * 16 + fr] = (bf16)f2bf(v[ee]);
                        if (fr == 15) ((LAS float*)(S + CS_DD))[key] = E15; }
                    qtw[e >> 1] = pk2(q2[0], q2[1]); rtw[e >> 1] = pk2(r2[0], r2[1]); ktw[e >> 1] = pk2(k2[0], k2[1]); btw[e >> 1] = pk2(b2[0], b2[1]); }
                { const int o = (fr * 64 + 16 * fq) * 2;
                  *(LAS v4u*)(S + CS_QT + o) = (v4u){qtw[0], qtw[1], qtw[2], qtw[3]}; *(LAS v4u*)(S + CS_QT + o + 16) = (v4u){qtw[4], qtw[5], qtw[6], qtw[7]};
                  *(LAS v4u*)(S + CS_RT + o) = (v4u){rtw[0], rtw[1], rtw[2], rtw[3]}; *(LAS v4u*)(S + CS_RT + o + 16) = (v4u){rtw[4], rtw[5], rtw[6], rtw[7]};
                  *(LAS v4u*)(tmp + CS_KT + o) = (v4u){ktw[0], ktw[1], ktw[2], ktw[3]}; *(LAS v4u*)(tmp + CS_KT + o + 16) = (v4u){ktw[4], ktw[5], ktw[6], ktw[7]};
                  *(LAS v4u*)(tmp + CS_BT + o) = (v4u){btw[0], btw[1], btw[2], btw[3]}; *(LAS v4u*)(tmp + CS_BT + o + 16) = (v4u){btw[4], btw[5], btw[6], btw[7]}; }
                asm volatile("s_waitcnt lgkmcnt(0)" ::: "memory");
                f32x4 mb = zero4, mk = zero4, nb = zero4, nk = zero4;
#pragma unroll
                for (int kh = 0; kh < 2; ++kh) { const int o = (fr * 64 + 32 * kh + 8 * fq) * 2;
                    const bf16x8 Qf = *(const LAS bf16x8*)(S + CS_QT + o), Rf = *(const LAS bf16x8*)(S + CS_RT + o), Kf = *(const LAS bf16x8*)(tmp + CS_KT + o), Bf = *(const LAS bf16x8*)(tmp + CS_BT + o);
                    mb = __builtin_amdgcn_mfma_f32_16x16x32_bf16(Qf, Bf, mb, 0, 0, 0); mk = __builtin_amdgcn_mfma_f32_16x16x32_bf16(Qf, Kf, mk, 0, 0, 0);
                    nb = __builtin_amdgcn_mfma_f32_16x16x32_bf16(Rf, Bf, nb, 0, 0, 0); nk = __builtin_amdgcn_mfma_f32_16x16x32_bf16(Rf, Kf, nk, 0, 0, 0); }
#pragma unroll
                for (int e = 0; e < 4; ++e) { const int tt = 4 * fq + e; const bool lo = fr < tt, le = fr <= tt;
                    ((LAS float*)(tmp + CS_MB))[tt * 16 + fr] = lo ? mb[e] : 0.f;
                    ((LAS bf16*)(S + CS_MK))[tt * 16 + fr] = (bf16)f2bf(lo ? mk[e] : 0.f); ((LAS bf16*)(S + CS_NK))[tt * 16 + fr] = (bf16)f2bf(le ? nk[e] : 0.f); ((LAS bf16*)(S + CS_NB))[tt * 16 + fr] = (bf16)f2bf(le ? nb[e] : 0.f); }
                asm volatile("s_waitcnt lgkmcnt(0)" ::: "memory");
                { float Tc[16];
#pragma unroll
                  for (int t = 0; t < 16; ++t) { const LAS f32x4* mrow = (const LAS f32x4*)(tmp + CS_MB + t * 64); float acc = (t == fr) ? 1.0f : 0.0f;
#pragma unroll
                      for (int s4 = 0; s4 < 4; ++s4) { if (4 * s4 < t) { const f32x4 m4 = mrow[s4];
#pragma unroll
                              for (int z = 0; z < 4; ++z) if (4 * s4 + z < t) acc -= m4[z] * Tc[4 * s4 + z]; } }
                      Tc[t] = acc; }
                  if (fq == 0) {
#pragma unroll
                      for (int t = 0; t < 16; ++t) { const unsigned hi = f2bf(Tc[t]); ((LAS bf16*)(S + CS_TM))[t * 16 + fr] = (bf16)hi; ((LAS bf16*)(S + CS_TL))[t * 16 + fr] = (bf16)f2bf(Tc[t] - __uint_as_float(hi << 16)); } } }
                LBAR();
            }
            LBAR();
#undef CK_LOAD
        } else {
            const int vt = F.wave;
            f32x4 Areg[4];
#pragma unroll
            for (int jt = 0; jt < 4; ++jt) Areg[jt] = zero4;
            LBAR();
            for (int rd = 0; rd < 128; ++rd) {
#pragma unroll 1
                for (int q = 0; q < 4; ++q) {
                    const LAS unsigned char* S = L + ((rd & 1) * 4 + q) * CS_SLOT; const size_t row0 = rowb + (size_t)(4 * rd + q) * 16;
                    bf16x8 Aq[2];
#pragma unroll
                    for (int kh = 0; kh < 2; ++kh) Aq[kh] = __builtin_bit_cast(bf16x8, (v4u){pk2(Areg[2 * kh].x, Areg[2 * kh].y), pk2(Areg[2 * kh].z, Areg[2 * kh].w), pk2(Areg[2 * kh + 1].x, Areg[2 * kh + 1].y), pk2(Areg[2 * kh + 1].z, Areg[2 * kh + 1].w)});
                    f32x4 X = zero4, YA = zero4;
#pragma unroll
                    for (int kh = 0; kh < 2; ++kh) { const int o = (fr * 64 + 32 * kh + 4 * fq) * 2;
                        const bf16x8 Pq = mk8(*(const LAS v2u*)(S + CS_QT + o), *(const LAS v2u*)(S + CS_QT + o + 32)), Pr = mk8(*(const LAS v2u*)(S + CS_RT + o), *(const LAS v2u*)(S + CS_RT + o + 32));
                        X = __builtin_amdgcn_mfma_f32_16x16x32_bf16(Pq, Aq[kh], X, 0, 0, 0); YA = __builtin_amdgcn_mfma_f32_16x16x32_bf16(Pr, Aq[kh], YA, 0, 0, 0); }
                    const bf16x8 Vq = mk8z(*(const LAS v2u*)(S + CS_VT + ((16 * vt + fr) * 16 + 4 * fq) * 2));
                    const int om = (fr * 16 + 4 * fq) * 2;
                    const bf16x8 Mkp = mk8z(*(const LAS v2u*)(S + CS_MK + om)), Nkp = mk8z(*(const LAS v2u*)(S + CS_NK + om)), Nbp = mk8z(*(const LAS v2u*)(S + CS_NB + om)), Tp = mk8z(*(const LAS v2u*)(S + CS_TM + om));
                    const f32x4 Z = __builtin_amdgcn_mfma_f32_16x16x32_bf16(Mkp, Vq, X, 0, 0, 0);
                    const bf16x8 Tl = mk8z(*(const LAS v2u*)(S + CS_TL + om));
                    f32x4 Zh, Zl;
#pragma unroll
                    for (int e = 0; e < 4; ++e) { Zh[e] = __uint_as_float(f2bf(Z[e]) << 16); Zl[e] = Z[e] - Zh[e]; }
                    f32x4 U = __builtin_amdgcn_mfma_f32_16x16x32_bf16(Tp, cvt8z(Zl), zero4, 0, 0, 0);
                    U = __builtin_amdgcn_mfma_f32_16x16x32_bf16(Tl, cvt8z(Zh), U, 0, 0, 0);
                    U = __builtin_amdgcn_mfma_f32_16x16x32_bf16(Tp, cvt8z(Zh), U, 0, 0, 0);
                    const bf16x8 Uq = cvt8z(U);
                    f32x4 Yv = __builtin_amdgcn_mfma_f32_16x16x32_bf16(Nkp, Vq, YA, 0, 0, 0);
                    const f32x4 Yn = __builtin_amdgcn_mfma_f32_16x16x32_bf16(Nbp, Uq, zero4, 0, 0, 0);
                    Yv = Yv - Yn;
#pragma unroll
                    for (int e = 0; e < 4; ++e) Y[(row0 + 4 * fq + e) * 1024 + h * 64 + 16 * vt + fr] = (bf16)f2bf(Yv[e]);
#pragma unroll
                    for (int jt = 0; jt < 4; ++jt) { const int ok = ((16 * jt + fr) * 16 + 4 * fq) * 2;
                        const bf16x8 Khp = mk8z(*(const LAS v2u*)(S + CS_KHT + ok)), Bhp = mk8z(*(const LAS v2u*)(S + CS_BHT + ok));
                        const f32x4 Dv = *(const LAS f32x4*)(S + CS_DD + (16 * jt + 4 * fq) * 4);
                        f32x4 acc = Dv * Areg[jt];
                        acc = __builtin_amdgcn_mfma_f32_16x16x32_bf16(Khp, Vq, acc, 0, 0, 0);
                        const f32x4 nbu = __builtin_amdgcn_mfma_f32_16x16x32_bf16(Bhp, Uq, zero4, 0, 0, 0);
                        Areg[jt] = acc - nbu; }
                }
                LBAR();
            }
        }
    }
}
__device__ __forceinline__ void rwkv_post_pass(Frame& F, const In& I, const bf16* R, const bf16* Kt, const bf16* V, const bf16* AA, const bf16* G, bf16* Y) {
    const int gw = F.vcu * NWAVES + F.wave, NGW = F.G * NWAVES; const int col = LANE_ * 16;
    for (int t0 = 2 * gw; t0 < T; t0 += 2 * NGW) {
        v4u py[2][2], pr[2][2], pk[2][2], pv[2][2], pa[2][2], pg[2][2];
#pragma unroll
        for (int rw = 0; rw < 2; ++rw) { const size_t off = (size_t)(t0 + rw) * 1024 + col;
#pragma unroll
            for (int hf = 0; hf < 2; ++hf) { py[rw][hf] = *(const v4u*)(Y + off + hf * 8); pr[rw][hf] = *(const v4u*)(R + off + hf * 8); pk[rw][hf] = *(const v4u*)(Kt + off + hf * 8);
                pv[rw][hf] = *(const v4u*)(V + off + hf * 8); pa[rw][hf] = *(const v4u*)(AA + off + hf * 8); pg[rw][hf] = *(const v4u*)(G + off + hf * 8); } }
#pragma unroll
        for (int rw = 0; rw < 2; ++rw) { const size_t off = (size_t)(t0 + rw) * 1024 + col;
            float kaw[16], rkw[16], lng[16], lnb[16];
#pragma unroll
            for (int e4 = 0; e4 < 4; ++e4) { const f32x4 c0 = *(const GAS f32x4*)(I.rwkv_ka + col + 4 * e4), c1 = *(const GAS f32x4*)(I.rwkv_rk + col + 4 * e4), c2 = *(const GAS f32x4*)(I.rwkv_ln_g + col + 4 * e4), c3 = *(const GAS f32x4*)(I.rwkv_ln_b + col + 4 * e4);
#pragma unroll
                for (int e = 0; e < 4; ++e) { kaw[4 * e4 + e] = c0[e]; rkw[4 * e4 + e] = c1[e]; lng[4 * e4 + e] = c2[e]; lnb[4 * e4 + e] = c3[e]; } }
            float y[16], r[16], k[16], v[16], a[16], g[16];
#pragma unroll
            for (int hf = 0; hf < 2; ++hf) { float t8[8];
                unpack8(py[rw][hf], t8);
#pragma unroll
                for (int e = 0; e < 8; ++e) y[hf * 8 + e] = t8[e];
                unpack8(pr[rw][hf], t8);
#pragma unroll
                for (int e = 0; e < 8; ++e) r[hf * 8 + e] = t8[e];
                unpack8(pk[rw][hf], t8);
#pragma unroll
                for (int e = 0; e < 8; ++e) k[hf * 8 + e] = t8[e];
                unpack8(pv[rw][hf], t8);
#pragma unroll
                for (int e = 0; e < 8; ++e) v[hf * 8 + e] = t8[e];
                unpack8(pa[rw][hf], t8);
#pragma unroll
                for (int e = 0; e < 8; ++e) a[hf * 8 + e] = t8[e];
                unpack8(pg[rw][hf], t8);
#pragma unroll
                for (int e = 0; e < 8; ++e) g[hf * 8 + e] = t8[e]; }
            float s = 0.f, bs = 0.f;
#pragma unroll
            for (int e = 0; e < 16; ++e) { s += y[e]; const float kp = k[e] * (1.0f + (a[e] - 1.0f) * kaw[e]); bs += r[e] * kp * rkw[e]; }
            s += __shfl_xor(s, 1); s += __shfl_xor(s, 2); bs += __shfl_xor(bs, 1); bs += __shfl_xor(bs, 2);
            const float mean = s * (1.0f / 64.0f); float q = 0.f;
#pragma unroll
            for (int e = 0; e < 16; ++e) { const float dd = y[e] - mean; q += dd * dd; }
            q += __shfl_xor(q, 1); q += __shfl_xor(q, 2);
            const float rstd = 1.0f / sqrtf(q * (1.0f / 64.0f) + 64e-5f);
            float o[16];
#pragma unroll
            for (int e = 0; e < 16; ++e) o[e] = ((y[e] - mean) * rstd * lng[e] + lnb[e] + bs * v[e]) * g[e];
            v4u w0, w1; w0.x = pk2(o[0], o[1]); w0.y = pk2(o[2], o[3]); w0.z = pk2(o[4], o[5]); w0.w = pk2(o[6], o[7]); w1.x = pk2(o[8], o[9]); w1.y = pk2(o[10], o[11]); w1.z = pk2(o[12], o[13]); w1.w = pk2(o[14], o[15]);
            *(v4u*)(Y + off) = w0; *(v4u*)(Y + off + 8) = w1; }
    }
}

#ifndef DUP_K
#define DUP_K (-1)
#endif
#ifndef DUP_K2
#define DUP_K2 (-1)
#endif
#define KARGS ((const __attribute__((address_space(4))) Args*)__builtin_amdgcn_kernarg_segment_ptr())
#define WSPTRS \
    bf16* H0 = (bf16*)(ws + WS_H0); bf16* QKV = (bf16*)(ws + WS_QKV); bf16* OB = (bf16*)(ws + WS_O); f32x2* AGG = (f32x2*)(ws + WS_LRUAGG); \
    bf16* H2 = (bf16*)(ws + WS_H2); float* LOG = (float*)(ws + WS_LOG); unsigned char* RTE = ws + WS_ROUTE; bf16* HID = (bf16*)(ws + WS_HID); bf16* YS = (bf16*)(ws + WS_YS); bf16* PP = (bf16*)(ws + WS_PP); \
    bf16* HCAT = (bf16*)(ws + WS_HCAT); bf16* RB = (bf16*)(ws + WS_R); bf16* KB = (bf16*)(ws + WS_K); bf16* VB = (bf16*)(ws + WS_V); bf16* XRB = (bf16*)(ws + WS_XR); bf16* XKB = (bf16*)(ws + WS_XK); bf16* XVB = (bf16*)(ws + WS_XV); bf16* MID = (bf16*)(ws + WS_MID); bf16* EWB = (bf16*)(ws + WS_EW); bf16* AAB = (bf16*)(ws + WS_AA); bf16* YB = (bf16*)(ws + WS_Y); \
    const size_t TD = (size_t)T * 1024; (void)H0; (void)QKV; (void)OB; (void)AGG; (void)H2; (void)LOG; (void)RTE; (void)HID; (void)YS; (void)PP; (void)HCAT; (void)RB; (void)KB; (void)VB; (void)XRB; (void)XKB; (void)XVB; (void)MID; (void)EWB; (void)AAB; (void)YB; (void)TD;

struct Args { In in; float* out; unsigned char* ws; int ph_lo, ph_hi; };
constexpr int N_PHASES = 34;
__device__ __forceinline__ int nrep(int k) { int n = (k == DUP_K) ? 2 : 1; if (DUP_K >= 0) asm volatile("" : "+s"(n)); return n; }
#define REP_SYNC if (rep_) __syncthreads();
typedef const __attribute__((address_space(4))) unsigned long long* kp64;
__device__ __forceinline__ void load_in(In& I) { kp64 s = (kp64)__builtin_amdgcn_kernarg_segment_ptr(); unsigned long long* d = (unsigned long long*)&I;
#pragma unroll
    for (int i = 0; i < 47; ++i) d[i] = s[i]; }

__device__ __forceinline__ int t5_bucket(int n) { if (n < 16) return n; const float v = logf((float)n / 16.0f) / 2.0794415416798357f * 16.0f; const int l = 16 + (int)v; return l < 31 ? l : 31; }

template <class Epi>
__device__ __forceinline__ void dense_gemm(Frame& F, const void* A, int lda, const void* B, int K, int M, int N, const Epi& E) {
    pg8::DenseOrder S; S.init(A, lda, B, K, M, N, F.G, (int)blockIdx.x);
    pg8::gemm_phase<Epi, pg8::DenseOrder, true, false>(F.lds, K, lda, S, E, nullptr, TID_);
}

__global__ void __launch_bounds__(NWAVES * 64, 2) mk_fwd(Args args) {
    extern __shared__ __attribute__((aligned(16))) unsigned char lds[];
    Frame F;
    F.lds = (LAS unsigned char*)lds;
    F.MISC = (volatile LAS unsigned*)(F.lds + MISC_OFF);
    { int w_ = __builtin_amdgcn_readfirstlane((int)threadIdx.x >> 6); asm volatile("" : "+s"(w_)); F.wave = w_; }
    F.G = gridDim.x; { const int bx = blockIdx.x; F.vcu = (F.G % 8 == 0) ? (bx % 8) * (F.G / 8) + bx / 8 : bx; }
    F.ctl = (gu32*)(KARGS->ws + WS_CTL);
    for (int u = TID_; u < (LDS_BYTES - LDSCTL_OFF) / 4; u += NWAVES * 64) ((LAS unsigned*)(F.lds + LDSCTL_OFF))[u] = 0u;
    __syncthreads();
    {
        LAS float* tb = (LAS float*)(F.lds + TB_OFF); const int h = TID_ >> 7, i = TID_ & 127;
        const float* rb = KARGS->in.rel_bias;
        tb[h * 128 + i] = (rb[t5_bucket(i) * 4 + h] - rb[31 * 4 + h]) * 1.4426950408889634f;
    }
    __syncthreads();
    const int lo = KARGS->ph_lo, hi = KARGS->ph_hi;
    const bool multi = (hi - lo) > 1;
    XcdBarrier bar; bar.bar = (unsigned*)(F.ctl + CW_BAR); bar.x = 0; bar.st = nullptr;
    if (multi) bar = xcd_barrier_post((unsigned*)(F.ctl + CW_BAR), F.MISC + 8, TID_ == 0);
#define IN(k) (lo <= (k) && (k) < hi)
#define PH_BEGIN_ unsigned char* ws = KARGS->ws; bf16* X = (bf16*)KARGS->out; float* OUT = KARGS->out; (void)OUT; In I; load_in(I); (void)X; WSPTRS
#define SEAM(k) do { if (IN(k) && IN((k) + 1)) xcd_barrier(bar, TID_ == 0); } while (0)

    if (IN(0)) { PH_BEGIN_ prep_dense_weights(F, I, ws); prep_layer_weights(F, I, ws, 0); norm_pass<false>(F, I.x, I.norm_mix, H0);
#ifdef DUP_PREP
        __syncthreads(); prep_dense_weights(F, I, ws); prep_layer_weights(F, I, ws, 0);
#endif
    } SEAM(0);
    if (IN(1)) { PH_BEGIN_ pg8::EpiBf16 E{QKV, 512, 512, (size_t)T * 512, attn_body::C2}; dense_gemm(F, H0, 1024, ws + WS_WIN, 1024, T, AB_IN, E); } SEAM(1);
    if (IN(2)) { PH_BEGIN_ lru_agg_mfma(F, I, QKV + 3 * (size_t)T * 512, AGG, (bf16*)(ws + WS_HL), (bf16*)(ws + WS_CA)); } SEAM(2);
    if (IN(3)) { PH_BEGIN_
        const attn_body::AttnTensors AT{(const attn_body::bf16*)QKV, (const attn_body::bf16*)(QKV + (size_t)T * 512), (const attn_body::bf16*)(QKV + 2 * (size_t)T * 512), (attn_body::bf16*)OB};
        if (F.G == 256) attn_body::attn_phase<8>((char*)lds, AT, F.vcu, (const LAS float*)(F.lds + TB_OFF), (int)threadIdx.x);
#ifdef DUP_ATTN
        __syncthreads(); if (F.G == 256) attn_body::attn_phase<8>((char*)lds, AT, F.vcu, (const LAS float*)(F.lds + TB_OFF), (int)threadIdx.x);
#endif
        __syncthreads();
        lru_final_pass(F, (const bf16*)(ws + WS_HL), (const bf16*)(ws + WS_CA), QKV + 4 * (size_t)T * 512, AGG, H0);
    } SEAM(3);
    if (IN(4)) { PH_BEGIN_ diff_combine_pass(F, I, OB, H0); } SEAM(4);
    if (IN(5)) { PH_BEGIN_ pg8::EpiResX<false> E{I.x, X}; dense_gemm(F, H0, 1024, ws + WS_WOUT, 1024, T, 1024, E); } SEAM(5);

#define MOE_PLE_PHASES(P, L) \
    if (IN(P + 0)) { PH_BEGIN_ norm_pass<true>(F, X, I.norm_ffn + (L) * 1024, H2); } SEAM(P + 0); \
    if (IN(P + 1)) { PH_BEGIN_ pg8::EpiRouter E{LOG}; dense_gemm(F, H2, 1024, ws + WS_ROUT + (size_t)(L) * 256 * 1024 * 2, 1024, T, 256, E); } SEAM(P + 1); \
    if (IN(P + 2)) { PH_BEGIN_ route_pass_a(F, I, (L), LOG, RTE, F.ctl + ((L) ? CW_CNT1 : CW_CNT0)); } SEAM(P + 2); \
    if (IN(P + 3)) { PH_BEGIN_ route_pass_b(F, RTE, F.ctl + ((L) ? CW_CNT1 : CW_CNT0)); } SEAM(P + 3); \
    if (IN(P + 4)) { PH_BEGIN_ route_bases(F, F.ctl + ((L) ? CW_CNT1 : CW_CNT0)); const LAS int* eb = (const LAS int*)(F.lds + RTE_OFF + 512); \
        MoeOrder S{F.G, (int)blockIdx.x, __builtin_amdgcn_readfirstlane(eb[32] >> 8), eb, (const char*)H2, (const char*)(ws + WS_MGU), 0, (size_t)1024 * 1024 * 2, (size_t)256 * 1024 * 2, true}; pg8::EpiGU E{HID}; \
        pg8::gemm_phase<pg8::EpiGU, MoeOrder, true, true>(F.lds, 1024, 1024, S, E, (const int*)(RTE + RT_ROWTOK), TID_); } SEAM(P + 4); \
    if (IN(P + 5)) { PH_BEGIN_ route_bases(F, F.ctl + ((L) ? CW_CNT1 : CW_CNT0)); const LAS int* eb = (const LAS int*)(F.lds + RTE_OFF + 512); \
        MoeOrder S{F.G, (int)blockIdx.x, __builtin_amdgcn_readfirstlane(eb[32] >> 8), eb, (const char*)HID, (const char*)(ws + WS_MDN), (size_t)256 * 512 * 2, (size_t)1024 * 512 * 2, (size_t)256 * 512 * 2, false}; pg8::EpiDown E{YS, (const float*)(RTE + RT_ROWGATE)}; \
        pg8::gemm_phase<pg8::EpiDown, MoeOrder, true, false>(F.lds, 512, 512, S, E, nullptr, TID_); } SEAM(P + 5); \
    if (IN(P + 6)) { PH_BEGIN_ combine_norm_pass(F, X, X, YS, (const int*)(RTE + RT_SLOT), I.ple_norm + (L) * 1024, H2); } SEAM(P + 6); \
    if (IN(P + 7)) { PH_BEGIN_ pg8::EpiBf16 E{PP, 1024, 0, 0, 1.f}; dense_gemm(F, ws + WS_PB, 256, ws + WS_PPROJ + (size_t)(L) * 1024 * 256 * 2, 256, T, 1024, E); } SEAM(P + 7); \
    if (IN(P + 8)) { PH_BEGIN_ pg8::EpiPle E{X, (L) ? (bf16*)(ws + WS_YS) : X, PP}; dense_gemm(F, H2, 1024, ws + WS_PGATE + (size_t)(L) * 1024 * 1024 * 2, 1024, T, 1024, E); } SEAM(P + 8);

    MOE_PLE_PHASES(6, 0)
    if (IN(15)) { PH_BEGIN_ rwkv_input_pass(F, X, I.norm_mix + 1024, I.rwkv_mu, HCAT, XRB, XKB, XVB); prep_layer_weights(F, I, ws, 1); } SEAM(15);
    if (IN(16)) { PH_BEGIN_ { pg8::EpiBf16 E{RB, 1024, 0, 0, 1.f}; dense_gemm(F, XRB, 1024, ws + WS_RCAT, 1024, T, 1024, E); }
        { pg8::EpiMid E{MID}; dense_gemm(F, HCAT, 2048, ws + WS_RL1, 2048, T, 512, E); } } SEAM(16);
    if (IN(17)) { PH_BEGIN_ pg8::EpiBf16 E{KB, 1024, 0, 0, 1.f}; dense_gemm(F, XKB, 1024, ws + WS_RCAT + (size_t)1024 * 1024 * 2, 1024, T, 1024, E); } SEAM(17);
    if (IN(18)) { PH_BEGIN_ pg8::EpiBf16 E{VB, 1024, 0, 0, 1.f}; dense_gemm(F, XVB, 1024, ws + WS_RCAT + (size_t)2 * 1024 * 1024 * 2, 1024, T, 1024, E); } SEAM(18);
    if (IN(19)) { PH_BEGIN_ pg8::EpiRwkv2 E{EWB, AAB, I.rwkv_w0, I.rwkv_a0, 0}; dense_gemm(F, MID, 512, ws + WS_RS2, 256, T, 2048, E); } SEAM(19);
    if (IN(20)) { PH_BEGIN_ rwkv_scan_chunked(F, I, RB, KB, VB, AAB, EWB, YB); } SEAM(20);
    if (IN(21)) { PH_BEGIN_ pg8::EpiRwkv2 E{EWB, EWB, nullptr, nullptr, 2}; dense_gemm(F, MID + 256, 512, ws + WS_RS2 + (size_t)2 * 1024 * 256 * 2, 256, T, 1024, E); } SEAM(21);
    if (IN(22)) { PH_BEGIN_ rwkv_post_pass(F, I, RB, KB, VB, AAB, EWB, YB); } SEAM(22);
    if (IN(23)) { PH_BEGIN_ pg8::EpiResX<true> E{X, X}; dense_gemm(F, YB, 1024, ws + WS_RWO, 1024, T, 1024, E); } SEAM(23);
    MOE_PLE_PHASES(24, 1)
    if (IN(33)) { PH_BEGIN_ final_norm_pass(F, (const bf16*)(ws + WS_YS), OUT, I.final_norm); }
#undef IN
#undef SEAM
}

extern "C" void kernel_launch(void* const* d_in, const int* in_sizes, int n_in, void* d_out, int out_size, void* d_ws, size_t ws_size, hipStream_t stream) {
    static int ok = 0;
    if (ok == 0) {
        if (n_in != 47 || out_size != T * D || ws_size < WS_END) { fprintf(stderr, "kernel_launch: unexpected problem shape (n_in %d out %d ws %zu)\n", n_in, out_size, ws_size); ok = -1; return; }
        if (hipFuncSetAttribute((const void*)mk_fwd, hipFuncAttributeMaxDynamicSharedMemorySize, LDS_BYTES) != hipSuccess) { fprintf(stderr, "kernel_launch: hipFuncSetAttribute failed\n"); ok = -1; return; }
        int per_cu = 0;
        if (hipOccupancyMaxActiveBlocksPerMultiprocessor(&per_cu, (const void*)mk_fwd, NWAVES * 64, LDS_BYTES) != hipSuccess || per_cu < 1) fprintf(stderr, "kernel_launch: occupancy query reports %d\n", per_cu);
        (void)hipGetLastError();
        ok = 1;
    }
    if (ok < 0) return;
    (void)hipMemsetAsync((char*)d_ws + WS_CTL, 0, CTL_ZERO_BYTES, stream);
    Args a{};
    const float** ip = (const float**)&a.in;
    for (int i = 0; i < 47; ++i) ip[i] = (const float*)d_in[i];
    a.out = (float*)d_out; a.ws = (unsigned char*)d_ws;
    const int grid = 256;
#if MK_ONE_LAUNCH
    a.ph_lo = 0; a.ph_hi = N_PHASES;
    hipLaunchKernelGGL(mk_fwd, dim3(grid), dim3(NWAVES * 64), LDS_BYTES, stream, a);
#else
    for (int k = 0; k < N_PHASES; ++k) { a.ph_lo = k; a.ph_hi = k + 1; hipLaunchKernelGGL(mk_fwd, dim3(grid), dim3(NWAVES * 64), LDS_BYTES, stream, a);
        if (k == DUP_K || k == DUP_K2) hipLaunchKernelGGL(mk_fwd, dim3(grid), dim3(NWAVES * 64), LDS_BYTES, stream, a); }
#endif
}
```

```cpp
#include <hip/hip_runtime.h>
#include <hip/hip_bf16.h>
#include <cstdio>
#include <cstdint>
#include <cmath>

#ifndef MK_ONE_LAUNCH
#define MK_ONE_LAUNCH 1
#endif

#define GAS __attribute__((address_space(1)))
#define LAS __attribute__((address_space(3)))
typedef unsigned short bf16;
typedef unsigned v4u __attribute__((ext_vector_type(4)));
typedef unsigned v2u __attribute__((ext_vector_type(2)));
typedef float f32x4 __attribute__((ext_vector_type(4)));
typedef float f32x2 __attribute__((ext_vector_type(2)));
typedef short bf16x8 __attribute__((ext_vector_type(8)));
typedef GAS unsigned gu32;
#define RLX_AGENT __ATOMIC_RELAXED, __HIP_MEMORY_SCOPE_AGENT
#define LDS_WAIT() asm volatile("s_waitcnt lgkmcnt(0)" ::: "memory")
#define VM_WAIT() asm volatile("s_waitcnt vmcnt(0)" ::: "memory")
__device__ __forceinline__ unsigned f2bf(float f) { unsigned u = __builtin_bit_cast(unsigned, f); return (u + 0x7fffu + ((u >> 16) & 1u)) >> 16; }
typedef float f32x2_cv __attribute__((ext_vector_type(2))); typedef __bf16 bf16x2_cv __attribute__((ext_vector_type(2)));
__device__ __forceinline__ unsigned pk2(float lo, float hi) { const f32x2_cv v = {lo, hi}; const bf16x2_cv b = __builtin_convertvector(v, bf16x2_cv); return __builtin_bit_cast(unsigned, b); }
__device__ __forceinline__ float bflo(unsigned w) { return __uint_as_float(w << 16); }
__device__ __forceinline__ float bfhi(unsigned w) { return __uint_as_float(w & 0xffff0000u); }
__device__ __forceinline__ float bf1(bf16 h) { return __uint_as_float((unsigned)h << 16); }
__device__ __forceinline__ float sigmoidf_(float x) { return __builtin_amdgcn_rcpf(1.0f + __builtin_amdgcn_exp2f(-1.4426950408889634f * x)); }
__device__ __forceinline__ float tanhf_(float x) { return 1.0f - 2.0f * __builtin_amdgcn_rcpf(1.0f + __builtin_amdgcn_exp2f(2.885390081777927f * x)); }
__device__ __forceinline__ void fmac_(float& acc, float a, float b) { asm("v_fmac_f32 %0, %1, %2" : "+v"(acc) : "v"(a), "v"(b)); }
__device__ __forceinline__ float fma_(float a, float b, float c) { float r; asm("v_fma_f32 %0, %1, %2, %3" : "=v"(r) : "v"(a), "v"(b), "v"(c)); return r; }
__device__ __forceinline__ float mul_(float a, float b) { float r; asm("v_mul_f32 %0, %1, %2" : "=v"(r) : "v"(a), "v"(b)); return r; }
__device__ __forceinline__ float wave_sum(float v) {
#pragma unroll
    for (int o = 1; o < 64; o <<= 1) v += __shfl_xor(v, o);
    return v;
}

constexpr int NB = 8, SEQ = 8192, D = 1024, T = NB * SEQ;
constexpr int AB_IN = 2560, PLE = 256;
constexpr int NEXP = 32, EH = 512;
constexpr int MAXSLOT = 2 * T + NEXP * 256;
constexpr int MAXTILES = MAXSLOT / 256;

namespace pg8 {
#define PG8_LAS __attribute__((address_space(3)))
typedef unsigned short bf16_t;
typedef unsigned u32x4 __attribute__((ext_vector_type(4)));
typedef unsigned u32x2 __attribute__((ext_vector_type(2)));
constexpr int BM = 256, BK = 64, HALF = 128, HTB = HALF * BK * 2, STAGE_BYTES = 8 * HTB, NXCD = 8, WGM = 8;
__host__ __device__ __forceinline__ int lds_byte(int r, int c) { const int st = (r >> 4) * 2 + (c >> 5), rr = r & 15, cc = c & 31, ob = rr * 64 + cc * 2; return st * 1024 + (ob ^ (((ob >> 9) & 1) << 5)); }
__host__ __device__ __forceinline__ void stage_rc(int b, int& R, int& C) { const int st = b / 1024, sb = b % 1024, swz = sb ^ (((sb >> 9) & 1) << 5); R = (st >> 1) * 16 + swz / 64; C = (st & 1) * 32 + (swz % 64) / 2; }
__host__ __device__ __forceinline__ int perm32(int rho) { const int n = rho >> 4, i = rho & 15; return 8 * (i >> 2) + 4 * n + (i & 3); }

struct Unit { int pm, pn, aux; const char* A; const char* B; };

struct DenseOrder {
    int nM, nN, nwg, G, c; const char* A; const char* B; size_t astep, bstep;
    __device__ void init(const void* A_, int lda, const void* B_, int K, int M, int N, int G_, int c_) { nM = M / BM; nN = N / BM; nwg = nM * nN; G = G_; c = c_; A = (const char*)A_; B = (const char*)B_; astep = (size_t)BM * lda * 2; bstep = (size_t)BM * K * 2; }
    __device__ bool next(int i, Unit& u) const {
        const long L = (long)i * G + c; if (L >= nwg) return false;
        int wgid = (int)L; { const int q = nwg / NXCD, r = nwg % NXCD, xcd = wgid % NXCD, off = wgid / NXCD; wgid = (xcd < r ? xcd * (q + 1) : r * (q + 1) + (xcd - r) * q) + off; }
        const int nig = WGM * nN, gid = wgid / nig, fm = gid * WGM, gsz = (nM - fm) < WGM ? (nM - fm) : WGM;
        u.pm = fm + ((wgid % nig) % gsz); u.pn = (wgid % nig) / gsz; u.aux = 0; u.A = A + (size_t)u.pm * astep; u.B = B + (size_t)u.pn * bstep; return true;
    }
};

__device__ __forceinline__ unsigned cvt_pk_bf16(float lo, float hi) { unsigned r; asm volatile("v_cvt_pk_bf16_f32 %0, %1, %2" : "=v"(r) : "v"(lo), "v"(hi)); return r; }

typedef f32x4 Acc[2][2][4][2];

struct EpiBf16 {
    static constexpr bool PERM = true;
    bf16_t* O; int ldc; int split_cols; size_t split_stride; float scale0;
    __device__ __forceinline__ void operator()(const Acc& acc, const Unit& u, int wr, int wc, int fr, int fq) const {
        const int row0 = u.pm * BM + wr * 64 + fr; int colt = u.pn * BM; bf16_t* base = O;
        float sc = 1.f; if (split_cols) { const int t = colt / split_cols; base += (size_t)t * split_stride; colt -= t * split_cols; if (t == 0) sc = scale0; }
        const int col0 = colt + wc * 32 + 8 * fq;
#pragma unroll
        for (int ai = 0; ai < 2; ++ai)
#pragma unroll
            for (int m = 0; m < 4; ++m) { bf16_t* rowp = base + (size_t)(row0 + ai * HALF + m * 16) * ldc + col0;
#pragma unroll
                for (int bj = 0; bj < 2; ++bj) { f32x4 v0 = acc[ai][bj][m][0] * sc, v1 = acc[ai][bj][m][1] * sc;
                    u32x4 w; w.x = cvt_pk_bf16(v0[0], v0[1]); w.y = cvt_pk_bf16(v0[2], v0[3]); w.z = cvt_pk_bf16(v1[0], v1[1]); w.w = cvt_pk_bf16(v1[2], v1[3]);
                    *(u32x4*)(rowp + bj * HALF) = w; } }
    }
};
__device__ __forceinline__ void unpack8f(const u32x4 w, f32x4& lo, f32x4& hi) { lo = (f32x4){bflo(w.x), bfhi(w.x), bflo(w.y), bfhi(w.y)}; hi = (f32x4){bflo(w.z), bfhi(w.z), bflo(w.w), bfhi(w.w)}; }
template <bool BASE_BF16>
struct EpiResX {
    static constexpr bool PERM = true;
    const void* base; bf16_t* out;
    __device__ __forceinline__ void operator()(const Acc& acc, const Unit& u, int wr, int wc, int fr, int fq) const {
        const int col0 = u.pn * BM + wc * 32 + 8 * fq; GAS bf16_t* op = (GAS bf16_t*)out;
#pragma unroll
        for (int ai = 0; ai < 2; ++ai) {
            f32x4 b0[4][2], b1[4][2];
#pragma unroll
            for (int m = 0; m < 4; ++m) { const size_t off = (size_t)(u.pm * BM + ai * HALF + wr * 64 + m * 16 + fr) * 1024 + col0;
#pragma unroll
                for (int bj = 0; bj < 2; ++bj) {
                    if (BASE_BF16) { const u32x4 w = *(const GAS u32x4*)((const GAS bf16_t*)base + off + bj * HALF); unpack8f(w, b0[m][bj], b1[m][bj]); }
                    else { b0[m][bj] = *(const GAS f32x4*)((const GAS float*)base + off + bj * HALF); b1[m][bj] = *(const GAS f32x4*)((const GAS float*)base + off + bj * HALF + 4); } } }
            asm volatile("" ::: "memory");
#pragma unroll
            for (int m = 0; m < 4; ++m) { const size_t off = (size_t)(u.pm * BM + ai * HALF + wr * 64 + m * 16 + fr) * 1024 + col0;
#pragma unroll
                for (int bj = 0; bj < 2; ++bj) { const f32x4 v0 = b0[m][bj] + acc[ai][bj][m][0], v1 = b1[m][bj] + acc[ai][bj][m][1];
                    u32x4 w; w.x = cvt_pk_bf16(v0[0], v0[1]); w.y = cvt_pk_bf16(v0[2], v0[3]); w.z = cvt_pk_bf16(v1[0], v1[1]); w.w = cvt_pk_bf16(v1[2], v1[3]);
                    *(GAS u32x4*)(op + off + bj * HALF) = w; } }
            asm volatile("" ::: "memory");
        }
    }
};
struct EpiRouter {
    static constexpr bool PERM = false;
    float* out;
    __device__ __forceinline__ void operator()(const Acc& acc, const Unit& u, int wr, int wc, int fr, int fq) const {
        if (wc >= 2) return;
#pragma unroll
        for (int ai = 0; ai < 2; ++ai)
#pragma unroll
            for (int m = 0; m < 4; ++m) { const size_t off = (size_t)(u.pm * BM + ai * HALF + wr * 64 + m * 16 + fr) * 64 + wc * 32 + 4 * fq;
#pragma unroll
                for (int n = 0; n < 2; ++n) *(f32x4*)(out + off + n * 16) = acc[ai][0][m][n]; }
    }
};
struct EpiGU {
    static constexpr bool PERM = true;
    bf16_t* H;
    __device__ __forceinline__ void operator()(const Acc& acc, const Unit& u, int wr, int wc, int fr, int fq) const {
        const int col0 = u.pn * 128 + wc * 32 + 8 * fq;
#pragma unroll
        for (int ai = 0; ai < 2; ++ai)
#pragma unroll
            for (int m = 0; m < 4; ++m) { bf16_t* rowp = H + (size_t)(u.pm * BM + ai * HALF + wr * 64 + m * 16 + fr) * EH + col0;
                f32x4 g0 = acc[ai][0][m][0], g1 = acc[ai][0][m][1]; const f32x4 u0 = acc[ai][1][m][0], u1 = acc[ai][1][m][1];
#pragma unroll
                for (int e = 0; e < 4; ++e) { g0[e] = g0[e] * sigmoidf_(g0[e]) * u0[e]; g1[e] = g1[e] * sigmoidf_(g1[e]) * u1[e]; }
                u32x4 w; w.x = cvt_pk_bf16(g0[0], g0[1]); w.y = cvt_pk_bf16(g0[2], g0[3]); w.z = cvt_pk_bf16(g1[0], g1[1]); w.w = cvt_pk_bf16(g1[2], g1[3]);
                *(u32x4*)rowp = w; }
    }
};
struct EpiDown {
    static constexpr bool PERM = true;
    bf16_t* Y; const float* gate;
    __device__ __forceinline__ void operator()(const Acc& acc, const Unit& u, int wr, int wc, int fr, int fq) const {
        const int col0 = u.pn * BM + wc * 32 + 8 * fq;
#pragma unroll
        for (int ai = 0; ai < 2; ++ai)
#pragma unroll
            for (int m = 0; m < 4; ++m) { const int row = u.pm * BM + ai * HALF + wr * 64 + m * 16 + fr; const float sc = gate[row]; bf16_t* rowp = Y + (size_t)row * 1024 + col0;
#pragma unroll
                for (int bj = 0; bj < 2; ++bj) { const f32x4 v0 = acc[ai][bj][m][0] * sc, v1 = acc[ai][bj][m][1] * sc;
                    u32x4 w; w.x = cvt_pk_bf16(v0[0], v0[1]); w.y = cvt_pk_bf16(v0[2], v0[3]); w.z = cvt_pk_bf16(v1[0], v1[1]); w.w = cvt_pk_bf16(v1[2], v1[3]);
                    *(u32x4*)(rowp + bj * HALF) = w; } }
    }
};
struct EpiPle {
    static constexpr bool PERM = true;
    const bf16_t* xin; bf16_t* xout; const bf16_t* pp;
    __device__ __forceinline__ void operator()(const Acc& acc, const Unit& u, int wr, int wc, int fr, int fq) const {
        const int col0 = u.pn * BM + wc * 32 + 8 * fq;
        const GAS bf16_t* xp = (const GAS bf16_t*)xin; GAS bf16_t* op = (GAS bf16_t*)xout; const GAS bf16_t* pq = (const GAS bf16_t*)pp;
#pragma unroll
        for (int ai = 0; ai < 2; ++ai) {
            u32x4 xw[4][2], pw[4][2];
#pragma unroll
            for (int m = 0; m < 4; ++m) { const size_t off = (size_t)(u.pm * BM + ai * HALF + wr * 64 + m * 16 + fr) * 1024 + col0;
#pragma unroll
                for (int bj = 0; bj < 2; ++bj) { xw[m][bj] = *(const GAS u32x4*)(xp + off + bj * HALF); pw[m][bj] = *(const GAS u32x4*)(pq + off + bj * HALF); } }
            asm volatile("" ::: "memory");
#pragma unroll
            for (int m = 0; m < 4; ++m) { const size_t off = (size_t)(u.pm * BM + ai * HALF + wr * 64 + m * 16 + fr) * 1024 + col0;
#pragma unroll
                for (int bj = 0; bj < 2; ++bj) { f32x4 x0, x1, p0, p1; unpack8f(xw[m][bj], x0, x1); unpack8f(pw[m][bj], p0, p1); const f32x4 a0 = acc[ai][bj][m][0], a1 = acc[ai][bj][m][1];
#pragma unroll
                    for (int e = 0; e < 4; ++e) { x0[e] += p0[e] * sigmoidf_(a0[e]); x1[e] += p1[e] * sigmoidf_(a1[e]); }
                    u32x4 w; w.x = cvt_pk_bf16(x0[0], x0[1]); w.y = cvt_pk_bf16(x0[2], x0[3]); w.z = cvt_pk_bf16(x1[0], x1[1]); w.w = cvt_pk_bf16(x1[2], x1[3]);
                    *(GAS u32x4*)(op + off + bj * HALF) = w; } }
            asm volatile("" ::: "memory");
        }
    }
};
struct EpiMid {
    static constexpr bool PERM = true;
    bf16_t* MID;
    __device__ __forceinline__ void operator()(const Acc& acc, const Unit& u, int wr, int wc, int fr, int fq) const {
        const int row0 = u.pm * BM + wr * 64 + fr;
        const int mode = (u.pn == 1) ? 2 : 0; const int colbase = u.pn * 256;
#pragma unroll
        for (int ai = 0; ai < 2; ++ai)
#pragma unroll
            for (int m = 0; m < 4; ++m) { bf16_t* rowp = MID + (size_t)(row0 + ai * HALF + m * 16) * 512 + colbase;
#pragma unroll
                for (int bj = 0; bj < 2; ++bj) { const int lc = bj * HALF + wc * 32 + 8 * fq; f32x4 v0 = acc[ai][bj][m][0], v1 = acc[ai][bj][m][1];
#pragma unroll
                    for (int e = 0; e < 4; ++e) {
                        if (mode == 2) { v0[e] = sigmoidf_(v0[e]); v1[e] = sigmoidf_(v1[e]); }
                        else if (lc < 64) { v0[e] = tanhf_(v0[e]); v1[e] = tanhf_(v1[e]); } }
                    u32x4 w; w.x = cvt_pk_bf16(v0[0], v0[1]); w.y = cvt_pk_bf16(v0[2], v0[3]); w.z = cvt_pk_bf16(v1[0], v1[1]); w.w = cvt_pk_bf16(v1[2], v1[3]);
                    *(u32x4*)(rowp + lc) = w; } }
    }
};
struct EpiRwkv2 {
    static constexpr bool PERM = true;
    bf16_t* O0; bf16_t* O1; const float* bias0; const float* bias1; int tybase;
    __device__ __forceinline__ void operator()(const Acc& acc, const Unit& u, int wr, int wc, int fr, int fq) const {
        const int ty = tybase + (u.pn >> 2); const int row0 = u.pm * BM + wr * 64 + fr; const int colt = (u.pn & 3) * BM + wc * 32 + 8 * fq;
        bf16_t* base = (u.pn >> 2) ? O1 : O0; const float* bias = (u.pn >> 2) ? bias1 : bias0;
#pragma unroll
        for (int bj = 0; bj < 2; ++bj) {
            f32x4 b0 = (f32x4){0.f, 0.f, 0.f, 0.f}, b1 = b0;
            if (ty < 2) { b0 = *(const f32x4*)(bias + colt + bj * HALF); b1 = *(const f32x4*)(bias + colt + bj * HALF + 4); }
#pragma unroll
            for (int ai = 0; ai < 2; ++ai)
#pragma unroll
                for (int m = 0; m < 4; ++m) { bf16_t* rowp = base + (size_t)(row0 + ai * HALF + m * 16) * 1024 + colt + bj * HALF;
                    f32x4 v0 = acc[ai][bj][m][0] + b0, v1 = acc[ai][bj][m][1] + b1;
                    if (ty < 2) { const float s = (ty == 0) ? 0.6065306597126334f : 1.0f;
#pragma unroll
                        for (int e = 0; e < 4; ++e) { v0[e] = s * sigmoidf_(v0[e]); v1[e] = s * sigmoidf_(v1[e]); } }
                    u32x4 w; w.x = cvt_pk_bf16(v0[0], v0[1]); w.y = cvt_pk_bf16(v0[2], v0[3]); w.z = cvt_pk_bf16(v1[0], v1[1]); w.w = cvt_pk_bf16(v1[2], v1[3]);
                    *(u32x4*)rowp = w; }
        }
    }
};

template <class Epi, class Sched, bool ALIGN_EPI, bool GATHER>
__device__ __forceinline__ void gemm_phase(PG8_LAS unsigned char* lds, const int K, const int lda, const Sched& S, const Epi& E, const int* __restrict__ rows, const int tid) {
    const int wid = __builtin_amdgcn_readfirstlane(tid >> 6), lane = tid & 63, wr = wid >> 2, wc = wid & 3, fr = lane & 15, fq = lane >> 4;
    const int nt = K / BK;
    unsigned voffA[2], voffB[2]; int RA[2];
#pragma unroll
    for (int i = 0; i < 2; ++i) { int R, C; stage_rc(tid * 16 + i * 8192, R, C); const int Rb = Epi::PERM ? ((R & ~31) + perm32(R & 31)) : R;
        RA[i] = R; voffA[i] = GATHER ? (unsigned)(C * 2) : (unsigned)(R * lda + C) * 2u; voffB[i] = (unsigned)(Rb * K + C) * 2u; }
    const size_t kstep = (size_t)(BK * 2);
    const size_t hstepA = GATHER ? 0 : (size_t)HALF * lda * 2, hstepB = (size_t)HALF * K * 2;
    const unsigned ldsw = (unsigned)wid * 1024u;
    const int aoff = lds_byte(wr * 64 + fr, fq * 8), boff = lds_byte(wc * 32 + fr, fq * 8);
#define PG8_SA(b, h) (((b) * 2 + (h)) * HTB)
#define PG8_SB(b, h) ((4 + (b) * 2 + (h)) * HTB)
#define PG8_ST2(bufoff, gbase, o0, o1) do { \
        __builtin_amdgcn_global_load_lds((const unsigned*)((const char*)(gbase) + (o0)), (PG8_LAS unsigned*)(lds + (bufoff) + ldsw), 16, 0, 0); \
        __builtin_amdgcn_global_load_lds((const unsigned*)((const char*)(gbase) + (o1)), (PG8_LAS unsigned*)(lds + (bufoff) + ldsw + 8192), 16, 0, 0); } while (0)
#define PG8_STB(bufoff, gbase) PG8_ST2(bufoff, gbase, voffB[0], voffB[1])
#define PG8_STA(bufoff, p, h, nx) do { if constexpr (GATHER) { const unsigned g0_ = (nx) ? gN[h][0] : gC[h][0], g1_ = (nx) ? gN[h][1] : gC[h][1]; PG8_ST2(bufoff, p, g0_, g1_); } \
        else { PG8_ST2(bufoff, (p) + (h) * hstepA, voffA[0], voffA[1]); } } while (0)
#define PG8_LDA(dst, b, h) do { _Pragma("unroll") for (int m = 0; m < 4; ++m) _Pragma("unroll") for (int k = 0; k < 2; ++k) dst[m][k] = *(const PG8_LAS bf16x8*)(lds + PG8_SA(b, h) + aoff + m * 2048 + k * 1024); } while (0)
#define PG8_LDB(dst, b, h) do { _Pragma("unroll") for (int n = 0; n < 2; ++n) _Pragma("unroll") for (int k = 0; k < 2; ++k) dst[n][k] = *(const PG8_LAS bf16x8*)(lds + PG8_SB(b, h) + boff + n * 2048 + k * 1024); } while (0)
#define PG8_MMA(ai, bj, At, Bt) do { __builtin_amdgcn_s_setprio(1); _Pragma("unroll") for (int m = 0; m < 4; ++m) _Pragma("unroll") for (int n = 0; n < 2; ++n) _Pragma("unroll") for (int k = 0; k < 2; ++k) \
        acc[ai][bj][m][n] = __builtin_amdgcn_mfma_f32_16x16x32_bf16(Bt[n][k], At[m][k], acc[ai][bj][m][n], 0, 0, 0); __builtin_amdgcn_s_setprio(0); } while (0)
#define PG8_WAIT_V(n) asm volatile("s_waitcnt vmcnt(" #n ")" ::: "memory")
#define PG8_WAIT_L(n) asm volatile("s_waitcnt lgkmcnt(" #n ")" ::: "memory")
#define PG8_BAR __builtin_amdgcn_s_barrier()
#define PG8_SCHED __builtin_amdgcn_sched_barrier(0)
#define PG8_GLOAD(dst, un) do { if constexpr (GATHER) { _Pragma("unroll") for (int h_ = 0; h_ < 2; ++h_) _Pragma("unroll") for (int i_ = 0; i_ < 2; ++i_) \
        dst[h_][i_] = (unsigned)rows[(un).pm * BM + h_ * HALF + RA[i_]] * (unsigned)(lda * 2) + voffA[i_]; } } while (0)
    Unit cur, nxt; int ui = 0;
    if (!S.next(0, cur)) return;
    unsigned gC[2][2] = {{0u, 0u}, {0u, 0u}}, gN[2][2] = {{0u, 0u}, {0u, 0u}};
    PG8_GLOAD(gC, cur);
    Acc acc;
#pragma unroll
    for (int a = 0; a < 2; ++a)
#pragma unroll
        for (int b = 0; b < 2; ++b)
#pragma unroll
            for (int m = 0; m < 4; ++m)
#pragma unroll
                for (int n = 0; n < 2; ++n) acc[a][b][m][n] = (f32x4){0.f, 0.f, 0.f, 0.f};
    bf16x8 At[4][2], B0[2][2], B1[2][2];
    const char* cA = cur.A; const char* cB = cur.B;
    PG8_STB(PG8_SB(0, 0), cB); PG8_STB(PG8_SB(0, 1), cB + hstepB); PG8_STA(PG8_SA(0, 0), cA, 0, false); PG8_STA(PG8_SA(0, 1), cA, 1, false);
    if (wr == 1) PG8_BAR;
    PG8_WAIT_V(2); PG8_BAR;
    PG8_STB(PG8_SB(1, 0), cB + kstep); PG8_STA(PG8_SA(1, 0), cA + kstep, 0, false); PG8_STB(PG8_SB(1, 1), cB + hstepB + kstep);
    PG8_WAIT_V(6); PG8_BAR;
    for (;;) {
        const bool has_next = S.next(ui + 1, nxt);
        if (has_next) { PG8_GLOAD(gN, nxt); }
        const char* nA = has_next ? nxt.A : cA; const char* nB = has_next ? nxt.B : cB;
#pragma unroll 1
        for (int t = 0; t < nt; t += 2) {
            const bool last = (t == nt - 2); const bool nx = last && has_next;
            const char* a1 = cA + (size_t)(t + 1) * kstep;
            const char* a2 = last ? nA : cA + (size_t)(t + 2) * kstep; const char* b2 = last ? nB : cB + (size_t)(t + 2) * kstep;
            const char* a3 = a2 + kstep; const char* b3 = b2 + kstep;
            PG8_LDB(B0, 0, 0); PG8_LDB(B1, 0, 1); PG8_SCHED; PG8_LDA(At, 0, 0); PG8_STA(PG8_SA(1, 1), a1, 1, false);
            PG8_WAIT_V(8); PG8_WAIT_L(0); PG8_BAR; PG8_MMA(0, 0, At, B0); PG8_MMA(0, 1, At, B1); PG8_BAR; PG8_SCHED;
            PG8_LDA(At, 0, 1); PG8_STB(PG8_SB(0, 0), b2); PG8_STB(PG8_SB(0, 1), b2 + hstepB); PG8_STA(PG8_SA(0, 0), a2, 0, nx);
            PG8_WAIT_V(8); PG8_WAIT_L(0); PG8_BAR; PG8_MMA(1, 0, At, B0); PG8_MMA(1, 1, At, B1); PG8_BAR; PG8_SCHED;
            PG8_LDB(B0, 1, 0); PG8_LDB(B1, 1, 1); PG8_SCHED; PG8_LDA(At, 1, 0); PG8_STA(PG8_SA(0, 1), a2, 1, nx);
            PG8_WAIT_V(8); PG8_WAIT_L(0); PG8_BAR; PG8_MMA(0, 0, At, B0); PG8_MMA(0, 1, At, B1); PG8_BAR; PG8_SCHED;
            PG8_LDA(At, 1, 1); PG8_STB(PG8_SB(1, 0), b3); PG8_STB(PG8_SB(1, 1), b3 + hstepB); PG8_STA(PG8_SA(1, 0), a3, 0, nx);
            PG8_WAIT_V(8); PG8_WAIT_L(0); PG8_BAR; PG8_MMA(1, 0, At, B0); PG8_MMA(1, 1, At, B1); PG8_BAR; PG8_SCHED;
        }
        if constexpr (ALIGN_EPI) { if (wr == 0) PG8_BAR; }
        E(acc, cur, wr, wc, fr, fq);
        if (!has_next) break;
#pragma unroll
        for (int a = 0; a < 2; ++a)
#pragma unroll
            for (int b = 0; b < 2; ++b)
#pragma unroll
                for (int m = 0; m < 4; ++m)
#pragma unroll
                    for (int n = 0; n < 2; ++n) acc[a][b][m][n] = (f32x4){0.f, 0.f, 0.f, 0.f};
        cur = nxt; cA = nA; cB = nB; ++ui;
        if constexpr (GATHER) {
#pragma unroll
            for (int h_ = 0; h_ < 2; ++h_)
#pragma unroll
                for (int i_ = 0; i_ < 2; ++i_) gC[h_][i_] = gN[h_][i_]; }
        if constexpr (ALIGN_EPI) { if (wr == 1) PG8_BAR; }
    }
    PG8_WAIT_V(0);
    if constexpr (!ALIGN_EPI) { if (wr == 0) PG8_BAR; }
    PG8_BAR;
#undef PG8_SA
#undef PG8_SB
#undef PG8_ST2
#undef PG8_STB
#undef PG8_STA
#undef PG8_LDA
#undef PG8_LDB
#undef PG8_MMA
#undef PG8_WAIT_V
#undef PG8_WAIT_L
#undef PG8_BAR
#undef PG8_SCHED
#undef PG8_GLOAD
}
}
namespace attn_body {
using bf16=__hip_bfloat16;
using bf16x8=__attribute__((ext_vector_type(8)))short;
using s16x4=__attribute__((ext_vector_type(4)))short;
using f32x16=__attribute__((ext_vector_type(16)))float;
using u32x4=__attribute__((ext_vector_type(4)))unsigned;
constexpr int BATCH=8,NHEAD=16,SEQ=8192,D=64,PQ=512,PO=1024;
constexpr int NW=8,QBLK=32,QB=QBLK*NW,KVBLK=64,NQB=SEQ/QB;
constexpr int ATTN_UNIT_ROWS=QB;
__device__ __forceinline__ int crow(int r,int hi){return (r&3)+8*(r>>2)+4*hi;}
#define SBAR() __builtin_amdgcn_sched_barrier(0)
__device__ __forceinline__ void cmask(f32x16&p0,f32x16&p1,int jb,int qrel,int hi){
  const float NEG=-INFINITY; int kb=64*jb+4*hi;
  #pragma unroll
  for(int r=0;r<16;++r){int kv=kb+(r&3)+8*(r>>2); if(kv>qrel)p0[r]=NEG; if(kv+32>qrel)p1[r]=NEG;}
}

__device__ __forceinline__ void cbias(f32x16&p0,f32x16&p1,int jb,int qrel,int hi,const __attribute__((address_space(3))) float*tb){
  const int kb=64*jb+4*hi;
  #pragma unroll
  for(int r=0;r<16;++r){const int rel=qrel-(kb+(r&3)+8*(r>>2)); const int i0=min(max(rel,0),127), i1=min(max(rel-32,0),127); p0[r]+=tb[i0]; p1[r]+=tb[i1];}
}
constexpr int NSLOT=3, SLOTB=8192;
constexpr int LDS_K=0, LDS_V=NSLOT*SLOTB, LDS_WS=2*NSLOT*SLOTB, LDS_OST=LDS_WS+NW*64*4, LDS_BYTES=LDS_OST+NW*4096;
constexpr float C2=0.125f*1.4426950408889634f;
__device__ __forceinline__ void glds16(const void*gsrc,unsigned lds_dst){unsigned keep;
  asm volatile("s_mov_b32 %0, m0\n\ts_mov_b32 m0, %2\n\ts_nop 0\n\tglobal_load_lds_dwordx4 %1, off\n\ts_mov_b32 m0, %0":"=&s"(keep):"v"(gsrc),"s"(lds_dst):"memory");}
__device__ __forceinline__ float max3f(float a,float b,float c){float r;asm("v_max3_f32 %0, %1, %2, %3":"=v"(r):"v"(a),"v"(b),"v"(c));return r;}
__device__ __forceinline__ float max2f(float a,float b){float r;asm("v_max_f32_e32 %0, %1, %2":"=v"(r):"v"(a),"v"(b));return r;}
__device__ __forceinline__ float fadd_s(float a,float b){float r;asm("v_add_f32_e32 %0, %1, %2":"=v"(r):"v"(a),"v"(b));return r;}
__device__ __forceinline__ float fsub_s(float a,float b){float r;asm("v_sub_f32_e32 %0, %1, %2":"=v"(r):"v"(a),"v"(b));return r;}
typedef float f32x2_t __attribute__((ext_vector_type(2))); typedef __bf16 bf16x2_t __attribute__((ext_vector_type(2)));
__device__ __forceinline__ unsigned cvtpk_s(float lo,float hi){f32x2_t v={lo,hi};bf16x2_t b=__builtin_convertvector(v,bf16x2_t);return __builtin_bit_cast(unsigned,b);}
#define WAIT_BAR(N) asm volatile("s_waitcnt vmcnt(" #N ") lgkmcnt(0)\n\ts_barrier":::"memory")

__device__ __forceinline__ void qkt(f32x16&p0,f32x16&p1,const char*Kslot,const bf16x8*qr,const f32x16&negm,int r32,int hi){
  const char*kb=Kslot+hi*1024+r32*16;
  #pragma unroll
  for(int d0=0;d0<4;++d0){
    const bf16x8 b0=*reinterpret_cast<const bf16x8*>(kb+d0*2048);
    const bf16x8 b1=*reinterpret_cast<const bf16x8*>(kb+d0*2048+512);
    if(d0==0){p0=__builtin_amdgcn_mfma_f32_32x32x16_bf16(b0,qr[0],negm,0,0,0);p1=__builtin_amdgcn_mfma_f32_32x32x16_bf16(b1,qr[0],negm,0,0,0);}
    else{p0=__builtin_amdgcn_mfma_f32_32x32x16_bf16(b0,qr[d0],p0,0,0,0);p1=__builtin_amdgcn_mfma_f32_32x32x16_bf16(b1,qr[d0],p1,0,0,0);}}
}
typedef __attribute__((address_space(3))) const char* lds_cptr;
typedef short v4i16_t __attribute__((ext_vector_type(4)));
__device__ __forceinline__ void kload8(bf16x8*kf,lds_cptr kp){
  kf[0]=*(const __attribute__((address_space(3))) bf16x8*)(kp);      kf[1]=*(const __attribute__((address_space(3))) bf16x8*)(kp+512);
  kf[2]=*(const __attribute__((address_space(3))) bf16x8*)(kp+2048); kf[3]=*(const __attribute__((address_space(3))) bf16x8*)(kp+2560);
  kf[4]=*(const __attribute__((address_space(3))) bf16x8*)(kp+4096); kf[5]=*(const __attribute__((address_space(3))) bf16x8*)(kp+4608);
  kf[6]=*(const __attribute__((address_space(3))) bf16x8*)(kp+6144); kf[7]=*(const __attribute__((address_space(3))) bf16x8*)(kp+6656);
}
__device__ __forceinline__ void kload2(bf16x8*kf,lds_cptr kp,int j){ kf[2*j]=*(const __attribute__((address_space(3))) bf16x8*)(kp+j*2048); kf[2*j+1]=*(const __attribute__((address_space(3))) bf16x8*)(kp+j*2048+512); }
__device__ __forceinline__ s16x4 vtr(lds_cptr p){ return __builtin_bit_cast(s16x4,__builtin_amdgcn_ds_read_tr16_b64_v4i16((__attribute__((address_space(3))) v4i16_t*)p)); }
__device__ __forceinline__ float rowmax(const f32x16&p0,const f32x16&p1){
  float a=max3f(p0[0],p0[1],p1[0]),b=max3f(p0[2],p0[3],p1[1]);a=max3f(a,p1[2],p1[3]);
  #pragma unroll
  for(int r=4;r<16;r+=4){a=max3f(a,p0[r],p0[r+1]);b=max3f(b,p0[r+2],p0[r+3]);a=max3f(a,p1[r],p1[r+1]);b=max3f(b,p1[r+2],p1[r+3]);}
  const float m=max2f(a,b);
  auto rr=__builtin_amdgcn_permlane32_swap(__float_as_uint(m),__float_as_uint(m),false,false);
  return max2f(__uint_as_float(rr[0]),__uint_as_float(rr[1]));
}
__device__ __forceinline__ void pv(f32x16*o,int vb,bf16x8 pa0,bf16x8 pa1,bf16x8 pa2,bf16x8 pa3){
  #pragma unroll
  for(int d0=0;d0<2;++d0){s16x4 lo[4],hi[4];
    #pragma unroll
    for(int ks=0;ks<4;++ks){
      asm volatile("ds_read_b64_tr_b16 %0,%1 offset:%c2":"=&v"(lo[ks]):"v"(vb),"i"(d0*4096+ks*1024):"memory");
      asm volatile("ds_read_b64_tr_b16 %0,%1 offset:%c2":"=&v"(hi[ks]):"v"(vb),"i"(d0*4096+ks*1024+512):"memory");}
    asm volatile("s_waitcnt lgkmcnt(0)":::"memory");SBAR();
    #define PK(k) (bf16x8){lo[k][0],lo[k][1],lo[k][2],lo[k][3],hi[k][0],hi[k][1],hi[k][2],hi[k][3]}
    o[d0]=__builtin_amdgcn_mfma_f32_32x32x16_bf16(pa0,PK(0),o[d0],0,0,0);
    o[d0]=__builtin_amdgcn_mfma_f32_32x32x16_bf16(pa1,PK(1),o[d0],0,0,0);
    o[d0]=__builtin_amdgcn_mfma_f32_32x32x16_bf16(pa2,PK(2),o[d0],0,0,0);
    o[d0]=__builtin_amdgcn_mfma_f32_32x32x16_bf16(pa3,PK(3),o[d0],0,0,0);
    #undef PK
  }
}

#ifndef ATTN_STORE16
#define ATTN_STORE16(p,v) (*(u32x4*)(p)=(v))
#endif
template<int THRL> __device__ __forceinline__ void attn_unit(int b,int vh,int qb,const bf16*Q,const bf16*__restrict__ K,const bf16*__restrict__ V,bf16*O,char*shm,const __attribute__((address_space(3))) float*tball,const int tid){
  const int lane=tid&63,r32=lane&31,hi=lane>>5; const int wid=__builtin_amdgcn_readfirstlane(tid>>6);
  const long rowbase=(long)b*SEQ; const int q0=qb*QB;
  const int hh=vh>>2, qcol=hh*128+((vh>>1)&1)*64, vcol=hh*128+(vh&1)*64;
  const __attribute__((address_space(3))) float*tb=tball+hh*128;
  const bf16*Qw=Q+(rowbase+q0+wid*QBLK)*PQ+qcol;
  const bf16*Kh=K+rowbase*PQ+qcol,*Vh=V+rowbase*PQ+vcol;
  const unsigned lds0=(unsigned)(uintptr_t)shm;
  float*wsf=(float*)(shm+LDS_WS)+wid*64;
  const bf16*ksrc=Kh+(long)lane*PQ+wid*8;
  const bf16*vsrc=Vh+(long)(16*(wid&3)+(lane>>2))*PQ+(wid>>2)*32+(lane&3)*8;
  const unsigned kdst=lds0+LDS_K+wid*1024, vdst=lds0+LDS_V+wid*1024;
  #define DMA_K(t,slot) glds16(ksrc+(long)(t)*KVBLK*PQ,(unsigned)__builtin_amdgcn_readfirstlane(kdst+(slot)))
  #define DMA_V(t,slot) glds16(vsrc+(long)(t)*KVBLK*PQ,(unsigned)__builtin_amdgcn_readfirstlane(vdst+(slot)))
  const int vb0=(int)(lds0+LDS_V)+((lane>>4)&1)*32+(lane&3)*8+(4*hi+((lane&15)>>2))*64;
  const char*Kbase=shm+LDS_K; bf16x8 kf[8];
  const lds_cptr shm3=(lds_cptr)shm; const lds_cptr kp0=shm3+LDS_K+hi*1024+r32*16; const lds_cptr vp0=shm3+LDS_V+((lane>>4)&1)*32+(lane&3)*8+(4*hi+((lane&15)>>2))*64;
  const int NT=(q0+QB)/KVBLK;
  DMA_K(0,0);DMA_V(0,0);DMA_K(1,SLOTB);
  bf16x8 qr[4];
  #pragma unroll
  for(int d0=0;d0<4;++d0)qr[d0]=*reinterpret_cast<const bf16x8*>(&Qw[(long)r32*PQ+d0*16+hi*8]);
  float mhat=0.f,l_reg=0.f;f32x16 o[2];o[0]=f32x16{};o[1]=f32x16{};f32x16 negm=f32x16{};asm volatile("":"+v"(negm));
  const int qrel=wid*QBLK+r32;
  #define CMASK(P0,P1,t) do{int jb_=(t)-(NT-4); if(jb_>=-2){cbias(P0,P1,jb_,qrel,hi,tb); if(jb_>=0)cmask(P0,P1,jb_,qrel,hi);}}while(0)
  bool resc=false;
  #define START(P0,P1) do{ const float rm=rowmax(P0,P1); resc=false; \
    { const float dl=rm; mhat=fadd_s(mhat,dl); \
      _Pragma("unroll") for(int r=0;r<16;++r){P0[r]=fsub_s(P0[r],dl);P1[r]=fsub_s(P1[r],dl);} \
      _Pragma("unroll") for(int r=0;r<16;++r)negm[r]=-mhat; asm volatile("":"+v"(negm)); } \
    _Pragma("unroll") for(int r=0;r<16;++r)P0[r]=__builtin_amdgcn_exp2f(P0[r]); }while(0)
  #define RESC() do{ if(resc){ asm volatile("s_waitcnt lgkmcnt(0)":::"memory"); \
      _Pragma("unroll") for(int d_=0;d_<2;++d_) _Pragma("unroll") for(int r=0;r<16;++r)o[d_][r]*=wsf[crow(r,hi)]; } }while(0)
  f32x16 pA0,pA1,pB0,pB1;
  int sl_prev=0,sl_cur=0,sl_next=SLOTB;
  #define ROT() do{sl_prev=sl_cur;sl_cur=sl_next;sl_next=(sl_next==(NSLOT-1)*SLOTB)?0:sl_next+SLOTB;}while(0)
  DMA_K(2,2*SLOTB);
  WAIT_BAR(3);
  qkt(pA0,pA1,Kbase,qr,negm,r32,hi);asm volatile("s_nop 15\n\ts_nop 7":"+v"(pA0),"+v"(pA1));CMASK(pA0,pA1,0);
  START(pA0,pA1);
  _Pragma("unroll") for(int r=0;r<16;++r)pA1[r]=__builtin_amdgcn_exp2f(pA1[r]);
  WAIT_BAR(0);
  DMA_K(3,0);DMA_V(1,SLOTB);
  ROT();
  kload8(kf,kp0+sl_cur);
  WAIT_BAR(2);
  s16x4 vlo[8],vhi[8]; u32x4 pw0,pw1,pw2,pw3;
  #define PKW(P,B) cvtpk_s(P[B],P[B+1])
  #define PAF(k) __builtin_bit_cast(bf16x8,pw##k)
  #define VFR(i) (bf16x8){vlo[i][0],vlo[i][1],vlo[i][2],vlo[i][3],vhi[i][0],vhi[i][1],vhi[i][2],vhi[i][3]}
  #define PIN(x) asm volatile("":"+v"(x))
  #define MX3(a,b,c) __builtin_fmaxf(__builtin_fmaxf((a),(b)),(c))
  #define GAPA(MF,A0,A1,A2,A3,W0,W1,PW) do{ MF; sacc+=A0; sacc+=A1; sacc+=A2; sacc+=A3; PIN(sacc); W0; W1; PIN(PW); SBAR(); }while(0)
  #define EX(v) __builtin_amdgcn_exp2f(v)
  #define GAPB(MF,X,B) do{ MF; X[B]=EX(X[B]); X[B+1]=EX(X[B+1]); X[B+2]=EX(X[B+2]); X[B+3]=EX(X[B+3]); PIN(X); SBAR(); }while(0)
  #define VRD(i) do{ vlo[i]=vtr(vp_+(((i)>>2)*4096+((i)&3)*1024)); vhi[i]=vtr(vp_+(((i)>>2)*4096+((i)&3)*1024+512)); }while(0)
  #define KRD(G,j) do{ if(G){ kload2(kf,kp0+sl_next,j); SBAR(); } }while(0)
  #define STEP(C0,C1,P0,P1,t,GK,GV,GL) do{ SBAR(); \
    const lds_cptr vp_=vp0+sl_prev; \
    VRD(0); SBAR(); float sacc=(P0[0]+P0[1]); \
    GAPA(C0=__builtin_amdgcn_mfma_f32_32x32x16_bf16(kf[0],qr[0],negm,0,0,0), P0[2],P0[3],P0[4],P0[5],     pw0[0]=PKW(P0,0), pw0[1]=PKW(P0,2), pw0); \
    VRD(4); SBAR(); GAPA(C1=__builtin_amdgcn_mfma_f32_32x32x16_bf16(kf[1],qr[0],negm,0,0,0), P0[6],P0[7],P0[8],P0[9],     pw0[2]=PKW(P0,4), pw0[3]=PKW(P0,6), pw0); \
    VRD(1); SBAR(); GAPA(C0=__builtin_amdgcn_mfma_f32_32x32x16_bf16(kf[2],qr[1],C0,0,0,0),   P0[10],P0[11],P0[12],P0[13], pw1[0]=PKW(P0,8), pw1[1]=PKW(P0,10), pw1); \
    VRD(5); SBAR(); GAPA(C1=__builtin_amdgcn_mfma_f32_32x32x16_bf16(kf[3],qr[1],C1,0,0,0),   P0[14],P0[15],P1[0],P1[1],   pw1[2]=PKW(P0,12),pw1[3]=PKW(P0,14), pw1); \
    VRD(2); SBAR(); GAPA(C0=__builtin_amdgcn_mfma_f32_32x32x16_bf16(kf[4],qr[2],C0,0,0,0),   P1[2],P1[3],P1[4],P1[5],     pw2[0]=PKW(P1,0), pw2[1]=PKW(P1,2), pw2); \
    VRD(6); SBAR(); GAPA(C1=__builtin_amdgcn_mfma_f32_32x32x16_bf16(kf[5],qr[2],C1,0,0,0),   P1[6],P1[7],P1[8],P1[9],     pw2[2]=PKW(P1,4), pw2[3]=PKW(P1,6), pw2); \
    VRD(3); SBAR(); GAPA(C0=__builtin_amdgcn_mfma_f32_32x32x16_bf16(kf[6],qr[3],C0,0,0,0),   P1[10],P1[11],P1[12],P1[13], pw3[0]=PKW(P1,8), pw3[1]=PKW(P1,10), pw3); \
    VRD(7); SBAR(); GAPA(C1=__builtin_amdgcn_mfma_f32_32x32x16_bf16(kf[7],qr[3],C1,0,0,0),   P1[14],P1[15],0.f,0.f,       pw3[2]=PKW(P1,12),pw3[3]=PKW(P1,14), pw3); \
    l_reg+=sacc; \
    if(GK){DMA_K((t)+3,sl_cur);} if(GV){DMA_V((t)+1,sl_next);} \
    CMASK(C0,C1,t); \
    { float a=MX3(C0[0],C0[1],C1[0]),b=MX3(C0[2],C0[3],C1[1]); a=MX3(a,C1[2],C1[3]); \
      _Pragma("unroll") for(int r=4;r<16;r+=4){a=MX3(a,C0[r],C0[r+1]);b=MX3(b,C0[r+2],C0[r+3]);a=MX3(a,C1[r],C1[r+1]);b=MX3(b,C1[r+2],C1[r+3]);} \
      float rm=__builtin_fmaxf(a,b); { auto rr=__builtin_amdgcn_permlane32_swap(__float_as_uint(rm),__float_as_uint(rm),false,false); rm=__builtin_fmaxf(__uint_as_float(rr[0]),__uint_as_float(rr[1])); } \
      resc=false; \
      if(__builtin_expect(__any(rm>(float)THRL),0)){ const float dl=__builtin_fmaxf(rm,0.f); mhat+=dl; \
        _Pragma("unroll") for(int r=0;r<16;++r){C0[r]-=dl;C1[r]-=dl;} \
        _Pragma("unroll") for(int r=0;r<16;++r)negm[r]=-mhat; asm volatile("":"+v"(negm)); \
        const float f=__builtin_amdgcn_exp2f(-dl); l_reg*=f; if(hi==0)wsf[r32]=f; resc=true; } } \
    SBAR(); \
    GAPB(o[0]=__builtin_amdgcn_mfma_f32_32x32x16_bf16(PAF(0),VFR(0),o[0],0,0,0), C0,0); \
    GAPB(o[1]=__builtin_amdgcn_mfma_f32_32x32x16_bf16(PAF(0),VFR(4),o[1],0,0,0), C0,4); \
    KRD(GL,0); GAPB(o[0]=__builtin_amdgcn_mfma_f32_32x32x16_bf16(PAF(1),VFR(1),o[0],0,0,0), C0,8); \
    KRD(GL,1); GAPB(o[1]=__builtin_amdgcn_mfma_f32_32x32x16_bf16(PAF(1),VFR(5),o[1],0,0,0), C0,12); \
    KRD(GL,2); GAPB(o[0]=__builtin_amdgcn_mfma_f32_32x32x16_bf16(PAF(2),VFR(2),o[0],0,0,0), C1,0); \
    KRD(GL,3); GAPB(o[1]=__builtin_amdgcn_mfma_f32_32x32x16_bf16(PAF(2),VFR(6),o[1],0,0,0), C1,4); \
    GAPB(o[0]=__builtin_amdgcn_mfma_f32_32x32x16_bf16(PAF(3),VFR(3),o[0],0,0,0), C1,8); \
    GAPB(o[1]=__builtin_amdgcn_mfma_f32_32x32x16_bf16(PAF(3),VFR(7),o[1],0,0,0), C1,12); \
    }while(0)
  int t=1;
  #undef CMASK
  #define CMASK(P0,P1,t) do{}while(0)
  for(;t+7<NT;t+=2){
    STEP(pB0,pB1,pA0,pA1,t,true,true,true);     WAIT_BAR(2); RESC(); ROT();
    STEP(pA0,pA1,pB0,pB1,t+1,true,true,true);   WAIT_BAR(2); RESC(); ROT();
  }
  #undef CMASK
  #define CMASK(P0,P1,t) do{int jb_=(t)-(NT-4); if(jb_>=-2){cbias(P0,P1,jb_,qrel,hi,tb); if(jb_>=0)cmask(P0,P1,jb_,qrel,hi);}}while(0)
  #define ENDW(tt) do{ if((tt)+3<NT){WAIT_BAR(2);} else if((tt)+2<NT){WAIT_BAR(1);} else {WAIT_BAR(0);} }while(0)
  for(;t+1<NT;t+=2){
    STEP(pB0,pB1,pA0,pA1,t,(t+3<NT),(t+1<NT),(t+1<NT));       ENDW(t);   RESC(); ROT();
    STEP(pA0,pA1,pB0,pB1,t+1,(t+4<NT),(t+2<NT),(t+2<NT));     ENDW(t+1); RESC(); ROT();
  }
  STEP(pB0,pB1,pA0,pA1,NT-1,false,false,false); RESC();
  { float sacc=pB0[0]+pB0[1]; _Pragma("unroll") for(int r=2;r<16;++r)sacc+=pB0[r]; _Pragma("unroll") for(int r=0;r<16;++r)sacc+=pB1[r]; l_reg+=sacc;
    pw0=(u32x4){PKW(pB0,0),PKW(pB0,2),PKW(pB0,4),PKW(pB0,6)};pw1=(u32x4){PKW(pB0,8),PKW(pB0,10),PKW(pB0,12),PKW(pB0,14)};pw2=(u32x4){PKW(pB1,0),PKW(pB1,2),PKW(pB1,4),PKW(pB1,6)};pw3=(u32x4){PKW(pB1,8),PKW(pB1,10),PKW(pB1,12),PKW(pB1,14)};
    SBAR(); pv(o,vb0+sl_cur,PAF(0),PAF(1),PAF(2),PAF(3)); }
  #undef PKW
  #undef PAF
  #undef VFR
  #undef PIN
  #undef MX3
  #undef GAPA
  #undef GAPB
  #undef EX
  #undef VRD
  #undef KRD
  #undef STEP
  #undef ENDW
  {auto rr=__builtin_amdgcn_permlane32_swap(__float_as_uint(l_reg),__float_as_uint(l_reg),false,false);l_reg=__uint_as_float(rr[0])+__uint_as_float(rr[1]);}
  if(hi==0)wsf[32+r32]=l_reg;asm volatile("s_waitcnt lgkmcnt(0)":::"memory");
  float rli[16];
  #pragma unroll
  for(int r=0;r<16;++r)rli[r]=__builtin_amdgcn_rcpf(wsf[32+crow(r,hi)]);
  bf16*Ow=O+(rowbase+q0+wid*QBLK)*PO+vh*D;
  { bf16*stg=(bf16*)(shm+LDS_OST)+wid*2048;
    #pragma unroll
    for(int r=0;r<16;++r){const int orow=crow(r,hi);
      #pragma unroll
      for(int d0=0;d0<2;++d0)stg[orow*64+d0*32+r32]=__float2bfloat16(o[d0][r]*rli[r]);}
    asm volatile("s_waitcnt lgkmcnt(0)":::"memory");
    #pragma unroll
    for(int i=0;i<4;++i){const int row=i*8+(lane>>3),ch=lane&7; const u32x4 v=*(const u32x4*)(stg+row*64+ch*8); ATTN_STORE16(Ow+(long)row*PO+ch*8,v);} }
  asm volatile("s_waitcnt lgkmcnt(0)\n\ts_barrier":::"memory");
  #undef DMA_K
  #undef DMA_V
  #undef CMASK
  #undef START
  #undef RESC
  #undef ROT
}
constexpr int ATTN_LDS_BYTES=LDS_BYTES;
struct AttnTensors { const bf16* Q; const bf16* K; const bf16* V; bf16* O; };
struct AttnUnit { int bh; int qb; };
__device__ __forceinline__ bool attn_next(int vcu,int i,AttnUnit&u){ if(i>=16)return false; const int s=vcu&7, j=i&3; u.bh=(vcu>>3)+32*(i>>2); u.qb=(j==0)?s:(j==1)?15-s:(j==2)?16+s:31-s; return true; }
template<int THRL=8> __device__ __forceinline__ void attn_phase(char*lds,const AttnTensors&T,int vcu,const __attribute__((address_space(3))) float*tball,const int tid){
  AttnUnit u;
  for(int i=0;attn_next(vcu,i,u);++i){ attn_unit<THRL>(u.bh/NHEAD,u.bh%NHEAD,u.qb,T.Q,T.K,T.V,T.O,lds,tball,tid); }
}
#undef SBAR
#undef WAIT_BAR
}

#define XB_TMO      128
#define XB_XCNT(j)  (256  + 64 * (j))
#define XB_XSUB(j)  (1280 + 64 * (j))
#define XB_XGEN(j)  (2304 + 64 * (j))
#define XB_TOP      3328
#define XB_TOPGEN   3392
#define XCD_BAR_WORDS 3456
#define XB_SPIN_CAP (1u << 18)

__device__ __forceinline__ unsigned xb_ld(unsigned* p)              { return __hip_atomic_load(p, __ATOMIC_RELAXED, __HIP_MEMORY_SCOPE_AGENT); }
__device__ __forceinline__ unsigned xb_add(unsigned* p, unsigned v) { return __hip_atomic_fetch_add(p, v, __ATOMIC_RELAXED, __HIP_MEMORY_SCOPE_AGENT); }
__device__ __forceinline__ unsigned xb_xcc_id() { return (unsigned)__builtin_amdgcn_s_getreg((3 << 11) | 20) & 0xFu; }
#define XB_SPIN(cond, bar) do { unsigned _sp = 0; while (cond) { __builtin_amdgcn_s_sleep(1); \
    if ((++_sp & 255u) == 0u) { if (xb_ld(&(bar)[XB_TMO])) break; if (_sp > XB_SPIN_CAP) { atomicAdd(&(bar)[XB_TMO], 1u); break; } } } } while (0)

struct XcdBarrier {
    unsigned* bar; unsigned x;
    volatile LAS unsigned* st;
};

__device__ __forceinline__ XcdBarrier xcd_barrier_post(unsigned* bar, volatile LAS unsigned* st, const bool leader  ) {
    XcdBarrier b; b.bar = bar; b.x = xb_xcc_id(); b.st = st;
    if (leader) (void)xb_add(&bar[XB_XCNT(b.x)], 1u);
    return b;
}
__device__ __forceinline__ void xcd_barrier_complete(unsigned* bar, unsigned x, unsigned& nloc, unsigned& nx) {
    const unsigned G = gridDim.x * gridDim.y * gridDim.z;
    unsigned sum, cnt, mine, sp = 0u;
    for (;;) {
        sum = 0u; cnt = 0u; mine = 0u;
#pragma unroll
        for (unsigned j = 0; j < 16; ++j) { const unsigned c = xb_ld(&bar[XB_XCNT(j)]); sum += c; cnt += (c > 0u) ? 1u : 0u; mine = (j == x) ? c : mine; }
        if (sum == G) break;
        __builtin_amdgcn_s_sleep(1);
        if ((++sp & 255u) == 0u) { if (xb_ld(&bar[XB_TMO])) break; if (sp > XB_SPIN_CAP) { atomicAdd(&bar[XB_TMO], 1u); break; } }
    }
    nloc = mine > 0u ? mine : 1u; nx = cnt > 0u ? cnt : 1u;
}

__device__ __forceinline__ void xcd_barrier(const XcdBarrier& b, const bool leader  ) {
    asm volatile("s_waitcnt vmcnt(0)" ::: "memory");
    __syncthreads();
    if (leader) {
        unsigned* bar = b.bar;
        __builtin_amdgcn_s_waitcnt(0);
        unsigned nloc = b.st[0], nx = b.st[1];
        if (nloc == 0u) { xcd_barrier_complete(bar, b.x, nloc, nx); b.st[0] = nloc; b.st[1] = nx; }
        const unsigned old = xb_add(&bar[XB_XSUB(b.x)], 1u);
        const unsigned gen = old / nloc;
        if (old + 1u == (gen + 1u) * nloc) {
            __builtin_amdgcn_fence(__ATOMIC_RELEASE, "agent");
            asm volatile("s_waitcnt vmcnt(0)" ::: "memory");
            const unsigned og = xb_add(&bar[XB_TOP], 1u);
            const unsigned tg = og / nx;
            if (og + 1u == (tg + 1u) * nx) xb_add(&bar[XB_TOPGEN], 1u);
            else XB_SPIN(xb_ld(&bar[XB_TOPGEN]) == tg, bar);
            __builtin_amdgcn_fence(__ATOMIC_ACQUIRE, "agent");
            xb_add(&bar[XB_XGEN(b.x)], 1u);
            asm volatile("s_waitcnt vmcnt(0)" ::: "memory");
        } else {
            XB_SPIN(xb_ld(&bar[XB_XGEN(b.x)]) == gen, bar);
            __builtin_amdgcn_fence(__ATOMIC_ACQUIRE, "agent");
            asm volatile("s_waitcnt vmcnt(0)" ::: "memory");
        }
    }
    __syncthreads();
}

constexpr size_t MiB = 1u << 20;
constexpr size_t WS_CTL = 0, CTL_ZERO_BYTES = 1 * MiB;
constexpr size_t WS_WIN = 2 * MiB;
constexpr size_t WS_WOUT = 7 * MiB;
constexpr size_t WS_PGATE = 9 * MiB;
constexpr size_t WS_PPROJ = 13 * MiB;
constexpr size_t WS_RCAT = 14 * MiB;
constexpr size_t WS_RL1 = 20 * MiB;
constexpr size_t WS_RS2 = 28 * MiB;
constexpr size_t WS_RWO = 30 * MiB;
constexpr size_t WS_ROUT = 32 * MiB;
constexpr size_t WS_LRUAGG = 33 * MiB;
constexpr size_t WS_MGU = 38 * MiB;
constexpr size_t WS_MDN = 102 * MiB;
constexpr size_t WS_PB = 134 * MiB;
constexpr size_t WS_ACT = 166 * MiB;
constexpr size_t WS_H0 = WS_ACT;
constexpr size_t WS_QKV = WS_ACT + 128 * MiB;
constexpr size_t WS_O = WS_ACT + 448 * MiB;
constexpr size_t WS_HL = WS_ACT + 576 * MiB, WS_CA = WS_ACT + 640 * MiB;
constexpr size_t WS_H2 = WS_ACT;
constexpr size_t WS_LOG = WS_ACT + 128 * MiB;
constexpr size_t WS_ROUTE = WS_ACT + 144 * MiB;
constexpr size_t WS_HID = WS_ACT + 152 * MiB;
constexpr size_t WS_YS = WS_ACT + 288 * MiB;
constexpr size_t WS_PP = WS_ACT + 128 * MiB;
constexpr size_t WS_HCAT = WS_ACT;
constexpr size_t WS_XR = WS_ACT + 256 * MiB, WS_XK = WS_ACT + 384 * MiB, WS_XV = WS_ACT + 512 * MiB;
constexpr size_t WS_R = WS_ACT + 640 * MiB, WS_K = WS_XR, WS_V = WS_XK;
constexpr size_t WS_MID = WS_ACT + 768 * MiB;
constexpr size_t WS_EW = WS_ACT;
constexpr size_t WS_AA = WS_ACT + 128 * MiB;
constexpr size_t WS_Y = WS_XV;
constexpr size_t WS_END = WS_ACT + 832 * MiB;
static_assert(WS_END <= 1024 * MiB, "workspace map");
constexpr size_t RT_EID = 0, RT_POS = 1 * MiB, RT_GATE = 2 * MiB, RT_ROWTOK = 3 * MiB, RT_ROWGATE = 4 * MiB, RT_SLOT = 5 * MiB;
constexpr int CW_BAR = 4096;
constexpr int CW_CNT0 = 16384, CW_CNT1 = 16384 + 64;

constexpr int RING_BYTES = 131072;
constexpr int LDSCTL_OFF = RING_BYTES, MISC_OFF = LDSCTL_OFF + 320;
constexpr int TB_OFF = RING_BYTES + 1024;
constexpr int RTE_OFF = TB_OFF + 2048;
constexpr int LDS_BYTES = 147456;

constexpr int NWAVES = 8;
__device__ __forceinline__ int lane_id_() { int l; asm volatile("v_mbcnt_lo_u32_b32 %0, -1, 0\n\tv_mbcnt_hi_u32_b32 %0, -1, %0" : "=v"(l)); return l; }
#define TID_ (F.wave * 64 + lane_id_())
#define LANE_ (lane_id_())
struct Frame {
    LAS unsigned char* lds; volatile LAS unsigned* MISC; gu32* ctl;
    int wave, vcu, G;
};

__device__ __forceinline__ void load_row4(const float* xrow, int lane, f32x4 (&v)[4]) { const f32x4* p = (const f32x4*)xrow + lane;
#pragma unroll
    for (int j = 0; j < 4; ++j) v[j] = p[64 * j]; }
__device__ __forceinline__ float row_rstd(const f32x4 (&v)[4], float eps) { float s = 0.f;
#pragma unroll
    for (int j = 0; j < 4; ++j) s += (v[j].x * v[j].x + v[j].y * v[j].y) + (v[j].z * v[j].z + v[j].w * v[j].w);
    return 1.0f / sqrtf(wave_sum(s) * (1.0f / 1024.0f) + eps); }
__device__ __forceinline__ void load_row4_bf(const bf16* xrow, int lane, f32x4 (&v)[4]) { const v2u* p = (const v2u*)xrow + lane;
#pragma unroll
    for (int j = 0; j < 4; ++j) { const v2u w = p[64 * j]; v[j] = (f32x4){bflo(w.x), bfhi(w.x), bflo(w.y), bfhi(w.y)}; } }
__device__ __forceinline__ void store_row4_bf(bf16* xrow, int lane, const f32x4 (&v)[4]) { v2u* p = (v2u*)xrow + lane;
#pragma unroll
    for (int j = 0; j < 4; ++j) { v2u o; o.x = pk2(v[j].x, v[j].y); o.y = pk2(v[j].z, v[j].w); p[64 * j] = o; } }
__device__ __forceinline__ void store_row_bf16(bf16* orow, int lane, const f32x4 (&v)[4], float rstd, const float* g) {
    unsigned long long* o8 = (unsigned long long*)orow + lane;
#pragma unroll
    for (int j = 0; j < 4; ++j) { const f32x4 gg = ((const f32x4*)g)[lane + 64 * j];
        o8[64 * j] = (unsigned long long)pk2(v[j].x * rstd * gg.x, v[j].y * rstd * gg.y) | ((unsigned long long)pk2(v[j].z * rstd * gg.z, v[j].w * rstd * gg.w) << 32); }
}

template <int MODE>
__device__ __forceinline__ void transpose_item(const float* W, int K, int N, bf16* WT, int ldo, int row_off, const float* mu, LAS float* scr, int item, int lane) {
    const int nblk = N / 32, kb = item / nblk, nb = item % nblk, k0 = 64 * kb, n0 = 32 * nb;
    float ld[32];
#pragma unroll
    for (int i = 0; i < 32; ++i) { const int kk = 2 * i + (lane >> 5); ld[i] = W[(size_t)(k0 + kk) * N + n0 + (lane & 31)]; }
#pragma unroll
    for (int i = 0; i < 32; ++i) { const int kk = 2 * i + (lane >> 5); scr[kk * 33 + (lane & 31)] = ld[i]; }
    LDS_WAIT(); asm volatile("" ::: "memory");
    const int c = lane & 7;
    int rbase = row_off + n0;
    if (MODE == 2) { rbase = row_off + ((n0 < 512) ? ((n0 >> 7) * 256 + (n0 & 127)) : (((n0 - 512) >> 7) * 256 + 128 + ((n0 - 512) & 127))); }
    float m[8];
    if (MODE == 1) {
#pragma unroll
        for (int e = 0; e < 8; ++e) m[e] = mu[k0 + 8 * c + e]; }
#pragma unroll
    for (int j = 0; j < 4; ++j) { const int n = (lane >> 3) + 8 * j; const LAS float* s = scr + (8 * c) * 33 + n;
        float v[8];
#pragma unroll
        for (int e = 0; e < 8; ++e) v[e] = s[e * 33];
        bf16* dst = WT + (size_t)(rbase + n) * ldo + k0 + 8 * c;
        if (MODE == 1) {
            v4u o, o2;
            o.x = pk2(v[0] * (1.f - m[0]), v[1] * (1.f - m[1])); o.y = pk2(v[2] * (1.f - m[2]), v[3] * (1.f - m[3])); o.z = pk2(v[4] * (1.f - m[4]), v[5] * (1.f - m[5])); o.w = pk2(v[6] * (1.f - m[6]), v[7] * (1.f - m[7]));
            o2.x = pk2(v[0] * m[0], v[1] * m[1]); o2.y = pk2(v[2] * m[2], v[3] * m[3]); o2.z = pk2(v[4] * m[4], v[5] * m[5]); o2.w = pk2(v[6] * m[6], v[7] * m[7]);
            *(GAS v4u*)dst = o; *(GAS v4u*)(dst + 1024) = o2;
        } else {
            v4u o; o.x = pk2(v[0], v[1]); o.y = pk2(v[2], v[3]); o.z = pk2(v[4], v[5]); o.w = pk2(v[6], v[7]);
            *(GAS v4u*)dst = o; }
    }
    LDS_WAIT(); asm volatile("" ::: "memory");
}

struct In {
    const float *x, *p, *rel_bias, *norm_mix, *ab_w_in, *ab_w_out, *lam_q1, *lam_k1, *lam_q2, *lam_k2, *sub_g, *conv_w, *conv_b, *lru_wa, *lru_ba, *lru_wx, *lru_bx, *lru_lambda,
        *rwkv_mu, *rwkv_wr, *rwkv_wk, *rwkv_wv, *rwkv_wo, *rwkv_w0, *rwkv_w1, *rwkv_w2, *rwkv_a0, *rwkv_a1, *rwkv_a2, *rwkv_g1, *rwkv_g2, *rwkv_kk, *rwkv_ka, *rwkv_rk, *rwkv_ln_g, *rwkv_ln_b,
        *norm_ffn, *moe_wc, *moe_bc, *moe_wf, *moe_bf, *moe_w_gu, *moe_w_down, *ple_norm, *ple_gate, *ple_proj, *final_norm;
};

__device__ __forceinline__ void prep_dense_weights(Frame& F, const In& I, unsigned char* ws) {
    LAS float* scr = (LAS float*)(F.lds + F.wave * 16384);
    const int gw = F.vcu * NWAVES + F.wave, NGW = F.G * NWAVES;
    bf16* WIN = (bf16*)(ws + WS_WIN); bf16* WOUT = (bf16*)(ws + WS_WOUT); bf16* PG = (bf16*)(ws + WS_PGATE); bf16* PPJ = (bf16*)(ws + WS_PPROJ);
    bf16* RCAT = (bf16*)(ws + WS_RCAT); bf16* RL1 = (bf16*)(ws + WS_RL1); bf16* RWO = (bf16*)(ws + WS_RWO);
    constexpr int I_IN = (1024 / 64) * (2560 / 32), I_SQ = (1024 / 64) * (1024 / 32), I_PJ = (256 / 64) * (1024 / 32), I_L64 = (1024 / 64) * (64 / 32), I_L160 = (1024 / 64) * (160 / 32);
    int st = gw;
#define TJOB(MODE, NITEMS, W, K, N, WT, LDO, ROFF, MU) do { for (int it = st; it < (NITEMS); it += NGW) transpose_item<MODE>(W, K, N, WT, LDO, ROFF, MU, scr, it, LANE_); \
        st = (st + NGW - ((NITEMS) % NGW)) % NGW; asm volatile("" : "+s"(st)); } while (0)
    TJOB(0, I_IN, I.ab_w_in, 1024, 2560, WIN, 1024, 0, nullptr);
    TJOB(0, I_SQ, I.ab_w_out, 1024, 1024, WOUT, 1024, 0, nullptr);
    TJOB(0, I_SQ, I.ple_gate, 1024, 1024, PG, 1024, 0, nullptr);
    TJOB(0, I_SQ, I.ple_gate + 1024 * 1024, 1024, 1024, PG + 1024 * 1024, 1024, 0, nullptr);
    TJOB(0, I_SQ, I.rwkv_wo, 1024, 1024, RWO, 1024, 0, nullptr);
    TJOB(0, I_SQ, I.rwkv_wr, 1024, 1024, RCAT, 1024, 0, nullptr);
    TJOB(0, I_SQ, I.rwkv_wk, 1024, 1024, RCAT, 1024, 1024, nullptr);
    TJOB(0, I_SQ, I.rwkv_wv, 1024, 1024, RCAT, 1024, 2048, nullptr);
    TJOB(0, I_PJ, I.ple_proj, 256, 1024, PPJ, 256, 0, nullptr);
    TJOB(0, I_PJ, I.ple_proj + 256 * 1024, 256, 1024, PPJ + 1024 * 256, 256, 0, nullptr);
    TJOB(1, I_L64, I.rwkv_w1, 1024, 64, RL1, 2048, 0, I.rwkv_mu + 1 * 1024);
    TJOB(1, I_L64, I.rwkv_a1, 1024, 64, RL1, 2048, 64, I.rwkv_mu + 4 * 1024);
    TJOB(1, I_L160, I.rwkv_g1, 1024, 160, RL1, 2048, 256, I.rwkv_mu + 5 * 1024);
#undef TJOB
    const int gt = F.vcu * 512 + TID_, NGT = F.G * 512;
    { v4u z = {0u, 0u, 0u, 0u}; const int per_row = 2048 / 8;
      for (int i = gt; i < (128 + 96) * per_row; i += NGT) { int rr = i / per_row, cc = i % per_row; rr = (rr < 128) ? (128 + rr) : (416 + rr - 128); *(GAS v4u*)(RL1 + (size_t)rr * 2048 + cc * 8) = z; } }
    { bf16* S2 = (bf16*)(ws + WS_RS2);
      for (int i = gt; i < 3 * 1024 * 256; i += NGT) { const int ty = i / (1024 * 256), n = (i / 256) & 1023, k = i & 255; float v = 0.f;
          if (ty == 0) { if (k < 64) v = I.rwkv_w2[k * 1024 + n]; } else if (ty == 1) { if (k >= 64 && k < 128) v = I.rwkv_a2[(k - 64) * 1024 + n]; } else { if (k < 160) v = I.rwkv_g2[k * 1024 + n]; }
          S2[i] = (bf16)f2bf(v); } }
    { bf16* RT = (bf16*)(ws + WS_ROUT);
      for (int i = gt; i < 2 * 256 * 1024; i += NGT) { const int l = i / (256 * 1024), n = (i / 1024) & 255, k = i & 1023; float v = 0.f;
          if (n < 4) v = I.moe_wc[(size_t)l * 1024 * 4 + k * 4 + n]; else if (n < 36) v = I.moe_wf[(size_t)l * 1024 * 32 + k * 32 + (n - 4)];
          RT[i] = (bf16)f2bf(v); } }
}
__device__ __forceinline__ void prep_layer_weights(Frame& F, const In& I, unsigned char* ws, int layer) {
    LAS float* scr = (LAS float*)(F.lds + F.wave * 16384);
    const int gw = F.vcu * NWAVES + F.wave, NGW = F.G * NWAVES;
    bf16* MGU = (bf16*)(ws + WS_MGU); bf16* MDN = (bf16*)(ws + WS_MDN);
    const float* wgu = I.moe_w_gu + (size_t)layer * NEXP * 1024 * 1024; const float* wdn = I.moe_w_down + (size_t)layer * NEXP * 512 * 1024;
    constexpr int I_GU = (1024 / 64) * (1024 / 32), I_DN = (512 / 64) * (1024 / 32);
    for (int it = gw; it < NEXP * (I_GU + I_DN); it += NGW) {
        const int e = it / (I_GU + I_DN); int r = it % (I_GU + I_DN);
        if (r < I_GU) transpose_item<2>(wgu + (size_t)e * 1024 * 1024, 1024, 1024, MGU + (size_t)e * 1024 * 1024, 1024, 0, nullptr, scr, r, LANE_);
        else transpose_item<0>(wdn + (size_t)e * 512 * 1024, 512, 1024, MDN + (size_t)e * 1024 * 512, 512, 0, nullptr, scr, r - I_GU, LANE_);
    }
    const int gt = F.vcu * 512 + TID_, NGT = F.G * 512;
    const f32x4* ps = (const f32x4*)(I.p + (size_t)layer * T * PLE); v2u* pd = (v2u*)(ws + WS_PB);
    for (int i = gt; i < T * PLE / 4; i += 4 * NGT) { f32x4 v[4];
#pragma unroll
        for (int r = 0; r < 4; ++r) v[r] = ps[i + r * NGT];
#pragma unroll
        for (int r = 0; r < 4; ++r) { v2u o; o.x = pk2(v[r].x, v[r].y); o.y = pk2(v[r].z, v[r].w); pd[i + r * NGT] = o; } }
}

template <bool XBF>
__device__ __forceinline__ void norm_pass(Frame& F, const void* x, const float* g, bf16* out) {
    const int gw = F.vcu * NWAVES + F.wave, NGW = F.G * NWAVES; const int lane = LANE_;
    for (int t = 4 * gw; t < T; t += 4 * NGW) {
        f32x4 v[4][4];
#pragma unroll
        for (int r = 0; r < 4; ++r) { if (XBF) load_row4_bf((const bf16*)x + (size_t)(t + r) * D, lane, v[r]); else load_row4((const float*)x + (size_t)(t + r) * D, lane, v[r]); }
#pragma unroll
        for (int r = 0; r < 4; ++r) { const float rs = row_rstd(v[r], 1e-6f); store_row_bf16(out + (size_t)(t + r) * D, lane, v[r], rs, g); }
    }
}
__device__ __forceinline__ void rwkv_input_pass(Frame& F, const bf16* x, const float* g, const float* mu, bf16* HCAT, bf16* XR, bf16* XK, bf16* XV) {
    const int gw = F.vcu * NWAVES + F.wave, NGW = F.G * NWAVES; const int lane = LANE_;
    f32x4 gg[4], mr[4], mk[4], mv[4];
#pragma unroll
    for (int j = 0; j < 4; ++j) { gg[j] = ((const f32x4*)g)[lane + 64 * j]; mr[j] = ((const f32x4*)(mu + 0 * 1024))[lane + 64 * j]; mk[j] = ((const f32x4*)(mu + 2 * 1024))[lane + 64 * j]; mv[j] = ((const f32x4*)(mu + 3 * 1024))[lane + 64 * j]; }
    for (int blk = gw; blk < T / 32; blk += NGW) {
        const int t0 = blk * 32; f32x4 hp[4];
        if ((t0 & (SEQ - 1)) == 0) {
#pragma unroll
            for (int j = 0; j < 4; ++j) hp[j] = (f32x4){0.f, 0.f, 0.f, 0.f};
        } else { f32x4 v[4]; load_row4_bf(x + (size_t)(t0 - 1) * D, lane, v); const float rstd = row_rstd(v, 1e-6f);
#pragma unroll
            for (int j = 0; j < 4; ++j) hp[j] = v[j] * rstd * gg[j]; }
        f32x4 vn[4]; load_row4_bf(x + (size_t)t0 * D, lane, vn);
        for (int t = t0; t < t0 + 32; ++t) {
            f32x4 v[4];
#pragma unroll
            for (int j = 0; j < 4; ++j) v[j] = vn[j];
            if (t + 1 < t0 + 32) load_row4_bf(x + (size_t)(t + 1) * D, lane, vn);
            const float rstd = row_rstd(v, 1e-6f);
            unsigned long long* oh = (unsigned long long*)(HCAT + (size_t)t * 2048) + lane; unsigned long long* or_ = (unsigned long long*)(XR + (size_t)t * 1024) + lane;
            unsigned long long* ok = (unsigned long long*)(XK + (size_t)t * 1024) + lane; unsigned long long* ov = (unsigned long long*)(XV + (size_t)t * 1024) + lane;
#pragma unroll
            for (int j = 0; j < 4; ++j) { const f32x4 h = v[j] * rstd * gg[j], dd = hp[j] - h;
                oh[64 * j] = (unsigned long long)pk2(h.x, h.y) | ((unsigned long long)pk2(h.z, h.w) << 32);
                oh[256 + 64 * j] = (unsigned long long)pk2(hp[j].x, hp[j].y) | ((unsigned long long)pk2(hp[j].z, hp[j].w) << 32);
                const f32x4 a = h + dd * mr[j], b = h + dd * mk[j], c = h + dd * mv[j];
                or_[64 * j] = (unsigned long long)pk2(a.x, a.y) | ((unsigned long long)pk2(a.z, a.w) << 32);
                ok[64 * j] = (unsigned long long)pk2(b.x, b.y) | ((unsigned long long)pk2(b.z, b.w) << 32);
                ov[64 * j] = (unsigned long long)pk2(c.x, c.y) | ((unsigned long long)pk2(c.z, c.w) << 32);
                hp[j] = h; }
        }
    }
}
__device__ __forceinline__ void combine_norm_pass(Frame& F, const bf16* xin, bf16* xout, const bf16* YS, const int* slot, const float* g, bf16* out) {
    const int gw = F.vcu * NWAVES + F.wave, NGW = F.G * NWAVES; const int lane = LANE_;
    for (int t = 2 * gw; t < T; t += 2 * NGW) {
        f32x4 v[2][4]; v2u ya[2][4], yb[2][4];
#pragma unroll
        for (int r = 0; r < 2; ++r) { load_row4_bf(xin + (size_t)(t + r) * D, lane, v[r]);
            const int s0 = slot[2 * (t + r)], s1 = slot[2 * (t + r) + 1];
            const v2u* y0 = (const v2u*)(YS + (size_t)s0 * D) + lane; const v2u* y1 = (const v2u*)(YS + (size_t)s1 * D) + lane;
#pragma unroll
            for (int j = 0; j < 4; ++j) { ya[r][j] = y0[64 * j]; yb[r][j] = y1[64 * j]; } }
#pragma unroll
        for (int r = 0; r < 2; ++r) {
#pragma unroll
            for (int j = 0; j < 4; ++j) { const v2u a = ya[r][j], b = yb[r][j];
                v[r][j].x += bflo(a.x) + bflo(b.x); v[r][j].y += bfhi(a.x) + bfhi(b.x); v[r][j].z += bflo(a.y) + bflo(b.y); v[r][j].w += bfhi(a.y) + bfhi(b.y); }
            store_row4_bf(xout + (size_t)(t + r) * D, lane, v[r]);
            const float rstd = row_rstd(v[r], 1e-6f);
            store_row_bf16(out + (size_t)(t + r) * D, lane, v[r], rstd, g); }
    }
}
__device__ __forceinline__ void final_norm_pass(Frame& F, const bf16* x, float* out, const float* g) {
    const int gw = F.vcu * NWAVES + F.wave, NGW = F.G * NWAVES; const int lane = LANE_;
    for (int t = 4 * gw; t < T; t += 4 * NGW) {
        f32x4 v[4][4];
#pragma unroll
        for (int r = 0; r < 4; ++r) load_row4_bf(x + (size_t)(t + r) * D, lane, v[r]);
#pragma unroll
        for (int r = 0; r < 4; ++r) { const float rs = row_rstd(v[r], 1e-6f); f32x4* xo = (f32x4*)(out + (size_t)(t + r) * D) + lane;
#pragma unroll
            for (int j = 0; j < 4; ++j) { const f32x4 gg = ((const f32x4*)g)[lane + 64 * j]; xo[64 * j] = v[r][j] * rs * gg; } }
    }
}

__device__ __forceinline__ void diff_combine_pass(Frame& F, const In& I, const bf16* O, bf16* YCAT) {
    const int gw = F.vcu * NWAVES + F.wave, NGW = F.G * NWAVES;
    const float lam_init = 0.2f;
    const float d1 = wave_sum(I.lam_q1[LANE_] * I.lam_k1[LANE_]), d2 = wave_sum(I.lam_q2[LANE_] * I.lam_k2[LANE_]);
    const float lam = expf(d1) - expf(d2) + lam_init;
    const int h = LANE_ >> 4, q = LANE_ & 15;
    float sg[8];
#pragma unroll
    for (int e = 0; e < 8; ++e) sg[e] = I.sub_g[q * 8 + e] * (1.0f - lam_init);
    for (int t0 = 4 * gw; t0 < T; t0 += 4 * NGW) {
        v4u av[4], bv[4];
#pragma unroll
        for (int r = 0; r < 4; ++r) { av[r] = *(const v4u*)(O + (size_t)(t0 + r) * 1024 + h * 256 + q * 8); bv[r] = *(const v4u*)(O + (size_t)(t0 + r) * 1024 + h * 256 + 128 + q * 8); }
#pragma unroll
        for (int r = 0; r < 4; ++r) { const v4u a = av[r], b = bv[r]; const int t = t0 + r;
        float o[8];
        o[0] = bflo(a.x) - lam * bflo(b.x); o[1] = bfhi(a.x) - lam * bfhi(b.x); o[2] = bflo(a.y) - lam * bflo(b.y); o[3] = bfhi(a.y) - lam * bfhi(b.y);
        o[4] = bflo(a.z) - lam * bflo(b.z); o[5] = bfhi(a.z) - lam * bfhi(b.z); o[6] = bflo(a.w) - lam * bflo(b.w); o[7] = bfhi(a.w) - lam * bfhi(b.w);
        float s = 0.f;
#pragma unroll
        for (int e = 0; e < 8; ++e) s += o[e] * o[e];
        s += __shfl_xor(s, 1); s += __shfl_xor(s, 2); s += __shfl_xor(s, 4); s += __shfl_xor(s, 8);
        const float rstd = 1.0f / sqrtf(s * (1.0f / 128.0f) + 1e-5f);
        v4u w; w.x = pk2(o[0] * rstd * sg[0], o[1] * rstd * sg[1]); w.y = pk2(o[2] * rstd * sg[2], o[3] * rstd * sg[3]); w.z = pk2(o[4] * rstd * sg[4], o[5] * rstd * sg[5]); w.w = pk2(o[6] * rstd * sg[6], o[7] * rstd * sg[7]);
        *(v4u*)(YCAT + (size_t)t * 1024 + h * 128 + q * 8) = w; }
    }
}

constexpr int LCT = 64, LNCH = SEQ / LCT;
__device__ __forceinline__ float gelu_tanh(float x) { const float u = 0.7978845608028654f * (x + 0.044715f * x * x * x); return x * sigmoidf_(2.0f * u); }
template <bool FINAL>
__device__ __forceinline__ void lru_phase(Frame& F, const In& I, const bf16* XB, const bf16* GB, f32x2* AGG, bf16* YCAT, bf16* HLp, bf16* CAp) {
    const int ch = TID_, n = ch >> 6, d = ch & 63;
    LAS float* U = (LAS float*)F.lds;
    f32x2 wg[64];
#pragma unroll
    for (int c = 0; c < 64; ++c) { wg[c].x = I.lru_wa[n * 4096 + c * 64 + d]; wg[c].y = I.lru_wx[n * 4096 + c * 64 + d]; }
    const float cw0 = I.conv_w[0 * 512 + ch], cw1 = I.conv_w[1 * 512 + ch], cw2 = I.conv_w[2 * 512 + ch], cw3 = I.conv_w[3 * 512 + ch], cb = I.conv_b[ch];
    const float ba = I.lru_ba[ch], bx = I.lru_bx[ch];
    const float lam = I.lru_lambda[ch]; const float sp = (lam > 15.f) ? expf(-lam) : log1pf(expf(-lam));
    const float m8sp = -8.0f * sp;
    for (int un = blockIdx.x; un < NB * LNCH; un += F.G) {
        const int b = un / LNCH, c = un % LNCH; const size_t row0 = (size_t)b * SEQ + (size_t)c * LCT;
        unsigned short xraw[LCT + 3];
        if (c > 0) { xraw[0] = XB[(row0 - 3) * 512 + ch]; xraw[1] = XB[(row0 - 2) * 512 + ch]; xraw[2] = XB[(row0 - 1) * 512 + ch]; } else { xraw[0] = 0; xraw[1] = 0; xraw[2] = 0; }
#pragma unroll
        for (int tk = 0; tk < LCT; ++tk) xraw[3 + tk] = XB[(row0 + tk) * 512 + ch];
        float h = 0.f, Ap = 1.f;
        if (FINAL) { for (int j = 0; j < c; ++j) { const f32x2 ag = AGG[((size_t)b * LNCH + j) * 512 + ch]; h = ag.x * h + ag.y; } }
#pragma unroll
        for (int tk = 0; tk < LCT; ++tk) U[tk * 512 + ch] = cw0 * bf1(xraw[tk]) + cw1 * bf1(xraw[tk + 1]) + cw2 * bf1(xraw[tk + 2]) + cw3 * bf1(xraw[tk + 3]) + cb;
        __syncthreads();
        unsigned short gcur[8], gnxt[8];
        if (FINAL) {
#pragma unroll
            for (int j = 0; j < 8; ++j) gcur[j] = GB[(row0 + j) * 512 + ch]; }
#pragma unroll 1
        for (int tg = 0; tg < LCT / 8; ++tg) {
            if (FINAL) { const int tn = (tg + 1 < LCT / 8) ? (tg + 1) * 8 : tg * 8;
#pragma unroll
                for (int j = 0; j < 8; ++j) gnxt[j] = GB[(row0 + tn + j) * 512 + ch]; }
#pragma unroll
            for (int j = 0; j < 8; ++j) { const int tk = tg * 8 + j;
                const LAS f32x4* up = (const LAS f32x4*)(U + tk * 512 + n * 64);
                f32x2 acc = {ba, bx};
#pragma unroll
                for (int c4 = 0; c4 < 16; ++c4) { const f32x4 uu = up[c4];
                    acc += wg[4 * c4 + 0] * uu.x; acc += wg[4 * c4 + 1] * uu.y; acc += wg[4 * c4 + 2] * uu.z; acc += wg[4 * c4 + 3] * uu.w; }
                const float r = sigmoidf_(acc.x), ig = sigmoidf_(acc.y);
                const float la = r * m8sp; const float a = __expf(la); const float t2 = 2.0f * la; const float om = (t2 > -0.02f) ? -t2 * (1.0f + t2 * (0.5f + t2 * (0.16666667f + t2 * 0.041666668f))) : 1.0f - a * a; const float bb = __builtin_amdgcn_sqrtf(om) * (ig * U[tk * 512 + ch]);
                h = a * h + bb;
                if (FINAL) { YCAT[(row0 + tk) * 1024 + 512 + ch] = (bf16)f2bf(h * gelu_tanh(bf1(gcur[j]))); }
                else { Ap *= a; HLp[(row0 + tk) * 512 + ch] = (bf16)f2bf(h); CAp[(row0 + tk) * 512 + ch] = (bf16)f2bf(Ap); } }
            if (FINAL) {
#pragma unroll
                for (int j = 0; j < 8; ++j) gcur[j] = gnxt[j]; }
        }
        if (!FINAL) { f32x2 ag; ag.x = Ap; ag.y = h; AGG[((size_t)b * LNCH + c) * 512 + ch] = ag; }
        __syncthreads();
    }
}

__device__ __forceinline__ void lru_agg_mfma(Frame& F, const In& I, const bf16* XB, f32x2* AGG, bf16* HLp, bf16* CAp) {
    const int tid = TID_, lane = tid & 63, fr = lane & 15, fq = lane >> 4, n = F.wave, ch = tid;
    constexpr int UP = 520;
    LAS bf16* U = (LAS bf16*)F.lds;
    bf16x8 Wr[4][2], Wi[4][2];
#pragma unroll
    for (int dd = 0; dd < 4; ++dd)
#pragma unroll
        for (int kh = 0; kh < 2; ++kh) { unsigned pr_[4], pi_[4];
#pragma unroll
            for (int j = 0; j < 4; ++j) { const int c0 = 32 * kh + 8 * fq + 2 * j, d = 16 * dd + fr;
                pr_[j] = pk2(I.lru_wa[n * 4096 + c0 * 64 + d], I.lru_wa[n * 4096 + (c0 + 1) * 64 + d]); pi_[j] = pk2(I.lru_wx[n * 4096 + c0 * 64 + d], I.lru_wx[n * 4096 + (c0 + 1) * 64 + d]); }
            Wr[dd][kh] = __builtin_bit_cast(bf16x8, (v4u){pr_[0], pr_[1], pr_[2], pr_[3]}); Wi[dd][kh] = __builtin_bit_cast(bf16x8, (v4u){pi_[0], pi_[1], pi_[2], pi_[3]}); }
    float cba[4], cbx[4], cm8[4];
#pragma unroll
    for (int dd = 0; dd < 4; ++dd) { const int chd = 64 * n + 16 * dd + fr; cba[dd] = I.lru_ba[chd]; cbx[dd] = I.lru_bx[chd];
        const float lam = I.lru_lambda[chd]; cm8[dd] = -8.0f * ((lam > 15.f) ? expf(-lam) : log1pf(expf(-lam))); }
    const float cw0 = I.conv_w[0 * 512 + ch], cw1 = I.conv_w[1 * 512 + ch], cw2 = I.conv_w[2 * 512 + ch], cw3 = I.conv_w[3 * 512 + ch], cb = I.conv_b[ch];
    for (int un = blockIdx.x; un < NB * LNCH; un += F.G) {
        const int b = un / LNCH, c = un % LNCH; const size_t row0 = (size_t)b * SEQ + (size_t)c * LCT;
        unsigned short xraw[LCT + 3];
        if (c > 0) { xraw[0] = XB[(row0 - 3) * 512 + ch]; xraw[1] = XB[(row0 - 2) * 512 + ch]; xraw[2] = XB[(row0 - 1) * 512 + ch]; } else { xraw[0] = 0; xraw[1] = 0; xraw[2] = 0; }
#pragma unroll
        for (int tk = 0; tk < LCT; ++tk) xraw[3 + tk] = XB[(row0 + tk) * 512 + ch];
#pragma unroll
        for (int tk = 0; tk < LCT; ++tk) U[tk * UP + ch] = (bf16)f2bf(cw0 * bf1(xraw[tk]) + cw1 * bf1(xraw[tk + 1]) + cw2 * bf1(xraw[tk + 2]) + cw3 * bf1(xraw[tk + 3]) + cb);
        __syncthreads();
        bf16x8 X[4][2];
#pragma unroll
        for (int tt = 0; tt < 4; ++tt)
#pragma unroll
            for (int kh = 0; kh < 2; ++kh) X[tt][kh] = *(const LAS bf16x8*)(U + (16 * tt + fr) * UP + 64 * n + 32 * kh + 8 * fq);
#pragma unroll 1
        for (int dd = 0; dd < 4; ++dd) {
            bf16x8 wr0, wr1, wi0, wi1; float kba, kbx, km8;
            if (dd == 0) { wr0 = Wr[0][0]; wr1 = Wr[0][1]; wi0 = Wi[0][0]; wi1 = Wi[0][1]; kba = cba[0]; kbx = cbx[0]; km8 = cm8[0]; }
            else if (dd == 1) { wr0 = Wr[1][0]; wr1 = Wr[1][1]; wi0 = Wi[1][0]; wi1 = Wi[1][1]; kba = cba[1]; kbx = cbx[1]; km8 = cm8[1]; }
            else if (dd == 2) { wr0 = Wr[2][0]; wr1 = Wr[2][1]; wi0 = Wi[2][0]; wi1 = Wi[2][1]; kba = cba[2]; kbx = cbx[2]; km8 = cm8[2]; }
            else { wr0 = Wr[3][0]; wr1 = Wr[3][1]; wi0 = Wi[3][0]; wi1 = Wi[3][1]; kba = cba[3]; kbx = cbx[3]; km8 = cm8[3]; }
            const int chd = 64 * n + 16 * dd + fr;
            float hc = 0.f, Ac = 1.f;
#pragma unroll
            for (int tt = 0; tt < 4; ++tt) {
                f32x4 pr = (f32x4){0.f, 0.f, 0.f, 0.f}, pi = pr;
                pr = __builtin_amdgcn_mfma_f32_16x16x32_bf16(X[tt][0], wr0, pr, 0, 0, 0); pr = __builtin_amdgcn_mfma_f32_16x16x32_bf16(X[tt][1], wr1, pr, 0, 0, 0);
                pi = __builtin_amdgcn_mfma_f32_16x16x32_bf16(X[tt][0], wi0, pi, 0, 0, 0); pi = __builtin_amdgcn_mfma_f32_16x16x32_bf16(X[tt][1], wi1, pi, 0, 0, 0);
                float a[4], bb[4];
#pragma unroll
                for (int e = 0; e < 4; ++e) { const int tok = 16 * tt + 4 * fq + e; const float u = bf1(U[tok * UP + chd]);
                    const float r = sigmoidf_(pr[e] + kba), ig = sigmoidf_(pi[e] + kbx); const float la = r * km8; a[e] = __expf(la); const float t2 = 2.0f * la;
                    const float om = (t2 > -0.02f) ? -t2 * (1.0f + t2 * (0.5f + t2 * (0.16666667f + t2 * 0.041666668f))) : 1.0f - a[e] * a[e]; bb[e] = __builtin_amdgcn_sqrtf(om) * (ig * u); }
                const float A4 = (a[0] * a[1]) * (a[2] * a[3]); const float B4 = ((bb[0] * a[1] + bb[1]) * a[2] + bb[2]) * a[3] + bb[3];
                float h = hc, Ap = Ac, hs = hc, As = Ac;
#pragma unroll
                for (int j = 0; j < 4; ++j) { const float Aj = __shfl(A4, fr + 16 * j), Bj = __shfl(B4, fr + 16 * j); if (j == fq) { hs = h; As = Ap; } h = Aj * h + Bj; Ap *= Aj; }
                hc = h; Ac = Ap; h = hs; Ap = As;
#pragma unroll
                for (int e = 0; e < 4; ++e) { h = a[e] * h + bb[e]; Ap *= a[e]; const size_t o = (row0 + 16 * tt + 4 * fq + e) * 512 + chd; HLp[o] = (bf16)f2bf(h); CAp[o] = (bf16)f2bf(Ap); }
            }
            if (fq == 0) { f32x2 ag; ag.x = Ac; ag.y = hc; AGG[((size_t)b * LNCH + c) * 512 + chd] = ag; }
        }
        __syncthreads();
    }
}

__device__ __forceinline__ void lru_final_pass(Frame& F, const bf16* HLp, const bf16* CAp, const bf16* GB, const f32x2* AGG, bf16* YCAT) {
    const int ch = TID_;
    for (int un = blockIdx.x; un < NB * LNCH; un += F.G) {
        const int b = un / LNCH, c = un % LNCH; const size_t row0 = (size_t)b * SEQ + (size_t)c * LCT;
        float carry = 0.f;
        for (int j = 0; j < c; ++j) { const f32x2 ag = AGG[((size_t)b * LNCH + j) * 512 + ch]; carry = ag.x * carry + ag.y; }
#pragma unroll 4
        for (int t8 = 0; t8 < LCT; t8 += 8) {
            bf16 hl[8], ca[8], gv[8];
#pragma unroll
            for (int j = 0; j < 8; ++j) { const size_t o = (row0 + t8 + j) * 512 + ch; hl[j] = HLp[o]; ca[j] = CAp[o]; gv[j] = GB[o]; }
#pragma unroll
            for (int j = 0; j < 8; ++j) { const float h = bf1(hl[j]) + bf1(ca[j]) * carry; YCAT[(row0 + t8 + j) * 1024 + 512 + ch] = (bf16)f2bf(h * gelu_tanh(bf1(gv[j]))); }
        }
    }
}

__device__ __forceinline__ void route_pass_a(Frame& F, const In& I, int layer, const float* LOG, unsigned char* rt, gu32* cnt) {
    LAS int* lcnt = (LAS int*)(F.lds + RTE_OFF); LAS int* lbase = lcnt + 32;
    int* EID = (int*)(rt + RT_EID); int* POS = (int*)(rt + RT_POS); float* GATE = (float*)(rt + RT_GATE);
    const float* bc = I.moe_bc + layer * 4; const float* bfb = I.moe_bf + layer * 32;
    for (int un = blockIdx.x; un < T / 512; un += F.G) {
        if (TID_ < 32) lcnt[TID_] = 0;
        __syncthreads();
        const int t = un * 512 + TID_; const float* lg = LOG + (size_t)t * 64;
        const f32x4 g4 = *(const f32x4*)lg;
        float gl[4] = {g4.x + bc[0], g4.y + bc[1], g4.z + bc[2], g4.w + bc[3]};
        int gi = 0; float gm = gl[0];
#pragma unroll
        for (int j = 1; j < 4; ++j) if (gl[j] > gm) { gm = gl[j]; gi = j; }
        float gs = 0.f;
#pragma unroll
        for (int j = 0; j < 4; ++j) gs += __expf(gl[j] - gm);
        const float gprob = 1.0f / gs;
        const f32x4 e0 = *(const f32x4*)(lg + 4 + gi * 8), e1 = *(const f32x4*)(lg + 8 + gi * 8);
        float el[8] = {e0.x, e0.y, e0.z, e0.w, e1.x, e1.y, e1.z, e1.w};
#pragma unroll
        for (int j = 0; j < 8; ++j) el[j] += bfb[gi * 8 + j];
        int i0 = 0; float m0 = el[0];
#pragma unroll
        for (int j = 1; j < 8; ++j) if (el[j] > m0) { m0 = el[j]; i0 = j; }
        int i1 = -1; float m1 = -INFINITY;
#pragma unroll
        for (int j = 0; j < 8; ++j) if (j != i0 && el[j] > m1) { m1 = el[j]; i1 = j; }
        const float r1 = __expf(m1 - m0); const float g0 = gprob / (1.0f + r1), g1 = gprob * r1 / (1.0f + r1);
        const int ex0 = gi * 8 + i0, ex1 = gi * 8 + i1;
        const int p0 = atomicAdd((int*)&lcnt[ex0], 1), p1 = atomicAdd((int*)&lcnt[ex1], 1);
        __syncthreads();
        if (TID_ < 32) lbase[TID_] = (int)__hip_atomic_fetch_add(cnt + TID_, (unsigned)lcnt[TID_], RLX_AGENT);
        __syncthreads();
        EID[2 * t] = ex0; EID[2 * t + 1] = ex1; POS[2 * t] = lbase[ex0] + p0; POS[2 * t + 1] = lbase[ex1] + p1; GATE[2 * t] = g0; GATE[2 * t + 1] = g1;
        __syncthreads();
    }
}
__device__ __forceinline__ void route_bases(Frame& F, gu32* cnt) {
    LAS int* eb = (LAS int*)(F.lds + RTE_OFF + 512);
    const int tid = TID_;
    if (tid < 64) {
        const int c = (tid < 32) ? (int)__hip_atomic_load(cnt + (tid & 31), RLX_AGENT) : 0; const int p = (c + 255) & ~255; int s = p;
#pragma unroll
        for (int o = 1; o < 32; o <<= 1) { const int t = __shfl_up(s, o); if ((tid & 63) >= o) s += t; }
        if (tid < 32) { eb[tid] = s - p; if (tid == 31) eb[32] = s; }
    }
    __syncthreads();
}
__device__ __forceinline__ void route_pass_b(Frame& F, unsigned char* rt, gu32* cnt) {
    route_bases(F, cnt);
    LAS int* eb = (LAS int*)(F.lds + RTE_OFF + 512);
    const int* EID = (const int*)(rt + RT_EID); const int* POS = (const int*)(rt + RT_POS); const float* GATE = (const float*)(rt + RT_GATE);
    int* ROWTOK = (int*)(rt + RT_ROWTOK); float* ROWGATE = (float*)(rt + RT_ROWGATE); int* SLOT = (int*)(rt + RT_SLOT);
    const int gt = F.vcu * 512 + TID_, NGT = F.G * 512;
    for (int i = gt; i < 2 * T; i += NGT) { const int dst = eb[EID[i]] + POS[i]; ROWTOK[dst] = i >> 1; ROWGATE[dst] = GATE[i]; SLOT[i] = dst; }
    for (int i = gt; i < 32 * 256; i += NGT) { const int e = i >> 8, j = i & 255; const int c = (int)__hip_atomic_load(cnt + e, RLX_AGENT); const int pad = ((c + 255) & ~255) - c;
        if (j < pad) { ROWTOK[eb[e] + c + j] = 0; ROWGATE[eb[e] + c + j] = 0.f; } }
    __syncthreads();
}
struct MoeOrder {
    int G, c, ntiles; const LAS int* eb; const char* A; const char* W; size_t astep, wexp, wtile; bool gather;
    __device__ bool next(int i, pg8::Unit& u) const {
        const int L = i * G + c; if (L >= ntiles * 4) return false;
        u.pm = L >> 2; u.pn = L & 3; const int s0 = u.pm * 256; int e = 0;
#pragma unroll 1
        for (int j = 1; j < 32; ++j) if (eb[j] <= s0) e = j;
        e = __builtin_amdgcn_readfirstlane(e); u.aux = e; u.A = gather ? A : A + (size_t)u.pm * astep; u.B = W + (size_t)e * wexp + (size_t)u.pn * wtile; return true;
    }
};

constexpr int RTC = 32, RNCH = SEQ / RTC, RTOK = 352;
#define LBAR() do { asm volatile("s_waitcnt lgkmcnt(0)" ::: "memory"); __builtin_amdgcn_s_barrier(); asm volatile("" ::: "memory"); } while (0)
template <int CTRL> __device__ __forceinline__ float dpp_f(float v) { return __builtin_bit_cast(float, __builtin_amdgcn_update_dpp(0, __builtin_bit_cast(int, v), CTRL, 0xf, 0xf, true)); }
__device__ __forceinline__ float red16(float v) { v += dpp_f<0xB1>(v); v += dpp_f<0x4E>(v); v += dpp_f<0x141>(v); v += dpp_f<0x140>(v); return v; }
__device__ __forceinline__ float red8(float v) { v += dpp_f<0xB1>(v); v += dpp_f<0x4E>(v); v += dpp_f<0x141>(v); return v; }
__device__ __forceinline__ void unpack8(const v4u w, float (&f)[8]) { f[0] = bflo(w.x); f[1] = bfhi(w.x); f[2] = bflo(w.y); f[3] = bfhi(w.y); f[4] = bflo(w.z); f[5] = bfhi(w.z); f[6] = bflo(w.w); f[7] = bfhi(w.w); }
__device__ __forceinline__ void rwkv_scan_phase(Frame& F, const In& I, const bf16* R, const bf16* Kt, const bf16* V, const bf16* AA, const bf16* EW, bf16* Y) {
    LAS float* buf = (LAS float*)F.lds;
    LAS float* ybuf = (LAS float*)(F.lds + 2 * RTC * RTOK * 4) + 32;
    const int tid = TID_, lane = tid & 63;
    const int seg = lane & 15, rl = F.wave * 4 + (lane >> 4);
    const int stk = tid >> 4, ssg = tid & 15;
    for (int un = blockIdx.x; un < NB * 16 * 2; un += F.G) {
        const int half = un & 1, h = (un >> 1) & 15, b = un >> 5;
        const size_t rowb = (size_t)b * SEQ;
        const int col = h * 64 + ssg * 4;
        const f32x4 kkw = *(const f32x4*)(I.rwkv_kk + col), kaw = *(const f32x4*)(I.rwkv_ka + col);
        v2u rr, kr, vr, ar, er;
#define RAW_LOAD(cc) do { const size_t off = (rowb + (size_t)(cc) * RTC + stk) * 1024 + col; rr = *(const v2u*)(R + off); kr = *(const v2u*)(Kt + off); vr = *(const v2u*)(V + off); ar = *(const v2u*)(AA + off); er = *(const v2u*)(EW + off); } while (0)
#define RAW_CONVERT(cc) do { LAS float* tp = buf + ((cc) & 1) * (RTC * RTOK) + stk * RTOK + ssg * 4; \
            const float r0 = bflo(rr.x), r1 = bfhi(rr.x), r2 = bflo(rr.y), r3 = bfhi(rr.y), k0 = bflo(kr.x), k1 = bfhi(kr.x), k2 = bflo(kr.y), k3 = bfhi(kr.y); \
            const float a0 = bflo(ar.x), a1 = bfhi(ar.x), a2 = bflo(ar.y), a3 = bfhi(ar.y); \
            const float x0 = k0 * kkw.x, x1 = k1 * kkw.y, x2 = k2 * kkw.z, x3 = k3 * kkw.w; \
            const float ss = red16((x0 * x0 + x1 * x1) + (x2 * x2 + x3 * x3)); const float inv = __builtin_amdgcn_rsqf(fmaxf(ss, 1e-24f)); \
            *(LAS f32x4*)(tp) = (f32x4){__expf(-bflo(er.x)), __expf(-bfhi(er.x)), __expf(-bflo(er.y)), __expf(-bfhi(er.y))}; \
            const f32x4 kkv = (f32x4){x0 * inv, x1 * inv, x2 * inv, x3 * inv}; *(LAS f32x4*)(tp + 64) = kkv; \
            *(LAS f32x4*)(tp + 128) = (f32x4){kkv.x * a0, kkv.y * a1, kkv.z * a2, kkv.w * a3}; \
            *(LAS f32x4*)(tp + 192) = (f32x4){k0 * (1.0f + (a0 - 1.0f) * kaw.x), k1 * (1.0f + (a1 - 1.0f) * kaw.y), k2 * (1.0f + (a2 - 1.0f) * kaw.z), k3 * (1.0f + (a3 - 1.0f) * kaw.w)}; \
            *(LAS f32x4*)(tp + 256) = (f32x4){r0, r1, r2, r3}; \
            if ((ssg >> 3) == half) *(LAS f32x4*)(buf + ((cc) & 1) * (RTC * RTOK) + stk * RTOK + 320 + (ssg & 7) * 4) = (f32x4){bflo(vr.x), bfhi(vr.x), bflo(vr.y), bfhi(vr.y)}; } while (0)
#define Y_WRITE(cc) do { const LAS f32x2* yp = (const LAS f32x2*)(ybuf + ((cc) & 1) * (RTC * 32 + 32) + stk * 32 + ssg * 2); const f32x2 yv = *yp; \
            *(unsigned*)(Y + (rowb + (size_t)(cc) * RTC + stk) * 1024 + h * 64 + half * 32 + ssg * 2) = pk2(yv.x, yv.y); } while (0)
        RAW_LOAD(0); RAW_CONVERT(0); RAW_LOAD(1);
        f32x2 S0 = (f32x2){0.f, 0.f}, S1 = (f32x2){0.f, 0.f};
        LBAR();
        for (int c = 0; c < RNCH; ++c) {
            if (c + 1 < RNCH) { RAW_CONVERT(c + 1); }
            if (c + 2 < RNCH) { RAW_LOAD(c + 2); }
            if (c >= 1) { Y_WRITE(c - 1); }
            const LAS float* cb = buf + (c & 1) * (RTC * RTOK); LAS float* yb = ybuf + (c & 1) * (RTC * 32 + 32);
            const LAS float* tp0 = cb + seg * 4; const LAS float* vp0 = cb + 320 + rl;
#define SV_DECL(X) f32x4 X##w, X##q, X##b, X##k, X##r; float X##v
#define SV_LOAD(X, tk) do { const LAS float* tp = tp0 + (tk) * RTOK; \
                X##w = *(const LAS f32x4*)(tp); X##q = *(const LAS f32x4*)(tp + 64); X##b = *(const LAS f32x4*)(tp + 128); X##k = *(const LAS f32x4*)(tp + 192); X##r = *(const LAS f32x4*)(tp + 256); X##v = vp0[(tk) * RTOK]; } while (0)
#define SV_STEP(X, tk) do { \
                const f32x2 d = S0 * (f32x2){X##q.x, X##q.y} + S1 * (f32x2){X##q.z, X##q.w}; \
                const f32x2 t0 = S0 * (f32x2){X##w.x, X##w.y} + (f32x2){X##k.x, X##k.y} * X##v, t1 = S1 * (f32x2){X##w.z, X##w.w} + (f32x2){X##k.z, X##k.w} * X##v; \
                float ra = d.x + d.y, rb = epend;                   \
                ra += dpp_f<0xB1>(ra); rb += dpp_f<0xB1>(rb); ra += dpp_f<0x4E>(ra); rb += dpp_f<0x4E>(rb); ra += dpp_f<0x141>(ra); rb += dpp_f<0x141>(rb); ra += dpp_f<0x140>(ra); rb += dpp_f<0x140>(rb); \
                if (seg == 0) yb[((tk) - 1) * 32 + rl] = rb;        \
                const float sa = -ra; \
                S0 = t0 + (f32x2){X##b.x, X##b.y} * sa; S1 = t1 + (f32x2){X##b.z, X##b.w} * sa; \
                const f32x2 e = S0 * (f32x2){X##r.x, X##r.y} + S1 * (f32x2){X##r.z, X##r.w}; epend = e.x + e.y; } while (0)
            SV_DECL(A_); SV_DECL(B_); float epend = 0.f;
            SV_LOAD(A_, 0);
#pragma unroll 1
            for (int tk = 0; tk < RTC; tk += 2) {
                SV_LOAD(B_, tk + 1);
                SV_STEP(A_, tk);
                { const int t2 = (tk + 2 < RTC) ? tk + 2 : RTC - 1; SV_LOAD(A_, t2); }
                SV_STEP(B_, tk + 1);
            }
#undef SV_DECL
#undef SV_LOAD
#undef SV_STEP
            { const float rb = red16(epend); if (seg == 0) yb[(RTC - 1) * 32 + rl] = rb; }
            LBAR();
        }
        Y_WRITE(RNCH - 1);
        LBAR();
#undef RAW_LOAD
#undef RAW_CONVERT
#undef Y_WRITE
    }
}
constexpr int CS_SLOT = 13056, CS_TL = 12544, CS_QT = 0, CS_RT = 2048, CS_BHT = 4096, CS_KHT = 6144, CS_VT = 8192, CS_TM = 10240, CS_MK = 10752, CS_NK = 11264, CS_NB = 11776, CS_DD = 12288;
constexpr int CS_TMP0 = 8 * CS_SLOT, CS_TMP = 5120, CS_KT = 0, CS_BT = 2048, CS_MB = 4096;
template <int N> __device__ __forceinline__ float dpp_shr(float v) { return __builtin_bit_cast(float, __builtin_amdgcn_update_dpp(0, __builtin_bit_cast(int, v), 0x110 + N, 0xf, 0xf, true)); }
__device__ __forceinline__ bf16x8 mk8(v2u a, v2u b) { return __builtin_bit_cast(bf16x8, (v4u){a.x, a.y, b.x, b.y}); }
__device__ __forceinline__ bf16x8 mk8z(v2u a) { return __builtin_bit_cast(bf16x8, (v4u){a.x, a.y, 0u, 0u}); }
__device__ __forceinline__ bf16x8 cvt8z(f32x4 v) { return __builtin_bit_cast(bf16x8, (v4u){pk2(v.x, v.y), pk2(v.z, v.w), 0u, 0u}); }
__device__ __forceinline__ void rwkv_scan_chunked(Frame& F, const In& I, const bf16* R, const bf16* Kt, const bf16* V, const bf16* AA, const bf16* EW, bf16* Y) {
    const int lane = LANE_, fr = lane & 15, fq = lane >> 4;
    LAS unsigned char* L = F.lds;
    const f32x4 zero4 = (f32x4){0.f, 0.f, 0.f, 0.f};
    for (int un = blockIdx.x; un < NB * 16; un += F.G) {
        const int h = un & 15, b = un >> 4; const size_t rowb = (size_t)b * SEQ;
        if (F.wave >= 4) {
            const int p = F.wave - 4; const int colb = h * 64 + 16 * fq;
            LAS unsigned char* tmp = L + CS_TMP0 + p * CS_TMP;
            float kkw[16], kaw[16];
#pragma unroll
            for (int e = 0; e < 16; ++e) { kkw[e] = I.rwkv_kk[colb + e]; kaw[e] = I.rwkv_ka[colb + e]; }
            v4u raw[10];
#define CK_LOAD(cidx) do { const size_t off = (rowb + (size_t)(cidx) * 16 + fr) * 1024 + colb; \
                raw[0] = *(const v4u*)(R + off); raw[1] = *(const v4u*)(R + off + 8); raw[2] = *(const v4u*)(Kt + off); raw[3] = *(const v4u*)(Kt + off + 8); raw[4] = *(const v4u*)(V + off); raw[5] = *(const v4u*)(V + off + 8); \
                raw[6] = *(const v4u*)(AA + off); raw[7] = *(const v4u*)(AA + off + 8); raw[8] = *(const v4u*)(EW + off); raw[9] = *(const v4u*)(EW + off + 8); } while (0)
            CK_LOAD(p);
            for (int rd = -1; rd < 127; ++rd) {
                const int cidx = 4 * (rd + 1) + p; LAS unsigned char* S = L + (((rd + 1) & 1) * 4 + p) * CS_SLOT;
                float r[16], k[16], v[16], a[16], ew[16];
                { float t8[8];
                  unpack8(raw[0], t8);
#pragma unroll
                  for (int e = 0; e < 8; ++e) r[e] = t8[e];
                  unpack8(raw[1], t8);
#pragma unroll
                  for (int e = 0; e < 8; ++e) r[8 + e] = t8[e];
                  unpack8(raw[2], t8);
#pragma unroll
                  for (int e = 0; e < 8; ++e) k[e] = t8[e];
                  unpack8(raw[3], t8);
#pragma unroll
                  for (int e = 0; e < 8; ++e) k[8 + e] = t8[e];
                  unpack8(raw[4], t8);
#pragma unroll
                  for (int e = 0; e < 8; ++e) v[e] = t8[e];
                  unpack8(raw[5], t8);
#pragma unroll
                  for (int e = 0; e < 8; ++e) v[8 + e] = t8[e];
                  unpack8(raw[6], t8);
#pragma unroll
                  for (int e = 0; e < 8; ++e) a[e] = t8[e];
                  unpack8(raw[7], t8);
#pragma unroll
                  for (int e = 0; e < 8; ++e) a[8 + e] = t8[e];
                  unpack8(raw[8], t8);
#pragma unroll
                  for (int e = 0; e < 8; ++e) ew[e] = t8[e];
                  unpack8(raw[9], t8);
#pragma unroll
                  for (int e = 0; e < 8; ++e) ew[8 + e] = t8[e]; }
                if (cidx + 4 < 512) CK_LOAD(cidx + 4);
                float kx[16], ss = 0.f;
#pragma unroll
                for (int e = 0; e < 16; ++e) { kx[e] = k[e] * kkw[e]; ss += kx[e] * kx[e]; }
                ss += __shfl_xor(ss, 16); ss += __shfl_xor(ss, 32);
                const float inv = __builtin_amdgcn_rsqf(fmaxf(ss, 1e-24f));
                unsigned qtw[8], rtw[8], ktw[8], btw[8];
#pragma unroll
                for (int e = 0; e < 16; e += 2) { float q2[2], r2[2], k2[2], b2[2];
#pragma unroll
                    for (int z = 0; z < 2; ++z) { const int ee = e + z;
                        float li = -ew[ee]; li += dpp_shr<1>(li); li += dpp_shr<2>(li); li += dpp_shr<4>(li); li += dpp_shr<8>(li);
                        const float l15 = __shfl(li, (lane & 48) | 15);
                        const float E1 = __builtin_amdgcn_exp2f(1.4426950408889634f * li), W1 = __builtin_amdgcn_exp2f(1.4426950408889634f * ew[ee]), E15 = __builtin_amdgcn_exp2f(1.4426950408889634f * l15);
                        const float Einv = __builtin_amdgcn_rcpf(E1);
                        const float kk = kx[ee] * inv, bb = a[ee] * kk, kp = k[ee] * (1.0f + (a[ee] - 1.0f) * kaw[ee]);
                        q2[z] = kk * (E1 * W1); k2[z] = kp * Einv; b2[z] = bb * Einv; r2[z] = r[ee] * E1;
                        const float eh = E15 * Einv; const int key = 16 * fq + ee;
                        ((LAS bf16*)(S + CS_BHT))[key * 16 + fr] = (bf16)f2bf(bb * eh); ((LAS bf16*)(S + CS_KHT))[key * 16 + fr] = (bf16)f2bf(kp * eh); ((LAS bf16*)(S + CS_VT))[key * 16 + fr] = (bf16)f2bf(v[ee]);
                        if (fr == 15) ((LAS float*)(S + CS_DD))[key] = E15; }
                    qtw[e >> 1] = pk2(q2[0], q2[1]); rtw[e >> 1] = pk2(r2[0], r2[1]); ktw[e >> 1] = pk2(k2[0], k2[1]); btw[e >> 1] = pk2(b2[0], b2[1]); }
                { const int o = (fr * 64 + 16 * fq) * 2;
                  *(LAS v4u*)(S + CS_QT + o) = (v4u){qtw[0], qtw[1], qtw[2], qtw[3]}; *(LAS v4u*)(S + CS_QT + o + 16) = (v4u){qtw[4], qtw[5], qtw[6], qtw[7]};
                  *(LAS v4u*)(S + CS_RT + o) = (v4u){rtw[0], rtw[1], rtw[2], rtw[3]}; *(LAS v4u*)(S + CS_RT + o + 16) = (v4u){rtw[4], rtw[5], rtw[6], rtw[7]};
                  *(LAS v4u*)(tmp + CS_KT + o) = (v4u){ktw[0], ktw[1], ktw[2], ktw[3]}; *(LAS v4u*)(tmp + CS_KT + o + 16) = (v4u){ktw[4], ktw[5], ktw[6], ktw[7]};
                  *(LAS v4u*)(tmp + CS_BT + o) = (v4u){btw[0], btw[1], btw[2], btw[3]}; *(LAS v4u*)(tmp + CS_BT + o + 16) = (v4u){btw[4], btw[5], btw[6], btw[7]}; }
                asm volatile("s_waitcnt lgkmcnt(0)" ::: "memory");
                f32x4 mb = zero4, mk = zero4, nb = zero4, nk = zero4;
#pragma unroll
                for (int kh = 0; kh < 2; ++kh) { const int o = (fr * 64 + 32 * kh + 8 * fq) * 2;
                    const bf16x8 Qf = *(const LAS bf16x8*)(S + CS_QT + o), Rf = *(const LAS bf16x8*)(S + CS_RT + o), Kf = *(const LAS bf16x8*)(tmp + CS_KT + o), Bf = *(const LAS bf16x8*)(tmp + CS_BT + o);
                    mb = __builtin_amdgcn_mfma_f32_16x16x32_bf16(Qf, Bf, mb, 0, 0, 0); mk = __builtin_amdgcn_mfma_f32_16x16x32_bf16(Qf, Kf, mk, 0, 0, 0);
                    nb = __builtin_amdgcn_mfma_f32_16x16x32_bf16(Rf, Bf, nb, 0, 0, 0); nk = __builtin_amdgcn_mfma_f32_16x16x32_bf16(Rf, Kf, nk, 0, 0, 0); }
#pragma unroll
                for (int e = 0; e < 4; ++e) { const int tt = 4 * fq + e; const bool lo = fr < tt, le = fr <= tt;
                    ((LAS float*)(tmp + CS_MB))[tt * 16 + fr] = lo ? mb[e] : 0.f;
                    ((LAS bf16*)(S + CS_MK))[tt * 16 + fr] = (bf16)f2bf(lo ? mk[e] : 0.f); ((LAS bf16*)(S + CS_NK))[tt * 16 + fr] = (bf16)f2bf(le ? nk[e] : 0.f); ((LAS bf16*)(S + CS_NB))[tt * 16 + fr] = (bf16)f2bf(le ? nb[e] : 0.f); }
                asm volatile("s_waitcnt lgkmcnt(0)" ::: "memory");
                { float Tc[16];
#pragma unroll
                  for (int t = 0; t < 16; ++t) { const LAS f32x4* mrow = (const LAS f32x4*)(tmp + CS_MB + t * 64); float acc = (t == fr) ? 1.0f : 0.0f;
#pragma unroll
                      for (int s4 = 0; s4 < 4; ++s4) { if (4 * s4 < t) { const f32x4 m4 = mrow[s4];
#pragma unroll
                              for (int z = 0; z < 4; ++z) if (4 * s4 + z < t) acc -= m4[z] * Tc[4 * s4 + z]; } }
                      Tc[t] = acc; }
                  if (fq == 0) {
#pragma unroll
                      for (int t = 0; t < 16; ++t) { const unsigned hi = f2bf(Tc[t]); ((LAS bf16*)(S + CS_TM))[t * 16 + fr] = (bf16)hi; ((LAS bf16*)(S + CS_TL))[t * 16 + fr] = (bf16)f2bf(Tc[t] - __uint_as_float(hi << 16)); } } }
                LBAR();
            }
            LBAR();
#undef CK_LOAD
        } else {
            const int vt = F.wave;
            f32x4 Areg[4];
#pragma unroll
            for (int jt = 0; jt < 4; ++jt) Areg[jt] = zero4;
            LBAR();
            for (int rd = 0; rd < 128; ++rd) {
#pragma unroll 1
                for (int q = 0; q < 4; ++q) {
                    const LAS unsigned char* S = L + ((rd & 1) * 4 + q) * CS_SLOT; const size_t row0 = rowb + (size_t)(4 * rd + q) * 16;
                    bf16x8 Aq[2];
#pragma unroll
                    for (int kh = 0; kh < 2; ++kh) Aq[kh] = __builtin_bit_cast(bf16x8, (v4u){pk2(Areg[2 * kh].x, Areg[2 * kh].y), pk2(Areg[2 * kh].z, Areg[2 * kh].w), pk2(Areg[2 * kh + 1].x, Areg[2 * kh + 1].y), pk2(Areg[2 * kh + 1].z, Areg[2 * kh + 1].w)});
                    f32x4 X = zero4, YA = zero4;
#pragma unroll
                    for (int kh = 0; kh < 2; ++kh) { const int o = (fr * 64 + 32 * kh + 4 * fq) * 2;
                        const bf16x8 Pq = mk8(*(const LAS v2u*)(S + CS_QT + o), *(const LAS v2u*)(S + CS_QT + o + 32)), Pr = mk8(*(const LAS v2u*)(S + CS_RT + o), *(const LAS v2u*)(S + CS_RT + o + 32));
                        X = __builtin_amdgcn_mfma_f32_16x16x32_bf16(Pq, Aq[kh], X, 0, 0, 0); YA = __builtin_amdgcn_mfma_f32_16x16x32_bf16(Pr, Aq[kh], YA, 0, 0, 0); }
                    const bf16x8 Vq = mk8z(*(const LAS v2u*)(S + CS_VT + ((16 * vt + fr) * 16 + 4 * fq) * 2));
                    const int om = (fr * 16 + 4 * fq) * 2;
                    const bf16x8 Mkp = mk8z(*(const LAS v2u*)(S + CS_MK + om)), Nkp = mk8z(*(const LAS v2u*)(S + CS_NK + om)), Nbp = mk8z(*(const LAS v2u*)(S + CS_NB + om)), Tp = mk8z(*(const LAS v2u*)(S + CS_TM + om));
                    const f32x4 Z = __builtin_amdgcn_mfma_f32_16x16x32_bf16(Mkp, Vq, X, 0, 0, 0);
                    const bf16x8 Tl = mk8z(*(const LAS v2u*)(S + CS_TL + om));
                    f32x4 Zh, Zl;
#pragma unroll
                    for (int e = 0; e < 4; ++e) { Zh[e] = __uint_as_float(f2bf(Z[e]) << 16); Zl[e] = Z[e] - Zh[e]; }
                    f32x4 U = __builtin_amdgcn_mfma_f32_16x16x32_bf16(Tp, cvt8z(Zl), zero4, 0, 0, 0);
                    U = __builtin_amdgcn_mfma_f32_16x16x32_bf16(Tl, cvt8z(Zh), U, 0, 0, 0);
                    U = __builtin_amdgcn_mfma_f32_16x16x32_bf16(Tp, cvt8z(Zh), U, 0, 0, 0);
                    const bf16x8 Uq = cvt8z(U);
                    f32x4 Yv = __builtin_amdgcn_mfma_f32_16x16x32_bf16(Nkp, Vq, YA, 0, 0, 0);
                    const f32x4 Yn = __builtin_amdgcn_mfma_f32_16x16x32_bf16(Nbp, Uq, zero4, 0, 0, 0);
                    Yv = Yv - Yn;
#pragma unroll
                    for (int e = 0; e < 4; ++e) Y[(row0 + 4 * fq + e) * 1024 + h * 64 + 16 * vt + fr] = (bf16)f2bf(Yv[e]);
#pragma unroll
                    for (int jt = 0; jt < 4; ++jt) { const int ok = ((16 * jt + fr) * 16 + 4 * fq) * 2;
                        const bf16x8 Khp = mk8z(*(const LAS v2u*)(S + CS_KHT + ok)), Bhp = mk8z(*(const LAS v2u*)(S + CS_BHT + ok));
                        const f32x4 Dv = *(const LAS f32x4*)(S + CS_DD + (16 * jt + 4 * fq) * 4);
                        f32x4 acc = Dv * Areg[jt];
                        acc = __builtin_amdgcn_mfma_f32_16x16x32_bf16(Khp, Vq, acc, 0, 0, 0);
                        const f32x4 nbu = __builtin_amdgcn_mfma_f32_16x16x32_bf16(Bhp, Uq, zero4, 0, 0, 0);
                        Areg[jt] = acc - nbu; }
                }
                LBAR();
            }
        }
    }
}
__device__ __forceinline__ void rwkv_post_pass(Frame& F, const In& I, const bf16* R, const bf16* Kt, const bf16* V, const bf16* AA, const bf16* G, bf16* Y) {
    const int gw = F.vcu * NWAVES + F.wave, NGW = F.G * NWAVES; const int col = LANE_ * 16;
    for (int t0 = 2 * gw; t0 < T; t0 += 2 * NGW) {
        v4u py[2][2], pr[2][2], pk[2][2], pv[2][2], pa[2][2], pg[2][2];
#pragma unroll
        for (int rw = 0; rw < 2; ++rw) { const size_t off = (size_t)(t0 + rw) * 1024 + col;
#pragma unroll
            for (int hf = 0; hf < 2; ++hf) { py[rw][hf] = *(const v4u*)(Y + off + hf * 8); pr[rw][hf] = *(const v4u*)(R + off + hf * 8); pk[rw][hf] = *(const v4u*)(Kt + off + hf * 8);
                pv[rw][hf] = *(const v4u*)(V + off + hf * 8); pa[rw][hf] = *(const v4u*)(AA + off + hf * 8); pg[rw][hf] = *(const v4u*)(G + off + hf * 8); } }
#pragma unroll
        for (int rw = 0; rw < 2; ++rw) { const size_t off = (size_t)(t0 + rw) * 1024 + col;
            float kaw[16], rkw[16], lng[16], lnb[16];
#pragma unroll
            for (int e4 = 0; e4 < 4; ++e4) { const f32x4 c0 = *(const GAS f32x4*)(I.rwkv_ka + col + 4 * e4), c1 = *(const GAS f32x4*)(I.rwkv_rk + col + 4 * e4), c2 = *(const GAS f32x4*)(I.rwkv_ln_g + col + 4 * e4), c3 = *(const GAS f32x4*)(I.rwkv_ln_b + col + 4 * e4);
#pragma unroll
                for (int e = 0; e < 4; ++e) { kaw[4 * e4 + e] = c0[e]; rkw[4 * e4 + e] = c1[e]; lng[4 * e4 + e] = c2[e]; lnb[4 * e4 + e] = c3[e]; } }
            float y[16], r[16], k[16], v[16], a[16], g[16];
#pragma unroll
            for (int hf = 0; hf < 2; ++hf) { float t8[8];
                unpack8(py[rw][hf], t8);
#pragma unroll
                for (int e = 0; e < 8; ++e) y[hf * 8 + e] = t8[e];
                unpack8(pr[rw][hf], t8);
#pragma unroll
                for (int e = 0; e < 8; ++e) r[hf * 8 + e] = t8[e];
                unpack8(pk[rw][hf], t8);
#pragma unroll
                for (int e = 0; e < 8; ++e) k[hf * 8 + e] = t8[e];
                unpack8(pv[rw][hf], t8);
#pragma unroll
                for (int e = 0; e < 8; ++e) v[hf * 8 + e] = t8[e];
                unpack8(pa[rw][hf], t8);
#pragma unroll
                for (int e = 0; e < 8; ++e) a[hf * 8 + e] = t8[e];
                unpack8(pg[rw][hf], t8);
#pragma unroll
                for (int e = 0; e < 8; ++e) g[hf * 8 + e] = t8[e]; }
            float s = 0.f, bs = 0.f;
#pragma unroll
            for (int e = 0; e < 16; ++e) { s += y[e]; const float kp = k[e] * (1.0f + (a[e] - 1.0f) * kaw[e]); bs += r[e] * kp * rkw[e]; }
            s += __shfl_xor(s, 1); s += __shfl_xor(s, 2); bs += __shfl_xor(bs, 1); bs += __shfl_xor(bs, 2);
            const float mean = s * (1.0f / 64.0f); float q = 0.f;
#pragma unroll
            for (int e = 0; e < 16; ++e) { const float dd = y[e] - mean; q += dd * dd; }
            q += __shfl_xor(q, 1); q += __shfl_xor(q, 2);
            const float rstd = 1.0f / sqrtf(q * (1.0f / 64.0f) + 64e-5f);
            float o[16];
#pragma unroll
            for (int e = 0; e < 16; ++e) o[e] = ((y[e] - mean) * rstd * lng[e] + lnb[e] + bs * v[e]) * g[e];
            v4u w0, w1; w0.x = pk2(o[0], o[1]); w0.y = pk2(o[2], o[3]); w0.z = pk2(o[4], o[5]); w0.w = pk2(o[6], o[7]); w1.x = pk2(o[8], o[9]); w1.y = pk2(o[10], o[11]); w1.z = pk2(o[12], o[13]); w1.w = pk2(o[14], o[15]);
            *(v4u*)(Y + off) = w0; *(v4u*)(Y + off + 8) = w1; }
    }
}

#ifndef DUP_K
#define DUP_K (-1)
#endif
#ifndef DUP_K2
#define DUP_K2 (-1)
#endif
#define KARGS ((const __attribute__((address_space(4))) Args*)__builtin_amdgcn_kernarg_segment_ptr())
#define WSPTRS \
    bf16* H0 = (bf16*)(ws + WS_H0); bf16* QKV = (bf16*)(ws + WS_QKV); bf16* OB = (bf16*)(ws + WS_O); f32x2* AGG = (f32x2*)(ws + WS_LRUAGG); \
    bf16* H2 = (bf16*)(ws + WS_H2); float* LOG = (float*)(ws + WS_LOG); unsigned char* RTE = ws + WS_ROUTE; bf16* HID = (bf16*)(ws + WS_HID); bf16* YS = (bf16*)(ws + WS_YS); bf16* PP = (bf16*)(ws + WS_PP); \
    bf16* HCAT = (bf16*)(ws + WS_HCAT); bf16* RB = (bf16*)(ws + WS_R); bf16* KB = (bf16*)(ws + WS_K); bf16* VB = (bf16*)(ws + WS_V); bf16* XRB = (bf16*)(ws + WS_XR); bf16* XKB = (bf16*)(ws + WS_XK); bf16* XVB = (bf16*)(ws + WS_XV); bf16* MID = (bf16*)(ws + WS_MID); bf16* EWB = (bf16*)(ws + WS_EW); bf16* AAB = (bf16*)(ws + WS_AA); bf16* YB = (bf16*)(ws + WS_Y); \
    const size_t TD = (size_t)T * 1024; (void)H0; (void)QKV; (void)OB; (void)AGG; (void)H2; (void)LOG; (void)RTE; (void)HID; (void)YS; (void)PP; (void)HCAT; (void)RB; (void)KB; (void)VB; (void)XRB; (void)XKB; (void)XVB; (void)MID; (void)EWB; (void)AAB; (void)YB; (void)TD;

struct Args { In in; float* out; unsigned char* ws; int ph_lo, ph_hi; };
constexpr int N_PHASES = 34;
__device__ __forceinline__ int nrep(int k) { int n = (k == DUP_K) ? 2 : 1; if (DUP_K >= 0) asm volatile("" : "+s"(n)); return n; }
#define REP_SYNC if (rep_) __syncthreads();
typedef const __attribute__((address_space(4))) unsigned long long* kp64;
__device__ __forceinline__ void load_in(In& I) { kp64 s = (kp64)__builtin_amdgcn_kernarg_segment_ptr(); unsigned long long* d = (unsigned long long*)&I;
#pragma unroll
    for (int i = 0; i < 47; ++i) d[i] = s[i]; }

__device__ __forceinline__ int t5_bucket(int n) { if (n < 16) return n; const float v = logf((float)n / 16.0f) / 2.0794415416798357f * 16.0f; const int l = 16 + (int)v; return l < 31 ? l : 31; }

template <class Epi>
__device__ __forceinline__ void dense_gemm(Frame& F, const void* A, int lda, const void* B, int K, int M, int N, const Epi& E) {
    pg8::DenseOrder S; S.init(A, lda, B, K, M, N, F.G, (int)blockIdx.x);
    pg8::gemm_phase<Epi, pg8::DenseOrder, true, false>(F.lds, K, lda, S, E, nullptr, TID_);
}

__global__ void __launch_bounds__(NWAVES * 64, 2) mk_fwd(Args args) {
    extern __shared__ __attribute__((aligned(16))) unsigned char lds[];
    Frame F;
    F.lds = (LAS unsigned char*)lds;
    F.MISC = (volatile LAS unsigned*)(F.lds + MISC_OFF);
    { int w_ = __builtin_amdgcn_readfirstlane((int)threadIdx.x >> 6); asm volatile("" : "+s"(w_)); F.wave = w_; }
    F.G = gridDim.x; { const int bx = blockIdx.x; F.vcu = (F.G % 8 == 0) ? (bx % 8) * (F.G / 8) + bx / 8 : bx; }
    F.ctl = (gu32*)(KARGS->ws + WS_CTL);
    for (int u = TID_; u < (LDS_BYTES - LDSCTL_OFF) / 4; u += NWAVES * 64) ((LAS unsigned*)(F.lds + LDSCTL_OFF))[u] = 0u;
    __syncthreads();
    {
        LAS float* tb = (LAS float*)(F.lds + TB_OFF); const int h = TID_ >> 7, i = TID_ & 127;
        const float* rb = KARGS->in.rel_bias;
        tb[h * 128 + i] = (rb[t5_bucket(i) * 4 + h] - rb[31 * 4 + h]) * 1.4426950408889634f;
    }
    __syncthreads();
    const int lo = KARGS->ph_lo, hi = KARGS->ph_hi;
    const bool multi = (hi - lo) > 1;
    XcdBarrier bar; bar.bar = (unsigned*)(F.ctl + CW_BAR); bar.x = 0; bar.st = nullptr;
    if (multi) bar = xcd_barrier_post((unsigned*)(F.ctl + CW_BAR), F.MISC + 8, TID_ == 0);
#define IN(k) (lo <= (k) && (k) < hi)
#define PH_BEGIN_ unsigned char* ws = KARGS->ws; bf16* X = (bf16*)KARGS->out; float* OUT = KARGS->out; (void)OUT; bf16* GB2 = (bf16*)KARGS->out + (size_t)T * 1024; (void)GB2; In I; load_in(I); (void)X; WSPTRS
#define SEAM(k) do { if (IN(k) && IN((k) + 1)) xcd_barrier(bar, TID_ == 0); } while (0)

    if (IN(0)) { PH_BEGIN_ prep_dense_weights(F, I, ws); prep_layer_weights(F, I, ws, 0); norm_pass<false>(F, I.x, I.norm_mix, H0);
#ifdef DUP_PREP
        __syncthreads(); prep_dense_weights(F, I, ws); prep_layer_weights(F, I, ws, 0);
#endif
    } SEAM(0);
    if (IN(1)) { PH_BEGIN_ pg8::EpiBf16 E{QKV, 512, 512, (size_t)T * 512, attn_body::C2}; dense_gemm(F, H0, 1024, ws + WS_WIN, 1024, T, AB_IN, E); } SEAM(1);
    if (IN(2)) { PH_BEGIN_ lru_agg_mfma(F, I, QKV + 3 * (size_t)T * 512, AGG, (bf16*)(ws + WS_HL), (bf16*)(ws + WS_CA)); } SEAM(2);
    if (IN(3)) { PH_BEGIN_
        const attn_body::AttnTensors AT{(const attn_body::bf16*)QKV, (const attn_body::bf16*)(QKV + (size_t)T * 512), (const attn_body::bf16*)(QKV + 2 * (size_t)T * 512), (attn_body::bf16*)OB};
        if (F.G == 256) attn_body::attn_phase<8>((char*)lds, AT, F.vcu, (const LAS float*)(F.lds + TB_OFF), (int)threadIdx.x);
#ifdef DUP_ATTN
        __syncthreads(); if (F.G == 256) attn_body::attn_phase<8>((char*)lds, AT, F.vcu, (const LAS float*)(F.lds + TB_OFF), (int)threadIdx.x);
#endif
        __syncthreads();
        lru_final_pass(F, (const bf16*)(ws + WS_HL), (const bf16*)(ws + WS_CA), QKV + 4 * (size_t)T * 512, AGG, H0);
    } SEAM(3);
    if (IN(4)) { PH_BEGIN_ diff_combine_pass(F, I, OB, H0); } SEAM(4);
    if (IN(5)) { PH_BEGIN_ pg8::EpiResX<false> E{I.x, X}; dense_gemm(F, H0, 1024, ws + WS_WOUT, 1024, T, 1024, E); } SEAM(5);

#define MOE_PLE_PHASES(P, L) \
    if (IN(P + 0)) { PH_BEGIN_ norm_pass<true>(F, X, I.norm_ffn + (L) * 1024, H2); } SEAM(P + 0); \
    if (IN(P + 1)) { PH_BEGIN_ pg8::EpiRouter E{LOG}; dense_gemm(F, H2, 1024, ws + WS_ROUT + (size_t)(L) * 256 * 1024 * 2, 1024, T, 256, E); } SEAM(P + 1); \
    if (IN(P + 2)) { PH_BEGIN_ route_pass_a(F, I, (L), LOG, RTE, F.ctl + ((L) ? CW_CNT1 : CW_CNT0)); } SEAM(P + 2); \
    if (IN(P + 3)) { PH_BEGIN_ route_pass_b(F, RTE, F.ctl + ((L) ? CW_CNT1 : CW_CNT0)); } SEAM(P + 3); \
    if (IN(P + 4)) { PH_BEGIN_ route_bases(F, F.ctl + ((L) ? CW_CNT1 : CW_CNT0)); const LAS int* eb = (const LAS int*)(F.lds + RTE_OFF + 512); \
        MoeOrder S{F.G, (int)blockIdx.x, __builtin_amdgcn_readfirstlane(eb[32] >> 8), eb, (const char*)H2, (const char*)(ws + WS_MGU), 0, (size_t)1024 * 1024 * 2, (size_t)256 * 1024 * 2, true}; pg8::EpiGU E{HID}; \
        pg8::gemm_phase<pg8::EpiGU, MoeOrder, true, true>(F.lds, 1024, 1024, S, E, (const int*)(RTE + RT_ROWTOK), TID_); } SEAM(P + 4); \
    if (IN(P + 5)) { PH_BEGIN_ route_bases(F, F.ctl + ((L) ? CW_CNT1 : CW_CNT0)); const LAS int* eb = (const LAS int*)(F.lds + RTE_OFF + 512); \
        MoeOrder S{F.G, (int)blockIdx.x, __builtin_amdgcn_readfirstlane(eb[32] >> 8), eb, (const char*)HID, (const char*)(ws + WS_MDN), (size_t)256 * 512 * 2, (size_t)1024 * 512 * 2, (size_t)256 * 512 * 2, false}; pg8::EpiDown E{YS, (const float*)(RTE + RT_ROWGATE)}; \
        pg8::gemm_phase<pg8::EpiDown, MoeOrder, true, false>(F.lds, 512, 512, S, E, nullptr, TID_); } SEAM(P + 5); \
    if (IN(P + 6)) { PH_BEGIN_ combine_norm_pass(F, X, X, YS, (const int*)(RTE + RT_SLOT), I.ple_norm + (L) * 1024, H2); } SEAM(P + 6); \
    if (IN(P + 7)) { PH_BEGIN_ pg8::EpiBf16 E{PP, 1024, 0, 0, 1.f}; dense_gemm(F, ws + WS_PB, 256, ws + WS_PPROJ + (size_t)(L) * 1024 * 256 * 2, 256, T, 1024, E); } SEAM(P + 7); \
    if (IN(P + 8)) { PH_BEGIN_ pg8::EpiPle E{X, (L) ? (bf16*)(ws + WS_YS) : X, PP}; dense_gemm(F, H2, 1024, ws + WS_PGATE + (size_t)(L) * 1024 * 1024 * 2, 1024, T, 1024, E); } SEAM(P + 8);

    MOE_PLE_PHASES(6, 0)
    if (IN(15)) { PH_BEGIN_ rwkv_input_pass(F, X, I.norm_mix + 1024, I.rwkv_mu, HCAT, XRB, XKB, XVB); } SEAM(15);
    if (IN(16)) { PH_BEGIN_ { pg8::EpiBf16 E{RB, 1024, 0, 0, 1.f}; dense_gemm(F, XRB, 1024, ws + WS_RCAT, 1024, T, 1024, E); }
        { pg8::EpiMid E{MID}; dense_gemm(F, HCAT, 2048, ws + WS_RL1, 2048, T, 512, E); } } SEAM(16);
    if (IN(17)) { PH_BEGIN_ pg8::EpiBf16 E{KB, 1024, 0, 0, 1.f}; dense_gemm(F, XKB, 1024, ws + WS_RCAT + (size_t)1024 * 1024 * 2, 1024, T, 1024, E); } SEAM(17);
    if (IN(18)) { PH_BEGIN_ pg8::EpiBf16 E{VB, 1024, 0, 0, 1.f}; dense_gemm(F, XVB, 1024, ws + WS_RCAT + (size_t)2 * 1024 * 1024 * 2, 1024, T, 1024, E); } SEAM(18);
    if (IN(19)) { PH_BEGIN_ pg8::EpiRwkv2 E{EWB, AAB, I.rwkv_w0, I.rwkv_a0, 0}; dense_gemm(F, MID, 512, ws + WS_RS2, 256, T, 2048, E); } SEAM(19);
    if (IN(20)) { PH_BEGIN_
        if (F.G == 256 && blockIdx.x >= 128) {
            Frame F2 = F; F2.G = 128; F2.vcu = (int)blockIdx.x - 128;
            prep_layer_weights(F2, I, ws, 1);
            __syncthreads();
            pg8::EpiRwkv2 E{GB2, GB2, nullptr, nullptr, 2}; pg8::DenseOrder S; S.init(MID + 256, 512, ws + WS_RS2 + (size_t)2 * 1024 * 256 * 2, 256, T, 1024, 128, (int)blockIdx.x - 128);
            pg8::gemm_phase<pg8::EpiRwkv2, pg8::DenseOrder, true, false>(F.lds, 256, 512, S, E, nullptr, TID_);
        } else rwkv_scan_chunked(F, I, RB, KB, VB, AAB, EWB, YB);
    } SEAM(20);
    if (IN(21)) { } SEAM(21);
    if (IN(22)) { PH_BEGIN_ rwkv_post_pass(F, I, RB, KB, VB, AAB, GB2, YB); } SEAM(22);
    if (IN(23)) { PH_BEGIN_ pg8::EpiResX<true> E{X, X}; dense_gemm(F, YB, 1024, ws + WS_RWO, 1024, T, 1024, E); } SEAM(23);
    MOE_PLE_PHASES(24, 1)
    if (IN(33)) { PH_BEGIN_ final_norm_pass(F, (const bf16*)(ws + WS_YS), OUT, I.final_norm); }
#undef IN
#undef SEAM
}

extern "C" void kernel_launch(void* const* d_in, const int* in_sizes, int n_in, void* d_out, int out_size, void* d_ws, size_t ws_size, hipStream_t stream) {
    static int ok = 0;
    if (ok == 0) {
        if (n_in != 47 || out_size != T * D || ws_size < WS_END) { fprintf(stderr, "kernel_launch: unexpected problem shape (n_in %d out %d ws %zu)\n", n_in, out_size, ws_size); ok = -1; return; }
        if (hipFuncSetAttribute((const void*)mk_fwd, hipFuncAttributeMaxDynamicSharedMemorySize, LDS_BYTES) != hipSuccess) { fprintf(stderr, "kernel_launch: hipFuncSetAttribute failed\n"); ok = -1; return; }
        int per_cu = 0;
        if (hipOccupancyMaxActiveBlocksPerMultiprocessor(&per_cu, (const void*)mk_fwd, NWAVES * 64, LDS_BYTES) != hipSuccess || per_cu < 1) fprintf(stderr, "kernel_launch: occupancy query reports %d\n", per_cu);
        (void)hipGetLastError();
        ok = 1;
    }
    if (ok < 0) return;
    (void)hipMemsetAsync((char*)d_ws + WS_CTL, 0, CTL_ZERO_BYTES, stream);
    Args a{};
    const float** ip = (const float**)&a.in;
    for (int i = 0; i < 47; ++i) ip[i] = (const float*)d_in[i];
    a.out = (float*)d_out; a.ws = (unsigned char*)d_ws;
    const int grid = 256;
#if MK_ONE_LAUNCH
    a.ph_lo = 0; a.ph_hi = N_PHASES;
    hipLaunchKernelGGL(mk_fwd, dim3(grid), dim3(NWAVES * 64), LDS_BYTES, stream, a);
#else
    for (int k = 0; k < N_PHASES; ++k) { a.ph_lo = k; a.ph_hi = k + 1; hipLaunchKernelGGL(mk_fwd, dim3(grid), dim3(NWAVES * 64), LDS_BYTES, stream, a);
        if (k == DUP_K || k == DUP_K2) hipLaunchKernelGGL(mk_fwd, dim3(grid), dim3(NWAVES * 64), LDS_BYTES, stream, a); }
#endif
}
```

```cpp
#include <hip/hip_runtime.h>
#include <hip/hip_bf16.h>
#include <cstdio>
#include <cstdint>
#include <cmath>

#ifndef MK_ONE_LAUNCH
#define MK_ONE_LAUNCH 1
#endif

#define GAS __attribute__((address_space(1)))
#define LAS __attribute__((address_space(3)))
typedef unsigned short bf16;
typedef unsigned v4u __attribute__((ext_vector_type(4)));
typedef unsigned v2u __attribute__((ext_vector_type(2)));
typedef float f32x4 __attribute__((ext_vector_type(4)));
typedef float f32x2 __attribute__((ext_vector_type(2)));
typedef short bf16x8 __attribute__((ext_vector_type(8)));
typedef GAS unsigned gu32;
#define RLX_AGENT __ATOMIC_RELAXED, __HIP_MEMORY_SCOPE_AGENT
#define LDS_WAIT() asm volatile("s_waitcnt lgkmcnt(0)" ::: "memory")
#define VM_WAIT() asm volatile("s_waitcnt vmcnt(0)" ::: "memory")
__device__ __forceinline__ unsigned f2bf(float f) { unsigned u = __builtin_bit_cast(unsigned, f); return (u + 0x7fffu + ((u >> 16) & 1u)) >> 16; }
typedef float f32x2_cv __attribute__((ext_vector_type(2))); typedef __bf16 bf16x2_cv __attribute__((ext_vector_type(2)));
__device__ __forceinline__ unsigned pk2(float lo, float hi) { const f32x2_cv v = {lo, hi}; const bf16x2_cv b = __builtin_convertvector(v, bf16x2_cv); return __builtin_bit_cast(unsigned, b); }
__device__ __forceinline__ float bflo(unsigned w) { return __uint_as_float(w << 16); }
__device__ __forceinline__ float bfhi(unsigned w) { return __uint_as_float(w & 0xffff0000u); }
__device__ __forceinline__ float bf1(bf16 h) { return __uint_as_float((unsigned)h << 16); }
__device__ __forceinline__ float sigmoidf_(float x) { return __builtin_amdgcn_rcpf(1.0f + __builtin_amdgcn_exp2f(-1.4426950408889634f * x)); }
__device__ __forceinline__ float tanhf_(float x) { return 1.0f - 2.0f * __builtin_amdgcn_rcpf(1.0f + __builtin_amdgcn_exp2f(2.885390081777927f * x)); }
__device__ __forceinline__ void fmac_(float& acc, float a, float b) { asm("v_fmac_f32 %0, %1, %2" : "+v"(acc) : "v"(a), "v"(b)); }
__device__ __forceinline__ float fma_(float a, float b, float c) { float r; asm("v_fma_f32 %0, %1, %2, %3" : "=v"(r) : "v"(a), "v"(b), "v"(c)); return r; }
__device__ __forceinline__ float mul_(float a, float b) { float r; asm("v_mul_f32 %0, %1, %2" : "=v"(r) : "v"(a), "v"(b)); return r; }
__device__ __forceinline__ float wave_sum(float v) {
#pragma unroll
    for (int o = 1; o < 64; o <<= 1) v += __shfl_xor(v, o);
    return v;
}

constexpr int NB = 8, SEQ = 8192, D = 1024, T = NB * SEQ;
constexpr int AB_IN = 2560, PLE = 256;
constexpr int NEXP = 32, EH = 512;
constexpr int MAXSLOT = 2 * T + NEXP * 256;
constexpr int MAXTILES = MAXSLOT / 256;

namespace pg8 {
#define PG8_LAS __attribute__((address_space(3)))
typedef unsigned short bf16_t;
typedef unsigned u32x4 __attribute__((ext_vector_type(4)));
typedef unsigned u32x2 __attribute__((ext_vector_type(2)));
constexpr int BM = 256, BK = 64, HALF = 128, HTB = HALF * BK * 2, STAGE_BYTES = 8 * HTB, NXCD = 8, WGM = 8;
__host__ __device__ __forceinline__ int lds_byte(int r, int c) { const int st = (r >> 4) * 2 + (c >> 5), rr = r & 15, cc = c & 31, ob = rr * 64 + cc * 2; return st * 1024 + (ob ^ (((ob >> 9) & 1) << 5)); }
__host__ __device__ __forceinline__ void stage_rc(int b, int& R, int& C) { const int st = b / 1024, sb = b % 1024, swz = sb ^ (((sb >> 9) & 1) << 5); R = (st >> 1) * 16 + swz / 64; C = (st & 1) * 32 + (swz % 64) / 2; }
__host__ __device__ __forceinline__ int perm32(int rho) { const int n = rho >> 4, i = rho & 15; return 8 * (i >> 2) + 4 * n + (i & 3); }

struct Unit { int pm, pn, aux; const char* A; const char* B; };

struct DenseOrder {
    int nM, nN, nwg, G, c; const char* A; const char* B; size_t astep, bstep;
    __device__ void init(const void* A_, int lda, const void* B_, int K, int M, int N, int G_, int c_) { nM = M / BM; nN = N / BM; nwg = nM * nN; G = G_; c = c_; A = (const char*)A_; B = (const char*)B_; astep = (size_t)BM * lda * 2; bstep = (size_t)BM * K * 2; }
    __device__ bool next(int i, Unit& u) const {
        const long L = (long)i * G + c; if (L >= nwg) return false;
        int wgid = (int)L; { const int q = nwg / NXCD, r = nwg % NXCD, xcd = wgid % NXCD, off = wgid / NXCD; wgid = (xcd < r ? xcd * (q + 1) : r * (q + 1) + (xcd - r) * q) + off; }
        const int nig = WGM * nN, gid = wgid / nig, fm = gid * WGM, gsz = (nM - fm) < WGM ? (nM - fm) : WGM;
        u.pm = fm + ((wgid % nig) % gsz); u.pn = (wgid % nig) / gsz; u.aux = 0; u.A = A + (size_t)u.pm * astep; u.B = B + (size_t)u.pn * bstep; return true;
    }
};

__device__ __forceinline__ unsigned cvt_pk_bf16(float lo, float hi) { unsigned r; asm volatile("v_cvt_pk_bf16_f32 %0, %1, %2" : "=v"(r) : "v"(lo), "v"(hi)); return r; }

typedef f32x4 Acc[2][2][4][2];

struct EpiBf16 {
    static constexpr bool PERM = true;
    bf16_t* O; int ldc; int split_cols; size_t split_stride; float scale0;
    __device__ __forceinline__ void operator()(const Acc& acc, const Unit& u, int wr, int wc, int fr, int fq) const {
        const int row0 = u.pm * BM + wr * 64 + fr; int colt = u.pn * BM; bf16_t* base = O;
        float sc = 1.f; if (split_cols) { const int t = colt / split_cols; base += (size_t)t * split_stride; colt -= t * split_cols; if (t == 0) sc = scale0; }
        const int col0 = colt + wc * 32 + 8 * fq;
#pragma unroll
        for (int ai = 0; ai < 2; ++ai)
#pragma unroll
            for (int m = 0; m < 4; ++m) { bf16_t* rowp = base + (size_t)(row0 + ai * HALF + m * 16) * ldc + col0;
#pragma unroll
                for (int bj = 0; bj < 2; ++bj) { f32x4 v0 = acc[ai][bj][m][0] * sc, v1 = acc[ai][bj][m][1] * sc;
                    u32x4 w; w.x = cvt_pk_bf16(v0[0], v0[1]); w.y = cvt_pk_bf16(v0[2], v0[3]); w.z = cvt_pk_bf16(v1[0], v1[1]); w.w = cvt_pk_bf16(v1[2], v1[3]);
                    *(u32x4*)(rowp + bj * HALF) = w; } }
    }
};
__device__ __forceinline__ void unpack8f(const u32x4 w, f32x4& lo, f32x4& hi) { lo = (f32x4){bflo(w.x), bfhi(w.x), bflo(w.y), bfhi(w.y)}; hi = (f32x4){bflo(w.z), bfhi(w.z), bflo(w.w), bfhi(w.w)}; }
template <bool BASE_BF16>
struct EpiResX {
    static constexpr bool PERM = true;
    const void* base; bf16_t* out;
    __device__ __forceinline__ void operator()(const Acc& acc, const Unit& u, int wr, int wc, int fr, int fq) const {
        const int col0 = u.pn * BM + wc * 32 + 8 * fq; GAS bf16_t* op = (GAS bf16_t*)out;
#pragma unroll
        for (int ai = 0; ai < 2; ++ai) {
            f32x4 b0[4][2], b1[4][2];
#pragma unroll
            for (int m = 0; m < 4; ++m) { const size_t off = (size_t)(u.pm * BM + ai * HALF + wr * 64 + m * 16 + fr) * 1024 + col0;
#pragma unroll
                for (int bj = 0; bj < 2; ++bj) {
                    if (BASE_BF16) { const u32x4 w = *(const GAS u32x4*)((const GAS bf16_t*)base + off + bj * HALF); unpack8f(w, b0[m][bj], b1[m][bj]); }
                    else { b0[m][bj] = *(const GAS f32x4*)((const GAS float*)base + off + bj * HALF); b1[m][bj] = *(const GAS f32x4*)((const GAS float*)base + off + bj * HALF + 4); } } }
            asm volatile("" ::: "memory");
#pragma unroll
            for (int m = 0; m < 4; ++m) { const size_t off = (size_t)(u.pm * BM + ai * HALF + wr * 64 + m * 16 + fr) * 1024 + col0;
#pragma unroll
                for (int bj = 0; bj < 2; ++bj) { const f32x4 v0 = b0[m][bj] + acc[ai][bj][m][0], v1 = b1[m][bj] + acc[ai][bj][m][1];
                    u32x4 w; w.x = cvt_pk_bf16(v0[0], v0[1]); w.y = cvt_pk_bf16(v0[2], v0[3]); w.z = cvt_pk_bf16(v1[0], v1[1]); w.w = cvt_pk_bf16(v1[2], v1[3]);
                    *(GAS u32x4*)(op + off + bj * HALF) = w; } }
            asm volatile("" ::: "memory");
        }
    }
};
struct EpiRouter {
    static constexpr bool PERM = false;
    float* out;
    __device__ __forceinline__ void operator()(const Acc& acc, const Unit& u, int wr, int wc, int fr, int fq) const {
        if (wc >= 2) return;
#pragma unroll
        for (int ai = 0; ai < 2; ++ai)
#pragma unroll
            for (int m = 0; m < 4; ++m) { const size_t off = (size_t)(u.pm * BM + ai * HALF + wr * 64 + m * 16 + fr) * 64 + wc * 32 + 4 * fq;
#pragma unroll
                for (int n = 0; n < 2; ++n) *(f32x4*)(out + off + n * 16) = acc[ai][0][m][n]; }
    }
};
struct EpiGU {
    static constexpr bool PERM = true;
    bf16_t* H;
    __device__ __forceinline__ void operator()(const Acc& acc, const Unit& u, int wr, int wc, int fr, int fq) const {
        const int col0 = u.pn * 128 + wc * 32 + 8 * fq;
#pragma unroll
        for (int ai = 0; ai < 2; ++ai)
#pragma unroll
            for (int m = 0; m < 4; ++m) { bf16_t* rowp = H + (size_t)(u.pm * BM + ai * HALF + wr * 64 + m * 16 + fr) * EH + col0;
                f32x4 g0 = acc[ai][0][m][0], g1 = acc[ai][0][m][1]; const f32x4 u0 = acc[ai][1][m][0], u1 = acc[ai][1][m][1];
#pragma unroll
                for (int e = 0; e < 4; ++e) { g0[e] = g0[e] * sigmoidf_(g0[e]) * u0[e]; g1[e] = g1[e] * sigmoidf_(g1[e]) * u1[e]; }
                u32x4 w; w.x = cvt_pk_bf16(g0[0], g0[1]); w.y = cvt_pk_bf16(g0[2], g0[3]); w.z = cvt_pk_bf16(g1[0], g1[1]); w.w = cvt_pk_bf16(g1[2], g1[3]);
                *(u32x4*)rowp = w; }
    }
};
struct EpiDown {
    static constexpr bool PERM = true;
    bf16_t* Y; const float* gate;
    __device__ __forceinline__ void operator()(const Acc& acc, const Unit& u, int wr, int wc, int fr, int fq) const {
        const int col0 = u.pn * BM + wc * 32 + 8 * fq;
#pragma unroll
        for (int ai = 0; ai < 2; ++ai)
#pragma unroll
            for (int m = 0; m < 4; ++m) { const int row = u.pm * BM + ai * HALF + wr * 64 + m * 16 + fr; const float sc = gate[row]; bf16_t* rowp = Y + (size_t)row * 1024 + col0;
#pragma unroll
                for (int bj = 0; bj < 2; ++bj) { const f32x4 v0 = acc[ai][bj][m][0] * sc, v1 = acc[ai][bj][m][1] * sc;
                    u32x4 w; w.x = cvt_pk_bf16(v0[0], v0[1]); w.y = cvt_pk_bf16(v0[2], v0[3]); w.z = cvt_pk_bf16(v1[0], v1[1]); w.w = cvt_pk_bf16(v1[2], v1[3]);
                    *(u32x4*)(rowp + bj * HALF) = w; } }
    }
};
struct EpiPle {
    static constexpr bool PERM = true;
    const bf16_t* xin; bf16_t* xout; const bf16_t* pp;
    __device__ __forceinline__ void operator()(const Acc& acc, const Unit& u, int wr, int wc, int fr, int fq) const {
        const int col0 = u.pn * BM + wc * 32 + 8 * fq;
        const GAS bf16_t* xp = (const GAS bf16_t*)xin; GAS bf16_t* op = (GAS bf16_t*)xout; const GAS bf16_t* pq = (const GAS bf16_t*)pp;
#pragma unroll
        for (int ai = 0; ai < 2; ++ai) {
            u32x4 xw[4][2], pw[4][2];
#pragma unroll
            for (int m = 0; m < 4; ++m) { const size_t off = (size_t)(u.pm * BM + ai * HALF + wr * 64 + m * 16 + fr) * 1024 + col0;
#pragma unroll
                for (int bj = 0; bj < 2; ++bj) { xw[m][bj] = *(const GAS u32x4*)(xp + off + bj * HALF); pw[m][bj] = *(const GAS u32x4*)(pq + off + bj * HALF); } }
            asm volatile("" ::: "memory");
#pragma unroll
            for (int m = 0; m < 4; ++m) { const size_t off = (size_t)(u.pm * BM + ai * HALF + wr * 64 + m * 16 + fr) * 1024 + col0;
#pragma unroll
                for (int bj = 0; bj < 2; ++bj) { f32x4 x0, x1, p0, p1; unpack8f(xw[m][bj], x0, x1); unpack8f(pw[m][bj], p0, p1); const f32x4 a0 = acc[ai][bj][m][0], a1 = acc[ai][bj][m][1];
#pragma unroll
                    for (int e = 0; e < 4; ++e) { x0[e] += p0[e] * sigmoidf_(a0[e]); x1[e] += p1[e] * sigmoidf_(a1[e]); }
                    u32x4 w; w.x = cvt_pk_bf16(x0[0], x0[1]); w.y = cvt_pk_bf16(x0[2], x0[3]); w.z = cvt_pk_bf16(x1[0], x1[1]); w.w = cvt_pk_bf16(x1[2], x1[3]);
                    *(GAS u32x4*)(op + off + bj * HALF) = w; } }
            asm volatile("" ::: "memory");
        }
    }
};
struct EpiMid {
    static constexpr bool PERM = true;
    bf16_t* MID;
    __device__ __forceinline__ void operator()(const Acc& acc, const Unit& u, int wr, int wc, int fr, int fq) const {
        const int row0 = u.pm * BM + wr * 64 + fr;
        const int mode = (u.pn == 1) ? 2 : 0; const int colbase = u.pn * 256;
#pragma unroll
        for (int ai = 0; ai < 2; ++ai)
#pragma unroll
            for (int m = 0; m < 4; ++m) { bf16_t* rowp = MID + (size_t)(row0 + ai * HALF + m * 16) * 512 + colbase;
#pragma unroll
                for (int bj = 0; bj < 2; ++bj) { const int lc = bj * HALF + wc * 32 + 8 * fq; f32x4 v0 = acc[ai][bj][m][0], v1 = acc[ai][bj][m][1];
#pragma unroll
                    for (int e = 0; e < 4; ++e) {
                        if (mode == 2) { v0[e] = sigmoidf_(v0[e]); v1[e] = sigmoidf_(v1[e]); }
                        else if (lc < 64) { v0[e] = tanhf_(v0[e]); v1[e] = tanhf_(v1[e]); } }
                    u32x4 w; w.x = cvt_pk_bf16(v0[0], v0[1]); w.y = cvt_pk_bf16(v0[2], v0[3]); w.z = cvt_pk_bf16(v1[0], v1[1]); w.w = cvt_pk_bf16(v1[2], v1[3]);
                    *(u32x4*)(rowp + lc) = w; } }
    }
};
struct EpiRwkv2 {
    static constexpr bool PERM = true;
    bf16_t* O0; bf16_t* O1; const float* bias0; const float* bias1; int tybase;
    __device__ __forceinline__ void operator()(const Acc& acc, const Unit& u, int wr, int wc, int fr, int fq) const {
        const int ty = tybase + (u.pn >> 2); const int row0 = u.pm * BM + wr * 64 + fr; const int colt = (u.pn & 3) * BM + wc * 32 + 8 * fq;
        bf16_t* base = (u.pn >> 2) ? O1 : O0; const float* bias = (u.pn >> 2) ? bias1 : bias0;
#pragma unroll
        for (int bj = 0; bj < 2; ++bj) {
            f32x4 b0 = (f32x4){0.f, 0.f, 0.f, 0.f}, b1 = b0;
            if (ty < 2) { b0 = *(const f32x4*)(bias + colt + bj * HALF); b1 = *(const f32x4*)(bias + colt + bj * HALF + 4); }
#pragma unroll
            for (int ai = 0; ai < 2; ++ai)
#pragma unroll
                for (int m = 0; m < 4; ++m) { bf16_t* rowp = base + (size_t)(row0 + ai * HALF + m * 16) * 1024 + colt + bj * HALF;
                    f32x4 v0 = acc[ai][bj][m][0] + b0, v1 = acc[ai][bj][m][1] + b1;
                    if (ty < 2) { const float s = (ty == 0) ? 0.6065306597126334f : 1.0f;
#pragma unroll
                        for (int e = 0; e < 4; ++e) { v0[e] = s * sigmoidf_(v0[e]); v1[e] = s * sigmoidf_(v1[e]); } }
                    u32x4 w; w.x = cvt_pk_bf16(v0[0], v0[1]); w.y = cvt_pk_bf16(v0[2], v0[3]); w.z = cvt_pk_bf16(v1[0], v1[1]); w.w = cvt_pk_bf16(v1[2], v1[3]);
                    *(u32x4*)rowp = w; }
        }
    }
};

template <class Epi, class Sched, bool ALIGN_EPI, bool GATHER>
__device__ __forceinline__ void gemm_phase(PG8_LAS unsigned char* lds, const int K, const int lda, const Sched& S, const Epi& E, const int* __restrict__ rows, const int tid) {
    const int wid = __builtin_amdgcn_readfirstlane(tid >> 6), lane = tid & 63, wr = wid >> 2, wc = wid & 3, fr = lane & 15, fq = lane >> 4;
    const int nt = K / BK;
    unsigned voffA[2], voffB[2]; int RA[2];
#pragma unroll
    for (int i = 0; i < 2; ++i) { int R, C; stage_rc(tid * 16 + i * 8192, R, C); const int Rb = Epi::PERM ? ((R & ~31) + perm32(R & 31)) : R;
        RA[i] = R; voffA[i] = GATHER ? (unsigned)(C * 2) : (unsigned)(R * lda + C) * 2u; voffB[i] = (unsigned)(Rb * K + C) * 2u; }
    const size_t kstep = (size_t)(BK * 2);
    const size_t hstepA = GATHER ? 0 : (size_t)HALF * lda * 2, hstepB = (size_t)HALF * K * 2;
    const unsigned ldsw = (unsigned)wid * 1024u;
    const int aoff = lds_byte(wr * 64 + fr, fq * 8), boff = lds_byte(wc * 32 + fr, fq * 8);
#define PG8_SA(b, h) (((b) * 2 + (h)) * HTB)
#define PG8_SB(b, h) ((4 + (b) * 2 + (h)) * HTB)
#define PG8_ST2(bufoff, gbase, o0, o1) do { \
        __builtin_amdgcn_global_load_lds((const unsigned*)((const char*)(gbase) + (o0)), (PG8_LAS unsigned*)(lds + (bufoff) + ldsw), 16, 0, 0); \
        __builtin_amdgcn_global_load_lds((const unsigned*)((const char*)(gbase) + (o1)), (PG8_LAS unsigned*)(lds + (bufoff) + ldsw + 8192), 16, 0, 0); } while (0)
#define PG8_STB(bufoff, gbase) PG8_ST2(bufoff, gbase, voffB[0], voffB[1])
#define PG8_STA(bufoff, p, h, nx) do { if constexpr (GATHER) { const unsigned g0_ = (nx) ? gN[h][0] : gC[h][0], g1_ = (nx) ? gN[h][1] : gC[h][1]; PG8_ST2(bufoff, p, g0_, g1_); } \
        else { PG8_ST2(bufoff, (p) + (h) * hstepA, voffA[0], voffA[1]); } } while (0)
#define PG8_LDA(dst, b, h) do { _Pragma("unroll") for (int m = 0; m < 4; ++m) _Pragma("unroll") for (int k = 0; k < 2; ++k) dst[m][k] = *(const PG8_LAS bf16x8*)(lds + PG8_SA(b, h) + aoff + m * 2048 + k * 1024); } while (0)
#define PG8_LDB(dst, b, h) do { _Pragma("unroll") for (int n = 0; n < 2; ++n) _Pragma("unroll") for (int k = 0; k < 2; ++k) dst[n][k] = *(const PG8_LAS bf16x8*)(lds + PG8_SB(b, h) + boff + n * 2048 + k * 1024); } while (0)
#define PG8_MMA(ai, bj, At, Bt) do { __builtin_amdgcn_s_setprio(1); _Pragma("unroll") for (int m = 0; m < 4; ++m) _Pragma("unroll") for (int n = 0; n < 2; ++n) _Pragma("unroll") for (int k = 0; k < 2; ++k) \
        acc[ai][bj][m][n] = __builtin_amdgcn_mfma_f32_16x16x32_bf16(Bt[n][k], At[m][k], acc[ai][bj][m][n], 0, 0, 0); __builtin_amdgcn_s_setprio(0); } while (0)
#define PG8_WAIT_V(n) asm volatile("s_waitcnt vmcnt(" #n ")" ::: "memory")
#define PG8_WAIT_L(n) asm volatile("s_waitcnt lgkmcnt(" #n ")" ::: "memory")
#define PG8_BAR __builtin_amdgcn_s_barrier()
#define PG8_SCHED __builtin_amdgcn_sched_barrier(0)
#define PG8_GLOAD(dst, un) do { if constexpr (GATHER) { _Pragma("unroll") for (int h_ = 0; h_ < 2; ++h_) _Pragma("unroll") for (int i_ = 0; i_ < 2; ++i_) \
        dst[h_][i_] = (unsigned)rows[(un).pm * BM + h_ * HALF + RA[i_]] * (unsigned)(lda * 2) + voffA[i_]; } } while (0)
    Unit cur, nxt; int ui = 0;
    if (!S.next(0, cur)) return;
    unsigned gC[2][2] = {{0u, 0u}, {0u, 0u}}, gN[2][2] = {{0u, 0u}, {0u, 0u}};
    PG8_GLOAD(gC, cur);
    Acc acc;
#pragma unroll
    for (int a = 0; a < 2; ++a)
#pragma unroll
        for (int b = 0; b < 2; ++b)
#pragma unroll
            for (int m = 0; m < 4; ++m)
#pragma unroll
                for (int n = 0; n < 2; ++n) acc[a][b][m][n] = (f32x4){0.f, 0.f, 0.f, 0.f};
    bf16x8 At[4][2], B0[2][2], B1[2][2];
    const char* cA = cur.A; const char* cB = cur.B;
    PG8_STB(PG8_SB(0, 0), cB); PG8_STB(PG8_SB(0, 1), cB + hstepB); PG8_STA(PG8_SA(0, 0), cA, 0, false); PG8_STA(PG8_SA(0, 1), cA, 1, false);
    if (wr == 1) PG8_BAR;
    PG8_WAIT_V(2); PG8_BAR;
    PG8_STB(PG8_SB(1, 0), cB + kstep); PG8_STA(PG8_SA(1, 0), cA + kstep, 0, false); PG8_STB(PG8_SB(1, 1), cB + hstepB + kstep);
    PG8_WAIT_V(6); PG8_BAR;
    for (;;) {
        const bool has_next = S.next(ui + 1, nxt);
        if (has_next) { PG8_GLOAD(gN, nxt); }
        const char* nA = has_next ? nxt.A : cA; const char* nB = has_next ? nxt.B : cB;
#pragma unroll 1
        for (int t = 0; t < nt; t += 2) {
            const bool last = (t == nt - 2); const bool nx = last && has_next;
            const char* a1 = cA + (size_t)(t + 1) * kstep;
            const char* a2 = last ? nA : cA + (size_t)(t + 2) * kstep; const char* b2 = last ? nB : cB + (size_t)(t + 2) * kstep;
            const char* a3 = a2 + kstep; const char* b3 = b2 + kstep;
            PG8_LDB(B0, 0, 0); PG8_LDB(B1, 0, 1); PG8_SCHED; PG8_LDA(At, 0, 0); PG8_STA(PG8_SA(1, 1), a1, 1, false);
            PG8_WAIT_V(8); PG8_WAIT_L(0); PG8_BAR; PG8_MMA(0, 0, At, B0); PG8_MMA(0, 1, At, B1); PG8_BAR; PG8_SCHED;
            PG8_LDA(At, 0, 1); PG8_STB(PG8_SB(0, 0), b2); PG8_STB(PG8_SB(0, 1), b2 + hstepB); PG8_STA(PG8_SA(0, 0), a2, 0, nx);
            PG8_WAIT_V(8); PG8_WAIT_L(0); PG8_BAR; PG8_MMA(1, 0, At, B0); PG8_MMA(1, 1, At, B1); PG8_BAR; PG8_SCHED;
            PG8_LDB(B0, 1, 0); PG8_LDB(B1, 1, 1); PG8_SCHED; PG8_LDA(At, 1, 0); PG8_STA(PG8_SA(0, 1), a2, 1, nx);
            PG8_WAIT_V(8); PG8_WAIT_L(0); PG8_BAR; PG8_MMA(0, 0, At, B0); PG8_MMA(0, 1, At, B1); PG8_BAR; PG8_SCHED;
            PG8_LDA(At, 1, 1); PG8_STB(PG8_SB(1, 0), b3); PG8_STB(PG8_SB(1, 1), b3 + hstepB); PG8_STA(PG8_SA(1, 0), a3, 0, nx);
            PG8_WAIT_V(8); PG8_WAIT_L(0); PG8_BAR; PG8_MMA(1, 0, At, B0); PG8_MMA(1, 1, At, B1); PG8_BAR; PG8_SCHED;
        }
        if constexpr (ALIGN_EPI) { if (wr == 0) PG8_BAR; }
        E(acc, cur, wr, wc, fr, fq);
        if (!has_next) break;
#pragma unroll
        for (int a = 0; a < 2; ++a)
#pragma unroll
            for (int b = 0; b < 2; ++b)
#pragma unroll
                for (int m = 0; m < 4; ++m)
#pragma unroll
                    for (int n = 0; n < 2; ++n) acc[a][b][m][n] = (f32x4){0.f, 0.f, 0.f, 0.f};
        cur = nxt; cA = nA; cB = nB; ++ui;
        if constexpr (GATHER) {
#pragma unroll
            for (int h_ = 0; h_ < 2; ++h_)
#pragma unroll
                for (int i_ = 0; i_ < 2; ++i_) gC[h_][i_] = gN[h_][i_]; }
        if constexpr (ALIGN_EPI) { if (wr == 1) PG8_BAR; }
    }
    PG8_WAIT_V(0);
    if constexpr (!ALIGN_EPI) { if (wr == 0) PG8_BAR; }
    PG8_BAR;
#undef PG8_SA
#undef PG8_SB
#undef PG8_ST2
#undef PG8_STB
#undef PG8_STA
#undef PG8_LDA
#undef PG8_LDB
#undef PG8_MMA
#undef PG8_WAIT_V
#undef PG8_WAIT_L
#undef PG8_BAR
#undef PG8_SCHED
#undef PG8_GLOAD
}
}
namespace attn_body {
using bf16=__hip_bfloat16;
using bf16x8=__attribute__((ext_vector_type(8)))short;
using s16x4=__attribute__((ext_vector_type(4)))short;
using f32x16=__attribute__((ext_vector_type(16)))float;
using u32x4=__attribute__((ext_vector_type(4)))unsigned;
constexpr int BATCH=8,NHEAD=16,SEQ=8192,D=64,PQ=512,PO=1024;
constexpr int NW=8,QBLK=32,QB=QBLK*NW,KVBLK=64,NQB=SEQ/QB;
constexpr int ATTN_UNIT_ROWS=QB;
__device__ __forceinline__ int crow(int r,int hi){return (r&3)+8*(r>>2)+4*hi;}
#define SBAR() __builtin_amdgcn_sched_barrier(0)
__device__ __forceinline__ void cmask(f32x16&p0,f32x16&p1,int jb,int qrel,int hi){
  const float NEG=-INFINITY; int kb=64*jb+4*hi;
  #pragma unroll
  for(int r=0;r<16;++r){int kv=kb+(r&3)+8*(r>>2); if(kv>qrel)p0[r]=NEG; if(kv+32>qrel)p1[r]=NEG;}
}

__device__ __forceinline__ void cbias(f32x16&p0,f32x16&p1,int jb,int qrel,int hi,const __attribute__((address_space(3))) float*tb){
  const int kb=64*jb+4*hi;
  #pragma unroll
  for(int r=0;r<16;++r){const int rel=qrel-(kb+(r&3)+8*(r>>2)); const int i0=min(max(rel,0),127), i1=min(max(rel-32,0),127); p0[r]+=tb[i0]; p1[r]+=tb[i1];}
}
constexpr int NSLOT=3, SLOTB=8192;
constexpr int LDS_K=0, LDS_V=NSLOT*SLOTB, LDS_WS=2*NSLOT*SLOTB, LDS_OST=LDS_WS+NW*64*4, LDS_BYTES=LDS_OST+NW*4096;
constexpr float C2=0.125f*1.4426950408889634f;
__device__ __forceinline__ void glds16(const void*gsrc,unsigned lds_dst){unsigned keep;
  asm volatile("s_mov_b32 %0, m0\n\ts_mov_b32 m0, %2\n\ts_nop 0\n\tglobal_load_lds_dwordx4 %1, off\n\ts_mov_b32 m0, %0":"=&s"(keep):"v"(gsrc),"s"(lds_dst):"memory");}
__device__ __forceinline__ float max3f(float a,float b,float c){float r;asm("v_max3_f32 %0, %1, %2, %3":"=v"(r):"v"(a),"v"(b),"v"(c));return r;}
__device__ __forceinline__ float max2f(float a,float b){float r;asm("v_max_f32_e32 %0, %1, %2":"=v"(r):"v"(a),"v"(b));return r;}
__device__ __forceinline__ float fadd_s(float a,float b){float r;asm("v_add_f32_e32 %0, %1, %2":"=v"(r):"v"(a),"v"(b));return r;}
__device__ __forceinline__ float fsub_s(float a,float b){float r;asm("v_sub_f32_e32 %0, %1, %2":"=v"(r):"v"(a),"v"(b));return r;}
typedef float f32x2_t __attribute__((ext_vector_type(2))); typedef __bf16 bf16x2_t __attribute__((ext_vector_type(2)));
__device__ __forceinline__ unsigned cvtpk_s(float lo,float hi){f32x2_t v={lo,hi};bf16x2_t b=__builtin_convertvector(v,bf16x2_t);return __builtin_bit_cast(unsigned,b);}
#define WAIT_BAR(N) asm volatile("s_waitcnt vmcnt(" #N ") lgkmcnt(0)\n\ts_barrier":::"memory")

__device__ __forceinline__ void qkt(f32x16&p0,f32x16&p1,const char*Kslot,const bf16x8*qr,const f32x16&negm,int r32,int hi){
  const char*kb=Kslot+hi*1024+r32*16;
  #pragma unroll
  for(int d0=0;d0<4;++d0){
    const bf16x8 b0=*reinterpret_cast<const bf16x8*>(kb+d0*2048);
    const bf16x8 b1=*reinterpret_cast<const bf16x8*>(kb+d0*2048+512);
    if(d0==0){p0=__builtin_amdgcn_mfma_f32_32x32x16_bf16(b0,qr[0],negm,0,0,0);p1=__builtin_amdgcn_mfma_f32_32x32x16_bf16(b1,qr[0],negm,0,0,0);}
    else{p0=__builtin_amdgcn_mfma_f32_32x32x16_bf16(b0,qr[d0],p0,0,0,0);p1=__builtin_amdgcn_mfma_f32_32x32x16_bf16(b1,qr[d0],p1,0,0,0);}}
}
typedef __attribute__((address_space(3))) const char* lds_cptr;
typedef short v4i16_t __attribute__((ext_vector_type(4)));
__device__ __forceinline__ void kload8(bf16x8*kf,lds_cptr kp){
  kf[0]=*(const __attribute__((address_space(3))) bf16x8*)(kp);      kf[1]=*(const __attribute__((address_space(3))) bf16x8*)(kp+512);
  kf[2]=*(const __attribute__((address_space(3))) bf16x8*)(kp+2048); kf[3]=*(const __attribute__((address_space(3))) bf16x8*)(kp+2560);
  kf[4]=*(const __attribute__((address_space(3))) bf16x8*)(kp+4096); kf[5]=*(const __attribute__((address_space(3))) bf16x8*)(kp+4608);
  kf[6]=*(const __attribute__((address_space(3))) bf16x8*)(kp+6144); kf[7]=*(const __attribute__((address_space(3))) bf16x8*)(kp+6656);
}
__device__ __forceinline__ void kload2(bf16x8*kf,lds_cptr kp,int j){ kf[2*j]=*(const __attribute__((address_space(3))) bf16x8*)(kp+j*2048); kf[2*j+1]=*(const __attribute__((address_space(3))) bf16x8*)(kp+j*2048+512); }
__device__ __forceinline__ s16x4 vtr(lds_cptr p){ return __builtin_bit_cast(s16x4,__builtin_amdgcn_ds_read_tr16_b64_v4i16((__attribute__((address_space(3))) v4i16_t*)p)); }
__device__ __forceinline__ float rowmax(const f32x16&p0,const f32x16&p1){
  float a=max3f(p0[0],p0[1],p1[0]),b=max3f(p0[2],p0[3],p1[1]);a=max3f(a,p1[2],p1[3]);
  #pragma unroll
  for(int r=4;r<16;r+=4){a=max3f(a,p0[r],p0[r+1]);b=max3f(b,p0[r+2],p0[r+3]);a=max3f(a,p1[r],p1[r+1]);b=max3f(b,p1[r+2],p1[r+3]);}
  const float m=max2f(a,b);
  auto rr=__builtin_amdgcn_permlane32_swap(__float_as_uint(m),__float_as_uint(m),false,false);
  return max2f(__uint_as_float(rr[0]),__uint_as_float(rr[1]));
}
__device__ __forceinline__ void pv(f32x16*o,int vb,bf16x8 pa0,bf16x8 pa1,bf16x8 pa2,bf16x8 pa3){
  #pragma unroll
  for(int d0=0;d0<2;++d0){s16x4 lo[4],hi[4];
    #pragma unroll
    for(int ks=0;ks<4;++ks){
      asm volatile("ds_read_b64_tr_b16 %0,%1 offset:%c2":"=&v"(lo[ks]):"v"(vb),"i"(d0*4096+ks*1024):"memory");
      asm volatile("ds_read_b64_tr_b16 %0,%1 offset:%c2":"=&v"(hi[ks]):"v"(vb),"i"(d0*4096+ks*1024+512):"memory");}
    asm volatile("s_waitcnt lgkmcnt(0)":::"memory");SBAR();
    #define PK(k) (bf16x8){lo[k][0],lo[k][1],lo[k][2],lo[k][3],hi[k][0],hi[k][1],hi[k][2],hi[k][3]}
    o[d0]=__builtin_amdgcn_mfma_f32_32x32x16_bf16(pa0,PK(0),o[d0],0,0,0);
    o[d0]=__builtin_amdgcn_mfma_f32_32x32x16_bf16(pa1,PK(1),o[d0],0,0,0);
    o[d0]=__builtin_amdgcn_mfma_f32_32x32x16_bf16(pa2,PK(2),o[d0],0,0,0);
    o[d0]=__builtin_amdgcn_mfma_f32_32x32x16_bf16(pa3,PK(3),o[d0],0,0,0);
    #undef PK
  }
}

#ifndef ATTN_STORE16
#define ATTN_STORE16(p,v) (*(u32x4*)(p)=(v))
#endif
template<int THRL> __device__ __forceinline__ void attn_unit(int b,int vh,int qb,const bf16*Q,const bf16*__restrict__ K,const bf16*__restrict__ V,bf16*O,char*shm,const __attribute__((address_space(3))) float*tball,const int tid){
  const int lane=tid&63,r32=lane&31,hi=lane>>5; const int wid=__builtin_amdgcn_readfirstlane(tid>>6);
  const long rowbase=(long)b*SEQ; const int q0=qb*QB;
  const int hh=vh>>2, qcol=hh*128+((vh>>1)&1)*64, vcol=hh*128+(vh&1)*64;
  const __attribute__((address_space(3))) float*tb=tball+hh*128;
  const bf16*Qw=Q+(rowbase+q0+wid*QBLK)*PQ+qcol;
  const bf16*Kh=K+rowbase*PQ+qcol,*Vh=V+rowbase*PQ+vcol;
  const unsigned lds0=(unsigned)(uintptr_t)shm;
  float*wsf=(float*)(shm+LDS_WS)+wid*64;
  const bf16*ksrc=Kh+(long)lane*PQ+wid*8;
  const bf16*vsrc=Vh+(long)(16*(wid&3)+(lane>>2))*PQ+(wid>>2)*32+(lane&3)*8;
  const unsigned kdst=lds0+LDS_K+wid*1024, vdst=lds0+LDS_V+wid*1024;
  #define DMA_K(t,slot) glds16(ksrc+(long)(t)*KVBLK*PQ,(unsigned)__builtin_amdgcn_readfirstlane(kdst+(slot)))
  #define DMA_V(t,slot) glds16(vsrc+(long)(t)*KVBLK*PQ,(unsigned)__builtin_amdgcn_readfirstlane(vdst+(slot)))
  const int vb0=(int)(lds0+LDS_V)+((lane>>4)&1)*32+(lane&3)*8+(4*hi+((lane&15)>>2))*64;
  const char*Kbase=shm+LDS_K; bf16x8 kf[8];
  const lds_cptr shm3=(lds_cptr)shm; const lds_cptr kp0=shm3+LDS_K+hi*1024+r32*16; const lds_cptr vp0=shm3+LDS_V+((lane>>4)&1)*32+(lane&3)*8+(4*hi+((lane&15)>>2))*64;
  const int NT=(q0+QB)/KVBLK;
  DMA_K(0,0);DMA_V(0,0);DMA_K(1,SLOTB);
  bf16x8 qr[4];
  #pragma unroll
  for(int d0=0;d0<4;++d0)qr[d0]=*reinterpret_cast<const bf16x8*>(&Qw[(long)r32*PQ+d0*16+hi*8]);
  float mhat=0.f,l_reg=0.f;f32x16 o[2];o[0]=f32x16{};o[1]=f32x16{};f32x16 negm=f32x16{};asm volatile("":"+v"(negm));
  const int qrel=wid*QBLK+r32;
  #define CMASK(P0,P1,t) do{int jb_=(t)-(NT-4); if(jb_>=-2){cbias(P0,P1,jb_,qrel,hi,tb); if(jb_>=0)cmask(P0,P1,jb_,qrel,hi);}}while(0)
  bool resc=false;
  #define START(P0,P1) do{ const float rm=rowmax(P0,P1); resc=false; \
    { const float dl=rm; mhat=fadd_s(mhat,dl); \
      _Pragma("unroll") for(int r=0;r<16;++r){P0[r]=fsub_s(P0[r],dl);P1[r]=fsub_s(P1[r],dl);} \
      _Pragma("unroll") for(int r=0;r<16;++r)negm[r]=-mhat; asm volatile("":"+v"(negm)); } \
    _Pragma("unroll") for(int r=0;r<16;++r)P0[r]=__builtin_amdgcn_exp2f(P0[r]); }while(0)
  #define RESC() do{ if(resc){ asm volatile("s_waitcnt lgkmcnt(0)":::"memory"); \
      _Pragma("unroll") for(int d_=0;d_<2;++d_) _Pragma("unroll") for(int r=0;r<16;++r)o[d_][r]*=wsf[crow(r,hi)]; } }while(0)
  f32x16 pA0,pA1,pB0,pB1;
  int sl_prev=0,sl_cur=0,sl_next=SLOTB;
  #define ROT() do{sl_prev=sl_cur;sl_cur=sl_next;sl_next=(sl_next==(NSLOT-1)*SLOTB)?0:sl_next+SLOTB;}while(0)
  DMA_K(2,2*SLOTB);
  WAIT_BAR(3);
  qkt(pA0,pA1,Kbase,qr,negm,r32,hi);asm volatile("s_nop 15\n\ts_nop 7":"+v"(pA0),"+v"(pA1));CMASK(pA0,pA1,0);
  START(pA0,pA1);
  _Pragma("unroll") for(int r=0;r<16;++r)pA1[r]=__builtin_amdgcn_exp2f(pA1[r]);
  WAIT_BAR(0);
  DMA_K(3,0);DMA_V(1,SLOTB);
  ROT();
  kload8(kf,kp0+sl_cur);
  WAIT_BAR(2);
  s16x4 vlo[8],vhi[8]; u32x4 pw0,pw1,pw2,pw3;
  #define PKW(P,B) cvtpk_s(P[B],P[B+1])
  #define PAF(k) __builtin_bit_cast(bf16x8,pw##k)
  #define VFR(i) (bf16x8){vlo[i][0],vlo[i][1],vlo[i][2],vlo[i][3],vhi[i][0],vhi[i][1],vhi[i][2],vhi[i][3]}
  #define PIN(x) asm volatile("":"+v"(x))
  #define MX3(a,b,c) __builtin_fmaxf(__builtin_fmaxf((a),(b)),(c))
  #define GAPA(MF,A0,A1,A2,A3,W0,W1,PW) do{ MF; sacc+=A0; sacc+=A1; sacc+=A2; sacc+=A3; PIN(sacc); W0; W1; PIN(PW); SBAR(); }while(0)
  #define EX(v) __builtin_amdgcn_exp2f(v)
  #define GAPB(MF,X,B) do{ MF; X[B]=EX(X[B]); X[B+1]=EX(X[B+1]); X[B+2]=EX(X[B+2]); X[B+3]=EX(X[B+3]); PIN(X); SBAR(); }while(0)
  #define VRD(i) do{ vlo[i]=vtr(vp_+(((i)>>2)*4096+((i)&3)*1024)); vhi[i]=vtr(vp_+(((i)>>2)*4096+((i)&3)*1024+512)); }while(0)
  #define KRD(G,j) do{ if(G){ kload2(kf,kp0+sl_next,j); SBAR(); } }while(0)
  #define STEP(C0,C1,P0,P1,t,GK,GV,GL) do{ SBAR(); \
    const lds_cptr vp_=vp0+sl_prev; \
    VRD(0); SBAR(); float sacc=(P0[0]+P0[1]); \
    GAPA(C0=__builtin_amdgcn_mfma_f32_32x32x16_bf16(kf[0],qr[0],negm,0,0,0), P0[2],P0[3],P0[4],P0[5],     pw0[0]=PKW(P0,0), pw0[1]=PKW(P0,2), pw0); \
    VRD(4); SBAR(); GAPA(C1=__builtin_amdgcn_mfma_f32_32x32x16_bf16(kf[1],qr[0],negm,0,0,0), P0[6],P0[7],P0[8],P0[9],     pw0[2]=PKW(P0,4), pw0[3]=PKW(P0,6), pw0); \
    VRD(1); SBAR(); GAPA(C0=__builtin_amdgcn_mfma_f32_32x32x16_bf16(kf[2],qr[1],C0,0,0,0),   P0[10],P0[11],P0[12],P0[13], pw1[0]=PKW(P0,8), pw1[1]=PKW(P0,10), pw1); \
    VRD(5); SBAR(); GAPA(C1=__builtin_amdgcn_mfma_f32_32x32x16_bf16(kf[3],qr[1],C1,0,0,0),   P0[14],P0[15],P1[0],P1[1],   pw1[2]=PKW(P0,12),pw1[3]=PKW(P0,14), pw1); \
    VRD(2); SBAR(); GAPA(C0=__builtin_amdgcn_mfma_f32_32x32x16_bf16(kf[4],qr[2],C0,0,0,0),   P1[2],P1[3],P1[4],P1[5],     pw2[0]=PKW(P1,0), pw2[1]=PKW(P1,2), pw2); \
    VRD(6); SBAR(); GAPA(C1=__builtin_amdgcn_mfma_f32_32x32x16_bf16(kf[5],qr[2],C1,0,0,0),   P1[6],P1[7],P1[8],P1[9],     pw2[2]=PKW(P1,4), pw2[3]=PKW(P1,6), pw2); \
    VRD(3); SBAR(); GAPA(C0=__builtin_amdgcn_mfma_f32_32x32x16_bf16(kf[6],qr[3],C0,0,0,0),   P1[10],P1[11],P1[12],P1[13], pw3[0]=PKW(P1,8), pw3[1]=PKW(P1,10), pw3); \
    VRD(7); SBAR(); GAPA(C1=__builtin_amdgcn_mfma_f32_32x32x16_bf16(kf[7],qr[3],C1,0,0,0),   P1[14],P1[15],0.f,0.f,       pw3[2]=PKW(P1,12),pw3[3]=PKW(P1,14), pw3); \
    l_reg+=sacc; \
    if(GK){DMA_K((t)+3,sl_cur);} if(GV){DMA_V((t)+1,sl_next);} \
    CMASK(C0,C1,t); \
    { float a=MX3(C0[0],C0[1],C1[0]),b=MX3(C0[2],C0[3],C1[1]); a=MX3(a,C1[2],C1[3]); \
      _Pragma("unroll") for(int r=4;r<16;r+=4){a=MX3(a,C0[r],C0[r+1]);b=MX3(b,C0[r+2],C0[r+3]);a=MX3(a,C1[r],C1[r+1]);b=MX3(b,C1[r+2],C1[r+3]);} \
      float rm=__builtin_fmaxf(a,b); { auto rr=__builtin_amdgcn_permlane32_swap(__float_as_uint(rm),__float_as_uint(rm),false,false); rm=__builtin_fmaxf(__uint_as_float(rr[0]),__uint_as_float(rr[1])); } \
      resc=false; \
      if(__builtin_expect(__any(rm>(float)THRL),0)){ const float dl=__builtin_fmaxf(rm,0.f); mhat+=dl; \
        _Pragma("unroll") for(int r=0;r<16;++r){C0[r]-=dl;C1[r]-=dl;} \
        _Pragma("unroll") for(int r=0;r<16;++r)negm[r]=-mhat; asm volatile("":"+v"(negm)); \
        const float f=__builtin_amdgcn_exp2f(-dl); l_reg*=f; if(hi==0)wsf[r32]=f; resc=true; } } \
    SBAR(); \
    GAPB(o[0]=__builtin_amdgcn_mfma_f32_32x32x16_bf16(PAF(0),VFR(0),o[0],0,0,0), C0,0); \
    GAPB(o[1]=__builtin_amdgcn_mfma_f32_32x32x16_bf16(PAF(0),VFR(4),o[1],0,0,0), C0,4); \
    KRD(GL,0); GAPB(o[0]=__builtin_amdgcn_mfma_f32_32x32x16_bf16(PAF(1),VFR(1),o[0],0,0,0), C0,8); \
    KRD(GL,1); GAPB(o[1]=__builtin_amdgcn_mfma_f32_32x32x16_bf16(PAF(1),VFR(5),o[1],0,0,0), C0,12); \
    KRD(GL,2); GAPB(o[0]=__builtin_amdgcn_mfma_f32_32x32x16_bf16(PAF(2),VFR(2),o[0],0,0,0), C1,0); \
    KRD(GL,3); GAPB(o[1]=__builtin_amdgcn_mfma_f32_32x32x16_bf16(PAF(2),VFR(6),o[1],0,0,0), C1,4); \
    GAPB(o[0]=__builtin_amdgcn_mfma_f32_32x32x16_bf16(PAF(3),VFR(3),o[0],0,0,0), C1,8); \
    GAPB(o[1]=__builtin_amdgcn_mfma_f32_32x32x16_bf16(PAF(3),VFR(7),o[1],0,0,0), C1,12); \
    }while(0)
  int t=1;
  #undef CMASK
  #define CMASK(P0,P1,t) do{}while(0)
  for(;t+7<NT;t+=2){
    STEP(pB0,pB1,pA0,pA1,t,true,true,true);     WAIT_BAR(2); RESC(); ROT();
    STEP(pA0,pA1,pB0,pB1,t+1,true,true,true);   WAIT_BAR(2); RESC(); ROT();
  }
  #undef CMASK
  #define CMASK(P0,P1,t) do{int jb_=(t)-(NT-4); if(jb_>=-2){cbias(P0,P1,jb_,qrel,hi,tb); if(jb_>=0)cmask(P0,P1,jb_,qrel,hi);}}while(0)
  #define ENDW(tt) do{ if((tt)+3<NT){WAIT_BAR(2);} else if((tt)+2<NT){WAIT_BAR(1);} else {WAIT_BAR(0);} }while(0)
  for(;t+1<NT;t+=2){
    STEP(pB0,pB1,pA0,pA1,t,(t+3<NT),(t+1<NT),(t+1<NT));       ENDW(t);   RESC(); ROT();
    STEP(pA0,pA1,pB0,pB1,t+1,(t+4<NT),(t+2<NT),(t+2<NT));     ENDW(t+1); RESC(); ROT();
  }
  STEP(pB0,pB1,pA0,pA1,NT-1,false,false,false); RESC();
  { float sacc=pB0[0]+pB0[1]; _Pragma("unroll") for(int r=2;r<16;++r)sacc+=pB0[r]; _Pragma("unroll") for(int r=0;r<16;++r)sacc+=pB1[r]; l_reg+=sacc;
    pw0=(u32x4){PKW(pB0,0),PKW(pB0,2),PKW(pB0,4),PKW(pB0,6)};pw1=(u32x4){PKW(pB0,8),PKW(pB0,10),PKW(pB0,12),PKW(pB0,14)};pw2=(u32x4){PKW(pB1,0),PKW(pB1,2),PKW(pB1,4),PKW(pB1,6)};pw3=(u32x4){PKW(pB1,8),PKW(pB1,10),PKW(pB1,12),PKW(pB1,14)};
    SBAR(); pv(o,vb0+sl_cur,PAF(0),PAF(1),PAF(2),PAF(3)); }
  #undef PKW
  #undef PAF
  #undef VFR
  #undef PIN
  #undef MX3
  #undef GAPA
  #undef GAPB
  #undef EX
  #undef VRD
  #undef KRD
  #undef STEP
  #undef ENDW
  {auto rr=__builtin_amdgcn_permlane32_swap(__float_as_uint(l_reg),__float_as_uint(l_reg),false,false);l_reg=__uint_as_float(rr[0])+__uint_as_float(rr[1]);}
  if(hi==0)wsf[32+r32]=l_reg;asm volatile("s_waitcnt lgkmcnt(0)":::"memory");
  float rli[16];
  #pragma unroll
  for(int r=0;r<16;++r)rli[r]=__builtin_amdgcn_rcpf(wsf[32+crow(r,hi)]);
  bf16*Ow=O+(rowbase+q0+wid*QBLK)*PO+vh*D;
  { bf16*stg=(bf16*)(shm+LDS_OST)+wid*2048;
    #pragma unroll
    for(int r=0;r<16;++r){const int orow=crow(r,hi);
      #pragma unroll
      for(int d0=0;d0<2;++d0)stg[orow*64+d0*32+r32]=__float2bfloat16(o[d0][r]*rli[r]);}
    asm volatile("s_waitcnt lgkmcnt(0)":::"memory");
    #pragma unroll
    for(int i=0;i<4;++i){const int row=i*8+(lane>>3),ch=lane&7; const u32x4 v=*(const u32x4*)(stg+row*64+ch*8); ATTN_STORE16(Ow+(long)row*PO+ch*8,v);} }
  asm volatile("s_waitcnt lgkmcnt(0)\n\ts_barrier":::"memory");
  #undef DMA_K
  #undef DMA_V
  #undef CMASK
  #undef START
  #undef RESC
  #undef ROT
}
constexpr int ATTN_LDS_BYTES=LDS_BYTES;
struct AttnTensors { const bf16* Q; const bf16* K; const bf16* V; bf16* O; };
struct AttnUnit { int bh; int qb; };
__device__ __forceinline__ bool attn_next(int vcu,int i,AttnUnit&u){ if(i>=16)return false; const int s=vcu&7, j=i&3; u.bh=(vcu>>3)+32*(i>>2); u.qb=(j==0)?s:(j==1)?15-s:(j==2)?16+s:31-s; return true; }
template<int THRL=8> __device__ __forceinline__ void attn_phase(char*lds,const AttnTensors&T,int vcu,const __attribute__((address_space(3))) float*tball,const int tid){
  AttnUnit u;
  for(int i=0;attn_next(vcu,i,u);++i){ attn_unit<THRL>(u.bh/NHEAD,u.bh%NHEAD,u.qb,T.Q,T.K,T.V,T.O,lds,tball,tid); }
}
#undef SBAR
#undef WAIT_BAR
}

#define XB_TMO      128
#define XB_XCNT(j)  (256  + 64 * (j))
#define XB_XSUB(j)  (1280 + 64 * (j))
#define XB_XGEN(j)  (2304 + 64 * (j))
#define XB_TOP      3328
#define XB_TOPGEN   3392
#define XCD_BAR_WORDS 3456
#define XB_SPIN_CAP (1u << 18)

__device__ __forceinline__ unsigned xb_ld(unsigned* p)              { return __hip_atomic_load(p, __ATOMIC_RELAXED, __HIP_MEMORY_SCOPE_AGENT); }
__device__ __forceinline__ unsigned xb_add(unsigned* p, unsigned v) { return __hip_atomic_fetch_add(p, v, __ATOMIC_RELAXED, __HIP_MEMORY_SCOPE_AGENT); }
__device__ __forceinline__ unsigned xb_xcc_id() { return (unsigned)__builtin_amdgcn_s_getreg((3 << 11) | 20) & 0xFu; }
#define XB_SPIN(cond, bar) do { unsigned _sp = 0; while (cond) { __builtin_amdgcn_s_sleep(1); \
    if ((++_sp & 255u) == 0u) { if (xb_ld(&(bar)[XB_TMO])) break; if (_sp > XB_SPIN_CAP) { atomicAdd(&(bar)[XB_TMO], 1u); break; } } } } while (0)

struct XcdBarrier {
    unsigned* bar; unsigned x;
    volatile LAS unsigned* st;
};

__device__ __forceinline__ XcdBarrier xcd_barrier_post(unsigned* bar, volatile LAS unsigned* st, const bool leader  ) {
    XcdBarrier b; b.bar = bar; b.x = xb_xcc_id(); b.st = st;
    if (leader) (void)xb_add(&bar[XB_XCNT(b.x)], 1u);
    return b;
}
__device__ __forceinline__ void xcd_barrier_complete(unsigned* bar, unsigned x, unsigned& nloc, unsigned& nx) {
    const unsigned G = gridDim.x * gridDim.y * gridDim.z;
    unsigned sum, cnt, mine, sp = 0u;
    for (;;) {
        sum = 0u; cnt = 0u; mine = 0u;
#pragma unroll
        for (unsigned j = 0; j < 16; ++j) { const unsigned c = xb_ld(&bar[XB_XCNT(j)]); sum += c; cnt += (c > 0u) ? 1u : 0u; mine = (j == x) ? c : mine; }
        if (sum == G) break;
        __builtin_amdgcn_s_sleep(1);
        if ((++sp & 255u) == 0u) { if (xb_ld(&bar[XB_TMO])) break; if (sp > XB_SPIN_CAP) { atomicAdd(&bar[XB_TMO], 1u); break; } }
    }
    nloc = mine > 0u ? mine : 1u; nx = cnt > 0u ? cnt : 1u;
}

__device__ __forceinline__ void xcd_barrier(const XcdBarrier& b, const bool leader  ) {
    asm volatile("s_waitcnt vmcnt(0)" ::: "memory");
    __syncthreads();
    if (leader) {
        unsigned* bar = b.bar;
        __builtin_amdgcn_s_waitcnt(0);
        unsigned nloc = b.st[0], nx = b.st[1];
        if (nloc == 0u) { xcd_barrier_complete(bar, b.x, nloc, nx); b.st[0] = nloc; b.st[1] = nx; }
        const unsigned old = xb_add(&bar[XB_XSUB(b.x)], 1u);
        const unsigned gen = old / nloc;
        if (old + 1u == (gen + 1u) * nloc) {
            __builtin_amdgcn_fence(__ATOMIC_RELEASE, "agent");
            asm volatile("s_waitcnt vmcnt(0)" ::: "memory");
            const unsigned og = xb_add(&bar[XB_TOP], 1u);
            const unsigned tg = og / nx;
            if (og + 1u == (tg + 1u) * nx) xb_add(&bar[XB_TOPGEN], 1u);
            else XB_SPIN(xb_ld(&bar[XB_TOPGEN]) == tg, bar);
            __builtin_amdgcn_fence(__ATOMIC_ACQUIRE, "agent");
            xb_add(&bar[XB_XGEN(b.x)], 1u);
            asm volatile("s_waitcnt vmcnt(0)" ::: "memory");
        } else {
            XB_SPIN(xb_ld(&bar[XB_XGEN(b.x)]) == gen, bar);
            __builtin_amdgcn_fence(__ATOMIC_ACQUIRE, "agent");
            asm volatile("s_waitcnt vmcnt(0)" ::: "memory");
        }
    }
    __syncthreads();
}

constexpr size_t MiB = 1u << 20;
constexpr size_t WS_CTL = 0, CTL_ZERO_BYTES = 1 * MiB;
constexpr size_t WS_WIN = 2 * MiB;
constexpr size_t WS_WOUT = 7 * MiB;
constexpr size_t WS_PGATE = 9 * MiB;
constexpr size_t WS_PPROJ = 13 * MiB;
constexpr size_t WS_RCAT = 14 * MiB;
constexpr size_t WS_RL1 = 20 * MiB;
constexpr size_t WS_RS2 = 28 * MiB;
constexpr size_t WS_RWO = 30 * MiB;
constexpr size_t WS_ROUT = 32 * MiB;
constexpr size_t WS_LRUAGG = 33 * MiB;
constexpr size_t WS_MGU = 38 * MiB;
constexpr size_t WS_MDN = 102 * MiB;
constexpr size_t WS_PB = 134 * MiB;
constexpr size_t WS_ACT = 166 * MiB;
constexpr size_t WS_H0 = WS_ACT;
constexpr size_t WS_QKV = WS_ACT + 128 * MiB;
constexpr size_t WS_O = WS_ACT + 448 * MiB;
constexpr size_t WS_HL = WS_ACT + 576 * MiB, WS_CA = WS_ACT + 640 * MiB;
constexpr size_t WS_H2 = WS_ACT;
constexpr size_t WS_LOG = WS_ACT + 128 * MiB;
constexpr size_t WS_ROUTE = WS_ACT + 144 * MiB;
constexpr size_t WS_HID = WS_ACT + 152 * MiB;
constexpr size_t WS_YS = WS_ACT + 288 * MiB;
constexpr size_t WS_PP = WS_ACT + 128 * MiB;
constexpr size_t WS_HCAT = WS_ACT;
constexpr size_t WS_XR = WS_ACT + 256 * MiB, WS_XK = WS_ACT + 384 * MiB, WS_XV = WS_ACT + 512 * MiB;
constexpr size_t WS_R = WS_ACT + 640 * MiB, WS_K = WS_XR, WS_V = WS_XK;
constexpr size_t WS_MID = WS_ACT + 768 * MiB;
constexpr size_t WS_EW = WS_ACT;
constexpr size_t WS_AA = WS_ACT + 128 * MiB;
constexpr size_t WS_Y = WS_XV;
constexpr size_t WS_END = WS_ACT + 832 * MiB;
static_assert(WS_END <= 1024 * MiB, "workspace map");
constexpr size_t RT_EID = 0, RT_POS = 1 * MiB, RT_GATE = 2 * MiB, RT_ROWTOK = 3 * MiB, RT_ROWGATE = 4 * MiB, RT_SLOT = 5 * MiB;
constexpr int CW_BAR = 4096;
constexpr int CW_CNT0 = 16384, CW_CNT1 = 16384 + 64;

constexpr int RING_BYTES = 131072;
constexpr int LDSCTL_OFF = RING_BYTES, MISC_OFF = LDSCTL_OFF + 320;
constexpr int TB_OFF = RING_BYTES + 1024;
constexpr int RTE_OFF = TB_OFF + 2048;
constexpr int LDS_BYTES = 147456;

constexpr int NWAVES = 8;
__device__ __forceinline__ int lane_id_() { int l; asm volatile("v_mbcnt_lo_u32_b32 %0, -1, 0\n\tv_mbcnt_hi_u32_b32 %0, -1, %0" : "=v"(l)); return l; }
#define TID_ (F.wave * 64 + lane_id_())
#define LANE_ (lane_id_())
struct Frame {
    LAS unsigned char* lds; volatile LAS unsigned* MISC; gu32* ctl;
    int wave, vcu, G;
};

__device__ __forceinline__ void load_row4(const float* xrow, int lane, f32x4 (&v)[4]) { const f32x4* p = (const f32x4*)xrow + lane;
#pragma unroll
    for (int j = 0; j < 4; ++j) v[j] = p[64 * j]; }
__device__ __forceinline__ float row_rstd(const f32x4 (&v)[4], float eps) { float s = 0.f;
#pragma unroll
    for (int j = 0; j < 4; ++j) s += (v[j].x * v[j].x + v[j].y * v[j].y) + (v[j].z * v[j].z + v[j].w * v[j].w);
    return 1.0f / sqrtf(wave_sum(s) * (1.0f / 1024.0f) + eps); }
__device__ __forceinline__ void load_row4_bf(const bf16* xrow, int lane, f32x4 (&v)[4]) { const v2u* p = (const v2u*)xrow + lane;
#pragma unroll
    for (int j = 0; j < 4; ++j) { const v2u w = p[64 * j]; v[j] = (f32x4){bflo(w.x), bfhi(w.x), bflo(w.y), bfhi(w.y)}; } }
__device__ __forceinline__ void store_row4_bf(bf16* xrow, int lane, const f32x4 (&v)[4]) { v2u* p = (v2u*)xrow + lane;
#pragma unroll
    for (int j = 0; j < 4; ++j) { v2u o; o.x = pk2(v[j].x, v[j].y); o.y = pk2(v[j].z, v[j].w); p[64 * j] = o; } }
__device__ __forceinline__ void store_row_bf16(bf16* orow, int lane, const f32x4 (&v)[4], float rstd, const float* g) {
    unsigned long long* o8 = (unsigned long long*)orow + lane;
#pragma unroll
    for (int j = 0; j < 4; ++j) { const f32x4 gg = ((const f32x4*)g)[lane + 64 * j];
        o8[64 * j] = (unsigned long long)pk2(v[j].x * rstd * gg.x, v[j].y * rstd * gg.y) | ((unsigned long long)pk2(v[j].z * rstd * gg.z, v[j].w * rstd * gg.w) << 32); }
}

template <int MODE>
__device__ __forceinline__ void transpose_item(const float* W, int K, int N, bf16* WT, int ldo, int row_off, const float* mu, LAS float* scr, int item, int lane) {
    const int nblk = N / 32, kb = item / nblk, nb = item % nblk, k0 = 64 * kb, n0 = 32 * nb;
    float ld[32];
#pragma unroll
    for (int i = 0; i < 32; ++i) { const int kk = 2 * i + (lane >> 5); ld[i] = W[(size_t)(k0 + kk) * N + n0 + (lane & 31)]; }
#pragma unroll
    for (int i = 0; i < 32; ++i) { const int kk = 2 * i + (lane >> 5); scr[kk * 33 + (lane & 31)] = ld[i]; }
    LDS_WAIT(); asm volatile("" ::: "memory");
    const int c = lane & 7;
    int rbase = row_off + n0;
    if (MODE == 2) { rbase = row_off + ((n0 < 512) ? ((n0 >> 7) * 256 + (n0 & 127)) : (((n0 - 512) >> 7) * 256 + 128 + ((n0 - 512) & 127))); }
    float m[8];
    if (MODE == 1) {
#pragma unroll
        for (int e = 0; e < 8; ++e) m[e] = mu[k0 + 8 * c + e]; }
#pragma unroll
    for (int j = 0; j < 4; ++j) { const int n = (lane >> 3) + 8 * j; const LAS float* s = scr + (8 * c) * 33 + n;
        float v[8];
#pragma unroll
        for (int e = 0; e < 8; ++e) v[e] = s[e * 33];
        bf16* dst = WT + (size_t)(rbase + n) * ldo + k0 + 8 * c;
        if (MODE == 1) {
            v4u o, o2;
            o.x = pk2(v[0] * (1.f - m[0]), v[1] * (1.f - m[1])); o.y = pk2(v[2] * (1.f - m[2]), v[3] * (1.f - m[3])); o.z = pk2(v[4] * (1.f - m[4]), v[5] * (1.f - m[5])); o.w = pk2(v[6] * (1.f - m[6]), v[7] * (1.f - m[7]));
            o2.x = pk2(v[0] * m[0], v[1] * m[1]); o2.y = pk2(v[2] * m[2], v[3] * m[3]); o2.z = pk2(v[4] * m[4], v[5] * m[5]); o2.w = pk2(v[6] * m[6], v[7] * m[7]);
            *(GAS v4u*)dst = o; *(GAS v4u*)(dst + 1024) = o2;
        } else {
            v4u o; o.x = pk2(v[0], v[1]); o.y = pk2(v[2], v[3]); o.z = pk2(v[4], v[5]); o.w = pk2(v[6], v[7]);
            *(GAS v4u*)dst = o; }
    }
    LDS_WAIT(); asm volatile("" ::: "memory");
}

struct In {
    const float *x, *p, *rel_bias, *norm_mix, *ab_w_in, *ab_w_out, *lam_q1, *lam_k1, *lam_q2, *lam_k2, *sub_g, *conv_w, *conv_b, *lru_wa, *lru_ba, *lru_wx, *lru_bx, *lru_lambda,
        *rwkv_mu, *rwkv_wr, *rwkv_wk, *rwkv_wv, *rwkv_wo, *rwkv_w0, *rwkv_w1, *rwkv_w2, *rwkv_a0, *rwkv_a1, *rwkv_a2, *rwkv_g1, *rwkv_g2, *rwkv_kk, *rwkv_ka, *rwkv_rk, *rwkv_ln_g, *rwkv_ln_b,
        *norm_ffn, *moe_wc, *moe_bc, *moe_wf, *moe_bf, *moe_w_gu, *moe_w_down, *ple_norm, *ple_gate, *ple_proj, *final_norm;
};

__device__ __forceinline__ void prep_dense_weights(Frame& F, const In& I, unsigned char* ws) {
    LAS float* scr = (LAS float*)(F.lds + F.wave * 16384);
    const int gw = F.vcu * NWAVES + F.wave, NGW = F.G * NWAVES;
    bf16* WIN = (bf16*)(ws + WS_WIN); bf16* WOUT = (bf16*)(ws + WS_WOUT); bf16* PG = (bf16*)(ws + WS_PGATE); bf16* PPJ = (bf16*)(ws + WS_PPROJ);
    bf16* RCAT = (bf16*)(ws + WS_RCAT); bf16* RL1 = (bf16*)(ws + WS_RL1); bf16* RWO = (bf16*)(ws + WS_RWO);
    constexpr int I_IN = (1024 / 64) * (2560 / 32), I_SQ = (1024 / 64) * (1024 / 32), I_PJ = (256 / 64) * (1024 / 32), I_L64 = (1024 / 64) * (64 / 32), I_L160 = (1024 / 64) * (160 / 32);
    int st = gw;
#define TJOB(MODE, NITEMS, W, K, N, WT, LDO, ROFF, MU) do { for (int it = st; it < (NITEMS); it += NGW) transpose_item<MODE>(W, K, N, WT, LDO, ROFF, MU, scr, it, LANE_); \
        st = (st + NGW - ((NITEMS) % NGW)) % NGW; asm volatile("" : "+s"(st)); } while (0)
    TJOB(0, I_IN, I.ab_w_in, 1024, 2560, WIN, 1024, 0, nullptr);
    TJOB(0, I_SQ, I.ab_w_out, 1024, 1024, WOUT, 1024, 0, nullptr);
    TJOB(0, I_SQ, I.ple_gate, 1024, 1024, PG, 1024, 0, nullptr);
    TJOB(0, I_SQ, I.ple_gate + 1024 * 1024, 1024, 1024, PG + 1024 * 1024, 1024, 0, nullptr);
    TJOB(0, I_SQ, I.rwkv_wo, 1024, 1024, RWO, 1024, 0, nullptr);
    TJOB(0, I_SQ, I.rwkv_wr, 1024, 1024, RCAT, 1024, 0, nullptr);
    TJOB(0, I_SQ, I.rwkv_wk, 1024, 1024, RCAT, 1024, 1024, nullptr);
    TJOB(0, I_SQ, I.rwkv_wv, 1024, 1024, RCAT, 1024, 2048, nullptr);
    TJOB(0, I_PJ, I.ple_proj, 256, 1024, PPJ, 256, 0, nullptr);
    TJOB(0, I_PJ, I.ple_proj + 256 * 1024, 256, 1024, PPJ + 1024 * 256, 256, 0, nullptr);
    TJOB(1, I_L64, I.rwkv_w1, 1024, 64, RL1, 2048, 0, I.rwkv_mu + 1 * 1024);
    TJOB(1, I_L64, I.rwkv_a1, 1024, 64, RL1, 2048, 64, I.rwkv_mu + 4 * 1024);
    TJOB(1, I_L160, I.rwkv_g1, 1024, 160, RL1, 2048, 256, I.rwkv_mu + 5 * 1024);
#undef TJOB
    const int gt = F.vcu * 512 + TID_, NGT = F.G * 512;
    { v4u z = {0u, 0u, 0u, 0u}; const int per_row = 2048 / 8;
      for (int i = gt; i < (128 + 96) * per_row; i += NGT) { int rr = i / per_row, cc = i % per_row; rr = (rr < 128) ? (128 + rr) : (416 + rr - 128); *(GAS v4u*)(RL1 + (size_t)rr * 2048 + cc * 8) = z; } }
    { bf16* S2 = (bf16*)(ws + WS_RS2);
      for (int i = gt; i < 3 * 1024 * 256; i += NGT) { const int ty = i / (1024 * 256), n = (i / 256) & 1023, k = i & 255; float v = 0.f;
          if (ty == 0) { if (k < 64) v = I.rwkv_w2[k * 1024 + n]; } else if (ty == 1) { if (k >= 64 && k < 128) v = I.rwkv_a2[(k - 64) * 1024 + n]; } else { if (k < 160) v = I.rwkv_g2[k * 1024 + n]; }
          S2[i] = (bf16)f2bf(v); } }
    { bf16* RT = (bf16*)(ws + WS_ROUT);
      for (int i = gt; i < 2 * 256 * 1024; i += NGT) { const int l = i / (256 * 1024), n = (i / 1024) & 255, k = i & 1023; float v = 0.f;
          if (n < 4) v = I.moe_wc[(size_t)l * 1024 * 4 + k * 4 + n]; else if (n < 36) v = I.moe_wf[(size_t)l * 1024 * 32 + k * 32 + (n - 4)];
          RT[i] = (bf16)f2bf(v); } }
}
__device__ __forceinline__ void prep_layer_weights(Frame& F, const In& I, unsigned char* ws, int layer) {
    LAS float* scr = (LAS float*)(F.lds + F.wave * 16384);
    const int gw = F.vcu * NWAVES + F.wave, NGW = F.G * NWAVES;
    bf16* MGU = (bf16*)(ws + WS_MGU); bf16* MDN = (bf16*)(ws + WS_MDN);
    const float* wgu = I.moe_w_gu + (size_t)layer * NEXP * 1024 * 1024; const float* wdn = I.moe_w_down + (size_t)layer * NEXP * 512 * 1024;
    constexpr int I_GU = (1024 / 64) * (1024 / 32), I_DN = (512 / 64) * (1024 / 32);
    for (int it = gw; it < NEXP * (I_GU + I_DN); it += NGW) {
        const int e = it / (I_GU + I_DN); int r = it % (I_GU + I_DN);
        if (r < I_GU) transpose_item<2>(wgu + (size_t)e * 1024 * 1024, 1024, 1024, MGU + (size_t)e * 1024 * 1024, 1024, 0, nullptr, scr, r, LANE_);
        else transpose_item<0>(wdn + (size_t)e * 512 * 1024, 512, 1024, MDN + (size_t)e * 1024 * 512, 512, 0, nullptr, scr, r - I_GU, LANE_);
    }
    const int gt = F.vcu * 512 + TID_, NGT = F.G * 512;
    const f32x4* ps = (const f32x4*)(I.p + (size_t)layer * T * PLE); v2u* pd = (v2u*)(ws + WS_PB);
    for (int i = gt; i < T * PLE / 4; i += 4 * NGT) { f32x4 v[4];
#pragma unroll
        for (int r = 0; r < 4; ++r) v[r] = ps[i + r * NGT];
#pragma unroll
        for (int r = 0; r < 4; ++r) { v2u o; o.x = pk2(v[r].x, v[r].y); o.y = pk2(v[r].z, v[r].w); pd[i + r * NGT] = o; } }
}

template <bool XBF>
__device__ __forceinline__ void norm_pass(Frame& F, const void* x, const float* g, bf16* out) {
    const int gw = F.vcu * NWAVES + F.wave, NGW = F.G * NWAVES; const int lane = LANE_;
    for (int t = 4 * gw; t < T; t += 4 * NGW) {
        f32x4 v[4][4];
#pragma unroll
        for (int r = 0; r < 4; ++r) { if (XBF) load_row4_bf((const bf16*)x + (size_t)(t + r) * D, lane, v[r]); else load_row4((const float*)x + (size_t)(t + r) * D, lane, v[r]); }
#pragma unroll
        for (int r = 0; r < 4; ++r) { const float rs = row_rstd(v[r], 1e-6f); store_row_bf16(out + (size_t)(t + r) * D, lane, v[r], rs, g); }
    }
}
__device__ __forceinline__ void rwkv_input_pass(Frame& F, const bf16* x, const float* g, const float* mu, bf16* HCAT, bf16* XR, bf16* XK, bf16* XV) {
    const int gw = F.vcu * NWAVES + F.wave, NGW = F.G * NWAVES; const int lane = LANE_;
    f32x4 gg[4], mr[4], mk[4], mv[4];
#pragma unroll
    for (int j = 0; j < 4; ++j) { gg[j] = ((const f32x4*)g)[lane + 64 * j]; mr[j] = ((const f32x4*)(mu + 0 * 1024))[lane + 64 * j]; mk[j] = ((const f32x4*)(mu + 2 * 1024))[lane + 64 * j]; mv[j] = ((const f32x4*)(mu + 3 * 1024))[lane + 64 * j]; }
    for (int blk = gw; blk < T / 32; blk += NGW) {
        const int t0 = blk * 32; f32x4 hp[4];
        if ((t0 & (SEQ - 1)) == 0) {
#pragma unroll
            for (int j = 0; j < 4; ++j) hp[j] = (f32x4){0.f, 0.f, 0.f, 0.f};
        } else { f32x4 v[4]; load_row4_bf(x + (size_t)(t0 - 1) * D, lane, v); const float rstd = row_rstd(v, 1e-6f);
#pragma unroll
            for (int j = 0; j < 4; ++j) hp[j] = v[j] * rstd * gg[j]; }
        f32x4 vn[4]; load_row4_bf(x + (size_t)t0 * D, lane, vn);
        for (int t = t0; t < t0 + 32; ++t) {
            f32x4 v[4];
#pragma unroll
            for (int j = 0; j < 4; ++j) v[j] = vn[j];
            if (t + 1 < t0 + 32) load_row4_bf(x + (size_t)(t + 1) * D, lane, vn);
            const float rstd = row_rstd(v, 1e-6f);
            unsigned long long* oh = (unsigned long long*)(HCAT + (size_t)t * 2048) + lane; unsigned long long* or_ = (unsigned long long*)(XR + (size_t)t * 1024) + lane;
            unsigned long long* ok = (unsigned long long*)(XK + (size_t)t * 1024) + lane; unsigned long long* ov = (unsigned long long*)(XV + (size_t)t * 1024) + lane;
#pragma unroll
            for (int j = 0; j < 4; ++j) { const f32x4 h = v[j] * rstd * gg[j], dd = hp[j] - h;
                oh[64 * j] = (unsigned long long)pk2(h.x, h.y) | ((unsigned long long)pk2(h.z, h.w) << 32);
                oh[256 + 64 * j] = (unsigned long long)pk2(hp[j].x, hp[j].y) | ((unsigned long long)pk2(hp[j].z, hp[j].w) << 32);
                const f32x4 a = h + dd * mr[j], b = h + dd * mk[j], c = h + dd * mv[j];
                or_[64 * j] = (unsigned long long)pk2(a.x, a.y) | ((unsigned long long)pk2(a.z, a.w) << 32);
                ok[64 * j] = (unsigned long long)pk2(b.x, b.y) | ((unsigned long long)pk2(b.z, b.w) << 32);
                ov[64 * j] = (unsigned long long)pk2(c.x, c.y) | ((unsigned long long)pk2(c.z, c.w) << 32);
                hp[j] = h; }
        }
    }
}
__device__ __forceinline__ void combine_norm_pass(Frame& F, const bf16* xin, bf16* xout, const bf16* YS, const int* slot, const float* g, bf16* out) {
    const int gw = F.vcu * NWAVES + F.wave, NGW = F.G * NWAVES; const int lane = LANE_;
    for (int t = 2 * gw; t < T; t += 2 * NGW) {
        f32x4 v[2][4]; v2u ya[2][4], yb[2][4];
#pragma unroll
        for (int r = 0; r < 2; ++r) { load_row4_bf(xin + (size_t)(t + r) * D, lane, v[r]);
            const int s0 = slot[2 * (t + r)], s1 = slot[2 * (t + r) + 1];
            const v2u* y0 = (const v2u*)(YS + (size_t)s0 * D) + lane; const v2u* y1 = (const v2u*)(YS + (size_t)s1 * D) + lane;
#pragma unroll
            for (int j = 0; j < 4; ++j) { ya[r][j] = y0[64 * j]; yb[r][j] = y1[64 * j]; } }
#pragma unroll
        for (int r = 0; r < 2; ++r) {
#pragma unroll
            for (int j = 0; j < 4; ++j) { const v2u a = ya[r][j], b = yb[r][j];
                v[r][j].x += bflo(a.x) + bflo(b.x); v[r][j].y += bfhi(a.x) + bfhi(b.x); v[r][j].z += bflo(a.y) + bflo(b.y); v[r][j].w += bfhi(a.y) + bfhi(b.y); }
            store_row4_bf(xout + (size_t)(t + r) * D, lane, v[r]);
            const float rstd = row_rstd(v[r], 1e-6f);
            store_row_bf16(out + (size_t)(t + r) * D, lane, v[r], rstd, g); }
    }
}
__device__ __forceinline__ void final_norm_pass(Frame& F, const bf16* x, float* out, const float* g) {
    const int gw = F.vcu * NWAVES + F.wave, NGW = F.G * NWAVES; const int lane = LANE_;
    for (int t = 4 * gw; t < T; t += 4 * NGW) {
        f32x4 v[4][4];
#pragma unroll
        for (int r = 0; r < 4; ++r) load_row4_bf(x + (size_t)(t + r) * D, lane, v[r]);
#pragma unroll
        for (int r = 0; r < 4; ++r) { const float rs = row_rstd(v[r], 1e-6f); f32x4* xo = (f32x4*)(out + (size_t)(t + r) * D) + lane;
#pragma unroll
            for (int j = 0; j < 4; ++j) { const f32x4 gg = ((const f32x4*)g)[lane + 64 * j]; xo[64 * j] = v[r][j] * rs * gg; } }
    }
}

__device__ __forceinline__ void diff_combine_pass(Frame& F, const In& I, const bf16* O, bf16* YCAT) {
    const int gw = F.vcu * NWAVES + F.wave, NGW = F.G * NWAVES;
    const float lam_init = 0.2f;
    const float d1 = wave_sum(I.lam_q1[LANE_] * I.lam_k1[LANE_]), d2 = wave_sum(I.lam_q2[LANE_] * I.lam_k2[LANE_]);
    const float lam = expf(d1) - expf(d2) + lam_init;
    const int h = LANE_ >> 4, q = LANE_ & 15;
    float sg[8];
#pragma unroll
    for (int e = 0; e < 8; ++e) sg[e] = I.sub_g[q * 8 + e] * (1.0f - lam_init);
    for (int t0 = 4 * gw; t0 < T; t0 += 4 * NGW) {
        v4u av[4], bv[4];
#pragma unroll
        for (int r = 0; r < 4; ++r) { av[r] = *(const v4u*)(O + (size_t)(t0 + r) * 1024 + h * 256 + q * 8); bv[r] = *(const v4u*)(O + (size_t)(t0 + r) * 1024 + h * 256 + 128 + q * 8); }
#pragma unroll
        for (int r = 0; r < 4; ++r) { const v4u a = av[r], b = bv[r]; const int t = t0 + r;
        float o[8];
        o[0] = bflo(a.x) - lam * bflo(b.x); o[1] = bfhi(a.x) - lam * bfhi(b.x); o[2] = bflo(a.y) - lam * bflo(b.y); o[3] = bfhi(a.y) - lam * bfhi(b.y);
        o[4] = bflo(a.z) - lam * bflo(b.z); o[5] = bfhi(a.z) - lam * bfhi(b.z); o[6] = bflo(a.w) - lam * bflo(b.w); o[7] = bfhi(a.w) - lam * bfhi(b.w);
        float s = 0.f;
#pragma unroll
        for (int e = 0; e < 8; ++e) s += o[e] * o[e];
        s += __shfl_xor(s, 1); s += __shfl_xor(s, 2); s += __shfl_xor(s, 4); s += __shfl_xor(s, 8);
        const float rstd = 1.0f / sqrtf(s * (1.0f / 128.0f) + 1e-5f);
        v4u w; w.x = pk2(o[0] * rstd * sg[0], o[1] * rstd * sg[1]); w.y = pk2(o[2] * rstd * sg[2], o[3] * rstd * sg[3]); w.z = pk2(o[4] * rstd * sg[4], o[5] * rstd * sg[5]); w.w = pk2(o[6] * rstd * sg[6], o[7] * rstd * sg[7]);
        *(v4u*)(YCAT + (size_t)t * 1024 + h * 128 + q * 8) = w; }
    }
}

constexpr int LCT = 64, LNCH = SEQ / LCT;
__device__ __forceinline__ float gelu_tanh(float x) { const float u = 0.7978845608028654f * (x + 0.044715f * x * x * x); return x * sigmoidf_(2.0f * u); }
template <bool FINAL>
__device__ __forceinline__ void lru_phase(Frame& F, const In& I, const bf16* XB, const bf16* GB, f32x2* AGG, bf16* YCAT, bf16* HLp, bf16* CAp) {
    const int ch = TID_, n = ch >> 6, d = ch & 63;
    LAS float* U = (LAS float*)F.lds;
    f32x2 wg[64];
#pragma unroll
    for (int c = 0; c < 64; ++c) { wg[c].x = I.lru_wa[n * 4096 + c * 64 + d]; wg[c].y = I.lru_wx[n * 4096 + c * 64 + d]; }
    const float cw0 = I.conv_w[0 * 512 + ch], cw1 = I.conv_w[1 * 512 + ch], cw2 = I.conv_w[2 * 512 + ch], cw3 = I.conv_w[3 * 512 + ch], cb = I.conv_b[ch];
    const float ba = I.lru_ba[ch], bx = I.lru_bx[ch];
    const float lam = I.lru_lambda[ch]; const float sp = (lam > 15.f) ? expf(-lam) : log1pf(expf(-lam));
    const float m8sp = -8.0f * sp;
    for (int un = blockIdx.x; un < NB * LNCH; un += F.G) {
        const int b = un / LNCH, c = un % LNCH; const size_t row0 = (size_t)b * SEQ + (size_t)c * LCT;
        unsigned short xraw[LCT + 3];
        if (c > 0) { xraw[0] = XB[(row0 - 3) * 512 + ch]; xraw[1] = XB[(row0 - 2) * 512 + ch]; xraw[2] = XB[(row0 - 1) * 512 + ch]; } else { xraw[0] = 0; xraw[1] = 0; xraw[2] = 0; }
#pragma unroll
        for (int tk = 0; tk < LCT; ++tk) xraw[3 + tk] = XB[(row0 + tk) * 512 + ch];
        float h = 0.f, Ap = 1.f;
        if (FINAL) { for (int j = 0; j < c; ++j) { const f32x2 ag = AGG[((size_t)b * LNCH + j) * 512 + ch]; h = ag.x * h + ag.y; } }
#pragma unroll
        for (int tk = 0; tk < LCT; ++tk) U[tk * 512 + ch] = cw0 * bf1(xraw[tk]) + cw1 * bf1(xraw[tk + 1]) + cw2 * bf1(xraw[tk + 2]) + cw3 * bf1(xraw[tk + 3]) + cb;
        __syncthreads();
        unsigned short gcur[8], gnxt[8];
        if (FINAL) {
#pragma unroll
            for (int j = 0; j < 8; ++j) gcur[j] = GB[(row0 + j) * 512 + ch]; }
#pragma unroll 1
        for (int tg = 0; tg < LCT / 8; ++tg) {
            if (FINAL) { const int tn = (tg + 1 < LCT / 8) ? (tg + 1) * 8 : tg * 8;
#pragma unroll
                for (int j = 0; j < 8; ++j) gnxt[j] = GB[(row0 + tn + j) * 512 + ch]; }
#pragma unroll
            for (int j = 0; j < 8; ++j) { const int tk = tg * 8 + j;
                const LAS f32x4* up = (const LAS f32x4*)(U + tk * 512 + n * 64);
                f32x2 acc = {ba, bx};
#pragma unroll
                for (int c4 = 0; c4 < 16; ++c4) { const f32x4 uu = up[c4];
                    acc += wg[4 * c4 + 0] * uu.x; acc += wg[4 * c4 + 1] * uu.y; acc += wg[4 * c4 + 2] * uu.z; acc += wg[4 * c4 + 3] * uu.w; }
                const float r = sigmoidf_(acc.x), ig = sigmoidf_(acc.y);
                const float la = r * m8sp; const float a = __expf(la); const float t2 = 2.0f * la; const float om = (t2 > -0.02f) ? -t2 * (1.0f + t2 * (0.5f + t2 * (0.16666667f + t2 * 0.041666668f))) : 1.0f - a * a; const float bb = __builtin_amdgcn_sqrtf(om) * (ig * U[tk * 512 + ch]);
                h = a * h + bb;
                if (FINAL) { YCAT[(row0 + tk) * 1024 + 512 + ch] = (bf16)f2bf(h * gelu_tanh(bf1(gcur[j]))); }
                else { Ap *= a; HLp[(row0 + tk) * 512 + ch] = (bf16)f2bf(h); CAp[(row0 + tk) * 512 + ch] = (bf16)f2bf(Ap); } }
            if (FINAL) {
#pragma unroll
                for (int j = 0; j < 8; ++j) gcur[j] = gnxt[j]; }
        }
        if (!FINAL) { f32x2 ag; ag.x = Ap; ag.y = h; AGG[((size_t)b * LNCH + c) * 512 + ch] = ag; }
        __syncthreads();
    }
}

__device__ __forceinline__ void lru_agg_mfma(Frame& F, const In& I, const bf16* XB, f32x2* AGG, bf16* HLp, bf16* CAp) {
    const int tid = TID_, lane = tid & 63, fr = lane & 15, fq = lane >> 4, n = F.wave, ch = tid;
    constexpr int UP = 520;
    LAS bf16* U = (LAS bf16*)F.lds;
    bf16x8 Wr[4][2], Wi[4][2];
#pragma unroll
    for (int dd = 0; dd < 4; ++dd)
#pragma unroll
        for (int kh = 0; kh < 2; ++kh) { unsigned pr_[4], pi_[4];
#pragma unroll
            for (int j = 0; j < 4; ++j) { const int c0 = 32 * kh + 8 * fq + 2 * j, d = 16 * dd + fr;
                pr_[j] = pk2(I.lru_wa[n * 4096 + c0 * 64 + d], I.lru_wa[n * 4096 + (c0 + 1) * 64 + d]); pi_[j] = pk2(I.lru_wx[n * 4096 + c0 * 64 + d], I.lru_wx[n * 4096 + (c0 + 1) * 64 + d]); }
            Wr[dd][kh] = __builtin_bit_cast(bf16x8, (v4u){pr_[0], pr_[1], pr_[2], pr_[3]}); Wi[dd][kh] = __builtin_bit_cast(bf16x8, (v4u){pi_[0], pi_[1], pi_[2], pi_[3]}); }
    float cba[4], cbx[4], cm8[4];
#pragma unroll
    for (int dd = 0; dd < 4; ++dd) { const int chd = 64 * n + 16 * dd + fr; cba[dd] = I.lru_ba[chd]; cbx[dd] = I.lru_bx[chd];
        const float lam = I.lru_lambda[chd]; cm8[dd] = -8.0f * ((lam > 15.f) ? expf(-lam) : log1pf(expf(-lam))); }
    const float cw0 = I.conv_w[0 * 512 + ch], cw1 = I.conv_w[1 * 512 + ch], cw2 = I.conv_w[2 * 512 + ch], cw3 = I.conv_w[3 * 512 + ch], cb = I.conv_b[ch];
    for (int un = blockIdx.x; un < NB * LNCH; un += F.G) {
        const int b = un / LNCH, c = un % LNCH; const size_t row0 = (size_t)b * SEQ + (size_t)c * LCT;
        unsigned short xraw[LCT + 3];
        if (c > 0) { xraw[0] = XB[(row0 - 3) * 512 + ch]; xraw[1] = XB[(row0 - 2) * 512 + ch]; xraw[2] = XB[(row0 - 1) * 512 + ch]; } else { xraw[0] = 0; xraw[1] = 0; xraw[2] = 0; }
#pragma unroll
        for (int tk = 0; tk < LCT; ++tk) xraw[3 + tk] = XB[(row0 + tk) * 512 + ch];
#pragma unroll
        for (int tk = 0; tk < LCT; ++tk) U[tk * UP + ch] = (bf16)f2bf(cw0 * bf1(xraw[tk]) + cw1 * bf1(xraw[tk + 1]) + cw2 * bf1(xraw[tk + 2]) + cw3 * bf1(xraw[tk + 3]) + cb);
        __syncthreads();
        bf16x8 X[4][2];
#pragma unroll
        for (int tt = 0; tt < 4; ++tt)
#pragma unroll
            for (int kh = 0; kh < 2; ++kh) X[tt][kh] = *(const LAS bf16x8*)(U + (16 * tt + fr) * UP + 64 * n + 32 * kh + 8 * fq);
#pragma unroll 1
        for (int dd = 0; dd < 4; ++dd) {
            bf16x8 wr0, wr1, wi0, wi1; float kba, kbx, km8;
            if (dd == 0) { wr0 = Wr[0][0]; wr1 = Wr[0][1]; wi0 = Wi[0][0]; wi1 = Wi[0][1]; kba = cba[0]; kbx = cbx[0]; km8 = cm8[0]; }
            else if (dd == 1) { wr0 = Wr[1][0]; wr1 = Wr[1][1]; wi0 = Wi[1][0]; wi1 = Wi[1][1]; kba = cba[1]; kbx = cbx[1]; km8 = cm8[1]; }
            else if (dd == 2) { wr0 = Wr[2][0]; wr1 = Wr[2][1]; wi0 = Wi[2][0]; wi1 = Wi[2][1]; kba = cba[2]; kbx = cbx[2]; km8 = cm8[2]; }
            else { wr0 = Wr[3][0]; wr1 = Wr[3][1]; wi0 = Wi[3][0]; wi1 = Wi[3][1]; kba = cba[3]; kbx = cbx[3]; km8 = cm8[3]; }
            const int chd = 64 * n + 16 * dd + fr;
            float hc = 0.f, Ac = 1.f;
#pragma unroll
            for (int tt = 0; tt < 4; ++tt) {
                f32x4 pr = (f32x4){0.f, 0.f, 0.f, 0.f}, pi = pr;
                pr = __builtin_amdgcn_mfma_f32_16x16x32_bf16(X[tt][0], wr0, pr, 0, 0, 0); pr = __builtin_amdgcn_mfma_f32_16x16x32_bf16(X[tt][1], wr1, pr, 0, 0, 0);
                pi = __builtin_amdgcn_mfma_f32_16x16x32_bf16(X[tt][0], wi0, pi, 0, 0, 0); pi = __builtin_amdgcn_mfma_f32_16x16x32_bf16(X[tt][1], wi1, pi, 0, 0, 0);
                float a[4], bb[4];
#pragma unroll
                for (int e = 0; e < 4; ++e) { const int tok = 16 * tt + 4 * fq + e; const float u = bf1(U[tok * UP + chd]);
                    const float r = sigmoidf_(pr[e] + kba), ig = sigmoidf_(pi[e] + kbx); const float la = r * km8; a[e] = __expf(la); const float t2 = 2.0f * la;
                    const float om = (t2 > -0.02f) ? -t2 * (1.0f + t2 * (0.5f + t2 * (0.16666667f + t2 * 0.041666668f))) : 1.0f - a[e] * a[e]; bb[e] = __builtin_amdgcn_sqrtf(om) * (ig * u); }
                const float A4 = (a[0] * a[1]) * (a[2] * a[3]); const float B4 = ((bb[0] * a[1] + bb[1]) * a[2] + bb[2]) * a[3] + bb[3];
                float h = hc, Ap = Ac, hs = hc, As = Ac;
#pragma unroll
                for (int j = 0; j < 4; ++j) { const float Aj = __shfl(A4, fr + 16 * j), Bj = __shfl(B4, fr + 16 * j); if (j == fq) { hs = h; As = Ap; } h = Aj * h + Bj; Ap *= Aj; }
                hc = h; Ac = Ap; h = hs; Ap = As;
#pragma unroll
                for (int e = 0; e < 4; ++e) { h = a[e] * h + bb[e]; Ap *= a[e]; const size_t o = (row0 + 16 * tt + 4 * fq + e) * 512 + chd; HLp[o] = (bf16)f2bf(h); CAp[o] = (bf16)f2bf(Ap); }
            }
            if (fq == 0) { f32x2 ag; ag.x = Ac; ag.y = hc; AGG[((size_t)b * LNCH + c) * 512 + chd] = ag; }
        }
        __syncthreads();
    }
}

__device__ __forceinline__ void lru_final_pass(Frame& F, const bf16* HLp, const bf16* CAp, const bf16* GB, const f32x2* AGG, bf16* YCAT) {
    const int ch = TID_;
    for (int un = blockIdx.x; un < NB * LNCH; un += F.G) {
        const int b = un / LNCH, c = un % LNCH; const size_t row0 = (size_t)b * SEQ + (size_t)c * LCT;
        float carry = 0.f;
        for (int j = 0; j < c; ++j) { const f32x2 ag = AGG[((size_t)b * LNCH + j) * 512 + ch]; carry = ag.x * carry + ag.y; }
#pragma unroll 4
        for (int t8 = 0; t8 < LCT; t8 += 8) {
            bf16 hl[8], ca[8], gv[8];
#pragma unroll
            for (int j = 0; j < 8; ++j) { const size_t o = (row0 + t8 + j) * 512 + ch; hl[j] = HLp[o]; ca[j] = CAp[o]; gv[j] = GB[o]; }
#pragma unroll
            for (int j = 0; j < 8; ++j) { const float h = bf1(hl[j]) + bf1(ca[j]) * carry; YCAT[(row0 + t8 + j) * 1024 + 512 + ch] = (bf16)f2bf(h * gelu_tanh(bf1(gv[j]))); }
        }
    }
}

__device__ __forceinline__ void route_pass_a(Frame& F, const In& I, int layer, const float* LOG, unsigned char* rt, gu32* cnt) {
    LAS int* lcnt = (LAS int*)(F.lds + RTE_OFF); LAS int* lbase = lcnt + 32;
    int* EID = (int*)(rt + RT_EID); int* POS = (int*)(rt + RT_POS); float* GATE = (float*)(rt + RT_GATE);
    const float* bc = I.moe_bc + layer * 4; const float* bfb = I.moe_bf + layer * 32;
    for (int un = blockIdx.x; un < T / 512; un += F.G) {
        if (TID_ < 32) lcnt[TID_] = 0;
        __syncthreads();
        const int t = un * 512 + TID_; const float* lg = LOG + (size_t)t * 64;
        const f32x4 g4 = *(const f32x4*)lg;
        float gl[4] = {g4.x + bc[0], g4.y + bc[1], g4.z + bc[2], g4.w + bc[3]};
        int gi = 0; float gm = gl[0];
#pragma unroll
        for (int j = 1; j < 4; ++j) if (gl[j] > gm) { gm = gl[j]; gi = j; }
        float gs = 0.f;
#pragma unroll
        for (int j = 0; j < 4; ++j) gs += __expf(gl[j] - gm);
        const float gprob = 1.0f / gs;
        const f32x4 e0 = *(const f32x4*)(lg + 4 + gi * 8), e1 = *(const f32x4*)(lg + 8 + gi * 8);
        float el[8] = {e0.x, e0.y, e0.z, e0.w, e1.x, e1.y, e1.z, e1.w};
#pragma unroll
        for (int j = 0; j < 8; ++j) el[j] += bfb[gi * 8 + j];
        int i0 = 0; float m0 = el[0];
#pragma unroll
        for (int j = 1; j < 8; ++j) if (el[j] > m0) { m0 = el[j]; i0 = j; }
        int i1 = -1; float m1 = -INFINITY;
#pragma unroll
        for (int j = 0; j < 8; ++j) if (j != i0 && el[j] > m1) { m1 = el[j]; i1 = j; }
        const float r1 = __expf(m1 - m0); const float g0 = gprob / (1.0f + r1), g1 = gprob * r1 / (1.0f + r1);
        const int ex0 = gi * 8 + i0, ex1 = gi * 8 + i1;
        const int p0 = atomicAdd((int*)&lcnt[ex0], 1), p1 = atomicAdd((int*)&lcnt[ex1], 1);
        __syncthreads();
        if (TID_ < 32) lbase[TID_] = (int)__hip_atomic_fetch_add(cnt + TID_, (unsigned)lcnt[TID_], RLX_AGENT);
        __syncthreads();
        EID[2 * t] = ex0; EID[2 * t + 1] = ex1; POS[2 * t] = lbase[ex0] + p0; POS[2 * t + 1] = lbase[ex1] + p1; GATE[2 * t] = g0; GATE[2 * t + 1] = g1;
        __syncthreads();
    }
}
__device__ __forceinline__ void route_bases(Frame& F, gu32* cnt) {
    LAS int* eb = (LAS int*)(F.lds + RTE_OFF + 512);
    const int tid = TID_;
    if (tid < 64) {
        const int c = (tid < 32) ? (int)__hip_atomic_load(cnt + (tid & 31), RLX_AGENT) : 0; const int p = (c + 255) & ~255; int s = p;
#pragma unroll
        for (int o = 1; o < 32; o <<= 1) { const int t = __shfl_up(s, o); if ((tid & 63) >= o) s += t; }
        if (tid < 32) { eb[tid] = s - p; if (tid == 31) eb[32] = s; }
    }
    __syncthreads();
}
__device__ __forceinline__ void route_pass_b(Frame& F, unsigned char* rt, gu32* cnt) {
    route_bases(F, cnt);
    LAS int* eb = (LAS int*)(F.lds + RTE_OFF + 512);
    const int* EID = (const int*)(rt + RT_EID); const int* POS = (const int*)(rt + RT_POS); const float* GATE = (const float*)(rt + RT_GATE);
    int* ROWTOK = (int*)(rt + RT_ROWTOK); float* ROWGATE = (float*)(rt + RT_ROWGATE); int* SLOT = (int*)(rt + RT_SLOT);
    const int gt = F.vcu * 512 + TID_, NGT = F.G * 512;
    for (int i = gt; i < 2 * T; i += NGT) { const int dst = eb[EID[i]] + POS[i]; ROWTOK[dst] = i >> 1; ROWGATE[dst] = GATE[i]; SLOT[i] = dst; }
    for (int i = gt; i < 32 * 256; i += NGT) { const int e = i >> 8, j = i & 255; const int c = (int)__hip_atomic_load(cnt + e, RLX_AGENT); const int pad = ((c + 255) & ~255) - c;
        if (j < pad) { ROWTOK[eb[e] + c + j] = 0; ROWGATE[eb[e] + c + j] = 0.f; } }
    __syncthreads();
}
struct MoeOrder {
    int G, c, ntiles; const LAS int* eb; const char* A; const char* W; size_t astep, wexp, wtile; bool gather;
    __device__ bool next(int i, pg8::Unit& u) const {
        const int L = i * G + c; if (L >= ntiles * 4) return false;
        u.pm = L >> 2; u.pn = L & 3; const int s0 = u.pm * 256; int e = 0;
#pragma unroll 1
        for (int j = 1; j < 32; ++j) if (eb[j] <= s0) e = j;
        e = __builtin_amdgcn_readfirstlane(e); u.aux = e; u.A = gather ? A : A + (size_t)u.pm * astep; u.B = W + (size_t)e * wexp + (size_t)u.pn * wtile; return true;
    }
};

constexpr int RTC = 32, RNCH = SEQ / RTC, RTOK = 352;
#define LBAR() do { asm volatile("s_waitcnt lgkmcnt(0)" ::: "memory"); __builtin_amdgcn_s_barrier(); asm volatile("" ::: "memory"); } while (0)
template <int CTRL> __device__ __forceinline__ float dpp_f(float v) { return __builtin_bit_cast(float, __builtin_amdgcn_update_dpp(0, __builtin_bit_cast(int, v), CTRL, 0xf, 0xf, true)); }
__device__ __forceinline__ float red16(float v) { v += dpp_f<0xB1>(v); v += dpp_f<0x4E>(v); v += dpp_f<0x141>(v); v += dpp_f<0x140>(v); return v; }
__device__ __forceinline__ float red8(float v) { v += dpp_f<0xB1>(v); v += dpp_f<0x4E>(v); v += dpp_f<0x141>(v); return v; }
__device__ __forceinline__ void unpack8(const v4u w, float (&f)[8]) { f[0] = bflo(w.x); f[1] = bfhi(w.x); f[2] = bflo(w.y); f[3] = bfhi(w.y); f[4] = bflo(w.z); f[5] = bfhi(w.z); f[6] = bflo(w.w); f[7] = bfhi(w.w); }
__device__ __forceinline__ void rwkv_scan_phase(Frame& F, const In& I, const bf16* R, const bf16* Kt, const bf16* V, const bf16* AA, const bf16* EW, bf16* Y) {
    LAS float* buf = (LAS float*)F.lds;
    LAS float* ybuf = (LAS float*)(F.lds + 2 * RTC * RTOK * 4) + 32;
    const int tid = TID_, lane = tid & 63;
    const int seg = lane & 15, rl = F.wave * 4 + (lane >> 4);
    const int stk = tid >> 4, ssg = tid & 15;
    for (int un = blockIdx.x; un < NB * 16 * 2; un += F.G) {
        const int half = un & 1, h = (un >> 1) & 15, b = un >> 5;
        const size_t rowb = (size_t)b * SEQ;
        const int col = h * 64 + ssg * 4;
        const f32x4 kkw = *(const f32x4*)(I.rwkv_kk + col), kaw = *(const f32x4*)(I.rwkv_ka + col);
        v2u rr, kr, vr, ar, er;
#define RAW_LOAD(cc) do { const size_t off = (rowb + (size_t)(cc) * RTC + stk) * 1024 + col; rr = *(const v2u*)(R + off); kr = *(const v2u*)(Kt + off); vr = *(const v2u*)(V + off); ar = *(const v2u*)(AA + off); er = *(const v2u*)(EW + off); } while (0)
#define RAW_CONVERT(cc) do { LAS float* tp = buf + ((cc) & 1) * (RTC * RTOK) + stk * RTOK + ssg * 4; \
            const float r0 = bflo(rr.x), r1 = bfhi(rr.x), r2 = bflo(rr.y), r3 = bfhi(rr.y), k0 = bflo(kr.x), k1 = bfhi(kr.x), k2 = bflo(kr.y), k3 = bfhi(kr.y); \
            const float a0 = bflo(ar.x), a1 = bfhi(ar.x), a2 = bflo(ar.y), a3 = bfhi(ar.y); \
            const float x0 = k0 * kkw.x, x1 = k1 * kkw.y, x2 = k2 * kkw.z, x3 = k3 * kkw.w; \
            const float ss = red16((x0 * x0 + x1 * x1) + (x2 * x2 + x3 * x3)); const float inv = __builtin_amdgcn_rsqf(fmaxf(ss, 1e-24f)); \
            *(LAS f32x4*)(tp) = (f32x4){__expf(-bflo(er.x)), __expf(-bfhi(er.x)), __expf(-bflo(er.y)), __expf(-bfhi(er.y))}; \
            const f32x4 kkv = (f32x4){x0 * inv, x1 * inv, x2 * inv, x3 * inv}; *(LAS f32x4*)(tp + 64) = kkv; \
            *(LAS f32x4*)(tp + 128) = (f32x4){kkv.x * a0, kkv.y * a1, kkv.z * a2, kkv.w * a3}; \
            *(LAS f32x4*)(tp + 192) = (f32x4){k0 * (1.0f + (a0 - 1.0f) * kaw.x), k1 * (1.0f + (a1 - 1.0f) * kaw.y), k2 * (1.0f + (a2 - 1.0f) * kaw.z), k3 * (1.0f + (a3 - 1.0f) * kaw.w)}; \
            *(LAS f32x4*)(tp + 256) = (f32x4){r0, r1, r2, r3}; \
            if ((ssg >> 3) == half) *(LAS f32x4*)(buf + ((cc) & 1) * (RTC * RTOK) + stk * RTOK + 320 + (ssg & 7) * 4) = (f32x4){bflo(vr.x), bfhi(vr.x), bflo(vr.y), bfhi(vr.y)}; } while (0)
#define Y_WRITE(cc) do { const LAS f32x2* yp = (const LAS f32x2*)(ybuf + ((cc) & 1) * (RTC * 32 + 32) + stk * 32 + ssg * 2); const f32x2 yv = *yp; \
            *(unsigned*)(Y + (rowb + (size_t)(cc) * RTC + stk) * 1024 + h * 64 + half * 32 + ssg * 2) = pk2(yv.x, yv.y); } while (0)
        RAW_LOAD(0); RAW_CONVERT(0); RAW_LOAD(1);
        f32x2 S0 = (f32x2){0.f, 0.f}, S1 = (f32x2){0.f, 0.f};
        LBAR();
        for (int c = 0; c < RNCH; ++c) {
            if (c + 1 < RNCH) { RAW_CONVERT(c + 1); }
            if (c + 2 < RNCH) { RAW_LOAD(c + 2); }
            if (c >= 1) { Y_WRITE(c - 1); }
            const LAS float* cb = buf + (c & 1) * (RTC * RTOK); LAS float* yb = ybuf + (c & 1) * (RTC * 32 + 32);
            const LAS float* tp0 = cb + seg * 4; const LAS float* vp0 = cb + 320 + rl;
#define SV_DECL(X) f32x4 X##w, X##q, X##b, X##k, X##r; float X##v
#define SV_LOAD(X, tk) do { const LAS float* tp = tp0 + (tk) * RTOK; \
                X##w = *(const LAS f32x4*)(tp); X##q = *(const LAS f32x4*)(tp + 64); X##b = *(const LAS f32x4*)(tp + 128); X##k = *(const LAS f32x4*)(tp + 192); X##r = *(const LAS f32x4*)(tp + 256); X##v = vp0[(tk) * RTOK]; } while (0)
#define SV_STEP(X, tk) do { \
                const f32x2 d = S0 * (f32x2){X##q.x, X##q.y} + S1 * (f32x2){X##q.z, X##q.w}; \
                const f32x2 t0 = S0 * (f32x2){X##w.x, X##w.y} + (f32x2){X##k.x, X##k.y} * X##v, t1 = S1 * (f32x2){X##w.z, X##w.w} + (f32x2){X##k.z, X##k.w} * X##v; \
                float ra = d.x + d.y, rb = epend;                   \
                ra += dpp_f<0xB1>(ra); rb += dpp_f<0xB1>(rb); ra += dpp_f<0x4E>(ra); rb += dpp_f<0x4E>(rb); ra += dpp_f<0x141>(ra); rb += dpp_f<0x141>(rb); ra += dpp_f<0x140>(ra); rb += dpp_f<0x140>(rb); \
                if (seg == 0) yb[((tk) - 1) * 32 + rl] = rb;        \
                const float sa = -ra; \
                S0 = t0 + (f32x2){X##b.x, X##b.y} * sa; S1 = t1 + (f32x2){X##b.z, X##b.w} * sa; \
                const f32x2 e = S0 * (f32x2){X##r.x, X##r.y} + S1 * (f32x2){X##r.z, X##r.w}; epend = e.x + e.y; } while (0)
            SV_DECL(A_); SV_DECL(B_); float epend = 0.f;
            SV_LOAD(A_, 0);
#pragma unroll 1
            for (int tk = 0; tk < RTC; tk += 2) {
                SV_LOAD(B_, tk + 1);
                SV_STEP(A_, tk);
                { const int t2 = (tk + 2 < RTC) ? tk + 2 : RTC - 1; SV_LOAD(A_, t2); }
                SV_STEP(B_, tk + 1);
            }
#undef SV_DECL
#undef SV_LOAD
#undef SV_STEP
            { const float rb = red16(epend); if (seg == 0) yb[(RTC - 1) * 32 + rl] = rb; }
            LBAR();
        }
        Y_WRITE(RNCH - 1);
        LBAR();
#undef RAW_LOAD
#undef RAW_CONVERT
#undef Y_WRITE
    }
}
constexpr int CS_SLOT = 13056, CS_TL = 12544, CS_QT = 0, CS_RT = 2048, CS_BHT = 4096, CS_KHT = 6144, CS_VT = 8192, CS_TM = 10240, CS_MK = 10752, CS_NK = 11264, CS_NB = 11776, CS_DD = 12288;
constexpr int CS_TMP0 = 8 * CS_SLOT, CS_TMP = 5120, CS_KT = 0, CS_BT = 2048, CS_MB = 4096;
template <int N> __device__ __forceinline__ float dpp_shr(float v) { return __builtin_bit_cast(float, __builtin_amdgcn_update_dpp(0, __builtin_bit_cast(int, v), 0x110 + N, 0xf, 0xf, true)); }
__device__ __forceinline__ bf16x8 mk8(v2u a, v2u b) { return __builtin_bit_cast(bf16x8, (v4u){a.x, a.y, b.x, b.y}); }
__device__ __forceinline__ bf16x8 mk8z(v2u a) { return __builtin_bit_cast(bf16x8, (v4u){a.x, a.y, 0u, 0u}); }
__device__ __forceinline__ bf16x8 cvt8z(f32x4 v) { return __builtin_bit_cast(bf16x8, (v4u){pk2(v.x, v.y), pk2(v.z, v.w), 0u, 0u}); }
__device__ __forceinline__ void rwkv_scan_chunked(Frame& F, const In& I, const bf16* R, const bf16* Kt, const bf16* V, const bf16* AA, const bf16* EW, bf16* Y) {
    const int lane = LANE_, fr = lane & 15, fq = lane >> 4;
    LAS unsigned char* L = F.lds;
    const f32x4 zero4 = (f32x4){0.f, 0.f, 0.f, 0.f};
    for (int un = blockIdx.x; un < NB * 16; un += F.G) {
        const int h = un & 15, b = un >> 4; const size_t rowb = (size_t)b * SEQ;
        if (F.wave >= 4) {
            const int p = F.wave - 4; const int colb = h * 64 + 16 * fq;
            LAS unsigned char* tmp = L + CS_TMP0 + p * CS_TMP;
            float kkw[16], kaw[16];
#pragma unroll
            for (int e = 0; e < 16; ++e) { kkw[e] = I.rwkv_kk[colb + e]; kaw[e] = I.rwkv_ka[colb + e]; }
            v4u raw[10];
#define CK_LOAD(cidx) do { const size_t off = (rowb + (size_t)(cidx) * 16 + fr) * 1024 + colb; \
                raw[0] = *(const v4u*)(R + off); raw[1] = *(const v4u*)(R + off + 8); raw[2] = *(const v4u*)(Kt + off); raw[3] = *(const v4u*)(Kt + off + 8); raw[4] = *(const v4u*)(V + off); raw[5] = *(const v4u*)(V + off + 8); \
                raw[6] = *(const v4u*)(AA + off); raw[7] = *(const v4u*)(AA + off + 8); raw[8] = *(const v4u*)(EW + off); raw[9] = *(const v4u*)(EW + off + 8); } while (0)
            CK_LOAD(p);
            for (int rd = -1; rd < 127; ++rd) {
                const int cidx = 4 * (rd + 1) + p; LAS unsigned char* S = L + (((rd + 1) & 1) * 4 + p) * CS_SLOT;
                float r[16], k[16], a[16], ew[16]; const v4u vraw0 = raw[4], vraw1 = raw[5];
                { float t8[8];
                  unpack8(raw[0], t8);
#pragma unroll
                  for (int e = 0; e < 8; ++e) r[e] = t8[e];
                  unpack8(raw[1], t8);
#pragma unroll
                  for (int e = 0; e < 8; ++e) r[8 + e] = t8[e];
                  unpack8(raw[2], t8);
#pragma unroll
                  for (int e = 0; e < 8; ++e) k[e] = t8[e];
                  unpack8(raw[3], t8);
#pragma unroll
                  for (int e = 0; e < 8; ++e) k[8 + e] = t8[e];
                  unpack8(raw[6], t8);
#pragma unroll
                  for (int e = 0; e < 8; ++e) a[e] = t8[e];
                  unpack8(raw[7], t8);
#pragma unroll
                  for (int e = 0; e < 8; ++e) a[8 + e] = t8[e];
                  unpack8(raw[8], t8);
#pragma unroll
                  for (int e = 0; e < 8; ++e) ew[e] = t8[e];
                  unpack8(raw[9], t8);
#pragma unroll
                  for (int e = 0; e < 8; ++e) ew[8 + e] = t8[e]; }
                if (cidx + 4 < 512) CK_LOAD(cidx + 4);
                float kx[16], ss = 0.f;
#pragma unroll
                for (int e = 0; e < 16; ++e) { kx[e] = k[e] * kkw[e]; ss += kx[e] * kx[e]; }
                ss += __shfl_xor(ss, 16); ss += __shfl_xor(ss, 32);
                const float inv = __builtin_amdgcn_rsqf(fmaxf(ss, 1e-24f));
                unsigned qtw[8], rtw[8], ktw[8], btw[8];
#pragma unroll
                for (int e = 0; e < 16; e += 2) { float q2[2], r2[2], k2[2], b2[2], b2h[2], k2h[2];
#pragma unroll
                    for (int z = 0; z < 2; ++z) { const int ee = e + z;
                        float li = -ew[ee]; li += dpp_shr<1>(li); li += dpp_shr<2>(li); li += dpp_shr<4>(li); li += dpp_shr<8>(li);
                        const float l15 = __shfl(li, (lane & 48) | 15);
                        const float E1 = __builtin_amdgcn_exp2f(1.4426950408889634f * li), W1 = __builtin_amdgcn_exp2f(1.4426950408889634f * ew[ee]), E15 = __builtin_amdgcn_exp2f(1.4426950408889634f * l15);
                        const float Einv = __builtin_amdgcn_rcpf(E1);
                        const float kk = kx[ee] * inv, bb = a[ee] * kk, kp = k[ee] * (1.0f + (a[ee] - 1.0f) * kaw[ee]);
                        q2[z] = kk * (E1 * W1); k2[z] = kp * Einv; b2[z] = bb * Einv; r2[z] = r[ee] * E1;
                        const float eh = E15 * Einv; const int key = 16 * fq + ee;
                        b2h[z] = bb * eh; k2h[z] = kp * eh;
                        if (fr == 15) ((LAS float*)(S + CS_DD))[key] = E15; }
                    qtw[e >> 1] = pk2(q2[0], q2[1]); rtw[e >> 1] = pk2(r2[0], r2[1]); ktw[e >> 1] = pk2(k2[0], k2[1]); btw[e >> 1] = pk2(b2[0], b2[1]);
                    { const unsigned bw = pk2(b2h[0], b2h[1]), kw = pk2(k2h[0], k2h[1]); const unsigned vw = (e < 8) ? vraw0[(e & 7) >> 1] : vraw1[(e & 7) >> 1]; const int key = 16 * fq + e;
                      LAS bf16* bp = (LAS bf16*)(S + CS_BHT) + key * 16 + fr; LAS bf16* kp_ = (LAS bf16*)(S + CS_KHT) + key * 16 + fr; LAS bf16* vp = (LAS bf16*)(S + CS_VT) + key * 16 + fr;
                      bp[0] = (bf16)(bw & 0xffffu); bp[16] = (bf16)(bw >> 16); kp_[0] = (bf16)(kw & 0xffffu); kp_[16] = (bf16)(kw >> 16); vp[0] = (bf16)(vw & 0xffffu); vp[16] = (bf16)(vw >> 16); } }
                { const int o = (fr * 64 + 16 * fq) * 2;
                  *(LAS v4u*)(S + CS_QT + o) = (v4u){qtw[0], qtw[1], qtw[2], qtw[3]}; *(LAS v4u*)(S + CS_QT + o + 16) = (v4u){qtw[4], qtw[5], qtw[6], qtw[7]};
                  *(LAS v4u*)(S + CS_RT + o) = (v4u){rtw[0], rtw[1], rtw[2], rtw[3]}; *(LAS v4u*)(S + CS_RT + o + 16) = (v4u){rtw[4], rtw[5], rtw[6], rtw[7]};
                  *(LAS v4u*)(tmp + CS_KT + o) = (v4u){ktw[0], ktw[1], ktw[2], ktw[3]}; *(LAS v4u*)(tmp + CS_KT + o + 16) = (v4u){ktw[4], ktw[5], ktw[6], ktw[7]};
                  *(LAS v4u*)(tmp + CS_BT + o) = (v4u){btw[0], btw[1], btw[2], btw[3]}; *(LAS v4u*)(tmp + CS_BT + o + 16) = (v4u){btw[4], btw[5], btw[6], btw[7]}; }
                asm volatile("s_waitcnt lgkmcnt(0)" ::: "memory");
                f32x4 mb = zero4, mk = zero4, nb = zero4, nk = zero4;
#pragma unroll
                for (int kh = 0; kh < 2; ++kh) { const int o = (fr * 64 + 32 * kh + 8 * fq) * 2;
                    const bf16x8 Qf = *(const LAS bf16x8*)(S + CS_QT + o), Rf = *(const LAS bf16x8*)(S + CS_RT + o), Kf = *(const LAS bf16x8*)(tmp + CS_KT + o), Bf = *(const LAS bf16x8*)(tmp + CS_BT + o);
                    mb = __builtin_amdgcn_mfma_f32_16x16x32_bf16(Qf, Bf, mb, 0, 0, 0); mk = __builtin_amdgcn_mfma_f32_16x16x32_bf16(Qf, Kf, mk, 0, 0, 0);
                    nb = __builtin_amdgcn_mfma_f32_16x16x32_bf16(Rf, Bf, nb, 0, 0, 0); nk = __builtin_amdgcn_mfma_f32_16x16x32_bf16(Rf, Kf, nk, 0, 0, 0); }
#pragma unroll
                for (int e = 0; e < 4; e += 2) { const int tt = 4 * fq + e; const bool lo0 = fr < tt, le0 = fr <= tt, lo1 = fr < tt + 1, le1 = fr <= tt + 1;
                    ((LAS float*)(tmp + CS_MB))[tt * 16 + fr] = lo0 ? mb[e] : 0.f; ((LAS float*)(tmp + CS_MB))[(tt + 1) * 16 + fr] = lo1 ? mb[e + 1] : 0.f;
                    const unsigned wk = pk2(lo0 ? mk[e] : 0.f, lo1 ? mk[e + 1] : 0.f), wn = pk2(le0 ? nk[e] : 0.f, le1 ? nk[e + 1] : 0.f), wb = pk2(le0 ? nb[e] : 0.f, le1 ? nb[e + 1] : 0.f);
                    LAS bf16* pk_ = (LAS bf16*)(S + CS_MK) + tt * 16 + fr; LAS bf16* pn = (LAS bf16*)(S + CS_NK) + tt * 16 + fr; LAS bf16* pb = (LAS bf16*)(S + CS_NB) + tt * 16 + fr;
                    pk_[0] = (bf16)(wk & 0xffffu); pk_[16] = (bf16)(wk >> 16); pn[0] = (bf16)(wn & 0xffffu); pn[16] = (bf16)(wn >> 16); pb[0] = (bf16)(wb & 0xffffu); pb[16] = (bf16)(wb >> 16); }
                asm volatile("s_waitcnt lgkmcnt(0)" ::: "memory");
                { float Tc[16];
#pragma unroll
                  for (int t = 0; t < 16; ++t) { const LAS f32x4* mrow = (const LAS f32x4*)(tmp + CS_MB + t * 64); float acc = (t == fr) ? 1.0f : 0.0f;
#pragma unroll
                      for (int s4 = 0; s4 < 4; ++s4) { if (4 * s4 < t) { const f32x4 m4 = mrow[s4];
#pragma unroll
                              for (int z = 0; z < 4; ++z) if (4 * s4 + z < t) acc -= m4[z] * Tc[4 * s4 + z]; } }
                      Tc[t] = acc; }
                  if (fq == 0) {
#pragma unroll
                      for (int t = 0; t < 16; t += 2) { const unsigned hw = pk2(Tc[t], Tc[t + 1]); const unsigned lw = pk2(Tc[t] - bflo(hw), Tc[t + 1] - bfhi(hw));
                          LAS bf16* ph = (LAS bf16*)(S + CS_TM) + t * 16 + fr; LAS bf16* pl = (LAS bf16*)(S + CS_TL) + t * 16 + fr;
                          ph[0] = (bf16)(hw & 0xffffu); ph[16] = (bf16)(hw >> 16); pl[0] = (bf16)(lw & 0xffffu); pl[16] = (bf16)(lw >> 16); } } }
                LBAR();
            }
            LBAR();
#undef CK_LOAD
        } else {
            const int vt = F.wave;
            f32x4 Areg[4];
#pragma unroll
            for (int jt = 0; jt < 4; ++jt) Areg[jt] = zero4;
            LBAR();
            for (int rd = 0; rd < 128; ++rd) {
#pragma unroll 1
                for (int q = 0; q < 4; ++q) {
                    const LAS unsigned char* S = L + ((rd & 1) * 4 + q) * CS_SLOT; const size_t row0 = rowb + (size_t)(4 * rd + q) * 16;
                    bf16x8 Aq[2];
#pragma unroll
                    for (int kh = 0; kh < 2; ++kh) Aq[kh] = __builtin_bit_cast(bf16x8, (v4u){pk2(Areg[2 * kh].x, Areg[2 * kh].y), pk2(Areg[2 * kh].z, Areg[2 * kh].w), pk2(Areg[2 * kh + 1].x, Areg[2 * kh + 1].y), pk2(Areg[2 * kh + 1].z, Areg[2 * kh + 1].w)});
                    f32x4 X = zero4, YA = zero4;
#pragma unroll
                    for (int kh = 0; kh < 2; ++kh) { const int o = (fr * 64 + 32 * kh + 4 * fq) * 2;
                        const bf16x8 Pq = mk8(*(const LAS v2u*)(S + CS_QT + o), *(const LAS v2u*)(S + CS_QT + o + 32)), Pr = mk8(*(const LAS v2u*)(S + CS_RT + o), *(const LAS v2u*)(S + CS_RT + o + 32));
                        X = __builtin_amdgcn_mfma_f32_16x16x32_bf16(Pq, Aq[kh], X, 0, 0, 0); YA = __builtin_amdgcn_mfma_f32_16x16x32_bf16(Pr, Aq[kh], YA, 0, 0, 0); }
                    const bf16x8 Vq = mk8z(*(const LAS v2u*)(S + CS_VT + ((16 * vt + fr) * 16 + 4 * fq) * 2));
                    const int om = (fr * 16 + 4 * fq) * 2;
                    const bf16x8 Mkp = mk8z(*(const LAS v2u*)(S + CS_MK + om)), Nkp = mk8z(*(const LAS v2u*)(S + CS_NK + om)), Nbp = mk8z(*(const LAS v2u*)(S + CS_NB + om)), Tp = mk8z(*(const LAS v2u*)(S + CS_TM + om));
                    const f32x4 Z = __builtin_amdgcn_mfma_f32_16x16x32_bf16(Mkp, Vq, X, 0, 0, 0);
                    const bf16x8 Tl = mk8z(*(const LAS v2u*)(S + CS_TL + om));
                    const unsigned zw0 = pk2(Z[0], Z[1]), zw1 = pk2(Z[2], Z[3]);
                    const bf16x8 Zhq = __builtin_bit_cast(bf16x8, (v4u){zw0, zw1, 0u, 0u});
                    const f32x4 Zl = (f32x4){Z[0] - bflo(zw0), Z[1] - bfhi(zw0), Z[2] - bflo(zw1), Z[3] - bfhi(zw1)};
                    f32x4 U = __builtin_amdgcn_mfma_f32_16x16x32_bf16(Tp, cvt8z(Zl), zero4, 0, 0, 0);
                    U = __builtin_amdgcn_mfma_f32_16x16x32_bf16(Tl, Zhq, U, 0, 0, 0);
                    U = __builtin_amdgcn_mfma_f32_16x16x32_bf16(Tp, Zhq, U, 0, 0, 0);
                    const bf16x8 Uq = cvt8z(U);
                    f32x4 Yv = __builtin_amdgcn_mfma_f32_16x16x32_bf16(Nkp, Vq, YA, 0, 0, 0);
                    const f32x4 Yn = __builtin_amdgcn_mfma_f32_16x16x32_bf16(Nbp, Uq, zero4, 0, 0, 0);
                    Yv = Yv - Yn;
#pragma unroll
                    for (int e = 0; e < 4; e += 2) { const unsigned yw = pk2(Yv[e], Yv[e + 1]); bf16* yp = Y + (row0 + 4 * fq + e) * 1024 + h * 64 + 16 * vt + fr; yp[0] = (bf16)(yw & 0xffffu); yp[1024] = (bf16)(yw >> 16); }
#pragma unroll
                    for (int jt = 0; jt < 4; ++jt) { const int ok = ((16 * jt + fr) * 16 + 4 * fq) * 2;
                        const bf16x8 Khp = mk8z(*(const LAS v2u*)(S + CS_KHT + ok)), Bhp = mk8z(*(const LAS v2u*)(S + CS_BHT + ok));
                        const f32x4 Dv = *(const LAS f32x4*)(S + CS_DD + (16 * jt + 4 * fq) * 4);
                        f32x4 acc = Dv * Areg[jt];
                        acc = __builtin_amdgcn_mfma_f32_16x16x32_bf16(Khp, Vq, acc, 0, 0, 0);
                        const f32x4 nbu = __builtin_amdgcn_mfma_f32_16x16x32_bf16(Bhp, Uq, zero4, 0, 0, 0);
                        Areg[jt] = acc - nbu; }
                }
                LBAR();
            }
        }
    }
}
__device__ __forceinline__ void rwkv_post_pass(Frame& F, const In& I, const bf16* R, const bf16* Kt, const bf16* V, const bf16* AA, const bf16* G, bf16* Y) {
    const int gw = F.vcu * NWAVES + F.wave, NGW = F.G * NWAVES; const int col = LANE_ * 16;
    for (int t0 = 2 * gw; t0 < T; t0 += 2 * NGW) {
        v4u py[2][2], pr[2][2], pk[2][2], pv[2][2], pa[2][2], pg[2][2];
#pragma unroll
        for (int rw = 0; rw < 2; ++rw) { const size_t off = (size_t)(t0 + rw) * 1024 + col;
#pragma unroll
            for (int hf = 0; hf < 2; ++hf) { py[rw][hf] = *(const v4u*)(Y + off + hf * 8); pr[rw][hf] = *(const v4u*)(R + off + hf * 8); pk[rw][hf] = *(const v4u*)(Kt + off + hf * 8);
                pv[rw][hf] = *(const v4u*)(V + off + hf * 8); pa[rw][hf] = *(const v4u*)(AA + off + hf * 8); pg[rw][hf] = *(const v4u*)(G + off + hf * 8); } }
#pragma unroll
        for (int rw = 0; rw < 2; ++rw) { const size_t off = (size_t)(t0 + rw) * 1024 + col;
            float kaw[16], rkw[16], lng[16], lnb[16];
#pragma unroll
            for (int e4 = 0; e4 < 4; ++e4) { const f32x4 c0 = *(const GAS f32x4*)(I.rwkv_ka + col + 4 * e4), c1 = *(const GAS f32x4*)(I.rwkv_rk + col + 4 * e4), c2 = *(const GAS f32x4*)(I.rwkv_ln_g + col + 4 * e4), c3 = *(const GAS f32x4*)(I.rwkv_ln_b + col + 4 * e4);
#pragma unroll
                for (int e = 0; e < 4; ++e) { kaw[4 * e4 + e] = c0[e]; rkw[4 * e4 + e] = c1[e]; lng[4 * e4 + e] = c2[e]; lnb[4 * e4 + e] = c3[e]; } }
            float y[16], r[16], k[16], v[16], a[16], g[16];
#pragma unroll
            for (int hf = 0; hf < 2; ++hf) { float t8[8];
                unpack8(py[rw][hf], t8);
#pragma unroll
                for (int e = 0; e < 8; ++e) y[hf * 8 + e] = t8[e];
                unpack8(pr[rw][hf], t8);
#pragma unroll
                for (int e = 0; e < 8; ++e) r[hf * 8 + e] = t8[e];
                unpack8(pk[rw][hf], t8);
#pragma unroll
                for (int e = 0; e < 8; ++e) k[hf * 8 + e] = t8[e];
                unpack8(pv[rw][hf], t8);
#pragma unroll
                for (int e = 0; e < 8; ++e) v[hf * 8 + e] = t8[e];
                unpack8(pa[rw][hf], t8);
#pragma unroll
                for (int e = 0; e < 8; ++e) a[hf * 8 + e] = t8[e];
                unpack8(pg[rw][hf], t8);
#pragma unroll
                for (int e = 0; e < 8; ++e) g[hf * 8 + e] = t8[e]; }
            float s = 0.f, bs = 0.f;
#pragma unroll
            for (int e = 0; e < 16; ++e) { s += y[e]; const float kp = k[e] * (1.0f + (a[e] - 1.0f) * kaw[e]); bs += r[e] * kp * rkw[e]; }
            s += __shfl_xor(s, 1); s += __shfl_xor(s, 2); bs += __shfl_xor(bs, 1); bs += __shfl_xor(bs, 2);
            const float mean = s * (1.0f / 64.0f); float q = 0.f;
#pragma unroll
            for (int e = 0; e < 16; ++e) { const float dd = y[e] - mean; q += dd * dd; }
            q += __shfl_xor(q, 1); q += __shfl_xor(q, 2);
            const float rstd = 1.0f / sqrtf(q * (1.0f / 64.0f) + 64e-5f);
            float o[16];
#pragma unroll
            for (int e = 0; e < 16; ++e) o[e] = ((y[e] - mean) * rstd * lng[e] + lnb[e] + bs * v[e]) * g[e];
            v4u w0, w1; w0.x = pk2(o[0], o[1]); w0.y = pk2(o[2], o[3]); w0.z = pk2(o[4], o[5]); w0.w = pk2(o[6], o[7]); w1.x = pk2(o[8], o[9]); w1.y = pk2(o[10], o[11]); w1.z = pk2(o[12], o[13]); w1.w = pk2(o[14], o[15]);
            *(v4u*)(Y + off) = w0; *(v4u*)(Y + off + 8) = w1; }
    }
}

#ifndef DUP_K
#define DUP_K (-1)
#endif
#ifndef DUP_K2
#define DUP_K2 (-1)
#endif
#define KARGS ((const __attribute__((address_space(4))) Args*)__builtin_amdgcn_kernarg_segment_ptr())
#define WSPTRS \
    bf16* H0 = (bf16*)(ws + WS_H0); bf16* QKV = (bf16*)(ws + WS_QKV); bf16* OB = (bf16*)(ws + WS_O); f32x2* AGG = (f32x2*)(ws + WS_LRUAGG); \
    bf16* H2 = (bf16*)(ws + WS_H2); float* LOG = (float*)(ws + WS_LOG); unsigned char* RTE = ws + WS_ROUTE; bf16* HID = (bf16*)(ws + WS_HID); bf16* YS = (bf16*)(ws + WS_YS); bf16* PP = (bf16*)(ws + WS_PP); \
    bf16* HCAT = (bf16*)(ws + WS_HCAT); bf16* RB = (bf16*)(ws + WS_R); bf16* KB = (bf16*)(ws + WS_K); bf16* VB = (bf16*)(ws + WS_V); bf16* XRB = (bf16*)(ws + WS_XR); bf16* XKB = (bf16*)(ws + WS_XK); bf16* XVB = (bf16*)(ws + WS_XV); bf16* MID = (bf16*)(ws + WS_MID); bf16* EWB = (bf16*)(ws + WS_EW); bf16* AAB = (bf16*)(ws + WS_AA); bf16* YB = (bf16*)(ws + WS_Y); \
    const size_t TD = (size_t)T * 1024; (void)H0; (void)QKV; (void)OB; (void)AGG; (void)H2; (void)LOG; (void)RTE; (void)HID; (void)YS; (void)PP; (void)HCAT; (void)RB; (void)KB; (void)VB; (void)XRB; (void)XKB; (void)XVB; (void)MID; (void)EWB; (void)AAB; (void)YB; (void)TD;

struct Args { In in; float* out; unsigned char* ws; int ph_lo, ph_hi; };
constexpr int N_PHASES = 34;
__device__ __forceinline__ int nrep(int k) { int n = (k == DUP_K) ? 2 : 1; if (DUP_K >= 0) asm volatile("" : "+s"(n)); return n; }
#define REP_SYNC if (rep_) __syncthreads();
typedef const __attribute__((address_space(4))) unsigned long long* kp64;
__device__ __forceinline__ void load_in(In& I) { kp64 s = (kp64)__builtin_amdgcn_kernarg_segment_ptr(); unsigned long long* d = (unsigned long long*)&I;
#pragma unroll
    for (int i = 0; i < 47; ++i) d[i] = s[i]; }

__device__ __forceinline__ int t5_bucket(int n) { if (n < 16) return n; const float v = logf((float)n / 16.0f) / 2.0794415416798357f * 16.0f; const int l = 16 + (int)v; return l < 31 ? l : 31; }

template <class Epi>
__device__ __forceinline__ void dense_gemm(Frame& F, const void* A, int lda, const void* B, int K, int M, int N, const Epi& E) {
    pg8::DenseOrder S; S.init(A, lda, B, K, M, N, F.G, (int)blockIdx.x);
    pg8::gemm_phase<Epi, pg8::DenseOrder, true, false>(F.lds, K, lda, S, E, nullptr, TID_);
}

__global__ void __launch_bounds__(NWAVES * 64, 2) mk_fwd(Args args) {
    extern __shared__ __attribute__((aligned(16))) unsigned char lds[];
    Frame F;
    F.lds = (LAS unsigned char*)lds;
    F.MISC = (volatile LAS unsigned*)(F.lds + MISC_OFF);
    { int w_ = __builtin_amdgcn_readfirstlane((int)threadIdx.x >> 6); asm volatile("" : "+s"(w_)); F.wave = w_; }
    F.G = gridDim.x; { const int bx = blockIdx.x; F.vcu = (F.G % 8 == 0) ? (bx % 8) * (F.G / 8) + bx / 8 : bx; }
    F.ctl = (gu32*)(KARGS->ws + WS_CTL);
    for (int u = TID_; u < (LDS_BYTES - LDSCTL_OFF) / 4; u += NWAVES * 64) ((LAS unsigned*)(F.lds + LDSCTL_OFF))[u] = 0u;
    __syncthreads();
    {
        LAS float* tb = (LAS float*)(F.lds + TB_OFF); const int h = TID_ >> 7, i = TID_ & 127;
        const float* rb = KARGS->in.rel_bias;
        tb[h * 128 + i] = (rb[t5_bucket(i) * 4 + h] - rb[31 * 4 + h]) * 1.4426950408889634f;
    }
    __syncthreads();
    const int lo = KARGS->ph_lo, hi = KARGS->ph_hi;
    const bool multi = (hi - lo) > 1;
    XcdBarrier bar; bar.bar = (unsigned*)(F.ctl + CW_BAR); bar.x = 0; bar.st = nullptr;
    if (multi) bar = xcd_barrier_post((unsigned*)(F.ctl + CW_BAR), F.MISC + 8, TID_ == 0);
#define IN(k) (lo <= (k) && (k) < hi)
#define PH_BEGIN_ unsigned char* ws = KARGS->ws; bf16* X = (bf16*)KARGS->out; float* OUT = KARGS->out; (void)OUT; bf16* GB2 = (bf16*)KARGS->out + (size_t)T * 1024; (void)GB2; In I; load_in(I); (void)X; WSPTRS
#define SEAM(k) do { if (IN(k) && IN((k) + 1)) xcd_barrier(bar, TID_ == 0); } while (0)

    if (IN(0)) { PH_BEGIN_ prep_dense_weights(F, I, ws); prep_layer_weights(F, I, ws, 0); norm_pass<false>(F, I.x, I.norm_mix, H0);
#ifdef DUP_PREP
        __syncthreads(); prep_dense_weights(F, I, ws); prep_layer_weights(F, I, ws, 0);
#endif
    } SEAM(0);
    if (IN(1)) { PH_BEGIN_ pg8::EpiBf16 E{QKV, 512, 512, (size_t)T * 512, attn_body::C2}; dense_gemm(F, H0, 1024, ws + WS_WIN, 1024, T, AB_IN, E); } SEAM(1);
    if (IN(2)) { PH_BEGIN_ lru_agg_mfma(F, I, QKV + 3 * (size_t)T * 512, AGG, (bf16*)(ws + WS_HL), (bf16*)(ws + WS_CA)); } SEAM(2);
    if (IN(3)) { PH_BEGIN_
        const attn_body::AttnTensors AT{(const attn_body::bf16*)QKV, (const attn_body::bf16*)(QKV + (size_t)T * 512), (const attn_body::bf16*)(QKV + 2 * (size_t)T * 512), (attn_body::bf16*)OB};
        if (F.G == 256) attn_body::attn_phase<8>((char*)lds, AT, F.vcu, (const LAS float*)(F.lds + TB_OFF), (int)threadIdx.x);
#ifdef DUP_ATTN
        __syncthreads(); if (F.G == 256) attn_body::attn_phase<8>((char*)lds, AT, F.vcu, (const LAS float*)(F.lds + TB_OFF), (int)threadIdx.x);
#endif
        __syncthreads();
        lru_final_pass(F, (const bf16*)(ws + WS_HL), (const bf16*)(ws + WS_CA), QKV + 4 * (size_t)T * 512, AGG, H0);
    } SEAM(3);
    if (IN(4)) { PH_BEGIN_ diff_combine_pass(F, I, OB, H0); } SEAM(4);
    if (IN(5)) { PH_BEGIN_ pg8::EpiResX<false> E{I.x, X}; dense_gemm(F, H0, 1024, ws + WS_WOUT, 1024, T, 1024, E); } SEAM(5);

#define MOE_PLE_PHASES(P, L) \
    if (IN(P + 0)) { PH_BEGIN_ norm_pass<true>(F, X, I.norm_ffn + (L) * 1024, H2); } SEAM(P + 0); \
    if (IN(P + 1)) { PH_BEGIN_ pg8::EpiRouter E{LOG}; dense_gemm(F, H2, 1024, ws + WS_ROUT + (size_t)(L) * 256 * 1024 * 2, 1024, T, 256, E); } SEAM(P + 1); \
    if (IN(P + 2)) { PH_BEGIN_ route_pass_a(F, I, (L), LOG, RTE, F.ctl + ((L) ? CW_CNT1 : CW_CNT0)); } SEAM(P + 2); \
    if (IN(P + 3)) { PH_BEGIN_ route_pass_b(F, RTE, F.ctl + ((L) ? CW_CNT1 : CW_CNT0)); } SEAM(P + 3); \
    if (IN(P + 4)) { PH_BEGIN_ route_bases(F, F.ctl + ((L) ? CW_CNT1 : CW_CNT0)); const LAS int* eb = (const LAS int*)(F.lds + RTE_OFF + 512); \
        MoeOrder S{F.G, (int)blockIdx.x, __builtin_amdgcn_readfirstlane(eb[32] >> 8), eb, (const char*)H2, (const char*)(ws + WS_MGU), 0, (size_t)1024 * 1024 * 2, (size_t)256 * 1024 * 2, true}; pg8::EpiGU E{HID}; \
        pg8::gemm_phase<pg8::EpiGU, MoeOrder, true, true>(F.lds, 1024, 1024, S, E, (const int*)(RTE + RT_ROWTOK), TID_); } SEAM(P + 4); \
    if (IN(P + 5)) { PH_BEGIN_ route_bases(F, F.ctl + ((L) ? CW_CNT1 : CW_CNT0)); const LAS int* eb = (const LAS int*)(F.lds + RTE_OFF + 512); \
        MoeOrder S{F.G, (int)blockIdx.x, __builtin_amdgcn_readfirstlane(eb[32] >> 8), eb, (const char*)HID, (const char*)(ws + WS_MDN), (size_t)256 * 512 * 2, (size_t)1024 * 512 * 2, (size_t)256 * 512 * 2, false}; pg8::EpiDown E{YS, (const float*)(RTE + RT_ROWGATE)}; \
        pg8::gemm_phase<pg8::EpiDown, MoeOrder, true, false>(F.lds, 512, 512, S, E, nullptr, TID_); } SEAM(P + 5); \
    if (IN(P + 6)) { PH_BEGIN_ combine_norm_pass(F, X, X, YS, (const int*)(RTE + RT_SLOT), I.ple_norm + (L) * 1024, H2); } SEAM(P + 6); \
    if (IN(P + 7)) { PH_BEGIN_ pg8::EpiBf16 E{PP, 1024, 0, 0, 1.f}; dense_gemm(F, ws + WS_PB, 256, ws + WS_PPROJ + (size_t)(L) * 1024 * 256 * 2, 256, T, 1024, E); } SEAM(P + 7); \
    if (IN(P + 8)) { PH_BEGIN_ pg8::EpiPle E{X, (L) ? (bf16*)(ws + WS_YS) : X, PP}; dense_gemm(F, H2, 1024, ws + WS_PGATE + (size_t)(L) * 1024 * 1024 * 2, 1024, T, 1024, E); } SEAM(P + 8);

    MOE_PLE_PHASES(6, 0)
    if (IN(15)) { PH_BEGIN_ rwkv_input_pass(F, X, I.norm_mix + 1024, I.rwkv_mu, HCAT, XRB, XKB, XVB); } SEAM(15);
    if (IN(16)) { PH_BEGIN_ { pg8::EpiBf16 E{RB, 1024, 0, 0, 1.f}; dense_gemm(F, XRB, 1024, ws + WS_RCAT, 1024, T, 1024, E); }
        { pg8::EpiMid E{MID}; dense_gemm(F, HCAT, 2048, ws + WS_RL1, 2048, T, 512, E); } } SEAM(16);
    if (IN(17)) { PH_BEGIN_ pg8::EpiBf16 E{KB, 1024, 0, 0, 1.f}; dense_gemm(F, XKB, 1024, ws + WS_RCAT + (size_t)1024 * 1024 * 2, 1024, T, 1024, E); } SEAM(17);
    if (IN(18)) { PH_BEGIN_ pg8::EpiBf16 E{VB, 1024, 0, 0, 1.f}; dense_gemm(F, XVB, 1024, ws + WS_RCAT + (size_t)2 * 1024 * 1024 * 2, 1024, T, 1024, E); } SEAM(18);
    if (IN(19)) { PH_BEGIN_ pg8::EpiRwkv2 E{EWB, AAB, I.rwkv_w0, I.rwkv_a0, 0}; dense_gemm(F, MID, 512, ws + WS_RS2, 256, T, 2048, E); } SEAM(19);
    if (IN(20)) { PH_BEGIN_
        if (F.G == 256 && blockIdx.x >= 128) {
            Frame F2 = F; F2.G = 128; F2.vcu = (int)blockIdx.x - 128;
            prep_layer_weights(F2, I, ws, 1);
            __syncthreads();
            pg8::EpiRwkv2 E{GB2, GB2, nullptr, nullptr, 2}; pg8::DenseOrder S; S.init(MID + 256, 512, ws + WS_RS2 + (size_t)2 * 1024 * 256 * 2, 256, T, 1024, 128, (int)blockIdx.x - 128);
            pg8::gemm_phase<pg8::EpiRwkv2, pg8::DenseOrder, true, false>(F.lds, 256, 512, S, E, nullptr, TID_);
        } else rwkv_scan_chunked(F, I, RB, KB, VB, AAB, EWB, YB);
    } SEAM(20);
    if (IN(21)) { } SEAM(21);
    if (IN(22)) { PH_BEGIN_ rwkv_post_pass(F, I, RB, KB, VB, AAB, GB2, YB); } SEAM(22);
    if (IN(23)) { PH_BEGIN_ pg8::EpiResX<true> E{X, X}; dense_gemm(F, YB, 1024, ws + WS_RWO, 1024, T, 1024, E); } SEAM(23);
    MOE_PLE_PHASES(24, 1)
    if (IN(33)) { PH_BEGIN_ final_norm_pass(F, (const bf16*)(ws + WS_YS), OUT, I.final_norm); }
#undef IN
#undef SEAM
}

extern "C" void kernel_launch(void* const* d_in, const int* in_sizes, int n_in, void* d_out, int out_size, void* d_ws, size_t ws_size, hipStream_t stream) {
    static int ok = 0;
    if (ok == 0) {
        if (n_in != 47 || out_size != T * D || ws_size < WS_END) { fprintf(stderr, "kernel_launch: unexpected problem shape (n_in %d out %d ws %zu)\n", n_in, out_size, ws_size); ok = -1; return; }
        if (hipFuncSetAttribute((const void*)mk_fwd, hipFuncAttributeMaxDynamicSharedMemorySize, LDS_BYTES) != hipSuccess) { fprintf(stderr, "kernel_launch: hipFuncSetAttribute failed\n"); ok = -1; return; }
        int per_cu = 0;
        if (hipOccupancyMaxActiveBlocksPerMultiprocessor(&per_cu, (const void*)mk_fwd, NWAVES * 64, LDS_BYTES) != hipSuccess || per_cu < 1) fprintf(stderr, "kernel_launch: occupancy query reports %d\n", per_cu);
        (void)hipGetLastError();
        ok = 1;
    }
    if (ok < 0) return;
    (void)hipMemsetAsync((char*)d_ws + WS_CTL, 0, CTL_ZERO_BYTES, stream);
    Args a{};
    const float** ip = (const float**)&a.in;
    for (int i = 0; i < 47; ++i) ip[i] = (const float*)d_in[i];
    a.out = (float*)d_out; a.ws = (unsigned char*)d_ws;
    const int grid = 256;
#if MK_ONE_LAUNCH
    a.ph_lo = 0; a.ph_hi = N_PHASES;
    hipLaunchKernelGGL(mk_fwd, dim3(grid), dim3(NWAVES * 64), LDS_BYTES, stream, a);
#else
    for (int k = 0; k < N_PHASES; ++k) { a.ph_lo = k; a.ph_hi = k + 1; hipLaunchKernelGGL(mk_fwd, dim3(grid), dim3(NWAVES * 64), LDS_BYTES, stream, a);
        if (k == DUP_K || k == DUP_K2) hipLaunchKernelGGL(mk_fwd, dim3(grid), dim3(NWAVES * 64), LDS_BYTES, stream, a); }
#endif
}
```

```cpp
#include <hip/hip_runtime.h>
#include <hip/hip_bf16.h>
#include <cstdio>
#include <cstdint>
#include <cmath>

#ifndef MK_ONE_LAUNCH
#define MK_ONE_LAUNCH 1
#endif

#define GAS __attribute__((address_space(1)))
#define LAS __attribute__((address_space(3)))
typedef unsigned short bf16;
typedef unsigned v4u __attribute__((ext_vector_type(4)));
typedef unsigned v2u __attribute__((ext_vector_type(2)));
typedef float f32x4 __attribute__((ext_vector_type(4)));
typedef float f32x2 __attribute__((ext_vector_type(2)));
typedef short bf16x8 __attribute__((ext_vector_type(8)));
typedef GAS unsigned gu32;
#define RLX_AGENT __ATOMIC_RELAXED, __HIP_MEMORY_SCOPE_AGENT
#define LDS_WAIT() asm volatile("s_waitcnt lgkmcnt(0)" ::: "memory")
#define VM_WAIT() asm volatile("s_waitcnt vmcnt(0)" ::: "memory")
__device__ __forceinline__ unsigned f2bf(float f) { unsigned u = __builtin_bit_cast(unsigned, f); return (u + 0x7fffu + ((u >> 16) & 1u)) >> 16; }
typedef float f32x2_cv __attribute__((ext_vector_type(2))); typedef __bf16 bf16x2_cv __attribute__((ext_vector_type(2)));
__device__ __forceinline__ unsigned pk2(float lo, float hi) { const f32x2_cv v = {lo, hi}; const bf16x2_cv b = __builtin_convertvector(v, bf16x2_cv); return __builtin_bit_cast(unsigned, b); }
__device__ __forceinline__ float bflo(unsigned w) { return __uint_as_float(w << 16); }
__device__ __forceinline__ float bfhi(unsigned w) { return __uint_as_float(w & 0xffff0000u); }
__device__ __forceinline__ float bf1(bf16 h) { return __uint_as_float((unsigned)h << 16); }
__device__ __forceinline__ float sigmoidf_(float x) { return __builtin_amdgcn_rcpf(1.0f + __builtin_amdgcn_exp2f(-1.4426950408889634f * x)); }
__device__ __forceinline__ float tanhf_(float x) { return 1.0f - 2.0f * __builtin_amdgcn_rcpf(1.0f + __builtin_amdgcn_exp2f(2.885390081777927f * x)); }
__device__ __forceinline__ void fmac_(float& acc, float a, float b) { asm("v_fmac_f32 %0, %1, %2" : "+v"(acc) : "v"(a), "v"(b)); }
__device__ __forceinline__ float fma_(float a, float b, float c) { float r; asm("v_fma_f32 %0, %1, %2, %3" : "=v"(r) : "v"(a), "v"(b), "v"(c)); return r; }
__device__ __forceinline__ float mul_(float a, float b) { float r; asm("v_mul_f32 %0, %1, %2" : "=v"(r) : "v"(a), "v"(b)); return r; }
__device__ __forceinline__ float wave_sum(float v) {
#pragma unroll
    for (int o = 1; o < 64; o <<= 1) v += __shfl_xor(v, o);
    return v;
}

constexpr int NB = 8, SEQ = 8192, D = 1024, T = NB * SEQ;
constexpr int AB_IN = 2560, PLE = 256;
constexpr int NEXP = 32, EH = 512;
constexpr int MAXSLOT = 2 * T + NEXP * 256;
constexpr int MAXTILES = MAXSLOT / 256;

namespace pg8 {
#define PG8_LAS __attribute__((address_space(3)))
typedef unsigned short bf16_t;
typedef unsigned u32x4 __attribute__((ext_vector_type(4)));
typedef unsigned u32x2 __attribute__((ext_vector_type(2)));
constexpr int BM = 256, BK = 64, HALF = 128, HTB = HALF * BK * 2, STAGE_BYTES = 8 * HTB, NXCD = 8, WGM = 8;
__host__ __device__ __forceinline__ int lds_byte(int r, int c) { const int st = (r >> 4) * 2 + (c >> 5), rr = r & 15, cc = c & 31, ob = rr * 64 + cc * 2; return st * 1024 + (ob ^ (((ob >> 9) & 1) << 5)); }
__host__ __device__ __forceinline__ void stage_rc(int b, int& R, int& C) { const int st = b / 1024, sb = b % 1024, swz = sb ^ (((sb >> 9) & 1) << 5); R = (st >> 1) * 16 + swz / 64; C = (st & 1) * 32 + (swz % 64) / 2; }
__host__ __device__ __forceinline__ int perm32(int rho) { const int n = rho >> 4, i = rho & 15; return 8 * (i >> 2) + 4 * n + (i & 3); }

struct Unit { int pm, pn, aux; const char* A; const char* B; };

struct DenseOrder {
    int nM, nN, nwg, G, c; const char* A; const char* B; size_t astep, bstep;
    __device__ void init(const void* A_, int lda, const void* B_, int K, int M, int N, int G_, int c_) { nM = M / BM; nN = N / BM; nwg = nM * nN; G = G_; c = c_; A = (const char*)A_; B = (const char*)B_; astep = (size_t)BM * lda * 2; bstep = (size_t)BM * K * 2; }
    __device__ bool next(int i, Unit& u) const {
        const long L = (long)i * G + c; if (L >= nwg) return false;
        int wgid = (int)L; { const int q = nwg / NXCD, r = nwg % NXCD, xcd = wgid % NXCD, off = wgid / NXCD; wgid = (xcd < r ? xcd * (q + 1) : r * (q + 1) + (xcd - r) * q) + off; }
        const int nig = WGM * nN, gid = wgid / nig, fm = gid * WGM, gsz = (nM - fm) < WGM ? (nM - fm) : WGM;
        u.pm = fm + ((wgid % nig) % gsz); u.pn = (wgid % nig) / gsz; u.aux = 0; u.A = A + (size_t)u.pm * astep; u.B = B + (size_t)u.pn * bstep; return true;
    }
};

__device__ __forceinline__ unsigned cvt_pk_bf16(float lo, float hi) { unsigned r; asm volatile("v_cvt_pk_bf16_f32 %0, %1, %2" : "=v"(r) : "v"(lo), "v"(hi)); return r; }

typedef f32x4 Acc[2][2][4][2];

struct EpiBf16 {
    static constexpr bool PERM = true;
    bf16_t* O; int ldc; int split_cols; size_t split_stride; float scale0;
    __device__ __forceinline__ void operator()(const Acc& acc, const Unit& u, int wr, int wc, int fr, int fq) const {
        const int row0 = u.pm * BM + wr * 64 + fr; int colt = u.pn * BM; bf16_t* base = O;
        float sc = 1.f; if (split_cols) { const int t = colt / split_cols; base += (size_t)t * split_stride; colt -= t * split_cols; if (t == 0) sc = scale0; }
        const int col0 = colt + wc * 32 + 8 * fq;
#pragma unroll
        for (int ai = 0; ai < 2; ++ai)
#pragma unroll
            for (int m = 0; m < 4; ++m) { bf16_t* rowp = base + (size_t)(row0 + ai * HALF + m * 16) * ldc + col0;
#pragma unroll
                for (int bj = 0; bj < 2; ++bj) { f32x4 v0 = acc[ai][bj][m][0] * sc, v1 = acc[ai][bj][m][1] * sc;
                    u32x4 w; w.x = cvt_pk_bf16(v0[0], v0[1]); w.y = cvt_pk_bf16(v0[2], v0[3]); w.z = cvt_pk_bf16(v1[0], v1[1]); w.w = cvt_pk_bf16(v1[2], v1[3]);
                    *(u32x4*)(rowp + bj * HALF) = w; } }
    }
};
__device__ __forceinline__ void unpack8f(const u32x4 w, f32x4& lo, f32x4& hi) { lo = (f32x4){bflo(w.x), bfhi(w.x), bflo(w.y), bfhi(w.y)}; hi = (f32x4){bflo(w.z), bfhi(w.z), bflo(w.w), bfhi(w.w)}; }
template <bool BASE_BF16>
struct EpiResX {
    static constexpr bool PERM = true;
    const void* base; bf16_t* out;
    __device__ __forceinline__ void operator()(const Acc& acc, const Unit& u, int wr, int wc, int fr, int fq) const {
        const int col0 = u.pn * BM + wc * 32 + 8 * fq; GAS bf16_t* op = (GAS bf16_t*)out;
#pragma unroll
        for (int ai = 0; ai < 2; ++ai) {
            f32x4 b0[4][2], b1[4][2];
#pragma unroll
            for (int m = 0; m < 4; ++m) { const size_t off = (size_t)(u.pm * BM + ai * HALF + wr * 64 + m * 16 + fr) * 1024 + col0;
#pragma unroll
                for (int bj = 0; bj < 2; ++bj) {
                    if (BASE_BF16) { const u32x4 w = *(const GAS u32x4*)((const GAS bf16_t*)base + off + bj * HALF); unpack8f(w, b0[m][bj], b1[m][bj]); }
                    else { b0[m][bj] = *(const GAS f32x4*)((const GAS float*)base + off + bj * HALF); b1[m][bj] = *(const GAS f32x4*)((const GAS float*)base + off + bj * HALF + 4); } } }
            asm volatile("" ::: "memory");
#pragma unroll
            for (int m = 0; m < 4; ++m) { const size_t off = (size_t)(u.pm * BM + ai * HALF + wr * 64 + m * 16 + fr) * 1024 + col0;
#pragma unroll
                for (int bj = 0; bj < 2; ++bj) { const f32x4 v0 = b0[m][bj] + acc[ai][bj][m][0], v1 = b1[m][bj] + acc[ai][bj][m][1];
                    u32x4 w; w.x = cvt_pk_bf16(v0[0], v0[1]); w.y = cvt_pk_bf16(v0[2], v0[3]); w.z = cvt_pk_bf16(v1[0], v1[1]); w.w = cvt_pk_bf16(v1[2], v1[3]);
                    *(GAS u32x4*)(op + off + bj * HALF) = w; } }
            asm volatile("" ::: "memory");
        }
    }
};
struct EpiRouter {
    static constexpr bool PERM = false;
    float* out;
    __device__ __forceinline__ void operator()(const Acc& acc, const Unit& u, int wr, int wc, int fr, int fq) const {
        if (wc >= 2) return;
#pragma unroll
        for (int ai = 0; ai < 2; ++ai)
#pragma unroll
            for (int m = 0; m < 4; ++m) { const size_t off = (size_t)(u.pm * BM + ai * HALF + wr * 64 + m * 16 + fr) * 64 + wc * 32 + 4 * fq;
#pragma unroll
                for (int n = 0; n < 2; ++n) *(f32x4*)(out + off + n * 16) = acc[ai][0][m][n]; }
    }
};
struct EpiGU {
    static constexpr bool PERM = true;
    bf16_t* H;
    __device__ __forceinline__ void operator()(const Acc& acc, const Unit& u, int wr, int wc, int fr, int fq) const {
        const int col0 = u.pn * 128 + wc * 32 + 8 * fq;
#pragma unroll
        for (int ai = 0; ai < 2; ++ai)
#pragma unroll
            for (int m = 0; m < 4; ++m) { bf16_t* rowp = H + (size_t)(u.pm * BM + ai * HALF + wr * 64 + m * 16 + fr) * EH + col0;
                f32x4 g0 = acc[ai][0][m][0], g1 = acc[ai][0][m][1]; const f32x4 u0 = acc[ai][1][m][0], u1 = acc[ai][1][m][1];
#pragma unroll
                for (int e = 0; e < 4; ++e) { g0[e] = g0[e] * sigmoidf_(g0[e]) * u0[e]; g1[e] = g1[e] * sigmoidf_(g1[e]) * u1[e]; }
                u32x4 w; w.x = cvt_pk_bf16(g0[0], g0[1]); w.y = cvt_pk_bf16(g0[2], g0[3]); w.z = cvt_pk_bf16(g1[0], g1[1]); w.w = cvt_pk_bf16(g1[2], g1[3]);
                *(u32x4*)rowp = w; }
    }
};
struct EpiDown {
    static constexpr bool PERM = true;
    bf16_t* Y; const float* gate;
    __device__ __forceinline__ void operator()(const Acc& acc, const Unit& u, int wr, int wc, int fr, int fq) const {
        const int col0 = u.pn * BM + wc * 32 + 8 * fq;
#pragma unroll
        for (int ai = 0; ai < 2; ++ai)
#pragma unroll
            for (int m = 0; m < 4; ++m) { const int row = u.pm * BM + ai * HALF + wr * 64 + m * 16 + fr; const float sc = gate[row]; bf16_t* rowp = Y + (size_t)row * 1024 + col0;
#pragma unroll
                for (int bj = 0; bj < 2; ++bj) { const f32x4 v0 = acc[ai][bj][m][0] * sc, v1 = acc[ai][bj][m][1] * sc;
                    u32x4 w; w.x = cvt_pk_bf16(v0[0], v0[1]); w.y = cvt_pk_bf16(v0[2], v0[3]); w.z = cvt_pk_bf16(v1[0], v1[1]); w.w = cvt_pk_bf16(v1[2], v1[3]);
                    *(u32x4*)(rowp + bj * HALF) = w; } }
    }
};
struct EpiPle {
    static constexpr bool PERM = true;
    const bf16_t* xin; bf16_t* xout; const bf16_t* pp;
    __device__ __forceinline__ void operator()(const Acc& acc, const Unit& u, int wr, int wc, int fr, int fq) const {
        const int col0 = u.pn * BM + wc * 32 + 8 * fq;
        const GAS bf16_t* xp = (const GAS bf16_t*)xin; GAS bf16_t* op = (GAS bf16_t*)xout; const GAS bf16_t* pq = (const GAS bf16_t*)pp;
#pragma unroll
        for (int ai = 0; ai < 2; ++ai) {
            u32x4 xw[4][2], pw[4][2];
#pragma unroll
            for (int m = 0; m < 4; ++m) { const size_t off = (size_t)(u.pm * BM + ai * HALF + wr * 64 + m * 16 + fr) * 1024 + col0;
#pragma unroll
                for (int bj = 0; bj < 2; ++bj) { xw[m][bj] = *(const GAS u32x4*)(xp + off + bj * HALF); pw[m][bj] = *(const GAS u32x4*)(pq + off + bj * HALF); } }
            asm volatile("" ::: "memory");
#pragma unroll
            for (int m = 0; m < 4; ++m) { const size_t off = (size_t)(u.pm * BM + ai * HALF + wr * 64 + m * 16 + fr) * 1024 + col0;
#pragma unroll
                for (int bj = 0; bj < 2; ++bj) { f32x4 x0, x1, p0, p1; unpack8f(xw[m][bj], x0, x1); unpack8f(pw[m][bj], p0, p1); const f32x4 a0 = acc[ai][bj][m][0], a1 = acc[ai][bj][m][1];
#pragma unroll
                    for (int e = 0; e < 4; ++e) { x0[e] += p0[e] * sigmoidf_(a0[e]); x1[e] += p1[e] * sigmoidf_(a1[e]); }
                    u32x4 w; w.x = cvt_pk_bf16(x0[0], x0[1]); w.y = cvt_pk_bf16(x0[2], x0[3]); w.z = cvt_pk_bf16(x1[0], x1[1]); w.w = cvt_pk_bf16(x1[2], x1[3]);
                    *(GAS u32x4*)(op + off + bj * HALF) = w; } }
            asm volatile("" ::: "memory");
        }
    }
};
struct EpiMid {
    static constexpr bool PERM = true;
    bf16_t* MID;
    __device__ __forceinline__ void operator()(const Acc& acc, const Unit& u, int wr, int wc, int fr, int fq) const {
        const int row0 = u.pm * BM + wr * 64 + fr;
        const int mode = (u.pn == 1) ? 2 : 0; const int colbase = u.pn * 256;
#pragma unroll
        for (int ai = 0; ai < 2; ++ai)
#pragma unroll
            for (int m = 0; m < 4; ++m) { bf16_t* rowp = MID + (size_t)(row0 + ai * HALF + m * 16) * 512 + colbase;
#pragma unroll
                for (int bj = 0; bj < 2; ++bj) { const int lc = bj * HALF + wc * 32 + 8 * fq; f32x4 v0 = acc[ai][bj][m][0], v1 = acc[ai][bj][m][1];
#pragma unroll
                    for (int e = 0; e < 4; ++e) {
                        if (mode == 2) { v0[e] = sigmoidf_(v0[e]); v1[e] = sigmoidf_(v1[e]); }
                        else if (lc < 64) { v0[e] = tanhf_(v0[e]); v1[e] = tanhf_(v1[e]); } }
                    u32x4 w; w.x = cvt_pk_bf16(v0[0], v0[1]); w.y = cvt_pk_bf16(v0[2], v0[3]); w.z = cvt_pk_bf16(v1[0], v1[1]); w.w = cvt_pk_bf16(v1[2], v1[3]);
                    *(u32x4*)(rowp + lc) = w; } }
    }
};
struct EpiRwkv2 {
    static constexpr bool PERM = true;
    bf16_t* O0; bf16_t* O1; const float* bias0; const float* bias1; int tybase;
    __device__ __forceinline__ void operator()(const Acc& acc, const Unit& u, int wr, int wc, int fr, int fq) const {
        const int ty = tybase + (u.pn >> 2); const int row0 = u.pm * BM + wr * 64 + fr; const int colt = (u.pn & 3) * BM + wc * 32 + 8 * fq;
        bf16_t* base = (u.pn >> 2) ? O1 : O0; const float* bias = (u.pn >> 2) ? bias1 : bias0;
#pragma unroll
        for (int bj = 0; bj < 2; ++bj) {
            f32x4 b0 = (f32x4){0.f, 0.f, 0.f, 0.f}, b1 = b0;
            if (ty < 2) { b0 = *(const f32x4*)(bias + colt + bj * HALF); b1 = *(const f32x4*)(bias + colt + bj * HALF + 4); }
#pragma unroll
            for (int ai = 0; ai < 2; ++ai)
#pragma unroll
                for (int m = 0; m < 4; ++m) { bf16_t* rowp = base + (size_t)(row0 + ai * HALF + m * 16) * 1024 + colt + bj * HALF;
                    f32x4 v0 = acc[ai][bj][m][0] + b0, v1 = acc[ai][bj][m][1] + b1;
                    if (ty < 2) { const float s = (ty == 0) ? 0.6065306597126334f : 1.0f;
#pragma unroll
                        for (int e = 0; e < 4; ++e) { v0[e] = s * sigmoidf_(v0[e]); v1[e] = s * sigmoidf_(v1[e]); } }
                    u32x4 w; w.x = cvt_pk_bf16(v0[0], v0[1]); w.y = cvt_pk_bf16(v0[2], v0[3]); w.z = cvt_pk_bf16(v1[0], v1[1]); w.w = cvt_pk_bf16(v1[2], v1[3]);
                    *(u32x4*)rowp = w; }
        }
    }
};

template <class Epi, class Sched, bool ALIGN_EPI, bool GATHER>
__device__ __forceinline__ void gemm_phase(PG8_LAS unsigned char* lds, const int K, const int lda, const Sched& S, const Epi& E, const int* __restrict__ rows, const int tid) {
    const int wid = __builtin_amdgcn_readfirstlane(tid >> 6), lane = tid & 63, wr = wid >> 2, wc = wid & 3, fr = lane & 15, fq = lane >> 4;
    const int nt = K / BK;
    unsigned voffA[2], voffB[2]; int RA[2];
#pragma unroll
    for (int i = 0; i < 2; ++i) { int R, C; stage_rc(tid * 16 + i * 8192, R, C); const int Rb = Epi::PERM ? ((R & ~31) + perm32(R & 31)) : R;
        RA[i] = R; voffA[i] = GATHER ? (unsigned)(C * 2) : (unsigned)(R * lda + C) * 2u; voffB[i] = (unsigned)(Rb * K + C) * 2u; }
    const size_t kstep = (size_t)(BK * 2);
    const size_t hstepA = GATHER ? 0 : (size_t)HALF * lda * 2, hstepB = (size_t)HALF * K * 2;
    const unsigned ldsw = (unsigned)wid * 1024u;
    const int aoff = lds_byte(wr * 64 + fr, fq * 8), boff = lds_byte(wc * 32 + fr, fq * 8);
#define PG8_SA(b, h) (((b) * 2 + (h)) * HTB)
#define PG8_SB(b, h) ((4 + (b) * 2 + (h)) * HTB)
#define PG8_ST2(bufoff, gbase, o0, o1) do { \
        __builtin_amdgcn_global_load_lds((const unsigned*)((const char*)(gbase) + (o0)), (PG8_LAS unsigned*)(lds + (bufoff) + ldsw), 16, 0, 0); \
        __builtin_amdgcn_global_load_lds((const unsigned*)((const char*)(gbase) + (o1)), (PG8_LAS unsigned*)(lds + (bufoff) + ldsw + 8192), 16, 0, 0); } while (0)
#define PG8_STB(bufoff, gbase) PG8_ST2(bufoff, gbase, voffB[0], voffB[1])
#define PG8_STA(bufoff, p, h, nx) do { if constexpr (GATHER) { const unsigned g0_ = (nx) ? gN[h][0] : gC[h][0], g1_ = (nx) ? gN[h][1] : gC[h][1]; PG8_ST2(bufoff, p, g0_, g1_); } \
        else { PG8_ST2(bufoff, (p) + (h) * hstepA, voffA[0], voffA[1]); } } while (0)
#define PG8_LDA(dst, b, h) do { _Pragma("unroll") for (int m = 0; m < 4; ++m) _Pragma("unroll") for (int k = 0; k < 2; ++k) dst[m][k] = *(const PG8_LAS bf16x8*)(lds + PG8_SA(b, h) + aoff + m * 2048 + k * 1024); } while (0)
#define PG8_LDB(dst, b, h) do { _Pragma("unroll") for (int n = 0; n < 2; ++n) _Pragma("unroll") for (int k = 0; k < 2; ++k) dst[n][k] = *(const PG8_LAS bf16x8*)(lds + PG8_SB(b, h) + boff + n * 2048 + k * 1024); } while (0)
#define PG8_MMA(ai, bj, At, Bt) do { __builtin_amdgcn_s_setprio(1); _Pragma("unroll") for (int m = 0; m < 4; ++m) _Pragma("unroll") for (int n = 0; n < 2; ++n) _Pragma("unroll") for (int k = 0; k < 2; ++k) \
        acc[ai][bj][m][n] = __builtin_amdgcn_mfma_f32_16x16x32_bf16(Bt[n][k], At[m][k], acc[ai][bj][m][n], 0, 0, 0); __builtin_amdgcn_s_setprio(0); } while (0)
#define PG8_WAIT_V(n) asm volatile("s_waitcnt vmcnt(" #n ")" ::: "memory")
#define PG8_WAIT_L(n) asm volatile("s_waitcnt lgkmcnt(" #n ")" ::: "memory")
#define PG8_BAR __builtin_amdgcn_s_barrier()
#define PG8_SCHED __builtin_amdgcn_sched_barrier(0)
#define PG8_GLOAD(dst, un) do { if constexpr (GATHER) { _Pragma("unroll") for (int h_ = 0; h_ < 2; ++h_) _Pragma("unroll") for (int i_ = 0; i_ < 2; ++i_) \
        dst[h_][i_] = (unsigned)rows[(un).pm * BM + h_ * HALF + RA[i_]] * (unsigned)(lda * 2) + voffA[i_]; } } while (0)
    Unit cur, nxt; int ui = 0;
    if (!S.next(0, cur)) return;
    unsigned gC[2][2] = {{0u, 0u}, {0u, 0u}}, gN[2][2] = {{0u, 0u}, {0u, 0u}};
    PG8_GLOAD(gC, cur);
    Acc acc;
#pragma unroll
    for (int a = 0; a < 2; ++a)
#pragma unroll
        for (int b = 0; b < 2; ++b)
#pragma unroll
            for (int m = 0; m < 4; ++m)
#pragma unroll
                for (int n = 0; n < 2; ++n) acc[a][b][m][n] = (f32x4){0.f, 0.f, 0.f, 0.f};
    bf16x8 At[4][2], B0[2][2], B1[2][2];
    const char* cA = cur.A; const char* cB = cur.B;
    PG8_STB(PG8_SB(0, 0), cB); PG8_STB(PG8_SB(0, 1), cB + hstepB); PG8_STA(PG8_SA(0, 0), cA, 0, false); PG8_STA(PG8_SA(0, 1), cA, 1, false);
    if (wr == 1) PG8_BAR;
    PG8_WAIT_V(2); PG8_BAR;
    PG8_STB(PG8_SB(1, 0), cB + kstep); PG8_STA(PG8_SA(1, 0), cA + kstep, 0, false); PG8_STB(PG8_SB(1, 1), cB + hstepB + kstep);
    PG8_WAIT_V(6); PG8_BAR;
    for (;;) {
        const bool has_next = S.next(ui + 1, nxt);
        if (has_next) { PG8_GLOAD(gN, nxt); }
        const char* nA = has_next ? nxt.A : cA; const char* nB = has_next ? nxt.B : cB;
#pragma unroll 1
        for (int t = 0; t < nt; t += 2) {
            const bool last = (t == nt - 2); const bool nx = last && has_next;
            const char* a1 = cA + (size_t)(t + 1) * kstep;
            const char* a2 = last ? nA : cA + (size_t)(t + 2) * kstep; const char* b2 = last ? nB : cB + (size_t)(t + 2) * kstep;
            const char* a3 = a2 + kstep; const char* b3 = b2 + kstep;
            PG8_LDB(B0, 0, 0); PG8_LDB(B1, 0, 1); PG8_SCHED; PG8_LDA(At, 0, 0); PG8_STA(PG8_SA(1, 1), a1, 1, false);
            PG8_WAIT_V(8); PG8_WAIT_L(0); PG8_BAR; PG8_MMA(0, 0, At, B0); PG8_MMA(0, 1, At, B1); PG8_BAR; PG8_SCHED;
            PG8_LDA(At, 0, 1); PG8_STB(PG8_SB(0, 0), b2); PG8_STB(PG8_SB(0, 1), b2 + hstepB); PG8_STA(PG8_SA(0, 0), a2, 0, nx);
            PG8_WAIT_V(8); PG8_WAIT_L(0); PG8_BAR; PG8_MMA(1, 0, At, B0); PG8_MMA(1, 1, At, B1); PG8_BAR; PG8_SCHED;
            PG8_LDB(B0, 1, 0); PG8_LDB(B1, 1, 1); PG8_SCHED; PG8_LDA(At, 1, 0); PG8_STA(PG8_SA(0, 1), a2, 1, nx);
            PG8_WAIT_V(8); PG8_WAIT_L(0); PG8_BAR; PG8_MMA(0, 0, At, B0); PG8_MMA(0, 1, At, B1); PG8_BAR; PG8_SCHED;
            PG8_LDA(At, 1, 1); PG8_STB(PG8_SB(1, 0), b3); PG8_STB(PG8_SB(1, 1), b3 + hstepB); PG8_STA(PG8_SA(1, 0), a3, 0, nx);
            PG8_WAIT_V(8); PG8_WAIT_L(0); PG8_BAR; PG8_MMA(1, 0, At, B0); PG8_MMA(1, 1, At, B1); PG8_BAR; PG8_SCHED;
        }
        if constexpr (ALIGN_EPI) { if (wr == 0) PG8_BAR; }
        E(acc, cur, wr, wc, fr, fq);
        if (!has_next) break;
#pragma unroll
        for (int a = 0; a < 2; ++a)
#pragma unroll
            for (int b = 0; b < 2; ++b)
#pragma unroll
                for (int m = 0; m < 4; ++m)
#pragma unroll
                    for (int n = 0; n < 2; ++n) acc[a][b][m][n] = (f32x4){0.f, 0.f, 0.f, 0.f};
        cur = nxt; cA = nA; cB = nB; ++ui;
        if constexpr (GATHER) {
#pragma unroll
            for (int h_ = 0; h_ < 2; ++h_)
#pragma unroll
                for (int i_ = 0; i_ < 2; ++i_) gC[h_][i_] = gN[h_][i_]; }
        if constexpr (ALIGN_EPI) { if (wr == 1) PG8_BAR; }
    }
    PG8_WAIT_V(0);
    if constexpr (!ALIGN_EPI) { if (wr == 0) PG8_BAR; }
    PG8_BAR;
#undef PG8_SA
#undef PG8_SB
#undef PG8_ST2
#undef PG8_STB
#undef PG8_STA
#undef PG8_LDA
#undef PG8_LDB
#undef PG8_MMA
#undef PG8_WAIT_V
#undef PG8_WAIT_L
#undef PG8_BAR
#undef PG8_SCHED
#undef PG8_GLOAD
}
}
namespace attn_body {
using bf16=__hip_bfloat16;
using bf16x8=__attribute__((ext_vector_type(8)))short;
using s16x4=__attribute__((ext_vector_type(4)))short;
using f32x16=__attribute__((ext_vector_type(16)))float;
using u32x4=__attribute__((ext_vector_type(4)))unsigned;
constexpr int BATCH=8,NHEAD=16,SEQ=8192,D=64,PQ=512,PO=1024;
constexpr int NW=8,QBLK=32,QB=QBLK*NW,KVBLK=64,NQB=SEQ/QB;
constexpr int ATTN_UNIT_ROWS=QB;
__device__ __forceinline__ int crow(int r,int hi){return (r&3)+8*(r>>2)+4*hi;}
#define SBAR() __builtin_amdgcn_sched_barrier(0)
__device__ __forceinline__ void cmask(f32x16&p0,f32x16&p1,int jb,int qrel,int hi){
  const float NEG=-INFINITY; int kb=64*jb+4*hi;
  #pragma unroll
  for(int r=0;r<16;++r){int kv=kb+(r&3)+8*(r>>2); if(kv>qrel)p0[r]=NEG; if(kv+32>qrel)p1[r]=NEG;}
}

__device__ __forceinline__ void cbias(f32x16&p0,f32x16&p1,int jb,int qrel,int hi,const __attribute__((address_space(3))) float*tb){
  const int kb=64*jb+4*hi;
  #pragma unroll
  for(int r=0;r<16;++r){const int rel=qrel-(kb+(r&3)+8*(r>>2)); const int i0=min(max(rel,0),127), i1=min(max(rel-32,0),127); p0[r]+=tb[i0]; p1[r]+=tb[i1];}
}
constexpr int NSLOT=3, SLOTB=8192;
constexpr int LDS_K=0, LDS_V=NSLOT*SLOTB, LDS_WS=2*NSLOT*SLOTB, LDS_OST=LDS_WS+NW*64*4, LDS_BYTES=LDS_OST+NW*4096;
constexpr float C2=0.125f*1.4426950408889634f;
__device__ __forceinline__ void glds16(const void*gsrc,unsigned lds_dst){unsigned keep;
  asm volatile("s_mov_b32 %0, m0\n\ts_mov_b32 m0, %2\n\ts_nop 0\n\tglobal_load_lds_dwordx4 %1, off\n\ts_mov_b32 m0, %0":"=&s"(keep):"v"(gsrc),"s"(lds_dst):"memory");}
__device__ __forceinline__ float max3f(float a,float b,float c){float r;asm("v_max3_f32 %0, %1, %2, %3":"=v"(r):"v"(a),"v"(b),"v"(c));return r;}
__device__ __forceinline__ float max2f(float a,float b){float r;asm("v_max_f32_e32 %0, %1, %2":"=v"(r):"v"(a),"v"(b));return r;}
__device__ __forceinline__ float fadd_s(float a,float b){float r;asm("v_add_f32_e32 %0, %1, %2":"=v"(r):"v"(a),"v"(b));return r;}
__device__ __forceinline__ float fsub_s(float a,float b){float r;asm("v_sub_f32_e32 %0, %1, %2":"=v"(r):"v"(a),"v"(b));return r;}
typedef float f32x2_t __attribute__((ext_vector_type(2))); typedef __bf16 bf16x2_t __attribute__((ext_vector_type(2)));
__device__ __forceinline__ unsigned cvtpk_s(float lo,float hi){f32x2_t v={lo,hi};bf16x2_t b=__builtin_convertvector(v,bf16x2_t);return __builtin_bit_cast(unsigned,b);}
#define WAIT_BAR(N) asm volatile("s_waitcnt vmcnt(" #N ") lgkmcnt(0)\n\ts_barrier":::"memory")

__device__ __forceinline__ void qkt(f32x16&p0,f32x16&p1,const char*Kslot,const bf16x8*qr,const f32x16&negm,int r32,int hi){
  const char*kb=Kslot+hi*1024+r32*16;
  #pragma unroll
  for(int d0=0;d0<4;++d0){
    const bf16x8 b0=*reinterpret_cast<const bf16x8*>(kb+d0*2048);
    const bf16x8 b1=*reinterpret_cast<const bf16x8*>(kb+d0*2048+512);
    if(d0==0){p0=__builtin_amdgcn_mfma_f32_32x32x16_bf16(b0,qr[0],negm,0,0,0);p1=__builtin_amdgcn_mfma_f32_32x32x16_bf16(b1,qr[0],negm,0,0,0);}
    else{p0=__builtin_amdgcn_mfma_f32_32x32x16_bf16(b0,qr[d0],p0,0,0,0);p1=__builtin_amdgcn_mfma_f32_32x32x16_bf16(b1,qr[d0],p1,0,0,0);}}
}
typedef __attribute__((address_space(3))) const char* lds_cptr;
typedef short v4i16_t __attribute__((ext_vector_type(4)));
__device__ __forceinline__ void kload8(bf16x8*kf,lds_cptr kp){
  kf[0]=*(const __attribute__((address_space(3))) bf16x8*)(kp);      kf[1]=*(const __attribute__((address_space(3))) bf16x8*)(kp+512);
  kf[2]=*(const __attribute__((address_space(3))) bf16x8*)(kp+2048); kf[3]=*(const __attribute__((address_space(3))) bf16x8*)(kp+2560);
  kf[4]=*(const __attribute__((address_space(3))) bf16x8*)(kp+4096); kf[5]=*(const __attribute__((address_space(3))) bf16x8*)(kp+4608);
  kf[6]=*(const __attribute__((address_space(3))) bf16x8*)(kp+6144); kf[7]=*(const __attribute__((address_space(3))) bf16x8*)(kp+6656);
}
__device__ __forceinline__ void kload2(bf16x8*kf,lds_cptr kp,int j){ kf[2*j]=*(const __attribute__((address_space(3))) bf16x8*)(kp+j*2048); kf[2*j+1]=*(const __attribute__((address_space(3))) bf16x8*)(kp+j*2048+512); }
__device__ __forceinline__ s16x4 vtr(lds_cptr p){ return __builtin_bit_cast(s16x4,__builtin_amdgcn_ds_read_tr16_b64_v4i16((__attribute__((address_space(3))) v4i16_t*)p)); }
__device__ __forceinline__ float rowmax(const f32x16&p0,const f32x16&p1){
  float a=max3f(p0[0],p0[1],p1[0]),b=max3f(p0[2],p0[3],p1[1]);a=max3f(a,p1[2],p1[3]);
  #pragma unroll
  for(int r=4;r<16;r+=4){a=max3f(a,p0[r],p0[r+1]);b=max3f(b,p0[r+2],p0[r+3]);a=max3f(a,p1[r],p1[r+1]);b=max3f(b,p1[r+2],p1[r+3]);}
  const float m=max2f(a,b);
  auto rr=__builtin_amdgcn_permlane32_swap(__float_as_uint(m),__float_as_uint(m),false,false);
  return max2f(__uint_as_float(rr[0]),__uint_as_float(rr[1]));
}
__device__ __forceinline__ void pv(f32x16*o,int vb,bf16x8 pa0,bf16x8 pa1,bf16x8 pa2,bf16x8 pa3){
  #pragma unroll
  for(int d0=0;d0<2;++d0){s16x4 lo[4],hi[4];
    #pragma unroll
    for(int ks=0;ks<4;++ks){
      asm volatile("ds_read_b64_tr_b16 %0,%1 offset:%c2":"=&v"(lo[ks]):"v"(vb),"i"(d0*4096+ks*1024):"memory");
      asm volatile("ds_read_b64_tr_b16 %0,%1 offset:%c2":"=&v"(hi[ks]):"v"(vb),"i"(d0*4096+ks*1024+512):"memory");}
    asm volatile("s_waitcnt lgkmcnt(0)":::"memory");SBAR();
    #define PK(k) (bf16x8){lo[k][0],lo[k][1],lo[k][2],lo[k][3],hi[k][0],hi[k][1],hi[k][2],hi[k][3]}
    o[d0]=__builtin_amdgcn_mfma_f32_32x32x16_bf16(pa0,PK(0),o[d0],0,0,0);
    o[d0]=__builtin_amdgcn_mfma_f32_32x32x16_bf16(pa1,PK(1),o[d0],0,0,0);
    o[d0]=__builtin_amdgcn_mfma_f32_32x32x16_bf16(pa2,PK(2),o[d0],0,0,0);
    o[d0]=__builtin_amdgcn_mfma_f32_32x32x16_bf16(pa3,PK(3),o[d0],0,0,0);
    #undef PK
  }
}

#ifndef ATTN_STORE16
#define ATTN_STORE16(p,v) (*(u32x4*)(p)=(v))
#endif
template<int THRL> __device__ __forceinline__ void attn_unit(int b,int vh,int qb,const bf16*Q,const bf16*__restrict__ K,const bf16*__restrict__ V,bf16*O,char*shm,const __attribute__((address_space(3))) float*tball,const int tid){
  const int lane=tid&63,r32=lane&31,hi=lane>>5; const int wid=__builtin_amdgcn_readfirstlane(tid>>6);
  const long rowbase=(long)b*SEQ; const int q0=qb*QB;
  const int hh=vh>>2, qcol=hh*128+((vh>>1)&1)*64, vcol=hh*128+(vh&1)*64;
  const __attribute__((address_space(3))) float*tb=tball+hh*128;
  const bf16*Qw=Q+(rowbase+q0+wid*QBLK)*PQ+qcol;
  const bf16*Kh=K+rowbase*PQ+qcol,*Vh=V+rowbase*PQ+vcol;
  const unsigned lds0=(unsigned)(uintptr_t)shm;
  float*wsf=(float*)(shm+LDS_WS)+wid*64;
  const bf16*ksrc=Kh+(long)lane*PQ+wid*8;
  const bf16*vsrc=Vh+(long)(16*(wid&3)+(lane>>2))*PQ+(wid>>2)*32+(lane&3)*8;
  const unsigned kdst=lds0+LDS_K+wid*1024, vdst=lds0+LDS_V+wid*1024;
  #define DMA_K(t,slot) glds16(ksrc+(long)(t)*KVBLK*PQ,(unsigned)__builtin_amdgcn_readfirstlane(kdst+(slot)))
  #define DMA_V(t,slot) glds16(vsrc+(long)(t)*KVBLK*PQ,(unsigned)__builtin_amdgcn_readfirstlane(vdst+(slot)))
  const int vb0=(int)(lds0+LDS_V)+((lane>>4)&1)*32+(lane&3)*8+(4*hi+((lane&15)>>2))*64;
  const char*Kbase=shm+LDS_K; bf16x8 kf[8];
  const lds_cptr shm3=(lds_cptr)shm; const lds_cptr kp0=shm3+LDS_K+hi*1024+r32*16; const lds_cptr vp0=shm3+LDS_V+((lane>>4)&1)*32+(lane&3)*8+(4*hi+((lane&15)>>2))*64;
  const int NT=(q0+QB)/KVBLK;
  DMA_K(0,0);DMA_V(0,0);DMA_K(1,SLOTB);
  bf16x8 qr[4];
  #pragma unroll
  for(int d0=0;d0<4;++d0)qr[d0]=*reinterpret_cast<const bf16x8*>(&Qw[(long)r32*PQ+d0*16+hi*8]);
  float mhat=0.f,l_reg=0.f;f32x16 o[2];o[0]=f32x16{};o[1]=f32x16{};f32x16 negm=f32x16{};asm volatile("":"+v"(negm));
  const int qrel=wid*QBLK+r32;
  #define CMASK(P0,P1,t) do{int jb_=(t)-(NT-4); if(jb_>=-2){cbias(P0,P1,jb_,qrel,hi,tb); if(jb_>=0)cmask(P0,P1,jb_,qrel,hi);}}while(0)
  bool resc=false;
  #define START(P0,P1) do{ const float rm=rowmax(P0,P1); resc=false; \
    { const float dl=rm; mhat=fadd_s(mhat,dl); \
      _Pragma("unroll") for(int r=0;r<16;++r){P0[r]=fsub_s(P0[r],dl);P1[r]=fsub_s(P1[r],dl);} \
      _Pragma("unroll") for(int r=0;r<16;++r)negm[r]=-mhat; asm volatile("":"+v"(negm)); } \
    _Pragma("unroll") for(int r=0;r<16;++r)P0[r]=__builtin_amdgcn_exp2f(P0[r]); }while(0)
  #define RESC() do{ if(resc){ asm volatile("s_waitcnt lgkmcnt(0)":::"memory"); \
      _Pragma("unroll") for(int d_=0;d_<2;++d_) _Pragma("unroll") for(int r=0;r<16;++r)o[d_][r]*=wsf[crow(r,hi)]; } }while(0)
  f32x16 pA0,pA1,pB0,pB1;
  int sl_prev=0,sl_cur=0,sl_next=SLOTB;
  #define ROT() do{sl_prev=sl_cur;sl_cur=sl_next;sl_next=(sl_next==(NSLOT-1)*SLOTB)?0:sl_next+SLOTB;}while(0)
  DMA_K(2,2*SLOTB);
  WAIT_BAR(3);
  qkt(pA0,pA1,Kbase,qr,negm,r32,hi);asm volatile("s_nop 15\n\ts_nop 7":"+v"(pA0),"+v"(pA1));CMASK(pA0,pA1,0);
  START(pA0,pA1);
  _Pragma("unroll") for(int r=0;r<16;++r)pA1[r]=__builtin_amdgcn_exp2f(pA1[r]);
  WAIT_BAR(0);
  DMA_K(3,0);DMA_V(1,SLOTB);
  ROT();
  kload8(kf,kp0+sl_cur);
  WAIT_BAR(2);
  s16x4 vlo[8],vhi[8]; u32x4 pw0,pw1,pw2,pw3;
  #define PKW(P,B) cvtpk_s(P[B],P[B+1])
  #define PAF(k) __builtin_bit_cast(bf16x8,pw##k)
  #define VFR(i) (bf16x8){vlo[i][0],vlo[i][1],vlo[i][2],vlo[i][3],vhi[i][0],vhi[i][1],vhi[i][2],vhi[i][3]}
  #define PIN(x) asm volatile("":"+v"(x))
  #define MX3(a,b,c) __builtin_fmaxf(__builtin_fmaxf((a),(b)),(c))
  #define GAPA(MF,A0,A1,A2,A3,W0,W1,PW) do{ MF; sacc+=A0; sacc+=A1; sacc+=A2; sacc+=A3; PIN(sacc); W0; W1; PIN(PW); SBAR(); }while(0)
  #define EX(v) __builtin_amdgcn_exp2f(v)
  #define GAPB(MF,X,B) do{ MF; X[B]=EX(X[B]); X[B+1]=EX(X[B+1]); X[B+2]=EX(X[B+2]); X[B+3]=EX(X[B+3]); PIN(X); SBAR(); }while(0)
  #define VRD(i) do{ vlo[i]=vtr(vp_+(((i)>>2)*4096+((i)&3)*1024)); vhi[i]=vtr(vp_+(((i)>>2)*4096+((i)&3)*1024+512)); }while(0)
  #define KRD(G,j) do{ if(G){ kload2(kf,kp0+sl_next,j); SBAR(); } }while(0)
  #define STEP(C0,C1,P0,P1,t,GK,GV,GL) do{ SBAR(); \
    const lds_cptr vp_=vp0+sl_prev; \
    VRD(0); SBAR(); float sacc=(P0[0]+P0[1]); \
    GAPA(C0=__builtin_amdgcn_mfma_f32_32x32x16_bf16(kf[0],qr[0],negm,0,0,0), P0[2],P0[3],P0[4],P0[5],     pw0[0]=PKW(P0,0), pw0[1]=PKW(P0,2), pw0); \
    VRD(4); SBAR(); GAPA(C1=__builtin_amdgcn_mfma_f32_32x32x16_bf16(kf[1],qr[0],negm,0,0,0), P0[6],P0[7],P0[8],P0[9],     pw0[2]=PKW(P0,4), pw0[3]=PKW(P0,6), pw0); \
    VRD(1); SBAR(); GAPA(C0=__builtin_amdgcn_mfma_f32_32x32x16_bf16(kf[2],qr[1],C0,0,0,0),   P0[10],P0[11],P0[12],P0[13], pw1[0]=PKW(P0,8), pw1[1]=PKW(P0,10), pw1); \
    VRD(5); SBAR(); GAPA(C1=__builtin_amdgcn_mfma_f32_32x32x16_bf16(kf[3],qr[1],C1,0,0,0),   P0[14],P0[15],P1[0],P1[1],   pw1[2]=PKW(P0,12),pw1[3]=PKW(P0,14), pw1); \
    VRD(2); SBAR(); GAPA(C0=__builtin_amdgcn_mfma_f32_32x32x16_bf16(kf[4],qr[2],C0,0,0,0),   P1[2],P1[3],P1[4],P1[5],     pw2[0]=PKW(P1,0), pw2[1]=PKW(P1,2), pw2); \
    VRD(6); SBAR(); GAPA(C1=__builtin_amdgcn_mfma_f32_32x32x16_bf16(kf[5],qr[2],C1,0,0,0),   P1[6],P1[7],P1[8],P1[9],     pw2[2]=PKW(P1,4), pw2[3]=PKW(P1,6), pw2); \
    VRD(3); SBAR(); GAPA(C0=__builtin_amdgcn_mfma_f32_32x32x16_bf16(kf[6],qr[3],C0,0,0,0),   P1[10],P1[11],P1[12],P1[13], pw3[0]=PKW(P1,8), pw3[1]=PKW(P1,10), pw3); \
    VRD(7); SBAR(); GAPA(C1=__builtin_amdgcn_mfma_f32_32x32x16_bf16(kf[7],qr[3],C1,0,0,0),   P1[14],P1[15],0.f,0.f,       pw3[2]=PKW(P1,12),pw3[3]=PKW(P1,14), pw3); \
    l_reg+=sacc; \
    if(GK){DMA_K((t)+3,sl_cur);} if(GV){DMA_V((t)+1,sl_next);} \
    CMASK(C0,C1,t); \
    { float a=MX3(C0[0],C0[1],C1[0]),b=MX3(C0[2],C0[3],C1[1]); a=MX3(a,C1[2],C1[3]); \
      _Pragma("unroll") for(int r=4;r<16;r+=4){a=MX3(a,C0[r],C0[r+1]);b=MX3(b,C0[r+2],C0[r+3]);a=MX3(a,C1[r],C1[r+1]);b=MX3(b,C1[r+2],C1[r+3]);} \
      float rm=__builtin_fmaxf(a,b); { auto rr=__builtin_amdgcn_permlane32_swap(__float_as_uint(rm),__float_as_uint(rm),false,false); rm=__builtin_fmaxf(__uint_as_float(rr[0]),__uint_as_float(rr[1])); } \
      resc=false; \
      if(__builtin_expect(__any(rm>(float)THRL),0)){ const float dl=__builtin_fmaxf(rm,0.f); mhat+=dl; \
        _Pragma("unroll") for(int r=0;r<16;++r){C0[r]-=dl;C1[r]-=dl;} \
        _Pragma("unroll") for(int r=0;r<16;++r)negm[r]=-mhat; asm volatile("":"+v"(negm)); \
        const float f=__builtin_amdgcn_exp2f(-dl); l_reg*=f; if(hi==0)wsf[r32]=f; resc=true; } } \
    SBAR(); \
    GAPB(o[0]=__builtin_amdgcn_mfma_f32_32x32x16_bf16(PAF(0),VFR(0),o[0],0,0,0), C0,0); \
    GAPB(o[1]=__builtin_amdgcn_mfma_f32_32x32x16_bf16(PAF(0),VFR(4),o[1],0,0,0), C0,4); \
    KRD(GL,0); GAPB(o[0]=__builtin_amdgcn_mfma_f32_32x32x16_bf16(PAF(1),VFR(1),o[0],0,0,0), C0,8); \
    KRD(GL,1); GAPB(o[1]=__builtin_amdgcn_mfma_f32_32x32x16_bf16(PAF(1),VFR(5),o[1],0,0,0), C0,12); \
    KRD(GL,2); GAPB(o[0]=__builtin_amdgcn_mfma_f32_32x32x16_bf16(PAF(2),VFR(2),o[0],0,0,0), C1,0); \
    KRD(GL,3); GAPB(o[1]=__builtin_amdgcn_mfma_f32_32x32x16_bf16(PAF(2),VFR(6),o[1],0,0,0), C1,4); \
    GAPB(o[0]=__builtin_amdgcn_mfma_f32_32x32x16_bf16(PAF(3),VFR(3),o[0],0,0,0), C1,8); \
    GAPB(o[1]=__builtin_amdgcn_mfma_f32_32x32x16_bf16(PAF(3),VFR(7),o[1],0,0,0), C1,12); \
    }while(0)
  int t=1;
  #undef CMASK
  #define CMASK(P0,P1,t) do{}while(0)
  for(;t+7<NT;t+=2){
    STEP(pB0,pB1,pA0,pA1,t,true,true,true);     WAIT_BAR(2); RESC(); ROT();
    STEP(pA0,pA1,pB0,pB1,t+1,true,true,true);   WAIT_BAR(2); RESC(); ROT();
  }
  #undef CMASK
  #define CMASK(P0,P1,t) do{int jb_=(t)-(NT-4); if(jb_>=-2){cbias(P0,P1,jb_,qrel,hi,tb); if(jb_>=0)cmask(P0,P1,jb_,qrel,hi);}}while(0)
  #define ENDW(tt) do{ if((tt)+3<NT){WAIT_BAR(2);} else if((tt)+2<NT){WAIT_BAR(1);} else {WAIT_BAR(0);} }while(0)
  for(;t+1<NT;t+=2){
    STEP(pB0,pB1,pA0,pA1,t,(t+3<NT),(t+1<NT),(t+1<NT));       ENDW(t);   RESC(); ROT();
    STEP(pA0,pA1,pB0,pB1,t+1,(t+4<NT),(t+2<NT),(t+2<NT));     ENDW(t+1); RESC(); ROT();
  }
  STEP(pB0,pB1,pA0,pA1,NT-1,false,false,false); RESC();
  { float sacc=pB0[0]+pB0[1]; _Pragma("unroll") for(int r=2;r<16;++r)sacc+=pB0[r]; _Pragma("unroll") for(int r=0;r<16;++r)sacc+=pB1[r]; l_reg+=sacc;
    pw0=(u32x4){PKW(pB0,0),PKW(pB0,2),PKW(pB0,4),PKW(pB0,6)};pw1=(u32x4){PKW(pB0,8),PKW(pB0,10),PKW(pB0,12),PKW(pB0,14)};pw2=(u32x4){PKW(pB1,0),PKW(pB1,2),PKW(pB1,4),PKW(pB1,6)};pw3=(u32x4){PKW(pB1,8),PKW(pB1,10),PKW(pB1,12),PKW(pB1,14)};
    SBAR(); pv(o,vb0+sl_cur,PAF(0),PAF(1),PAF(2),PAF(3)); }
  #undef PKW
  #undef PAF
  #undef VFR
  #undef PIN
  #undef MX3
  #undef GAPA
  #undef GAPB
  #undef EX
  #undef VRD
  #undef KRD
  #undef STEP
  #undef ENDW
  {auto rr=__builtin_amdgcn_permlane32_swap(__float_as_uint(l_reg),__float_as_uint(l_reg),false,false);l_reg=__uint_as_float(rr[0])+__uint_as_float(rr[1]);}
  if(hi==0)wsf[32+r32]=l_reg;asm volatile("s_waitcnt lgkmcnt(0)":::"memory");
  float rli[16];
  #pragma unroll
  for(int r=0;r<16;++r)rli[r]=__builtin_amdgcn_rcpf(wsf[32+crow(r,hi)]);
  bf16*Ow=O+(rowbase+q0+wid*QBLK)*PO+vh*D;
  { bf16*stg=(bf16*)(shm+LDS_OST)+wid*2048;
    #pragma unroll
    for(int r=0;r<16;++r){const int orow=crow(r,hi);
      #pragma unroll
      for(int d0=0;d0<2;++d0)stg[orow*64+d0*32+r32]=__float2bfloat16(o[d0][r]*rli[r]);}
    asm volatile("s_waitcnt lgkmcnt(0)":::"memory");
    #pragma unroll
    for(int i=0;i<4;++i){const int row=i*8+(lane>>3),ch=lane&7; const u32x4 v=*(const u32x4*)(stg+row*64+ch*8); ATTN_STORE16(Ow+(long)row*PO+ch*8,v);} }
  asm volatile("s_waitcnt lgkmcnt(0)\n\ts_barrier":::"memory");
  #undef DMA_K
  #undef DMA_V
  #undef CMASK
  #undef START
  #undef RESC
  #undef ROT
}
constexpr int ATTN_LDS_BYTES=LDS_BYTES;
struct AttnTensors { const bf16* Q; const bf16* K; const bf16* V; bf16* O; };
struct AttnUnit { int bh; int qb; };
__device__ __forceinline__ bool attn_next(int vcu,int i,AttnUnit&u){ if(i>=16)return false; const int s=vcu&7, j=i&3; u.bh=(vcu>>3)+32*(i>>2); u.qb=(j==0)?s:(j==1)?15-s:(j==2)?16+s:31-s; return true; }
template<int THRL=8> __device__ __forceinline__ void attn_phase(char*lds,const AttnTensors&T,int vcu,const __attribute__((address_space(3))) float*tball,const int tid){
  AttnUnit u;
  for(int i=0;attn_next(vcu,i,u);++i){ attn_unit<THRL>(u.bh/NHEAD,u.bh%NHEAD,u.qb,T.Q,T.K,T.V,T.O,lds,tball,tid); }
}
#undef SBAR
#undef WAIT_BAR
}

#define XB_TMO      128
#define XB_XCNT(j)  (256  + 64 * (j))
#define XB_XSUB(j)  (1280 + 64 * (j))
#define XB_XGEN(j)  (2304 + 64 * (j))
#define XB_TOP      3328
#define XB_TOPGEN   3392
#define XCD_BAR_WORDS 3456
#define XB_SPIN_CAP (1u << 18)

__device__ __forceinline__ unsigned xb_ld(unsigned* p)              { return __hip_atomic_load(p, __ATOMIC_RELAXED, __HIP_MEMORY_SCOPE_AGENT); }
__device__ __forceinline__ unsigned xb_add(unsigned* p, unsigned v) { return __hip_atomic_fetch_add(p, v, __ATOMIC_RELAXED, __HIP_MEMORY_SCOPE_AGENT); }
__device__ __forceinline__ unsigned xb_xcc_id() { return (unsigned)__builtin_amdgcn_s_getreg((3 << 11) | 20) & 0xFu; }
#define XB_SPIN(cond, bar) do { unsigned _sp = 0; while (cond) { __builtin_amdgcn_s_sleep(1); \
    if ((++_sp & 255u) == 0u) { if (xb_ld(&(bar)[XB_TMO])) break; if (_sp > XB_SPIN_CAP) { atomicAdd(&(bar)[XB_TMO], 1u); break; } } } } while (0)

struct XcdBarrier {
    unsigned* bar; unsigned x;
    volatile LAS unsigned* st;
};

__device__ __forceinline__ XcdBarrier xcd_barrier_post(unsigned* bar, volatile LAS unsigned* st, const bool leader  ) {
    XcdBarrier b; b.bar = bar; b.x = xb_xcc_id(); b.st = st;
    if (leader) (void)xb_add(&bar[XB_XCNT(b.x)], 1u);
    return b;
}
__device__ __forceinline__ void xcd_barrier_complete(unsigned* bar, unsigned x, unsigned& nloc, unsigned& nx) {
    const unsigned G = gridDim.x * gridDim.y * gridDim.z;
    unsigned sum, cnt, mine, sp = 0u;
    for (;;) {
        sum = 0u; cnt = 0u; mine = 0u;
#pragma unroll
        for (unsigned j = 0; j < 16; ++j) { const unsigned c = xb_ld(&bar[XB_XCNT(j)]); sum += c; cnt += (c > 0u) ? 1u : 0u; mine = (j == x) ? c : mine; }
        if (sum == G) break;
        __builtin_amdgcn_s_sleep(1);
        if ((++sp & 255u) == 0u) { if (xb_ld(&bar[XB_TMO])) break; if (sp > XB_SPIN_CAP) { atomicAdd(&bar[XB_TMO], 1u); break; } }
    }
    nloc = mine > 0u ? mine : 1u; nx = cnt > 0u ? cnt : 1u;
}

__device__ __forceinline__ void xcd_barrier(const XcdBarrier& b, const bool leader  ) {
    asm volatile("s_waitcnt vmcnt(0)" ::: "memory");
    __syncthreads();
    if (leader) {
        unsigned* bar = b.bar;
        __builtin_amdgcn_s_waitcnt(0);
        unsigned nloc = b.st[0], nx = b.st[1];
        if (nloc == 0u) { xcd_barrier_complete(bar, b.x, nloc, nx); b.st[0] = nloc; b.st[1] = nx; }
        const unsigned old = xb_add(&bar[XB_XSUB(b.x)], 1u);
        const unsigned gen = old / nloc;
        if (old + 1u == (gen + 1u) * nloc) {
            __builtin_amdgcn_fence(__ATOMIC_RELEASE, "agent");
            asm volatile("s_waitcnt vmcnt(0)" ::: "memory");
            const unsigned og = xb_add(&bar[XB_TOP], 1u);
            const unsigned tg = og / nx;
            if (og + 1u == (tg + 1u) * nx) xb_add(&bar[XB_TOPGEN], 1u);
            else XB_SPIN(xb_ld(&bar[XB_TOPGEN]) == tg, bar);
            __builtin_amdgcn_fence(__ATOMIC_ACQUIRE, "agent");
            xb_add(&bar[XB_XGEN(b.x)], 1u);
            asm volatile("s_waitcnt vmcnt(0)" ::: "memory");
        } else {
            XB_SPIN(xb_ld(&bar[XB_XGEN(b.x)]) == gen, bar);
            __builtin_amdgcn_fence(__ATOMIC_ACQUIRE, "agent");
            asm volatile("s_waitcnt vmcnt(0)" ::: "memory");
        }
    }
    __syncthreads();
}

constexpr size_t MiB = 1u << 20;
constexpr size_t WS_CTL = 0, CTL_ZERO_BYTES = 1 * MiB;
constexpr size_t WS_WIN = 2 * MiB;
constexpr size_t WS_WOUT = 7 * MiB;
constexpr size_t WS_PGATE = 9 * MiB;
constexpr size_t WS_PPROJ = 13 * MiB;
constexpr size_t WS_RCAT = 14 * MiB;
constexpr size_t WS_RL1 = 20 * MiB;
constexpr size_t WS_RS2 = 28 * MiB;
constexpr size_t WS_RWO = 30 * MiB;
constexpr size_t WS_ROUT = 32 * MiB;
constexpr size_t WS_LRUAGG = 33 * MiB;
constexpr size_t WS_MGU = 38 * MiB;
constexpr size_t WS_MDN = 102 * MiB;
constexpr size_t WS_PB = 134 * MiB;
constexpr size_t WS_ACT = 166 * MiB;
constexpr size_t WS_H0 = WS_ACT;
constexpr size_t WS_QKV = WS_ACT + 128 * MiB;
constexpr size_t WS_O = WS_ACT + 448 * MiB;
constexpr size_t WS_HL = WS_ACT + 576 * MiB, WS_CA = WS_ACT + 640 * MiB;
constexpr size_t WS_H2 = WS_ACT;
constexpr size_t WS_LOG = WS_ACT + 128 * MiB;
constexpr size_t WS_ROUTE = WS_ACT + 144 * MiB;
constexpr size_t WS_HID = WS_ACT + 152 * MiB;
constexpr size_t WS_YS = WS_ACT + 288 * MiB;
constexpr size_t WS_PP = WS_ACT + 128 * MiB;
constexpr size_t WS_HCAT = WS_ACT;
constexpr size_t WS_XR = WS_ACT + 256 * MiB, WS_XK = WS_ACT + 384 * MiB, WS_XV = WS_ACT + 512 * MiB;
constexpr size_t WS_R = WS_ACT + 640 * MiB, WS_K = WS_XR, WS_V = WS_XK;
constexpr size_t WS_MID = WS_ACT + 768 * MiB;
constexpr size_t WS_EW = WS_ACT;
constexpr size_t WS_AA = WS_ACT + 128 * MiB;
constexpr size_t WS_Y = WS_XV;
constexpr size_t WS_END = WS_ACT + 832 * MiB;
static_assert(WS_END <= 1024 * MiB, "workspace map");
constexpr size_t RT_EID = 0, RT_POS = 1 * MiB, RT_GATE = 2 * MiB, RT_ROWTOK = 3 * MiB, RT_ROWGATE = 4 * MiB, RT_SLOT = 5 * MiB;
constexpr int CW_BAR = 4096;
constexpr int CW_CNT0 = 16384, CW_CNT1 = 16384 + 64;

constexpr int RING_BYTES = 131072;
constexpr int LDSCTL_OFF = RING_BYTES, MISC_OFF = LDSCTL_OFF + 320;
constexpr int TB_OFF = RING_BYTES + 1024;
constexpr int RTE_OFF = TB_OFF + 2048;
constexpr int LDS_BYTES = 147456;

constexpr int NWAVES = 8;
__device__ __forceinline__ int lane_id_() { int l; asm volatile("v_mbcnt_lo_u32_b32 %0, -1, 0\n\tv_mbcnt_hi_u32_b32 %0, -1, %0" : "=v"(l)); return l; }
#define TID_ (F.wave * 64 + lane_id_())
#define LANE_ (lane_id_())
struct Frame {
    LAS unsigned char* lds; volatile LAS unsigned* MISC; gu32* ctl;
    int wave, vcu, G;
};

__device__ __forceinline__ void load_row4(const float* xrow, int lane, f32x4 (&v)[4]) { const f32x4* p = (const f32x4*)xrow + lane;
#pragma unroll
    for (int j = 0; j < 4; ++j) v[j] = p[64 * j]; }
__device__ __forceinline__ float row_rstd(const f32x4 (&v)[4], float eps) { float s = 0.f;
#pragma unroll
    for (int j = 0; j < 4; ++j) s += (v[j].x * v[j].x + v[j].y * v[j].y) + (v[j].z * v[j].z + v[j].w * v[j].w);
    return 1.0f / sqrtf(wave_sum(s) * (1.0f / 1024.0f) + eps); }
__device__ __forceinline__ void load_row4_bf(const bf16* xrow, int lane, f32x4 (&v)[4]) { const v2u* p = (const v2u*)xrow + lane;
#pragma unroll
    for (int j = 0; j < 4; ++j) { const v2u w = p[64 * j]; v[j] = (f32x4){bflo(w.x), bfhi(w.x), bflo(w.y), bfhi(w.y)}; } }
__device__ __forceinline__ void store_row4_bf(bf16* xrow, int lane, const f32x4 (&v)[4]) { v2u* p = (v2u*)xrow + lane;
#pragma unroll
    for (int j = 0; j < 4; ++j) { v2u o; o.x = pk2(v[j].x, v[j].y); o.y = pk2(v[j].z, v[j].w); p[64 * j] = o; } }
__device__ __forceinline__ void store_row_bf16(bf16* orow, int lane, const f32x4 (&v)[4], float rstd, const float* g) {
    unsigned long long* o8 = (unsigned long long*)orow + lane;
#pragma unroll
    for (int j = 0; j < 4; ++j) { const f32x4 gg = ((const f32x4*)g)[lane + 64 * j];
        o8[64 * j] = (unsigned long long)pk2(v[j].x * rstd * gg.x, v[j].y * rstd * gg.y) | ((unsigned long long)pk2(v[j].z * rstd * gg.z, v[j].w * rstd * gg.w) << 32); }
}

template <int MODE>
__device__ __forceinline__ void transpose_item(const float* W, int K, int N, bf16* WT, int ldo, int row_off, const float* mu, LAS float* scr, int item, int lane) {
    const int nblk = N / 32, kb = item / nblk, nb = item % nblk, k0 = 64 * kb, n0 = 32 * nb;
    float ld[32];
#pragma unroll
    for (int i = 0; i < 32; ++i) { const int kk = 2 * i + (lane >> 5); ld[i] = W[(size_t)(k0 + kk) * N + n0 + (lane & 31)]; }
#pragma unroll
    for (int i = 0; i < 32; ++i) { const int kk = 2 * i + (lane >> 5); scr[kk * 33 + (lane & 31)] = ld[i]; }
    LDS_WAIT(); asm volatile("" ::: "memory");
    const int c = lane & 7;
    int rbase = row_off + n0;
    if (MODE == 2) { rbase = row_off + ((n0 < 512) ? ((n0 >> 7) * 256 + (n0 & 127)) : (((n0 - 512) >> 7) * 256 + 128 + ((n0 - 512) & 127))); }
    float m[8];
    if (MODE == 1) {
#pragma unroll
        for (int e = 0; e < 8; ++e) m[e] = mu[k0 + 8 * c + e]; }
#pragma unroll
    for (int j = 0; j < 4; ++j) { const int n = (lane >> 3) + 8 * j; const LAS float* s = scr + (8 * c) * 33 + n;
        float v[8];
#pragma unroll
        for (int e = 0; e < 8; ++e) v[e] = s[e * 33];
        bf16* dst = WT + (size_t)(rbase + n) * ldo + k0 + 8 * c;
        if (MODE == 1) {
            v4u o, o2;
            o.x = pk2(v[0] * (1.f - m[0]), v[1] * (1.f - m[1])); o.y = pk2(v[2] * (1.f - m[2]), v[3] * (1.f - m[3])); o.z = pk2(v[4] * (1.f - m[4]), v[5] * (1.f - m[5])); o.w = pk2(v[6] * (1.f - m[6]), v[7] * (1.f - m[7]));
            o2.x = pk2(v[0] * m[0], v[1] * m[1]); o2.y = pk2(v[2] * m[2], v[3] * m[3]); o2.z = pk2(v[4] * m[4], v[5] * m[5]); o2.w = pk2(v[6] * m[6], v[7] * m[7]);
            *(GAS v4u*)dst = o; *(GAS v4u*)(dst + 1024) = o2;
        } else {
            v4u o; o.x = pk2(v[0], v[1]); o.y = pk2(v[2], v[3]); o.z = pk2(v[4], v[5]); o.w = pk2(v[6], v[7]);
            *(GAS v4u*)dst = o; }
    }
    LDS_WAIT(); asm volatile("" ::: "memory");
}

struct In {
    const float *x, *p, *rel_bias, *norm_mix, *ab_w_in, *ab_w_out, *lam_q1, *lam_k1, *lam_q2, *lam_k2, *sub_g, *conv_w, *conv_b, *lru_wa, *lru_ba, *lru_wx, *lru_bx, *lru_lambda,
        *rwkv_mu, *rwkv_wr, *rwkv_wk, *rwkv_wv, *rwkv_wo, *rwkv_w0, *rwkv_w1, *rwkv_w2, *rwkv_a0, *rwkv_a1, *rwkv_a2, *rwkv_g1, *rwkv_g2, *rwkv_kk, *rwkv_ka, *rwkv_rk, *rwkv_ln_g, *rwkv_ln_b,
        *norm_ffn, *moe_wc, *moe_bc, *moe_wf, *moe_bf, *moe_w_gu, *moe_w_down, *ple_norm, *ple_gate, *ple_proj, *final_norm;
};

__device__ __forceinline__ void prep_dense_weights(Frame& F, const In& I, unsigned char* ws) {
    LAS float* scr = (LAS float*)(F.lds + F.wave * 16384);
    const int gw = F.vcu * NWAVES + F.wave, NGW = F.G * NWAVES;
    bf16* WIN = (bf16*)(ws + WS_WIN); bf16* WOUT = (bf16*)(ws + WS_WOUT); bf16* PG = (bf16*)(ws + WS_PGATE); bf16* PPJ = (bf16*)(ws + WS_PPROJ);
    bf16* RCAT = (bf16*)(ws + WS_RCAT); bf16* RL1 = (bf16*)(ws + WS_RL1); bf16* RWO = (bf16*)(ws + WS_RWO);
    constexpr int I_IN = (1024 / 64) * (2560 / 32), I_SQ = (1024 / 64) * (1024 / 32), I_PJ = (256 / 64) * (1024 / 32), I_L64 = (1024 / 64) * (64 / 32), I_L160 = (1024 / 64) * (160 / 32);
    int st = gw;
#define TJOB(MODE, NITEMS, W, K, N, WT, LDO, ROFF, MU) do { for (int it = st; it < (NITEMS); it += NGW) transpose_item<MODE>(W, K, N, WT, LDO, ROFF, MU, scr, it, LANE_); \
        st = (st + NGW - ((NITEMS) % NGW)) % NGW; asm volatile("" : "+s"(st)); } while (0)
    TJOB(0, I_IN, I.ab_w_in, 1024, 2560, WIN, 1024, 0, nullptr);
    TJOB(0, I_SQ, I.ab_w_out, 1024, 1024, WOUT, 1024, 0, nullptr);
    TJOB(0, I_SQ, I.ple_gate, 1024, 1024, PG, 1024, 0, nullptr);
    TJOB(0, I_SQ, I.ple_gate + 1024 * 1024, 1024, 1024, PG + 1024 * 1024, 1024, 0, nullptr);
    TJOB(0, I_SQ, I.rwkv_wo, 1024, 1024, RWO, 1024, 0, nullptr);
    TJOB(0, I_SQ, I.rwkv_wr, 1024, 1024, RCAT, 1024, 0, nullptr);
    TJOB(0, I_SQ, I.rwkv_wk, 1024, 1024, RCAT, 1024, 1024, nullptr);
    TJOB(0, I_SQ, I.rwkv_wv, 1024, 1024, RCAT, 1024, 2048, nullptr);
    TJOB(0, I_PJ, I.ple_proj, 256, 1024, PPJ, 256, 0, nullptr);
    TJOB(0, I_PJ, I.ple_proj + 256 * 1024, 256, 1024, PPJ + 1024 * 256, 256, 0, nullptr);
    TJOB(1, I_L64, I.rwkv_w1, 1024, 64, RL1, 2048, 0, I.rwkv_mu + 1 * 1024);
    TJOB(1, I_L64, I.rwkv_a1, 1024, 64, RL1, 2048, 64, I.rwkv_mu + 4 * 1024);
    TJOB(1, I_L160, I.rwkv_g1, 1024, 160, RL1, 2048, 256, I.rwkv_mu + 5 * 1024);
#undef TJOB
    const int gt = F.vcu * 512 + TID_, NGT = F.G * 512;
    { v4u z = {0u, 0u, 0u, 0u}; const int per_row = 2048 / 8;
      for (int i = gt; i < (128 + 96) * per_row; i += NGT) { int rr = i / per_row, cc = i % per_row; rr = (rr < 128) ? (128 + rr) : (416 + rr - 128); *(GAS v4u*)(RL1 + (size_t)rr * 2048 + cc * 8) = z; } }
    { bf16* S2 = (bf16*)(ws + WS_RS2);
      for (int i = gt; i < 3 * 1024 * 256; i += NGT) { const int ty = i / (1024 * 256), n = (i / 256) & 1023, k = i & 255; float v = 0.f;
          if (ty == 0) { if (k < 64) v = I.rwkv_w2[k * 1024 + n]; } else if (ty == 1) { if (k >= 64 && k < 128) v = I.rwkv_a2[(k - 64) * 1024 + n]; } else { if (k < 160) v = I.rwkv_g2[k * 1024 + n]; }
          S2[i] = (bf16)f2bf(v); } }
    { bf16* RT = (bf16*)(ws + WS_ROUT);
      for (int i = gt; i < 2 * 256 * 1024; i += NGT) { const int l = i / (256 * 1024), n = (i / 1024) & 255, k = i & 1023; float v = 0.f;
          if (n < 4) v = I.moe_wc[(size_t)l * 1024 * 4 + k * 4 + n]; else if (n < 36) v = I.moe_wf[(size_t)l * 1024 * 32 + k * 32 + (n - 4)];
          RT[i] = (bf16)f2bf(v); } }
}
__device__ __forceinline__ void prep_layer_weights(Frame& F, const In& I, unsigned char* ws, int layer) {
    LAS float* scr = (LAS float*)(F.lds + F.wave * 16384);
    const int gw = F.vcu * NWAVES + F.wave, NGW = F.G * NWAVES;
    bf16* MGU = (bf16*)(ws + WS_MGU); bf16* MDN = (bf16*)(ws + WS_MDN);
    const float* wgu = I.moe_w_gu + (size_t)layer * NEXP * 1024 * 1024; const float* wdn = I.moe_w_down + (size_t)layer * NEXP * 512 * 1024;
    constexpr int I_GU = (1024 / 64) * (1024 / 32), I_DN = (512 / 64) * (1024 / 32);
    for (int it = gw; it < NEXP * (I_GU + I_DN); it += NGW) {
        const int e = it / (I_GU + I_DN); int r = it % (I_GU + I_DN);
        if (r < I_GU) transpose_item<2>(wgu + (size_t)e * 1024 * 1024, 1024, 1024, MGU + (size_t)e * 1024 * 1024, 1024, 0, nullptr, scr, r, LANE_);
        else transpose_item<0>(wdn + (size_t)e * 512 * 1024, 512, 1024, MDN + (size_t)e * 1024 * 512, 512, 0, nullptr, scr, r - I_GU, LANE_);
    }
    const int gt = F.vcu * 512 + TID_, NGT = F.G * 512;
    const f32x4* ps = (const f32x4*)(I.p + (size_t)layer * T * PLE); v2u* pd = (v2u*)(ws + WS_PB);
    for (int i = gt; i < T * PLE / 4; i += 4 * NGT) { f32x4 v[4];
#pragma unroll
        for (int r = 0; r < 4; ++r) v[r] = ps[i + r * NGT];
#pragma unroll
        for (int r = 0; r < 4; ++r) { v2u o; o.x = pk2(v[r].x, v[r].y); o.y = pk2(v[r].z, v[r].w); pd[i + r * NGT] = o; } }
}

template <bool XBF>
__device__ __forceinline__ void norm_pass(Frame& F, const void* x, const float* g, bf16* out) {
    const int gw = F.vcu * NWAVES + F.wave, NGW = F.G * NWAVES; const int lane = LANE_;
    for (int t = 4 * gw; t < T; t += 4 * NGW) {
        f32x4 v[4][4];
#pragma unroll
        for (int r = 0; r < 4; ++r) { if (XBF) load_row4_bf((const bf16*)x + (size_t)(t + r) * D, lane, v[r]); else load_row4((const float*)x + (size_t)(t + r) * D, lane, v[r]); }
#pragma unroll
        for (int r = 0; r < 4; ++r) { const float rs = row_rstd(v[r], 1e-6f); store_row_bf16(out + (size_t)(t + r) * D, lane, v[r], rs, g); }
    }
}
__device__ __forceinline__ void rwkv_input_pass(Frame& F, const bf16* x, const float* g, const float* mu, bf16* HCAT, bf16* XR, bf16* XK, bf16* XV) {
    const int gw = F.vcu * NWAVES + F.wave, NGW = F.G * NWAVES; const int lane = LANE_;
    f32x4 gg[4], mr[4], mk[4], mv[4];
#pragma unroll
    for (int j = 0; j < 4; ++j) { gg[j] = ((const f32x4*)g)[lane + 64 * j]; mr[j] = ((const f32x4*)(mu + 0 * 1024))[lane + 64 * j]; mk[j] = ((const f32x4*)(mu + 2 * 1024))[lane + 64 * j]; mv[j] = ((const f32x4*)(mu + 3 * 1024))[lane + 64 * j]; }
    for (int blk = gw; blk < T / 32; blk += NGW) {
        const int t0 = blk * 32; f32x4 hp[4];
        if ((t0 & (SEQ - 1)) == 0) {
#pragma unroll
            for (int j = 0; j < 4; ++j) hp[j] = (f32x4){0.f, 0.f, 0.f, 0.f};
        } else { f32x4 v[4]; load_row4_bf(x + (size_t)(t0 - 1) * D, lane, v); const float rstd = row_rstd(v, 1e-6f);
#pragma unroll
            for (int j = 0; j < 4; ++j) hp[j] = v[j] * rstd * gg[j]; }
        f32x4 vn[4]; load_row4_bf(x + (size_t)t0 * D, lane, vn);
        for (int t = t0; t < t0 + 32; ++t) {
            f32x4 v[4];
#pragma unroll
            for (int j = 0; j < 4; ++j) v[j] = vn[j];
            if (t + 1 < t0 + 32) load_row4_bf(x + (size_t)(t + 1) * D, lane, vn);
            const float rstd = row_rstd(v, 1e-6f);
            unsigned long long* oh = (unsigned long long*)(HCAT + (size_t)t * 2048) + lane; unsigned long long* or_ = (unsigned long long*)(XR + (size_t)t * 1024) + lane;
            unsigned long long* ok = (unsigned long long*)(XK + (size_t)t * 1024) + lane; unsigned long long* ov = (unsigned long long*)(XV + (size_t)t * 1024) + lane;
#pragma unroll
            for (int j = 0; j < 4; ++j) { const f32x4 h = v[j] * rstd * gg[j], dd = hp[j] - h;
                oh[64 * j] = (unsigned long long)pk2(h.x, h.y) | ((unsigned long long)pk2(h.z, h.w) << 32);
                oh[256 + 64 * j] = (unsigned long long)pk2(hp[j].x, hp[j].y) | ((unsigned long long)pk2(hp[j].z, hp[j].w) << 32);
                const f32x4 a = h + dd * mr[j], b = h + dd * mk[j], c = h + dd * mv[j];
                or_[64 * j] = (unsigned long long)pk2(a.x, a.y) | ((unsigned long long)pk2(a.z, a.w) << 32);
                ok[64 * j] = (unsigned long long)pk2(b.x, b.y) | ((unsigned long long)pk2(b.z, b.w) << 32);
                ov[64 * j] = (unsigned long long)pk2(c.x, c.y) | ((unsigned long long)pk2(c.z, c.w) << 32);
                hp[j] = h; }
        }
    }
}
__device__ __forceinline__ void combine_norm_pass(Frame& F, const bf16* xin, bf16* xout, const bf16* YS, const int* slot, const float* g, bf16* out) {
    const int gw = F.vcu * NWAVES + F.wave, NGW = F.G * NWAVES; const int lane = LANE_;
    for (int t = 2 * gw; t < T; t += 2 * NGW) {
        f32x4 v[2][4]; v2u ya[2][4], yb[2][4];
#pragma unroll
        for (int r = 0; r < 2; ++r) { load_row4_bf(xin + (size_t)(t + r) * D, lane, v[r]);
            const int s0 = slot[2 * (t + r)], s1 = slot[2 * (t + r) + 1];
            const v2u* y0 = (const v2u*)(YS + (size_t)s0 * D) + lane; const v2u* y1 = (const v2u*)(YS + (size_t)s1 * D) + lane;
#pragma unroll
            for (int j = 0; j < 4; ++j) { ya[r][j] = y0[64 * j]; yb[r][j] = y1[64 * j]; } }
#pragma unroll
        for (int r = 0; r < 2; ++r) {
#pragma unroll
            for (int j = 0; j < 4; ++j) { const v2u a = ya[r][j], b = yb[r][j];
                v[r][j].x += bflo(a.x) + bflo(b.x); v[r][j].y += bfhi(a.x) + bfhi(b.x); v[r][j].z += bflo(a.y) + bflo(b.y); v[r][j].w += bfhi(a.y) + bfhi(b.y); }
            store_row4_bf(xout + (size_t)(t + r) * D, lane, v[r]);
            const float rstd = row_rstd(v[r], 1e-6f);
            store_row_bf16(out + (size_t)(t + r) * D, lane, v[r], rstd, g); }
    }
}
__device__ __forceinline__ void final_norm_pass(Frame& F, const bf16* x, float* out, const float* g) {
    const int gw = F.vcu * NWAVES + F.wave, NGW = F.G * NWAVES; const int lane = LANE_;
    for (int t = 4 * gw; t < T; t += 4 * NGW) {
        f32x4 v[4][4];
#pragma unroll
        for (int r = 0; r < 4; ++r) load_row4_bf(x + (size_t)(t + r) * D, lane, v[r]);
#pragma unroll
        for (int r = 0; r < 4; ++r) { const float rs = row_rstd(v[r], 1e-6f); f32x4* xo = (f32x4*)(out + (size_t)(t + r) * D) + lane;
#pragma unroll
            for (int j = 0; j < 4; ++j) { const f32x4 gg = ((const f32x4*)g)[lane + 64 * j]; xo[64 * j] = v[r][j] * rs * gg; } }
    }
}

__device__ __forceinline__ void diff_combine_pass(Frame& F, const In& I, const bf16* O, bf16* YCAT) {
    const int gw = F.vcu * NWAVES + F.wave, NGW = F.G * NWAVES;
    const float lam_init = 0.2f;
    const float d1 = wave_sum(I.lam_q1[LANE_] * I.lam_k1[LANE_]), d2 = wave_sum(I.lam_q2[LANE_] * I.lam_k2[LANE_]);
    const float lam = expf(d1) - expf(d2) + lam_init;
    const int h = LANE_ >> 4, q = LANE_ & 15;
    float sg[8];
#pragma unroll
    for (int e = 0; e < 8; ++e) sg[e] = I.sub_g[q * 8 + e] * (1.0f - lam_init);
    for (int t0 = 4 * gw; t0 < T; t0 += 4 * NGW) {
        v4u av[4], bv[4];
#pragma unroll
        for (int r = 0; r < 4; ++r) { av[r] = *(const v4u*)(O + (size_t)(t0 + r) * 1024 + h * 256 + q * 8); bv[r] = *(const v4u*)(O + (size_t)(t0 + r) * 1024 + h * 256 + 128 + q * 8); }
#pragma unroll
        for (int r = 0; r < 4; ++r) { const v4u a = av[r], b = bv[r]; const int t = t0 + r;
        float o[8];
        o[0] = bflo(a.x) - lam * bflo(b.x); o[1] = bfhi(a.x) - lam * bfhi(b.x); o[2] = bflo(a.y) - lam * bflo(b.y); o[3] = bfhi(a.y) - lam * bfhi(b.y);
        o[4] = bflo(a.z) - lam * bflo(b.z); o[5] = bfhi(a.z) - lam * bfhi(b.z); o[6] = bflo(a.w) - lam * bflo(b.w); o[7] = bfhi(a.w) - lam * bfhi(b.w);
        float s = 0.f;
#pragma unroll
        for (int e = 0; e < 8; ++e) s += o[e] * o[e];
        s += __shfl_xor(s, 1); s += __shfl_xor(s, 2); s += __shfl_xor(s, 4); s += __shfl_xor(s, 8);
        const float rstd = 1.0f / sqrtf(s * (1.0f / 128.0f) + 1e-5f);
        v4u w; w.x = pk2(o[0] * rstd * sg[0], o[1] * rstd * sg[1]); w.y = pk2(o[2] * rstd * sg[2], o[3] * rstd * sg[3]); w.z = pk2(o[4] * rstd * sg[4], o[5] * rstd * sg[5]); w.w = pk2(o[6] * rstd * sg[6], o[7] * rstd * sg[7]);
        *(v4u*)(YCAT + (size_t)t * 1024 + h * 128 + q * 8) = w; }
    }
}

constexpr int LCT = 64, LNCH = SEQ / LCT;
__device__ __forceinline__ float gelu_tanh(float x) { const float u = 0.7978845608028654f * (x + 0.044715f * x * x * x); return x * sigmoidf_(2.0f * u); }
template <bool FINAL>
__device__ __forceinline__ void lru_phase(Frame& F, const In& I, const bf16* XB, const bf16* GB, f32x2* AGG, bf16* YCAT, bf16* HLp, bf16* CAp) {
    const int ch = TID_, n = ch >> 6, d = ch & 63;
    LAS float* U = (LAS float*)F.lds;
    f32x2 wg[64];
#pragma unroll
    for (int c = 0; c < 64; ++c) { wg[c].x = I.lru_wa[n * 4096 + c * 64 + d]; wg[c].y = I.lru_wx[n * 4096 + c * 64 + d]; }
    const float cw0 = I.conv_w[0 * 512 + ch], cw1 = I.conv_w[1 * 512 + ch], cw2 = I.conv_w[2 * 512 + ch], cw3 = I.conv_w[3 * 512 + ch], cb = I.conv_b[ch];
    const float ba = I.lru_ba[ch], bx = I.lru_bx[ch];
    const float lam = I.lru_lambda[ch]; const float sp = (lam > 15.f) ? expf(-lam) : log1pf(expf(-lam));
    const float m8sp = -8.0f * sp;
    for (int un = blockIdx.x; un < NB * LNCH; un += F.G) {
        const int b = un / LNCH, c = un % LNCH; const size_t row0 = (size_t)b * SEQ + (size_t)c * LCT;
        unsigned short xraw[LCT + 3];
        if (c > 0) { xraw[0] = XB[(row0 - 3) * 512 + ch]; xraw[1] = XB[(row0 - 2) * 512 + ch]; xraw[2] = XB[(row0 - 1) * 512 + ch]; } else { xraw[0] = 0; xraw[1] = 0; xraw[2] = 0; }
#pragma unroll
        for (int tk = 0; tk < LCT; ++tk) xraw[3 + tk] = XB[(row0 + tk) * 512 + ch];
        float h = 0.f, Ap = 1.f;
        if (FINAL) { for (int j = 0; j < c; ++j) { const f32x2 ag = AGG[((size_t)b * LNCH + j) * 512 + ch]; h = ag.x * h + ag.y; } }
#pragma unroll
        for (int tk = 0; tk < LCT; ++tk) U[tk * 512 + ch] = cw0 * bf1(xraw[tk]) + cw1 * bf1(xraw[tk + 1]) + cw2 * bf1(xraw[tk + 2]) + cw3 * bf1(xraw[tk + 3]) + cb;
        __syncthreads();
        unsigned short gcur[8], gnxt[8];
        if (FINAL) {
#pragma unroll
            for (int j = 0; j < 8; ++j) gcur[j] = GB[(row0 + j) * 512 + ch]; }
#pragma unroll 1
        for (int tg = 0; tg < LCT / 8; ++tg) {
            if (FINAL) { const int tn = (tg + 1 < LCT / 8) ? (tg + 1) * 8 : tg * 8;
#pragma unroll
                for (int j = 0; j < 8; ++j) gnxt[j] = GB[(row0 + tn + j) * 512 + ch]; }
#pragma unroll
            for (int j = 0; j < 8; ++j) { const int tk = tg * 8 + j;
                const LAS f32x4* up = (const LAS f32x4*)(U + tk * 512 + n * 64);
                f32x2 acc = {ba, bx};
#pragma unroll
                for (int c4 = 0; c4 < 16; ++c4) { const f32x4 uu = up[c4];
                    acc += wg[4 * c4 + 0] * uu.x; acc += wg[4 * c4 + 1] * uu.y; acc += wg[4 * c4 + 2] * uu.z; acc += wg[4 * c4 + 3] * uu.w; }
                const float r = sigmoidf_(acc.x), ig = sigmoidf_(acc.y);
                const float la = r * m8sp; const float a = __expf(la); const float t2 = 2.0f * la; const float om = (t2 > -0.02f) ? -t2 * (1.0f + t2 * (0.5f + t2 * (0.16666667f + t2 * 0.041666668f))) : 1.0f - a * a; const float bb = __builtin_amdgcn_sqrtf(om) * (ig * U[tk * 512 + ch]);
                h = a * h + bb;
                if (FINAL) { YCAT[(row0 + tk) * 1024 + 512 + ch] = (bf16)f2bf(h * gelu_tanh(bf1(gcur[j]))); }
                else { Ap *= a; HLp[(row0 + tk) * 512 + ch] = (bf16)f2bf(h); CAp[(row0 + tk) * 512 + ch] = (bf16)f2bf(Ap); } }
            if (FINAL) {
#pragma unroll
                for (int j = 0; j < 8; ++j) gcur[j] = gnxt[j]; }
        }
        if (!FINAL) { f32x2 ag; ag.x = Ap; ag.y = h; AGG[((size_t)b * LNCH + c) * 512 + ch] = ag; }
        __syncthreads();
    }
}

__device__ __forceinline__ void lru_agg_mfma(Frame& F, const In& I, const bf16* XB, f32x2* AGG, bf16* HLp, bf16* CAp) {
    const int tid = TID_, lane = tid & 63, fr = lane & 15, fq = lane >> 4, n = F.wave, ch = tid;
    constexpr int UP = 520;
    LAS bf16* U = (LAS bf16*)F.lds;
    bf16x8 Wr[4][2], Wi[4][2];
#pragma unroll
    for (int dd = 0; dd < 4; ++dd)
#pragma unroll
        for (int kh = 0; kh < 2; ++kh) { unsigned pr_[4], pi_[4];
#pragma unroll
            for (int j = 0; j < 4; ++j) { const int c0 = 32 * kh + 8 * fq + 2 * j, d = 16 * dd + fr;
                pr_[j] = pk2(I.lru_wa[n * 4096 + c0 * 64 + d], I.lru_wa[n * 4096 + (c0 + 1) * 64 + d]); pi_[j] = pk2(I.lru_wx[n * 4096 + c0 * 64 + d], I.lru_wx[n * 4096 + (c0 + 1) * 64 + d]); }
            Wr[dd][kh] = __builtin_bit_cast(bf16x8, (v4u){pr_[0], pr_[1], pr_[2], pr_[3]}); Wi[dd][kh] = __builtin_bit_cast(bf16x8, (v4u){pi_[0], pi_[1], pi_[2], pi_[3]}); }
    float cba[4], cbx[4], cm8[4];
#pragma unroll
    for (int dd = 0; dd < 4; ++dd) { const int chd = 64 * n + 16 * dd + fr; cba[dd] = I.lru_ba[chd]; cbx[dd] = I.lru_bx[chd];
        const float lam = I.lru_lambda[chd]; cm8[dd] = -8.0f * ((lam > 15.f) ? expf(-lam) : log1pf(expf(-lam))); }
    const float cw0 = I.conv_w[0 * 512 + ch], cw1 = I.conv_w[1 * 512 + ch], cw2 = I.conv_w[2 * 512 + ch], cw3 = I.conv_w[3 * 512 + ch], cb = I.conv_b[ch];
    for (int un = blockIdx.x; un < NB * LNCH; un += F.G) {
        const int b = un / LNCH, c = un % LNCH; const size_t row0 = (size_t)b * SEQ + (size_t)c * LCT;
        unsigned short xraw[LCT + 3];
        if (c > 0) { xraw[0] = XB[(row0 - 3) * 512 + ch]; xraw[1] = XB[(row0 - 2) * 512 + ch]; xraw[2] = XB[(row0 - 1) * 512 + ch]; } else { xraw[0] = 0; xraw[1] = 0; xraw[2] = 0; }
#pragma unroll
        for (int tk = 0; tk < LCT; ++tk) xraw[3 + tk] = XB[(row0 + tk) * 512 + ch];
#pragma unroll
        for (int tk = 0; tk < LCT; ++tk) U[tk * UP + ch] = (bf16)f2bf(cw0 * bf1(xraw[tk]) + cw1 * bf1(xraw[tk + 1]) + cw2 * bf1(xraw[tk + 2]) + cw3 * bf1(xraw[tk + 3]) + cb);
        __syncthreads();
        bf16x8 X[4][2];
#pragma unroll
        for (int tt = 0; tt < 4; ++tt)
#pragma unroll
            for (int kh = 0; kh < 2; ++kh) X[tt][kh] = *(const LAS bf16x8*)(U + (16 * tt + fr) * UP + 64 * n + 32 * kh + 8 * fq);
#pragma unroll 1
        for (int dd = 0; dd < 4; ++dd) {
            bf16x8 wr0, wr1, wi0, wi1; float kba, kbx, km8;
            if (dd == 0) { wr0 = Wr[0][0]; wr1 = Wr[0][1]; wi0 = Wi[0][0]; wi1 = Wi[0][1]; kba = cba[0]; kbx = cbx[0]; km8 = cm8[0]; }
            else if (dd == 1) { wr0 = Wr[1][0]; wr1 = Wr[1][1]; wi0 = Wi[1][0]; wi1 = Wi[1][1]; kba = cba[1]; kbx = cbx[1]; km8 = cm8[1]; }
            else if (dd == 2) { wr0 = Wr[2][0]; wr1 = Wr[2][1]; wi0 = Wi[2][0]; wi1 = Wi[2][1]; kba = cba[2]; kbx = cbx[2]; km8 = cm8[2]; }
            else { wr0 = Wr[3][0]; wr1 = Wr[3][1]; wi0 = Wi[3][0]; wi1 = Wi[3][1]; kba = cba[3]; kbx = cbx[3]; km8 = cm8[3]; }
            const int chd = 64 * n + 16 * dd + fr;
            float hc = 0.f, Ac = 1.f;
#pragma unroll
            for (int tt = 0; tt < 4; ++tt) {
                f32x4 pr = (f32x4){0.f, 0.f, 0.f, 0.f}, pi = pr;
                pr = __builtin_amdgcn_mfma_f32_16x16x32_bf16(X[tt][0], wr0, pr, 0, 0, 0); pr = __builtin_amdgcn_mfma_f32_16x16x32_bf16(X[tt][1], wr1, pr, 0, 0, 0);
                pi = __builtin_amdgcn_mfma_f32_16x16x32_bf16(X[tt][0], wi0, pi, 0, 0, 0); pi = __builtin_amdgcn_mfma_f32_16x16x32_bf16(X[tt][1], wi1, pi, 0, 0, 0);
                float a[4], bb[4];
#pragma unroll
                for (int e = 0; e < 4; ++e) { const int tok = 16 * tt + 4 * fq + e; const float u = bf1(U[tok * UP + chd]);
                    const float r = sigmoidf_(pr[e] + kba), ig = sigmoidf_(pi[e] + kbx); const float la = r * km8; a[e] = __expf(la); const float t2 = 2.0f * la;
                    const float om = (t2 > -0.02f) ? -t2 * (1.0f + t2 * (0.5f + t2 * (0.16666667f + t2 * 0.041666668f))) : 1.0f - a[e] * a[e]; bb[e] = __builtin_amdgcn_sqrtf(om) * (ig * u); }
                const float A4 = (a[0] * a[1]) * (a[2] * a[3]); const float B4 = ((bb[0] * a[1] + bb[1]) * a[2] + bb[2]) * a[3] + bb[3];
                float h = hc, Ap = Ac, hs = hc, As = Ac;
#pragma unroll
                for (int j = 0; j < 4; ++j) { const float Aj = __shfl(A4, fr + 16 * j), Bj = __shfl(B4, fr + 16 * j); if (j == fq) { hs = h; As = Ap; } h = Aj * h + Bj; Ap *= Aj; }
                hc = h; Ac = Ap; h = hs; Ap = As;
#pragma unroll
                for (int e = 0; e < 4; ++e) { h = a[e] * h + bb[e]; Ap *= a[e]; const size_t o = (row0 + 16 * tt + 4 * fq + e) * 512 + chd; HLp[o] = (bf16)f2bf(h); CAp[o] = (bf16)f2bf(Ap); }
            }
            if (fq == 0) { f32x2 ag; ag.x = Ac; ag.y = hc; AGG[((size_t)b * LNCH + c) * 512 + chd] = ag; }
        }
        __syncthreads();
    }
}

__device__ __forceinline__ void lru_final_pass(Frame& F, const bf16* HLp, const bf16* CAp, const bf16* GB, const f32x2* AGG, bf16* YCAT) {
    const int ch = TID_;
    for (int un = blockIdx.x; un < NB * LNCH; un += F.G) {
        const int b = un / LNCH, c = un % LNCH; const size_t row0 = (size_t)b * SEQ + (size_t)c * LCT;
        float carry = 0.f;
        for (int j = 0; j < c; ++j) { const f32x2 ag = AGG[((size_t)b * LNCH + j) * 512 + ch]; carry = ag.x * carry + ag.y; }
#pragma unroll 4
        for (int t8 = 0; t8 < LCT; t8 += 8) {
            bf16 hl[8], ca[8], gv[8];
#pragma unroll
            for (int j = 0; j < 8; ++j) { const size_t o = (row0 + t8 + j) * 512 + ch; hl[j] = HLp[o]; ca[j] = CAp[o]; gv[j] = GB[o]; }
#pragma unroll
            for (int j = 0; j < 8; ++j) { const float h = bf1(hl[j]) + bf1(ca[j]) * carry; YCAT[(row0 + t8 + j) * 1024 + 512 + ch] = (bf16)f2bf(h * gelu_tanh(bf1(gv[j]))); }
        }
    }
}

__device__ __forceinline__ void route_pass_a(Frame& F, const In& I, int layer, const float* LOG, unsigned char* rt, gu32* cnt) {
    LAS int* lcnt = (LAS int*)(F.lds + RTE_OFF); LAS int* lbase = lcnt + 32;
    int* EID = (int*)(rt + RT_EID); int* POS = (int*)(rt + RT_POS); float* GATE = (float*)(rt + RT_GATE);
    const float* bc = I.moe_bc + layer * 4; const float* bfb = I.moe_bf + layer * 32;
    for (int un = blockIdx.x; un < T / 512; un += F.G) {
        if (TID_ < 32) lcnt[TID_] = 0;
        __syncthreads();
        const int t = un * 512 + TID_; const float* lg = LOG + (size_t)t * 64;
        const f32x4 g4 = *(const f32x4*)lg;
        float gl[4] = {g4.x + bc[0], g4.y + bc[1], g4.z + bc[2], g4.w + bc[3]};
        int gi = 0; float gm = gl[0];
#pragma unroll
        for (int j = 1; j < 4; ++j) if (gl[j] > gm) { gm = gl[j]; gi = j; }
        float gs = 0.f;
#pragma unroll
        for (int j = 0; j < 4; ++j) gs += __expf(gl[j] - gm);
        const float gprob = 1.0f / gs;
        const f32x4 e0 = *(const f32x4*)(lg + 4 + gi * 8), e1 = *(const f32x4*)(lg + 8 + gi * 8);
        float el[8] = {e0.x, e0.y, e0.z, e0.w, e1.x, e1.y, e1.z, e1.w};
#pragma unroll
        for (int j = 0; j < 8; ++j) el[j] += bfb[gi * 8 + j];
        int i0 = 0; float m0 = el[0];
#pragma unroll
        for (int j = 1; j < 8; ++j) if (el[j] > m0) { m0 = el[j]; i0 = j; }
        int i1 = -1; float m1 = -INFINITY;
#pragma unroll
        for (int j = 0; j < 8; ++j) if (j != i0 && el[j] > m1) { m1 = el[j]; i1 = j; }
        const float r1 = __expf(m1 - m0); const float g0 = gprob / (1.0f + r1), g1 = gprob * r1 / (1.0f + r1);
        const int ex0 = gi * 8 + i0, ex1 = gi * 8 + i1;
        const int p0 = atomicAdd((int*)&lcnt[ex0], 1), p1 = atomicAdd((int*)&lcnt[ex1], 1);
        __syncthreads();
        if (TID_ < 32) lbase[TID_] = (int)__hip_atomic_fetch_add(cnt + TID_, (unsigned)lcnt[TID_], RLX_AGENT);
        __syncthreads();
        EID[2 * t] = ex0; EID[2 * t + 1] = ex1; POS[2 * t] = lbase[ex0] + p0; POS[2 * t + 1] = lbase[ex1] + p1; GATE[2 * t] = g0; GATE[2 * t + 1] = g1;
        __syncthreads();
    }
}
__device__ __forceinline__ void route_bases(Frame& F, gu32* cnt) {
    LAS int* eb = (LAS int*)(F.lds + RTE_OFF + 512);
    const int tid = TID_;
    if (tid < 64) {
        const int c = (tid < 32) ? (int)__hip_atomic_load(cnt + (tid & 31), RLX_AGENT) : 0; const int p = (c + 255) & ~255; int s = p;
#pragma unroll
        for (int o = 1; o < 32; o <<= 1) { const int t = __shfl_up(s, o); if ((tid & 63) >= o) s += t; }
        if (tid < 32) { eb[tid] = s - p; if (tid == 31) eb[32] = s; }
    }
    __syncthreads();
}
__device__ __forceinline__ void route_pass_b(Frame& F, unsigned char* rt, gu32* cnt) {
    route_bases(F, cnt);
    LAS int* eb = (LAS int*)(F.lds + RTE_OFF + 512);
    const int* EID = (const int*)(rt + RT_EID); const int* POS = (const int*)(rt + RT_POS); const float* GATE = (const float*)(rt + RT_GATE);
    int* ROWTOK = (int*)(rt + RT_ROWTOK); float* ROWGATE = (float*)(rt + RT_ROWGATE); int* SLOT = (int*)(rt + RT_SLOT);
    const int gt = F.vcu * 512 + TID_, NGT = F.G * 512;
    for (int i = gt; i < 2 * T; i += NGT) { const int dst = eb[EID[i]] + POS[i]; ROWTOK[dst] = i >> 1; ROWGATE[dst] = GATE[i]; SLOT[i] = dst; }
    for (int i = gt; i < 32 * 256; i += NGT) { const int e = i >> 8, j = i & 255; const int c = (int)__hip_atomic_load(cnt + e, RLX_AGENT); const int pad = ((c + 255) & ~255) - c;
        if (j < pad) { ROWTOK[eb[e] + c + j] = 0; ROWGATE[eb[e] + c + j] = 0.f; } }
    __syncthreads();
}
struct MoeOrder {
    int G, c, ntiles; const LAS int* eb; const char* A; const char* W; size_t astep, wexp, wtile; bool gather;
    __device__ bool next(int i, pg8::Unit& u) const {
        const int L = i * G + c; if (L >= ntiles * 4) return false;
        u.pm = L >> 2; u.pn = L & 3; const int s0 = u.pm * 256; int e = 0;
#pragma unroll 1
        for (int j = 1; j < 32; ++j) if (eb[j] <= s0) e = j;
        e = __builtin_amdgcn_readfirstlane(e); u.aux = e; u.A = gather ? A : A + (size_t)u.pm * astep; u.B = W + (size_t)e * wexp + (size_t)u.pn * wtile; return true;
    }
};

constexpr int RTC = 32, RNCH = SEQ / RTC, RTOK = 352;
#define LBAR() do { asm volatile("s_waitcnt lgkmcnt(0)" ::: "memory"); __builtin_amdgcn_s_barrier(); asm volatile("" ::: "memory"); } while (0)
template <int CTRL> __device__ __forceinline__ float dpp_f(float v) { return __builtin_bit_cast(float, __builtin_amdgcn_update_dpp(0, __builtin_bit_cast(int, v), CTRL, 0xf, 0xf, true)); }
__device__ __forceinline__ float red16(float v) { v += dpp_f<0xB1>(v); v += dpp_f<0x4E>(v); v += dpp_f<0x141>(v); v += dpp_f<0x140>(v); return v; }
__device__ __forceinline__ float red8(float v) { v += dpp_f<0xB1>(v); v += dpp_f<0x4E>(v); v += dpp_f<0x141>(v); return v; }
__device__ __forceinline__ void unpack8(const v4u w, float (&f)[8]) { f[0] = bflo(w.x); f[1] = bfhi(w.x); f[2] = bflo(w.y); f[3] = bfhi(w.y); f[4] = bflo(w.z); f[5] = bfhi(w.z); f[6] = bflo(w.w); f[7] = bfhi(w.w); }
__device__ __forceinline__ void rwkv_scan_phase(Frame& F, const In& I, const bf16* R, const bf16* Kt, const bf16* V, const bf16* AA, const bf16* EW, bf16* Y) {
    LAS float* buf = (LAS float*)F.lds;
    LAS float* ybuf = (LAS float*)(F.lds + 2 * RTC * RTOK * 4) + 32;
    const int tid = TID_, lane = tid & 63;
    const int seg = lane & 15, rl = F.wave * 4 + (lane >> 4);
    const int stk = tid >> 4, ssg = tid & 15;
    for (int un = blockIdx.x; un < NB * 16 * 2; un += F.G) {
        const int half = un & 1, h = (un >> 1) & 15, b = un >> 5;
        const size_t rowb = (size_t)b * SEQ;
        const int col = h * 64 + ssg * 4;
        const f32x4 kkw = *(const f32x4*)(I.rwkv_kk + col), kaw = *(const f32x4*)(I.rwkv_ka + col);
        v2u rr, kr, vr, ar, er;
#define RAW_LOAD(cc) do { const size_t off = (rowb + (size_t)(cc) * RTC + stk) * 1024 + col; rr = *(const v2u*)(R + off); kr = *(const v2u*)(Kt + off); vr = *(const v2u*)(V + off); ar = *(const v2u*)(AA + off); er = *(const v2u*)(EW + off); } while (0)
#define RAW_CONVERT(cc) do { LAS float* tp = buf + ((cc) & 1) * (RTC * RTOK) + stk * RTOK + ssg * 4; \
            const float r0 = bflo(rr.x), r1 = bfhi(rr.x), r2 = bflo(rr.y), r3 = bfhi(rr.y), k0 = bflo(kr.x), k1 = bfhi(kr.x), k2 = bflo(kr.y), k3 = bfhi(kr.y); \
            const float a0 = bflo(ar.x), a1 = bfhi(ar.x), a2 = bflo(ar.y), a3 = bfhi(ar.y); \
            const float x0 = k0 * kkw.x, x1 = k1 * kkw.y, x2 = k2 * kkw.z, x3 = k3 * kkw.w; \
            const float ss = red16((x0 * x0 + x1 * x1) + (x2 * x2 + x3 * x3)); const float inv = __builtin_amdgcn_rsqf(fmaxf(ss, 1e-24f)); \
            *(LAS f32x4*)(tp) = (f32x4){__expf(-bflo(er.x)), __expf(-bfhi(er.x)), __expf(-bflo(er.y)), __expf(-bfhi(er.y))}; \
            const f32x4 kkv = (f32x4){x0 * inv, x1 * inv, x2 * inv, x3 * inv}; *(LAS f32x4*)(tp + 64) = kkv; \
            *(LAS f32x4*)(tp + 128) = (f32x4){kkv.x * a0, kkv.y * a1, kkv.z * a2, kkv.w * a3}; \
            *(LAS f32x4*)(tp + 192) = (f32x4){k0 * (1.0f + (a0 - 1.0f) * kaw.x), k1 * (1.0f + (a1 - 1.0f) * kaw.y), k2 * (1.0f + (a2 - 1.0f) * kaw.z), k3 * (1.0f + (a3 - 1.0f) * kaw.w)}; \
            *(LAS f32x4*)(tp + 256) = (f32x4){r0, r1, r2, r3}; \
            if ((ssg >> 3) == half) *(LAS f32x4*)(buf + ((cc) & 1) * (RTC * RTOK) + stk * RTOK + 320 + (ssg & 7) * 4) = (f32x4){bflo(vr.x), bfhi(vr.x), bflo(vr.y), bfhi(vr.y)}; } while (0)
#define Y_WRITE(cc) do { const LAS f32x2* yp = (const LAS f32x2*)(ybuf + ((cc) & 1) * (RTC * 32 + 32) + stk * 32 + ssg * 2); const f32x2 yv = *yp; \
            *(unsigned*)(Y + (rowb + (size_t)(cc) * RTC + stk) * 1024 + h * 64 + half * 32 + ssg * 2) = pk2(yv.x, yv.y); } while (0)
        RAW_LOAD(0); RAW_CONVERT(0); RAW_LOAD(1);
        f32x2 S0 = (f32x2){0.f, 0.f}, S1 = (f32x2){0.f, 0.f};
        LBAR();
        for (int c = 0; c < RNCH; ++c) {
            if (c + 1 < RNCH) { RAW_CONVERT(c + 1); }
            if (c + 2 < RNCH) { RAW_LOAD(c + 2); }
            if (c >= 1) { Y_WRITE(c - 1); }
            const LAS float* cb = buf + (c & 1) * (RTC * RTOK); LAS float* yb = ybuf + (c & 1) * (RTC * 32 + 32);
            const LAS float* tp0 = cb + seg * 4; const LAS float* vp0 = cb + 320 + rl;
#define SV_DECL(X) f32x4 X##w, X##q, X##b, X##k, X##r; float X##v
#define SV_LOAD(X, tk) do { const LAS float* tp = tp0 + (tk) * RTOK; \
                X##w = *(const LAS f32x4*)(tp); X##q = *(const LAS f32x4*)(tp + 64); X##b = *(const LAS f32x4*)(tp + 128); X##k = *(const LAS f32x4*)(tp + 192); X##r = *(const LAS f32x4*)(tp + 256); X##v = vp0[(tk) * RTOK]; } while (0)
#define SV_STEP(X, tk) do { \
                const f32x2 d = S0 * (f32x2){X##q.x, X##q.y} + S1 * (f32x2){X##q.z, X##q.w}; \
                const f32x2 t0 = S0 * (f32x2){X##w.x, X##w.y} + (f32x2){X##k.x, X##k.y} * X##v, t1 = S1 * (f32x2){X##w.z, X##w.w} + (f32x2){X##k.z, X##k.w} * X##v; \
                float ra = d.x + d.y, rb = epend;                   \
                ra += dpp_f<0xB1>(ra); rb += dpp_f<0xB1>(rb); ra += dpp_f<0x4E>(ra); rb += dpp_f<0x4E>(rb); ra += dpp_f<0x141>(ra); rb += dpp_f<0x141>(rb); ra += dpp_f<0x140>(ra); rb += dpp_f<0x140>(rb); \
                if (seg == 0) yb[((tk) - 1) * 32 + rl] = rb;        \
                const float sa = -ra; \
                S0 = t0 + (f32x2){X##b.x, X##b.y} * sa; S1 = t1 + (f32x2){X##b.z, X##b.w} * sa; \
                const f32x2 e = S0 * (f32x2){X##r.x, X##r.y} + S1 * (f32x2){X##r.z, X##r.w}; epend = e.x + e.y; } while (0)
            SV_DECL(A_); SV_DECL(B_); float epend = 0.f;
            SV_LOAD(A_, 0);
#pragma unroll 1
            for (int tk = 0; tk < RTC; tk += 2) {
                SV_LOAD(B_, tk + 1);
                SV_STEP(A_, tk);
                { const int t2 = (tk + 2 < RTC) ? tk + 2 : RTC - 1; SV_LOAD(A_, t2); }
                SV_STEP(B_, tk + 1);
            }
#undef SV_DECL
#undef SV_LOAD
#undef SV_STEP
            { const float rb = red16(epend); if (seg == 0) yb[(RTC - 1) * 32 + rl] = rb; }
            LBAR();
        }
        Y_WRITE(RNCH - 1);
        LBAR();
#undef RAW_LOAD
#undef RAW_CONVERT
#undef Y_WRITE
    }
}
constexpr int CS_SLOT = 13056, CS_TL = 12544, CS_QT = 0, CS_RT = 2048, CS_BHT = 4096, CS_KHT = 6144, CS_VT = 8192, CS_TM = 10240, CS_MK = 10752, CS_NK = 11264, CS_NB = 11776, CS_DD = 12288;
constexpr int CS_TMP0 = 8 * CS_SLOT, CS_TMP = 5120, CS_KT = 0, CS_BT = 2048, CS_MB = 4096;
template <int N> __device__ __forceinline__ float dpp_shr(float v) { return __builtin_bit_cast(float, __builtin_amdgcn_update_dpp(0, __builtin_bit_cast(int, v), 0x110 + N, 0xf, 0xf, true)); }
__device__ __forceinline__ bf16x8 mk8(v2u a, v2u b) { return __builtin_bit_cast(bf16x8, (v4u){a.x, a.y, b.x, b.y}); }
__device__ __forceinline__ bf16x8 mk8z(v2u a) { return __builtin_bit_cast(bf16x8, (v4u){a.x, a.y, 0u, 0u}); }
__device__ __forceinline__ bf16x8 cvt8z(f32x4 v) { return __builtin_bit_cast(bf16x8, (v4u){pk2(v.x, v.y), pk2(v.z, v.w), 0u, 0u}); }
__device__ __forceinline__ void rwkv_scan_chunked(Frame& F, const In& I, const bf16* R, const bf16* Kt, const bf16* V, const bf16* AA, const bf16* EW, bf16* Y) {
    const int lane = LANE_, fr = lane & 15, fq = lane >> 4;
    LAS unsigned char* L = F.lds;
    const f32x4 zero4 = (f32x4){0.f, 0.f, 0.f, 0.f};
    for (int un = blockIdx.x; un < NB * 16; un += F.G) {
        const int h = un & 15, b = un >> 4; const size_t rowb = (size_t)b * SEQ;
        if (F.wave >= 4) {
            const int p = F.wave - 4; const int colb = h * 64 + 16 * fq;
            LAS unsigned char* tmp = L + CS_TMP0 + p * CS_TMP;
            float kkw[16], kaw[16];
#pragma unroll
            for (int e = 0; e < 16; ++e) { kkw[e] = I.rwkv_kk[colb + e]; kaw[e] = I.rwkv_ka[colb + e]; }
            v4u raw[10];
#define CK_LOAD(cidx) do { const size_t off = (rowb + (size_t)(cidx) * 16 + fr) * 1024 + colb; \
                raw[0] = *(const v4u*)(R + off); raw[1] = *(const v4u*)(R + off + 8); raw[2] = *(const v4u*)(Kt + off); raw[3] = *(const v4u*)(Kt + off + 8); raw[4] = *(const v4u*)(V + off); raw[5] = *(const v4u*)(V + off + 8); \
                raw[6] = *(const v4u*)(AA + off); raw[7] = *(const v4u*)(AA + off + 8); raw[8] = *(const v4u*)(EW + off); raw[9] = *(const v4u*)(EW + off + 8); } while (0)
            CK_LOAD(p);
            for (int rd = -1; rd < 127; ++rd) {
                const int cidx = 4 * (rd + 1) + p; LAS unsigned char* S = L + (((rd + 1) & 1) * 4 + p) * CS_SLOT;
                float r[16], k[16], a[16], ew[16]; const v4u vraw0 = raw[4], vraw1 = raw[5];
                { float t8[8];
                  unpack8(raw[0], t8);
#pragma unroll
                  for (int e = 0; e < 8; ++e) r[e] = t8[e];
                  unpack8(raw[1], t8);
#pragma unroll
                  for (int e = 0; e < 8; ++e) r[8 + e] = t8[e];
                  unpack8(raw[2], t8);
#pragma unroll
                  for (int e = 0; e < 8; ++e) k[e] = t8[e];
                  unpack8(raw[3], t8);
#pragma unroll
                  for (int e = 0; e < 8; ++e) k[8 + e] = t8[e];
                  unpack8(raw[6], t8);
#pragma unroll
                  for (int e = 0; e < 8; ++e) a[e] = t8[e];
                  unpack8(raw[7], t8);
#pragma unroll
                  for (int e = 0; e < 8; ++e) a[8 + e] = t8[e];
                  unpack8(raw[8], t8);
#pragma unroll
                  for (int e = 0; e < 8; ++e) ew[e] = t8[e];
                  unpack8(raw[9], t8);
#pragma unroll
                  for (int e = 0; e < 8; ++e) ew[8 + e] = t8[e]; }
                if (cidx + 4 < 512) CK_LOAD(cidx + 4);
                float kx[16], ss = 0.f;
#pragma unroll
                for (int e = 0; e < 16; ++e) { kx[e] = k[e] * kkw[e]; ss += kx[e] * kx[e]; }
                ss += __shfl_xor(ss, 16); ss += __shfl_xor(ss, 32);
                const float inv = __builtin_amdgcn_rsqf(fmaxf(ss, 1e-24f));
                unsigned qtw[8], rtw[8], ktw[8], btw[8];
#pragma unroll
                for (int g = 0; g < 16; g += 8) {
                    float li[8], l15[8], Eex[8], E1[8], E15[8], Einv[8];
#pragma unroll
                    for (int j = 0; j < 8; ++j) li[j] = -ew[g + j];
#pragma unroll
                    for (int j = 0; j < 8; ++j) li[j] += dpp_shr<1>(li[j]);
#pragma unroll
                    for (int j = 0; j < 8; ++j) li[j] += dpp_shr<2>(li[j]);
#pragma unroll
                    for (int j = 0; j < 8; ++j) li[j] += dpp_shr<4>(li[j]);
#pragma unroll
                    for (int j = 0; j < 8; ++j) li[j] += dpp_shr<8>(li[j]);
#pragma unroll
                    for (int j = 0; j < 8; ++j) l15[j] = __shfl(li[j], (lane & 48) | 15);
#pragma unroll
                    for (int j = 0; j < 8; ++j) { Eex[j] = __builtin_amdgcn_exp2f(1.4426950408889634f * (li[j] + ew[g + j])); E1[j] = __builtin_amdgcn_exp2f(1.4426950408889634f * li[j]); E15[j] = __builtin_amdgcn_exp2f(1.4426950408889634f * l15[j]); }
#pragma unroll
                    for (int j = 0; j < 8; ++j) Einv[j] = __builtin_amdgcn_rcpf(E1[j]);
#pragma unroll
                    for (int j = 0; j < 8; j += 2) { const int e = g + j; float q2[2], r2[2], k2[2], b2[2], b2h[2], k2h[2];
#pragma unroll
                        for (int z = 0; z < 2; ++z) { const int ee = e + z;
                            const float kk = kx[ee] * inv, bb = a[ee] * kk, kp = k[ee] * (1.0f + (a[ee] - 1.0f) * kaw[ee]);
                            q2[z] = kk * Eex[j + z]; k2[z] = kp * Einv[j + z]; b2[z] = bb * Einv[j + z]; r2[z] = r[ee] * E1[j + z];
                            const float eh = E15[j + z] * Einv[j + z]; b2h[z] = bb * eh; k2h[z] = kp * eh;
                            if (fr == 15) ((LAS float*)(S + CS_DD))[16 * fq + ee] = E15[j + z]; }
                        qtw[e >> 1] = pk2(q2[0], q2[1]); rtw[e >> 1] = pk2(r2[0], r2[1]); ktw[e >> 1] = pk2(k2[0], k2[1]); btw[e >> 1] = pk2(b2[0], b2[1]);
                        { const unsigned bw = pk2(b2h[0], b2h[1]), kw = pk2(k2h[0], k2h[1]); const unsigned vw = (e < 8) ? vraw0[(e & 7) >> 1] : vraw1[(e & 7) >> 1]; const int key = 16 * fq + e;
                          LAS bf16* bp = (LAS bf16*)(S + CS_BHT) + key * 16 + fr; LAS bf16* kp_ = (LAS bf16*)(S + CS_KHT) + key * 16 + fr; LAS bf16* vp = (LAS bf16*)(S + CS_VT) + key * 16 + fr;
                          bp[0] = (bf16)(bw & 0xffffu); bp[16] = (bf16)(bw >> 16); kp_[0] = (bf16)(kw & 0xffffu); kp_[16] = (bf16)(kw >> 16); vp[0] = (bf16)(vw & 0xffffu); vp[16] = (bf16)(vw >> 16); } } }
                { const int o = (fr * 64 + 16 * fq) * 2;
                  *(LAS v4u*)(S + CS_QT + o) = (v4u){qtw[0], qtw[1], qtw[2], qtw[3]}; *(LAS v4u*)(S + CS_QT + o + 16) = (v4u){qtw[4], qtw[5], qtw[6], qtw[7]};
                  *(LAS v4u*)(S + CS_RT + o) = (v4u){rtw[0], rtw[1], rtw[2], rtw[3]}; *(LAS v4u*)(S + CS_RT + o + 16) = (v4u){rtw[4], rtw[5], rtw[6], rtw[7]};
                  *(LAS v4u*)(tmp + CS_KT + o) = (v4u){ktw[0], ktw[1], ktw[2], ktw[3]}; *(LAS v4u*)(tmp + CS_KT + o + 16) = (v4u){ktw[4], ktw[5], ktw[6], ktw[7]};
                  *(LAS v4u*)(tmp + CS_BT + o) = (v4u){btw[0], btw[1], btw[2], btw[3]}; *(LAS v4u*)(tmp + CS_BT + o + 16) = (v4u){btw[4], btw[5], btw[6], btw[7]}; }
                asm volatile("s_waitcnt lgkmcnt(0)" ::: "memory");
                f32x4 mb = zero4, mk = zero4, nb = zero4, nk = zero4;
#pragma unroll
                for (int kh = 0; kh < 2; ++kh) { const int o = (fr * 64 + 32 * kh + 8 * fq) * 2;
                    const bf16x8 Qf = *(const LAS bf16x8*)(S + CS_QT + o), Rf = *(const LAS bf16x8*)(S + CS_RT + o), Kf = *(const LAS bf16x8*)(tmp + CS_KT + o), Bf = *(const LAS bf16x8*)(tmp + CS_BT + o);
                    mb = __builtin_amdgcn_mfma_f32_16x16x32_bf16(Qf, Bf, mb, 0, 0, 0); mk = __builtin_amdgcn_mfma_f32_16x16x32_bf16(Qf, Kf, mk, 0, 0, 0);
                    nb = __builtin_amdgcn_mfma_f32_16x16x32_bf16(Rf, Bf, nb, 0, 0, 0); nk = __builtin_amdgcn_mfma_f32_16x16x32_bf16(Rf, Kf, nk, 0, 0, 0); }
#pragma unroll
                for (int e = 0; e < 4; e += 2) { const int tt = 4 * fq + e; const bool lo0 = fr < tt, le0 = fr <= tt, lo1 = fr < tt + 1, le1 = fr <= tt + 1;
                    ((LAS float*)(tmp + CS_MB))[tt * 16 + fr] = lo0 ? mb[e] : 0.f; ((LAS float*)(tmp + CS_MB))[(tt + 1) * 16 + fr] = lo1 ? mb[e + 1] : 0.f;
                    const unsigned wk = pk2(lo0 ? mk[e] : 0.f, lo1 ? mk[e + 1] : 0.f), wn = pk2(le0 ? nk[e] : 0.f, le1 ? nk[e + 1] : 0.f), wb = pk2(le0 ? nb[e] : 0.f, le1 ? nb[e + 1] : 0.f);
                    LAS bf16* pk_ = (LAS bf16*)(S + CS_MK) + tt * 16 + fr; LAS bf16* pn = (LAS bf16*)(S + CS_NK) + tt * 16 + fr; LAS bf16* pb = (LAS bf16*)(S + CS_NB) + tt * 16 + fr;
                    pk_[0] = (bf16)(wk & 0xffffu); pk_[16] = (bf16)(wk >> 16); pn[0] = (bf16)(wn & 0xffffu); pn[16] = (bf16)(wn >> 16); pb[0] = (bf16)(wb & 0xffffu); pb[16] = (bf16)(wb >> 16); }
                asm volatile("s_waitcnt lgkmcnt(0)" ::: "memory");
                { float Tc[16];
#pragma unroll
                  for (int t = 0; t < 16; ++t) { const LAS f32x4* mrow = (const LAS f32x4*)(tmp + CS_MB + t * 64); float acc = (t == fr) ? 1.0f : 0.0f;
#pragma unroll
                      for (int s4 = 0; s4 < 4; ++s4) { if (4 * s4 < t) { const f32x4 m4 = mrow[s4];
#pragma unroll
                              for (int z = 0; z < 4; ++z) if (4 * s4 + z < t) acc -= m4[z] * Tc[4 * s4 + z]; } }
                      Tc[t] = acc; }
                  if (fq == 0) {
#pragma unroll
                      for (int t = 0; t < 16; t += 2) { const unsigned hw = pk2(Tc[t], Tc[t + 1]); const unsigned lw = pk2(Tc[t] - bflo(hw), Tc[t + 1] - bfhi(hw));
                          LAS bf16* ph = (LAS bf16*)(S + CS_TM) + t * 16 + fr; LAS bf16* pl = (LAS bf16*)(S + CS_TL) + t * 16 + fr;
                          ph[0] = (bf16)(hw & 0xffffu); ph[16] = (bf16)(hw >> 16); pl[0] = (bf16)(lw & 0xffffu); pl[16] = (bf16)(lw >> 16); } } }
                LBAR();
            }
            LBAR();
#undef CK_LOAD
        } else {
            const int vt = F.wave;
            f32x4 Areg[4];
#pragma unroll
            for (int jt = 0; jt < 4; ++jt) Areg[jt] = zero4;
            LBAR();
            for (int rd = 0; rd < 128; ++rd) {
#pragma unroll 1
                for (int q = 0; q < 4; ++q) {
                    const LAS unsigned char* S = L + ((rd & 1) * 4 + q) * CS_SLOT; const size_t row0 = rowb + (size_t)(4 * rd + q) * 16;
                    bf16x8 Aq[2];
#pragma unroll
                    for (int kh = 0; kh < 2; ++kh) Aq[kh] = __builtin_bit_cast(bf16x8, (v4u){pk2(Areg[2 * kh].x, Areg[2 * kh].y), pk2(Areg[2 * kh].z, Areg[2 * kh].w), pk2(Areg[2 * kh + 1].x, Areg[2 * kh + 1].y), pk2(Areg[2 * kh + 1].z, Areg[2 * kh + 1].w)});
                    f32x4 X = zero4, YA = zero4;
#pragma unroll
                    for (int kh = 0; kh < 2; ++kh) { const int o = (fr * 64 + 32 * kh + 4 * fq) * 2;
                        const bf16x8 Pq = mk8(*(const LAS v2u*)(S + CS_QT + o), *(const LAS v2u*)(S + CS_QT + o + 32)), Pr = mk8(*(const LAS v2u*)(S + CS_RT + o), *(const LAS v2u*)(S + CS_RT + o + 32));
                        X = __builtin_amdgcn_mfma_f32_16x16x32_bf16(Pq, Aq[kh], X, 0, 0, 0); YA = __builtin_amdgcn_mfma_f32_16x16x32_bf16(Pr, Aq[kh], YA, 0, 0, 0); }
                    const bf16x8 Vq = mk8z(*(const LAS v2u*)(S + CS_VT + ((16 * vt + fr) * 16 + 4 * fq) * 2));
                    const int om = (fr * 16 + 4 * fq) * 2;
                    const bf16x8 Mkp = mk8z(*(const LAS v2u*)(S + CS_MK + om)), Nkp = mk8z(*(const LAS v2u*)(S + CS_NK + om)), Nbp = mk8z(*(const LAS v2u*)(S + CS_NB + om)), Tp = mk8z(*(const LAS v2u*)(S + CS_TM + om));
                    const f32x4 Z = __builtin_amdgcn_mfma_f32_16x16x32_bf16(Mkp, Vq, X, 0, 0, 0);
                    const bf16x8 Tl = mk8z(*(const LAS v2u*)(S + CS_TL + om));
                    const unsigned zw0 = pk2(Z[0], Z[1]), zw1 = pk2(Z[2], Z[3]);
                    const bf16x8 Zhq = __builtin_bit_cast(bf16x8, (v4u){zw0, zw1, 0u, 0u});
                    const f32x4 Zl = (f32x4){Z[0] - bflo(zw0), Z[1] - bfhi(zw0), Z[2] - bflo(zw1), Z[3] - bfhi(zw1)};
                    f32x4 U = __builtin_amdgcn_mfma_f32_16x16x32_bf16(Tp, cvt8z(Zl), zero4, 0, 0, 0);
                    U = __builtin_amdgcn_mfma_f32_16x16x32_bf16(Tl, Zhq, U, 0, 0, 0);
                    U = __builtin_amdgcn_mfma_f32_16x16x32_bf16(Tp, Zhq, U, 0, 0, 0);
                    const bf16x8 Uq = cvt8z(U);
                    f32x4 Yv = __builtin_amdgcn_mfma_f32_16x16x32_bf16(Nkp, Vq, YA, 0, 0, 0);
                    const f32x4 Yn = __builtin_amdgcn_mfma_f32_16x16x32_bf16(Nbp, Uq, zero4, 0, 0, 0);
                    Yv = Yv - Yn;
#pragma unroll
                    for (int e = 0; e < 4; e += 2) { const unsigned yw = pk2(Yv[e], Yv[e + 1]); bf16* yp = Y + (row0 + 4 * fq + e) * 1024 + h * 64 + 16 * vt + fr; yp[0] = (bf16)(yw & 0xffffu); yp[1024] = (bf16)(yw >> 16); }
#pragma unroll
                    for (int jt = 0; jt < 4; ++jt) { const int ok = ((16 * jt + fr) * 16 + 4 * fq) * 2;
                        const bf16x8 Khp = mk8z(*(const LAS v2u*)(S + CS_KHT + ok)), Bhp = mk8z(*(const LAS v2u*)(S + CS_BHT + ok));
                        const f32x4 Dv = *(const LAS f32x4*)(S + CS_DD + (16 * jt + 4 * fq) * 4);
                        f32x4 acc = Dv * Areg[jt];
                        acc = __builtin_amdgcn_mfma_f32_16x16x32_bf16(Khp, Vq, acc, 0, 0, 0);
                        const f32x4 nbu = __builtin_amdgcn_mfma_f32_16x16x32_bf16(Bhp, Uq, zero4, 0, 0, 0);
                        Areg[jt] = acc - nbu; }
                }
                LBAR();
            }
        }
    }
}
__device__ __forceinline__ void rwkv_post_pass(Frame& F, const In& I, const bf16* R, const bf16* Kt, const bf16* V, const bf16* AA, const bf16* G, bf16* Y) {
    const int gw = F.vcu * NWAVES + F.wave, NGW = F.G * NWAVES; const int col = LANE_ * 16;
    for (int t0 = 2 * gw; t0 < T; t0 += 2 * NGW) {
        v4u py[2][2], pr[2][2], pk[2][2], pv[2][2], pa[2][2], pg[2][2];
#pragma unroll
        for (int rw = 0; rw < 2; ++rw) { const size_t off = (size_t)(t0 + rw) * 1024 + col;
#pragma unroll
            for (int hf = 0; hf < 2; ++hf) { py[rw][hf] = *(const v4u*)(Y + off + hf * 8); pr[rw][hf] = *(const v4u*)(R + off + hf * 8); pk[rw][hf] = *(const v4u*)(Kt + off + hf * 8);
                pv[rw][hf] = *(const v4u*)(V + off + hf * 8); pa[rw][hf] = *(const v4u*)(AA + off + hf * 8); pg[rw][hf] = *(const v4u*)(G + off + hf * 8); } }
#pragma unroll
        for (int rw = 0; rw < 2; ++rw) { const size_t off = (size_t)(t0 + rw) * 1024 + col;
            float kaw[16], rkw[16], lng[16], lnb[16];
#pragma unroll
            for (int e4 = 0; e4 < 4; ++e4) { const f32x4 c0 = *(const GAS f32x4*)(I.rwkv_ka + col + 4 * e4), c1 = *(const GAS f32x4*)(I.rwkv_rk + col + 4 * e4), c2 = *(const GAS f32x4*)(I.rwkv_ln_g + col + 4 * e4), c3 = *(const GAS f32x4*)(I.rwkv_ln_b + col + 4 * e4);
#pragma unroll
                for (int e = 0; e < 4; ++e) { kaw[4 * e4 + e] = c0[e]; rkw[4 * e4 + e] = c1[e]; lng[4 * e4 + e] = c2[e]; lnb[4 * e4 + e] = c3[e]; } }
            float y[16], r[16], k[16], v[16], a[16], g[16];
#pragma unroll
            for (int hf = 0; hf < 2; ++hf) { float t8[8];
                unpack8(py[rw][hf], t8);
#pragma unroll
                for (int e = 0; e < 8; ++e) y[hf * 8 + e] = t8[e];
                unpack8(pr[rw][hf], t8);
#pragma unroll
                for (int e = 0; e < 8; ++e) r[hf * 8 + e] = t8[e];
                unpack8(pk[rw][hf], t8);
#pragma unroll
                for (int e = 0; e < 8; ++e) k[hf * 8 + e] = t8[e];
                unpack8(pv[rw][hf], t8);
#pragma unroll
                for (int e = 0; e < 8; ++e) v[hf * 8 + e] = t8[e];
                unpack8(pa[rw][hf], t8);
#pragma unroll
                for (int e = 0; e < 8; ++e) a[hf * 8 + e] = t8[e];
                unpack8(pg[rw][hf], t8);
#pragma unroll
                for (int e = 0; e < 8; ++e) g[hf * 8 + e] = t8[e]; }
            float s = 0.f, bs = 0.f;
#pragma unroll
            for (int e = 0; e < 16; ++e) { s += y[e]; const float kp = k[e] * (1.0f + (a[e] - 1.0f) * kaw[e]); bs += r[e] * kp * rkw[e]; }
            s += __shfl_xor(s, 1); s += __shfl_xor(s, 2); bs += __shfl_xor(bs, 1); bs += __shfl_xor(bs, 2);
            const float mean = s * (1.0f / 64.0f); float q = 0.f;
#pragma unroll
            for (int e = 0; e < 16; ++e) { const float dd = y[e] - mean; q += dd * dd; }
            q += __shfl_xor(q, 1); q += __shfl_xor(q, 2);
            const float rstd = 1.0f / sqrtf(q * (1.0f / 64.0f) + 64e-5f);
            float o[16];
#pragma unroll
            for (int e = 0; e < 16; ++e) o[e] = ((y[e] - mean) * rstd * lng[e] + lnb[e] + bs * v[e]) * g[e];
            v4u w0, w1; w0.x = pk2(o[0], o[1]); w0.y = pk2(o[2], o[3]); w0.z = pk2(o[4], o[5]); w0.w = pk2(o[6], o[7]); w1.x = pk2(o[8], o[9]); w1.y = pk2(o[10], o[11]); w1.z = pk2(o[12], o[13]); w1.w = pk2(o[14], o[15]);
            *(v4u*)(Y + off) = w0; *(v4u*)(Y + off + 8) = w1; }
    }
}

#ifndef DUP_K
#define DUP_K (-1)
#endif
#ifndef DUP_K2
#define DUP_K2 (-1)
#endif
#define KARGS ((const __attribute__((address_space(4))) Args*)__builtin_amdgcn_kernarg_segment_ptr())
#define WSPTRS \
    bf16* H0 = (bf16*)(ws + WS_H0); bf16* QKV = (bf16*)(ws + WS_QKV); bf16* OB = (bf16*)(ws + WS_O); f32x2* AGG = (f32x2*)(ws + WS_LRUAGG); \
    bf16* H2 = (bf16*)(ws + WS_H2); float* LOG = (float*)(ws + WS_LOG); unsigned char* RTE = ws + WS_ROUTE; bf16* HID = (bf16*)(ws + WS_HID); bf16* YS = (bf16*)(ws + WS_YS); bf16* PP = (bf16*)(ws + WS_PP); \
    bf16* HCAT = (bf16*)(ws + WS_HCAT); bf16* RB = (bf16*)(ws + WS_R); bf16* KB = (bf16*)(ws + WS_K); bf16* VB = (bf16*)(ws + WS_V); bf16* XRB = (bf16*)(ws + WS_XR); bf16* XKB = (bf16*)(ws + WS_XK); bf16* XVB = (bf16*)(ws + WS_XV); bf16* MID = (bf16*)(ws + WS_MID); bf16* EWB = (bf16*)(ws + WS_EW); bf16* AAB = (bf16*)(ws + WS_AA); bf16* YB = (bf16*)(ws + WS_Y); \
    const size_t TD = (size_t)T * 1024; (void)H0; (void)QKV; (void)OB; (void)AGG; (void)H2; (void)LOG; (void)RTE; (void)HID; (void)YS; (void)PP; (void)HCAT; (void)RB; (void)KB; (void)VB; (void)XRB; (void)XKB; (void)XVB; (void)MID; (void)EWB; (void)AAB; (void)YB; (void)TD;

struct Args { In in; float* out; unsigned char* ws; int ph_lo, ph_hi; };
constexpr int N_PHASES = 34;
__device__ __forceinline__ int nrep(int k) { int n = (k == DUP_K) ? 2 : 1; if (DUP_K >= 0) asm volatile("" : "+s"(n)); return n; }
#define REP_SYNC if (rep_) __syncthreads();
typedef const __attribute__((address_space(4))) unsigned long long* kp64;
__device__ __forceinline__ void load_in(In& I) { kp64 s = (kp64)__builtin_amdgcn_kernarg_segment_ptr(); unsigned long long* d = (unsigned long long*)&I;
#pragma unroll
    for (int i = 0; i < 47; ++i) d[i] = s[i]; }

__device__ __forceinline__ int t5_bucket(int n) { if (n < 16) return n; const float v = logf((float)n / 16.0f) / 2.0794415416798357f * 16.0f; const int l = 16 + (int)v; return l < 31 ? l : 31; }

template <class Epi>
__device__ __forceinline__ void dense_gemm(Frame& F, const void* A, int lda, const void* B, int K, int M, int N, const Epi& E) {
    pg8::DenseOrder S; S.init(A, lda, B, K, M, N, F.G, (int)blockIdx.x);
    pg8::gemm_phase<Epi, pg8::DenseOrder, true, false>(F.lds, K, lda, S, E, nullptr, TID_);
}

__global__ void __launch_bounds__(NWAVES * 64, 2) mk_fwd(Args args) {
    extern __shared__ __attribute__((aligned(16))) unsigned char lds[];
    Frame F;
    F.lds = (LAS unsigned char*)lds;
    F.MISC = (volatile LAS unsigned*)(F.lds + MISC_OFF);
    { int w_ = __builtin_amdgcn_readfirstlane((int)threadIdx.x >> 6); asm volatile("" : "+s"(w_)); F.wave = w_; }
    F.G = gridDim.x; { const int bx = blockIdx.x; F.vcu = (F.G % 8 == 0) ? (bx % 8) * (F.G / 8) + bx / 8 : bx; }
    F.ctl = (gu32*)(KARGS->ws + WS_CTL);
    for (int u = TID_; u < (LDS_BYTES - LDSCTL_OFF) / 4; u += NWAVES * 64) ((LAS unsigned*)(F.lds + LDSCTL_OFF))[u] = 0u;
    __syncthreads();
    {
        LAS float* tb = (LAS float*)(F.lds + TB_OFF); const int h = TID_ >> 7, i = TID_ & 127;
        const float* rb = KARGS->in.rel_bias;
        tb[h * 128 + i] = (rb[t5_bucket(i) * 4 + h] - rb[31 * 4 + h]) * 1.4426950408889634f;
    }
    __syncthreads();
    const int lo = KARGS->ph_lo, hi = KARGS->ph_hi;
    const bool multi = (hi - lo) > 1;
    XcdBarrier bar; bar.bar = (unsigned*)(F.ctl + CW_BAR); bar.x = 0; bar.st = nullptr;
    if (multi) bar = xcd_barrier_post((unsigned*)(F.ctl + CW_BAR), F.MISC + 8, TID_ == 0);
#define IN(k) (lo <= (k) && (k) < hi)
#define PH_BEGIN_ unsigned char* ws = KARGS->ws; bf16* X = (bf16*)KARGS->out; float* OUT = KARGS->out; (void)OUT; bf16* GB2 = (bf16*)KARGS->out + (size_t)T * 1024; (void)GB2; In I; load_in(I); (void)X; WSPTRS
#define SEAM(k) do { if (IN(k) && IN((k) + 1)) xcd_barrier(bar, TID_ == 0); } while (0)

    if (IN(0)) { PH_BEGIN_ prep_dense_weights(F, I, ws); prep_layer_weights(F, I, ws, 0); norm_pass<false>(F, I.x, I.norm_mix, H0);
#ifdef DUP_PREP
        __syncthreads(); prep_dense_weights(F, I, ws); prep_layer_weights(F, I, ws, 0);
#endif
    } SEAM(0);
    if (IN(1)) { PH_BEGIN_ pg8::EpiBf16 E{QKV, 512, 512, (size_t)T * 512, attn_body::C2}; dense_gemm(F, H0, 1024, ws + WS_WIN, 1024, T, AB_IN, E); } SEAM(1);
    if (IN(2)) { PH_BEGIN_ lru_agg_mfma(F, I, QKV + 3 * (size_t)T * 512, AGG, (bf16*)(ws + WS_HL), (bf16*)(ws + WS_CA)); } SEAM(2);
    if (IN(3)) { PH_BEGIN_
        const attn_body::AttnTensors AT{(const attn_body::bf16*)QKV, (const attn_body::bf16*)(QKV + (size_t)T * 512), (const attn_body::bf16*)(QKV + 2 * (size_t)T * 512), (attn_body::bf16*)OB};
        if (F.G == 256) attn_body::attn_phase<8>((char*)lds, AT, F.vcu, (const LAS float*)(F.lds + TB_OFF), (int)threadIdx.x);
#ifdef DUP_ATTN
        __syncthreads(); if (F.G == 256) attn_body::attn_phase<8>((char*)lds, AT, F.vcu, (const LAS float*)(F.lds + TB_OFF), (int)threadIdx.x);
#endif
        __syncthreads();
        lru_final_pass(F, (const bf16*)(ws + WS_HL), (const bf16*)(ws + WS_CA), QKV + 4 * (size_t)T * 512, AGG, H0);
    } SEAM(3);
    if (IN(4)) { PH_BEGIN_ diff_combine_pass(F, I, OB, H0); } SEAM(4);
    if (IN(5)) { PH_BEGIN_ pg8::EpiResX<false> E{I.x, X}; dense_gemm(F, H0, 1024, ws + WS_WOUT, 1024, T, 1024, E); } SEAM(5);

#define MOE_PLE_PHASES(P, L) \
    if (IN(P + 0)) { PH_BEGIN_ norm_pass<true>(F, X, I.norm_ffn + (L) * 1024, H2); } SEAM(P + 0); \
    if (IN(P + 1)) { PH_BEGIN_ pg8::EpiRouter E{LOG}; dense_gemm(F, H2, 1024, ws + WS_ROUT + (size_t)(L) * 256 * 1024 * 2, 1024, T, 256, E); } SEAM(P + 1); \
    if (IN(P + 2)) { PH_BEGIN_ route_pass_a(F, I, (L), LOG, RTE, F.ctl + ((L) ? CW_CNT1 : CW_CNT0)); } SEAM(P + 2); \
    if (IN(P + 3)) { PH_BEGIN_ route_pass_b(F, RTE, F.ctl + ((L) ? CW_CNT1 : CW_CNT0)); } SEAM(P + 3); \
    if (IN(P + 4)) { PH_BEGIN_ route_bases(F, F.ctl + ((L) ? CW_CNT1 : CW_CNT0)); const LAS int* eb = (const LAS int*)(F.lds + RTE_OFF + 512); \
        MoeOrder S{F.G, (int)blockIdx.x, __builtin_amdgcn_readfirstlane(eb[32] >> 8), eb, (const char*)H2, (const char*)(ws + WS_MGU), 0, (size_t)1024 * 1024 * 2, (size_t)256 * 1024 * 2, true}; pg8::EpiGU E{HID}; \
        pg8::gemm_phase<pg8::EpiGU, MoeOrder, true, true>(F.lds, 1024, 1024, S, E, (const int*)(RTE + RT_ROWTOK), TID_); } SEAM(P + 4); \
    if (IN(P + 5)) { PH_BEGIN_ route_bases(F, F.ctl + ((L) ? CW_CNT1 : CW_CNT0)); const LAS int* eb = (const LAS int*)(F.lds + RTE_OFF + 512); \
        MoeOrder S{F.G, (int)blockIdx.x, __builtin_amdgcn_readfirstlane(eb[32] >> 8), eb, (const char*)HID, (const char*)(ws + WS_MDN), (size_t)256 * 512 * 2, (size_t)1024 * 512 * 2, (size_t)256 * 512 * 2, false}; pg8::EpiDown E{YS, (const float*)(RTE + RT_ROWGATE)}; \
        pg8::gemm_phase<pg8::EpiDown, MoeOrder, true, false>(F.lds, 512, 512, S, E, nullptr, TID_); } SEAM(P + 5); \
    if (IN(P + 6)) { PH_BEGIN_ combine_norm_pass(F, X, X, YS, (const int*)(RTE + RT_SLOT), I.ple_norm + (L) * 1024, H2); } SEAM(P + 6); \
    if (IN(P + 7)) { PH_BEGIN_ pg8::EpiBf16 E{PP, 1024, 0, 0, 1.f}; dense_gemm(F, ws + WS_PB, 256, ws + WS_PPROJ + (size_t)(L) * 1024 * 256 * 2, 256, T, 1024, E); } SEAM(P + 7); \
    if (IN(P + 8)) { PH_BEGIN_ pg8::EpiPle E{X, (L) ? (bf16*)(ws + WS_YS) : X, PP}; dense_gemm(F, H2, 1024, ws + WS_PGATE + (size_t)(L) * 1024 * 1024 * 2, 1024, T, 1024, E); } SEAM(P + 8);

    MOE_PLE_PHASES(6, 0)
    if (IN(15)) { PH_BEGIN_ rwkv_input_pass(F, X, I.norm_mix + 1024, I.rwkv_mu, HCAT, XRB, XKB, XVB); } SEAM(15);
    if (IN(16)) { PH_BEGIN_ { pg8::EpiBf16 E{RB, 1024, 0, 0, 1.f}; dense_gemm(F, XRB, 1024, ws + WS_RCAT, 1024, T, 1024, E); }
        { pg8::EpiMid E{MID}; dense_gemm(F, HCAT, 2048, ws + WS_RL1, 2048, T, 512, E); } } SEAM(16);
    if (IN(17)) { PH_BEGIN_ pg8::EpiBf16 E{KB, 1024, 0, 0, 1.f}; dense_gemm(F, XKB, 1024, ws + WS_RCAT + (size_t)1024 * 1024 * 2, 1024, T, 1024, E); } SEAM(17);
    if (IN(18)) { PH_BEGIN_ pg8::EpiBf16 E{VB, 1024, 0, 0, 1.f}; dense_gemm(F, XVB, 1024, ws + WS_RCAT + (size_t)2 * 1024 * 1024 * 2, 1024, T, 1024, E); } SEAM(18);
    if (IN(19)) { PH_BEGIN_ pg8::EpiRwkv2 E{EWB, AAB, I.rwkv_w0, I.rwkv_a0, 0}; dense_gemm(F, MID, 512, ws + WS_RS2, 256, T, 2048, E); } SEAM(19);
    if (IN(20)) { PH_BEGIN_
        if (F.G == 256 && blockIdx.x >= 128) {
            Frame F2 = F; F2.G = 128; F2.vcu = (int)blockIdx.x - 128;
            prep_layer_weights(F2, I, ws, 1);
            __syncthreads();
            pg8::EpiRwkv2 E{GB2, GB2, nullptr, nullptr, 2}; pg8::DenseOrder S; S.init(MID + 256, 512, ws + WS_RS2 + (size_t)2 * 1024 * 256 * 2, 256, T, 1024, 128, (int)blockIdx.x - 128);
            pg8::gemm_phase<pg8::EpiRwkv2, pg8::DenseOrder, true, false>(F.lds, 256, 512, S, E, nullptr, TID_);
        } else rwkv_scan_chunked(F, I, RB, KB, VB, AAB, EWB, YB);
    } SEAM(20);
    if (IN(21)) { } SEAM(21);
    if (IN(22)) { PH_BEGIN_ rwkv_post_pass(F, I, RB, KB, VB, AAB, GB2, YB); } SEAM(22);
    if (IN(23)) { PH_BEGIN_ pg8::EpiResX<true> E{X, X}; dense_gemm(F, YB, 1024, ws + WS_RWO, 1024, T, 1024, E); } SEAM(23);
    MOE_PLE_PHASES(24, 1)
    if (IN(33)) { PH_BEGIN_ final_norm_pass(F, (const bf16*)(ws + WS_YS), OUT, I.final_norm); }
#undef IN
#undef SEAM
}

extern "C" void kernel_launch(void* const* d_in, const int* in_sizes, int n_in, void* d_out, int out_size, void* d_ws, size_t ws_size, hipStream_t stream) {
    static int ok = 0;
    if (ok == 0) {
        if (n_in != 47 || out_size != T * D || ws_size < WS_END) { fprintf(stderr, "kernel_launch: unexpected problem shape (n_in %d out %d ws %zu)\n", n_in, out_size, ws_size); ok = -1; return; }
        if (hipFuncSetAttribute((const void*)mk_fwd, hipFuncAttributeMaxDynamicSharedMemorySize, LDS_BYTES) != hipSuccess) { fprintf(stderr, "kernel_launch: hipFuncSetAttribute failed\n"); ok = -1; return; }
        int per_cu = 0;
        if (hipOccupancyMaxActiveBlocksPerMultiprocessor(&per_cu, (const void*)mk_fwd, NWAVES * 64, LDS_BYTES) != hipSuccess || per_cu < 1) fprintf(stderr, "kernel_launch: occupancy query reports %d\n", per_cu);
        (void)hipGetLastError();
        ok = 1;
    }
    if (ok < 0) return;
    (void)hipMemsetAsync((char*)d_ws + WS_CTL, 0, CTL_ZERO_BYTES, stream);
    Args a{};
    const float** ip = (const float**)&a.in;
    for (int i = 0; i < 47; ++i) ip[i] = (const float*)d_in[i];
    a.out = (float*)d_out; a.ws = (unsigned char*)d_ws;
    const int grid = 256;
#if MK_ONE_LAUNCH
    a.ph_lo = 0; a.ph_hi = N_PHASES;
    hipLaunchKernelGGL(mk_fwd, dim3(grid), dim3(NWAVES * 64), LDS_BYTES, stream, a);
#else
    for (int k = 0; k < N_PHASES; ++k) { a.ph_lo = k; a.ph_hi = k + 1; hipLaunchKernelGGL(mk_fwd, dim3(grid), dim3(NWAVES * 64), LDS_BYTES, stream, a);
        if (k == DUP_K || k == DUP_K2) hipLaunchKernelGGL(mk_fwd, dim3(grid), dim3(NWAVES * 64), LDS_BYTES, stream, a); }
#endif
}
```

```cpp
#include <hip/hip_runtime.h>
#include <hip/hip_bf16.h>
#include <cstdio>
#include <cstdint>
#include <cmath>

#ifndef MK_ONE_LAUNCH
#define MK_ONE_LAUNCH 1
#endif

#define GAS __attribute__((address_space(1)))
#define LAS __attribute__((address_space(3)))
typedef unsigned short bf16;
typedef unsigned v4u __attribute__((ext_vector_type(4)));
typedef unsigned v2u __attribute__((ext_vector_type(2)));
typedef float f32x4 __attribute__((ext_vector_type(4)));
typedef float f32x2 __attribute__((ext_vector_type(2)));
typedef short bf16x8 __attribute__((ext_vector_type(8)));
typedef GAS unsigned gu32;
#define RLX_AGENT __ATOMIC_RELAXED, __HIP_MEMORY_SCOPE_AGENT
#define LDS_WAIT() asm volatile("s_waitcnt lgkmcnt(0)" ::: "memory")
#define VM_WAIT() asm volatile("s_waitcnt vmcnt(0)" ::: "memory")
__device__ __forceinline__ unsigned f2bf(float f) { unsigned u = __builtin_bit_cast(unsigned, f); return (u + 0x7fffu + ((u >> 16) & 1u)) >> 16; }
typedef float f32x2_cv __attribute__((ext_vector_type(2))); typedef __bf16 bf16x2_cv __attribute__((ext_vector_type(2)));
__device__ __forceinline__ unsigned pk2(float lo, float hi) { const f32x2_cv v = {lo, hi}; const bf16x2_cv b = __builtin_convertvector(v, bf16x2_cv); return __builtin_bit_cast(unsigned, b); }
__device__ __forceinline__ float bflo(unsigned w) { return __uint_as_float(w << 16); }
__device__ __forceinline__ float bfhi(unsigned w) { return __uint_as_float(w & 0xffff0000u); }
__device__ __forceinline__ float bf1(bf16 h) { return __uint_as_float((unsigned)h << 16); }
__device__ __forceinline__ float sigmoidf_(float x) { return __builtin_amdgcn_rcpf(1.0f + __builtin_amdgcn_exp2f(-1.4426950408889634f * x)); }
__device__ __forceinline__ float tanhf_(float x) { return 1.0f - 2.0f * __builtin_amdgcn_rcpf(1.0f + __builtin_amdgcn_exp2f(2.885390081777927f * x)); }
__device__ __forceinline__ void fmac_(float& acc, float a, float b) { asm("v_fmac_f32 %0, %1, %2" : "+v"(acc) : "v"(a), "v"(b)); }
__device__ __forceinline__ float fma_(float a, float b, float c) { float r; asm("v_fma_f32 %0, %1, %2, %3" : "=v"(r) : "v"(a), "v"(b), "v"(c)); return r; }
__device__ __forceinline__ float mul_(float a, float b) { float r; asm("v_mul_f32 %0, %1, %2" : "=v"(r) : "v"(a), "v"(b)); return r; }
__device__ __forceinline__ float wave_sum(float v) {
#pragma unroll
    for (int o = 1; o < 64; o <<= 1) v += __shfl_xor(v, o);
    return v;
}

constexpr int NB = 8, SEQ = 8192, D = 1024, T = NB * SEQ;
constexpr int AB_IN = 2560, PLE = 256;
constexpr int NEXP = 32, EH = 512;
constexpr int MAXSLOT = 2 * T + NEXP * 256;
constexpr int MAXTILES = MAXSLOT / 256;

namespace pg8 {
#define PG8_LAS __attribute__((address_space(3)))
typedef unsigned short bf16_t;
typedef unsigned u32x4 __attribute__((ext_vector_type(4)));
typedef unsigned u32x2 __attribute__((ext_vector_type(2)));
constexpr int BM = 256, BK = 64, HALF = 128, HTB = HALF * BK * 2, STAGE_BYTES = 8 * HTB, NXCD = 8, WGM = 8;
__host__ __device__ __forceinline__ int lds_byte(int r, int c) { const int st = (r >> 4) * 2 + (c >> 5), rr = r & 15, cc = c & 31, ob = rr * 64 + cc * 2; return st * 1024 + (ob ^ (((ob >> 9) & 1) << 5)); }
__host__ __device__ __forceinline__ void stage_rc(int b, int& R, int& C) { const int st = b / 1024, sb = b % 1024, swz = sb ^ (((sb >> 9) & 1) << 5); R = (st >> 1) * 16 + swz / 64; C = (st & 1) * 32 + (swz % 64) / 2; }
__host__ __device__ __forceinline__ int perm32(int rho) { const int n = rho >> 4, i = rho & 15; return 8 * (i >> 2) + 4 * n + (i & 3); }

struct Unit { int pm, pn, aux; const char* A; const char* B; };

struct DenseOrder {
    int nM, nN, nwg, G, c; const char* A; const char* B; size_t astep, bstep;
    __device__ void init(const void* A_, int lda, const void* B_, int K, int M, int N, int G_, int c_) { nM = M / BM; nN = N / BM; nwg = nM * nN; G = G_; c = c_; A = (const char*)A_; B = (const char*)B_; astep = (size_t)BM * lda * 2; bstep = (size_t)BM * K * 2; }
    __device__ bool next(int i, Unit& u) const {
        const long L = (long)i * G + c; if (L >= nwg) return false;
        int wgid = (int)L; { const int q = nwg / NXCD, r = nwg % NXCD, xcd = wgid % NXCD, off = wgid / NXCD; wgid = (xcd < r ? xcd * (q + 1) : r * (q + 1) + (xcd - r) * q) + off; }
        const int nig = WGM * nN, gid = wgid / nig, fm = gid * WGM, gsz = (nM - fm) < WGM ? (nM - fm) : WGM;
        u.pm = fm + ((wgid % nig) % gsz); u.pn = (wgid % nig) / gsz; u.aux = 0; u.A = A + (size_t)u.pm * astep; u.B = B + (size_t)u.pn * bstep; return true;
    }
};

__device__ __forceinline__ unsigned cvt_pk_bf16(float lo, float hi) { unsigned r; asm volatile("v_cvt_pk_bf16_f32 %0, %1, %2" : "=v"(r) : "v"(lo), "v"(hi)); return r; }

typedef f32x4 Acc[2][2][4][2];

struct EpiBf16 {
    static constexpr bool PERM = true;
    bf16_t* O; int ldc; int split_cols; size_t split_stride; float scale0;
    __device__ __forceinline__ void operator()(const Acc& acc, const Unit& u, int wr, int wc, int fr, int fq) const {
        const int row0 = u.pm * BM + wr * 64 + fr; int colt = u.pn * BM; bf16_t* base = O;
        float sc = 1.f; if (split_cols) { const int t = colt / split_cols; base += (size_t)t * split_stride; colt -= t * split_cols; if (t == 0) sc = scale0; }
        const int col0 = colt + wc * 32 + 8 * fq;
#pragma unroll
        for (int ai = 0; ai < 2; ++ai)
#pragma unroll
            for (int m = 0; m < 4; ++m) { bf16_t* rowp = base + (size_t)(row0 + ai * HALF + m * 16) * ldc + col0;
#pragma unroll
                for (int bj = 0; bj < 2; ++bj) { f32x4 v0 = acc[ai][bj][m][0] * sc, v1 = acc[ai][bj][m][1] * sc;
                    u32x4 w; w.x = cvt_pk_bf16(v0[0], v0[1]); w.y = cvt_pk_bf16(v0[2], v0[3]); w.z = cvt_pk_bf16(v1[0], v1[1]); w.w = cvt_pk_bf16(v1[2], v1[3]);
                    *(u32x4*)(rowp + bj * HALF) = w; } }
    }
};
__device__ __forceinline__ void unpack8f(const u32x4 w, f32x4& lo, f32x4& hi) { lo = (f32x4){bflo(w.x), bfhi(w.x), bflo(w.y), bfhi(w.y)}; hi = (f32x4){bflo(w.z), bfhi(w.z), bflo(w.w), bfhi(w.w)}; }
template <bool BASE_BF16>
struct EpiResX {
    static constexpr bool PERM = true;
    const void* base; bf16_t* out;
    __device__ __forceinline__ void operator()(const Acc& acc, const Unit& u, int wr, int wc, int fr, int fq) const {
        const int col0 = u.pn * BM + wc * 32 + 8 * fq; GAS bf16_t* op = (GAS bf16_t*)out;
#pragma unroll
        for (int ai = 0; ai < 2; ++ai) {
            f32x4 b0[4][2], b1[4][2];
#pragma unroll
            for (int m = 0; m < 4; ++m) { const size_t off = (size_t)(u.pm * BM + ai * HALF + wr * 64 + m * 16 + fr) * 1024 + col0;
#pragma unroll
                for (int bj = 0; bj < 2; ++bj) {
                    if (BASE_BF16) { const u32x4 w = *(const GAS u32x4*)((const GAS bf16_t*)base + off + bj * HALF); unpack8f(w, b0[m][bj], b1[m][bj]); }
                    else { b0[m][bj] = *(const GAS f32x4*)((const GAS float*)base + off + bj * HALF); b1[m][bj] = *(const GAS f32x4*)((const GAS float*)base + off + bj * HALF + 4); } } }
            asm volatile("" ::: "memory");
#pragma unroll
            for (int m = 0; m < 4; ++m) { const size_t off = (size_t)(u.pm * BM + ai * HALF + wr * 64 + m * 16 + fr) * 1024 + col0;
#pragma unroll
                for (int bj = 0; bj < 2; ++bj) { const f32x4 v0 = b0[m][bj] + acc[ai][bj][m][0], v1 = b1[m][bj] + acc[ai][bj][m][1];
                    u32x4 w; w.x = cvt_pk_bf16(v0[0], v0[1]); w.y = cvt_pk_bf16(v0[2], v0[3]); w.z = cvt_pk_bf16(v1[0], v1[1]); w.w = cvt_pk_bf16(v1[2], v1[3]);
                    *(GAS u32x4*)(op + off + bj * HALF) = w; } }
            asm volatile("" ::: "memory");
        }
    }
};
struct EpiRouter {
    static constexpr bool PERM = false;
    float* out;
    __device__ __forceinline__ void operator()(const Acc& acc, const Unit& u, int wr, int wc, int fr, int fq) const {
        if (wc >= 2) return;
#pragma unroll
        for (int ai = 0; ai < 2; ++ai)
#pragma unroll
            for (int m = 0; m < 4; ++m) { const size_t off = (size_t)(u.pm * BM + ai * HALF + wr * 64 + m * 16 + fr) * 64 + wc * 32 + 4 * fq;
#pragma unroll
                for (int n = 0; n < 2; ++n) *(f32x4*)(out + off + n * 16) = acc[ai][0][m][n]; }
    }
};
struct EpiGU {
    static constexpr bool PERM = true;
    bf16_t* H;
    __device__ __forceinline__ void operator()(const Acc& acc, const Unit& u, int wr, int wc, int fr, int fq) const {
        const int col0 = u.pn * 128 + wc * 32 + 8 * fq;
#pragma unroll
        for (int ai = 0; ai < 2; ++ai)
#pragma unroll
            for (int m = 0; m < 4; ++m) { bf16_t* rowp = H + (size_t)(u.pm * BM + ai * HALF + wr * 64 + m * 16 + fr) * EH + col0;
                f32x4 g0 = acc[ai][0][m][0], g1 = acc[ai][0][m][1]; const f32x4 u0 = acc[ai][1][m][0], u1 = acc[ai][1][m][1];
#pragma unroll
                for (int e = 0; e < 4; ++e) { g0[e] = g0[e] * sigmoidf_(g0[e]) * u0[e]; g1[e] = g1[e] * sigmoidf_(g1[e]) * u1[e]; }
                u32x4 w; w.x = cvt_pk_bf16(g0[0], g0[1]); w.y = cvt_pk_bf16(g0[2], g0[3]); w.z = cvt_pk_bf16(g1[0], g1[1]); w.w = cvt_pk_bf16(g1[2], g1[3]);
                *(u32x4*)rowp = w; }
    }
};
struct EpiDown {
    static constexpr bool PERM = true;
    bf16_t* Y; const float* gate;
    __device__ __forceinline__ void operator()(const Acc& acc, const Unit& u, int wr, int wc, int fr, int fq) const {
        const int col0 = u.pn * BM + wc * 32 + 8 * fq;
#pragma unroll
        for (int ai = 0; ai < 2; ++ai)
#pragma unroll
            for (int m = 0; m < 4; ++m) { const int row = u.pm * BM + ai * HALF + wr * 64 + m * 16 + fr; const float sc = gate[row]; bf16_t* rowp = Y + (size_t)row * 1024 + col0;
#pragma unroll
                for (int bj = 0; bj < 2; ++bj) { const f32x4 v0 = acc[ai][bj][m][0] * sc, v1 = acc[ai][bj][m][1] * sc;
                    u32x4 w; w.x = cvt_pk_bf16(v0[0], v0[1]); w.y = cvt_pk_bf16(v0[2], v0[3]); w.z = cvt_pk_bf16(v1[0], v1[1]); w.w = cvt_pk_bf16(v1[2], v1[3]);
                    *(u32x4*)(rowp + bj * HALF) = w; } }
    }
};
struct EpiPle {
    static constexpr bool PERM = true;
    const bf16_t* xin; bf16_t* xout; const bf16_t* pp;
    __device__ __forceinline__ void operator()(const Acc& acc, const Unit& u, int wr, int wc, int fr, int fq) const {
        const int col0 = u.pn * BM + wc * 32 + 8 * fq;
        const GAS bf16_t* xp = (const GAS bf16_t*)xin; GAS bf16_t* op = (GAS bf16_t*)xout; const GAS bf16_t* pq = (const GAS bf16_t*)pp;
#pragma unroll
        for (int ai = 0; ai < 2; ++ai) {
            u32x4 xw[4][2], pw[4][2];
#pragma unroll
            for (int m = 0; m < 4; ++m) { const size_t off = (size_t)(u.pm * BM + ai * HALF + wr * 64 + m * 16 + fr) * 1024 + col0;
#pragma unroll
                for (int bj = 0; bj < 2; ++bj) { xw[m][bj] = *(const GAS u32x4*)(xp + off + bj * HALF); pw[m][bj] = *(const GAS u32x4*)(pq + off + bj * HALF); } }
            asm volatile("" ::: "memory");
#pragma unroll
            for (int m = 0; m < 4; ++m) { const size_t off = (size_t)(u.pm * BM + ai * HALF + wr * 64 + m * 16 + fr) * 1024 + col0;
#pragma unroll
                for (int bj = 0; bj < 2; ++bj) { f32x4 x0, x1, p0, p1; unpack8f(xw[m][bj], x0, x1); unpack8f(pw[m][bj], p0, p1); const f32x4 a0 = acc[ai][bj][m][0], a1 = acc[ai][bj][m][1];
#pragma unroll
                    for (int e = 0; e < 4; ++e) { x0[e] += p0[e] * sigmoidf_(a0[e]); x1[e] += p1[e] * sigmoidf_(a1[e]); }
                    u32x4 w; w.x = cvt_pk_bf16(x0[0], x0[1]); w.y = cvt_pk_bf16(x0[2], x0[3]); w.z = cvt_pk_bf16(x1[0], x1[1]); w.w = cvt_pk_bf16(x1[2], x1[3]);
                    *(GAS u32x4*)(op + off + bj * HALF) = w; } }
            asm volatile("" ::: "memory");
        }
    }
};
struct EpiMid {
    static constexpr bool PERM = true;
    bf16_t* MID;
    __device__ __forceinline__ void operator()(const Acc& acc, const Unit& u, int wr, int wc, int fr, int fq) const {
        const int row0 = u.pm * BM + wr * 64 + fr;
        const int mode = (u.pn == 1) ? 2 : 0; const int colbase = u.pn * 256;
#pragma unroll
        for (int ai = 0; ai < 2; ++ai)
#pragma unroll
            for (int m = 0; m < 4; ++m) { bf16_t* rowp = MID + (size_t)(row0 + ai * HALF + m * 16) * 512 + colbase;
#pragma unroll
                for (int bj = 0; bj < 2; ++bj) { const int lc = bj * HALF + wc * 32 + 8 * fq; f32x4 v0 = acc[ai][bj][m][0], v1 = acc[ai][bj][m][1];
#pragma unroll
                    for (int e = 0; e < 4; ++e) {
                        if (mode == 2) { v0[e] = sigmoidf_(v0[e]); v1[e] = sigmoidf_(v1[e]); }
                        else if (lc < 64) { v0[e] = tanhf_(v0[e]); v1[e] = tanhf_(v1[e]); } }
                    u32x4 w; w.x = cvt_pk_bf16(v0[0], v0[1]); w.y = cvt_pk_bf16(v0[2], v0[3]); w.z = cvt_pk_bf16(v1[0], v1[1]); w.w = cvt_pk_bf16(v1[2], v1[3]);
                    *(u32x4*)(rowp + lc) = w; } }
    }
};
struct EpiRwkv2 {
    static constexpr bool PERM = true;
    bf16_t* O0; bf16_t* O1; const float* bias0; const float* bias1; int tybase;
    __device__ __forceinline__ void operator()(const Acc& acc, const Unit& u, int wr, int wc, int fr, int fq) const {
        const int ty = tybase + (u.pn >> 2); const int row0 = u.pm * BM + wr * 64 + fr; const int colt = (u.pn & 3) * BM + wc * 32 + 8 * fq;
        bf16_t* base = (u.pn >> 2) ? O1 : O0; const float* bias = (u.pn >> 2) ? bias1 : bias0;
#pragma unroll
        for (int bj = 0; bj < 2; ++bj) {
            f32x4 b0 = (f32x4){0.f, 0.f, 0.f, 0.f}, b1 = b0;
            if (ty < 2) { b0 = *(const f32x4*)(bias + colt + bj * HALF); b1 = *(const f32x4*)(bias + colt + bj * HALF + 4); }
#pragma unroll
            for (int ai = 0; ai < 2; ++ai)
#pragma unroll
                for (int m = 0; m < 4; ++m) { bf16_t* rowp = base + (size_t)(row0 + ai * HALF + m * 16) * 1024 + colt + bj * HALF;
                    f32x4 v0 = acc[ai][bj][m][0] + b0, v1 = acc[ai][bj][m][1] + b1;
                    if (ty < 2) { const float s = (ty == 0) ? 0.6065306597126334f : 1.0f;
#pragma unroll
                        for (int e = 0; e < 4; ++e) { v0[e] = s * sigmoidf_(v0[e]); v1[e] = s * sigmoidf_(v1[e]); } }
                    u32x4 w; w.x = cvt_pk_bf16(v0[0], v0[1]); w.y = cvt_pk_bf16(v0[2], v0[3]); w.z = cvt_pk_bf16(v1[0], v1[1]); w.w = cvt_pk_bf16(v1[2], v1[3]);
                    *(u32x4*)rowp = w; }
        }
    }
};

template <class Epi, class Sched, bool ALIGN_EPI, bool GATHER>
__device__ __forceinline__ void gemm_phase(PG8_LAS unsigned char* lds, const int K, const int lda, const Sched& S, const Epi& E, const int* __restrict__ rows, const int tid) {
    const int wid = __builtin_amdgcn_readfirstlane(tid >> 6), lane = tid & 63, wr = wid >> 2, wc = wid & 3, fr = lane & 15, fq = lane >> 4;
    const int nt = K / BK;
    unsigned voffA[2], voffB[2]; int RA[2];
#pragma unroll
    for (int i = 0; i < 2; ++i) { int R, C; stage_rc(tid * 16 + i * 8192, R, C); const int Rb = Epi::PERM ? ((R & ~31) + perm32(R & 31)) : R;
        RA[i] = R; voffA[i] = GATHER ? (unsigned)(C * 2) : (unsigned)(R * lda + C) * 2u; voffB[i] = (unsigned)(Rb * K + C) * 2u; }
    const size_t kstep = (size_t)(BK * 2);
    const size_t hstepA = GATHER ? 0 : (size_t)HALF * lda * 2, hstepB = (size_t)HALF * K * 2;
    const unsigned ldsw = (unsigned)wid * 1024u;
    const int aoff = lds_byte(wr * 64 + fr, fq * 8), boff = lds_byte(wc * 32 + fr, fq * 8);
#define PG8_SA(b, h) (((b) * 2 + (h)) * HTB)
#define PG8_SB(b, h) ((4 + (b) * 2 + (h)) * HTB)
#define PG8_ST2(bufoff, gbase, o0, o1) do { \
        __builtin_amdgcn_global_load_lds((const unsigned*)((const char*)(gbase) + (o0)), (PG8_LAS unsigned*)(lds + (bufoff) + ldsw), 16, 0, 0); \
        __builtin_amdgcn_global_load_lds((const unsigned*)((const char*)(gbase) + (o1)), (PG8_LAS unsigned*)(lds + (bufoff) + ldsw + 8192), 16, 0, 0); } while (0)
#define PG8_STB(bufoff, gbase) PG8_ST2(bufoff, gbase, voffB[0], voffB[1])
#define PG8_STA(bufoff, p, h, nx) do { if constexpr (GATHER) { const unsigned g0_ = (nx) ? gN[h][0] : gC[h][0], g1_ = (nx) ? gN[h][1] : gC[h][1]; PG8_ST2(bufoff, p, g0_, g1_); } \
        else { PG8_ST2(bufoff, (p) + (h) * hstepA, voffA[0], voffA[1]); } } while (0)
#define PG8_LDA(dst, b, h) do { _Pragma("unroll") for (int m = 0; m < 4; ++m) _Pragma("unroll") for (int k = 0; k < 2; ++k) dst[m][k] = *(const PG8_LAS bf16x8*)(lds + PG8_SA(b, h) + aoff + m * 2048 + k * 1024); } while (0)
#define PG8_LDB(dst, b, h) do { _Pragma("unroll") for (int n = 0; n < 2; ++n) _Pragma("unroll") for (int k = 0; k < 2; ++k) dst[n][k] = *(const PG8_LAS bf16x8*)(lds + PG8_SB(b, h) + boff + n * 2048 + k * 1024); } while (0)
#define PG8_MMA(ai, bj, At, Bt) do { __builtin_amdgcn_s_setprio(1); _Pragma("unroll") for (int m = 0; m < 4; ++m) _Pragma("unroll") for (int n = 0; n < 2; ++n) _Pragma("unroll") for (int k = 0; k < 2; ++k) \
        acc[ai][bj][m][n] = __builtin_amdgcn_mfma_f32_16x16x32_bf16(Bt[n][k], At[m][k], acc[ai][bj][m][n], 0, 0, 0); __builtin_amdgcn_s_setprio(0); } while (0)
#define PG8_WAIT_V(n) asm volatile("s_waitcnt vmcnt(" #n ")" ::: "memory")
#define PG8_WAIT_L(n) asm volatile("s_waitcnt lgkmcnt(" #n ")" ::: "memory")
#define PG8_BAR __builtin_amdgcn_s_barrier()
#define PG8_SCHED __builtin_amdgcn_sched_barrier(0)
#define PG8_GLOAD(dst, un) do { if constexpr (GATHER) { _Pragma("unroll") for (int h_ = 0; h_ < 2; ++h_) _Pragma("unroll") for (int i_ = 0; i_ < 2; ++i_) \
        dst[h_][i_] = (unsigned)rows[(un).pm * BM + h_ * HALF + RA[i_]] * (unsigned)(lda * 2) + voffA[i_]; } } while (0)
    Unit cur, nxt; int ui = 0;
    if (!S.next(0, cur)) return;
    unsigned gC[2][2] = {{0u, 0u}, {0u, 0u}}, gN[2][2] = {{0u, 0u}, {0u, 0u}};
    PG8_GLOAD(gC, cur);
    Acc acc;
#pragma unroll
    for (int a = 0; a < 2; ++a)
#pragma unroll
        for (int b = 0; b < 2; ++b)
#pragma unroll
            for (int m = 0; m < 4; ++m)
#pragma unroll
                for (int n = 0; n < 2; ++n) acc[a][b][m][n] = (f32x4){0.f, 0.f, 0.f, 0.f};
    bf16x8 At[4][2], B0[2][2], B1[2][2];
    const char* cA = cur.A; const char* cB = cur.B;
    PG8_STB(PG8_SB(0, 0), cB); PG8_STB(PG8_SB(0, 1), cB + hstepB); PG8_STA(PG8_SA(0, 0), cA, 0, false); PG8_STA(PG8_SA(0, 1), cA, 1, false);
    if (wr == 1) PG8_BAR;
    PG8_WAIT_V(2); PG8_BAR;
    PG8_STB(PG8_SB(1, 0), cB + kstep); PG8_STA(PG8_SA(1, 0), cA + kstep, 0, false); PG8_STB(PG8_SB(1, 1), cB + hstepB + kstep);
    PG8_WAIT_V(6); PG8_BAR;
    for (;;) {
        const bool has_next = S.next(ui + 1, nxt);
        if (has_next) { PG8_GLOAD(gN, nxt); }
        const char* nA = has_next ? nxt.A : cA; const char* nB = has_next ? nxt.B : cB;
#pragma unroll 1
        for (int t = 0; t < nt; t += 2) {
            const bool last = (t == nt - 2); const bool nx = last && has_next;
            const char* a1 = cA + (size_t)(t + 1) * kstep;
            const char* a2 = last ? nA : cA + (size_t)(t + 2) * kstep; const char* b2 = last ? nB : cB + (size_t)(t + 2) * kstep;
            const char* a3 = a2 + kstep; const char* b3 = b2 + kstep;
            PG8_LDB(B0, 0, 0); PG8_LDB(B1, 0, 1); PG8_SCHED; PG8_LDA(At, 0, 0); PG8_STA(PG8_SA(1, 1), a1, 1, false);
            PG8_WAIT_V(8); PG8_WAIT_L(0); PG8_BAR; PG8_MMA(0, 0, At, B0); PG8_MMA(0, 1, At, B1); PG8_BAR; PG8_SCHED;
            PG8_LDA(At, 0, 1); PG8_STB(PG8_SB(0, 0), b2); PG8_STB(PG8_SB(0, 1), b2 + hstepB); PG8_STA(PG8_SA(0, 0), a2, 0, nx);
            PG8_WAIT_V(8); PG8_WAIT_L(0); PG8_BAR; PG8_MMA(1, 0, At, B0); PG8_MMA(1, 1, At, B1); PG8_BAR; PG8_SCHED;
            PG8_LDB(B0, 1, 0); PG8_LDB(B1, 1, 1); PG8_SCHED; PG8_LDA(At, 1, 0); PG8_STA(PG8_SA(0, 1), a2, 1, nx);
            PG8_WAIT_V(8); PG8_WAIT_L(0); PG8_BAR; PG8_MMA(0, 0, At, B0); PG8_MMA(0, 1, At, B1); PG8_BAR; PG8_SCHED;
            PG8_LDA(At, 1, 1); PG8_STB(PG8_SB(1, 0), b3); PG8_STB(PG8_SB(1, 1), b3 + hstepB); PG8_STA(PG8_SA(1, 0), a3, 0, nx);
            PG8_WAIT_V(8); PG8_WAIT_L(0); PG8_BAR; PG8_MMA(1, 0, At, B0); PG8_MMA(1, 1, At, B1); PG8_BAR; PG8_SCHED;
        }
        if constexpr (ALIGN_EPI) { if (wr == 0) PG8_BAR; }
        E(acc, cur, wr, wc, fr, fq);
        if (!has_next) break;
#pragma unroll
        for (int a = 0; a < 2; ++a)
#pragma unroll
            for (int b = 0; b < 2; ++b)
#pragma unroll
                for (int m = 0; m < 4; ++m)
#pragma unroll
                    for (int n = 0; n < 2; ++n) acc[a][b][m][n] = (f32x4){0.f, 0.f, 0.f, 0.f};
        cur = nxt; cA = nA; cB = nB; ++ui;
        if constexpr (GATHER) {
#pragma unroll
            for (int h_ = 0; h_ < 2; ++h_)
#pragma unroll
                for (int i_ = 0; i_ < 2; ++i_) gC[h_][i_] = gN[h_][i_]; }
        if constexpr (ALIGN_EPI) { if (wr == 1) PG8_BAR; }
    }
    PG8_WAIT_V(0);
    if constexpr (!ALIGN_EPI) { if (wr == 0) PG8_BAR; }
    PG8_BAR;
#undef PG8_SA
#undef PG8_SB
#undef PG8_ST2
#undef PG8_STB
#undef PG8_STA
#undef PG8_LDA
#undef PG8_LDB
#undef PG8_MMA
#undef PG8_WAIT_V
#undef PG8_WAIT_L
#undef PG8_BAR
#undef PG8_SCHED
#undef PG8_GLOAD
}
}
namespace attn_body {
using bf16=__hip_bfloat16;
using bf16x8=__attribute__((ext_vector_type(8)))short;
using s16x4=__attribute__((ext_vector_type(4)))short;
using f32x16=__attribute__((ext_vector_type(16)))float;
using u32x4=__attribute__((ext_vector_type(4)))unsigned;
constexpr int BATCH=8,NHEAD=16,SEQ=8192,D=64,PQ=512,PO=1024;
constexpr int NW=8,QBLK=32,QB=QBLK*NW,KVBLK=64,NQB=SEQ/QB;
constexpr int ATTN_UNIT_ROWS=QB;
__device__ __forceinline__ int crow(int r,int hi){return (r&3)+8*(r>>2)+4*hi;}
#define SBAR() __builtin_amdgcn_sched_barrier(0)
__device__ __forceinline__ void cmask(f32x16&p0,f32x16&p1,int jb,int qrel,int hi){
  const float NEG=-INFINITY; int kb=64*jb+4*hi;
  #pragma unroll
  for(int r=0;r<16;++r){int kv=kb+(r&3)+8*(r>>2); if(kv>qrel)p0[r]=NEG; if(kv+32>qrel)p1[r]=NEG;}
}

__device__ __forceinline__ void cbias(f32x16&p0,f32x16&p1,int jb,int qrel,int hi,const __attribute__((address_space(3))) float*tb){
  const int kb=64*jb+4*hi;
  #pragma unroll
  for(int r=0;r<16;++r){const int rel=qrel-(kb+(r&3)+8*(r>>2)); const int i0=min(max(rel,0),127), i1=min(max(rel-32,0),127); p0[r]+=tb[i0]; p1[r]+=tb[i1];}
}
constexpr int NSLOT=3, SLOTB=8192;
constexpr int LDS_K=0, LDS_V=NSLOT*SLOTB, LDS_WS=2*NSLOT*SLOTB, LDS_OST=LDS_WS+NW*64*4, LDS_BYTES=LDS_OST+NW*4096;
constexpr float C2=0.125f*1.4426950408889634f;
__device__ __forceinline__ void glds16(const void*gsrc,unsigned lds_dst){unsigned keep;
  asm volatile("s_mov_b32 %0, m0\n\ts_mov_b32 m0, %2\n\ts_nop 0\n\tglobal_load_lds_dwordx4 %1, off\n\ts_mov_b32 m0, %0":"=&s"(keep):"v"(gsrc),"s"(lds_dst):"memory");}
__device__ __forceinline__ float max3f(float a,float b,float c){float r;asm("v_max3_f32 %0, %1, %2, %3":"=v"(r):"v"(a),"v"(b),"v"(c));return r;}
__device__ __forceinline__ float max2f(float a,float b){float r;asm("v_max_f32_e32 %0, %1, %2":"=v"(r):"v"(a),"v"(b));return r;}
__device__ __forceinline__ float fadd_s(float a,float b){float r;asm("v_add_f32_e32 %0, %1, %2":"=v"(r):"v"(a),"v"(b));return r;}
__device__ __forceinline__ float fsub_s(float a,float b){float r;asm("v_sub_f32_e32 %0, %1, %2":"=v"(r):"v"(a),"v"(b));return r;}
typedef float f32x2_t __attribute__((ext_vector_type(2))); typedef __bf16 bf16x2_t __attribute__((ext_vector_type(2)));
__device__ __forceinline__ unsigned cvtpk_s(float lo,float hi){f32x2_t v={lo,hi};bf16x2_t b=__builtin_convertvector(v,bf16x2_t);return __builtin_bit_cast(unsigned,b);}
#define WAIT_BAR(N) asm volatile("s_waitcnt vmcnt(" #N ") lgkmcnt(0)\n\ts_barrier":::"memory")

__device__ __forceinline__ void qkt(f32x16&p0,f32x16&p1,const char*Kslot,const bf16x8*qr,const f32x16&negm,int r32,int hi){
  const char*kb=Kslot+hi*1024+r32*16;
  #pragma unroll
  for(int d0=0;d0<4;++d0){
    const bf16x8 b0=*reinterpret_cast<const bf16x8*>(kb+d0*2048);
    const bf16x8 b1=*reinterpret_cast<const bf16x8*>(kb+d0*2048+512);
    if(d0==0){p0=__builtin_amdgcn_mfma_f32_32x32x16_bf16(b0,qr[0],negm,0,0,0);p1=__builtin_amdgcn_mfma_f32_32x32x16_bf16(b1,qr[0],negm,0,0,0);}
    else{p0=__builtin_amdgcn_mfma_f32_32x32x16_bf16(b0,qr[d0],p0,0,0,0);p1=__builtin_amdgcn_mfma_f32_32x32x16_bf16(b1,qr[d0],p1,0,0,0);}}
}
typedef __attribute__((address_space(3))) const char* lds_cptr;
typedef short v4i16_t __attribute__((ext_vector_type(4)));
__device__ __forceinline__ void kload8(bf16x8*kf,lds_cptr kp){
  kf[0]=*(const __attribute__((address_space(3))) bf16x8*)(kp);      kf[1]=*(const __attribute__((address_space(3))) bf16x8*)(kp+512);
  kf[2]=*(const __attribute__((address_space(3))) bf16x8*)(kp+2048); kf[3]=*(const __attribute__((address_space(3))) bf16x8*)(kp+2560);
  kf[4]=*(const __attribute__((address_space(3))) bf16x8*)(kp+4096); kf[5]=*(const __attribute__((address_space(3))) bf16x8*)(kp+4608);
  kf[6]=*(const __attribute__((address_space(3))) bf16x8*)(kp+6144); kf[7]=*(const __attribute__((address_space(3))) bf16x8*)(kp+6656);
}
__device__ __forceinline__ void kload2(bf16x8*kf,lds_cptr kp,int j){ kf[2*j]=*(const __attribute__((address_space(3))) bf16x8*)(kp+j*2048); kf[2*j+1]=*(const __attribute__((address_space(3))) bf16x8*)(kp+j*2048+512); }
__device__ __forceinline__ s16x4 vtr(lds_cptr p){ return __builtin_bit_cast(s16x4,__builtin_amdgcn_ds_read_tr16_b64_v4i16((__attribute__((address_space(3))) v4i16_t*)p)); }
__device__ __forceinline__ float rowmax(const f32x16&p0,const f32x16&p1){
  float a=max3f(p0[0],p0[1],p1[0]),b=max3f(p0[2],p0[3],p1[1]);a=max3f(a,p1[2],p1[3]);
  #pragma unroll
  for(int r=4;r<16;r+=4){a=max3f(a,p0[r],p0[r+1]);b=max3f(b,p0[r+2],p0[r+3]);a=max3f(a,p1[r],p1[r+1]);b=max3f(b,p1[r+2],p1[r+3]);}
  const float m=max2f(a,b);
  auto rr=__builtin_amdgcn_permlane32_swap(__float_as_uint(m),__float_as_uint(m),false,false);
  return max2f(__uint_as_float(rr[0]),__uint_as_float(rr[1]));
}
__device__ __forceinline__ void pv(f32x16*o,int vb,bf16x8 pa0,bf16x8 pa1,bf16x8 pa2,bf16x8 pa3){
  #pragma unroll
  for(int d0=0;d0<2;++d0){s16x4 lo[4],hi[4];
    #pragma unroll
    for(int ks=0;ks<4;++ks){
      asm volatile("ds_read_b64_tr_b16 %0,%1 offset:%c2":"=&v"(lo[ks]):"v"(vb),"i"(d0*4096+ks*1024):"memory");
      asm volatile("ds_read_b64_tr_b16 %0,%1 offset:%c2":"=&v"(hi[ks]):"v"(vb),"i"(d0*4096+ks*1024+512):"memory");}
    asm volatile("s_waitcnt lgkmcnt(0)":::"memory");SBAR();
    #define PK(k) (bf16x8){lo[k][0],lo[k][1],lo[k][2],lo[k][3],hi[k][0],hi[k][1],hi[k][2],hi[k][3]}
    o[d0]=__builtin_amdgcn_mfma_f32_32x32x16_bf16(pa0,PK(0),o[d0],0,0,0);
    o[d0]=__builtin_amdgcn_mfma_f32_32x32x16_bf16(pa1,PK(1),o[d0],0,0,0);
    o[d0]=__builtin_amdgcn_mfma_f32_32x32x16_bf16(pa2,PK(2),o[d0],0,0,0);
    o[d0]=__builtin_amdgcn_mfma_f32_32x32x16_bf16(pa3,PK(3),o[d0],0,0,0);
    #undef PK
  }
}

#ifndef ATTN_STORE16
#define ATTN_STORE16(p,v) (*(u32x4*)(p)=(v))
#endif
template<int THRL> __device__ __forceinline__ void attn_unit(int b,int vh,int qb,const bf16*Q,const bf16*__restrict__ K,const bf16*__restrict__ V,bf16*O,char*shm,const __attribute__((address_space(3))) float*tball,const int tid){
  const int lane=tid&63,r32=lane&31,hi=lane>>5; const int wid=__builtin_amdgcn_readfirstlane(tid>>6);
  const long rowbase=(long)b*SEQ; const int q0=qb*QB;
  const int hh=vh>>2, qcol=hh*128+((vh>>1)&1)*64, vcol=hh*128+(vh&1)*64;
  const __attribute__((address_space(3))) float*tb=tball+hh*128;
  const bf16*Qw=Q+(rowbase+q0+wid*QBLK)*PQ+qcol;
  const bf16*Kh=K+rowbase*PQ+qcol,*Vh=V+rowbase*PQ+vcol;
  const unsigned lds0=(unsigned)(uintptr_t)shm;
  float*wsf=(float*)(shm+LDS_WS)+wid*64;
  const bf16*ksrc=Kh+(long)lane*PQ+wid*8;
  const bf16*vsrc=Vh+(long)(16*(wid&3)+(lane>>2))*PQ+(wid>>2)*32+(lane&3)*8;
  const unsigned kdst=lds0+LDS_K+wid*1024, vdst=lds0+LDS_V+wid*1024;
  #define DMA_K(t,slot) glds16(ksrc+(long)(t)*KVBLK*PQ,(unsigned)__builtin_amdgcn_readfirstlane(kdst+(slot)))
  #define DMA_V(t,slot) glds16(vsrc+(long)(t)*KVBLK*PQ,(unsigned)__builtin_amdgcn_readfirstlane(vdst+(slot)))
  const int vb0=(int)(lds0+LDS_V)+((lane>>4)&1)*32+(lane&3)*8+(4*hi+((lane&15)>>2))*64;
  const char*Kbase=shm+LDS_K; bf16x8 kf[8];
  const lds_cptr shm3=(lds_cptr)shm; const lds_cptr kp0=shm3+LDS_K+hi*1024+r32*16; const lds_cptr vp0=shm3+LDS_V+((lane>>4)&1)*32+(lane&3)*8+(4*hi+((lane&15)>>2))*64;
  const int NT=(q0+QB)/KVBLK;
  DMA_K(0,0);DMA_V(0,0);DMA_K(1,SLOTB);
  bf16x8 qr[4];
  #pragma unroll
  for(int d0=0;d0<4;++d0)qr[d0]=*reinterpret_cast<const bf16x8*>(&Qw[(long)r32*PQ+d0*16+hi*8]);
  float mhat=0.f,l_reg=0.f;f32x16 o[2];o[0]=f32x16{};o[1]=f32x16{};f32x16 negm=f32x16{};asm volatile("":"+v"(negm));
  const int qrel=wid*QBLK+r32;
  #define CMASK(P0,P1,t) do{int jb_=(t)-(NT-4); if(jb_>=-2){cbias(P0,P1,jb_,qrel,hi,tb); if(jb_>=0)cmask(P0,P1,jb_,qrel,hi);}}while(0)
  bool resc=false;
  #define START(P0,P1) do{ const float rm=rowmax(P0,P1); resc=false; \
    { const float dl=rm; mhat=fadd_s(mhat,dl); \
      _Pragma("unroll") for(int r=0;r<16;++r){P0[r]=fsub_s(P0[r],dl);P1[r]=fsub_s(P1[r],dl);} \
      _Pragma("unroll") for(int r=0;r<16;++r)negm[r]=-mhat; asm volatile("":"+v"(negm)); } \
    _Pragma("unroll") for(int r=0;r<16;++r)P0[r]=__builtin_amdgcn_exp2f(P0[r]); }while(0)
  #define RESC() do{ if(resc){ asm volatile("s_waitcnt lgkmcnt(0)":::"memory"); \
      _Pragma("unroll") for(int d_=0;d_<2;++d_) _Pragma("unroll") for(int r=0;r<16;++r)o[d_][r]*=wsf[crow(r,hi)]; } }while(0)
  f32x16 pA0,pA1,pB0,pB1;
  int sl_prev=0,sl_cur=0,sl_next=SLOTB;
  #define ROT() do{sl_prev=sl_cur;sl_cur=sl_next;sl_next=(sl_next==(NSLOT-1)*SLOTB)?0:sl_next+SLOTB;}while(0)
  DMA_K(2,2*SLOTB);
  WAIT_BAR(3);
  qkt(pA0,pA1,Kbase,qr,negm,r32,hi);asm volatile("s_nop 15\n\ts_nop 7":"+v"(pA0),"+v"(pA1));CMASK(pA0,pA1,0);
  START(pA0,pA1);
  _Pragma("unroll") for(int r=0;r<16;++r)pA1[r]=__builtin_amdgcn_exp2f(pA1[r]);
  WAIT_BAR(0);
  DMA_K(3,0);DMA_V(1,SLOTB);
  ROT();
  kload8(kf,kp0+sl_cur);
  WAIT_BAR(2);
  s16x4 vlo[8],vhi[8]; u32x4 pw0,pw1,pw2,pw3;
  #define PKW(P,B) cvtpk_s(P[B],P[B+1])
  #define PAF(k) __builtin_bit_cast(bf16x8,pw##k)
  #define VFR(i) (bf16x8){vlo[i][0],vlo[i][1],vlo[i][2],vlo[i][3],vhi[i][0],vhi[i][1],vhi[i][2],vhi[i][3]}
  #define PIN(x) asm volatile("":"+v"(x))
  #define MX3(a,b,c) __builtin_fmaxf(__builtin_fmaxf((a),(b)),(c))
  #define GAPA(MF,A0,A1,A2,A3,W0,W1,PW) do{ MF; sacc+=A0; sacc+=A1; sacc+=A2; sacc+=A3; PIN(sacc); W0; W1; PIN(PW); SBAR(); }while(0)
  #define EX(v) __builtin_amdgcn_exp2f(v)
  #define GAPB(MF,X,B) do{ MF; X[B]=EX(X[B]); X[B+1]=EX(X[B+1]); X[B+2]=EX(X[B+2]); X[B+3]=EX(X[B+3]); PIN(X); SBAR(); }while(0)
  #define VRD(i) do{ vlo[i]=vtr(vp_+(((i)>>2)*4096+((i)&3)*1024)); vhi[i]=vtr(vp_+(((i)>>2)*4096+((i)&3)*1024+512)); }while(0)
  #define KRD(G,j) do{ if(G){ kload2(kf,kp0+sl_next,j); SBAR(); } }while(0)
  #define STEP(C0,C1,P0,P1,t,GK,GV,GL) do{ SBAR(); \
    const lds_cptr vp_=vp0+sl_prev; \
    VRD(0); SBAR(); float sacc=(P0[0]+P0[1]); \
    GAPA(C0=__builtin_amdgcn_mfma_f32_32x32x16_bf16(kf[0],qr[0],negm,0,0,0), P0[2],P0[3],P0[4],P0[5],     pw0[0]=PKW(P0,0), pw0[1]=PKW(P0,2), pw0); \
    VRD(4); SBAR(); GAPA(C1=__builtin_amdgcn_mfma_f32_32x32x16_bf16(kf[1],qr[0],negm,0,0,0), P0[6],P0[7],P0[8],P0[9],     pw0[2]=PKW(P0,4), pw0[3]=PKW(P0,6), pw0); \
    VRD(1); SBAR(); GAPA(C0=__builtin_amdgcn_mfma_f32_32x32x16_bf16(kf[2],qr[1],C0,0,0,0),   P0[10],P0[11],P0[12],P0[13], pw1[0]=PKW(P0,8), pw1[1]=PKW(P0,10), pw1); \
    VRD(5); SBAR(); GAPA(C1=__builtin_amdgcn_mfma_f32_32x32x16_bf16(kf[3],qr[1],C1,0,0,0),   P0[14],P0[15],P1[0],P1[1],   pw1[2]=PKW(P0,12),pw1[3]=PKW(P0,14), pw1); \
    VRD(2); SBAR(); GAPA(C0=__builtin_amdgcn_mfma_f32_32x32x16_bf16(kf[4],qr[2],C0,0,0,0),   P1[2],P1[3],P1[4],P1[5],     pw2[0]=PKW(P1,0), pw2[1]=PKW(P1,2), pw2); \
    VRD(6); SBAR(); GAPA(C1=__builtin_amdgcn_mfma_f32_32x32x16_bf16(kf[5],qr[2],C1,0,0,0),   P1[6],P1[7],P1[8],P1[9],     pw2[2]=PKW(P1,4), pw2[3]=PKW(P1,6), pw2); \
    VRD(3); SBAR(); GAPA(C0=__builtin_amdgcn_mfma_f32_32x32x16_bf16(kf[6],qr[3],C0,0,0,0),   P1[10],P1[11],P1[12],P1[13], pw3[0]=PKW(P1,8), pw3[1]=PKW(P1,10), pw3); \
    VRD(7); SBAR(); GAPA(C1=__builtin_amdgcn_mfma_f32_32x32x16_bf16(kf[7],qr[3],C1,0,0,0),   P1[14],P1[15],0.f,0.f,       pw3[2]=PKW(P1,12),pw3[3]=PKW(P1,14), pw3); \
    l_reg+=sacc; \
    if(GK){DMA_K((t)+3,sl_cur);} if(GV){DMA_V((t)+1,sl_next);} \
    CMASK(C0,C1,t); \
    { float a=MX3(C0[0],C0[1],C1[0]),b=MX3(C0[2],C0[3],C1[1]); a=MX3(a,C1[2],C1[3]); \
      _Pragma("unroll") for(int r=4;r<16;r+=4){a=MX3(a,C0[r],C0[r+1]);b=MX3(b,C0[r+2],C0[r+3]);a=MX3(a,C1[r],C1[r+1]);b=MX3(b,C1[r+2],C1[r+3]);} \
      float rm=__builtin_fmaxf(a,b); { auto rr=__builtin_amdgcn_permlane32_swap(__float_as_uint(rm),__float_as_uint(rm),false,false); rm=__builtin_fmaxf(__uint_as_float(rr[0]),__uint_as_float(rr[1])); } \
      resc=false; \
      if(__builtin_expect(__any(rm>(float)THRL),0)){ const float dl=__builtin_fmaxf(rm,0.f); mhat+=dl; \
        _Pragma("unroll") for(int r=0;r<16;++r){C0[r]-=dl;C1[r]-=dl;} \
        _Pragma("unroll") for(int r=0;r<16;++r)negm[r]=-mhat; asm volatile("":"+v"(negm)); \
        const float f=__builtin_amdgcn_exp2f(-dl); l_reg*=f; if(hi==0)wsf[r32]=f; resc=true; } } \
    SBAR(); \
    GAPB(o[0]=__builtin_amdgcn_mfma_f32_32x32x16_bf16(PAF(0),VFR(0),o[0],0,0,0), C0,0); \
    GAPB(o[1]=__builtin_amdgcn_mfma_f32_32x32x16_bf16(PAF(0),VFR(4),o[1],0,0,0), C0,4); \
    KRD(GL,0); GAPB(o[0]=__builtin_amdgcn_mfma_f32_32x32x16_bf16(PAF(1),VFR(1),o[0],0,0,0), C0,8); \
    KRD(GL,1); GAPB(o[1]=__builtin_amdgcn_mfma_f32_32x32x16_bf16(PAF(1),VFR(5),o[1],0,0,0), C0,12); \
    KRD(GL,2); GAPB(o[0]=__builtin_amdgcn_mfma_f32_32x32x16_bf16(PAF(2),VFR(2),o[0],0,0,0), C1,0); \
    KRD(GL,3); GAPB(o[1]=__builtin_amdgcn_mfma_f32_32x32x16_bf16(PAF(2),VFR(6),o[1],0,0,0), C1,4); \
    GAPB(o[0]=__builtin_amdgcn_mfma_f32_32x32x16_bf16(PAF(3),VFR(3),o[0],0,0,0), C1,8); \
    GAPB(o[1]=__builtin_amdgcn_mfma_f32_32x32x16_bf16(PAF(3),VFR(7),o[1],0,0,0), C1,12); \
    }while(0)
  int t=1;
  #undef CMASK
  #define CMASK(P0,P1,t) do{}while(0)
  for(;t+7<NT;t+=2){
    STEP(pB0,pB1,pA0,pA1,t,true,true,true);     WAIT_BAR(2); RESC(); ROT();
    STEP(pA0,pA1,pB0,pB1,t+1,true,true,true);   WAIT_BAR(2); RESC(); ROT();
  }
  #undef CMASK
  #define CMASK(P0,P1,t) do{int jb_=(t)-(NT-4); if(jb_>=-2){cbias(P0,P1,jb_,qrel,hi,tb); if(jb_>=0)cmask(P0,P1,jb_,qrel,hi);}}while(0)
  #define ENDW(tt) do{ if((tt)+3<NT){WAIT_BAR(2);} else if((tt)+2<NT){WAIT_BAR(1);} else {WAIT_BAR(0);} }while(0)
  for(;t+1<NT;t+=2){
    STEP(pB0,pB1,pA0,pA1,t,(t+3<NT),(t+1<NT),(t+1<NT));       ENDW(t);   RESC(); ROT();
    STEP(pA0,pA1,pB0,pB1,t+1,(t+4<NT),(t+2<NT),(t+2<NT));     ENDW(t+1); RESC(); ROT();
  }
  STEP(pB0,pB1,pA0,pA1,NT-1,false,false,false); RESC();
  { float sacc=pB0[0]+pB0[1]; _Pragma("unroll") for(int r=2;r<16;++r)sacc+=pB0[r]; _Pragma("unroll") for(int r=0;r<16;++r)sacc+=pB1[r]; l_reg+=sacc;
    pw0=(u32x4){PKW(pB0,0),PKW(pB0,2),PKW(pB0,4),PKW(pB0,6)};pw1=(u32x4){PKW(pB0,8),PKW(pB0,10),PKW(pB0,12),PKW(pB0,14)};pw2=(u32x4){PKW(pB1,0),PKW(pB1,2),PKW(pB1,4),PKW(pB1,6)};pw3=(u32x4){PKW(pB1,8),PKW(pB1,10),PKW(pB1,12),PKW(pB1,14)};
    SBAR(); pv(o,vb0+sl_cur,PAF(0),PAF(1),PAF(2),PAF(3)); }
  #undef PKW
  #undef PAF
  #undef VFR
  #undef PIN
  #undef MX3
  #undef GAPA
  #undef GAPB
  #undef EX
  #undef VRD
  #undef KRD
  #undef STEP
  #undef ENDW
  {auto rr=__builtin_amdgcn_permlane32_swap(__float_as_uint(l_reg),__float_as_uint(l_reg),false,false);l_reg=__uint_as_float(rr[0])+__uint_as_float(rr[1]);}
  if(hi==0)wsf[32+r32]=l_reg;asm volatile("s_waitcnt lgkmcnt(0)":::"memory");
  float rli[16];
  #pragma unroll
  for(int r=0;r<16;++r)rli[r]=__builtin_amdgcn_rcpf(wsf[32+crow(r,hi)]);
  bf16*Ow=O+(rowbase+q0+wid*QBLK)*PO+vh*D;
  { bf16*stg=(bf16*)(shm+LDS_OST)+wid*2048;
    #pragma unroll
    for(int r=0;r<16;++r){const int orow=crow(r,hi);
      #pragma unroll
      for(int d0=0;d0<2;++d0)stg[orow*64+d0*32+r32]=__float2bfloat16(o[d0][r]*rli[r]);}
    asm volatile("s_waitcnt lgkmcnt(0)":::"memory");
    #pragma unroll
    for(int i=0;i<4;++i){const int row=i*8+(lane>>3),ch=lane&7; const u32x4 v=*(const u32x4*)(stg+row*64+ch*8); ATTN_STORE16(Ow+(long)row*PO+ch*8,v);} }
  asm volatile("s_waitcnt lgkmcnt(0)\n\ts_barrier":::"memory");
  #undef DMA_K
  #undef DMA_V
  #undef CMASK
  #undef START
  #undef RESC
  #undef ROT
}
constexpr int ATTN_LDS_BYTES=LDS_BYTES;
struct AttnTensors { const bf16* Q; const bf16* K; const bf16* V; bf16* O; };
struct AttnUnit { int bh; int qb; };
__device__ __forceinline__ bool attn_next(int vcu,int i,AttnUnit&u){ if(i>=16)return false; const int s=vcu&7, j=i&3; u.bh=(vcu>>3)+32*(i>>2); u.qb=(j==0)?s:(j==1)?15-s:(j==2)?16+s:31-s; return true; }
template<int THRL=8> __device__ __forceinline__ void attn_phase(char*lds,const AttnTensors&T,int vcu,const __attribute__((address_space(3))) float*tball,const int tid){
  AttnUnit u;
  for(int i=0;attn_next(vcu,i,u);++i){ attn_unit<THRL>(u.bh/NHEAD,u.bh%NHEAD,u.qb,T.Q,T.K,T.V,T.O,lds,tball,tid); }
}
#undef SBAR
#undef WAIT_BAR
}

#define XB_TMO      128
#define XB_XCNT(j)  (256  + 64 * (j))
#define XB_XSUB(j)  (1280 + 64 * (j))
#define XB_XGEN(j)  (2304 + 64 * (j))
#define XB_TOP      3328
#define XB_TOPGEN   3392
#define XCD_BAR_WORDS 3456
#define XB_SPIN_CAP (1u << 18)

__device__ __forceinline__ unsigned xb_ld(unsigned* p)              { return __hip_atomic_load(p, __ATOMIC_RELAXED, __HIP_MEMORY_SCOPE_AGENT); }
__device__ __forceinline__ unsigned xb_add(unsigned* p, unsigned v) { return __hip_atomic_fetch_add(p, v, __ATOMIC_RELAXED, __HIP_MEMORY_SCOPE_AGENT); }
__device__ __forceinline__ unsigned xb_xcc_id() { return (unsigned)__builtin_amdgcn_s_getreg((3 << 11) | 20) & 0xFu; }
#define XB_SPIN(cond, bar) do { unsigned _sp = 0; while (cond) { __builtin_amdgcn_s_sleep(1); \
    if ((++_sp & 255u) == 0u) { if (xb_ld(&(bar)[XB_TMO])) break; if (_sp > XB_SPIN_CAP) { atomicAdd(&(bar)[XB_TMO], 1u); break; } } } } while (0)

struct XcdBarrier {
    unsigned* bar; unsigned x;
    volatile LAS unsigned* st;
};

__device__ __forceinline__ XcdBarrier xcd_barrier_post(unsigned* bar, volatile LAS unsigned* st, const bool leader  ) {
    XcdBarrier b; b.bar = bar; b.x = xb_xcc_id(); b.st = st;
    if (leader) (void)xb_add(&bar[XB_XCNT(b.x)], 1u);
    return b;
}
__device__ __forceinline__ void xcd_barrier_complete(unsigned* bar, unsigned x, unsigned& nloc, unsigned& nx) {
    const unsigned G = gridDim.x * gridDim.y * gridDim.z;
    unsigned sum, cnt, mine, sp = 0u;
    for (;;) {
        sum = 0u; cnt = 0u; mine = 0u;
#pragma unroll
        for (unsigned j = 0; j < 16; ++j) { const unsigned c = xb_ld(&bar[XB_XCNT(j)]); sum += c; cnt += (c > 0u) ? 1u : 0u; mine = (j == x) ? c : mine; }
        if (sum == G) break;
        __builtin_amdgcn_s_sleep(1);
        if ((++sp & 255u) == 0u) { if (xb_ld(&bar[XB_TMO])) break; if (sp > XB_SPIN_CAP) { atomicAdd(&bar[XB_TMO], 1u); break; } }
    }
    nloc = mine > 0u ? mine : 1u; nx = cnt > 0u ? cnt : 1u;
}

__device__ __forceinline__ void xcd_barrier(const XcdBarrier& b, const bool leader  ) {
    asm volatile("s_waitcnt vmcnt(0)" ::: "memory");
    __syncthreads();
    if (leader) {
        unsigned* bar = b.bar;
        __builtin_amdgcn_s_waitcnt(0);
        unsigned nloc = b.st[0], nx = b.st[1];
        if (nloc == 0u) { xcd_barrier_complete(bar, b.x, nloc, nx); b.st[0] = nloc; b.st[1] = nx; }
        const unsigned old = xb_add(&bar[XB_XSUB(b.x)], 1u);
        const unsigned gen = old / nloc;
        if (old + 1u == (gen + 1u) * nloc) {
            __builtin_amdgcn_fence(__ATOMIC_RELEASE, "agent");
            asm volatile("s_waitcnt vmcnt(0)" ::: "memory");
            const unsigned og = xb_add(&bar[XB_TOP], 1u);
            const unsigned tg = og / nx;
            if (og + 1u == (tg + 1u) * nx) xb_add(&bar[XB_TOPGEN], 1u);
            else XB_SPIN(xb_ld(&bar[XB_TOPGEN]) == tg, bar);
            __builtin_amdgcn_fence(__ATOMIC_ACQUIRE, "agent");
            xb_add(&bar[XB_XGEN(b.x)], 1u);
            asm volatile("s_waitcnt vmcnt(0)" ::: "memory");
        } else {
            XB_SPIN(xb_ld(&bar[XB_XGEN(b.x)]) == gen, bar);
            __builtin_amdgcn_fence(__ATOMIC_ACQUIRE, "agent");
            asm volatile("s_waitcnt vmcnt(0)" ::: "memory");
        }
    }
    __syncthreads();
}

constexpr size_t MiB = 1u << 20;
constexpr size_t WS_CTL = 0, CTL_ZERO_BYTES = 1 * MiB;
constexpr size_t WS_WIN = 2 * MiB;
constexpr size_t WS_WOUT = 7 * MiB;
constexpr size_t WS_PGATE = 9 * MiB;
constexpr size_t WS_PPROJ = 13 * MiB;
constexpr size_t WS_RCAT = 14 * MiB;
constexpr size_t WS_RL1 = 20 * MiB;
constexpr size_t WS_RS2 = 28 * MiB;
constexpr size_t WS_RWO = 30 * MiB;
constexpr size_t WS_ROUT = 32 * MiB;
constexpr size_t WS_LRUAGG = 33 * MiB;
constexpr size_t WS_MGU = 38 * MiB;
constexpr size_t WS_MDN = 102 * MiB;
constexpr size_t WS_PB = 134 * MiB;
constexpr size_t WS_ACT = 166 * MiB;
constexpr size_t WS_H0 = WS_ACT;
constexpr size_t WS_QKV = WS_ACT + 128 * MiB;
constexpr size_t WS_O = WS_ACT + 448 * MiB;
constexpr size_t WS_HL = WS_ACT + 576 * MiB, WS_CA = WS_ACT + 640 * MiB;
constexpr size_t WS_H2 = WS_ACT;
constexpr size_t WS_LOG = WS_ACT + 128 * MiB;
constexpr size_t WS_ROUTE = WS_ACT + 144 * MiB;
constexpr size_t WS_HID = WS_ACT + 152 * MiB;
constexpr size_t WS_YS = WS_ACT + 288 * MiB;
constexpr size_t WS_PP = WS_ACT + 128 * MiB;
constexpr size_t WS_HCAT = WS_ACT;
constexpr size_t WS_XR = WS_ACT + 256 * MiB, WS_XK = WS_ACT + 384 * MiB, WS_XV = WS_ACT + 512 * MiB;
constexpr size_t WS_R = WS_ACT + 640 * MiB, WS_K = WS_XR, WS_V = WS_XK;
constexpr size_t WS_MID = WS_ACT + 768 * MiB;
constexpr size_t WS_EW = WS_ACT;
constexpr size_t WS_AA = WS_ACT + 128 * MiB;
constexpr size_t WS_Y = WS_XV;
constexpr size_t WS_END = WS_ACT + 832 * MiB;
static_assert(WS_END <= 1024 * MiB, "workspace map");
constexpr size_t RT_EID = 0, RT_POS = 1 * MiB, RT_GATE = 2 * MiB, RT_ROWTOK = 3 * MiB, RT_ROWGATE = 4 * MiB, RT_SLOT = 5 * MiB;
constexpr int CW_BAR = 4096;
constexpr int CW_CNT0 = 16384, CW_CNT1 = 16384 + 64;

constexpr int RING_BYTES = 131072;
constexpr int LDSCTL_OFF = RING_BYTES, MISC_OFF = LDSCTL_OFF + 320;
constexpr int TB_OFF = RING_BYTES + 1024;
constexpr int RTE_OFF = TB_OFF + 2048;
constexpr int LDS_BYTES = 147456;

constexpr int NWAVES = 8;
__device__ __forceinline__ int lane_id_() { int l; asm volatile("v_mbcnt_lo_u32_b32 %0, -1, 0\n\tv_mbcnt_hi_u32_b32 %0, -1, %0" : "=v"(l)); return l; }
#define TID_ (F.wave * 64 + lane_id_())
#define LANE_ (lane_id_())
struct Frame {
    LAS unsigned char* lds; volatile LAS unsigned* MISC; gu32* ctl;
    int wave, vcu, G;
};

__device__ __forceinline__ void load_row4(const float* xrow, int lane, f32x4 (&v)[4]) { const f32x4* p = (const f32x4*)xrow + lane;
#pragma unroll
    for (int j = 0; j < 4; ++j) v[j] = p[64 * j]; }
__device__ __forceinline__ float row_rstd(const f32x4 (&v)[4], float eps) { float s = 0.f;
#pragma unroll
    for (int j = 0; j < 4; ++j) s += (v[j].x * v[j].x + v[j].y * v[j].y) + (v[j].z * v[j].z + v[j].w * v[j].w);
    return 1.0f / sqrtf(wave_sum(s) * (1.0f / 1024.0f) + eps); }
__device__ __forceinline__ void load_row4_bf(const bf16* xrow, int lane, f32x4 (&v)[4]) { const v2u* p = (const v2u*)xrow + lane;
#pragma unroll
    for (int j = 0; j < 4; ++j) { const v2u w = p[64 * j]; v[j] = (f32x4){bflo(w.x), bfhi(w.x), bflo(w.y), bfhi(w.y)}; } }
__device__ __forceinline__ void store_row4_bf(bf16* xrow, int lane, const f32x4 (&v)[4]) { v2u* p = (v2u*)xrow + lane;
#pragma unroll
    for (int j = 0; j < 4; ++j) { v2u o; o.x = pk2(v[j].x, v[j].y); o.y = pk2(v[j].z, v[j].w); p[64 * j] = o; } }
__device__ __forceinline__ void store_row_bf16(bf16* orow, int lane, const f32x4 (&v)[4], float rstd, const float* g) {
    unsigned long long* o8 = (unsigned long long*)orow + lane;
#pragma unroll
    for (int j = 0; j < 4; ++j) { const f32x4 gg = ((const f32x4*)g)[lane + 64 * j];
        o8[64 * j] = (unsigned long long)pk2(v[j].x * rstd * gg.x, v[j].y * rstd * gg.y) | ((unsigned long long)pk2(v[j].z * rstd * gg.z, v[j].w * rstd * gg.w) << 32); }
}

template <int MODE>
__device__ __forceinline__ void transpose_item(const float* W, int K, int N, bf16* WT, int ldo, int row_off, const float* mu, LAS float* scr, int item, int lane) {
    const int nblk = N / 32, kb = item / nblk, nb = item % nblk, k0 = 64 * kb, n0 = 32 * nb;
    float ld[32];
#pragma unroll
    for (int i = 0; i < 32; ++i) { const int kk = 2 * i + (lane >> 5); ld[i] = W[(size_t)(k0 + kk) * N + n0 + (lane & 31)]; }
#pragma unroll
    for (int i = 0; i < 32; ++i) { const int kk = 2 * i + (lane >> 5); scr[kk * 33 + (lane & 31)] = ld[i]; }
    LDS_WAIT(); asm volatile("" ::: "memory");
    const int c = lane & 7;
    int rbase = row_off + n0;
    if (MODE == 2) { rbase = row_off + ((n0 < 512) ? ((n0 >> 7) * 256 + (n0 & 127)) : (((n0 - 512) >> 7) * 256 + 128 + ((n0 - 512) & 127))); }
    float m[8];
    if (MODE == 1) {
#pragma unroll
        for (int e = 0; e < 8; ++e) m[e] = mu[k0 + 8 * c + e]; }
#pragma unroll
    for (int j = 0; j < 4; ++j) { const int n = (lane >> 3) + 8 * j; const LAS float* s = scr + (8 * c) * 33 + n;
        float v[8];
#pragma unroll
        for (int e = 0; e < 8; ++e) v[e] = s[e * 33];
        bf16* dst = WT + (size_t)(rbase + n) * ldo + k0 + 8 * c;
        if (MODE == 1) {
            v4u o, o2;
            o.x = pk2(v[0] * (1.f - m[0]), v[1] * (1.f - m[1])); o.y = pk2(v[2] * (1.f - m[2]), v[3] * (1.f - m[3])); o.z = pk2(v[4] * (1.f - m[4]), v[5] * (1.f - m[5])); o.w = pk2(v[6] * (1.f - m[6]), v[7] * (1.f - m[7]));
            o2.x = pk2(v[0] * m[0], v[1] * m[1]); o2.y = pk2(v[2] * m[2], v[3] * m[3]); o2.z = pk2(v[4] * m[4], v[5] * m[5]); o2.w = pk2(v[6] * m[6], v[7] * m[7]);
            *(GAS v4u*)dst = o; *(GAS v4u*)(dst + 1024) = o2;
        } else {
            v4u o; o.x = pk2(v[0], v[1]); o.y = pk2(v[2], v[3]); o.z = pk2(v[4], v[5]); o.w = pk2(v[6], v[7]);
            *(GAS v4u*)dst = o; }
    }
    LDS_WAIT(); asm volatile("" ::: "memory");
}

struct In {
    const float *x, *p, *rel_bias, *norm_mix, *ab_w_in, *ab_w_out, *lam_q1, *lam_k1, *lam_q2, *lam_k2, *sub_g, *conv_w, *conv_b, *lru_wa, *lru_ba, *lru_wx, *lru_bx, *lru_lambda,
        *rwkv_mu, *rwkv_wr, *rwkv_wk, *rwkv_wv, *rwkv_wo, *rwkv_w0, *rwkv_w1, *rwkv_w2, *rwkv_a0, *rwkv_a1, *rwkv_a2, *rwkv_g1, *rwkv_g2, *rwkv_kk, *rwkv_ka, *rwkv_rk, *rwkv_ln_g, *rwkv_ln_b,
        *norm_ffn, *moe_wc, *moe_bc, *moe_wf, *moe_bf, *moe_w_gu, *moe_w_down, *ple_norm, *ple_gate, *ple_proj, *final_norm;
};

__device__ __forceinline__ void prep_dense_weights(Frame& F, const In& I, unsigned char* ws) {
    LAS float* scr = (LAS float*)(F.lds + F.wave * 16384);
    const int gw = F.vcu * NWAVES + F.wave, NGW = F.G * NWAVES;
    bf16* WIN = (bf16*)(ws + WS_WIN); bf16* WOUT = (bf16*)(ws + WS_WOUT); bf16* PG = (bf16*)(ws + WS_PGATE); bf16* PPJ = (bf16*)(ws + WS_PPROJ);
    bf16* RCAT = (bf16*)(ws + WS_RCAT); bf16* RL1 = (bf16*)(ws + WS_RL1); bf16* RWO = (bf16*)(ws + WS_RWO);
    constexpr int I_IN = (1024 / 64) * (2560 / 32), I_SQ = (1024 / 64) * (1024 / 32), I_PJ = (256 / 64) * (1024 / 32), I_L64 = (1024 / 64) * (64 / 32), I_L160 = (1024 / 64) * (160 / 32);
    int st = gw;
#define TJOB(MODE, NITEMS, W, K, N, WT, LDO, ROFF, MU) do { for (int it = st; it < (NITEMS); it += NGW) transpose_item<MODE>(W, K, N, WT, LDO, ROFF, MU, scr, it, LANE_); \
        st = (st + NGW - ((NITEMS) % NGW)) % NGW; asm volatile("" : "+s"(st)); } while (0)
    TJOB(0, I_IN, I.ab_w_in, 1024, 2560, WIN, 1024, 0, nullptr);
    TJOB(0, I_SQ, I.ab_w_out, 1024, 1024, WOUT, 1024, 0, nullptr);
    TJOB(0, I_SQ, I.ple_gate, 1024, 1024, PG, 1024, 0, nullptr);
    TJOB(0, I_SQ, I.ple_gate + 1024 * 1024, 1024, 1024, PG + 1024 * 1024, 1024, 0, nullptr);
    TJOB(0, I_SQ, I.rwkv_wo, 1024, 1024, RWO, 1024, 0, nullptr);
    TJOB(0, I_SQ, I.rwkv_wr, 1024, 1024, RCAT, 1024, 0, nullptr);
    TJOB(0, I_SQ, I.rwkv_wk, 1024, 1024, RCAT, 1024, 1024, nullptr);
    TJOB(0, I_SQ, I.rwkv_wv, 1024, 1024, RCAT, 1024, 2048, nullptr);
    TJOB(0, I_PJ, I.ple_proj, 256, 1024, PPJ, 256, 0, nullptr);
    TJOB(0, I_PJ, I.ple_proj + 256 * 1024, 256, 1024, PPJ + 1024 * 256, 256, 0, nullptr);
    TJOB(1, I_L64, I.rwkv_w1, 1024, 64, RL1, 2048, 0, I.rwkv_mu + 1 * 1024);
    TJOB(1, I_L64, I.rwkv_a1, 1024, 64, RL1, 2048, 64, I.rwkv_mu + 4 * 1024);
    TJOB(1, I_L160, I.rwkv_g1, 1024, 160, RL1, 2048, 256, I.rwkv_mu + 5 * 1024);
#undef TJOB
    const int gt = F.vcu * 512 + TID_, NGT = F.G * 512;
    { v4u z = {0u, 0u, 0u, 0u}; const int per_row = 2048 / 8;
      for (int i = gt; i < (128 + 96) * per_row; i += NGT) { int rr = i / per_row, cc = i % per_row; rr = (rr < 128) ? (128 + rr) : (416 + rr - 128); *(GAS v4u*)(RL1 + (size_t)rr * 2048 + cc * 8) = z; } }
    { bf16* S2 = (bf16*)(ws + WS_RS2);
      for (int i = gt; i < 3 * 1024 * 256; i += NGT) { const int ty = i / (1024 * 256), n = (i / 256) & 1023, k = i & 255; float v = 0.f;
          if (ty == 0) { if (k < 64) v = I.rwkv_w2[k * 1024 + n]; } else if (ty == 1) { if (k >= 64 && k < 128) v = I.rwkv_a2[(k - 64) * 1024 + n]; } else { if (k < 160) v = I.rwkv_g2[k * 1024 + n]; }
          S2[i] = (bf16)f2bf(v); } }
    { bf16* RT = (bf16*)(ws + WS_ROUT);
      for (int i = gt; i < 2 * 256 * 1024; i += NGT) { const int l = i / (256 * 1024), n = (i / 1024) & 255, k = i & 1023; float v = 0.f;
          if (n < 4) v = I.moe_wc[(size_t)l * 1024 * 4 + k * 4 + n]; else if (n < 36) v = I.moe_wf[(size_t)l * 1024 * 32 + k * 32 + (n - 4)];
          RT[i] = (bf16)f2bf(v); } }
}
__device__ __forceinline__ void prep_layer_weights(Frame& F, const In& I, unsigned char* ws, int layer) {
    LAS float* scr = (LAS float*)(F.lds + F.wave * 16384);
    const int gw = F.vcu * NWAVES + F.wave, NGW = F.G * NWAVES;
    bf16* MGU = (bf16*)(ws + WS_MGU); bf16* MDN = (bf16*)(ws + WS_MDN);
    const float* wgu = I.moe_w_gu + (size_t)layer * NEXP * 1024 * 1024; const float* wdn = I.moe_w_down + (size_t)layer * NEXP * 512 * 1024;
    constexpr int I_GU = (1024 / 64) * (1024 / 32), I_DN = (512 / 64) * (1024 / 32);
    for (int it = gw; it < NEXP * (I_GU + I_DN); it += NGW) {
        const int e = it / (I_GU + I_DN); int r = it % (I_GU + I_DN);
        if (r < I_GU) transpose_item<2>(wgu + (size_t)e * 1024 * 1024, 1024, 1024, MGU + (size_t)e * 1024 * 1024, 1024, 0, nullptr, scr, r, LANE_);
        else transpose_item<0>(wdn + (size_t)e * 512 * 1024, 512, 1024, MDN + (size_t)e * 1024 * 512, 512, 0, nullptr, scr, r - I_GU, LANE_);
    }
    const int gt = F.vcu * 512 + TID_, NGT = F.G * 512;
    const f32x4* ps = (const f32x4*)(I.p + (size_t)layer * T * PLE); v2u* pd = (v2u*)(ws + WS_PB);
    for (int i = gt; i < T * PLE / 4; i += 4 * NGT) { f32x4 v[4];
#pragma unroll
        for (int r = 0; r < 4; ++r) v[r] = ps[i + r * NGT];
#pragma unroll
        for (int r = 0; r < 4; ++r) { v2u o; o.x = pk2(v[r].x, v[r].y); o.y = pk2(v[r].z, v[r].w); pd[i + r * NGT] = o; } }
}

template <bool XBF>
__device__ __forceinline__ void norm_pass(Frame& F, const void* x, const float* g, bf16* out) {
    const int gw = F.vcu * NWAVES + F.wave, NGW = F.G * NWAVES; const int lane = LANE_;
    for (int t = 4 * gw; t < T; t += 4 * NGW) {
        f32x4 v[4][4];
#pragma unroll
        for (int r = 0; r < 4; ++r) { if (XBF) load_row4_bf((const bf16*)x + (size_t)(t + r) * D, lane, v[r]); else load_row4((const float*)x + (size_t)(t + r) * D, lane, v[r]); }
#pragma unroll
        for (int r = 0; r < 4; ++r) { const float rs = row_rstd(v[r], 1e-6f); store_row_bf16(out + (size_t)(t + r) * D, lane, v[r], rs, g); }
    }
}
__device__ __forceinline__ void rwkv_input_pass(Frame& F, const bf16* x, const float* g, const float* mu, bf16* HCAT, bf16* XR, bf16* XK, bf16* XV) {
    const int gw = F.vcu * NWAVES + F.wave, NGW = F.G * NWAVES; const int lane = LANE_;
    f32x4 gg[4], mr[4], mk[4], mv[4];
#pragma unroll
    for (int j = 0; j < 4; ++j) { gg[j] = ((const f32x4*)g)[lane + 64 * j]; mr[j] = ((const f32x4*)(mu + 0 * 1024))[lane + 64 * j]; mk[j] = ((const f32x4*)(mu + 2 * 1024))[lane + 64 * j]; mv[j] = ((const f32x4*)(mu + 3 * 1024))[lane + 64 * j]; }
    for (int blk = gw; blk < T / 32; blk += NGW) {
        const int t0 = blk * 32; f32x4 hp[4];
        if ((t0 & (SEQ - 1)) == 0) {
#pragma unroll
            for (int j = 0; j < 4; ++j) hp[j] = (f32x4){0.f, 0.f, 0.f, 0.f};
        } else { f32x4 v[4]; load_row4_bf(x + (size_t)(t0 - 1) * D, lane, v); const float rstd = row_rstd(v, 1e-6f);
#pragma unroll
            for (int j = 0; j < 4; ++j) hp[j] = v[j] * rstd * gg[j]; }
        f32x4 vn[4]; load_row4_bf(x + (size_t)t0 * D, lane, vn);
        for (int t = t0; t < t0 + 32; ++t) {
            f32x4 v[4];
#pragma unroll
            for (int j = 0; j < 4; ++j) v[j] = vn[j];
            if (t + 1 < t0 + 32) load_row4_bf(x + (size_t)(t + 1) * D, lane, vn);
            const float rstd = row_rstd(v, 1e-6f);
            unsigned long long* oh = (unsigned long long*)(HCAT + (size_t)t * 2048) + lane; unsigned long long* or_ = (unsigned long long*)(XR + (size_t)t * 1024) + lane;
            unsigned long long* ok = (unsigned long long*)(XK + (size_t)t * 1024) + lane; unsigned long long* ov = (unsigned long long*)(XV + (size_t)t * 1024) + lane;
#pragma unroll
            for (int j = 0; j < 4; ++j) { const f32x4 h = v[j] * rstd * gg[j], dd = hp[j] - h;
                oh[64 * j] = (unsigned long long)pk2(h.x, h.y) | ((unsigned long long)pk2(h.z, h.w) << 32);
                oh[256 + 64 * j] = (unsigned long long)pk2(hp[j].x, hp[j].y) | ((unsigned long long)pk2(hp[j].z, hp[j].w) << 32);
                const f32x4 a = h + dd * mr[j], b = h + dd * mk[j], c = h + dd * mv[j];
                or_[64 * j] = (unsigned long long)pk2(a.x, a.y) | ((unsigned long long)pk2(a.z, a.w) << 32);
                ok[64 * j] = (unsigned long long)pk2(b.x, b.y) | ((unsigned long long)pk2(b.z, b.w) << 32);
                ov[64 * j] = (unsigned long long)pk2(c.x, c.y) | ((unsigned long long)pk2(c.z, c.w) << 32);
                hp[j] = h; }
        }
    }
}
__device__ __forceinline__ void combine_norm_pass(Frame& F, const bf16* xin, bf16* xout, const bf16* YS, const int* slot, const float* g, bf16* out) {
    const int gw = F.vcu * NWAVES + F.wave, NGW = F.G * NWAVES; const int lane = LANE_;
    for (int t = 2 * gw; t < T; t += 2 * NGW) {
        f32x4 v[2][4]; v2u ya[2][4], yb[2][4];
#pragma unroll
        for (int r = 0; r < 2; ++r) { load_row4_bf(xin + (size_t)(t + r) * D, lane, v[r]);
            const int s0 = slot[2 * (t + r)], s1 = slot[2 * (t + r) + 1];
            const v2u* y0 = (const v2u*)(YS + (size_t)s0 * D) + lane; const v2u* y1 = (const v2u*)(YS + (size_t)s1 * D) + lane;
#pragma unroll
            for (int j = 0; j < 4; ++j) { ya[r][j] = y0[64 * j]; yb[r][j] = y1[64 * j]; } }
#pragma unroll
        for (int r = 0; r < 2; ++r) {
#pragma unroll
            for (int j = 0; j < 4; ++j) { const v2u a = ya[r][j], b = yb[r][j];
                v[r][j].x += bflo(a.x) + bflo(b.x); v[r][j].y += bfhi(a.x) + bfhi(b.x); v[r][j].z += bflo(a.y) + bflo(b.y); v[r][j].w += bfhi(a.y) + bfhi(b.y); }
            store_row4_bf(xout + (size_t)(t + r) * D, lane, v[r]);
            const float rstd = row_rstd(v[r], 1e-6f);
            store_row_bf16(out + (size_t)(t + r) * D, lane, v[r], rstd, g); }
    }
}
__device__ __forceinline__ void final_norm_pass(Frame& F, const bf16* x, float* out, const float* g) {
    const int gw = F.vcu * NWAVES + F.wave, NGW = F.G * NWAVES; const int lane = LANE_;
    for (int t = 4 * gw; t < T; t += 4 * NGW) {
        f32x4 v[4][4];
#pragma unroll
        for (int r = 0; r < 4; ++r) load_row4_bf(x + (size_t)(t + r) * D, lane, v[r]);
#pragma unroll
        for (int r = 0; r < 4; ++r) { const float rs = row_rstd(v[r], 1e-6f); f32x4* xo = (f32x4*)(out + (size_t)(t + r) * D) + lane;
#pragma unroll
            for (int j = 0; j < 4; ++j) { const f32x4 gg = ((const f32x4*)g)[lane + 64 * j]; xo[64 * j] = v[r][j] * rs * gg; } }
    }
}

__device__ __forceinline__ void diff_combine_pass(Frame& F, const In& I, const bf16* O, bf16* YCAT) {
    const int gw = F.vcu * NWAVES + F.wave, NGW = F.G * NWAVES;
    const float lam_init = 0.2f;
    const float d1 = wave_sum(I.lam_q1[LANE_] * I.lam_k1[LANE_]), d2 = wave_sum(I.lam_q2[LANE_] * I.lam_k2[LANE_]);
    const float lam = expf(d1) - expf(d2) + lam_init;
    const int h = LANE_ >> 4, q = LANE_ & 15;
    float sg[8];
#pragma unroll
    for (int e = 0; e < 8; ++e) sg[e] = I.sub_g[q * 8 + e] * (1.0f - lam_init);
    for (int t0 = 4 * gw; t0 < T; t0 += 4 * NGW) {
        v4u av[4], bv[4];
#pragma unroll
        for (int r = 0; r < 4; ++r) { av[r] = *(const v4u*)(O + (size_t)(t0 + r) * 1024 + h * 256 + q * 8); bv[r] = *(const v4u*)(O + (size_t)(t0 + r) * 1024 + h * 256 + 128 + q * 8); }
#pragma unroll
        for (int r = 0; r < 4; ++r) { const v4u a = av[r], b = bv[r]; const int t = t0 + r;
        float o[8];
        o[0] = bflo(a.x) - lam * bflo(b.x); o[1] = bfhi(a.x) - lam * bfhi(b.x); o[2] = bflo(a.y) - lam * bflo(b.y); o[3] = bfhi(a.y) - lam * bfhi(b.y);
        o[4] = bflo(a.z) - lam * bflo(b.z); o[5] = bfhi(a.z) - lam * bfhi(b.z); o[6] = bflo(a.w) - lam * bflo(b.w); o[7] = bfhi(a.w) - lam * bfhi(b.w);
        float s = 0.f;
#pragma unroll
        for (int e = 0; e < 8; ++e) s += o[e] * o[e];
        s += __shfl_xor(s, 1); s += __shfl_xor(s, 2); s += __shfl_xor(s, 4); s += __shfl_xor(s, 8);
        const float rstd = 1.0f / sqrtf(s * (1.0f / 128.0f) + 1e-5f);
        v4u w; w.x = pk2(o[0] * rstd * sg[0], o[1] * rstd * sg[1]); w.y = pk2(o[2] * rstd * sg[2], o[3] * rstd * sg[3]); w.z = pk2(o[4] * rstd * sg[4], o[5] * rstd * sg[5]); w.w = pk2(o[6] * rstd * sg[6], o[7] * rstd * sg[7]);
        *(v4u*)(YCAT + (size_t)t * 1024 + h * 128 + q * 8) = w; }
    }
}

constexpr int LCT = 64, LNCH = SEQ / LCT;
__device__ __forceinline__ float gelu_tanh(float x) { const float u = 0.7978845608028654f * (x + 0.044715f * x * x * x); return x * sigmoidf_(2.0f * u); }
template <bool FINAL>
__device__ __forceinline__ void lru_phase(Frame& F, const In& I, const bf16* XB, const bf16* GB, f32x2* AGG, bf16* YCAT, bf16* HLp, bf16* CAp) {
    const int ch = TID_, n = ch >> 6, d = ch & 63;
    LAS float* U = (LAS float*)F.lds;
    f32x2 wg[64];
#pragma unroll
    for (int c = 0; c < 64; ++c) { wg[c].x = I.lru_wa[n * 4096 + c * 64 + d]; wg[c].y = I.lru_wx[n * 4096 + c * 64 + d]; }
    const float cw0 = I.conv_w[0 * 512 + ch], cw1 = I.conv_w[1 * 512 + ch], cw2 = I.conv_w[2 * 512 + ch], cw3 = I.conv_w[3 * 512 + ch], cb = I.conv_b[ch];
    const float ba = I.lru_ba[ch], bx = I.lru_bx[ch];
    const float lam = I.lru_lambda[ch]; const float sp = (lam > 15.f) ? expf(-lam) : log1pf(expf(-lam));
    const float m8sp = -8.0f * sp;
    for (int un = blockIdx.x; un < NB * LNCH; un += F.G) {
        const int b = un / LNCH, c = un % LNCH; const size_t row0 = (size_t)b * SEQ + (size_t)c * LCT;
        unsigned short xraw[LCT + 3];
        if (c > 0) { xraw[0] = XB[(row0 - 3) * 512 + ch]; xraw[1] = XB[(row0 - 2) * 512 + ch]; xraw[2] = XB[(row0 - 1) * 512 + ch]; } else { xraw[0] = 0; xraw[1] = 0; xraw[2] = 0; }
#pragma unroll
        for (int tk = 0; tk < LCT; ++tk) xraw[3 + tk] = XB[(row0 + tk) * 512 + ch];
        float h = 0.f, Ap = 1.f;
        if (FINAL) { for (int j = 0; j < c; ++j) { const f32x2 ag = AGG[((size_t)b * LNCH + j) * 512 + ch]; h = ag.x * h + ag.y; } }
#pragma unroll
        for (int tk = 0; tk < LCT; ++tk) U[tk * 512 + ch] = cw0 * bf1(xraw[tk]) + cw1 * bf1(xraw[tk + 1]) + cw2 * bf1(xraw[tk + 2]) + cw3 * bf1(xraw[tk + 3]) + cb;
        __syncthreads();
        unsigned short gcur[8], gnxt[8];
        if (FINAL) {
#pragma unroll
            for (int j = 0; j < 8; ++j) gcur[j] = GB[(row0 + j) * 512 + ch]; }
#pragma unroll 1
        for (int tg = 0; tg < LCT / 8; ++tg) {
            if (FINAL) { const int tn = (tg + 1 < LCT / 8) ? (tg + 1) * 8 : tg * 8;
#pragma unroll
                for (int j = 0; j < 8; ++j) gnxt[j] = GB[(row0 + tn + j) * 512 + ch]; }
#pragma unroll
            for (int j = 0; j < 8; ++j) { const int tk = tg * 8 + j;
                const LAS f32x4* up = (const LAS f32x4*)(U + tk * 512 + n * 64);
                f32x2 acc = {ba, bx};
#pragma unroll
                for (int c4 = 0; c4 < 16; ++c4) { const f32x4 uu = up[c4];
                    acc += wg[4 * c4 + 0] * uu.x; acc += wg[4 * c4 + 1] * uu.y; acc += wg[4 * c4 + 2] * uu.z; acc += wg[4 * c4 + 3] * uu.w; }
                const float r = sigmoidf_(acc.x), ig = sigmoidf_(acc.y);
                const float la = r * m8sp; const float a = __expf(la); const float t2 = 2.0f * la; const float om = (t2 > -0.02f) ? -t2 * (1.0f + t2 * (0.5f + t2 * (0.16666667f + t2 * 0.041666668f))) : 1.0f - a * a; const float bb = __builtin_amdgcn_sqrtf(om) * (ig * U[tk * 512 + ch]);
                h = a * h + bb;
                if (FINAL) { YCAT[(row0 + tk) * 1024 + 512 + ch] = (bf16)f2bf(h * gelu_tanh(bf1(gcur[j]))); }
                else { Ap *= a; HLp[(row0 + tk) * 512 + ch] = (bf16)f2bf(h); CAp[(row0 + tk) * 512 + ch] = (bf16)f2bf(Ap); } }
            if (FINAL) {
#pragma unroll
                for (int j = 0; j < 8; ++j) gcur[j] = gnxt[j]; }
        }
        if (!FINAL) { f32x2 ag; ag.x = Ap; ag.y = h; AGG[((size_t)b * LNCH + c) * 512 + ch] = ag; }
        __syncthreads();
    }
}

__device__ __forceinline__ void lru_agg_mfma(Frame& F, const In& I, const bf16* XB, f32x2* AGG, bf16* HLp, bf16* CAp) {
    const int tid = TID_, lane = tid & 63, fr = lane & 15, fq = lane >> 4, n = F.wave, ch = tid;
    constexpr int UP = 520;
    LAS bf16* U = (LAS bf16*)F.lds;
    bf16x8 Wr[4][2], Wi[4][2];
#pragma unroll
    for (int dd = 0; dd < 4; ++dd)
#pragma unroll
        for (int kh = 0; kh < 2; ++kh) { unsigned pr_[4], pi_[4];
#pragma unroll
            for (int j = 0; j < 4; ++j) { const int c0 = 32 * kh + 8 * fq + 2 * j, d = 16 * dd + fr;
                pr_[j] = pk2(I.lru_wa[n * 4096 + c0 * 64 + d], I.lru_wa[n * 4096 + (c0 + 1) * 64 + d]); pi_[j] = pk2(I.lru_wx[n * 4096 + c0 * 64 + d], I.lru_wx[n * 4096 + (c0 + 1) * 64 + d]); }
            Wr[dd][kh] = __builtin_bit_cast(bf16x8, (v4u){pr_[0], pr_[1], pr_[2], pr_[3]}); Wi[dd][kh] = __builtin_bit_cast(bf16x8, (v4u){pi_[0], pi_[1], pi_[2], pi_[3]}); }
    float cba[4], cbx[4], cm8[4];
#pragma unroll
    for (int dd = 0; dd < 4; ++dd) { const int chd = 64 * n + 16 * dd + fr; cba[dd] = I.lru_ba[chd]; cbx[dd] = I.lru_bx[chd];
        const float lam = I.lru_lambda[chd]; cm8[dd] = -8.0f * ((lam > 15.f) ? expf(-lam) : log1pf(expf(-lam))); }
    const float cw0 = I.conv_w[0 * 512 + ch], cw1 = I.conv_w[1 * 512 + ch], cw2 = I.conv_w[2 * 512 + ch], cw3 = I.conv_w[3 * 512 + ch], cb = I.conv_b[ch];
    for (int un = blockIdx.x; un < NB * LNCH; un += F.G) {
        const int b = un / LNCH, c = un % LNCH; const size_t row0 = (size_t)b * SEQ + (size_t)c * LCT;
        unsigned short xraw[LCT + 3];
        if (c > 0) { xraw[0] = XB[(row0 - 3) * 512 + ch]; xraw[1] = XB[(row0 - 2) * 512 + ch]; xraw[2] = XB[(row0 - 1) * 512 + ch]; } else { xraw[0] = 0; xraw[1] = 0; xraw[2] = 0; }
#pragma unroll
        for (int tk = 0; tk < LCT; ++tk) xraw[3 + tk] = XB[(row0 + tk) * 512 + ch];
#pragma unroll
        for (int tk = 0; tk < LCT; ++tk) U[tk * UP + ch] = (bf16)f2bf(cw0 * bf1(xraw[tk]) + cw1 * bf1(xraw[tk + 1]) + cw2 * bf1(xraw[tk + 2]) + cw3 * bf1(xraw[tk + 3]) + cb);
        __syncthreads();
        bf16x8 X[4][2];
#pragma unroll
        for (int tt = 0; tt < 4; ++tt)
#pragma unroll
            for (int kh = 0; kh < 2; ++kh) X[tt][kh] = *(const LAS bf16x8*)(U + (16 * tt + fr) * UP + 64 * n + 32 * kh + 8 * fq);
#pragma unroll 1
        for (int dd = 0; dd < 4; ++dd) {
            bf16x8 wr0, wr1, wi0, wi1; float kba, kbx, km8;
            if (dd == 0) { wr0 = Wr[0][0]; wr1 = Wr[0][1]; wi0 = Wi[0][0]; wi1 = Wi[0][1]; kba = cba[0]; kbx = cbx[0]; km8 = cm8[0]; }
            else if (dd == 1) { wr0 = Wr[1][0]; wr1 = Wr[1][1]; wi0 = Wi[1][0]; wi1 = Wi[1][1]; kba = cba[1]; kbx = cbx[1]; km8 = cm8[1]; }
            else if (dd == 2) { wr0 = Wr[2][0]; wr1 = Wr[2][1]; wi0 = Wi[2][0]; wi1 = Wi[2][1]; kba = cba[2]; kbx = cbx[2]; km8 = cm8[2]; }
            else { wr0 = Wr[3][0]; wr1 = Wr[3][1]; wi0 = Wi[3][0]; wi1 = Wi[3][1]; kba = cba[3]; kbx = cbx[3]; km8 = cm8[3]; }
            const int chd = 64 * n + 16 * dd + fr;
            float hc = 0.f, Ac = 1.f;
#pragma unroll
            for (int tt = 0; tt < 4; ++tt) {
                f32x4 pr = (f32x4){0.f, 0.f, 0.f, 0.f}, pi = pr;
                pr = __builtin_amdgcn_mfma_f32_16x16x32_bf16(X[tt][0], wr0, pr, 0, 0, 0); pr = __builtin_amdgcn_mfma_f32_16x16x32_bf16(X[tt][1], wr1, pr, 0, 0, 0);
                pi = __builtin_amdgcn_mfma_f32_16x16x32_bf16(X[tt][0], wi0, pi, 0, 0, 0); pi = __builtin_amdgcn_mfma_f32_16x16x32_bf16(X[tt][1], wi1, pi, 0, 0, 0);
                float a[4], bb[4];
#pragma unroll
                for (int e = 0; e < 4; ++e) { const int tok = 16 * tt + 4 * fq + e; const float u = bf1(U[tok * UP + chd]);
                    const float r = sigmoidf_(pr[e] + kba), ig = sigmoidf_(pi[e] + kbx); const float la = r * km8; a[e] = __expf(la); const float t2 = 2.0f * la;
                    const float om = (t2 > -0.02f) ? -t2 * (1.0f + t2 * (0.5f + t2 * (0.16666667f + t2 * 0.041666668f))) : 1.0f - a[e] * a[e]; bb[e] = __builtin_amdgcn_sqrtf(om) * (ig * u); }
                const float A4 = (a[0] * a[1]) * (a[2] * a[3]); const float B4 = ((bb[0] * a[1] + bb[1]) * a[2] + bb[2]) * a[3] + bb[3];
                float h = hc, Ap = Ac, hs = hc, As = Ac;
#pragma unroll
                for (int j = 0; j < 4; ++j) { const float Aj = __shfl(A4, fr + 16 * j), Bj = __shfl(B4, fr + 16 * j); if (j == fq) { hs = h; As = Ap; } h = Aj * h + Bj; Ap *= Aj; }
                hc = h; Ac = Ap; h = hs; Ap = As;
#pragma unroll
                for (int e = 0; e < 4; ++e) { h = a[e] * h + bb[e]; Ap *= a[e]; const size_t o = (row0 + 16 * tt + 4 * fq + e) * 512 + chd; HLp[o] = (bf16)f2bf(h); CAp[o] = (bf16)f2bf(Ap); }
            }
            if (fq == 0) { f32x2 ag; ag.x = Ac; ag.y = hc; AGG[((size_t)b * LNCH + c) * 512 + chd] = ag; }
        }
        __syncthreads();
    }
}

__device__ __forceinline__ void lru_final_pass(Frame& F, const bf16* HLp, const bf16* CAp, const bf16* GB, const f32x2* AGG, bf16* YCAT) {
    const int ch = TID_;
    for (int un = blockIdx.x; un < NB * LNCH; un += F.G) {
        const int b = un / LNCH, c = un % LNCH; const size_t row0 = (size_t)b * SEQ + (size_t)c * LCT;
        float carry = 0.f;
        for (int j = 0; j < c; ++j) { const f32x2 ag = AGG[((size_t)b * LNCH + j) * 512 + ch]; carry = ag.x * carry + ag.y; }
#pragma unroll 4
        for (int t8 = 0; t8 < LCT; t8 += 8) {
            bf16 hl[8], ca[8], gv[8];
#pragma unroll
            for (int j = 0; j < 8; ++j) { const size_t o = (row0 + t8 + j) * 512 + ch; hl[j] = HLp[o]; ca[j] = CAp[o]; gv[j] = GB[o]; }
#pragma unroll
            for (int j = 0; j < 8; ++j) { const float h = bf1(hl[j]) + bf1(ca[j]) * carry; YCAT[(row0 + t8 + j) * 1024 + 512 + ch] = (bf16)f2bf(h * gelu_tanh(bf1(gv[j]))); }
        }
    }
}

__device__ __forceinline__ void route_pass_a(Frame& F, const In& I, int layer, const float* LOG, unsigned char* rt, gu32* cnt) {
    LAS int* lcnt = (LAS int*)(F.lds + RTE_OFF); LAS int* lbase = lcnt + 32;
    int* EID = (int*)(rt + RT_EID); int* POS = (int*)(rt + RT_POS); float* GATE = (float*)(rt + RT_GATE);
    const float* bc = I.moe_bc + layer * 4; const float* bfb = I.moe_bf + layer * 32;
    for (int un = blockIdx.x; un < T / 512; un += F.G) {
        if (TID_ < 32) lcnt[TID_] = 0;
        __syncthreads();
        const int t = un * 512 + TID_; const float* lg = LOG + (size_t)t * 64;
        const f32x4 g4 = *(const f32x4*)lg;
        float gl[4] = {g4.x + bc[0], g4.y + bc[1], g4.z + bc[2], g4.w + bc[3]};
        int gi = 0; float gm = gl[0];
#pragma unroll
        for (int j = 1; j < 4; ++j) if (gl[j] > gm) { gm = gl[j]; gi = j; }
        float gs = 0.f;
#pragma unroll
        for (int j = 0; j < 4; ++j) gs += __expf(gl[j] - gm);
        const float gprob = 1.0f / gs;
        const f32x4 e0 = *(const f32x4*)(lg + 4 + gi * 8), e1 = *(const f32x4*)(lg + 8 + gi * 8);
        float el[8] = {e0.x, e0.y, e0.z, e0.w, e1.x, e1.y, e1.z, e1.w};
#pragma unroll
        for (int j = 0; j < 8; ++j) el[j] += bfb[gi * 8 + j];
        int i0 = 0; float m0 = el[0];
#pragma unroll
        for (int j = 1; j < 8; ++j) if (el[j] > m0) { m0 = el[j]; i0 = j; }
        int i1 = -1; float m1 = -INFINITY;
#pragma unroll
        for (int j = 0; j < 8; ++j) if (j != i0 && el[j] > m1) { m1 = el[j]; i1 = j; }
        const float r1 = __expf(m1 - m0); const float g0 = gprob / (1.0f + r1), g1 = gprob * r1 / (1.0f + r1);
        const int ex0 = gi * 8 + i0, ex1 = gi * 8 + i1;
        const int p0 = atomicAdd((int*)&lcnt[ex0], 1), p1 = atomicAdd((int*)&lcnt[ex1], 1);
        __syncthreads();
        if (TID_ < 32) lbase[TID_] = (int)__hip_atomic_fetch_add(cnt + TID_, (unsigned)lcnt[TID_], RLX_AGENT);
        __syncthreads();
        EID[2 * t] = ex0; EID[2 * t + 1] = ex1; POS[2 * t] = lbase[ex0] + p0; POS[2 * t + 1] = lbase[ex1] + p1; GATE[2 * t] = g0; GATE[2 * t + 1] = g1;
        __syncthreads();
    }
}
__device__ __forceinline__ void route_bases(Frame& F, gu32* cnt) {
    LAS int* eb = (LAS int*)(F.lds + RTE_OFF + 512);
    const int tid = TID_;
    if (tid < 64) {
        const int c = (tid < 32) ? (int)__hip_atomic_load(cnt + (tid & 31), RLX_AGENT) : 0; const int p = (c + 255) & ~255; int s = p;
#pragma unroll
        for (int o = 1; o < 32; o <<= 1) { const int t = __shfl_up(s, o); if ((tid & 63) >= o) s += t; }
        if (tid < 32) { eb[tid] = s - p; if (tid == 31) eb[32] = s; }
    }
    __syncthreads();
}
__device__ __forceinline__ void route_pass_b(Frame& F, unsigned char* rt, gu32* cnt) {
    route_bases(F, cnt);
    LAS int* eb = (LAS int*)(F.lds + RTE_OFF + 512);
    const int* EID = (const int*)(rt + RT_EID); const int* POS = (const int*)(rt + RT_POS); const float* GATE = (const float*)(rt + RT_GATE);
    int* ROWTOK = (int*)(rt + RT_ROWTOK); float* ROWGATE = (float*)(rt + RT_ROWGATE); int* SLOT = (int*)(rt + RT_SLOT);
    const int gt = F.vcu * 512 + TID_, NGT = F.G * 512;
    for (int i = gt; i < 2 * T; i += NGT) { const int dst = eb[EID[i]] + POS[i]; ROWTOK[dst] = i >> 1; ROWGATE[dst] = GATE[i]; SLOT[i] = dst; }
    for (int i = gt; i < 32 * 256; i += NGT) { const int e = i >> 8, j = i & 255; const int c = (int)__hip_atomic_load(cnt + e, RLX_AGENT); const int pad = ((c + 255) & ~255) - c;
        if (j < pad) { ROWTOK[eb[e] + c + j] = 0; ROWGATE[eb[e] + c + j] = 0.f; } }
    __syncthreads();
}
struct MoeOrder {
    int G, c, ntiles; const LAS int* eb; const char* A; const char* W; size_t astep, wexp, wtile; bool gather;
    __device__ bool next(int i, pg8::Unit& u) const {
        const int L = i * G + c; if (L >= ntiles * 4) return false;
        u.pm = L >> 2; u.pn = L & 3; const int s0 = u.pm * 256; int e = 0;
#pragma unroll 1
        for (int j = 1; j < 32; ++j) if (eb[j] <= s0) e = j;
        e = __builtin_amdgcn_readfirstlane(e); u.aux = e; u.A = gather ? A : A + (size_t)u.pm * astep; u.B = W + (size_t)e * wexp + (size_t)u.pn * wtile; return true;
    }
};

constexpr int RTC = 32, RNCH = SEQ / RTC, RTOK = 352;
#define LBAR() do { asm volatile("s_waitcnt lgkmcnt(0)" ::: "memory"); __builtin_amdgcn_s_barrier(); asm volatile("" ::: "memory"); } while (0)
template <int CTRL> __device__ __forceinline__ float dpp_f(float v) { return __builtin_bit_cast(float, __builtin_amdgcn_update_dpp(0, __builtin_bit_cast(int, v), CTRL, 0xf, 0xf, true)); }
__device__ __forceinline__ float red16(float v) { v += dpp_f<0xB1>(v); v += dpp_f<0x4E>(v); v += dpp_f<0x141>(v); v += dpp_f<0x140>(v); return v; }
__device__ __forceinline__ float red8(float v) { v += dpp_f<0xB1>(v); v += dpp_f<0x4E>(v); v += dpp_f<0x141>(v); return v; }
__device__ __forceinline__ void unpack8(const v4u w, float (&f)[8]) { f[0] = bflo(w.x); f[1] = bfhi(w.x); f[2] = bflo(w.y); f[3] = bfhi(w.y); f[4] = bflo(w.z); f[5] = bfhi(w.z); f[6] = bflo(w.w); f[7] = bfhi(w.w); }
__device__ __forceinline__ void rwkv_scan_phase(Frame& F, const In& I, const bf16* R, const bf16* Kt, const bf16* V, const bf16* AA, const bf16* EW, bf16* Y) {
    LAS float* buf = (LAS float*)F.lds;
    LAS float* ybuf = (LAS float*)(F.lds + 2 * RTC * RTOK * 4) + 32;
    const int tid = TID_, lane = tid & 63;
    const int seg = lane & 15, rl = F.wave * 4 + (lane >> 4);
    const int stk = tid >> 4, ssg = tid & 15;
    for (int un = blockIdx.x; un < NB * 16 * 2; un += F.G) {
        const int half = un & 1, h = (un >> 1) & 15, b = un >> 5;
        const size_t rowb = (size_t)b * SEQ;
        const int col = h * 64 + ssg * 4;
        const f32x4 kkw = *(const f32x4*)(I.rwkv_kk + col), kaw = *(const f32x4*)(I.rwkv_ka + col);
        v2u rr, kr, vr, ar, er;
#define RAW_LOAD(cc) do { const size_t off = (rowb + (size_t)(cc) * RTC + stk) * 1024 + col; rr = *(const v2u*)(R + off); kr = *(const v2u*)(Kt + off); vr = *(const v2u*)(V + off); ar = *(const v2u*)(AA + off); er = *(const v2u*)(EW + off); } while (0)
#define RAW_CONVERT(cc) do { LAS float* tp = buf + ((cc) & 1) * (RTC * RTOK) + stk * RTOK + ssg * 4; \
            const float r0 = bflo(rr.x), r1 = bfhi(rr.x), r2 = bflo(rr.y), r3 = bfhi(rr.y), k0 = bflo(kr.x), k1 = bfhi(kr.x), k2 = bflo(kr.y), k3 = bfhi(kr.y); \
            const float a0 = bflo(ar.x), a1 = bfhi(ar.x), a2 = bflo(ar.y), a3 = bfhi(ar.y); \
            const float x0 = k0 * kkw.x, x1 = k1 * kkw.y, x2 = k2 * kkw.z, x3 = k3 * kkw.w; \
            const float ss = red16((x0 * x0 + x1 * x1) + (x2 * x2 + x3 * x3)); const float inv = __builtin_amdgcn_rsqf(fmaxf(ss, 1e-24f)); \
            *(LAS f32x4*)(tp) = (f32x4){__expf(-bflo(er.x)), __expf(-bfhi(er.x)), __expf(-bflo(er.y)), __expf(-bfhi(er.y))}; \
            const f32x4 kkv = (f32x4){x0 * inv, x1 * inv, x2 * inv, x3 * inv}; *(LAS f32x4*)(tp + 64) = kkv; \
            *(LAS f32x4*)(tp + 128) = (f32x4){kkv.x * a0, kkv.y * a1, kkv.z * a2, kkv.w * a3}; \
            *(LAS f32x4*)(tp + 192) = (f32x4){k0 * (1.0f + (a0 - 1.0f) * kaw.x), k1 * (1.0f + (a1 - 1.0f) * kaw.y), k2 * (1.0f + (a2 - 1.0f) * kaw.z), k3 * (1.0f + (a3 - 1.0f) * kaw.w)}; \
            *(LAS f32x4*)(tp + 256) = (f32x4){r0, r1, r2, r3}; \
            if ((ssg >> 3) == half) *(LAS f32x4*)(buf + ((cc) & 1) * (RTC * RTOK) + stk * RTOK + 320 + (ssg & 7) * 4) = (f32x4){bflo(vr.x), bfhi(vr.x), bflo(vr.y), bfhi(vr.y)}; } while (0)
#define Y_WRITE(cc) do { const LAS f32x2* yp = (const LAS f32x2*)(ybuf + ((cc) & 1) * (RTC * 32 + 32) + stk * 32 + ssg * 2); const f32x2 yv = *yp; \
            *(unsigned*)(Y + (rowb + (size_t)(cc) * RTC + stk) * 1024 + h * 64 + half * 32 + ssg * 2) = pk2(yv.x, yv.y); } while (0)
        RAW_LOAD(0); RAW_CONVERT(0); RAW_LOAD(1);
        f32x2 S0 = (f32x2){0.f, 0.f}, S1 = (f32x2){0.f, 0.f};
        LBAR();
        for (int c = 0; c < RNCH; ++c) {
            if (c + 1 < RNCH) { RAW_CONVERT(c + 1); }
            if (c + 2 < RNCH) { RAW_LOAD(c + 2); }
            if (c >= 1) { Y_WRITE(c - 1); }
            const LAS float* cb = buf + (c & 1) * (RTC * RTOK); LAS float* yb = ybuf + (c & 1) * (RTC * 32 + 32);
            const LAS float* tp0 = cb + seg * 4; const LAS float* vp0 = cb + 320 + rl;
#define SV_DECL(X) f32x4 X##w, X##q, X##b, X##k, X##r; float X##v
#define SV_LOAD(X, tk) do { const LAS float* tp = tp0 + (tk) * RTOK; \
                X##w = *(const LAS f32x4*)(tp); X##q = *(const LAS f32x4*)(tp + 64); X##b = *(const LAS f32x4*)(tp + 128); X##k = *(const LAS f32x4*)(tp + 192); X##r = *(const LAS f32x4*)(tp + 256); X##v = vp0[(tk) * RTOK]; } while (0)
#define SV_STEP(X, tk) do { \
                const f32x2 d = S0 * (f32x2){X##q.x, X##q.y} + S1 * (f32x2){X##q.z, X##q.w}; \
                const f32x2 t0 = S0 * (f32x2){X##w.x, X##w.y} + (f32x2){X##k.x, X##k.y} * X##v, t1 = S1 * (f32x2){X##w.z, X##w.w} + (f32x2){X##k.z, X##k.w} * X##v; \
                float ra = d.x + d.y, rb = epend;                   \
                ra += dpp_f<0xB1>(ra); rb += dpp_f<0xB1>(rb); ra += dpp_f<0x4E>(ra); rb += dpp_f<0x4E>(rb); ra += dpp_f<0x141>(ra); rb += dpp_f<0x141>(rb); ra += dpp_f<0x140>(ra); rb += dpp_f<0x140>(rb); \
                if (seg == 0) yb[((tk) - 1) * 32 + rl] = rb;        \
                const float sa = -ra; \
                S0 = t0 + (f32x2){X##b.x, X##b.y} * sa; S1 = t1 + (f32x2){X##b.z, X##b.w} * sa; \
                const f32x2 e = S0 * (f32x2){X##r.x, X##r.y} + S1 * (f32x2){X##r.z, X##r.w}; epend = e.x + e.y; } while (0)
            SV_DECL(A_); SV_DECL(B_); float epend = 0.f;
            SV_LOAD(A_, 0);
#pragma unroll 1
            for (int tk = 0; tk < RTC; tk += 2) {
                SV_LOAD(B_, tk + 1);
                SV_STEP(A_, tk);
                { const int t2 = (tk + 2 < RTC) ? tk + 2 : RTC - 1; SV_LOAD(A_, t2); }
                SV_STEP(B_, tk + 1);
            }
#undef SV_DECL
#undef SV_LOAD
#undef SV_STEP
            { const float rb = red16(epend); if (seg == 0) yb[(RTC - 1) * 32 + rl] = rb; }
            LBAR();
        }
        Y_WRITE(RNCH - 1);
        LBAR();
#undef RAW_LOAD
#undef RAW_CONVERT
#undef Y_WRITE
    }
}
constexpr int GS_QT = 0, GS_RT = 2048, GS_BHT = 4096, GS_KHT = 6144, GS_VT = 8192, GS_TM = 10240, GS_TL = 10752, GS_MK = 11264, GS_NK = 11776, GS_NB = 12288, GS_DD = 12800, GS_SLOT = 13056;
constexpr int GS_KT = GS_KHT, GS_BT = GS_BHT, GS_MB = GS_TM;
constexpr int CH_NP = 5, CH_ROUNDS = (512 + CH_NP - 1) / CH_NP;
static_assert(2 * CH_NP * GS_SLOT <= 131072, "chunked-scan LDS map");
template <int N> __device__ __forceinline__ float dpp_shr(float v) { return __builtin_bit_cast(float, __builtin_amdgcn_update_dpp(0, __builtin_bit_cast(int, v), 0x110 + N, 0xf, 0xf, true)); }
__device__ __forceinline__ bf16x8 mk8(v2u a, v2u b) { return __builtin_bit_cast(bf16x8, (v4u){a.x, a.y, b.x, b.y}); }
__device__ __forceinline__ bf16x8 mk8z(v2u a) { return __builtin_bit_cast(bf16x8, (v4u){a.x, a.y, 0u, 0u}); }
__device__ __forceinline__ bf16x8 cvt8z(f32x4 v) { return __builtin_bit_cast(bf16x8, (v4u){pk2(v.x, v.y), pk2(v.z, v.w), 0u, 0u}); }
__device__ __forceinline__ void chain_step(const LAS unsigned char* C, f32x4 (&Areg)[4], const int vt, const int fr, const int fq, GAS bf16* yrow) {
    const f32x4 zero4 = (f32x4){0.f, 0.f, 0.f, 0.f};
    bf16x8 Aq[2];
#pragma unroll
    for (int kh = 0; kh < 2; ++kh) Aq[kh] = __builtin_bit_cast(bf16x8, (v4u){pk2(Areg[2 * kh].x, Areg[2 * kh].y), pk2(Areg[2 * kh].z, Areg[2 * kh].w), pk2(Areg[2 * kh + 1].x, Areg[2 * kh + 1].y), pk2(Areg[2 * kh + 1].z, Areg[2 * kh + 1].w)});
    f32x4 X = zero4, YA = zero4;
#pragma unroll
    for (int kh = 0; kh < 2; ++kh) { const int o = (fr * 64 + 32 * kh + 4 * fq) * 2;
        const bf16x8 Pq = mk8(*(const LAS v2u*)(C + GS_QT + o), *(const LAS v2u*)(C + GS_QT + o + 32)), Pr = mk8(*(const LAS v2u*)(C + GS_RT + o), *(const LAS v2u*)(C + GS_RT + o + 32));
        X = __builtin_amdgcn_mfma_f32_16x16x32_bf16(Pq, Aq[kh], X, 0, 0, 0); YA = __builtin_amdgcn_mfma_f32_16x16x32_bf16(Pr, Aq[kh], YA, 0, 0, 0); }
    const bf16x8 Vq = mk8z(*(const LAS v2u*)(C + GS_VT + ((16 * vt + fr) * 16 + 4 * fq) * 2));
    const int om = (fr * 16 + 4 * fq) * 2;
    const bf16x8 Mkp = mk8z(*(const LAS v2u*)(C + GS_MK + om)), Nkp = mk8z(*(const LAS v2u*)(C + GS_NK + om)), Nbp = mk8z(*(const LAS v2u*)(C + GS_NB + om)), Tp = mk8z(*(const LAS v2u*)(C + GS_TM + om)), Tl = mk8z(*(const LAS v2u*)(C + GS_TL + om));
    const f32x4 Z = __builtin_amdgcn_mfma_f32_16x16x32_bf16(Mkp, Vq, X, 0, 0, 0);
    const unsigned zw0 = pk2(Z[0], Z[1]), zw1 = pk2(Z[2], Z[3]);
    const bf16x8 Zhq = __builtin_bit_cast(bf16x8, (v4u){zw0, zw1, 0u, 0u});
    const f32x4 Zl = (f32x4){Z[0] - bflo(zw0), Z[1] - bfhi(zw0), Z[2] - bflo(zw1), Z[3] - bfhi(zw1)};
    f32x4 U = __builtin_amdgcn_mfma_f32_16x16x32_bf16(Tp, cvt8z(Zl), zero4, 0, 0, 0);
    U = __builtin_amdgcn_mfma_f32_16x16x32_bf16(Tl, Zhq, U, 0, 0, 0);
    U = __builtin_amdgcn_mfma_f32_16x16x32_bf16(Tp, Zhq, U, 0, 0, 0);
    const bf16x8 Uq = cvt8z(U);
    f32x4 Yv = __builtin_amdgcn_mfma_f32_16x16x32_bf16(Nkp, Vq, YA, 0, 0, 0);
    const f32x4 Yn = __builtin_amdgcn_mfma_f32_16x16x32_bf16(Nbp, Uq, zero4, 0, 0, 0);
    Yv = Yv - Yn;
#pragma unroll
    for (int e = 0; e < 4; e += 2) { const unsigned yw = pk2(Yv[e], Yv[e + 1]); GAS bf16* yp = yrow + (size_t)(4 * fq + e) * 1024 + 16 * vt + fr; yp[0] = (bf16)(yw & 0xffffu); yp[1024] = (bf16)(yw >> 16); }
#pragma unroll
    for (int jt = 0; jt < 4; ++jt) { const int ok = ((16 * jt + fr) * 16 + 4 * fq) * 2;
        const bf16x8 Khp = mk8z(*(const LAS v2u*)(C + GS_KHT + ok)), Bhp = mk8z(*(const LAS v2u*)(C + GS_BHT + ok));
        const f32x4 Dv = *(const LAS f32x4*)(C + GS_DD + (16 * jt + 4 * fq) * 4);
        f32x4 acc = Dv * Areg[jt];
        acc = __builtin_amdgcn_mfma_f32_16x16x32_bf16(Khp, Vq, acc, 0, 0, 0);
        const f32x4 nbu = __builtin_amdgcn_mfma_f32_16x16x32_bf16(Bhp, Uq, zero4, 0, 0, 0);
        Areg[jt] = acc - nbu; }
}
__device__ __forceinline__ void rwkv_scan_chunked(Frame& F, const In& I, const bf16* R, const bf16* Kt, const bf16* V, const bf16* AA, const bf16* EW, bf16* Y) {
    const int lane = LANE_, fr = lane & 15, fq = lane >> 4;
    LAS unsigned char* L = F.lds;
    const f32x4 zero4 = (f32x4){0.f, 0.f, 0.f, 0.f};
    for (int un = blockIdx.x; un < NB * 16; un += F.G) {
        const int h = un & 15, b = un >> 4; const size_t rowb = (size_t)b * SEQ;
        if (F.wave >= 3) {
            const int p = F.wave - 3; const int colb = h * 64 + 16 * fq;
            v4u raw[10];
#define CK_LOAD(cidx) do { const size_t off = (rowb + (size_t)(cidx) * 16 + fr) * 1024 + colb; \
                raw[0] = *(const GAS v4u*)(R + off); raw[1] = *(const GAS v4u*)(R + off + 8); raw[2] = *(const GAS v4u*)(Kt + off); raw[3] = *(const GAS v4u*)(Kt + off + 8); raw[4] = *(const GAS v4u*)(V + off); raw[5] = *(const GAS v4u*)(V + off + 8); \
                raw[6] = *(const GAS v4u*)(AA + off); raw[7] = *(const GAS v4u*)(AA + off + 8); raw[8] = *(const GAS v4u*)(EW + off); raw[9] = *(const GAS v4u*)(EW + off + 8); } while (0)
            CK_LOAD(p);
            for (int rd = -1; rd < CH_ROUNDS - 1; ++rd) {
                const int cidx = CH_NP * (rd + 1) + p; LAS unsigned char* S = L + (((rd + 1) & 1) * CH_NP + p) * GS_SLOT;
                if (cidx < 512) {
                float r[16], k[16], a[16], ew[16]; const v4u vraw0 = raw[4], vraw1 = raw[5];
                { float t8[8];
                  unpack8(raw[0], t8);
#pragma unroll
                  for (int e = 0; e < 8; ++e) r[e] = t8[e];
                  unpack8(raw[1], t8);
#pragma unroll
                  for (int e = 0; e < 8; ++e) r[8 + e] = t8[e];
                  unpack8(raw[2], t8);
#pragma unroll
                  for (int e = 0; e < 8; ++e) k[e] = t8[e];
                  unpack8(raw[3], t8);
#pragma unroll
                  for (int e = 0; e < 8; ++e) k[8 + e] = t8[e];
                  unpack8(raw[6], t8);
#pragma unroll
                  for (int e = 0; e < 8; ++e) a[e] = t8[e];
                  unpack8(raw[7], t8);
#pragma unroll
                  for (int e = 0; e < 8; ++e) a[8 + e] = t8[e];
                  unpack8(raw[8], t8);
#pragma unroll
                  for (int e = 0; e < 8; ++e) ew[e] = t8[e];
                  unpack8(raw[9], t8);
#pragma unroll
                  for (int e = 0; e < 8; ++e) ew[8 + e] = t8[e]; }
                if (cidx + 5 < 512) CK_LOAD(cidx + 5);
                float kx[16], ss = 0.f;
                const float* rkk = I.rwkv_kk; const float* rka = I.rwkv_ka;
#pragma unroll
                for (int e4 = 0; e4 < 4; ++e4) { const f32x4 c0_ = *(const GAS f32x4*)(rkk + colb + 4 * e4), c1_ = *(const GAS f32x4*)(rka + colb + 4 * e4);
#pragma unroll
                    for (int z = 0; z < 4; ++z) { const int ee = 4 * e4 + z; kx[ee] = k[ee] * c0_[z]; ss += kx[ee] * kx[ee]; k[ee] = k[ee] * (1.0f + (a[ee] - 1.0f) * c1_[z]); } }
                ss += __shfl_xor(ss, 16); ss += __shfl_xor(ss, 32);
                const float inv = __builtin_amdgcn_rsqf(fmaxf(ss, 1e-24f));
                unsigned qtw[8], rtw[8], ktw[8], btw[8], bhw[8], khw[8];
#pragma unroll
                for (int e = 0; e < 16; e += 2) { float q2[2], r2[2], k2[2], b2[2], b2h[2], k2h[2];
#pragma unroll
                    for (int z = 0; z < 2; ++z) { const int ee = e + z;
                        float li = -ew[ee]; li += dpp_shr<1>(li); li += dpp_shr<2>(li); li += dpp_shr<4>(li); li += dpp_shr<8>(li);
                        const float l15 = __shfl(li, (lane & 48) | 15);
                        const float E1 = __builtin_amdgcn_exp2f(1.4426950408889634f * li), W1 = __builtin_amdgcn_exp2f(1.4426950408889634f * ew[ee]), E15 = __builtin_amdgcn_exp2f(1.4426950408889634f * l15);
                        const float Einv = __builtin_amdgcn_rcpf(E1);
                        const float kk = kx[ee] * inv, bb = a[ee] * kk, kp = k[ee];
                        q2[z] = kk * (E1 * W1); k2[z] = kp * Einv; b2[z] = bb * Einv; r2[z] = r[ee] * E1;
                        const float eh = E15 * Einv; b2h[z] = bb * eh; k2h[z] = kp * eh;
                        if (fr == 15) ((LAS float*)(S + GS_DD))[16 * fq + ee] = E15; }
                    qtw[e >> 1] = pk2(q2[0], q2[1]); rtw[e >> 1] = pk2(r2[0], r2[1]); ktw[e >> 1] = pk2(k2[0], k2[1]); btw[e >> 1] = pk2(b2[0], b2[1]); bhw[e >> 1] = pk2(b2h[0], b2h[1]); khw[e >> 1] = pk2(k2h[0], k2h[1]);
                    { const unsigned vw = (e < 8) ? vraw0[(e & 7) >> 1] : vraw1[(e & 7) >> 1]; LAS bf16* vp = (LAS bf16*)(S + GS_VT) + (16 * fq + e) * 16 + fr; vp[0] = (bf16)(vw & 0xffffu); vp[16] = (bf16)(vw >> 16); } }
                { const int o = (fr * 64 + 16 * fq) * 2;
                  *(LAS v4u*)(S + GS_QT + o) = (v4u){qtw[0], qtw[1], qtw[2], qtw[3]}; *(LAS v4u*)(S + GS_QT + o + 16) = (v4u){qtw[4], qtw[5], qtw[6], qtw[7]};
                  *(LAS v4u*)(S + GS_RT + o) = (v4u){rtw[0], rtw[1], rtw[2], rtw[3]}; *(LAS v4u*)(S + GS_RT + o + 16) = (v4u){rtw[4], rtw[5], rtw[6], rtw[7]};
                  *(LAS v4u*)(S + GS_KT + o) = (v4u){ktw[0], ktw[1], ktw[2], ktw[3]}; *(LAS v4u*)(S + GS_KT + o + 16) = (v4u){ktw[4], ktw[5], ktw[6], ktw[7]};
                  *(LAS v4u*)(S + GS_BT + o) = (v4u){btw[0], btw[1], btw[2], btw[3]}; *(LAS v4u*)(S + GS_BT + o + 16) = (v4u){btw[4], btw[5], btw[6], btw[7]}; }
                asm volatile("s_waitcnt lgkmcnt(0)" ::: "memory");
                f32x4 mb = zero4, mk = zero4, nb = zero4, nk = zero4;
#pragma unroll
                for (int kh = 0; kh < 2; ++kh) { const int o = (fr * 64 + 32 * kh + 8 * fq) * 2;
                    const bf16x8 Qf = *(const LAS bf16x8*)(S + GS_QT + o), Rf = *(const LAS bf16x8*)(S + GS_RT + o), Kf = *(const LAS bf16x8*)(S + GS_KT + o), Bf = *(const LAS bf16x8*)(S + GS_BT + o);
                    mb = __builtin_amdgcn_mfma_f32_16x16x32_bf16(Qf, Bf, mb, 0, 0, 0); mk = __builtin_amdgcn_mfma_f32_16x16x32_bf16(Qf, Kf, mk, 0, 0, 0);
                    nb = __builtin_amdgcn_mfma_f32_16x16x32_bf16(Rf, Bf, nb, 0, 0, 0); nk = __builtin_amdgcn_mfma_f32_16x16x32_bf16(Rf, Kf, nk, 0, 0, 0); }
                asm volatile("s_waitcnt lgkmcnt(0)" ::: "memory");
#pragma unroll
                for (int e = 0; e < 16; e += 2) { const unsigned bw = bhw[e >> 1], kw = khw[e >> 1]; LAS bf16* bp = (LAS bf16*)(S + GS_BHT) + (16 * fq + e) * 16 + fr; LAS bf16* kp_ = (LAS bf16*)(S + GS_KHT) + (16 * fq + e) * 16 + fr;
                    bp[0] = (bf16)(bw & 0xffffu); bp[16] = (bf16)(bw >> 16); kp_[0] = (bf16)(kw & 0xffffu); kp_[16] = (bf16)(kw >> 16); }
#pragma unroll
                for (int e = 0; e < 4; e += 2) { const int tt = 4 * fq + e; const bool lo0 = fr < tt, le0 = fr <= tt, lo1 = fr < tt + 1, le1 = fr <= tt + 1;
                    ((LAS float*)(S + GS_MB))[tt * 16 + fr] = lo0 ? mb[e] : 0.f; ((LAS float*)(S + GS_MB))[(tt + 1) * 16 + fr] = lo1 ? mb[e + 1] : 0.f;
                    const unsigned wk = pk2(lo0 ? mk[e] : 0.f, lo1 ? mk[e + 1] : 0.f), wn = pk2(le0 ? nk[e] : 0.f, le1 ? nk[e + 1] : 0.f), wb = pk2(le0 ? nb[e] : 0.f, le1 ? nb[e + 1] : 0.f);
                    LAS bf16* pk_ = (LAS bf16*)(S + GS_MK) + tt * 16 + fr; LAS bf16* pn = (LAS bf16*)(S + GS_NK) + tt * 16 + fr; LAS bf16* pb = (LAS bf16*)(S + GS_NB) + tt * 16 + fr;
                    pk_[0] = (bf16)(wk & 0xffffu); pk_[16] = (bf16)(wk >> 16); pn[0] = (bf16)(wn & 0xffffu); pn[16] = (bf16)(wn >> 16); pb[0] = (bf16)(wb & 0xffffu); pb[16] = (bf16)(wb >> 16); }
                asm volatile("s_waitcnt lgkmcnt(0)" ::: "memory");
                { float Tc[16]; int frx = fr; asm volatile("" : "+v"(frx));
#pragma unroll
                  for (int t = 0; t < 16; ++t) { const LAS f32x4* mrow = (const LAS f32x4*)(S + GS_MB + t * 64); float acc = (t == frx) ? 1.0f : 0.0f;
#pragma unroll
                      for (int s4 = 0; s4 < 4; ++s4) { if (4 * s4 < t) { const f32x4 m4 = mrow[s4];
#pragma unroll
                              for (int z = 0; z < 4; ++z) if (4 * s4 + z < t) acc -= m4[z] * Tc[4 * s4 + z]; } }
                      Tc[t] = acc; }
                  asm volatile("s_waitcnt lgkmcnt(0)" ::: "memory");
                  if (fq == 0) {
#pragma unroll
                      for (int t = 0; t < 16; t += 2) { const unsigned hw = pk2(Tc[t], Tc[t + 1]); const unsigned lw = pk2(Tc[t] - bflo(hw), Tc[t + 1] - bfhi(hw));
                          LAS bf16* ph = (LAS bf16*)(S + GS_TM) + t * 16 + fr; LAS bf16* pl = (LAS bf16*)(S + GS_TL) + t * 16 + fr;
                          ph[0] = (bf16)(hw & 0xffffu); ph[16] = (bf16)(hw >> 16); pl[0] = (bf16)(lw & 0xffffu); pl[16] = (bf16)(lw >> 16); } } }
                }
                LBAR();
            }
            LBAR();
#undef CK_LOAD
        } else {
            const int vtA = (F.wave == 0) ? 0 : F.wave + 1;
            f32x4 A0[4], A1[4];
#pragma unroll
            for (int jt = 0; jt < 4; ++jt) { A0[jt] = zero4; A1[jt] = zero4; }
            LBAR();
            for (int rd = 0; rd < CH_ROUNDS; ++rd) {
#pragma unroll 1
                for (int q = 0; q < CH_NP; ++q) {
                    const int cidx = CH_NP * rd + q;
                    if (cidx < 512) {
                        const LAS unsigned char* C = L + ((rd & 1) * CH_NP + q) * GS_SLOT; GAS bf16* yrow = (GAS bf16*)Y + (rowb + (size_t)cidx * 16) * 1024 + h * 64;
                        chain_step(C, A0, vtA, fr, fq, yrow);
                        if (F.wave == 0) chain_step(C, A1, 1, fr, fq, yrow);
                    }
                }
                LBAR();
            }
        }
    }
}
__device__ __forceinline__ void rwkv_post_pass(Frame& F, const In& I, const bf16* R, const bf16* Kt, const bf16* V, const bf16* AA, const bf16* G, bf16* Y) {
    const int gw = F.vcu * NWAVES + F.wave, NGW = F.G * NWAVES; const int col = LANE_ * 16;
    for (int t0 = 2 * gw; t0 < T; t0 += 2 * NGW) {
        v4u py[2][2], pr[2][2], pk[2][2], pv[2][2], pa[2][2], pg[2][2];
#pragma unroll
        for (int rw = 0; rw < 2; ++rw) { const size_t off = (size_t)(t0 + rw) * 1024 + col;
#pragma unroll
            for (int hf = 0; hf < 2; ++hf) { py[rw][hf] = *(const v4u*)(Y + off + hf * 8); pr[rw][hf] = *(const v4u*)(R + off + hf * 8); pk[rw][hf] = *(const v4u*)(Kt + off + hf * 8);
                pv[rw][hf] = *(const v4u*)(V + off + hf * 8); pa[rw][hf] = *(const v4u*)(AA + off + hf * 8); pg[rw][hf] = *(const v4u*)(G + off + hf * 8); } }
#pragma unroll
        for (int rw = 0; rw < 2; ++rw) { const size_t off = (size_t)(t0 + rw) * 1024 + col;
            float kaw[16], rkw[16], lng[16], lnb[16];
#pragma unroll
            for (int e4 = 0; e4 < 4; ++e4) { const f32x4 c0 = *(const GAS f32x4*)(I.rwkv_ka + col + 4 * e4), c1 = *(const GAS f32x4*)(I.rwkv_rk + col + 4 * e4), c2 = *(const GAS f32x4*)(I.rwkv_ln_g + col + 4 * e4), c3 = *(const GAS f32x4*)(I.rwkv_ln_b + col + 4 * e4);
#pragma unroll
                for (int e = 0; e < 4; ++e) { kaw[4 * e4 + e] = c0[e]; rkw[4 * e4 + e] = c1[e]; lng[4 * e4 + e] = c2[e]; lnb[4 * e4 + e] = c3[e]; } }
            float y[16], r[16], k[16], v[16], a[16], g[16];
#pragma unroll
            for (int hf = 0; hf < 2; ++hf) { float t8[8];
                unpack8(py[rw][hf], t8);
#pragma unroll
                for (int e = 0; e < 8; ++e) y[hf * 8 + e] = t8[e];
                unpack8(pr[rw][hf], t8);
#pragma unroll
                for (int e = 0; e < 8; ++e) r[hf * 8 + e] = t8[e];
                unpack8(pk[rw][hf], t8);
#pragma unroll
                for (int e = 0; e < 8; ++e) k[hf * 8 + e] = t8[e];
                unpack8(pv[rw][hf], t8);
#pragma unroll
                for (int e = 0; e < 8; ++e) v[hf * 8 + e] = t8[e];
                unpack8(pa[rw][hf], t8);
#pragma unroll
                for (int e = 0; e < 8; ++e) a[hf * 8 + e] = t8[e];
                unpack8(pg[rw][hf], t8);
#pragma unroll
                for (int e = 0; e < 8; ++e) g[hf * 8 + e] = t8[e]; }
            float s = 0.f, bs = 0.f;
#pragma unroll
            for (int e = 0; e < 16; ++e) { s += y[e]; const float kp = k[e] * (1.0f + (a[e] - 1.0f) * kaw[e]); bs += r[e] * kp * rkw[e]; }
            s += __shfl_xor(s, 1); s += __shfl_xor(s, 2); bs += __shfl_xor(bs, 1); bs += __shfl_xor(bs, 2);
            const float mean = s * (1.0f / 64.0f); float q = 0.f;
#pragma unroll
            for (int e = 0; e < 16; ++e) { const float dd = y[e] - mean; q += dd * dd; }
            q += __shfl_xor(q, 1); q += __shfl_xor(q, 2);
            const float rstd = 1.0f / sqrtf(q * (1.0f / 64.0f) + 64e-5f);
            float o[16];
#pragma unroll
            for (int e = 0; e < 16; ++e) o[e] = ((y[e] - mean) * rstd * lng[e] + lnb[e] + bs * v[e]) * g[e];
            v4u w0, w1; w0.x = pk2(o[0], o[1]); w0.y = pk2(o[2], o[3]); w0.z = pk2(o[4], o[5]); w0.w = pk2(o[6], o[7]); w1.x = pk2(o[8], o[9]); w1.y = pk2(o[10], o[11]); w1.z = pk2(o[12], o[13]); w1.w = pk2(o[14], o[15]);
            *(v4u*)(Y + off) = w0; *(v4u*)(Y + off + 8) = w1; }
    }
}

#ifndef DUP_K
#define DUP_K (-1)
#endif
#ifndef DUP_K2
#define DUP_K2 (-1)
#endif
#define KARGS ((const __attribute__((address_space(4))) Args*)__builtin_amdgcn_kernarg_segment_ptr())
#define WSPTRS \
    bf16* H0 = (bf16*)(ws + WS_H0); bf16* QKV = (bf16*)(ws + WS_QKV); bf16* OB = (bf16*)(ws + WS_O); f32x2* AGG = (f32x2*)(ws + WS_LRUAGG); \
    bf16* H2 = (bf16*)(ws + WS_H2); float* LOG = (float*)(ws + WS_LOG); unsigned char* RTE = ws + WS_ROUTE; bf16* HID = (bf16*)(ws + WS_HID); bf16* YS = (bf16*)(ws + WS_YS); bf16* PP = (bf16*)(ws + WS_PP); \
    bf16* HCAT = (bf16*)(ws + WS_HCAT); bf16* RB = (bf16*)(ws + WS_R); bf16* KB = (bf16*)(ws + WS_K); bf16* VB = (bf16*)(ws + WS_V); bf16* XRB = (bf16*)(ws + WS_XR); bf16* XKB = (bf16*)(ws + WS_XK); bf16* XVB = (bf16*)(ws + WS_XV); bf16* MID = (bf16*)(ws + WS_MID); bf16* EWB = (bf16*)(ws + WS_EW); bf16* AAB = (bf16*)(ws + WS_AA); bf16* YB = (bf16*)(ws + WS_Y); \
    const size_t TD = (size_t)T * 1024; (void)H0; (void)QKV; (void)OB; (void)AGG; (void)H2; (void)LOG; (void)RTE; (void)HID; (void)YS; (void)PP; (void)HCAT; (void)RB; (void)KB; (void)VB; (void)XRB; (void)XKB; (void)XVB; (void)MID; (void)EWB; (void)AAB; (void)YB; (void)TD;

struct Args { In in; float* out; unsigned char* ws; int ph_lo, ph_hi; };
constexpr int N_PHASES = 34;
__device__ __forceinline__ int nrep(int k) { int n = (k == DUP_K) ? 2 : 1; if (DUP_K >= 0) asm volatile("" : "+s"(n)); return n; }
#define REP_SYNC if (rep_) __syncthreads();
typedef const __attribute__((address_space(4))) unsigned long long* kp64;
__device__ __forceinline__ void load_in(In& I) { kp64 s = (kp64)__builtin_amdgcn_kernarg_segment_ptr(); unsigned long long* d = (unsigned long long*)&I;
#pragma unroll
    for (int i = 0; i < 47; ++i) d[i] = s[i]; }

__device__ __forceinline__ int t5_bucket(int n) { if (n < 16) return n; const float v = logf((float)n / 16.0f) / 2.0794415416798357f * 16.0f; const int l = 16 + (int)v; return l < 31 ? l : 31; }

template <class Epi>
__device__ __forceinline__ void dense_gemm(Frame& F, const void* A, int lda, const void* B, int K, int M, int N, const Epi& E) {
    pg8::DenseOrder S; S.init(A, lda, B, K, M, N, F.G, (int)blockIdx.x);
    pg8::gemm_phase<Epi, pg8::DenseOrder, true, false>(F.lds, K, lda, S, E, nullptr, TID_);
}

__global__ void __launch_bounds__(NWAVES * 64, 2) mk_fwd(Args args) {
    extern __shared__ __attribute__((aligned(16))) unsigned char lds[];
    Frame F;
    F.lds = (LAS unsigned char*)lds;
    F.MISC = (volatile LAS unsigned*)(F.lds + MISC_OFF);
    { int w_ = __builtin_amdgcn_readfirstlane((int)threadIdx.x >> 6); asm volatile("" : "+s"(w_)); F.wave = w_; }
    F.G = gridDim.x; { const int bx = blockIdx.x; F.vcu = (F.G % 8 == 0) ? (bx % 8) * (F.G / 8) + bx / 8 : bx; }
    F.ctl = (gu32*)(KARGS->ws + WS_CTL);
    for (int u = TID_; u < (LDS_BYTES - LDSCTL_OFF) / 4; u += NWAVES * 64) ((LAS unsigned*)(F.lds + LDSCTL_OFF))[u] = 0u;
    __syncthreads();
    {
        LAS float* tb = (LAS float*)(F.lds + TB_OFF); const int h = TID_ >> 7, i = TID_ & 127;
        const float* rb = KARGS->in.rel_bias;
        tb[h * 128 + i] = (rb[t5_bucket(i) * 4 + h] - rb[31 * 4 + h]) * 1.4426950408889634f;
    }
    __syncthreads();
    const int lo = KARGS->ph_lo, hi = KARGS->ph_hi;
    const bool multi = (hi - lo) > 1;
    XcdBarrier bar; bar.bar = (unsigned*)(F.ctl + CW_BAR); bar.x = 0; bar.st = nullptr;
    if (multi) bar = xcd_barrier_post((unsigned*)(F.ctl + CW_BAR), F.MISC + 8, TID_ == 0);
#define IN(k) (lo <= (k) && (k) < hi)
#define PH_BEGIN_ unsigned char* ws = KARGS->ws; bf16* X = (bf16*)KARGS->out; float* OUT = KARGS->out; (void)OUT; bf16* GB2 = (bf16*)KARGS->out + (size_t)T * 1024; (void)GB2; In I; load_in(I); (void)X; WSPTRS
#define SEAM(k) do { if (IN(k) && IN((k) + 1)) xcd_barrier(bar, TID_ == 0); } while (0)

    if (IN(0)) { PH_BEGIN_ prep_dense_weights(F, I, ws); prep_layer_weights(F, I, ws, 0); norm_pass<false>(F, I.x, I.norm_mix, H0);
#ifdef DUP_PREP
        __syncthreads(); prep_dense_weights(F, I, ws); prep_layer_weights(F, I, ws, 0);
#endif
    } SEAM(0);
    if (IN(1)) { PH_BEGIN_ pg8::EpiBf16 E{QKV, 512, 512, (size_t)T * 512, attn_body::C2}; dense_gemm(F, H0, 1024, ws + WS_WIN, 1024, T, AB_IN, E); } SEAM(1);
    if (IN(2)) { PH_BEGIN_ lru_agg_mfma(F, I, QKV + 3 * (size_t)T * 512, AGG, (bf16*)(ws + WS_HL), (bf16*)(ws + WS_CA)); } SEAM(2);
    if (IN(3)) { PH_BEGIN_
        const attn_body::AttnTensors AT{(const attn_body::bf16*)QKV, (const attn_body::bf16*)(QKV + (size_t)T * 512), (const attn_body::bf16*)(QKV + 2 * (size_t)T * 512), (attn_body::bf16*)OB};
        if (F.G == 256) attn_body::attn_phase<8>((char*)lds, AT, F.vcu, (const LAS float*)(F.lds + TB_OFF), (int)threadIdx.x);
#ifdef DUP_ATTN
        __syncthreads(); if (F.G == 256) attn_body::attn_phase<8>((char*)lds, AT, F.vcu, (const LAS float*)(F.lds + TB_OFF), (int)threadIdx.x);
#endif
        __syncthreads();
        lru_final_pass(F, (const bf16*)(ws + WS_HL), (const bf16*)(ws + WS_CA), QKV + 4 * (size_t)T * 512, AGG, H0);
    } SEAM(3);
    if (IN(4)) { PH_BEGIN_ diff_combine_pass(F, I, OB, H0); } SEAM(4);
    if (IN(5)) { PH_BEGIN_ pg8::EpiResX<false> E{I.x, X}; dense_gemm(F, H0, 1024, ws + WS_WOUT, 1024, T, 1024, E); } SEAM(5);

#define MOE_PLE_PHASES(P, L) \
    if (IN(P + 0)) { PH_BEGIN_ norm_pass<true>(F, X, I.norm_ffn + (L) * 1024, H2); } SEAM(P + 0); \
    if (IN(P + 1)) { PH_BEGIN_ pg8::EpiRouter E{LOG}; dense_gemm(F, H2, 1024, ws + WS_ROUT + (size_t)(L) * 256 * 1024 * 2, 1024, T, 256, E); } SEAM(P + 1); \
    if (IN(P + 2)) { PH_BEGIN_ route_pass_a(F, I, (L), LOG, RTE, F.ctl + ((L) ? CW_CNT1 : CW_CNT0)); } SEAM(P + 2); \
    if (IN(P + 3)) { PH_BEGIN_ route_pass_b(F, RTE, F.ctl + ((L) ? CW_CNT1 : CW_CNT0)); } SEAM(P + 3); \
    if (IN(P + 4)) { PH_BEGIN_ route_bases(F, F.ctl + ((L) ? CW_CNT1 : CW_CNT0)); const LAS int* eb = (const LAS int*)(F.lds + RTE_OFF + 512); \
        MoeOrder S{F.G, (int)blockIdx.x, __builtin_amdgcn_readfirstlane(eb[32] >> 8), eb, (const char*)H2, (const char*)(ws + WS_MGU), 0, (size_t)1024 * 1024 * 2, (size_t)256 * 1024 * 2, true}; pg8::EpiGU E{HID}; \
        pg8::gemm_phase<pg8::EpiGU, MoeOrder, true, true>(F.lds, 1024, 1024, S, E, (const int*)(RTE + RT_ROWTOK), TID_); } SEAM(P + 4); \
    if (IN(P + 5)) { PH_BEGIN_ route_bases(F, F.ctl + ((L) ? CW_CNT1 : CW_CNT0)); const LAS int* eb = (const LAS int*)(F.lds + RTE_OFF + 512); \
        MoeOrder S{F.G, (int)blockIdx.x, __builtin_amdgcn_readfirstlane(eb[32] >> 8), eb, (const char*)HID, (const char*)(ws + WS_MDN), (size_t)256 * 512 * 2, (size_t)1024 * 512 * 2, (size_t)256 * 512 * 2, false}; pg8::EpiDown E{YS, (const float*)(RTE + RT_ROWGATE)}; \
        pg8::gemm_phase<pg8::EpiDown, MoeOrder, true, false>(F.lds, 512, 512, S, E, nullptr, TID_); } SEAM(P + 5); \
    if (IN(P + 6)) { PH_BEGIN_ combine_norm_pass(F, X, X, YS, (const int*)(RTE + RT_SLOT), I.ple_norm + (L) * 1024, H2); } SEAM(P + 6); \
    if (IN(P + 7)) { PH_BEGIN_ pg8::EpiBf16 E{PP, 1024, 0, 0, 1.f}; dense_gemm(F, ws + WS_PB, 256, ws + WS_PPROJ + (size_t)(L) * 1024 * 256 * 2, 256, T, 1024, E); } SEAM(P + 7); \
    if (IN(P + 8)) { PH_BEGIN_ pg8::EpiPle E{X, (L) ? (bf16*)(ws + WS_YS) : X, PP}; dense_gemm(F, H2, 1024, ws + WS_PGATE + (size_t)(L) * 1024 * 1024 * 2, 1024, T, 1024, E); } SEAM(P + 8);

    MOE_PLE_PHASES(6, 0)
    if (IN(15)) { PH_BEGIN_ rwkv_input_pass(F, X, I.norm_mix + 1024, I.rwkv_mu, HCAT, XRB, XKB, XVB); } SEAM(15);
    if (IN(16)) { PH_BEGIN_ { pg8::EpiBf16 E{RB, 1024, 0, 0, 1.f}; dense_gemm(F, XRB, 1024, ws + WS_RCAT, 1024, T, 1024, E); }
        { pg8::EpiMid E{MID}; dense_gemm(F, HCAT, 2048, ws + WS_RL1, 2048, T, 512, E); } } SEAM(16);
    if (IN(17)) { PH_BEGIN_ pg8::EpiBf16 E{KB, 1024, 0, 0, 1.f}; dense_gemm(F, XKB, 1024, ws + WS_RCAT + (size_t)1024 * 1024 * 2, 1024, T, 1024, E); } SEAM(17);
    if (IN(18)) { PH_BEGIN_ pg8::EpiBf16 E{VB, 1024, 0, 0, 1.f}; dense_gemm(F, XVB, 1024, ws + WS_RCAT + (size_t)2 * 1024 * 1024 * 2, 1024, T, 1024, E); } SEAM(18);
    if (IN(19)) { PH_BEGIN_ pg8::EpiRwkv2 E{EWB, AAB, I.rwkv_w0, I.rwkv_a0, 0}; dense_gemm(F, MID, 512, ws + WS_RS2, 256, T, 2048, E); } SEAM(19);
    if (IN(20)) { PH_BEGIN_
        if (F.G == 256 && blockIdx.x >= 128) {
            Frame F2 = F; F2.G = 128; F2.vcu = (int)blockIdx.x - 128;
            prep_layer_weights(F2, I, ws, 1);
            __syncthreads();
            pg8::EpiRwkv2 E{GB2, GB2, nullptr, nullptr, 2}; pg8::DenseOrder S; S.init(MID + 256, 512, ws + WS_RS2 + (size_t)2 * 1024 * 256 * 2, 256, T, 1024, 128, (int)blockIdx.x - 128);
            pg8::gemm_phase<pg8::EpiRwkv2, pg8::DenseOrder, true, false>(F.lds, 256, 512, S, E, nullptr, TID_);
        } else rwkv_scan_chunked(F, I, RB, KB, VB, AAB, EWB, YB);
    } SEAM(20);
    if (IN(21)) { } SEAM(21);
    if (IN(22)) { PH_BEGIN_ rwkv_post_pass(F, I, RB, KB, VB, AAB, GB2, YB); } SEAM(22);
    if (IN(23)) { PH_BEGIN_ pg8::EpiResX<true> E{X, X}; dense_gemm(F, YB, 1024, ws + WS_RWO, 1024, T, 1024, E); } SEAM(23);
    MOE_PLE_PHASES(24, 1)
    if (IN(33)) { PH_BEGIN_ final_norm_pass(F, (const bf16*)(ws + WS_YS), OUT, I.final_norm); }
#undef IN
#undef SEAM
}

extern "C" void kernel_launch(void* const* d_in, const int* in_sizes, int n_in, void* d_out, int out_size, void* d_ws, size_t ws_size, hipStream_t stream) {
    static int ok = 0;
    if (ok == 0) {
        if (n_in != 47 || out_size != T * D || ws_size < WS_END) { fprintf(stderr, "kernel_launch: unexpected problem shape (n_in %d out %d ws %zu)\n", n_in, out_size, ws_size); ok = -1; return; }
        if (hipFuncSetAttribute((const void*)mk_fwd, hipFuncAttributeMaxDynamicSharedMemorySize, LDS_BYTES) != hipSuccess) { fprintf(stderr, "kernel_launch: hipFuncSetAttribute failed\n"); ok = -1; return; }
        int per_cu = 0;
        if (hipOccupancyMaxActiveBlocksPerMultiprocessor(&per_cu, (const void*)mk_fwd, NWAVES * 64, LDS_BYTES) != hipSuccess || per_cu < 1) fprintf(stderr, "kernel_launch: occupancy query reports %d\n", per_cu);
        (void)hipGetLastError();
        ok = 1;
    }
    if (ok < 0) return;
    (void)hipMemsetAsync((char*)d_ws + WS_CTL, 0, CTL_ZERO_BYTES, stream);
    Args a{};
    const float** ip = (const float**)&a.in;
    for (int i = 0; i < 47; ++i) ip[i] = (const float*)d_in[i];
    a.out = (float*)d_out; a.ws = (unsigned char*)d_ws;
    const int grid = 256;
#if MK_ONE_LAUNCH
    a.ph_lo = 0; a.ph_hi = N_PHASES;
    hipLaunchKernelGGL(mk_fwd, dim3(grid), dim3(NWAVES * 64), LDS_BYTES, stream, a);
#else
    for (int k = 0; k < N_PHASES; ++k) { a.ph_lo = k; a.ph_hi = k + 1; hipLaunchKernelGGL(mk_fwd, dim3(grid), dim3(NWAVES * 64), LDS_BYTES, stream, a);
        if (k == DUP_K || k == DUP_K2) hipLaunchKernelGGL(mk_fwd, dim3(grid), dim3(NWAVES * 64), LDS_BYTES, stream, a); }
#endif
}
```

```cpp
#include <hip/hip_runtime.h>
#include <hip/hip_bf16.h>
#include <cstdio>
#include <cstdint>
#include <cmath>

#ifndef MK_ONE_LAUNCH
#define MK_ONE_LAUNCH 1
#endif

#define GAS __attribute__((address_space(1)))
#define LAS __attribute__((address_space(3)))
typedef unsigned short bf16;
typedef unsigned v4u __attribute__((ext_vector_type(4)));
typedef unsigned v2u __attribute__((ext_vector_type(2)));
typedef float f32x4 __attribute__((ext_vector_type(4)));
typedef float f32x2 __attribute__((ext_vector_type(2)));
typedef short bf16x8 __attribute__((ext_vector_type(8)));
typedef GAS unsigned gu32;
#define RLX_AGENT __ATOMIC_RELAXED, __HIP_MEMORY_SCOPE_AGENT
#define LDS_WAIT() asm volatile("s_waitcnt lgkmcnt(0)" ::: "memory")
#define VM_WAIT() asm volatile("s_waitcnt vmcnt(0)" ::: "memory")
__device__ __forceinline__ unsigned f2bf(float f) { unsigned u = __builtin_bit_cast(unsigned, f); return (u + 0x7fffu + ((u >> 16) & 1u)) >> 16; }
typedef float f32x2_cv __attribute__((ext_vector_type(2))); typedef __bf16 bf16x2_cv __attribute__((ext_vector_type(2)));
__device__ __forceinline__ unsigned pk2(float lo, float hi) { const f32x2_cv v = {lo, hi}; const bf16x2_cv b = __builtin_convertvector(v, bf16x2_cv); return __builtin_bit_cast(unsigned, b); }
__device__ __forceinline__ float bflo(unsigned w) { return __uint_as_float(w << 16); }
__device__ __forceinline__ float bfhi(unsigned w) { return __uint_as_float(w & 0xffff0000u); }
__device__ __forceinline__ float bf1(bf16 h) { return __uint_as_float((unsigned)h << 16); }
__device__ __forceinline__ float sigmoidf_(float x) { return __builtin_amdgcn_rcpf(1.0f + __builtin_amdgcn_exp2f(-1.4426950408889634f * x)); }
__device__ __forceinline__ float tanhf_(float x) { return 1.0f - 2.0f * __builtin_amdgcn_rcpf(1.0f + __builtin_amdgcn_exp2f(2.885390081777927f * x)); }
__device__ __forceinline__ void fmac_(float& acc, float a, float b) { asm("v_fmac_f32 %0, %1, %2" : "+v"(acc) : "v"(a), "v"(b)); }
__device__ __forceinline__ float fma_(float a, float b, float c) { float r; asm("v_fma_f32 %0, %1, %2, %3" : "=v"(r) : "v"(a), "v"(b), "v"(c)); return r; }
__device__ __forceinline__ float mul_(float a, float b) { float r; asm("v_mul_f32 %0, %1, %2" : "=v"(r) : "v"(a), "v"(b)); return r; }
__device__ __forceinline__ float wave_sum(float v) {
#pragma unroll
    for (int o = 1; o < 64; o <<= 1) v += __shfl_xor(v, o);
    return v;
}

constexpr int NB = 8, SEQ = 8192, D = 1024, T = NB * SEQ;
constexpr int AB_IN = 2560, PLE = 256;
constexpr int NEXP = 32, EH = 512;
constexpr int MAXSLOT = 2 * T + NEXP * 256;
constexpr int MAXTILES = MAXSLOT / 256;

namespace pg8 {
#define PG8_LAS __attribute__((address_space(3)))
typedef unsigned short bf16_t;
typedef unsigned u32x4 __attribute__((ext_vector_type(4)));
typedef unsigned u32x2 __attribute__((ext_vector_type(2)));
constexpr int BM = 256, BK = 64, HALF = 128, HTB = HALF * BK * 2, STAGE_BYTES = 8 * HTB, NXCD = 8, WGM = 8;
__host__ __device__ __forceinline__ int lds_byte(int r, int c) { const int st = (r >> 4) * 2 + (c >> 5), rr = r & 15, cc = c & 31, ob = rr * 64 + cc * 2; return st * 1024 + (ob ^ (((ob >> 9) & 1) << 5)); }
__host__ __device__ __forceinline__ void stage_rc(int b, int& R, int& C) { const int st = b / 1024, sb = b % 1024, swz = sb ^ (((sb >> 9) & 1) << 5); R = (st >> 1) * 16 + swz / 64; C = (st & 1) * 32 + (swz % 64) / 2; }
__host__ __device__ __forceinline__ int perm32(int rho) { const int n = rho >> 4, i = rho & 15; return 8 * (i >> 2) + 4 * n + (i & 3); }

struct Unit { int pm, pn, aux; const char* A; const char* B; };

struct DenseOrder {
    int nM, nN, nwg, G, c; const char* A; const char* B; size_t astep, bstep;
    __device__ void init(const void* A_, int lda, const void* B_, int K, int M, int N, int G_, int c_) { nM = M / BM; nN = N / BM; nwg = nM * nN; G = G_; c = c_; A = (const char*)A_; B = (const char*)B_; astep = (size_t)BM * lda * 2; bstep = (size_t)BM * K * 2; }
    __device__ bool next(int i, Unit& u) const {
        const long L = (long)i * G + c; if (L >= nwg) return false;
        int wgid = (int)L; { const int q = nwg / NXCD, r = nwg % NXCD, xcd = wgid % NXCD, off = wgid / NXCD; wgid = (xcd < r ? xcd * (q + 1) : r * (q + 1) + (xcd - r) * q) + off; }
        const int nig = WGM * nN, gid = wgid / nig, fm = gid * WGM, gsz = (nM - fm) < WGM ? (nM - fm) : WGM;
        u.pm = fm + ((wgid % nig) % gsz); u.pn = (wgid % nig) / gsz; u.aux = 0; u.A = A + (size_t)u.pm * astep; u.B = B + (size_t)u.pn * bstep; return true;
    }
};

__device__ __forceinline__ unsigned cvt_pk_bf16(float lo, float hi) { unsigned r; asm volatile("v_cvt_pk_bf16_f32 %0, %1, %2" : "=v"(r) : "v"(lo), "v"(hi)); return r; }

typedef f32x4 Acc[2][2][4][2];

struct EpiBf16 {
    static constexpr bool PERM = true;
    bf16_t* O; int ldc; int split_cols; size_t split_stride; float scale0;
    __device__ __forceinline__ void operator()(const Acc& acc, const Unit& u, int wr, int wc, int fr, int fq) const {
        const int row0 = u.pm * BM + wr * 64 + fr; int colt = u.pn * BM; bf16_t* base = O;
        float sc = 1.f; if (split_cols) { const int t = colt / split_cols; base += (size_t)t * split_stride; colt -= t * split_cols; if (t == 0) sc = scale0; }
        const int col0 = colt + wc * 32 + 8 * fq;
#pragma unroll
        for (int ai = 0; ai < 2; ++ai)
#pragma unroll
            for (int m = 0; m < 4; ++m) { bf16_t* rowp = base + (size_t)(row0 + ai * HALF + m * 16) * ldc + col0;
#pragma unroll
                for (int bj = 0; bj < 2; ++bj) { f32x4 v0 = acc[ai][bj][m][0] * sc, v1 = acc[ai][bj][m][1] * sc;
                    u32x4 w; w.x = cvt_pk_bf16(v0[0], v0[1]); w.y = cvt_pk_bf16(v0[2], v0[3]); w.z = cvt_pk_bf16(v1[0], v1[1]); w.w = cvt_pk_bf16(v1[2], v1[3]);
                    *(u32x4*)(rowp + bj * HALF) = w; } }
    }
};
__device__ __forceinline__ void unpack8f(const u32x4 w, f32x4& lo, f32x4& hi) { lo = (f32x4){bflo(w.x), bfhi(w.x), bflo(w.y), bfhi(w.y)}; hi = (f32x4){bflo(w.z), bfhi(w.z), bflo(w.w), bfhi(w.w)}; }
template <bool BASE_BF16>
struct EpiResX {
    static constexpr bool PERM = true;
    const void* base; bf16_t* out;
    __device__ __forceinline__ void operator()(const Acc& acc, const Unit& u, int wr, int wc, int fr, int fq) const {
        const int col0 = u.pn * BM + wc * 32 + 8 * fq; GAS bf16_t* op = (GAS bf16_t*)out;
#pragma unroll
        for (int ai = 0; ai < 2; ++ai) {
            f32x4 b0[4][2], b1[4][2];
#pragma unroll
            for (int m = 0; m < 4; ++m) { const size_t off = (size_t)(u.pm * BM + ai * HALF + wr * 64 + m * 16 + fr) * 1024 + col0;
#pragma unroll
                for (int bj = 0; bj < 2; ++bj) {
                    if (BASE_BF16) { const u32x4 w = *(const GAS u32x4*)((const GAS bf16_t*)base + off + bj * HALF); unpack8f(w, b0[m][bj], b1[m][bj]); }
                    else { b0[m][bj] = *(const GAS f32x4*)((const GAS float*)base + off + bj * HALF); b1[m][bj] = *(const GAS f32x4*)((const GAS float*)base + off + bj * HALF + 4); } } }
            asm volatile("" ::: "memory");
#pragma unroll
            for (int m = 0; m < 4; ++m) { const size_t off = (size_t)(u.pm * BM + ai * HALF + wr * 64 + m * 16 + fr) * 1024 + col0;
#pragma unroll
                for (int bj = 0; bj < 2; ++bj) { const f32x4 v0 = b0[m][bj] + acc[ai][bj][m][0], v1 = b1[m][bj] + acc[ai][bj][m][1];
                    u32x4 w; w.x = cvt_pk_bf16(v0[0], v0[1]); w.y = cvt_pk_bf16(v0[2], v0[3]); w.z = cvt_pk_bf16(v1[0], v1[1]); w.w = cvt_pk_bf16(v1[2], v1[3]);
                    *(GAS u32x4*)(op + off + bj * HALF) = w; } }
            asm volatile("" ::: "memory");
        }
    }
};
struct EpiRouter {
    static constexpr bool PERM = false;
    float* out;
    __device__ __forceinline__ void operator()(const Acc& acc, const Unit& u, int wr, int wc, int fr, int fq) const {
        if (wc >= 2) return;
#pragma unroll
        for (int ai = 0; ai < 2; ++ai)
#pragma unroll
            for (int m = 0; m < 4; ++m) { const size_t off = (size_t)(u.pm * BM + ai * HALF + wr * 64 + m * 16 + fr) * 64 + wc * 32 + 4 * fq;
#pragma unroll
                for (int n = 0; n < 2; ++n) *(f32x4*)(out + off + n * 16) = acc[ai][0][m][n]; }
    }
};
struct EpiGU {
    static constexpr bool PERM = true;
    bf16_t* H;
    __device__ __forceinline__ void operator()(const Acc& acc, const Unit& u, int wr, int wc, int fr, int fq) const {
        const int col0 = u.pn * 128 + wc * 32 + 8 * fq;
#pragma unroll
        for (int ai = 0; ai < 2; ++ai)
#pragma unroll
            for (int m = 0; m < 4; ++m) { bf16_t* rowp = H + (size_t)(u.pm * BM + ai * HALF + wr * 64 + m * 16 + fr) * EH + col0;
                f32x4 g0 = acc[ai][0][m][0], g1 = acc[ai][0][m][1]; const f32x4 u0 = acc[ai][1][m][0], u1 = acc[ai][1][m][1];
#pragma unroll
                for (int e = 0; e < 4; ++e) { g0[e] = g0[e] * sigmoidf_(g0[e]) * u0[e]; g1[e] = g1[e] * sigmoidf_(g1[e]) * u1[e]; }
                u32x4 w; w.x = cvt_pk_bf16(g0[0], g0[1]); w.y = cvt_pk_bf16(g0[2], g0[3]); w.z = cvt_pk_bf16(g1[0], g1[1]); w.w = cvt_pk_bf16(g1[2], g1[3]);
                *(u32x4*)rowp = w; }
    }
};
struct EpiDown {
    static constexpr bool PERM = true;
    bf16_t* Y; const float* gate;
    __device__ __forceinline__ void operator()(const Acc& acc, const Unit& u, int wr, int wc, int fr, int fq) const {
        const int col0 = u.pn * BM + wc * 32 + 8 * fq;
#pragma unroll
        for (int ai = 0; ai < 2; ++ai)
#pragma unroll
            for (int m = 0; m < 4; ++m) { const int row = u.pm * BM + ai * HALF + wr * 64 + m * 16 + fr; const float sc = gate[row]; bf16_t* rowp = Y + (size_t)row * 1024 + col0;
#pragma unroll
                for (int bj = 0; bj < 2; ++bj) { const f32x4 v0 = acc[ai][bj][m][0] * sc, v1 = acc[ai][bj][m][1] * sc;
                    u32x4 w; w.x = cvt_pk_bf16(v0[0], v0[1]); w.y = cvt_pk_bf16(v0[2], v0[3]); w.z = cvt_pk_bf16(v1[0], v1[1]); w.w = cvt_pk_bf16(v1[2], v1[3]);
                    *(u32x4*)(rowp + bj * HALF) = w; } }
    }
};
struct EpiPle {
    static constexpr bool PERM = true;
    const bf16_t* xin; bf16_t* xout; const bf16_t* pp;
    __device__ __forceinline__ void operator()(const Acc& acc, const Unit& u, int wr, int wc, int fr, int fq) const {
        const int col0 = u.pn * BM + wc * 32 + 8 * fq;
        const GAS bf16_t* xp = (const GAS bf16_t*)xin; GAS bf16_t* op = (GAS bf16_t*)xout; const GAS bf16_t* pq = (const GAS bf16_t*)pp;
#pragma unroll
        for (int ai = 0; ai < 2; ++ai) {
            u32x4 xw[4][2], pw[4][2];
#pragma unroll
            for (int m = 0; m < 4; ++m) { const size_t off = (size_t)(u.pm * BM + ai * HALF + wr * 64 + m * 16 + fr) * 1024 + col0;
#pragma unroll
                for (int bj = 0; bj < 2; ++bj) { xw[m][bj] = *(const GAS u32x4*)(xp + off + bj * HALF); pw[m][bj] = *(const GAS u32x4*)(pq + off + bj * HALF); } }
            asm volatile("" ::: "memory");
#pragma unroll
            for (int m = 0; m < 4; ++m) { const size_t off = (size_t)(u.pm * BM + ai * HALF + wr * 64 + m * 16 + fr) * 1024 + col0;
#pragma unroll
                for (int bj = 0; bj < 2; ++bj) { f32x4 x0, x1, p0, p1; unpack8f(xw[m][bj], x0, x1); unpack8f(pw[m][bj], p0, p1); const f32x4 a0 = acc[ai][bj][m][0], a1 = acc[ai][bj][m][1];
#pragma unroll
                    for (int e = 0; e < 4; ++e) { x0[e] += p0[e] * sigmoidf_(a0[e]); x1[e] += p1[e] * sigmoidf_(a1[e]); }
                    u32x4 w; w.x = cvt_pk_bf16(x0[0], x0[1]); w.y = cvt_pk_bf16(x0[2], x0[3]); w.z = cvt_pk_bf16(x1[0], x1[1]); w.w = cvt_pk_bf16(x1[2], x1[3]);
                    *(GAS u32x4*)(op + off + bj * HALF) = w; } }
            asm volatile("" ::: "memory");
        }
    }
};
struct EpiMid {
    static constexpr bool PERM = true;
    bf16_t* MID;
    __device__ __forceinline__ void operator()(const Acc& acc, const Unit& u, int wr, int wc, int fr, int fq) const {
        const int row0 = u.pm * BM + wr * 64 + fr;
        const int mode = (u.pn == 1) ? 2 : 0; const int colbase = u.pn * 256;
#pragma unroll
        for (int ai = 0; ai < 2; ++ai)
#pragma unroll
            for (int m = 0; m < 4; ++m) { bf16_t* rowp = MID + (size_t)(row0 + ai * HALF + m * 16) * 512 + colbase;
#pragma unroll
                for (int bj = 0; bj < 2; ++bj) { const int lc = bj * HALF + wc * 32 + 8 * fq; f32x4 v0 = acc[ai][bj][m][0], v1 = acc[ai][bj][m][1];
#pragma unroll
                    for (int e = 0; e < 4; ++e) {
                        if (mode == 2) { v0[e] = sigmoidf_(v0[e]); v1[e] = sigmoidf_(v1[e]); }
                        else if (lc < 64) { v0[e] = tanhf_(v0[e]); v1[e] = tanhf_(v1[e]); } }
                    u32x4 w; w.x = cvt_pk_bf16(v0[0], v0[1]); w.y = cvt_pk_bf16(v0[2], v0[3]); w.z = cvt_pk_bf16(v1[0], v1[1]); w.w = cvt_pk_bf16(v1[2], v1[3]);
                    *(u32x4*)(rowp + lc) = w; } }
    }
};
struct EpiRwkv2 {
    static constexpr bool PERM = true;
    bf16_t* O0; bf16_t* O1; const float* bias0; const float* bias1; int tybase;
    __device__ __forceinline__ void operator()(const Acc& acc, const Unit& u, int wr, int wc, int fr, int fq) const {
        const int ty = tybase + (u.pn >> 2); const int row0 = u.pm * BM + wr * 64 + fr; const int colt = (u.pn & 3) * BM + wc * 32 + 8 * fq;
        bf16_t* base = (u.pn >> 2) ? O1 : O0; const float* bias = (u.pn >> 2) ? bias1 : bias0;
#pragma unroll
        for (int bj = 0; bj < 2; ++bj) {
            f32x4 b0 = (f32x4){0.f, 0.f, 0.f, 0.f}, b1 = b0;
            if (ty < 2) { b0 = *(const f32x4*)(bias + colt + bj * HALF); b1 = *(const f32x4*)(bias + colt + bj * HALF + 4); }
#pragma unroll
            for (int ai = 0; ai < 2; ++ai)
#pragma unroll
                for (int m = 0; m < 4; ++m) { bf16_t* rowp = base + (size_t)(row0 + ai * HALF + m * 16) * 1024 + colt + bj * HALF;
                    f32x4 v0 = acc[ai][bj][m][0] + b0, v1 = acc[ai][bj][m][1] + b1;
                    if (ty < 2) { const float s = (ty == 0) ? 0.6065306597126334f : 1.0f;
#pragma unroll
                        for (int e = 0; e < 4; ++e) { v0[e] = s * sigmoidf_(v0[e]); v1[e] = s * sigmoidf_(v1[e]); } }
                    u32x4 w; w.x = cvt_pk_bf16(v0[0], v0[1]); w.y = cvt_pk_bf16(v0[2], v0[3]); w.z = cvt_pk_bf16(v1[0], v1[1]); w.w = cvt_pk_bf16(v1[2], v1[3]);
                    *(u32x4*)rowp = w; }
        }
    }
};

template <class Epi, class Sched, bool ALIGN_EPI, bool GATHER>
__device__ __forceinline__ void gemm_phase(PG8_LAS unsigned char* lds, const int K, const int lda, const Sched& S, const Epi& E, const int* __restrict__ rows, const int tid) {
    const int wid = __builtin_amdgcn_readfirstlane(tid >> 6), lane = tid & 63, wr = wid >> 2, wc = wid & 3, fr = lane & 15, fq = lane >> 4;
    const int nt = K / BK;
    unsigned voffA[2], voffB[2]; int RA[2];
#pragma unroll
    for (int i = 0; i < 2; ++i) { int R, C; stage_rc(tid * 16 + i * 8192, R, C); const int Rb = Epi::PERM ? ((R & ~31) + perm32(R & 31)) : R;
        RA[i] = R; voffA[i] = GATHER ? (unsigned)(C * 2) : (unsigned)(R * lda + C) * 2u; voffB[i] = (unsigned)(Rb * K + C) * 2u; }
    const size_t kstep = (size_t)(BK * 2);
    const size_t hstepA = GATHER ? 0 : (size_t)HALF * lda * 2, hstepB = (size_t)HALF * K * 2;
    const unsigned ldsw = (unsigned)wid * 1024u;
    const int aoff = lds_byte(wr * 64 + fr, fq * 8), boff = lds_byte(wc * 32 + fr, fq * 8);
#define PG8_SA(b, h) (((b) * 2 + (h)) * HTB)
#define PG8_SB(b, h) ((4 + (b) * 2 + (h)) * HTB)
#define PG8_ST2(bufoff, gbase, o0, o1) do { \
        __builtin_amdgcn_global_load_lds((const unsigned*)((const char*)(gbase) + (o0)), (PG8_LAS unsigned*)(lds + (bufoff) + ldsw), 16, 0, 0); \
        __builtin_amdgcn_global_load_lds((const unsigned*)((const char*)(gbase) + (o1)), (PG8_LAS unsigned*)(lds + (bufoff) + ldsw + 8192), 16, 0, 0); } while (0)
#define PG8_STB(bufoff, gbase) PG8_ST2(bufoff, gbase, voffB[0], voffB[1])
#define PG8_STA(bufoff, p, h, nx) do { if constexpr (GATHER) { const unsigned g0_ = (nx) ? gN[h][0] : gC[h][0], g1_ = (nx) ? gN[h][1] : gC[h][1]; PG8_ST2(bufoff, p, g0_, g1_); } \
        else { PG8_ST2(bufoff, (p) + (h) * hstepA, voffA[0], voffA[1]); } } while (0)
#define PG8_LDA(dst, b, h) do { _Pragma("unroll") for (int m = 0; m < 4; ++m) _Pragma("unroll") for (int k = 0; k < 2; ++k) dst[m][k] = *(const PG8_LAS bf16x8*)(lds + PG8_SA(b, h) + aoff + m * 2048 + k * 1024); } while (0)
#define PG8_LDB(dst, b, h) do { _Pragma("unroll") for (int n = 0; n < 2; ++n) _Pragma("unroll") for (int k = 0; k < 2; ++k) dst[n][k] = *(const PG8_LAS bf16x8*)(lds + PG8_SB(b, h) + boff + n * 2048 + k * 1024); } while (0)
#define PG8_MMA(ai, bj, At, Bt) do { __builtin_amdgcn_s_setprio(1); _Pragma("unroll") for (int m = 0; m < 4; ++m) _Pragma("unroll") for (int n = 0; n < 2; ++n) _Pragma("unroll") for (int k = 0; k < 2; ++k) \
        acc[ai][bj][m][n] = __builtin_amdgcn_mfma_f32_16x16x32_bf16(Bt[n][k], At[m][k], acc[ai][bj][m][n], 0, 0, 0); __builtin_amdgcn_s_setprio(0); } while (0)
#define PG8_WAIT_V(n) asm volatile("s_waitcnt vmcnt(" #n ")" ::: "memory")
#define PG8_WAIT_L(n) asm volatile("s_waitcnt lgkmcnt(" #n ")" ::: "memory")
#define PG8_BAR __builtin_amdgcn_s_barrier()
#define PG8_SCHED __builtin_amdgcn_sched_barrier(0)
#define PG8_GLOAD(dst, un) do { if constexpr (GATHER) { _Pragma("unroll") for (int h_ = 0; h_ < 2; ++h_) _Pragma("unroll") for (int i_ = 0; i_ < 2; ++i_) \
        dst[h_][i_] = (unsigned)rows[(un).pm * BM + h_ * HALF + RA[i_]] * (unsigned)(lda * 2) + voffA[i_]; } } while (0)
    Unit cur, nxt; int ui = 0;
    if (!S.next(0, cur)) return;
    unsigned gC[2][2] = {{0u, 0u}, {0u, 0u}}, gN[2][2] = {{0u, 0u}, {0u, 0u}};
    PG8_GLOAD(gC, cur);
    Acc acc;
#pragma unroll
    for (int a = 0; a < 2; ++a)
#pragma unroll
        for (int b = 0; b < 2; ++b)
#pragma unroll
            for (int m = 0; m < 4; ++m)
#pragma unroll
                for (int n = 0; n < 2; ++n) acc[a][b][m][n] = (f32x4){0.f, 0.f, 0.f, 0.f};
    bf16x8 At[4][2], B0[2][2], B1[2][2];
    const char* cA = cur.A; const char* cB = cur.B;
    PG8_STB(PG8_SB(0, 0), cB); PG8_STB(PG8_SB(0, 1), cB + hstepB); PG8_STA(PG8_SA(0, 0), cA, 0, false); PG8_STA(PG8_SA(0, 1), cA, 1, false);
    if (wr == 1) PG8_BAR;
    PG8_WAIT_V(2); PG8_BAR;
    PG8_STB(PG8_SB(1, 0), cB + kstep); PG8_STA(PG8_SA(1, 0), cA + kstep, 0, false); PG8_STB(PG8_SB(1, 1), cB + hstepB + kstep);
    PG8_WAIT_V(6); PG8_BAR;
    for (;;) {
        const bool has_next = S.next(ui + 1, nxt);
        if (has_next) { PG8_GLOAD(gN, nxt); }
        const char* nA = has_next ? nxt.A : cA; const char* nB = has_next ? nxt.B : cB;
#pragma unroll 1
        for (int t = 0; t < nt; t += 2) {
            const bool last = (t == nt - 2); const bool nx = last && has_next;
            const char* a1 = cA + (size_t)(t + 1) * kstep;
            const char* a2 = last ? nA : cA + (size_t)(t + 2) * kstep; const char* b2 = last ? nB : cB + (size_t)(t + 2) * kstep;
            const char* a3 = a2 + kstep; const char* b3 = b2 + kstep;
            PG8_LDB(B0, 0, 0); PG8_LDB(B1, 0, 1); PG8_SCHED; PG8_LDA(At, 0, 0); PG8_STA(PG8_SA(1, 1), a1, 1, false);
            PG8_WAIT_V(8); PG8_WAIT_L(0); PG8_BAR; PG8_MMA(0, 0, At, B0); PG8_MMA(0, 1, At, B1); PG8_BAR; PG8_SCHED;
            PG8_LDA(At, 0, 1); PG8_STB(PG8_SB(0, 0), b2); PG8_STB(PG8_SB(0, 1), b2 + hstepB); PG8_STA(PG8_SA(0, 0), a2, 0, nx);
            PG8_WAIT_V(8); PG8_WAIT_L(0); PG8_BAR; PG8_MMA(1, 0, At, B0); PG8_MMA(1, 1, At, B1); PG8_BAR; PG8_SCHED;
            PG8_LDB(B0, 1, 0); PG8_LDB(B1, 1, 1); PG8_SCHED; PG8_LDA(At, 1, 0); PG8_STA(PG8_SA(0, 1), a2, 1, nx);
            PG8_WAIT_V(8); PG8_WAIT_L(0); PG8_BAR; PG8_MMA(0, 0, At, B0); PG8_MMA(0, 1, At, B1); PG8_BAR; PG8_SCHED;
            PG8_LDA(At, 1, 1); PG8_STB(PG8_SB(1, 0), b3); PG8_STB(PG8_SB(1, 1), b3 + hstepB); PG8_STA(PG8_SA(1, 0), a3, 0, nx);
            PG8_WAIT_V(8); PG8_WAIT_L(0); PG8_BAR; PG8_MMA(1, 0, At, B0); PG8_MMA(1, 1, At, B1); PG8_BAR; PG8_SCHED;
        }
        if constexpr (ALIGN_EPI) { if (wr == 0) PG8_BAR; }
        E(acc, cur, wr, wc, fr, fq);
        if (!has_next) break;
#pragma unroll
        for (int a = 0; a < 2; ++a)
#pragma unroll
            for (int b = 0; b < 2; ++b)
#pragma unroll
                for (int m = 0; m < 4; ++m)
#pragma unroll
                    for (int n = 0; n < 2; ++n) acc[a][b][m][n] = (f32x4){0.f, 0.f, 0.f, 0.f};
        cur = nxt; cA = nA; cB = nB; ++ui;
        if constexpr (GATHER) {
#pragma unroll
            for (int h_ = 0; h_ < 2; ++h_)
#pragma unroll
                for (int i_ = 0; i_ < 2; ++i_) gC[h_][i_] = gN[h_][i_]; }
        if constexpr (ALIGN_EPI) { if (wr == 1) PG8_BAR; }
    }
    PG8_WAIT_V(0);
    if constexpr (!ALIGN_EPI) { if (wr == 0) PG8_BAR; }
    PG8_BAR;
#undef PG8_SA
#undef PG8_SB
#undef PG8_ST2
#undef PG8_STB
#undef PG8_STA
#undef PG8_LDA
#undef PG8_LDB
#undef PG8_MMA
#undef PG8_WAIT_V
#undef PG8_WAIT_L
#undef PG8_BAR
#undef PG8_SCHED
#undef PG8_GLOAD
}
}
namespace attn_body {
using bf16=__hip_bfloat16;
using bf16x8=__attribute__((ext_vector_type(8)))short;
using s16x4=__attribute__((ext_vector_type(4)))short;
using f32x16=__attribute__((ext_vector_type(16)))float;
using u32x4=__attribute__((ext_vector_type(4)))unsigned;
constexpr int BATCH=8,NHEAD=16,SEQ=8192,D=64,PQ=512,PO=1024;
constexpr int NW=8,QBLK=32,QB=QBLK*NW,KVBLK=64,NQB=SEQ/QB;
constexpr int ATTN_UNIT_ROWS=QB;
__device__ __forceinline__ int crow(int r,int hi){return (r&3)+8*(r>>2)+4*hi;}
#define SBAR() __builtin_amdgcn_sched_barrier(0)
__device__ __forceinline__ void cmask(f32x16&p0,f32x16&p1,int jb,int qrel,int hi){
  const float NEG=-INFINITY; int kb=64*jb+4*hi;
  #pragma unroll
  for(int r=0;r<16;++r){int kv=kb+(r&3)+8*(r>>2); if(kv>qrel)p0[r]=NEG; if(kv+32>qrel)p1[r]=NEG;}
}

__device__ __forceinline__ void cbias(f32x16&p0,f32x16&p1,int jb,int qrel,int hi,const __attribute__((address_space(3))) float*tb){
  const int kb=64*jb+4*hi;
  #pragma unroll
  for(int r=0;r<16;++r){const int rel=qrel-(kb+(r&3)+8*(r>>2)); const int i0=min(max(rel,0),127), i1=min(max(rel-32,0),127); p0[r]+=tb[i0]; p1[r]+=tb[i1];}
}
constexpr int NSLOT=3, SLOTB=8192;
constexpr int LDS_K=0, LDS_V=NSLOT*SLOTB, LDS_WS=2*NSLOT*SLOTB, LDS_OST=LDS_WS+NW*64*4, LDS_BYTES=LDS_OST+NW*4096;
constexpr float C2=0.125f*1.4426950408889634f;
__device__ __forceinline__ void glds16(const void*gsrc,unsigned lds_dst){unsigned keep;
  asm volatile("s_mov_b32 %0, m0\n\ts_mov_b32 m0, %2\n\ts_nop 0\n\tglobal_load_lds_dwordx4 %1, off\n\ts_mov_b32 m0, %0":"=&s"(keep):"v"(gsrc),"s"(lds_dst):"memory");}
__device__ __forceinline__ float max3f(float a,float b,float c){float r;asm("v_max3_f32 %0, %1, %2, %3":"=v"(r):"v"(a),"v"(b),"v"(c));return r;}
__device__ __forceinline__ float max2f(float a,float b){float r;asm("v_max_f32_e32 %0, %1, %2":"=v"(r):"v"(a),"v"(b));return r;}
__device__ __forceinline__ float fadd_s(float a,float b){float r;asm("v_add_f32_e32 %0, %1, %2":"=v"(r):"v"(a),"v"(b));return r;}
__device__ __forceinline__ float fsub_s(float a,float b){float r;asm("v_sub_f32_e32 %0, %1, %2":"=v"(r):"v"(a),"v"(b));return r;}
typedef float f32x2_t __attribute__((ext_vector_type(2))); typedef __bf16 bf16x2_t __attribute__((ext_vector_type(2)));
__device__ __forceinline__ unsigned cvtpk_s(float lo,float hi){f32x2_t v={lo,hi};bf16x2_t b=__builtin_convertvector(v,bf16x2_t);return __builtin_bit_cast(unsigned,b);}
#define WAIT_BAR(N) asm volatile("s_waitcnt vmcnt(" #N ") lgkmcnt(0)\n\ts_barrier":::"memory")

__device__ __forceinline__ void qkt(f32x16&p0,f32x16&p1,const char*Kslot,const bf16x8*qr,const f32x16&negm,int r32,int hi){
  const char*kb=Kslot+hi*1024+r32*16;
  #pragma unroll
  for(int d0=0;d0<4;++d0){
    const bf16x8 b0=*reinterpret_cast<const bf16x8*>(kb+d0*2048);
    const bf16x8 b1=*reinterpret_cast<const bf16x8*>(kb+d0*2048+512);
    if(d0==0){p0=__builtin_amdgcn_mfma_f32_32x32x16_bf16(b0,qr[0],negm,0,0,0);p1=__builtin_amdgcn_mfma_f32_32x32x16_bf16(b1,qr[0],negm,0,0,0);}
    else{p0=__builtin_amdgcn_mfma_f32_32x32x16_bf16(b0,qr[d0],p0,0,0,0);p1=__builtin_amdgcn_mfma_f32_32x32x16_bf16(b1,qr[d0],p1,0,0,0);}}
}
typedef __attribute__((address_space(3))) const char* lds_cptr;
typedef short v4i16_t __attribute__((ext_vector_type(4)));
__device__ __forceinline__ void kload8(bf16x8*kf,lds_cptr kp){
  kf[0]=*(const __attribute__((address_space(3))) bf16x8*)(kp);      kf[1]=*(const __attribute__((address_space(3))) bf16x8*)(kp+512);
  kf[2]=*(const __attribute__((address_space(3))) bf16x8*)(kp+2048); kf[3]=*(const __attribute__((address_space(3))) bf16x8*)(kp+2560);
  kf[4]=*(const __attribute__((address_space(3))) bf16x8*)(kp+4096); kf[5]=*(const __attribute__((address_space(3))) bf16x8*)(kp+4608);
  kf[6]=*(const __attribute__((address_space(3))) bf16x8*)(kp+6144); kf[7]=*(const __attribute__((address_space(3))) bf16x8*)(kp+6656);
}
__device__ __forceinline__ void kload2(bf16x8*kf,lds_cptr kp,int j){ kf[2*j]=*(const __attribute__((address_space(3))) bf16x8*)(kp+j*2048); kf[2*j+1]=*(const __attribute__((address_space(3))) bf16x8*)(kp+j*2048+512); }
__device__ __forceinline__ s16x4 vtr(lds_cptr p){ return __builtin_bit_cast(s16x4,__builtin_amdgcn_ds_read_tr16_b64_v4i16((__attribute__((address_space(3))) v4i16_t*)p)); }
__device__ __forceinline__ float rowmax(const f32x16&p0,const f32x16&p1){
  float a=max3f(p0[0],p0[1],p1[0]),b=max3f(p0[2],p0[3],p1[1]);a=max3f(a,p1[2],p1[3]);
  #pragma unroll
  for(int r=4;r<16;r+=4){a=max3f(a,p0[r],p0[r+1]);b=max3f(b,p0[r+2],p0[r+3]);a=max3f(a,p1[r],p1[r+1]);b=max3f(b,p1[r+2],p1[r+3]);}
  const float m=max2f(a,b);
  auto rr=__builtin_amdgcn_permlane32_swap(__float_as_uint(m),__float_as_uint(m),false,false);
  return max2f(__uint_as_float(rr[0]),__uint_as_float(rr[1]));
}
__device__ __forceinline__ void pv(f32x16*o,int vb,bf16x8 pa0,bf16x8 pa1,bf16x8 pa2,bf16x8 pa3){
  #pragma unroll
  for(int d0=0;d0<2;++d0){s16x4 lo[4],hi[4];
    #pragma unroll
    for(int ks=0;ks<4;++ks){
      asm volatile("ds_read_b64_tr_b16 %0,%1 offset:%c2":"=&v"(lo[ks]):"v"(vb),"i"(d0*4096+ks*1024):"memory");
      asm volatile("ds_read_b64_tr_b16 %0,%1 offset:%c2":"=&v"(hi[ks]):"v"(vb),"i"(d0*4096+ks*1024+512):"memory");}
    asm volatile("s_waitcnt lgkmcnt(0)":::"memory");SBAR();
    #define PK(k) (bf16x8){lo[k][0],lo[k][1],lo[k][2],lo[k][3],hi[k][0],hi[k][1],hi[k][2],hi[k][3]}
    o[d0]=__builtin_amdgcn_mfma_f32_32x32x16_bf16(pa0,PK(0),o[d0],0,0,0);
    o[d0]=__builtin_amdgcn_mfma_f32_32x32x16_bf16(pa1,PK(1),o[d0],0,0,0);
    o[d0]=__builtin_amdgcn_mfma_f32_32x32x16_bf16(pa2,PK(2),o[d0],0,0,0);
    o[d0]=__builtin_amdgcn_mfma_f32_32x32x16_bf16(pa3,PK(3),o[d0],0,0,0);
    #undef PK
  }
}

#ifndef ATTN_STORE16
#define ATTN_STORE16(p,v) (*(u32x4*)(p)=(v))
#endif
template<int THRL> __device__ __forceinline__ void attn_unit(int b,int vh,int qb,const bf16*Q,const bf16*__restrict__ K,const bf16*__restrict__ V,bf16*O,char*shm,const __attribute__((address_space(3))) float*tball,const int tid){
  const int lane=tid&63,r32=lane&31,hi=lane>>5; const int wid=__builtin_amdgcn_readfirstlane(tid>>6);
  const long rowbase=(long)b*SEQ; const int q0=qb*QB;
  const int hh=vh>>2, qcol=hh*128+((vh>>1)&1)*64, vcol=hh*128+(vh&1)*64;
  const __attribute__((address_space(3))) float*tb=tball+hh*128;
  const bf16*Qw=Q+(rowbase+q0+wid*QBLK)*PQ+qcol;
  const bf16*Kh=K+rowbase*PQ+qcol,*Vh=V+rowbase*PQ+vcol;
  const unsigned lds0=(unsigned)(uintptr_t)shm;
  float*wsf=(float*)(shm+LDS_WS)+wid*64;
  const bf16*ksrc=Kh+(long)lane*PQ+wid*8;
  const bf16*vsrc=Vh+(long)(16*(wid&3)+(lane>>2))*PQ+(wid>>2)*32+(lane&3)*8;
  const unsigned kdst=lds0+LDS_K+wid*1024, vdst=lds0+LDS_V+wid*1024;
  #define DMA_K(t,slot) glds16(ksrc+(long)(t)*KVBLK*PQ,(unsigned)__builtin_amdgcn_readfirstlane(kdst+(slot)))
  #define DMA_V(t,slot) glds16(vsrc+(long)(t)*KVBLK*PQ,(unsigned)__builtin_amdgcn_readfirstlane(vdst+(slot)))
  const int vb0=(int)(lds0+LDS_V)+((lane>>4)&1)*32+(lane&3)*8+(4*hi+((lane&15)>>2))*64;
  const char*Kbase=shm+LDS_K; bf16x8 kf[8];
  const lds_cptr shm3=(lds_cptr)shm; const lds_cptr kp0=shm3+LDS_K+hi*1024+r32*16; const lds_cptr vp0=shm3+LDS_V+((lane>>4)&1)*32+(lane&3)*8+(4*hi+((lane&15)>>2))*64;
  const int NT=(q0+QB)/KVBLK;
  DMA_K(0,0);DMA_V(0,0);DMA_K(1,SLOTB);
  bf16x8 qr[4];
  #pragma unroll
  for(int d0=0;d0<4;++d0)qr[d0]=*reinterpret_cast<const bf16x8*>(&Qw[(long)r32*PQ+d0*16+hi*8]);
  float mhat=0.f,l_reg=0.f;f32x16 o[2];o[0]=f32x16{};o[1]=f32x16{};f32x16 negm=f32x16{};asm volatile("":"+v"(negm));
  const int qrel=wid*QBLK+r32;
  #define CMASK(P0,P1,t) do{int jb_=(t)-(NT-4); if(jb_>=-2){cbias(P0,P1,jb_,qrel,hi,tb); if(jb_>=0)cmask(P0,P1,jb_,qrel,hi);}}while(0)
  bool resc=false;
  #define START(P0,P1) do{ const float rm=rowmax(P0,P1); resc=false; \
    { const float dl=rm; mhat=fadd_s(mhat,dl); \
      _Pragma("unroll") for(int r=0;r<16;++r){P0[r]=fsub_s(P0[r],dl);P1[r]=fsub_s(P1[r],dl);} \
      _Pragma("unroll") for(int r=0;r<16;++r)negm[r]=-mhat; asm volatile("":"+v"(negm)); } \
    _Pragma("unroll") for(int r=0;r<16;++r)P0[r]=__builtin_amdgcn_exp2f(P0[r]); }while(0)
  #define RESC() do{ if(resc){ asm volatile("s_waitcnt lgkmcnt(0)":::"memory"); \
      _Pragma("unroll") for(int d_=0;d_<2;++d_) _Pragma("unroll") for(int r=0;r<16;++r)o[d_][r]*=wsf[crow(r,hi)]; } }while(0)
  f32x16 pA0,pA1,pB0,pB1;
  int sl_prev=0,sl_cur=0,sl_next=SLOTB;
  #define ROT() do{sl_prev=sl_cur;sl_cur=sl_next;sl_next=(sl_next==(NSLOT-1)*SLOTB)?0:sl_next+SLOTB;}while(0)
  DMA_K(2,2*SLOTB);
  WAIT_BAR(3);
  qkt(pA0,pA1,Kbase,qr,negm,r32,hi);asm volatile("s_nop 15\n\ts_nop 7":"+v"(pA0),"+v"(pA1));CMASK(pA0,pA1,0);
  START(pA0,pA1);
  _Pragma("unroll") for(int r=0;r<16;++r)pA1[r]=__builtin_amdgcn_exp2f(pA1[r]);
  WAIT_BAR(0);
  DMA_K(3,0);DMA_V(1,SLOTB);
  ROT();
  kload8(kf,kp0+sl_cur);
  WAIT_BAR(2);
  s16x4 vlo[8],vhi[8]; u32x4 pw0,pw1,pw2,pw3;
  #define PKW(P,B) cvtpk_s(P[B],P[B+1])
  #define PAF(k) __builtin_bit_cast(bf16x8,pw##k)
  #define VFR(i) (bf16x8){vlo[i][0],vlo[i][1],vlo[i][2],vlo[i][3],vhi[i][0],vhi[i][1],vhi[i][2],vhi[i][3]}
  #define PIN(x) asm volatile("":"+v"(x))
  #define MX3(a,b,c) __builtin_fmaxf(__builtin_fmaxf((a),(b)),(c))
  #define GAPA(MF,A0,A1,A2,A3,W0,W1,PW) do{ MF; sacc+=A0; sacc+=A1; sacc+=A2; sacc+=A3; PIN(sacc); W0; W1; PIN(PW); SBAR(); }while(0)
  #define EX(v) __builtin_amdgcn_exp2f(v)
  #define GAPB(MF,X,B) do{ MF; X[B]=EX(X[B]); X[B+1]=EX(X[B+1]); X[B+2]=EX(X[B+2]); X[B+3]=EX(X[B+3]); PIN(X); SBAR(); }while(0)
  #define VRD(i) do{ vlo[i]=vtr(vp_+(((i)>>2)*4096+((i)&3)*1024)); vhi[i]=vtr(vp_+(((i)>>2)*4096+((i)&3)*1024+512)); }while(0)
  #define KRD(G,j) do{ if(G){ kload2(kf,kp0+sl_next,j); SBAR(); } }while(0)
  #define STEP(C0,C1,P0,P1,t,GK,GV,GL) do{ SBAR(); \
    const lds_cptr vp_=vp0+sl_prev; \
    VRD(0); SBAR(); float sacc=(P0[0]+P0[1]); \
    GAPA(C0=__builtin_amdgcn_mfma_f32_32x32x16_bf16(kf[0],qr[0],negm,0,0,0), P0[2],P0[3],P0[4],P0[5],     pw0[0]=PKW(P0,0), pw0[1]=PKW(P0,2), pw0); \
    VRD(4); SBAR(); GAPA(C1=__builtin_amdgcn_mfma_f32_32x32x16_bf16(kf[1],qr[0],negm,0,0,0), P0[6],P0[7],P0[8],P0[9],     pw0[2]=PKW(P0,4), pw0[3]=PKW(P0,6), pw0); \
    VRD(1); SBAR(); GAPA(C0=__builtin_amdgcn_mfma_f32_32x32x16_bf16(kf[2],qr[1],C0,0,0,0),   P0[10],P0[11],P0[12],P0[13], pw1[0]=PKW(P0,8), pw1[1]=PKW(P0,10), pw1); \
    VRD(5); SBAR(); GAPA(C1=__builtin_amdgcn_mfma_f32_32x32x16_bf16(kf[3],qr[1],C1,0,0,0),   P0[14],P0[15],P1[0],P1[1],   pw1[2]=PKW(P0,12),pw1[3]=PKW(P0,14), pw1); \
    VRD(2); SBAR(); GAPA(C0=__builtin_amdgcn_mfma_f32_32x32x16_bf16(kf[4],qr[2],C0,0,0,0),   P1[2],P1[3],P1[4],P1[5],     pw2[0]=PKW(P1,0), pw2[1]=PKW(P1,2), pw2); \
    VRD(6); SBAR(); GAPA(C1=__builtin_amdgcn_mfma_f32_32x32x16_bf16(kf[5],qr[2],C1,0,0,0),   P1[6],P1[7],P1[8],P1[9],     pw2[2]=PKW(P1,4), pw2[3]=PKW(P1,6), pw2); \
    VRD(3); SBAR(); GAPA(C0=__builtin_amdgcn_mfma_f32_32x32x16_bf16(kf[6],qr[3],C0,0,0,0),   P1[10],P1[11],P1[12],P1[13], pw3[0]=PKW(P1,8), pw3[1]=PKW(P1,10), pw3); \
    VRD(7); SBAR(); GAPA(C1=__builtin_amdgcn_mfma_f32_32x32x16_bf16(kf[7],qr[3],C1,0,0,0),   P1[14],P1[15],0.f,0.f,       pw3[2]=PKW(P1,12),pw3[3]=PKW(P1,14), pw3); \
    l_reg+=sacc; \
    if(GK){DMA_K((t)+3,sl_cur);} if(GV){DMA_V((t)+1,sl_next);} \
    CMASK(C0,C1,t); \
    { float a=MX3(C0[0],C0[1],C1[0]),b=MX3(C0[2],C0[3],C1[1]); a=MX3(a,C1[2],C1[3]); \
      _Pragma("unroll") for(int r=4;r<16;r+=4){a=MX3(a,C0[r],C0[r+1]);b=MX3(b,C0[r+2],C0[r+3]);a=MX3(a,C1[r],C1[r+1]);b=MX3(b,C1[r+2],C1[r+3]);} \
      float rm=__builtin_fmaxf(a,b); { auto rr=__builtin_amdgcn_permlane32_swap(__float_as_uint(rm),__float_as_uint(rm),false,false); rm=__builtin_fmaxf(__uint_as_float(rr[0]),__uint_as_float(rr[1])); } \
      resc=false; \
      if(__builtin_expect(__any(rm>(float)THRL),0)){ const float dl=__builtin_fmaxf(rm,0.f); mhat+=dl; \
        _Pragma("unroll") for(int r=0;r<16;++r){C0[r]-=dl;C1[r]-=dl;} \
        _Pragma("unroll") for(int r=0;r<16;++r)negm[r]=-mhat; asm volatile("":"+v"(negm)); \
        const float f=__builtin_amdgcn_exp2f(-dl); l_reg*=f; if(hi==0)wsf[r32]=f; resc=true; } } \
    SBAR(); \
    GAPB(o[0]=__builtin_amdgcn_mfma_f32_32x32x16_bf16(PAF(0),VFR(0),o[0],0,0,0), C0,0); \
    GAPB(o[1]=__builtin_amdgcn_mfma_f32_32x32x16_bf16(PAF(0),VFR(4),o[1],0,0,0), C0,4); \
    KRD(GL,0); GAPB(o[0]=__builtin_amdgcn_mfma_f32_32x32x16_bf16(PAF(1),VFR(1),o[0],0,0,0), C0,8); \
    KRD(GL,1); GAPB(o[1]=__builtin_amdgcn_mfma_f32_32x32x16_bf16(PAF(1),VFR(5),o[1],0,0,0), C0,12); \
    KRD(GL,2); GAPB(o[0]=__builtin_amdgcn_mfma_f32_32x32x16_bf16(PAF(2),VFR(2),o[0],0,0,0), C1,0); \
    KRD(GL,3); GAPB(o[1]=__builtin_amdgcn_mfma_f32_32x32x16_bf16(PAF(2),VFR(6),o[1],0,0,0), C1,4); \
    GAPB(o[0]=__builtin_amdgcn_mfma_f32_32x32x16_bf16(PAF(3),VFR(3),o[0],0,0,0), C1,8); \
    GAPB(o[1]=__builtin_amdgcn_mfma_f32_32x32x16_bf16(PAF(3),VFR(7),o[1],0,0,0), C1,12); \
    }while(0)
  int t=1;
  #undef CMASK
  #define CMASK(P0,P1,t) do{}while(0)
  for(;t+7<NT;t+=2){
    STEP(pB0,pB1,pA0,pA1,t,true,true,true);     WAIT_BAR(2); RESC(); ROT();
    STEP(pA0,pA1,pB0,pB1,t+1,true,true,true);   WAIT_BAR(2); RESC(); ROT();
  }
  #undef CMASK
  #define CMASK(P0,P1,t) do{int jb_=(t)-(NT-4); if(jb_>=-2){cbias(P0,P1,jb_,qrel,hi,tb); if(jb_>=0)cmask(P0,P1,jb_,qrel,hi);}}while(0)
  #define ENDW(tt) do{ if((tt)+3<NT){WAIT_BAR(2);} else if((tt)+2<NT){WAIT_BAR(1);} else {WAIT_BAR(0);} }while(0)
  for(;t+1<NT;t+=2){
    STEP(pB0,pB1,pA0,pA1,t,(t+3<NT),(t+1<NT),(t+1<NT));       ENDW(t);   RESC(); ROT();
    STEP(pA0,pA1,pB0,pB1,t+1,(t+4<NT),(t+2<NT),(t+2<NT));     ENDW(t+1); RESC(); ROT();
  }
  STEP(pB0,pB1,pA0,pA1,NT-1,false,false,false); RESC();
  { float sacc=pB0[0]+pB0[1]; _Pragma("unroll") for(int r=2;r<16;++r)sacc+=pB0[r]; _Pragma("unroll") for(int r=0;r<16;++r)sacc+=pB1[r]; l_reg+=sacc;
    pw0=(u32x4){PKW(pB0,0),PKW(pB0,2),PKW(pB0,4),PKW(pB0,6)};pw1=(u32x4){PKW(pB0,8),PKW(pB0,10),PKW(pB0,12),PKW(pB0,14)};pw2=(u32x4){PKW(pB1,0),PKW(pB1,2),PKW(pB1,4),PKW(pB1,6)};pw3=(u32x4){PKW(pB1,8),PKW(pB1,10),PKW(pB1,12),PKW(pB1,14)};
    SBAR(); pv(o,vb0+sl_cur,PAF(0),PAF(1),PAF(2),PAF(3)); }
  #undef PKW
  #undef PAF
  #undef VFR
  #undef PIN
  #undef MX3
  #undef GAPA
  #undef GAPB
  #undef EX
  #undef VRD
  #undef KRD
  #undef STEP
  #undef ENDW
  {auto rr=__builtin_amdgcn_permlane32_swap(__float_as_uint(l_reg),__float_as_uint(l_reg),false,false);l_reg=__uint_as_float(rr[0])+__uint_as_float(rr[1]);}
  if(hi==0)wsf[32+r32]=l_reg;asm volatile("s_waitcnt lgkmcnt(0)":::"memory");
  float rli[16];
  #pragma unroll
  for(int r=0;r<16;++r)rli[r]=__builtin_amdgcn_rcpf(wsf[32+crow(r,hi)]);
  bf16*Ow=O+(rowbase+q0+wid*QBLK)*PO+vh*D;
  { bf16*stg=(bf16*)(shm+LDS_OST)+wid*2048;
    #pragma unroll
    for(int r=0;r<16;++r){const int orow=crow(r,hi);
      #pragma unroll
      for(int d0=0;d0<2;++d0)stg[orow*64+d0*32+r32]=__float2bfloat16(o[d0][r]*rli[r]);}
    asm volatile("s_waitcnt lgkmcnt(0)":::"memory");
    #pragma unroll
    for(int i=0;i<4;++i){const int row=i*8+(lane>>3),ch=lane&7; const u32x4 v=*(const u32x4*)(stg+row*64+ch*8); ATTN_STORE16(Ow+(long)row*PO+ch*8,v);} }
  asm volatile("s_waitcnt lgkmcnt(0)\n\ts_barrier":::"memory");
  #undef DMA_K
  #undef DMA_V
  #undef CMASK
  #undef START
  #undef RESC
  #undef ROT
}
constexpr int ATTN_LDS_BYTES=LDS_BYTES;
struct AttnTensors { const bf16* Q; const bf16* K; const bf16* V; bf16* O; };
struct AttnUnit { int bh; int qb; };
__device__ __forceinline__ bool attn_next(int vcu,int i,AttnUnit&u){ if(i>=16)return false; const int s=vcu&7, j=i&3; u.bh=(vcu>>3)+32*(i>>2); u.qb=(j==0)?s:(j==1)?15-s:(j==2)?16+s:31-s; return true; }
template<int THRL=8> __device__ __forceinline__ void attn_phase(char*lds,const AttnTensors&T,int vcu,const __attribute__((address_space(3))) float*tball,const int tid){
  AttnUnit u;
  for(int i=0;attn_next(vcu,i,u);++i){ attn_unit<THRL>(u.bh/NHEAD,u.bh%NHEAD,u.qb,T.Q,T.K,T.V,T.O,lds,tball,tid); }
}
#undef SBAR
#undef WAIT_BAR
}

#define XB_TMO      128
#define XB_XCNT(j)  (256  + 64 * (j))
#define XB_XSUB(j)  (1280 + 64 * (j))
#define XB_XGEN(j)  (2304 + 64 * (j))
#define XB_TOP      3328
#define XB_TOPGEN   3392
#define XCD_BAR_WORDS 3456
#define XB_SPIN_CAP (1u << 18)

__device__ __forceinline__ unsigned xb_ld(unsigned* p)              { return __hip_atomic_load(p, __ATOMIC_RELAXED, __HIP_MEMORY_SCOPE_AGENT); }
__device__ __forceinline__ unsigned xb_add(unsigned* p, unsigned v) { return __hip_atomic_fetch_add(p, v, __ATOMIC_RELAXED, __HIP_MEMORY_SCOPE_AGENT); }
__device__ __forceinline__ unsigned xb_xcc_id() { return (unsigned)__builtin_amdgcn_s_getreg((3 << 11) | 20) & 0xFu; }
#define XB_SPIN(cond, bar) do { unsigned _sp = 0; while (cond) { __builtin_amdgcn_s_sleep(1); \
    if ((++_sp & 255u) == 0u) { if (xb_ld(&(bar)[XB_TMO])) break; if (_sp > XB_SPIN_CAP) { atomicAdd(&(bar)[XB_TMO], 1u); break; } } } } while (0)

struct XcdBarrier {
    unsigned* bar; unsigned x;
    volatile LAS unsigned* st;
};

__device__ __forceinline__ XcdBarrier xcd_barrier_post(unsigned* bar, volatile LAS unsigned* st, const bool leader  ) {
    XcdBarrier b; b.bar = bar; b.x = xb_xcc_id(); b.st = st;
    if (leader) (void)xb_add(&bar[XB_XCNT(b.x)], 1u);
    return b;
}
__device__ __forceinline__ void xcd_barrier_complete(unsigned* bar, unsigned x, unsigned& nloc, unsigned& nx) {
    const unsigned G = gridDim.x * gridDim.y * gridDim.z;
    unsigned sum, cnt, mine, sp = 0u;
    for (;;) {
        sum = 0u; cnt = 0u; mine = 0u;
#pragma unroll
        for (unsigned j = 0; j < 16; ++j) { const unsigned c = xb_ld(&bar[XB_XCNT(j)]); sum += c; cnt += (c > 0u) ? 1u : 0u; mine = (j == x) ? c : mine; }
        if (sum == G) break;
        __builtin_amdgcn_s_sleep(1);
        if ((++sp & 255u) == 0u) { if (xb_ld(&bar[XB_TMO])) break; if (sp > XB_SPIN_CAP) { atomicAdd(&bar[XB_TMO], 1u); break; } }
    }
    nloc = mine > 0u ? mine : 1u; nx = cnt > 0u ? cnt : 1u;
}

__device__ __forceinline__ void xcd_barrier(const XcdBarrier& b, const bool leader  ) {
    asm volatile("s_waitcnt vmcnt(0)" ::: "memory");
    __syncthreads();
    if (leader) {
        unsigned* bar = b.bar;
        __builtin_amdgcn_s_waitcnt(0);
        unsigned nloc = b.st[0], nx = b.st[1];
        if (nloc == 0u) { xcd_barrier_complete(bar, b.x, nloc, nx); b.st[0] = nloc; b.st[1] = nx; }
        const unsigned old = xb_add(&bar[XB_XSUB(b.x)], 1u);
        const unsigned gen = old / nloc;
        if (old + 1u == (gen + 1u) * nloc) {
            __builtin_amdgcn_fence(__ATOMIC_RELEASE, "agent");
            asm volatile("s_waitcnt vmcnt(0)" ::: "memory");
            const unsigned og = xb_add(&bar[XB_TOP], 1u);
            const unsigned tg = og / nx;
            if (og + 1u == (tg + 1u) * nx) xb_add(&bar[XB_TOPGEN], 1u);
            else XB_SPIN(xb_ld(&bar[XB_TOPGEN]) == tg, bar);
            __builtin_amdgcn_fence(__ATOMIC_ACQUIRE, "agent");
            xb_add(&bar[XB_XGEN(b.x)], 1u);
            asm volatile("s_waitcnt vmcnt(0)" ::: "memory");
        } else {
            XB_SPIN(xb_ld(&bar[XB_XGEN(b.x)]) == gen, bar);
            __builtin_amdgcn_fence(__ATOMIC_ACQUIRE, "agent");
            asm volatile("s_waitcnt vmcnt(0)" ::: "memory");
        }
    }
    __syncthreads();
}

constexpr size_t MiB = 1u << 20;
constexpr size_t WS_CTL = 0, CTL_ZERO_BYTES = 1 * MiB;
constexpr size_t WS_WIN = 2 * MiB;
constexpr size_t WS_WOUT = 7 * MiB;
constexpr size_t WS_PGATE = 9 * MiB;
constexpr size_t WS_PPROJ = 13 * MiB;
constexpr size_t WS_RCAT = 14 * MiB;
constexpr size_t WS_RL1 = 20 * MiB;
constexpr size_t WS_RS2 = 28 * MiB;
constexpr size_t WS_RWO = 30 * MiB;
constexpr size_t WS_ROUT = 32 * MiB;
constexpr size_t WS_LRUAGG = 33 * MiB;
constexpr size_t WS_MGU = 38 * MiB;
constexpr size_t WS_MDN = 102 * MiB;
constexpr size_t WS_PB = 134 * MiB;
constexpr size_t WS_ACT = 166 * MiB;
constexpr size_t WS_H0 = WS_ACT;
constexpr size_t WS_QKV = WS_ACT + 128 * MiB;
constexpr size_t WS_O = WS_ACT + 448 * MiB;
constexpr size_t WS_HL = WS_ACT + 576 * MiB, WS_CA = WS_ACT + 640 * MiB;
constexpr size_t WS_H2 = WS_ACT;
constexpr size_t WS_LOG = WS_ACT + 128 * MiB;
constexpr size_t WS_ROUTE = WS_ACT + 144 * MiB;
constexpr size_t WS_HID = WS_ACT + 152 * MiB;
constexpr size_t WS_YS = WS_ACT + 288 * MiB;
constexpr size_t WS_PP = WS_ACT + 128 * MiB;
constexpr size_t WS_HCAT = WS_ACT;
constexpr size_t WS_XR = WS_ACT + 256 * MiB, WS_XK = WS_ACT + 384 * MiB, WS_XV = WS_ACT + 512 * MiB;
constexpr size_t WS_R = WS_ACT + 640 * MiB, WS_K = WS_XR, WS_V = WS_XK;
constexpr size_t WS_MID = WS_ACT + 768 * MiB;
constexpr size_t WS_EW = WS_ACT;
constexpr size_t WS_AA = WS_ACT + 128 * MiB;
constexpr size_t WS_Y = WS_XV;
constexpr size_t WS_END = WS_ACT + 832 * MiB;
static_assert(WS_END <= 1024 * MiB, "workspace map");
constexpr size_t RT_EID = 0, RT_POS = 1 * MiB, RT_GATE = 2 * MiB, RT_ROWTOK = 3 * MiB, RT_ROWGATE = 4 * MiB, RT_SLOT = 5 * MiB;
constexpr int CW_BAR = 4096;
constexpr int CW_CNT0 = 16384, CW_CNT1 = 16384 + 64;

constexpr int RING_BYTES = 131072;
constexpr int LDSCTL_OFF = RING_BYTES, MISC_OFF = LDSCTL_OFF + 320;
constexpr int TB_OFF = RING_BYTES + 1024;
constexpr int RTE_OFF = TB_OFF + 2048;
constexpr int LDS_BYTES = 147456;

constexpr int NWAVES = 8;
__device__ __forceinline__ int lane_id_() { int l; asm volatile("v_mbcnt_lo_u32_b32 %0, -1, 0\n\tv_mbcnt_hi_u32_b32 %0, -1, %0" : "=v"(l)); return l; }
#define TID_ (F.wave * 64 + lane_id_())
#define LANE_ (lane_id_())
struct Frame {
    LAS unsigned char* lds; volatile LAS unsigned* MISC; gu32* ctl;
    int wave, vcu, G;
};

__device__ __forceinline__ void load_row4(const float* xrow, int lane, f32x4 (&v)[4]) { const f32x4* p = (const f32x4*)xrow + lane;
#pragma unroll
    for (int j = 0; j < 4; ++j) v[j] = p[64 * j]; }
__device__ __forceinline__ float row_rstd(const f32x4 (&v)[4], float eps) { float s = 0.f;
#pragma unroll
    for (int j = 0; j < 4; ++j) s += (v[j].x * v[j].x + v[j].y * v[j].y) + (v[j].z * v[j].z + v[j].w * v[j].w);
    return 1.0f / sqrtf(wave_sum(s) * (1.0f / 1024.0f) + eps); }
__device__ __forceinline__ void load_row4_bf(const bf16* xrow, int lane, f32x4 (&v)[4]) { const v2u* p = (const v2u*)xrow + lane;
#pragma unroll
    for (int j = 0; j < 4; ++j) { const v2u w = p[64 * j]; v[j] = (f32x4){bflo(w.x), bfhi(w.x), bflo(w.y), bfhi(w.y)}; } }
__device__ __forceinline__ void store_row4_bf(bf16* xrow, int lane, const f32x4 (&v)[4]) { v2u* p = (v2u*)xrow + lane;
#pragma unroll
    for (int j = 0; j < 4; ++j) { v2u o; o.x = pk2(v[j].x, v[j].y); o.y = pk2(v[j].z, v[j].w); p[64 * j] = o; } }
__device__ __forceinline__ void store_row_bf16(bf16* orow, int lane, const f32x4 (&v)[4], float rstd, const float* g) {
    unsigned long long* o8 = (unsigned long long*)orow + lane;
#pragma unroll
    for (int j = 0; j < 4; ++j) { const f32x4 gg = ((const f32x4*)g)[lane + 64 * j];
        o8[64 * j] = (unsigned long long)pk2(v[j].x * rstd * gg.x, v[j].y * rstd * gg.y) | ((unsigned long long)pk2(v[j].z * rstd * gg.z, v[j].w * rstd * gg.w) << 32); }
}

template <int MODE>
__device__ __forceinline__ void transpose_item(const float* W, int K, int N, bf16* WT, int ldo, int row_off, const float* mu, LAS float* scr, int item, int lane) {
    const int nblk = N / 32, kb = item / nblk, nb = item % nblk, k0 = 64 * kb, n0 = 32 * nb;
    float ld[32];
#pragma unroll
    for (int i = 0; i < 32; ++i) { const int kk = 2 * i + (lane >> 5); ld[i] = W[(size_t)(k0 + kk) * N + n0 + (lane & 31)]; }
#pragma unroll
    for (int i = 0; i < 32; ++i) { const int kk = 2 * i + (lane >> 5); scr[kk * 33 + (lane & 31)] = ld[i]; }
    LDS_WAIT(); asm volatile("" ::: "memory");
    const int c = lane & 7;
    int rbase = row_off + n0;
    if (MODE == 2) { rbase = row_off + ((n0 < 512) ? ((n0 >> 7) * 256 + (n0 & 127)) : (((n0 - 512) >> 7) * 256 + 128 + ((n0 - 512) & 127))); }
    float m[8];
    if (MODE == 1) {
#pragma unroll
        for (int e = 0; e < 8; ++e) m[e] = mu[k0 + 8 * c + e]; }
#pragma unroll
    for (int j = 0; j < 4; ++j) { const int n = (lane >> 3) + 8 * j; const LAS float* s = scr + (8 * c) * 33 + n;
        float v[8];
#pragma unroll
        for (int e = 0; e < 8; ++e) v[e] = s[e * 33];
        bf16* dst = WT + (size_t)(rbase + n) * ldo + k0 + 8 * c;
        if (MODE == 1) {
            v4u o, o2;
            o.x = pk2(v[0] * (1.f - m[0]), v[1] * (1.f - m[1])); o.y = pk2(v[2] * (1.f - m[2]), v[3] * (1.f - m[3])); o.z = pk2(v[4] * (1.f - m[4]), v[5] * (1.f - m[5])); o.w = pk2(v[6] * (1.f - m[6]), v[7] * (1.f - m[7]));
            o2.x = pk2(v[0] * m[0], v[1] * m[1]); o2.y = pk2(v[2] * m[2], v[3] * m[3]); o2.z = pk2(v[4] * m[4], v[5] * m[5]); o2.w = pk2(v[6] * m[6], v[7] * m[7]);
            *(GAS v4u*)dst = o; *(GAS v4u*)(dst + 1024) = o2;
        } else {
            v4u o; o.x = pk2(v[0], v[1]); o.y = pk2(v[2], v[3]); o.z = pk2(v[4], v[5]); o.w = pk2(v[6], v[7]);
            *(GAS v4u*)dst = o; }
    }
    LDS_WAIT(); asm volatile("" ::: "memory");
}

struct In {
    const float *x, *p, *rel_bias, *norm_mix, *ab_w_in, *ab_w_out, *lam_q1, *lam_k1, *lam_q2, *lam_k2, *sub_g, *conv_w, *conv_b, *lru_wa, *lru_ba, *lru_wx, *lru_bx, *lru_lambda,
        *rwkv_mu, *rwkv_wr, *rwkv_wk, *rwkv_wv, *rwkv_wo, *rwkv_w0, *rwkv_w1, *rwkv_w2, *rwkv_a0, *rwkv_a1, *rwkv_a2, *rwkv_g1, *rwkv_g2, *rwkv_kk, *rwkv_ka, *rwkv_rk, *rwkv_ln_g, *rwkv_ln_b,
        *norm_ffn, *moe_wc, *moe_bc, *moe_wf, *moe_bf, *moe_w_gu, *moe_w_down, *ple_norm, *ple_gate, *ple_proj, *final_norm;
};

__device__ __forceinline__ void prep_dense_weights(Frame& F, const In& I, unsigned char* ws) {
    LAS float* scr = (LAS float*)(F.lds + F.wave * 16384);
    const int gw = F.vcu * NWAVES + F.wave, NGW = F.G * NWAVES;
    bf16* WIN = (bf16*)(ws + WS_WIN); bf16* WOUT = (bf16*)(ws + WS_WOUT); bf16* PG = (bf16*)(ws + WS_PGATE); bf16* PPJ = (bf16*)(ws + WS_PPROJ);
    bf16* RCAT = (bf16*)(ws + WS_RCAT); bf16* RL1 = (bf16*)(ws + WS_RL1); bf16* RWO = (bf16*)(ws + WS_RWO);
    constexpr int I_IN = (1024 / 64) * (2560 / 32), I_SQ = (1024 / 64) * (1024 / 32), I_PJ = (256 / 64) * (1024 / 32), I_L64 = (1024 / 64) * (64 / 32), I_L160 = (1024 / 64) * (160 / 32);
    int st = gw;
#define TJOB(MODE, NITEMS, W, K, N, WT, LDO, ROFF, MU) do { for (int it = st; it < (NITEMS); it += NGW) transpose_item<MODE>(W, K, N, WT, LDO, ROFF, MU, scr, it, LANE_); \
        st = (st + NGW - ((NITEMS) % NGW)) % NGW; asm volatile("" : "+s"(st)); } while (0)
    TJOB(0, I_IN, I.ab_w_in, 1024, 2560, WIN, 1024, 0, nullptr);
    TJOB(0, I_SQ, I.ab_w_out, 1024, 1024, WOUT, 1024, 0, nullptr);
    TJOB(0, I_SQ, I.ple_gate, 1024, 1024, PG, 1024, 0, nullptr);
    TJOB(0, I_SQ, I.ple_gate + 1024 * 1024, 1024, 1024, PG + 1024 * 1024, 1024, 0, nullptr);
    TJOB(0, I_SQ, I.rwkv_wo, 1024, 1024, RWO, 1024, 0, nullptr);
    TJOB(0, I_SQ, I.rwkv_wr, 1024, 1024, RCAT, 1024, 0, nullptr);
    TJOB(0, I_SQ, I.rwkv_wk, 1024, 1024, RCAT, 1024, 1024, nullptr);
    TJOB(0, I_SQ, I.rwkv_wv, 1024, 1024, RCAT, 1024, 2048, nullptr);
    TJOB(0, I_PJ, I.ple_proj, 256, 1024, PPJ, 256, 0, nullptr);
    TJOB(0, I_PJ, I.ple_proj + 256 * 1024, 256, 1024, PPJ + 1024 * 256, 256, 0, nullptr);
    TJOB(1, I_L64, I.rwkv_w1, 1024, 64, RL1, 2048, 0, I.rwkv_mu + 1 * 1024);
    TJOB(1, I_L64, I.rwkv_a1, 1024, 64, RL1, 2048, 64, I.rwkv_mu + 4 * 1024);
    TJOB(1, I_L160, I.rwkv_g1, 1024, 160, RL1, 2048, 256, I.rwkv_mu + 5 * 1024);
#undef TJOB
    const int gt = F.vcu * 512 + TID_, NGT = F.G * 512;
    { v4u z = {0u, 0u, 0u, 0u}; const int per_row = 2048 / 8;
      for (int i = gt; i < (128 + 96) * per_row; i += NGT) { int rr = i / per_row, cc = i % per_row; rr = (rr < 128) ? (128 + rr) : (416 + rr - 128); *(GAS v4u*)(RL1 + (size_t)rr * 2048 + cc * 8) = z; } }
    { bf16* S2 = (bf16*)(ws + WS_RS2);
      for (int i = gt; i < 3 * 1024 * 256; i += NGT) { const int ty = i / (1024 * 256), n = (i / 256) & 1023, k = i & 255; float v = 0.f;
          if (ty == 0) { if (k < 64) v = I.rwkv_w2[k * 1024 + n]; } else if (ty == 1) { if (k >= 64 && k < 128) v = I.rwkv_a2[(k - 64) * 1024 + n]; } else { if (k < 160) v = I.rwkv_g2[k * 1024 + n]; }
          S2[i] = (bf16)f2bf(v); } }
    { bf16* RT = (bf16*)(ws + WS_ROUT);
      for (int i = gt; i < 2 * 256 * 1024; i += NGT) { const int l = i / (256 * 1024), n = (i / 1024) & 255, k = i & 1023; float v = 0.f;
          if (n < 4) v = I.moe_wc[(size_t)l * 1024 * 4 + k * 4 + n]; else if (n < 36) v = I.moe_wf[(size_t)l * 1024 * 32 + k * 32 + (n - 4)];
          RT[i] = (bf16)f2bf(v); } }
}
__device__ __forceinline__ void prep_layer_weights(Frame& F, const In& I, unsigned char* ws, int layer) {
    LAS float* scr = (LAS float*)(F.lds + F.wave * 16384);
    const int gw = F.vcu * NWAVES + F.wave, NGW = F.G * NWAVES;
    bf16* MGU = (bf16*)(ws + WS_MGU); bf16* MDN = (bf16*)(ws + WS_MDN);
    const float* wgu = I.moe_w_gu + (size_t)layer * NEXP * 1024 * 1024; const float* wdn = I.moe_w_down + (size_t)layer * NEXP * 512 * 1024;
    constexpr int I_GU = (1024 / 64) * (1024 / 32), I_DN = (512 / 64) * (1024 / 32);
    for (int it = gw; it < NEXP * (I_GU + I_DN); it += NGW) {
        const int e = it / (I_GU + I_DN); int r = it % (I_GU + I_DN);
        if (r < I_GU) transpose_item<2>(wgu + (size_t)e * 1024 * 1024, 1024, 1024, MGU + (size_t)e * 1024 * 1024, 1024, 0, nullptr, scr, r, LANE_);
        else transpose_item<0>(wdn + (size_t)e * 512 * 1024, 512, 1024, MDN + (size_t)e * 1024 * 512, 512, 0, nullptr, scr, r - I_GU, LANE_);
    }
    const int gt = F.vcu * 512 + TID_, NGT = F.G * 512;
    const f32x4* ps = (const f32x4*)(I.p + (size_t)layer * T * PLE); v2u* pd = (v2u*)(ws + WS_PB);
    for (int i = gt; i < T * PLE / 4; i += 4 * NGT) { f32x4 v[4];
#pragma unroll
        for (int r = 0; r < 4; ++r) v[r] = ps[i + r * NGT];
#pragma unroll
        for (int r = 0; r < 4; ++r) { v2u o; o.x = pk2(v[r].x, v[r].y); o.y = pk2(v[r].z, v[r].w); pd[i + r * NGT] = o; } }
}

template <bool XBF>
__device__ __forceinline__ void norm_pass(Frame& F, const void* x, const float* g, bf16* out) {
    const int gw = F.vcu * NWAVES + F.wave, NGW = F.G * NWAVES; const int lane = LANE_;
    for (int t = 4 * gw; t < T; t += 4 * NGW) {
        f32x4 v[4][4];
#pragma unroll
        for (int r = 0; r < 4; ++r) { if (XBF) load_row4_bf((const bf16*)x + (size_t)(t + r) * D, lane, v[r]); else load_row4((const float*)x + (size_t)(t + r) * D, lane, v[r]); }
#pragma unroll
        for (int r = 0; r < 4; ++r) { const float rs = row_rstd(v[r], 1e-6f); store_row_bf16(out + (size_t)(t + r) * D, lane, v[r], rs, g); }
    }
}
__device__ __forceinline__ void rwkv_input_pass(Frame& F, const bf16* x, const float* g, const float* mu, bf16* HCAT, bf16* XR, bf16* XK, bf16* XV) {
    const int gw = F.vcu * NWAVES + F.wave, NGW = F.G * NWAVES; const int lane = LANE_;
    f32x4 gg[4], mr[4], mk[4], mv[4];
#pragma unroll
    for (int j = 0; j < 4; ++j) { gg[j] = ((const f32x4*)g)[lane + 64 * j]; mr[j] = ((const f32x4*)(mu + 0 * 1024))[lane + 64 * j]; mk[j] = ((const f32x4*)(mu + 2 * 1024))[lane + 64 * j]; mv[j] = ((const f32x4*)(mu + 3 * 1024))[lane + 64 * j]; }
    for (int blk = gw; blk < T / 32; blk += NGW) {
        const int t0 = blk * 32; f32x4 hp[4];
        if ((t0 & (SEQ - 1)) == 0) {
#pragma unroll
            for (int j = 0; j < 4; ++j) hp[j] = (f32x4){0.f, 0.f, 0.f, 0.f};
        } else { f32x4 v[4]; load_row4_bf(x + (size_t)(t0 - 1) * D, lane, v); const float rstd = row_rstd(v, 1e-6f);
#pragma unroll
            for (int j = 0; j < 4; ++j) hp[j] = v[j] * rstd * gg[j]; }
        f32x4 vn[4]; load_row4_bf(x + (size_t)t0 * D, lane, vn);
        for (int t = t0; t < t0 + 32; ++t) {
            f32x4 v[4];
#pragma unroll
            for (int j = 0; j < 4; ++j) v[j] = vn[j];
            if (t + 1 < t0 + 32) load_row4_bf(x + (size_t)(t + 1) * D, lane, vn);
            const float rstd = row_rstd(v, 1e-6f);
            unsigned long long* oh = (unsigned long long*)(HCAT + (size_t)t * 2048) + lane; unsigned long long* or_ = (unsigned long long*)(XR + (size_t)t * 1024) + lane;
            unsigned long long* ok = (unsigned long long*)(XK + (size_t)t * 1024) + lane; unsigned long long* ov = (unsigned long long*)(XV + (size_t)t * 1024) + lane;
#pragma unroll
            for (int j = 0; j < 4; ++j) { const f32x4 h = v[j] * rstd * gg[j], dd = hp[j] - h;
                oh[64 * j] = (unsigned long long)pk2(h.x, h.y) | ((unsigned long long)pk2(h.z, h.w) << 32);
                oh[256 + 64 * j] = (unsigned long long)pk2(hp[j].x, hp[j].y) | ((unsigned long long)pk2(hp[j].z, hp[j].w) << 32);
                const f32x4 a = h + dd * mr[j], b = h + dd * mk[j], c = h + dd * mv[j];
                or_[64 * j] = (unsigned long long)pk2(a.x, a.y) | ((unsigned long long)pk2(a.z, a.w) << 32);
                ok[64 * j] = (unsigned long long)pk2(b.x, b.y) | ((unsigned long long)pk2(b.z, b.w) << 32);
                ov[64 * j] = (unsigned long long)pk2(c.x, c.y) | ((unsigned long long)pk2(c.z, c.w) << 32);
                hp[j] = h; }
        }
    }
}
__device__ __forceinline__ void combine_norm_pass(Frame& F, const bf16* xin, bf16* xout, const bf16* YS, const int* slot, const float* g, bf16* out) {
    const int gw = F.vcu * NWAVES + F.wave, NGW = F.G * NWAVES; const int lane = LANE_;
    for (int t = 2 * gw; t < T; t += 2 * NGW) {
        f32x4 v[2][4]; v2u ya[2][4], yb[2][4];
#pragma unroll
        for (int r = 0; r < 2; ++r) { load_row4_bf(xin + (size_t)(t + r) * D, lane, v[r]);
            const int s0 = slot[2 * (t + r)], s1 = slot[2 * (t + r) + 1];
            const v2u* y0 = (const v2u*)(YS + (size_t)s0 * D) + lane; const v2u* y1 = (const v2u*)(YS + (size_t)s1 * D) + lane;
#pragma unroll
            for (int j = 0; j < 4; ++j) { ya[r][j] = y0[64 * j]; yb[r][j] = y1[64 * j]; } }
#pragma unroll
        for (int r = 0; r < 2; ++r) {
#pragma unroll
            for (int j = 0; j < 4; ++j) { const v2u a = ya[r][j], b = yb[r][j];
                v[r][j].x += bflo(a.x) + bflo(b.x); v[r][j].y += bfhi(a.x) + bfhi(b.x); v[r][j].z += bflo(a.y) + bflo(b.y); v[r][j].w += bfhi(a.y) + bfhi(b.y); }
            store_row4_bf(xout + (size_t)(t + r) * D, lane, v[r]);
            const float rstd = row_rstd(v[r], 1e-6f);
            store_row_bf16(out + (size_t)(t + r) * D, lane, v[r], rstd, g); }
    }
}
__device__ __forceinline__ void final_norm_pass(Frame& F, const bf16* x, float* out, const float* g) {
    const int gw = F.vcu * NWAVES + F.wave, NGW = F.G * NWAVES; const int lane = LANE_;
    for (int t = 4 * gw; t < T; t += 4 * NGW) {
        f32x4 v[4][4];
#pragma unroll
        for (int r = 0; r < 4; ++r) load_row4_bf(x + (size_t)(t + r) * D, lane, v[r]);
#pragma unroll
        for (int r = 0; r < 4; ++r) { const float rs = row_rstd(v[r], 1e-6f); f32x4* xo = (f32x4*)(out + (size_t)(t + r) * D) + lane;
#pragma unroll
            for (int j = 0; j < 4; ++j) { const f32x4 gg = ((const f32x4*)g)[lane + 64 * j]; xo[64 * j] = v[r][j] * rs * gg; } }
    }
}

__device__ __forceinline__ void diff_combine_pass(Frame& F, const In& I, const bf16* O, bf16* YCAT) {
    const int gw = F.vcu * NWAVES + F.wave, NGW = F.G * NWAVES;
    const float lam_init = 0.2f;
    const float d1 = wave_sum(I.lam_q1[LANE_] * I.lam_k1[LANE_]), d2 = wave_sum(I.lam_q2[LANE_] * I.lam_k2[LANE_]);
    const float lam = expf(d1) - expf(d2) + lam_init;
    const int h = LANE_ >> 4, q = LANE_ & 15;
    float sg[8];
#pragma unroll
    for (int e = 0; e < 8; ++e) sg[e] = I.sub_g[q * 8 + e] * (1.0f - lam_init);
    for (int t0 = 4 * gw; t0 < T; t0 += 4 * NGW) {
        v4u av[4], bv[4];
#pragma unroll
        for (int r = 0; r < 4; ++r) { av[r] = *(const v4u*)(O + (size_t)(t0 + r) * 1024 + h * 256 + q * 8); bv[r] = *(const v4u*)(O + (size_t)(t0 + r) * 1024 + h * 256 + 128 + q * 8); }
#pragma unroll
        for (int r = 0; r < 4; ++r) { const v4u a = av[r], b = bv[r]; const int t = t0 + r;
        float o[8];
        o[0] = bflo(a.x) - lam * bflo(b.x); o[1] = bfhi(a.x) - lam * bfhi(b.x); o[2] = bflo(a.y) - lam * bflo(b.y); o[3] = bfhi(a.y) - lam * bfhi(b.y);
        o[4] = bflo(a.z) - lam * bflo(b.z); o[5] = bfhi(a.z) - lam * bfhi(b.z); o[6] = bflo(a.w) - lam * bflo(b.w); o[7] = bfhi(a.w) - lam * bfhi(b.w);
        float s = 0.f;
#pragma unroll
        for (int e = 0; e < 8; ++e) s += o[e] * o[e];
        s += __shfl_xor(s, 1); s += __shfl_xor(s, 2); s += __shfl_xor(s, 4); s += __shfl_xor(s, 8);
        const float rstd = 1.0f / sqrtf(s * (1.0f / 128.0f) + 1e-5f);
        v4u w; w.x = pk2(o[0] * rstd * sg[0], o[1] * rstd * sg[1]); w.y = pk2(o[2] * rstd * sg[2], o[3] * rstd * sg[3]); w.z = pk2(o[4] * rstd * sg[4], o[5] * rstd * sg[5]); w.w = pk2(o[6] * rstd * sg[6], o[7] * rstd * sg[7]);
        *(v4u*)(YCAT + (size_t)t * 1024 + h * 128 + q * 8) = w; }
    }
}

constexpr int LCT = 64, LNCH = SEQ / LCT;
__device__ __forceinline__ float gelu_tanh(float x) { const float u = 0.7978845608028654f * (x + 0.044715f * x * x * x); return x * sigmoidf_(2.0f * u); }
template <bool FINAL>
__device__ __forceinline__ void lru_phase(Frame& F, const In& I, const bf16* XB, const bf16* GB, f32x2* AGG, bf16* YCAT, bf16* HLp, bf16* CAp) {
    const int ch = TID_, n = ch >> 6, d = ch & 63;
    LAS float* U = (LAS float*)F.lds;
    f32x2 wg[64];
#pragma unroll
    for (int c = 0; c < 64; ++c) { wg[c].x = I.lru_wa[n * 4096 + c * 64 + d]; wg[c].y = I.lru_wx[n * 4096 + c * 64 + d]; }
    const float cw0 = I.conv_w[0 * 512 + ch], cw1 = I.conv_w[1 * 512 + ch], cw2 = I.conv_w[2 * 512 + ch], cw3 = I.conv_w[3 * 512 + ch], cb = I.conv_b[ch];
    const float ba = I.lru_ba[ch], bx = I.lru_bx[ch];
    const float lam = I.lru_lambda[ch]; const float sp = (lam > 15.f) ? expf(-lam) : log1pf(expf(-lam));
    const float m8sp = -8.0f * sp;
    for (int un = blockIdx.x; un < NB * LNCH; un += F.G) {
        const int b = un / LNCH, c = un % LNCH; const size_t row0 = (size_t)b * SEQ + (size_t)c * LCT;
        unsigned short xraw[LCT + 3];
        if (c > 0) { xraw[0] = XB[(row0 - 3) * 512 + ch]; xraw[1] = XB[(row0 - 2) * 512 + ch]; xraw[2] = XB[(row0 - 1) * 512 + ch]; } else { xraw[0] = 0; xraw[1] = 0; xraw[2] = 0; }
#pragma unroll
        for (int tk = 0; tk < LCT; ++tk) xraw[3 + tk] = XB[(row0 + tk) * 512 + ch];
        float h = 0.f, Ap = 1.f;
        if (FINAL) { for (int j = 0; j < c; ++j) { const f32x2 ag = AGG[((size_t)b * LNCH + j) * 512 + ch]; h = ag.x * h + ag.y; } }
#pragma unroll
        for (int tk = 0; tk < LCT; ++tk) U[tk * 512 + ch] = cw0 * bf1(xraw[tk]) + cw1 * bf1(xraw[tk + 1]) + cw2 * bf1(xraw[tk + 2]) + cw3 * bf1(xraw[tk + 3]) + cb;
        __syncthreads();
        unsigned short gcur[8], gnxt[8];
        if (FINAL) {
#pragma unroll
            for (int j = 0; j < 8; ++j) gcur[j] = GB[(row0 + j) * 512 + ch]; }
#pragma unroll 1
        for (int tg = 0; tg < LCT / 8; ++tg) {
            if (FINAL) { const int tn = (tg + 1 < LCT / 8) ? (tg + 1) * 8 : tg * 8;
#pragma unroll
                for (int j = 0; j < 8; ++j) gnxt[j] = GB[(row0 + tn + j) * 512 + ch]; }
#pragma unroll
            for (int j = 0; j < 8; ++j) { const int tk = tg * 8 + j;
                const LAS f32x4* up = (const LAS f32x4*)(U + tk * 512 + n * 64);
                f32x2 acc = {ba, bx};
#pragma unroll
                for (int c4 = 0; c4 < 16; ++c4) { const f32x4 uu = up[c4];
                    acc += wg[4 * c4 + 0] * uu.x; acc += wg[4 * c4 + 1] * uu.y; acc += wg[4 * c4 + 2] * uu.z; acc += wg[4 * c4 + 3] * uu.w; }
                const float r = sigmoidf_(acc.x), ig = sigmoidf_(acc.y);
                const float la = r * m8sp; const float a = __expf(la); const float t2 = 2.0f * la; const float om = (t2 > -0.02f) ? -t2 * (1.0f + t2 * (0.5f + t2 * (0.16666667f + t2 * 0.041666668f))) : 1.0f - a * a; const float bb = __builtin_amdgcn_sqrtf(om) * (ig * U[tk * 512 + ch]);
                h = a * h + bb;
                if (FINAL) { YCAT[(row0 + tk) * 1024 + 512 + ch] = (bf16)f2bf(h * gelu_tanh(bf1(gcur[j]))); }
                else { Ap *= a; HLp[(row0 + tk) * 512 + ch] = (bf16)f2bf(h); CAp[(row0 + tk) * 512 + ch] = (bf16)f2bf(Ap); } }
            if (FINAL) {
#pragma unroll
                for (int j = 0; j < 8; ++j) gcur[j] = gnxt[j]; }
        }
        if (!FINAL) { f32x2 ag; ag.x = Ap; ag.y = h; AGG[((size_t)b * LNCH + c) * 512 + ch] = ag; }
        __syncthreads();
    }
}

__device__ __forceinline__ void lru_agg_mfma(Frame& F, const In& I, const bf16* XB, f32x2* AGG, bf16* HLp, bf16* CAp) {
    const int tid = TID_, lane = tid & 63, fr = lane & 15, fq = lane >> 4, n = F.wave, ch = tid;
    constexpr int UP = 520;
    LAS bf16* U = (LAS bf16*)F.lds;
    bf16x8 Wr[4][2], Wi[4][2];
#pragma unroll
    for (int dd = 0; dd < 4; ++dd)
#pragma unroll
        for (int kh = 0; kh < 2; ++kh) { unsigned pr_[4], pi_[4];
#pragma unroll
            for (int j = 0; j < 4; ++j) { const int c0 = 32 * kh + 8 * fq + 2 * j, d = 16 * dd + fr;
                pr_[j] = pk2(I.lru_wa[n * 4096 + c0 * 64 + d], I.lru_wa[n * 4096 + (c0 + 1) * 64 + d]); pi_[j] = pk2(I.lru_wx[n * 4096 + c0 * 64 + d], I.lru_wx[n * 4096 + (c0 + 1) * 64 + d]); }
            Wr[dd][kh] = __builtin_bit_cast(bf16x8, (v4u){pr_[0], pr_[1], pr_[2], pr_[3]}); Wi[dd][kh] = __builtin_bit_cast(bf16x8, (v4u){pi_[0], pi_[1], pi_[2], pi_[3]}); }
    float cba[4], cbx[4], cm8[4];
#pragma unroll
    for (int dd = 0; dd < 4; ++dd) { const int chd = 64 * n + 16 * dd + fr; cba[dd] = I.lru_ba[chd]; cbx[dd] = I.lru_bx[chd];
        const float lam = I.lru_lambda[chd]; cm8[dd] = -8.0f * ((lam > 15.f) ? expf(-lam) : log1pf(expf(-lam))); }
    const float cw0 = I.conv_w[0 * 512 + ch], cw1 = I.conv_w[1 * 512 + ch], cw2 = I.conv_w[2 * 512 + ch], cw3 = I.conv_w[3 * 512 + ch], cb = I.conv_b[ch];
    for (int un = blockIdx.x; un < NB * LNCH; un += F.G) {
        const int b = un / LNCH, c = un % LNCH; const size_t row0 = (size_t)b * SEQ + (size_t)c * LCT;
        unsigned short xraw[LCT + 3];
        if (c > 0) { xraw[0] = XB[(row0 - 3) * 512 + ch]; xraw[1] = XB[(row0 - 2) * 512 + ch]; xraw[2] = XB[(row0 - 1) * 512 + ch]; } else { xraw[0] = 0; xraw[1] = 0; xraw[2] = 0; }
#pragma unroll
        for (int tk = 0; tk < LCT; ++tk) xraw[3 + tk] = XB[(row0 + tk) * 512 + ch];
#pragma unroll
        for (int tk = 0; tk < LCT; ++tk) U[tk * UP + ch] = (bf16)f2bf(cw0 * bf1(xraw[tk]) + cw1 * bf1(xraw[tk + 1]) + cw2 * bf1(xraw[tk + 2]) + cw3 * bf1(xraw[tk + 3]) + cb);
        __syncthreads();
        bf16x8 X[4][2];
#pragma unroll
        for (int tt = 0; tt < 4; ++tt)
#pragma unroll
            for (int kh = 0; kh < 2; ++kh) X[tt][kh] = *(const LAS bf16x8*)(U + (16 * tt + fr) * UP + 64 * n + 32 * kh + 8 * fq);
#pragma unroll 1
        for (int dd = 0; dd < 4; ++dd) {
            bf16x8 wr0, wr1, wi0, wi1; float kba, kbx, km8;
            if (dd == 0) { wr0 = Wr[0][0]; wr1 = Wr[0][1]; wi0 = Wi[0][0]; wi1 = Wi[0][1]; kba = cba[0]; kbx = cbx[0]; km8 = cm8[0]; }
            else if (dd == 1) { wr0 = Wr[1][0]; wr1 = Wr[1][1]; wi0 = Wi[1][0]; wi1 = Wi[1][1]; kba = cba[1]; kbx = cbx[1]; km8 = cm8[1]; }
            else if (dd == 2) { wr0 = Wr[2][0]; wr1 = Wr[2][1]; wi0 = Wi[2][0]; wi1 = Wi[2][1]; kba = cba[2]; kbx = cbx[2]; km8 = cm8[2]; }
            else { wr0 = Wr[3][0]; wr1 = Wr[3][1]; wi0 = Wi[3][0]; wi1 = Wi[3][1]; kba = cba[3]; kbx = cbx[3]; km8 = cm8[3]; }
            const int chd = 64 * n + 16 * dd + fr;
            float hc = 0.f, Ac = 1.f;
#pragma unroll
            for (int tt = 0; tt < 4; ++tt) {
                f32x4 pr = (f32x4){0.f, 0.f, 0.f, 0.f}, pi = pr;
                pr = __builtin_amdgcn_mfma_f32_16x16x32_bf16(X[tt][0], wr0, pr, 0, 0, 0); pr = __builtin_amdgcn_mfma_f32_16x16x32_bf16(X[tt][1], wr1, pr, 0, 0, 0);
                pi = __builtin_amdgcn_mfma_f32_16x16x32_bf16(X[tt][0], wi0, pi, 0, 0, 0); pi = __builtin_amdgcn_mfma_f32_16x16x32_bf16(X[tt][1], wi1, pi, 0, 0, 0);
                float a[4], bb[4];
#pragma unroll
                for (int e = 0; e < 4; ++e) { const int tok = 16 * tt + 4 * fq + e; const float u = bf1(U[tok * UP + chd]);
                    const float r = sigmoidf_(pr[e] + kba), ig = sigmoidf_(pi[e] + kbx); const float la = r * km8; a[e] = __expf(la); const float t2 = 2.0f * la;
                    const float om = (t2 > -0.02f) ? -t2 * (1.0f + t2 * (0.5f + t2 * (0.16666667f + t2 * 0.041666668f))) : 1.0f - a[e] * a[e]; bb[e] = __builtin_amdgcn_sqrtf(om) * (ig * u); }
                const float A4 = (a[0] * a[1]) * (a[2] * a[3]); const float B4 = ((bb[0] * a[1] + bb[1]) * a[2] + bb[2]) * a[3] + bb[3];
                float h = hc, Ap = Ac, hs = hc, As = Ac;
#pragma unroll
                for (int j = 0; j < 4; ++j) { const float Aj = __shfl(A4, fr + 16 * j), Bj = __shfl(B4, fr + 16 * j); if (j == fq) { hs = h; As = Ap; } h = Aj * h + Bj; Ap *= Aj; }
                hc = h; Ac = Ap; h = hs; Ap = As;
#pragma unroll
                for (int e = 0; e < 4; ++e) { h = a[e] * h + bb[e]; Ap *= a[e]; const size_t o = (row0 + 16 * tt + 4 * fq + e) * 512 + chd; HLp[o] = (bf16)f2bf(h); CAp[o] = (bf16)f2bf(Ap); }
            }
            if (fq == 0) { f32x2 ag; ag.x = Ac; ag.y = hc; AGG[((size_t)b * LNCH + c) * 512 + chd] = ag; }
        }
        __syncthreads();
    }
}

__device__ __forceinline__ void lru_final_pass(Frame& F, const bf16* HLp, const bf16* CAp, const bf16* GB, const f32x2* AGG, bf16* YCAT) {
    const int ch = TID_;
    for (int un = blockIdx.x; un < NB * LNCH; un += F.G) {
        const int b = un / LNCH, c = un % LNCH; const size_t row0 = (size_t)b * SEQ + (size_t)c * LCT;
        float carry = 0.f;
        for (int j = 0; j < c; ++j) { const f32x2 ag = AGG[((size_t)b * LNCH + j) * 512 + ch]; carry = ag.x * carry + ag.y; }
#pragma unroll 4
        for (int t8 = 0; t8 < LCT; t8 += 8) {
            bf16 hl[8], ca[8], gv[8];
#pragma unroll
            for (int j = 0; j < 8; ++j) { const size_t o = (row0 + t8 + j) * 512 + ch; hl[j] = HLp[o]; ca[j] = CAp[o]; gv[j] = GB[o]; }
#pragma unroll
            for (int j = 0; j < 8; ++j) { const float h = bf1(hl[j]) + bf1(ca[j]) * carry; YCAT[(row0 + t8 + j) * 1024 + 512 + ch] = (bf16)f2bf(h * gelu_tanh(bf1(gv[j]))); }
        }
    }
}

__device__ __forceinline__ void route_pass_a(Frame& F, const In& I, int layer, const float* LOG, unsigned char* rt, gu32* cnt) {
    LAS int* lcnt = (LAS int*)(F.lds + RTE_OFF); LAS int* lbase = lcnt + 32;
    int* EID = (int*)(rt + RT_EID); int* POS = (int*)(rt + RT_POS); float* GATE = (float*)(rt + RT_GATE);
    const float* bc = I.moe_bc + layer * 4; const float* bfb = I.moe_bf + layer * 32;
    for (int un = blockIdx.x; un < T / 512; un += F.G) {
        if (TID_ < 32) lcnt[TID_] = 0;
        __syncthreads();
        const int t = un * 512 + TID_; const float* lg = LOG + (size_t)t * 64;
        const f32x4 g4 = *(const f32x4*)lg;
        float gl[4] = {g4.x + bc[0], g4.y + bc[1], g4.z + bc[2], g4.w + bc[3]};
        int gi = 0; float gm = gl[0];
#pragma unroll
        for (int j = 1; j < 4; ++j) if (gl[j] > gm) { gm = gl[j]; gi = j; }
        float gs = 0.f;
#pragma unroll
        for (int j = 0; j < 4; ++j) gs += __expf(gl[j] - gm);
        const float gprob = 1.0f / gs;
        const f32x4 e0 = *(const f32x4*)(lg + 4 + gi * 8), e1 = *(const f32x4*)(lg + 8 + gi * 8);
        float el[8] = {e0.x, e0.y, e0.z, e0.w, e1.x, e1.y, e1.z, e1.w};
#pragma unroll
        for (int j = 0; j < 8; ++j) el[j] += bfb[gi * 8 + j];
        int i0 = 0; float m0 = el[0];
#pragma unroll
        for (int j = 1; j < 8; ++j) if (el[j] > m0) { m0 = el[j]; i0 = j; }
        int i1 = -1; float m1 = -INFINITY;
#pragma unroll
        for (int j = 0; j < 8; ++j) if (j != i0 && el[j] > m1) { m1 = el[j]; i1 = j; }
        const float r1 = __expf(m1 - m0); const float g0 = gprob / (1.0f + r1), g1 = gprob * r1 / (1.0f + r1);
        const int ex0 = gi * 8 + i0, ex1 = gi * 8 + i1;
        const int p0 = atomicAdd((int*)&lcnt[ex0], 1), p1 = atomicAdd((int*)&lcnt[ex1], 1);
        __syncthreads();
        if (TID_ < 32) lbase[TID_] = (int)__hip_atomic_fetch_add(cnt + TID_, (unsigned)lcnt[TID_], RLX_AGENT);
        __syncthreads();
        EID[2 * t] = ex0; EID[2 * t + 1] = ex1; POS[2 * t] = lbase[ex0] + p0; POS[2 * t + 1] = lbase[ex1] + p1; GATE[2 * t] = g0; GATE[2 * t + 1] = g1;
        __syncthreads();
    }
}
__device__ __forceinline__ void route_bases(Frame& F, gu32* cnt) {
    LAS int* eb = (LAS int*)(F.lds + RTE_OFF + 512);
    const int tid = TID_;
    if (tid < 64) {
        const int c = (tid < 32) ? (int)__hip_atomic_load(cnt + (tid & 31), RLX_AGENT) : 0; const int p = (c + 255) & ~255; int s = p;
#pragma unroll
        for (int o = 1; o < 32; o <<= 1) { const int t = __shfl_up(s, o); if ((tid & 63) >= o) s += t; }
        if (tid < 32) { eb[tid] = s - p; if (tid == 31) eb[32] = s; }
    }
    __syncthreads();
}
__device__ __forceinline__ void route_pass_b(Frame& F, unsigned char* rt, gu32* cnt) {
    route_bases(F, cnt);
    LAS int* eb = (LAS int*)(F.lds + RTE_OFF + 512);
    const int* EID = (const int*)(rt + RT_EID); const int* POS = (const int*)(rt + RT_POS); const float* GATE = (const float*)(rt + RT_GATE);
    int* ROWTOK = (int*)(rt + RT_ROWTOK); float* ROWGATE = (float*)(rt + RT_ROWGATE); int* SLOT = (int*)(rt + RT_SLOT);
    const int gt = F.vcu * 512 + TID_, NGT = F.G * 512;
    for (int i = gt; i < 2 * T; i += NGT) { const int dst = eb[EID[i]] + POS[i]; ROWTOK[dst] = i >> 1; ROWGATE[dst] = GATE[i]; SLOT[i] = dst; }
    for (int i = gt; i < 32 * 256; i += NGT) { const int e = i >> 8, j = i & 255; const int c = (int)__hip_atomic_load(cnt + e, RLX_AGENT); const int pad = ((c + 255) & ~255) - c;
        if (j < pad) { ROWTOK[eb[e] + c + j] = 0; ROWGATE[eb[e] + c + j] = 0.f; } }
    __syncthreads();
}
struct MoeOrder {
    int G, c, ntiles; const LAS int* eb; const char* A; const char* W; size_t astep, wexp, wtile; bool gather;
    __device__ bool next(int i, pg8::Unit& u) const {
        const int L = i * G + c; if (L >= ntiles * 4) return false;
        u.pm = L >> 2; u.pn = L & 3; const int s0 = u.pm * 256; int e = 0;
#pragma unroll 1
        for (int j = 1; j < 32; ++j) if (eb[j] <= s0) e = j;
        e = __builtin_amdgcn_readfirstlane(e); u.aux = e; u.A = gather ? A : A + (size_t)u.pm * astep; u.B = W + (size_t)e * wexp + (size_t)u.pn * wtile; return true;
    }
};

constexpr int RTC = 32, RNCH = SEQ / RTC, RTOK = 352;
#define LBAR() do { asm volatile("s_waitcnt lgkmcnt(0)" ::: "memory"); __builtin_amdgcn_s_barrier(); asm volatile("" ::: "memory"); } while (0)
template <int CTRL> __device__ __forceinline__ float dpp_f(float v) { return __builtin_bit_cast(float, __builtin_amdgcn_update_dpp(0, __builtin_bit_cast(int, v), CTRL, 0xf, 0xf, true)); }
__device__ __forceinline__ float red16(float v) { v += dpp_f<0xB1>(v); v += dpp_f<0x4E>(v); v += dpp_f<0x141>(v); v += dpp_f<0x140>(v); return v; }
__device__ __forceinline__ float red8(float v) { v += dpp_f<0xB1>(v); v += dpp_f<0x4E>(v); v += dpp_f<0x141>(v); return v; }
__device__ __forceinline__ void unpack8(const v4u w, float (&f)[8]) { f[0] = bflo(w.x); f[1] = bfhi(w.x); f[2] = bflo(w.y); f[3] = bfhi(w.y); f[4] = bflo(w.z); f[5] = bfhi(w.z); f[6] = bflo(w.w); f[7] = bfhi(w.w); }
__device__ __forceinline__ void rwkv_scan_phase(Frame& F, const In& I, const bf16* R, const bf16* Kt, const bf16* V, const bf16* AA, const bf16* EW, bf16* Y) {
    LAS float* buf = (LAS float*)F.lds;
    LAS float* ybuf = (LAS float*)(F.lds + 2 * RTC * RTOK * 4) + 32;
    const int tid = TID_, lane = tid & 63;
    const int seg = lane & 15, rl = F.wave * 4 + (lane >> 4);
    const int stk = tid >> 4, ssg = tid & 15;
    for (int un = blockIdx.x; un < NB * 16 * 2; un += F.G) {
        const int half = un & 1, h = (un >> 1) & 15, b = un >> 5;
        const size_t rowb = (size_t)b * SEQ;
        const int col = h * 64 + ssg * 4;
        const f32x4 kkw = *(const f32x4*)(I.rwkv_kk + col), kaw = *(const f32x4*)(I.rwkv_ka + col);
        v2u rr, kr, vr, ar, er;
#define RAW_LOAD(cc) do { const size_t off = (rowb + (size_t)(cc) * RTC + stk) * 1024 + col; rr = *(const v2u*)(R + off); kr = *(const v2u*)(Kt + off); vr = *(const v2u*)(V + off); ar = *(const v2u*)(AA + off); er = *(const v2u*)(EW + off); } while (0)
#define RAW_CONVERT(cc) do { LAS float* tp = buf + ((cc) & 1) * (RTC * RTOK) + stk * RTOK + ssg * 4; \
            const float r0 = bflo(rr.x), r1 = bfhi(rr.x), r2 = bflo(rr.y), r3 = bfhi(rr.y), k0 = bflo(kr.x), k1 = bfhi(kr.x), k2 = bflo(kr.y), k3 = bfhi(kr.y); \
            const float a0 = bflo(ar.x), a1 = bfhi(ar.x), a2 = bflo(ar.y), a3 = bfhi(ar.y); \
            const float x0 = k0 * kkw.x, x1 = k1 * kkw.y, x2 = k2 * kkw.z, x3 = k3 * kkw.w; \
            const float ss = red16((x0 * x0 + x1 * x1) + (x2 * x2 + x3 * x3)); const float inv = __builtin_amdgcn_rsqf(fmaxf(ss, 1e-24f)); \
            *(LAS f32x4*)(tp) = (f32x4){__expf(-bflo(er.x)), __expf(-bfhi(er.x)), __expf(-bflo(er.y)), __expf(-bfhi(er.y))}; \
            const f32x4 kkv = (f32x4){x0 * inv, x1 * inv, x2 * inv, x3 * inv}; *(LAS f32x4*)(tp + 64) = kkv; \
            *(LAS f32x4*)(tp + 128) = (f32x4){kkv.x * a0, kkv.y * a1, kkv.z * a2, kkv.w * a3}; \
            *(LAS f32x4*)(tp + 192) = (f32x4){k0 * (1.0f + (a0 - 1.0f) * kaw.x), k1 * (1.0f + (a1 - 1.0f) * kaw.y), k2 * (1.0f + (a2 - 1.0f) * kaw.z), k3 * (1.0f + (a3 - 1.0f) * kaw.w)}; \
            *(LAS f32x4*)(tp + 256) = (f32x4){r0, r1, r2, r3}; \
            if ((ssg >> 3) == half) *(LAS f32x4*)(buf + ((cc) & 1) * (RTC * RTOK) + stk * RTOK + 320 + (ssg & 7) * 4) = (f32x4){bflo(vr.x), bfhi(vr.x), bflo(vr.y), bfhi(vr.y)}; } while (0)
#define Y_WRITE(cc) do { const LAS f32x2* yp = (const LAS f32x2*)(ybuf + ((cc) & 1) * (RTC * 32 + 32) + stk * 32 + ssg * 2); const f32x2 yv = *yp; \
            *(unsigned*)(Y + (rowb + (size_t)(cc) * RTC + stk) * 1024 + h * 64 + half * 32 + ssg * 2) = pk2(yv.x, yv.y); } while (0)
        RAW_LOAD(0); RAW_CONVERT(0); RAW_LOAD(1);
        f32x2 S0 = (f32x2){0.f, 0.f}, S1 = (f32x2){0.f, 0.f};
        LBAR();
        for (int c = 0; c < RNCH; ++c) {
            if (c + 1 < RNCH) { RAW_CONVERT(c + 1); }
            if (c + 2 < RNCH) { RAW_LOAD(c + 2); }
            if (c >= 1) { Y_WRITE(c - 1); }
            const LAS float* cb = buf + (c & 1) * (RTC * RTOK); LAS float* yb = ybuf + (c & 1) * (RTC * 32 + 32);
            const LAS float* tp0 = cb + seg * 4; const LAS float* vp0 = cb + 320 + rl;
#define SV_DECL(X) f32x4 X##w, X##q, X##b, X##k, X##r; float X##v
#define SV_LOAD(X, tk) do { const LAS float* tp = tp0 + (tk) * RTOK; \
                X##w = *(const LAS f32x4*)(tp); X##q = *(const LAS f32x4*)(tp + 64); X##b = *(const LAS f32x4*)(tp + 128); X##k = *(const LAS f32x4*)(tp + 192); X##r = *(const LAS f32x4*)(tp + 256); X##v = vp0[(tk) * RTOK]; } while (0)
#define SV_STEP(X, tk) do { \
                const f32x2 d = S0 * (f32x2){X##q.x, X##q.y} + S1 * (f32x2){X##q.z, X##q.w}; \
                const f32x2 t0 = S0 * (f32x2){X##w.x, X##w.y} + (f32x2){X##k.x, X##k.y} * X##v, t1 = S1 * (f32x2){X##w.z, X##w.w} + (f32x2){X##k.z, X##k.w} * X##v; \
                float ra = d.x + d.y, rb = epend;                   \
                ra += dpp_f<0xB1>(ra); rb += dpp_f<0xB1>(rb); ra += dpp_f<0x4E>(ra); rb += dpp_f<0x4E>(rb); ra += dpp_f<0x141>(ra); rb += dpp_f<0x141>(rb); ra += dpp_f<0x140>(ra); rb += dpp_f<0x140>(rb); \
                if (seg == 0) yb[((tk) - 1) * 32 + rl] = rb;        \
                const float sa = -ra; \
                S0 = t0 + (f32x2){X##b.x, X##b.y} * sa; S1 = t1 + (f32x2){X##b.z, X##b.w} * sa; \
                const f32x2 e = S0 * (f32x2){X##r.x, X##r.y} + S1 * (f32x2){X##r.z, X##r.w}; epend = e.x + e.y; } while (0)
            SV_DECL(A_); SV_DECL(B_); float epend = 0.f;
            SV_LOAD(A_, 0);
#pragma unroll 1
            for (int tk = 0; tk < RTC; tk += 2) {
                SV_LOAD(B_, tk + 1);
                SV_STEP(A_, tk);
                { const int t2 = (tk + 2 < RTC) ? tk + 2 : RTC - 1; SV_LOAD(A_, t2); }
                SV_STEP(B_, tk + 1);
            }
#undef SV_DECL
#undef SV_LOAD
#undef SV_STEP
            { const float rb = red16(epend); if (seg == 0) yb[(RTC - 1) * 32 + rl] = rb; }
            LBAR();
        }
        Y_WRITE(RNCH - 1);
        LBAR();
#undef RAW_LOAD
#undef RAW_CONVERT
#undef Y_WRITE
    }
}
constexpr int GS_QT = 0, GS_RT = 2048, GS_BHT = 4096, GS_KHT = 6144, GS_VT = 8192, GS_TM = 10240, GS_TL = 10752, GS_MK = 11264, GS_NK = 11776, GS_NB = 12288, GS_DD = 12800, GS_SLOT = 13056;
constexpr int GS_KT = GS_KHT, GS_BT = GS_BHT, GS_MB = GS_TM;
#ifndef SCAN_NP
#define SCAN_NP 5
#endif
constexpr int CH_NP = SCAN_NP, CH_NS = 8 - CH_NP, CH_ROUNDS = (512 + CH_NP - 1) / CH_NP;
constexpr int CH_KTAB = 2 * CH_NP * GS_SLOT;
static_assert(CH_KTAB + 512 <= 131072, "chunked-scan LDS map");
template <int N> __device__ __forceinline__ float dpp_shr(float v) { return __builtin_bit_cast(float, __builtin_amdgcn_update_dpp(0, __builtin_bit_cast(int, v), 0x110 + N, 0xf, 0xf, true)); }
__device__ __forceinline__ bf16x8 mk8(v2u a, v2u b) { return __builtin_bit_cast(bf16x8, (v4u){a.x, a.y, b.x, b.y}); }
__device__ __forceinline__ bf16x8 mk8z(v2u a) { return __builtin_bit_cast(bf16x8, (v4u){a.x, a.y, 0u, 0u}); }
__device__ __forceinline__ bf16x8 cvt8z(f32x4 v) { return __builtin_bit_cast(bf16x8, (v4u){pk2(v.x, v.y), pk2(v.z, v.w), 0u, 0u}); }
__device__ __forceinline__ int tokoff(const int t, const int c) { return t * 128 + ((c ^ ((t >> 1) & 7)) << 4); }
__device__ __forceinline__ int tokoff2(const int t, const int c) { return t * 128 + ((c ^ (((t >> 1) & 3) << 1)) << 4); }
__device__ __forceinline__ v2u trld(const LAS unsigned char* p) { return __builtin_bit_cast(v2u, __builtin_amdgcn_ds_read_tr16_b64_v4i16((LAS attn_body::v4i16_t*)p)); }
struct ChOps { v2u q[2][2], r[2][2], mk, nk, nb, tp, tl, kh[4], bh[4]; f32x4 dv[4]; };
__device__ __forceinline__ void chain_load(ChOps& O, const LAS unsigned char* C, const int fr, const int fq) {
#pragma unroll
    for (int kh = 0; kh < 2; ++kh) { const int o0 = tokoff(fr, 4 * kh + (fq >> 1)) + 8 * (fq & 1), o1 = tokoff(fr, 4 * kh + 2 + (fq >> 1)) + 8 * (fq & 1);
        O.q[kh][0] = *(const LAS v2u*)(C + GS_QT + o0); O.q[kh][1] = *(const LAS v2u*)(C + GS_QT + o1); O.r[kh][0] = *(const LAS v2u*)(C + GS_RT + o0); O.r[kh][1] = *(const LAS v2u*)(C + GS_RT + o1); }
    const int om = (fr * 16 + 4 * fq) * 2;
    O.mk = *(const LAS v2u*)(C + GS_MK + om); O.nk = *(const LAS v2u*)(C + GS_NK + om); O.nb = *(const LAS v2u*)(C + GS_NB + om); O.tp = *(const LAS v2u*)(C + GS_TM + om); O.tl = *(const LAS v2u*)(C + GS_TL + om);
#pragma unroll
    for (int jt = 0; jt < 4; ++jt) { const int ok = tokoff2(4 * fq + (fr >> 2), 2 * jt + ((fr >> 1) & 1)) + 8 * (fr & 1); O.kh[jt] = trld(C + GS_KHT + ok); O.bh[jt] = trld(C + GS_BHT + ok); O.dv[jt] = *(const LAS f32x4*)(C + GS_DD + (16 * jt + 4 * fq) * 4); }
}
__device__ __forceinline__ void chain_step(const ChOps& O, const v2u vqw, f32x4 (&Areg)[4], const int vt, const int fr, const int fq, GAS bf16* yrow) {
    const f32x4 zero4 = (f32x4){0.f, 0.f, 0.f, 0.f};
    bf16x8 Aq[2];
#pragma unroll
    for (int kh = 0; kh < 2; ++kh) Aq[kh] = __builtin_bit_cast(bf16x8, (v4u){pk2(Areg[2 * kh].x, Areg[2 * kh].y), pk2(Areg[2 * kh].z, Areg[2 * kh].w), pk2(Areg[2 * kh + 1].x, Areg[2 * kh + 1].y), pk2(Areg[2 * kh + 1].z, Areg[2 * kh + 1].w)});
    f32x4 X = zero4, YA = zero4;
#pragma unroll
    for (int kh = 0; kh < 2; ++kh) { X = __builtin_amdgcn_mfma_f32_16x16x32_bf16(mk8(O.q[kh][0], O.q[kh][1]), Aq[kh], X, 0, 0, 0); YA = __builtin_amdgcn_mfma_f32_16x16x32_bf16(mk8(O.r[kh][0], O.r[kh][1]), Aq[kh], YA, 0, 0, 0); }
    const bf16x8 Vq = mk8z(vqw), Tp = mk8z(O.tp), Tl = mk8z(O.tl);
    const f32x4 Z = __builtin_amdgcn_mfma_f32_16x16x32_bf16(mk8z(O.mk), Vq, X, 0, 0, 0);
    const unsigned zw0 = pk2(Z[0], Z[1]), zw1 = pk2(Z[2], Z[3]);
    const bf16x8 Zhq = __builtin_bit_cast(bf16x8, (v4u){zw0, zw1, 0u, 0u});
    const f32x4 Zl = (f32x4){Z[0] - bflo(zw0), Z[1] - bfhi(zw0), Z[2] - bflo(zw1), Z[3] - bfhi(zw1)};
    f32x4 U = __builtin_amdgcn_mfma_f32_16x16x32_bf16(Tp, cvt8z(Zl), zero4, 0, 0, 0);
    U = __builtin_amdgcn_mfma_f32_16x16x32_bf16(Tl, Zhq, U, 0, 0, 0);
    U = __builtin_amdgcn_mfma_f32_16x16x32_bf16(Tp, Zhq, U, 0, 0, 0);
    const bf16x8 Uq = cvt8z(U);
    f32x4 Yv = __builtin_amdgcn_mfma_f32_16x16x32_bf16(mk8z(O.nk), Vq, YA, 0, 0, 0);
    const f32x4 Yn = __builtin_amdgcn_mfma_f32_16x16x32_bf16(mk8z(O.nb), Uq, zero4, 0, 0, 0);
    Yv = Yv - Yn;
#pragma unroll
    for (int e = 0; e < 4; e += 2) { const unsigned yw = pk2(Yv[e], Yv[e + 1]); GAS bf16* yp = yrow + (size_t)(4 * fq + e) * 1024 + 16 * vt + fr; yp[0] = (bf16)(yw & 0xffffu); yp[1024] = (bf16)(yw >> 16); }
#pragma unroll
    for (int jt = 0; jt < 4; ++jt) { f32x4 acc = O.dv[jt] * Areg[jt];
        acc = __builtin_amdgcn_mfma_f32_16x16x32_bf16(mk8z(O.kh[jt]), Vq, acc, 0, 0, 0);
        const f32x4 nbu = __builtin_amdgcn_mfma_f32_16x16x32_bf16(mk8z(O.bh[jt]), Uq, zero4, 0, 0, 0);
        Areg[jt] = acc - nbu; }
}
#ifndef SCAN_WMAP
#define SCAN_WMAP 0x76543210u
#endif
__device__ __forceinline__ void rwkv_scan_chunked(Frame& F, const In& I, const bf16* R, const bf16* Kt, const bf16* V, const bf16* AA, const bf16* EW, bf16* Y) {
    const int lane = LANE_, fr = lane & 15, fq = lane >> 4;
    const int lw = (int)((SCAN_WMAP >> (4 * F.wave)) & 7u);
    LAS unsigned char* L = F.lds;
    const f32x4 zero4 = (f32x4){0.f, 0.f, 0.f, 0.f};
    for (int un = blockIdx.x; un < NB * 16; un += F.G) {
        const int h = un & 15, b = un >> 4; const size_t rowb = (size_t)b * SEQ;
        if (lw == 0) { ((LAS float*)(L + CH_KTAB))[lane] = ((const GAS float*)I.rwkv_kk)[h * 64 + lane]; ((LAS float*)(L + CH_KTAB + 256))[lane] = ((const GAS float*)I.rwkv_ka)[h * 64 + lane]; }
        LBAR();
        if (lw >= CH_NS) {
            const int p = lw - CH_NS; const int colb = h * 64 + 16 * fq;
            v4u raw[10];
#define CK_LOAD(cidx) do { const size_t off = (rowb + (size_t)(cidx) * 16 + fr) * 1024 + colb; \
                raw[0] = *(const GAS v4u*)(R + off); raw[1] = *(const GAS v4u*)(R + off + 8); raw[2] = *(const GAS v4u*)(Kt + off); raw[3] = *(const GAS v4u*)(Kt + off + 8); raw[4] = *(const GAS v4u*)(V + off); raw[5] = *(const GAS v4u*)(V + off + 8); \
                raw[6] = *(const GAS v4u*)(AA + off); raw[7] = *(const GAS v4u*)(AA + off + 8); raw[8] = *(const GAS v4u*)(EW + off); raw[9] = *(const GAS v4u*)(EW + off + 8); } while (0)
#ifdef SCAN_STAMP
            unsigned long long st_[7] = {0, 0, 0, 0, 0, 0, 0};
#define STAMP(i) do { if (blockIdx.x == 0 && p == 0 && rd == 20) st_[i] = __builtin_amdgcn_s_memtime(); } while (0)
#else
#define STAMP(i) do { } while (0)
#endif
            CK_LOAD(p);
            for (int rd = -1; rd < CH_ROUNDS - 1; ++rd) {
                const int cidx = CH_NP * (rd + 1) + p; LAS unsigned char* S = L + (((rd + 1) & 1) * CH_NP + p) * GS_SLOT;
                if (cidx < 512) {
                STAMP(0);
                float r[16], k[16], a[16], ew[16]; const v4u vraw0 = raw[4], vraw1 = raw[5];
                { float t8[8];
                  unpack8(raw[0], t8);
#pragma unroll
                  for (int e = 0; e < 8; ++e) r[e] = t8[e];
                  unpack8(raw[1], t8);
#pragma unroll
                  for (int e = 0; e < 8; ++e) r[8 + e] = t8[e];
                  unpack8(raw[2], t8);
#pragma unroll
                  for (int e = 0; e < 8; ++e) k[e] = t8[e];
                  unpack8(raw[3], t8);
#pragma unroll
                  for (int e = 0; e < 8; ++e) k[8 + e] = t8[e];
                  unpack8(raw[6], t8);
#pragma unroll
                  for (int e = 0; e < 8; ++e) a[e] = t8[e];
                  unpack8(raw[7], t8);
#pragma unroll
                  for (int e = 0; e < 8; ++e) a[8 + e] = t8[e];
                  unpack8(raw[8], t8);
#pragma unroll
                  for (int e = 0; e < 8; ++e) ew[e] = t8[e];
                  unpack8(raw[9], t8);
#pragma unroll
                  for (int e = 0; e < 8; ++e) ew[8 + e] = t8[e]; }
                if (cidx + CH_NP < 512) CK_LOAD(cidx + CH_NP);
                float kx[16], ss = 0.f;
#pragma unroll
                for (int e4 = 0; e4 < 4; ++e4) { const f32x4 c0_ = *(const LAS f32x4*)(L + CH_KTAB + (16 * fq + 4 * e4) * 4), c1_ = *(const LAS f32x4*)(L + CH_KTAB + 256 + (16 * fq + 4 * e4) * 4);
#pragma unroll
                    for (int z = 0; z < 4; ++z) { const int ee = 4 * e4 + z; kx[ee] = k[ee] * c0_[z]; ss += kx[ee] * kx[ee]; k[ee] = k[ee] * (1.0f + (a[ee] - 1.0f) * c1_[z]); } }
                ss += __shfl_xor(ss, 16); ss += __shfl_xor(ss, 32);
                const float inv = __builtin_amdgcn_rsqf(fmaxf(ss, 1e-24f));
                unsigned qtw[8], rtw[8], ktw[8], btw[8], bhw[8], khw[8];
                {
                    float li[16], e15[16], ep[16];
#pragma unroll
                    for (int e = 0; e < 16; ++e) li[e] = -ew[e];
#pragma unroll
                    for (int e = 0; e < 16; ++e) li[e] += dpp_shr<1>(li[e]);
#pragma unroll
                    for (int e = 0; e < 16; ++e) li[e] += dpp_shr<2>(li[e]);
#pragma unroll
                    for (int e = 0; e < 16; ++e) li[e] += dpp_shr<4>(li[e]);
#pragma unroll
                    for (int e = 0; e < 16; ++e) li[e] += dpp_shr<8>(li[e]);
#pragma unroll
                    for (int e = 0; e < 16; ++e) li[e] = __builtin_amdgcn_exp2f(1.4426950408889634f * li[e]);
#pragma unroll
                    for (int e = 0; e < 16; ++e) e15[e] = __shfl(li[e], (lane & 48) | 15);
#pragma unroll
                    for (int e = 0; e < 16; ++e) ep[e] = __builtin_bit_cast(float, __builtin_amdgcn_update_dpp(0x3f800000, __builtin_bit_cast(int, li[e]), 0x111, 0xf, 0xf, false));
                    if (fr == 15) {
#pragma unroll
                        for (int e4 = 0; e4 < 4; ++e4) *(LAS f32x4*)(S + GS_DD + (16 * fq + 4 * e4) * 4) = (f32x4){li[4 * e4], li[4 * e4 + 1], li[4 * e4 + 2], li[4 * e4 + 3]}; }
#pragma unroll
                    for (int e = 0; e < 16; e += 2) { float q2[2], r2[2], k2[2], b2[2], b2h[2], k2h[2];
#pragma unroll
                        for (int z = 0; z < 2; ++z) { const int ee = e + z;
                            const float Einv = __builtin_amdgcn_rcpf(li[ee]);
                            const float kk = kx[ee] * inv, bb = a[ee] * kk;
                            q2[z] = kk * ep[ee]; k2[z] = k[ee] * Einv; b2[z] = bb * Einv; r2[z] = r[ee] * li[ee];
                            b2h[z] = b2[z] * e15[ee]; k2h[z] = k2[z] * e15[ee]; }
                        qtw[e >> 1] = pk2(q2[0], q2[1]); rtw[e >> 1] = pk2(r2[0], r2[1]); ktw[e >> 1] = pk2(k2[0], k2[1]); btw[e >> 1] = pk2(b2[0], b2[1]); bhw[e >> 1] = pk2(b2h[0], b2h[1]); khw[e >> 1] = pk2(k2h[0], k2h[1]);
 } }
                { const int ov = tokoff2(fr, 2 * fq); *(LAS v4u*)(S + GS_VT + ov) = vraw0; *(LAS v4u*)(S + GS_VT + ov + 16) = vraw1; }
                { const int o = tokoff(fr, 2 * fq), o2 = o ^ 16;
                  *(LAS v4u*)(S + GS_QT + o) = (v4u){qtw[0], qtw[1], qtw[2], qtw[3]}; *(LAS v4u*)(S + GS_QT + o2) = (v4u){qtw[4], qtw[5], qtw[6], qtw[7]};
                  *(LAS v4u*)(S + GS_RT + o) = (v4u){rtw[0], rtw[1], rtw[2], rtw[3]}; *(LAS v4u*)(S + GS_RT + o2) = (v4u){rtw[4], rtw[5], rtw[6], rtw[7]};
                  *(LAS v4u*)(S + GS_KT + o) = (v4u){ktw[0], ktw[1], ktw[2], ktw[3]}; *(LAS v4u*)(S + GS_KT + o2) = (v4u){ktw[4], ktw[5], ktw[6], ktw[7]};
                  *(LAS v4u*)(S + GS_BT + o) = (v4u){btw[0], btw[1], btw[2], btw[3]}; *(LAS v4u*)(S + GS_BT + o2) = (v4u){btw[4], btw[5], btw[6], btw[7]}; }
                asm volatile("s_waitcnt lgkmcnt(0)" ::: "memory");
                STAMP(1);
                f32x4 mb = zero4, mk = zero4, nb = zero4, nk = zero4;
#pragma unroll
                for (int kh = 0; kh < 2; ++kh) { const int o = tokoff(fr, 4 * kh + fq);
                    const bf16x8 Qf = *(const LAS bf16x8*)(S + GS_QT + o), Rf = *(const LAS bf16x8*)(S + GS_RT + o), Kf = *(const LAS bf16x8*)(S + GS_KT + o), Bf = *(const LAS bf16x8*)(S + GS_BT + o);
                    mb = __builtin_amdgcn_mfma_f32_16x16x32_bf16(Qf, Bf, mb, 0, 0, 0); mk = __builtin_amdgcn_mfma_f32_16x16x32_bf16(Qf, Kf, mk, 0, 0, 0);
                    nb = __builtin_amdgcn_mfma_f32_16x16x32_bf16(Rf, Bf, nb, 0, 0, 0); nk = __builtin_amdgcn_mfma_f32_16x16x32_bf16(Rf, Kf, nk, 0, 0, 0); }
                asm volatile("s_waitcnt lgkmcnt(0)" ::: "memory");
                STAMP(2);
                { const int oh = tokoff2(fr, 2 * fq);
                  *(LAS v4u*)(S + GS_BHT + oh) = (v4u){bhw[0], bhw[1], bhw[2], bhw[3]}; *(LAS v4u*)(S + GS_BHT + oh + 16) = (v4u){bhw[4], bhw[5], bhw[6], bhw[7]};
                  *(LAS v4u*)(S + GS_KHT + oh) = (v4u){khw[0], khw[1], khw[2], khw[3]}; *(LAS v4u*)(S + GS_KHT + oh + 16) = (v4u){khw[4], khw[5], khw[6], khw[7]}; }
#pragma unroll
                for (int e = 0; e < 4; e += 2) { const int tt = 4 * fq + e; const bool lo0 = fr < tt, le0 = fr <= tt, lo1 = fr < tt + 1, le1 = fr <= tt + 1;
                    ((LAS float*)(S + GS_MB))[tt * 16 + fr] = lo0 ? mb[e] : 0.f; ((LAS float*)(S + GS_MB))[(tt + 1) * 16 + fr] = lo1 ? mb[e + 1] : 0.f;
                    const unsigned wk = pk2(lo0 ? mk[e] : 0.f, lo1 ? mk[e + 1] : 0.f), wn = pk2(le0 ? nk[e] : 0.f, le1 ? nk[e + 1] : 0.f), wb = pk2(le0 ? nb[e] : 0.f, le1 ? nb[e + 1] : 0.f);
                    LAS bf16* pk_ = (LAS bf16*)(S + GS_MK) + tt * 16 + fr; LAS bf16* pn = (LAS bf16*)(S + GS_NK) + tt * 16 + fr; LAS bf16* pb = (LAS bf16*)(S + GS_NB) + tt * 16 + fr;
                    pk_[0] = (bf16)(wk & 0xffffu); pk_[16] = (bf16)(wk >> 16); pn[0] = (bf16)(wn & 0xffffu); pn[16] = (bf16)(wn >> 16); pb[0] = (bf16)(wb & 0xffffu); pb[16] = (bf16)(wb >> 16); }
                asm volatile("s_waitcnt lgkmcnt(0)" ::: "memory");
                STAMP(3);
                { float Tc[16]; int frx = fr; asm volatile("" : "+v"(frx));
#pragma unroll
                  for (int t = 0; t < 16; ++t) { const LAS f32x4* mrow = (const LAS f32x4*)(S + GS_MB + t * 64); float acc = (t == frx) ? 1.0f : 0.0f;
#pragma unroll
                      for (int s4 = 0; s4 < 4; ++s4) { if (4 * s4 < t) { const f32x4 m4 = mrow[s4];
#pragma unroll
                              for (int z = 0; z < 4; ++z) if (4 * s4 + z < t) acc -= m4[z] * Tc[4 * s4 + z]; } }
                      Tc[t] = acc; }
                  asm volatile("s_waitcnt lgkmcnt(0)" ::: "memory");
                  STAMP(4);
                  if (fq == 0) {
#pragma unroll
                      for (int t = 0; t < 16; t += 2) { const unsigned hw = pk2(Tc[t], Tc[t + 1]); const unsigned lw = pk2(Tc[t] - bflo(hw), Tc[t + 1] - bfhi(hw));
                          LAS bf16* ph = (LAS bf16*)(S + GS_TM) + t * 16 + fr; LAS bf16* pl = (LAS bf16*)(S + GS_TL) + t * 16 + fr;
                          ph[0] = (bf16)(hw & 0xffffu); ph[16] = (bf16)(hw >> 16); pl[0] = (bf16)(lw & 0xffffu); pl[16] = (bf16)(lw >> 16); } } }
                STAMP(5);
                }
                LBAR();
                STAMP(6);
            }
            LBAR();
#ifdef SCAN_STAMP
            if (blockIdx.x == 0 && p == 0) { const unsigned long long d_ = (SCAN_STAMP == 0) ? st_[6] - st_[0] : st_[SCAN_STAMP] - st_[SCAN_STAMP - 1]; const unsigned long long t0_ = __builtin_amdgcn_s_memtime();
                while (__builtin_amdgcn_s_memtime() - t0_ < d_ * 512ull) __builtin_amdgcn_s_sleep(8); }
#endif
#undef CK_LOAD
        } else {
            const int vtA = (CH_NS == 4) ? lw : ((lw == 0) ? 0 : lw + 1);
            f32x4 A0[4], A1[4];
#pragma unroll
            for (int jt = 0; jt < 4; ++jt) { A0[jt] = zero4; A1[jt] = zero4; }
            LBAR();
            for (int rd = 0; rd < CH_ROUNDS; ++rd) {
#pragma unroll 1
                for (int q = 0; q < CH_NP; ++q) {
                    const int cidx = CH_NP * rd + q;
                    if (cidx < 512) {
                        const LAS unsigned char* C = L + ((rd & 1) * CH_NP + q) * GS_SLOT; GAS bf16* yrow = (GAS bf16*)Y + (rowb + (size_t)cidx * 16) * 1024 + h * 64;
                        ChOps cur; chain_load(cur, C, fr, fq);
                        const v2u va = trld(C + GS_VT + tokoff2(4 * fq + (fr >> 2), 2 * vtA + ((fr >> 1) & 1)) + 8 * (fr & 1));
                        chain_step(cur, va, A0, vtA, fr, fq, yrow);
                        if (CH_NS == 3 && lw == 0) { const v2u vb = trld(C + GS_VT + tokoff2(4 * fq + (fr >> 2), 2 + ((fr >> 1) & 1)) + 8 * (fr & 1)); chain_step(cur, vb, A1, 1, fr, fq, yrow); }
                    }
                }
                LBAR();
            }
        }
    }
}
__device__ __forceinline__ void rwkv_post_pass(Frame& F, const In& I, const bf16* R, const bf16* Kt, const bf16* V, const bf16* AA, const bf16* G, bf16* Y) {
    const int gw = F.vcu * NWAVES + F.wave, NGW = F.G * NWAVES; const int col = LANE_ * 16;
    for (int t0 = 2 * gw; t0 < T; t0 += 2 * NGW) {
        v4u py[2][2], pr[2][2], pk[2][2], pv[2][2], pa[2][2], pg[2][2];
#pragma unroll
        for (int rw = 0; rw < 2; ++rw) { const size_t off = (size_t)(t0 + rw) * 1024 + col;
#pragma unroll
            for (int hf = 0; hf < 2; ++hf) { py[rw][hf] = *(const v4u*)(Y + off + hf * 8); pr[rw][hf] = *(const v4u*)(R + off + hf * 8); pk[rw][hf] = *(const v4u*)(Kt + off + hf * 8);
                pv[rw][hf] = *(const v4u*)(V + off + hf * 8); pa[rw][hf] = *(const v4u*)(AA + off + hf * 8); pg[rw][hf] = *(const v4u*)(G + off + hf * 8); } }
#pragma unroll
        for (int rw = 0; rw < 2; ++rw) { const size_t off = (size_t)(t0 + rw) * 1024 + col;
            float kaw[16], rkw[16], lng[16], lnb[16];
#pragma unroll
            for (int e4 = 0; e4 < 4; ++e4) { const f32x4 c0 = *(const GAS f32x4*)(I.rwkv_ka + col + 4 * e4), c1 = *(const GAS f32x4*)(I.rwkv_rk + col + 4 * e4), c2 = *(const GAS f32x4*)(I.rwkv_ln_g + col + 4 * e4), c3 = *(const GAS f32x4*)(I.rwkv_ln_b + col + 4 * e4);
#pragma unroll
                for (int e = 0; e < 4; ++e) { kaw[4 * e4 + e] = c0[e]; rkw[4 * e4 + e] = c1[e]; lng[4 * e4 + e] = c2[e]; lnb[4 * e4 + e] = c3[e]; } }
            float y[16], r[16], k[16], v[16], a[16], g[16];
#pragma unroll
            for (int hf = 0; hf < 2; ++hf) { float t8[8];
                unpack8(py[rw][hf], t8);
#pragma unroll
                for (int e = 0; e < 8; ++e) y[hf * 8 + e] = t8[e];
                unpack8(pr[rw][hf], t8);
#pragma unroll
                for (int e = 0; e < 8; ++e) r[hf * 8 + e] = t8[e];
                unpack8(pk[rw][hf], t8);
#pragma unroll
                for (int e = 0; e < 8; ++e) k[hf * 8 + e] = t8[e];
                unpack8(pv[rw][hf], t8);
#pragma unroll
                for (int e = 0; e < 8; ++e) v[hf * 8 + e] = t8[e];
                unpack8(pa[rw][hf], t8);
#pragma unroll
                for (int e = 0; e < 8; ++e) a[hf * 8 + e] = t8[e];
                unpack8(pg[rw][hf], t8);
#pragma unroll
                for (int e = 0; e < 8; ++e) g[hf * 8 + e] = t8[e]; }
            float s = 0.f, bs = 0.f;
#pragma unroll
            for (int e = 0; e < 16; ++e) { s += y[e]; const float kp = k[e] * (1.0f + (a[e] - 1.0f) * kaw[e]); bs += r[e] * kp * rkw[e]; }
            s += __shfl_xor(s, 1); s += __shfl_xor(s, 2); bs += __shfl_xor(bs, 1); bs += __shfl_xor(bs, 2);
            const float mean = s * (1.0f / 64.0f); float q = 0.f;
#pragma unroll
            for (int e = 0; e < 16; ++e) { const float dd = y[e] - mean; q += dd * dd; }
            q += __shfl_xor(q, 1); q += __shfl_xor(q, 2);
            const float rstd = 1.0f / sqrtf(q * (1.0f / 64.0f) + 64e-5f);
            float o[16];
#pragma unroll
            for (int e = 0; e < 16; ++e) o[e] = ((y[e] - mean) * rstd * lng[e] + lnb[e] + bs * v[e]) * g[e];
            v4u w0, w1; w0.x = pk2(o[0], o[1]); w0.y = pk2(o[2], o[3]); w0.z = pk2(o[4], o[5]); w0.w = pk2(o[6], o[7]); w1.x = pk2(o[8], o[9]); w1.y = pk2(o[10], o[11]); w1.z = pk2(o[12], o[13]); w1.w = pk2(o[14], o[15]);
            *(v4u*)(Y + off) = w0; *(v4u*)(Y + off + 8) = w1; }
    }
}

#ifndef DUP_K
#define DUP_K (-1)
#endif
#ifndef DUP_K2
#define DUP_K2 (-1)
#endif
#define KARGS ((const __attribute__((address_space(4))) Args*)__builtin_amdgcn_kernarg_segment_ptr())
#define WSPTRS \
    bf16* H0 = (bf16*)(ws + WS_H0); bf16* QKV = (bf16*)(ws + WS_QKV); bf16* OB = (bf16*)(ws + WS_O); f32x2* AGG = (f32x2*)(ws + WS_LRUAGG); \
    bf16* H2 = (bf16*)(ws + WS_H2); float* LOG = (float*)(ws + WS_LOG); unsigned char* RTE = ws + WS_ROUTE; bf16* HID = (bf16*)(ws + WS_HID); bf16* YS = (bf16*)(ws + WS_YS); bf16* PP = (bf16*)(ws + WS_PP); \
    bf16* HCAT = (bf16*)(ws + WS_HCAT); bf16* RB = (bf16*)(ws + WS_R); bf16* KB = (bf16*)(ws + WS_K); bf16* VB = (bf16*)(ws + WS_V); bf16* XRB = (bf16*)(ws + WS_XR); bf16* XKB = (bf16*)(ws + WS_XK); bf16* XVB = (bf16*)(ws + WS_XV); bf16* MID = (bf16*)(ws + WS_MID); bf16* EWB = (bf16*)(ws + WS_EW); bf16* AAB = (bf16*)(ws + WS_AA); bf16* YB = (bf16*)(ws + WS_Y); \
    const size_t TD = (size_t)T * 1024; (void)H0; (void)QKV; (void)OB; (void)AGG; (void)H2; (void)LOG; (void)RTE; (void)HID; (void)YS; (void)PP; (void)HCAT; (void)RB; (void)KB; (void)VB; (void)XRB; (void)XKB; (void)XVB; (void)MID; (void)EWB; (void)AAB; (void)YB; (void)TD;

struct Args { In in; float* out; unsigned char* ws; int ph_lo, ph_hi; };
constexpr int N_PHASES = 34;
__device__ __forceinline__ int nrep(int k) { int n = (k == DUP_K) ? 2 : 1; if (DUP_K >= 0) asm volatile("" : "+s"(n)); return n; }
#define REP_SYNC if (rep_) __syncthreads();
typedef const __attribute__((address_space(4))) unsigned long long* kp64;
__device__ __forceinline__ void load_in(In& I) { kp64 s = (kp64)__builtin_amdgcn_kernarg_segment_ptr(); unsigned long long* d = (unsigned long long*)&I;
#pragma unroll
    for (int i = 0; i < 47; ++i) d[i] = s[i]; }

__device__ __forceinline__ int t5_bucket(int n) { if (n < 16) return n; const float v = logf((float)n / 16.0f) / 2.0794415416798357f * 16.0f; const int l = 16 + (int)v; return l < 31 ? l : 31; }

template <class Epi>
__device__ __forceinline__ void dense_gemm(Frame& F, const void* A, int lda, const void* B, int K, int M, int N, const Epi& E) {
    pg8::DenseOrder S; S.init(A, lda, B, K, M, N, F.G, (int)blockIdx.x);
    pg8::gemm_phase<Epi, pg8::DenseOrder, true, false>(F.lds, K, lda, S, E, nullptr, TID_);
}

__global__ void __launch_bounds__(NWAVES * 64, 2) mk_fwd(Args args) {
    extern __shared__ __attribute__((aligned(16))) unsigned char lds[];
    Frame F;
    F.lds = (LAS unsigned char*)lds;
    F.MISC = (volatile LAS unsigned*)(F.lds + MISC_OFF);
    { int w_ = __builtin_amdgcn_readfirstlane((int)threadIdx.x >> 6); asm volatile("" : "+s"(w_)); F.wave = w_; }
    F.G = gridDim.x; { const int bx = blockIdx.x; F.vcu = (F.G % 8 == 0) ? (bx % 8) * (F.G / 8) + bx / 8 : bx; }
    F.ctl = (gu32*)(KARGS->ws + WS_CTL);
    for (int u = TID_; u < (LDS_BYTES - LDSCTL_OFF) / 4; u += NWAVES * 64) ((LAS unsigned*)(F.lds + LDSCTL_OFF))[u] = 0u;
    __syncthreads();
    {
        LAS float* tb = (LAS float*)(F.lds + TB_OFF); const int h = TID_ >> 7, i = TID_ & 127;
        const float* rb = KARGS->in.rel_bias;
        tb[h * 128 + i] = (rb[t5_bucket(i) * 4 + h] - rb[31 * 4 + h]) * 1.4426950408889634f;
    }
    __syncthreads();
    const int lo = KARGS->ph_lo, hi = KARGS->ph_hi;
    const bool multi = (hi - lo) > 1;
    XcdBarrier bar; bar.bar = (unsigned*)(F.ctl + CW_BAR); bar.x = 0; bar.st = nullptr;
    if (multi) bar = xcd_barrier_post((unsigned*)(F.ctl + CW_BAR), F.MISC + 8, TID_ == 0);
#define IN(k) (lo <= (k) && (k) < hi)
#define PH_BEGIN_ unsigned char* ws = KARGS->ws; bf16* X = (bf16*)KARGS->out; float* OUT = KARGS->out; (void)OUT; bf16* GB2 = (bf16*)KARGS->out + (size_t)T * 1024; (void)GB2; In I; load_in(I); (void)X; WSPTRS
#define SEAM(k) do { if (IN(k) && IN((k) + 1)) xcd_barrier(bar, TID_ == 0); } while (0)

    if (IN(0)) { PH_BEGIN_ prep_dense_weights(F, I, ws); prep_layer_weights(F, I, ws, 0); norm_pass<false>(F, I.x, I.norm_mix, H0);
#ifdef DUP_PREP
        __syncthreads(); prep_dense_weights(F, I, ws); prep_layer_weights(F, I, ws, 0);
#endif
    } SEAM(0);
    if (IN(1)) { PH_BEGIN_ pg8::EpiBf16 E{QKV, 512, 512, (size_t)T * 512, attn_body::C2}; dense_gemm(F, H0, 1024, ws + WS_WIN, 1024, T, AB_IN, E); } SEAM(1);
    if (IN(2)) { PH_BEGIN_ lru_agg_mfma(F, I, QKV + 3 * (size_t)T * 512, AGG, (bf16*)(ws + WS_HL), (bf16*)(ws + WS_CA)); } SEAM(2);
    if (IN(3)) { PH_BEGIN_
        const attn_body::AttnTensors AT{(const attn_body::bf16*)QKV, (const attn_body::bf16*)(QKV + (size_t)T * 512), (const attn_body::bf16*)(QKV + 2 * (size_t)T * 512), (attn_body::bf16*)OB};
        if (F.G == 256) attn_body::attn_phase<8>((char*)lds, AT, F.vcu, (const LAS float*)(F.lds + TB_OFF), (int)threadIdx.x);
#ifdef DUP_ATTN
        __syncthreads(); if (F.G == 256) attn_body::attn_phase<8>((char*)lds, AT, F.vcu, (const LAS float*)(F.lds + TB_OFF), (int)threadIdx.x);
#endif
        __syncthreads();
        lru_final_pass(F, (const bf16*)(ws + WS_HL), (const bf16*)(ws + WS_CA), QKV + 4 * (size_t)T * 512, AGG, H0);
    } SEAM(3);
    if (IN(4)) { PH_BEGIN_ diff_combine_pass(F, I, OB, H0); } SEAM(4);
    if (IN(5)) { PH_BEGIN_ pg8::EpiResX<false> E{I.x, X}; dense_gemm(F, H0, 1024, ws + WS_WOUT, 1024, T, 1024, E); } SEAM(5);

#define MOE_PLE_PHASES(P, L) \
    if (IN(P + 0)) { PH_BEGIN_ norm_pass<true>(F, X, I.norm_ffn + (L) * 1024, H2); } SEAM(P + 0); \
    if (IN(P + 1)) { PH_BEGIN_ pg8::EpiRouter E{LOG}; dense_gemm(F, H2, 1024, ws + WS_ROUT + (size_t)(L) * 256 * 1024 * 2, 1024, T, 256, E); } SEAM(P + 1); \
    if (IN(P + 2)) { PH_BEGIN_ route_pass_a(F, I, (L), LOG, RTE, F.ctl + ((L) ? CW_CNT1 : CW_CNT0)); } SEAM(P + 2); \
    if (IN(P + 3)) { PH_BEGIN_ route_pass_b(F, RTE, F.ctl + ((L) ? CW_CNT1 : CW_CNT0)); } SEAM(P + 3); \
    if (IN(P + 4)) { PH_BEGIN_ route_bases(F, F.ctl + ((L) ? CW_CNT1 : CW_CNT0)); const LAS int* eb = (const LAS int*)(F.lds + RTE_OFF + 512); \
        MoeOrder S{F.G, (int)blockIdx.x, __builtin_amdgcn_readfirstlane(eb[32] >> 8), eb, (const char*)H2, (const char*)(ws + WS_MGU), 0, (size_t)1024 * 1024 * 2, (size_t)256 * 1024 * 2, true}; pg8::EpiGU E{HID}; \
        pg8::gemm_phase<pg8::EpiGU, MoeOrder, true, true>(F.lds, 1024, 1024, S, E, (const int*)(RTE + RT_ROWTOK), TID_); } SEAM(P + 4); \
    if (IN(P + 5)) { PH_BEGIN_ route_bases(F, F.ctl + ((L) ? CW_CNT1 : CW_CNT0)); const LAS int* eb = (const LAS int*)(F.lds + RTE_OFF + 512); \
        MoeOrder S{F.G, (int)blockIdx.x, __builtin_amdgcn_readfirstlane(eb[32] >> 8), eb, (const char*)HID, (const char*)(ws + WS_MDN), (size_t)256 * 512 * 2, (size_t)1024 * 512 * 2, (size_t)256 * 512 * 2, false}; pg8::EpiDown E{YS, (const float*)(RTE + RT_ROWGATE)}; \
        pg8::gemm_phase<pg8::EpiDown, MoeOrder, true, false>(F.lds, 512, 512, S, E, nullptr, TID_); } SEAM(P + 5); \
    if (IN(P + 6)) { PH_BEGIN_ combine_norm_pass(F, X, X, YS, (const int*)(RTE + RT_SLOT), I.ple_norm + (L) * 1024, H2); } SEAM(P + 6); \
    if (IN(P + 7)) { PH_BEGIN_ pg8::EpiBf16 E{PP, 1024, 0, 0, 1.f}; dense_gemm(F, ws + WS_PB, 256, ws + WS_PPROJ + (size_t)(L) * 1024 * 256 * 2, 256, T, 1024, E); } SEAM(P + 7); \
    if (IN(P + 8)) { PH_BEGIN_ pg8::EpiPle E{X, (L) ? (bf16*)(ws + WS_YS) : X, PP}; dense_gemm(F, H2, 1024, ws + WS_PGATE + (size_t)(L) * 1024 * 1024 * 2, 1024, T, 1024, E); } SEAM(P + 8);

    MOE_PLE_PHASES(6, 0)
    if (IN(15)) { PH_BEGIN_ rwkv_input_pass(F, X, I.norm_mix + 1024, I.rwkv_mu, HCAT, XRB, XKB, XVB); } SEAM(15);
    if (IN(16)) { PH_BEGIN_ { pg8::EpiBf16 E{RB, 1024, 0, 0, 1.f}; dense_gemm(F, XRB, 1024, ws + WS_RCAT, 1024, T, 1024, E); }
        { pg8::EpiMid E{MID}; dense_gemm(F, HCAT, 2048, ws + WS_RL1, 2048, T, 512, E); } } SEAM(16);
    if (IN(17)) { PH_BEGIN_ pg8::EpiBf16 E{KB, 1024, 0, 0, 1.f}; dense_gemm(F, XKB, 1024, ws + WS_RCAT + (size_t)1024 * 1024 * 2, 1024, T, 1024, E); } SEAM(17);
    if (IN(18)) { PH_BEGIN_ pg8::EpiBf16 E{VB, 1024, 0, 0, 1.f}; dense_gemm(F, XVB, 1024, ws + WS_RCAT + (size_t)2 * 1024 * 1024 * 2, 1024, T, 1024, E); } SEAM(18);
    if (IN(19)) { PH_BEGIN_ pg8::EpiRwkv2 E{EWB, AAB, I.rwkv_w0, I.rwkv_a0, 0}; dense_gemm(F, MID, 512, ws + WS_RS2, 256, T, 2048, E); } SEAM(19);
    if (IN(20)) { PH_BEGIN_
        if (F.G == 256 && blockIdx.x >= 128) {
            Frame F2 = F; F2.G = 128; F2.vcu = (int)blockIdx.x - 128;
            prep_layer_weights(F2, I, ws, 1);
            __syncthreads();
            pg8::EpiRwkv2 E{GB2, GB2, nullptr, nullptr, 2}; pg8::DenseOrder S; S.init(MID + 256, 512, ws + WS_RS2 + (size_t)2 * 1024 * 256 * 2, 256, T, 1024, 128, (int)blockIdx.x - 128);
            pg8::gemm_phase<pg8::EpiRwkv2, pg8::DenseOrder, true, false>(F.lds, 256, 512, S, E, nullptr, TID_);
        } else rwkv_scan_chunked(F, I, RB, KB, VB, AAB, EWB, YB);
    } SEAM(20);
    if (IN(21)) { } SEAM(21);
    if (IN(22)) { PH_BEGIN_ rwkv_post_pass(F, I, RB, KB, VB, AAB, GB2, YB); } SEAM(22);
    if (IN(23)) { PH_BEGIN_ pg8::EpiResX<true> E{X, X}; dense_gemm(F, YB, 1024, ws + WS_RWO, 1024, T, 1024, E); } SEAM(23);
    MOE_PLE_PHASES(24, 1)
    if (IN(33)) { PH_BEGIN_ final_norm_pass(F, (const bf16*)(ws + WS_YS), OUT, I.final_norm); }
#undef IN
#undef SEAM
}

extern "C" void kernel_launch(void* const* d_in, const int* in_sizes, int n_in, void* d_out, int out_size, void* d_ws, size_t ws_size, hipStream_t stream) {
    static int ok = 0;
    if (ok == 0) {
        if (n_in != 47 || out_size != T * D || ws_size < WS_END) { fprintf(stderr, "kernel_launch: unexpected problem shape (n_in %d out %d ws %zu)\n", n_in, out_size, ws_size); ok = -1; return; }
        if (hipFuncSetAttribute((const void*)mk_fwd, hipFuncAttributeMaxDynamicSharedMemorySize, LDS_BYTES) != hipSuccess) { fprintf(stderr, "kernel_launch: hipFuncSetAttribute failed\n"); ok = -1; return; }
        int per_cu = 0;
        if (hipOccupancyMaxActiveBlocksPerMultiprocessor(&per_cu, (const void*)mk_fwd, NWAVES * 64, LDS_BYTES) != hipSuccess || per_cu < 1) fprintf(stderr, "kernel_launch: occupancy query reports %d\n", per_cu);
        (void)hipGetLastError();
        ok = 1;
    }
    if (ok < 0) return;
    (void)hipMemsetAsync((char*)d_ws + WS_CTL, 0, CTL_ZERO_BYTES, stream);
    Args a{};
    const float** ip = (const float**)&a.in;
    for (int i = 0; i < 47; ++i) ip[i] = (const float*)d_in[i];
    a.out = (float*)d_out; a.ws = (unsigned char*)d_ws;
    const int grid = 256;
#if MK_ONE_LAUNCH
    a.ph_lo = 0; a.ph_hi = N_PHASES;
    hipLaunchKernelGGL(mk_fwd, dim3(grid), dim3(NWAVES * 64), LDS_BYTES, stream, a);
#else
    for (int k = 0; k < N_PHASES; ++k) { a.ph_lo = k; a.ph_hi = k + 1; hipLaunchKernelGGL(mk_fwd, dim3(grid), dim3(NWAVES * 64), LDS_BYTES, stream, a);
        if (k == DUP_K || k == DUP_K2) hipLaunchKernelGGL(mk_fwd, dim3(grid), dim3(NWAVES * 64), LDS_BYTES, stream, a); }
#endif
}
```

```cpp
#include <hip/hip_runtime.h>
#include <hip/hip_bf16.h>
#include <cstdio>
#include <cstdint>
#include <cmath>

#ifndef MK_ONE_LAUNCH
#define MK_ONE_LAUNCH 1
#endif

#define GAS __attribute__((address_space(1)))
#define LAS __attribute__((address_space(3)))
typedef unsigned short bf16;
typedef unsigned v4u __attribute__((ext_vector_type(4)));
typedef unsigned v2u __attribute__((ext_vector_type(2)));
typedef float f32x4 __attribute__((ext_vector_type(4)));
typedef float f32x2 __attribute__((ext_vector_type(2)));
typedef short bf16x8 __attribute__((ext_vector_type(8)));
typedef GAS unsigned gu32;
#define RLX_AGENT __ATOMIC_RELAXED, __HIP_MEMORY_SCOPE_AGENT
#define LDS_WAIT() asm volatile("s_waitcnt lgkmcnt(0)" ::: "memory")
#define VM_WAIT() asm volatile("s_waitcnt vmcnt(0)" ::: "memory")
__device__ __forceinline__ unsigned f2bf(float f) { unsigned u = __builtin_bit_cast(unsigned, f); return (u + 0x7fffu + ((u >> 16) & 1u)) >> 16; }
typedef float f32x2_cv __attribute__((ext_vector_type(2))); typedef __bf16 bf16x2_cv __attribute__((ext_vector_type(2)));
__device__ __forceinline__ unsigned pk2(float lo, float hi) { const f32x2_cv v = {lo, hi}; const bf16x2_cv b = __builtin_convertvector(v, bf16x2_cv); return __builtin_bit_cast(unsigned, b); }
__device__ __forceinline__ float bflo(unsigned w) { return __uint_as_float(w << 16); }
__device__ __forceinline__ float bfhi(unsigned w) { return __uint_as_float(w & 0xffff0000u); }
__device__ __forceinline__ float bf1(bf16 h) { return __uint_as_float((unsigned)h << 16); }
__device__ __forceinline__ float sigmoidf_(float x) { return __builtin_amdgcn_rcpf(1.0f + __builtin_amdgcn_exp2f(-1.4426950408889634f * x)); }
__device__ __forceinline__ float tanhf_(float x) { return 1.0f - 2.0f * __builtin_amdgcn_rcpf(1.0f + __builtin_amdgcn_exp2f(2.885390081777927f * x)); }
__device__ __forceinline__ void fmac_(float& acc, float a, float b) { asm("v_fmac_f32 %0, %1, %2" : "+v"(acc) : "v"(a), "v"(b)); }
__device__ __forceinline__ float fma_(float a, float b, float c) { float r; asm("v_fma_f32 %0, %1, %2, %3" : "=v"(r) : "v"(a), "v"(b), "v"(c)); return r; }
__device__ __forceinline__ float mul_(float a, float b) { float r; asm("v_mul_f32 %0, %1, %2" : "=v"(r) : "v"(a), "v"(b)); return r; }
__device__ __forceinline__ float wave_sum(float v) {
#pragma unroll
    for (int o = 1; o < 64; o <<= 1) v += __shfl_xor(v, o);
    return v;
}

constexpr int NB = 8, SEQ = 8192, D = 1024, T = NB * SEQ;
constexpr int AB_IN = 2560, PLE = 256;
constexpr int NEXP = 32, EH = 512;
constexpr int MAXSLOT = 2 * T + NEXP * 256;
constexpr int MAXTILES = MAXSLOT / 256;

namespace pg8 {
#define PG8_LAS __attribute__((address_space(3)))
typedef unsigned short bf16_t;
typedef unsigned u32x4 __attribute__((ext_vector_type(4)));
typedef unsigned u32x2 __attribute__((ext_vector_type(2)));
constexpr int BM = 256, BK = 64, HALF = 128, HTB = HALF * BK * 2, STAGE_BYTES = 8 * HTB, NXCD = 8, WGM = 8;
__host__ __device__ __forceinline__ int lds_byte(int r, int c) { const int st = (r >> 4) * 2 + (c >> 5), rr = r & 15, cc = c & 31, ob = rr * 64 + cc * 2; return st * 1024 + (ob ^ (((ob >> 9) & 1) << 5)); }
__host__ __device__ __forceinline__ void stage_rc(int b, int& R, int& C) { const int st = b / 1024, sb = b % 1024, swz = sb ^ (((sb >> 9) & 1) << 5); R = (st >> 1) * 16 + swz / 64; C = (st & 1) * 32 + (swz % 64) / 2; }
__host__ __device__ __forceinline__ int perm32(int rho) { const int n = rho >> 4, i = rho & 15; return 8 * (i >> 2) + 4 * n + (i & 3); }

struct Unit { int pm, pn, aux; const char* A; const char* B; };

struct DenseOrder {
    int nM, nN, nwg, G, c; const char* A; const char* B; size_t astep, bstep;
    __device__ void init(const void* A_, int lda, const void* B_, int K, int M, int N, int G_, int c_) { nM = M / BM; nN = N / BM; nwg = nM * nN; G = G_; c = c_; A = (const char*)A_; B = (const char*)B_; astep = (size_t)BM * lda * 2; bstep = (size_t)BM * K * 2; }
    __device__ bool next(int i, Unit& u) const {
        const long L = (long)i * G + c; if (L >= nwg) return false;
        int wgid = (int)L; { const int q = nwg / NXCD, r = nwg % NXCD, xcd = wgid % NXCD, off = wgid / NXCD; wgid = (xcd < r ? xcd * (q + 1) : r * (q + 1) + (xcd - r) * q) + off; }
        const int nig = WGM * nN, gid = wgid / nig, fm = gid * WGM, gsz = (nM - fm) < WGM ? (nM - fm) : WGM;
        u.pm = fm + ((wgid % nig) % gsz); u.pn = (wgid % nig) / gsz; u.aux = 0; u.A = A + (size_t)u.pm * astep; u.B = B + (size_t)u.pn * bstep; return true;
    }
};

__device__ __forceinline__ unsigned cvt_pk_bf16(float lo, float hi) { unsigned r; asm volatile("v_cvt_pk_bf16_f32 %0, %1, %2" : "=v"(r) : "v"(lo), "v"(hi)); return r; }

typedef f32x4 Acc[2][2][4][2];

struct EpiBf16 {
    static constexpr bool PERM = true;
    bf16_t* O; int ldc; int split_cols; size_t split_stride; float scale0;
    __device__ __forceinline__ void operator()(const Acc& acc, const Unit& u, int wr, int wc, int fr, int fq) const {
        const int row0 = u.pm * BM + wr * 64 + fr; int colt = u.pn * BM; bf16_t* base = O;
        float sc = 1.f; if (split_cols) { const int t = colt / split_cols; base += (size_t)t * split_stride; colt -= t * split_cols; if (t == 0) sc = scale0; }
        const int col0 = colt + wc * 32 + 8 * fq;
#pragma unroll
        for (int ai = 0; ai < 2; ++ai)
#pragma unroll
            for (int m = 0; m < 4; ++m) { bf16_t* rowp = base + (size_t)(row0 + ai * HALF + m * 16) * ldc + col0;
#pragma unroll
                for (int bj = 0; bj < 2; ++bj) { f32x4 v0 = acc[ai][bj][m][0] * sc, v1 = acc[ai][bj][m][1] * sc;
                    u32x4 w; w.x = cvt_pk_bf16(v0[0], v0[1]); w.y = cvt_pk_bf16(v0[2], v0[3]); w.z = cvt_pk_bf16(v1[0], v1[1]); w.w = cvt_pk_bf16(v1[2], v1[3]);
                    *(u32x4*)(rowp + bj * HALF) = w; } }
    }
};
__device__ __forceinline__ void unpack8f(const u32x4 w, f32x4& lo, f32x4& hi) { lo = (f32x4){bflo(w.x), bfhi(w.x), bflo(w.y), bfhi(w.y)}; hi = (f32x4){bflo(w.z), bfhi(w.z), bflo(w.w), bfhi(w.w)}; }
template <bool BASE_BF16>
struct EpiResX {
    static constexpr bool PERM = true;
    const void* base; bf16_t* out;
    __device__ __forceinline__ void operator()(const Acc& acc, const Unit& u, int wr, int wc, int fr, int fq) const {
        const int col0 = u.pn * BM + wc * 32 + 8 * fq; GAS bf16_t* op = (GAS bf16_t*)out;
#pragma unroll
        for (int ai = 0; ai < 2; ++ai) {
            f32x4 b0[4][2], b1[4][2];
#pragma unroll
            for (int m = 0; m < 4; ++m) { const size_t off = (size_t)(u.pm * BM + ai * HALF + wr * 64 + m * 16 + fr) * 1024 + col0;
#pragma unroll
                for (int bj = 0; bj < 2; ++bj) {
                    if (BASE_BF16) { const u32x4 w = *(const GAS u32x4*)((const GAS bf16_t*)base + off + bj * HALF); unpack8f(w, b0[m][bj], b1[m][bj]); }
                    else { b0[m][bj] = *(const GAS f32x4*)((const GAS float*)base + off + bj * HALF); b1[m][bj] = *(const GAS f32x4*)((const GAS float*)base + off + bj * HALF + 4); } } }
            asm volatile("" ::: "memory");
#pragma unroll
            for (int m = 0; m < 4; ++m) { const size_t off = (size_t)(u.pm * BM + ai * HALF + wr * 64 + m * 16 + fr) * 1024 + col0;
#pragma unroll
                for (int bj = 0; bj < 2; ++bj) { const f32x4 v0 = b0[m][bj] + acc[ai][bj][m][0], v1 = b1[m][bj] + acc[ai][bj][m][1];
                    u32x4 w; w.x = cvt_pk_bf16(v0[0], v0[1]); w.y = cvt_pk_bf16(v0[2], v0[3]); w.z = cvt_pk_bf16(v1[0], v1[1]); w.w = cvt_pk_bf16(v1[2], v1[3]);
                    *(GAS u32x4*)(op + off + bj * HALF) = w; } }
            asm volatile("" ::: "memory");
        }
    }
};
struct EpiRouter {
    static constexpr bool PERM = false;
    float* out;
    __device__ __forceinline__ void operator()(const Acc& acc, const Unit& u, int wr, int wc, int fr, int fq) const {
        if (wc >= 2) return;
#pragma unroll
        for (int ai = 0; ai < 2; ++ai)
#pragma unroll
            for (int m = 0; m < 4; ++m) { const size_t off = (size_t)(u.pm * BM + ai * HALF + wr * 64 + m * 16 + fr) * 64 + wc * 32 + 4 * fq;
#pragma unroll
                for (int n = 0; n < 2; ++n) *(f32x4*)(out + off + n * 16) = acc[ai][0][m][n]; }
    }
};
struct EpiGU {
    static constexpr bool PERM = true;
    bf16_t* H;
    __device__ __forceinline__ void operator()(const Acc& acc, const Unit& u, int wr, int wc, int fr, int fq) const {
        const int col0 = u.pn * 128 + wc * 32 + 8 * fq;
#pragma unroll
        for (int ai = 0; ai < 2; ++ai)
#pragma unroll
            for (int m = 0; m < 4; ++m) { bf16_t* rowp = H + (size_t)(u.pm * BM + ai * HALF + wr * 64 + m * 16 + fr) * EH + col0;
                f32x4 g0 = acc[ai][0][m][0], g1 = acc[ai][0][m][1]; const f32x4 u0 = acc[ai][1][m][0], u1 = acc[ai][1][m][1];
#pragma unroll
                for (int e = 0; e < 4; ++e) { g0[e] = g0[e] * sigmoidf_(g0[e]) * u0[e]; g1[e] = g1[e] * sigmoidf_(g1[e]) * u1[e]; }
                u32x4 w; w.x = cvt_pk_bf16(g0[0], g0[1]); w.y = cvt_pk_bf16(g0[2], g0[3]); w.z = cvt_pk_bf16(g1[0], g1[1]); w.w = cvt_pk_bf16(g1[2], g1[3]);
                *(u32x4*)rowp = w; }
    }
};
struct EpiDown {
    static constexpr bool PERM = true;
    bf16_t* Y; const float* gate;
    __device__ __forceinline__ void operator()(const Acc& acc, const Unit& u, int wr, int wc, int fr, int fq) const {
        const int col0 = u.pn * BM + wc * 32 + 8 * fq;
#pragma unroll
        for (int ai = 0; ai < 2; ++ai)
#pragma unroll
            for (int m = 0; m < 4; ++m) { const int row = u.pm * BM + ai * HALF + wr * 64 + m * 16 + fr; const float sc = gate[row]; bf16_t* rowp = Y + (size_t)row * 1024 + col0;
#pragma unroll
                for (int bj = 0; bj < 2; ++bj) { const f32x4 v0 = acc[ai][bj][m][0] * sc, v1 = acc[ai][bj][m][1] * sc;
                    u32x4 w; w.x = cvt_pk_bf16(v0[0], v0[1]); w.y = cvt_pk_bf16(v0[2], v0[3]); w.z = cvt_pk_bf16(v1[0], v1[1]); w.w = cvt_pk_bf16(v1[2], v1[3]);
                    *(u32x4*)(rowp + bj * HALF) = w; } }
    }
};
struct EpiPle {
    static constexpr bool PERM = true;
    const bf16_t* xin; bf16_t* xout; const bf16_t* pp;
    __device__ __forceinline__ void operator()(const Acc& acc, const Unit& u, int wr, int wc, int fr, int fq) const {
        const int col0 = u.pn * BM + wc * 32 + 8 * fq;
        const GAS bf16_t* xp = (const GAS bf16_t*)xin; GAS bf16_t* op = (GAS bf16_t*)xout; const GAS bf16_t* pq = (const GAS bf16_t*)pp;
#pragma unroll
        for (int ai = 0; ai < 2; ++ai) {
            u32x4 xw[4][2], pw[4][2];
#pragma unroll
            for (int m = 0; m < 4; ++m) { const size_t off = (size_t)(u.pm * BM + ai * HALF + wr * 64 + m * 16 + fr) * 1024 + col0;
#pragma unroll
                for (int bj = 0; bj < 2; ++bj) { xw[m][bj] = *(const GAS u32x4*)(xp + off + bj * HALF); pw[m][bj] = *(const GAS u32x4*)(pq + off + bj * HALF); } }
            asm volatile("" ::: "memory");
#pragma unroll
            for (int m = 0; m < 4; ++m) { const size_t off = (size_t)(u.pm * BM + ai * HALF + wr * 64 + m * 16 + fr) * 1024 + col0;
#pragma unroll
                for (int bj = 0; bj < 2; ++bj) { f32x4 x0, x1, p0, p1; unpack8f(xw[m][bj], x0, x1); unpack8f(pw[m][bj], p0, p1); const f32x4 a0 = acc[ai][bj][m][0], a1 = acc[ai][bj][m][1];
#pragma unroll
                    for (int e = 0; e < 4; ++e) { x0[e] += p0[e] * sigmoidf_(a0[e]); x1[e] += p1[e] * sigmoidf_(a1[e]); }
                    u32x4 w; w.x = cvt_pk_bf16(x0[0], x0[1]); w.y = cvt_pk_bf16(x0[2], x0[3]); w.z = cvt_pk_bf16(x1[0], x1[1]); w.w = cvt_pk_bf16(x1[2], x1[3]);
                    *(GAS u32x4*)(op + off + bj * HALF) = w; } }
            asm volatile("" ::: "memory");
        }
    }
};
struct EpiMid {
    static constexpr bool PERM = true;
    bf16_t* MID;
    __device__ __forceinline__ void operator()(const Acc& acc, const Unit& u, int wr, int wc, int fr, int fq) const {
        const int row0 = u.pm * BM + wr * 64 + fr;
        const int mode = (u.pn == 1) ? 2 : 0; const int colbase = u.pn * 256;
#pragma unroll
        for (int ai = 0; ai < 2; ++ai)
#pragma unroll
            for (int m = 0; m < 4; ++m) { bf16_t* rowp = MID + (size_t)(row0 + ai * HALF + m * 16) * 512 + colbase;
#pragma unroll
                for (int bj = 0; bj < 2; ++bj) { const int lc = bj * HALF + wc * 32 + 8 * fq; f32x4 v0 = acc[ai][bj][m][0], v1 = acc[ai][bj][m][1];
#pragma unroll
                    for (int e = 0; e < 4; ++e) {
                        if (mode == 2) { v0[e] = sigmoidf_(v0[e]); v1[e] = sigmoidf_(v1[e]); }
                        else if (lc < 64) { v0[e] = tanhf_(v0[e]); v1[e] = tanhf_(v1[e]); } }
                    u32x4 w; w.x = cvt_pk_bf16(v0[0], v0[1]); w.y = cvt_pk_bf16(v0[2], v0[3]); w.z = cvt_pk_bf16(v1[0], v1[1]); w.w = cvt_pk_bf16(v1[2], v1[3]);
                    *(u32x4*)(rowp + lc) = w; } }
    }
};
struct EpiRwkv2 {
    static constexpr bool PERM = true;
    bf16_t* O0; bf16_t* O1; const float* bias0; const float* bias1; int tybase;
    __device__ __forceinline__ void operator()(const Acc& acc, const Unit& u, int wr, int wc, int fr, int fq) const {
        const int ty = tybase + (u.pn >> 2); const int row0 = u.pm * BM + wr * 64 + fr; const int colt = (u.pn & 3) * BM + wc * 32 + 8 * fq;
        bf16_t* base = (u.pn >> 2) ? O1 : O0; const float* bias = (u.pn >> 2) ? bias1 : bias0;
#pragma unroll
        for (int bj = 0; bj < 2; ++bj) {
            f32x4 b0 = (f32x4){0.f, 0.f, 0.f, 0.f}, b1 = b0;
            if (ty < 2) { b0 = *(const f32x4*)(bias + colt + bj * HALF); b1 = *(const f32x4*)(bias + colt + bj * HALF + 4); }
#pragma unroll
            for (int ai = 0; ai < 2; ++ai)
#pragma unroll
                for (int m = 0; m < 4; ++m) { bf16_t* rowp = base + (size_t)(row0 + ai * HALF + m * 16) * 1024 + colt + bj * HALF;
                    f32x4 v0 = acc[ai][bj][m][0] + b0, v1 = acc[ai][bj][m][1] + b1;
                    if (ty < 2) { const float s = (ty == 0) ? 0.6065306597126334f : 1.0f;
#pragma unroll
                        for (int e = 0; e < 4; ++e) { v0[e] = s * sigmoidf_(v0[e]); v1[e] = s * sigmoidf_(v1[e]); } }
                    u32x4 w; w.x = cvt_pk_bf16(v0[0], v0[1]); w.y = cvt_pk_bf16(v0[2], v0[3]); w.z = cvt_pk_bf16(v1[0], v1[1]); w.w = cvt_pk_bf16(v1[2], v1[3]);
                    *(u32x4*)rowp = w; }
        }
    }
};

template <class Epi, class Sched, bool ALIGN_EPI, bool GATHER>
__device__ __forceinline__ void gemm_phase(PG8_LAS unsigned char* lds, const int K, const int lda, const Sched& S, const Epi& E, const int* __restrict__ rows, const int tid) {
    const int wid = __builtin_amdgcn_readfirstlane(tid >> 6), lane = tid & 63, wr = wid >> 2, wc = wid & 3, fr = lane & 15, fq = lane >> 4;
    const int nt = K / BK;
    unsigned voffA[2], voffB[2]; int RA[2];
#pragma unroll
    for (int i = 0; i < 2; ++i) { int R, C; stage_rc(tid * 16 + i * 8192, R, C); const int Rb = Epi::PERM ? ((R & ~31) + perm32(R & 31)) : R;
        RA[i] = R; voffA[i] = GATHER ? (unsigned)(C * 2) : (unsigned)(R * lda + C) * 2u; voffB[i] = (unsigned)(Rb * K + C) * 2u; }
    const size_t kstep = (size_t)(BK * 2);
    const size_t hstepA = GATHER ? 0 : (size_t)HALF * lda * 2, hstepB = (size_t)HALF * K * 2;
    const unsigned ldsw = (unsigned)wid * 1024u;
    const int aoff = lds_byte(wr * 64 + fr, fq * 8), boff = lds_byte(wc * 32 + fr, fq * 8);
#define PG8_SA(b, h) (((b) * 2 + (h)) * HTB)
#define PG8_SB(b, h) ((4 + (b) * 2 + (h)) * HTB)
#define PG8_ST2(bufoff, gbase, o0, o1) do { \
        __builtin_amdgcn_global_load_lds((const unsigned*)((const char*)(gbase) + (o0)), (PG8_LAS unsigned*)(lds + (bufoff) + ldsw), 16, 0, 0); \
        __builtin_amdgcn_global_load_lds((const unsigned*)((const char*)(gbase) + (o1)), (PG8_LAS unsigned*)(lds + (bufoff) + ldsw + 8192), 16, 0, 0); } while (0)
#define PG8_STB(bufoff, gbase) PG8_ST2(bufoff, gbase, voffB[0], voffB[1])
#define PG8_STA(bufoff, p, h, nx) do { if constexpr (GATHER) { const unsigned g0_ = (nx) ? gN[h][0] : gC[h][0], g1_ = (nx) ? gN[h][1] : gC[h][1]; PG8_ST2(bufoff, p, g0_, g1_); } \
        else { PG8_ST2(bufoff, (p) + (h) * hstepA, voffA[0], voffA[1]); } } while (0)
#define PG8_LDA(dst, b, h) do { _Pragma("unroll") for (int m = 0; m < 4; ++m) _Pragma("unroll") for (int k = 0; k < 2; ++k) dst[m][k] = *(const PG8_LAS bf16x8*)(lds + PG8_SA(b, h) + aoff + m * 2048 + k * 1024); } while (0)
#define PG8_LDB(dst, b, h) do { _Pragma("unroll") for (int n = 0; n < 2; ++n) _Pragma("unroll") for (int k = 0; k < 2; ++k) dst[n][k] = *(const PG8_LAS bf16x8*)(lds + PG8_SB(b, h) + boff + n * 2048 + k * 1024); } while (0)
#define PG8_MMA(ai, bj, At, Bt) do { __builtin_amdgcn_s_setprio(1); _Pragma("unroll") for (int m = 0; m < 4; ++m) _Pragma("unroll") for (int n = 0; n < 2; ++n) _Pragma("unroll") for (int k = 0; k < 2; ++k) \
        acc[ai][bj][m][n] = __builtin_amdgcn_mfma_f32_16x16x32_bf16(Bt[n][k], At[m][k], acc[ai][bj][m][n], 0, 0, 0); __builtin_amdgcn_s_setprio(0); } while (0)
#define PG8_WAIT_V(n) asm volatile("s_waitcnt vmcnt(" #n ")" ::: "memory")
#define PG8_WAIT_L(n) asm volatile("s_waitcnt lgkmcnt(" #n ")" ::: "memory")
#define PG8_BAR __builtin_amdgcn_s_barrier()
#define PG8_SCHED __builtin_amdgcn_sched_barrier(0)
#define PG8_GLOAD(dst, un) do { if constexpr (GATHER) { _Pragma("unroll") for (int h_ = 0; h_ < 2; ++h_) _Pragma("unroll") for (int i_ = 0; i_ < 2; ++i_) \
        dst[h_][i_] = (unsigned)rows[(un).pm * BM + h_ * HALF + RA[i_]] * (unsigned)(lda * 2) + voffA[i_]; } } while (0)
    Unit cur, nxt; int ui = 0;
    if (!S.next(0, cur)) return;
    unsigned gC[2][2] = {{0u, 0u}, {0u, 0u}}, gN[2][2] = {{0u, 0u}, {0u, 0u}};
    PG8_GLOAD(gC, cur);
    Acc acc;
#pragma unroll
    for (int a = 0; a < 2; ++a)
#pragma unroll
        for (int b = 0; b < 2; ++b)
#pragma unroll
            for (int m = 0; m < 4; ++m)
#pragma unroll
                for (int n = 0; n < 2; ++n) acc[a][b][m][n] = (f32x4){0.f, 0.f, 0.f, 0.f};
    bf16x8 At[4][2], B0[2][2], B1[2][2];
    const char* cA = cur.A; const char* cB = cur.B;
    PG8_STB(PG8_SB(0, 0), cB); PG8_STB(PG8_SB(0, 1), cB + hstepB); PG8_STA(PG8_SA(0, 0), cA, 0, false); PG8_STA(PG8_SA(0, 1), cA, 1, false);
    if (wr == 1) PG8_BAR;
    PG8_WAIT_V(2); PG8_BAR;
    PG8_STB(PG8_SB(1, 0), cB + kstep); PG8_STA(PG8_SA(1, 0), cA + kstep, 0, false); PG8_STB(PG8_SB(1, 1), cB + hstepB + kstep);
    PG8_WAIT_V(6); PG8_BAR;
    for (;;) {
        const bool has_next = S.next(ui + 1, nxt);
        if (has_next) { PG8_GLOAD(gN, nxt); }
        const char* nA = has_next ? nxt.A : cA; const char* nB = has_next ? nxt.B : cB;
#pragma unroll 1
        for (int t = 0; t < nt; t += 2) {
            const bool last = (t == nt - 2); const bool nx = last && has_next;
            const char* a1 = cA + (size_t)(t + 1) * kstep;
            const char* a2 = last ? nA : cA + (size_t)(t + 2) * kstep; const char* b2 = last ? nB : cB + (size_t)(t + 2) * kstep;
            const char* a3 = a2 + kstep; const char* b3 = b2 + kstep;
            PG8_LDB(B0, 0, 0); PG8_LDB(B1, 0, 1); PG8_SCHED; PG8_LDA(At, 0, 0); PG8_STA(PG8_SA(1, 1), a1, 1, false);
            PG8_WAIT_V(8); PG8_WAIT_L(0); PG8_BAR; PG8_MMA(0, 0, At, B0); PG8_MMA(0, 1, At, B1); PG8_BAR; PG8_SCHED;
            PG8_LDA(At, 0, 1); PG8_STB(PG8_SB(0, 0), b2); PG8_STB(PG8_SB(0, 1), b2 + hstepB); PG8_STA(PG8_SA(0, 0), a2, 0, nx);
            PG8_WAIT_V(8); PG8_WAIT_L(0); PG8_BAR; PG8_MMA(1, 0, At, B0); PG8_MMA(1, 1, At, B1); PG8_BAR; PG8_SCHED;
            PG8_LDB(B0, 1, 0); PG8_LDB(B1, 1, 1); PG8_SCHED; PG8_LDA(At, 1, 0); PG8_STA(PG8_SA(0, 1), a2, 1, nx);
            PG8_WAIT_V(8); PG8_WAIT_L(0); PG8_BAR; PG8_MMA(0, 0, At, B0); PG8_MMA(0, 1, At, B1); PG8_BAR; PG8_SCHED;
            PG8_LDA(At, 1, 1); PG8_STB(PG8_SB(1, 0), b3); PG8_STB(PG8_SB(1, 1), b3 + hstepB); PG8_STA(PG8_SA(1, 0), a3, 0, nx);
            PG8_WAIT_V(8); PG8_WAIT_L(0); PG8_BAR; PG8_MMA(1, 0, At, B0); PG8_MMA(1, 1, At, B1); PG8_BAR; PG8_SCHED;
        }
        if constexpr (ALIGN_EPI) { if (wr == 0) PG8_BAR; }
        E(acc, cur, wr, wc, fr, fq);
        if (!has_next) break;
#pragma unroll
        for (int a = 0; a < 2; ++a)
#pragma unroll
            for (int b = 0; b < 2; ++b)
#pragma unroll
                for (int m = 0; m < 4; ++m)
#pragma unroll
                    for (int n = 0; n < 2; ++n) acc[a][b][m][n] = (f32x4){0.f, 0.f, 0.f, 0.f};
        cur = nxt; cA = nA; cB = nB; ++ui;
        if constexpr (GATHER) {
#pragma unroll
            for (int h_ = 0; h_ < 2; ++h_)
#pragma unroll
                for (int i_ = 0; i_ < 2; ++i_) gC[h_][i_] = gN[h_][i_]; }
        if constexpr (ALIGN_EPI) { if (wr == 1) PG8_BAR; }
    }
    PG8_WAIT_V(0);
    if constexpr (!ALIGN_EPI) { if (wr == 0) PG8_BAR; }
    PG8_BAR;
#undef PG8_SA
#undef PG8_SB
#undef PG8_ST2
#undef PG8_STB
#undef PG8_STA
#undef PG8_LDA
#undef PG8_LDB
#undef PG8_MMA
#undef PG8_WAIT_V
#undef PG8_WAIT_L
#undef PG8_BAR
#undef PG8_SCHED
#undef PG8_GLOAD
}
}
namespace attn_body {
using bf16=__hip_bfloat16;
using bf16x8=__attribute__((ext_vector_type(8)))short;
using s16x4=__attribute__((ext_vector_type(4)))short;
using f32x16=__attribute__((ext_vector_type(16)))float;
using u32x4=__attribute__((ext_vector_type(4)))unsigned;
constexpr int BATCH=8,NHEAD=16,SEQ=8192,D=64,PQ=512,PO=1024;
constexpr int NW=8,QBLK=32,QB=QBLK*NW,KVBLK=64,NQB=SEQ/QB;
constexpr int ATTN_UNIT_ROWS=QB;
__device__ __forceinline__ int crow(int r,int hi){return (r&3)+8*(r>>2)+4*hi;}
#define SBAR() __builtin_amdgcn_sched_barrier(0)
__device__ __forceinline__ void cmask(f32x16&p0,f32x16&p1,int jb,int qrel,int hi){
  const float NEG=-INFINITY; int kb=64*jb+4*hi;
  #pragma unroll
  for(int r=0;r<16;++r){int kv=kb+(r&3)+8*(r>>2); if(kv>qrel)p0[r]=NEG; if(kv+32>qrel)p1[r]=NEG;}
}

__device__ __forceinline__ void cbias(f32x16&p0,f32x16&p1,int jb,int qrel,int hi,const __attribute__((address_space(3))) float*tb){
  const int kb=64*jb+4*hi;
  #pragma unroll
  for(int r=0;r<16;++r){const int rel=qrel-(kb+(r&3)+8*(r>>2)); const int i0=min(max(rel,0),127), i1=min(max(rel-32,0),127); p0[r]+=tb[i0]; p1[r]+=tb[i1];}
}
constexpr int NSLOT=3, SLOTB=8192;
constexpr int LDS_K=0, LDS_V=NSLOT*SLOTB, LDS_WS=2*NSLOT*SLOTB, LDS_OST=LDS_WS+NW*64*4, LDS_BYTES=LDS_OST+NW*4096;
constexpr float C2=0.125f*1.4426950408889634f;
__device__ __forceinline__ void glds16(const void*gsrc,unsigned lds_dst){unsigned keep;
  asm volatile("s_mov_b32 %0, m0\n\ts_mov_b32 m0, %2\n\ts_nop 0\n\tglobal_load_lds_dwordx4 %1, off\n\ts_mov_b32 m0, %0":"=&s"(keep):"v"(gsrc),"s"(lds_dst):"memory");}
__device__ __forceinline__ float max3f(float a,float b,float c){float r;asm("v_max3_f32 %0, %1, %2, %3":"=v"(r):"v"(a),"v"(b),"v"(c));return r;}
__device__ __forceinline__ float max2f(float a,float b){float r;asm("v_max_f32_e32 %0, %1, %2":"=v"(r):"v"(a),"v"(b));return r;}
__device__ __forceinline__ float fadd_s(float a,float b){float r;asm("v_add_f32_e32 %0, %1, %2":"=v"(r):"v"(a),"v"(b));return r;}
__device__ __forceinline__ float fsub_s(float a,float b){float r;asm("v_sub_f32_e32 %0, %1, %2":"=v"(r):"v"(a),"v"(b));return r;}
typedef float f32x2_t __attribute__((ext_vector_type(2))); typedef __bf16 bf16x2_t __attribute__((ext_vector_type(2)));
__device__ __forceinline__ unsigned cvtpk_s(float lo,float hi){f32x2_t v={lo,hi};bf16x2_t b=__builtin_convertvector(v,bf16x2_t);return __builtin_bit_cast(unsigned,b);}
#define WAIT_BAR(N) asm volatile("s_waitcnt vmcnt(" #N ") lgkmcnt(0)\n\ts_barrier":::"memory")

__device__ __forceinline__ void qkt(f32x16&p0,f32x16&p1,const char*Kslot,const bf16x8*qr,const f32x16&negm,int r32,int hi){
  const char*kb=Kslot+hi*1024+r32*16;
  #pragma unroll
  for(int d0=0;d0<4;++d0){
    const bf16x8 b0=*reinterpret_cast<const bf16x8*>(kb+d0*2048);
    const bf16x8 b1=*reinterpret_cast<const bf16x8*>(kb+d0*2048+512);
    if(d0==0){p0=__builtin_amdgcn_mfma_f32_32x32x16_bf16(b0,qr[0],negm,0,0,0);p1=__builtin_amdgcn_mfma_f32_32x32x16_bf16(b1,qr[0],negm,0,0,0);}
    else{p0=__builtin_amdgcn_mfma_f32_32x32x16_bf16(b0,qr[d0],p0,0,0,0);p1=__builtin_amdgcn_mfma_f32_32x32x16_bf16(b1,qr[d0],p1,0,0,0);}}
}
typedef __attribute__((address_space(3))) const char* lds_cptr;
typedef short v4i16_t __attribute__((ext_vector_type(4)));
__device__ __forceinline__ void kload8(bf16x8*kf,lds_cptr kp){
  kf[0]=*(const __attribute__((address_space(3))) bf16x8*)(kp);      kf[1]=*(const __attribute__((address_space(3))) bf16x8*)(kp+512);
  kf[2]=*(const __attribute__((address_space(3))) bf16x8*)(kp+2048); kf[3]=*(const __attribute__((address_space(3))) bf16x8*)(kp+2560);
  kf[4]=*(const __attribute__((address_space(3))) bf16x8*)(kp+4096); kf[5]=*(const __attribute__((address_space(3))) bf16x8*)(kp+4608);
  kf[6]=*(const __attribute__((address_space(3))) bf16x8*)(kp+6144); kf[7]=*(const __attribute__((address_space(3))) bf16x8*)(kp+6656);
}
__device__ __forceinline__ void kload2(bf16x8*kf,lds_cptr kp,int j){ kf[2*j]=*(const __attribute__((address_space(3))) bf16x8*)(kp+j*2048); kf[2*j+1]=*(const __attribute__((address_space(3))) bf16x8*)(kp+j*2048+512); }
__device__ __forceinline__ s16x4 vtr(lds_cptr p){ return __builtin_bit_cast(s16x4,__builtin_amdgcn_ds_read_tr16_b64_v4i16((__attribute__((address_space(3))) v4i16_t*)p)); }
__device__ __forceinline__ float rowmax(const f32x16&p0,const f32x16&p1){
  float a=max3f(p0[0],p0[1],p1[0]),b=max3f(p0[2],p0[3],p1[1]);a=max3f(a,p1[2],p1[3]);
  #pragma unroll
  for(int r=4;r<16;r+=4){a=max3f(a,p0[r],p0[r+1]);b=max3f(b,p0[r+2],p0[r+3]);a=max3f(a,p1[r],p1[r+1]);b=max3f(b,p1[r+2],p1[r+3]);}
  const float m=max2f(a,b);
  auto rr=__builtin_amdgcn_permlane32_swap(__float_as_uint(m),__float_as_uint(m),false,false);
  return max2f(__uint_as_float(rr[0]),__uint_as_float(rr[1]));
}
__device__ __forceinline__ void pv(f32x16*o,int vb,bf16x8 pa0,bf16x8 pa1,bf16x8 pa2,bf16x8 pa3){
  #pragma unroll
  for(int d0=0;d0<2;++d0){s16x4 lo[4],hi[4];
    #pragma unroll
    for(int ks=0;ks<4;++ks){
      asm volatile("ds_read_b64_tr_b16 %0,%1 offset:%c2":"=&v"(lo[ks]):"v"(vb),"i"(d0*4096+ks*1024):"memory");
      asm volatile("ds_read_b64_tr_b16 %0,%1 offset:%c2":"=&v"(hi[ks]):"v"(vb),"i"(d0*4096+ks*1024+512):"memory");}
    asm volatile("s_waitcnt lgkmcnt(0)":::"memory");SBAR();
    #define PK(k) (bf16x8){lo[k][0],lo[k][1],lo[k][2],lo[k][3],hi[k][0],hi[k][1],hi[k][2],hi[k][3]}
    o[d0]=__builtin_amdgcn_mfma_f32_32x32x16_bf16(pa0,PK(0),o[d0],0,0,0);
    o[d0]=__builtin_amdgcn_mfma_f32_32x32x16_bf16(pa1,PK(1),o[d0],0,0,0);
    o[d0]=__builtin_amdgcn_mfma_f32_32x32x16_bf16(pa2,PK(2),o[d0],0,0,0);
    o[d0]=__builtin_amdgcn_mfma_f32_32x32x16_bf16(pa3,PK(3),o[d0],0,0,0);
    #undef PK
  }
}

#ifndef ATTN_STORE16
#define ATTN_STORE16(p,v) (*(u32x4*)(p)=(v))
#endif
template<int THRL> __device__ __forceinline__ void attn_unit(int b,int vh,int qb,const bf16*Q,const bf16*__restrict__ K,const bf16*__restrict__ V,bf16*O,char*shm,const __attribute__((address_space(3))) float*tball,const int tid){
  const int lane=tid&63,r32=lane&31,hi=lane>>5; const int wid=__builtin_amdgcn_readfirstlane(tid>>6);
  const long rowbase=(long)b*SEQ; const int q0=qb*QB;
  const int hh=vh>>2, qcol=hh*128+((vh>>1)&1)*64, vcol=hh*128+(vh&1)*64;
  const __attribute__((address_space(3))) float*tb=tball+hh*128;
  const bf16*Qw=Q+(rowbase+q0+wid*QBLK)*PQ+qcol;
  const bf16*Kh=K+rowbase*PQ+qcol,*Vh=V+rowbase*PQ+vcol;
  const unsigned lds0=(unsigned)(uintptr_t)shm;
  float*wsf=(float*)(shm+LDS_WS)+wid*64;
  const bf16*ksrc=Kh+(long)lane*PQ+wid*8;
  const bf16*vsrc=Vh+(long)(16*(wid&3)+(lane>>2))*PQ+(wid>>2)*32+(lane&3)*8;
  const unsigned kdst=lds0+LDS_K+wid*1024, vdst=lds0+LDS_V+wid*1024;
  #define DMA_K(t,slot) glds16(ksrc+(long)(t)*KVBLK*PQ,(unsigned)__builtin_amdgcn_readfirstlane(kdst+(slot)))
  #define DMA_V(t,slot) glds16(vsrc+(long)(t)*KVBLK*PQ,(unsigned)__builtin_amdgcn_readfirstlane(vdst+(slot)))
  const int vb0=(int)(lds0+LDS_V)+((lane>>4)&1)*32+(lane&3)*8+(4*hi+((lane&15)>>2))*64;
  const char*Kbase=shm+LDS_K; bf16x8 kf[8];
  const lds_cptr shm3=(lds_cptr)shm; const lds_cptr kp0=shm3+LDS_K+hi*1024+r32*16; const lds_cptr vp0=shm3+LDS_V+((lane>>4)&1)*32+(lane&3)*8+(4*hi+((lane&15)>>2))*64;
  const int NT=(q0+QB)/KVBLK;
  DMA_K(0,0);DMA_V(0,0);DMA_K(1,SLOTB);
  bf16x8 qr[4];
  #pragma unroll
  for(int d0=0;d0<4;++d0)qr[d0]=*reinterpret_cast<const bf16x8*>(&Qw[(long)r32*PQ+d0*16+hi*8]);
  float mhat=0.f,l_reg=0.f;f32x16 o[2];o[0]=f32x16{};o[1]=f32x16{};f32x16 negm=f32x16{};asm volatile("":"+v"(negm));
  const int qrel=wid*QBLK+r32;
  #define CMASK(P0,P1,t) do{int jb_=(t)-(NT-4); if(jb_>=-2){cbias(P0,P1,jb_,qrel,hi,tb); if(jb_>=0)cmask(P0,P1,jb_,qrel,hi);}}while(0)
  bool resc=false;
  #define START(P0,P1) do{ const float rm=rowmax(P0,P1); resc=false; \
    { const float dl=rm; mhat=fadd_s(mhat,dl); \
      _Pragma("unroll") for(int r=0;r<16;++r){P0[r]=fsub_s(P0[r],dl);P1[r]=fsub_s(P1[r],dl);} \
      _Pragma("unroll") for(int r=0;r<16;++r)negm[r]=-mhat; asm volatile("":"+v"(negm)); } \
    _Pragma("unroll") for(int r=0;r<16;++r)P0[r]=__builtin_amdgcn_exp2f(P0[r]); }while(0)
  #define RESC() do{ if(resc){ asm volatile("s_waitcnt lgkmcnt(0)":::"memory"); \
      _Pragma("unroll") for(int d_=0;d_<2;++d_) _Pragma("unroll") for(int r=0;r<16;++r)o[d_][r]*=wsf[crow(r,hi)]; } }while(0)
  f32x16 pA0,pA1,pB0,pB1;
  int sl_prev=0,sl_cur=0,sl_next=SLOTB;
  #define ROT() do{sl_prev=sl_cur;sl_cur=sl_next;sl_next=(sl_next==(NSLOT-1)*SLOTB)?0:sl_next+SLOTB;}while(0)
  DMA_K(2,2*SLOTB);
  WAIT_BAR(3);
  qkt(pA0,pA1,Kbase,qr,negm,r32,hi);asm volatile("s_nop 15\n\ts_nop 7":"+v"(pA0),"+v"(pA1));CMASK(pA0,pA1,0);
  START(pA0,pA1);
  _Pragma("unroll") for(int r=0;r<16;++r)pA1[r]=__builtin_amdgcn_exp2f(pA1[r]);
  WAIT_BAR(0);
  DMA_K(3,0);DMA_V(1,SLOTB);
  ROT();
  kload8(kf,kp0+sl_cur);
  WAIT_BAR(2);
  s16x4 vlo[8],vhi[8]; u32x4 pw0,pw1,pw2,pw3;
  #define PKW(P,B) cvtpk_s(P[B],P[B+1])
  #define PAF(k) __builtin_bit_cast(bf16x8,pw##k)
  #define VFR(i) (bf16x8){vlo[i][0],vlo[i][1],vlo[i][2],vlo[i][3],vhi[i][0],vhi[i][1],vhi[i][2],vhi[i][3]}
  #define PIN(x) asm volatile("":"+v"(x))
  #define MX3(a,b,c) __builtin_fmaxf(__builtin_fmaxf((a),(b)),(c))
  #define GAPA(MF,A0,A1,A2,A3,W0,W1,PW) do{ MF; sacc+=A0; sacc+=A1; sacc+=A2; sacc+=A3; PIN(sacc); W0; W1; PIN(PW); SBAR(); }while(0)
  #define EX(v) __builtin_amdgcn_exp2f(v)
  #define GAPB(MF,X,B) do{ MF; X[B]=EX(X[B]); X[B+1]=EX(X[B+1]); X[B+2]=EX(X[B+2]); X[B+3]=EX(X[B+3]); PIN(X); SBAR(); }while(0)
  #define VRD(i) do{ vlo[i]=vtr(vp_+(((i)>>2)*4096+((i)&3)*1024)); vhi[i]=vtr(vp_+(((i)>>2)*4096+((i)&3)*1024+512)); }while(0)
  #define KRD(G,j) do{ if(G){ kload2(kf,kp0+sl_next,j); SBAR(); } }while(0)
  #define STEP(C0,C1,P0,P1,t,GK,GV,GL) do{ SBAR(); \
    const lds_cptr vp_=vp0+sl_prev; \
    VRD(0); SBAR(); float sacc=(P0[0]+P0[1]); \
    GAPA(C0=__builtin_amdgcn_mfma_f32_32x32x16_bf16(kf[0],qr[0],negm,0,0,0), P0[2],P0[3],P0[4],P0[5],     pw0[0]=PKW(P0,0), pw0[1]=PKW(P0,2), pw0); \
    VRD(4); SBAR(); GAPA(C1=__builtin_amdgcn_mfma_f32_32x32x16_bf16(kf[1],qr[0],negm,0,0,0), P0[6],P0[7],P0[8],P0[9],     pw0[2]=PKW(P0,4), pw0[3]=PKW(P0,6), pw0); \
    VRD(1); SBAR(); GAPA(C0=__builtin_amdgcn_mfma_f32_32x32x16_bf16(kf[2],qr[1],C0,0,0,0),   P0[10],P0[11],P0[12],P0[13], pw1[0]=PKW(P0,8), pw1[1]=PKW(P0,10), pw1); \
    VRD(5); SBAR(); GAPA(C1=__builtin_amdgcn_mfma_f32_32x32x16_bf16(kf[3],qr[1],C1,0,0,0),   P0[14],P0[15],P1[0],P1[1],   pw1[2]=PKW(P0,12),pw1[3]=PKW(P0,14), pw1); \
    VRD(2); SBAR(); GAPA(C0=__builtin_amdgcn_mfma_f32_32x32x16_bf16(kf[4],qr[2],C0,0,0,0),   P1[2],P1[3],P1[4],P1[5],     pw2[0]=PKW(P1,0), pw2[1]=PKW(P1,2), pw2); \
    VRD(6); SBAR(); GAPA(C1=__builtin_amdgcn_mfma_f32_32x32x16_bf16(kf[5],qr[2],C1,0,0,0),   P1[6],P1[7],P1[8],P1[9],     pw2[2]=PKW(P1,4), pw2[3]=PKW(P1,6), pw2); \
    VRD(3); SBAR(); GAPA(C0=__builtin_amdgcn_mfma_f32_32x32x16_bf16(kf[6],qr[3],C0,0,0,0),   P1[10],P1[11],P1[12],P1[13], pw3[0]=PKW(P1,8), pw3[1]=PKW(P1,10), pw3); \
    VRD(7); SBAR(); GAPA(C1=__builtin_amdgcn_mfma_f32_32x32x16_bf16(kf[7],qr[3],C1,0,0,0),   P1[14],P1[15],0.f,0.f,       pw3[2]=PKW(P1,12),pw3[3]=PKW(P1,14), pw3); \
    l_reg+=sacc; \
    if(GK){DMA_K((t)+3,sl_cur);} if(GV){DMA_V((t)+1,sl_next);} \
    CMASK(C0,C1,t); \
    { float a=MX3(C0[0],C0[1],C1[0]),b=MX3(C0[2],C0[3],C1[1]); a=MX3(a,C1[2],C1[3]); \
      _Pragma("unroll") for(int r=4;r<16;r+=4){a=MX3(a,C0[r],C0[r+1]);b=MX3(b,C0[r+2],C0[r+3]);a=MX3(a,C1[r],C1[r+1]);b=MX3(b,C1[r+2],C1[r+3]);} \
      float rm=__builtin_fmaxf(a,b); { auto rr=__builtin_amdgcn_permlane32_swap(__float_as_uint(rm),__float_as_uint(rm),false,false); rm=__builtin_fmaxf(__uint_as_float(rr[0]),__uint_as_float(rr[1])); } \
      resc=false; \
      if(__builtin_expect(__any(rm>(float)THRL),0)){ const float dl=__builtin_fmaxf(rm,0.f); mhat+=dl; \
        _Pragma("unroll") for(int r=0;r<16;++r){C0[r]-=dl;C1[r]-=dl;} \
        _Pragma("unroll") for(int r=0;r<16;++r)negm[r]=-mhat; asm volatile("":"+v"(negm)); \
        const float f=__builtin_amdgcn_exp2f(-dl); l_reg*=f; if(hi==0)wsf[r32]=f; resc=true; } } \
    SBAR(); \
    GAPB(o[0]=__builtin_amdgcn_mfma_f32_32x32x16_bf16(PAF(0),VFR(0),o[0],0,0,0), C0,0); \
    GAPB(o[1]=__builtin_amdgcn_mfma_f32_32x32x16_bf16(PAF(0),VFR(4),o[1],0,0,0), C0,4); \
    KRD(GL,0); GAPB(o[0]=__builtin_amdgcn_mfma_f32_32x32x16_bf16(PAF(1),VFR(1),o[0],0,0,0), C0,8); \
    KRD(GL,1); GAPB(o[1]=__builtin_amdgcn_mfma_f32_32x32x16_bf16(PAF(1),VFR(5),o[1],0,0,0), C0,12); \
    KRD(GL,2); GAPB(o[0]=__builtin_amdgcn_mfma_f32_32x32x16_bf16(PAF(2),VFR(2),o[0],0,0,0), C1,0); \
    KRD(GL,3); GAPB(o[1]=__builtin_amdgcn_mfma_f32_32x32x16_bf16(PAF(2),VFR(6),o[1],0,0,0), C1,4); \
    GAPB(o[0]=__builtin_amdgcn_mfma_f32_32x32x16_bf16(PAF(3),VFR(3),o[0],0,0,0), C1,8); \
    GAPB(o[1]=__builtin_amdgcn_mfma_f32_32x32x16_bf16(PAF(3),VFR(7),o[1],0,0,0), C1,12); \
    }while(0)
  int t=1;
  #undef CMASK
  #define CMASK(P0,P1,t) do{}while(0)
  for(;t+7<NT;t+=2){
    STEP(pB0,pB1,pA0,pA1,t,true,true,true);     WAIT_BAR(2); RESC(); ROT();
    STEP(pA0,pA1,pB0,pB1,t+1,true,true,true);   WAIT_BAR(2); RESC(); ROT();
  }
  #undef CMASK
  #define CMASK(P0,P1,t) do{int jb_=(t)-(NT-4); if(jb_>=-2){cbias(P0,P1,jb_,qrel,hi,tb); if(jb_>=0)cmask(P0,P1,jb_,qrel,hi);}}while(0)
  #define ENDW(tt) do{ if((tt)+3<NT){WAIT_BAR(2);} else if((tt)+2<NT){WAIT_BAR(1);} else {WAIT_BAR(0);} }while(0)
  for(;t+1<NT;t+=2){
    STEP(pB0,pB1,pA0,pA1,t,(t+3<NT),(t+1<NT),(t+1<NT));       ENDW(t);   RESC(); ROT();
    STEP(pA0,pA1,pB0,pB1,t+1,(t+4<NT),(t+2<NT),(t+2<NT));     ENDW(t+1); RESC(); ROT();
  }
  STEP(pB0,pB1,pA0,pA1,NT-1,false,false,false); RESC();
  { float sacc=pB0[0]+pB0[1]; _Pragma("unroll") for(int r=2;r<16;++r)sacc+=pB0[r]; _Pragma("unroll") for(int r=0;r<16;++r)sacc+=pB1[r]; l_reg+=sacc;
    pw0=(u32x4){PKW(pB0,0),PKW(pB0,2),PKW(pB0,4),PKW(pB0,6)};pw1=(u32x4){PKW(pB0,8),PKW(pB0,10),PKW(pB0,12),PKW(pB0,14)};pw2=(u32x4){PKW(pB1,0),PKW(pB1,2),PKW(pB1,4),PKW(pB1,6)};pw3=(u32x4){PKW(pB1,8),PKW(pB1,10),PKW(pB1,12),PKW(pB1,14)};
    SBAR(); pv(o,vb0+sl_cur,PAF(0),PAF(1),PAF(2),PAF(3)); }
  #undef PKW
  #undef PAF
  #undef VFR
  #undef PIN
  #undef MX3
  #undef GAPA
  #undef GAPB
  #undef EX
  #undef VRD
  #undef KRD
  #undef STEP
  #undef ENDW
  {auto rr=__builtin_amdgcn_permlane32_swap(__float_as_uint(l_reg),__float_as_uint(l_reg),false,false);l_reg=__uint_as_float(rr[0])+__uint_as_float(rr[1]);}
  if(hi==0)wsf[32+r32]=l_reg;asm volatile("s_waitcnt lgkmcnt(0)":::"memory");
  float rli[16];
  #pragma unroll
  for(int r=0;r<16;++r)rli[r]=__builtin_amdgcn_rcpf(wsf[32+crow(r,hi)]);
  bf16*Ow=O+(rowbase+q0+wid*QBLK)*PO+vh*D;
  { bf16*stg=(bf16*)(shm+LDS_OST)+wid*2048;
    #pragma unroll
    for(int r=0;r<16;++r){const int orow=crow(r,hi);
      #pragma unroll
      for(int d0=0;d0<2;++d0)stg[orow*64+d0*32+r32]=__float2bfloat16(o[d0][r]*rli[r]);}
    asm volatile("s_waitcnt lgkmcnt(0)":::"memory");
    #pragma unroll
    for(int i=0;i<4;++i){const int row=i*8+(lane>>3),ch=lane&7; const u32x4 v=*(const u32x4*)(stg+row*64+ch*8); ATTN_STORE16(Ow+(long)row*PO+ch*8,v);} }
  asm volatile("s_waitcnt lgkmcnt(0)\n\ts_barrier":::"memory");
  #undef DMA_K
  #undef DMA_V
  #undef CMASK
  #undef START
  #undef RESC
  #undef ROT
}
constexpr int ATTN_LDS_BYTES=LDS_BYTES;
struct AttnTensors { const bf16* Q; const bf16* K; const bf16* V; bf16* O; };
struct AttnUnit { int bh; int qb; };
__device__ __forceinline__ bool attn_next(int vcu,int i,AttnUnit&u){ if(i>=16)return false; const int s=vcu&7, j=i&3; u.bh=(vcu>>3)+32*(i>>2); u.qb=(j==0)?s:(j==1)?15-s:(j==2)?16+s:31-s; return true; }
template<int THRL=8> __device__ __forceinline__ void attn_phase(char*lds,const AttnTensors&T,int vcu,const __attribute__((address_space(3))) float*tball,const int tid){
  AttnUnit u;
  for(int i=0;attn_next(vcu,i,u);++i){ attn_unit<THRL>(u.bh/NHEAD,u.bh%NHEAD,u.qb,T.Q,T.K,T.V,T.O,lds,tball,tid); }
}
#undef SBAR
#undef WAIT_BAR
}

#define XB_TMO      128
#define XB_XCNT(j)  (256  + 64 * (j))
#define XB_XSUB(j)  (1280 + 64 * (j))
#define XB_XGEN(j)  (2304 + 64 * (j))
#define XB_TOP      3328
#define XB_TOPGEN   3392
#define XCD_BAR_WORDS 3456
#define XB_SPIN_CAP (1u << 18)

__device__ __forceinline__ unsigned xb_ld(unsigned* p)              { return __hip_atomic_load(p, __ATOMIC_RELAXED, __HIP_MEMORY_SCOPE_AGENT); }
__device__ __forceinline__ unsigned xb_add(unsigned* p, unsigned v) { return __hip_atomic_fetch_add(p, v, __ATOMIC_RELAXED, __HIP_MEMORY_SCOPE_AGENT); }
__device__ __forceinline__ unsigned xb_xcc_id() { return (unsigned)__builtin_amdgcn_s_getreg((3 << 11) | 20) & 0xFu; }
#define XB_SPIN(cond, bar) do { unsigned _sp = 0; while (cond) { __builtin_amdgcn_s_sleep(1); \
    if ((++_sp & 255u) == 0u) { if (xb_ld(&(bar)[XB_TMO])) break; if (_sp > XB_SPIN_CAP) { atomicAdd(&(bar)[XB_TMO], 1u); break; } } } } while (0)

struct XcdBarrier {
    unsigned* bar; unsigned x;
    volatile LAS unsigned* st;
};

__device__ __forceinline__ XcdBarrier xcd_barrier_post(unsigned* bar, volatile LAS unsigned* st, const bool leader  ) {
    XcdBarrier b; b.bar = bar; b.x = xb_xcc_id(); b.st = st;
    if (leader) (void)xb_add(&bar[XB_XCNT(b.x)], 1u);
    return b;
}
__device__ __forceinline__ void xcd_barrier_complete(unsigned* bar, unsigned x, unsigned& nloc, unsigned& nx) {
    const unsigned G = gridDim.x * gridDim.y * gridDim.z;
    unsigned sum, cnt, mine, sp = 0u;
    for (;;) {
        sum = 0u; cnt = 0u; mine = 0u;
#pragma unroll
        for (unsigned j = 0; j < 16; ++j) { const unsigned c = xb_ld(&bar[XB_XCNT(j)]); sum += c; cnt += (c > 0u) ? 1u : 0u; mine = (j == x) ? c : mine; }
        if (sum == G) break;
        __builtin_amdgcn_s_sleep(1);
        if ((++sp & 255u) == 0u) { if (xb_ld(&bar[XB_TMO])) break; if (sp > XB_SPIN_CAP) { atomicAdd(&bar[XB_TMO], 1u); break; } }
    }
    nloc = mine > 0u ? mine : 1u; nx = cnt > 0u ? cnt : 1u;
}

__device__ __forceinline__ void xcd_barrier(const XcdBarrier& b, const bool leader  ) {
    asm volatile("s_waitcnt vmcnt(0)" ::: "memory");
    __syncthreads();
    if (leader) {
        unsigned* bar = b.bar;
        __builtin_amdgcn_s_waitcnt(0);
        unsigned nloc = b.st[0], nx = b.st[1];
        if (nloc == 0u) { xcd_barrier_complete(bar, b.x, nloc, nx); b.st[0] = nloc; b.st[1] = nx; }
        const unsigned old = xb_add(&bar[XB_XSUB(b.x)], 1u);
        const unsigned gen = old / nloc;
        if (old + 1u == (gen + 1u) * nloc) {
            __builtin_amdgcn_fence(__ATOMIC_RELEASE, "agent");
            asm volatile("s_waitcnt vmcnt(0)" ::: "memory");
            const unsigned og = xb_add(&bar[XB_TOP], 1u);
            const unsigned tg = og / nx;
            if (og + 1u == (tg + 1u) * nx) xb_add(&bar[XB_TOPGEN], 1u);
            else XB_SPIN(xb_ld(&bar[XB_TOPGEN]) == tg, bar);
            __builtin_amdgcn_fence(__ATOMIC_ACQUIRE, "agent");
            xb_add(&bar[XB_XGEN(b.x)], 1u);
            asm volatile("s_waitcnt vmcnt(0)" ::: "memory");
        } else {
            XB_SPIN(xb_ld(&bar[XB_XGEN(b.x)]) == gen, bar);
            __builtin_amdgcn_fence(__ATOMIC_ACQUIRE, "agent");
            asm volatile("s_waitcnt vmcnt(0)" ::: "memory");
        }
    }
    __syncthreads();
}

constexpr size_t MiB = 1u << 20;
constexpr size_t WS_CTL = 0, CTL_ZERO_BYTES = 1 * MiB;
constexpr size_t WS_WIN = 2 * MiB;
constexpr size_t WS_WOUT = 7 * MiB;
constexpr size_t WS_PGATE = 9 * MiB;
constexpr size_t WS_PPROJ = 13 * MiB;
constexpr size_t WS_RCAT = 14 * MiB;
constexpr size_t WS_RL1 = 20 * MiB;
constexpr size_t WS_RS2 = 28 * MiB;
constexpr size_t WS_RWO = 30 * MiB;
constexpr size_t WS_ROUT = 32 * MiB;
constexpr size_t WS_LRUAGG = 33 * MiB;
constexpr size_t WS_MGU = 38 * MiB;
constexpr size_t WS_MDN = 102 * MiB;
constexpr size_t WS_PB = 134 * MiB;
constexpr size_t WS_ACT = 166 * MiB;
constexpr size_t WS_H0 = WS_ACT;
constexpr size_t WS_QKV = WS_ACT + 128 * MiB;
constexpr size_t WS_O = WS_ACT + 448 * MiB;
constexpr size_t WS_HL = WS_ACT + 576 * MiB, WS_CA = WS_ACT + 640 * MiB;
constexpr size_t WS_H2 = WS_ACT;
constexpr size_t WS_LOG = WS_ACT + 128 * MiB;
constexpr size_t WS_ROUTE = WS_ACT + 144 * MiB;
constexpr size_t WS_HID = WS_ACT + 152 * MiB;
constexpr size_t WS_YS = WS_ACT + 288 * MiB;
constexpr size_t WS_PP = WS_ACT + 128 * MiB;
constexpr size_t WS_HCAT = WS_ACT;
constexpr size_t WS_XR = WS_ACT + 256 * MiB, WS_XK = WS_ACT + 384 * MiB, WS_XV = WS_ACT + 512 * MiB;
constexpr size_t WS_R = WS_ACT + 640 * MiB, WS_K = WS_XR, WS_V = WS_XK;
constexpr size_t WS_MID = WS_ACT + 768 * MiB;
constexpr size_t WS_EW = WS_ACT;
constexpr size_t WS_AA = WS_ACT + 128 * MiB;
constexpr size_t WS_Y = WS_XV;
constexpr size_t WS_END = WS_ACT + 832 * MiB;
static_assert(WS_END <= 1024 * MiB, "workspace map");
constexpr size_t RT_EID = 0, RT_POS = 1 * MiB, RT_GATE = 2 * MiB, RT_ROWTOK = 3 * MiB, RT_ROWGATE = 4 * MiB, RT_SLOT = 5 * MiB;
constexpr int CW_BAR = 4096;
constexpr int CW_CNT0 = 16384, CW_CNT1 = 16384 + 64;

constexpr int RING_BYTES = 131072;
constexpr int LDSCTL_OFF = RING_BYTES, MISC_OFF = LDSCTL_OFF + 320;
constexpr int TB_OFF = RING_BYTES + 1024;
constexpr int RTE_OFF = TB_OFF + 2048;
constexpr int LDS_BYTES = 147456;

constexpr int NWAVES = 8;
__device__ __forceinline__ int lane_id_() { int l; asm volatile("v_mbcnt_lo_u32_b32 %0, -1, 0\n\tv_mbcnt_hi_u32_b32 %0, -1, %0" : "=v"(l)); return l; }
#define TID_ (F.wave * 64 + lane_id_())
#define LANE_ (lane_id_())
struct Frame {
    LAS unsigned char* lds; volatile LAS unsigned* MISC; gu32* ctl;
    int wave, vcu, G;
};

__device__ __forceinline__ void load_row4(const float* xrow, int lane, f32x4 (&v)[4]) { const f32x4* p = (const f32x4*)xrow + lane;
#pragma unroll
    for (int j = 0; j < 4; ++j) v[j] = p[64 * j]; }
__device__ __forceinline__ float row_rstd(const f32x4 (&v)[4], float eps) { float s = 0.f;
#pragma unroll
    for (int j = 0; j < 4; ++j) s += (v[j].x * v[j].x + v[j].y * v[j].y) + (v[j].z * v[j].z + v[j].w * v[j].w);
    return 1.0f / sqrtf(wave_sum(s) * (1.0f / 1024.0f) + eps); }
__device__ __forceinline__ void load_row4_bf(const bf16* xrow, int lane, f32x4 (&v)[4]) { const v2u* p = (const v2u*)xrow + lane;
#pragma unroll
    for (int j = 0; j < 4; ++j) { const v2u w = p[64 * j]; v[j] = (f32x4){bflo(w.x), bfhi(w.x), bflo(w.y), bfhi(w.y)}; } }
__device__ __forceinline__ void store_row4_bf(bf16* xrow, int lane, const f32x4 (&v)[4]) { v2u* p = (v2u*)xrow + lane;
#pragma unroll
    for (int j = 0; j < 4; ++j) { v2u o; o.x = pk2(v[j].x, v[j].y); o.y = pk2(v[j].z, v[j].w); p[64 * j] = o; } }
__device__ __forceinline__ void store_row_bf16(bf16* orow, int lane, const f32x4 (&v)[4], float rstd, const float* g) {
    unsigned long long* o8 = (unsigned long long*)orow + lane;
#pragma unroll
    for (int j = 0; j < 4; ++j) { const f32x4 gg = ((const f32x4*)g)[lane + 64 * j];
        o8[64 * j] = (unsigned long long)pk2(v[j].x * rstd * gg.x, v[j].y * rstd * gg.y) | ((unsigned long long)pk2(v[j].z * rstd * gg.z, v[j].w * rstd * gg.w) << 32); }
}

template <int MODE>
__device__ __forceinline__ void transpose_item(const float* W, int K, int N, bf16* WT, int ldo, int row_off, const float* mu, LAS float* scr, int item, int lane) {
    const int nblk = N / 32, kb = item / nblk, nb = item % nblk, k0 = 64 * kb, n0 = 32 * nb;
    float ld[32];
#pragma unroll
    for (int i = 0; i < 32; ++i) { const int kk = 2 * i + (lane >> 5); ld[i] = W[(size_t)(k0 + kk) * N + n0 + (lane & 31)]; }
#pragma unroll
    for (int i = 0; i < 32; ++i) { const int kk = 2 * i + (lane >> 5); scr[kk * 33 + (lane & 31)] = ld[i]; }
    LDS_WAIT(); asm volatile("" ::: "memory");
    const int c = lane & 7;
    int rbase = row_off + n0;
    if (MODE == 2) { rbase = row_off + ((n0 < 512) ? ((n0 >> 7) * 256 + (n0 & 127)) : (((n0 - 512) >> 7) * 256 + 128 + ((n0 - 512) & 127))); }
    float m[8];
    if (MODE == 1) {
#pragma unroll
        for (int e = 0; e < 8; ++e) m[e] = mu[k0 + 8 * c + e]; }
#pragma unroll
    for (int j = 0; j < 4; ++j) { const int n = (lane >> 3) + 8 * j; const LAS float* s = scr + (8 * c) * 33 + n;
        float v[8];
#pragma unroll
        for (int e = 0; e < 8; ++e) v[e] = s[e * 33];
        bf16* dst = WT + (size_t)(rbase + n) * ldo + k0 + 8 * c;
        if (MODE == 1) {
            v4u o, o2;
            o.x = pk2(v[0] * (1.f - m[0]), v[1] * (1.f - m[1])); o.y = pk2(v[2] * (1.f - m[2]), v[3] * (1.f - m[3])); o.z = pk2(v[4] * (1.f - m[4]), v[5] * (1.f - m[5])); o.w = pk2(v[6] * (1.f - m[6]), v[7] * (1.f - m[7]));
            o2.x = pk2(v[0] * m[0], v[1] * m[1]); o2.y = pk2(v[2] * m[2], v[3] * m[3]); o2.z = pk2(v[4] * m[4], v[5] * m[5]); o2.w = pk2(v[6] * m[6], v[7] * m[7]);
            *(GAS v4u*)dst = o; *(GAS v4u*)(dst + 1024) = o2;
        } else {
            v4u o; o.x = pk2(v[0], v[1]); o.y = pk2(v[2], v[3]); o.z = pk2(v[4], v[5]); o.w = pk2(v[6], v[7]);
            *(GAS v4u*)dst = o; }
    }
    LDS_WAIT(); asm volatile("" ::: "memory");
}

struct In {
    const float *x, *p, *rel_bias, *norm_mix, *ab_w_in, *ab_w_out, *lam_q1, *lam_k1, *lam_q2, *lam_k2, *sub_g, *conv_w, *conv_b, *lru_wa, *lru_ba, *lru_wx, *lru_bx, *lru_lambda,
        *rwkv_mu, *rwkv_wr, *rwkv_wk, *rwkv_wv, *rwkv_wo, *rwkv_w0, *rwkv_w1, *rwkv_w2, *rwkv_a0, *rwkv_a1, *rwkv_a2, *rwkv_g1, *rwkv_g2, *rwkv_kk, *rwkv_ka, *rwkv_rk, *rwkv_ln_g, *rwkv_ln_b,
        *norm_ffn, *moe_wc, *moe_bc, *moe_wf, *moe_bf, *moe_w_gu, *moe_w_down, *ple_norm, *ple_gate, *ple_proj, *final_norm;
};

__device__ __forceinline__ void prep_dense_weights(Frame& F, const In& I, unsigned char* ws) {
    LAS float* scr = (LAS float*)(F.lds + F.wave * 16384);
    const int gw = F.vcu * NWAVES + F.wave, NGW = F.G * NWAVES;
    bf16* WIN = (bf16*)(ws + WS_WIN); bf16* WOUT = (bf16*)(ws + WS_WOUT); bf16* PG = (bf16*)(ws + WS_PGATE); bf16* PPJ = (bf16*)(ws + WS_PPROJ);
    bf16* RCAT = (bf16*)(ws + WS_RCAT); bf16* RL1 = (bf16*)(ws + WS_RL1); bf16* RWO = (bf16*)(ws + WS_RWO);
    constexpr int I_IN = (1024 / 64) * (2560 / 32), I_SQ = (1024 / 64) * (1024 / 32), I_PJ = (256 / 64) * (1024 / 32), I_L64 = (1024 / 64) * (64 / 32), I_L160 = (1024 / 64) * (160 / 32);
    int st = gw;
#define TJOB(MODE, NITEMS, W, K, N, WT, LDO, ROFF, MU) do { for (int it = st; it < (NITEMS); it += NGW) transpose_item<MODE>(W, K, N, WT, LDO, ROFF, MU, scr, it, LANE_); \
        st = (st + NGW - ((NITEMS) % NGW)) % NGW; asm volatile("" : "+s"(st)); } while (0)
    TJOB(0, I_IN, I.ab_w_in, 1024, 2560, WIN, 1024, 0, nullptr);
    TJOB(0, I_SQ, I.ab_w_out, 1024, 1024, WOUT, 1024, 0, nullptr);
    TJOB(0, I_SQ, I.ple_gate, 1024, 1024, PG, 1024, 0, nullptr);
    TJOB(0, I_SQ, I.ple_gate + 1024 * 1024, 1024, 1024, PG + 1024 * 1024, 1024, 0, nullptr);
    TJOB(0, I_SQ, I.rwkv_wo, 1024, 1024, RWO, 1024, 0, nullptr);
    TJOB(0, I_SQ, I.rwkv_wr, 1024, 1024, RCAT, 1024, 0, nullptr);
    TJOB(0, I_SQ, I.rwkv_wk, 1024, 1024, RCAT, 1024, 1024, nullptr);
    TJOB(0, I_SQ, I.rwkv_wv, 1024, 1024, RCAT, 1024, 2048, nullptr);
    TJOB(0, I_PJ, I.ple_proj, 256, 1024, PPJ, 256, 0, nullptr);
    TJOB(0, I_PJ, I.ple_proj + 256 * 1024, 256, 1024, PPJ + 1024 * 256, 256, 0, nullptr);
    TJOB(1, I_L64, I.rwkv_w1, 1024, 64, RL1, 2048, 0, I.rwkv_mu + 1 * 1024);
    TJOB(1, I_L64, I.rwkv_a1, 1024, 64, RL1, 2048, 64, I.rwkv_mu + 4 * 1024);
    TJOB(1, I_L160, I.rwkv_g1, 1024, 160, RL1, 2048, 256, I.rwkv_mu + 5 * 1024);
#undef TJOB
    const int gt = F.vcu * 512 + TID_, NGT = F.G * 512;
    { v4u z = {0u, 0u, 0u, 0u}; const int per_row = 2048 / 8;
      for (int i = gt; i < (128 + 96) * per_row; i += NGT) { int rr = i / per_row, cc = i % per_row; rr = (rr < 128) ? (128 + rr) : (416 + rr - 128); *(GAS v4u*)(RL1 + (size_t)rr * 2048 + cc * 8) = z; } }
    { bf16* S2 = (bf16*)(ws + WS_RS2);
      for (int i = gt; i < 3 * 1024 * 256; i += NGT) { const int ty = i / (1024 * 256), n = (i / 256) & 1023, k = i & 255; float v = 0.f;
          if (ty == 0) { if (k < 64) v = I.rwkv_w2[k * 1024 + n]; } else if (ty == 1) { if (k >= 64 && k < 128) v = I.rwkv_a2[(k - 64) * 1024 + n]; } else { if (k < 160) v = I.rwkv_g2[k * 1024 + n]; }
          S2[i] = (bf16)f2bf(v); } }
    { bf16* RT = (bf16*)(ws + WS_ROUT);
      for (int i = gt; i < 2 * 256 * 1024; i += NGT) { const int l = i / (256 * 1024), n = (i / 1024) & 255, k = i & 1023; float v = 0.f;
          if (n < 4) v = I.moe_wc[(size_t)l * 1024 * 4 + k * 4 + n]; else if (n < 36) v = I.moe_wf[(size_t)l * 1024 * 32 + k * 32 + (n - 4)];
          RT[i] = (bf16)f2bf(v); } }
}
__device__ __forceinline__ void prep_layer_weights(Frame& F, const In& I, unsigned char* ws, int layer) {
    LAS float* scr = (LAS float*)(F.lds + F.wave * 16384);
    const int gw = F.vcu * NWAVES + F.wave, NGW = F.G * NWAVES;
    bf16* MGU = (bf16*)(ws + WS_MGU); bf16* MDN = (bf16*)(ws + WS_MDN);
    const float* wgu = I.moe_w_gu + (size_t)layer * NEXP * 1024 * 1024; const float* wdn = I.moe_w_down + (size_t)layer * NEXP * 512 * 1024;
    constexpr int I_GU = (1024 / 64) * (1024 / 32), I_DN = (512 / 64) * (1024 / 32);
    for (int it = gw; it < NEXP * (I_GU + I_DN); it += NGW) {
        const int e = it / (I_GU + I_DN); int r = it % (I_GU + I_DN);
        if (r < I_GU) transpose_item<2>(wgu + (size_t)e * 1024 * 1024, 1024, 1024, MGU + (size_t)e * 1024 * 1024, 1024, 0, nullptr, scr, r, LANE_);
        else transpose_item<0>(wdn + (size_t)e * 512 * 1024, 512, 1024, MDN + (size_t)e * 1024 * 512, 512, 0, nullptr, scr, r - I_GU, LANE_);
    }
    const int gt = F.vcu * 512 + TID_, NGT = F.G * 512;
    const f32x4* ps = (const f32x4*)(I.p + (size_t)layer * T * PLE); v2u* pd = (v2u*)(ws + WS_PB);
    for (int i = gt; i < T * PLE / 4; i += 4 * NGT) { f32x4 v[4];
#pragma unroll
        for (int r = 0; r < 4; ++r) v[r] = ps[i + r * NGT];
#pragma unroll
        for (int r = 0; r < 4; ++r) { v2u o; o.x = pk2(v[r].x, v[r].y); o.y = pk2(v[r].z, v[r].w); pd[i + r * NGT] = o; } }
}

template <bool XBF>
__device__ __forceinline__ void norm_pass(Frame& F, const void* x, const float* g, bf16* out) {
    const int gw = F.vcu * NWAVES + F.wave, NGW = F.G * NWAVES; const int lane = LANE_;
    for (int t = 4 * gw; t < T; t += 4 * NGW) {
        f32x4 v[4][4];
#pragma unroll
        for (int r = 0; r < 4; ++r) { if (XBF) load_row4_bf((const bf16*)x + (size_t)(t + r) * D, lane, v[r]); else load_row4((const float*)x + (size_t)(t + r) * D, lane, v[r]); }
#pragma unroll
        for (int r = 0; r < 4; ++r) { const float rs = row_rstd(v[r], 1e-6f); store_row_bf16(out + (size_t)(t + r) * D, lane, v[r], rs, g); }
    }
}
__device__ __forceinline__ void rwkv_input_pass(Frame& F, const bf16* x, const float* g, const float* mu, bf16* HCAT, bf16* XR, bf16* XK, bf16* XV) {
    const int gw = F.vcu * NWAVES + F.wave, NGW = F.G * NWAVES; const int lane = LANE_;
    f32x4 gg[4], mr[4], mk[4], mv[4];
#pragma unroll
    for (int j = 0; j < 4; ++j) { gg[j] = ((const f32x4*)g)[lane + 64 * j]; mr[j] = ((const f32x4*)(mu + 0 * 1024))[lane + 64 * j]; mk[j] = ((const f32x4*)(mu + 2 * 1024))[lane + 64 * j]; mv[j] = ((const f32x4*)(mu + 3 * 1024))[lane + 64 * j]; }
    for (int blk = gw; blk < T / 32; blk += NGW) {
        const int t0 = blk * 32; f32x4 hp[4];
        if ((t0 & (SEQ - 1)) == 0) {
#pragma unroll
            for (int j = 0; j < 4; ++j) hp[j] = (f32x4){0.f, 0.f, 0.f, 0.f};
        } else { f32x4 v[4]; load_row4_bf(x + (size_t)(t0 - 1) * D, lane, v); const float rstd = row_rstd(v, 1e-6f);
#pragma unroll
            for (int j = 0; j < 4; ++j) hp[j] = v[j] * rstd * gg[j]; }
        f32x4 vn[4]; load_row4_bf(x + (size_t)t0 * D, lane, vn);
        for (int t = t0; t < t0 + 32; ++t) {
            f32x4 v[4];
#pragma unroll
            for (int j = 0; j < 4; ++j) v[j] = vn[j];
            if (t + 1 < t0 + 32) load_row4_bf(x + (size_t)(t + 1) * D, lane, vn);
            const float rstd = row_rstd(v, 1e-6f);
            unsigned long long* oh = (unsigned long long*)(HCAT + (size_t)t * 2048) + lane; unsigned long long* or_ = (unsigned long long*)(XR + (size_t)t * 1024) + lane;
            unsigned long long* ok = (unsigned long long*)(XK + (size_t)t * 1024) + lane; unsigned long long* ov = (unsigned long long*)(XV + (size_t)t * 1024) + lane;
#pragma unroll
            for (int j = 0; j < 4; ++j) { const f32x4 h = v[j] * rstd * gg[j], dd = hp[j] - h;
                oh[64 * j] = (unsigned long long)pk2(h.x, h.y) | ((unsigned long long)pk2(h.z, h.w) << 32);
                oh[256 + 64 * j] = (unsigned long long)pk2(hp[j].x, hp[j].y) | ((unsigned long long)pk2(hp[j].z, hp[j].w) << 32);
                const f32x4 a = h + dd * mr[j], b = h + dd * mk[j], c = h + dd * mv[j];
                or_[64 * j] = (unsigned long long)pk2(a.x, a.y) | ((unsigned long long)pk2(a.z, a.w) << 32);
                ok[64 * j] = (unsigned long long)pk2(b.x, b.y) | ((unsigned long long)pk2(b.z, b.w) << 32);
                ov[64 * j] = (unsigned long long)pk2(c.x, c.y) | ((unsigned long long)pk2(c.z, c.w) << 32);
                hp[j] = h; }
        }
    }
}
__device__ __forceinline__ void combine_norm_pass(Frame& F, const bf16* xin, bf16* xout, const bf16* YS, const int* slot, const float* g, bf16* out) {
    const int gw = F.vcu * NWAVES + F.wave, NGW = F.G * NWAVES; const int lane = LANE_;
    for (int t = 2 * gw; t < T; t += 2 * NGW) {
        f32x4 v[2][4]; v2u ya[2][4], yb[2][4];
#pragma unroll
        for (int r = 0; r < 2; ++r) { load_row4_bf(xin + (size_t)(t + r) * D, lane, v[r]);
            const int s0 = slot[2 * (t + r)], s1 = slot[2 * (t + r) + 1];
            const v2u* y0 = (const v2u*)(YS + (size_t)s0 * D) + lane; const v2u* y1 = (const v2u*)(YS + (size_t)s1 * D) + lane;
#pragma unroll
            for (int j = 0; j < 4; ++j) { ya[r][j] = y0[64 * j]; yb[r][j] = y1[64 * j]; } }
#pragma unroll
        for (int r = 0; r < 2; ++r) {
#pragma unroll
            for (int j = 0; j < 4; ++j) { const v2u a = ya[r][j], b = yb[r][j];
                v[r][j].x += bflo(a.x) + bflo(b.x); v[r][j].y += bfhi(a.x) + bfhi(b.x); v[r][j].z += bflo(a.y) + bflo(b.y); v[r][j].w += bfhi(a.y) + bfhi(b.y); }
            store_row4_bf(xout + (size_t)(t + r) * D, lane, v[r]);
            const float rstd = row_rstd(v[r], 1e-6f);
            store_row_bf16(out + (size_t)(t + r) * D, lane, v[r], rstd, g); }
    }
}
__device__ __forceinline__ void final_norm_pass(Frame& F, const bf16* x, float* out, const float* g) {
    const int gw = F.vcu * NWAVES + F.wave, NGW = F.G * NWAVES; const int lane = LANE_;
    for (int t = 4 * gw; t < T; t += 4 * NGW) {
        f32x4 v[4][4];
#pragma unroll
        for (int r = 0; r < 4; ++r) load_row4_bf(x + (size_t)(t + r) * D, lane, v[r]);
#pragma unroll
        for (int r = 0; r < 4; ++r) { const float rs = row_rstd(v[r], 1e-6f); f32x4* xo = (f32x4*)(out + (size_t)(t + r) * D) + lane;
#pragma unroll
            for (int j = 0; j < 4; ++j) { const f32x4 gg = ((const f32x4*)g)[lane + 64 * j]; xo[64 * j] = v[r][j] * rs * gg; } }
    }
}

__device__ __forceinline__ void diff_combine_pass(Frame& F, const In& I, const bf16* O, bf16* YCAT) {
    const int gw = F.vcu * NWAVES + F.wave, NGW = F.G * NWAVES;
    const float lam_init = 0.2f;
    const float d1 = wave_sum(I.lam_q1[LANE_] * I.lam_k1[LANE_]), d2 = wave_sum(I.lam_q2[LANE_] * I.lam_k2[LANE_]);
    const float lam = expf(d1) - expf(d2) + lam_init;
    const int h = LANE_ >> 4, q = LANE_ & 15;
    float sg[8];
#pragma unroll
    for (int e = 0; e < 8; ++e) sg[e] = I.sub_g[q * 8 + e] * (1.0f - lam_init);
    for (int t0 = 4 * gw; t0 < T; t0 += 4 * NGW) {
        v4u av[4], bv[4];
#pragma unroll
        for (int r = 0; r < 4; ++r) { av[r] = *(const v4u*)(O + (size_t)(t0 + r) * 1024 + h * 256 + q * 8); bv[r] = *(const v4u*)(O + (size_t)(t0 + r) * 1024 + h * 256 + 128 + q * 8); }
#pragma unroll
        for (int r = 0; r < 4; ++r) { const v4u a = av[r], b = bv[r]; const int t = t0 + r;
        float o[8];
        o[0] = bflo(a.x) - lam * bflo(b.x); o[1] = bfhi(a.x) - lam * bfhi(b.x); o[2] = bflo(a.y) - lam * bflo(b.y); o[3] = bfhi(a.y) - lam * bfhi(b.y);
        o[4] = bflo(a.z) - lam * bflo(b.z); o[5] = bfhi(a.z) - lam * bfhi(b.z); o[6] = bflo(a.w) - lam * bflo(b.w); o[7] = bfhi(a.w) - lam * bfhi(b.w);
        float s = 0.f;
#pragma unroll
        for (int e = 0; e < 8; ++e) s += o[e] * o[e];
        s += __shfl_xor(s, 1); s += __shfl_xor(s, 2); s += __shfl_xor(s, 4); s += __shfl_xor(s, 8);
        const float rstd = 1.0f / sqrtf(s * (1.0f / 128.0f) + 1e-5f);
        v4u w; w.x = pk2(o[0] * rstd * sg[0], o[1] * rstd * sg[1]); w.y = pk2(o[2] * rstd * sg[2], o[3] * rstd * sg[3]); w.z = pk2(o[4] * rstd * sg[4], o[5] * rstd * sg[5]); w.w = pk2(o[6] * rstd * sg[6], o[7] * rstd * sg[7]);
        *(v4u*)(YCAT + (size_t)t * 1024 + h * 128 + q * 8) = w; }
    }
}

constexpr int LCT = 64, LNCH = SEQ / LCT;
__device__ __forceinline__ float gelu_tanh(float x) { const float u = 0.7978845608028654f * (x + 0.044715f * x * x * x); return x * sigmoidf_(2.0f * u); }
template <bool FINAL>
__device__ __forceinline__ void lru_phase(Frame& F, const In& I, const bf16* XB, const bf16* GB, f32x2* AGG, bf16* YCAT, bf16* HLp, bf16* CAp) {
    const int ch = TID_, n = ch >> 6, d = ch & 63;
    LAS float* U = (LAS float*)F.lds;
    f32x2 wg[64];
#pragma unroll
    for (int c = 0; c < 64; ++c) { wg[c].x = I.lru_wa[n * 4096 + c * 64 + d]; wg[c].y = I.lru_wx[n * 4096 + c * 64 + d]; }
    const float cw0 = I.conv_w[0 * 512 + ch], cw1 = I.conv_w[1 * 512 + ch], cw2 = I.conv_w[2 * 512 + ch], cw3 = I.conv_w[3 * 512 + ch], cb = I.conv_b[ch];
    const float ba = I.lru_ba[ch], bx = I.lru_bx[ch];
    const float lam = I.lru_lambda[ch]; const float sp = (lam > 15.f) ? expf(-lam) : log1pf(expf(-lam));
    const float m8sp = -8.0f * sp;
    for (int un = blockIdx.x; un < NB * LNCH; un += F.G) {
        const int b = un / LNCH, c = un % LNCH; const size_t row0 = (size_t)b * SEQ + (size_t)c * LCT;
        unsigned short xraw[LCT + 3];
        if (c > 0) { xraw[0] = XB[(row0 - 3) * 512 + ch]; xraw[1] = XB[(row0 - 2) * 512 + ch]; xraw[2] = XB[(row0 - 1) * 512 + ch]; } else { xraw[0] = 0; xraw[1] = 0; xraw[2] = 0; }
#pragma unroll
        for (int tk = 0; tk < LCT; ++tk) xraw[3 + tk] = XB[(row0 + tk) * 512 + ch];
        float h = 0.f, Ap = 1.f;
        if (FINAL) { for (int j = 0; j < c; ++j) { const f32x2 ag = AGG[((size_t)b * LNCH + j) * 512 + ch]; h = ag.x * h + ag.y; } }
#pragma unroll
        for (int tk = 0; tk < LCT; ++tk) U[tk * 512 + ch] = cw0 * bf1(xraw[tk]) + cw1 * bf1(xraw[tk + 1]) + cw2 * bf1(xraw[tk + 2]) + cw3 * bf1(xraw[tk + 3]) + cb;
        __syncthreads();
        unsigned short gcur[8], gnxt[8];
        if (FINAL) {
#pragma unroll
            for (int j = 0; j < 8; ++j) gcur[j] = GB[(row0 + j) * 512 + ch]; }
#pragma unroll 1
        for (int tg = 0; tg < LCT / 8; ++tg) {
            if (FINAL) { const int tn = (tg + 1 < LCT / 8) ? (tg + 1) * 8 : tg * 8;
#pragma unroll
                for (int j = 0; j < 8; ++j) gnxt[j] = GB[(row0 + tn + j) * 512 + ch]; }
#pragma unroll
            for (int j = 0; j < 8; ++j) { const int tk = tg * 8 + j;
                const LAS f32x4* up = (const LAS f32x4*)(U + tk * 512 + n * 64);
                f32x2 acc = {ba, bx};
#pragma unroll
                for (int c4 = 0; c4 < 16; ++c4) { const f32x4 uu = up[c4];
                    acc += wg[4 * c4 + 0] * uu.x; acc += wg[4 * c4 + 1] * uu.y; acc += wg[4 * c4 + 2] * uu.z; acc += wg[4 * c4 + 3] * uu.w; }
                const float r = sigmoidf_(acc.x), ig = sigmoidf_(acc.y);
                const float la = r * m8sp; const float a = __expf(la); const float t2 = 2.0f * la; const float om = (t2 > -0.02f) ? -t2 * (1.0f + t2 * (0.5f + t2 * (0.16666667f + t2 * 0.041666668f))) : 1.0f - a * a; const float bb = __builtin_amdgcn_sqrtf(om) * (ig * U[tk * 512 + ch]);
                h = a * h + bb;
                if (FINAL) { YCAT[(row0 + tk) * 1024 + 512 + ch] = (bf16)f2bf(h * gelu_tanh(bf1(gcur[j]))); }
                else { Ap *= a; HLp[(row0 + tk) * 512 + ch] = (bf16)f2bf(h); CAp[(row0 + tk) * 512 + ch] = (bf16)f2bf(Ap); } }
            if (FINAL) {
#pragma unroll
                for (int j = 0; j < 8; ++j) gcur[j] = gnxt[j]; }
        }
        if (!FINAL) { f32x2 ag; ag.x = Ap; ag.y = h; AGG[((size_t)b * LNCH + c) * 512 + ch] = ag; }
        __syncthreads();
    }
}

__device__ __forceinline__ void lru_agg_mfma(Frame& F, const In& I, const bf16* XB, f32x2* AGG, bf16* HLp, bf16* CAp) {
    const int tid = TID_, lane = tid & 63, fr = lane & 15, fq = lane >> 4, n = F.wave, ch = tid;
    constexpr int UP = 520;
    LAS bf16* U = (LAS bf16*)F.lds;
    bf16x8 Wr[4][2], Wi[4][2];
#pragma unroll
    for (int dd = 0; dd < 4; ++dd)
#pragma unroll
        for (int kh = 0; kh < 2; ++kh) { unsigned pr_[4], pi_[4];
#pragma unroll
            for (int j = 0; j < 4; ++j) { const int c0 = 32 * kh + 8 * fq + 2 * j, d = 16 * dd + fr;
                pr_[j] = pk2(I.lru_wa[n * 4096 + c0 * 64 + d], I.lru_wa[n * 4096 + (c0 + 1) * 64 + d]); pi_[j] = pk2(I.lru_wx[n * 4096 + c0 * 64 + d], I.lru_wx[n * 4096 + (c0 + 1) * 64 + d]); }
            Wr[dd][kh] = __builtin_bit_cast(bf16x8, (v4u){pr_[0], pr_[1], pr_[2], pr_[3]}); Wi[dd][kh] = __builtin_bit_cast(bf16x8, (v4u){pi_[0], pi_[1], pi_[2], pi_[3]}); }
    float cba[4], cbx[4], cm8[4];
#pragma unroll
    for (int dd = 0; dd < 4; ++dd) { const int chd = 64 * n + 16 * dd + fr; cba[dd] = I.lru_ba[chd]; cbx[dd] = I.lru_bx[chd];
        const float lam = I.lru_lambda[chd]; cm8[dd] = -8.0f * ((lam > 15.f) ? expf(-lam) : log1pf(expf(-lam))); }
    const float cw0 = I.conv_w[0 * 512 + ch], cw1 = I.conv_w[1 * 512 + ch], cw2 = I.conv_w[2 * 512 + ch], cw3 = I.conv_w[3 * 512 + ch], cb = I.conv_b[ch];
    for (int un = blockIdx.x; un < NB * LNCH; un += F.G) {
        const int b = un / LNCH, c = un % LNCH; const size_t row0 = (size_t)b * SEQ + (size_t)c * LCT;
        unsigned short xraw[LCT + 3];
        if (c > 0) { xraw[0] = XB[(row0 - 3) * 512 + ch]; xraw[1] = XB[(row0 - 2) * 512 + ch]; xraw[2] = XB[(row0 - 1) * 512 + ch]; } else { xraw[0] = 0; xraw[1] = 0; xraw[2] = 0; }
#pragma unroll
        for (int tk = 0; tk < LCT; ++tk) xraw[3 + tk] = XB[(row0 + tk) * 512 + ch];
#pragma unroll
        for (int tk = 0; tk < LCT; ++tk) U[tk * UP + ch] = (bf16)f2bf(cw0 * bf1(xraw[tk]) + cw1 * bf1(xraw[tk + 1]) + cw2 * bf1(xraw[tk + 2]) + cw3 * bf1(xraw[tk + 3]) + cb);
        __syncthreads();
        bf16x8 X[4][2];
#pragma unroll
        for (int tt = 0; tt < 4; ++tt)
#pragma unroll
            for (int kh = 0; kh < 2; ++kh) X[tt][kh] = *(const LAS bf16x8*)(U + (16 * tt + fr) * UP + 64 * n + 32 * kh + 8 * fq);
#pragma unroll 1
        for (int dd = 0; dd < 4; ++dd) {
            bf16x8 wr0, wr1, wi0, wi1; float kba, kbx, km8;
            if (dd == 0) { wr0 = Wr[0][0]; wr1 = Wr[0][1]; wi0 = Wi[0][0]; wi1 = Wi[0][1]; kba = cba[0]; kbx = cbx[0]; km8 = cm8[0]; }
            else if (dd == 1) { wr0 = Wr[1][0]; wr1 = Wr[1][1]; wi0 = Wi[1][0]; wi1 = Wi[1][1]; kba = cba[1]; kbx = cbx[1]; km8 = cm8[1]; }
            else if (dd == 2) { wr0 = Wr[2][0]; wr1 = Wr[2][1]; wi0 = Wi[2][0]; wi1 = Wi[2][1]; kba = cba[2]; kbx = cbx[2]; km8 = cm8[2]; }
            else { wr0 = Wr[3][0]; wr1 = Wr[3][1]; wi0 = Wi[3][0]; wi1 = Wi[3][1]; kba = cba[3]; kbx = cbx[3]; km8 = cm8[3]; }
            const int chd = 64 * n + 16 * dd + fr;
            float hc = 0.f, Ac = 1.f;
#pragma unroll
            for (int tt = 0; tt < 4; ++tt) {
                f32x4 pr = (f32x4){0.f, 0.f, 0.f, 0.f}, pi = pr;
                pr = __builtin_amdgcn_mfma_f32_16x16x32_bf16(X[tt][0], wr0, pr, 0, 0, 0); pr = __builtin_amdgcn_mfma_f32_16x16x32_bf16(X[tt][1], wr1, pr, 0, 0, 0);
                pi = __builtin_amdgcn_mfma_f32_16x16x32_bf16(X[tt][0], wi0, pi, 0, 0, 0); pi = __builtin_amdgcn_mfma_f32_16x16x32_bf16(X[tt][1], wi1, pi, 0, 0, 0);
                float a[4], bb[4];
#pragma unroll
                for (int e = 0; e < 4; ++e) { const int tok = 16 * tt + 4 * fq + e; const float u = bf1(U[tok * UP + chd]);
                    const float r = sigmoidf_(pr[e] + kba), ig = sigmoidf_(pi[e] + kbx); const float la = r * km8; a[e] = __expf(la); const float t2 = 2.0f * la;
                    const float om = (t2 > -0.02f) ? -t2 * (1.0f + t2 * (0.5f + t2 * (0.16666667f + t2 * 0.041666668f))) : 1.0f - a[e] * a[e]; bb[e] = __builtin_amdgcn_sqrtf(om) * (ig * u); }
                const float A4 = (a[0] * a[1]) * (a[2] * a[3]); const float B4 = ((bb[0] * a[1] + bb[1]) * a[2] + bb[2]) * a[3] + bb[3];
                float h = hc, Ap = Ac, hs = hc, As = Ac;
#pragma unroll
                for (int j = 0; j < 4; ++j) { const float Aj = __shfl(A4, fr + 16 * j), Bj = __shfl(B4, fr + 16 * j); if (j == fq) { hs = h; As = Ap; } h = Aj * h + Bj; Ap *= Aj; }
                hc = h; Ac = Ap; h = hs; Ap = As;
#pragma unroll
                for (int e = 0; e < 4; ++e) { h = a[e] * h + bb[e]; Ap *= a[e]; const size_t o = (row0 + 16 * tt + 4 * fq + e) * 512 + chd; HLp[o] = (bf16)f2bf(h); CAp[o] = (bf16)f2bf(Ap); }
            }
            if (fq == 0) { f32x2 ag; ag.x = Ac; ag.y = hc; AGG[((size_t)b * LNCH + c) * 512 + chd] = ag; }
        }
        __syncthreads();
    }
}

__device__ __forceinline__ void lru_final_pass(Frame& F, const bf16* HLp, const bf16* CAp, const bf16* GB, const f32x2* AGG, bf16* YCAT) {
    const int ch = TID_;
    for (int un = blockIdx.x; un < NB * LNCH; un += F.G) {
        const int b = un / LNCH, c = un % LNCH; const size_t row0 = (size_t)b * SEQ + (size_t)c * LCT;
        float carry = 0.f;
        for (int j = 0; j < c; ++j) { const f32x2 ag = AGG[((size_t)b * LNCH + j) * 512 + ch]; carry = ag.x * carry + ag.y; }
#pragma unroll 4
        for (int t8 = 0; t8 < LCT; t8 += 8) {
            bf16 hl[8], ca[8], gv[8];
#pragma unroll
            for (int j = 0; j < 8; ++j) { const size_t o = (row0 + t8 + j) * 512 + ch; hl[j] = HLp[o]; ca[j] = CAp[o]; gv[j] = GB[o]; }
#pragma unroll
            for (int j = 0; j < 8; ++j) { const float h = bf1(hl[j]) + bf1(ca[j]) * carry; YCAT[(row0 + t8 + j) * 1024 + 512 + ch] = (bf16)f2bf(h * gelu_tanh(bf1(gv[j]))); }
        }
    }
}

__device__ __forceinline__ void route_pass_a(Frame& F, const In& I, int layer, const float* LOG, unsigned char* rt, gu32* cnt) {
    LAS int* lcnt = (LAS int*)(F.lds + RTE_OFF); LAS int* lbase = lcnt + 32;
    int* EID = (int*)(rt + RT_EID); int* POS = (int*)(rt + RT_POS); float* GATE = (float*)(rt + RT_GATE);
    const float* bc = I.moe_bc + layer * 4; const float* bfb = I.moe_bf + layer * 32;
    for (int un = blockIdx.x; un < T / 512; un += F.G) {
        if (TID_ < 32) lcnt[TID_] = 0;
        __syncthreads();
        const int t = un * 512 + TID_; const float* lg = LOG + (size_t)t * 64;
        const f32x4 g4 = *(const f32x4*)lg;
        float gl[4] = {g4.x + bc[0], g4.y + bc[1], g4.z + bc[2], g4.w + bc[3]};
        int gi = 0; float gm = gl[0];
#pragma unroll
        for (int j = 1; j < 4; ++j) if (gl[j] > gm) { gm = gl[j]; gi = j; }
        float gs = 0.f;
#pragma unroll
        for (int j = 0; j < 4; ++j) gs += __expf(gl[j] - gm);
        const float gprob = 1.0f / gs;
        const f32x4 e0 = *(const f32x4*)(lg + 4 + gi * 8), e1 = *(const f32x4*)(lg + 8 + gi * 8);
        float el[8] = {e0.x, e0.y, e0.z, e0.w, e1.x, e1.y, e1.z, e1.w};
#pragma unroll
        for (int j = 0; j < 8; ++j) el[j] += bfb[gi * 8 + j];
        int i0 = 0; float m0 = el[0];
#pragma unroll
        for (int j = 1; j < 8; ++j) if (el[j] > m0) { m0 = el[j]; i0 = j; }
        int i1 = -1; float m1 = -INFINITY;
#pragma unroll
        for (int j = 0; j < 8; ++j) if (j != i0 && el[j] > m1) { m1 = el[j]; i1 = j; }
        const float r1 = __expf(m1 - m0); const float g0 = gprob / (1.0f + r1), g1 = gprob * r1 / (1.0f + r1);
        const int ex0 = gi * 8 + i0, ex1 = gi * 8 + i1;
        const int p0 = atomicAdd((int*)&lcnt[ex0], 1), p1 = atomicAdd((int*)&lcnt[ex1], 1);
        __syncthreads();
        if (TID_ < 32) lbase[TID_] = (int)__hip_atomic_fetch_add(cnt + TID_, (unsigned)lcnt[TID_], RLX_AGENT);
        __syncthreads();
        EID[2 * t] = ex0; EID[2 * t + 1] = ex1; POS[2 * t] = lbase[ex0] + p0; POS[2 * t + 1] = lbase[ex1] + p1; GATE[2 * t] = g0; GATE[2 * t + 1] = g1;
        __syncthreads();
    }
}
__device__ __forceinline__ void route_bases(Frame& F, gu32* cnt) {
    LAS int* eb = (LAS int*)(F.lds + RTE_OFF + 512);
    const int tid = TID_;
    if (tid < 64) {
        const int c = (tid < 32) ? (int)__hip_atomic_load(cnt + (tid & 31), RLX_AGENT) : 0; const int p = (c + 255) & ~255; int s = p;
#pragma unroll
        for (int o = 1; o < 32; o <<= 1) { const int t = __shfl_up(s, o); if ((tid & 63) >= o) s += t; }
        if (tid < 32) { eb[tid] = s - p; if (tid == 31) eb[32] = s; }
    }
    __syncthreads();
}
__device__ __forceinline__ void route_pass_b(Frame& F, unsigned char* rt, gu32* cnt) {
    route_bases(F, cnt);
    LAS int* eb = (LAS int*)(F.lds + RTE_OFF + 512);
    const int* EID = (const int*)(rt + RT_EID); const int* POS = (const int*)(rt + RT_POS); const float* GATE = (const float*)(rt + RT_GATE);
    int* ROWTOK = (int*)(rt + RT_ROWTOK); float* ROWGATE = (float*)(rt + RT_ROWGATE); int* SLOT = (int*)(rt + RT_SLOT);
    const int gt = F.vcu * 512 + TID_, NGT = F.G * 512;
    for (int i = gt; i < 2 * T; i += NGT) { const int dst = eb[EID[i]] + POS[i]; ROWTOK[dst] = i >> 1; ROWGATE[dst] = GATE[i]; SLOT[i] = dst; }
    for (int i = gt; i < 32 * 256; i += NGT) { const int e = i >> 8, j = i & 255; const int c = (int)__hip_atomic_load(cnt + e, RLX_AGENT); const int pad = ((c + 255) & ~255) - c;
        if (j < pad) { ROWTOK[eb[e] + c + j] = 0; ROWGATE[eb[e] + c + j] = 0.f; } }
    __syncthreads();
}
struct MoeOrder {
    int G, c, ntiles; const LAS int* eb; const char* A; const char* W; size_t astep, wexp, wtile; bool gather;
    __device__ bool next(int i, pg8::Unit& u) const {
        const int L = i * G + c; if (L >= ntiles * 4) return false;
        u.pm = L >> 2; u.pn = L & 3; const int s0 = u.pm * 256; int e = 0;
#pragma unroll 1
        for (int j = 1; j < 32; ++j) if (eb[j] <= s0) e = j;
        e = __builtin_amdgcn_readfirstlane(e); u.aux = e; u.A = gather ? A : A + (size_t)u.pm * astep; u.B = W + (size_t)e * wexp + (size_t)u.pn * wtile; return true;
    }
};

constexpr int RTC = 32, RNCH = SEQ / RTC, RTOK = 352;
#define LBAR() do { asm volatile("s_waitcnt lgkmcnt(0)" ::: "memory"); __builtin_amdgcn_s_barrier(); asm volatile("" ::: "memory"); } while (0)
template <int CTRL> __device__ __forceinline__ float dpp_f(float v) { return __builtin_bit_cast(float, __builtin_amdgcn_update_dpp(0, __builtin_bit_cast(int, v), CTRL, 0xf, 0xf, true)); }
__device__ __forceinline__ float red16(float v) { v += dpp_f<0xB1>(v); v += dpp_f<0x4E>(v); v += dpp_f<0x141>(v); v += dpp_f<0x140>(v); return v; }
__device__ __forceinline__ float red8(float v) { v += dpp_f<0xB1>(v); v += dpp_f<0x4E>(v); v += dpp_f<0x141>(v); return v; }
__device__ __forceinline__ void unpack8(const v4u w, float (&f)[8]) { f[0] = bflo(w.x); f[1] = bfhi(w.x); f[2] = bflo(w.y); f[3] = bfhi(w.y); f[4] = bflo(w.z); f[5] = bfhi(w.z); f[6] = bflo(w.w); f[7] = bfhi(w.w); }
__device__ __forceinline__ void rwkv_scan_phase(Frame& F, const In& I, const bf16* R, const bf16* Kt, const bf16* V, const bf16* AA, const bf16* EW, bf16* Y) {
    LAS float* buf = (LAS float*)F.lds;
    LAS float* ybuf = (LAS float*)(F.lds + 2 * RTC * RTOK * 4) + 32;
    const int tid = TID_, lane = tid & 63;
    const int seg = lane & 15, rl = F.wave * 4 + (lane >> 4);
    const int stk = tid >> 4, ssg = tid & 15;
    for (int un = blockIdx.x; un < NB * 16 * 2; un += F.G) {
        const int half = un & 1, h = (un >> 1) & 15, b = un >> 5;
        const size_t rowb = (size_t)b * SEQ;
        const int col = h * 64 + ssg * 4;
        const f32x4 kkw = *(const f32x4*)(I.rwkv_kk + col), kaw = *(const f32x4*)(I.rwkv_ka + col);
        v2u rr, kr, vr, ar, er;
#define RAW_LOAD(cc) do { const size_t off = (rowb + (size_t)(cc) * RTC + stk) * 1024 + col; rr = *(const v2u*)(R + off); kr = *(const v2u*)(Kt + off); vr = *(const v2u*)(V + off); ar = *(const v2u*)(AA + off); er = *(const v2u*)(EW + off); } while (0)
#define RAW_CONVERT(cc) do { LAS float* tp = buf + ((cc) & 1) * (RTC * RTOK) + stk * RTOK + ssg * 4; \
            const float r0 = bflo(rr.x), r1 = bfhi(rr.x), r2 = bflo(rr.y), r3 = bfhi(rr.y), k0 = bflo(kr.x), k1 = bfhi(kr.x), k2 = bflo(kr.y), k3 = bfhi(kr.y); \
            const float a0 = bflo(ar.x), a1 = bfhi(ar.x), a2 = bflo(ar.y), a3 = bfhi(ar.y); \
            const float x0 = k0 * kkw.x, x1 = k1 * kkw.y, x2 = k2 * kkw.z, x3 = k3 * kkw.w; \
            const float ss = red16((x0 * x0 + x1 * x1) + (x2 * x2 + x3 * x3)); const float inv = __builtin_amdgcn_rsqf(fmaxf(ss, 1e-24f)); \
            *(LAS f32x4*)(tp) = (f32x4){__expf(-bflo(er.x)), __expf(-bfhi(er.x)), __expf(-bflo(er.y)), __expf(-bfhi(er.y))}; \
            const f32x4 kkv = (f32x4){x0 * inv, x1 * inv, x2 * inv, x3 * inv}; *(LAS f32x4*)(tp + 64) = kkv; \
            *(LAS f32x4*)(tp + 128) = (f32x4){kkv.x * a0, kkv.y * a1, kkv.z * a2, kkv.w * a3}; \
            *(LAS f32x4*)(tp + 192) = (f32x4){k0 * (1.0f + (a0 - 1.0f) * kaw.x), k1 * (1.0f + (a1 - 1.0f) * kaw.y), k2 * (1.0f + (a2 - 1.0f) * kaw.z), k3 * (1.0f + (a3 - 1.0f) * kaw.w)}; \
            *(LAS f32x4*)(tp + 256) = (f32x4){r0, r1, r2, r3}; \
            if ((ssg >> 3) == half) *(LAS f32x4*)(buf + ((cc) & 1) * (RTC * RTOK) + stk * RTOK + 320 + (ssg & 7) * 4) = (f32x4){bflo(vr.x), bfhi(vr.x), bflo(vr.y), bfhi(vr.y)}; } while (0)
#define Y_WRITE(cc) do { const LAS f32x2* yp = (const LAS f32x2*)(ybuf + ((cc) & 1) * (RTC * 32 + 32) + stk * 32 + ssg * 2); const f32x2 yv = *yp; \
            *(unsigned*)(Y + (rowb + (size_t)(cc) * RTC + stk) * 1024 + h * 64 + half * 32 + ssg * 2) = pk2(yv.x, yv.y); } while (0)
        RAW_LOAD(0); RAW_CONVERT(0); RAW_LOAD(1);
        f32x2 S0 = (f32x2){0.f, 0.f}, S1 = (f32x2){0.f, 0.f};
        LBAR();
        for (int c = 0; c < RNCH; ++c) {
            if (c + 1 < RNCH) { RAW_CONVERT(c + 1); }
            if (c + 2 < RNCH) { RAW_LOAD(c + 2); }
            if (c >= 1) { Y_WRITE(c - 1); }
            const LAS float* cb = buf + (c & 1) * (RTC * RTOK); LAS float* yb = ybuf + (c & 1) * (RTC * 32 + 32);
            const LAS float* tp0 = cb + seg * 4; const LAS float* vp0 = cb + 320 + rl;
#define SV_DECL(X) f32x4 X##w, X##q, X##b, X##k, X##r; float X##v
#define SV_LOAD(X, tk) do { const LAS float* tp = tp0 + (tk) * RTOK; \
                X##w = *(const LAS f32x4*)(tp); X##q = *(const LAS f32x4*)(tp + 64); X##b = *(const LAS f32x4*)(tp + 128); X##k = *(const LAS f32x4*)(tp + 192); X##r = *(const LAS f32x4*)(tp + 256); X##v = vp0[(tk) * RTOK]; } while (0)
#define SV_STEP(X, tk) do { \
                const f32x2 d = S0 * (f32x2){X##q.x, X##q.y} + S1 * (f32x2){X##q.z, X##q.w}; \
                const f32x2 t0 = S0 * (f32x2){X##w.x, X##w.y} + (f32x2){X##k.x, X##k.y} * X##v, t1 = S1 * (f32x2){X##w.z, X##w.w} + (f32x2){X##k.z, X##k.w} * X##v; \
                float ra = d.x + d.y, rb = epend;                   \
                ra += dpp_f<0xB1>(ra); rb += dpp_f<0xB1>(rb); ra += dpp_f<0x4E>(ra); rb += dpp_f<0x4E>(rb); ra += dpp_f<0x141>(ra); rb += dpp_f<0x141>(rb); ra += dpp_f<0x140>(ra); rb += dpp_f<0x140>(rb); \
                if (seg == 0) yb[((tk) - 1) * 32 + rl] = rb;        \
                const float sa = -ra; \
                S0 = t0 + (f32x2){X##b.x, X##b.y} * sa; S1 = t1 + (f32x2){X##b.z, X##b.w} * sa; \
                const f32x2 e = S0 * (f32x2){X##r.x, X##r.y} + S1 * (f32x2){X##r.z, X##r.w}; epend = e.x + e.y; } while (0)
            SV_DECL(A_); SV_DECL(B_); float epend = 0.f;
            SV_LOAD(A_, 0);
#pragma unroll 1
            for (int tk = 0; tk < RTC; tk += 2) {
                SV_LOAD(B_, tk + 1);
                SV_STEP(A_, tk);
                { const int t2 = (tk + 2 < RTC) ? tk + 2 : RTC - 1; SV_LOAD(A_, t2); }
                SV_STEP(B_, tk + 1);
            }
#undef SV_DECL
#undef SV_LOAD
#undef SV_STEP
            { const float rb = red16(epend); if (seg == 0) yb[(RTC - 1) * 32 + rl] = rb; }
            LBAR();
        }
        Y_WRITE(RNCH - 1);
        LBAR();
#undef RAW_LOAD
#undef RAW_CONVERT
#undef Y_WRITE
    }
}
constexpr int GS_QT = 0, GS_RT = 2048, GS_BHT = 4096, GS_KHT = 6144, GS_VT = 8192, GS_TM = 10240, GS_TL = 10752, GS_MK = 11264, GS_NK = 11776, GS_NB = 12288, GS_DD = 12800, GS_SLOT = 13056;
constexpr int GS_KT = GS_KHT, GS_BT = GS_BHT, GS_MB = GS_TM;
#ifndef SCAN_NP
#define SCAN_NP 5
#endif
constexpr int CH_NP = SCAN_NP, CH_NS = 8 - CH_NP, CH_ROUNDS = (512 + CH_NP - 1) / CH_NP;
constexpr int CH_KTAB = 2 * CH_NP * GS_SLOT;
static_assert(CH_KTAB + 512 <= 131072, "chunked-scan LDS map");
template <int N> __device__ __forceinline__ float dpp_shr(float v) { return __builtin_bit_cast(float, __builtin_amdgcn_update_dpp(0, __builtin_bit_cast(int, v), 0x110 + N, 0xf, 0xf, true)); }
__device__ __forceinline__ bf16x8 mk8(v2u a, v2u b) { return __builtin_bit_cast(bf16x8, (v4u){a.x, a.y, b.x, b.y}); }
__device__ __forceinline__ bf16x8 mk8z(v2u a) { return __builtin_bit_cast(bf16x8, (v4u){a.x, a.y, 0u, 0u}); }
__device__ __forceinline__ bf16x8 cvt8z(f32x4 v) { return __builtin_bit_cast(bf16x8, (v4u){pk2(v.x, v.y), pk2(v.z, v.w), 0u, 0u}); }
__device__ __forceinline__ int tokoff(const int t, const int c) { return t * 128 + ((c ^ ((t >> 1) & 7)) << 4); }
__device__ __forceinline__ int tokoff2(const int t, const int c) { return t * 128 + ((c ^ (((t >> 1) & 3) << 1)) << 4); }
__device__ __forceinline__ v2u trld(const LAS unsigned char* p) { return __builtin_bit_cast(v2u, __builtin_amdgcn_ds_read_tr16_b64_v4i16((LAS attn_body::v4i16_t*)p)); }
struct ChOps { v2u q[2][2], r[2][2], mk, nk, nb, tp, kh[4], bh[4]; f32x4 dv[4]; };
__device__ __forceinline__ void chain_load(ChOps& O, const LAS unsigned char* C, const int fr, const int fq) {
#pragma unroll
    for (int kh = 0; kh < 2; ++kh) { const int o0 = tokoff(fr, 4 * kh + (fq >> 1)) + 8 * (fq & 1), o1 = tokoff(fr, 4 * kh + 2 + (fq >> 1)) + 8 * (fq & 1);
        O.q[kh][0] = *(const LAS v2u*)(C + GS_QT + o0); O.q[kh][1] = *(const LAS v2u*)(C + GS_QT + o1); O.r[kh][0] = *(const LAS v2u*)(C + GS_RT + o0); O.r[kh][1] = *(const LAS v2u*)(C + GS_RT + o1); }
    const int om = (fr * 16 + 4 * fq) * 2;
    O.mk = *(const LAS v2u*)(C + GS_MK + om); O.nk = *(const LAS v2u*)(C + GS_NK + om); O.nb = *(const LAS v2u*)(C + GS_NB + om); O.tp = *(const LAS v2u*)(C + GS_TM + om);
#pragma unroll
    for (int jt = 0; jt < 4; ++jt) { const int ok = tokoff2(4 * fq + (fr >> 2), 2 * jt + ((fr >> 1) & 1)) + 8 * (fr & 1); O.kh[jt] = trld(C + GS_KHT + ok); O.bh[jt] = trld(C + GS_BHT + ok); O.dv[jt] = *(const LAS f32x4*)(C + GS_DD + (16 * jt + 4 * fq) * 4); }
}
__device__ __forceinline__ void chain_step(const ChOps& O, const v2u vqw, f32x4 (&Areg)[4], const int vt, const int fr, const int fq, GAS bf16* yrow) {
    const f32x4 zero4 = (f32x4){0.f, 0.f, 0.f, 0.f};
    bf16x8 Aq[2];
#pragma unroll
    for (int kh = 0; kh < 2; ++kh) Aq[kh] = __builtin_bit_cast(bf16x8, (v4u){pk2(Areg[2 * kh].x, Areg[2 * kh].y), pk2(Areg[2 * kh].z, Areg[2 * kh].w), pk2(Areg[2 * kh + 1].x, Areg[2 * kh + 1].y), pk2(Areg[2 * kh + 1].z, Areg[2 * kh + 1].w)});
    f32x4 X = zero4, YA = zero4;
#pragma unroll
    for (int kh = 0; kh < 2; ++kh) { X = __builtin_amdgcn_mfma_f32_16x16x32_bf16(mk8(O.q[kh][0], O.q[kh][1]), Aq[kh], X, 0, 0, 0); YA = __builtin_amdgcn_mfma_f32_16x16x32_bf16(mk8(O.r[kh][0], O.r[kh][1]), Aq[kh], YA, 0, 0, 0); }
    const bf16x8 Vq = mk8z(vqw);
    const f32x4 Z = __builtin_amdgcn_mfma_f32_16x16x32_bf16(mk8z(O.mk), Vq, X, 0, 0, 0);
    const f32x4 U = __builtin_amdgcn_mfma_f32_16x16x32_bf16(mk8z(O.tp), cvt8z(Z), zero4, 0, 0, 0);
    const bf16x8 Uq = cvt8z(U);
    f32x4 Yv = __builtin_amdgcn_mfma_f32_16x16x32_bf16(mk8z(O.nk), Vq, YA, 0, 0, 0);
    const f32x4 Yn = __builtin_amdgcn_mfma_f32_16x16x32_bf16(mk8z(O.nb), Uq, zero4, 0, 0, 0);
    Yv = Yv - Yn;
#pragma unroll
    for (int e = 0; e < 4; e += 2) { const unsigned yw = pk2(Yv[e], Yv[e + 1]); GAS bf16* yp = yrow + (size_t)(4 * fq + e) * 1024 + 16 * vt + fr; yp[0] = (bf16)(yw & 0xffffu); yp[1024] = (bf16)(yw >> 16); }
#pragma unroll
    for (int jt = 0; jt < 4; ++jt) { f32x4 acc = O.dv[jt] * Areg[jt];
        acc = __builtin_amdgcn_mfma_f32_16x16x32_bf16(mk8z(O.kh[jt]), Vq, acc, 0, 0, 0);
        const f32x4 nbu = __builtin_amdgcn_mfma_f32_16x16x32_bf16(mk8z(O.bh[jt]), Uq, zero4, 0, 0, 0);
        Areg[jt] = acc - nbu; }
}
#ifndef SCAN_WMAP
#define SCAN_WMAP 0x76543210u
#endif
__device__ __forceinline__ void rwkv_scan_chunked(Frame& F, const In& I, const bf16* R, const bf16* Kt, const bf16* V, const bf16* AA, const bf16* EW, bf16* Y) {
    const int lane = LANE_, fr = lane & 15, fq = lane >> 4;
    const int lw = (int)((SCAN_WMAP >> (4 * F.wave)) & 7u);
    LAS unsigned char* L = F.lds;
    const f32x4 zero4 = (f32x4){0.f, 0.f, 0.f, 0.f};
    for (int un = blockIdx.x; un < NB * 16; un += F.G) {
        const int h = un & 15, b = un >> 4; const size_t rowb = (size_t)b * SEQ;
        if (lw == 0) { ((LAS float*)(L + CH_KTAB))[lane] = ((const GAS float*)I.rwkv_kk)[h * 64 + lane]; ((LAS float*)(L + CH_KTAB + 256))[lane] = ((const GAS float*)I.rwkv_ka)[h * 64 + lane]; }
        LBAR();
        if (lw >= CH_NS) {
            const int p = lw - CH_NS; const int colb = h * 64 + 16 * fq;
            v4u raw[10];
#define CK_LOAD(cidx) do { const size_t off = (rowb + (size_t)(cidx) * 16 + fr) * 1024 + colb; \
                raw[0] = *(const GAS v4u*)(R + off); raw[1] = *(const GAS v4u*)(R + off + 8); raw[2] = *(const GAS v4u*)(Kt + off); raw[3] = *(const GAS v4u*)(Kt + off + 8); raw[4] = *(const GAS v4u*)(V + off); raw[5] = *(const GAS v4u*)(V + off + 8); \
                raw[6] = *(const GAS v4u*)(AA + off); raw[7] = *(const GAS v4u*)(AA + off + 8); raw[8] = *(const GAS v4u*)(EW + off); raw[9] = *(const GAS v4u*)(EW + off + 8); } while (0)
#ifdef SCAN_STAMP
            unsigned long long st_[7] = {0, 0, 0, 0, 0, 0, 0};
#define STAMP(i) do { if (blockIdx.x == 0 && p == 0 && rd == 20) st_[i] = __builtin_amdgcn_s_memtime(); } while (0)
#else
#define STAMP(i) do { } while (0)
#endif
            CK_LOAD(p);
            for (int rd = -1; rd < CH_ROUNDS - 1; ++rd) {
                const int cidx = CH_NP * (rd + 1) + p; LAS unsigned char* S = L + (((rd + 1) & 1) * CH_NP + p) * GS_SLOT;
                if (cidx < 512) {
                STAMP(0);
                float r[16], k[16], a[16], ew[16]; const v4u vraw0 = raw[4], vraw1 = raw[5];
                { float t8[8];
                  unpack8(raw[0], t8);
#pragma unroll
                  for (int e = 0; e < 8; ++e) r[e] = t8[e];
                  unpack8(raw[1], t8);
#pragma unroll
                  for (int e = 0; e < 8; ++e) r[8 + e] = t8[e];
                  unpack8(raw[2], t8);
#pragma unroll
                  for (int e = 0; e < 8; ++e) k[e] = t8[e];
                  unpack8(raw[3], t8);
#pragma unroll
                  for (int e = 0; e < 8; ++e) k[8 + e] = t8[e];
                  unpack8(raw[6], t8);
#pragma unroll
                  for (int e = 0; e < 8; ++e) a[e] = t8[e];
                  unpack8(raw[7], t8);
#pragma unroll
                  for (int e = 0; e < 8; ++e) a[8 + e] = t8[e];
                  unpack8(raw[8], t8);
#pragma unroll
                  for (int e = 0; e < 8; ++e) ew[e] = t8[e];
                  unpack8(raw[9], t8);
#pragma unroll
                  for (int e = 0; e < 8; ++e) ew[8 + e] = t8[e]; }
                if (cidx + CH_NP < 512) CK_LOAD(cidx + CH_NP);
                float kx[16], ss = 0.f;
#pragma unroll
                for (int e4 = 0; e4 < 4; ++e4) { const f32x4 c0_ = *(const LAS f32x4*)(L + CH_KTAB + (16 * fq + 4 * e4) * 4), c1_ = *(const LAS f32x4*)(L + CH_KTAB + 256 + (16 * fq + 4 * e4) * 4);
#pragma unroll
                    for (int z = 0; z < 4; ++z) { const int ee = 4 * e4 + z; kx[ee] = k[ee] * c0_[z]; ss += kx[ee] * kx[ee]; k[ee] = k[ee] * (1.0f + (a[ee] - 1.0f) * c1_[z]); } }
                ss += __shfl_xor(ss, 16); ss += __shfl_xor(ss, 32);
                const float inv = __builtin_amdgcn_rsqf(fmaxf(ss, 1e-24f));
                unsigned qtw[8], rtw[8], ktw[8], btw[8], bhw[8], khw[8];
                {
                    float li[16], e15[16], ep[16];
#pragma unroll
                    for (int e = 0; e < 16; ++e) li[e] = -ew[e];
#pragma unroll
                    for (int e = 0; e < 16; ++e) li[e] += dpp_shr<1>(li[e]);
#pragma unroll
                    for (int e = 0; e < 16; ++e) li[e] += dpp_shr<2>(li[e]);
#pragma unroll
                    for (int e = 0; e < 16; ++e) li[e] += dpp_shr<4>(li[e]);
#pragma unroll
                    for (int e = 0; e < 16; ++e) li[e] += dpp_shr<8>(li[e]);
#pragma unroll
                    for (int e = 0; e < 16; ++e) li[e] = __builtin_amdgcn_exp2f(1.4426950408889634f * li[e]);
#pragma unroll
                    for (int e = 0; e < 16; ++e) e15[e] = __shfl(li[e], (lane & 48) | 15);
#pragma unroll
                    for (int e = 0; e < 16; ++e) ep[e] = __builtin_bit_cast(float, __builtin_amdgcn_update_dpp(0x3f800000, __builtin_bit_cast(int, li[e]), 0x111, 0xf, 0xf, false));
                    if (fr == 15) {
#pragma unroll
                        for (int e4 = 0; e4 < 4; ++e4) *(LAS f32x4*)(S + GS_DD + (16 * fq + 4 * e4) * 4) = (f32x4){li[4 * e4], li[4 * e4 + 1], li[4 * e4 + 2], li[4 * e4 + 3]}; }
#pragma unroll
                    for (int e = 0; e < 16; e += 2) { float q2[2], r2[2], k2[2], b2[2], b2h[2], k2h[2];
#pragma unroll
                        for (int z = 0; z < 2; ++z) { const int ee = e + z;
                            const float Einv = __builtin_amdgcn_rcpf(li[ee]);
                            const float kk = kx[ee] * inv, bb = a[ee] * kk;
                            q2[z] = kk * ep[ee]; k2[z] = k[ee] * Einv; b2[z] = bb * Einv; r2[z] = r[ee] * li[ee];
                            b2h[z] = b2[z] * e15[ee]; k2h[z] = k2[z] * e15[ee]; }
                        qtw[e >> 1] = pk2(q2[0], q2[1]); rtw[e >> 1] = pk2(r2[0], r2[1]); ktw[e >> 1] = pk2(k2[0], k2[1]); btw[e >> 1] = pk2(b2[0], b2[1]); bhw[e >> 1] = pk2(b2h[0], b2h[1]); khw[e >> 1] = pk2(k2h[0], k2h[1]);
 } }
                { const int ov = tokoff2(fr, 2 * fq); *(LAS v4u*)(S + GS_VT + ov) = vraw0; *(LAS v4u*)(S + GS_VT + ov + 16) = vraw1; }
                { const int o = tokoff(fr, 2 * fq), o2 = o ^ 16;
                  *(LAS v4u*)(S + GS_QT + o) = (v4u){qtw[0], qtw[1], qtw[2], qtw[3]}; *(LAS v4u*)(S + GS_QT + o2) = (v4u){qtw[4], qtw[5], qtw[6], qtw[7]};
                  *(LAS v4u*)(S + GS_RT + o) = (v4u){rtw[0], rtw[1], rtw[2], rtw[3]}; *(LAS v4u*)(S + GS_RT + o2) = (v4u){rtw[4], rtw[5], rtw[6], rtw[7]};
                  *(LAS v4u*)(S + GS_KT + o) = (v4u){ktw[0], ktw[1], ktw[2], ktw[3]}; *(LAS v4u*)(S + GS_KT + o2) = (v4u){ktw[4], ktw[5], ktw[6], ktw[7]};
                  *(LAS v4u*)(S + GS_BT + o) = (v4u){btw[0], btw[1], btw[2], btw[3]}; *(LAS v4u*)(S + GS_BT + o2) = (v4u){btw[4], btw[5], btw[6], btw[7]}; }
                asm volatile("s_waitcnt lgkmcnt(0)" ::: "memory");
                STAMP(1);
                f32x4 mb = zero4, mbt = zero4, mkt = zero4, nbt = zero4, nkt = zero4;
#pragma unroll
                for (int kh = 0; kh < 2; ++kh) { const int o = tokoff(fr, 4 * kh + fq);
                    const bf16x8 Qf = *(const LAS bf16x8*)(S + GS_QT + o), Rf = *(const LAS bf16x8*)(S + GS_RT + o), Kf = *(const LAS bf16x8*)(S + GS_KT + o), Bf = *(const LAS bf16x8*)(S + GS_BT + o);
                    mb = __builtin_amdgcn_mfma_f32_16x16x32_bf16(Qf, Bf, mb, 0, 0, 0); mbt = __builtin_amdgcn_mfma_f32_16x16x32_bf16(Bf, Qf, mbt, 0, 0, 0);
                    mkt = __builtin_amdgcn_mfma_f32_16x16x32_bf16(Kf, Qf, mkt, 0, 0, 0);
                    nbt = __builtin_amdgcn_mfma_f32_16x16x32_bf16(Bf, Rf, nbt, 0, 0, 0); nkt = __builtin_amdgcn_mfma_f32_16x16x32_bf16(Kf, Rf, nkt, 0, 0, 0); }
                asm volatile("s_waitcnt lgkmcnt(0)" ::: "memory");
                STAMP(2);
                { const int oh = tokoff2(fr, 2 * fq);
                  *(LAS v4u*)(S + GS_BHT + oh) = (v4u){bhw[0], bhw[1], bhw[2], bhw[3]}; *(LAS v4u*)(S + GS_BHT + oh + 16) = (v4u){bhw[4], bhw[5], bhw[6], bhw[7]};
                  *(LAS v4u*)(S + GS_KHT + oh) = (v4u){khw[0], khw[1], khw[2], khw[3]}; *(LAS v4u*)(S + GS_KHT + oh + 16) = (v4u){khw[4], khw[5], khw[6], khw[7]}; }
                { f32x4 nAf, nDf, iD, mkm, nkm, nbm;
#pragma unroll
                  for (int e = 0; e < 4; ++e) { const int tt = 4 * fq + e; const bool lo = fr < tt, up = tt < fr, ue = tt <= fr;
                      nAf[e] = lo ? -mb[e] : 0.f; nDf[e] = up ? -mbt[e] : 0.f; iD[e] = (tt == fr) ? 1.0f : 0.0f;
                      mkm[e] = up ? mkt[e] : 0.f; nkm[e] = ue ? nkt[e] : 0.f; nbm[e] = ue ? nbt[e] : 0.f; }
                  const int om = (fr * 16 + 4 * fq) * 2;
                  *(LAS v2u*)(S + GS_MK + om) = (v2u){pk2(mkm[0], mkm[1]), pk2(mkm[2], mkm[3])}; *(LAS v2u*)(S + GS_NK + om) = (v2u){pk2(nkm[0], nkm[1]), pk2(nkm[2], nkm[3])};
                  *(LAS v2u*)(S + GS_NB + om) = (v2u){pk2(nbm[0], nbm[1]), pk2(nbm[2], nbm[3])};
                  STAMP(3);
                  const bf16x8 nA = cvt8z(nAf), nD = cvt8z(nDf);
                  const f32x4 n2D = __builtin_amdgcn_mfma_f32_16x16x32_bf16(nA, nD, zero4, 0, 0, 0), n2A = __builtin_amdgcn_mfma_f32_16x16x32_bf16(nD, nA, zero4, 0, 0, 0);
                  const bf16x8 n2Db = cvt8z(n2D), n2Ab = cvt8z(n2A);
                  const f32x4 n4D = __builtin_amdgcn_mfma_f32_16x16x32_bf16(n2Ab, n2Db, zero4, 0, 0, 0), n4A = __builtin_amdgcn_mfma_f32_16x16x32_bf16(n2Db, n2Ab, zero4, 0, 0, 0);
                  f32x4 Tt = __builtin_amdgcn_mfma_f32_16x16x32_bf16(nA, n2Db, iD + nDf + n2D, 0, 0, 0);
                  const bf16x8 n4Db = cvt8z(n4D), n4Ab = cvt8z(n4A);
                  const f32x4 n8A = __builtin_amdgcn_mfma_f32_16x16x32_bf16(n4Db, n4Ab, zero4, 0, 0, 0);
                  Tt = __builtin_amdgcn_mfma_f32_16x16x32_bf16(n4Ab, cvt8z(Tt), Tt, 0, 0, 0);
                  Tt = __builtin_amdgcn_mfma_f32_16x16x32_bf16(cvt8z(n8A), cvt8z(Tt), Tt, 0, 0, 0);
                  STAMP(4);
                  *(LAS v2u*)(S + GS_TM + om) = (v2u){pk2(Tt[0], Tt[1]), pk2(Tt[2], Tt[3])}; }
                STAMP(5);
                }
                LBAR();
                STAMP(6);
            }
            LBAR();
#ifdef SCAN_STAMP
            if (blockIdx.x == 0 && p == 0) { const unsigned long long d_ = (SCAN_STAMP == 0) ? st_[6] - st_[0] : st_[SCAN_STAMP] - st_[SCAN_STAMP - 1]; const unsigned long long t0_ = __builtin_amdgcn_s_memtime();
                while (__builtin_amdgcn_s_memtime() - t0_ < d_ * 512ull) __builtin_amdgcn_s_sleep(8); }
#endif
#undef CK_LOAD
        } else {
            const int vtA = (CH_NS == 4) ? lw : ((lw == 0) ? 0 : lw + 1);
            f32x4 A0[4], A1[4];
#pragma unroll
            for (int jt = 0; jt < 4; ++jt) { A0[jt] = zero4; A1[jt] = zero4; }
            LBAR();
            for (int rd = 0; rd < CH_ROUNDS; ++rd) {
#pragma unroll 1
                for (int q = 0; q < CH_NP; ++q) {
                    const int cidx = CH_NP * rd + q;
                    if (cidx < 512) {
                        const LAS unsigned char* C = L + ((rd & 1) * CH_NP + q) * GS_SLOT; GAS bf16* yrow = (GAS bf16*)Y + (rowb + (size_t)cidx * 16) * 1024 + h * 64;
                        ChOps cur; chain_load(cur, C, fr, fq);
                        const v2u va = trld(C + GS_VT + tokoff2(4 * fq + (fr >> 2), 2 * vtA + ((fr >> 1) & 1)) + 8 * (fr & 1));
                        chain_step(cur, va, A0, vtA, fr, fq, yrow);
                        if (CH_NS == 3 && lw == 0) { const v2u vb = trld(C + GS_VT + tokoff2(4 * fq + (fr >> 2), 2 + ((fr >> 1) & 1)) + 8 * (fr & 1)); chain_step(cur, vb, A1, 1, fr, fq, yrow); }
                    }
                }
                LBAR();
            }
        }
    }
}
__device__ __forceinline__ void rwkv_post_pass(Frame& F, const In& I, const bf16* R, const bf16* Kt, const bf16* V, const bf16* AA, const bf16* G, bf16* Y) {
    const int gw = F.vcu * NWAVES + F.wave, NGW = F.G * NWAVES; const int col = LANE_ * 16;
    for (int t0 = 2 * gw; t0 < T; t0 += 2 * NGW) {
        v4u py[2][2], pr[2][2], pk[2][2], pv[2][2], pa[2][2], pg[2][2];
#pragma unroll
        for (int rw = 0; rw < 2; ++rw) { const size_t off = (size_t)(t0 + rw) * 1024 + col;
#pragma unroll
            for (int hf = 0; hf < 2; ++hf) { py[rw][hf] = *(const v4u*)(Y + off + hf * 8); pr[rw][hf] = *(const v4u*)(R + off + hf * 8); pk[rw][hf] = *(const v4u*)(Kt + off + hf * 8);
                pv[rw][hf] = *(const v4u*)(V + off + hf * 8); pa[rw][hf] = *(const v4u*)(AA + off + hf * 8); pg[rw][hf] = *(const v4u*)(G + off + hf * 8); } }
#pragma unroll
        for (int rw = 0; rw < 2; ++rw) { const size_t off = (size_t)(t0 + rw) * 1024 + col;
            float kaw[16], rkw[16], lng[16], lnb[16];
#pragma unroll
            for (int e4 = 0; e4 < 4; ++e4) { const f32x4 c0 = *(const GAS f32x4*)(I.rwkv_ka + col + 4 * e4), c1 = *(const GAS f32x4*)(I.rwkv_rk + col + 4 * e4), c2 = *(const GAS f32x4*)(I.rwkv_ln_g + col + 4 * e4), c3 = *(const GAS f32x4*)(I.rwkv_ln_b + col + 4 * e4);
#pragma unroll
                for (int e = 0; e < 4; ++e) { kaw[4 * e4 + e] = c0[e]; rkw[4 * e4 + e] = c1[e]; lng[4 * e4 + e] = c2[e]; lnb[4 * e4 + e] = c3[e]; } }
            float y[16], r[16], k[16], v[16], a[16], g[16];
#pragma unroll
            for (int hf = 0; hf < 2; ++hf) { float t8[8];
                unpack8(py[rw][hf], t8);
#pragma unroll
                for (int e = 0; e < 8; ++e) y[hf * 8 + e] = t8[e];
                unpack8(pr[rw][hf], t8);
#pragma unroll
                for (int e = 0; e < 8; ++e) r[hf * 8 + e] = t8[e];
                unpack8(pk[rw][hf], t8);
#pragma unroll
                for (int e = 0; e < 8; ++e) k[hf * 8 + e] = t8[e];
                unpack8(pv[rw][hf], t8);
#pragma unroll
                for (int e = 0; e < 8; ++e) v[hf * 8 + e] = t8[e];
                unpack8(pa[rw][hf], t8);
#pragma unroll
                for (int e = 0; e < 8; ++e) a[hf * 8 + e] = t8[e];
                unpack8(pg[rw][hf], t8);
#pragma unroll
                for (int e = 0; e < 8; ++e) g[hf * 8 + e] = t8[e]; }
            float s = 0.f, bs = 0.f;
#pragma unroll
            for (int e = 0; e < 16; ++e) { s += y[e]; const float kp = k[e] * (1.0f + (a[e] - 1.0f) * kaw[e]); bs += r[e] * kp * rkw[e]; }
            s += __shfl_xor(s, 1); s += __shfl_xor(s, 2); bs += __shfl_xor(bs, 1); bs += __shfl_xor(bs, 2);
            const float mean = s * (1.0f / 64.0f); float q = 0.f;
#pragma unroll
            for (int e = 0; e < 16; ++e) { const float dd = y[e] - mean; q += dd * dd; }
            q += __shfl_xor(q, 1); q += __shfl_xor(q, 2);
            const float rstd = 1.0f / sqrtf(q * (1.0f / 64.0f) + 64e-5f);
            float o[16];
#pragma unroll
            for (int e = 0; e < 16; ++e) o[e] = ((y[e] - mean) * rstd * lng[e] + lnb[e] + bs * v[e]) * g[e];
            v4u w0, w1; w0.x = pk2(o[0], o[1]); w0.y = pk2(o[2], o[3]); w0.z = pk2(o[4], o[5]); w0.w = pk2(o[6], o[7]); w1.x = pk2(o[8], o[9]); w1.y = pk2(o[10], o[11]); w1.z = pk2(o[12], o[13]); w1.w = pk2(o[14], o[15]);
            *(v4u*)(Y + off) = w0; *(v4u*)(Y + off + 8) = w1; }
    }
}

#ifndef DUP_K
#define DUP_K (-1)
#endif
#ifndef DUP_K2
#define DUP_K2 (-1)
#endif
#define KARGS ((const __attribute__((address_space(4))) Args*)__builtin_amdgcn_kernarg_segment_ptr())
#define WSPTRS \
    bf16* H0 = (bf16*)(ws + WS_H0); bf16* QKV = (bf16*)(ws + WS_QKV); bf16* OB = (bf16*)(ws + WS_O); f32x2* AGG = (f32x2*)(ws + WS_LRUAGG); \
    bf16* H2 = (bf16*)(ws + WS_H2); float* LOG = (float*)(ws + WS_LOG); unsigned char* RTE = ws + WS_ROUTE; bf16* HID = (bf16*)(ws + WS_HID); bf16* YS = (bf16*)(ws + WS_YS); bf16* PP = (bf16*)(ws + WS_PP); \
    bf16* HCAT = (bf16*)(ws + WS_HCAT); bf16* RB = (bf16*)(ws + WS_R); bf16* KB = (bf16*)(ws + WS_K); bf16* VB = (bf16*)(ws + WS_V); bf16* XRB = (bf16*)(ws + WS_XR); bf16* XKB = (bf16*)(ws + WS_XK); bf16* XVB = (bf16*)(ws + WS_XV); bf16* MID = (bf16*)(ws + WS_MID); bf16* EWB = (bf16*)(ws + WS_EW); bf16* AAB = (bf16*)(ws + WS_AA); bf16* YB = (bf16*)(ws + WS_Y); \
    const size_t TD = (size_t)T * 1024; (void)H0; (void)QKV; (void)OB; (void)AGG; (void)H2; (void)LOG; (void)RTE; (void)HID; (void)YS; (void)PP; (void)HCAT; (void)RB; (void)KB; (void)VB; (void)XRB; (void)XKB; (void)XVB; (void)MID; (void)EWB; (void)AAB; (void)YB; (void)TD;

struct Args { In in; float* out; unsigned char* ws; int ph_lo, ph_hi; };
constexpr int N_PHASES = 34;
__device__ __forceinline__ int nrep(int k) { int n = (k == DUP_K) ? 2 : 1; if (DUP_K >= 0) asm volatile("" : "+s"(n)); return n; }
#define REP_SYNC if (rep_) __syncthreads();
typedef const __attribute__((address_space(4))) unsigned long long* kp64;
__device__ __forceinline__ void load_in(In& I) { kp64 s = (kp64)__builtin_amdgcn_kernarg_segment_ptr(); unsigned long long* d = (unsigned long long*)&I;
#pragma unroll
    for (int i = 0; i < 47; ++i) d[i] = s[i]; }

__device__ __forceinline__ int t5_bucket(int n) { if (n < 16) return n; const float v = logf((float)n / 16.0f) / 2.0794415416798357f * 16.0f; const int l = 16 + (int)v; return l < 31 ? l : 31; }

template <class Epi>
__device__ __forceinline__ void dense_gemm(Frame& F, const void* A, int lda, const void* B, int K, int M, int N, const Epi& E) {
    pg8::DenseOrder S; S.init(A, lda, B, K, M, N, F.G, (int)blockIdx.x);
    pg8::gemm_phase<Epi, pg8::DenseOrder, true, false>(F.lds, K, lda, S, E, nullptr, TID_);
}

__global__ void __launch_bounds__(NWAVES * 64, 2) mk_fwd(Args args) {
    extern __shared__ __attribute__((aligned(16))) unsigned char lds[];
    Frame F;
    F.lds = (LAS unsigned char*)lds;
    F.MISC = (volatile LAS unsigned*)(F.lds + MISC_OFF);
    { int w_ = __builtin_amdgcn_readfirstlane((int)threadIdx.x >> 6); asm volatile("" : "+s"(w_)); F.wave = w_; }
    F.G = gridDim.x; { const int bx = blockIdx.x; F.vcu = (F.G % 8 == 0) ? (bx % 8) * (F.G / 8) + bx / 8 : bx; }
    F.ctl = (gu32*)(KARGS->ws + WS_CTL);
    for (int u = TID_; u < (LDS_BYTES - LDSCTL_OFF) / 4; u += NWAVES * 64) ((LAS unsigned*)(F.lds + LDSCTL_OFF))[u] = 0u;
    __syncthreads();
    {
        LAS float* tb = (LAS float*)(F.lds + TB_OFF); const int h = TID_ >> 7, i = TID_ & 127;
        const float* rb = KARGS->in.rel_bias;
        tb[h * 128 + i] = (rb[t5_bucket(i) * 4 + h] - rb[31 * 4 + h]) * 1.4426950408889634f;
    }
    __syncthreads();
    const int lo = KARGS->ph_lo, hi = KARGS->ph_hi;
    const bool multi = (hi - lo) > 1;
    XcdBarrier bar; bar.bar = (unsigned*)(F.ctl + CW_BAR); bar.x = 0; bar.st = nullptr;
    if (multi) bar = xcd_barrier_post((unsigned*)(F.ctl + CW_BAR), F.MISC + 8, TID_ == 0);
#define IN(k) (lo <= (k) && (k) < hi)
#define PH_BEGIN_ unsigned char* ws = KARGS->ws; bf16* X = (bf16*)KARGS->out; float* OUT = KARGS->out; (void)OUT; bf16* GB2 = (bf16*)KARGS->out + (size_t)T * 1024; (void)GB2; In I; load_in(I); (void)X; WSPTRS
#define SEAM(k) do { if (IN(k) && IN((k) + 1)) xcd_barrier(bar, TID_ == 0); } while (0)

    if (IN(0)) { PH_BEGIN_ prep_dense_weights(F, I, ws); prep_layer_weights(F, I, ws, 0); norm_pass<false>(F, I.x, I.norm_mix, H0);
#ifdef DUP_PREP
        __syncthreads(); prep_dense_weights(F, I, ws); prep_layer_weights(F, I, ws, 0);
#endif
    } SEAM(0);
    if (IN(1)) { PH_BEGIN_ pg8::EpiBf16 E{QKV, 512, 512, (size_t)T * 512, attn_body::C2}; dense_gemm(F, H0, 1024, ws + WS_WIN, 1024, T, AB_IN, E); } SEAM(1);
    if (IN(2)) { PH_BEGIN_ lru_agg_mfma(F, I, QKV + 3 * (size_t)T * 512, AGG, (bf16*)(ws + WS_HL), (bf16*)(ws + WS_CA)); } SEAM(2);
    if (IN(3)) { PH_BEGIN_
        const attn_body::AttnTensors AT{(const attn_body::bf16*)QKV, (const attn_body::bf16*)(QKV + (size_t)T * 512), (const attn_body::bf16*)(QKV + 2 * (size_t)T * 512), (attn_body::bf16*)OB};
        if (F.G == 256) attn_body::attn_phase<8>((char*)lds, AT, F.vcu, (const LAS float*)(F.lds + TB_OFF), (int)threadIdx.x);
#ifdef DUP_ATTN
        __syncthreads(); if (F.G == 256) attn_body::attn_phase<8>((char*)lds, AT, F.vcu, (const LAS float*)(F.lds + TB_OFF), (int)threadIdx.x);
#endif
        __syncthreads();
        lru_final_pass(F, (const bf16*)(ws + WS_HL), (const bf16*)(ws + WS_CA), QKV + 4 * (size_t)T * 512, AGG, H0);
    } SEAM(3);
    if (IN(4)) { PH_BEGIN_ diff_combine_pass(F, I, OB, H0); } SEAM(4);
    if (IN(5)) { PH_BEGIN_ pg8::EpiResX<false> E{I.x, X}; dense_gemm(F, H0, 1024, ws + WS_WOUT, 1024, T, 1024, E); } SEAM(5);

#define MOE_PLE_PHASES(P, L) \
    if (IN(P + 0)) { PH_BEGIN_ norm_pass<true>(F, X, I.norm_ffn + (L) * 1024, H2); } SEAM(P + 0); \
    if (IN(P + 1)) { PH_BEGIN_ pg8::EpiRouter E{LOG}; dense_gemm(F, H2, 1024, ws + WS_ROUT + (size_t)(L) * 256 * 1024 * 2, 1024, T, 256, E); } SEAM(P + 1); \
    if (IN(P + 2)) { PH_BEGIN_ route_pass_a(F, I, (L), LOG, RTE, F.ctl + ((L) ? CW_CNT1 : CW_CNT0)); } SEAM(P + 2); \
    if (IN(P + 3)) { PH_BEGIN_ route_pass_b(F, RTE, F.ctl + ((L) ? CW_CNT1 : CW_CNT0)); } SEAM(P + 3); \
    if (IN(P + 4)) { PH_BEGIN_ route_bases(F, F.ctl + ((L) ? CW_CNT1 : CW_CNT0)); const LAS int* eb = (const LAS int*)(F.lds + RTE_OFF + 512); \
        MoeOrder S{F.G, (int)blockIdx.x, __builtin_amdgcn_readfirstlane(eb[32] >> 8), eb, (const char*)H2, (const char*)(ws + WS_MGU), 0, (size_t)1024 * 1024 * 2, (size_t)256 * 1024 * 2, true}; pg8::EpiGU E{HID}; \
        pg8::gemm_phase<pg8::EpiGU, MoeOrder, true, true>(F.lds, 1024, 1024, S, E, (const int*)(RTE + RT_ROWTOK), TID_); } SEAM(P + 4); \
    if (IN(P + 5)) { PH_BEGIN_ route_bases(F, F.ctl + ((L) ? CW_CNT1 : CW_CNT0)); const LAS int* eb = (const LAS int*)(F.lds + RTE_OFF + 512); \
        MoeOrder S{F.G, (int)blockIdx.x, __builtin_amdgcn_readfirstlane(eb[32] >> 8), eb, (const char*)HID, (const char*)(ws + WS_MDN), (size_t)256 * 512 * 2, (size_t)1024 * 512 * 2, (size_t)256 * 512 * 2, false}; pg8::EpiDown E{YS, (const float*)(RTE + RT_ROWGATE)}; \
        pg8::gemm_phase<pg8::EpiDown, MoeOrder, true, false>(F.lds, 512, 512, S, E, nullptr, TID_); } SEAM(P + 5); \
    if (IN(P + 6)) { PH_BEGIN_ combine_norm_pass(F, X, X, YS, (const int*)(RTE + RT_SLOT), I.ple_norm + (L) * 1024, H2); } SEAM(P + 6); \
    if (IN(P + 7)) { PH_BEGIN_ pg8::EpiBf16 E{PP, 1024, 0, 0, 1.f}; dense_gemm(F, ws + WS_PB, 256, ws + WS_PPROJ + (size_t)(L) * 1024 * 256 * 2, 256, T, 1024, E); } SEAM(P + 7); \
    if (IN(P + 8)) { PH_BEGIN_ pg8::EpiPle E{X, (L) ? (bf16*)(ws + WS_YS) : X, PP}; dense_gemm(F, H2, 1024, ws + WS_PGATE + (size_t)(L) * 1024 * 1024 * 2, 1024, T, 1024, E); } SEAM(P + 8);

    MOE_PLE_PHASES(6, 0)
    if (IN(15)) { PH_BEGIN_ rwkv_input_pass(F, X, I.norm_mix + 1024, I.rwkv_mu, HCAT, XRB, XKB, XVB); } SEAM(15);
    if (IN(16)) { PH_BEGIN_ { pg8::EpiBf16 E{RB, 1024, 0, 0, 1.f}; dense_gemm(F, XRB, 1024, ws + WS_RCAT, 1024, T, 1024, E); }
        { pg8::EpiMid E{MID}; dense_gemm(F, HCAT, 2048, ws + WS_RL1, 2048, T, 512, E); } } SEAM(16);
    if (IN(17)) { PH_BEGIN_ pg8::EpiBf16 E{KB, 1024, 0, 0, 1.f}; dense_gemm(F, XKB, 1024, ws + WS_RCAT + (size_t)1024 * 1024 * 2, 1024, T, 1024, E); } SEAM(17);
    if (IN(18)) { PH_BEGIN_ pg8::EpiBf16 E{VB, 1024, 0, 0, 1.f}; dense_gemm(F, XVB, 1024, ws + WS_RCAT + (size_t)2 * 1024 * 1024 * 2, 1024, T, 1024, E); } SEAM(18);
    if (IN(19)) { PH_BEGIN_ pg8::EpiRwkv2 E{EWB, AAB, I.rwkv_w0, I.rwkv_a0, 0}; dense_gemm(F, MID, 512, ws + WS_RS2, 256, T, 2048, E); } SEAM(19);
    if (IN(20)) { PH_BEGIN_
        if (F.G == 256 && blockIdx.x >= 128) {
            Frame F2 = F; F2.G = 128; F2.vcu = (int)blockIdx.x - 128;
            prep_layer_weights(F2, I, ws, 1);
            __syncthreads();
            pg8::EpiRwkv2 E{GB2, GB2, nullptr, nullptr, 2}; pg8::DenseOrder S; S.init(MID + 256, 512, ws + WS_RS2 + (size_t)2 * 1024 * 256 * 2, 256, T, 1024, 128, (int)blockIdx.x - 128);
            pg8::gemm_phase<pg8::EpiRwkv2, pg8::DenseOrder, true, false>(F.lds, 256, 512, S, E, nullptr, TID_);
        } else rwkv_scan_chunked(F, I, RB, KB, VB, AAB, EWB, YB);
    } SEAM(20);
    if (IN(21)) { } SEAM(21);
    if (IN(22)) { PH_BEGIN_ rwkv_post_pass(F, I, RB, KB, VB, AAB, GB2, YB); } SEAM(22);
    if (IN(23)) { PH_BEGIN_ pg8::EpiResX<true> E{X, X}; dense_gemm(F, YB, 1024, ws + WS_RWO, 1024, T, 1024, E); } SEAM(23);
    MOE_PLE_PHASES(24, 1)
    if (IN(33)) { PH_BEGIN_ final_norm_pass(F, (const bf16*)(ws + WS_YS), OUT, I.final_norm); }
#undef IN
#undef SEAM
}

extern "C" void kernel_launch(void* const* d_in, const int* in_sizes, int n_in, void* d_out, int out_size, void* d_ws, size_t ws_size, hipStream_t stream) {
    static int ok = 0;
    if (ok == 0) {
        if (n_in != 47 || out_size != T * D || ws_size < WS_END) { fprintf(stderr, "kernel_launch: unexpected problem shape (n_in %d out %d ws %zu)\n", n_in, out_size, ws_size); ok = -1; return; }
        if (hipFuncSetAttribute((const void*)mk_fwd, hipFuncAttributeMaxDynamicSharedMemorySize, LDS_BYTES) != hipSuccess) { fprintf(stderr, "kernel_launch: hipFuncSetAttribute failed\n"); ok = -1; return; }
        int per_cu = 0;
        if (hipOccupancyMaxActiveBlocksPerMultiprocessor(&per_cu, (const void*)mk_fwd, NWAVES * 64, LDS_BYTES) != hipSuccess || per_cu < 1) fprintf(stderr, "kernel_launch: occupancy query reports %d\n", per_cu);
        (void)hipGetLastError();
        ok = 1;
    }
    if (ok < 0) return;
    (void)hipMemsetAsync((char*)d_ws + WS_CTL, 0, CTL_ZERO_BYTES, stream);
    Args a{};
    const float** ip = (const float**)&a.in;
    for (int i = 0; i < 47; ++i) ip[i] = (const float*)d_in[i];
    a.out = (float*)d_out; a.ws = (unsigned char*)d_ws;
    const int grid = 256;
#if MK_ONE_LAUNCH
    a.ph_lo = 0; a.ph_hi = N_PHASES;
    hipLaunchKernelGGL(mk_fwd, dim3(grid), dim3(NWAVES * 64), LDS_BYTES, stream, a);
#else
    for (int k = 0; k < N_PHASES; ++k) { a.ph_lo = k; a.ph_hi = k + 1; hipLaunchKernelGGL(mk_fwd, dim3(grid), dim3(NWAVES * 64), LDS_BYTES, stream, a);
        if (k == DUP_K || k == DUP_K2) hipLaunchKernelGGL(mk_fwd, dim3(grid), dim3(NWAVES * 64), LDS_BYTES, stream, a); }
#endif
}
```

```cpp
#include <hip/hip_runtime.h>
#include <hip/hip_bf16.h>
#include <cstdio>
#include <cstdint>
#include <cmath>

#ifndef MK_ONE_LAUNCH
#define MK_ONE_LAUNCH 1
#endif

#define GAS __attribute__((address_space(1)))
#define LAS __attribute__((address_space(3)))
typedef unsigned short bf16;
typedef unsigned v4u __attribute__((ext_vector_type(4)));
typedef unsigned v2u __attribute__((ext_vector_type(2)));
typedef float f32x4 __attribute__((ext_vector_type(4)));
typedef float f32x2 __attribute__((ext_vector_type(2)));
typedef short bf16x8 __attribute__((ext_vector_type(8)));
typedef GAS unsigned gu32;
#define RLX_AGENT __ATOMIC_RELAXED, __HIP_MEMORY_SCOPE_AGENT
#define LDS_WAIT() asm volatile("s_waitcnt lgkmcnt(0)" ::: "memory")
#define VM_WAIT() asm volatile("s_waitcnt vmcnt(0)" ::: "memory")
__device__ __forceinline__ unsigned f2bf(float f) { unsigned u = __builtin_bit_cast(unsigned, f); return (u + 0x7fffu + ((u >> 16) & 1u)) >> 16; }
typedef float f32x2_cv __attribute__((ext_vector_type(2))); typedef __bf16 bf16x2_cv __attribute__((ext_vector_type(2)));
__device__ __forceinline__ unsigned pk2(float lo, float hi) { const f32x2_cv v = {lo, hi}; const bf16x2_cv b = __builtin_convertvector(v, bf16x2_cv); return __builtin_bit_cast(unsigned, b); }
__device__ __forceinline__ float bflo(unsigned w) { return __uint_as_float(w << 16); }
__device__ __forceinline__ float bfhi(unsigned w) { return __uint_as_float(w & 0xffff0000u); }
__device__ __forceinline__ float bf1(bf16 h) { return __uint_as_float((unsigned)h << 16); }
__device__ __forceinline__ float sigmoidf_(float x) { return __builtin_amdgcn_rcpf(1.0f + __builtin_amdgcn_exp2f(-1.4426950408889634f * x)); }
__device__ __forceinline__ float tanhf_(float x) { return 1.0f - 2.0f * __builtin_amdgcn_rcpf(1.0f + __builtin_amdgcn_exp2f(2.885390081777927f * x)); }
__device__ __forceinline__ void fmac_(float& acc, float a, float b) { asm("v_fmac_f32 %0, %1, %2" : "+v"(acc) : "v"(a), "v"(b)); }
__device__ __forceinline__ float fma_(float a, float b, float c) { float r; asm("v_fma_f32 %0, %1, %2, %3" : "=v"(r) : "v"(a), "v"(b), "v"(c)); return r; }
__device__ __forceinline__ float mul_(float a, float b) { float r; asm("v_mul_f32 %0, %1, %2" : "=v"(r) : "v"(a), "v"(b)); return r; }
__device__ __forceinline__ float wave_sum(float v) {
#pragma unroll
    for (int o = 1; o < 64; o <<= 1) v += __shfl_xor(v, o);
    return v;
}

constexpr int NB = 8, SEQ = 8192, D = 1024, T = NB * SEQ;
constexpr int AB_IN = 2560, PLE = 256;
constexpr int NEXP = 32, EH = 512;
constexpr int MAXSLOT = 2 * T + NEXP * 256;
constexpr int MAXTILES = MAXSLOT / 256;

namespace pg8 {
#define PG8_LAS __attribute__((address_space(3)))
typedef unsigned short bf16_t;
typedef unsigned u32x4 __attribute__((ext_vector_type(4)));
typedef unsigned u32x2 __attribute__((ext_vector_type(2)));
constexpr int BM = 256, BK = 64, HALF = 128, HTB = HALF * BK * 2, STAGE_BYTES = 8 * HTB, NXCD = 8, WGM = 8;
__host__ __device__ __forceinline__ int lds_byte(int r, int c) { const int st = (r >> 4) * 2 + (c >> 5), rr = r & 15, cc = c & 31, ob = rr * 64 + cc * 2; return st * 1024 + (ob ^ (((ob >> 9) & 1) << 5)); }
__host__ __device__ __forceinline__ void stage_rc(int b, int& R, int& C) { const int st = b / 1024, sb = b % 1024, swz = sb ^ (((sb >> 9) & 1) << 5); R = (st >> 1) * 16 + swz / 64; C = (st & 1) * 32 + (swz % 64) / 2; }
__host__ __device__ __forceinline__ int perm32(int rho) { const int n = rho >> 4, i = rho & 15; return 8 * (i >> 2) + 4 * n + (i & 3); }

struct Unit { int pm, pn, aux; const char* A; const char* B; };

struct DenseOrder {
    int nM, nN, nwg, G, c; const char* A; const char* B; size_t astep, bstep;
    __device__ void init(const void* A_, int lda, const void* B_, int K, int M, int N, int G_, int c_) { nM = M / BM; nN = N / BM; nwg = nM * nN; G = G_; c = c_; A = (const char*)A_; B = (const char*)B_; astep = (size_t)BM * lda * 2; bstep = (size_t)BM * K * 2; }
    __device__ bool next(int i, Unit& u) const {
        const long L = (long)i * G + c; if (L >= nwg) return false;
        int wgid = (int)L; { const int q = nwg / NXCD, r = nwg % NXCD, xcd = wgid % NXCD, off = wgid / NXCD; wgid = (xcd < r ? xcd * (q + 1) : r * (q + 1) + (xcd - r) * q) + off; }
        const int nig = WGM * nN, gid = wgid / nig, fm = gid * WGM, gsz = (nM - fm) < WGM ? (nM - fm) : WGM;
        u.pm = fm + ((wgid % nig) % gsz); u.pn = (wgid % nig) / gsz; u.aux = 0; u.A = A + (size_t)u.pm * astep; u.B = B + (size_t)u.pn * bstep; return true;
    }
};

__device__ __forceinline__ unsigned cvt_pk_bf16(float lo, float hi) { unsigned r; asm volatile("v_cvt_pk_bf16_f32 %0, %1, %2" : "=v"(r) : "v"(lo), "v"(hi)); return r; }

typedef f32x4 Acc[2][2][4][2];

struct EpiBf16 {
    static constexpr bool PERM = true;
    bf16_t* O; int ldc; int split_cols; size_t split_stride; float scale0;
    __device__ __forceinline__ void operator()(const Acc& acc, const Unit& u, int wr, int wc, int fr, int fq) const {
        const int row0 = u.pm * BM + wr * 64 + fr; int colt = u.pn * BM; bf16_t* base = O;
        float sc = 1.f; if (split_cols) { const int t = colt / split_cols; base += (size_t)t * split_stride; colt -= t * split_cols; if (t == 0) sc = scale0; }
        const int col0 = colt + wc * 32 + 8 * fq;
#pragma unroll
        for (int ai = 0; ai < 2; ++ai)
#pragma unroll
            for (int m = 0; m < 4; ++m) { bf16_t* rowp = base + (size_t)(row0 + ai * HALF + m * 16) * ldc + col0;
#pragma unroll
                for (int bj = 0; bj < 2; ++bj) { f32x4 v0 = acc[ai][bj][m][0] * sc, v1 = acc[ai][bj][m][1] * sc;
                    u32x4 w; w.x = cvt_pk_bf16(v0[0], v0[1]); w.y = cvt_pk_bf16(v0[2], v0[3]); w.z = cvt_pk_bf16(v1[0], v1[1]); w.w = cvt_pk_bf16(v1[2], v1[3]);
                    *(u32x4*)(rowp + bj * HALF) = w; } }
    }
};
__device__ __forceinline__ void unpack8f(const u32x4 w, f32x4& lo, f32x4& hi) { lo = (f32x4){bflo(w.x), bfhi(w.x), bflo(w.y), bfhi(w.y)}; hi = (f32x4){bflo(w.z), bfhi(w.z), bflo(w.w), bfhi(w.w)}; }
template <bool BASE_BF16>
struct EpiResX {
    static constexpr bool PERM = true;
    const void* base; bf16_t* out;
    __device__ __forceinline__ void operator()(const Acc& acc, const Unit& u, int wr, int wc, int fr, int fq) const {
        const int col0 = u.pn * BM + wc * 32 + 8 * fq; GAS bf16_t* op = (GAS bf16_t*)out;
#pragma unroll
        for (int ai = 0; ai < 2; ++ai) {
            f32x4 b0[4][2], b1[4][2];
#pragma unroll
            for (int m = 0; m < 4; ++m) { const size_t off = (size_t)(u.pm * BM + ai * HALF + wr * 64 + m * 16 + fr) * 1024 + col0;
#pragma unroll
                for (int bj = 0; bj < 2; ++bj) {
                    if (BASE_BF16) { const u32x4 w = *(const GAS u32x4*)((const GAS bf16_t*)base + off + bj * HALF); unpack8f(w, b0[m][bj], b1[m][bj]); }
                    else { b0[m][bj] = *(const GAS f32x4*)((const GAS float*)base + off + bj * HALF); b1[m][bj] = *(const GAS f32x4*)((const GAS float*)base + off + bj * HALF + 4); } } }
            asm volatile("" ::: "memory");
#pragma unroll
            for (int m = 0; m < 4; ++m) { const size_t off = (size_t)(u.pm * BM + ai * HALF + wr * 64 + m * 16 + fr) * 1024 + col0;
#pragma unroll
                for (int bj = 0; bj < 2; ++bj) { const f32x4 v0 = b0[m][bj] + acc[ai][bj][m][0], v1 = b1[m][bj] + acc[ai][bj][m][1];
                    u32x4 w; w.x = cvt_pk_bf16(v0[0], v0[1]); w.y = cvt_pk_bf16(v0[2], v0[3]); w.z = cvt_pk_bf16(v1[0], v1[1]); w.w = cvt_pk_bf16(v1[2], v1[3]);
                    *(GAS u32x4*)(op + off + bj * HALF) = w; } }
            asm volatile("" ::: "memory");
        }
    }
};
struct EpiRouter {
    static constexpr bool PERM = false;
    float* out;
    __device__ __forceinline__ void operator()(const Acc& acc, const Unit& u, int wr, int wc, int fr, int fq) const {
        if (wc >= 2) return;
#pragma unroll
        for (int ai = 0; ai < 2; ++ai)
#pragma unroll
            for (int m = 0; m < 4; ++m) { const size_t off = (size_t)(u.pm * BM + ai * HALF + wr * 64 + m * 16 + fr) * 64 + wc * 32 + 4 * fq;
#pragma unroll
                for (int n = 0; n < 2; ++n) *(f32x4*)(out + off + n * 16) = acc[ai][0][m][n]; }
    }
};
struct EpiGU {
    static constexpr bool PERM = true;
    bf16_t* H;
    __device__ __forceinline__ void operator()(const Acc& acc, const Unit& u, int wr, int wc, int fr, int fq) const {
        const int col0 = u.pn * 128 + wc * 32 + 8 * fq;
#pragma unroll
        for (int ai = 0; ai < 2; ++ai)
#pragma unroll
            for (int m = 0; m < 4; ++m) { bf16_t* rowp = H + (size_t)(u.pm * BM + ai * HALF + wr * 64 + m * 16 + fr) * EH + col0;
                f32x4 g0 = acc[ai][0][m][0], g1 = acc[ai][0][m][1]; const f32x4 u0 = acc[ai][1][m][0], u1 = acc[ai][1][m][1];
#pragma unroll
                for (int e = 0; e < 4; ++e) { g0[e] = g0[e] * sigmoidf_(g0[e]) * u0[e]; g1[e] = g1[e] * sigmoidf_(g1[e]) * u1[e]; }
                u32x4 w; w.x = cvt_pk_bf16(g0[0], g0[1]); w.y = cvt_pk_bf16(g0[2], g0[3]); w.z = cvt_pk_bf16(g1[0], g1[1]); w.w = cvt_pk_bf16(g1[2], g1[3]);
                *(u32x4*)rowp = w; }
    }
};
struct EpiDown {
    static constexpr bool PERM = true;
    bf16_t* Y; const float* gate;
    __device__ __forceinline__ void operator()(const Acc& acc, const Unit& u, int wr, int wc, int fr, int fq) const {
        const int col0 = u.pn * BM + wc * 32 + 8 * fq;
#pragma unroll
        for (int ai = 0; ai < 2; ++ai)
#pragma unroll
            for (int m = 0; m < 4; ++m) { const int row = u.pm * BM + ai * HALF + wr * 64 + m * 16 + fr; const float sc = gate[row]; bf16_t* rowp = Y + (size_t)row * 1024 + col0;
#pragma unroll
                for (int bj = 0; bj < 2; ++bj) { const f32x4 v0 = acc[ai][bj][m][0] * sc, v1 = acc[ai][bj][m][1] * sc;
                    u32x4 w; w.x = cvt_pk_bf16(v0[0], v0[1]); w.y = cvt_pk_bf16(v0[2], v0[3]); w.z = cvt_pk_bf16(v1[0], v1[1]); w.w = cvt_pk_bf16(v1[2], v1[3]);
                    *(u32x4*)(rowp + bj * HALF) = w; } }
    }
};
struct EpiPle {
    static constexpr bool PERM = true;
    const bf16_t* xin; bf16_t* xout; const bf16_t* pp;
    __device__ __forceinline__ void operator()(const Acc& acc, const Unit& u, int wr, int wc, int fr, int fq) const {
        const int col0 = u.pn * BM + wc * 32 + 8 * fq;
        const GAS bf16_t* xp = (const GAS bf16_t*)xin; GAS bf16_t* op = (GAS bf16_t*)xout; const GAS bf16_t* pq = (const GAS bf16_t*)pp;
#pragma unroll
        for (int ai = 0; ai < 2; ++ai) {
            u32x4 xw[4][2], pw[4][2];
#pragma unroll
            for (int m = 0; m < 4; ++m) { const size_t off = (size_t)(u.pm * BM + ai * HALF + wr * 64 + m * 16 + fr) * 1024 + col0;
#pragma unroll
                for (int bj = 0; bj < 2; ++bj) { xw[m][bj] = *(const GAS u32x4*)(xp + off + bj * HALF); pw[m][bj] = *(const GAS u32x4*)(pq + off + bj * HALF); } }
            asm volatile("" ::: "memory");
#pragma unroll
            for (int m = 0; m < 4; ++m) { const size_t off = (size_t)(u.pm * BM + ai * HALF + wr * 64 + m * 16 + fr) * 1024 + col0;
#pragma unroll
                for (int bj = 0; bj < 2; ++bj) { f32x4 x0, x1, p0, p1; unpack8f(xw[m][bj], x0, x1); unpack8f(pw[m][bj], p0, p1); const f32x4 a0 = acc[ai][bj][m][0], a1 = acc[ai][bj][m][1];
#pragma unroll
                    for (int e = 0; e < 4; ++e) { x0[e] += p0[e] * sigmoidf_(a0[e]); x1[e] += p1[e] * sigmoidf_(a1[e]); }
                    u32x4 w; w.x = cvt_pk_bf16(x0[0], x0[1]); w.y = cvt_pk_bf16(x0[2], x0[3]); w.z = cvt_pk_bf16(x1[0], x1[1]); w.w = cvt_pk_bf16(x1[2], x1[3]);
                    *(GAS u32x4*)(op + off + bj * HALF) = w; } }
            asm volatile("" ::: "memory");
        }
    }
};
struct EpiMid {
    static constexpr bool PERM = true;
    bf16_t* MID;
    __device__ __forceinline__ void operator()(const Acc& acc, const Unit& u, int wr, int wc, int fr, int fq) const {
        const int row0 = u.pm * BM + wr * 64 + fr;
        const int mode = (u.pn == 1) ? 2 : 0; const int colbase = u.pn * 256;
#pragma unroll
        for (int ai = 0; ai < 2; ++ai)
#pragma unroll
            for (int m = 0; m < 4; ++m) { bf16_t* rowp = MID + (size_t)(row0 + ai * HALF + m * 16) * 512 + colbase;
#pragma unroll
                for (int bj = 0; bj < 2; ++bj) { const int lc = bj * HALF + wc * 32 + 8 * fq; f32x4 v0 = acc[ai][bj][m][0], v1 = acc[ai][bj][m][1];
#pragma unroll
                    for (int e = 0; e < 4; ++e) {
                        if (mode == 2) { v0[e] = sigmoidf_(v0[e]); v1[e] = sigmoidf_(v1[e]); }
                        else if (lc < 64) { v0[e] = tanhf_(v0[e]); v1[e] = tanhf_(v1[e]); } }
                    u32x4 w; w.x = cvt_pk_bf16(v0[0], v0[1]); w.y = cvt_pk_bf16(v0[2], v0[3]); w.z = cvt_pk_bf16(v1[0], v1[1]); w.w = cvt_pk_bf16(v1[2], v1[3]);
                    *(u32x4*)(rowp + lc) = w; } }
    }
};
struct EpiRwkv2 {
    static constexpr bool PERM = true;
    bf16_t* O0; bf16_t* O1; const float* bias0; const float* bias1; int tybase;
    __device__ __forceinline__ void operator()(const Acc& acc, const Unit& u, int wr, int wc, int fr, int fq) const {
        const int ty = tybase + (u.pn >> 2); const int row0 = u.pm * BM + wr * 64 + fr; const int colt = (u.pn & 3) * BM + wc * 32 + 8 * fq;
        bf16_t* base = (u.pn >> 2) ? O1 : O0; const float* bias = (u.pn >> 2) ? bias1 : bias0;
#pragma unroll
        for (int bj = 0; bj < 2; ++bj) {
            f32x4 b0 = (f32x4){0.f, 0.f, 0.f, 0.f}, b1 = b0;
            if (ty < 2) { b0 = *(const f32x4*)(bias + colt + bj * HALF); b1 = *(const f32x4*)(bias + colt + bj * HALF + 4); }
#pragma unroll
            for (int ai = 0; ai < 2; ++ai)
#pragma unroll
                for (int m = 0; m < 4; ++m) { bf16_t* rowp = base + (size_t)(row0 + ai * HALF + m * 16) * 1024 + colt + bj * HALF;
                    f32x4 v0 = acc[ai][bj][m][0] + b0, v1 = acc[ai][bj][m][1] + b1;
                    if (ty < 2) { const float s = (ty == 0) ? 0.6065306597126334f : 1.0f;
#pragma unroll
                        for (int e = 0; e < 4; ++e) { v0[e] = s * sigmoidf_(v0[e]); v1[e] = s * sigmoidf_(v1[e]); } }
                    u32x4 w; w.x = cvt_pk_bf16(v0[0], v0[1]); w.y = cvt_pk_bf16(v0[2], v0[3]); w.z = cvt_pk_bf16(v1[0], v1[1]); w.w = cvt_pk_bf16(v1[2], v1[3]);
                    *(u32x4*)rowp = w; }
        }
    }
};

template <class Epi, class Sched, bool ALIGN_EPI, bool GATHER>
__device__ __forceinline__ void gemm_phase(PG8_LAS unsigned char* lds, const int K, const int lda, const Sched& S, const Epi& E, const int* __restrict__ rows, const int tid) {
    const int wid = __builtin_amdgcn_readfirstlane(tid >> 6), lane = tid & 63, wr = wid >> 2, wc = wid & 3, fr = lane & 15, fq = lane >> 4;
    const int nt = K / BK;
    unsigned voffA[2], voffB[2]; int RA[2];
#pragma unroll
    for (int i = 0; i < 2; ++i) { int R, C; stage_rc(tid * 16 + i * 8192, R, C); const int Rb = Epi::PERM ? ((R & ~31) + perm32(R & 31)) : R;
        RA[i] = R; voffA[i] = GATHER ? (unsigned)(C * 2) : (unsigned)(R * lda + C) * 2u; voffB[i] = (unsigned)(Rb * K + C) * 2u; }
    const size_t kstep = (size_t)(BK * 2);
    const size_t hstepA = GATHER ? 0 : (size_t)HALF * lda * 2, hstepB = (size_t)HALF * K * 2;
    const unsigned ldsw = (unsigned)wid * 1024u;
    const int aoff = lds_byte(wr * 64 + fr, fq * 8), boff = lds_byte(wc * 32 + fr, fq * 8);
#define PG8_SA(b, h) (((b) * 2 + (h)) * HTB)
#define PG8_SB(b, h) ((4 + (b) * 2 + (h)) * HTB)
#define PG8_ST2(bufoff, gbase, o0, o1) do { \
        __builtin_amdgcn_global_load_lds((const unsigned*)((const char*)(gbase) + (o0)), (PG8_LAS unsigned*)(lds + (bufoff) + ldsw), 16, 0, 0); \
        __builtin_amdgcn_global_load_lds((const unsigned*)((const char*)(gbase) + (o1)), (PG8_LAS unsigned*)(lds + (bufoff) + ldsw + 8192), 16, 0, 0); } while (0)
#define PG8_STB(bufoff, gbase) PG8_ST2(bufoff, gbase, voffB[0], voffB[1])
#define PG8_STA(bufoff, p, h, nx) do { if constexpr (GATHER) { const unsigned g0_ = (nx) ? gN[h][0] : gC[h][0], g1_ = (nx) ? gN[h][1] : gC[h][1]; PG8_ST2(bufoff, p, g0_, g1_); } \
        else { PG8_ST2(bufoff, (p) + (h) * hstepA, voffA[0], voffA[1]); } } while (0)
#define PG8_LDA(dst, b, h) do { _Pragma("unroll") for (int m = 0; m < 4; ++m) _Pragma("unroll") for (int k = 0; k < 2; ++k) dst[m][k] = *(const PG8_LAS bf16x8*)(lds + PG8_SA(b, h) + aoff + m * 2048 + k * 1024); } while (0)
#define PG8_LDB(dst, b, h) do { _Pragma("unroll") for (int n = 0; n < 2; ++n) _Pragma("unroll") for (int k = 0; k < 2; ++k) dst[n][k] = *(const PG8_LAS bf16x8*)(lds + PG8_SB(b, h) + boff + n * 2048 + k * 1024); } while (0)
#define PG8_MMA(ai, bj, At, Bt) do { __builtin_amdgcn_s_setprio(1); _Pragma("unroll") for (int m = 0; m < 4; ++m) _Pragma("unroll") for (int n = 0; n < 2; ++n) _Pragma("unroll") for (int k = 0; k < 2; ++k) \
        acc[ai][bj][m][n] = __builtin_amdgcn_mfma_f32_16x16x32_bf16(Bt[n][k], At[m][k], acc[ai][bj][m][n], 0, 0, 0); __builtin_amdgcn_s_setprio(0); } while (0)
#define PG8_WAIT_V(n) asm volatile("s_waitcnt vmcnt(" #n ")" ::: "memory")
#define PG8_WAIT_L(n) asm volatile("s_waitcnt lgkmcnt(" #n ")" ::: "memory")
#define PG8_BAR __builtin_amdgcn_s_barrier()
#define PG8_SCHED __builtin_amdgcn_sched_barrier(0)
#define PG8_GLOAD(dst, un) do { if constexpr (GATHER) { _Pragma("unroll") for (int h_ = 0; h_ < 2; ++h_) _Pragma("unroll") for (int i_ = 0; i_ < 2; ++i_) \
        dst[h_][i_] = (unsigned)rows[(un).pm * BM + h_ * HALF + RA[i_]] * (unsigned)(lda * 2) + voffA[i_]; } } while (0)
    Unit cur, nxt; int ui = 0;
    if (!S.next(0, cur)) return;
    unsigned gC[2][2] = {{0u, 0u}, {0u, 0u}}, gN[2][2] = {{0u, 0u}, {0u, 0u}};
    PG8_GLOAD(gC, cur);
    Acc acc;
#pragma unroll
    for (int a = 0; a < 2; ++a)
#pragma unroll
        for (int b = 0; b < 2; ++b)
#pragma unroll
            for (int m = 0; m < 4; ++m)
#pragma unroll
                for (int n = 0; n < 2; ++n) acc[a][b][m][n] = (f32x4){0.f, 0.f, 0.f, 0.f};
    bf16x8 At[4][2], B0[2][2], B1[2][2];
    const char* cA = cur.A; const char* cB = cur.B;
    PG8_STB(PG8_SB(0, 0), cB); PG8_STB(PG8_SB(0, 1), cB + hstepB); PG8_STA(PG8_SA(0, 0), cA, 0, false); PG8_STA(PG8_SA(0, 1), cA, 1, false);
    if (wr == 1) PG8_BAR;
    PG8_WAIT_V(2); PG8_BAR;
    PG8_STB(PG8_SB(1, 0), cB + kstep); PG8_STA(PG8_SA(1, 0), cA + kstep, 0, false); PG8_STB(PG8_SB(1, 1), cB + hstepB + kstep);
    PG8_WAIT_V(6); PG8_BAR;
    for (;;) {
        const bool has_next = S.next(ui + 1, nxt);
        if (has_next) { PG8_GLOAD(gN, nxt); }
        const char* nA = has_next ? nxt.A : cA; const char* nB = has_next ? nxt.B : cB;
#pragma unroll 1
        for (int t = 0; t < nt; t += 2) {
            const bool last = (t == nt - 2); const bool nx = last && has_next;
            const char* a1 = cA + (size_t)(t + 1) * kstep;
            const char* a2 = last ? nA : cA + (size_t)(t + 2) * kstep; const char* b2 = last ? nB : cB + (size_t)(t + 2) * kstep;
            const char* a3 = a2 + kstep; const char* b3 = b2 + kstep;
            PG8_LDB(B0, 0, 0); PG8_LDB(B1, 0, 1); PG8_SCHED; PG8_LDA(At, 0, 0); PG8_STA(PG8_SA(1, 1), a1, 1, false);
            PG8_WAIT_V(8); PG8_WAIT_L(0); PG8_BAR; PG8_MMA(0, 0, At, B0); PG8_MMA(0, 1, At, B1); PG8_BAR; PG8_SCHED;
            PG8_LDA(At, 0, 1); PG8_STB(PG8_SB(0, 0), b2); PG8_STB(PG8_SB(0, 1), b2 + hstepB); PG8_STA(PG8_SA(0, 0), a2, 0, nx);
            PG8_WAIT_V(8); PG8_WAIT_L(0); PG8_BAR; PG8_MMA(1, 0, At, B0); PG8_MMA(1, 1, At, B1); PG8_BAR; PG8_SCHED;
            PG8_LDB(B0, 1, 0); PG8_LDB(B1, 1, 1); PG8_SCHED; PG8_LDA(At, 1, 0); PG8_STA(PG8_SA(0, 1), a2, 1, nx);
            PG8_WAIT_V(8); PG8_WAIT_L(0); PG8_BAR; PG8_MMA(0, 0, At, B0); PG8_MMA(0, 1, At, B1); PG8_BAR; PG8_SCHED;
            PG8_LDA(At, 1, 1); PG8_STB(PG8_SB(1, 0), b3); PG8_STB(PG8_SB(1, 1), b3 + hstepB); PG8_STA(PG8_SA(1, 0), a3, 0, nx);
            PG8_WAIT_V(8); PG8_WAIT_L(0); PG8_BAR; PG8_MMA(1, 0, At, B0); PG8_MMA(1, 1, At, B1); PG8_BAR; PG8_SCHED;
        }
        if constexpr (ALIGN_EPI) { if (wr == 0) PG8_BAR; }
        E(acc, cur, wr, wc, fr, fq);
        if (!has_next) break;
#pragma unroll
        for (int a = 0; a < 2; ++a)
#pragma unroll
            for (int b = 0; b < 2; ++b)
#pragma unroll
                for (int m = 0; m < 4; ++m)
#pragma unroll
                    for (int n = 0; n < 2; ++n) acc[a][b][m][n] = (f32x4){0.f, 0.f, 0.f, 0.f};
        cur = nxt; cA = nA; cB = nB; ++ui;
        if constexpr (GATHER) {
#pragma unroll
            for (int h_ = 0; h_ < 2; ++h_)
#pragma unroll
                for (int i_ = 0; i_ < 2; ++i_) gC[h_][i_] = gN[h_][i_]; }
        if constexpr (ALIGN_EPI) { if (wr == 1) PG8_BAR; }
    }
    PG8_WAIT_V(0);
    if constexpr (!ALIGN_EPI) { if (wr == 0) PG8_BAR; }
    PG8_BAR;
#undef PG8_SA
#undef PG8_SB
#undef PG8_ST2
#undef PG8_STB
#undef PG8_STA
#undef PG8_LDA
#undef PG8_LDB
#undef PG8_MMA
#undef PG8_WAIT_V
#undef PG8_WAIT_L
#undef PG8_BAR
#undef PG8_SCHED
#undef PG8_GLOAD
}
}
namespace attn_body {
using bf16=__hip_bfloat16;
using bf16x8=__attribute__((ext_vector_type(8)))short;
using s16x4=__attribute__((ext_vector_type(4)))short;
using f32x16=__attribute__((ext_vector_type(16)))float;
using u32x4=__attribute__((ext_vector_type(4)))unsigned;
constexpr int BATCH=8,NHEAD=16,SEQ=8192,D=64,PQ=512,PO=1024;
constexpr int NW=8,QBLK=32,QB=QBLK*NW,KVBLK=64,NQB=SEQ/QB;
constexpr int ATTN_UNIT_ROWS=QB;
__device__ __forceinline__ int crow(int r,int hi){return (r&3)+8*(r>>2)+4*hi;}
#define SBAR() __builtin_amdgcn_sched_barrier(0)
__device__ __forceinline__ void cmask(f32x16&p0,f32x16&p1,int jb,int qrel,int hi){
  const float NEG=-INFINITY; int kb=64*jb+4*hi;
  #pragma unroll
  for(int r=0;r<16;++r){int kv=kb+(r&3)+8*(r>>2); if(kv>qrel)p0[r]=NEG; if(kv+32>qrel)p1[r]=NEG;}
}

__device__ __forceinline__ void cbias(f32x16&p0,f32x16&p1,int jb,int qrel,int hi,const __attribute__((address_space(3))) float*tb){
  const int kb=64*jb+4*hi;
  #pragma unroll
  for(int r=0;r<16;++r){const int rel=qrel-(kb+(r&3)+8*(r>>2)); const int i0=min(max(rel,0),127), i1=min(max(rel-32,0),127); p0[r]+=tb[i0]; p1[r]+=tb[i1];}
}
constexpr int NSLOT=3, SLOTB=8192;
constexpr int LDS_K=0, LDS_V=NSLOT*SLOTB, LDS_WS=2*NSLOT*SLOTB, LDS_OST=LDS_WS+NW*64*4, LDS_BYTES=LDS_OST+NW*4096;
constexpr float C2=0.125f*1.4426950408889634f;
__device__ __forceinline__ void glds16(const void*gsrc,unsigned lds_dst){unsigned keep;
  asm volatile("s_mov_b32 %0, m0\n\ts_mov_b32 m0, %2\n\ts_nop 0\n\tglobal_load_lds_dwordx4 %1, off\n\ts_mov_b32 m0, %0":"=&s"(keep):"v"(gsrc),"s"(lds_dst):"memory");}
__device__ __forceinline__ float max3f(float a,float b,float c){float r;asm("v_max3_f32 %0, %1, %2, %3":"=v"(r):"v"(a),"v"(b),"v"(c));return r;}
__device__ __forceinline__ float max2f(float a,float b){float r;asm("v_max_f32_e32 %0, %1, %2":"=v"(r):"v"(a),"v"(b));return r;}
__device__ __forceinline__ float fadd_s(float a,float b){float r;asm("v_add_f32_e32 %0, %1, %2":"=v"(r):"v"(a),"v"(b));return r;}
__device__ __forceinline__ float fsub_s(float a,float b){float r;asm("v_sub_f32_e32 %0, %1, %2":"=v"(r):"v"(a),"v"(b));return r;}
typedef float f32x2_t __attribute__((ext_vector_type(2))); typedef __bf16 bf16x2_t __attribute__((ext_vector_type(2)));
__device__ __forceinline__ unsigned cvtpk_s(float lo,float hi){f32x2_t v={lo,hi};bf16x2_t b=__builtin_convertvector(v,bf16x2_t);return __builtin_bit_cast(unsigned,b);}
#define WAIT_BAR(N) asm volatile("s_waitcnt vmcnt(" #N ") lgkmcnt(0)\n\ts_barrier":::"memory")

__device__ __forceinline__ void qkt(f32x16&p0,f32x16&p1,const char*Kslot,const bf16x8*qr,const f32x16&negm,int r32,int hi){
  const char*kb=Kslot+hi*1024+r32*16;
  #pragma unroll
  for(int d0=0;d0<4;++d0){
    const bf16x8 b0=*reinterpret_cast<const bf16x8*>(kb+d0*2048);
    const bf16x8 b1=*reinterpret_cast<const bf16x8*>(kb+d0*2048+512);
    if(d0==0){p0=__builtin_amdgcn_mfma_f32_32x32x16_bf16(b0,qr[0],negm,0,0,0);p1=__builtin_amdgcn_mfma_f32_32x32x16_bf16(b1,qr[0],negm,0,0,0);}
    else{p0=__builtin_amdgcn_mfma_f32_32x32x16_bf16(b0,qr[d0],p0,0,0,0);p1=__builtin_amdgcn_mfma_f32_32x32x16_bf16(b1,qr[d0],p1,0,0,0);}}
}
typedef __attribute__((address_space(3))) const char* lds_cptr;
typedef short v4i16_t __attribute__((ext_vector_type(4)));
__device__ __forceinline__ void kload8(bf16x8*kf,lds_cptr kp){
  kf[0]=*(const __attribute__((address_space(3))) bf16x8*)(kp);      kf[1]=*(const __attribute__((address_space(3))) bf16x8*)(kp+512);
  kf[2]=*(const __attribute__((address_space(3))) bf16x8*)(kp+2048); kf[3]=*(const __attribute__((address_space(3))) bf16x8*)(kp+2560);
  kf[4]=*(const __attribute__((address_space(3))) bf16x8*)(kp+4096); kf[5]=*(const __attribute__((address_space(3))) bf16x8*)(kp+4608);
  kf[6]=*(const __attribute__((address_space(3))) bf16x8*)(kp+6144); kf[7]=*(const __attribute__((address_space(3))) bf16x8*)(kp+6656);
}
__device__ __forceinline__ void kload2(bf16x8*kf,lds_cptr kp,int j){ kf[2*j]=*(const __attribute__((address_space(3))) bf16x8*)(kp+j*2048); kf[2*j+1]=*(const __attribute__((address_space(3))) bf16x8*)(kp+j*2048+512); }
__device__ __forceinline__ s16x4 vtr(lds_cptr p){ return __builtin_bit_cast(s16x4,__builtin_amdgcn_ds_read_tr16_b64_v4i16((__attribute__((address_space(3))) v4i16_t*)p)); }
__device__ __forceinline__ float rowmax(const f32x16&p0,const f32x16&p1){
  float a=max3f(p0[0],p0[1],p1[0]),b=max3f(p0[2],p0[3],p1[1]);a=max3f(a,p1[2],p1[3]);
  #pragma unroll
  for(int r=4;r<16;r+=4){a=max3f(a,p0[r],p0[r+1]);b=max3f(b,p0[r+2],p0[r+3]);a=max3f(a,p1[r],p1[r+1]);b=max3f(b,p1[r+2],p1[r+3]);}
  const float m=max2f(a,b);
  auto rr=__builtin_amdgcn_permlane32_swap(__float_as_uint(m),__float_as_uint(m),false,false);
  return max2f(__uint_as_float(rr[0]),__uint_as_float(rr[1]));
}
__device__ __forceinline__ void pv(f32x16*o,int vb,bf16x8 pa0,bf16x8 pa1,bf16x8 pa2,bf16x8 pa3){
  #pragma unroll
  for(int d0=0;d0<2;++d0){s16x4 lo[4],hi[4];
    #pragma unroll
    for(int ks=0;ks<4;++ks){
      asm volatile("ds_read_b64_tr_b16 %0,%1 offset:%c2":"=&v"(lo[ks]):"v"(vb),"i"(d0*4096+ks*1024):"memory");
      asm volatile("ds_read_b64_tr_b16 %0,%1 offset:%c2":"=&v"(hi[ks]):"v"(vb),"i"(d0*4096+ks*1024+512):"memory");}
    asm volatile("s_waitcnt lgkmcnt(0)":::"memory");SBAR();
    #define PK(k) (bf16x8){lo[k][0],lo[k][1],lo[k][2],lo[k][3],hi[k][0],hi[k][1],hi[k][2],hi[k][3]}
    o[d0]=__builtin_amdgcn_mfma_f32_32x32x16_bf16(pa0,PK(0),o[d0],0,0,0);
    o[d0]=__builtin_amdgcn_mfma_f32_32x32x16_bf16(pa1,PK(1),o[d0],0,0,0);
    o[d0]=__builtin_amdgcn_mfma_f32_32x32x16_bf16(pa2,PK(2),o[d0],0,0,0);
    o[d0]=__builtin_amdgcn_mfma_f32_32x32x16_bf16(pa3,PK(3),o[d0],0,0,0);
    #undef PK
  }
}

#ifndef ATTN_STORE16
#define ATTN_STORE16(p,v) (*(u32x4*)(p)=(v))
#endif
template<int THRL> __device__ __forceinline__ void attn_unit(int b,int vh,int qb,const bf16*Q,const bf16*__restrict__ K,const bf16*__restrict__ V,bf16*O,char*shm,const __attribute__((address_space(3))) float*tball,const int tid){
  const int lane=tid&63,r32=lane&31,hi=lane>>5; const int wid=__builtin_amdgcn_readfirstlane(tid>>6);
  const long rowbase=(long)b*SEQ; const int q0=qb*QB;
  const int hh=vh>>2, qcol=hh*128+((vh>>1)&1)*64, vcol=hh*128+(vh&1)*64;
  const __attribute__((address_space(3))) float*tb=tball+hh*128;
  const bf16*Qw=Q+(rowbase+q0+wid*QBLK)*PQ+qcol;
  const bf16*Kh=K+rowbase*PQ+qcol,*Vh=V+rowbase*PQ+vcol;
  const unsigned lds0=(unsigned)(uintptr_t)shm;
  float*wsf=(float*)(shm+LDS_WS)+wid*64;
  const bf16*ksrc=Kh+(long)lane*PQ+wid*8;
  const bf16*vsrc=Vh+(long)(16*(wid&3)+(lane>>2))*PQ+(wid>>2)*32+(lane&3)*8;
  const unsigned kdst=lds0+LDS_K+wid*1024, vdst=lds0+LDS_V+wid*1024;
  #define DMA_K(t,slot) glds16(ksrc+(long)(t)*KVBLK*PQ,(unsigned)__builtin_amdgcn_readfirstlane(kdst+(slot)))
  #define DMA_V(t,slot) glds16(vsrc+(long)(t)*KVBLK*PQ,(unsigned)__builtin_amdgcn_readfirstlane(vdst+(slot)))
  const int vb0=(int)(lds0+LDS_V)+((lane>>4)&1)*32+(lane&3)*8+(4*hi+((lane&15)>>2))*64;
  const char*Kbase=shm+LDS_K; bf16x8 kf[8];
  const lds_cptr shm3=(lds_cptr)shm; const lds_cptr kp0=shm3+LDS_K+hi*1024+r32*16; const lds_cptr vp0=shm3+LDS_V+((lane>>4)&1)*32+(lane&3)*8+(4*hi+((lane&15)>>2))*64;
  const int NT=(q0+QB)/KVBLK;
  DMA_K(0,0);DMA_V(0,0);DMA_K(1,SLOTB);
  bf16x8 qr[4];
  #pragma unroll
  for(int d0=0;d0<4;++d0)qr[d0]=*reinterpret_cast<const bf16x8*>(&Qw[(long)r32*PQ+d0*16+hi*8]);
  float mhat=0.f,l_reg=0.f;f32x16 o[2];o[0]=f32x16{};o[1]=f32x16{};f32x16 negm=f32x16{};asm volatile("":"+v"(negm));
  const int qrel=wid*QBLK+r32;
  #define CMASK(P0,P1,t) do{int jb_=(t)-(NT-4); if(jb_>=-2){cbias(P0,P1,jb_,qrel,hi,tb); if(jb_>=0)cmask(P0,P1,jb_,qrel,hi);}}while(0)
  bool resc=false;
  #define START(P0,P1) do{ const float rm=rowmax(P0,P1); resc=false; \
    { const float dl=rm; mhat=fadd_s(mhat,dl); \
      _Pragma("unroll") for(int r=0;r<16;++r){P0[r]=fsub_s(P0[r],dl);P1[r]=fsub_s(P1[r],dl);} \
      _Pragma("unroll") for(int r=0;r<16;++r)negm[r]=-mhat; asm volatile("":"+v"(negm)); } \
    _Pragma("unroll") for(int r=0;r<16;++r)P0[r]=__builtin_amdgcn_exp2f(P0[r]); }while(0)
  #define RESC() do{ if(resc){ asm volatile("s_waitcnt lgkmcnt(0)":::"memory"); \
      _Pragma("unroll") for(int d_=0;d_<2;++d_) _Pragma("unroll") for(int r=0;r<16;++r)o[d_][r]*=wsf[crow(r,hi)]; } }while(0)
  f32x16 pA0,pA1,pB0,pB1;
  int sl_prev=0,sl_cur=0,sl_next=SLOTB;
  #define ROT() do{sl_prev=sl_cur;sl_cur=sl_next;sl_next=(sl_next==(NSLOT-1)*SLOTB)?0:sl_next+SLOTB;}while(0)
  DMA_K(2,2*SLOTB);
  WAIT_BAR(3);
  qkt(pA0,pA1,Kbase,qr,negm,r32,hi);asm volatile("s_nop 15\n\ts_nop 7":"+v"(pA0),"+v"(pA1));CMASK(pA0,pA1,0);
  START(pA0,pA1);
  _Pragma("unroll") for(int r=0;r<16;++r)pA1[r]=__builtin_amdgcn_exp2f(pA1[r]);
  WAIT_BAR(0);
  DMA_K(3,0);DMA_V(1,SLOTB);
  ROT();
  kload8(kf,kp0+sl_cur);
  WAIT_BAR(2);
  s16x4 vlo[8],vhi[8]; u32x4 pw0,pw1,pw2,pw3;
  #define PKW(P,B) cvtpk_s(P[B],P[B+1])
  #define PAF(k) __builtin_bit_cast(bf16x8,pw##k)
  #define VFR(i) (bf16x8){vlo[i][0],vlo[i][1],vlo[i][2],vlo[i][3],vhi[i][0],vhi[i][1],vhi[i][2],vhi[i][3]}
  #define PIN(x) asm volatile("":"+v"(x))
  #define MX3(a,b,c) __builtin_fmaxf(__builtin_fmaxf((a),(b)),(c))
  #define GAPA(MF,A0,A1,A2,A3,W0,W1,PW) do{ MF; sacc+=A0; sacc+=A1; sacc+=A2; sacc+=A3; PIN(sacc); W0; W1; PIN(PW); SBAR(); }while(0)
  #define EX(v) __builtin_amdgcn_exp2f(v)
  #define GAPB(MF,X,B) do{ MF; X[B]=EX(X[B]); X[B+1]=EX(X[B+1]); X[B+2]=EX(X[B+2]); X[B+3]=EX(X[B+3]); PIN(X); SBAR(); }while(0)
  #define VRD(i) do{ vlo[i]=vtr(vp_+(((i)>>2)*4096+((i)&3)*1024)); vhi[i]=vtr(vp_+(((i)>>2)*4096+((i)&3)*1024+512)); }while(0)
  #define KRD(G,j) do{ if(G){ kload2(kf,kp0+sl_next,j); SBAR(); } }while(0)
  #define STEP(C0,C1,P0,P1,t,GK,GV,GL) do{ SBAR(); \
    const lds_cptr vp_=vp0+sl_prev; \
    VRD(0); SBAR(); float sacc=(P0[0]+P0[1]); \
    GAPA(C0=__builtin_amdgcn_mfma_f32_32x32x16_bf16(kf[0],qr[0],negm,0,0,0), P0[2],P0[3],P0[4],P0[5],     pw0[0]=PKW(P0,0), pw0[1]=PKW(P0,2), pw0); \
    VRD(4); SBAR(); GAPA(C1=__builtin_amdgcn_mfma_f32_32x32x16_bf16(kf[1],qr[0],negm,0,0,0), P0[6],P0[7],P0[8],P0[9],     pw0[2]=PKW(P0,4), pw0[3]=PKW(P0,6), pw0); \
    VRD(1); SBAR(); GAPA(C0=__builtin_amdgcn_mfma_f32_32x32x16_bf16(kf[2],qr[1],C0,0,0,0),   P0[10],P0[11],P0[12],P0[13], pw1[0]=PKW(P0,8), pw1[1]=PKW(P0,10), pw1); \
    VRD(5); SBAR(); GAPA(C1=__builtin_amdgcn_mfma_f32_32x32x16_bf16(kf[3],qr[1],C1,0,0,0),   P0[14],P0[15],P1[0],P1[1],   pw1[2]=PKW(P0,12),pw1[3]=PKW(P0,14), pw1); \
    VRD(2); SBAR(); GAPA(C0=__builtin_amdgcn_mfma_f32_32x32x16_bf16(kf[4],qr[2],C0,0,0,0),   P1[2],P1[3],P1[4],P1[5],     pw2[0]=PKW(P1,0), pw2[1]=PKW(P1,2), pw2); \
    VRD(6); SBAR(); GAPA(C1=__builtin_amdgcn_mfma_f32_32x32x16_bf16(kf[5],qr[2],C1,0,0,0),   P1[6],P1[7],P1[8],P1[9],     pw2[2]=PKW(P1,4), pw2[3]=PKW(P1,6), pw2); \
    VRD(3); SBAR(); GAPA(C0=__builtin_amdgcn_mfma_f32_32x32x16_bf16(kf[6],qr[3],C0,0,0,0),   P1[10],P1[11],P1[12],P1[13], pw3[0]=PKW(P1,8), pw3[1]=PKW(P1,10), pw3); \
    VRD(7); SBAR(); GAPA(C1=__builtin_amdgcn_mfma_f32_32x32x16_bf16(kf[7],qr[3],C1,0,0,0),   P1[14],P1[15],0.f,0.f,       pw3[2]=PKW(P1,12),pw3[3]=PKW(P1,14), pw3); \
    l_reg+=sacc; \
    if(GK){DMA_K((t)+3,sl_cur);} if(GV){DMA_V((t)+1,sl_next);} \
    CMASK(C0,C1,t); \
    { float a=MX3(C0[0],C0[1],C1[0]),b=MX3(C0[2],C0[3],C1[1]); a=MX3(a,C1[2],C1[3]); \
      _Pragma("unroll") for(int r=4;r<16;r+=4){a=MX3(a,C0[r],C0[r+1]);b=MX3(b,C0[r+2],C0[r+3]);a=MX3(a,C1[r],C1[r+1]);b=MX3(b,C1[r+2],C1[r+3]);} \
      float rm=__builtin_fmaxf(a,b); { auto rr=__builtin_amdgcn_permlane32_swap(__float_as_uint(rm),__float_as_uint(rm),false,false); rm=__builtin_fmaxf(__uint_as_float(rr[0]),__uint_as_float(rr[1])); } \
      resc=false; \
      if(__builtin_expect(__any(rm>(float)THRL),0)){ const float dl=__builtin_fmaxf(rm,0.f); mhat+=dl; \
        _Pragma("unroll") for(int r=0;r<16;++r){C0[r]-=dl;C1[r]-=dl;} \
        _Pragma("unroll") for(int r=0;r<16;++r)negm[r]=-mhat; asm volatile("":"+v"(negm)); \
        const float f=__builtin_amdgcn_exp2f(-dl); l_reg*=f; if(hi==0)wsf[r32]=f; resc=true; } } \
    SBAR(); \
    GAPB(o[0]=__builtin_amdgcn_mfma_f32_32x32x16_bf16(PAF(0),VFR(0),o[0],0,0,0), C0,0); \
    GAPB(o[1]=__builtin_amdgcn_mfma_f32_32x32x16_bf16(PAF(0),VFR(4),o[1],0,0,0), C0,4); \
    KRD(GL,0); GAPB(o[0]=__builtin_amdgcn_mfma_f32_32x32x16_bf16(PAF(1),VFR(1),o[0],0,0,0), C0,8); \
    KRD(GL,1); GAPB(o[1]=__builtin_amdgcn_mfma_f32_32x32x16_bf16(PAF(1),VFR(5),o[1],0,0,0), C0,12); \
    KRD(GL,2); GAPB(o[0]=__builtin_amdgcn_mfma_f32_32x32x16_bf16(PAF(2),VFR(2),o[0],0,0,0), C1,0); \
    KRD(GL,3); GAPB(o[1]=__builtin_amdgcn_mfma_f32_32x32x16_bf16(PAF(2),VFR(6),o[1],0,0,0), C1,4); \
    GAPB(o[0]=__builtin_amdgcn_mfma_f32_32x32x16_bf16(PAF(3),VFR(3),o[0],0,0,0), C1,8); \
    GAPB(o[1]=__builtin_amdgcn_mfma_f32_32x32x16_bf16(PAF(3),VFR(7),o[1],0,0,0), C1,12); \
    }while(0)
  int t=1;
  #undef CMASK
  #define CMASK(P0,P1,t) do{}while(0)
  for(;t+7<NT;t+=2){
    STEP(pB0,pB1,pA0,pA1,t,true,true,true);     WAIT_BAR(2); RESC(); ROT();
    STEP(pA0,pA1,pB0,pB1,t+1,true,true,true);   WAIT_BAR(2); RESC(); ROT();
  }
  #undef CMASK
  #define CMASK(P0,P1,t) do{int jb_=(t)-(NT-4); if(jb_>=-2){cbias(P0,P1,jb_,qrel,hi,tb); if(jb_>=0)cmask(P0,P1,jb_,qrel,hi);}}while(0)
  #define ENDW(tt) do{ if((tt)+3<NT){WAIT_BAR(2);} else if((tt)+2<NT){WAIT_BAR(1);} else {WAIT_BAR(0);} }while(0)
  for(;t+1<NT;t+=2){
    STEP(pB0,pB1,pA0,pA1,t,(t+3<NT),(t+1<NT),(t+1<NT));       ENDW(t);   RESC(); ROT();
    STEP(pA0,pA1,pB0,pB1,t+1,(t+4<NT),(t+2<NT),(t+2<NT));     ENDW(t+1); RESC(); ROT();
  }
  STEP(pB0,pB1,pA0,pA1,NT-1,false,false,false); RESC();
  { float sacc=pB0[0]+pB0[1]; _Pragma("unroll") for(int r=2;r<16;++r)sacc+=pB0[r]; _Pragma("unroll") for(int r=0;r<16;++r)sacc+=pB1[r]; l_reg+=sacc;
    pw0=(u32x4){PKW(pB0,0),PKW(pB0,2),PKW(pB0,4),PKW(pB0,6)};pw1=(u32x4){PKW(pB0,8),PKW(pB0,10),PKW(pB0,12),PKW(pB0,14)};pw2=(u32x4){PKW(pB1,0),PKW(pB1,2),PKW(pB1,4),PKW(pB1,6)};pw3=(u32x4){PKW(pB1,8),PKW(pB1,10),PKW(pB1,12),PKW(pB1,14)};
    SBAR(); pv(o,vb0+sl_cur,PAF(0),PAF(1),PAF(2),PAF(3)); }
  #undef PKW
  #undef PAF
  #undef VFR
  #undef PIN
  #undef MX3
  #undef GAPA
  #undef GAPB
  #undef EX
  #undef VRD
  #undef KRD
  #undef STEP
  #undef ENDW
  {auto rr=__builtin_amdgcn_permlane32_swap(__float_as_uint(l_reg),__float_as_uint(l_reg),false,false);l_reg=__uint_as_float(rr[0])+__uint_as_float(rr[1]);}
  if(hi==0)wsf[32+r32]=l_reg;asm volatile("s_waitcnt lgkmcnt(0)":::"memory");
  float rli[16];
  #pragma unroll
  for(int r=0;r<16;++r)rli[r]=__builtin_amdgcn_rcpf(wsf[32+crow(r,hi)]);
  bf16*Ow=O+(rowbase+q0+wid*QBLK)*PO+vh*D;
  { bf16*stg=(bf16*)(shm+LDS_OST)+wid*2048;
    #pragma unroll
    for(int r=0;r<16;++r){const int orow=crow(r,hi);
      #pragma unroll
      for(int d0=0;d0<2;++d0)stg[orow*64+d0*32+r32]=__float2bfloat16(o[d0][r]*rli[r]);}
    asm volatile("s_waitcnt lgkmcnt(0)":::"memory");
    #pragma unroll
    for(int i=0;i<4;++i){const int row=i*8+(lane>>3),ch=lane&7; const u32x4 v=*(const u32x4*)(stg+row*64+ch*8); ATTN_STORE16(Ow+(long)row*PO+ch*8,v);} }
  asm volatile("s_waitcnt lgkmcnt(0)\n\ts_barrier":::"memory");
  #undef DMA_K
  #undef DMA_V
  #undef CMASK
  #undef START
  #undef RESC
  #undef ROT
}
constexpr int ATTN_LDS_BYTES=LDS_BYTES;
struct AttnTensors { const bf16* Q; const bf16* K; const bf16* V; bf16* O; };
struct AttnUnit { int bh; int qb; };
__device__ __forceinline__ bool attn_next(int vcu,int i,AttnUnit&u){ if(i>=16)return false; const int s=vcu&7, j=i&3; u.bh=(vcu>>3)+32*(i>>2); u.qb=(j==0)?s:(j==1)?15-s:(j==2)?16+s:31-s; return true; }
template<int THRL=8> __device__ __forceinline__ void attn_phase(char*lds,const AttnTensors&T,int vcu,const __attribute__((address_space(3))) float*tball,const int tid){
  AttnUnit u;
  for(int i=0;attn_next(vcu,i,u);++i){ attn_unit<THRL>(u.bh/NHEAD,u.bh%NHEAD,u.qb,T.Q,T.K,T.V,T.O,lds,tball,tid); }
}
#undef SBAR
#undef WAIT_BAR
}

#define XB_TMO      128
#define XB_XCNT(j)  (256  + 64 * (j))
#define XB_XSUB(j)  (1280 + 64 * (j))
#define XB_XGEN(j)  (2304 + 64 * (j))
#define XB_TOP      3328
#define XB_TOPGEN   3392
#define XCD_BAR_WORDS 3456
#define XB_SPIN_CAP (1u << 18)

__device__ __forceinline__ unsigned xb_ld(unsigned* p)              { return __hip_atomic_load(p, __ATOMIC_RELAXED, __HIP_MEMORY_SCOPE_AGENT); }
__device__ __forceinline__ unsigned xb_add(unsigned* p, unsigned v) { return __hip_atomic_fetch_add(p, v, __ATOMIC_RELAXED, __HIP_MEMORY_SCOPE_AGENT); }
__device__ __forceinline__ unsigned xb_xcc_id() { return (unsigned)__builtin_amdgcn_s_getreg((3 << 11) | 20) & 0xFu; }
#define XB_SPIN(cond, bar) do { unsigned _sp = 0; while (cond) { __builtin_amdgcn_s_sleep(1); \
    if ((++_sp & 255u) == 0u) { if (xb_ld(&(bar)[XB_TMO])) break; if (_sp > XB_SPIN_CAP) { atomicAdd(&(bar)[XB_TMO], 1u); break; } } } } while (0)

struct XcdBarrier {
    unsigned* bar; unsigned x;
    volatile LAS unsigned* st;
};

__device__ __forceinline__ XcdBarrier xcd_barrier_post(unsigned* bar, volatile LAS unsigned* st, const bool leader  ) {
    XcdBarrier b; b.bar = bar; b.x = xb_xcc_id(); b.st = st;
    if (leader) (void)xb_add(&bar[XB_XCNT(b.x)], 1u);
    return b;
}
__device__ __forceinline__ void xcd_barrier_complete(unsigned* bar, unsigned x, unsigned& nloc, unsigned& nx) {
    const unsigned G = gridDim.x * gridDim.y * gridDim.z;
    unsigned sum, cnt, mine, sp = 0u;
    for (;;) {
        sum = 0u; cnt = 0u; mine = 0u;
#pragma unroll
        for (unsigned j = 0; j < 16; ++j) { const unsigned c = xb_ld(&bar[XB_XCNT(j)]); sum += c; cnt += (c > 0u) ? 1u : 0u; mine = (j == x) ? c : mine; }
        if (sum == G) break;
        __builtin_amdgcn_s_sleep(1);
        if ((++sp & 255u) == 0u) { if (xb_ld(&bar[XB_TMO])) break; if (sp > XB_SPIN_CAP) { atomicAdd(&bar[XB_TMO], 1u); break; } }
    }
    nloc = mine > 0u ? mine : 1u; nx = cnt > 0u ? cnt : 1u;
}

__device__ __forceinline__ void xcd_barrier(const XcdBarrier& b, const bool leader  ) {
    asm volatile("s_waitcnt vmcnt(0)" ::: "memory");
    __syncthreads();
    if (leader) {
        unsigned* bar = b.bar;
        __builtin_amdgcn_s_waitcnt(0);
        unsigned nloc = b.st[0], nx = b.st[1];
        if (nloc == 0u) { xcd_barrier_complete(bar, b.x, nloc, nx); b.st[0] = nloc; b.st[1] = nx; }
        const unsigned old = xb_add(&bar[XB_XSUB(b.x)], 1u);
        const unsigned gen = old / nloc;
        if (old + 1u == (gen + 1u) * nloc) {
            __builtin_amdgcn_fence(__ATOMIC_RELEASE, "agent");
            asm volatile("s_waitcnt vmcnt(0)" ::: "memory");
            const unsigned og = xb_add(&bar[XB_TOP], 1u);
            const unsigned tg = og / nx;
            if (og + 1u == (tg + 1u) * nx) xb_add(&bar[XB_TOPGEN], 1u);
            else XB_SPIN(xb_ld(&bar[XB_TOPGEN]) == tg, bar);
            __builtin_amdgcn_fence(__ATOMIC_ACQUIRE, "agent");
            xb_add(&bar[XB_XGEN(b.x)], 1u);
            asm volatile("s_waitcnt vmcnt(0)" ::: "memory");
        } else {
            XB_SPIN(xb_ld(&bar[XB_XGEN(b.x)]) == gen, bar);
            __builtin_amdgcn_fence(__ATOMIC_ACQUIRE, "agent");
            asm volatile("s_waitcnt vmcnt(0)" ::: "memory");
        }
    }
    __syncthreads();
}

constexpr size_t MiB = 1u << 20;
constexpr size_t WS_CTL = 0, CTL_ZERO_BYTES = 1 * MiB;
constexpr size_t WS_WIN = 2 * MiB;
constexpr size_t WS_WOUT = 7 * MiB;
constexpr size_t WS_PGATE = 9 * MiB;
constexpr size_t WS_PPROJ = 13 * MiB;
constexpr size_t WS_RCAT = 14 * MiB;
constexpr size_t WS_RL1 = 20 * MiB;
constexpr size_t WS_RS2 = 28 * MiB;
constexpr size_t WS_RWO = 30 * MiB;
constexpr size_t WS_ROUT = 32 * MiB;
constexpr size_t WS_LRUAGG = 33 * MiB;
constexpr size_t WS_MGU = 38 * MiB;
constexpr size_t WS_MDN = 102 * MiB;
constexpr size_t WS_PB = 134 * MiB;
constexpr size_t WS_ACT = 166 * MiB;
constexpr size_t WS_H0 = WS_ACT;
constexpr size_t WS_QKV = WS_ACT + 128 * MiB;
constexpr size_t WS_O = WS_ACT + 448 * MiB;
constexpr size_t WS_HL = WS_ACT + 576 * MiB, WS_CA = WS_ACT + 640 * MiB;
constexpr size_t WS_H2 = WS_ACT;
constexpr size_t WS_LOG = WS_ACT + 128 * MiB;
constexpr size_t WS_ROUTE = WS_ACT + 144 * MiB;
constexpr size_t WS_HID = WS_ACT + 152 * MiB;
constexpr size_t WS_YS = WS_ACT + 288 * MiB;
constexpr size_t WS_PP = WS_ACT + 128 * MiB;
constexpr size_t WS_HCAT = WS_ACT;
constexpr size_t WS_XR = WS_ACT + 256 * MiB, WS_XK = WS_ACT + 384 * MiB, WS_XV = WS_ACT + 512 * MiB;
constexpr size_t WS_R = WS_ACT + 640 * MiB, WS_K = WS_XR, WS_V = WS_XK;
constexpr size_t WS_MID = WS_ACT + 768 * MiB;
constexpr size_t WS_EW = WS_ACT;
constexpr size_t WS_AA = WS_ACT + 128 * MiB;
constexpr size_t WS_Y = WS_XV;
constexpr size_t WS_END = WS_ACT + 832 * MiB;
static_assert(WS_END <= 1024 * MiB, "workspace map");
constexpr size_t RT_EID = 0, RT_POS = 1 * MiB, RT_GATE = 2 * MiB, RT_ROWTOK = 3 * MiB, RT_ROWGATE = 4 * MiB, RT_SLOT = 5 * MiB;
constexpr int CW_BAR = 4096;
constexpr int CW_CNT0 = 16384, CW_CNT1 = 16384 + 64;

constexpr int RING_BYTES = 131072;
constexpr int LDSCTL_OFF = RING_BYTES, MISC_OFF = LDSCTL_OFF + 320;
constexpr int TB_OFF = RING_BYTES + 1024;
constexpr int RTE_OFF = TB_OFF + 2048;
constexpr int LDS_BYTES = 147456;

constexpr int NWAVES = 8;
__device__ __forceinline__ int lane_id_() { int l; asm volatile("v_mbcnt_lo_u32_b32 %0, -1, 0\n\tv_mbcnt_hi_u32_b32 %0, -1, %0" : "=v"(l)); return l; }
#define TID_ (F.wave * 64 + lane_id_())
#define LANE_ (lane_id_())
struct Frame {
    LAS unsigned char* lds; volatile LAS unsigned* MISC; gu32* ctl;
    int wave, vcu, G;
};

__device__ __forceinline__ void load_row4(const float* xrow, int lane, f32x4 (&v)[4]) { const f32x4* p = (const f32x4*)xrow + lane;
#pragma unroll
    for (int j = 0; j < 4; ++j) v[j] = p[64 * j]; }
__device__ __forceinline__ float row_rstd(const f32x4 (&v)[4], float eps) { float s = 0.f;
#pragma unroll
    for (int j = 0; j < 4; ++j) s += (v[j].x * v[j].x + v[j].y * v[j].y) + (v[j].z * v[j].z + v[j].w * v[j].w);
    return 1.0f / sqrtf(wave_sum(s) * (1.0f / 1024.0f) + eps); }
__device__ __forceinline__ void load_row4_bf(const bf16* xrow, int lane, f32x4 (&v)[4]) { const v2u* p = (const v2u*)xrow + lane;
#pragma unroll
    for (int j = 0; j < 4; ++j) { const v2u w = p[64 * j]; v[j] = (f32x4){bflo(w.x), bfhi(w.x), bflo(w.y), bfhi(w.y)}; } }
__device__ __forceinline__ void store_row4_bf(bf16* xrow, int lane, const f32x4 (&v)[4]) { v2u* p = (v2u*)xrow + lane;
#pragma unroll
    for (int j = 0; j < 4; ++j) { v2u o; o.x = pk2(v[j].x, v[j].y); o.y = pk2(v[j].z, v[j].w); p[64 * j] = o; } }
__device__ __forceinline__ void store_row_bf16(bf16* orow, int lane, const f32x4 (&v)[4], float rstd, const float* g) {
    unsigned long long* o8 = (unsigned long long*)orow + lane;
#pragma unroll
    for (int j = 0; j < 4; ++j) { const f32x4 gg = ((const f32x4*)g)[lane + 64 * j];
        o8[64 * j] = (unsigned long long)pk2(v[j].x * rstd * gg.x, v[j].y * rstd * gg.y) | ((unsigned long long)pk2(v[j].z * rstd * gg.z, v[j].w * rstd * gg.w) << 32); }
}

template <int MODE>
__device__ __forceinline__ void transpose_item(const float* W, int K, int N, bf16* WT, int ldo, int row_off, const float* mu, LAS float* scr, int item, int lane) {
    const int nblk = N / 32, kb = item / nblk, nb = item % nblk, k0 = 64 * kb, n0 = 32 * nb;
    float ld[32];
#pragma unroll
    for (int i = 0; i < 32; ++i) { const int kk = 2 * i + (lane >> 5); ld[i] = W[(size_t)(k0 + kk) * N + n0 + (lane & 31)]; }
#pragma unroll
    for (int i = 0; i < 32; ++i) { const int kk = 2 * i + (lane >> 5); scr[kk * 33 + (lane & 31)] = ld[i]; }
    LDS_WAIT(); asm volatile("" ::: "memory");
    const int c = lane & 7;
    int rbase = row_off + n0;
    if (MODE == 2) { rbase = row_off + ((n0 < 512) ? ((n0 >> 7) * 256 + (n0 & 127)) : (((n0 - 512) >> 7) * 256 + 128 + ((n0 - 512) & 127))); }
    float m[8];
    if (MODE == 1) {
#pragma unroll
        for (int e = 0; e < 8; ++e) m[e] = mu[k0 + 8 * c + e]; }
#pragma unroll
    for (int j = 0; j < 4; ++j) { const int n = (lane >> 3) + 8 * j; const LAS float* s = scr + (8 * c) * 33 + n;
        float v[8];
#pragma unroll
        for (int e = 0; e < 8; ++e) v[e] = s[e * 33];
        bf16* dst = WT + (size_t)(rbase + n) * ldo + k0 + 8 * c;
        if (MODE == 1) {
            v4u o, o2;
            o.x = pk2(v[0] * (1.f - m[0]), v[1] * (1.f - m[1])); o.y = pk2(v[2] * (1.f - m[2]), v[3] * (1.f - m[3])); o.z = pk2(v[4] * (1.f - m[4]), v[5] * (1.f - m[5])); o.w = pk2(v[6] * (1.f - m[6]), v[7] * (1.f - m[7]));
            o2.x = pk2(v[0] * m[0], v[1] * m[1]); o2.y = pk2(v[2] * m[2], v[3] * m[3]); o2.z = pk2(v[4] * m[4], v[5] * m[5]); o2.w = pk2(v[6] * m[6], v[7] * m[7]);
            *(GAS v4u*)dst = o; *(GAS v4u*)(dst + 1024) = o2;
        } else {
            v4u o; o.x = pk2(v[0], v[1]); o.y = pk2(v[2], v[3]); o.z = pk2(v[4], v[5]); o.w = pk2(v[6], v[7]);
            *(GAS v4u*)dst = o; }
    }
    LDS_WAIT(); asm volatile("" ::: "memory");
}

struct In {
    const float *x, *p, *rel_bias, *norm_mix, *ab_w_in, *ab_w_out, *lam_q1, *lam_k1, *lam_q2, *lam_k2, *sub_g, *conv_w, *conv_b, *lru_wa, *lru_ba, *lru_wx, *lru_bx, *lru_lambda,
        *rwkv_mu, *rwkv_wr, *rwkv_wk, *rwkv_wv, *rwkv_wo, *rwkv_w0, *rwkv_w1, *rwkv_w2, *rwkv_a0, *rwkv_a1, *rwkv_a2, *rwkv_g1, *rwkv_g2, *rwkv_kk, *rwkv_ka, *rwkv_rk, *rwkv_ln_g, *rwkv_ln_b,
        *norm_ffn, *moe_wc, *moe_bc, *moe_wf, *moe_bf, *moe_w_gu, *moe_w_down, *ple_norm, *ple_gate, *ple_proj, *final_norm;
};

__device__ __forceinline__ void prep_dense_weights(Frame& F, const In& I, unsigned char* ws) {
    LAS float* scr = (LAS float*)(F.lds + F.wave * 16384);
    const int gw = F.vcu * NWAVES + F.wave, NGW = F.G * NWAVES;
    bf16* WIN = (bf16*)(ws + WS_WIN); bf16* WOUT = (bf16*)(ws + WS_WOUT); bf16* PG = (bf16*)(ws + WS_PGATE); bf16* PPJ = (bf16*)(ws + WS_PPROJ);
    bf16* RCAT = (bf16*)(ws + WS_RCAT); bf16* RL1 = (bf16*)(ws + WS_RL1); bf16* RWO = (bf16*)(ws + WS_RWO);
    constexpr int I_IN = (1024 / 64) * (2560 / 32), I_SQ = (1024 / 64) * (1024 / 32), I_PJ = (256 / 64) * (1024 / 32), I_L64 = (1024 / 64) * (64 / 32), I_L160 = (1024 / 64) * (160 / 32);
    int st = gw;
#define TJOB(MODE, NITEMS, W, K, N, WT, LDO, ROFF, MU) do { for (int it = st; it < (NITEMS); it += NGW) transpose_item<MODE>(W, K, N, WT, LDO, ROFF, MU, scr, it, LANE_); \
        st = (st + NGW - ((NITEMS) % NGW)) % NGW; asm volatile("" : "+s"(st)); } while (0)
    TJOB(0, I_IN, I.ab_w_in, 1024, 2560, WIN, 1024, 0, nullptr);
    TJOB(0, I_SQ, I.ab_w_out, 1024, 1024, WOUT, 1024, 0, nullptr);
    TJOB(0, I_SQ, I.ple_gate, 1024, 1024, PG, 1024, 0, nullptr);
    TJOB(0, I_SQ, I.ple_gate + 1024 * 1024, 1024, 1024, PG + 1024 * 1024, 1024, 0, nullptr);
    TJOB(0, I_SQ, I.rwkv_wo, 1024, 1024, RWO, 1024, 0, nullptr);
    TJOB(0, I_SQ, I.rwkv_wr, 1024, 1024, RCAT, 1024, 0, nullptr);
    TJOB(0, I_SQ, I.rwkv_wk, 1024, 1024, RCAT, 1024, 1024, nullptr);
    TJOB(0, I_SQ, I.rwkv_wv, 1024, 1024, RCAT, 1024, 2048, nullptr);
    TJOB(0, I_PJ, I.ple_proj, 256, 1024, PPJ, 256, 0, nullptr);
    TJOB(0, I_PJ, I.ple_proj + 256 * 1024, 256, 1024, PPJ + 1024 * 256, 256, 0, nullptr);
    TJOB(1, I_L64, I.rwkv_w1, 1024, 64, RL1, 2048, 0, I.rwkv_mu + 1 * 1024);
    TJOB(1, I_L64, I.rwkv_a1, 1024, 64, RL1, 2048, 64, I.rwkv_mu + 4 * 1024);
    TJOB(1, I_L160, I.rwkv_g1, 1024, 160, RL1, 2048, 256, I.rwkv_mu + 5 * 1024);
#undef TJOB
    const int gt = F.vcu * 512 + TID_, NGT = F.G * 512;
    { v4u z = {0u, 0u, 0u, 0u}; const int per_row = 2048 / 8;
      for (int i = gt; i < (128 + 96) * per_row; i += NGT) { int rr = i / per_row, cc = i % per_row; rr = (rr < 128) ? (128 + rr) : (416 + rr - 128); *(GAS v4u*)(RL1 + (size_t)rr * 2048 + cc * 8) = z; } }
    { bf16* S2 = (bf16*)(ws + WS_RS2);
      for (int i = gt; i < 3 * 1024 * 256; i += NGT) { const int ty = i / (1024 * 256), n = (i / 256) & 1023, k = i & 255; float v = 0.f;
          if (ty == 0) { if (k < 64) v = I.rwkv_w2[k * 1024 + n]; } else if (ty == 1) { if (k >= 64 && k < 128) v = I.rwkv_a2[(k - 64) * 1024 + n]; } else { if (k < 160) v = I.rwkv_g2[k * 1024 + n]; }
          S2[i] = (bf16)f2bf(v); } }
    { bf16* RT = (bf16*)(ws + WS_ROUT);
      for (int i = gt; i < 2 * 256 * 1024; i += NGT) { const int l = i / (256 * 1024), n = (i / 1024) & 255, k = i & 1023; float v = 0.f;
          if (n < 4) v = I.moe_wc[(size_t)l * 1024 * 4 + k * 4 + n]; else if (n < 36) v = I.moe_wf[(size_t)l * 1024 * 32 + k * 32 + (n - 4)];
          RT[i] = (bf16)f2bf(v); } }
}
__device__ __forceinline__ void prep_layer_weights(Frame& F, const In& I, unsigned char* ws, int layer) {
    LAS float* scr = (LAS float*)(F.lds + F.wave * 16384);
    const int gw = F.vcu * NWAVES + F.wave, NGW = F.G * NWAVES;
    bf16* MGU = (bf16*)(ws + WS_MGU); bf16* MDN = (bf16*)(ws + WS_MDN);
    const float* wgu = I.moe_w_gu + (size_t)layer * NEXP * 1024 * 1024; const float* wdn = I.moe_w_down + (size_t)layer * NEXP * 512 * 1024;
    constexpr int I_GU = (1024 / 64) * (1024 / 32), I_DN = (512 / 64) * (1024 / 32);
    for (int it = gw; it < NEXP * (I_GU + I_DN); it += NGW) {
        const int e = it / (I_GU + I_DN); int r = it % (I_GU + I_DN);
        if (r < I_GU) transpose_item<2>(wgu + (size_t)e * 1024 * 1024, 1024, 1024, MGU + (size_t)e * 1024 * 1024, 1024, 0, nullptr, scr, r, LANE_);
        else transpose_item<0>(wdn + (size_t)e * 512 * 1024, 512, 1024, MDN + (size_t)e * 1024 * 512, 512, 0, nullptr, scr, r - I_GU, LANE_);
    }
    const int gt = F.vcu * 512 + TID_, NGT = F.G * 512;
    const f32x4* ps = (const f32x4*)(I.p + (size_t)layer * T * PLE); v2u* pd = (v2u*)(ws + WS_PB);
    for (int i = gt; i < T * PLE / 4; i += 4 * NGT) { f32x4 v[4];
#pragma unroll
        for (int r = 0; r < 4; ++r) v[r] = ps[i + r * NGT];
#pragma unroll
        for (int r = 0; r < 4; ++r) { v2u o; o.x = pk2(v[r].x, v[r].y); o.y = pk2(v[r].z, v[r].w); pd[i + r * NGT] = o; } }
}

template <bool XBF>
__device__ __forceinline__ void norm_pass(Frame& F, const void* x, const float* g, bf16* out) {
    const int gw = F.vcu * NWAVES + F.wave, NGW = F.G * NWAVES; const int lane = LANE_;
    for (int t = 4 * gw; t < T; t += 4 * NGW) {
        f32x4 v[4][4];
#pragma unroll
        for (int r = 0; r < 4; ++r) { if (XBF) load_row4_bf((const bf16*)x + (size_t)(t + r) * D, lane, v[r]); else load_row4((const float*)x + (size_t)(t + r) * D, lane, v[r]); }
#pragma unroll
        for (int r = 0; r < 4; ++r) { const float rs = row_rstd(v[r], 1e-6f); store_row_bf16(out + (size_t)(t + r) * D, lane, v[r], rs, g); }
    }
}
__device__ __forceinline__ void rwkv_input_pass(Frame& F, const bf16* x, const float* g, const float* mu, bf16* HCAT, bf16* XR, bf16* XK, bf16* XV) {
    const int gw = F.vcu * NWAVES + F.wave, NGW = F.G * NWAVES; const int lane = LANE_;
    f32x4 gg[4], mr[4], mk[4], mv[4];
#pragma unroll
    for (int j = 0; j < 4; ++j) { gg[j] = ((const f32x4*)g)[lane + 64 * j]; mr[j] = ((const f32x4*)(mu + 0 * 1024))[lane + 64 * j]; mk[j] = ((const f32x4*)(mu + 2 * 1024))[lane + 64 * j]; mv[j] = ((const f32x4*)(mu + 3 * 1024))[lane + 64 * j]; }
    for (int blk = gw; blk < T / 32; blk += NGW) {
        const int t0 = blk * 32; f32x4 hp[4];
        if ((t0 & (SEQ - 1)) == 0) {
#pragma unroll
            for (int j = 0; j < 4; ++j) hp[j] = (f32x4){0.f, 0.f, 0.f, 0.f};
        } else { f32x4 v[4]; load_row4_bf(x + (size_t)(t0 - 1) * D, lane, v); const float rstd = row_rstd(v, 1e-6f);
#pragma unroll
            for (int j = 0; j < 4; ++j) hp[j] = v[j] * rstd * gg[j]; }
        f32x4 vn[4]; load_row4_bf(x + (size_t)t0 * D, lane, vn);
        for (int t = t0; t < t0 + 32; ++t) {
            f32x4 v[4];
#pragma unroll
            for (int j = 0; j < 4; ++j) v[j] = vn[j];
            if (t + 1 < t0 + 32) load_row4_bf(x + (size_t)(t + 1) * D, lane, vn);
            const float rstd = row_rstd(v, 1e-6f);
            unsigned long long* oh = (unsigned long long*)(HCAT + (size_t)t * 2048) + lane; unsigned long long* or_ = (unsigned long long*)(XR + (size_t)t * 1024) + lane;
            unsigned long long* ok = (unsigned long long*)(XK + (size_t)t * 1024) + lane; unsigned long long* ov = (unsigned long long*)(XV + (size_t)t * 1024) + lane;
#pragma unroll
            for (int j = 0; j < 4; ++j) { const f32x4 h = v[j] * rstd * gg[j], dd = hp[j] - h;
                oh[64 * j] = (unsigned long long)pk2(h.x, h.y) | ((unsigned long long)pk2(h.z, h.w) << 32);
                oh[256 + 64 * j] = (unsigned long long)pk2(hp[j].x, hp[j].y) | ((unsigned long long)pk2(hp[j].z, hp[j].w) << 32);
                const f32x4 a = h + dd * mr[j], b = h + dd * mk[j], c = h + dd * mv[j];
                or_[64 * j] = (unsigned long long)pk2(a.x, a.y) | ((unsigned long long)pk2(a.z, a.w) << 32);
                ok[64 * j] = (unsigned long long)pk2(b.x, b.y) | ((unsigned long long)pk2(b.z, b.w) << 32);
                ov[64 * j] = (unsigned long long)pk2(c.x, c.y) | ((unsigned long long)pk2(c.z, c.w) << 32);
                hp[j] = h; }
        }
    }
}
__device__ __forceinline__ void combine_norm_pass(Frame& F, const bf16* xin, bf16* xout, const bf16* YS, const int* slot, const float* g, bf16* out) {
    const int gw = F.vcu * NWAVES + F.wave, NGW = F.G * NWAVES; const int lane = LANE_;
    for (int t = 2 * gw; t < T; t += 2 * NGW) {
        f32x4 v[2][4]; v2u ya[2][4], yb[2][4];
#pragma unroll
        for (int r = 0; r < 2; ++r) { load_row4_bf(xin + (size_t)(t + r) * D, lane, v[r]);
            const int s0 = slot[2 * (t + r)], s1 = slot[2 * (t + r) + 1];
            const v2u* y0 = (const v2u*)(YS + (size_t)s0 * D) + lane; const v2u* y1 = (const v2u*)(YS + (size_t)s1 * D) + lane;
#pragma unroll
            for (int j = 0; j < 4; ++j) { ya[r][j] = y0[64 * j]; yb[r][j] = y1[64 * j]; } }
#pragma unroll
        for (int r = 0; r < 2; ++r) {
#pragma unroll
            for (int j = 0; j < 4; ++j) { const v2u a = ya[r][j], b = yb[r][j];
                v[r][j].x += bflo(a.x) + bflo(b.x); v[r][j].y += bfhi(a.x) + bfhi(b.x); v[r][j].z += bflo(a.y) + bflo(b.y); v[r][j].w += bfhi(a.y) + bfhi(b.y); }
            store_row4_bf(xout + (size_t)(t + r) * D, lane, v[r]);
            const float rstd = row_rstd(v[r], 1e-6f);
            store_row_bf16(out + (size_t)(t + r) * D, lane, v[r], rstd, g); }
    }
}
__device__ __forceinline__ void final_norm_pass(Frame& F, const bf16* x, float* out, const float* g) {
    const int gw = F.vcu * NWAVES + F.wave, NGW = F.G * NWAVES; const int lane = LANE_;
    for (int t = 4 * gw; t < T; t += 4 * NGW) {
        f32x4 v[4][4];
#pragma unroll
        for (int r = 0; r < 4; ++r) load_row4_bf(x + (size_t)(t + r) * D, lane, v[r]);
#pragma unroll
        for (int r = 0; r < 4; ++r) { const float rs = row_rstd(v[r], 1e-6f); f32x4* xo = (f32x4*)(out + (size_t)(t + r) * D) + lane;
#pragma unroll
            for (int j = 0; j < 4; ++j) { const f32x4 gg = ((const f32x4*)g)[lane + 64 * j]; xo[64 * j] = v[r][j] * rs * gg; } }
    }
}

__device__ __forceinline__ void diff_combine_pass(Frame& F, const In& I, const bf16* O, bf16* YCAT) {
    const int gw = F.vcu * NWAVES + F.wave, NGW = F.G * NWAVES;
    const float lam_init = 0.2f;
    const float d1 = wave_sum(I.lam_q1[LANE_] * I.lam_k1[LANE_]), d2 = wave_sum(I.lam_q2[LANE_] * I.lam_k2[LANE_]);
    const float lam = expf(d1) - expf(d2) + lam_init;
    const int h = LANE_ >> 4, q = LANE_ & 15;
    float sg[8];
#pragma unroll
    for (int e = 0; e < 8; ++e) sg[e] = I.sub_g[q * 8 + e] * (1.0f - lam_init);
    for (int t0 = 4 * gw; t0 < T; t0 += 4 * NGW) {
        v4u av[4], bv[4];
#pragma unroll
        for (int r = 0; r < 4; ++r) { av[r] = *(const v4u*)(O + (size_t)(t0 + r) * 1024 + h * 256 + q * 8); bv[r] = *(const v4u*)(O + (size_t)(t0 + r) * 1024 + h * 256 + 128 + q * 8); }
#pragma unroll
        for (int r = 0; r < 4; ++r) { const v4u a = av[r], b = bv[r]; const int t = t0 + r;
        float o[8];
        o[0] = bflo(a.x) - lam * bflo(b.x); o[1] = bfhi(a.x) - lam * bfhi(b.x); o[2] = bflo(a.y) - lam * bflo(b.y); o[3] = bfhi(a.y) - lam * bfhi(b.y);
        o[4] = bflo(a.z) - lam * bflo(b.z); o[5] = bfhi(a.z) - lam * bfhi(b.z); o[6] = bflo(a.w) - lam * bflo(b.w); o[7] = bfhi(a.w) - lam * bfhi(b.w);
        float s = 0.f;
#pragma unroll
        for (int e = 0; e < 8; ++e) s += o[e] * o[e];
        s += __shfl_xor(s, 1); s += __shfl_xor(s, 2); s += __shfl_xor(s, 4); s += __shfl_xor(s, 8);
        const float rstd = 1.0f / sqrtf(s * (1.0f / 128.0f) + 1e-5f);
        v4u w; w.x = pk2(o[0] * rstd * sg[0], o[1] * rstd * sg[1]); w.y = pk2(o[2] * rstd * sg[2], o[3] * rstd * sg[3]); w.z = pk2(o[4] * rstd * sg[4], o[5] * rstd * sg[5]); w.w = pk2(o[6] * rstd * sg[6], o[7] * rstd * sg[7]);
        *(v4u*)(YCAT + (size_t)t * 1024 + h * 128 + q * 8) = w; }
    }
}

constexpr int LCT = 64, LNCH = SEQ / LCT;
__device__ __forceinline__ float gelu_tanh(float x) { const float u = 0.7978845608028654f * (x + 0.044715f * x * x * x); return x * sigmoidf_(2.0f * u); }
template <bool FINAL>
__device__ __forceinline__ void lru_phase(Frame& F, const In& I, const bf16* XB, const bf16* GB, f32x2* AGG, bf16* YCAT, bf16* HLp, bf16* CAp) {
    const int ch = TID_, n = ch >> 6, d = ch & 63;
    LAS float* U = (LAS float*)F.lds;
    f32x2 wg[64];
#pragma unroll
    for (int c = 0; c < 64; ++c) { wg[c].x = I.lru_wa[n * 4096 + c * 64 + d]; wg[c].y = I.lru_wx[n * 4096 + c * 64 + d]; }
    const float cw0 = I.conv_w[0 * 512 + ch], cw1 = I.conv_w[1 * 512 + ch], cw2 = I.conv_w[2 * 512 + ch], cw3 = I.conv_w[3 * 512 + ch], cb = I.conv_b[ch];
    const float ba = I.lru_ba[ch], bx = I.lru_bx[ch];
    const float lam = I.lru_lambda[ch]; const float sp = (lam > 15.f) ? expf(-lam) : log1pf(expf(-lam));
    const float m8sp = -8.0f * sp;
    for (int un = blockIdx.x; un < NB * LNCH; un += F.G) {
        const int b = un / LNCH, c = un % LNCH; const size_t row0 = (size_t)b * SEQ + (size_t)c * LCT;
        unsigned short xraw[LCT + 3];
        if (c > 0) { xraw[0] = XB[(row0 - 3) * 512 + ch]; xraw[1] = XB[(row0 - 2) * 512 + ch]; xraw[2] = XB[(row0 - 1) * 512 + ch]; } else { xraw[0] = 0; xraw[1] = 0; xraw[2] = 0; }
#pragma unroll
        for (int tk = 0; tk < LCT; ++tk) xraw[3 + tk] = XB[(row0 + tk) * 512 + ch];
        float h = 0.f, Ap = 1.f;
        if (FINAL) { for (int j = 0; j < c; ++j) { const f32x2 ag = AGG[((size_t)b * LNCH + j) * 512 + ch]; h = ag.x * h + ag.y; } }
#pragma unroll
        for (int tk = 0; tk < LCT; ++tk) U[tk * 512 + ch] = cw0 * bf1(xraw[tk]) + cw1 * bf1(xraw[tk + 1]) + cw2 * bf1(xraw[tk + 2]) + cw3 * bf1(xraw[tk + 3]) + cb;
        __syncthreads();
        unsigned short gcur[8], gnxt[8];
        if (FINAL) {
#pragma unroll
            for (int j = 0; j < 8; ++j) gcur[j] = GB[(row0 + j) * 512 + ch]; }
#pragma unroll 1
        for (int tg = 0; tg < LCT / 8; ++tg) {
            if (FINAL) { const int tn = (tg + 1 < LCT / 8) ? (tg + 1) * 8 : tg * 8;
#pragma unroll
                for (int j = 0; j < 8; ++j) gnxt[j] = GB[(row0 + tn + j) * 512 + ch]; }
#pragma unroll
            for (int j = 0; j < 8; ++j) { const int tk = tg * 8 + j;
                const LAS f32x4* up = (const LAS f32x4*)(U + tk * 512 + n * 64);
                f32x2 acc = {ba, bx};
#pragma unroll
                for (int c4 = 0; c4 < 16; ++c4) { const f32x4 uu = up[c4];
                    acc += wg[4 * c4 + 0] * uu.x; acc += wg[4 * c4 + 1] * uu.y; acc += wg[4 * c4 + 2] * uu.z; acc += wg[4 * c4 + 3] * uu.w; }
                const float r = sigmoidf_(acc.x), ig = sigmoidf_(acc.y);
                const float la = r * m8sp; const float a = __expf(la); const float t2 = 2.0f * la; const float om = (t2 > -0.02f) ? -t2 * (1.0f + t2 * (0.5f + t2 * (0.16666667f + t2 * 0.041666668f))) : 1.0f - a * a; const float bb = __builtin_amdgcn_sqrtf(om) * (ig * U[tk * 512 + ch]);
                h = a * h + bb;
                if (FINAL) { YCAT[(row0 + tk) * 1024 + 512 + ch] = (bf16)f2bf(h * gelu_tanh(bf1(gcur[j]))); }
                else { Ap *= a; HLp[(row0 + tk) * 512 + ch] = (bf16)f2bf(h); CAp[(row0 + tk) * 512 + ch] = (bf16)f2bf(Ap); } }
            if (FINAL) {
#pragma unroll
                for (int j = 0; j < 8; ++j) gcur[j] = gnxt[j]; }
        }
        if (!FINAL) { f32x2 ag; ag.x = Ap; ag.y = h; AGG[((size_t)b * LNCH + c) * 512 + ch] = ag; }
        __syncthreads();
    }
}

__device__ __forceinline__ void lru_agg_mfma(Frame& F, const In& I, const bf16* XB, f32x2* AGG, bf16* HLp, bf16* CAp) {
    const int tid = TID_, lane = tid & 63, fr = lane & 15, fq = lane >> 4, n = F.wave, ch = tid;
    constexpr int UP = 520;
    LAS bf16* U = (LAS bf16*)F.lds;
    bf16x8 Wr[4][2], Wi[4][2];
#pragma unroll
    for (int dd = 0; dd < 4; ++dd)
#pragma unroll
        for (int kh = 0; kh < 2; ++kh) { unsigned pr_[4], pi_[4];
#pragma unroll
            for (int j = 0; j < 4; ++j) { const int c0 = 32 * kh + 8 * fq + 2 * j, d = 16 * dd + fr;
                pr_[j] = pk2(I.lru_wa[n * 4096 + c0 * 64 + d], I.lru_wa[n * 4096 + (c0 + 1) * 64 + d]); pi_[j] = pk2(I.lru_wx[n * 4096 + c0 * 64 + d], I.lru_wx[n * 4096 + (c0 + 1) * 64 + d]); }
            Wr[dd][kh] = __builtin_bit_cast(bf16x8, (v4u){pr_[0], pr_[1], pr_[2], pr_[3]}); Wi[dd][kh] = __builtin_bit_cast(bf16x8, (v4u){pi_[0], pi_[1], pi_[2], pi_[3]}); }
    float cba[4], cbx[4], cm8[4];
#pragma unroll
    for (int dd = 0; dd < 4; ++dd) { const int chd = 64 * n + 16 * dd + fr; cba[dd] = I.lru_ba[chd]; cbx[dd] = I.lru_bx[chd];
        const float lam = I.lru_lambda[chd]; cm8[dd] = -8.0f * ((lam > 15.f) ? expf(-lam) : log1pf(expf(-lam))); }
    const float cw0 = I.conv_w[0 * 512 + ch], cw1 = I.conv_w[1 * 512 + ch], cw2 = I.conv_w[2 * 512 + ch], cw3 = I.conv_w[3 * 512 + ch], cb = I.conv_b[ch];
    for (int un = blockIdx.x; un < NB * LNCH; un += F.G) {
        const int b = un / LNCH, c = un % LNCH; const size_t row0 = (size_t)b * SEQ + (size_t)c * LCT;
        unsigned short xraw[LCT + 3];
        if (c > 0) { xraw[0] = XB[(row0 - 3) * 512 + ch]; xraw[1] = XB[(row0 - 2) * 512 + ch]; xraw[2] = XB[(row0 - 1) * 512 + ch]; } else { xraw[0] = 0; xraw[1] = 0; xraw[2] = 0; }
#pragma unroll
        for (int tk = 0; tk < LCT; ++tk) xraw[3 + tk] = XB[(row0 + tk) * 512 + ch];
#pragma unroll
        for (int tk = 0; tk < LCT; ++tk) U[tk * UP + ch] = (bf16)f2bf(cw0 * bf1(xraw[tk]) + cw1 * bf1(xraw[tk + 1]) + cw2 * bf1(xraw[tk + 2]) + cw3 * bf1(xraw[tk + 3]) + cb);
        __syncthreads();
        bf16x8 X[4][2];
#pragma unroll
        for (int tt = 0; tt < 4; ++tt)
#pragma unroll
            for (int kh = 0; kh < 2; ++kh) X[tt][kh] = *(const LAS bf16x8*)(U + (16 * tt + fr) * UP + 64 * n + 32 * kh + 8 * fq);
#pragma unroll 1
        for (int dd = 0; dd < 4; ++dd) {
            bf16x8 wr0, wr1, wi0, wi1; float kba, kbx, km8;
            if (dd == 0) { wr0 = Wr[0][0]; wr1 = Wr[0][1]; wi0 = Wi[0][0]; wi1 = Wi[0][1]; kba = cba[0]; kbx = cbx[0]; km8 = cm8[0]; }
            else if (dd == 1) { wr0 = Wr[1][0]; wr1 = Wr[1][1]; wi0 = Wi[1][0]; wi1 = Wi[1][1]; kba = cba[1]; kbx = cbx[1]; km8 = cm8[1]; }
            else if (dd == 2) { wr0 = Wr[2][0]; wr1 = Wr[2][1]; wi0 = Wi[2][0]; wi1 = Wi[2][1]; kba = cba[2]; kbx = cbx[2]; km8 = cm8[2]; }
            else { wr0 = Wr[3][0]; wr1 = Wr[3][1]; wi0 = Wi[3][0]; wi1 = Wi[3][1]; kba = cba[3]; kbx = cbx[3]; km8 = cm8[3]; }
            const int chd = 64 * n + 16 * dd + fr;
            float hc = 0.f, Ac = 1.f;
#pragma unroll
            for (int tt = 0; tt < 4; ++tt) {
                f32x4 pr = (f32x4){0.f, 0.f, 0.f, 0.f}, pi = pr;
                pr = __builtin_amdgcn_mfma_f32_16x16x32_bf16(X[tt][0], wr0, pr, 0, 0, 0); pr = __builtin_amdgcn_mfma_f32_16x16x32_bf16(X[tt][1], wr1, pr, 0, 0, 0);
                pi = __builtin_amdgcn_mfma_f32_16x16x32_bf16(X[tt][0], wi0, pi, 0, 0, 0); pi = __builtin_amdgcn_mfma_f32_16x16x32_bf16(X[tt][1], wi1, pi, 0, 0, 0);
                float a[4], bb[4];
#pragma unroll
                for (int e = 0; e < 4; ++e) { const int tok = 16 * tt + 4 * fq + e; const float u = bf1(U[tok * UP + chd]);
                    const float r = sigmoidf_(pr[e] + kba), ig = sigmoidf_(pi[e] + kbx); const float la = r * km8; a[e] = __expf(la); const float t2 = 2.0f * la;
                    const float om = (t2 > -0.02f) ? -t2 * (1.0f + t2 * (0.5f + t2 * (0.16666667f + t2 * 0.041666668f))) : 1.0f - a[e] * a[e]; bb[e] = __builtin_amdgcn_sqrtf(om) * (ig * u); }
                const float A4 = (a[0] * a[1]) * (a[2] * a[3]); const float B4 = ((bb[0] * a[1] + bb[1]) * a[2] + bb[2]) * a[3] + bb[3];
                float h = hc, Ap = Ac, hs = hc, As = Ac;
#pragma unroll
                for (int j = 0; j < 4; ++j) { const float Aj = __shfl(A4, fr + 16 * j), Bj = __shfl(B4, fr + 16 * j); if (j == fq) { hs = h; As = Ap; } h = Aj * h + Bj; Ap *= Aj; }
                hc = h; Ac = Ap; h = hs; Ap = As;
#pragma unroll
                for (int e = 0; e < 4; ++e) { h = a[e] * h + bb[e]; Ap *= a[e]; const size_t o = (row0 + 16 * tt + 4 * fq + e) * 512 + chd; HLp[o] = (bf16)f2bf(h); CAp[o] = (bf16)f2bf(Ap); }
            }
            if (fq == 0) { f32x2 ag; ag.x = Ac; ag.y = hc; AGG[((size_t)b * LNCH + c) * 512 + chd] = ag; }
        }
        __syncthreads();
    }
}

__device__ __forceinline__ void lru_final_pass(Frame& F, const bf16* HLp, const bf16* CAp, const bf16* GB, const f32x2* AGG, bf16* YCAT) {
    const int ch = TID_;
    for (int un = blockIdx.x; un < NB * LNCH; un += F.G) {
        const int b = un / LNCH, c = un % LNCH; const size_t row0 = (size_t)b * SEQ + (size_t)c * LCT;
        float carry = 0.f;
        for (int j = 0; j < c; ++j) { const f32x2 ag = AGG[((size_t)b * LNCH + j) * 512 + ch]; carry = ag.x * carry + ag.y; }
#pragma unroll 4
        for (int t8 = 0; t8 < LCT; t8 += 8) {
            bf16 hl[8], ca[8], gv[8];
#pragma unroll
            for (int j = 0; j < 8; ++j) { const size_t o = (row0 + t8 + j) * 512 + ch; hl[j] = HLp[o]; ca[j] = CAp[o]; gv[j] = GB[o]; }
#pragma unroll
            for (int j = 0; j < 8; ++j) { const float h = bf1(hl[j]) + bf1(ca[j]) * carry; YCAT[(row0 + t8 + j) * 1024 + 512 + ch] = (bf16)f2bf(h * gelu_tanh(bf1(gv[j]))); }
        }
    }
}

__device__ __forceinline__ void route_pass_a(Frame& F, const In& I, int layer, const float* LOG, unsigned char* rt, gu32* cnt) {
    LAS int* lcnt = (LAS int*)(F.lds + RTE_OFF); LAS int* lbase = lcnt + 32;
    int* EID = (int*)(rt + RT_EID); int* POS = (int*)(rt + RT_POS); float* GATE = (float*)(rt + RT_GATE);
    const float* bc = I.moe_bc + layer * 4; const float* bfb = I.moe_bf + layer * 32;
    for (int un = blockIdx.x; un < T / 512; un += F.G) {
        if (TID_ < 32) lcnt[TID_] = 0;
        __syncthreads();
        const int t = un * 512 + TID_; const float* lg = LOG + (size_t)t * 64;
        const f32x4 g4 = *(const f32x4*)lg;
        float gl[4] = {g4.x + bc[0], g4.y + bc[1], g4.z + bc[2], g4.w + bc[3]};
        int gi = 0; float gm = gl[0];
#pragma unroll
        for (int j = 1; j < 4; ++j) if (gl[j] > gm) { gm = gl[j]; gi = j; }
        float gs = 0.f;
#pragma unroll
        for (int j = 0; j < 4; ++j) gs += __expf(gl[j] - gm);
        const float gprob = 1.0f / gs;
        const f32x4 e0 = *(const f32x4*)(lg + 4 + gi * 8), e1 = *(const f32x4*)(lg + 8 + gi * 8);
        float el[8] = {e0.x, e0.y, e0.z, e0.w, e1.x, e1.y, e1.z, e1.w};
#pragma unroll
        for (int j = 0; j < 8; ++j) el[j] += bfb[gi * 8 + j];
        int i0 = 0; float m0 = el[0];
#pragma unroll
        for (int j = 1; j < 8; ++j) if (el[j] > m0) { m0 = el[j]; i0 = j; }
        int i1 = -1; float m1 = -INFINITY;
#pragma unroll
        for (int j = 0; j < 8; ++j) if (j != i0 && el[j] > m1) { m1 = el[j]; i1 = j; }
        const float r1 = __expf(m1 - m0); const float g0 = gprob / (1.0f + r1), g1 = gprob * r1 / (1.0f + r1);
        const int ex0 = gi * 8 + i0, ex1 = gi * 8 + i1;
        const int p0 = atomicAdd((int*)&lcnt[ex0], 1), p1 = atomicAdd((int*)&lcnt[ex1], 1);
        __syncthreads();
        if (TID_ < 32) lbase[TID_] = (int)__hip_atomic_fetch_add(cnt + TID_, (unsigned)lcnt[TID_], RLX_AGENT);
        __syncthreads();
        EID[2 * t] = ex0; EID[2 * t + 1] = ex1; POS[2 * t] = lbase[ex0] + p0; POS[2 * t + 1] = lbase[ex1] + p1; GATE[2 * t] = g0; GATE[2 * t + 1] = g1;
        __syncthreads();
    }
}
__device__ __forceinline__ void route_bases(Frame& F, gu32* cnt) {
    LAS int* eb = (LAS int*)(F.lds + RTE_OFF + 512);
    const int tid = TID_;
    if (tid < 64) {
        const int c = (tid < 32) ? (int)__hip_atomic_load(cnt + (tid & 31), RLX_AGENT) : 0; const int p = (c + 255) & ~255; int s = p;
#pragma unroll
        for (int o = 1; o < 32; o <<= 1) { const int t = __shfl_up(s, o); if ((tid & 63) >= o) s += t; }
        if (tid < 32) { eb[tid] = s - p; if (tid == 31) eb[32] = s; }
    }
    __syncthreads();
}
__device__ __forceinline__ void route_pass_b(Frame& F, unsigned char* rt, gu32* cnt) {
    route_bases(F, cnt);
    LAS int* eb = (LAS int*)(F.lds + RTE_OFF + 512);
    const int* EID = (const int*)(rt + RT_EID); const int* POS = (const int*)(rt + RT_POS); const float* GATE = (const float*)(rt + RT_GATE);
    int* ROWTOK = (int*)(rt + RT_ROWTOK); float* ROWGATE = (float*)(rt + RT_ROWGATE); int* SLOT = (int*)(rt + RT_SLOT);
    const int gt = F.vcu * 512 + TID_, NGT = F.G * 512;
    for (int i = gt; i < 2 * T; i += NGT) { const int dst = eb[EID[i]] + POS[i]; ROWTOK[dst] = i >> 1; ROWGATE[dst] = GATE[i]; SLOT[i] = dst; }
    for (int i = gt; i < 32 * 256; i += NGT) { const int e = i >> 8, j = i & 255; const int c = (int)__hip_atomic_load(cnt + e, RLX_AGENT); const int pad = ((c + 255) & ~255) - c;
        if (j < pad) { ROWTOK[eb[e] + c + j] = 0; ROWGATE[eb[e] + c + j] = 0.f; } }
    __syncthreads();
}
struct MoeOrder {
    int G, c, ntiles; const LAS int* eb; const char* A; const char* W; size_t astep, wexp, wtile; bool gather;
    __device__ bool next(int i, pg8::Unit& u) const {
        const int L = i * G + c; if (L >= ntiles * 4) return false;
        u.pm = L >> 2; u.pn = L & 3; const int s0 = u.pm * 256; int e = 0;
#pragma unroll 1
        for (int j = 1; j < 32; ++j) if (eb[j] <= s0) e = j;
        e = __builtin_amdgcn_readfirstlane(e); u.aux = e; u.A = gather ? A : A + (size_t)u.pm * astep; u.B = W + (size_t)e * wexp + (size_t)u.pn * wtile; return true;
    }
};

constexpr int RTC = 32, RNCH = SEQ / RTC, RTOK = 352;
#define LBAR() do { asm volatile("s_waitcnt lgkmcnt(0)" ::: "memory"); __builtin_amdgcn_s_barrier(); asm volatile("" ::: "memory"); } while (0)
template <int CTRL> __device__ __forceinline__ float dpp_f(float v) { return __builtin_bit_cast(float, __builtin_amdgcn_update_dpp(0, __builtin_bit_cast(int, v), CTRL, 0xf, 0xf, true)); }
__device__ __forceinline__ float red16(float v) { v += dpp_f<0xB1>(v); v += dpp_f<0x4E>(v); v += dpp_f<0x141>(v); v += dpp_f<0x140>(v); return v; }
__device__ __forceinline__ float red8(float v) { v += dpp_f<0xB1>(v); v += dpp_f<0x4E>(v); v += dpp_f<0x141>(v); return v; }
__device__ __forceinline__ void unpack8(const v4u w, float (&f)[8]) { f[0] = bflo(w.x); f[1] = bfhi(w.x); f[2] = bflo(w.y); f[3] = bfhi(w.y); f[4] = bflo(w.z); f[5] = bfhi(w.z); f[6] = bflo(w.w); f[7] = bfhi(w.w); }
__device__ __forceinline__ void rwkv_scan_phase(Frame& F, const In& I, const bf16* R, const bf16* Kt, const bf16* V, const bf16* AA, const bf16* EW, bf16* Y) {
    LAS float* buf = (LAS float*)F.lds;
    LAS float* ybuf = (LAS float*)(F.lds + 2 * RTC * RTOK * 4) + 32;
    const int tid = TID_, lane = tid & 63;
    const int seg = lane & 15, rl = F.wave * 4 + (lane >> 4);
    const int stk = tid >> 4, ssg = tid & 15;
    for (int un = blockIdx.x; un < NB * 16 * 2; un += F.G) {
        const int half = un & 1, h = (un >> 1) & 15, b = un >> 5;
        const size_t rowb = (size_t)b * SEQ;
        const int col = h * 64 + ssg * 4;
        const f32x4 kkw = *(const f32x4*)(I.rwkv_kk + col), kaw = *(const f32x4*)(I.rwkv_ka + col);
        v2u rr, kr, vr, ar, er;
#define RAW_LOAD(cc) do { const size_t off = (rowb + (size_t)(cc) * RTC + stk) * 1024 + col; rr = *(const v2u*)(R + off); kr = *(const v2u*)(Kt + off); vr = *(const v2u*)(V + off); ar = *(const v2u*)(AA + off); er = *(const v2u*)(EW + off); } while (0)
#define RAW_CONVERT(cc) do { LAS float* tp = buf + ((cc) & 1) * (RTC * RTOK) + stk * RTOK + ssg * 4; \
            const float r0 = bflo(rr.x), r1 = bfhi(rr.x), r2 = bflo(rr.y), r3 = bfhi(rr.y), k0 = bflo(kr.x), k1 = bfhi(kr.x), k2 = bflo(kr.y), k3 = bfhi(kr.y); \
            const float a0 = bflo(ar.x), a1 = bfhi(ar.x), a2 = bflo(ar.y), a3 = bfhi(ar.y); \
            const float x0 = k0 * kkw.x, x1 = k1 * kkw.y, x2 = k2 * kkw.z, x3 = k3 * kkw.w; \
            const float ss = red16((x0 * x0 + x1 * x1) + (x2 * x2 + x3 * x3)); const float inv = __builtin_amdgcn_rsqf(fmaxf(ss, 1e-24f)); \
            *(LAS f32x4*)(tp) = (f32x4){__expf(-bflo(er.x)), __expf(-bfhi(er.x)), __expf(-bflo(er.y)), __expf(-bfhi(er.y))}; \
            const f32x4 kkv = (f32x4){x0 * inv, x1 * inv, x2 * inv, x3 * inv}; *(LAS f32x4*)(tp + 64) = kkv; \
            *(LAS f32x4*)(tp + 128) = (f32x4){kkv.x * a0, kkv.y * a1, kkv.z * a2, kkv.w * a3}; \
            *(LAS f32x4*)(tp + 192) = (f32x4){k0 * (1.0f + (a0 - 1.0f) * kaw.x), k1 * (1.0f + (a1 - 1.0f) * kaw.y), k2 * (1.0f + (a2 - 1.0f) * kaw.z), k3 * (1.0f + (a3 - 1.0f) * kaw.w)}; \
            *(LAS f32x4*)(tp + 256) = (f32x4){r0, r1, r2, r3}; \
            if ((ssg >> 3) == half) *(LAS f32x4*)(buf + ((cc) & 1) * (RTC * RTOK) + stk * RTOK + 320 + (ssg & 7) * 4) = (f32x4){bflo(vr.x), bfhi(vr.x), bflo(vr.y), bfhi(vr.y)}; } while (0)
#define Y_WRITE(cc) do { const LAS f32x2* yp = (const LAS f32x2*)(ybuf + ((cc) & 1) * (RTC * 32 + 32) + stk * 32 + ssg * 2); const f32x2 yv = *yp; \
            *(unsigned*)(Y + (rowb + (size_t)(cc) * RTC + stk) * 1024 + h * 64 + half * 32 + ssg * 2) = pk2(yv.x, yv.y); } while (0)
        RAW_LOAD(0); RAW_CONVERT(0); RAW_LOAD(1);
        f32x2 S0 = (f32x2){0.f, 0.f}, S1 = (f32x2){0.f, 0.f};
        LBAR();
        for (int c = 0; c < RNCH; ++c) {
            if (c + 1 < RNCH) { RAW_CONVERT(c + 1); }
            if (c + 2 < RNCH) { RAW_LOAD(c + 2); }
            if (c >= 1) { Y_WRITE(c - 1); }
            const LAS float* cb = buf + (c & 1) * (RTC * RTOK); LAS float* yb = ybuf + (c & 1) * (RTC * 32 + 32);
            const LAS float* tp0 = cb + seg * 4; const LAS float* vp0 = cb + 320 + rl;
#define SV_DECL(X) f32x4 X##w, X##q, X##b, X##k, X##r; float X##v
#define SV_LOAD(X, tk) do { const LAS float* tp = tp0 + (tk) * RTOK; \
                X##w = *(const LAS f32x4*)(tp); X##q = *(const LAS f32x4*)(tp + 64); X##b = *(const LAS f32x4*)(tp + 128); X##k = *(const LAS f32x4*)(tp + 192); X##r = *(const LAS f32x4*)(tp + 256); X##v = vp0[(tk) * RTOK]; } while (0)
#define SV_STEP(X, tk) do { \
                const f32x2 d = S0 * (f32x2){X##q.x, X##q.y} + S1 * (f32x2){X##q.z, X##q.w}; \
                const f32x2 t0 = S0 * (f32x2){X##w.x, X##w.y} + (f32x2){X##k.x, X##k.y} * X##v, t1 = S1 * (f32x2){X##w.z, X##w.w} + (f32x2){X##k.z, X##k.w} * X##v; \
                float ra = d.x + d.y, rb = epend;                   \
                ra += dpp_f<0xB1>(ra); rb += dpp_f<0xB1>(rb); ra += dpp_f<0x4E>(ra); rb += dpp_f<0x4E>(rb); ra += dpp_f<0x141>(ra); rb += dpp_f<0x141>(rb); ra += dpp_f<0x140>(ra); rb += dpp_f<0x140>(rb); \
                if (seg == 0) yb[((tk) - 1) * 32 + rl] = rb;        \
                const float sa = -ra; \
                S0 = t0 + (f32x2){X##b.x, X##b.y} * sa; S1 = t1 + (f32x2){X##b.z, X##b.w} * sa; \
                const f32x2 e = S0 * (f32x2){X##r.x, X##r.y} + S1 * (f32x2){X##r.z, X##r.w}; epend = e.x + e.y; } while (0)
            SV_DECL(A_); SV_DECL(B_); float epend = 0.f;
            SV_LOAD(A_, 0);
#pragma unroll 1
            for (int tk = 0; tk < RTC; tk += 2) {
                SV_LOAD(B_, tk + 1);
                SV_STEP(A_, tk);
                { const int t2 = (tk + 2 < RTC) ? tk + 2 : RTC - 1; SV_LOAD(A_, t2); }
                SV_STEP(B_, tk + 1);
            }
#undef SV_DECL
#undef SV_LOAD
#undef SV_STEP
            { const float rb = red16(epend); if (seg == 0) yb[(RTC - 1) * 32 + rl] = rb; }
            LBAR();
        }
        Y_WRITE(RNCH - 1);
        LBAR();
#undef RAW_LOAD
#undef RAW_CONVERT
#undef Y_WRITE
    }
}
constexpr int GS_QT = 0, GS_RT = 2048, GS_BHT = 4096, GS_KHT = 6144, GS_VT = 8192, GS_TM = 10240, GS_TL = 10752, GS_MK = 11264, GS_NK = 11776, GS_NB = 12288, GS_DD = 12800, GS_SLOT = 13056;
constexpr int GS_KT = GS_KHT, GS_BT = GS_BHT, GS_MB = GS_TM;
#ifndef SCAN_NP
#define SCAN_NP 5
#endif
constexpr int CH_NP = SCAN_NP, CH_NS = 8 - CH_NP, CH_ROUNDS = (512 + CH_NP - 1) / CH_NP;
constexpr int CH_KTAB = 2 * CH_NP * GS_SLOT;
static_assert(CH_KTAB + 512 <= 131072, "chunked-scan LDS map");
template <int N> __device__ __forceinline__ float dpp_shr(float v) { return __builtin_bit_cast(float, __builtin_amdgcn_update_dpp(0, __builtin_bit_cast(int, v), 0x110 + N, 0xf, 0xf, true)); }
__device__ __forceinline__ bf16x8 mk8(v2u a, v2u b) { return __builtin_bit_cast(bf16x8, (v4u){a.x, a.y, b.x, b.y}); }
__device__ __forceinline__ bf16x8 mk8z(v2u a) { return __builtin_bit_cast(bf16x8, (v4u){a.x, a.y, 0u, 0u}); }
__device__ __forceinline__ bf16x8 cvt8z(f32x4 v) { return __builtin_bit_cast(bf16x8, (v4u){pk2(v.x, v.y), pk2(v.z, v.w), 0u, 0u}); }
__device__ __forceinline__ int tokoff(const int t, const int c) { return t * 128 + ((c ^ ((t >> 1) & 7)) << 4); }
__device__ __forceinline__ int tokoff2(const int t, const int c) { return t * 128 + ((c ^ (((t >> 1) & 3) << 1)) << 4); }
__device__ __forceinline__ v2u trld(const LAS unsigned char* p) { return __builtin_bit_cast(v2u, __builtin_amdgcn_ds_read_tr16_b64_v4i16((LAS attn_body::v4i16_t*)p)); }
struct ChOps { v4u q0, q1, r0, r1, mn, bt; };
struct ChOpsB { v2u kh[4], bh[4]; f32x4 dv[4]; };
__device__ __forceinline__ void chain_load(ChOps& O, const LAS unsigned char* C, const int fr, const int fq) {
    const int w8 = 8 * (fq & 1), c = fq >> 1;
    { const v2u a = *(const LAS v2u*)(C + GS_QT + tokoff(fr, c) + w8), b = *(const LAS v2u*)(C + GS_QT + tokoff(fr, 2 + c) + w8); O.q0 = (v4u){a.x, a.y, b.x, b.y}; }
    { const v2u a = *(const LAS v2u*)(C + GS_QT + tokoff(fr, 4 + c) + w8), b = *(const LAS v2u*)(C + GS_QT + tokoff(fr, 6 + c) + w8); O.q1 = (v4u){a.x, a.y, b.x, b.y}; }
    { const v2u a = *(const LAS v2u*)(C + GS_RT + tokoff(fr, c) + w8), b = *(const LAS v2u*)(C + GS_RT + tokoff(fr, 2 + c) + w8); O.r0 = (v4u){a.x, a.y, b.x, b.y}; }
    { const v2u a = *(const LAS v2u*)(C + GS_RT + tokoff(fr, 4 + c) + w8), b = *(const LAS v2u*)(C + GS_RT + tokoff(fr, 6 + c) + w8); O.r1 = (v4u){a.x, a.y, b.x, b.y}; }
    const int om = (fr * 16 + 4 * fq) * 2;
    { const v2u a = *(const LAS v2u*)(C + GS_MK + om), b = *(const LAS v2u*)(C + GS_NK + om); O.mn = (v4u){a.x, a.y, b.x, b.y}; }
    { const v2u a = *(const LAS v2u*)(C + GS_NB + om), b = *(const LAS v2u*)(C + GS_TM + om); O.bt = (v4u){a.x, a.y, b.x, b.y}; }
}
__device__ __forceinline__ void chain_load_b(ChOpsB& O, const LAS unsigned char* C, const int fr, const int fq) {
#pragma unroll
    for (int jt = 0; jt < 4; ++jt) { const int ok = tokoff2(4 * fq + (fr >> 2), 2 * jt + ((fr >> 1) & 1)) + 8 * (fr & 1); O.kh[jt] = trld(C + GS_KHT + ok); O.bh[jt] = trld(C + GS_BHT + ok); O.dv[jt] = *(const LAS f32x4*)(C + GS_DD + (16 * jt + 4 * fq) * 4); }
}
template <int NT>
__device__ __forceinline__ void chain_step(const ChOps& O, const LAS unsigned char* C, const v2u vq0, const v2u vq1, f32x4 (&Areg)[2][4], const int vt0, const int fr, const int fq, GAS bf16* yrow, LAS unsigned char* ys) {
    const f32x4 zero4 = (f32x4){0.f, 0.f, 0.f, 0.f};
    v2u kh0, kh1, kh2, kh3, bh0, bh1, bh2, bh3; f32x4 dv0, dv1, dv2, dv3;
    { const int okb = tokoff2(4 * fq + (fr >> 2), 0) + 8 * (fr & 1), xs = (((4 * fq + (fr >> 2)) >> 1) & 3) << 1, cb = (fr >> 1) & 1;
#define KB_(jt) (4 * fq + (fr >> 2)) * 128 + ((((2 * (jt) + cb) ^ xs)) << 4) + 8 * (fr & 1)
      kh0 = trld(C + GS_KHT + KB_(0)); kh1 = trld(C + GS_KHT + KB_(1)); kh2 = trld(C + GS_KHT + KB_(2)); kh3 = trld(C + GS_KHT + KB_(3));
      bh0 = trld(C + GS_BHT + KB_(0)); bh1 = trld(C + GS_BHT + KB_(1)); bh2 = trld(C + GS_BHT + KB_(2)); bh3 = trld(C + GS_BHT + KB_(3)); (void)okb;
#undef KB_
      dv0 = *(const LAS f32x4*)(C + GS_DD + (4 * fq) * 4); dv1 = *(const LAS f32x4*)(C + GS_DD + (16 + 4 * fq) * 4); dv2 = *(const LAS f32x4*)(C + GS_DD + (32 + 4 * fq) * 4); dv3 = *(const LAS f32x4*)(C + GS_DD + (48 + 4 * fq) * 4); }
    bf16x8 Aq[NT][2], Vq[NT], Uq[NT]; f32x4 X[NT], YA[NT], Z[NT], U[NT], Yv[NT], Yn[NT];
#pragma unroll
    for (int ti = 0; ti < NT; ++ti) {
#pragma unroll
        for (int kh = 0; kh < 2; ++kh) Aq[ti][kh] = __builtin_bit_cast(bf16x8, (v4u){pk2(Areg[ti][2 * kh].x, Areg[ti][2 * kh].y), pk2(Areg[ti][2 * kh].z, Areg[ti][2 * kh].w), pk2(Areg[ti][2 * kh + 1].x, Areg[ti][2 * kh + 1].y), pk2(Areg[ti][2 * kh + 1].z, Areg[ti][2 * kh + 1].w)});
        Vq[ti] = mk8z(ti == 0 ? vq0 : vq1); X[ti] = zero4; YA[ti] = zero4; }
#pragma unroll
    for (int kh = 0; kh < 2; ++kh) {
#pragma unroll
        for (int ti = 0; ti < NT; ++ti) { X[ti] = __builtin_amdgcn_mfma_f32_16x16x32_bf16(__builtin_bit_cast(bf16x8, kh == 0 ? O.q0 : O.q1), Aq[ti][kh], X[ti], 0, 0, 0); YA[ti] = __builtin_amdgcn_mfma_f32_16x16x32_bf16(__builtin_bit_cast(bf16x8, kh == 0 ? O.r0 : O.r1), Aq[ti][kh], YA[ti], 0, 0, 0); } }
#pragma unroll
    for (int ti = 0; ti < NT; ++ti) Z[ti] = __builtin_amdgcn_mfma_f32_16x16x32_bf16(__builtin_bit_cast(bf16x8, (v4u){O.mn.x, O.mn.y, 0u, 0u}), Vq[ti], X[ti], 0, 0, 0);
#pragma unroll
    for (int ti = 0; ti < NT; ++ti) Yv[ti] = __builtin_amdgcn_mfma_f32_16x16x32_bf16(__builtin_bit_cast(bf16x8, (v4u){O.mn.z, O.mn.w, 0u, 0u}), Vq[ti], YA[ti], 0, 0, 0);
#pragma unroll
    for (int ti = 0; ti < NT; ++ti) U[ti] = __builtin_amdgcn_mfma_f32_16x16x32_bf16(__builtin_bit_cast(bf16x8, (v4u){O.bt.z, O.bt.w, 0u, 0u}), cvt8z(Z[ti]), zero4, 0, 0, 0);
#pragma unroll
    for (int ti = 0; ti < NT; ++ti) Uq[ti] = cvt8z(U[ti]);
#pragma unroll
    for (int ti = 0; ti < NT; ++ti) Yn[ti] = __builtin_amdgcn_mfma_f32_16x16x32_bf16(__builtin_bit_cast(bf16x8, (v4u){O.bt.x, O.bt.y, 0u, 0u}), Uq[ti], zero4, 0, 0, 0);
#pragma unroll
    for (int jt = 0; jt < 4; ++jt) {
#pragma unroll
        for (int ti = 0; ti < NT; ++ti) { f32x4 acc = (jt == 0 ? dv0 : jt == 1 ? dv1 : jt == 2 ? dv2 : dv3) * Areg[ti][jt];
            acc = __builtin_amdgcn_mfma_f32_16x16x32_bf16(mk8z(jt == 0 ? kh0 : jt == 1 ? kh1 : jt == 2 ? kh2 : kh3), Vq[ti], acc, 0, 0, 0);
            const f32x4 nbu = __builtin_amdgcn_mfma_f32_16x16x32_bf16(mk8z(jt == 0 ? bh0 : jt == 1 ? bh1 : jt == 2 ? bh2 : bh3), Uq[ti], zero4, 0, 0, 0);
            Areg[ti][jt] = acc - nbu; } }
#pragma unroll
    for (int ti = 0; ti < NT; ++ti) { const f32x4 yy = Yv[ti] - Yn[ti]; *(LAS v2u*)(ys + ti * 512 + (fr * 16 + 4 * fq) * 2) = (v2u){pk2(yy[0], yy[1]), pk2(yy[2], yy[3])}; }
#pragma unroll
    for (int ti = 0; ti < NT; ++ti) { const v2u w = trld(ys + ti * 512 + ((4 * fq + (fr >> 2)) * 16 + 4 * (fr & 3)) * 2); *(GAS v2u*)(yrow + (size_t)fr * 1024 + 16 * (vt0 + ti) + 4 * fq) = w; }
}
#ifndef SCAN_WMAP
#define SCAN_WMAP 0x76543210u
#endif
__device__ __forceinline__ void rwkv_scan_chunked(Frame& F, const In& I, const bf16* R, const bf16* Kt, const bf16* V, const bf16* AA, const bf16* EW, bf16* Y) {
    const int lane = LANE_, fr = lane & 15, fq = lane >> 4;
    const int lw = (int)((SCAN_WMAP >> (4 * F.wave)) & 7u);
    LAS unsigned char* L = F.lds;
    const f32x4 zero4 = (f32x4){0.f, 0.f, 0.f, 0.f};
    for (int un = blockIdx.x; un < NB * 16; un += F.G) {
        const int h = un & 15, b = un >> 4; const size_t rowb = (size_t)b * SEQ;
        if (lw == 0) { ((LAS float*)(L + CH_KTAB))[lane] = ((const GAS float*)I.rwkv_kk)[h * 64 + lane]; ((LAS float*)(L + CH_KTAB + 256))[lane] = ((const GAS float*)I.rwkv_ka)[h * 64 + lane]; }
        LBAR();
        if (lw >= CH_NS) {
            const int p = lw - CH_NS; const int colb = h * 64 + 16 * fq;
            v4u raw[10];
#define CK_LOAD(cidx) do { const size_t off = (rowb + (size_t)(cidx) * 16 + fr) * 1024 + colb; \
                raw[0] = *(const GAS v4u*)(R + off); raw[1] = *(const GAS v4u*)(R + off + 8); raw[2] = *(const GAS v4u*)(Kt + off); raw[3] = *(const GAS v4u*)(Kt + off + 8); raw[4] = *(const GAS v4u*)(V + off); raw[5] = *(const GAS v4u*)(V + off + 8); \
                raw[6] = *(const GAS v4u*)(AA + off); raw[7] = *(const GAS v4u*)(AA + off + 8); raw[8] = *(const GAS v4u*)(EW + off); raw[9] = *(const GAS v4u*)(EW + off + 8); } while (0)
#ifdef SCAN_STAMP
            unsigned long long st_[7] = {0, 0, 0, 0, 0, 0, 0};
#ifndef SCAN_STAMP_P
#define SCAN_STAMP_P 0
#endif
#ifndef SCAN_STAMP_RD
#define SCAN_STAMP_RD 20
#endif
#ifndef SCAN_STAMP_B
#define SCAN_STAMP_B 0
#endif
#define STAMP(i) do { if ((SCAN_STAMP_B < 0 || blockIdx.x == SCAN_STAMP_B) && p == SCAN_STAMP_P && rd == SCAN_STAMP_RD) st_[i] = __builtin_amdgcn_s_memtime(); } while (0)
#else
#define STAMP(i) do { } while (0)
#endif
            CK_LOAD(p);
            for (int rd = -1; rd < CH_ROUNDS - 1; ++rd) {
                const int cidx = CH_NP * (rd + 1) + p; LAS unsigned char* S = L + (((rd + 1) & 1) * CH_NP + p) * GS_SLOT;
                if (cidx < 512) {
                STAMP(0);
                float r[16], k[16], a[16], ew[16]; const v4u vraw0 = raw[4], vraw1 = raw[5];
                { float t8[8];
                  unpack8(raw[0], t8);
#pragma unroll
                  for (int e = 0; e < 8; ++e) r[e] = t8[e];
                  unpack8(raw[1], t8);
#pragma unroll
                  for (int e = 0; e < 8; ++e) r[8 + e] = t8[e];
                  unpack8(raw[2], t8);
#pragma unroll
                  for (int e = 0; e < 8; ++e) k[e] = t8[e];
                  unpack8(raw[3], t8);
#pragma unroll
                  for (int e = 0; e < 8; ++e) k[8 + e] = t8[e];
                  unpack8(raw[6], t8);
#pragma unroll
                  for (int e = 0; e < 8; ++e) a[e] = t8[e];
                  unpack8(raw[7], t8);
#pragma unroll
                  for (int e = 0; e < 8; ++e) a[8 + e] = t8[e];
                  unpack8(raw[8], t8);
#pragma unroll
                  for (int e = 0; e < 8; ++e) ew[e] = t8[e];
                  unpack8(raw[9], t8);
#pragma unroll
                  for (int e = 0; e < 8; ++e) ew[8 + e] = t8[e]; }
#if defined(SCAN_STAMP) && defined(SCAN_STAMP_LD)
                asm volatile("s_waitcnt vmcnt(0)" ::: "memory"); STAMP(1);
#endif
                if (cidx + CH_NP < 512) CK_LOAD(cidx + CH_NP);
                float kx[16], ss = 0.f;
#pragma unroll
                for (int e4 = 0; e4 < 4; ++e4) { const f32x4 c0_ = *(const LAS f32x4*)(L + CH_KTAB + (16 * fq + 4 * e4) * 4), c1_ = *(const LAS f32x4*)(L + CH_KTAB + 256 + (16 * fq + 4 * e4) * 4);
#pragma unroll
                    for (int z = 0; z < 4; ++z) { const int ee = 4 * e4 + z; kx[ee] = k[ee] * c0_[z]; ss += kx[ee] * kx[ee]; k[ee] = k[ee] * (1.0f + (a[ee] - 1.0f) * c1_[z]); } }
                ss += __shfl_xor(ss, 16); ss += __shfl_xor(ss, 32);
                const float inv = __builtin_amdgcn_rsqf(fmaxf(ss, 1e-24f));
                unsigned qtw[8], rtw[8], ktw[8], btw[8], bhw[8], khw[8];
                {
                    float li[16], e15[16], ep[16];
#pragma unroll
                    for (int e = 0; e < 16; ++e) li[e] = -ew[e];
#pragma unroll
                    for (int e = 0; e < 16; ++e) li[e] += dpp_shr<1>(li[e]);
#pragma unroll
                    for (int e = 0; e < 16; ++e) li[e] += dpp_shr<2>(li[e]);
#pragma unroll
                    for (int e = 0; e < 16; ++e) li[e] += dpp_shr<4>(li[e]);
#pragma unroll
                    for (int e = 0; e < 16; ++e) li[e] += dpp_shr<8>(li[e]);
#pragma unroll
                    for (int e = 0; e < 16; ++e) li[e] = __builtin_amdgcn_exp2f(1.4426950408889634f * li[e]);
#pragma unroll
                    for (int e = 0; e < 16; ++e) e15[e] = __shfl(li[e], (lane & 48) | 15);
#pragma unroll
                    for (int e = 0; e < 16; ++e) ep[e] = __builtin_bit_cast(float, __builtin_amdgcn_update_dpp(0x3f800000, __builtin_bit_cast(int, li[e]), 0x111, 0xf, 0xf, false));
                    if (fr == 15) {
#pragma unroll
                        for (int e4 = 0; e4 < 4; ++e4) *(LAS f32x4*)(S + GS_DD + (16 * fq + 4 * e4) * 4) = (f32x4){li[4 * e4], li[4 * e4 + 1], li[4 * e4 + 2], li[4 * e4 + 3]}; }
#pragma unroll
                    for (int e = 0; e < 16; e += 2) { float q2[2], r2[2], k2[2], b2[2], b2h[2], k2h[2];
#pragma unroll
                        for (int z = 0; z < 2; ++z) { const int ee = e + z;
                            const float Einv = __builtin_amdgcn_rcpf(li[ee]);
                            const float kk = kx[ee] * inv, bb = a[ee] * kk;
                            q2[z] = kk * ep[ee]; k2[z] = k[ee] * Einv; b2[z] = bb * Einv; r2[z] = r[ee] * li[ee];
                            b2h[z] = b2[z] * e15[ee]; k2h[z] = k2[z] * e15[ee]; }
                        qtw[e >> 1] = pk2(q2[0], q2[1]); rtw[e >> 1] = pk2(r2[0], r2[1]); ktw[e >> 1] = pk2(k2[0], k2[1]); btw[e >> 1] = pk2(b2[0], b2[1]); bhw[e >> 1] = pk2(b2h[0], b2h[1]); khw[e >> 1] = pk2(k2h[0], k2h[1]);
 } }
                { const int ov = tokoff2(fr, 2 * fq); *(LAS v4u*)(S + GS_VT + ov) = vraw0; *(LAS v4u*)(S + GS_VT + ov + 16) = vraw1; }
                { const int o = tokoff(fr, 2 * fq), o2 = o ^ 16;
                  *(LAS v4u*)(S + GS_QT + o) = (v4u){qtw[0], qtw[1], qtw[2], qtw[3]}; *(LAS v4u*)(S + GS_QT + o2) = (v4u){qtw[4], qtw[5], qtw[6], qtw[7]};
                  *(LAS v4u*)(S + GS_RT + o) = (v4u){rtw[0], rtw[1], rtw[2], rtw[3]}; *(LAS v4u*)(S + GS_RT + o2) = (v4u){rtw[4], rtw[5], rtw[6], rtw[7]};
                  *(LAS v4u*)(S + GS_KT + o) = (v4u){ktw[0], ktw[1], ktw[2], ktw[3]}; *(LAS v4u*)(S + GS_KT + o2) = (v4u){ktw[4], ktw[5], ktw[6], ktw[7]};
                  *(LAS v4u*)(S + GS_BT + o) = (v4u){btw[0], btw[1], btw[2], btw[3]}; *(LAS v4u*)(S + GS_BT + o2) = (v4u){btw[4], btw[5], btw[6], btw[7]}; }
                asm volatile("s_waitcnt lgkmcnt(0)" ::: "memory");
#if !defined(SCAN_STAMP_LD)
                STAMP(1);
#endif
                f32x4 mb = zero4, mbt = zero4, mkt = zero4, nbt = zero4, nkt = zero4;
#pragma unroll
                for (int kh = 0; kh < 2; ++kh) { const int o = tokoff(fr, 4 * kh + fq);
                    const bf16x8 Qf = *(const LAS bf16x8*)(S + GS_QT + o), Rf = *(const LAS bf16x8*)(S + GS_RT + o), Kf = *(const LAS bf16x8*)(S + GS_KT + o), Bf = *(const LAS bf16x8*)(S + GS_BT + o);
                    mb = __builtin_amdgcn_mfma_f32_16x16x32_bf16(Qf, Bf, mb, 0, 0, 0); mbt = __builtin_amdgcn_mfma_f32_16x16x32_bf16(Bf, Qf, mbt, 0, 0, 0);
                    mkt = __builtin_amdgcn_mfma_f32_16x16x32_bf16(Kf, Qf, mkt, 0, 0, 0);
                    nbt = __builtin_amdgcn_mfma_f32_16x16x32_bf16(Bf, Rf, nbt, 0, 0, 0); nkt = __builtin_amdgcn_mfma_f32_16x16x32_bf16(Kf, Rf, nkt, 0, 0, 0); }
                asm volatile("s_waitcnt lgkmcnt(0)" ::: "memory");
                STAMP(2);
                { const int oh = tokoff2(fr, 2 * fq);
                  *(LAS v4u*)(S + GS_BHT + oh) = (v4u){bhw[0], bhw[1], bhw[2], bhw[3]}; *(LAS v4u*)(S + GS_BHT + oh + 16) = (v4u){bhw[4], bhw[5], bhw[6], bhw[7]};
                  *(LAS v4u*)(S + GS_KHT + oh) = (v4u){khw[0], khw[1], khw[2], khw[3]}; *(LAS v4u*)(S + GS_KHT + oh + 16) = (v4u){khw[4], khw[5], khw[6], khw[7]}; }
                { f32x4 nAf, nDf, iD, mkm, nkm, nbm;
#pragma unroll
                  for (int e = 0; e < 4; ++e) { const int tt = 4 * fq + e; const bool lo = fr < tt, up = tt < fr, ue = tt <= fr;
                      nAf[e] = lo ? -mb[e] : 0.f; nDf[e] = up ? -mbt[e] : 0.f; iD[e] = (tt == fr) ? 1.0f : 0.0f;
                      mkm[e] = up ? mkt[e] : 0.f; nkm[e] = ue ? nkt[e] : 0.f; nbm[e] = ue ? nbt[e] : 0.f; }
                  const int om = (fr * 16 + 4 * fq) * 2;
                  *(LAS v2u*)(S + GS_MK + om) = (v2u){pk2(mkm[0], mkm[1]), pk2(mkm[2], mkm[3])}; *(LAS v2u*)(S + GS_NK + om) = (v2u){pk2(nkm[0], nkm[1]), pk2(nkm[2], nkm[3])};
                  *(LAS v2u*)(S + GS_NB + om) = (v2u){pk2(nbm[0], nbm[1]), pk2(nbm[2], nbm[3])};
                  STAMP(3);
                  const bf16x8 nA = cvt8z(nAf), nD = cvt8z(nDf);
                  const f32x4 n2D = __builtin_amdgcn_mfma_f32_16x16x32_bf16(nA, nD, zero4, 0, 0, 0), n2A = __builtin_amdgcn_mfma_f32_16x16x32_bf16(nD, nA, zero4, 0, 0, 0);
                  const bf16x8 n2Db = cvt8z(n2D), n2Ab = cvt8z(n2A);
                  const f32x4 n4D = __builtin_amdgcn_mfma_f32_16x16x32_bf16(n2Ab, n2Db, zero4, 0, 0, 0), n4A = __builtin_amdgcn_mfma_f32_16x16x32_bf16(n2Db, n2Ab, zero4, 0, 0, 0);
                  f32x4 Tt = __builtin_amdgcn_mfma_f32_16x16x32_bf16(nA, n2Db, iD + nDf + n2D, 0, 0, 0);
                  const bf16x8 n4Db = cvt8z(n4D), n4Ab = cvt8z(n4A);
                  const f32x4 n8A = __builtin_amdgcn_mfma_f32_16x16x32_bf16(n4Db, n4Ab, zero4, 0, 0, 0);
                  Tt = __builtin_amdgcn_mfma_f32_16x16x32_bf16(n4Ab, cvt8z(Tt), Tt, 0, 0, 0);
                  Tt = __builtin_amdgcn_mfma_f32_16x16x32_bf16(cvt8z(n8A), cvt8z(Tt), Tt, 0, 0, 0);
                  STAMP(4);
                  *(LAS v2u*)(S + GS_TM + om) = (v2u){pk2(Tt[0], Tt[1]), pk2(Tt[2], Tt[3])}; }
                STAMP(5);
                }
                LBAR();
                STAMP(6);
            }
            LBAR();
#ifdef SCAN_STAMP
            if ((SCAN_STAMP_B < 0 || blockIdx.x == SCAN_STAMP_B) && p == SCAN_STAMP_P) { const unsigned long long d_ = (SCAN_STAMP == 0) ? st_[6] - st_[0] : (SCAN_STAMP == 7) ? st_[5] - st_[0] : st_[SCAN_STAMP] - st_[SCAN_STAMP - 1]; const unsigned long long t0_ = __builtin_amdgcn_s_memtime();
                while (__builtin_amdgcn_s_memtime() - t0_ < d_ * 512ull) __builtin_amdgcn_s_sleep(8); }
#endif
#undef CK_LOAD
        } else {
            const int vtA = (CH_NS == 4) ? lw : ((lw == 0) ? 0 : lw + 1);
            f32x4 A2[2][4];
#ifdef SCAN_PRIO
            __builtin_amdgcn_s_setprio(SCAN_PRIO);
#endif
#pragma unroll
            for (int jt = 0; jt < 4; ++jt) { A2[0][jt] = zero4; A2[1][jt] = zero4; }
            const int trb = 4 * fq + (fr >> 2), trc = (fr >> 1) & 1, trl = 8 * (fr & 1);
            LAS unsigned char* ys = L + TB_OFF + lw * 1024;
#ifdef SCAN_SSTAMP
            unsigned long long ss0_ = 0, ss1_ = 0;
#endif
            LBAR();
            const int vt0 = (CH_NS == 3 && lw == 0) ? 0 : vtA; const bool two = (CH_NS == 3 && lw == 0);
            for (int rd = 0; rd < CH_ROUNDS; ++rd) {
                const int c0 = CH_NP * rd; const LAS unsigned char* C0 = L + ((rd & 1) * CH_NP) * GS_SLOT;
                ChOps opA, opB; v2u vA0, vA1, vB0, vB1;
#define CH_FETCH(OP, V0, V1, q_) do { const LAS unsigned char* C_ = C0 + (q_) * GS_SLOT; chain_load(OP, C_, fr, fq); V0 = trld(C_ + GS_VT + tokoff2(trb, 2 * vt0 + trc) + trl); \
                    if (two) V1 = trld(C_ + GS_VT + tokoff2(trb, 2 + trc) + trl); } while (0)
#define CH_ITER(q_, CUR, U0, U1, NXT, W0, W1) do { if ((q_) < CH_NP) { const int cidx = c0 + (q_); \
                    if ((q_) + 1 < CH_NP && cidx + 1 < 512) CH_FETCH(NXT, W0, W1, (q_) + 1); \
                    if (cidx < 512) { GAS bf16* yrow = (GAS bf16*)Y + (rowb + (size_t)cidx * 16) * 1024 + h * 64; \
                        if (two) chain_step<2>(CUR, C0 + (q_) * GS_SLOT, U0, U1, A2, 0, fr, fq, yrow, ys); \
                        else chain_step<1>(CUR, C0 + (q_) * GS_SLOT, U0, U0, A2, vtA, fr, fq, yrow, ys); } } } while (0)
                vA1 = (v2u){0u, 0u}; vB1 = (v2u){0u, 0u};
                if (c0 < 512) CH_FETCH(opA, vA0, vA1, 0);
                CH_ITER(0, opA, vA0, vA1, opB, vB0, vB1);
                CH_ITER(1, opB, vB0, vB1, opA, vA0, vA1);
                CH_ITER(2, opA, vA0, vA1, opB, vB0, vB1);
                CH_ITER(3, opB, vB0, vB1, opA, vA0, vA1);
                CH_ITER(4, opA, vA0, vA1, opB, vB0, vB1);
                CH_ITER(5, opB, vB0, vB1, opA, vA0, vA1);
#undef CH_ITER
#undef CH_FETCH
                LBAR();
            }
#ifdef SCAN_SSTAMP
            if (lw == SCAN_SSTAMP_W) { const unsigned long long d_ = (ss1_ - ss0_) * 512ull, t0_ = __builtin_amdgcn_s_memtime(); while (__builtin_amdgcn_s_memtime() - t0_ < d_) __builtin_amdgcn_s_sleep(8); }
#endif
#ifdef SCAN_PRIO
            __builtin_amdgcn_s_setprio(0);
#endif
        }
    }
}
__device__ __forceinline__ void rwkv_post_pass(Frame& F, const In& I, const bf16* R, const bf16* Kt, const bf16* V, const bf16* AA, const bf16* G, bf16* Y) {
    const int gw = F.vcu * NWAVES + F.wave, NGW = F.G * NWAVES; const int col = LANE_ * 16;
    for (int t0 = 2 * gw; t0 < T; t0 += 2 * NGW) {
        v4u py[2][2], pr[2][2], pk[2][2], pv[2][2], pa[2][2], pg[2][2];
#pragma unroll
        for (int rw = 0; rw < 2; ++rw) { const size_t off = (size_t)(t0 + rw) * 1024 + col;
#pragma unroll
            for (int hf = 0; hf < 2; ++hf) { py[rw][hf] = *(const v4u*)(Y + off + hf * 8); pr[rw][hf] = *(const v4u*)(R + off + hf * 8); pk[rw][hf] = *(const v4u*)(Kt + off + hf * 8);
                pv[rw][hf] = *(const v4u*)(V + off + hf * 8); pa[rw][hf] = *(const v4u*)(AA + off + hf * 8); pg[rw][hf] = *(const v4u*)(G + off + hf * 8); } }
#pragma unroll
        for (int rw = 0; rw < 2; ++rw) { const size_t off = (size_t)(t0 + rw) * 1024 + col;
            float kaw[16], rkw[16], lng[16], lnb[16];
#pragma unroll
            for (int e4 = 0; e4 < 4; ++e4) { const f32x4 c0 = *(const GAS f32x4*)(I.rwkv_ka + col + 4 * e4), c1 = *(const GAS f32x4*)(I.rwkv_rk + col + 4 * e4), c2 = *(const GAS f32x4*)(I.rwkv_ln_g + col + 4 * e4), c3 = *(const GAS f32x4*)(I.rwkv_ln_b + col + 4 * e4);
#pragma unroll
                for (int e = 0; e < 4; ++e) { kaw[4 * e4 + e] = c0[e]; rkw[4 * e4 + e] = c1[e]; lng[4 * e4 + e] = c2[e]; lnb[4 * e4 + e] = c3[e]; } }
            float y[16], r[16], k[16], v[16], a[16], g[16];
#pragma unroll
            for (int hf = 0; hf < 2; ++hf) { float t8[8];
                unpack8(py[rw][hf], t8);
#pragma unroll
                for (int e = 0; e < 8; ++e) y[hf * 8 + e] = t8[e];
                unpack8(pr[rw][hf], t8);
#pragma unroll
                for (int e = 0; e < 8; ++e) r[hf * 8 + e] = t8[e];
                unpack8(pk[rw][hf], t8);
#pragma unroll
                for (int e = 0; e < 8; ++e) k[hf * 8 + e] = t8[e];
                unpack8(pv[rw][hf], t8);
#pragma unroll
                for (int e = 0; e < 8; ++e) v[hf * 8 + e] = t8[e];
                unpack8(pa[rw][hf], t8);
#pragma unroll
                for (int e = 0; e < 8; ++e) a[hf * 8 + e] = t8[e];
                unpack8(pg[rw][hf], t8);
#pragma unroll
                for (int e = 0; e < 8; ++e) g[hf * 8 + e] = t8[e]; }
            float s = 0.f, bs = 0.f;
#pragma unroll
            for (int e = 0; e < 16; ++e) { s += y[e]; const float kp = k[e] * (1.0f + (a[e] - 1.0f) * kaw[e]); bs += r[e] * kp * rkw[e]; }
            s += __shfl_xor(s, 1); s += __shfl_xor(s, 2); bs += __shfl_xor(bs, 1); bs += __shfl_xor(bs, 2);
            const float mean = s * (1.0f / 64.0f); float q = 0.f;
#pragma unroll
            for (int e = 0; e < 16; ++e) { const float dd = y[e] - mean; q += dd * dd; }
            q += __shfl_xor(q, 1); q += __shfl_xor(q, 2);
            const float rstd = 1.0f / sqrtf(q * (1.0f / 64.0f) + 64e-5f);
            float o[16];
#pragma unroll
            for (int e = 0; e < 16; ++e) o[e] = ((y[e] - mean) * rstd * lng[e] + lnb[e] + bs * v[e]) * g[e];
            v4u w0, w1; w0.x = pk2(o[0], o[1]); w0.y = pk2(o[2], o[3]); w0.z = pk2(o[4], o[5]); w0.w = pk2(o[6], o[7]); w1.x = pk2(o[8], o[9]); w1.y = pk2(o[10], o[11]); w1.z = pk2(o[12], o[13]); w1.w = pk2(o[14], o[15]);
            *(v4u*)(Y + off) = w0; *(v4u*)(Y + off + 8) = w1; }
    }
}

#ifndef DUP_K
#define DUP_K (-1)
#endif
#ifndef DUP_K2
#define DUP_K2 (-1)
#endif
#define KARGS ((const __attribute__((address_space(4))) Args*)__builtin_amdgcn_kernarg_segment_ptr())
#define WSPTRS \
    bf16* H0 = (bf16*)(ws + WS_H0); bf16* QKV = (bf16*)(ws + WS_QKV); bf16* OB = (bf16*)(ws + WS_O); f32x2* AGG = (f32x2*)(ws + WS_LRUAGG); \
    bf16* H2 = (bf16*)(ws + WS_H2); float* LOG = (float*)(ws + WS_LOG); unsigned char* RTE = ws + WS_ROUTE; bf16* HID = (bf16*)(ws + WS_HID); bf16* YS = (bf16*)(ws + WS_YS); bf16* PP = (bf16*)(ws + WS_PP); \
    bf16* HCAT = (bf16*)(ws + WS_HCAT); bf16* RB = (bf16*)(ws + WS_R); bf16* KB = (bf16*)(ws + WS_K); bf16* VB = (bf16*)(ws + WS_V); bf16* XRB = (bf16*)(ws + WS_XR); bf16* XKB = (bf16*)(ws + WS_XK); bf16* XVB = (bf16*)(ws + WS_XV); bf16* MID = (bf16*)(ws + WS_MID); bf16* EWB = (bf16*)(ws + WS_EW); bf16* AAB = (bf16*)(ws + WS_AA); bf16* YB = (bf16*)(ws + WS_Y); \
    const size_t TD = (size_t)T * 1024; (void)H0; (void)QKV; (void)OB; (void)AGG; (void)H2; (void)LOG; (void)RTE; (void)HID; (void)YS; (void)PP; (void)HCAT; (void)RB; (void)KB; (void)VB; (void)XRB; (void)XKB; (void)XVB; (void)MID; (void)EWB; (void)AAB; (void)YB; (void)TD;

struct Args { In in; float* out; unsigned char* ws; int ph_lo, ph_hi; };
constexpr int N_PHASES = 34;
__device__ __forceinline__ int nrep(int k) { int n = (k == DUP_K) ? 2 : 1; if (DUP_K >= 0) asm volatile("" : "+s"(n)); return n; }
#define REP_SYNC if (rep_) __syncthreads();
typedef const __attribute__((address_space(4))) unsigned long long* kp64;
__device__ __forceinline__ void load_in(In& I) { kp64 s = (kp64)__builtin_amdgcn_kernarg_segment_ptr(); unsigned long long* d = (unsigned long long*)&I;
#pragma unroll
    for (int i = 0; i < 47; ++i) d[i] = s[i]; }

__device__ __forceinline__ int t5_bucket(int n) { if (n < 16) return n; const float v = logf((float)n / 16.0f) / 2.0794415416798357f * 16.0f; const int l = 16 + (int)v; return l < 31 ? l : 31; }

template <class Epi>
__device__ __forceinline__ void dense_gemm(Frame& F, const void* A, int lda, const void* B, int K, int M, int N, const Epi& E) {
    pg8::DenseOrder S; S.init(A, lda, B, K, M, N, F.G, (int)blockIdx.x);
    pg8::gemm_phase<Epi, pg8::DenseOrder, true, false>(F.lds, K, lda, S, E, nullptr, TID_);
}

__global__ void __launch_bounds__(NWAVES * 64, 2) mk_fwd(Args args) {
    extern __shared__ __attribute__((aligned(16))) unsigned char lds[];
    Frame F;
    F.lds = (LAS unsigned char*)lds;
    F.MISC = (volatile LAS unsigned*)(F.lds + MISC_OFF);
    { int w_ = __builtin_amdgcn_readfirstlane((int)threadIdx.x >> 6); asm volatile("" : "+s"(w_)); F.wave = w_; }
    F.G = gridDim.x; { const int bx = blockIdx.x; F.vcu = (F.G % 8 == 0) ? (bx % 8) * (F.G / 8) + bx / 8 : bx; }
    F.ctl = (gu32*)(KARGS->ws + WS_CTL);
    for (int u = TID_; u < (LDS_BYTES - LDSCTL_OFF) / 4; u += NWAVES * 64) ((LAS unsigned*)(F.lds + LDSCTL_OFF))[u] = 0u;
    __syncthreads();
    {
        LAS float* tb = (LAS float*)(F.lds + TB_OFF); const int h = TID_ >> 7, i = TID_ & 127;
        const float* rb = KARGS->in.rel_bias;
        tb[h * 128 + i] = (rb[t5_bucket(i) * 4 + h] - rb[31 * 4 + h]) * 1.4426950408889634f;
    }
    __syncthreads();
    const int lo = KARGS->ph_lo, hi = KARGS->ph_hi;
    const bool multi = (hi - lo) > 1;
    XcdBarrier bar; bar.bar = (unsigned*)(F.ctl + CW_BAR); bar.x = 0; bar.st = nullptr;
    if (multi) bar = xcd_barrier_post((unsigned*)(F.ctl + CW_BAR), F.MISC + 8, TID_ == 0);
#define IN(k) (lo <= (k) && (k) < hi)
#define PH_BEGIN_ unsigned char* ws = KARGS->ws; bf16* X = (bf16*)KARGS->out; float* OUT = KARGS->out; (void)OUT; bf16* GB2 = (bf16*)KARGS->out + (size_t)T * 1024; (void)GB2; In I; load_in(I); (void)X; WSPTRS
#define SEAM(k) do { if (IN(k) && IN((k) + 1)) xcd_barrier(bar, TID_ == 0); } while (0)

    if (IN(0)) { PH_BEGIN_ prep_dense_weights(F, I, ws); prep_layer_weights(F, I, ws, 0); norm_pass<false>(F, I.x, I.norm_mix, H0);
#ifdef DUP_PREP
        __syncthreads(); prep_dense_weights(F, I, ws); prep_layer_weights(F, I, ws, 0);
#endif
    } SEAM(0);
    if (IN(1)) { PH_BEGIN_ pg8::EpiBf16 E{QKV, 512, 512, (size_t)T * 512, attn_body::C2}; dense_gemm(F, H0, 1024, ws + WS_WIN, 1024, T, AB_IN, E); } SEAM(1);
    if (IN(2)) { PH_BEGIN_ lru_agg_mfma(F, I, QKV + 3 * (size_t)T * 512, AGG, (bf16*)(ws + WS_HL), (bf16*)(ws + WS_CA)); } SEAM(2);
    if (IN(3)) { PH_BEGIN_
        const attn_body::AttnTensors AT{(const attn_body::bf16*)QKV, (const attn_body::bf16*)(QKV + (size_t)T * 512), (const attn_body::bf16*)(QKV + 2 * (size_t)T * 512), (attn_body::bf16*)OB};
        if (F.G == 256) attn_body::attn_phase<8>((char*)lds, AT, F.vcu, (const LAS float*)(F.lds + TB_OFF), (int)threadIdx.x);
#ifdef DUP_ATTN
        __syncthreads(); if (F.G == 256) attn_body::attn_phase<8>((char*)lds, AT, F.vcu, (const LAS float*)(F.lds + TB_OFF), (int)threadIdx.x);
#endif
        __syncthreads();
        lru_final_pass(F, (const bf16*)(ws + WS_HL), (const bf16*)(ws + WS_CA), QKV + 4 * (size_t)T * 512, AGG, H0);
    } SEAM(3);
    if (IN(4)) { PH_BEGIN_ diff_combine_pass(F, I, OB, H0); } SEAM(4);
    if (IN(5)) { PH_BEGIN_ pg8::EpiResX<false> E{I.x, X}; dense_gemm(F, H0, 1024, ws + WS_WOUT, 1024, T, 1024, E); } SEAM(5);

#define MOE_PLE_PHASES(P, L) \
    if (IN(P + 0)) { PH_BEGIN_ norm_pass<true>(F, X, I.norm_ffn + (L) * 1024, H2); } SEAM(P + 0); \
    if (IN(P + 1)) { PH_BEGIN_ pg8::EpiRouter E{LOG}; dense_gemm(F, H2, 1024, ws + WS_ROUT + (size_t)(L) * 256 * 1024 * 2, 1024, T, 256, E); } SEAM(P + 1); \
    if (IN(P + 2)) { PH_BEGIN_ route_pass_a(F, I, (L), LOG, RTE, F.ctl + ((L) ? CW_CNT1 : CW_CNT0)); } SEAM(P + 2); \
    if (IN(P + 3)) { PH_BEGIN_ route_pass_b(F, RTE, F.ctl + ((L) ? CW_CNT1 : CW_CNT0)); } SEAM(P + 3); \
    if (IN(P + 4)) { PH_BEGIN_ route_bases(F, F.ctl + ((L) ? CW_CNT1 : CW_CNT0)); const LAS int* eb = (const LAS int*)(F.lds + RTE_OFF + 512); \
        MoeOrder S{F.G, (int)blockIdx.x, __builtin_amdgcn_readfirstlane(eb[32] >> 8), eb, (const char*)H2, (const char*)(ws + WS_MGU), 0, (size_t)1024 * 1024 * 2, (size_t)256 * 1024 * 2, true}; pg8::EpiGU E{HID}; \
        pg8::gemm_phase<pg8::EpiGU, MoeOrder, true, true>(F.lds, 1024, 1024, S, E, (const int*)(RTE + RT_ROWTOK), TID_); } SEAM(P + 4); \
    if (IN(P + 5)) { PH_BEGIN_ route_bases(F, F.ctl + ((L) ? CW_CNT1 : CW_CNT0)); const LAS int* eb = (const LAS int*)(F.lds + RTE_OFF + 512); \
        MoeOrder S{F.G, (int)blockIdx.x, __builtin_amdgcn_readfirstlane(eb[32] >> 8), eb, (const char*)HID, (const char*)(ws + WS_MDN), (size_t)256 * 512 * 2, (size_t)1024 * 512 * 2, (size_t)256 * 512 * 2, false}; pg8::EpiDown E{YS, (const float*)(RTE + RT_ROWGATE)}; \
        pg8::gemm_phase<pg8::EpiDown, MoeOrder, true, false>(F.lds, 512, 512, S, E, nullptr, TID_); } SEAM(P + 5); \
    if (IN(P + 6)) { PH_BEGIN_ combine_norm_pass(F, X, X, YS, (const int*)(RTE + RT_SLOT), I.ple_norm + (L) * 1024, H2); } SEAM(P + 6); \
    if (IN(P + 7)) { PH_BEGIN_ pg8::EpiBf16 E{PP, 1024, 0, 0, 1.f}; dense_gemm(F, ws + WS_PB, 256, ws + WS_PPROJ + (size_t)(L) * 1024 * 256 * 2, 256, T, 1024, E); } SEAM(P + 7); \
    if (IN(P + 8)) { PH_BEGIN_ pg8::EpiPle E{X, (L) ? (bf16*)(ws + WS_YS) : X, PP}; dense_gemm(F, H2, 1024, ws + WS_PGATE + (size_t)(L) * 1024 * 1024 * 2, 1024, T, 1024, E); } SEAM(P + 8);

    MOE_PLE_PHASES(6, 0)
    if (IN(15)) { PH_BEGIN_ rwkv_input_pass(F, X, I.norm_mix + 1024, I.rwkv_mu, HCAT, XRB, XKB, XVB); } SEAM(15);
    if (IN(16)) { PH_BEGIN_ { pg8::EpiBf16 E{RB, 1024, 0, 0, 1.f}; dense_gemm(F, XRB, 1024, ws + WS_RCAT, 1024, T, 1024, E); }
        { pg8::EpiMid E{MID}; dense_gemm(F, HCAT, 2048, ws + WS_RL1, 2048, T, 512, E); } } SEAM(16);
    if (IN(17)) { PH_BEGIN_ pg8::EpiBf16 E{KB, 1024, 0, 0, 1.f}; dense_gemm(F, XKB, 1024, ws + WS_RCAT + (size_t)1024 * 1024 * 2, 1024, T, 1024, E); } SEAM(17);
    if (IN(18)) { PH_BEGIN_ pg8::EpiBf16 E{VB, 1024, 0, 0, 1.f}; dense_gemm(F, XVB, 1024, ws + WS_RCAT + (size_t)2 * 1024 * 1024 * 2, 1024, T, 1024, E); } SEAM(18);
    if (IN(19)) { PH_BEGIN_ pg8::EpiRwkv2 E{EWB, AAB, I.rwkv_w0, I.rwkv_a0, 0}; dense_gemm(F, MID, 512, ws + WS_RS2, 256, T, 2048, E); } SEAM(19);
    if (IN(20)) { PH_BEGIN_
        if (F.G == 256 && blockIdx.x >= 128) {
            Frame F2 = F; F2.G = 128; F2.vcu = (int)blockIdx.x - 128;
#ifdef HELP_STAMP
            const unsigned long long hs0_ = __builtin_amdgcn_s_memtime();
#endif
            prep_layer_weights(F2, I, ws, 1);
            __syncthreads();
            pg8::EpiRwkv2 E{GB2, GB2, nullptr, nullptr, 2}; pg8::DenseOrder S; S.init(MID + 256, 512, ws + WS_RS2 + (size_t)2 * 1024 * 256 * 2, 256, T, 1024, 128, (int)blockIdx.x - 128);
            pg8::gemm_phase<pg8::EpiRwkv2, pg8::DenseOrder, true, false>(F.lds, 256, 512, S, E, nullptr, TID_);
#ifdef HELP_STAMP
            if (blockIdx.x == 128) { const unsigned long long d_ = (__builtin_amdgcn_s_memtime() - hs0_) * HELP_STAMP; const unsigned long long t0_ = __builtin_amdgcn_s_memtime(); while (__builtin_amdgcn_s_memtime() - t0_ < d_) __builtin_amdgcn_s_sleep(8); }
#endif
        } else rwkv_scan_chunked(F, I, RB, KB, VB, AAB, EWB, YB);
    } SEAM(20);
    if (IN(21)) { } SEAM(21);
    if (IN(22)) { PH_BEGIN_ rwkv_post_pass(F, I, RB, KB, VB, AAB, GB2, YB); } SEAM(22);
    if (IN(23)) { PH_BEGIN_ pg8::EpiResX<true> E{X, X}; dense_gemm(F, YB, 1024, ws + WS_RWO, 1024, T, 1024, E); } SEAM(23);
    MOE_PLE_PHASES(24, 1)
    if (IN(33)) { PH_BEGIN_ final_norm_pass(F, (const bf16*)(ws + WS_YS), OUT, I.final_norm); }
#undef IN
#undef SEAM
}

extern "C" void kernel_launch(void* const* d_in, const int* in_sizes, int n_in, void* d_out, int out_size, void* d_ws, size_t ws_size, hipStream_t stream) {
    static int ok = 0;
    if (ok == 0) {
        if (n_in != 47 || out_size != T * D || ws_size < WS_END) { fprintf(stderr, "kernel_launch: unexpected problem shape (n_in %d out %d ws %zu)\n", n_in, out_size, ws_size); ok = -1; return; }
        if (hipFuncSetAttribute((const void*)mk_fwd, hipFuncAttributeMaxDynamicSharedMemorySize, LDS_BYTES) != hipSuccess) { fprintf(stderr, "kernel_launch: hipFuncSetAttribute failed\n"); ok = -1; return; }
        int per_cu = 0;
        if (hipOccupancyMaxActiveBlocksPerMultiprocessor(&per_cu, (const void*)mk_fwd, NWAVES * 64, LDS_BYTES) != hipSuccess || per_cu < 1) fprintf(stderr, "kernel_launch: occupancy query reports %d\n", per_cu);
        (void)hipGetLastError();
        ok = 1;
    }
    if (ok < 0) return;
    (void)hipMemsetAsync((char*)d_ws + WS_CTL, 0, CTL_ZERO_BYTES, stream);
    Args a{};
    const float** ip = (const float**)&a.in;
    for (int i = 0; i < 47; ++i) ip[i] = (const float*)d_in[i];
    a.out = (float*)d_out; a.ws = (unsigned char*)d_ws;
    const int grid = 256;
#if MK_ONE_LAUNCH
    a.ph_lo = 0; a.ph_hi = N_PHASES;
    hipLaunchKernelGGL(mk_fwd, dim3(grid), dim3(NWAVES * 64), LDS_BYTES, stream, a);
#else
    for (int k = 0; k < N_PHASES; ++k) { a.ph_lo = k; a.ph_hi = k + 1; hipLaunchKernelGGL(mk_fwd, dim3(grid), dim3(NWAVES * 64), LDS_BYTES, stream, a);
        if (k == DUP_K || k == DUP_K2) hipLaunchKernelGGL(mk_fwd, dim3(grid), dim3(NWAVES * 64), LDS_BYTES, stream, a); }
#endif
}
```

```cpp
#include <hip/hip_runtime.h>
#include <hip/hip_bf16.h>
#include <cstdio>
#include <cstdint>
#include <cmath>

#ifndef MK_ONE_LAUNCH
#define MK_ONE_LAUNCH 1
#endif

#define GAS __attribute__((address_space(1)))
#define LAS __attribute__((address_space(3)))
typedef unsigned short bf16;
typedef unsigned v4u __attribute__((ext_vector_type(4)));
typedef unsigned v2u __attribute__((ext_vector_type(2)));
typedef float f32x4 __attribute__((ext_vector_type(4)));
typedef float f32x2 __attribute__((ext_vector_type(2)));
typedef short bf16x8 __attribute__((ext_vector_type(8)));
typedef GAS unsigned gu32;
#define RLX_AGENT __ATOMIC_RELAXED, __HIP_MEMORY_SCOPE_AGENT
#define LDS_WAIT() asm volatile("s_waitcnt lgkmcnt(0)" ::: "memory")
#define VM_WAIT() asm volatile("s_waitcnt vmcnt(0)" ::: "memory")
__device__ __forceinline__ unsigned f2bf(float f) { unsigned u = __builtin_bit_cast(unsigned, f); return (u + 0x7fffu + ((u >> 16) & 1u)) >> 16; }
typedef float f32x2_cv __attribute__((ext_vector_type(2))); typedef __bf16 bf16x2_cv __attribute__((ext_vector_type(2)));
__device__ __forceinline__ unsigned pk2(float lo, float hi) { const f32x2_cv v = {lo, hi}; const bf16x2_cv b = __builtin_convertvector(v, bf16x2_cv); return __builtin_bit_cast(unsigned, b); }
__device__ __forceinline__ float bflo(unsigned w) { return __uint_as_float(w << 16); }
__device__ __forceinline__ float bfhi(unsigned w) { return __uint_as_float(w & 0xffff0000u); }
__device__ __forceinline__ float bf1(bf16 h) { return __uint_as_float((unsigned)h << 16); }
__device__ __forceinline__ float sigmoidf_(float x) { return __builtin_amdgcn_rcpf(1.0f + __builtin_amdgcn_exp2f(-1.4426950408889634f * x)); }
__device__ __forceinline__ float tanhf_(float x) { return 1.0f - 2.0f * __builtin_amdgcn_rcpf(1.0f + __builtin_amdgcn_exp2f(2.885390081777927f * x)); }
__device__ __forceinline__ void fmac_(float& acc, float a, float b) { asm("v_fmac_f32 %0, %1, %2" : "+v"(acc) : "v"(a), "v"(b)); }
__device__ __forceinline__ float fma_(float a, float b, float c) { float r; asm("v_fma_f32 %0, %1, %2, %3" : "=v"(r) : "v"(a), "v"(b), "v"(c)); return r; }
__device__ __forceinline__ float mul_(float a, float b) { float r; asm("v_mul_f32 %0, %1, %2" : "=v"(r) : "v"(a), "v"(b)); return r; }
__device__ __forceinline__ float wave_sum(float v) {
#pragma unroll
    for (int o = 1; o < 64; o <<= 1) v += __shfl_xor(v, o);
    return v;
}

constexpr int NB = 8, SEQ = 8192, D = 1024, T = NB * SEQ;
constexpr int AB_IN = 2560, PLE = 256;
constexpr int NEXP = 32, EH = 512;
constexpr int MAXSLOT = 2 * T + NEXP * 256;
constexpr int MAXTILES = MAXSLOT / 256;

namespace pg8 {
#define PG8_LAS __attribute__((address_space(3)))
typedef unsigned short bf16_t;
typedef unsigned u32x4 __attribute__((ext_vector_type(4)));
typedef unsigned u32x2 __attribute__((ext_vector_type(2)));
constexpr int BM = 256, BK = 64, HALF = 128, HTB = HALF * BK * 2, STAGE_BYTES = 8 * HTB, NXCD = 8, WGM = 8;
__host__ __device__ __forceinline__ int lds_byte(int r, int c) { const int st = (r >> 4) * 2 + (c >> 5), rr = r & 15, cc = c & 31, ob = rr * 64 + cc * 2; return st * 1024 + (ob ^ (((ob >> 9) & 1) << 5)); }
__host__ __device__ __forceinline__ void stage_rc(int b, int& R, int& C) { const int st = b / 1024, sb = b % 1024, swz = sb ^ (((sb >> 9) & 1) << 5); R = (st >> 1) * 16 + swz / 64; C = (st & 1) * 32 + (swz % 64) / 2; }
__host__ __device__ __forceinline__ int perm32(int rho) { const int n = rho >> 4, i = rho & 15; return 8 * (i >> 2) + 4 * n + (i & 3); }

struct Unit { int pm, pn, aux; const char* A; const char* B; };

struct DenseOrder {
    int nM, nN, nwg, G, c; const char* A; const char* B; size_t astep, bstep;
    __device__ void init(const void* A_, int lda, const void* B_, int K, int M, int N, int G_, int c_) { nM = M / BM; nN = N / BM; nwg = nM * nN; G = G_; c = c_; A = (const char*)A_; B = (const char*)B_; astep = (size_t)BM * lda * 2; bstep = (size_t)BM * K * 2; }
    __device__ bool next(int i, Unit& u) const {
        const long L = (long)i * G + c; if (L >= nwg) return false;
        int wgid = (int)L; { const int q = nwg / NXCD, r = nwg % NXCD, xcd = wgid % NXCD, off = wgid / NXCD; wgid = (xcd < r ? xcd * (q + 1) : r * (q + 1) + (xcd - r) * q) + off; }
        const int nig = WGM * nN, gid = wgid / nig, fm = gid * WGM, gsz = (nM - fm) < WGM ? (nM - fm) : WGM;
        u.pm = fm + ((wgid % nig) % gsz); u.pn = (wgid % nig) / gsz; u.aux = 0; u.A = A + (size_t)u.pm * astep; u.B = B + (size_t)u.pn * bstep; return true;
    }
};

__device__ __forceinline__ unsigned cvt_pk_bf16(float lo, float hi) { unsigned r; asm volatile("v_cvt_pk_bf16_f32 %0, %1, %2" : "=v"(r) : "v"(lo), "v"(hi)); return r; }

typedef f32x4 Acc[2][2][4][2];

struct EpiBf16 {
    static constexpr bool PERM = true;
    bf16_t* O; int ldc; int split_cols; size_t split_stride; float scale0;
    __device__ __forceinline__ void operator()(const Acc& acc, const Unit& u, int wr, int wc, int fr, int fq) const {
        const int row0 = u.pm * BM + wr * 64 + fr; int colt = u.pn * BM; bf16_t* base = O;
        float sc = 1.f; if (split_cols) { const int t = colt / split_cols; base += (size_t)t * split_stride; colt -= t * split_cols; if (t == 0) sc = scale0; }
        const int col0 = colt + wc * 32 + 8 * fq;
#pragma unroll
        for (int ai = 0; ai < 2; ++ai)
#pragma unroll
            for (int m = 0; m < 4; ++m) { bf16_t* rowp = base + (size_t)(row0 + ai * HALF + m * 16) * ldc + col0;
#pragma unroll
                for (int bj = 0; bj < 2; ++bj) { f32x4 v0 = acc[ai][bj][m][0] * sc, v1 = acc[ai][bj][m][1] * sc;
                    u32x4 w; w.x = cvt_pk_bf16(v0[0], v0[1]); w.y = cvt_pk_bf16(v0[2], v0[3]); w.z = cvt_pk_bf16(v1[0], v1[1]); w.w = cvt_pk_bf16(v1[2], v1[3]);
                    *(u32x4*)(rowp + bj * HALF) = w; } }
    }
};
__device__ __forceinline__ void unpack8f(const u32x4 w, f32x4& lo, f32x4& hi) { lo = (f32x4){bflo(w.x), bfhi(w.x), bflo(w.y), bfhi(w.y)}; hi = (f32x4){bflo(w.z), bfhi(w.z), bflo(w.w), bfhi(w.w)}; }
template <bool BASE_BF16>
struct EpiResX {
    static constexpr bool PERM = true;
    const void* base; bf16_t* out;
    __device__ __forceinline__ void operator()(const Acc& acc, const Unit& u, int wr, int wc, int fr, int fq) const {
        const int col0 = u.pn * BM + wc * 32 + 8 * fq; GAS bf16_t* op = (GAS bf16_t*)out;
#pragma unroll
        for (int ai = 0; ai < 2; ++ai) {
            f32x4 b0[4][2], b1[4][2];
#pragma unroll
            for (int m = 0; m < 4; ++m) { const size_t off = (size_t)(u.pm * BM + ai * HALF + wr * 64 + m * 16 + fr) * 1024 + col0;
#pragma unroll
                for (int bj = 0; bj < 2; ++bj) {
                    if (BASE_BF16) { const u32x4 w = *(const GAS u32x4*)((const GAS bf16_t*)base + off + bj * HALF); unpack8f(w, b0[m][bj], b1[m][bj]); }
                    else { b0[m][bj] = *(const GAS f32x4*)((const GAS float*)base + off + bj * HALF); b1[m][bj] = *(const GAS f32x4*)((const GAS float*)base + off + bj * HALF + 4); } } }
            asm volatile("" ::: "memory");
#pragma unroll
            for (int m = 0; m < 4; ++m) { const size_t off = (size_t)(u.pm * BM + ai * HALF + wr * 64 + m * 16 + fr) * 1024 + col0;
#pragma unroll
                for (int bj = 0; bj < 2; ++bj) { const f32x4 v0 = b0[m][bj] + acc[ai][bj][m][0], v1 = b1[m][bj] + acc[ai][bj][m][1];
                    u32x4 w; w.x = cvt_pk_bf16(v0[0], v0[1]); w.y = cvt_pk_bf16(v0[2], v0[3]); w.z = cvt_pk_bf16(v1[0], v1[1]); w.w = cvt_pk_bf16(v1[2], v1[3]);
                    *(GAS u32x4*)(op + off + bj * HALF) = w; } }
            asm volatile("" ::: "memory");
        }
    }
};
struct EpiRouter {
    static constexpr bool PERM = false;
    float* out;
    __device__ __forceinline__ void operator()(const Acc& acc, const Unit& u, int wr, int wc, int fr, int fq) const {
        if (wc >= 2) return;
#pragma unroll
        for (int ai = 0; ai < 2; ++ai)
#pragma unroll
            for (int m = 0; m < 4; ++m) { const size_t off = (size_t)(u.pm * BM + ai * HALF + wr * 64 + m * 16 + fr) * 64 + wc * 32 + 4 * fq;
#pragma unroll
                for (int n = 0; n < 2; ++n) *(f32x4*)(out + off + n * 16) = acc[ai][0][m][n]; }
    }
};
struct EpiGU {
    static constexpr bool PERM = true;
    bf16_t* H;
    __device__ __forceinline__ void operator()(const Acc& acc, const Unit& u, int wr, int wc, int fr, int fq) const {
        const int col0 = u.pn * 128 + wc * 32 + 8 * fq;
#pragma unroll
        for (int ai = 0; ai < 2; ++ai)
#pragma unroll
            for (int m = 0; m < 4; ++m) { bf16_t* rowp = H + (size_t)(u.pm * BM + ai * HALF + wr * 64 + m * 16 + fr) * EH + col0;
                f32x4 g0 = acc[ai][0][m][0], g1 = acc[ai][0][m][1]; const f32x4 u0 = acc[ai][1][m][0], u1 = acc[ai][1][m][1];
#pragma unroll
                for (int e = 0; e < 4; ++e) { g0[e] = g0[e] * sigmoidf_(g0[e]) * u0[e]; g1[e] = g1[e] * sigmoidf_(g1[e]) * u1[e]; }
                u32x4 w; w.x = cvt_pk_bf16(g0[0], g0[1]); w.y = cvt_pk_bf16(g0[2], g0[3]); w.z = cvt_pk_bf16(g1[0], g1[1]); w.w = cvt_pk_bf16(g1[2], g1[3]);
                *(u32x4*)rowp = w; }
    }
};
struct EpiDown {
    static constexpr bool PERM = true;
    bf16_t* Y; const float* gate;
    __device__ __forceinline__ void operator()(const Acc& acc, const Unit& u, int wr, int wc, int fr, int fq) const {
        const int col0 = u.pn * BM + wc * 32 + 8 * fq;
#pragma unroll
        for (int ai = 0; ai < 2; ++ai)
#pragma unroll
            for (int m = 0; m < 4; ++m) { const int row = u.pm * BM + ai * HALF + wr * 64 + m * 16 + fr; const float sc = gate[row]; bf16_t* rowp = Y + (size_t)row * 1024 + col0;
#pragma unroll
                for (int bj = 0; bj < 2; ++bj) { const f32x4 v0 = acc[ai][bj][m][0] * sc, v1 = acc[ai][bj][m][1] * sc;
                    u32x4 w; w.x = cvt_pk_bf16(v0[0], v0[1]); w.y = cvt_pk_bf16(v0[2], v0[3]); w.z = cvt_pk_bf16(v1[0], v1[1]); w.w = cvt_pk_bf16(v1[2], v1[3]);
                    *(u32x4*)(rowp + bj * HALF) = w; } }
    }
};
struct EpiPle {
    static constexpr bool PERM = true;
    const bf16_t* xin; bf16_t* xout; const bf16_t* pp;
    __device__ __forceinline__ void operator()(const Acc& acc, const Unit& u, int wr, int wc, int fr, int fq) const {
        const int col0 = u.pn * BM + wc * 32 + 8 * fq;
        const GAS bf16_t* xp = (const GAS bf16_t*)xin; GAS bf16_t* op = (GAS bf16_t*)xout; const GAS bf16_t* pq = (const GAS bf16_t*)pp;
#pragma unroll
        for (int ai = 0; ai < 2; ++ai) {
            u32x4 xw[4][2], pw[4][2];
#pragma unroll
            for (int m = 0; m < 4; ++m) { const size_t off = (size_t)(u.pm * BM + ai * HALF + wr * 64 + m * 16 + fr) * 1024 + col0;
#pragma unroll
                for (int bj = 0; bj < 2; ++bj) { xw[m][bj] = *(const GAS u32x4*)(xp + off + bj * HALF); pw[m][bj] = *(const GAS u32x4*)(pq + off + bj * HALF); } }
            asm volatile("" ::: "memory");
#pragma unroll
            for (int m = 0; m < 4; ++m) { const size_t off = (size_t)(u.pm * BM + ai * HALF + wr * 64 + m * 16 + fr) * 1024 + col0;
#pragma unroll
                for (int bj = 0; bj < 2; ++bj) { f32x4 x0, x1, p0, p1; unpack8f(xw[m][bj], x0, x1); unpack8f(pw[m][bj], p0, p1); const f32x4 a0 = acc[ai][bj][m][0], a1 = acc[ai][bj][m][1];
#pragma unroll
                    for (int e = 0; e < 4; ++e) { x0[e] += p0[e] * sigmoidf_(a0[e]); x1[e] += p1[e] * sigmoidf_(a1[e]); }
                    u32x4 w; w.x = cvt_pk_bf16(x0[0], x0[1]); w.y = cvt_pk_bf16(x0[2], x0[3]); w.z = cvt_pk_bf16(x1[0], x1[1]); w.w = cvt_pk_bf16(x1[2], x1[3]);
                    *(GAS u32x4*)(op + off + bj * HALF) = w; } }
            asm volatile("" ::: "memory");
        }
    }
};
struct EpiMid {
    static constexpr bool PERM = true;
    bf16_t* MID;
    __device__ __forceinline__ void operator()(const Acc& acc, const Unit& u, int wr, int wc, int fr, int fq) const {
        const int row0 = u.pm * BM + wr * 64 + fr;
        const int mode = (u.pn == 1) ? 2 : 0; const int colbase = u.pn * 256;
#pragma unroll
        for (int ai = 0; ai < 2; ++ai)
#pragma unroll
            for (int m = 0; m < 4; ++m) { bf16_t* rowp = MID + (size_t)(row0 + ai * HALF + m * 16) * 512 + colbase;
#pragma unroll
                for (int bj = 0; bj < 2; ++bj) { const int lc = bj * HALF + wc * 32 + 8 * fq; f32x4 v0 = acc[ai][bj][m][0], v1 = acc[ai][bj][m][1];
#pragma unroll
                    for (int e = 0; e < 4; ++e) {
                        if (mode == 2) { v0[e] = sigmoidf_(v0[e]); v1[e] = sigmoidf_(v1[e]); }
                        else if (lc < 64) { v0[e] = tanhf_(v0[e]); v1[e] = tanhf_(v1[e]); } }
                    u32x4 w; w.x = cvt_pk_bf16(v0[0], v0[1]); w.y = cvt_pk_bf16(v0[2], v0[3]); w.z = cvt_pk_bf16(v1[0], v1[1]); w.w = cvt_pk_bf16(v1[2], v1[3]);
                    *(u32x4*)(rowp + lc) = w; } }
    }
};
struct EpiRwkv2 {
    static constexpr bool PERM = true;
    bf16_t* O0; bf16_t* O1; const float* bias0; const float* bias1; int tybase;
    __device__ __forceinline__ void operator()(const Acc& acc, const Unit& u, int wr, int wc, int fr, int fq) const {
        const int ty = tybase + (u.pn >> 2); const int row0 = u.pm * BM + wr * 64 + fr; const int colt = (u.pn & 3) * BM + wc * 32 + 8 * fq;
        bf16_t* base = (u.pn >> 2) ? O1 : O0; const float* bias = (u.pn >> 2) ? bias1 : bias0;
#pragma unroll
        for (int bj = 0; bj < 2; ++bj) {
            f32x4 b0 = (f32x4){0.f, 0.f, 0.f, 0.f}, b1 = b0;
            if (ty < 2) { b0 = *(const f32x4*)(bias + colt + bj * HALF); b1 = *(const f32x4*)(bias + colt + bj * HALF + 4); }
#pragma unroll
            for (int ai = 0; ai < 2; ++ai)
#pragma unroll
                for (int m = 0; m < 4; ++m) { bf16_t* rowp = base + (size_t)(row0 + ai * HALF + m * 16) * 1024 + colt + bj * HALF;
                    f32x4 v0 = acc[ai][bj][m][0] + b0, v1 = acc[ai][bj][m][1] + b1;
                    if (ty < 2) { const float s = (ty == 0) ? 0.6065306597126334f : 1.0f;
#pragma unroll
                        for (int e = 0; e < 4; ++e) { v0[e] = s * sigmoidf_(v0[e]); v1[e] = s * sigmoidf_(v1[e]); } }
                    u32x4 w; w.x = cvt_pk_bf16(v0[0], v0[1]); w.y = cvt_pk_bf16(v0[2], v0[3]); w.z = cvt_pk_bf16(v1[0], v1[1]); w.w = cvt_pk_bf16(v1[2], v1[3]);
                    *(u32x4*)rowp = w; }
        }
    }
};

template <class Epi, class Sched, bool ALIGN_EPI, bool GATHER>
__device__ __forceinline__ void gemm_phase(PG8_LAS unsigned char* lds, const int K, const int lda, const Sched& S, const Epi& E, const int* __restrict__ rows, const int tid) {
    const int wid = __builtin_amdgcn_readfirstlane(tid >> 6), lane = tid & 63, wr = wid >> 2, wc = wid & 3, fr = lane & 15, fq = lane >> 4;
    const int nt = K / BK;
    unsigned voffA[2], voffB[2]; int RA[2];
#pragma unroll
    for (int i = 0; i < 2; ++i) { int R, C; stage_rc(tid * 16 + i * 8192, R, C); const int Rb = Epi::PERM ? ((R & ~31) + perm32(R & 31)) : R;
        RA[i] = R; voffA[i] = GATHER ? (unsigned)(C * 2) : (unsigned)(R * lda + C) * 2u; voffB[i] = (unsigned)(Rb * K + C) * 2u; }
    const size_t kstep = (size_t)(BK * 2);
    const size_t hstepA = GATHER ? 0 : (size_t)HALF * lda * 2, hstepB = (size_t)HALF * K * 2;
    const unsigned ldsw = (unsigned)wid * 1024u;
    const int aoff = lds_byte(wr * 64 + fr, fq * 8), boff = lds_byte(wc * 32 + fr, fq * 8);
#define PG8_SA(b, h) (((b) * 2 + (h)) * HTB)
#define PG8_SB(b, h) ((4 + (b) * 2 + (h)) * HTB)
#define PG8_ST2(bufoff, gbase, o0, o1) do { \
        __builtin_amdgcn_global_load_lds((const unsigned*)((const char*)(gbase) + (o0)), (PG8_LAS unsigned*)(lds + (bufoff) + ldsw), 16, 0, 0); \
        __builtin_amdgcn_global_load_lds((const unsigned*)((const char*)(gbase) + (o1)), (PG8_LAS unsigned*)(lds + (bufoff) + ldsw + 8192), 16, 0, 0); } while (0)
#define PG8_STB(bufoff, gbase) PG8_ST2(bufoff, gbase, voffB[0], voffB[1])
#define PG8_STA(bufoff, p, h, nx) do { if constexpr (GATHER) { const unsigned g0_ = (nx) ? gN[h][0] : gC[h][0], g1_ = (nx) ? gN[h][1] : gC[h][1]; PG8_ST2(bufoff, p, g0_, g1_); } \
        else { PG8_ST2(bufoff, (p) + (h) * hstepA, voffA[0], voffA[1]); } } while (0)
#define PG8_LDA(dst, b, h) do { _Pragma("unroll") for (int m = 0; m < 4; ++m) _Pragma("unroll") for (int k = 0; k < 2; ++k) dst[m][k] = *(const PG8_LAS bf16x8*)(lds + PG8_SA(b, h) + aoff + m * 2048 + k * 1024); } while (0)
#define PG8_LDB(dst, b, h) do { _Pragma("unroll") for (int n = 0; n < 2; ++n) _Pragma("unroll") for (int k = 0; k < 2; ++k) dst[n][k] = *(const PG8_LAS bf16x8*)(lds + PG8_SB(b, h) + boff + n * 2048 + k * 1024); } while (0)
#define PG8_MMA(ai, bj, At, Bt) do { __builtin_amdgcn_s_setprio(1); _Pragma("unroll") for (int m = 0; m < 4; ++m) _Pragma("unroll") for (int n = 0; n < 2; ++n) _Pragma("unroll") for (int k = 0; k < 2; ++k) \
        acc[ai][bj][m][n] = __builtin_amdgcn_mfma_f32_16x16x32_bf16(Bt[n][k], At[m][k], acc[ai][bj][m][n], 0, 0, 0); __builtin_amdgcn_s_setprio(0); } while (0)
#define PG8_WAIT_V(n) asm volatile("s_waitcnt vmcnt(" #n ")" ::: "memory")
#define PG8_WAIT_L(n) asm volatile("s_waitcnt lgkmcnt(" #n ")" ::: "memory")
#define PG8_BAR __builtin_amdgcn_s_barrier()
#define PG8_SCHED __builtin_amdgcn_sched_barrier(0)
#define PG8_GLOAD(dst, un) do { if constexpr (GATHER) { _Pragma("unroll") for (int h_ = 0; h_ < 2; ++h_) _Pragma("unroll") for (int i_ = 0; i_ < 2; ++i_) \
        dst[h_][i_] = (unsigned)rows[(un).pm * BM + h_ * HALF + RA[i_]] * (unsigned)(lda * 2) + voffA[i_]; } } while (0)
    Unit cur, nxt; int ui = 0;
    if (!S.next(0, cur)) return;
    unsigned gC[2][2] = {{0u, 0u}, {0u, 0u}}, gN[2][2] = {{0u, 0u}, {0u, 0u}};
    PG8_GLOAD(gC, cur);
    Acc acc;
#pragma unroll
    for (int a = 0; a < 2; ++a)
#pragma unroll
        for (int b = 0; b < 2; ++b)
#pragma unroll
            for (int m = 0; m < 4; ++m)
#pragma unroll
                for (int n = 0; n < 2; ++n) acc[a][b][m][n] = (f32x4){0.f, 0.f, 0.f, 0.f};
    bf16x8 At[4][2], B0[2][2], B1[2][2];
    const char* cA = cur.A; const char* cB = cur.B;
    PG8_STB(PG8_SB(0, 0), cB); PG8_STB(PG8_SB(0, 1), cB + hstepB); PG8_STA(PG8_SA(0, 0), cA, 0, false); PG8_STA(PG8_SA(0, 1), cA, 1, false);
    if (wr == 1) PG8_BAR;
    PG8_WAIT_V(2); PG8_BAR;
    PG8_STB(PG8_SB(1, 0), cB + kstep); PG8_STA(PG8_SA(1, 0), cA + kstep, 0, false); PG8_STB(PG8_SB(1, 1), cB + hstepB + kstep);
    PG8_WAIT_V(6); PG8_BAR;
    for (;;) {
        const bool has_next = S.next(ui + 1, nxt);
        if (has_next) { PG8_GLOAD(gN, nxt); }
        const char* nA = has_next ? nxt.A : cA; const char* nB = has_next ? nxt.B : cB;
#pragma unroll 1
        for (int t = 0; t < nt; t += 2) {
            const bool last = (t == nt - 2); const bool nx = last && has_next;
            const char* a1 = cA + (size_t)(t + 1) * kstep;
            const char* a2 = last ? nA : cA + (size_t)(t + 2) * kstep; const char* b2 = last ? nB : cB + (size_t)(t + 2) * kstep;
            const char* a3 = a2 + kstep; const char* b3 = b2 + kstep;
            PG8_LDB(B0, 0, 0); PG8_LDB(B1, 0, 1); PG8_SCHED; PG8_LDA(At, 0, 0); PG8_STA(PG8_SA(1, 1), a1, 1, false);
            PG8_WAIT_V(8); PG8_WAIT_L(0); PG8_BAR; PG8_MMA(0, 0, At, B0); PG8_MMA(0, 1, At, B1); PG8_BAR; PG8_SCHED;
            PG8_LDA(At, 0, 1); PG8_STB(PG8_SB(0, 0), b2); PG8_STB(PG8_SB(0, 1), b2 + hstepB); PG8_STA(PG8_SA(0, 0), a2, 0, nx);
            PG8_WAIT_V(8); PG8_WAIT_L(0); PG8_BAR; PG8_MMA(1, 0, At, B0); PG8_MMA(1, 1, At, B1); PG8_BAR; PG8_SCHED;
            PG8_LDB(B0, 1, 0); PG8_LDB(B1, 1, 1); PG8_SCHED; PG8_LDA(At, 1, 0); PG8_STA(PG8_SA(0, 1), a2, 1, nx);
            PG8_WAIT_V(8); PG8_WAIT_L(0); PG8_BAR; PG8_MMA(0, 0, At, B0); PG8_MMA(0, 1, At, B1); PG8_BAR; PG8_SCHED;
            PG8_LDA(At, 1, 1); PG8_STB(PG8_SB(1, 0), b3); PG8_STB(PG8_SB(1, 1), b3 + hstepB); PG8_STA(PG8_SA(1, 0), a3, 0, nx);
            PG8_WAIT_V(8); PG8_WAIT_L(0); PG8_BAR; PG8_MMA(1, 0, At, B0); PG8_MMA(1, 1, At, B1); PG8_BAR; PG8_SCHED;
        }
        if constexpr (ALIGN_EPI) { if (wr == 0) PG8_BAR; }
        E(acc, cur, wr, wc, fr, fq);
        if (!has_next) break;
#pragma unroll
        for (int a = 0; a < 2; ++a)
#pragma unroll
            for (int b = 0; b < 2; ++b)
#pragma unroll
                for (int m = 0; m < 4; ++m)
#pragma unroll
                    for (int n = 0; n < 2; ++n) acc[a][b][m][n] = (f32x4){0.f, 0.f, 0.f, 0.f};
        cur = nxt; cA = nA; cB = nB; ++ui;
        if constexpr (GATHER) {
#pragma unroll
            for (int h_ = 0; h_ < 2; ++h_)
#pragma unroll
                for (int i_ = 0; i_ < 2; ++i_) gC[h_][i_] = gN[h_][i_]; }
        if constexpr (ALIGN_EPI) { if (wr == 1) PG8_BAR; }
    }
    PG8_WAIT_V(0);
    if constexpr (!ALIGN_EPI) { if (wr == 0) PG8_BAR; }
    PG8_BAR;
#undef PG8_SA
#undef PG8_SB
#undef PG8_ST2
#undef PG8_STB
#undef PG8_STA
#undef PG8_LDA
#undef PG8_LDB
#undef PG8_MMA
#undef PG8_WAIT_V
#undef PG8_WAIT_L
#undef PG8_BAR
#undef PG8_SCHED
#undef PG8_GLOAD
}
}
namespace attn_body {
using bf16=__hip_bfloat16;
using bf16x8=__attribute__((ext_vector_type(8)))short;
using s16x4=__attribute__((ext_vector_type(4)))short;
using f32x16=__attribute__((ext_vector_type(16)))float;
using u32x4=__attribute__((ext_vector_type(4)))unsigned;
constexpr int BATCH=8,NHEAD=16,SEQ=8192,D=64,PQ=512,PO=1024;
constexpr int NW=8,QBLK=32,QB=QBLK*NW,KVBLK=64,NQB=SEQ/QB;
constexpr int ATTN_UNIT_ROWS=QB;
__device__ __forceinline__ int crow(int r,int hi){return (r&3)+8*(r>>2)+4*hi;}
#define SBAR() __builtin_amdgcn_sched_barrier(0)
__device__ __forceinline__ void cmask(f32x16&p0,f32x16&p1,int jb,int qrel,int hi){
  const float NEG=-INFINITY; int kb=64*jb+4*hi;
  #pragma unroll
  for(int r=0;r<16;++r){int kv=kb+(r&3)+8*(r>>2); if(kv>qrel)p0[r]=NEG; if(kv+32>qrel)p1[r]=NEG;}
}

__device__ __forceinline__ void cbias(f32x16&p0,f32x16&p1,int jb,int qrel,int hi,const __attribute__((address_space(3))) float*tb){
  const int kb=64*jb+4*hi;
  #pragma unroll
  for(int r=0;r<16;++r){const int rel=qrel-(kb+(r&3)+8*(r>>2)); const int i0=min(max(rel,0),127), i1=min(max(rel-32,0),127); p0[r]+=tb[i0]; p1[r]+=tb[i1];}
}
constexpr int NSLOT=3, SLOTB=8192;
constexpr int LDS_K=0, LDS_V=NSLOT*SLOTB, LDS_WS=2*NSLOT*SLOTB, LDS_OST=LDS_WS+NW*64*4, LDS_BYTES=LDS_OST+NW*4096;
constexpr float C2=0.125f*1.4426950408889634f;
__device__ __forceinline__ void glds16(const void*gsrc,unsigned lds_dst){unsigned keep;
  asm volatile("s_mov_b32 %0, m0\n\ts_mov_b32 m0, %2\n\ts_nop 0\n\tglobal_load_lds_dwordx4 %1, off\n\ts_mov_b32 m0, %0":"=&s"(keep):"v"(gsrc),"s"(lds_dst):"memory");}
__device__ __forceinline__ float max3f(float a,float b,float c){float r;asm("v_max3_f32 %0, %1, %2, %3":"=v"(r):"v"(a),"v"(b),"v"(c));return r;}
__device__ __forceinline__ float max2f(float a,float b){float r;asm("v_max_f32_e32 %0, %1, %2":"=v"(r):"v"(a),"v"(b));return r;}
__device__ __forceinline__ float fadd_s(float a,float b){float r;asm("v_add_f32_e32 %0, %1, %2":"=v"(r):"v"(a),"v"(b));return r;}
__device__ __forceinline__ float fsub_s(float a,float b){float r;asm("v_sub_f32_e32 %0, %1, %2":"=v"(r):"v"(a),"v"(b));return r;}
typedef float f32x2_t __attribute__((ext_vector_type(2))); typedef __bf16 bf16x2_t __attribute__((ext_vector_type(2)));
__device__ __forceinline__ unsigned cvtpk_s(float lo,float hi){f32x2_t v={lo,hi};bf16x2_t b=__builtin_convertvector(v,bf16x2_t);return __builtin_bit_cast(unsigned,b);}
#define WAIT_BAR(N) asm volatile("s_waitcnt vmcnt(" #N ") lgkmcnt(0)\n\ts_barrier":::"memory")

__device__ __forceinline__ void qkt(f32x16&p0,f32x16&p1,const char*Kslot,const bf16x8*qr,const f32x16&negm,int r32,int hi){
  const char*kb=Kslot+hi*1024+r32*16;
  #pragma unroll
  for(int d0=0;d0<4;++d0){
    const bf16x8 b0=*reinterpret_cast<const bf16x8*>(kb+d0*2048);
    const bf16x8 b1=*reinterpret_cast<const bf16x8*>(kb+d0*2048+512);
    if(d0==0){p0=__builtin_amdgcn_mfma_f32_32x32x16_bf16(b0,qr[0],negm,0,0,0);p1=__builtin_amdgcn_mfma_f32_32x32x16_bf16(b1,qr[0],negm,0,0,0);}
    else{p0=__builtin_amdgcn_mfma_f32_32x32x16_bf16(b0,qr[d0],p0,0,0,0);p1=__builtin_amdgcn_mfma_f32_32x32x16_bf16(b1,qr[d0],p1,0,0,0);}}
}
typedef __attribute__((address_space(3))) const char* lds_cptr;
typedef short v4i16_t __attribute__((ext_vector_type(4)));
__device__ __forceinline__ void kload8(bf16x8*kf,lds_cptr kp){
  kf[0]=*(const __attribute__((address_space(3))) bf16x8*)(kp);      kf[1]=*(const __attribute__((address_space(3))) bf16x8*)(kp+512);
  kf[2]=*(const __attribute__((address_space(3))) bf16x8*)(kp+2048); kf[3]=*(const __attribute__((address_space(3))) bf16x8*)(kp+2560);
  kf[4]=*(const __attribute__((address_space(3))) bf16x8*)(kp+4096); kf[5]=*(const __attribute__((address_space(3))) bf16x8*)(kp+4608);
  kf[6]=*(const __attribute__((address_space(3))) bf16x8*)(kp+6144); kf[7]=*(const __attribute__((address_space(3))) bf16x8*)(kp+6656);
}
__device__ __forceinline__ void kload2(bf16x8*kf,lds_cptr kp,int j){ kf[2*j]=*(const __attribute__((address_space(3))) bf16x8*)(kp+j*2048); kf[2*j+1]=*(const __attribute__((address_space(3))) bf16x8*)(kp+j*2048+512); }
__device__ __forceinline__ s16x4 vtr(lds_cptr p){ return __builtin_bit_cast(s16x4,__builtin_amdgcn_ds_read_tr16_b64_v4i16((__attribute__((address_space(3))) v4i16_t*)p)); }
__device__ __forceinline__ float rowmax(const f32x16&p0,const f32x16&p1){
  float a=max3f(p0[0],p0[1],p1[0]),b=max3f(p0[2],p0[3],p1[1]);a=max3f(a,p1[2],p1[3]);
  #pragma unroll
  for(int r=4;r<16;r+=4){a=max3f(a,p0[r],p0[r+1]);b=max3f(b,p0[r+2],p0[r+3]);a=max3f(a,p1[r],p1[r+1]);b=max3f(b,p1[r+2],p1[r+3]);}
  const float m=max2f(a,b);
  auto rr=__builtin_amdgcn_permlane32_swap(__float_as_uint(m),__float_as_uint(m),false,false);
  return max2f(__uint_as_float(rr[0]),__uint_as_float(rr[1]));
}
__device__ __forceinline__ void pv(f32x16*o,int vb,bf16x8 pa0,bf16x8 pa1,bf16x8 pa2,bf16x8 pa3){
  #pragma unroll
  for(int d0=0;d0<2;++d0){s16x4 lo[4],hi[4];
    #pragma unroll
    for(int ks=0;ks<4;++ks){
      asm volatile("ds_read_b64_tr_b16 %0,%1 offset:%c2":"=&v"(lo[ks]):"v"(vb),"i"(d0*4096+ks*1024):"memory");
      asm volatile("ds_read_b64_tr_b16 %0,%1 offset:%c2":"=&v"(hi[ks]):"v"(vb),"i"(d0*4096+ks*1024+512):"memory");}
    asm volatile("s_waitcnt lgkmcnt(0)":::"memory");SBAR();
    #define PK(k) (bf16x8){lo[k][0],lo[k][1],lo[k][2],lo[k][3],hi[k][0],hi[k][1],hi[k][2],hi[k][3]}
    o[d0]=__builtin_amdgcn_mfma_f32_32x32x16_bf16(pa0,PK(0),o[d0],0,0,0);
    o[d0]=__builtin_amdgcn_mfma_f32_32x32x16_bf16(pa1,PK(1),o[d0],0,0,0);
    o[d0]=__builtin_amdgcn_mfma_f32_32x32x16_bf16(pa2,PK(2),o[d0],0,0,0);
    o[d0]=__builtin_amdgcn_mfma_f32_32x32x16_bf16(pa3,PK(3),o[d0],0,0,0);
    #undef PK
  }
}

#ifndef ATTN_STORE16
#define ATTN_STORE16(p,v) (*(u32x4*)(p)=(v))
#endif
template<int THRL> __device__ __forceinline__ void attn_unit(int b,int vh,int qb,const bf16*Q,const bf16*__restrict__ K,const bf16*__restrict__ V,bf16*O,char*shm,const __attribute__((address_space(3))) float*tball,const int tid){
  const int lane=tid&63,r32=lane&31,hi=lane>>5; const int wid=__builtin_amdgcn_readfirstlane(tid>>6);
  const long rowbase=(long)b*SEQ; const int q0=qb*QB;
  const int hh=vh>>2, qcol=hh*128+((vh>>1)&1)*64, vcol=hh*128+(vh&1)*64;
  const __attribute__((address_space(3))) float*tb=tball+hh*128;
  const bf16*Qw=Q+(rowbase+q0+wid*QBLK)*PQ+qcol;
  const bf16*Kh=K+rowbase*PQ+qcol,*Vh=V+rowbase*PQ+vcol;
  const unsigned lds0=(unsigned)(uintptr_t)shm;
  float*wsf=(float*)(shm+LDS_WS)+wid*64;
  const bf16*ksrc=Kh+(long)lane*PQ+wid*8;
  const bf16*vsrc=Vh+(long)(16*(wid&3)+(lane>>2))*PQ+(wid>>2)*32+(lane&3)*8;
  const unsigned kdst=lds0+LDS_K+wid*1024, vdst=lds0+LDS_V+wid*1024;
  #define DMA_K(t,slot) glds16(ksrc+(long)(t)*KVBLK*PQ,(unsigned)__builtin_amdgcn_readfirstlane(kdst+(slot)))
  #define DMA_V(t,slot) glds16(vsrc+(long)(t)*KVBLK*PQ,(unsigned)__builtin_amdgcn_readfirstlane(vdst+(slot)))
  const int vb0=(int)(lds0+LDS_V)+((lane>>4)&1)*32+(lane&3)*8+(4*hi+((lane&15)>>2))*64;
  const char*Kbase=shm+LDS_K; bf16x8 kf[8];
  const lds_cptr shm3=(lds_cptr)shm; const lds_cptr kp0=shm3+LDS_K+hi*1024+r32*16; const lds_cptr vp0=shm3+LDS_V+((lane>>4)&1)*32+(lane&3)*8+(4*hi+((lane&15)>>2))*64;
  const int NT=(q0+QB)/KVBLK;
  DMA_K(0,0);DMA_V(0,0);DMA_K(1,SLOTB);
  bf16x8 qr[4];
  #pragma unroll
  for(int d0=0;d0<4;++d0)qr[d0]=*reinterpret_cast<const bf16x8*>(&Qw[(long)r32*PQ+d0*16+hi*8]);
  float mhat=0.f,l_reg=0.f;f32x16 o[2];o[0]=f32x16{};o[1]=f32x16{};f32x16 negm=f32x16{};asm volatile("":"+v"(negm));
  const int qrel=wid*QBLK+r32;
  #define CMASK(P0,P1,t) do{int jb_=(t)-(NT-4); if(jb_>=-2){cbias(P0,P1,jb_,qrel,hi,tb); if(jb_>=0)cmask(P0,P1,jb_,qrel,hi);}}while(0)
  bool resc=false;
  #define START(P0,P1) do{ const float rm=rowmax(P0,P1); resc=false; \
    { const float dl=rm; mhat=fadd_s(mhat,dl); \
      _Pragma("unroll") for(int r=0;r<16;++r){P0[r]=fsub_s(P0[r],dl);P1[r]=fsub_s(P1[r],dl);} \
      _Pragma("unroll") for(int r=0;r<16;++r)negm[r]=-mhat; asm volatile("":"+v"(negm)); } \
    _Pragma("unroll") for(int r=0;r<16;++r)P0[r]=__builtin_amdgcn_exp2f(P0[r]); }while(0)
  #define RESC() do{ if(resc){ asm volatile("s_waitcnt lgkmcnt(0)":::"memory"); \
      _Pragma("unroll") for(int d_=0;d_<2;++d_) _Pragma("unroll") for(int r=0;r<16;++r)o[d_][r]*=wsf[crow(r,hi)]; } }while(0)
  f32x16 pA0,pA1,pB0,pB1;
  int sl_prev=0,sl_cur=0,sl_next=SLOTB;
  #define ROT() do{sl_prev=sl_cur;sl_cur=sl_next;sl_next=(sl_next==(NSLOT-1)*SLOTB)?0:sl_next+SLOTB;}while(0)
  DMA_K(2,2*SLOTB);
  WAIT_BAR(3);
  qkt(pA0,pA1,Kbase,qr,negm,r32,hi);asm volatile("s_nop 15\n\ts_nop 7":"+v"(pA0),"+v"(pA1));CMASK(pA0,pA1,0);
  START(pA0,pA1);
  _Pragma("unroll") for(int r=0;r<16;++r)pA1[r]=__builtin_amdgcn_exp2f(pA1[r]);
  WAIT_BAR(0);
  DMA_K(3,0);DMA_V(1,SLOTB);
  ROT();
  kload8(kf,kp0+sl_cur);
  WAIT_BAR(2);
  s16x4 vlo[8],vhi[8]; u32x4 pw0,pw1,pw2,pw3;
  #define PKW(P,B) cvtpk_s(P[B],P[B+1])
  #define PAF(k) __builtin_bit_cast(bf16x8,pw##k)
  #define VFR(i) (bf16x8){vlo[i][0],vlo[i][1],vlo[i][2],vlo[i][3],vhi[i][0],vhi[i][1],vhi[i][2],vhi[i][3]}
  #define PIN(x) asm volatile("":"+v"(x))
  #define MX3(a,b,c) __builtin_fmaxf(__builtin_fmaxf((a),(b)),(c))
  #define GAPA(MF,A0,A1,A2,A3,W0,W1,PW) do{ MF; sacc+=A0; sacc+=A1; sacc+=A2; sacc+=A3; PIN(sacc); W0; W1; PIN(PW); SBAR(); }while(0)
  #define EX(v) __builtin_amdgcn_exp2f(v)
  #define GAPB(MF,X,B) do{ MF; X[B]=EX(X[B]); X[B+1]=EX(X[B+1]); X[B+2]=EX(X[B+2]); X[B+3]=EX(X[B+3]); PIN(X); SBAR(); }while(0)
  #define VRD(i) do{ vlo[i]=vtr(vp_+(((i)>>2)*4096+((i)&3)*1024)); vhi[i]=vtr(vp_+(((i)>>2)*4096+((i)&3)*1024+512)); }while(0)
  #define KRD(G,j) do{ if(G){ kload2(kf,kp0+sl_next,j); SBAR(); } }while(0)
  #define STEP(C0,C1,P0,P1,t,GK,GV,GL) do{ SBAR(); \
    const lds_cptr vp_=vp0+sl_prev; \
    VRD(0); SBAR(); float sacc=(P0[0]+P0[1]); \
    GAPA(C0=__builtin_amdgcn_mfma_f32_32x32x16_bf16(kf[0],qr[0],negm,0,0,0), P0[2],P0[3],P0[4],P0[5],     pw0[0]=PKW(P0,0), pw0[1]=PKW(P0,2), pw0); \
    VRD(4); SBAR(); GAPA(C1=__builtin_amdgcn_mfma_f32_32x32x16_bf16(kf[1],qr[0],negm,0,0,0), P0[6],P0[7],P0[8],P0[9],     pw0[2]=PKW(P0,4), pw0[3]=PKW(P0,6), pw0); \
    VRD(1); SBAR(); GAPA(C0=__builtin_amdgcn_mfma_f32_32x32x16_bf16(kf[2],qr[1],C0,0,0,0),   P0[10],P0[11],P0[12],P0[13], pw1[0]=PKW(P0,8), pw1[1]=PKW(P0,10), pw1); \
    VRD(5); SBAR(); GAPA(C1=__builtin_amdgcn_mfma_f32_32x32x16_bf16(kf[3],qr[1],C1,0,0,0),   P0[14],P0[15],P1[0],P1[1],   pw1[2]=PKW(P0,12),pw1[3]=PKW(P0,14), pw1); \
    VRD(2); SBAR(); GAPA(C0=__builtin_amdgcn_mfma_f32_32x32x16_bf16(kf[4],qr[2],C0,0,0,0),   P1[2],P1[3],P1[4],P1[5],     pw2[0]=PKW(P1,0), pw2[1]=PKW(P1,2), pw2); \
    VRD(6); SBAR(); GAPA(C1=__builtin_amdgcn_mfma_f32_32x32x16_bf16(kf[5],qr[2],C1,0,0,0),   P1[6],P1[7],P1[8],P1[9],     pw2[2]=PKW(P1,4), pw2[3]=PKW(P1,6), pw2); \
    VRD(3); SBAR(); GAPA(C0=__builtin_amdgcn_mfma_f32_32x32x16_bf16(kf[6],qr[3],C0,0,0,0),   P1[10],P1[11],P1[12],P1[13], pw3[0]=PKW(P1,8), pw3[1]=PKW(P1,10), pw3); \
    VRD(7); SBAR(); GAPA(C1=__builtin_amdgcn_mfma_f32_32x32x16_bf16(kf[7],qr[3],C1,0,0,0),   P1[14],P1[15],0.f,0.f,       pw3[2]=PKW(P1,12),pw3[3]=PKW(P1,14), pw3); \
    l_reg+=sacc; \
    if(GK){DMA_K((t)+3,sl_cur);} if(GV){DMA_V((t)+1,sl_next);} \
    CMASK(C0,C1,t); \
    { float a=MX3(C0[0],C0[1],C1[0]),b=MX3(C0[2],C0[3],C1[1]); a=MX3(a,C1[2],C1[3]); \
      _Pragma("unroll") for(int r=4;r<16;r+=4){a=MX3(a,C0[r],C0[r+1]);b=MX3(b,C0[r+2],C0[r+3]);a=MX3(a,C1[r],C1[r+1]);b=MX3(b,C1[r+2],C1[r+3]);} \
      float rm=__builtin_fmaxf(a,b); { auto rr=__builtin_amdgcn_permlane32_swap(__float_as_uint(rm),__float_as_uint(rm),false,false); rm=__builtin_fmaxf(__uint_as_float(rr[0]),__uint_as_float(rr[1])); } \
      resc=false; \
      if(__builtin_expect(__any(rm>(float)THRL),0)){ const float dl=__builtin_fmaxf(rm,0.f); mhat+=dl; \
        _Pragma("unroll") for(int r=0;r<16;++r){C0[r]-=dl;C1[r]-=dl;} \
        _Pragma("unroll") for(int r=0;r<16;++r)negm[r]=-mhat; asm volatile("":"+v"(negm)); \
        const float f=__builtin_amdgcn_exp2f(-dl); l_reg*=f; if(hi==0)wsf[r32]=f; resc=true; } } \
    SBAR(); \
    GAPB(o[0]=__builtin_amdgcn_mfma_f32_32x32x16_bf16(PAF(0),VFR(0),o[0],0,0,0), C0,0); \
    GAPB(o[1]=__builtin_amdgcn_mfma_f32_32x32x16_bf16(PAF(0),VFR(4),o[1],0,0,0), C0,4); \
    KRD(GL,0); GAPB(o[0]=__builtin_amdgcn_mfma_f32_32x32x16_bf16(PAF(1),VFR(1),o[0],0,0,0), C0,8); \
    KRD(GL,1); GAPB(o[1]=__builtin_amdgcn_mfma_f32_32x32x16_bf16(PAF(1),VFR(5),o[1],0,0,0), C0,12); \
    KRD(GL,2); GAPB(o[0]=__builtin_amdgcn_mfma_f32_32x32x16_bf16(PAF(2),VFR(2),o[0],0,0,0), C1,0); \
    KRD(GL,3); GAPB(o[1]=__builtin_amdgcn_mfma_f32_32x32x16_bf16(PAF(2),VFR(6),o[1],0,0,0), C1,4); \
    GAPB(o[0]=__builtin_amdgcn_mfma_f32_32x32x16_bf16(PAF(3),VFR(3),o[0],0,0,0), C1,8); \
    GAPB(o[1]=__builtin_amdgcn_mfma_f32_32x32x16_bf16(PAF(3),VFR(7),o[1],0,0,0), C1,12); \
    }while(0)
  int t=1;
  #undef CMASK
  #define CMASK(P0,P1,t) do{}while(0)
  for(;t+7<NT;t+=2){
    STEP(pB0,pB1,pA0,pA1,t,true,true,true);     WAIT_BAR(2); RESC(); ROT();
    STEP(pA0,pA1,pB0,pB1,t+1,true,true,true);   WAIT_BAR(2); RESC(); ROT();
  }
  #undef CMASK
  #define CMASK(P0,P1,t) do{int jb_=(t)-(NT-4); if(jb_>=-2){cbias(P0,P1,jb_,qrel,hi,tb); if(jb_>=0)cmask(P0,P1,jb_,qrel,hi);}}while(0)
  #define ENDW(tt) do{ if((tt)+3<NT){WAIT_BAR(2);} else if((tt)+2<NT){WAIT_BAR(1);} else {WAIT_BAR(0);} }while(0)
  for(;t+1<NT;t+=2){
    STEP(pB0,pB1,pA0,pA1,t,(t+3<NT),(t+1<NT),(t+1<NT));       ENDW(t);   RESC(); ROT();
    STEP(pA0,pA1,pB0,pB1,t+1,(t+4<NT),(t+2<NT),(t+2<NT));     ENDW(t+1); RESC(); ROT();
  }
  STEP(pB0,pB1,pA0,pA1,NT-1,false,false,false); RESC();
  { float sacc=pB0[0]+pB0[1]; _Pragma("unroll") for(int r=2;r<16;++r)sacc+=pB0[r]; _Pragma("unroll") for(int r=0;r<16;++r)sacc+=pB1[r]; l_reg+=sacc;
    pw0=(u32x4){PKW(pB0,0),PKW(pB0,2),PKW(pB0,4),PKW(pB0,6)};pw1=(u32x4){PKW(pB0,8),PKW(pB0,10),PKW(pB0,12),PKW(pB0,14)};pw2=(u32x4){PKW(pB1,0),PKW(pB1,2),PKW(pB1,4),PKW(pB1,6)};pw3=(u32x4){PKW(pB1,8),PKW(pB1,10),PKW(pB1,12),PKW(pB1,14)};
    SBAR(); pv(o,vb0+sl_cur,PAF(0),PAF(1),PAF(2),PAF(3)); }
  #undef PKW
  #undef PAF
  #undef VFR
  #undef PIN
  #undef MX3
  #undef GAPA
  #undef GAPB
  #undef EX
  #undef VRD
  #undef KRD
  #undef STEP
  #undef ENDW
  {auto rr=__builtin_amdgcn_permlane32_swap(__float_as_uint(l_reg),__float_as_uint(l_reg),false,false);l_reg=__uint_as_float(rr[0])+__uint_as_float(rr[1]);}
  if(hi==0)wsf[32+r32]=l_reg;asm volatile("s_waitcnt lgkmcnt(0)":::"memory");
  float rli[16];
  #pragma unroll
  for(int r=0;r<16;++r)rli[r]=__builtin_amdgcn_rcpf(wsf[32+crow(r,hi)]);
  bf16*Ow=O+(rowbase+q0+wid*QBLK)*PO+vh*D;
  { bf16*stg=(bf16*)(shm+LDS_OST)+wid*2048;
    #pragma unroll
    for(int r=0;r<16;++r){const int orow=crow(r,hi);
      #pragma unroll
      for(int d0=0;d0<2;++d0)stg[orow*64+d0*32+r32]=__float2bfloat16(o[d0][r]*rli[r]);}
    asm volatile("s_waitcnt lgkmcnt(0)":::"memory");
    #pragma unroll
    for(int i=0;i<4;++i){const int row=i*8+(lane>>3),ch=lane&7; const u32x4 v=*(const u32x4*)(stg+row*64+ch*8); ATTN_STORE16(Ow+(long)row*PO+ch*8,v);} }
  asm volatile("s_waitcnt lgkmcnt(0)\n\ts_barrier":::"memory");
  #undef DMA_K
  #undef DMA_V
  #undef CMASK
  #undef START
  #undef RESC
  #undef ROT
}
constexpr int ATTN_LDS_BYTES=LDS_BYTES;
struct AttnTensors { const bf16* Q; const bf16* K; const bf16* V; bf16* O; };
struct AttnUnit { int bh; int qb; };
__device__ __forceinline__ bool attn_next(int vcu,int i,AttnUnit&u){ if(i>=16)return false; const int s=vcu&7, j=i&3; u.bh=(vcu>>3)+32*(i>>2); u.qb=(j==0)?s:(j==1)?15-s:(j==2)?16+s:31-s; return true; }
template<int THRL=8> __device__ __forceinline__ void attn_phase(char*lds,const AttnTensors&T,int vcu,const __attribute__((address_space(3))) float*tball,const int tid){
  AttnUnit u;
  for(int i=0;attn_next(vcu,i,u);++i){ attn_unit<THRL>(u.bh/NHEAD,u.bh%NHEAD,u.qb,T.Q,T.K,T.V,T.O,lds,tball,tid); }
}
#undef SBAR
#undef WAIT_BAR
}

#define XB_TMO      128
#define XB_XCNT(j)  (256  + 64 * (j))
#define XB_XSUB(j)  (1280 + 64 * (j))
#define XB_XGEN(j)  (2304 + 64 * (j))
#define XB_TOP      3328
#define XB_TOPGEN   3392
#define XCD_BAR_WORDS 3456
#define XB_SPIN_CAP (1u << 18)

__device__ __forceinline__ unsigned xb_ld(unsigned* p)              { return __hip_atomic_load(p, __ATOMIC_RELAXED, __HIP_MEMORY_SCOPE_AGENT); }
__device__ __forceinline__ unsigned xb_add(unsigned* p, unsigned v) { return __hip_atomic_fetch_add(p, v, __ATOMIC_RELAXED, __HIP_MEMORY_SCOPE_AGENT); }
__device__ __forceinline__ unsigned xb_xcc_id() { return (unsigned)__builtin_amdgcn_s_getreg((3 << 11) | 20) & 0xFu; }
#define XB_SPIN(cond, bar) do { unsigned _sp = 0; while (cond) { __builtin_amdgcn_s_sleep(1); \
    if ((++_sp & 255u) == 0u) { if (xb_ld(&(bar)[XB_TMO])) break; if (_sp > XB_SPIN_CAP) { atomicAdd(&(bar)[XB_TMO], 1u); break; } } } } while (0)

struct XcdBarrier {
    unsigned* bar; unsigned x;
    volatile LAS unsigned* st;
};

__device__ __forceinline__ XcdBarrier xcd_barrier_post(unsigned* bar, volatile LAS unsigned* st, const bool leader  ) {
    XcdBarrier b; b.bar = bar; b.x = xb_xcc_id(); b.st = st;
    if (leader) (void)xb_add(&bar[XB_XCNT(b.x)], 1u);
    return b;
}
__device__ __forceinline__ void xcd_barrier_complete(unsigned* bar, unsigned x, unsigned& nloc, unsigned& nx) {
    const unsigned G = gridDim.x * gridDim.y * gridDim.z;
    unsigned sum, cnt, mine, sp = 0u;
    for (;;) {
        sum = 0u; cnt = 0u; mine = 0u;
#pragma unroll
        for (unsigned j = 0; j < 16; ++j) { const unsigned c = xb_ld(&bar[XB_XCNT(j)]); sum += c; cnt += (c > 0u) ? 1u : 0u; mine = (j == x) ? c : mine; }
        if (sum == G) break;
        __builtin_amdgcn_s_sleep(1);
        if ((++sp & 255u) == 0u) { if (xb_ld(&bar[XB_TMO])) break; if (sp > XB_SPIN_CAP) { atomicAdd(&bar[XB_TMO], 1u); break; } }
    }
    nloc = mine > 0u ? mine : 1u; nx = cnt > 0u ? cnt : 1u;
}

__device__ __forceinline__ void xcd_barrier(const XcdBarrier& b, const bool leader  ) {
    asm volatile("s_waitcnt vmcnt(0)" ::: "memory");
    __syncthreads();
    if (leader) {
        unsigned* bar = b.bar;
        __builtin_amdgcn_s_waitcnt(0);
        unsigned nloc = b.st[0], nx = b.st[1];
        if (nloc == 0u) { xcd_barrier_complete(bar, b.x, nloc, nx); b.st[0] = nloc; b.st[1] = nx; }
        const unsigned old = xb_add(&bar[XB_XSUB(b.x)], 1u);
        const unsigned gen = old / nloc;
        if (old + 1u == (gen + 1u) * nloc) {
            __builtin_amdgcn_fence(__ATOMIC_RELEASE, "agent");
            asm volatile("s_waitcnt vmcnt(0)" ::: "memory");
            const unsigned og = xb_add(&bar[XB_TOP], 1u);
            const unsigned tg = og / nx;
            if (og + 1u == (tg + 1u) * nx) xb_add(&bar[XB_TOPGEN], 1u);
            else XB_SPIN(xb_ld(&bar[XB_TOPGEN]) == tg, bar);
            __builtin_amdgcn_fence(__ATOMIC_ACQUIRE, "agent");
            xb_add(&bar[XB_XGEN(b.x)], 1u);
            asm volatile("s_waitcnt vmcnt(0)" ::: "memory");
        } else {
            XB_SPIN(xb_ld(&bar[XB_XGEN(b.x)]) == gen, bar);
            __builtin_amdgcn_fence(__ATOMIC_ACQUIRE, "agent");
            asm volatile("s_waitcnt vmcnt(0)" ::: "memory");
        }
    }
    __syncthreads();
}

constexpr size_t MiB = 1u << 20;
constexpr size_t WS_CTL = 0, CTL_ZERO_BYTES = 1 * MiB;
constexpr size_t WS_WIN = 2 * MiB;
constexpr size_t WS_WOUT = 7 * MiB;
constexpr size_t WS_PGATE = 9 * MiB;
constexpr size_t WS_PPROJ = 13 * MiB;
constexpr size_t WS_RCAT = 14 * MiB;
constexpr size_t WS_RL1 = 20 * MiB;
constexpr size_t WS_RS2 = 28 * MiB;
constexpr size_t WS_RWO = 30 * MiB;
constexpr size_t WS_ROUT = 32 * MiB;
constexpr size_t WS_LRUAGG = 33 * MiB;
constexpr size_t WS_MGU = 38 * MiB;
constexpr size_t WS_MDN = 102 * MiB;
constexpr size_t WS_PB = 134 * MiB;
constexpr size_t WS_ACT = 166 * MiB;
constexpr size_t WS_H0 = WS_ACT;
constexpr size_t WS_QKV = WS_ACT + 128 * MiB;
constexpr size_t WS_O = WS_ACT + 448 * MiB;
constexpr size_t WS_HL = WS_ACT + 576 * MiB, WS_CA = WS_ACT + 640 * MiB;
constexpr size_t WS_H2 = WS_ACT;
constexpr size_t WS_LOG = WS_ACT + 128 * MiB;
constexpr size_t WS_ROUTE = WS_ACT + 144 * MiB;
constexpr size_t WS_HID = WS_ACT + 152 * MiB;
constexpr size_t WS_YS = WS_ACT + 288 * MiB;
constexpr size_t WS_PP = WS_ACT + 128 * MiB;
constexpr size_t WS_HCAT = WS_ACT;
constexpr size_t WS_XR = WS_ACT + 256 * MiB, WS_XK = WS_ACT + 384 * MiB, WS_XV = WS_ACT + 512 * MiB;
constexpr size_t WS_R = WS_ACT + 640 * MiB, WS_K = WS_XR, WS_V = WS_XK;
constexpr size_t WS_MID = WS_ACT + 768 * MiB;
constexpr size_t WS_EW = WS_ACT;
constexpr size_t WS_AA = WS_ACT + 128 * MiB;
constexpr size_t WS_Y = WS_XV;
constexpr size_t WS_END = WS_ACT + 832 * MiB;
static_assert(WS_END <= 1024 * MiB, "workspace map");
constexpr size_t RT_EID = 0, RT_POS = 1 * MiB, RT_GATE = 2 * MiB, RT_ROWTOK = 3 * MiB, RT_ROWGATE = 4 * MiB, RT_SLOT = 5 * MiB;
constexpr int CW_BAR = 4096;
constexpr int CW_CNT0 = 16384, CW_CNT1 = 16384 + 64;

constexpr int RING_BYTES = 131072;
constexpr int LDSCTL_OFF = RING_BYTES, MISC_OFF = LDSCTL_OFF + 320;
constexpr int TB_OFF = RING_BYTES + 1024;
constexpr int RTE_OFF = TB_OFF + 2048;
constexpr int LDS_BYTES = 147456;

constexpr int NWAVES = 8;
__device__ __forceinline__ int lane_id_() { int l; asm volatile("v_mbcnt_lo_u32_b32 %0, -1, 0\n\tv_mbcnt_hi_u32_b32 %0, -1, %0" : "=v"(l)); return l; }
#define TID_ (F.wave * 64 + lane_id_())
#define LANE_ (lane_id_())
struct Frame {
    LAS unsigned char* lds; volatile LAS unsigned* MISC; gu32* ctl;
    int wave, vcu, G;
};

__device__ __forceinline__ void load_row4(const float* xrow, int lane, f32x4 (&v)[4]) { const f32x4* p = (const f32x4*)xrow + lane;
#pragma unroll
    for (int j = 0; j < 4; ++j) v[j] = p[64 * j]; }
__device__ __forceinline__ float row_rstd(const f32x4 (&v)[4], float eps) { float s = 0.f;
#pragma unroll
    for (int j = 0; j < 4; ++j) s += (v[j].x * v[j].x + v[j].y * v[j].y) + (v[j].z * v[j].z + v[j].w * v[j].w);
    return 1.0f / sqrtf(wave_sum(s) * (1.0f / 1024.0f) + eps); }
__device__ __forceinline__ void load_row4_bf(const bf16* xrow, int lane, f32x4 (&v)[4]) { const v2u* p = (const v2u*)xrow + lane;
#pragma unroll
    for (int j = 0; j < 4; ++j) { const v2u w = p[64 * j]; v[j] = (f32x4){bflo(w.x), bfhi(w.x), bflo(w.y), bfhi(w.y)}; } }
__device__ __forceinline__ void store_row4_bf(bf16* xrow, int lane, const f32x4 (&v)[4]) { v2u* p = (v2u*)xrow + lane;
#pragma unroll
    for (int j = 0; j < 4; ++j) { v2u o; o.x = pk2(v[j].x, v[j].y); o.y = pk2(v[j].z, v[j].w); p[64 * j] = o; } }
__device__ __forceinline__ void store_row_bf16(bf16* orow, int lane, const f32x4 (&v)[4], float rstd, const float* g) {
    unsigned long long* o8 = (unsigned long long*)orow + lane;
#pragma unroll
    for (int j = 0; j < 4; ++j) { const f32x4 gg = ((const f32x4*)g)[lane + 64 * j];
        o8[64 * j] = (unsigned long long)pk2(v[j].x * rstd * gg.x, v[j].y * rstd * gg.y) | ((unsigned long long)pk2(v[j].z * rstd * gg.z, v[j].w * rstd * gg.w) << 32); }
}

template <int MODE>
__device__ __forceinline__ void transpose_item(const float* W, int K, int N, bf16* WT, int ldo, int row_off, const float* mu, LAS float* scr, int item, int lane) {
    const int nblk = N / 32, kb = item / nblk, nb = item % nblk, k0 = 64 * kb, n0 = 32 * nb;
    float ld[32];
#pragma unroll
    for (int i = 0; i < 32; ++i) { const int kk = 2 * i + (lane >> 5); ld[i] = W[(size_t)(k0 + kk) * N + n0 + (lane & 31)]; }
#pragma unroll
    for (int i = 0; i < 32; ++i) { const int kk = 2 * i + (lane >> 5); scr[kk * 33 + (lane & 31)] = ld[i]; }
    LDS_WAIT(); asm volatile("" ::: "memory");
    const int c = lane & 7;
    int rbase = row_off + n0;
    if (MODE == 2) { rbase = row_off + ((n0 < 512) ? ((n0 >> 7) * 256 + (n0 & 127)) : (((n0 - 512) >> 7) * 256 + 128 + ((n0 - 512) & 127))); }
    float m[8];
    if (MODE == 1) {
#pragma unroll
        for (int e = 0; e < 8; ++e) m[e] = mu[k0 + 8 * c + e]; }
#pragma unroll
    for (int j = 0; j < 4; ++j) { const int n = (lane >> 3) + 8 * j; const LAS float* s = scr + (8 * c) * 33 + n;
        float v[8];
#pragma unroll
        for (int e = 0; e < 8; ++e) v[e] = s[e * 33];
        bf16* dst = WT + (size_t)(rbase + n) * ldo + k0 + 8 * c;
        if (MODE == 1) {
            v4u o, o2;
            o.x = pk2(v[0] * (1.f - m[0]), v[1] * (1.f - m[1])); o.y = pk2(v[2] * (1.f - m[2]), v[3] * (1.f - m[3])); o.z = pk2(v[4] * (1.f - m[4]), v[5] * (1.f - m[5])); o.w = pk2(v[6] * (1.f - m[6]), v[7] * (1.f - m[7]));
            o2.x = pk2(v[0] * m[0], v[1] * m[1]); o2.y = pk2(v[2] * m[2], v[3] * m[3]); o2.z = pk2(v[4] * m[4], v[5] * m[5]); o2.w = pk2(v[6] * m[6], v[7] * m[7]);
            *(GAS v4u*)dst = o; *(GAS v4u*)(dst + 1024) = o2;
        } else {
            v4u o; o.x = pk2(v[0], v[1]); o.y = pk2(v[2], v[3]); o.z = pk2(v[4], v[5]); o.w = pk2(v[6], v[7]);
            *(GAS v4u*)dst = o; }
    }
    LDS_WAIT(); asm volatile("" ::: "memory");
}

struct In {
    const float *x, *p, *rel_bias, *norm_mix, *ab_w_in, *ab_w_out, *lam_q1, *lam_k1, *lam_q2, *lam_k2, *sub_g, *conv_w, *conv_b, *lru_wa, *lru_ba, *lru_wx, *lru_bx, *lru_lambda,
        *rwkv_mu, *rwkv_wr, *rwkv_wk, *rwkv_wv, *rwkv_wo, *rwkv_w0, *rwkv_w1, *rwkv_w2, *rwkv_a0, *rwkv_a1, *rwkv_a2, *rwkv_g1, *rwkv_g2, *rwkv_kk, *rwkv_ka, *rwkv_rk, *rwkv_ln_g, *rwkv_ln_b,
        *norm_ffn, *moe_wc, *moe_bc, *moe_wf, *moe_bf, *moe_w_gu, *moe_w_down, *ple_norm, *ple_gate, *ple_proj, *final_norm;
};

__device__ __forceinline__ void prep_dense_weights(Frame& F, const In& I, unsigned char* ws) {
    LAS float* scr = (LAS float*)(F.lds + F.wave * 16384);
    const int gw = F.vcu * NWAVES + F.wave, NGW = F.G * NWAVES;
    bf16* WIN = (bf16*)(ws + WS_WIN); bf16* WOUT = (bf16*)(ws + WS_WOUT); bf16* PG = (bf16*)(ws + WS_PGATE); bf16* PPJ = (bf16*)(ws + WS_PPROJ);
    bf16* RCAT = (bf16*)(ws + WS_RCAT); bf16* RL1 = (bf16*)(ws + WS_RL1); bf16* RWO = (bf16*)(ws + WS_RWO);
    constexpr int I_IN = (1024 / 64) * (2560 / 32), I_SQ = (1024 / 64) * (1024 / 32), I_PJ = (256 / 64) * (1024 / 32), I_L64 = (1024 / 64) * (64 / 32), I_L160 = (1024 / 64) * (160 / 32);
    int st = gw;
#define TJOB(MODE, NITEMS, W, K, N, WT, LDO, ROFF, MU) do { for (int it = st; it < (NITEMS); it += NGW) transpose_item<MODE>(W, K, N, WT, LDO, ROFF, MU, scr, it, LANE_); \
        st = (st + NGW - ((NITEMS) % NGW)) % NGW; asm volatile("" : "+s"(st)); } while (0)
    TJOB(0, I_IN, I.ab_w_in, 1024, 2560, WIN, 1024, 0, nullptr);
    TJOB(0, I_SQ, I.ab_w_out, 1024, 1024, WOUT, 1024, 0, nullptr);
    TJOB(0, I_SQ, I.ple_gate, 1024, 1024, PG, 1024, 0, nullptr);
    TJOB(0, I_SQ, I.ple_gate + 1024 * 1024, 1024, 1024, PG + 1024 * 1024, 1024, 0, nullptr);
    TJOB(0, I_SQ, I.rwkv_wo, 1024, 1024, RWO, 1024, 0, nullptr);
    TJOB(0, I_SQ, I.rwkv_wr, 1024, 1024, RCAT, 1024, 0, nullptr);
    TJOB(0, I_SQ, I.rwkv_wk, 1024, 1024, RCAT, 1024, 1024, nullptr);
    TJOB(0, I_SQ, I.rwkv_wv, 1024, 1024, RCAT, 1024, 2048, nullptr);
    TJOB(0, I_PJ, I.ple_proj, 256, 1024, PPJ, 256, 0, nullptr);
    TJOB(0, I_PJ, I.ple_proj + 256 * 1024, 256, 1024, PPJ + 1024 * 256, 256, 0, nullptr);
    TJOB(1, I_L64, I.rwkv_w1, 1024, 64, RL1, 2048, 0, I.rwkv_mu + 1 * 1024);
    TJOB(1, I_L64, I.rwkv_a1, 1024, 64, RL1, 2048, 64, I.rwkv_mu + 4 * 1024);
    TJOB(1, I_L160, I.rwkv_g1, 1024, 160, RL1, 2048, 256, I.rwkv_mu + 5 * 1024);
#undef TJOB
    const int gt = F.vcu * 512 + TID_, NGT = F.G * 512;
    { v4u z = {0u, 0u, 0u, 0u}; const int per_row = 2048 / 8;
      for (int i = gt; i < (128 + 96) * per_row; i += NGT) { int rr = i / per_row, cc = i % per_row; rr = (rr < 128) ? (128 + rr) : (416 + rr - 128); *(GAS v4u*)(RL1 + (size_t)rr * 2048 + cc * 8) = z; } }
    { bf16* S2 = (bf16*)(ws + WS_RS2);
      for (int i = gt; i < 3 * 1024 * 256; i += NGT) { const int ty = i / (1024 * 256), n = (i / 256) & 1023, k = i & 255; float v = 0.f;
          if (ty == 0) { if (k < 64) v = I.rwkv_w2[k * 1024 + n]; } else if (ty == 1) { if (k >= 64 && k < 128) v = I.rwkv_a2[(k - 64) * 1024 + n]; } else { if (k < 160) v = I.rwkv_g2[k * 1024 + n]; }
          S2[i] = (bf16)f2bf(v); } }
    { bf16* RT = (bf16*)(ws + WS_ROUT);
      for (int i = gt; i < 2 * 256 * 1024; i += NGT) { const int l = i / (256 * 1024), n = (i / 1024) & 255, k = i & 1023; float v = 0.f;
          if (n < 4) v = I.moe_wc[(size_t)l * 1024 * 4 + k * 4 + n]; else if (n < 36) v = I.moe_wf[(size_t)l * 1024 * 32 + k * 32 + (n - 4)];
          RT[i] = (bf16)f2bf(v); } }
}
__device__ __forceinline__ void prep_layer_weights(Frame& F, const In& I, unsigned char* ws, int layer) {
    LAS float* scr = (LAS float*)(F.lds + F.wave * 16384);
    const int gw = F.vcu * NWAVES + F.wave, NGW = F.G * NWAVES;
    bf16* MGU = (bf16*)(ws + WS_MGU); bf16* MDN = (bf16*)(ws + WS_MDN);
    const float* wgu = I.moe_w_gu + (size_t)layer * NEXP * 1024 * 1024; const float* wdn = I.moe_w_down + (size_t)layer * NEXP * 512 * 1024;
    constexpr int I_GU = (1024 / 64) * (1024 / 32), I_DN = (512 / 64) * (1024 / 32);
    for (int it = gw; it < NEXP * (I_GU + I_DN); it += NGW) {
        const int e = it / (I_GU + I_DN); int r = it % (I_GU + I_DN);
        if (r < I_GU) transpose_item<2>(wgu + (size_t)e * 1024 * 1024, 1024, 1024, MGU + (size_t)e * 1024 * 1024, 1024, 0, nullptr, scr, r, LANE_);
        else transpose_item<0>(wdn + (size_t)e * 512 * 1024, 512, 1024, MDN + (size_t)e * 1024 * 512, 512, 0, nullptr, scr, r - I_GU, LANE_);
    }
    const int gt = F.vcu * 512 + TID_, NGT = F.G * 512;
    const f32x4* ps = (const f32x4*)(I.p + (size_t)layer * T * PLE); v2u* pd = (v2u*)(ws + WS_PB);
    for (int i = gt; i < T * PLE / 4; i += 4 * NGT) { f32x4 v[4];
#pragma unroll
        for (int r = 0; r < 4; ++r) v[r] = ps[i + r * NGT];
#pragma unroll
        for (int r = 0; r < 4; ++r) { v2u o; o.x = pk2(v[r].x, v[r].y); o.y = pk2(v[r].z, v[r].w); pd[i + r * NGT] = o; } }
}

template <bool XBF>
__device__ __forceinline__ void norm_pass(Frame& F, const void* x, const float* g, bf16* out) {
    const int gw = F.vcu * NWAVES + F.wave, NGW = F.G * NWAVES; const int lane = LANE_;
    for (int t = 4 * gw; t < T; t += 4 * NGW) {
        f32x4 v[4][4];
#pragma unroll
        for (int r = 0; r < 4; ++r) { if (XBF) load_row4_bf((const bf16*)x + (size_t)(t + r) * D, lane, v[r]); else load_row4((const float*)x + (size_t)(t + r) * D, lane, v[r]); }
#pragma unroll
        for (int r = 0; r < 4; ++r) { const float rs = row_rstd(v[r], 1e-6f); store_row_bf16(out + (size_t)(t + r) * D, lane, v[r], rs, g); }
    }
}
__device__ __forceinline__ void rwkv_input_pass(Frame& F, const bf16* x, const float* g, const float* mu, bf16* HCAT, bf16* XR, bf16* XK, bf16* XV) {
    const int gw = F.vcu * NWAVES + F.wave, NGW = F.G * NWAVES; const int lane = LANE_;
    f32x4 gg[4], mr[4], mk[4], mv[4];
#pragma unroll
    for (int j = 0; j < 4; ++j) { gg[j] = ((const f32x4*)g)[lane + 64 * j]; mr[j] = ((const f32x4*)(mu + 0 * 1024))[lane + 64 * j]; mk[j] = ((const f32x4*)(mu + 2 * 1024))[lane + 64 * j]; mv[j] = ((const f32x4*)(mu + 3 * 1024))[lane + 64 * j]; }
    for (int blk = gw; blk < T / 32; blk += NGW) {
        const int t0 = blk * 32; f32x4 hp[4];
        if ((t0 & (SEQ - 1)) == 0) {
#pragma unroll
            for (int j = 0; j < 4; ++j) hp[j] = (f32x4){0.f, 0.f, 0.f, 0.f};
        } else { f32x4 v[4]; load_row4_bf(x + (size_t)(t0 - 1) * D, lane, v); const float rstd = row_rstd(v, 1e-6f);
#pragma unroll
            for (int j = 0; j < 4; ++j) hp[j] = v[j] * rstd * gg[j]; }
        f32x4 vn[4]; load_row4_bf(x + (size_t)t0 * D, lane, vn);
        for (int t = t0; t < t0 + 32; ++t) {
            f32x4 v[4];
#pragma unroll
            for (int j = 0; j < 4; ++j) v[j] = vn[j];
            if (t + 1 < t0 + 32) load_row4_bf(x + (size_t)(t + 1) * D, lane, vn);
            const float rstd = row_rstd(v, 1e-6f);
            unsigned long long* oh = (unsigned long long*)(HCAT + (size_t)t * 2048) + lane; unsigned long long* or_ = (unsigned long long*)(XR + (size_t)t * 1024) + lane;
            unsigned long long* ok = (unsigned long long*)(XK + (size_t)t * 1024) + lane; unsigned long long* ov = (unsigned long long*)(XV + (size_t)t * 1024) + lane;
#pragma unroll
            for (int j = 0; j < 4; ++j) { const f32x4 h = v[j] * rstd * gg[j], dd = hp[j] - h;
                oh[64 * j] = (unsigned long long)pk2(h.x, h.y) | ((unsigned long long)pk2(h.z, h.w) << 32);
                oh[256 + 64 * j] = (unsigned long long)pk2(hp[j].x, hp[j].y) | ((unsigned long long)pk2(hp[j].z, hp[j].w) << 32);
                const f32x4 a = h + dd * mr[j], b = h + dd * mk[j], c = h + dd * mv[j];
                or_[64 * j] = (unsigned long long)pk2(a.x, a.y) | ((unsigned long long)pk2(a.z, a.w) << 32);
                ok[64 * j] = (unsigned long long)pk2(b.x, b.y) | ((unsigned long long)pk2(b.z, b.w) << 32);
                ov[64 * j] = (unsigned long long)pk2(c.x, c.y) | ((unsigned long long)pk2(c.z, c.w) << 32);
                hp[j] = h; }
        }
    }
}
__device__ __forceinline__ void combine_norm_pass(Frame& F, const bf16* xin, bf16* xout, const bf16* YS, const int* slot, const float* g, bf16* out) {
    const int gw = F.vcu * NWAVES + F.wave, NGW = F.G * NWAVES; const int lane = LANE_;
    for (int t = 2 * gw; t < T; t += 2 * NGW) {
        f32x4 v[2][4]; v2u ya[2][4], yb[2][4];
#pragma unroll
        for (int r = 0; r < 2; ++r) { load_row4_bf(xin + (size_t)(t + r) * D, lane, v[r]);
            const int s0 = slot[2 * (t + r)], s1 = slot[2 * (t + r) + 1];
            const v2u* y0 = (const v2u*)(YS + (size_t)s0 * D) + lane; const v2u* y1 = (const v2u*)(YS + (size_t)s1 * D) + lane;
#pragma unroll
            for (int j = 0; j < 4; ++j) { ya[r][j] = y0[64 * j]; yb[r][j] = y1[64 * j]; } }
#pragma unroll
        for (int r = 0; r < 2; ++r) {
#pragma unroll
            for (int j = 0; j < 4; ++j) { const v2u a = ya[r][j], b = yb[r][j];
                v[r][j].x += bflo(a.x) + bflo(b.x); v[r][j].y += bfhi(a.x) + bfhi(b.x); v[r][j].z += bflo(a.y) + bflo(b.y); v[r][j].w += bfhi(a.y) + bfhi(b.y); }
            store_row4_bf(xout + (size_t)(t + r) * D, lane, v[r]);
            const float rstd = row_rstd(v[r], 1e-6f);
            store_row_bf16(out + (size_t)(t + r) * D, lane, v[r], rstd, g); }
    }
}
__device__ __forceinline__ void final_norm_pass(Frame& F, const bf16* x, float* out, const float* g) {
    const int gw = F.vcu * NWAVES + F.wave, NGW = F.G * NWAVES; const int lane = LANE_;
    for (int t = 4 * gw; t < T; t += 4 * NGW) {
        f32x4 v[4][4];
#pragma unroll
        for (int r = 0; r < 4; ++r) load_row4_bf(x + (size_t)(t + r) * D, lane, v[r]);
#pragma unroll
        for (int r = 0; r < 4; ++r) { const float rs = row_rstd(v[r], 1e-6f); f32x4* xo = (f32x4*)(out + (size_t)(t + r) * D) + lane;
#pragma unroll
            for (int j = 0; j < 4; ++j) { const f32x4 gg = ((const f32x4*)g)[lane + 64 * j]; xo[64 * j] = v[r][j] * rs * gg; } }
    }
}

__device__ __forceinline__ void diff_combine_pass(Frame& F, const In& I, const bf16* O, bf16* YCAT) {
    const int gw = F.vcu * NWAVES + F.wave, NGW = F.G * NWAVES;
    const float lam_init = 0.2f;
    const float d1 = wave_sum(I.lam_q1[LANE_] * I.lam_k1[LANE_]), d2 = wave_sum(I.lam_q2[LANE_] * I.lam_k2[LANE_]);
    const float lam = expf(d1) - expf(d2) + lam_init;
    const int h = LANE_ >> 4, q = LANE_ & 15;
    float sg[8];
#pragma unroll
    for (int e = 0; e < 8; ++e) sg[e] = I.sub_g[q * 8 + e] * (1.0f - lam_init);
    for (int t0 = 4 * gw; t0 < T; t0 += 4 * NGW) {
        v4u av[4], bv[4];
#pragma unroll
        for (int r = 0; r < 4; ++r) { av[r] = *(const v4u*)(O + (size_t)(t0 + r) * 1024 + h * 256 + q * 8); bv[r] = *(const v4u*)(O + (size_t)(t0 + r) * 1024 + h * 256 + 128 + q * 8); }
#pragma unroll
        for (int r = 0; r < 4; ++r) { const v4u a = av[r], b = bv[r]; const int t = t0 + r;
        float o[8];
        o[0] = bflo(a.x) - lam * bflo(b.x); o[1] = bfhi(a.x) - lam * bfhi(b.x); o[2] = bflo(a.y) - lam * bflo(b.y); o[3] = bfhi(a.y) - lam * bfhi(b.y);
        o[4] = bflo(a.z) - lam * bflo(b.z); o[5] = bfhi(a.z) - lam * bfhi(b.z); o[6] = bflo(a.w) - lam * bflo(b.w); o[7] = bfhi(a.w) - lam * bfhi(b.w);
        float s = 0.f;
#pragma unroll
        for (int e = 0; e < 8; ++e) s += o[e] * o[e];
        s += __shfl_xor(s, 1); s += __shfl_xor(s, 2); s += __shfl_xor(s, 4); s += __shfl_xor(s, 8);
        const float rstd = 1.0f / sqrtf(s * (1.0f / 128.0f) + 1e-5f);
        v4u w; w.x = pk2(o[0] * rstd * sg[0], o[1] * rstd * sg[1]); w.y = pk2(o[2] * rstd * sg[2], o[3] * rstd * sg[3]); w.z = pk2(o[4] * rstd * sg[4], o[5] * rstd * sg[5]); w.w = pk2(o[6] * rstd * sg[6], o[7] * rstd * sg[7]);
        *(v4u*)(YCAT + (size_t)t * 1024 + h * 128 + q * 8) = w; }
    }
}

constexpr int LCT = 64, LNCH = SEQ / LCT;
__device__ __forceinline__ float gelu_tanh(float x) { const float u = 0.7978845608028654f * (x + 0.044715f * x * x * x); return x * sigmoidf_(2.0f * u); }
template <bool FINAL>
__device__ __forceinline__ void lru_phase(Frame& F, const In& I, const bf16* XB, const bf16* GB, f32x2* AGG, bf16* YCAT, bf16* HLp, bf16* CAp) {
    const int ch = TID_, n = ch >> 6, d = ch & 63;
    LAS float* U = (LAS float*)F.lds;
    f32x2 wg[64];
#pragma unroll
    for (int c = 0; c < 64; ++c) { wg[c].x = I.lru_wa[n * 4096 + c * 64 + d]; wg[c].y = I.lru_wx[n * 4096 + c * 64 + d]; }
    const float cw0 = I.conv_w[0 * 512 + ch], cw1 = I.conv_w[1 * 512 + ch], cw2 = I.conv_w[2 * 512 + ch], cw3 = I.conv_w[3 * 512 + ch], cb = I.conv_b[ch];
    const float ba = I.lru_ba[ch], bx = I.lru_bx[ch];
    const float lam = I.lru_lambda[ch]; const float sp = (lam > 15.f) ? expf(-lam) : log1pf(expf(-lam));
    const float m8sp = -8.0f * sp;
    for (int un = blockIdx.x; un < NB * LNCH; un += F.G) {
        const int b = un / LNCH, c = un % LNCH; const size_t row0 = (size_t)b * SEQ + (size_t)c * LCT;
        unsigned short xraw[LCT + 3];
        if (c > 0) { xraw[0] = XB[(row0 - 3) * 512 + ch]; xraw[1] = XB[(row0 - 2) * 512 + ch]; xraw[2] = XB[(row0 - 1) * 512 + ch]; } else { xraw[0] = 0; xraw[1] = 0; xraw[2] = 0; }
#pragma unroll
        for (int tk = 0; tk < LCT; ++tk) xraw[3 + tk] = XB[(row0 + tk) * 512 + ch];
        float h = 0.f, Ap = 1.f;
        if (FINAL) { for (int j = 0; j < c; ++j) { const f32x2 ag = AGG[((size_t)b * LNCH + j) * 512 + ch]; h = ag.x * h + ag.y; } }
#pragma unroll
        for (int tk = 0; tk < LCT; ++tk) U[tk * 512 + ch] = cw0 * bf1(xraw[tk]) + cw1 * bf1(xraw[tk + 1]) + cw2 * bf1(xraw[tk + 2]) + cw3 * bf1(xraw[tk + 3]) + cb;
        __syncthreads();
        unsigned short gcur[8], gnxt[8];
        if (FINAL) {
#pragma unroll
            for (int j = 0; j < 8; ++j) gcur[j] = GB[(row0 + j) * 512 + ch]; }
#pragma unroll 1
        for (int tg = 0; tg < LCT / 8; ++tg) {
            if (FINAL) { const int tn = (tg + 1 < LCT / 8) ? (tg + 1) * 8 : tg * 8;
#pragma unroll
                for (int j = 0; j < 8; ++j) gnxt[j] = GB[(row0 + tn + j) * 512 + ch]; }
#pragma unroll
            for (int j = 0; j < 8; ++j) { const int tk = tg * 8 + j;
                const LAS f32x4* up = (const LAS f32x4*)(U + tk * 512 + n * 64);
                f32x2 acc = {ba, bx};
#pragma unroll
                for (int c4 = 0; c4 < 16; ++c4) { const f32x4 uu = up[c4];
                    acc += wg[4 * c4 + 0] * uu.x; acc += wg[4 * c4 + 1] * uu.y; acc += wg[4 * c4 + 2] * uu.z; acc += wg[4 * c4 + 3] * uu.w; }
                const float r = sigmoidf_(acc.x), ig = sigmoidf_(acc.y);
                const float la = r * m8sp; const float a = __expf(la); const float t2 = 2.0f * la; const float om = (t2 > -0.02f) ? -t2 * (1.0f + t2 * (0.5f + t2 * (0.16666667f + t2 * 0.041666668f))) : 1.0f - a * a; const float bb = __builtin_amdgcn_sqrtf(om) * (ig * U[tk * 512 + ch]);
                h = a * h + bb;
                if (FINAL) { YCAT[(row0 + tk) * 1024 + 512 + ch] = (bf16)f2bf(h * gelu_tanh(bf1(gcur[j]))); }
                else { Ap *= a; HLp[(row0 + tk) * 512 + ch] = (bf16)f2bf(h); CAp[(row0 + tk) * 512 + ch] = (bf16)f2bf(Ap); } }
            if (FINAL) {
#pragma unroll
                for (int j = 0; j < 8; ++j) gcur[j] = gnxt[j]; }
        }
        if (!FINAL) { f32x2 ag; ag.x = Ap; ag.y = h; AGG[((size_t)b * LNCH + c) * 512 + ch] = ag; }
        __syncthreads();
    }
}

__device__ __forceinline__ void lru_agg_mfma(Frame& F, const In& I, const bf16* XB, f32x2* AGG, bf16* HLp, bf16* CAp) {
    const int tid = TID_, lane = tid & 63, fr = lane & 15, fq = lane >> 4, n = F.wave, ch = tid;
    constexpr int UP = 520;
    LAS bf16* U = (LAS bf16*)F.lds;
    bf16x8 Wr[4][2], Wi[4][2];
#pragma unroll
    for (int dd = 0; dd < 4; ++dd)
#pragma unroll
        for (int kh = 0; kh < 2; ++kh) { unsigned pr_[4], pi_[4];
#pragma unroll
            for (int j = 0; j < 4; ++j) { const int c0 = 32 * kh + 8 * fq + 2 * j, d = 16 * dd + fr;
                pr_[j] = pk2(I.lru_wa[n * 4096 + c0 * 64 + d], I.lru_wa[n * 4096 + (c0 + 1) * 64 + d]); pi_[j] = pk2(I.lru_wx[n * 4096 + c0 * 64 + d], I.lru_wx[n * 4096 + (c0 + 1) * 64 + d]); }
            Wr[dd][kh] = __builtin_bit_cast(bf16x8, (v4u){pr_[0], pr_[1], pr_[2], pr_[3]}); Wi[dd][kh] = __builtin_bit_cast(bf16x8, (v4u){pi_[0], pi_[1], pi_[2], pi_[3]}); }
    float cba[4], cbx[4], cm8[4];
#pragma unroll
    for (int dd = 0; dd < 4; ++dd) { const int chd = 64 * n + 16 * dd + fr; cba[dd] = I.lru_ba[chd]; cbx[dd] = I.lru_bx[chd];
        const float lam = I.lru_lambda[chd]; cm8[dd] = -8.0f * ((lam > 15.f) ? expf(-lam) : log1pf(expf(-lam))); }
    const float cw0 = I.conv_w[0 * 512 + ch], cw1 = I.conv_w[1 * 512 + ch], cw2 = I.conv_w[2 * 512 + ch], cw3 = I.conv_w[3 * 512 + ch], cb = I.conv_b[ch];
    for (int un = blockIdx.x; un < NB * LNCH; un += F.G) {
        const int b = un / LNCH, c = un % LNCH; const size_t row0 = (size_t)b * SEQ + (size_t)c * LCT;
        unsigned short xraw[LCT + 3];
        if (c > 0) { xraw[0] = XB[(row0 - 3) * 512 + ch]; xraw[1] = XB[(row0 - 2) * 512 + ch]; xraw[2] = XB[(row0 - 1) * 512 + ch]; } else { xraw[0] = 0; xraw[1] = 0; xraw[2] = 0; }
#pragma unroll
        for (int tk = 0; tk < LCT; ++tk) xraw[3 + tk] = XB[(row0 + tk) * 512 + ch];
#pragma unroll
        for (int tk = 0; tk < LCT; ++tk) U[tk * UP + ch] = (bf16)f2bf(cw0 * bf1(xraw[tk]) + cw1 * bf1(xraw[tk + 1]) + cw2 * bf1(xraw[tk + 2]) + cw3 * bf1(xraw[tk + 3]) + cb);
        __syncthreads();
        bf16x8 X[4][2];
#pragma unroll
        for (int tt = 0; tt < 4; ++tt)
#pragma unroll
            for (int kh = 0; kh < 2; ++kh) X[tt][kh] = *(const LAS bf16x8*)(U + (16 * tt + fr) * UP + 64 * n + 32 * kh + 8 * fq);
#pragma unroll 1
        for (int dd = 0; dd < 4; ++dd) {
            bf16x8 wr0, wr1, wi0, wi1; float kba, kbx, km8;
            if (dd == 0) { wr0 = Wr[0][0]; wr1 = Wr[0][1]; wi0 = Wi[0][0]; wi1 = Wi[0][1]; kba = cba[0]; kbx = cbx[0]; km8 = cm8[0]; }
            else if (dd == 1) { wr0 = Wr[1][0]; wr1 = Wr[1][1]; wi0 = Wi[1][0]; wi1 = Wi[1][1]; kba = cba[1]; kbx = cbx[1]; km8 = cm8[1]; }
            else if (dd == 2) { wr0 = Wr[2][0]; wr1 = Wr[2][1]; wi0 = Wi[2][0]; wi1 = Wi[2][1]; kba = cba[2]; kbx = cbx[2]; km8 = cm8[2]; }
            else { wr0 = Wr[3][0]; wr1 = Wr[3][1]; wi0 = Wi[3][0]; wi1 = Wi[3][1]; kba = cba[3]; kbx = cbx[3]; km8 = cm8[3]; }
            const int chd = 64 * n + 16 * dd + fr;
            float hc = 0.f, Ac = 1.f;
#pragma unroll
            for (int tt = 0; tt < 4; ++tt) {
                f32x4 pr = (f32x4){0.f, 0.f, 0.f, 0.f}, pi = pr;
                pr = __builtin_amdgcn_mfma_f32_16x16x32_bf16(X[tt][0], wr0, pr, 0, 0, 0); pr = __builtin_amdgcn_mfma_f32_16x16x32_bf16(X[tt][1], wr1, pr, 0, 0, 0);
                pi = __builtin_amdgcn_mfma_f32_16x16x32_bf16(X[tt][0], wi0, pi, 0, 0, 0); pi = __builtin_amdgcn_mfma_f32_16x16x32_bf16(X[tt][1], wi1, pi, 0, 0, 0);
                float a[4], bb[4];
#pragma unroll
                for (int e = 0; e < 4; ++e) { const int tok = 16 * tt + 4 * fq + e; const float u = bf1(U[tok * UP + chd]);
                    const float r = sigmoidf_(pr[e] + kba), ig = sigmoidf_(pi[e] + kbx); const float la = r * km8; a[e] = __expf(la); const float t2 = 2.0f * la;
                    const float om = (t2 > -0.02f) ? -t2 * (1.0f + t2 * (0.5f + t2 * (0.16666667f + t2 * 0.041666668f))) : 1.0f - a[e] * a[e]; bb[e] = __builtin_amdgcn_sqrtf(om) * (ig * u); }
                const float A4 = (a[0] * a[1]) * (a[2] * a[3]); const float B4 = ((bb[0] * a[1] + bb[1]) * a[2] + bb[2]) * a[3] + bb[3];
                float h = hc, Ap = Ac, hs = hc, As = Ac;
#pragma unroll
                for (int j = 0; j < 4; ++j) { const float Aj = __shfl(A4, fr + 16 * j), Bj = __shfl(B4, fr + 16 * j); if (j == fq) { hs = h; As = Ap; } h = Aj * h + Bj; Ap *= Aj; }
                hc = h; Ac = Ap; h = hs; Ap = As;
#pragma unroll
                for (int e = 0; e < 4; ++e) { h = a[e] * h + bb[e]; Ap *= a[e]; const size_t o = (row0 + 16 * tt + 4 * fq + e) * 512 + chd; HLp[o] = (bf16)f2bf(h); CAp[o] = (bf16)f2bf(Ap); }
            }
            if (fq == 0) { f32x2 ag; ag.x = Ac; ag.y = hc; AGG[((size_t)b * LNCH + c) * 512 + chd] = ag; }
        }
        __syncthreads();
    }
}

__device__ __forceinline__ void lru_final_pass(Frame& F, const bf16* HLp, const bf16* CAp, const bf16* GB, const f32x2* AGG, bf16* YCAT) {
    const int ch = TID_;
    for (int un = blockIdx.x; un < NB * LNCH; un += F.G) {
        const int b = un / LNCH, c = un % LNCH; const size_t row0 = (size_t)b * SEQ + (size_t)c * LCT;
        float carry = 0.f;
        for (int j = 0; j < c; ++j) { const f32x2 ag = AGG[((size_t)b * LNCH + j) * 512 + ch]; carry = ag.x * carry + ag.y; }
#pragma unroll 4
        for (int t8 = 0; t8 < LCT; t8 += 8) {
            bf16 hl[8], ca[8], gv[8];
#pragma unroll
            for (int j = 0; j < 8; ++j) { const size_t o = (row0 + t8 + j) * 512 + ch; hl[j] = HLp[o]; ca[j] = CAp[o]; gv[j] = GB[o]; }
#pragma unroll
            for (int j = 0; j < 8; ++j) { const float h = bf1(hl[j]) + bf1(ca[j]) * carry; YCAT[(row0 + t8 + j) * 1024 + 512 + ch] = (bf16)f2bf(h * gelu_tanh(bf1(gv[j]))); }
        }
    }
}

__device__ __forceinline__ void route_pass_a(Frame& F, const In& I, int layer, const float* LOG, unsigned char* rt, gu32* cnt) {
    LAS int* lcnt = (LAS int*)(F.lds + RTE_OFF); LAS int* lbase = lcnt + 32;
    int* EID = (int*)(rt + RT_EID); int* POS = (int*)(rt + RT_POS); float* GATE = (float*)(rt + RT_GATE);
    const float* bc = I.moe_bc + layer * 4; const float* bfb = I.moe_bf + layer * 32;
    for (int un = blockIdx.x; un < T / 512; un += F.G) {
        if (TID_ < 32) lcnt[TID_] = 0;
        __syncthreads();
        const int t = un * 512 + TID_; const float* lg = LOG + (size_t)t * 64;
        const f32x4 g4 = *(const f32x4*)lg;
        float gl[4] = {g4.x + bc[0], g4.y + bc[1], g4.z + bc[2], g4.w + bc[3]};
        int gi = 0; float gm = gl[0];
#pragma unroll
        for (int j = 1; j < 4; ++j) if (gl[j] > gm) { gm = gl[j]; gi = j; }
        float gs = 0.f;
#pragma unroll
        for (int j = 0; j < 4; ++j) gs += __expf(gl[j] - gm);
        const float gprob = 1.0f / gs;
        const f32x4 e0 = *(const f32x4*)(lg + 4 + gi * 8), e1 = *(const f32x4*)(lg + 8 + gi * 8);
        float el[8] = {e0.x, e0.y, e0.z, e0.w, e1.x, e1.y, e1.z, e1.w};
#pragma unroll
        for (int j = 0; j < 8; ++j) el[j] += bfb[gi * 8 + j];
        int i0 = 0; float m0 = el[0];
#pragma unroll
        for (int j = 1; j < 8; ++j) if (el[j] > m0) { m0 = el[j]; i0 = j; }
        int i1 = -1; float m1 = -INFINITY;
#pragma unroll
        for (int j = 0; j < 8; ++j) if (j != i0 && el[j] > m1) { m1 = el[j]; i1 = j; }
        const float r1 = __expf(m1 - m0); const float g0 = gprob / (1.0f + r1), g1 = gprob * r1 / (1.0f + r1);
        const int ex0 = gi * 8 + i0, ex1 = gi * 8 + i1;
        const int p0 = atomicAdd((int*)&lcnt[ex0], 1), p1 = atomicAdd((int*)&lcnt[ex1], 1);
        __syncthreads();
        if (TID_ < 32) lbase[TID_] = (int)__hip_atomic_fetch_add(cnt + TID_, (unsigned)lcnt[TID_], RLX_AGENT);
        __syncthreads();
        EID[2 * t] = ex0; EID[2 * t + 1] = ex1; POS[2 * t] = lbase[ex0] + p0; POS[2 * t + 1] = lbase[ex1] + p1; GATE[2 * t] = g0; GATE[2 * t + 1] = g1;
        __syncthreads();
    }
}
__device__ __forceinline__ void route_bases(Frame& F, gu32* cnt) {
    LAS int* eb = (LAS int*)(F.lds + RTE_OFF + 512);
    const int tid = TID_;
    if (tid < 64) {
        const int c = (tid < 32) ? (int)__hip_atomic_load(cnt + (tid & 31), RLX_AGENT) : 0; const int p = (c + 255) & ~255; int s = p;
#pragma unroll
        for (int o = 1; o < 32; o <<= 1) { const int t = __shfl_up(s, o); if ((tid & 63) >= o) s += t; }
        if (tid < 32) { eb[tid] = s - p; if (tid == 31) eb[32] = s; }
    }
    __syncthreads();
}
__device__ __forceinline__ void route_pass_b(Frame& F, unsigned char* rt, gu32* cnt) {
    route_bases(F, cnt);
    LAS int* eb = (LAS int*)(F.lds + RTE_OFF + 512);
    const int* EID = (const int*)(rt + RT_EID); const int* POS = (const int*)(rt + RT_POS); const float* GATE = (const float*)(rt + RT_GATE);
    int* ROWTOK = (int*)(rt + RT_ROWTOK); float* ROWGATE = (float*)(rt + RT_ROWGATE); int* SLOT = (int*)(rt + RT_SLOT);
    const int gt = F.vcu * 512 + TID_, NGT = F.G * 512;
    for (int i = gt; i < 2 * T; i += NGT) { const int dst = eb[EID[i]] + POS[i]; ROWTOK[dst] = i >> 1; ROWGATE[dst] = GATE[i]; SLOT[i] = dst; }
    for (int i = gt; i < 32 * 256; i += NGT) { const int e = i >> 8, j = i & 255; const int c = (int)__hip_atomic_load(cnt + e, RLX_AGENT); const int pad = ((c + 255) & ~255) - c;
        if (j < pad) { ROWTOK[eb[e] + c + j] = 0; ROWGATE[eb[e] + c + j] = 0.f; } }
    __syncthreads();
}
struct MoeOrder {
    int G, c, ntiles; const LAS int* eb; const char* A; const char* W; size_t astep, wexp, wtile; bool gather;
    __device__ bool next(int i, pg8::Unit& u) const {
        const int L = i * G + c; if (L >= ntiles * 4) return false;
        u.pm = L >> 2; u.pn = L & 3; const int s0 = u.pm * 256; int e = 0;
#pragma unroll 1
        for (int j = 1; j < 32; ++j) if (eb[j] <= s0) e = j;
        e = __builtin_amdgcn_readfirstlane(e); u.aux = e; u.A = gather ? A : A + (size_t)u.pm * astep; u.B = W + (size_t)e * wexp + (size_t)u.pn * wtile; return true;
    }
};

constexpr int RTC = 32, RNCH = SEQ / RTC, RTOK = 352;
#define LBAR() do { asm volatile("s_waitcnt lgkmcnt(0)" ::: "memory"); __builtin_amdgcn_s_barrier(); asm volatile("" ::: "memory"); } while (0)
template <int CTRL> __device__ __forceinline__ float dpp_f(float v) { return __builtin_bit_cast(float, __builtin_amdgcn_update_dpp(0, __builtin_bit_cast(int, v), CTRL, 0xf, 0xf, true)); }
__device__ __forceinline__ float red16(float v) { v += dpp_f<0xB1>(v); v += dpp_f<0x4E>(v); v += dpp_f<0x141>(v); v += dpp_f<0x140>(v); return v; }
__device__ __forceinline__ float red8(float v) { v += dpp_f<0xB1>(v); v += dpp_f<0x4E>(v); v += dpp_f<0x141>(v); return v; }
__device__ __forceinline__ void unpack8(const v4u w, float (&f)[8]) { f[0] = bflo(w.x); f[1] = bfhi(w.x); f[2] = bflo(w.y); f[3] = bfhi(w.y); f[4] = bflo(w.z); f[5] = bfhi(w.z); f[6] = bflo(w.w); f[7] = bfhi(w.w); }
__device__ __forceinline__ void rwkv_scan_phase(Frame& F, const In& I, const bf16* R, const bf16* Kt, const bf16* V, const bf16* AA, const bf16* EW, bf16* Y) {
    LAS float* buf = (LAS float*)F.lds;
    LAS float* ybuf = (LAS float*)(F.lds + 2 * RTC * RTOK * 4) + 32;
    const int tid = TID_, lane = tid & 63;
    const int seg = lane & 15, rl = F.wave * 4 + (lane >> 4);
    const int stk = tid >> 4, ssg = tid & 15;
    for (int un = blockIdx.x; un < NB * 16 * 2; un += F.G) {
        const int half = un & 1, h = (un >> 1) & 15, b = un >> 5;
        const size_t rowb = (size_t)b * SEQ;
        const int col = h * 64 + ssg * 4;
        const f32x4 kkw = *(const f32x4*)(I.rwkv_kk + col), kaw = *(const f32x4*)(I.rwkv_ka + col);
        v2u rr, kr, vr, ar, er;
#define RAW_LOAD(cc) do { const size_t off = (rowb + (size_t)(cc) * RTC + stk) * 1024 + col; rr = *(const v2u*)(R + off); kr = *(const v2u*)(Kt + off); vr = *(const v2u*)(V + off); ar = *(const v2u*)(AA + off); er = *(const v2u*)(EW + off); } while (0)
#define RAW_CONVERT(cc) do { LAS float* tp = buf + ((cc) & 1) * (RTC * RTOK) + stk * RTOK + ssg * 4; \
            const float r0 = bflo(rr.x), r1 = bfhi(rr.x), r2 = bflo(rr.y), r3 = bfhi(rr.y), k0 = bflo(kr.x), k1 = bfhi(kr.x), k2 = bflo(kr.y), k3 = bfhi(kr.y); \
            const float a0 = bflo(ar.x), a1 = bfhi(ar.x), a2 = bflo(ar.y), a3 = bfhi(ar.y); \
            const float x0 = k0 * kkw.x, x1 = k1 * kkw.y, x2 = k2 * kkw.z, x3 = k3 * kkw.w; \
            const float ss = red16((x0 * x0 + x1 * x1) + (x2 * x2 + x3 * x3)); const float inv = __builtin_amdgcn_rsqf(fmaxf(ss, 1e-24f)); \
            *(LAS f32x4*)(tp) = (f32x4){__expf(-bflo(er.x)), __expf(-bfhi(er.x)), __expf(-bflo(er.y)), __expf(-bfhi(er.y))}; \
            const f32x4 kkv = (f32x4){x0 * inv, x1 * inv, x2 * inv, x3 * inv}; *(LAS f32x4*)(tp + 64) = kkv; \
            *(LAS f32x4*)(tp + 128) = (f32x4){kkv.x * a0, kkv.y * a1, kkv.z * a2, kkv.w * a3}; \
            *(LAS f32x4*)(tp + 192) = (f32x4){k0 * (1.0f + (a0 - 1.0f) * kaw.x), k1 * (1.0f + (a1 - 1.0f) * kaw.y), k2 * (1.0f + (a2 - 1.0f) * kaw.z), k3 * (1.0f + (a3 - 1.0f) * kaw.w)}; \
            *(LAS f32x4*)(tp + 256) = (f32x4){r0, r1, r2, r3}; \
            if ((ssg >> 3) == half) *(LAS f32x4*)(buf + ((cc) & 1) * (RTC * RTOK) + stk * RTOK + 320 + (ssg & 7) * 4) = (f32x4){bflo(vr.x), bfhi(vr.x), bflo(vr.y), bfhi(vr.y)}; } while (0)
#define Y_WRITE(cc) do { const LAS f32x2* yp = (const LAS f32x2*)(ybuf + ((cc) & 1) * (RTC * 32 + 32) + stk * 32 + ssg * 2); const f32x2 yv = *yp; \
            *(unsigned*)(Y + (rowb + (size_t)(cc) * RTC + stk) * 1024 + h * 64 + half * 32 + ssg * 2) = pk2(yv.x, yv.y); } while (0)
        RAW_LOAD(0); RAW_CONVERT(0); RAW_LOAD(1);
        f32x2 S0 = (f32x2){0.f, 0.f}, S1 = (f32x2){0.f, 0.f};
        LBAR();
        for (int c = 0; c < RNCH; ++c) {
            if (c + 1 < RNCH) { RAW_CONVERT(c + 1); }
            if (c + 2 < RNCH) { RAW_LOAD(c + 2); }
            if (c >= 1) { Y_WRITE(c - 1); }
            const LAS float* cb = buf + (c & 1) * (RTC * RTOK); LAS float* yb = ybuf + (c & 1) * (RTC * 32 + 32);
            const LAS float* tp0 = cb + seg * 4; const LAS float* vp0 = cb + 320 + rl;
#define SV_DECL(X) f32x4 X##w, X##q, X##b, X##k, X##r; float X##v
#define SV_LOAD(X, tk) do { const LAS float* tp = tp0 + (tk) * RTOK; \
                X##w = *(const LAS f32x4*)(tp); X##q = *(const LAS f32x4*)(tp + 64); X##b = *(const LAS f32x4*)(tp + 128); X##k = *(const LAS f32x4*)(tp + 192); X##r = *(const LAS f32x4*)(tp + 256); X##v = vp0[(tk) * RTOK]; } while (0)
#define SV_STEP(X, tk) do { \
                const f32x2 d = S0 * (f32x2){X##q.x, X##q.y} + S1 * (f32x2){X##q.z, X##q.w}; \
                const f32x2 t0 = S0 * (f32x2){X##w.x, X##w.y} + (f32x2){X##k.x, X##k.y} * X##v, t1 = S1 * (f32x2){X##w.z, X##w.w} + (f32x2){X##k.z, X##k.w} * X##v; \
                float ra = d.x + d.y, rb = epend;                   \
                ra += dpp_f<0xB1>(ra); rb += dpp_f<0xB1>(rb); ra += dpp_f<0x4E>(ra); rb += dpp_f<0x4E>(rb); ra += dpp_f<0x141>(ra); rb += dpp_f<0x141>(rb); ra += dpp_f<0x140>(ra); rb += dpp_f<0x140>(rb); \
                if (seg == 0) yb[((tk) - 1) * 32 + rl] = rb;        \
                const float sa = -ra; \
                S0 = t0 + (f32x2){X##b.x, X##b.y} * sa; S1 = t1 + (f32x2){X##b.z, X##b.w} * sa; \
                const f32x2 e = S0 * (f32x2){X##r.x, X##r.y} + S1 * (f32x2){X##r.z, X##r.w}; epend = e.x + e.y; } while (0)
            SV_DECL(A_); SV_DECL(B_); float epend = 0.f;
            SV_LOAD(A_, 0);
#pragma unroll 1
            for (int tk = 0; tk < RTC; tk += 2) {
                SV_LOAD(B_, tk + 1);
                SV_STEP(A_, tk);
                { const int t2 = (tk + 2 < RTC) ? tk + 2 : RTC - 1; SV_LOAD(A_, t2); }
                SV_STEP(B_, tk + 1);
            }
#undef SV_DECL
#undef SV_LOAD
#undef SV_STEP
            { const float rb = red16(epend); if (seg == 0) yb[(RTC - 1) * 32 + rl] = rb; }
            LBAR();
        }
        Y_WRITE(RNCH - 1);
        LBAR();
#undef RAW_LOAD
#undef RAW_CONVERT
#undef Y_WRITE
    }
}
constexpr int GS_QT = 0, GS_RT = 2048, GS_BHT = 4096, GS_KHT = 6144, GS_VT = 8192, GS_TM = 10240, GS_TL = 10752, GS_MK = 11264, GS_NK = 11776, GS_NB = 12288, GS_DD = 12800, GS_SLOT = 13056;
constexpr int GS_KT = GS_KHT, GS_BT = GS_BHT, GS_MB = GS_TM;
#ifndef SCAN_NP
#define SCAN_NP 4
#endif
constexpr int CH_NP = SCAN_NP, CH_NS = 8 - CH_NP, CH_ROUNDS = (512 + CH_NP - 1) / CH_NP;
constexpr int CH_KTAB = 2 * CH_NP * GS_SLOT;
static_assert(CH_KTAB + 512 <= 131072, "chunked-scan LDS map");
template <int N> __device__ __forceinline__ float dpp_shr(float v) { return __builtin_bit_cast(float, __builtin_amdgcn_update_dpp(0, __builtin_bit_cast(int, v), 0x110 + N, 0xf, 0xf, true)); }
__device__ __forceinline__ bf16x8 mk8(v2u a, v2u b) { return __builtin_bit_cast(bf16x8, (v4u){a.x, a.y, b.x, b.y}); }
__device__ __forceinline__ bf16x8 mk8z(v2u a) { return __builtin_bit_cast(bf16x8, (v4u){a.x, a.y, 0u, 0u}); }
__device__ __forceinline__ bf16x8 cvt8z(f32x4 v) { return __builtin_bit_cast(bf16x8, (v4u){pk2(v.x, v.y), pk2(v.z, v.w), 0u, 0u}); }
__device__ __forceinline__ int tokoff(const int t, const int c) { return t * 128 + ((c ^ ((t >> 1) & 7)) << 4); }
__device__ __forceinline__ int tokoff2(const int t, const int c) { return t * 128 + ((c ^ (((t >> 1) & 3) << 1)) << 4); }
__device__ __forceinline__ v2u trld(const LAS unsigned char* p) { return __builtin_bit_cast(v2u, __builtin_amdgcn_ds_read_tr16_b64_v4i16((LAS attn_body::v4i16_t*)p)); }
struct ChOps { v4u q0, q1, r0, r1, mn, bt; };
struct ChOpsB { v2u kh[4], bh[4]; f32x4 dv[4]; };
__device__ __forceinline__ void chain_load(ChOps& O, const LAS unsigned char* C, const int fr, const int fq) {
    const int w8 = 8 * (fq & 1), c = fq >> 1;
    { const v2u a = *(const LAS v2u*)(C + GS_QT + tokoff(fr, c) + w8), b = *(const LAS v2u*)(C + GS_QT + tokoff(fr, 2 + c) + w8); O.q0 = (v4u){a.x, a.y, b.x, b.y}; }
    { const v2u a = *(const LAS v2u*)(C + GS_QT + tokoff(fr, 4 + c) + w8), b = *(const LAS v2u*)(C + GS_QT + tokoff(fr, 6 + c) + w8); O.q1 = (v4u){a.x, a.y, b.x, b.y}; }
    { const v2u a = *(const LAS v2u*)(C + GS_RT + tokoff(fr, c) + w8), b = *(const LAS v2u*)(C + GS_RT + tokoff(fr, 2 + c) + w8); O.r0 = (v4u){a.x, a.y, b.x, b.y}; }
    { const v2u a = *(const LAS v2u*)(C + GS_RT + tokoff(fr, 4 + c) + w8), b = *(const LAS v2u*)(C + GS_RT + tokoff(fr, 6 + c) + w8); O.r1 = (v4u){a.x, a.y, b.x, b.y}; }
    const int om = (fr * 16 + 4 * fq) * 2;
    { const v2u a = *(const LAS v2u*)(C + GS_MK + om), b = *(const LAS v2u*)(C + GS_NK + om); O.mn = (v4u){a.x, a.y, b.x, b.y}; }
    { const v2u a = *(const LAS v2u*)(C + GS_NB + om), b = *(const LAS v2u*)(C + GS_TM + om); O.bt = (v4u){a.x, a.y, b.x, b.y}; }
}
__device__ __forceinline__ void chain_load_b(ChOpsB& O, const LAS unsigned char* C, const int fr, const int fq) {
#pragma unroll
    for (int jt = 0; jt < 4; ++jt) { const int ok = tokoff2(4 * fq + (fr >> 2), 2 * jt + ((fr >> 1) & 1)) + 8 * (fr & 1); O.kh[jt] = trld(C + GS_KHT + ok); O.bh[jt] = trld(C + GS_BHT + ok); O.dv[jt] = *(const LAS f32x4*)(C + GS_DD + (16 * jt + 4 * fq) * 4); }
}
template <int NT>
__device__ __forceinline__ void chain_step(const ChOps& O, const LAS unsigned char* C, const v2u vq0, const v2u vq1, f32x4 (&Areg)[2][4], const int vt0, const int fr, const int fq, GAS bf16* yrow, LAS unsigned char* ys) {
    const f32x4 zero4 = (f32x4){0.f, 0.f, 0.f, 0.f};
    v2u kh0, kh1, kh2, kh3, bh0, bh1, bh2, bh3; f32x4 dv0, dv1, dv2, dv3;
    { const int okb = tokoff2(4 * fq + (fr >> 2), 0) + 8 * (fr & 1), xs = (((4 * fq + (fr >> 2)) >> 1) & 3) << 1, cb = (fr >> 1) & 1;
#define KB_(jt) (4 * fq + (fr >> 2)) * 128 + ((((2 * (jt) + cb) ^ xs)) << 4) + 8 * (fr & 1)
      kh0 = trld(C + GS_KHT + KB_(0)); kh1 = trld(C + GS_KHT + KB_(1)); kh2 = trld(C + GS_KHT + KB_(2)); kh3 = trld(C + GS_KHT + KB_(3));
      bh0 = trld(C + GS_BHT + KB_(0)); bh1 = trld(C + GS_BHT + KB_(1)); bh2 = trld(C + GS_BHT + KB_(2)); bh3 = trld(C + GS_BHT + KB_(3)); (void)okb;
#undef KB_
      dv0 = *(const LAS f32x4*)(C + GS_DD + (4 * fq) * 4); dv1 = *(const LAS f32x4*)(C + GS_DD + (16 + 4 * fq) * 4); dv2 = *(const LAS f32x4*)(C + GS_DD + (32 + 4 * fq) * 4); dv3 = *(const LAS f32x4*)(C + GS_DD + (48 + 4 * fq) * 4); }
    bf16x8 Aq[NT][2], Vq[NT], Uq[NT]; f32x4 X[NT], YA[NT], Z[NT], U[NT], Yv[NT], Yn[NT];
#pragma unroll
    for (int ti = 0; ti < NT; ++ti) {
#pragma unroll
        for (int kh = 0; kh < 2; ++kh) Aq[ti][kh] = __builtin_bit_cast(bf16x8, (v4u){pk2(Areg[ti][2 * kh].x, Areg[ti][2 * kh].y), pk2(Areg[ti][2 * kh].z, Areg[ti][2 * kh].w), pk2(Areg[ti][2 * kh + 1].x, Areg[ti][2 * kh + 1].y), pk2(Areg[ti][2 * kh + 1].z, Areg[ti][2 * kh + 1].w)});
        Vq[ti] = mk8z(ti == 0 ? vq0 : vq1); X[ti] = zero4; YA[ti] = zero4; }
#pragma unroll
    for (int kh = 0; kh < 2; ++kh) {
#pragma unroll
        for (int ti = 0; ti < NT; ++ti) { X[ti] = __builtin_amdgcn_mfma_f32_16x16x32_bf16(__builtin_bit_cast(bf16x8, kh == 0 ? O.q0 : O.q1), Aq[ti][kh], X[ti], 0, 0, 0); YA[ti] = __builtin_amdgcn_mfma_f32_16x16x32_bf16(__builtin_bit_cast(bf16x8, kh == 0 ? O.r0 : O.r1), Aq[ti][kh], YA[ti], 0, 0, 0); } }
#pragma unroll
    for (int ti = 0; ti < NT; ++ti) Z[ti] = __builtin_amdgcn_mfma_f32_16x16x32_bf16(__builtin_bit_cast(bf16x8, (v4u){O.mn.x, O.mn.y, 0u, 0u}), Vq[ti], X[ti], 0, 0, 0);
#pragma unroll
    for (int ti = 0; ti < NT; ++ti) Yv[ti] = __builtin_amdgcn_mfma_f32_16x16x32_bf16(__builtin_bit_cast(bf16x8, (v4u){O.mn.z, O.mn.w, 0u, 0u}), Vq[ti], YA[ti], 0, 0, 0);
#pragma unroll
    for (int ti = 0; ti < NT; ++ti) U[ti] = __builtin_amdgcn_mfma_f32_16x16x32_bf16(__builtin_bit_cast(bf16x8, (v4u){O.bt.z, O.bt.w, 0u, 0u}), cvt8z(Z[ti]), zero4, 0, 0, 0);
#pragma unroll
    for (int ti = 0; ti < NT; ++ti) Uq[ti] = cvt8z(U[ti]);
#pragma unroll
    for (int ti = 0; ti < NT; ++ti) Yn[ti] = __builtin_amdgcn_mfma_f32_16x16x32_bf16(__builtin_bit_cast(bf16x8, (v4u){O.bt.x, O.bt.y, 0u, 0u}), Uq[ti], zero4, 0, 0, 0);
#pragma unroll
    for (int jt = 0; jt < 4; ++jt) {
#pragma unroll
        for (int ti = 0; ti < NT; ++ti) { f32x4 acc = (jt == 0 ? dv0 : jt == 1 ? dv1 : jt == 2 ? dv2 : dv3) * Areg[ti][jt];
            acc = __builtin_amdgcn_mfma_f32_16x16x32_bf16(mk8z(jt == 0 ? kh0 : jt == 1 ? kh1 : jt == 2 ? kh2 : kh3), Vq[ti], acc, 0, 0, 0);
            const f32x4 nbu = __builtin_amdgcn_mfma_f32_16x16x32_bf16(mk8z(jt == 0 ? bh0 : jt == 1 ? bh1 : jt == 2 ? bh2 : bh3), Uq[ti], zero4, 0, 0, 0);
            Areg[ti][jt] = acc - nbu; } }
#pragma unroll
    for (int ti = 0; ti < NT; ++ti) { const f32x4 yy = Yv[ti] - Yn[ti]; *(LAS v2u*)(ys + ti * 512 + (fr * 16 + 4 * fq) * 2) = (v2u){pk2(yy[0], yy[1]), pk2(yy[2], yy[3])}; }
#pragma unroll
    for (int ti = 0; ti < NT; ++ti) { const v2u w = trld(ys + ti * 512 + ((4 * fq + (fr >> 2)) * 16 + 4 * (fr & 3)) * 2); *(GAS v2u*)(yrow + (size_t)fr * 1024 + 16 * (vt0 + ti) + 4 * fq) = w; }
}
#ifndef SCAN_WMAP
#define SCAN_WMAP 0x76543210u
#endif
__device__ __forceinline__ void rwkv_scan_chunked(Frame& F, const In& I, const bf16* R, const bf16* Kt, const bf16* V, const bf16* AA, const bf16* EW, bf16* Y) {
    const int lane = LANE_, fr = lane & 15, fq = lane >> 4;
    const int lw = (int)((SCAN_WMAP >> (4 * F.wave)) & 7u);
    LAS unsigned char* L = F.lds;
    const f32x4 zero4 = (f32x4){0.f, 0.f, 0.f, 0.f};
    for (int un = blockIdx.x; un < NB * 16; un += F.G) {
        const int h = un & 15, b = un >> 4; const size_t rowb = (size_t)b * SEQ;
        if (lw == 0) { ((LAS float*)(L + CH_KTAB))[lane] = ((const GAS float*)I.rwkv_kk)[h * 64 + lane]; ((LAS float*)(L + CH_KTAB + 256))[lane] = ((const GAS float*)I.rwkv_ka)[h * 64 + lane]; }
        LBAR();
        if (lw >= CH_NS) {
            const int p = lw - CH_NS; const int colb = h * 64 + 16 * fq;
            v4u raw[10];
#define CK_LOAD(cidx) do { const size_t off = (rowb + (size_t)(cidx) * 16 + fr) * 1024 + colb; \
                raw[0] = *(const GAS v4u*)(R + off); raw[1] = *(const GAS v4u*)(R + off + 8); raw[2] = *(const GAS v4u*)(Kt + off); raw[3] = *(const GAS v4u*)(Kt + off + 8); raw[4] = *(const GAS v4u*)(V + off); raw[5] = *(const GAS v4u*)(V + off + 8); \
                raw[6] = *(const GAS v4u*)(AA + off); raw[7] = *(const GAS v4u*)(AA + off + 8); raw[8] = *(const GAS v4u*)(EW + off); raw[9] = *(const GAS v4u*)(EW + off + 8); } while (0)
#ifdef SCAN_STAMP
            unsigned long long st_[7] = {0, 0, 0, 0, 0, 0, 0};
#ifndef SCAN_STAMP_P
#define SCAN_STAMP_P 0
#endif
#ifndef SCAN_STAMP_RD
#define SCAN_STAMP_RD 20
#endif
#ifndef SCAN_STAMP_B
#define SCAN_STAMP_B 0
#endif
#define STAMP(i) do { if ((SCAN_STAMP_B < 0 || blockIdx.x == SCAN_STAMP_B) && p == SCAN_STAMP_P && rd == SCAN_STAMP_RD) st_[i] = __builtin_amdgcn_s_memtime(); } while (0)
#else
#define STAMP(i) do { } while (0)
#endif
            CK_LOAD(p);
            for (int rd = -1; rd < CH_ROUNDS - 1; ++rd) {
                const int cidx = CH_NP * (rd + 1) + p; LAS unsigned char* S = L + (((rd + 1) & 1) * CH_NP + p) * GS_SLOT;
                if (cidx < 512) {
                STAMP(0);
                float r[16], k[16], a[16], ew[16]; const v4u vraw0 = raw[4], vraw1 = raw[5];
                { float t8[8];
                  unpack8(raw[0], t8);
#pragma unroll
                  for (int e = 0; e < 8; ++e) r[e] = t8[e];
                  unpack8(raw[1], t8);
#pragma unroll
                  for (int e = 0; e < 8; ++e) r[8 + e] = t8[e];
                  unpack8(raw[2], t8);
#pragma unroll
                  for (int e = 0; e < 8; ++e) k[e] = t8[e];
                  unpack8(raw[3], t8);
#pragma unroll
                  for (int e = 0; e < 8; ++e) k[8 + e] = t8[e];
                  unpack8(raw[6], t8);
#pragma unroll
                  for (int e = 0; e < 8; ++e) a[e] = t8[e];
                  unpack8(raw[7], t8);
#pragma unroll
                  for (int e = 0; e < 8; ++e) a[8 + e] = t8[e];
                  unpack8(raw[8], t8);
#pragma unroll
                  for (int e = 0; e < 8; ++e) ew[e] = t8[e];
                  unpack8(raw[9], t8);
#pragma unroll
                  for (int e = 0; e < 8; ++e) ew[8 + e] = t8[e]; }
#if defined(SCAN_STAMP) && defined(SCAN_STAMP_LD)
                asm volatile("s_waitcnt vmcnt(0)" ::: "memory"); STAMP(1);
#endif
                if (cidx + CH_NP < 512) CK_LOAD(cidx + CH_NP);
                float kx[16], ss = 0.f;
#pragma unroll
                for (int e4 = 0; e4 < 4; ++e4) { const f32x4 c0_ = *(const LAS f32x4*)(L + CH_KTAB + (16 * fq + 4 * e4) * 4), c1_ = *(const LAS f32x4*)(L + CH_KTAB + 256 + (16 * fq + 4 * e4) * 4);
#pragma unroll
                    for (int z = 0; z < 4; ++z) { const int ee = 4 * e4 + z; kx[ee] = k[ee] * c0_[z]; ss += kx[ee] * kx[ee]; k[ee] = k[ee] * (1.0f + (a[ee] - 1.0f) * c1_[z]); } }
                ss += __shfl_xor(ss, 16); ss += __shfl_xor(ss, 32);
                const float inv = __builtin_amdgcn_rsqf(fmaxf(ss, 1e-24f));
                unsigned qtw[8], rtw[8], ktw[8], btw[8], bhw[8], khw[8];
                {
                    float li[16], e15[16], ep[16];
#pragma unroll
                    for (int e = 0; e < 16; ++e) li[e] = -ew[e];
#pragma unroll
                    for (int e = 0; e < 16; ++e) li[e] += dpp_shr<1>(li[e]);
#pragma unroll
                    for (int e = 0; e < 16; ++e) li[e] += dpp_shr<2>(li[e]);
#pragma unroll
                    for (int e = 0; e < 16; ++e) li[e] += dpp_shr<4>(li[e]);
#pragma unroll
                    for (int e = 0; e < 16; ++e) li[e] += dpp_shr<8>(li[e]);
#pragma unroll
                    for (int e = 0; e < 16; ++e) li[e] = __builtin_amdgcn_exp2f(1.4426950408889634f * li[e]);
#pragma unroll
                    for (int e = 0; e < 16; ++e) e15[e] = __shfl(li[e], (lane & 48) | 15);
#pragma unroll
                    for (int e = 0; e < 16; ++e) ep[e] = __builtin_bit_cast(float, __builtin_amdgcn_update_dpp(0x3f800000, __builtin_bit_cast(int, li[e]), 0x111, 0xf, 0xf, false));
                    if (fr == 15) {
#pragma unroll
                        for (int e4 = 0; e4 < 4; ++e4) *(LAS f32x4*)(S + GS_DD + (16 * fq + 4 * e4) * 4) = (f32x4){li[4 * e4], li[4 * e4 + 1], li[4 * e4 + 2], li[4 * e4 + 3]}; }
#pragma unroll
                    for (int e = 0; e < 16; e += 2) { float q2[2], r2[2], k2[2], b2[2], b2h[2], k2h[2];
#pragma unroll
                        for (int z = 0; z < 2; ++z) { const int ee = e + z;
                            const float Einv = __builtin_amdgcn_rcpf(li[ee]);
                            const float kk = kx[ee] * inv, bb = a[ee] * kk;
                            q2[z] = kk * ep[ee]; k2[z] = k[ee] * Einv; b2[z] = bb * Einv; r2[z] = r[ee] * li[ee];
                            b2h[z] = b2[z] * e15[ee]; k2h[z] = k2[z] * e15[ee]; }
                        qtw[e >> 1] = pk2(q2[0], q2[1]); rtw[e >> 1] = pk2(r2[0], r2[1]); ktw[e >> 1] = pk2(k2[0], k2[1]); btw[e >> 1] = pk2(b2[0], b2[1]); bhw[e >> 1] = pk2(b2h[0], b2h[1]); khw[e >> 1] = pk2(k2h[0], k2h[1]);
 } }
                { const int ov = tokoff2(fr, 2 * fq); *(LAS v4u*)(S + GS_VT + ov) = vraw0; *(LAS v4u*)(S + GS_VT + ov + 16) = vraw1; }
                { const int o = tokoff(fr, 2 * fq), o2 = o ^ 16;
                  *(LAS v4u*)(S + GS_QT + o) = (v4u){qtw[0], qtw[1], qtw[2], qtw[3]}; *(LAS v4u*)(S + GS_QT + o2) = (v4u){qtw[4], qtw[5], qtw[6], qtw[7]};
                  *(LAS v4u*)(S + GS_RT + o) = (v4u){rtw[0], rtw[1], rtw[2], rtw[3]}; *(LAS v4u*)(S + GS_RT + o2) = (v4u){rtw[4], rtw[5], rtw[6], rtw[7]};
                  *(LAS v4u*)(S + GS_KT + o) = (v4u){ktw[0], ktw[1], ktw[2], ktw[3]}; *(LAS v4u*)(S + GS_KT + o2) = (v4u){ktw[4], ktw[5], ktw[6], ktw[7]};
                  *(LAS v4u*)(S + GS_BT + o) = (v4u){btw[0], btw[1], btw[2], btw[3]}; *(LAS v4u*)(S + GS_BT + o2) = (v4u){btw[4], btw[5], btw[6], btw[7]}; }
                asm volatile("s_waitcnt lgkmcnt(0)" ::: "memory");
#if !defined(SCAN_STAMP_LD)
                STAMP(1);
#endif
                f32x4 mb = zero4, mbt = zero4, mkt = zero4, nbt = zero4, nkt = zero4;
#pragma unroll
                for (int kh = 0; kh < 2; ++kh) { const int o = tokoff(fr, 4 * kh + fq);
                    const bf16x8 Qf = *(const LAS bf16x8*)(S + GS_QT + o), Rf = *(const LAS bf16x8*)(S + GS_RT + o), Kf = *(const LAS bf16x8*)(S + GS_KT + o), Bf = *(const LAS bf16x8*)(S + GS_BT + o);
                    mb = __builtin_amdgcn_mfma_f32_16x16x32_bf16(Qf, Bf, mb, 0, 0, 0); mbt = __builtin_amdgcn_mfma_f32_16x16x32_bf16(Bf, Qf, mbt, 0, 0, 0);
                    mkt = __builtin_amdgcn_mfma_f32_16x16x32_bf16(Kf, Qf, mkt, 0, 0, 0);
                    nbt = __builtin_amdgcn_mfma_f32_16x16x32_bf16(Bf, Rf, nbt, 0, 0, 0); nkt = __builtin_amdgcn_mfma_f32_16x16x32_bf16(Kf, Rf, nkt, 0, 0, 0); }
                asm volatile("s_waitcnt lgkmcnt(0)" ::: "memory");
                STAMP(2);
                { const int oh = tokoff2(fr, 2 * fq);
                  *(LAS v4u*)(S + GS_BHT + oh) = (v4u){bhw[0], bhw[1], bhw[2], bhw[3]}; *(LAS v4u*)(S + GS_BHT + oh + 16) = (v4u){bhw[4], bhw[5], bhw[6], bhw[7]};
                  *(LAS v4u*)(S + GS_KHT + oh) = (v4u){khw[0], khw[1], khw[2], khw[3]}; *(LAS v4u*)(S + GS_KHT + oh + 16) = (v4u){khw[4], khw[5], khw[6], khw[7]}; }
                { f32x4 nAf, nDf, iD, mkm, nkm, nbm;
#pragma unroll
                  for (int e = 0; e < 4; ++e) { const int tt = 4 * fq + e; const bool lo = fr < tt, up = tt < fr, ue = tt <= fr;
                      nAf[e] = lo ? -mb[e] : 0.f; nDf[e] = up ? -mbt[e] : 0.f; iD[e] = (tt == fr) ? 1.0f : 0.0f;
                      mkm[e] = up ? mkt[e] : 0.f; nkm[e] = ue ? nkt[e] : 0.f; nbm[e] = ue ? nbt[e] : 0.f; }
                  const int om = (fr * 16 + 4 * fq) * 2;
                  *(LAS v2u*)(S + GS_MK + om) = (v2u){pk2(mkm[0], mkm[1]), pk2(mkm[2], mkm[3])}; *(LAS v2u*)(S + GS_NK + om) = (v2u){pk2(nkm[0], nkm[1]), pk2(nkm[2], nkm[3])};
                  *(LAS v2u*)(S + GS_NB + om) = (v2u){pk2(nbm[0], nbm[1]), pk2(nbm[2], nbm[3])};
                  STAMP(3);
                  const bf16x8 nA = cvt8z(nAf), nD = cvt8z(nDf);
                  const f32x4 n2D = __builtin_amdgcn_mfma_f32_16x16x32_bf16(nA, nD, zero4, 0, 0, 0), n2A = __builtin_amdgcn_mfma_f32_16x16x32_bf16(nD, nA, zero4, 0, 0, 0);
                  const bf16x8 n2Db = cvt8z(n2D), n2Ab = cvt8z(n2A);
                  const f32x4 n4D = __builtin_amdgcn_mfma_f32_16x16x32_bf16(n2Ab, n2Db, zero4, 0, 0, 0), n4A = __builtin_amdgcn_mfma_f32_16x16x32_bf16(n2Db, n2Ab, zero4, 0, 0, 0);
                  f32x4 Tt = __builtin_amdgcn_mfma_f32_16x16x32_bf16(nA, n2Db, iD + nDf + n2D, 0, 0, 0);
                  const bf16x8 n4Db = cvt8z(n4D), n4Ab = cvt8z(n4A);
                  const f32x4 n8A = __builtin_amdgcn_mfma_f32_16x16x32_bf16(n4Db, n4Ab, zero4, 0, 0, 0);
                  Tt = __builtin_amdgcn_mfma_f32_16x16x32_bf16(n4Ab, cvt8z(Tt), Tt, 0, 0, 0);
                  Tt = __builtin_amdgcn_mfma_f32_16x16x32_bf16(cvt8z(n8A), cvt8z(Tt), Tt, 0, 0, 0);
                  STAMP(4);
                  *(LAS v2u*)(S + GS_TM + om) = (v2u){pk2(Tt[0], Tt[1]), pk2(Tt[2], Tt[3])}; }
                STAMP(5);
                }
                LBAR();
                STAMP(6);
            }
            LBAR();
#ifdef SCAN_STAMP
            if ((SCAN_STAMP_B < 0 || blockIdx.x == SCAN_STAMP_B) && p == SCAN_STAMP_P) { const unsigned long long d_ = (SCAN_STAMP == 0) ? st_[6] - st_[0] : (SCAN_STAMP == 7) ? st_[5] - st_[0] : st_[SCAN_STAMP] - st_[SCAN_STAMP - 1]; const unsigned long long t0_ = __builtin_amdgcn_s_memtime();
                while (__builtin_amdgcn_s_memtime() - t0_ < d_ * 512ull) __builtin_amdgcn_s_sleep(8); }
#endif
#undef CK_LOAD
        } else {
            const int vtA = (CH_NS == 4) ? lw : ((lw == 0) ? 0 : lw + 1);
            f32x4 A2[2][4];
#ifdef SCAN_PRIO
            __builtin_amdgcn_s_setprio(SCAN_PRIO);
#endif
#pragma unroll
            for (int jt = 0; jt < 4; ++jt) { A2[0][jt] = zero4; A2[1][jt] = zero4; }
            const int trb = 4 * fq + (fr >> 2), trc = (fr >> 1) & 1, trl = 8 * (fr & 1);
            LAS unsigned char* ys = L + TB_OFF + lw * 1024;
#ifdef SCAN_SSTAMP
            unsigned long long ss0_ = 0, ss1_ = 0;
#endif
            LBAR();
            const int vt0 = (CH_NS == 3 && lw == 0) ? 0 : vtA; const bool two = (CH_NS == 3 && lw == 0);
            for (int rd = 0; rd < CH_ROUNDS; ++rd) {
                const int c0 = CH_NP * rd; const LAS unsigned char* C0 = L + ((rd & 1) * CH_NP) * GS_SLOT;
                ChOps opA, opB; v2u vA0, vA1, vB0, vB1;
#define CH_FETCH(OP, V0, V1, q_) do { const LAS unsigned char* C_ = C0 + (q_) * GS_SLOT; chain_load(OP, C_, fr, fq); V0 = trld(C_ + GS_VT + tokoff2(trb, 2 * vt0 + trc) + trl); \
                    if (two) V1 = trld(C_ + GS_VT + tokoff2(trb, 2 + trc) + trl); } while (0)
#define CH_ITER(q_, CUR, U0, U1, NXT, W0, W1) do { if ((q_) < CH_NP) { const int cidx = c0 + (q_); \
                    if ((q_) + 1 < CH_NP && cidx + 1 < 512) CH_FETCH(NXT, W0, W1, (q_) + 1); \
                    if (cidx < 512) { GAS bf16* yrow = (GAS bf16*)Y + (rowb + (size_t)cidx * 16) * 1024 + h * 64; \
                        if (two) chain_step<2>(CUR, C0 + (q_) * GS_SLOT, U0, U1, A2, 0, fr, fq, yrow, ys); \
                        else chain_step<1>(CUR, C0 + (q_) * GS_SLOT, U0, U0, A2, vtA, fr, fq, yrow, ys); } } } while (0)
                vA1 = (v2u){0u, 0u}; vB1 = (v2u){0u, 0u};
                if (c0 < 512) CH_FETCH(opA, vA0, vA1, 0);
                CH_ITER(0, opA, vA0, vA1, opB, vB0, vB1);
                CH_ITER(1, opB, vB0, vB1, opA, vA0, vA1);
                CH_ITER(2, opA, vA0, vA1, opB, vB0, vB1);
                CH_ITER(3, opB, vB0, vB1, opA, vA0, vA1);
                CH_ITER(4, opA, vA0, vA1, opB, vB0, vB1);
                CH_ITER(5, opB, vB0, vB1, opA, vA0, vA1);
#undef CH_ITER
#undef CH_FETCH
                LBAR();
            }
#ifdef SCAN_SSTAMP
            if (lw == SCAN_SSTAMP_W) { const unsigned long long d_ = (ss1_ - ss0_) * 512ull, t0_ = __builtin_amdgcn_s_memtime(); while (__builtin_amdgcn_s_memtime() - t0_ < d_) __builtin_amdgcn_s_sleep(8); }
#endif
#ifdef SCAN_PRIO
            __builtin_amdgcn_s_setprio(0);
#endif
        }
    }
}
__device__ __forceinline__ void rwkv_post_pass(Frame& F, const In& I, const bf16* R, const bf16* Kt, const bf16* V, const bf16* AA, const bf16* G, bf16* Y) {
    const int gw = F.vcu * NWAVES + F.wave, NGW = F.G * NWAVES; const int col = LANE_ * 16;
    for (int t0 = 2 * gw; t0 < T; t0 += 2 * NGW) {
        v4u py[2][2], pr[2][2], pk[2][2], pv[2][2], pa[2][2], pg[2][2];
#pragma unroll
        for (int rw = 0; rw < 2; ++rw) { const size_t off = (size_t)(t0 + rw) * 1024 + col;
#pragma unroll
            for (int hf = 0; hf < 2; ++hf) { py[rw][hf] = *(const v4u*)(Y + off + hf * 8); pr[rw][hf] = *(const v4u*)(R + off + hf * 8); pk[rw][hf] = *(const v4u*)(Kt + off + hf * 8);
                pv[rw][hf] = *(const v4u*)(V + off + hf * 8); pa[rw][hf] = *(const v4u*)(AA + off + hf * 8); pg[rw][hf] = *(const v4u*)(G + off + hf * 8); } }
#pragma unroll
        for (int rw = 0; rw < 2; ++rw) { const size_t off = (size_t)(t0 + rw) * 1024 + col;
            float kaw[16], rkw[16], lng[16], lnb[16];
#pragma unroll
            for (int e4 = 0; e4 < 4; ++e4) { const f32x4 c0 = *(const GAS f32x4*)(I.rwkv_ka + col + 4 * e4), c1 = *(const GAS f32x4*)(I.rwkv_rk + col + 4 * e4), c2 = *(const GAS f32x4*)(I.rwkv_ln_g + col + 4 * e4), c3 = *(const GAS f32x4*)(I.rwkv_ln_b + col + 4 * e4);
#pragma unroll
                for (int e = 0; e < 4; ++e) { kaw[4 * e4 + e] = c0[e]; rkw[4 * e4 + e] = c1[e]; lng[4 * e4 + e] = c2[e]; lnb[4 * e4 + e] = c3[e]; } }
            float y[16], r[16], k[16], v[16], a[16], g[16];
#pragma unroll
            for (int hf = 0; hf < 2; ++hf) { float t8[8];
                unpack8(py[rw][hf], t8);
#pragma unroll
                for (int e = 0; e < 8; ++e) y[hf * 8 + e] = t8[e];
                unpack8(pr[rw][hf], t8);
#pragma unroll
                for (int e = 0; e < 8; ++e) r[hf * 8 + e] = t8[e];
                unpack8(pk[rw][hf], t8);
#pragma unroll
                for (int e = 0; e < 8; ++e) k[hf * 8 + e] = t8[e];
                unpack8(pv[rw][hf], t8);
#pragma unroll
                for (int e = 0; e < 8; ++e) v[hf * 8 + e] = t8[e];
                unpack8(pa[rw][hf], t8);
#pragma unroll
                for (int e = 0; e < 8; ++e) a[hf * 8 + e] = t8[e];
                unpack8(pg[rw][hf], t8);
#pragma unroll
                for (int e = 0; e < 8; ++e) g[hf * 8 + e] = t8[e]; }
            float s = 0.f, bs = 0.f;
#pragma unroll
            for (int e = 0; e < 16; ++e) { s += y[e]; const float kp = k[e] * (1.0f + (a[e] - 1.0f) * kaw[e]); bs += r[e] * kp * rkw[e]; }
            s += __shfl_xor(s, 1); s += __shfl_xor(s, 2); bs += __shfl_xor(bs, 1); bs += __shfl_xor(bs, 2);
            const float mean = s * (1.0f / 64.0f); float q = 0.f;
#pragma unroll
            for (int e = 0; e < 16; ++e) { const float dd = y[e] - mean; q += dd * dd; }
            q += __shfl_xor(q, 1); q += __shfl_xor(q, 2);
            const float rstd = 1.0f / sqrtf(q * (1.0f / 64.0f) + 64e-5f);
            float o[16];
#pragma unroll
            for (int e = 0; e < 16; ++e) o[e] = ((y[e] - mean) * rstd * lng[e] + lnb[e] + bs * v[e]) * g[e];
            v4u w0, w1; w0.x = pk2(o[0], o[1]); w0.y = pk2(o[2], o[3]); w0.z = pk2(o[4], o[5]); w0.w = pk2(o[6], o[7]); w1.x = pk2(o[8], o[9]); w1.y = pk2(o[10], o[11]); w1.z = pk2(o[12], o[13]); w1.w = pk2(o[14], o[15]);
            *(v4u*)(Y + off) = w0; *(v4u*)(Y + off + 8) = w1; }
    }
}

#ifndef DUP_K
#define DUP_K (-1)
#endif
#ifndef DUP_K2
#define DUP_K2 (-1)
#endif
#define KARGS ((const __attribute__((address_space(4))) Args*)__builtin_amdgcn_kernarg_segment_ptr())
#define WSPTRS \
    bf16* H0 = (bf16*)(ws + WS_H0); bf16* QKV = (bf16*)(ws + WS_QKV); bf16* OB = (bf16*)(ws + WS_O); f32x2* AGG = (f32x2*)(ws + WS_LRUAGG); \
    bf16* H2 = (bf16*)(ws + WS_H2); float* LOG = (float*)(ws + WS_LOG); unsigned char* RTE = ws + WS_ROUTE; bf16* HID = (bf16*)(ws + WS_HID); bf16* YS = (bf16*)(ws + WS_YS); bf16* PP = (bf16*)(ws + WS_PP); \
    bf16* HCAT = (bf16*)(ws + WS_HCAT); bf16* RB = (bf16*)(ws + WS_R); bf16* KB = (bf16*)(ws + WS_K); bf16* VB = (bf16*)(ws + WS_V); bf16* XRB = (bf16*)(ws + WS_XR); bf16* XKB = (bf16*)(ws + WS_XK); bf16* XVB = (bf16*)(ws + WS_XV); bf16* MID = (bf16*)(ws + WS_MID); bf16* EWB = (bf16*)(ws + WS_EW); bf16* AAB = (bf16*)(ws + WS_AA); bf16* YB = (bf16*)(ws + WS_Y); \
    const size_t TD = (size_t)T * 1024; (void)H0; (void)QKV; (void)OB; (void)AGG; (void)H2; (void)LOG; (void)RTE; (void)HID; (void)YS; (void)PP; (void)HCAT; (void)RB; (void)KB; (void)VB; (void)XRB; (void)XKB; (void)XVB; (void)MID; (void)EWB; (void)AAB; (void)YB; (void)TD;

struct Args { In in; float* out; unsigned char* ws; int ph_lo, ph_hi; };
constexpr int N_PHASES = 34;
__device__ __forceinline__ int nrep(int k) { int n = (k == DUP_K) ? 2 : 1; if (DUP_K >= 0) asm volatile("" : "+s"(n)); return n; }
#define REP_SYNC if (rep_) __syncthreads();
typedef const __attribute__((address_space(4))) unsigned long long* kp64;
__device__ __forceinline__ void load_in(In& I) { kp64 s = (kp64)__builtin_amdgcn_kernarg_segment_ptr(); unsigned long long* d = (unsigned long long*)&I;
#pragma unroll
    for (int i = 0; i < 47; ++i) d[i] = s[i]; }

__device__ __forceinline__ int t5_bucket(int n) { if (n < 16) return n; const float v = logf((float)n / 16.0f) / 2.0794415416798357f * 16.0f; const int l = 16 + (int)v; return l < 31 ? l : 31; }

template <class Epi>
__device__ __forceinline__ void dense_gemm(Frame& F, const void* A, int lda, const void* B, int K, int M, int N, const Epi& E) {
    pg8::DenseOrder S; S.init(A, lda, B, K, M, N, F.G, (int)blockIdx.x);
    pg8::gemm_phase<Epi, pg8::DenseOrder, true, false>(F.lds, K, lda, S, E, nullptr, TID_);
}

__global__ void __launch_bounds__(NWAVES * 64, 2) mk_fwd(Args args) {
    extern __shared__ __attribute__((aligned(16))) unsigned char lds[];
    Frame F;
    F.lds = (LAS unsigned char*)lds;
    F.MISC = (volatile LAS unsigned*)(F.lds + MISC_OFF);
    { int w_ = __builtin_amdgcn_readfirstlane((int)threadIdx.x >> 6); asm volatile("" : "+s"(w_)); F.wave = w_; }
    F.G = gridDim.x; { const int bx = blockIdx.x; F.vcu = (F.G % 8 == 0) ? (bx % 8) * (F.G / 8) + bx / 8 : bx; }
    F.ctl = (gu32*)(KARGS->ws + WS_CTL);
    for (int u = TID_; u < (LDS_BYTES - LDSCTL_OFF) / 4; u += NWAVES * 64) ((LAS unsigned*)(F.lds + LDSCTL_OFF))[u] = 0u;
    __syncthreads();
    {
        LAS float* tb = (LAS float*)(F.lds + TB_OFF); const int h = TID_ >> 7, i = TID_ & 127;
        const float* rb = KARGS->in.rel_bias;
        tb[h * 128 + i] = (rb[t5_bucket(i) * 4 + h] - rb[31 * 4 + h]) * 1.4426950408889634f;
    }
    __syncthreads();
    const int lo = KARGS->ph_lo, hi = KARGS->ph_hi;
    const bool multi = (hi - lo) > 1;
    XcdBarrier bar; bar.bar = (unsigned*)(F.ctl + CW_BAR); bar.x = 0; bar.st = nullptr;
    if (multi) bar = xcd_barrier_post((unsigned*)(F.ctl + CW_BAR), F.MISC + 8, TID_ == 0);
#define IN(k) (lo <= (k) && (k) < hi)
#define PH_BEGIN_ unsigned char* ws = KARGS->ws; bf16* X = (bf16*)KARGS->out; float* OUT = KARGS->out; (void)OUT; bf16* GB2 = (bf16*)KARGS->out + (size_t)T * 1024; (void)GB2; In I; load_in(I); (void)X; WSPTRS
#define SEAM(k) do { if (IN(k) && IN((k) + 1)) xcd_barrier(bar, TID_ == 0); } while (0)

    if (IN(0)) { PH_BEGIN_ prep_dense_weights(F, I, ws); prep_layer_weights(F, I, ws, 0); norm_pass<false>(F, I.x, I.norm_mix, H0);
#ifdef DUP_PREP
        __syncthreads(); prep_dense_weights(F, I, ws); prep_layer_weights(F, I, ws, 0);
#endif
    } SEAM(0);
    if (IN(1)) { PH_BEGIN_ pg8::EpiBf16 E{QKV, 512, 512, (size_t)T * 512, attn_body::C2}; dense_gemm(F, H0, 1024, ws + WS_WIN, 1024, T, AB_IN, E); } SEAM(1);
    if (IN(2)) { PH_BEGIN_ lru_agg_mfma(F, I, QKV + 3 * (size_t)T * 512, AGG, (bf16*)(ws + WS_HL), (bf16*)(ws + WS_CA)); } SEAM(2);
    if (IN(3)) { PH_BEGIN_
        const attn_body::AttnTensors AT{(const attn_body::bf16*)QKV, (const attn_body::bf16*)(QKV + (size_t)T * 512), (const attn_body::bf16*)(QKV + 2 * (size_t)T * 512), (attn_body::bf16*)OB};
        if (F.G == 256) attn_body::attn_phase<8>((char*)lds, AT, F.vcu, (const LAS float*)(F.lds + TB_OFF), (int)threadIdx.x);
#ifdef DUP_ATTN
        __syncthreads(); if (F.G == 256) attn_body::attn_phase<8>((char*)lds, AT, F.vcu, (const LAS float*)(F.lds + TB_OFF), (int)threadIdx.x);
#endif
        __syncthreads();
        lru_final_pass(F, (const bf16*)(ws + WS_HL), (const bf16*)(ws + WS_CA), QKV + 4 * (size_t)T * 512, AGG, H0);
    } SEAM(3);
    if (IN(4)) { PH_BEGIN_ diff_combine_pass(F, I, OB, H0); } SEAM(4);
    if (IN(5)) { PH_BEGIN_ pg8::EpiResX<false> E{I.x, X}; dense_gemm(F, H0, 1024, ws + WS_WOUT, 1024, T, 1024, E); } SEAM(5);

#define MOE_PLE_PHASES(P, L) \
    if (IN(P + 0)) { PH_BEGIN_ norm_pass<true>(F, X, I.norm_ffn + (L) * 1024, H2); } SEAM(P + 0); \
    if (IN(P + 1)) { PH_BEGIN_ pg8::EpiRouter E{LOG}; dense_gemm(F, H2, 1024, ws + WS_ROUT + (size_t)(L) * 256 * 1024 * 2, 1024, T, 256, E); } SEAM(P + 1); \
    if (IN(P + 2)) { PH_BEGIN_ route_pass_a(F, I, (L), LOG, RTE, F.ctl + ((L) ? CW_CNT1 : CW_CNT0)); } SEAM(P + 2); \
    if (IN(P + 3)) { PH_BEGIN_ route_pass_b(F, RTE, F.ctl + ((L) ? CW_CNT1 : CW_CNT0)); } SEAM(P + 3); \
    if (IN(P + 4)) { PH_BEGIN_ route_bases(F, F.ctl + ((L) ? CW_CNT1 : CW_CNT0)); const LAS int* eb = (const LAS int*)(F.lds + RTE_OFF + 512); \
        MoeOrder S{F.G, (int)blockIdx.x, __builtin_amdgcn_readfirstlane(eb[32] >> 8), eb, (const char*)H2, (const char*)(ws + WS_MGU), 0, (size_t)1024 * 1024 * 2, (size_t)256 * 1024 * 2, true}; pg8::EpiGU E{HID}; \
        pg8::gemm_phase<pg8::EpiGU, MoeOrder, true, true>(F.lds, 1024, 1024, S, E, (const int*)(RTE + RT_ROWTOK), TID_); } SEAM(P + 4); \
    if (IN(P + 5)) { PH_BEGIN_ route_bases(F, F.ctl + ((L) ? CW_CNT1 : CW_CNT0)); const LAS int* eb = (const LAS int*)(F.lds + RTE_OFF + 512); \
        MoeOrder S{F.G, (int)blockIdx.x, __builtin_amdgcn_readfirstlane(eb[32] >> 8), eb, (const char*)HID, (const char*)(ws + WS_MDN), (size_t)256 * 512 * 2, (size_t)1024 * 512 * 2, (size_t)256 * 512 * 2, false}; pg8::EpiDown E{YS, (const float*)(RTE + RT_ROWGATE)}; \
        pg8::gemm_phase<pg8::EpiDown, MoeOrder, true, false>(F.lds, 512, 512, S, E, nullptr, TID_); } SEAM(P + 5); \
    if (IN(P + 6)) { PH_BEGIN_ combine_norm_pass(F, X, X, YS, (const int*)(RTE + RT_SLOT), I.ple_norm + (L) * 1024, H2); } SEAM(P + 6); \
    if (IN(P + 7)) { PH_BEGIN_ pg8::EpiBf16 E{PP, 1024, 0, 0, 1.f}; dense_gemm(F, ws + WS_PB, 256, ws + WS_PPROJ + (size_t)(L) * 1024 * 256 * 2, 256, T, 1024, E); } SEAM(P + 7); \
    if (IN(P + 8)) { PH_BEGIN_ pg8::EpiPle E{X, (L) ? (bf16*)(ws + WS_YS) : X, PP}; dense_gemm(F, H2, 1024, ws + WS_PGATE + (size_t)(L) * 1024 * 1024 * 2, 1024, T, 1024, E); } SEAM(P + 8);

    MOE_PLE_PHASES(6, 0)
    if (IN(15)) { PH_BEGIN_ rwkv_input_pass(F, X, I.norm_mix + 1024, I.rwkv_mu, HCAT, XRB, XKB, XVB); } SEAM(15);
    if (IN(16)) { PH_BEGIN_ { pg8::EpiBf16 E{RB, 1024, 0, 0, 1.f}; dense_gemm(F, XRB, 1024, ws + WS_RCAT, 1024, T, 1024, E); }
        { pg8::EpiMid E{MID}; dense_gemm(F, HCAT, 2048, ws + WS_RL1, 2048, T, 512, E); } } SEAM(16);
    if (IN(17)) { PH_BEGIN_ pg8::EpiBf16 E{KB, 1024, 0, 0, 1.f}; dense_gemm(F, XKB, 1024, ws + WS_RCAT + (size_t)1024 * 1024 * 2, 1024, T, 1024, E); } SEAM(17);
    if (IN(18)) { PH_BEGIN_ pg8::EpiBf16 E{VB, 1024, 0, 0, 1.f}; dense_gemm(F, XVB, 1024, ws + WS_RCAT + (size_t)2 * 1024 * 1024 * 2, 1024, T, 1024, E); } SEAM(18);
    if (IN(19)) { PH_BEGIN_ pg8::EpiRwkv2 E{EWB, AAB, I.rwkv_w0, I.rwkv_a0, 0}; dense_gemm(F, MID, 512, ws + WS_RS2, 256, T, 2048, E); } SEAM(19);
    if (IN(20)) { PH_BEGIN_
        if (F.G == 256 && blockIdx.x >= 128) {
            Frame F2 = F; F2.G = 128; F2.vcu = (int)blockIdx.x - 128;
#ifdef HELP_STAMP
            const unsigned long long hs0_ = __builtin_amdgcn_s_memtime();
#endif
            prep_layer_weights(F2, I, ws, 1);
            __syncthreads();
            pg8::EpiRwkv2 E{GB2, GB2, nullptr, nullptr, 2}; pg8::DenseOrder S; S.init(MID + 256, 512, ws + WS_RS2 + (size_t)2 * 1024 * 256 * 2, 256, T, 1024, 128, (int)blockIdx.x - 128);
            pg8::gemm_phase<pg8::EpiRwkv2, pg8::DenseOrder, true, false>(F.lds, 256, 512, S, E, nullptr, TID_);
#ifdef HELP_STAMP
            if (blockIdx.x == 128) { const unsigned long long d_ = (__builtin_amdgcn_s_memtime() - hs0_) * HELP_STAMP; const unsigned long long t0_ = __builtin_amdgcn_s_memtime(); while (__builtin_amdgcn_s_memtime() - t0_ < d_) __builtin_amdgcn_s_sleep(8); }
#endif
        } else rwkv_scan_chunked(F, I, RB, KB, VB, AAB, EWB, YB);
    } SEAM(20);
    if (IN(22)) { PH_BEGIN_ rwkv_post_pass(F, I, RB, KB, VB, AAB, GB2, YB); } SEAM(22);
    if (IN(23)) { PH_BEGIN_ pg8::EpiResX<true> E{X, X}; dense_gemm(F, YB, 1024, ws + WS_RWO, 1024, T, 1024, E); } SEAM(23);
    MOE_PLE_PHASES(24, 1)
    if (IN(33)) { PH_BEGIN_ final_norm_pass(F, (const bf16*)(ws + WS_YS), OUT, I.final_norm); }
#undef IN
#undef SEAM
}

extern "C" void kernel_launch(void* const* d_in, const int* in_sizes, int n_in, void* d_out, int out_size, void* d_ws, size_t ws_size, hipStream_t stream) {
    static int ok = 0;
    if (ok == 0) {
        if (n_in != 47 || out_size != T * D || ws_size < WS_END) { fprintf(stderr, "kernel_launch: unexpected problem shape (n_in %d out %d ws %zu)\n", n_in, out_size, ws_size); ok = -1; return; }
        if (hipFuncSetAttribute((const void*)mk_fwd, hipFuncAttributeMaxDynamicSharedMemorySize, LDS_BYTES) != hipSuccess) { fprintf(stderr, "kernel_launch: hipFuncSetAttribute failed\n"); ok = -1; return; }
        int per_cu = 0;
        if (hipOccupancyMaxActiveBlocksPerMultiprocessor(&per_cu, (const void*)mk_fwd, NWAVES * 64, LDS_BYTES) != hipSuccess || per_cu < 1) fprintf(stderr, "kernel_launch: occupancy query reports %d\n", per_cu);
        (void)hipGetLastError();
        ok = 1;
    }
    if (ok < 0) return;
    (void)hipMemsetAsync((char*)d_ws + WS_CTL, 0, CTL_ZERO_BYTES, stream);
    Args a{};
    const float** ip = (const float**)&a.in;
    for (int i = 0; i < 47; ++i) ip[i] = (const float*)d_in[i];
    a.out = (float*)d_out; a.ws = (unsigned char*)d_ws;
    const int grid = 256;
#if MK_ONE_LAUNCH
    a.ph_lo = 0; a.ph_hi = N_PHASES;
    hipLaunchKernelGGL(mk_fwd, dim3(grid), dim3(NWAVES * 64), LDS_BYTES, stream, a);
#else
    for (int k = 0; k < N_PHASES; ++k) { a.ph_lo = k; a.ph_hi = k + 1; hipLaunchKernelGGL(mk_fwd, dim3(grid), dim3(NWAVES * 64), LDS_BYTES, stream, a);
        if (k == DUP_K || k == DUP_K2) hipLaunchKernelGGL(mk_fwd, dim3(grid), dim3(NWAVES * 64), LDS_BYTES, stream, a); }
#endif
}
```

```cpp
#include <hip/hip_runtime.h>
#include <hip/hip_bf16.h>
#include <cstdio>
#include <cstdint>
#include <cmath>

#ifndef MK_ONE_LAUNCH
#define MK_ONE_LAUNCH 1
#endif

#define GAS __attribute__((address_space(1)))
#define LAS __attribute__((address_space(3)))
typedef unsigned short bf16;
typedef unsigned v4u __attribute__((ext_vector_type(4)));
typedef unsigned v2u __attribute__((ext_vector_type(2)));
typedef float f32x4 __attribute__((ext_vector_type(4)));
typedef float f32x2 __attribute__((ext_vector_type(2)));
typedef short bf16x8 __attribute__((ext_vector_type(8)));
typedef GAS unsigned gu32;
#define RLX_AGENT __ATOMIC_RELAXED, __HIP_MEMORY_SCOPE_AGENT
#define LDS_WAIT() asm volatile("s_waitcnt lgkmcnt(0)" ::: "memory")
#define VM_WAIT() asm volatile("s_waitcnt vmcnt(0)" ::: "memory")
__device__ __forceinline__ unsigned f2bf(float f) { unsigned u = __builtin_bit_cast(unsigned, f); return (u + 0x7fffu + ((u >> 16) & 1u)) >> 16; }
typedef float f32x2_cv __attribute__((ext_vector_type(2))); typedef __bf16 bf16x2_cv __attribute__((ext_vector_type(2)));
__device__ __forceinline__ unsigned pk2(float lo, float hi) { const f32x2_cv v = {lo, hi}; const bf16x2_cv b = __builtin_convertvector(v, bf16x2_cv); return __builtin_bit_cast(unsigned, b); }
__device__ __forceinline__ float bflo(unsigned w) { return __uint_as_float(w << 16); }
__device__ __forceinline__ float bfhi(unsigned w) { return __uint_as_float(w & 0xffff0000u); }
__device__ __forceinline__ float bf1(bf16 h) { return __uint_as_float((unsigned)h << 16); }
__device__ __forceinline__ float sigmoidf_(float x) { return __builtin_amdgcn_rcpf(1.0f + __builtin_amdgcn_exp2f(-1.4426950408889634f * x)); }
__device__ __forceinline__ float tanhf_(float x) { return 1.0f - 2.0f * __builtin_amdgcn_rcpf(1.0f + __builtin_amdgcn_exp2f(2.885390081777927f * x)); }
__device__ __forceinline__ void fmac_(float& acc, float a, float b) { asm("v_fmac_f32 %0, %1, %2" : "+v"(acc) : "v"(a), "v"(b)); }
__device__ __forceinline__ float fma_(float a, float b, float c) { float r; asm("v_fma_f32 %0, %1, %2, %3" : "=v"(r) : "v"(a), "v"(b), "v"(c)); return r; }
__device__ __forceinline__ float mul_(float a, float b) { float r; asm("v_mul_f32 %0, %1, %2" : "=v"(r) : "v"(a), "v"(b)); return r; }
__device__ __forceinline__ float wave_sum(float v) {
#pragma unroll
    for (int o = 1; o < 64; o <<= 1) v += __shfl_xor(v, o);
    return v;
}

constexpr int NB = 8, SEQ = 8192, D = 1024, T = NB * SEQ;
constexpr int AB_IN = 2560, PLE = 256;
constexpr int NEXP = 32, EH = 512;
constexpr int MAXSLOT = 2 * T + NEXP * 256;
constexpr int MAXTILES = MAXSLOT / 256;

namespace pg8 {
#define PG8_LAS __attribute__((address_space(3)))
typedef unsigned short bf16_t;
typedef unsigned u32x4 __attribute__((ext_vector_type(4)));
typedef unsigned u32x2 __attribute__((ext_vector_type(2)));
constexpr int BM = 256, BK = 64, HALF = 128, HTB = HALF * BK * 2, STAGE_BYTES = 8 * HTB, NXCD = 8, WGM = 8;
__host__ __device__ __forceinline__ int lds_byte(int r, int c) { const int st = (r >> 4) * 2 + (c >> 5), rr = r & 15, cc = c & 31, ob = rr * 64 + cc * 2; return st * 1024 + (ob ^ (((ob >> 9) & 1) << 5)); }
__host__ __device__ __forceinline__ void stage_rc(int b, int& R, int& C) { const int st = b / 1024, sb = b % 1024, swz = sb ^ (((sb >> 9) & 1) << 5); R = (st >> 1) * 16 + swz / 64; C = (st & 1) * 32 + (swz % 64) / 2; }
__host__ __device__ __forceinline__ int perm32(int rho) { const int n = rho >> 4, i = rho & 15; return 8 * (i >> 2) + 4 * n + (i & 3); }

struct Unit { int pm, pn, aux; const char* A; const char* B; };

struct DenseOrder {
    int nM, nN, nwg, G, c; const char* A; const char* B; size_t astep, bstep;
    __device__ void init(const void* A_, int lda, const void* B_, int K, int M, int N, int G_, int c_) { nM = M / BM; nN = N / BM; nwg = nM * nN; G = G_; c = c_; A = (const char*)A_; B = (const char*)B_; astep = (size_t)BM * lda * 2; bstep = (size_t)BM * K * 2; }
    __device__ bool next(int i, Unit& u) const {
        const long L = (long)i * G + c; if (L >= nwg) return false;
        int wgid = (int)L; { const int q = nwg / NXCD, r = nwg % NXCD, xcd = wgid % NXCD, off = wgid / NXCD; wgid = (xcd < r ? xcd * (q + 1) : r * (q + 1) + (xcd - r) * q) + off; }
        const int nig = WGM * nN, gid = wgid / nig, fm = gid * WGM, gsz = (nM - fm) < WGM ? (nM - fm) : WGM;
        u.pm = fm + ((wgid % nig) % gsz); u.pn = (wgid % nig) / gsz; u.aux = 0; u.A = A + (size_t)u.pm * astep; u.B = B + (size_t)u.pn * bstep; return true;
    }
};

__device__ __forceinline__ unsigned cvt_pk_bf16(float lo, float hi) { unsigned r; asm volatile("v_cvt_pk_bf16_f32 %0, %1, %2" : "=v"(r) : "v"(lo), "v"(hi)); return r; }

typedef f32x4 Acc[2][2][4][2];

struct EpiBf16 {
    static constexpr bool PERM = true;
    bf16_t* O; int ldc; int split_cols; size_t split_stride; float scale0;
    __device__ __forceinline__ void operator()(const Acc& acc, const Unit& u, int wr, int wc, int fr, int fq) const {
        const int row0 = u.pm * BM + wr * 64 + fr; int colt = u.pn * BM; bf16_t* base = O;
        float sc = 1.f; if (split_cols) { const int t = colt / split_cols; base += (size_t)t * split_stride; colt -= t * split_cols; if (t == 0) sc = scale0; }
        const int col0 = colt + wc * 32 + 8 * fq;
#pragma unroll
        for (int ai = 0; ai < 2; ++ai)
#pragma unroll
            for (int m = 0; m < 4; ++m) { bf16_t* rowp = base + (size_t)(row0 + ai * HALF + m * 16) * ldc + col0;
#pragma unroll
                for (int bj = 0; bj < 2; ++bj) { f32x4 v0 = acc[ai][bj][m][0] * sc, v1 = acc[ai][bj][m][1] * sc;
                    u32x4 w; w.x = cvt_pk_bf16(v0[0], v0[1]); w.y = cvt_pk_bf16(v0[2], v0[3]); w.z = cvt_pk_bf16(v1[0], v1[1]); w.w = cvt_pk_bf16(v1[2], v1[3]);
                    *(u32x4*)(rowp + bj * HALF) = w; } }
    }
};
__device__ __forceinline__ void unpack8f(const u32x4 w, f32x4& lo, f32x4& hi) { lo = (f32x4){bflo(w.x), bfhi(w.x), bflo(w.y), bfhi(w.y)}; hi = (f32x4){bflo(w.z), bfhi(w.z), bflo(w.w), bfhi(w.w)}; }
template <bool BASE_BF16>
struct EpiResX {
    static constexpr bool PERM = true;
    const void* base; bf16_t* out;
    __device__ __forceinline__ void operator()(const Acc& acc, const Unit& u, int wr, int wc, int fr, int fq) const {
        const int col0 = u.pn * BM + wc * 32 + 8 * fq; GAS bf16_t* op = (GAS bf16_t*)out;
#pragma unroll
        for (int ai = 0; ai < 2; ++ai) {
            f32x4 b0[4][2], b1[4][2];
#pragma unroll
            for (int m = 0; m < 4; ++m) { const size_t off = (size_t)(u.pm * BM + ai * HALF + wr * 64 + m * 16 + fr) * 1024 + col0;
#pragma unroll
                for (int bj = 0; bj < 2; ++bj) {
                    if (BASE_BF16) { const u32x4 w = *(const GAS u32x4*)((const GAS bf16_t*)base + off + bj * HALF); unpack8f(w, b0[m][bj], b1[m][bj]); }
                    else { b0[m][bj] = *(const GAS f32x4*)((const GAS float*)base + off + bj * HALF); b1[m][bj] = *(const GAS f32x4*)((const GAS float*)base + off + bj * HALF + 4); } } }
            asm volatile("" ::: "memory");
#pragma unroll
            for (int m = 0; m < 4; ++m) { const size_t off = (size_t)(u.pm * BM + ai * HALF + wr * 64 + m * 16 + fr) * 1024 + col0;
#pragma unroll
                for (int bj = 0; bj < 2; ++bj) { const f32x4 v0 = b0[m][bj] + acc[ai][bj][m][0], v1 = b1[m][bj] + acc[ai][bj][m][1];
                    u32x4 w; w.x = cvt_pk_bf16(v0[0], v0[1]); w.y = cvt_pk_bf16(v0[2], v0[3]); w.z = cvt_pk_bf16(v1[0], v1[1]); w.w = cvt_pk_bf16(v1[2], v1[3]);
                    *(GAS u32x4*)(op + off + bj * HALF) = w; } }
            asm volatile("" ::: "memory");
        }
    }
};
struct EpiRouter {
    static constexpr bool PERM = false;
    float* out;
    __device__ __forceinline__ void operator()(const Acc& acc, const Unit& u, int wr, int wc, int fr, int fq) const {
        if (wc >= 2) return;
#pragma unroll
        for (int ai = 0; ai < 2; ++ai)
#pragma unroll
            for (int m = 0; m < 4; ++m) { const size_t off = (size_t)(u.pm * BM + ai * HALF + wr * 64 + m * 16 + fr) * 64 + wc * 32 + 4 * fq;
#pragma unroll
                for (int n = 0; n < 2; ++n) *(f32x4*)(out + off + n * 16) = acc[ai][0][m][n]; }
    }
};
struct EpiGU {
    static constexpr bool PERM = true;
    bf16_t* H;
    __device__ __forceinline__ void operator()(const Acc& acc, const Unit& u, int wr, int wc, int fr, int fq) const {
        const int col0 = u.pn * 128 + wc * 32 + 8 * fq;
#pragma unroll
        for (int ai = 0; ai < 2; ++ai)
#pragma unroll
            for (int m = 0; m < 4; ++m) { bf16_t* rowp = H + (size_t)(u.pm * BM + ai * HALF + wr * 64 + m * 16 + fr) * EH + col0;
                f32x4 g0 = acc[ai][0][m][0], g1 = acc[ai][0][m][1]; const f32x4 u0 = acc[ai][1][m][0], u1 = acc[ai][1][m][1];
#pragma unroll
                for (int e = 0; e < 4; ++e) { g0[e] = g0[e] * sigmoidf_(g0[e]) * u0[e]; g1[e] = g1[e] * sigmoidf_(g1[e]) * u1[e]; }
                u32x4 w; w.x = cvt_pk_bf16(g0[0], g0[1]); w.y = cvt_pk_bf16(g0[2], g0[3]); w.z = cvt_pk_bf16(g1[0], g1[1]); w.w = cvt_pk_bf16(g1[2], g1[3]);
                *(u32x4*)rowp = w; }
    }
};
struct EpiDown {
    static constexpr bool PERM = true;
    bf16_t* Y; const float* gate;
    __device__ __forceinline__ void operator()(const Acc& acc, const Unit& u, int wr, int wc, int fr, int fq) const {
        const int col0 = u.pn * BM + wc * 32 + 8 * fq;
#pragma unroll
        for (int ai = 0; ai < 2; ++ai)
#pragma unroll
            for (int m = 0; m < 4; ++m) { const int row = u.pm * BM + ai * HALF + wr * 64 + m * 16 + fr; const float sc = gate[row]; bf16_t* rowp = Y + (size_t)row * 1024 + col0;
#pragma unroll
                for (int bj = 0; bj < 2; ++bj) { const f32x4 v0 = acc[ai][bj][m][0] * sc, v1 = acc[ai][bj][m][1] * sc;
                    u32x4 w; w.x = cvt_pk_bf16(v0[0], v0[1]); w.y = cvt_pk_bf16(v0[2], v0[3]); w.z = cvt_pk_bf16(v1[0], v1[1]); w.w = cvt_pk_bf16(v1[2], v1[3]);
                    *(u32x4*)(rowp + bj * HALF) = w; } }
    }
};
struct EpiPle {
    static constexpr bool PERM = true;
    const bf16_t* xin; bf16_t* xout; const bf16_t* pp;
    __device__ __forceinline__ void operator()(const Acc& acc, const Unit& u, int wr, int wc, int fr, int fq) const {
        const int col0 = u.pn * BM + wc * 32 + 8 * fq;
        const GAS bf16_t* xp = (const GAS bf16_t*)xin; GAS bf16_t* op = (GAS bf16_t*)xout; const GAS bf16_t* pq = (const GAS bf16_t*)pp;
#pragma unroll
        for (int ai = 0; ai < 2; ++ai) {
            u32x4 xw[4][2], pw[4][2];
#pragma unroll
            for (int m = 0; m < 4; ++m) { const size_t off = (size_t)(u.pm * BM + ai * HALF + wr * 64 + m * 16 + fr) * 1024 + col0;
#pragma unroll
                for (int bj = 0; bj < 2; ++bj) { xw[m][bj] = *(const GAS u32x4*)(xp + off + bj * HALF); pw[m][bj] = *(const GAS u32x4*)(pq + off + bj * HALF); } }
            asm volatile("" ::: "memory");
#pragma unroll
            for (int m = 0; m < 4; ++m) { const size_t off = (size_t)(u.pm * BM + ai * HALF + wr * 64 + m * 16 + fr) * 1024 + col0;
#pragma unroll
                for (int bj = 0; bj < 2; ++bj) { f32x4 x0, x1, p0, p1; unpack8f(xw[m][bj], x0, x1); unpack8f(pw[m][bj], p0, p1); const f32x4 a0 = acc[ai][bj][m][0], a1 = acc[ai][bj][m][1];
#pragma unroll
                    for (int e = 0; e < 4; ++e) { x0[e] += p0[e] * sigmoidf_(a0[e]); x1[e] += p1[e] * sigmoidf_(a1[e]); }
                    u32x4 w; w.x = cvt_pk_bf16(x0[0], x0[1]); w.y = cvt_pk_bf16(x0[2], x0[3]); w.z = cvt_pk_bf16(x1[0], x1[1]); w.w = cvt_pk_bf16(x1[2], x1[3]);
                    *(GAS u32x4*)(op + off + bj * HALF) = w; } }
            asm volatile("" ::: "memory");
        }
    }
};
struct EpiMid {
    static constexpr bool PERM = true;
    bf16_t* MID;
    __device__ __forceinline__ void operator()(const Acc& acc, const Unit& u, int wr, int wc, int fr, int fq) const {
        const int row0 = u.pm * BM + wr * 64 + fr;
        const int mode = (u.pn == 1) ? 2 : 0; const int colbase = u.pn * 256;
#pragma unroll
        for (int ai = 0; ai < 2; ++ai)
#pragma unroll
            for (int m = 0; m < 4; ++m) { bf16_t* rowp = MID + (size_t)(row0 + ai * HALF + m * 16) * 512 + colbase;
#pragma unroll
                for (int bj = 0; bj < 2; ++bj) { const int lc = bj * HALF + wc * 32 + 8 * fq; f32x4 v0 = acc[ai][bj][m][0], v1 = acc[ai][bj][m][1];
#pragma unroll
                    for (int e = 0; e < 4; ++e) {
                        if (mode == 2) { v0[e] = sigmoidf_(v0[e]); v1[e] = sigmoidf_(v1[e]); }
                        else if (lc < 64) { v0[e] = tanhf_(v0[e]); v1[e] = tanhf_(v1[e]); } }
                    u32x4 w; w.x = cvt_pk_bf16(v0[0], v0[1]); w.y = cvt_pk_bf16(v0[2], v0[3]); w.z = cvt_pk_bf16(v1[0], v1[1]); w.w = cvt_pk_bf16(v1[2], v1[3]);
                    *(u32x4*)(rowp + lc) = w; } }
    }
};
struct EpiRwkv2 {
    static constexpr bool PERM = true;
    bf16_t* O0; bf16_t* O1; const float* bias0; const float* bias1; int tybase;
    __device__ __forceinline__ void operator()(const Acc& acc, const Unit& u, int wr, int wc, int fr, int fq) const {
        const int ty = tybase + (u.pn >> 2); const int row0 = u.pm * BM + wr * 64 + fr; const int colt = (u.pn & 3) * BM + wc * 32 + 8 * fq;
        bf16_t* base = (u.pn >> 2) ? O1 : O0; const float* bias = (u.pn >> 2) ? bias1 : bias0;
#pragma unroll
        for (int bj = 0; bj < 2; ++bj) {
            f32x4 b0 = (f32x4){0.f, 0.f, 0.f, 0.f}, b1 = b0;
            if (ty < 2) { b0 = *(const f32x4*)(bias + colt + bj * HALF); b1 = *(const f32x4*)(bias + colt + bj * HALF + 4); }
#pragma unroll
            for (int ai = 0; ai < 2; ++ai)
#pragma unroll
                for (int m = 0; m < 4; ++m) { bf16_t* rowp = base + (size_t)(row0 + ai * HALF + m * 16) * 1024 + colt + bj * HALF;
                    f32x4 v0 = acc[ai][bj][m][0] + b0, v1 = acc[ai][bj][m][1] + b1;
                    if (ty < 2) { const float s = (ty == 0) ? 0.6065306597126334f : 1.0f;
#pragma unroll
                        for (int e = 0; e < 4; ++e) { v0[e] = s * sigmoidf_(v0[e]); v1[e] = s * sigmoidf_(v1[e]); } }
                    u32x4 w; w.x = cvt_pk_bf16(v0[0], v0[1]); w.y = cvt_pk_bf16(v0[2], v0[3]); w.z = cvt_pk_bf16(v1[0], v1[1]); w.w = cvt_pk_bf16(v1[2], v1[3]);
                    *(u32x4*)rowp = w; }
        }
    }
};

template <class Epi, class Sched, bool ALIGN_EPI, bool GATHER>
__device__ __forceinline__ void gemm_phase(PG8_LAS unsigned char* lds, const int K, const int lda, const Sched& S, const Epi& E, const int* __restrict__ rows, const int tid) {
    const int wid = __builtin_amdgcn_readfirstlane(tid >> 6), lane = tid & 63, wr = wid >> 2, wc = wid & 3, fr = lane & 15, fq = lane >> 4;
    const int nt = K / BK;
    unsigned voffA[2], voffB[2]; int RA[2];
#pragma unroll
    for (int i = 0; i < 2; ++i) { int R, C; stage_rc(tid * 16 + i * 8192, R, C); const int Rb = Epi::PERM ? ((R & ~31) + perm32(R & 31)) : R;
        RA[i] = R; voffA[i] = GATHER ? (unsigned)(C * 2) : (unsigned)(R * lda + C) * 2u; voffB[i] = (unsigned)(Rb * K + C) * 2u; }
    const size_t kstep = (size_t)(BK * 2);
    const size_t hstepA = GATHER ? 0 : (size_t)HALF * lda * 2, hstepB = (size_t)HALF * K * 2;
    const unsigned ldsw = (unsigned)wid * 1024u;
    const int aoff = lds_byte(wr * 64 + fr, fq * 8), boff = lds_byte(wc * 32 + fr, fq * 8);
#define PG8_SA(b, h) (((b) * 2 + (h)) * HTB)
#define PG8_SB(b, h) ((4 + (b) * 2 + (h)) * HTB)
#define PG8_ST2(bufoff, gbase, o0, o1) do { \
        __builtin_amdgcn_global_load_lds((const unsigned*)((const char*)(gbase) + (o0)), (PG8_LAS unsigned*)(lds + (bufoff) + ldsw), 16, 0, 0); \
        __builtin_amdgcn_global_load_lds((const unsigned*)((const char*)(gbase) + (o1)), (PG8_LAS unsigned*)(lds + (bufoff) + ldsw + 8192), 16, 0, 0); } while (0)
#define PG8_STB(bufoff, gbase) PG8_ST2(bufoff, gbase, voffB[0], voffB[1])
#define PG8_STA(bufoff, p, h, nx) do { if constexpr (GATHER) { const unsigned g0_ = (nx) ? gN[h][0] : gC[h][0], g1_ = (nx) ? gN[h][1] : gC[h][1]; PG8_ST2(bufoff, p, g0_, g1_); } \
        else { PG8_ST2(bufoff, (p) + (h) * hstepA, voffA[0], voffA[1]); } } while (0)
#define PG8_LDA(dst, b, h) do { _Pragma("unroll") for (int m = 0; m < 4; ++m) _Pragma("unroll") for (int k = 0; k < 2; ++k) dst[m][k] = *(const PG8_LAS bf16x8*)(lds + PG8_SA(b, h) + aoff + m * 2048 + k * 1024); } while (0)
#define PG8_LDB(dst, b, h) do { _Pragma("unroll") for (int n = 0; n < 2; ++n) _Pragma("unroll") for (int k = 0; k < 2; ++k) dst[n][k] = *(const PG8_LAS bf16x8*)(lds + PG8_SB(b, h) + boff + n * 2048 + k * 1024); } while (0)
#define PG8_MMA(ai, bj, At, Bt) do { __builtin_amdgcn_s_setprio(1); _Pragma("unroll") for (int m = 0; m < 4; ++m) _Pragma("unroll") for (int n = 0; n < 2; ++n) _Pragma("unroll") for (int k = 0; k < 2; ++k) \
        acc[ai][bj][m][n] = __builtin_amdgcn_mfma_f32_16x16x32_bf16(Bt[n][k], At[m][k], acc[ai][bj][m][n], 0, 0, 0); __builtin_amdgcn_s_setprio(0); } while (0)
#define PG8_WAIT_V(n) asm volatile("s_waitcnt vmcnt(" #n ")" ::: "memory")
#define PG8_WAIT_L(n) asm volatile("s_waitcnt lgkmcnt(" #n ")" ::: "memory")
#define PG8_BAR __builtin_amdgcn_s_barrier()
#define PG8_SCHED __builtin_amdgcn_sched_barrier(0)
#define PG8_GLOAD(dst, un) do { if constexpr (GATHER) { _Pragma("unroll") for (int h_ = 0; h_ < 2; ++h_) _Pragma("unroll") for (int i_ = 0; i_ < 2; ++i_) \
        dst[h_][i_] = (unsigned)rows[(un).pm * BM + h_ * HALF + RA[i_]] * (unsigned)(lda * 2) + voffA[i_]; } } while (0)
    Unit cur, nxt; int ui = 0;
    if (!S.next(0, cur)) return;
    unsigned gC[2][2] = {{0u, 0u}, {0u, 0u}}, gN[2][2] = {{0u, 0u}, {0u, 0u}};
    PG8_GLOAD(gC, cur);
    Acc acc;
#pragma unroll
    for (int a = 0; a < 2; ++a)
#pragma unroll
        for (int b = 0; b < 2; ++b)
#pragma unroll
            for (int m = 0; m < 4; ++m)
#pragma unroll
                for (int n = 0; n < 2; ++n) acc[a][b][m][n] = (f32x4){0.f, 0.f, 0.f, 0.f};
    bf16x8 At[4][2], B0[2][2], B1[2][2];
    const char* cA = cur.A; const char* cB = cur.B;
    PG8_STB(PG8_SB(0, 0), cB); PG8_STB(PG8_SB(0, 1), cB + hstepB); PG8_STA(PG8_SA(0, 0), cA, 0, false); PG8_STA(PG8_SA(0, 1), cA, 1, false);
    if (wr == 1) PG8_BAR;
    PG8_WAIT_V(2); PG8_BAR;
    PG8_STB(PG8_SB(1, 0), cB + kstep); PG8_STA(PG8_SA(1, 0), cA + kstep, 0, false); PG8_STB(PG8_SB(1, 1), cB + hstepB + kstep);
    PG8_WAIT_V(6); PG8_BAR;
    for (;;) {
        const bool has_next = S.next(ui + 1, nxt);
        if (has_next) { PG8_GLOAD(gN, nxt); }
        const char* nA = has_next ? nxt.A : cA; const char* nB = has_next ? nxt.B : cB;
#pragma unroll 1
        for (int t = 0; t < nt; t += 2) {
            const bool last = (t == nt - 2); const bool nx = last && has_next;
            const char* a1 = cA + (size_t)(t + 1) * kstep;
            const char* a2 = last ? nA : cA + (size_t)(t + 2) * kstep; const char* b2 = last ? nB : cB + (size_t)(t + 2) * kstep;
            const char* a3 = a2 + kstep; const char* b3 = b2 + kstep;
            PG8_LDB(B0, 0, 0); PG8_LDB(B1, 0, 1); PG8_SCHED; PG8_LDA(At, 0, 0); PG8_STA(PG8_SA(1, 1), a1, 1, false);
            PG8_WAIT_V(8); PG8_WAIT_L(0); PG8_BAR; PG8_MMA(0, 0, At, B0); PG8_MMA(0, 1, At, B1); PG8_BAR; PG8_SCHED;
            PG8_LDA(At, 0, 1); PG8_STB(PG8_SB(0, 0), b2); PG8_STB(PG8_SB(0, 1), b2 + hstepB); PG8_STA(PG8_SA(0, 0), a2, 0, nx);
            PG8_WAIT_V(8); PG8_WAIT_L(0); PG8_BAR; PG8_MMA(1, 0, At, B0); PG8_MMA(1, 1, At, B1); PG8_BAR; PG8_SCHED;
            PG8_LDB(B0, 1, 0); PG8_LDB(B1, 1, 1); PG8_SCHED; PG8_LDA(At, 1, 0); PG8_STA(PG8_SA(0, 1), a2, 1, nx);
            PG8_WAIT_V(8); PG8_WAIT_L(0); PG8_BAR; PG8_MMA(0, 0, At, B0); PG8_MMA(0, 1, At, B1); PG8_BAR; PG8_SCHED;
            PG8_LDA(At, 1, 1); PG8_STB(PG8_SB(1, 0), b3); PG8_STB(PG8_SB(1, 1), b3 + hstepB); PG8_STA(PG8_SA(1, 0), a3, 0, nx);
            PG8_WAIT_V(8); PG8_WAIT_L(0); PG8_BAR; PG8_MMA(1, 0, At, B0); PG8_MMA(1, 1, At, B1); PG8_BAR; PG8_SCHED;
        }
        if constexpr (ALIGN_EPI) { if (wr == 0) PG8_BAR; }
        E(acc, cur, wr, wc, fr, fq);
        if (!has_next) break;
#pragma unroll
        for (int a = 0; a < 2; ++a)
#pragma unroll
            for (int b = 0; b < 2; ++b)
#pragma unroll
                for (int m = 0; m < 4; ++m)
#pragma unroll
                    for (int n = 0; n < 2; ++n) acc[a][b][m][n] = (f32x4){0.f, 0.f, 0.f, 0.f};
        cur = nxt; cA = nA; cB = nB; ++ui;
        if constexpr (GATHER) {
#pragma unroll
            for (int h_ = 0; h_ < 2; ++h_)
#pragma unroll
                for (int i_ = 0; i_ < 2; ++i_) gC[h_][i_] = gN[h_][i_]; }
        if constexpr (ALIGN_EPI) { if (wr == 1) PG8_BAR; }
    }
    PG8_WAIT_V(0);
    if constexpr (!ALIGN_EPI) { if (wr == 0) PG8_BAR; }
    PG8_BAR;
#undef PG8_SA
#undef PG8_SB
#undef PG8_ST2
#undef PG8_STB
#undef PG8_STA
#undef PG8_LDA
#undef PG8_LDB
#undef PG8_MMA
#undef PG8_WAIT_V
#undef PG8_WAIT_L
#undef PG8_BAR
#undef PG8_SCHED
#undef PG8_GLOAD
}
}
namespace attn_body {
using bf16=__hip_bfloat16;
using bf16x8=__attribute__((ext_vector_type(8)))short;
using s16x4=__attribute__((ext_vector_type(4)))short;
using f32x16=__attribute__((ext_vector_type(16)))float;
using u32x4=__attribute__((ext_vector_type(4)))unsigned;
constexpr int BATCH=8,NHEAD=16,SEQ=8192,D=64,PQ=512,PO=1024;
constexpr int NW=8,QBLK=32,QB=QBLK*NW,KVBLK=64,NQB=SEQ/QB;
constexpr int ATTN_UNIT_ROWS=QB;
__device__ __forceinline__ int crow(int r,int hi){return (r&3)+8*(r>>2)+4*hi;}
#define SBAR() __builtin_amdgcn_sched_barrier(0)
__device__ __forceinline__ void cmask(f32x16&p0,f32x16&p1,int jb,int qrel,int hi){
  const float NEG=-INFINITY; int kb=64*jb+4*hi;
  #pragma unroll
  for(int r=0;r<16;++r){int kv=kb+(r&3)+8*(r>>2); if(kv>qrel)p0[r]=NEG; if(kv+32>qrel)p1[r]=NEG;}
}

__device__ __forceinline__ void cbias(f32x16&p0,f32x16&p1,int jb,int qrel,int hi,const __attribute__((address_space(3))) float*tb){
  const int kb=64*jb+4*hi;
  #pragma unroll
  for(int r=0;r<16;++r){const int rel=qrel-(kb+(r&3)+8*(r>>2)); const int i0=min(max(rel,0),127), i1=min(max(rel-32,0),127); p0[r]+=tb[i0]; p1[r]+=tb[i1];}
}
constexpr int NSLOT=3, SLOTB=8192;
constexpr int LDS_K=0, LDS_V=NSLOT*SLOTB, LDS_WS=2*NSLOT*SLOTB, LDS_OST=LDS_WS+NW*64*4, LDS_BYTES=LDS_OST+NW*4096;
constexpr float C2=0.125f*1.4426950408889634f;
__device__ __forceinline__ void glds16(const void*gsrc,unsigned lds_dst){unsigned keep;
  asm volatile("s_mov_b32 %0, m0\n\ts_mov_b32 m0, %2\n\ts_nop 0\n\tglobal_load_lds_dwordx4 %1, off\n\ts_mov_b32 m0, %0":"=&s"(keep):"v"(gsrc),"s"(lds_dst):"memory");}
__device__ __forceinline__ float max3f(float a,float b,float c){float r;asm("v_max3_f32 %0, %1, %2, %3":"=v"(r):"v"(a),"v"(b),"v"(c));return r;}
__device__ __forceinline__ float max2f(float a,float b){float r;asm("v_max_f32_e32 %0, %1, %2":"=v"(r):"v"(a),"v"(b));return r;}
__device__ __forceinline__ float fadd_s(float a,float b){float r;asm("v_add_f32_e32 %0, %1, %2":"=v"(r):"v"(a),"v"(b));return r;}
__device__ __forceinline__ float fsub_s(float a,float b){float r;asm("v_sub_f32_e32 %0, %1, %2":"=v"(r):"v"(a),"v"(b));return r;}
typedef float f32x2_t __attribute__((ext_vector_type(2))); typedef __bf16 bf16x2_t __attribute__((ext_vector_type(2)));
__device__ __forceinline__ unsigned cvtpk_s(float lo,float hi){f32x2_t v={lo,hi};bf16x2_t b=__builtin_convertvector(v,bf16x2_t);return __builtin_bit_cast(unsigned,b);}
#define WAIT_BAR(N) asm volatile("s_waitcnt vmcnt(" #N ") lgkmcnt(0)\n\ts_barrier":::"memory")

__device__ __forceinline__ void qkt(f32x16&p0,f32x16&p1,const char*Kslot,const bf16x8*qr,const f32x16&negm,int r32,int hi){
  const char*kb=Kslot+hi*1024+r32*16;
  #pragma unroll
  for(int d0=0;d0<4;++d0){
    const bf16x8 b0=*reinterpret_cast<const bf16x8*>(kb+d0*2048);
    const bf16x8 b1=*reinterpret_cast<const bf16x8*>(kb+d0*2048+512);
    if(d0==0){p0=__builtin_amdgcn_mfma_f32_32x32x16_bf16(b0,qr[0],negm,0,0,0);p1=__builtin_amdgcn_mfma_f32_32x32x16_bf16(b1,qr[0],negm,0,0,0);}
    else{p0=__builtin_amdgcn_mfma_f32_32x32x16_bf16(b0,qr[d0],p0,0,0,0);p1=__builtin_amdgcn_mfma_f32_32x32x16_bf16(b1,qr[d0],p1,0,0,0);}}
}
typedef __attribute__((address_space(3))) const char* lds_cptr;
typedef short v4i16_t __attribute__((ext_vector_type(4)));
__device__ __forceinline__ void kload8(bf16x8*kf,lds_cptr kp){
  kf[0]=*(const __attribute__((address_space(3))) bf16x8*)(kp);      kf[1]=*(const __attribute__((address_space(3))) bf16x8*)(kp+512);
  kf[2]=*(const __attribute__((address_space(3))) bf16x8*)(kp+2048); kf[3]=*(const __attribute__((address_space(3))) bf16x8*)(kp+2560);
  kf[4]=*(const __attribute__((address_space(3))) bf16x8*)(kp+4096); kf[5]=*(const __attribute__((address_space(3))) bf16x8*)(kp+4608);
  kf[6]=*(const __attribute__((address_space(3))) bf16x8*)(kp+6144); kf[7]=*(const __attribute__((address_space(3))) bf16x8*)(kp+6656);
}
__device__ __forceinline__ void kload2(bf16x8*kf,lds_cptr kp,int j){ kf[2*j]=*(const __attribute__((address_space(3))) bf16x8*)(kp+j*2048); kf[2*j+1]=*(const __attribute__((address_space(3))) bf16x8*)(kp+j*2048+512); }
__device__ __forceinline__ s16x4 vtr(lds_cptr p){ return __builtin_bit_cast(s16x4,__builtin_amdgcn_ds_read_tr16_b64_v4i16((__attribute__((address_space(3))) v4i16_t*)p)); }
__device__ __forceinline__ float rowmax(const f32x16&p0,const f32x16&p1){
  float a=max3f(p0[0],p0[1],p1[0]),b=max3f(p0[2],p0[3],p1[1]);a=max3f(a,p1[2],p1[3]);
  #pragma unroll
  for(int r=4;r<16;r+=4){a=max3f(a,p0[r],p0[r+1]);b=max3f(b,p0[r+2],p0[r+3]);a=max3f(a,p1[r],p1[r+1]);b=max3f(b,p1[r+2],p1[r+3]);}
  const float m=max2f(a,b);
  auto rr=__builtin_amdgcn_permlane32_swap(__float_as_uint(m),__float_as_uint(m),false,false);
  return max2f(__uint_as_float(rr[0]),__uint_as_float(rr[1]));
}
__device__ __forceinline__ void pv(f32x16*o,int vb,bf16x8 pa0,bf16x8 pa1,bf16x8 pa2,bf16x8 pa3){
  #pragma unroll
  for(int d0=0;d0<2;++d0){s16x4 lo[4],hi[4];
    #pragma unroll
    for(int ks=0;ks<4;++ks){
      asm volatile("ds_read_b64_tr_b16 %0,%1 offset:%c2":"=&v"(lo[ks]):"v"(vb),"i"(d0*4096+ks*1024):"memory");
      asm volatile("ds_read_b64_tr_b16 %0,%1 offset:%c2":"=&v"(hi[ks]):"v"(vb),"i"(d0*4096+ks*1024+512):"memory");}
    asm volatile("s_waitcnt lgkmcnt(0)":::"memory");SBAR();
    #define PK(k) (bf16x8){lo[k][0],lo[k][1],lo[k][2],lo[k][3],hi[k][0],hi[k][1],hi[k][2],hi[k][3]}
    o[d0]=__builtin_amdgcn_mfma_f32_32x32x16_bf16(pa0,PK(0),o[d0],0,0,0);
    o[d0]=__builtin_amdgcn_mfma_f32_32x32x16_bf16(pa1,PK(1),o[d0],0,0,0);
    o[d0]=__builtin_amdgcn_mfma_f32_32x32x16_bf16(pa2,PK(2),o[d0],0,0,0);
    o[d0]=__builtin_amdgcn_mfma_f32_32x32x16_bf16(pa3,PK(3),o[d0],0,0,0);
    #undef PK
  }
}

#ifndef ATTN_STORE16
#define ATTN_STORE16(p,v) (*(u32x4*)(p)=(v))
#endif
template<int THRL> __device__ __forceinline__ void attn_unit(int b,int vh,int qb,const bf16*Q,const bf16*__restrict__ K,const bf16*__restrict__ V,bf16*O,char*shm,const __attribute__((address_space(3))) float*tball,const int tid){
  const int lane=tid&63,r32=lane&31,hi=lane>>5; const int wid=__builtin_amdgcn_readfirstlane(tid>>6);
  const long rowbase=(long)b*SEQ; const int q0=qb*QB;
  const int hh=vh>>2, qcol=hh*128+((vh>>1)&1)*64, vcol=hh*128+(vh&1)*64;
  const __attribute__((address_space(3))) float*tb=tball+hh*128;
  const bf16*Qw=Q+(rowbase+q0+wid*QBLK)*PQ+qcol;
  const bf16*Kh=K+rowbase*PQ+qcol,*Vh=V+rowbase*PQ+vcol;
  const unsigned lds0=(unsigned)(uintptr_t)shm;
  float*wsf=(float*)(shm+LDS_WS)+wid*64;
  const bf16*ksrc=Kh+(long)lane*PQ+wid*8;
  const bf16*vsrc=Vh+(long)(16*(wid&3)+(lane>>2))*PQ+(wid>>2)*32+(lane&3)*8;
  const unsigned kdst=lds0+LDS_K+wid*1024, vdst=lds0+LDS_V+wid*1024;
  #define DMA_K(t,slot) glds16(ksrc+(long)(t)*KVBLK*PQ,(unsigned)__builtin_amdgcn_readfirstlane(kdst+(slot)))
  #define DMA_V(t,slot) glds16(vsrc+(long)(t)*KVBLK*PQ,(unsigned)__builtin_amdgcn_readfirstlane(vdst+(slot)))
  const int vb0=(int)(lds0+LDS_V)+((lane>>4)&1)*32+(lane&3)*8+(4*hi+((lane&15)>>2))*64;
  const char*Kbase=shm+LDS_K; bf16x8 kf[8];
  const lds_cptr shm3=(lds_cptr)shm; const lds_cptr kp0=shm3+LDS_K+hi*1024+r32*16; const lds_cptr vp0=shm3+LDS_V+((lane>>4)&1)*32+(lane&3)*8+(4*hi+((lane&15)>>2))*64;
  const int NT=(q0+QB)/KVBLK;
  DMA_K(0,0);DMA_V(0,0);DMA_K(1,SLOTB);
  bf16x8 qr[4];
  #pragma unroll
  for(int d0=0;d0<4;++d0)qr[d0]=*reinterpret_cast<const bf16x8*>(&Qw[(long)r32*PQ+d0*16+hi*8]);
  float mhat=0.f,l_reg=0.f;f32x16 o[2];o[0]=f32x16{};o[1]=f32x16{};f32x16 negm=f32x16{};asm volatile("":"+v"(negm));
  const int qrel=wid*QBLK+r32;
  #define CMASK(P0,P1,t) do{int jb_=(t)-(NT-4); if(jb_>=-2){cbias(P0,P1,jb_,qrel,hi,tb); if(jb_>=0)cmask(P0,P1,jb_,qrel,hi);}}while(0)
  bool resc=false;
  #define START(P0,P1) do{ const float rm=rowmax(P0,P1); resc=false; \
    { const float dl=rm; mhat=fadd_s(mhat,dl); \
      _Pragma("unroll") for(int r=0;r<16;++r){P0[r]=fsub_s(P0[r],dl);P1[r]=fsub_s(P1[r],dl);} \
      _Pragma("unroll") for(int r=0;r<16;++r)negm[r]=-mhat; asm volatile("":"+v"(negm)); } \
    _Pragma("unroll") for(int r=0;r<16;++r)P0[r]=__builtin_amdgcn_exp2f(P0[r]); }while(0)
  #define RESC() do{ if(resc){ asm volatile("s_waitcnt lgkmcnt(0)":::"memory"); \
      _Pragma("unroll") for(int d_=0;d_<2;++d_) _Pragma("unroll") for(int r=0;r<16;++r)o[d_][r]*=wsf[crow(r,hi)]; } }while(0)
  f32x16 pA0,pA1,pB0,pB1;
  int sl_prev=0,sl_cur=0,sl_next=SLOTB;
  #define ROT() do{sl_prev=sl_cur;sl_cur=sl_next;sl_next=(sl_next==(NSLOT-1)*SLOTB)?0:sl_next+SLOTB;}while(0)
  DMA_K(2,2*SLOTB);
  WAIT_BAR(3);
  qkt(pA0,pA1,Kbase,qr,negm,r32,hi);asm volatile("s_nop 15\n\ts_nop 7":"+v"(pA0),"+v"(pA1));CMASK(pA0,pA1,0);
  START(pA0,pA1);
  _Pragma("unroll") for(int r=0;r<16;++r)pA1[r]=__builtin_amdgcn_exp2f(pA1[r]);
  WAIT_BAR(0);
  DMA_K(3,0);DMA_V(1,SLOTB);
  ROT();
  kload8(kf,kp0+sl_cur);
  WAIT_BAR(2);
  s16x4 vlo[8],vhi[8]; u32x4 pw0,pw1,pw2,pw3;
  #define PKW(P,B) cvtpk_s(P[B],P[B+1])
  #define PAF(k) __builtin_bit_cast(bf16x8,pw##k)
  #define VFR(i) (bf16x8){vlo[i][0],vlo[i][1],vlo[i][2],vlo[i][3],vhi[i][0],vhi[i][1],vhi[i][2],vhi[i][3]}
  #define PIN(x) asm volatile("":"+v"(x))
  #define MX3(a,b,c) __builtin_fmaxf(__builtin_fmaxf((a),(b)),(c))
  #define GAPA(MF,A0,A1,A2,A3,W0,W1,PW) do{ MF; sacc+=A0; sacc+=A1; sacc+=A2; sacc+=A3; PIN(sacc); W0; W1; PIN(PW); SBAR(); }while(0)
  #define EX(v) __builtin_amdgcn_exp2f(v)
  #define GAPB(MF,X,B) do{ MF; X[B]=EX(X[B]); X[B+1]=EX(X[B+1]); X[B+2]=EX(X[B+2]); X[B+3]=EX(X[B+3]); PIN(X); SBAR(); }while(0)
  #define VRD(i) do{ vlo[i]=vtr(vp_+(((i)>>2)*4096+((i)&3)*1024)); vhi[i]=vtr(vp_+(((i)>>2)*4096+((i)&3)*1024+512)); }while(0)
  #define KRD(G,j) do{ if(G){ kload2(kf,kp0+sl_next,j); SBAR(); } }while(0)
  #define STEP(C0,C1,P0,P1,t,GK,GV,GL) do{ SBAR(); \
    const lds_cptr vp_=vp0+sl_prev; \
    VRD(0); SBAR(); float sacc=(P0[0]+P0[1]); \
    GAPA(C0=__builtin_amdgcn_mfma_f32_32x32x16_bf16(kf[0],qr[0],negm,0,0,0), P0[2],P0[3],P0[4],P0[5],     pw0[0]=PKW(P0,0), pw0[1]=PKW(P0,2), pw0); \
    VRD(4); SBAR(); GAPA(C1=__builtin_amdgcn_mfma_f32_32x32x16_bf16(kf[1],qr[0],negm,0,0,0), P0[6],P0[7],P0[8],P0[9],     pw0[2]=PKW(P0,4), pw0[3]=PKW(P0,6), pw0); \
    VRD(1); SBAR(); GAPA(C0=__builtin_amdgcn_mfma_f32_32x32x16_bf16(kf[2],qr[1],C0,0,0,0),   P0[10],P0[11],P0[12],P0[13], pw1[0]=PKW(P0,8), pw1[1]=PKW(P0,10), pw1); \
    VRD(5); SBAR(); GAPA(C1=__builtin_amdgcn_mfma_f32_32x32x16_bf16(kf[3],qr[1],C1,0,0,0),   P0[14],P0[15],P1[0],P1[1],   pw1[2]=PKW(P0,12),pw1[3]=PKW(P0,14), pw1); \
    VRD(2); SBAR(); GAPA(C0=__builtin_amdgcn_mfma_f32_32x32x16_bf16(kf[4],qr[2],C0,0,0,0),   P1[2],P1[3],P1[4],P1[5],     pw2[0]=PKW(P1,0), pw2[1]=PKW(P1,2), pw2); \
    VRD(6); SBAR(); GAPA(C1=__builtin_amdgcn_mfma_f32_32x32x16_bf16(kf[5],qr[2],C1,0,0,0),   P1[6],P1[7],P1[8],P1[9],     pw2[2]=PKW(P1,4), pw2[3]=PKW(P1,6), pw2); \
    VRD(3); SBAR(); GAPA(C0=__builtin_amdgcn_mfma_f32_32x32x16_bf16(kf[6],qr[3],C0,0,0,0),   P1[10],P1[11],P1[12],P1[13], pw3[0]=PKW(P1,8), pw3[1]=PKW(P1,10), pw3); \
    VRD(7); SBAR(); GAPA(C1=__builtin_amdgcn_mfma_f32_32x32x16_bf16(kf[7],qr[3],C1,0,0,0),   P1[14],P1[15],0.f,0.f,       pw3[2]=PKW(P1,12),pw3[3]=PKW(P1,14), pw3); \
    l_reg+=sacc; \
    if(GK){DMA_K((t)+3,sl_cur);} if(GV){DMA_V((t)+1,sl_next);} \
    CMASK(C0,C1,t); \
    { float a=MX3(C0[0],C0[1],C1[0]),b=MX3(C0[2],C0[3],C1[1]); a=MX3(a,C1[2],C1[3]); \
      _Pragma("unroll") for(int r=4;r<16;r+=4){a=MX3(a,C0[r],C0[r+1]);b=MX3(b,C0[r+2],C0[r+3]);a=MX3(a,C1[r],C1[r+1]);b=MX3(b,C1[r+2],C1[r+3]);} \
      float rm=__builtin_fmaxf(a,b); { auto rr=__builtin_amdgcn_permlane32_swap(__float_as_uint(rm),__float_as_uint(rm),false,false); rm=__builtin_fmaxf(__uint_as_float(rr[0]),__uint_as_float(rr[1])); } \
      resc=false; \
      if(__builtin_expect(__any(rm>(float)THRL),0)){ const float dl=__builtin_fmaxf(rm,0.f); mhat+=dl; \
        _Pragma("unroll") for(int r=0;r<16;++r){C0[r]-=dl;C1[r]-=dl;} \
        _Pragma("unroll") for(int r=0;r<16;++r)negm[r]=-mhat; asm volatile("":"+v"(negm)); \
        const float f=__builtin_amdgcn_exp2f(-dl); l_reg*=f; if(hi==0)wsf[r32]=f; resc=true; } } \
    SBAR(); \
    GAPB(o[0]=__builtin_amdgcn_mfma_f32_32x32x16_bf16(PAF(0),VFR(0),o[0],0,0,0), C0,0); \
    GAPB(o[1]=__builtin_amdgcn_mfma_f32_32x32x16_bf16(PAF(0),VFR(4),o[1],0,0,0), C0,4); \
    KRD(GL,0); GAPB(o[0]=__builtin_amdgcn_mfma_f32_32x32x16_bf16(PAF(1),VFR(1),o[0],0,0,0), C0,8); \
    KRD(GL,1); GAPB(o[1]=__builtin_amdgcn_mfma_f32_32x32x16_bf16(PAF(1),VFR(5),o[1],0,0,0), C0,12); \
    KRD(GL,2); GAPB(o[0]=__builtin_amdgcn_mfma_f32_32x32x16_bf16(PAF(2),VFR(2),o[0],0,0,0), C1,0); \
    KRD(GL,3); GAPB(o[1]=__builtin_amdgcn_mfma_f32_32x32x16_bf16(PAF(2),VFR(6),o[1],0,0,0), C1,4); \
    GAPB(o[0]=__builtin_amdgcn_mfma_f32_32x32x16_bf16(PAF(3),VFR(3),o[0],0,0,0), C1,8); \
    GAPB(o[1]=__builtin_amdgcn_mfma_f32_32x32x16_bf16(PAF(3),VFR(7),o[1],0,0,0), C1,12); \
    }while(0)
  int t=1;
  #undef CMASK
  #define CMASK(P0,P1,t) do{}while(0)
  for(;t+7<NT;t+=2){
    STEP(pB0,pB1,pA0,pA1,t,true,true,true);     WAIT_BAR(2); RESC(); ROT();
    STEP(pA0,pA1,pB0,pB1,t+1,true,true,true);   WAIT_BAR(2); RESC(); ROT();
  }
  #undef CMASK
  #define CMASK(P0,P1,t) do{int jb_=(t)-(NT-4); if(jb_>=-2){cbias(P0,P1,jb_,qrel,hi,tb); if(jb_>=0)cmask(P0,P1,jb_,qrel,hi);}}while(0)
  #define ENDW(tt) do{ if((tt)+3<NT){WAIT_BAR(2);} else if((tt)+2<NT){WAIT_BAR(1);} else {WAIT_BAR(0);} }while(0)
  for(;t+1<NT;t+=2){
    STEP(pB0,pB1,pA0,pA1,t,(t+3<NT),(t+1<NT),(t+1<NT));       ENDW(t);   RESC(); ROT();
    STEP(pA0,pA1,pB0,pB1,t+1,(t+4<NT),(t+2<NT),(t+2<NT));     ENDW(t+1); RESC(); ROT();
  }
  STEP(pB0,pB1,pA0,pA1,NT-1,false,false,false); RESC();
  { float sacc=pB0[0]+pB0[1]; _Pragma("unroll") for(int r=2;r<16;++r)sacc+=pB0[r]; _Pragma("unroll") for(int r=0;r<16;++r)sacc+=pB1[r]; l_reg+=sacc;
    pw0=(u32x4){PKW(pB0,0),PKW(pB0,2),PKW(pB0,4),PKW(pB0,6)};pw1=(u32x4){PKW(pB0,8),PKW(pB0,10),PKW(pB0,12),PKW(pB0,14)};pw2=(u32x4){PKW(pB1,0),PKW(pB1,2),PKW(pB1,4),PKW(pB1,6)};pw3=(u32x4){PKW(pB1,8),PKW(pB1,10),PKW(pB1,12),PKW(pB1,14)};
    SBAR(); pv(o,vb0+sl_cur,PAF(0),PAF(1),PAF(2),PAF(3)); }
  #undef PKW
  #undef PAF
  #undef VFR
  #undef PIN
  #undef MX3
  #undef GAPA
  #undef GAPB
  #undef EX
  #undef VRD
  #undef KRD
  #undef STEP
  #undef ENDW
  {auto rr=__builtin_amdgcn_permlane32_swap(__float_as_uint(l_reg),__float_as_uint(l_reg),false,false);l_reg=__uint_as_float(rr[0])+__uint_as_float(rr[1]);}
  if(hi==0)wsf[32+r32]=l_reg;asm volatile("s_waitcnt lgkmcnt(0)":::"memory");
  float rli[16];
  #pragma unroll
  for(int r=0;r<16;++r)rli[r]=__builtin_amdgcn_rcpf(wsf[32+crow(r,hi)]);
  bf16*Ow=O+(rowbase+q0+wid*QBLK)*PO+vh*D;
  { bf16*stg=(bf16*)(shm+LDS_OST)+wid*2048;
    #pragma unroll
    for(int r=0;r<16;++r){const int orow=crow(r,hi);
      #pragma unroll
      for(int d0=0;d0<2;++d0)stg[orow*64+d0*32+r32]=__float2bfloat16(o[d0][r]*rli[r]);}
    asm volatile("s_waitcnt lgkmcnt(0)":::"memory");
    #pragma unroll
    for(int i=0;i<4;++i){const int row=i*8+(lane>>3),ch=lane&7; const u32x4 v=*(const u32x4*)(stg+row*64+ch*8); ATTN_STORE16(Ow+(long)row*PO+ch*8,v);} }
  asm volatile("s_waitcnt lgkmcnt(0)\n\ts_barrier":::"memory");
  #undef DMA_K
  #undef DMA_V
  #undef CMASK
  #undef START
  #undef RESC
  #undef ROT
}
constexpr int ATTN_LDS_BYTES=LDS_BYTES;
struct AttnTensors { const bf16* Q; const bf16* K; const bf16* V; bf16* O; };
struct AttnUnit { int bh; int qb; };
__device__ __forceinline__ bool attn_next(int vcu,int i,AttnUnit&u){ if(i>=16)return false; const int s=vcu&7, j=i&3; u.bh=(vcu>>3)+32*(i>>2); u.qb=(j==0)?s:(j==1)?15-s:(j==2)?16+s:31-s; return true; }
template<int THRL=8> __device__ __forceinline__ void attn_phase(char*lds,const AttnTensors&T,int vcu,const __attribute__((address_space(3))) float*tball,const int tid){
  AttnUnit u;
  for(int i=0;attn_next(vcu,i,u);++i){ attn_unit<THRL>(u.bh/NHEAD,u.bh%NHEAD,u.qb,T.Q,T.K,T.V,T.O,lds,tball,tid); }
}
#undef SBAR
#undef WAIT_BAR
}

#define XB_TMO      128
#define XB_XCNT(j)  (256  + 64 * (j))
#define XB_XSUB(j)  (1280 + 64 * (j))
#define XB_XGEN(j)  (2304 + 64 * (j))
#define XB_TOP      3328
#define XB_TOPGEN   3392
#define XCD_BAR_WORDS 3456
#define XB_SPIN_CAP (1u << 18)

__device__ __forceinline__ unsigned xb_ld(unsigned* p)              { return __hip_atomic_load(p, __ATOMIC_RELAXED, __HIP_MEMORY_SCOPE_AGENT); }
__device__ __forceinline__ unsigned xb_add(unsigned* p, unsigned v) { return __hip_atomic_fetch_add(p, v, __ATOMIC_RELAXED, __HIP_MEMORY_SCOPE_AGENT); }
__device__ __forceinline__ unsigned xb_xcc_id() { return (unsigned)__builtin_amdgcn_s_getreg((3 << 11) | 20) & 0xFu; }
#define XB_SPIN(cond, bar) do { unsigned _sp = 0; while (cond) { __builtin_amdgcn_s_sleep(1); \
    if ((++_sp & 255u) == 0u) { if (xb_ld(&(bar)[XB_TMO])) break; if (_sp > XB_SPIN_CAP) { atomicAdd(&(bar)[XB_TMO], 1u); break; } } } } while (0)

struct XcdBarrier {
    unsigned* bar; unsigned x;
    volatile LAS unsigned* st;
};

__device__ __forceinline__ XcdBarrier xcd_barrier_post(unsigned* bar, volatile LAS unsigned* st, const bool leader  ) {
    XcdBarrier b; b.bar = bar; b.x = xb_xcc_id(); b.st = st;
    if (leader) (void)xb_add(&bar[XB_XCNT(b.x)], 1u);
    return b;
}
__device__ __forceinline__ void xcd_barrier_complete(unsigned* bar, unsigned x, unsigned& nloc, unsigned& nx) {
    const unsigned G = gridDim.x * gridDim.y * gridDim.z;
    unsigned sum, cnt, mine, sp = 0u;
    for (;;) {
        sum = 0u; cnt = 0u; mine = 0u;
#pragma unroll
        for (unsigned j = 0; j < 16; ++j) { const unsigned c = xb_ld(&bar[XB_XCNT(j)]); sum += c; cnt += (c > 0u) ? 1u : 0u; mine = (j == x) ? c : mine; }
        if (sum == G) break;
        __builtin_amdgcn_s_sleep(1);
        if ((++sp & 255u) == 0u) { if (xb_ld(&bar[XB_TMO])) break; if (sp > XB_SPIN_CAP) { atomicAdd(&bar[XB_TMO], 1u); break; } }
    }
    nloc = mine > 0u ? mine : 1u; nx = cnt > 0u ? cnt : 1u;
}

__device__ __forceinline__ void xcd_barrier(const XcdBarrier& b, const bool leader  ) {
    asm volatile("s_waitcnt vmcnt(0)" ::: "memory");
    __syncthreads();
    if (leader) {
        unsigned* bar = b.bar;
        __builtin_amdgcn_s_waitcnt(0);
        unsigned nloc = b.st[0], nx = b.st[1];
        if (nloc == 0u) { xcd_barrier_complete(bar, b.x, nloc, nx); b.st[0] = nloc; b.st[1] = nx; }
        const unsigned old = xb_add(&bar[XB_XSUB(b.x)], 1u);
        const unsigned gen = old / nloc;
        if (old + 1u == (gen + 1u) * nloc) {
            __builtin_amdgcn_fence(__ATOMIC_RELEASE, "agent");
            asm volatile("s_waitcnt vmcnt(0)" ::: "memory");
            const unsigned og = xb_add(&bar[XB_TOP], 1u);
            const unsigned tg = og / nx;
            if (og + 1u == (tg + 1u) * nx) xb_add(&bar[XB_TOPGEN], 1u);
            else XB_SPIN(xb_ld(&bar[XB_TOPGEN]) == tg, bar);
            __builtin_amdgcn_fence(__ATOMIC_ACQUIRE, "agent");
            xb_add(&bar[XB_XGEN(b.x)], 1u);
            asm volatile("s_waitcnt vmcnt(0)" ::: "memory");
        } else {
            XB_SPIN(xb_ld(&bar[XB_XGEN(b.x)]) == gen, bar);
            __builtin_amdgcn_fence(__ATOMIC_ACQUIRE, "agent");
            asm volatile("s_waitcnt vmcnt(0)" ::: "memory");
        }
    }
    __syncthreads();
}

constexpr size_t MiB = 1u << 20;
constexpr size_t WS_CTL = 0, CTL_ZERO_BYTES = 1 * MiB;
constexpr size_t WS_WIN = 2 * MiB;
constexpr size_t WS_WOUT = 7 * MiB;
constexpr size_t WS_PGATE = 9 * MiB;
constexpr size_t WS_PPROJ = 13 * MiB;
constexpr size_t WS_RCAT = 14 * MiB;
constexpr size_t WS_RL1 = 20 * MiB;
constexpr size_t WS_RS2 = 28 * MiB;
constexpr size_t WS_RWO = 30 * MiB;
constexpr size_t WS_ROUT = 32 * MiB;
constexpr size_t WS_LRUAGG = 33 * MiB;
constexpr size_t WS_MGU = 38 * MiB;
constexpr size_t WS_MDN = 102 * MiB;
constexpr size_t WS_PB = 134 * MiB;
constexpr size_t WS_ACT = 166 * MiB;
constexpr size_t WS_H0 = WS_ACT;
constexpr size_t WS_QKV = WS_ACT + 128 * MiB;
constexpr size_t WS_O = WS_ACT + 448 * MiB;
constexpr size_t WS_HL = WS_ACT + 576 * MiB, WS_CA = WS_ACT + 640 * MiB;
constexpr size_t WS_H2 = WS_ACT;
constexpr size_t WS_LOG = WS_ACT + 128 * MiB;
constexpr size_t WS_ROUTE = WS_ACT + 144 * MiB;
constexpr size_t WS_HID = WS_ACT + 152 * MiB;
constexpr size_t WS_YS = WS_ACT + 288 * MiB;
constexpr size_t WS_PP = WS_ACT + 128 * MiB;
constexpr size_t WS_HCAT = WS_ACT;
constexpr size_t WS_XR = WS_ACT + 256 * MiB, WS_XK = WS_ACT + 384 * MiB, WS_XV = WS_ACT + 512 * MiB;
constexpr size_t WS_R = WS_ACT + 640 * MiB, WS_K = WS_XR, WS_V = WS_XK;
constexpr size_t WS_MID = WS_ACT + 768 * MiB;
constexpr size_t WS_EW = WS_ACT;
constexpr size_t WS_AA = WS_ACT + 128 * MiB;
constexpr size_t WS_Y = WS_XV;
constexpr size_t WS_END = WS_ACT + 832 * MiB;
static_assert(WS_END <= 1024 * MiB, "workspace map");
constexpr size_t RT_EID = 0, RT_POS = 1 * MiB, RT_GATE = 2 * MiB, RT_ROWTOK = 3 * MiB, RT_ROWGATE = 4 * MiB, RT_SLOT = 5 * MiB;
constexpr int CW_BAR = 4096;
constexpr int CW_PROG = 32768, CW_GDONE = 36864;
constexpr int CW_CNT0 = 16384, CW_CNT1 = 16384 + 64;

constexpr int RING_BYTES = 131072;
constexpr int LDSCTL_OFF = RING_BYTES, MISC_OFF = LDSCTL_OFF + 320;
constexpr int TB_OFF = RING_BYTES + 1024;
constexpr int RTE_OFF = TB_OFF + 2048;
constexpr int LDS_BYTES = 147456;

constexpr int NWAVES = 8;
__device__ __forceinline__ int lane_id_() { int l; asm volatile("v_mbcnt_lo_u32_b32 %0, -1, 0\n\tv_mbcnt_hi_u32_b32 %0, -1, %0" : "=v"(l)); return l; }
#define TID_ (F.wave * 64 + lane_id_())
#define LANE_ (lane_id_())
struct Frame {
    LAS unsigned char* lds; volatile LAS unsigned* MISC; gu32* ctl;
    int wave, vcu, G;
};

__device__ __forceinline__ void load_row4(const float* xrow, int lane, f32x4 (&v)[4]) { const f32x4* p = (const f32x4*)xrow + lane;
#pragma unroll
    for (int j = 0; j < 4; ++j) v[j] = p[64 * j]; }
__device__ __forceinline__ float row_rstd(const f32x4 (&v)[4], float eps) { float s = 0.f;
#pragma unroll
    for (int j = 0; j < 4; ++j) s += (v[j].x * v[j].x + v[j].y * v[j].y) + (v[j].z * v[j].z + v[j].w * v[j].w);
    return 1.0f / sqrtf(wave_sum(s) * (1.0f / 1024.0f) + eps); }
__device__ __forceinline__ void load_row4_bf(const bf16* xrow, int lane, f32x4 (&v)[4]) { const v2u* p = (const v2u*)xrow + lane;
#pragma unroll
    for (int j = 0; j < 4; ++j) { const v2u w = p[64 * j]; v[j] = (f32x4){bflo(w.x), bfhi(w.x), bflo(w.y), bfhi(w.y)}; } }
__device__ __forceinline__ void store_row4_bf(bf16* xrow, int lane, const f32x4 (&v)[4]) { v2u* p = (v2u*)xrow + lane;
#pragma unroll
    for (int j = 0; j < 4; ++j) { v2u o; o.x = pk2(v[j].x, v[j].y); o.y = pk2(v[j].z, v[j].w); p[64 * j] = o; } }
__device__ __forceinline__ void store_row_bf16(bf16* orow, int lane, const f32x4 (&v)[4], float rstd, const float* g) {
    unsigned long long* o8 = (unsigned long long*)orow + lane;
#pragma unroll
    for (int j = 0; j < 4; ++j) { const f32x4 gg = ((const f32x4*)g)[lane + 64 * j];
        o8[64 * j] = (unsigned long long)pk2(v[j].x * rstd * gg.x, v[j].y * rstd * gg.y) | ((unsigned long long)pk2(v[j].z * rstd * gg.z, v[j].w * rstd * gg.w) << 32); }
}

template <int MODE>
__device__ __forceinline__ void transpose_item(const float* W, int K, int N, bf16* WT, int ldo, int row_off, const float* mu, LAS float* scr, int item, int lane) {
    const int nblk = N / 32, kb = item / nblk, nb = item % nblk, k0 = 64 * kb, n0 = 32 * nb;
    float ld[32];
#pragma unroll
    for (int i = 0; i < 32; ++i) { const int kk = 2 * i + (lane >> 5); ld[i] = W[(size_t)(k0 + kk) * N + n0 + (lane & 31)]; }
#pragma unroll
    for (int i = 0; i < 32; ++i) { const int kk = 2 * i + (lane >> 5); scr[kk * 33 + (lane & 31)] = ld[i]; }
    LDS_WAIT(); asm volatile("" ::: "memory");
    const int c = lane & 7;
    int rbase = row_off + n0;
    if (MODE == 2) { rbase = row_off + ((n0 < 512) ? ((n0 >> 7) * 256 + (n0 & 127)) : (((n0 - 512) >> 7) * 256 + 128 + ((n0 - 512) & 127))); }
    float m[8];
    if (MODE == 1) {
#pragma unroll
        for (int e = 0; e < 8; ++e) m[e] = mu[k0 + 8 * c + e]; }
#pragma unroll
    for (int j = 0; j < 4; ++j) { const int n = (lane >> 3) + 8 * j; const LAS float* s = scr + (8 * c) * 33 + n;
        float v[8];
#pragma unroll
        for (int e = 0; e < 8; ++e) v[e] = s[e * 33];
        bf16* dst = WT + (size_t)(rbase + n) * ldo + k0 + 8 * c;
        if (MODE == 1) {
            v4u o, o2;
            o.x = pk2(v[0] * (1.f - m[0]), v[1] * (1.f - m[1])); o.y = pk2(v[2] * (1.f - m[2]), v[3] * (1.f - m[3])); o.z = pk2(v[4] * (1.f - m[4]), v[5] * (1.f - m[5])); o.w = pk2(v[6] * (1.f - m[6]), v[7] * (1.f - m[7]));
            o2.x = pk2(v[0] * m[0], v[1] * m[1]); o2.y = pk2(v[2] * m[2], v[3] * m[3]); o2.z = pk2(v[4] * m[4], v[5] * m[5]); o2.w = pk2(v[6] * m[6], v[7] * m[7]);
            *(GAS v4u*)dst = o; *(GAS v4u*)(dst + 1024) = o2;
        } else {
            v4u o; o.x = pk2(v[0], v[1]); o.y = pk2(v[2], v[3]); o.z = pk2(v[4], v[5]); o.w = pk2(v[6], v[7]);
            *(GAS v4u*)dst = o; }
    }
    LDS_WAIT(); asm volatile("" ::: "memory");
}

struct In {
    const float *x, *p, *rel_bias, *norm_mix, *ab_w_in, *ab_w_out, *lam_q1, *lam_k1, *lam_q2, *lam_k2, *sub_g, *conv_w, *conv_b, *lru_wa, *lru_ba, *lru_wx, *lru_bx, *lru_lambda,
        *rwkv_mu, *rwkv_wr, *rwkv_wk, *rwkv_wv, *rwkv_wo, *rwkv_w0, *rwkv_w1, *rwkv_w2, *rwkv_a0, *rwkv_a1, *rwkv_a2, *rwkv_g1, *rwkv_g2, *rwkv_kk, *rwkv_ka, *rwkv_rk, *rwkv_ln_g, *rwkv_ln_b,
        *norm_ffn, *moe_wc, *moe_bc, *moe_wf, *moe_bf, *moe_w_gu, *moe_w_down, *ple_norm, *ple_gate, *ple_proj, *final_norm;
};

__device__ __forceinline__ void prep_dense_weights(Frame& F, const In& I, unsigned char* ws) {
    LAS float* scr = (LAS float*)(F.lds + F.wave * 16384);
    const int gw = F.vcu * NWAVES + F.wave, NGW = F.G * NWAVES;
    bf16* WIN = (bf16*)(ws + WS_WIN); bf16* WOUT = (bf16*)(ws + WS_WOUT); bf16* PG = (bf16*)(ws + WS_PGATE); bf16* PPJ = (bf16*)(ws + WS_PPROJ);
    bf16* RCAT = (bf16*)(ws + WS_RCAT); bf16* RL1 = (bf16*)(ws + WS_RL1); bf16* RWO = (bf16*)(ws + WS_RWO);
    constexpr int I_IN = (1024 / 64) * (2560 / 32), I_SQ = (1024 / 64) * (1024 / 32), I_PJ = (256 / 64) * (1024 / 32), I_L64 = (1024 / 64) * (64 / 32), I_L160 = (1024 / 64) * (160 / 32);
    int st = gw;
#define TJOB(MODE, NITEMS, W, K, N, WT, LDO, ROFF, MU) do { for (int it = st; it < (NITEMS); it += NGW) transpose_item<MODE>(W, K, N, WT, LDO, ROFF, MU, scr, it, LANE_); \
        st = (st + NGW - ((NITEMS) % NGW)) % NGW; asm volatile("" : "+s"(st)); } while (0)
    TJOB(0, I_IN, I.ab_w_in, 1024, 2560, WIN, 1024, 0, nullptr);
    TJOB(0, I_SQ, I.ab_w_out, 1024, 1024, WOUT, 1024, 0, nullptr);
    TJOB(0, I_SQ, I.ple_gate, 1024, 1024, PG, 1024, 0, nullptr);
    TJOB(0, I_SQ, I.ple_gate + 1024 * 1024, 1024, 1024, PG + 1024 * 1024, 1024, 0, nullptr);
    TJOB(0, I_SQ, I.rwkv_wo, 1024, 1024, RWO, 1024, 0, nullptr);
    TJOB(0, I_SQ, I.rwkv_wr, 1024, 1024, RCAT, 1024, 0, nullptr);
    TJOB(0, I_SQ, I.rwkv_wk, 1024, 1024, RCAT, 1024, 1024, nullptr);
    TJOB(0, I_SQ, I.rwkv_wv, 1024, 1024, RCAT, 1024, 2048, nullptr);
    TJOB(0, I_PJ, I.ple_proj, 256, 1024, PPJ, 256, 0, nullptr);
    TJOB(0, I_PJ, I.ple_proj + 256 * 1024, 256, 1024, PPJ + 1024 * 256, 256, 0, nullptr);
    TJOB(1, I_L64, I.rwkv_w1, 1024, 64, RL1, 2048, 0, I.rwkv_mu + 1 * 1024);
    TJOB(1, I_L64, I.rwkv_a1, 1024, 64, RL1, 2048, 64, I.rwkv_mu + 4 * 1024);
    TJOB(1, I_L160, I.rwkv_g1, 1024, 160, RL1, 2048, 256, I.rwkv_mu + 5 * 1024);
#undef TJOB
    const int gt = F.vcu * 512 + TID_, NGT = F.G * 512;
    { v4u z = {0u, 0u, 0u, 0u}; const int per_row = 2048 / 8;
      for (int i = gt; i < (128 + 96) * per_row; i += NGT) { int rr = i / per_row, cc = i % per_row; rr = (rr < 128) ? (128 + rr) : (416 + rr - 128); *(GAS v4u*)(RL1 + (size_t)rr * 2048 + cc * 8) = z; } }
    { bf16* S2 = (bf16*)(ws + WS_RS2);
      for (int i = gt; i < 3 * 1024 * 256; i += NGT) { const int ty = i / (1024 * 256), n = (i / 256) & 1023, k = i & 255; float v = 0.f;
          if (ty == 0) { if (k < 64) v = I.rwkv_w2[k * 1024 + n]; } else if (ty == 1) { if (k >= 64 && k < 128) v = I.rwkv_a2[(k - 64) * 1024 + n]; } else { if (k < 160) v = I.rwkv_g2[k * 1024 + n]; }
          S2[i] = (bf16)f2bf(v); } }
    { bf16* RT = (bf16*)(ws + WS_ROUT);
      for (int i = gt; i < 2 * 256 * 1024; i += NGT) { const int l = i / (256 * 1024), n = (i / 1024) & 255, k = i & 1023; float v = 0.f;
          if (n < 4) v = I.moe_wc[(size_t)l * 1024 * 4 + k * 4 + n]; else if (n < 36) v = I.moe_wf[(size_t)l * 1024 * 32 + k * 32 + (n - 4)];
          RT[i] = (bf16)f2bf(v); } }
}
__device__ __forceinline__ void prep_layer_weights(Frame& F, const In& I, unsigned char* ws, int layer) {
    LAS float* scr = (LAS float*)(F.lds + F.wave * 16384);
    const int gw = F.vcu * NWAVES + F.wave, NGW = F.G * NWAVES;
    bf16* MGU = (bf16*)(ws + WS_MGU); bf16* MDN = (bf16*)(ws + WS_MDN);
    const float* wgu = I.moe_w_gu + (size_t)layer * NEXP * 1024 * 1024; const float* wdn = I.moe_w_down + (size_t)layer * NEXP * 512 * 1024;
    constexpr int I_GU = (1024 / 64) * (1024 / 32), I_DN = (512 / 64) * (1024 / 32);
    for (int it = gw; it < NEXP * (I_GU + I_DN); it += NGW) {
        const int e = it / (I_GU + I_DN); int r = it % (I_GU + I_DN);
        if (r < I_GU) transpose_item<2>(wgu + (size_t)e * 1024 * 1024, 1024, 1024, MGU + (size_t)e * 1024 * 1024, 1024, 0, nullptr, scr, r, LANE_);
        else transpose_item<0>(wdn + (size_t)e * 512 * 1024, 512, 1024, MDN + (size_t)e * 1024 * 512, 512, 0, nullptr, scr, r - I_GU, LANE_);
    }
    const int gt = F.vcu * 512 + TID_, NGT = F.G * 512;
    const f32x4* ps = (const f32x4*)(I.p + (size_t)layer * T * PLE); v2u* pd = (v2u*)(ws + WS_PB);
    for (int i = gt; i < T * PLE / 4; i += 4 * NGT) { f32x4 v[4];
#pragma unroll
        for (int r = 0; r < 4; ++r) v[r] = ps[i + r * NGT];
#pragma unroll
        for (int r = 0; r < 4; ++r) { v2u o; o.x = pk2(v[r].x, v[r].y); o.y = pk2(v[r].z, v[r].w); pd[i + r * NGT] = o; } }
}

template <bool XBF>
__device__ __forceinline__ void norm_pass(Frame& F, const void* x, const float* g, bf16* out) {
    const int gw = F.vcu * NWAVES + F.wave, NGW = F.G * NWAVES; const int lane = LANE_;
    for (int t = 4 * gw; t < T; t += 4 * NGW) {
        f32x4 v[4][4];
#pragma unroll
        for (int r = 0; r < 4; ++r) { if (XBF) load_row4_bf((const bf16*)x + (size_t)(t + r) * D, lane, v[r]); else load_row4((const float*)x + (size_t)(t + r) * D, lane, v[r]); }
#pragma unroll
        for (int r = 0; r < 4; ++r) { const float rs = row_rstd(v[r], 1e-6f); store_row_bf16(out + (size_t)(t + r) * D, lane, v[r], rs, g); }
    }
}
__device__ __forceinline__ void rwkv_input_pass(Frame& F, const bf16* x, const float* g, const float* mu, bf16* HCAT, bf16* XR, bf16* XK, bf16* XV) {
    const int gw = F.vcu * NWAVES + F.wave, NGW = F.G * NWAVES; const int lane = LANE_;
    f32x4 gg[4], mr[4], mk[4], mv[4];
#pragma unroll
    for (int j = 0; j < 4; ++j) { gg[j] = ((const f32x4*)g)[lane + 64 * j]; mr[j] = ((const f32x4*)(mu + 0 * 1024))[lane + 64 * j]; mk[j] = ((const f32x4*)(mu + 2 * 1024))[lane + 64 * j]; mv[j] = ((const f32x4*)(mu + 3 * 1024))[lane + 64 * j]; }
    for (int blk = gw; blk < T / 32; blk += NGW) {
        const int t0 = blk * 32; f32x4 hp[4];
        if ((t0 & (SEQ - 1)) == 0) {
#pragma unroll
            for (int j = 0; j < 4; ++j) hp[j] = (f32x4){0.f, 0.f, 0.f, 0.f};
        } else { f32x4 v[4]; load_row4_bf(x + (size_t)(t0 - 1) * D, lane, v); const float rstd = row_rstd(v, 1e-6f);
#pragma unroll
            for (int j = 0; j < 4; ++j) hp[j] = v[j] * rstd * gg[j]; }
        f32x4 vn[4]; load_row4_bf(x + (size_t)t0 * D, lane, vn);
        for (int t = t0; t < t0 + 32; ++t) {
            f32x4 v[4];
#pragma unroll
            for (int j = 0; j < 4; ++j) v[j] = vn[j];
            if (t + 1 < t0 + 32) load_row4_bf(x + (size_t)(t + 1) * D, lane, vn);
            const float rstd = row_rstd(v, 1e-6f);
            unsigned long long* oh = (unsigned long long*)(HCAT + (size_t)t * 2048) + lane; unsigned long long* or_ = (unsigned long long*)(XR + (size_t)t * 1024) + lane;
            unsigned long long* ok = (unsigned long long*)(XK + (size_t)t * 1024) + lane; unsigned long long* ov = (unsigned long long*)(XV + (size_t)t * 1024) + lane;
#pragma unroll
            for (int j = 0; j < 4; ++j) { const f32x4 h = v[j] * rstd * gg[j], dd = hp[j] - h;
                oh[64 * j] = (unsigned long long)pk2(h.x, h.y) | ((unsigned long long)pk2(h.z, h.w) << 32);
                oh[256 + 64 * j] = (unsigned long long)pk2(hp[j].x, hp[j].y) | ((unsigned long long)pk2(hp[j].z, hp[j].w) << 32);
                const f32x4 a = h + dd * mr[j], b = h + dd * mk[j], c = h + dd * mv[j];
                or_[64 * j] = (unsigned long long)pk2(a.x, a.y) | ((unsigned long long)pk2(a.z, a.w) << 32);
                ok[64 * j] = (unsigned long long)pk2(b.x, b.y) | ((unsigned long long)pk2(b.z, b.w) << 32);
                ov[64 * j] = (unsigned long long)pk2(c.x, c.y) | ((unsigned long long)pk2(c.z, c.w) << 32);
                hp[j] = h; }
        }
    }
}
__device__ __forceinline__ void combine_norm_pass(Frame& F, const bf16* xin, bf16* xout, const bf16* YS, const int* slot, const float* g, bf16* out) {
    const int gw = F.vcu * NWAVES + F.wave, NGW = F.G * NWAVES; const int lane = LANE_;
    for (int t = 2 * gw; t < T; t += 2 * NGW) {
        f32x4 v[2][4]; v2u ya[2][4], yb[2][4];
#pragma unroll
        for (int r = 0; r < 2; ++r) { load_row4_bf(xin + (size_t)(t + r) * D, lane, v[r]);
            const int s0 = slot[2 * (t + r)], s1 = slot[2 * (t + r) + 1];
            const v2u* y0 = (const v2u*)(YS + (size_t)s0 * D) + lane; const v2u* y1 = (const v2u*)(YS + (size_t)s1 * D) + lane;
#pragma unroll
            for (int j = 0; j < 4; ++j) { ya[r][j] = y0[64 * j]; yb[r][j] = y1[64 * j]; } }
#pragma unroll
        for (int r = 0; r < 2; ++r) {
#pragma unroll
            for (int j = 0; j < 4; ++j) { const v2u a = ya[r][j], b = yb[r][j];
                v[r][j].x += bflo(a.x) + bflo(b.x); v[r][j].y += bfhi(a.x) + bfhi(b.x); v[r][j].z += bflo(a.y) + bflo(b.y); v[r][j].w += bfhi(a.y) + bfhi(b.y); }
            store_row4_bf(xout + (size_t)(t + r) * D, lane, v[r]);
            const float rstd = row_rstd(v[r], 1e-6f);
            store_row_bf16(out + (size_t)(t + r) * D, lane, v[r], rstd, g); }
    }
}
__device__ __forceinline__ void final_norm_pass(Frame& F, const bf16* x, float* out, const float* g) {
    const int gw = F.vcu * NWAVES + F.wave, NGW = F.G * NWAVES; const int lane = LANE_;
    for (int t = 4 * gw; t < T; t += 4 * NGW) {
        f32x4 v[4][4];
#pragma unroll
        for (int r = 0; r < 4; ++r) load_row4_bf(x + (size_t)(t + r) * D, lane, v[r]);
#pragma unroll
        for (int r = 0; r < 4; ++r) { const float rs = row_rstd(v[r], 1e-6f); f32x4* xo = (f32x4*)(out + (size_t)(t + r) * D) + lane;
#pragma unroll
            for (int j = 0; j < 4; ++j) { const f32x4 gg = ((const f32x4*)g)[lane + 64 * j]; xo[64 * j] = v[r][j] * rs * gg; } }
    }
}

__device__ __forceinline__ void diff_combine_pass(Frame& F, const In& I, const bf16* O, bf16* YCAT) {
    const int gw = F.vcu * NWAVES + F.wave, NGW = F.G * NWAVES;
    const float lam_init = 0.2f;
    const float d1 = wave_sum(I.lam_q1[LANE_] * I.lam_k1[LANE_]), d2 = wave_sum(I.lam_q2[LANE_] * I.lam_k2[LANE_]);
    const float lam = expf(d1) - expf(d2) + lam_init;
    const int h = LANE_ >> 4, q = LANE_ & 15;
    float sg[8];
#pragma unroll
    for (int e = 0; e < 8; ++e) sg[e] = I.sub_g[q * 8 + e] * (1.0f - lam_init);
    for (int t0 = 4 * gw; t0 < T; t0 += 4 * NGW) {
        v4u av[4], bv[4];
#pragma unroll
        for (int r = 0; r < 4; ++r) { av[r] = *(const v4u*)(O + (size_t)(t0 + r) * 1024 + h * 256 + q * 8); bv[r] = *(const v4u*)(O + (size_t)(t0 + r) * 1024 + h * 256 + 128 + q * 8); }
#pragma unroll
        for (int r = 0; r < 4; ++r) { const v4u a = av[r], b = bv[r]; const int t = t0 + r;
        float o[8];
        o[0] = bflo(a.x) - lam * bflo(b.x); o[1] = bfhi(a.x) - lam * bfhi(b.x); o[2] = bflo(a.y) - lam * bflo(b.y); o[3] = bfhi(a.y) - lam * bfhi(b.y);
        o[4] = bflo(a.z) - lam * bflo(b.z); o[5] = bfhi(a.z) - lam * bfhi(b.z); o[6] = bflo(a.w) - lam * bflo(b.w); o[7] = bfhi(a.w) - lam * bfhi(b.w);
        float s = 0.f;
#pragma unroll
        for (int e = 0; e < 8; ++e) s += o[e] * o[e];
        s += __shfl_xor(s, 1); s += __shfl_xor(s, 2); s += __shfl_xor(s, 4); s += __shfl_xor(s, 8);
        const float rstd = 1.0f / sqrtf(s * (1.0f / 128.0f) + 1e-5f);
        v4u w; w.x = pk2(o[0] * rstd * sg[0], o[1] * rstd * sg[1]); w.y = pk2(o[2] * rstd * sg[2], o[3] * rstd * sg[3]); w.z = pk2(o[4] * rstd * sg[4], o[5] * rstd * sg[5]); w.w = pk2(o[6] * rstd * sg[6], o[7] * rstd * sg[7]);
        *(v4u*)(YCAT + (size_t)t * 1024 + h * 128 + q * 8) = w; }
    }
}

constexpr int LCT = 64, LNCH = SEQ / LCT;
__device__ __forceinline__ float gelu_tanh(float x) { const float u = 0.7978845608028654f * (x + 0.044715f * x * x * x); return x * sigmoidf_(2.0f * u); }
template <bool FINAL>
__device__ __forceinline__ void lru_phase(Frame& F, const In& I, const bf16* XB, const bf16* GB, f32x2* AGG, bf16* YCAT, bf16* HLp, bf16* CAp) {
    const int ch = TID_, n = ch >> 6, d = ch & 63;
    LAS float* U = (LAS float*)F.lds;
    f32x2 wg[64];
#pragma unroll
    for (int c = 0; c < 64; ++c) { wg[c].x = I.lru_wa[n * 4096 + c * 64 + d]; wg[c].y = I.lru_wx[n * 4096 + c * 64 + d]; }
    const float cw0 = I.conv_w[0 * 512 + ch], cw1 = I.conv_w[1 * 512 + ch], cw2 = I.conv_w[2 * 512 + ch], cw3 = I.conv_w[3 * 512 + ch], cb = I.conv_b[ch];
    const float ba = I.lru_ba[ch], bx = I.lru_bx[ch];
    const float lam = I.lru_lambda[ch]; const float sp = (lam > 15.f) ? expf(-lam) : log1pf(expf(-lam));
    const float m8sp = -8.0f * sp;
    for (int un = blockIdx.x; un < NB * LNCH; un += F.G) {
        const int b = un / LNCH, c = un % LNCH; const size_t row0 = (size_t)b * SEQ + (size_t)c * LCT;
        unsigned short xraw[LCT + 3];
        if (c > 0) { xraw[0] = XB[(row0 - 3) * 512 + ch]; xraw[1] = XB[(row0 - 2) * 512 + ch]; xraw[2] = XB[(row0 - 1) * 512 + ch]; } else { xraw[0] = 0; xraw[1] = 0; xraw[2] = 0; }
#pragma unroll
        for (int tk = 0; tk < LCT; ++tk) xraw[3 + tk] = XB[(row0 + tk) * 512 + ch];
        float h = 0.f, Ap = 1.f;
        if (FINAL) { for (int j = 0; j < c; ++j) { const f32x2 ag = AGG[((size_t)b * LNCH + j) * 512 + ch]; h = ag.x * h + ag.y; } }
#pragma unroll
        for (int tk = 0; tk < LCT; ++tk) U[tk * 512 + ch] = cw0 * bf1(xraw[tk]) + cw1 * bf1(xraw[tk + 1]) + cw2 * bf1(xraw[tk + 2]) + cw3 * bf1(xraw[tk + 3]) + cb;
        __syncthreads();
        unsigned short gcur[8], gnxt[8];
        if (FINAL) {
#pragma unroll
            for (int j = 0; j < 8; ++j) gcur[j] = GB[(row0 + j) * 512 + ch]; }
#pragma unroll 1
        for (int tg = 0; tg < LCT / 8; ++tg) {
            if (FINAL) { const int tn = (tg + 1 < LCT / 8) ? (tg + 1) * 8 : tg * 8;
#pragma unroll
                for (int j = 0; j < 8; ++j) gnxt[j] = GB[(row0 + tn + j) * 512 + ch]; }
#pragma unroll
            for (int j = 0; j < 8; ++j) { const int tk = tg * 8 + j;
                const LAS f32x4* up = (const LAS f32x4*)(U + tk * 512 + n * 64);
                f32x2 acc = {ba, bx};
#pragma unroll
                for (int c4 = 0; c4 < 16; ++c4) { const f32x4 uu = up[c4];
                    acc += wg[4 * c4 + 0] * uu.x; acc += wg[4 * c4 + 1] * uu.y; acc += wg[4 * c4 + 2] * uu.z; acc += wg[4 * c4 + 3] * uu.w; }
                const float r = sigmoidf_(acc.x), ig = sigmoidf_(acc.y);
                const float la = r * m8sp; const float a = __expf(la); const float t2 = 2.0f * la; const float om = (t2 > -0.02f) ? -t2 * (1.0f + t2 * (0.5f + t2 * (0.16666667f + t2 * 0.041666668f))) : 1.0f - a * a; const float bb = __builtin_amdgcn_sqrtf(om) * (ig * U[tk * 512 + ch]);
                h = a * h + bb;
                if (FINAL) { YCAT[(row0 + tk) * 1024 + 512 + ch] = (bf16)f2bf(h * gelu_tanh(bf1(gcur[j]))); }
                else { Ap *= a; HLp[(row0 + tk) * 512 + ch] = (bf16)f2bf(h); CAp[(row0 + tk) * 512 + ch] = (bf16)f2bf(Ap); } }
            if (FINAL) {
#pragma unroll
                for (int j = 0; j < 8; ++j) gcur[j] = gnxt[j]; }
        }
        if (!FINAL) { f32x2 ag; ag.x = Ap; ag.y = h; AGG[((size_t)b * LNCH + c) * 512 + ch] = ag; }
        __syncthreads();
    }
}

__device__ __forceinline__ void lru_agg_mfma(Frame& F, const In& I, const bf16* XB, f32x2* AGG, bf16* HLp, bf16* CAp) {
    const int tid = TID_, lane = tid & 63, fr = lane & 15, fq = lane >> 4, n = F.wave, ch = tid;
    constexpr int UP = 520;
    LAS bf16* U = (LAS bf16*)F.lds;
    bf16x8 Wr[4][2], Wi[4][2];
#pragma unroll
    for (int dd = 0; dd < 4; ++dd)
#pragma unroll
        for (int kh = 0; kh < 2; ++kh) { unsigned pr_[4], pi_[4];
#pragma unroll
            for (int j = 0; j < 4; ++j) { const int c0 = 32 * kh + 8 * fq + 2 * j, d = 16 * dd + fr;
                pr_[j] = pk2(I.lru_wa[n * 4096 + c0 * 64 + d], I.lru_wa[n * 4096 + (c0 + 1) * 64 + d]); pi_[j] = pk2(I.lru_wx[n * 4096 + c0 * 64 + d], I.lru_wx[n * 4096 + (c0 + 1) * 64 + d]); }
            Wr[dd][kh] = __builtin_bit_cast(bf16x8, (v4u){pr_[0], pr_[1], pr_[2], pr_[3]}); Wi[dd][kh] = __builtin_bit_cast(bf16x8, (v4u){pi_[0], pi_[1], pi_[2], pi_[3]}); }
    float cba[4], cbx[4], cm8[4];
#pragma unroll
    for (int dd = 0; dd < 4; ++dd) { const int chd = 64 * n + 16 * dd + fr; cba[dd] = I.lru_ba[chd]; cbx[dd] = I.lru_bx[chd];
        const float lam = I.lru_lambda[chd]; cm8[dd] = -8.0f * ((lam > 15.f) ? expf(-lam) : log1pf(expf(-lam))); }
    const float cw0 = I.conv_w[0 * 512 + ch], cw1 = I.conv_w[1 * 512 + ch], cw2 = I.conv_w[2 * 512 + ch], cw3 = I.conv_w[3 * 512 + ch], cb = I.conv_b[ch];
    for (int un = blockIdx.x; un < NB * LNCH; un += F.G) {
        const int b = un / LNCH, c = un % LNCH; const size_t row0 = (size_t)b * SEQ + (size_t)c * LCT;
        unsigned short xraw[LCT + 3];
        if (c > 0) { xraw[0] = XB[(row0 - 3) * 512 + ch]; xraw[1] = XB[(row0 - 2) * 512 + ch]; xraw[2] = XB[(row0 - 1) * 512 + ch]; } else { xraw[0] = 0; xraw[1] = 0; xraw[2] = 0; }
#pragma unroll
        for (int tk = 0; tk < LCT; ++tk) xraw[3 + tk] = XB[(row0 + tk) * 512 + ch];
#pragma unroll
        for (int tk = 0; tk < LCT; ++tk) U[tk * UP + ch] = (bf16)f2bf(cw0 * bf1(xraw[tk]) + cw1 * bf1(xraw[tk + 1]) + cw2 * bf1(xraw[tk + 2]) + cw3 * bf1(xraw[tk + 3]) + cb);
        __syncthreads();
        bf16x8 X[4][2];
#pragma unroll
        for (int tt = 0; tt < 4; ++tt)
#pragma unroll
            for (int kh = 0; kh < 2; ++kh) X[tt][kh] = *(const LAS bf16x8*)(U + (16 * tt + fr) * UP + 64 * n + 32 * kh + 8 * fq);
#pragma unroll 1
        for (int dd = 0; dd < 4; ++dd) {
            bf16x8 wr0, wr1, wi0, wi1; float kba, kbx, km8;
            if (dd == 0) { wr0 = Wr[0][0]; wr1 = Wr[0][1]; wi0 = Wi[0][0]; wi1 = Wi[0][1]; kba = cba[0]; kbx = cbx[0]; km8 = cm8[0]; }
            else if (dd == 1) { wr0 = Wr[1][0]; wr1 = Wr[1][1]; wi0 = Wi[1][0]; wi1 = Wi[1][1]; kba = cba[1]; kbx = cbx[1]; km8 = cm8[1]; }
            else if (dd == 2) { wr0 = Wr[2][0]; wr1 = Wr[2][1]; wi0 = Wi[2][0]; wi1 = Wi[2][1]; kba = cba[2]; kbx = cbx[2]; km8 = cm8[2]; }
            else { wr0 = Wr[3][0]; wr1 = Wr[3][1]; wi0 = Wi[3][0]; wi1 = Wi[3][1]; kba = cba[3]; kbx = cbx[3]; km8 = cm8[3]; }
            const int chd = 64 * n + 16 * dd + fr;
            float hc = 0.f, Ac = 1.f;
#pragma unroll
            for (int tt = 0; tt < 4; ++tt) {
                f32x4 pr = (f32x4){0.f, 0.f, 0.f, 0.f}, pi = pr;
                pr = __builtin_amdgcn_mfma_f32_16x16x32_bf16(X[tt][0], wr0, pr, 0, 0, 0); pr = __builtin_amdgcn_mfma_f32_16x16x32_bf16(X[tt][1], wr1, pr, 0, 0, 0);
                pi = __builtin_amdgcn_mfma_f32_16x16x32_bf16(X[tt][0], wi0, pi, 0, 0, 0); pi = __builtin_amdgcn_mfma_f32_16x16x32_bf16(X[tt][1], wi1, pi, 0, 0, 0);
                float a[4], bb[4];
#pragma unroll
                for (int e = 0; e < 4; ++e) { const int tok = 16 * tt + 4 * fq + e; const float u = bf1(U[tok * UP + chd]);
                    const float r = sigmoidf_(pr[e] + kba), ig = sigmoidf_(pi[e] + kbx); const float la = r * km8; a[e] = __expf(la); const float t2 = 2.0f * la;
                    const float om = (t2 > -0.02f) ? -t2 * (1.0f + t2 * (0.5f + t2 * (0.16666667f + t2 * 0.041666668f))) : 1.0f - a[e] * a[e]; bb[e] = __builtin_amdgcn_sqrtf(om) * (ig * u); }
                const float A4 = (a[0] * a[1]) * (a[2] * a[3]); const float B4 = ((bb[0] * a[1] + bb[1]) * a[2] + bb[2]) * a[3] + bb[3];
                float h = hc, Ap = Ac, hs = hc, As = Ac;
#pragma unroll
                for (int j = 0; j < 4; ++j) { const float Aj = __shfl(A4, fr + 16 * j), Bj = __shfl(B4, fr + 16 * j); if (j == fq) { hs = h; As = Ap; } h = Aj * h + Bj; Ap *= Aj; }
                hc = h; Ac = Ap; h = hs; Ap = As;
#pragma unroll
                for (int e = 0; e < 4; ++e) { h = a[e] * h + bb[e]; Ap *= a[e]; const size_t o = (row0 + 16 * tt + 4 * fq + e) * 512 + chd; HLp[o] = (bf16)f2bf(h); CAp[o] = (bf16)f2bf(Ap); }
            }
            if (fq == 0) { f32x2 ag; ag.x = Ac; ag.y = hc; AGG[((size_t)b * LNCH + c) * 512 + chd] = ag; }
        }
        __syncthreads();
    }
}

__device__ __forceinline__ void lru_final_pass(Frame& F, const bf16* HLp, const bf16* CAp, const bf16* GB, const f32x2* AGG, bf16* YCAT) {
    const int ch = TID_;
    for (int un = blockIdx.x; un < NB * LNCH; un += F.G) {
        const int b = un / LNCH, c = un % LNCH; const size_t row0 = (size_t)b * SEQ + (size_t)c * LCT;
        float carry = 0.f;
        for (int j = 0; j < c; ++j) { const f32x2 ag = AGG[((size_t)b * LNCH + j) * 512 + ch]; carry = ag.x * carry + ag.y; }
#pragma unroll 4
        for (int t8 = 0; t8 < LCT; t8 += 8) {
            bf16 hl[8], ca[8], gv[8];
#pragma unroll
            for (int j = 0; j < 8; ++j) { const size_t o = (row0 + t8 + j) * 512 + ch; hl[j] = HLp[o]; ca[j] = CAp[o]; gv[j] = GB[o]; }
#pragma unroll
            for (int j = 0; j < 8; ++j) { const float h = bf1(hl[j]) + bf1(ca[j]) * carry; YCAT[(row0 + t8 + j) * 1024 + 512 + ch] = (bf16)f2bf(h * gelu_tanh(bf1(gv[j]))); }
        }
    }
}

__device__ __forceinline__ void route_pass_a(Frame& F, const In& I, int layer, const float* LOG, unsigned char* rt, gu32* cnt) {
    LAS int* lcnt = (LAS int*)(F.lds + RTE_OFF); LAS int* lbase = lcnt + 32;
    int* EID = (int*)(rt + RT_EID); int* POS = (int*)(rt + RT_POS); float* GATE = (float*)(rt + RT_GATE);
    const float* bc = I.moe_bc + layer * 4; const float* bfb = I.moe_bf + layer * 32;
    for (int un = blockIdx.x; un < T / 512; un += F.G) {
        if (TID_ < 32) lcnt[TID_] = 0;
        __syncthreads();
        const int t = un * 512 + TID_; const float* lg = LOG + (size_t)t * 64;
        const f32x4 g4 = *(const f32x4*)lg;
        float gl[4] = {g4.x + bc[0], g4.y + bc[1], g4.z + bc[2], g4.w + bc[3]};
        int gi = 0; float gm = gl[0];
#pragma unroll
        for (int j = 1; j < 4; ++j) if (gl[j] > gm) { gm = gl[j]; gi = j; }
        float gs = 0.f;
#pragma unroll
        for (int j = 0; j < 4; ++j) gs += __expf(gl[j] - gm);
        const float gprob = 1.0f / gs;
        const f32x4 e0 = *(const f32x4*)(lg + 4 + gi * 8), e1 = *(const f32x4*)(lg + 8 + gi * 8);
        float el[8] = {e0.x, e0.y, e0.z, e0.w, e1.x, e1.y, e1.z, e1.w};
#pragma unroll
        for (int j = 0; j < 8; ++j) el[j] += bfb[gi * 8 + j];
        int i0 = 0; float m0 = el[0];
#pragma unroll
        for (int j = 1; j < 8; ++j) if (el[j] > m0) { m0 = el[j]; i0 = j; }
        int i1 = -1; float m1 = -INFINITY;
#pragma unroll
        for (int j = 0; j < 8; ++j) if (j != i0 && el[j] > m1) { m1 = el[j]; i1 = j; }
        const float r1 = __expf(m1 - m0); const float g0 = gprob / (1.0f + r1), g1 = gprob * r1 / (1.0f + r1);
        const int ex0 = gi * 8 + i0, ex1 = gi * 8 + i1;
        const int p0 = atomicAdd((int*)&lcnt[ex0], 1), p1 = atomicAdd((int*)&lcnt[ex1], 1);
        __syncthreads();
        if (TID_ < 32) lbase[TID_] = (int)__hip_atomic_fetch_add(cnt + TID_, (unsigned)lcnt[TID_], RLX_AGENT);
        __syncthreads();
        EID[2 * t] = ex0; EID[2 * t + 1] = ex1; POS[2 * t] = lbase[ex0] + p0; POS[2 * t + 1] = lbase[ex1] + p1; GATE[2 * t] = g0; GATE[2 * t + 1] = g1;
        __syncthreads();
    }
}
__device__ __forceinline__ void route_bases(Frame& F, gu32* cnt) {
    LAS int* eb = (LAS int*)(F.lds + RTE_OFF + 512);
    const int tid = TID_;
    if (tid < 64) {
        const int c = (tid < 32) ? (int)__hip_atomic_load(cnt + (tid & 31), RLX_AGENT) : 0; const int p = (c + 255) & ~255; int s = p;
#pragma unroll
        for (int o = 1; o < 32; o <<= 1) { const int t = __shfl_up(s, o); if ((tid & 63) >= o) s += t; }
        if (tid < 32) { eb[tid] = s - p; if (tid == 31) eb[32] = s; }
    }
    __syncthreads();
}
__device__ __forceinline__ void route_pass_b(Frame& F, unsigned char* rt, gu32* cnt) {
    route_bases(F, cnt);
    LAS int* eb = (LAS int*)(F.lds + RTE_OFF + 512);
    const int* EID = (const int*)(rt + RT_EID); const int* POS = (const int*)(rt + RT_POS); const float* GATE = (const float*)(rt + RT_GATE);
    int* ROWTOK = (int*)(rt + RT_ROWTOK); float* ROWGATE = (float*)(rt + RT_ROWGATE); int* SLOT = (int*)(rt + RT_SLOT);
    const int gt = F.vcu * 512 + TID_, NGT = F.G * 512;
    for (int i = gt; i < 2 * T; i += NGT) { const int dst = eb[EID[i]] + POS[i]; ROWTOK[dst] = i >> 1; ROWGATE[dst] = GATE[i]; SLOT[i] = dst; }
    for (int i = gt; i < 32 * 256; i += NGT) { const int e = i >> 8, j = i & 255; const int c = (int)__hip_atomic_load(cnt + e, RLX_AGENT); const int pad = ((c + 255) & ~255) - c;
        if (j < pad) { ROWTOK[eb[e] + c + j] = 0; ROWGATE[eb[e] + c + j] = 0.f; } }
    __syncthreads();
}
struct MoeOrder {
    int G, c, ntiles; const LAS int* eb; const char* A; const char* W; size_t astep, wexp, wtile; bool gather;
    __device__ bool next(int i, pg8::Unit& u) const {
        const int L = i * G + c; if (L >= ntiles * 4) return false;
        u.pm = L >> 2; u.pn = L & 3; const int s0 = u.pm * 256; int e = 0;
#pragma unroll 1
        for (int j = 1; j < 32; ++j) if (eb[j] <= s0) e = j;
        e = __builtin_amdgcn_readfirstlane(e); u.aux = e; u.A = gather ? A : A + (size_t)u.pm * astep; u.B = W + (size_t)e * wexp + (size_t)u.pn * wtile; return true;
    }
};

constexpr int RTC = 32, RNCH = SEQ / RTC, RTOK = 352;
#define LBAR() do { asm volatile("s_waitcnt lgkmcnt(0)" ::: "memory"); __builtin_amdgcn_s_barrier(); asm volatile("" ::: "memory"); } while (0)
template <int CTRL> __device__ __forceinline__ float dpp_f(float v) { return __builtin_bit_cast(float, __builtin_amdgcn_update_dpp(0, __builtin_bit_cast(int, v), CTRL, 0xf, 0xf, true)); }
__device__ __forceinline__ float red16(float v) { v += dpp_f<0xB1>(v); v += dpp_f<0x4E>(v); v += dpp_f<0x141>(v); v += dpp_f<0x140>(v); return v; }
__device__ __forceinline__ float red8(float v) { v += dpp_f<0xB1>(v); v += dpp_f<0x4E>(v); v += dpp_f<0x141>(v); return v; }
__device__ __forceinline__ void unpack8(const v4u w, float (&f)[8]) { f[0] = bflo(w.x); f[1] = bfhi(w.x); f[2] = bflo(w.y); f[3] = bfhi(w.y); f[4] = bflo(w.z); f[5] = bfhi(w.z); f[6] = bflo(w.w); f[7] = bfhi(w.w); }
__device__ __forceinline__ void rwkv_scan_phase(Frame& F, const In& I, const bf16* R, const bf16* Kt, const bf16* V, const bf16* AA, const bf16* EW, bf16* Y) {
    LAS float* buf = (LAS float*)F.lds;
    LAS float* ybuf = (LAS float*)(F.lds + 2 * RTC * RTOK * 4) + 32;
    const int tid = TID_, lane = tid & 63;
    const int seg = lane & 15, rl = F.wave * 4 + (lane >> 4);
    const int stk = tid >> 4, ssg = tid & 15;
    for (int un = blockIdx.x; un < NB * 16 * 2; un += F.G) {
        const int half = un & 1, h = (un >> 1) & 15, b = un >> 5;
        const size_t rowb = (size_t)b * SEQ;
        const int col = h * 64 + ssg * 4;
        const f32x4 kkw = *(const f32x4*)(I.rwkv_kk + col), kaw = *(const f32x4*)(I.rwkv_ka + col);
        v2u rr, kr, vr, ar, er;
#define RAW_LOAD(cc) do { const size_t off = (rowb + (size_t)(cc) * RTC + stk) * 1024 + col; rr = *(const v2u*)(R + off); kr = *(const v2u*)(Kt + off); vr = *(const v2u*)(V + off); ar = *(const v2u*)(AA + off); er = *(const v2u*)(EW + off); } while (0)
#define RAW_CONVERT(cc) do { LAS float* tp = buf + ((cc) & 1) * (RTC * RTOK) + stk * RTOK + ssg * 4; \
            const float r0 = bflo(rr.x), r1 = bfhi(rr.x), r2 = bflo(rr.y), r3 = bfhi(rr.y), k0 = bflo(kr.x), k1 = bfhi(kr.x), k2 = bflo(kr.y), k3 = bfhi(kr.y); \
            const float a0 = bflo(ar.x), a1 = bfhi(ar.x), a2 = bflo(ar.y), a3 = bfhi(ar.y); \
            const float x0 = k0 * kkw.x, x1 = k1 * kkw.y, x2 = k2 * kkw.z, x3 = k3 * kkw.w; \
            const float ss = red16((x0 * x0 + x1 * x1) + (x2 * x2 + x3 * x3)); const float inv = __builtin_amdgcn_rsqf(fmaxf(ss, 1e-24f)); \
            *(LAS f32x4*)(tp) = (f32x4){__expf(-bflo(er.x)), __expf(-bfhi(er.x)), __expf(-bflo(er.y)), __expf(-bfhi(er.y))}; \
            const f32x4 kkv = (f32x4){x0 * inv, x1 * inv, x2 * inv, x3 * inv}; *(LAS f32x4*)(tp + 64) = kkv; \
            *(LAS f32x4*)(tp + 128) = (f32x4){kkv.x * a0, kkv.y * a1, kkv.z * a2, kkv.w * a3}; \
            *(LAS f32x4*)(tp + 192) = (f32x4){k0 * (1.0f + (a0 - 1.0f) * kaw.x), k1 * (1.0f + (a1 - 1.0f) * kaw.y), k2 * (1.0f + (a2 - 1.0f) * kaw.z), k3 * (1.0f + (a3 - 1.0f) * kaw.w)}; \
            *(LAS f32x4*)(tp + 256) = (f32x4){r0, r1, r2, r3}; \
            if ((ssg >> 3) == half) *(LAS f32x4*)(buf + ((cc) & 1) * (RTC * RTOK) + stk * RTOK + 320 + (ssg & 7) * 4) = (f32x4){bflo(vr.x), bfhi(vr.x), bflo(vr.y), bfhi(vr.y)}; } while (0)
#define Y_WRITE(cc) do { const LAS f32x2* yp = (const LAS f32x2*)(ybuf + ((cc) & 1) * (RTC * 32 + 32) + stk * 32 + ssg * 2); const f32x2 yv = *yp; \
            *(unsigned*)(Y + (rowb + (size_t)(cc) * RTC + stk) * 1024 + h * 64 + half * 32 + ssg * 2) = pk2(yv.x, yv.y); } while (0)
        RAW_LOAD(0); RAW_CONVERT(0); RAW_LOAD(1);
        f32x2 S0 = (f32x2){0.f, 0.f}, S1 = (f32x2){0.f, 0.f};
        LBAR();
        for (int c = 0; c < RNCH; ++c) {
            if (c + 1 < RNCH) { RAW_CONVERT(c + 1); }
            if (c + 2 < RNCH) { RAW_LOAD(c + 2); }
            if (c >= 1) { Y_WRITE(c - 1); }
            const LAS float* cb = buf + (c & 1) * (RTC * RTOK); LAS float* yb = ybuf + (c & 1) * (RTC * 32 + 32);
            const LAS float* tp0 = cb + seg * 4; const LAS float* vp0 = cb + 320 + rl;
#define SV_DECL(X) f32x4 X##w, X##q, X##b, X##k, X##r; float X##v
#define SV_LOAD(X, tk) do { const LAS float* tp = tp0 + (tk) * RTOK; \
                X##w = *(const LAS f32x4*)(tp); X##q = *(const LAS f32x4*)(tp + 64); X##b = *(const LAS f32x4*)(tp + 128); X##k = *(const LAS f32x4*)(tp + 192); X##r = *(const LAS f32x4*)(tp + 256); X##v = vp0[(tk) * RTOK]; } while (0)
#define SV_STEP(X, tk) do { \
                const f32x2 d = S0 * (f32x2){X##q.x, X##q.y} + S1 * (f32x2){X##q.z, X##q.w}; \
                const f32x2 t0 = S0 * (f32x2){X##w.x, X##w.y} + (f32x2){X##k.x, X##k.y} * X##v, t1 = S1 * (f32x2){X##w.z, X##w.w} + (f32x2){X##k.z, X##k.w} * X##v; \
                float ra = d.x + d.y, rb = epend;                   \
                ra += dpp_f<0xB1>(ra); rb += dpp_f<0xB1>(rb); ra += dpp_f<0x4E>(ra); rb += dpp_f<0x4E>(rb); ra += dpp_f<0x141>(ra); rb += dpp_f<0x141>(rb); ra += dpp_f<0x140>(ra); rb += dpp_f<0x140>(rb); \
                if (seg == 0) yb[((tk) - 1) * 32 + rl] = rb;        \
                const float sa = -ra; \
                S0 = t0 + (f32x2){X##b.x, X##b.y} * sa; S1 = t1 + (f32x2){X##b.z, X##b.w} * sa; \
                const f32x2 e = S0 * (f32x2){X##r.x, X##r.y} + S1 * (f32x2){X##r.z, X##r.w}; epend = e.x + e.y; } while (0)
            SV_DECL(A_); SV_DECL(B_); float epend = 0.f;
            SV_LOAD(A_, 0);
#pragma unroll 1
            for (int tk = 0; tk < RTC; tk += 2) {
                SV_LOAD(B_, tk + 1);
                SV_STEP(A_, tk);
                { const int t2 = (tk + 2 < RTC) ? tk + 2 : RTC - 1; SV_LOAD(A_, t2); }
                SV_STEP(B_, tk + 1);
            }
#undef SV_DECL
#undef SV_LOAD
#undef SV_STEP
            { const float rb = red16(epend); if (seg == 0) yb[(RTC - 1) * 32 + rl] = rb; }
            LBAR();
        }
        Y_WRITE(RNCH - 1);
        LBAR();
#undef RAW_LOAD
#undef RAW_CONVERT
#undef Y_WRITE
    }
}
constexpr int GS_QT = 0, GS_RT = 2048, GS_BHT = 4096, GS_KHT = 6144, GS_VT = 8192, GS_TM = 10240, GS_TL = 10752, GS_MK = 11264, GS_NK = 11776, GS_NB = 12288, GS_DD = 12800, GS_SLOT = 13056;
constexpr int GS_KT = GS_KHT, GS_BT = GS_BHT, GS_MB = GS_TM;
#ifndef SCAN_NP
#define SCAN_NP 4
#endif
constexpr int CH_NP = SCAN_NP, CH_NS = 8 - CH_NP, CH_ROUNDS = (512 + CH_NP - 1) / CH_NP;
constexpr int CH_KTAB = 2 * CH_NP * GS_SLOT;
static_assert(CH_KTAB + 512 <= 131072, "chunked-scan LDS map");
template <int N> __device__ __forceinline__ float dpp_shr(float v) { return __builtin_bit_cast(float, __builtin_amdgcn_update_dpp(0, __builtin_bit_cast(int, v), 0x110 + N, 0xf, 0xf, true)); }
__device__ __forceinline__ bf16x8 mk8(v2u a, v2u b) { return __builtin_bit_cast(bf16x8, (v4u){a.x, a.y, b.x, b.y}); }
__device__ __forceinline__ bf16x8 mk8z(v2u a) { return __builtin_bit_cast(bf16x8, (v4u){a.x, a.y, 0u, 0u}); }
__device__ __forceinline__ bf16x8 cvt8z(f32x4 v) { return __builtin_bit_cast(bf16x8, (v4u){pk2(v.x, v.y), pk2(v.z, v.w), 0u, 0u}); }
__device__ __forceinline__ int tokoff(const int t, const int c) { return t * 128 + ((c ^ ((t >> 1) & 7)) << 4); }
__device__ __forceinline__ int tokoff2(const int t, const int c) { return t * 128 + ((c ^ (((t >> 1) & 3) << 1)) << 4); }
__device__ __forceinline__ v2u trld(const LAS unsigned char* p) { return __builtin_bit_cast(v2u, __builtin_amdgcn_ds_read_tr16_b64_v4i16((LAS attn_body::v4i16_t*)p)); }
struct ChOps { v4u q0, q1, r0, r1, mn, bt; };
struct ChOpsB { v2u kh[4], bh[4]; f32x4 dv[4]; };
__device__ __forceinline__ void chain_load(ChOps& O, const LAS unsigned char* C, const int fr, const int fq) {
    const int w8 = 8 * (fq & 1), c = fq >> 1;
    { const v2u a = *(const LAS v2u*)(C + GS_QT + tokoff(fr, c) + w8), b = *(const LAS v2u*)(C + GS_QT + tokoff(fr, 2 + c) + w8); O.q0 = (v4u){a.x, a.y, b.x, b.y}; }
    { const v2u a = *(const LAS v2u*)(C + GS_QT + tokoff(fr, 4 + c) + w8), b = *(const LAS v2u*)(C + GS_QT + tokoff(fr, 6 + c) + w8); O.q1 = (v4u){a.x, a.y, b.x, b.y}; }
    { const v2u a = *(const LAS v2u*)(C + GS_RT + tokoff(fr, c) + w8), b = *(const LAS v2u*)(C + GS_RT + tokoff(fr, 2 + c) + w8); O.r0 = (v4u){a.x, a.y, b.x, b.y}; }
    { const v2u a = *(const LAS v2u*)(C + GS_RT + tokoff(fr, 4 + c) + w8), b = *(const LAS v2u*)(C + GS_RT + tokoff(fr, 6 + c) + w8); O.r1 = (v4u){a.x, a.y, b.x, b.y}; }
    const int om = (fr * 16 + 4 * fq) * 2;
    { const v2u a = *(const LAS v2u*)(C + GS_MK + om), b = *(const LAS v2u*)(C + GS_NK + om); O.mn = (v4u){a.x, a.y, b.x, b.y}; }
    { const v2u a = *(const LAS v2u*)(C + GS_NB + om), b = *(const LAS v2u*)(C + GS_TM + om); O.bt = (v4u){a.x, a.y, b.x, b.y}; }
}
__device__ __forceinline__ void chain_load_b(ChOpsB& O, const LAS unsigned char* C, const int fr, const int fq) {
#pragma unroll
    for (int jt = 0; jt < 4; ++jt) { const int ok = tokoff2(4 * fq + (fr >> 2), 2 * jt + ((fr >> 1) & 1)) + 8 * (fr & 1); O.kh[jt] = trld(C + GS_KHT + ok); O.bh[jt] = trld(C + GS_BHT + ok); O.dv[jt] = *(const LAS f32x4*)(C + GS_DD + (16 * jt + 4 * fq) * 4); }
}
template <int NT>
__device__ __forceinline__ void chain_step(const ChOps& O, const LAS unsigned char* C, const v2u vq0, const v2u vq1, f32x4 (&Areg)[2][4], const int vt0, const int fr, const int fq, GAS bf16* yrow, LAS unsigned char* ys) {
    const f32x4 zero4 = (f32x4){0.f, 0.f, 0.f, 0.f};
    v2u kh0, kh1, kh2, kh3, bh0, bh1, bh2, bh3; f32x4 dv0, dv1, dv2, dv3;
    { const int okb = tokoff2(4 * fq + (fr >> 2), 0) + 8 * (fr & 1), xs = (((4 * fq + (fr >> 2)) >> 1) & 3) << 1, cb = (fr >> 1) & 1;
#define KB_(jt) (4 * fq + (fr >> 2)) * 128 + ((((2 * (jt) + cb) ^ xs)) << 4) + 8 * (fr & 1)
      kh0 = trld(C + GS_KHT + KB_(0)); kh1 = trld(C + GS_KHT + KB_(1)); kh2 = trld(C + GS_KHT + KB_(2)); kh3 = trld(C + GS_KHT + KB_(3));
      bh0 = trld(C + GS_BHT + KB_(0)); bh1 = trld(C + GS_BHT + KB_(1)); bh2 = trld(C + GS_BHT + KB_(2)); bh3 = trld(C + GS_BHT + KB_(3)); (void)okb;
#undef KB_
      dv0 = *(const LAS f32x4*)(C + GS_DD + (4 * fq) * 4); dv1 = *(const LAS f32x4*)(C + GS_DD + (16 + 4 * fq) * 4); dv2 = *(const LAS f32x4*)(C + GS_DD + (32 + 4 * fq) * 4); dv3 = *(const LAS f32x4*)(C + GS_DD + (48 + 4 * fq) * 4); }
    bf16x8 Aq[NT][2], Vq[NT], Uq[NT]; f32x4 X[NT], YA[NT], Z[NT], U[NT], Yv[NT], Yn[NT];
#pragma unroll
    for (int ti = 0; ti < NT; ++ti) {
#pragma unroll
        for (int kh = 0; kh < 2; ++kh) Aq[ti][kh] = __builtin_bit_cast(bf16x8, (v4u){pk2(Areg[ti][2 * kh].x, Areg[ti][2 * kh].y), pk2(Areg[ti][2 * kh].z, Areg[ti][2 * kh].w), pk2(Areg[ti][2 * kh + 1].x, Areg[ti][2 * kh + 1].y), pk2(Areg[ti][2 * kh + 1].z, Areg[ti][2 * kh + 1].w)});
        Vq[ti] = mk8z(ti == 0 ? vq0 : vq1); X[ti] = zero4; YA[ti] = zero4; }
#pragma unroll
    for (int kh = 0; kh < 2; ++kh) {
#pragma unroll
        for (int ti = 0; ti < NT; ++ti) { X[ti] = __builtin_amdgcn_mfma_f32_16x16x32_bf16(__builtin_bit_cast(bf16x8, kh == 0 ? O.q0 : O.q1), Aq[ti][kh], X[ti], 0, 0, 0); YA[ti] = __builtin_amdgcn_mfma_f32_16x16x32_bf16(__builtin_bit_cast(bf16x8, kh == 0 ? O.r0 : O.r1), Aq[ti][kh], YA[ti], 0, 0, 0); } }
#pragma unroll
    for (int ti = 0; ti < NT; ++ti) Z[ti] = __builtin_amdgcn_mfma_f32_16x16x32_bf16(__builtin_bit_cast(bf16x8, (v4u){O.mn.x, O.mn.y, 0u, 0u}), Vq[ti], X[ti], 0, 0, 0);
#pragma unroll
    for (int ti = 0; ti < NT; ++ti) Yv[ti] = __builtin_amdgcn_mfma_f32_16x16x32_bf16(__builtin_bit_cast(bf16x8, (v4u){O.mn.z, O.mn.w, 0u, 0u}), Vq[ti], YA[ti], 0, 0, 0);
#pragma unroll
    for (int ti = 0; ti < NT; ++ti) U[ti] = __builtin_amdgcn_mfma_f32_16x16x32_bf16(__builtin_bit_cast(bf16x8, (v4u){O.bt.z, O.bt.w, 0u, 0u}), cvt8z(Z[ti]), zero4, 0, 0, 0);
#pragma unroll
    for (int ti = 0; ti < NT; ++ti) Uq[ti] = cvt8z(U[ti]);
#pragma unroll
    for (int ti = 0; ti < NT; ++ti) Yn[ti] = __builtin_amdgcn_mfma_f32_16x16x32_bf16(__builtin_bit_cast(bf16x8, (v4u){O.bt.x, O.bt.y, 0u, 0u}), Uq[ti], zero4, 0, 0, 0);
#pragma unroll
    for (int jt = 0; jt < 4; ++jt) {
#pragma unroll
        for (int ti = 0; ti < NT; ++ti) { f32x4 acc = (jt == 0 ? dv0 : jt == 1 ? dv1 : jt == 2 ? dv2 : dv3) * Areg[ti][jt];
            acc = __builtin_amdgcn_mfma_f32_16x16x32_bf16(mk8z(jt == 0 ? kh0 : jt == 1 ? kh1 : jt == 2 ? kh2 : kh3), Vq[ti], acc, 0, 0, 0);
            const f32x4 nbu = __builtin_amdgcn_mfma_f32_16x16x32_bf16(mk8z(jt == 0 ? bh0 : jt == 1 ? bh1 : jt == 2 ? bh2 : bh3), Uq[ti], zero4, 0, 0, 0);
            Areg[ti][jt] = acc - nbu; } }
#pragma unroll
    for (int ti = 0; ti < NT; ++ti) { const f32x4 yy = Yv[ti] - Yn[ti]; *(LAS v2u*)(ys + ti * 512 + (fr * 16 + 4 * fq) * 2) = (v2u){pk2(yy[0], yy[1]), pk2(yy[2], yy[3])}; }
#pragma unroll
    for (int ti = 0; ti < NT; ++ti) { const v2u w = trld(ys + ti * 512 + ((4 * fq + (fr >> 2)) * 16 + 4 * (fr & 3)) * 2); __hip_atomic_store((GAS unsigned long long*)(yrow + (size_t)fr * 1024 + 16 * (vt0 + ti) + 4 * fq), __builtin_bit_cast(unsigned long long, w), __ATOMIC_RELAXED, __HIP_MEMORY_SCOPE_AGENT); }
}
#ifndef SCAN_WMAP
#define SCAN_WMAP 0x76543210u
#endif
__device__ __forceinline__ void rwkv_scan_chunked(Frame& F, const In& I, const bf16* R, const bf16* Kt, const bf16* V, const bf16* AA, const bf16* EW, bf16* Y, gu32* prog) {
    const int lane = LANE_, fr = lane & 15, fq = lane >> 4;
    const int lw = (int)((SCAN_WMAP >> (4 * F.wave)) & 7u);
    LAS unsigned char* L = F.lds;
    const f32x4 zero4 = (f32x4){0.f, 0.f, 0.f, 0.f};
    for (int un = blockIdx.x; un < NB * 16; un += F.G) {
        const int h = un & 15, b = un >> 4; const size_t rowb = (size_t)b * SEQ;
        if (lw == 0) { ((LAS float*)(L + CH_KTAB))[lane] = ((const GAS float*)I.rwkv_kk)[h * 64 + lane]; ((LAS float*)(L + CH_KTAB + 256))[lane] = ((const GAS float*)I.rwkv_ka)[h * 64 + lane]; }
        LBAR();
        if (lw >= CH_NS) {
            const int p = lw - CH_NS; const int colb = h * 64 + 16 * fq;
            v4u raw[10];
#define CK_LOAD(cidx) do { const size_t off = (rowb + (size_t)(cidx) * 16 + fr) * 1024 + colb; \
                raw[0] = *(const GAS v4u*)(R + off); raw[1] = *(const GAS v4u*)(R + off + 8); raw[2] = *(const GAS v4u*)(Kt + off); raw[3] = *(const GAS v4u*)(Kt + off + 8); raw[4] = *(const GAS v4u*)(V + off); raw[5] = *(const GAS v4u*)(V + off + 8); \
                raw[6] = *(const GAS v4u*)(AA + off); raw[7] = *(const GAS v4u*)(AA + off + 8); raw[8] = *(const GAS v4u*)(EW + off); raw[9] = *(const GAS v4u*)(EW + off + 8); } while (0)
#ifdef SCAN_STAMP
            unsigned long long st_[7] = {0, 0, 0, 0, 0, 0, 0};
#ifndef SCAN_STAMP_P
#define SCAN_STAMP_P 0
#endif
#ifndef SCAN_STAMP_RD
#define SCAN_STAMP_RD 20
#endif
#ifndef SCAN_STAMP_B
#define SCAN_STAMP_B 0
#endif
#define STAMP(i) do { if ((SCAN_STAMP_B < 0 || blockIdx.x == SCAN_STAMP_B) && p == SCAN_STAMP_P && rd == SCAN_STAMP_RD) st_[i] = __builtin_amdgcn_s_memtime(); } while (0)
#else
#define STAMP(i) do { } while (0)
#endif
            CK_LOAD(p);
            for (int rd = -1; rd < CH_ROUNDS - 1; ++rd) {
                const int cidx = CH_NP * (rd + 1) + p; LAS unsigned char* S = L + (((rd + 1) & 1) * CH_NP + p) * GS_SLOT;
                if (cidx < 512) {
                STAMP(0);
                float r[16], k[16], a[16], ew[16]; const v4u vraw0 = raw[4], vraw1 = raw[5];
                { float t8[8];
                  unpack8(raw[0], t8);
#pragma unroll
                  for (int e = 0; e < 8; ++e) r[e] = t8[e];
                  unpack8(raw[1], t8);
#pragma unroll
                  for (int e = 0; e < 8; ++e) r[8 + e] = t8[e];
                  unpack8(raw[2], t8);
#pragma unroll
                  for (int e = 0; e < 8; ++e) k[e] = t8[e];
                  unpack8(raw[3], t8);
#pragma unroll
                  for (int e = 0; e < 8; ++e) k[8 + e] = t8[e];
                  unpack8(raw[6], t8);
#pragma unroll
                  for (int e = 0; e < 8; ++e) a[e] = t8[e];
                  unpack8(raw[7], t8);
#pragma unroll
                  for (int e = 0; e < 8; ++e) a[8 + e] = t8[e];
                  unpack8(raw[8], t8);
#pragma unroll
                  for (int e = 0; e < 8; ++e) ew[e] = t8[e];
                  unpack8(raw[9], t8);
#pragma unroll
                  for (int e = 0; e < 8; ++e) ew[8 + e] = t8[e]; }
#if defined(SCAN_STAMP) && defined(SCAN_STAMP_LD)
                asm volatile("s_waitcnt vmcnt(0)" ::: "memory"); STAMP(1);
#endif
                if (cidx + CH_NP < 512) CK_LOAD(cidx + CH_NP);
                float kx[16], ss = 0.f;
#pragma unroll
                for (int e4 = 0; e4 < 4; ++e4) { const f32x4 c0_ = *(const LAS f32x4*)(L + CH_KTAB + (16 * fq + 4 * e4) * 4), c1_ = *(const LAS f32x4*)(L + CH_KTAB + 256 + (16 * fq + 4 * e4) * 4);
#pragma unroll
                    for (int z = 0; z < 4; ++z) { const int ee = 4 * e4 + z; kx[ee] = k[ee] * c0_[z]; ss += kx[ee] * kx[ee]; k[ee] = k[ee] * (1.0f + (a[ee] - 1.0f) * c1_[z]); } }
                ss += __shfl_xor(ss, 16); ss += __shfl_xor(ss, 32);
                const float inv = __builtin_amdgcn_rsqf(fmaxf(ss, 1e-24f));
                unsigned qtw[8], rtw[8], ktw[8], btw[8], bhw[8], khw[8];
                {
                    float li[16], e15[16], ep[16];
#pragma unroll
                    for (int e = 0; e < 16; ++e) li[e] = -ew[e];
#pragma unroll
                    for (int e = 0; e < 16; ++e) li[e] += dpp_shr<1>(li[e]);
#pragma unroll
                    for (int e = 0; e < 16; ++e) li[e] += dpp_shr<2>(li[e]);
#pragma unroll
                    for (int e = 0; e < 16; ++e) li[e] += dpp_shr<4>(li[e]);
#pragma unroll
                    for (int e = 0; e < 16; ++e) li[e] += dpp_shr<8>(li[e]);
#pragma unroll
                    for (int e = 0; e < 16; ++e) li[e] = __builtin_amdgcn_exp2f(1.4426950408889634f * li[e]);
#pragma unroll
                    for (int e = 0; e < 16; ++e) e15[e] = __shfl(li[e], (lane & 48) | 15);
#pragma unroll
                    for (int e = 0; e < 16; ++e) ep[e] = __builtin_bit_cast(float, __builtin_amdgcn_update_dpp(0x3f800000, __builtin_bit_cast(int, li[e]), 0x111, 0xf, 0xf, false));
                    if (fr == 15) {
#pragma unroll
                        for (int e4 = 0; e4 < 4; ++e4) *(LAS f32x4*)(S + GS_DD + (16 * fq + 4 * e4) * 4) = (f32x4){li[4 * e4], li[4 * e4 + 1], li[4 * e4 + 2], li[4 * e4 + 3]}; }
#pragma unroll
                    for (int e = 0; e < 16; e += 2) { float q2[2], r2[2], k2[2], b2[2], b2h[2], k2h[2];
#pragma unroll
                        for (int z = 0; z < 2; ++z) { const int ee = e + z;
                            const float Einv = __builtin_amdgcn_rcpf(li[ee]);
                            const float kk = kx[ee] * inv, bb = a[ee] * kk;
                            q2[z] = kk * ep[ee]; k2[z] = k[ee] * Einv; b2[z] = bb * Einv; r2[z] = r[ee] * li[ee];
                            b2h[z] = b2[z] * e15[ee]; k2h[z] = k2[z] * e15[ee]; }
                        qtw[e >> 1] = pk2(q2[0], q2[1]); rtw[e >> 1] = pk2(r2[0], r2[1]); ktw[e >> 1] = pk2(k2[0], k2[1]); btw[e >> 1] = pk2(b2[0], b2[1]); bhw[e >> 1] = pk2(b2h[0], b2h[1]); khw[e >> 1] = pk2(k2h[0], k2h[1]);
 } }
                { const int ov = tokoff2(fr, 2 * fq); *(LAS v4u*)(S + GS_VT + ov) = vraw0; *(LAS v4u*)(S + GS_VT + ov + 16) = vraw1; }
                { const int o = tokoff(fr, 2 * fq), o2 = o ^ 16;
                  *(LAS v4u*)(S + GS_QT + o) = (v4u){qtw[0], qtw[1], qtw[2], qtw[3]}; *(LAS v4u*)(S + GS_QT + o2) = (v4u){qtw[4], qtw[5], qtw[6], qtw[7]};
                  *(LAS v4u*)(S + GS_RT + o) = (v4u){rtw[0], rtw[1], rtw[2], rtw[3]}; *(LAS v4u*)(S + GS_RT + o2) = (v4u){rtw[4], rtw[5], rtw[6], rtw[7]};
                  *(LAS v4u*)(S + GS_KT + o) = (v4u){ktw[0], ktw[1], ktw[2], ktw[3]}; *(LAS v4u*)(S + GS_KT + o2) = (v4u){ktw[4], ktw[5], ktw[6], ktw[7]};
                  *(LAS v4u*)(S + GS_BT + o) = (v4u){btw[0], btw[1], btw[2], btw[3]}; *(LAS v4u*)(S + GS_BT + o2) = (v4u){btw[4], btw[5], btw[6], btw[7]}; }
                asm volatile("s_waitcnt lgkmcnt(0)" ::: "memory");
#if !defined(SCAN_STAMP_LD)
                STAMP(1);
#endif
                f32x4 mb = zero4, mbt = zero4, mkt = zero4, nbt = zero4, nkt = zero4;
#pragma unroll
                for (int kh = 0; kh < 2; ++kh) { const int o = tokoff(fr, 4 * kh + fq);
                    const bf16x8 Qf = *(const LAS bf16x8*)(S + GS_QT + o), Rf = *(const LAS bf16x8*)(S + GS_RT + o), Kf = *(const LAS bf16x8*)(S + GS_KT + o), Bf = *(const LAS bf16x8*)(S + GS_BT + o);
                    mb = __builtin_amdgcn_mfma_f32_16x16x32_bf16(Qf, Bf, mb, 0, 0, 0); mbt = __builtin_amdgcn_mfma_f32_16x16x32_bf16(Bf, Qf, mbt, 0, 0, 0);
                    mkt = __builtin_amdgcn_mfma_f32_16x16x32_bf16(Kf, Qf, mkt, 0, 0, 0);
                    nbt = __builtin_amdgcn_mfma_f32_16x16x32_bf16(Bf, Rf, nbt, 0, 0, 0); nkt = __builtin_amdgcn_mfma_f32_16x16x32_bf16(Kf, Rf, nkt, 0, 0, 0); }
                asm volatile("s_waitcnt lgkmcnt(0)" ::: "memory");
                STAMP(2);
                { const int oh = tokoff2(fr, 2 * fq);
                  *(LAS v4u*)(S + GS_BHT + oh) = (v4u){bhw[0], bhw[1], bhw[2], bhw[3]}; *(LAS v4u*)(S + GS_BHT + oh + 16) = (v4u){bhw[4], bhw[5], bhw[6], bhw[7]};
                  *(LAS v4u*)(S + GS_KHT + oh) = (v4u){khw[0], khw[1], khw[2], khw[3]}; *(LAS v4u*)(S + GS_KHT + oh + 16) = (v4u){khw[4], khw[5], khw[6], khw[7]}; }
                { f32x4 nAf, nDf, iD, mkm, nkm, nbm;
#pragma unroll
                  for (int e = 0; e < 4; ++e) { const int tt = 4 * fq + e; const bool lo = fr < tt, up = tt < fr, ue = tt <= fr;
                      nAf[e] = lo ? -mb[e] : 0.f; nDf[e] = up ? -mbt[e] : 0.f; iD[e] = (tt == fr) ? 1.0f : 0.0f;
                      mkm[e] = up ? mkt[e] : 0.f; nkm[e] = ue ? nkt[e] : 0.f; nbm[e] = ue ? nbt[e] : 0.f; }
                  const int om = (fr * 16 + 4 * fq) * 2;
                  *(LAS v2u*)(S + GS_MK + om) = (v2u){pk2(mkm[0], mkm[1]), pk2(mkm[2], mkm[3])}; *(LAS v2u*)(S + GS_NK + om) = (v2u){pk2(nkm[0], nkm[1]), pk2(nkm[2], nkm[3])};
                  *(LAS v2u*)(S + GS_NB + om) = (v2u){pk2(nbm[0], nbm[1]), pk2(nbm[2], nbm[3])};
                  STAMP(3);
                  const bf16x8 nA = cvt8z(nAf), nD = cvt8z(nDf);
                  const f32x4 n2D = __builtin_amdgcn_mfma_f32_16x16x32_bf16(nA, nD, zero4, 0, 0, 0), n2A = __builtin_amdgcn_mfma_f32_16x16x32_bf16(nD, nA, zero4, 0, 0, 0);
                  const bf16x8 n2Db = cvt8z(n2D), n2Ab = cvt8z(n2A);
                  const f32x4 n4D = __builtin_amdgcn_mfma_f32_16x16x32_bf16(n2Ab, n2Db, zero4, 0, 0, 0), n4A = __builtin_amdgcn_mfma_f32_16x16x32_bf16(n2Db, n2Ab, zero4, 0, 0, 0);
                  f32x4 Tt = __builtin_amdgcn_mfma_f32_16x16x32_bf16(nA, n2Db, iD + nDf + n2D, 0, 0, 0);
                  const bf16x8 n4Db = cvt8z(n4D), n4Ab = cvt8z(n4A);
                  const f32x4 n8A = __builtin_amdgcn_mfma_f32_16x16x32_bf16(n4Db, n4Ab, zero4, 0, 0, 0);
                  Tt = __builtin_amdgcn_mfma_f32_16x16x32_bf16(n4Ab, cvt8z(Tt), Tt, 0, 0, 0);
                  Tt = __builtin_amdgcn_mfma_f32_16x16x32_bf16(cvt8z(n8A), cvt8z(Tt), Tt, 0, 0, 0);
                  STAMP(4);
                  *(LAS v2u*)(S + GS_TM + om) = (v2u){pk2(Tt[0], Tt[1]), pk2(Tt[2], Tt[3])}; }
                STAMP(5);
                }
                LBAR();
                STAMP(6);
            }
            LBAR();
#ifdef SCAN_STAMP
            if ((SCAN_STAMP_B < 0 || blockIdx.x == SCAN_STAMP_B) && p == SCAN_STAMP_P) { const unsigned long long d_ = (SCAN_STAMP == 0) ? st_[6] - st_[0] : (SCAN_STAMP == 7) ? st_[5] - st_[0] : st_[SCAN_STAMP] - st_[SCAN_STAMP - 1]; const unsigned long long t0_ = __builtin_amdgcn_s_memtime();
                while (__builtin_amdgcn_s_memtime() - t0_ < d_ * 512ull) __builtin_amdgcn_s_sleep(8); }
#endif
#undef CK_LOAD
        } else {
            const int vtA = (CH_NS == 4) ? lw : ((lw == 0) ? 0 : lw + 1);
            f32x4 A2[2][4];
#ifdef SCAN_PRIO
            __builtin_amdgcn_s_setprio(SCAN_PRIO);
#endif
#pragma unroll
            for (int jt = 0; jt < 4; ++jt) { A2[0][jt] = zero4; A2[1][jt] = zero4; }
            const int trb = 4 * fq + (fr >> 2), trc = (fr >> 1) & 1, trl = 8 * (fr & 1);
            LAS unsigned char* ys = L + TB_OFF + lw * 1024;
#ifdef SCAN_SSTAMP
            unsigned long long ss0_ = 0, ss1_ = 0;
#endif
            LBAR();
            const int vt0 = (CH_NS == 3 && lw == 0) ? 0 : vtA; const bool two = (CH_NS == 3 && lw == 0);
            for (int rd = 0; rd < CH_ROUNDS; ++rd) {
                const int c0 = CH_NP * rd; const LAS unsigned char* C0 = L + ((rd & 1) * CH_NP) * GS_SLOT;
                ChOps opA, opB; v2u vA0, vA1, vB0, vB1;
#define CH_FETCH(OP, V0, V1, q_) do { const LAS unsigned char* C_ = C0 + (q_) * GS_SLOT; chain_load(OP, C_, fr, fq); V0 = trld(C_ + GS_VT + tokoff2(trb, 2 * vt0 + trc) + trl); \
                    if (two) V1 = trld(C_ + GS_VT + tokoff2(trb, 2 + trc) + trl); } while (0)
#define CH_ITER(q_, CUR, U0, U1, NXT, W0, W1) do { if ((q_) < CH_NP) { const int cidx = c0 + (q_); \
                    if ((q_) + 1 < CH_NP && cidx + 1 < 512) CH_FETCH(NXT, W0, W1, (q_) + 1); \
                    if (cidx < 512) { GAS bf16* yrow = (GAS bf16*)Y + (rowb + (size_t)cidx * 16) * 1024 + h * 64; \
                        if (two) chain_step<2>(CUR, C0 + (q_) * GS_SLOT, U0, U1, A2, 0, fr, fq, yrow, ys); \
                        else chain_step<1>(CUR, C0 + (q_) * GS_SLOT, U0, U0, A2, vtA, fr, fq, yrow, ys); } } } while (0)
                vA1 = (v2u){0u, 0u}; vB1 = (v2u){0u, 0u};
                if (c0 < 512) CH_FETCH(opA, vA0, vA1, 0);
                CH_ITER(0, opA, vA0, vA1, opB, vB0, vB1);
                CH_ITER(1, opB, vB0, vB1, opA, vA0, vA1);
                CH_ITER(2, opA, vA0, vA1, opB, vB0, vB1);
                CH_ITER(3, opB, vB0, vB1, opA, vA0, vA1);
                CH_ITER(4, opA, vA0, vA1, opB, vB0, vB1);
                CH_ITER(5, opB, vB0, vB1, opA, vA0, vA1);
#undef CH_ITER
#undef CH_FETCH
                asm volatile("s_waitcnt vmcnt(0)" ::: "memory");
                LBAR();
                if (lw == 0 && lane == 0) __hip_atomic_fetch_add((GAS unsigned*)(prog + b * CH_ROUNDS + rd), 1u, __ATOMIC_RELAXED, __HIP_MEMORY_SCOPE_AGENT);
            }
#ifdef SCAN_SSTAMP
            if (lw == SCAN_SSTAMP_W) { const unsigned long long d_ = (ss1_ - ss0_) * 512ull, t0_ = __builtin_amdgcn_s_memtime(); while (__builtin_amdgcn_s_memtime() - t0_ < d_) __builtin_amdgcn_s_sleep(8); }
#endif
#ifdef SCAN_PRIO
            __builtin_amdgcn_s_setprio(0);
#endif
        }
    }
}
__device__ __forceinline__ void rwkv_post_pass(Frame& F, const In& I, const bf16* R, const bf16* Kt, const bf16* V, const bf16* AA, const bf16* G, bf16* Y, const int tbeg, const int tend, const int tstep) {
    const int col = LANE_ * 16;
    for (int t0 = tbeg; t0 < tend; t0 += tstep) {
        v4u py[2][2], pr[2][2], pk[2][2], pv[2][2], pa[2][2], pg[2][2];
#pragma unroll
        for (int rw = 0; rw < 2; ++rw) { const size_t off = (size_t)(t0 + rw) * 1024 + col;
#pragma unroll
            for (int hf = 0; hf < 2; ++hf) { py[rw][hf] = *(const v4u*)(Y + off + hf * 8); pr[rw][hf] = *(const v4u*)(R + off + hf * 8); pk[rw][hf] = *(const v4u*)(Kt + off + hf * 8);
                pv[rw][hf] = *(const v4u*)(V + off + hf * 8); pa[rw][hf] = *(const v4u*)(AA + off + hf * 8); pg[rw][hf] = *(const v4u*)(G + off + hf * 8); } }
#pragma unroll
        for (int rw = 0; rw < 2; ++rw) { const size_t off = (size_t)(t0 + rw) * 1024 + col;
            float kaw[16], rkw[16], lng[16], lnb[16];
#pragma unroll
            for (int e4 = 0; e4 < 4; ++e4) { const f32x4 c0 = *(const GAS f32x4*)(I.rwkv_ka + col + 4 * e4), c1 = *(const GAS f32x4*)(I.rwkv_rk + col + 4 * e4), c2 = *(const GAS f32x4*)(I.rwkv_ln_g + col + 4 * e4), c3 = *(const GAS f32x4*)(I.rwkv_ln_b + col + 4 * e4);
#pragma unroll
                for (int e = 0; e < 4; ++e) { kaw[4 * e4 + e] = c0[e]; rkw[4 * e4 + e] = c1[e]; lng[4 * e4 + e] = c2[e]; lnb[4 * e4 + e] = c3[e]; } }
            float y[16], r[16], k[16], v[16], a[16], g[16];
#pragma unroll
            for (int hf = 0; hf < 2; ++hf) { float t8[8];
                unpack8(py[rw][hf], t8);
#pragma unroll
                for (int e = 0; e < 8; ++e) y[hf * 8 + e] = t8[e];
                unpack8(pr[rw][hf], t8);
#pragma unroll
                for (int e = 0; e < 8; ++e) r[hf * 8 + e] = t8[e];
                unpack8(pk[rw][hf], t8);
#pragma unroll
                for (int e = 0; e < 8; ++e) k[hf * 8 + e] = t8[e];
                unpack8(pv[rw][hf], t8);
#pragma unroll
                for (int e = 0; e < 8; ++e) v[hf * 8 + e] = t8[e];
                unpack8(pa[rw][hf], t8);
#pragma unroll
                for (int e = 0; e < 8; ++e) a[hf * 8 + e] = t8[e];
                unpack8(pg[rw][hf], t8);
#pragma unroll
                for (int e = 0; e < 8; ++e) g[hf * 8 + e] = t8[e]; }
            float s = 0.f, bs = 0.f;
#pragma unroll
            for (int e = 0; e < 16; ++e) { s += y[e]; const float kp = k[e] * (1.0f + (a[e] - 1.0f) * kaw[e]); bs += r[e] * kp * rkw[e]; }
            s += __shfl_xor(s, 1); s += __shfl_xor(s, 2); bs += __shfl_xor(bs, 1); bs += __shfl_xor(bs, 2);
            const float mean = s * (1.0f / 64.0f); float q = 0.f;
#pragma unroll
            for (int e = 0; e < 16; ++e) { const float dd = y[e] - mean; q += dd * dd; }
            q += __shfl_xor(q, 1); q += __shfl_xor(q, 2);
            const float rstd = 1.0f / sqrtf(q * (1.0f / 64.0f) + 64e-5f);
            float o[16];
#pragma unroll
            for (int e = 0; e < 16; ++e) o[e] = ((y[e] - mean) * rstd * lng[e] + lnb[e] + bs * v[e]) * g[e];
            v4u w0, w1; w0.x = pk2(o[0], o[1]); w0.y = pk2(o[2], o[3]); w0.z = pk2(o[4], o[5]); w0.w = pk2(o[6], o[7]); w1.x = pk2(o[8], o[9]); w1.y = pk2(o[10], o[11]); w1.z = pk2(o[12], o[13]); w1.w = pk2(o[14], o[15]);
            *(v4u*)(Y + off) = w0; *(v4u*)(Y + off + 8) = w1; }
    }
}

#ifndef DUP_K
#define DUP_K (-1)
#endif
#ifndef DUP_K2
#define DUP_K2 (-1)
#endif
#define KARGS ((const __attribute__((address_space(4))) Args*)__builtin_amdgcn_kernarg_segment_ptr())
#define WSPTRS \
    bf16* H0 = (bf16*)(ws + WS_H0); bf16* QKV = (bf16*)(ws + WS_QKV); bf16* OB = (bf16*)(ws + WS_O); f32x2* AGG = (f32x2*)(ws + WS_LRUAGG); \
    bf16* H2 = (bf16*)(ws + WS_H2); float* LOG = (float*)(ws + WS_LOG); unsigned char* RTE = ws + WS_ROUTE; bf16* HID = (bf16*)(ws + WS_HID); bf16* YS = (bf16*)(ws + WS_YS); bf16* PP = (bf16*)(ws + WS_PP); \
    bf16* HCAT = (bf16*)(ws + WS_HCAT); bf16* RB = (bf16*)(ws + WS_R); bf16* KB = (bf16*)(ws + WS_K); bf16* VB = (bf16*)(ws + WS_V); bf16* XRB = (bf16*)(ws + WS_XR); bf16* XKB = (bf16*)(ws + WS_XK); bf16* XVB = (bf16*)(ws + WS_XV); bf16* MID = (bf16*)(ws + WS_MID); bf16* EWB = (bf16*)(ws + WS_EW); bf16* AAB = (bf16*)(ws + WS_AA); bf16* YB = (bf16*)(ws + WS_Y); \
    const size_t TD = (size_t)T * 1024; (void)H0; (void)QKV; (void)OB; (void)AGG; (void)H2; (void)LOG; (void)RTE; (void)HID; (void)YS; (void)PP; (void)HCAT; (void)RB; (void)KB; (void)VB; (void)XRB; (void)XKB; (void)XVB; (void)MID; (void)EWB; (void)AAB; (void)YB; (void)TD;

struct Args { In in; float* out; unsigned char* ws; int ph_lo, ph_hi; };
constexpr int N_PHASES = 34;
__device__ __forceinline__ int nrep(int k) { int n = (k == DUP_K) ? 2 : 1; if (DUP_K >= 0) asm volatile("" : "+s"(n)); return n; }
#define REP_SYNC if (rep_) __syncthreads();
typedef const __attribute__((address_space(4))) unsigned long long* kp64;
__device__ __forceinline__ void load_in(In& I) { kp64 s = (kp64)__builtin_amdgcn_kernarg_segment_ptr(); unsigned long long* d = (unsigned long long*)&I;
#pragma unroll
    for (int i = 0; i < 47; ++i) d[i] = s[i]; }

__device__ __forceinline__ int t5_bucket(int n) { if (n < 16) return n; const float v = logf((float)n / 16.0f) / 2.0794415416798357f * 16.0f; const int l = 16 + (int)v; return l < 31 ? l : 31; }

template <class Epi>
__device__ __forceinline__ void dense_gemm(Frame& F, const void* A, int lda, const void* B, int K, int M, int N, const Epi& E) {
    pg8::DenseOrder S; S.init(A, lda, B, K, M, N, F.G, (int)blockIdx.x);
    pg8::gemm_phase<Epi, pg8::DenseOrder, true, false>(F.lds, K, lda, S, E, nullptr, TID_);
}

__global__ void __launch_bounds__(NWAVES * 64, 2) mk_fwd(Args args) {
    extern __shared__ __attribute__((aligned(16))) unsigned char lds[];
    Frame F;
    F.lds = (LAS unsigned char*)lds;
    F.MISC = (volatile LAS unsigned*)(F.lds + MISC_OFF);
    { int w_ = __builtin_amdgcn_readfirstlane((int)threadIdx.x >> 6); asm volatile("" : "+s"(w_)); F.wave = w_; }
    F.G = gridDim.x; { const int bx = blockIdx.x; F.vcu = (F.G % 8 == 0) ? (bx % 8) * (F.G / 8) + bx / 8 : bx; }
    F.ctl = (gu32*)(KARGS->ws + WS_CTL);
    for (int u = TID_; u < (LDS_BYTES - LDSCTL_OFF) / 4; u += NWAVES * 64) ((LAS unsigned*)(F.lds + LDSCTL_OFF))[u] = 0u;
    __syncthreads();
    {
        LAS float* tb = (LAS float*)(F.lds + TB_OFF); const int h = TID_ >> 7, i = TID_ & 127;
        const float* rb = KARGS->in.rel_bias;
        tb[h * 128 + i] = (rb[t5_bucket(i) * 4 + h] - rb[31 * 4 + h]) * 1.4426950408889634f;
    }
    __syncthreads();
    const int lo = KARGS->ph_lo, hi = KARGS->ph_hi;
    const bool multi = (hi - lo) > 1;
    XcdBarrier bar; bar.bar = (unsigned*)(F.ctl + CW_BAR); bar.x = 0; bar.st = nullptr;
    if (multi) bar = xcd_barrier_post((unsigned*)(F.ctl + CW_BAR), F.MISC + 8, TID_ == 0);
#define IN(k) (lo <= (k) && (k) < hi)
#define PH_BEGIN_ unsigned char* ws = KARGS->ws; bf16* X = (bf16*)KARGS->out; float* OUT = KARGS->out; (void)OUT; bf16* GB2 = (bf16*)KARGS->out + (size_t)T * 1024; (void)GB2; In I; load_in(I); (void)X; WSPTRS
#define SEAM(k) do { if (IN(k) && IN((k) + 1)) xcd_barrier(bar, TID_ == 0); } while (0)

    if (IN(0)) { PH_BEGIN_ prep_dense_weights(F, I, ws); prep_layer_weights(F, I, ws, 0); norm_pass<false>(F, I.x, I.norm_mix, H0);
#ifdef DUP_PREP
        __syncthreads(); prep_dense_weights(F, I, ws); prep_layer_weights(F, I, ws, 0);
#endif
    } SEAM(0);
    if (IN(1)) { PH_BEGIN_ pg8::EpiBf16 E{QKV, 512, 512, (size_t)T * 512, attn_body::C2}; dense_gemm(F, H0, 1024, ws + WS_WIN, 1024, T, AB_IN, E); } SEAM(1);
    if (IN(2)) { PH_BEGIN_ lru_agg_mfma(F, I, QKV + 3 * (size_t)T * 512, AGG, (bf16*)(ws + WS_HL), (bf16*)(ws + WS_CA)); } SEAM(2);
    if (IN(3)) { PH_BEGIN_
        const attn_body::AttnTensors AT{(const attn_body::bf16*)QKV, (const attn_body::bf16*)(QKV + (size_t)T * 512), (const attn_body::bf16*)(QKV + 2 * (size_t)T * 512), (attn_body::bf16*)OB};
        if (F.G == 256) attn_body::attn_phase<8>((char*)lds, AT, F.vcu, (const LAS float*)(F.lds + TB_OFF), (int)threadIdx.x);
#ifdef DUP_ATTN
        __syncthreads(); if (F.G == 256) attn_body::attn_phase<8>((char*)lds, AT, F.vcu, (const LAS float*)(F.lds + TB_OFF), (int)threadIdx.x);
#endif
        __syncthreads();
        lru_final_pass(F, (const bf16*)(ws + WS_HL), (const bf16*)(ws + WS_CA), QKV + 4 * (size_t)T * 512, AGG, H0);
    } SEAM(3);
    if (IN(4)) { PH_BEGIN_ diff_combine_pass(F, I, OB, H0); } SEAM(4);
    if (IN(5)) { PH_BEGIN_ pg8::EpiResX<false> E{I.x, X}; dense_gemm(F, H0, 1024, ws + WS_WOUT, 1024, T, 1024, E); } SEAM(5);

#define MOE_PLE_PHASES(P, L) \
    if (IN(P + 0)) { PH_BEGIN_ norm_pass<true>(F, X, I.norm_ffn + (L) * 1024, H2); } SEAM(P + 0); \
    if (IN(P + 1)) { PH_BEGIN_ pg8::EpiRouter E{LOG}; dense_gemm(F, H2, 1024, ws + WS_ROUT + (size_t)(L) * 256 * 1024 * 2, 1024, T, 256, E); } SEAM(P + 1); \
    if (IN(P + 2)) { PH_BEGIN_ route_pass_a(F, I, (L), LOG, RTE, F.ctl + ((L) ? CW_CNT1 : CW_CNT0)); } SEAM(P + 2); \
    if (IN(P + 3)) { PH_BEGIN_ route_pass_b(F, RTE, F.ctl + ((L) ? CW_CNT1 : CW_CNT0)); } SEAM(P + 3); \
    if (IN(P + 4)) { PH_BEGIN_ route_bases(F, F.ctl + ((L) ? CW_CNT1 : CW_CNT0)); const LAS int* eb = (const LAS int*)(F.lds + RTE_OFF + 512); \
        MoeOrder S{F.G, (int)blockIdx.x, __builtin_amdgcn_readfirstlane(eb[32] >> 8), eb, (const char*)H2, (const char*)(ws + WS_MGU), 0, (size_t)1024 * 1024 * 2, (size_t)256 * 1024 * 2, true}; pg8::EpiGU E{HID}; \
        pg8::gemm_phase<pg8::EpiGU, MoeOrder, true, true>(F.lds, 1024, 1024, S, E, (const int*)(RTE + RT_ROWTOK), TID_); } SEAM(P + 4); \
    if (IN(P + 5)) { PH_BEGIN_ route_bases(F, F.ctl + ((L) ? CW_CNT1 : CW_CNT0)); const LAS int* eb = (const LAS int*)(F.lds + RTE_OFF + 512); \
        MoeOrder S{F.G, (int)blockIdx.x, __builtin_amdgcn_readfirstlane(eb[32] >> 8), eb, (const char*)HID, (const char*)(ws + WS_MDN), (size_t)256 * 512 * 2, (size_t)1024 * 512 * 2, (size_t)256 * 512 * 2, false}; pg8::EpiDown E{YS, (const float*)(RTE + RT_ROWGATE)}; \
        pg8::gemm_phase<pg8::EpiDown, MoeOrder, true, false>(F.lds, 512, 512, S, E, nullptr, TID_); } SEAM(P + 5); \
    if (IN(P + 6)) { PH_BEGIN_ combine_norm_pass(F, X, X, YS, (const int*)(RTE + RT_SLOT), I.ple_norm + (L) * 1024, H2); } SEAM(P + 6); \
    if (IN(P + 7)) { PH_BEGIN_ pg8::EpiBf16 E{PP, 1024, 0, 0, 1.f}; dense_gemm(F, ws + WS_PB, 256, ws + WS_PPROJ + (size_t)(L) * 1024 * 256 * 2, 256, T, 1024, E); } SEAM(P + 7); \
    if (IN(P + 8)) { PH_BEGIN_ pg8::EpiPle E{X, (L) ? (bf16*)(ws + WS_YS) : X, PP}; dense_gemm(F, H2, 1024, ws + WS_PGATE + (size_t)(L) * 1024 * 1024 * 2, 1024, T, 1024, E); } SEAM(P + 8);

    MOE_PLE_PHASES(6, 0)
    if (IN(15)) { PH_BEGIN_ rwkv_input_pass(F, X, I.norm_mix + 1024, I.rwkv_mu, HCAT, XRB, XKB, XVB); } SEAM(15);
    if (IN(16)) { PH_BEGIN_ { pg8::EpiBf16 E{RB, 1024, 0, 0, 1.f}; dense_gemm(F, XRB, 1024, ws + WS_RCAT, 1024, T, 1024, E); }
        { pg8::EpiMid E{MID}; dense_gemm(F, HCAT, 2048, ws + WS_RL1, 2048, T, 512, E); } } SEAM(16);
    if (IN(17)) { PH_BEGIN_ pg8::EpiBf16 E{KB, 1024, 0, 0, 1.f}; dense_gemm(F, XKB, 1024, ws + WS_RCAT + (size_t)1024 * 1024 * 2, 1024, T, 1024, E); } SEAM(17);
    if (IN(18)) { PH_BEGIN_ pg8::EpiBf16 E{VB, 1024, 0, 0, 1.f}; dense_gemm(F, XVB, 1024, ws + WS_RCAT + (size_t)2 * 1024 * 1024 * 2, 1024, T, 1024, E); } SEAM(18);
    if (IN(19)) { PH_BEGIN_ pg8::EpiRwkv2 E{EWB, AAB, I.rwkv_w0, I.rwkv_a0, 0}; dense_gemm(F, MID, 512, ws + WS_RS2, 256, T, 2048, E); } SEAM(19);
    if (IN(20)) { PH_BEGIN_
        if (F.G == 256 && blockIdx.x >= 128) {
            Frame F2 = F; F2.G = 128; F2.vcu = (int)blockIdx.x - 128;
#ifdef HELP_STAMP
            const unsigned long long hs0_ = __builtin_amdgcn_s_memtime();
#endif
            prep_layer_weights(F2, I, ws, 1);
            __syncthreads();
            pg8::EpiRwkv2 E{GB2, GB2, nullptr, nullptr, 2}; pg8::DenseOrder S; S.init(MID + 256, 512, ws + WS_RS2 + (size_t)2 * 1024 * 256 * 2, 256, T, 1024, 128, (int)blockIdx.x - 128);
            pg8::gemm_phase<pg8::EpiRwkv2, pg8::DenseOrder, true, false>(F.lds, 256, 512, S, E, nullptr, TID_);
            static_assert(CH_NP == 4, "the y hand-off below counts 64-token rounds");
            asm volatile("s_waitcnt vmcnt(0)" ::: "memory"); __syncthreads();
            {
                const __attribute__((address_space(4))) Args* ka = KARGS; asm volatile("" : "+s"(ka));
                unsigned char* ws2 = ka->ws; bf16* G2 = (bf16*)ka->out + (size_t)T * 1024; gu32* ctl2 = (gu32*)(ws2 + WS_CTL);
                In I2; I2.rwkv_ka = ka->in.rwkv_ka; I2.rwkv_rk = ka->in.rwkv_rk; I2.rwkv_ln_g = ka->in.rwkv_ln_g; I2.rwkv_ln_b = ka->in.rwkv_ln_b;
                if (TID_ == 0) { __builtin_amdgcn_fence(__ATOMIC_RELEASE, "agent"); asm volatile("s_waitcnt vmcnt(0)" ::: "memory"); __hip_atomic_fetch_add(ctl2 + CW_GDONE, 1u, __ATOMIC_RELAXED, __HIP_MEMORY_SCOPE_AGENT);
                    while (__hip_atomic_load(ctl2 + CW_GDONE, __ATOMIC_RELAXED, __HIP_MEMORY_SCOPE_AGENT) < 128u) __builtin_amdgcn_s_sleep(8);
                    __builtin_amdgcn_fence(__ATOMIC_ACQUIRE, "agent"); }
                __syncthreads();
                const int hb = ((int)blockIdx.x - 128) >> 4, hs = ((int)blockIdx.x - 128) & 15;
                for (int rd = hs; rd < CH_ROUNDS; rd += 16) {
                    if (TID_ == 0) { const gu32* pw = ctl2 + CW_PROG + hb * CH_ROUNDS + rd;
                        while (__hip_atomic_load(pw, __ATOMIC_RELAXED, __HIP_MEMORY_SCOPE_AGENT) < 16u) __builtin_amdgcn_s_sleep(8);
                        __builtin_amdgcn_fence(__ATOMIC_ACQUIRE, "agent"); }
                    __syncthreads();
                    const int tb = hb * SEQ + rd * 64;
                    rwkv_post_pass(F, I2, (const bf16*)(ws2 + WS_R), (const bf16*)(ws2 + WS_K), (const bf16*)(ws2 + WS_V), (const bf16*)(ws2 + WS_AA), G2, (bf16*)(ws2 + WS_Y), tb + 2 * F.wave, tb + 64, 2 * NWAVES);
                    asm volatile("s_waitcnt vmcnt(0)" ::: "memory"); __syncthreads(); } }
        } else rwkv_scan_chunked(F, I, RB, KB, VB, AAB, EWB, YB, (gu32*)(ws + WS_CTL) + CW_PROG);
    } SEAM(20);
    if (IN(23)) { PH_BEGIN_ pg8::EpiResX<true> E{X, X}; dense_gemm(F, YB, 1024, ws + WS_RWO, 1024, T, 1024, E); } SEAM(23);
    MOE_PLE_PHASES(24, 1)
    if (IN(33)) { PH_BEGIN_ final_norm_pass(F, (const bf16*)(ws + WS_YS), OUT, I.final_norm); }
#undef IN
#undef SEAM
}

extern "C" void kernel_launch(void* const* d_in, const int* in_sizes, int n_in, void* d_out, int out_size, void* d_ws, size_t ws_size, hipStream_t stream) {
    static int ok = 0;
    if (ok == 0) {
        if (n_in != 47 || out_size != T * D || ws_size < WS_END) { fprintf(stderr, "kernel_launch: unexpected problem shape (n_in %d out %d ws %zu)\n", n_in, out_size, ws_size); ok = -1; return; }
        if (hipFuncSetAttribute((const void*)mk_fwd, hipFuncAttributeMaxDynamicSharedMemorySize, LDS_BYTES) != hipSuccess) { fprintf(stderr, "kernel_launch: hipFuncSetAttribute failed\n"); ok = -1; return; }
        int per_cu = 0;
        if (hipOccupancyMaxActiveBlocksPerMultiprocessor(&per_cu, (const void*)mk_fwd, NWAVES * 64, LDS_BYTES) != hipSuccess || per_cu < 1) fprintf(stderr, "kernel_launch: occupancy query reports %d\n", per_cu);
        (void)hipGetLastError();
        ok = 1;
    }
    if (ok < 0) return;
    (void)hipMemsetAsync((char*)d_ws + WS_CTL, 0, CTL_ZERO_BYTES, stream);
    Args a{};
    const float** ip = (const float**)&a.in;
    for (int i = 0; i < 47; ++i) ip[i] = (const float*)d_in[i];
    a.out = (float*)d_out; a.ws = (unsigned char*)d_ws;
    const int grid = 256;
#if MK_ONE_LAUNCH
    a.ph_lo = 0; a.ph_hi = N_PHASES;
    hipLaunchKernelGGL(mk_fwd, dim3(grid), dim3(NWAVES * 64), LDS_BYTES, stream, a);
#else
    for (int k = 0; k < N_PHASES; ++k) { a.ph_lo = k; a.ph_hi = k + 1; hipLaunchKernelGGL(mk_fwd, dim3(grid), dim3(NWAVES * 64), LDS_BYTES, stream, a);
        if (k == DUP_K || k == DUP_K2) hipLaunchKernelGGL(mk_fwd, dim3(grid), dim3(NWAVES * 64), LDS_BYTES, stream, a); }
#endif
}
```

```cpp
#include <hip/hip_runtime.h>
#include <hip/hip_bf16.h>
#include <cstdio>
#include <cstdint>
#include <cmath>

#ifndef MK_ONE_LAUNCH
#define MK_ONE_LAUNCH 1
#endif

#define GAS __attribute__((address_space(1)))
#define LAS __attribute__((address_space(3)))
typedef unsigned short bf16;
typedef unsigned v4u __attribute__((ext_vector_type(4)));
typedef unsigned v2u __attribute__((ext_vector_type(2)));
typedef float f32x4 __attribute__((ext_vector_type(4)));
typedef float f32x2 __attribute__((ext_vector_type(2)));
typedef short bf16x8 __attribute__((ext_vector_type(8)));
typedef GAS unsigned gu32;
#define RLX_AGENT __ATOMIC_RELAXED, __HIP_MEMORY_SCOPE_AGENT
#define LDS_WAIT() asm volatile("s_waitcnt lgkmcnt(0)" ::: "memory")
#define VM_WAIT() asm volatile("s_waitcnt vmcnt(0)" ::: "memory")
__device__ __forceinline__ unsigned f2bf(float f) { unsigned u = __builtin_bit_cast(unsigned, f); return (u + 0x7fffu + ((u >> 16) & 1u)) >> 16; }
typedef float f32x2_cv __attribute__((ext_vector_type(2))); typedef __bf16 bf16x2_cv __attribute__((ext_vector_type(2)));
__device__ __forceinline__ unsigned pk2(float lo, float hi) { const f32x2_cv v = {lo, hi}; const bf16x2_cv b = __builtin_convertvector(v, bf16x2_cv); return __builtin_bit_cast(unsigned, b); }
__device__ __forceinline__ float bflo(unsigned w) { return __uint_as_float(w << 16); }
__device__ __forceinline__ float bfhi(unsigned w) { return __uint_as_float(w & 0xffff0000u); }
__device__ __forceinline__ float bf1(bf16 h) { return __uint_as_float((unsigned)h << 16); }
__device__ __forceinline__ float sigmoidf_(float x) { return __builtin_amdgcn_rcpf(1.0f + __builtin_amdgcn_exp2f(-1.4426950408889634f * x)); }
__device__ __forceinline__ float tanhf_(float x) { return 1.0f - 2.0f * __builtin_amdgcn_rcpf(1.0f + __builtin_amdgcn_exp2f(2.885390081777927f * x)); }
__device__ __forceinline__ void fmac_(float& acc, float a, float b) { asm("v_fmac_f32 %0, %1, %2" : "+v"(acc) : "v"(a), "v"(b)); }
__device__ __forceinline__ float fma_(float a, float b, float c) { float r; asm("v_fma_f32 %0, %1, %2, %3" : "=v"(r) : "v"(a), "v"(b), "v"(c)); return r; }
__device__ __forceinline__ float mul_(float a, float b) { float r; asm("v_mul_f32 %0, %1, %2" : "=v"(r) : "v"(a), "v"(b)); return r; }
__device__ __forceinline__ float wave_sum(float v) {
#pragma unroll
    for (int o = 1; o < 64; o <<= 1) v += __shfl_xor(v, o);
    return v;
}

constexpr int NB = 8, SEQ = 8192, D = 1024, T = NB * SEQ;
constexpr int AB_IN = 2560, PLE = 256;
constexpr int NEXP = 32, EH = 512;
constexpr int MAXSLOT = 2 * T + NEXP * 256;
constexpr int MAXTILES = MAXSLOT / 256;

namespace pg8 {
#define PG8_LAS __attribute__((address_space(3)))
typedef unsigned short bf16_t;
typedef unsigned u32x4 __attribute__((ext_vector_type(4)));
typedef unsigned u32x2 __attribute__((ext_vector_type(2)));
constexpr int BM = 256, BK = 64, HALF = 128, HTB = HALF * BK * 2, STAGE_BYTES = 8 * HTB, NXCD = 8, WGM = 8;
__host__ __device__ __forceinline__ int lds_byte(int r, int c) { const int st = (r >> 4) * 2 + (c >> 5), rr = r & 15, cc = c & 31, ob = rr * 64 + cc * 2; return st * 1024 + (ob ^ (((ob >> 9) & 1) << 5)); }
__host__ __device__ __forceinline__ void stage_rc(int b, int& R, int& C) { const int st = b / 1024, sb = b % 1024, swz = sb ^ (((sb >> 9) & 1) << 5); R = (st >> 1) * 16 + swz / 64; C = (st & 1) * 32 + (swz % 64) / 2; }
__host__ __device__ __forceinline__ int perm32(int rho) { const int n = rho >> 4, i = rho & 15; return 8 * (i >> 2) + 4 * n + (i & 3); }

struct Unit { int pm, pn, aux; const char* A; const char* B; };

struct DenseOrder {
    int nM, nN, nwg, G, c; const char* A; const char* B; size_t astep, bstep;
    __device__ void init(const void* A_, int lda, const void* B_, int K, int M, int N, int G_, int c_) { nM = M / BM; nN = N / BM; nwg = nM * nN; G = G_; c = c_; A = (const char*)A_; B = (const char*)B_; astep = (size_t)BM * lda * 2; bstep = (size_t)BM * K * 2; }
    __device__ bool next(int i, Unit& u) const {
        const long L = (long)i * G + c; if (L >= nwg) return false;
        int wgid = (int)L; { const int q = nwg / NXCD, r = nwg % NXCD, xcd = wgid % NXCD, off = wgid / NXCD; wgid = (xcd < r ? xcd * (q + 1) : r * (q + 1) + (xcd - r) * q) + off; }
        const int nig = WGM * nN, gid = wgid / nig, fm = gid * WGM, gsz = (nM - fm) < WGM ? (nM - fm) : WGM;
        u.pm = fm + ((wgid % nig) % gsz); u.pn = (wgid % nig) / gsz; u.aux = 0; u.A = A + (size_t)u.pm * astep; u.B = B + (size_t)u.pn * bstep; return true;
    }
};

__device__ __forceinline__ unsigned cvt_pk_bf16(float lo, float hi) { unsigned r; asm volatile("v_cvt_pk_bf16_f32 %0, %1, %2" : "=v"(r) : "v"(lo), "v"(hi)); return r; }

typedef f32x4 Acc[2][2][4][2];

struct EpiBf16 {
    static constexpr bool PERM = true;
    bf16_t* O; int ldc; int split_cols; size_t split_stride; float scale0;
    __device__ __forceinline__ void operator()(const Acc& acc, const Unit& u, int wr, int wc, int fr, int fq) const {
        const int row0 = u.pm * BM + wr * 64 + fr; int colt = u.pn * BM; bf16_t* base = O;
        float sc = 1.f; if (split_cols) { const int t = colt / split_cols; base += (size_t)t * split_stride; colt -= t * split_cols; if (t == 0) sc = scale0; }
        const int col0 = colt + wc * 32 + 8 * fq;
#pragma unroll
        for (int ai = 0; ai < 2; ++ai)
#pragma unroll
            for (int m = 0; m < 4; ++m) { bf16_t* rowp = base + (size_t)(row0 + ai * HALF + m * 16) * ldc + col0;
#pragma unroll
                for (int bj = 0; bj < 2; ++bj) { f32x4 v0 = acc[ai][bj][m][0] * sc, v1 = acc[ai][bj][m][1] * sc;
                    u32x4 w; w.x = cvt_pk_bf16(v0[0], v0[1]); w.y = cvt_pk_bf16(v0[2], v0[3]); w.z = cvt_pk_bf16(v1[0], v1[1]); w.w = cvt_pk_bf16(v1[2], v1[3]);
                    *(u32x4*)(rowp + bj * HALF) = w; } }
    }
};
__device__ __forceinline__ void unpack8f(const u32x4 w, f32x4& lo, f32x4& hi) { lo = (f32x4){bflo(w.x), bfhi(w.x), bflo(w.y), bfhi(w.y)}; hi = (f32x4){bflo(w.z), bfhi(w.z), bflo(w.w), bfhi(w.w)}; }
template <bool BASE_BF16>
struct EpiResX {
    static constexpr bool PERM = true;
    const void* base; bf16_t* out;
    __device__ __forceinline__ void operator()(const Acc& acc, const Unit& u, int wr, int wc, int fr, int fq) const {
        const int col0 = u.pn * BM + wc * 32 + 8 * fq; GAS bf16_t* op = (GAS bf16_t*)out;
#pragma unroll
        for (int ai = 0; ai < 2; ++ai) {
            f32x4 b0[4][2], b1[4][2];
#pragma unroll
            for (int m = 0; m < 4; ++m) { const size_t off = (size_t)(u.pm * BM + ai * HALF + wr * 64 + m * 16 + fr) * 1024 + col0;
#pragma unroll
                for (int bj = 0; bj < 2; ++bj) {
                    if (BASE_BF16) { const u32x4 w = *(const GAS u32x4*)((const GAS bf16_t*)base + off + bj * HALF); unpack8f(w, b0[m][bj], b1[m][bj]); }
                    else { b0[m][bj] = *(const GAS f32x4*)((const GAS float*)base + off + bj * HALF); b1[m][bj] = *(const GAS f32x4*)((const GAS float*)base + off + bj * HALF + 4); } } }
            asm volatile("" ::: "memory");
#pragma unroll
            for (int m = 0; m < 4; ++m) { const size_t off = (size_t)(u.pm * BM + ai * HALF + wr * 64 + m * 16 + fr) * 1024 + col0;
#pragma unroll
                for (int bj = 0; bj < 2; ++bj) { const f32x4 v0 = b0[m][bj] + acc[ai][bj][m][0], v1 = b1[m][bj] + acc[ai][bj][m][1];
                    u32x4 w; w.x = cvt_pk_bf16(v0[0], v0[1]); w.y = cvt_pk_bf16(v0[2], v0[3]); w.z = cvt_pk_bf16(v1[0], v1[1]); w.w = cvt_pk_bf16(v1[2], v1[3]);
                    *(GAS u32x4*)(op + off + bj * HALF) = w; } }
            asm volatile("" ::: "memory");
        }
    }
};
struct EpiRouter {
    static constexpr bool PERM = false;
    float* out;
    __device__ __forceinline__ void operator()(const Acc& acc, const Unit& u, int wr, int wc, int fr, int fq) const {
        if (wc >= 2) return;
#pragma unroll
        for (int ai = 0; ai < 2; ++ai)
#pragma unroll
            for (int m = 0; m < 4; ++m) { const size_t off = (size_t)(u.pm * BM + ai * HALF + wr * 64 + m * 16 + fr) * 64 + wc * 32 + 4 * fq;
#pragma unroll
                for (int n = 0; n < 2; ++n) *(f32x4*)(out + off + n * 16) = acc[ai][0][m][n]; }
    }
};
struct EpiGU {
    static constexpr bool PERM = true;
    bf16_t* H;
    __device__ __forceinline__ void operator()(const Acc& acc, const Unit& u, int wr, int wc, int fr, int fq) const {
        const int col0 = u.pn * 128 + wc * 32 + 8 * fq;
#pragma unroll
        for (int ai = 0; ai < 2; ++ai)
#pragma unroll
            for (int m = 0; m < 4; ++m) { bf16_t* rowp = H + (size_t)(u.pm * BM + ai * HALF + wr * 64 + m * 16 + fr) * EH + col0;
                f32x4 g0 = acc[ai][0][m][0], g1 = acc[ai][0][m][1]; const f32x4 u0 = acc[ai][1][m][0], u1 = acc[ai][1][m][1];
#pragma unroll
                for (int e = 0; e < 4; ++e) { g0[e] = g0[e] * sigmoidf_(g0[e]) * u0[e]; g1[e] = g1[e] * sigmoidf_(g1[e]) * u1[e]; }
                u32x4 w; w.x = cvt_pk_bf16(g0[0], g0[1]); w.y = cvt_pk_bf16(g0[2], g0[3]); w.z = cvt_pk_bf16(g1[0], g1[1]); w.w = cvt_pk_bf16(g1[2], g1[3]);
                *(u32x4*)rowp = w; }
    }
};
struct EpiDown {
    static constexpr bool PERM = true;
    bf16_t* Y; const float* gate;
    __device__ __forceinline__ void operator()(const Acc& acc, const Unit& u, int wr, int wc, int fr, int fq) const {
        const int col0 = u.pn * BM + wc * 32 + 8 * fq;
#pragma unroll
        for (int ai = 0; ai < 2; ++ai)
#pragma unroll
            for (int m = 0; m < 4; ++m) { const int row = u.pm * BM + ai * HALF + wr * 64 + m * 16 + fr; const float sc = gate[row]; bf16_t* rowp = Y + (size_t)row * 1024 + col0;
#pragma unroll
                for (int bj = 0; bj < 2; ++bj) { const f32x4 v0 = acc[ai][bj][m][0] * sc, v1 = acc[ai][bj][m][1] * sc;
                    u32x4 w; w.x = cvt_pk_bf16(v0[0], v0[1]); w.y = cvt_pk_bf16(v0[2], v0[3]); w.z = cvt_pk_bf16(v1[0], v1[1]); w.w = cvt_pk_bf16(v1[2], v1[3]);
                    *(u32x4*)(rowp + bj * HALF) = w; } }
    }
};
struct EpiPle {
    static constexpr bool PERM = true;
    const bf16_t* xin; bf16_t* xout; const bf16_t* pp;
    __device__ __forceinline__ void operator()(const Acc& acc, const Unit& u, int wr, int wc, int fr, int fq) const {
        const int col0 = u.pn * BM + wc * 32 + 8 * fq;
        const GAS bf16_t* xp = (const GAS bf16_t*)xin; GAS bf16_t* op = (GAS bf16_t*)xout; const GAS bf16_t* pq = (const GAS bf16_t*)pp;
#pragma unroll
        for (int ai = 0; ai < 2; ++ai) {
            u32x4 xw[4][2], pw[4][2];
#pragma unroll
            for (int m = 0; m < 4; ++m) { const size_t off = (size_t)(u.pm * BM + ai * HALF + wr * 64 + m * 16 + fr) * 1024 + col0;
#pragma unroll
                for (int bj = 0; bj < 2; ++bj) { xw[m][bj] = *(const GAS u32x4*)(xp + off + bj * HALF); pw[m][bj] = *(const GAS u32x4*)(pq + off + bj * HALF); } }
            asm volatile("" ::: "memory");
#pragma unroll
            for (int m = 0; m < 4; ++m) { const size_t off = (size_t)(u.pm * BM + ai * HALF + wr * 64 + m * 16 + fr) * 1024 + col0;
#pragma unroll
                for (int bj = 0; bj < 2; ++bj) { f32x4 x0, x1, p0, p1; unpack8f(xw[m][bj], x0, x1); unpack8f(pw[m][bj], p0, p1); const f32x4 a0 = acc[ai][bj][m][0], a1 = acc[ai][bj][m][1];
#pragma unroll
                    for (int e = 0; e < 4; ++e) { x0[e] += p0[e] * sigmoidf_(a0[e]); x1[e] += p1[e] * sigmoidf_(a1[e]); }
                    u32x4 w; w.x = cvt_pk_bf16(x0[0], x0[1]); w.y = cvt_pk_bf16(x0[2], x0[3]); w.z = cvt_pk_bf16(x1[0], x1[1]); w.w = cvt_pk_bf16(x1[2], x1[3]);
                    *(GAS u32x4*)(op + off + bj * HALF) = w; } }
            asm volatile("" ::: "memory");
        }
    }
};
struct EpiMid {
    static constexpr bool PERM = true;
    bf16_t* MID;
    __device__ __forceinline__ void operator()(const Acc& acc, const Unit& u, int wr, int wc, int fr, int fq) const {
        const int row0 = u.pm * BM + wr * 64 + fr;
        const int mode = (u.pn == 1) ? 2 : 0; const int colbase = u.pn * 256;
#pragma unroll
        for (int ai = 0; ai < 2; ++ai)
#pragma unroll
            for (int m = 0; m < 4; ++m) { bf16_t* rowp = MID + (size_t)(row0 + ai * HALF + m * 16) * 512 + colbase;
#pragma unroll
                for (int bj = 0; bj < 2; ++bj) { const int lc = bj * HALF + wc * 32 + 8 * fq; f32x4 v0 = acc[ai][bj][m][0], v1 = acc[ai][bj][m][1];
#pragma unroll
                    for (int e = 0; e < 4; ++e) {
                        if (mode == 2) { v0[e] = sigmoidf_(v0[e]); v1[e] = sigmoidf_(v1[e]); }
                        else if (lc < 64) { v0[e] = tanhf_(v0[e]); v1[e] = tanhf_(v1[e]); } }
                    u32x4 w; w.x = cvt_pk_bf16(v0[0], v0[1]); w.y = cvt_pk_bf16(v0[2], v0[3]); w.z = cvt_pk_bf16(v1[0], v1[1]); w.w = cvt_pk_bf16(v1[2], v1[3]);
                    *(u32x4*)(rowp + lc) = w; } }
    }
};
struct EpiRwkv2 {
    static constexpr bool PERM = true;
    bf16_t* O0; bf16_t* O1; const float* bias0; const float* bias1; int tybase;
    __device__ __forceinline__ void operator()(const Acc& acc, const Unit& u, int wr, int wc, int fr, int fq) const {
        const int ty = tybase + (u.pn >> 2); const int row0 = u.pm * BM + wr * 64 + fr; const int colt = (u.pn & 3) * BM + wc * 32 + 8 * fq;
        bf16_t* base = (u.pn >> 2) ? O1 : O0; const float* bias = (u.pn >> 2) ? bias1 : bias0;
#pragma unroll
        for (int bj = 0; bj < 2; ++bj) {
            f32x4 b0 = (f32x4){0.f, 0.f, 0.f, 0.f}, b1 = b0;
            if (ty < 2) { b0 = *(const f32x4*)(bias + colt + bj * HALF); b1 = *(const f32x4*)(bias + colt + bj * HALF + 4); }
#pragma unroll
            for (int ai = 0; ai < 2; ++ai)
#pragma unroll
                for (int m = 0; m < 4; ++m) { bf16_t* rowp = base + (size_t)(row0 + ai * HALF + m * 16) * 1024 + colt + bj * HALF;
                    f32x4 v0 = acc[ai][bj][m][0] + b0, v1 = acc[ai][bj][m][1] + b1;
                    if (ty < 2) { const float s = (ty == 0) ? 0.6065306597126334f * 1.4426950408889634f : 1.0f;
#pragma unroll
                        for (int e = 0; e < 4; ++e) { v0[e] = s * sigmoidf_(v0[e]); v1[e] = s * sigmoidf_(v1[e]); } }
                    u32x4 w; w.x = cvt_pk_bf16(v0[0], v0[1]); w.y = cvt_pk_bf16(v0[2], v0[3]); w.z = cvt_pk_bf16(v1[0], v1[1]); w.w = cvt_pk_bf16(v1[2], v1[3]);
                    *(u32x4*)rowp = w; }
        }
    }
};

template <class Epi, class Sched, bool ALIGN_EPI, bool GATHER>
__device__ __forceinline__ void gemm_phase(PG8_LAS unsigned char* lds, const int K, const int lda, const Sched& S, const Epi& E, const int* __restrict__ rows, const int tid) {
    const int wid = __builtin_amdgcn_readfirstlane(tid >> 6), lane = tid & 63, wr = wid >> 2, wc = wid & 3, fr = lane & 15, fq = lane >> 4;
    const int nt = K / BK;
    unsigned voffA[2], voffB[2]; int RA[2];
#pragma unroll
    for (int i = 0; i < 2; ++i) { int R, C; stage_rc(tid * 16 + i * 8192, R, C); const int Rb = Epi::PERM ? ((R & ~31) + perm32(R & 31)) : R;
        RA[i] = R; voffA[i] = GATHER ? (unsigned)(C * 2) : (unsigned)(R * lda + C) * 2u; voffB[i] = (unsigned)(Rb * K + C) * 2u; }
    const size_t kstep = (size_t)(BK * 2);
    const size_t hstepA = GATHER ? 0 : (size_t)HALF * lda * 2, hstepB = (size_t)HALF * K * 2;
    const unsigned ldsw = (unsigned)wid * 1024u;
    const int aoff = lds_byte(wr * 64 + fr, fq * 8), boff = lds_byte(wc * 32 + fr, fq * 8);
#define PG8_SA(b, h) (((b) * 2 + (h)) * HTB)
#define PG8_SB(b, h) ((4 + (b) * 2 + (h)) * HTB)
#define PG8_ST2(bufoff, gbase, o0, o1) do { \
        __builtin_amdgcn_global_load_lds((const unsigned*)((const char*)(gbase) + (o0)), (PG8_LAS unsigned*)(lds + (bufoff) + ldsw), 16, 0, 0); \
        __builtin_amdgcn_global_load_lds((const unsigned*)((const char*)(gbase) + (o1)), (PG8_LAS unsigned*)(lds + (bufoff) + ldsw + 8192), 16, 0, 0); } while (0)
#define PG8_STB(bufoff, gbase) PG8_ST2(bufoff, gbase, voffB[0], voffB[1])
#define PG8_STA(bufoff, p, h, nx) do { if constexpr (GATHER) { const unsigned g0_ = (nx) ? gN[h][0] : gC[h][0], g1_ = (nx) ? gN[h][1] : gC[h][1]; PG8_ST2(bufoff, p, g0_, g1_); } \
        else { PG8_ST2(bufoff, (p) + (h) * hstepA, voffA[0], voffA[1]); } } while (0)
#define PG8_LDA(dst, b, h) do { _Pragma("unroll") for (int m = 0; m < 4; ++m) _Pragma("unroll") for (int k = 0; k < 2; ++k) dst[m][k] = *(const PG8_LAS bf16x8*)(lds + PG8_SA(b, h) + aoff + m * 2048 + k * 1024); } while (0)
#define PG8_LDB(dst, b, h) do { _Pragma("unroll") for (int n = 0; n < 2; ++n) _Pragma("unroll") for (int k = 0; k < 2; ++k) dst[n][k] = *(const PG8_LAS bf16x8*)(lds + PG8_SB(b, h) + boff + n * 2048 + k * 1024); } while (0)
#define PG8_MMA(ai, bj, At, Bt) do { __builtin_amdgcn_s_setprio(1); _Pragma("unroll") for (int m = 0; m < 4; ++m) _Pragma("unroll") for (int n = 0; n < 2; ++n) _Pragma("unroll") for (int k = 0; k < 2; ++k) \
        acc[ai][bj][m][n] = __builtin_amdgcn_mfma_f32_16x16x32_bf16(Bt[n][k], At[m][k], acc[ai][bj][m][n], 0, 0, 0); __builtin_amdgcn_s_setprio(0); } while (0)
#define PG8_WAIT_V(n) asm volatile("s_waitcnt vmcnt(" #n ")" ::: "memory")
#define PG8_WAIT_L(n) asm volatile("s_waitcnt lgkmcnt(" #n ")" ::: "memory")
#define PG8_BAR __builtin_amdgcn_s_barrier()
#define PG8_SCHED __builtin_amdgcn_sched_barrier(0)
#define PG8_GLOAD(dst, un) do { if constexpr (GATHER) { _Pragma("unroll") for (int h_ = 0; h_ < 2; ++h_) _Pragma("unroll") for (int i_ = 0; i_ < 2; ++i_) \
        dst[h_][i_] = (unsigned)rows[(un).pm * BM + h_ * HALF + RA[i_]] * (unsigned)(lda * 2) + voffA[i_]; } } while (0)
    Unit cur, nxt; int ui = 0;
    if (!S.next(0, cur)) return;
    unsigned gC[2][2] = {{0u, 0u}, {0u, 0u}}, gN[2][2] = {{0u, 0u}, {0u, 0u}};
    PG8_GLOAD(gC, cur);
    Acc acc;
#pragma unroll
    for (int a = 0; a < 2; ++a)
#pragma unroll
        for (int b = 0; b < 2; ++b)
#pragma unroll
            for (int m = 0; m < 4; ++m)
#pragma unroll
                for (int n = 0; n < 2; ++n) acc[a][b][m][n] = (f32x4){0.f, 0.f, 0.f, 0.f};
    bf16x8 At[4][2], B0[2][2], B1[2][2];
    const char* cA = cur.A; const char* cB = cur.B;
    PG8_STB(PG8_SB(0, 0), cB); PG8_STB(PG8_SB(0, 1), cB + hstepB); PG8_STA(PG8_SA(0, 0), cA, 0, false); PG8_STA(PG8_SA(0, 1), cA, 1, false);
    if (wr == 1) PG8_BAR;
    PG8_WAIT_V(2); PG8_BAR;
    PG8_STB(PG8_SB(1, 0), cB + kstep); PG8_STA(PG8_SA(1, 0), cA + kstep, 0, false); PG8_STB(PG8_SB(1, 1), cB + hstepB + kstep);
    PG8_WAIT_V(6); PG8_BAR;
    for (;;) {
        const bool has_next = S.next(ui + 1, nxt);
        if (has_next) { PG8_GLOAD(gN, nxt); }
        const char* nA = has_next ? nxt.A : cA; const char* nB = has_next ? nxt.B : cB;
#pragma unroll 1
        for (int t = 0; t < nt; t += 2) {
            const bool last = (t == nt - 2); const bool nx = last && has_next;
            const char* a1 = cA + (size_t)(t + 1) * kstep;
            const char* a2 = last ? nA : cA + (size_t)(t + 2) * kstep; const char* b2 = last ? nB : cB + (size_t)(t + 2) * kstep;
            const char* a3 = a2 + kstep; const char* b3 = b2 + kstep;
            PG8_LDB(B0, 0, 0); PG8_LDB(B1, 0, 1); PG8_SCHED; PG8_LDA(At, 0, 0); PG8_STA(PG8_SA(1, 1), a1, 1, false);
            PG8_WAIT_V(8); PG8_WAIT_L(0); PG8_BAR; PG8_MMA(0, 0, At, B0); PG8_MMA(0, 1, At, B1); PG8_BAR; PG8_SCHED;
            PG8_LDA(At, 0, 1); PG8_STB(PG8_SB(0, 0), b2); PG8_STB(PG8_SB(0, 1), b2 + hstepB); PG8_STA(PG8_SA(0, 0), a2, 0, nx);
            PG8_WAIT_V(8); PG8_WAIT_L(0); PG8_BAR; PG8_MMA(1, 0, At, B0); PG8_MMA(1, 1, At, B1); PG8_BAR; PG8_SCHED;
            PG8_LDB(B0, 1, 0); PG8_LDB(B1, 1, 1); PG8_SCHED; PG8_LDA(At, 1, 0); PG8_STA(PG8_SA(0, 1), a2, 1, nx);
            PG8_WAIT_V(8); PG8_WAIT_L(0); PG8_BAR; PG8_MMA(0, 0, At, B0); PG8_MMA(0, 1, At, B1); PG8_BAR; PG8_SCHED;
            PG8_LDA(At, 1, 1); PG8_STB(PG8_SB(1, 0), b3); PG8_STB(PG8_SB(1, 1), b3 + hstepB); PG8_STA(PG8_SA(1, 0), a3, 0, nx);
            PG8_WAIT_V(8); PG8_WAIT_L(0); PG8_BAR; PG8_MMA(1, 0, At, B0); PG8_MMA(1, 1, At, B1); PG8_BAR; PG8_SCHED;
        }
        if constexpr (ALIGN_EPI) { if (wr == 0) PG8_BAR; }
        E(acc, cur, wr, wc, fr, fq);
        if (!has_next) break;
#pragma unroll
        for (int a = 0; a < 2; ++a)
#pragma unroll
            for (int b = 0; b < 2; ++b)
#pragma unroll
                for (int m = 0; m < 4; ++m)
#pragma unroll
                    for (int n = 0; n < 2; ++n) acc[a][b][m][n] = (f32x4){0.f, 0.f, 0.f, 0.f};
        cur = nxt; cA = nA; cB = nB; ++ui;
        if constexpr (GATHER) {
#pragma unroll
            for (int h_ = 0; h_ < 2; ++h_)
#pragma unroll
                for (int i_ = 0; i_ < 2; ++i_) gC[h_][i_] = gN[h_][i_]; }
        if constexpr (ALIGN_EPI) { if (wr == 1) PG8_BAR; }
    }
    PG8_WAIT_V(0);
    if constexpr (!ALIGN_EPI) { if (wr == 0) PG8_BAR; }
    PG8_BAR;
#undef PG8_SA
#undef PG8_SB
#undef PG8_ST2
#undef PG8_STB
#undef PG8_STA
#undef PG8_LDA
#undef PG8_LDB
#undef PG8_MMA
#undef PG8_WAIT_V
#undef PG8_WAIT_L
#undef PG8_BAR
#undef PG8_SCHED
#undef PG8_GLOAD
}
}
namespace attn_body {
using bf16=__hip_bfloat16;
using bf16x8=__attribute__((ext_vector_type(8)))short;
using s16x4=__attribute__((ext_vector_type(4)))short;
using f32x16=__attribute__((ext_vector_type(16)))float;
using u32x4=__attribute__((ext_vector_type(4)))unsigned;
constexpr int BATCH=8,NHEAD=16,SEQ=8192,D=64,PQ=512,PO=1024;
constexpr int NW=8,QBLK=32,QB=QBLK*NW,KVBLK=64,NQB=SEQ/QB;
constexpr int ATTN_UNIT_ROWS=QB;
__device__ __forceinline__ int crow(int r,int hi){return (r&3)+8*(r>>2)+4*hi;}
#define SBAR() __builtin_amdgcn_sched_barrier(0)
__device__ __forceinline__ void cmask(f32x16&p0,f32x16&p1,int jb,int qrel,int hi){
  const float NEG=-INFINITY; int kb=64*jb+4*hi;
  #pragma unroll
  for(int r=0;r<16;++r){int kv=kb+(r&3)+8*(r>>2); if(kv>qrel)p0[r]=NEG; if(kv+32>qrel)p1[r]=NEG;}
}

__device__ __forceinline__ void cbias(f32x16&p0,f32x16&p1,int jb,int qrel,int hi,const __attribute__((address_space(3))) float*tb){
  const int kb=64*jb+4*hi;
  #pragma unroll
  for(int r=0;r<16;++r){const int rel=qrel-(kb+(r&3)+8*(r>>2)); const int i0=min(max(rel,0),127), i1=min(max(rel-32,0),127); p0[r]+=tb[i0]; p1[r]+=tb[i1];}
}
constexpr int NSLOT=3, SLOTB=8192;
constexpr int LDS_K=0, LDS_V=NSLOT*SLOTB, LDS_WS=2*NSLOT*SLOTB, LDS_OST=LDS_WS+NW*64*4, LDS_BYTES=LDS_OST+NW*4096;
constexpr float C2=0.125f*1.4426950408889634f;
__device__ __forceinline__ void glds16(const void*gsrc,unsigned lds_dst){unsigned keep;
  asm volatile("s_mov_b32 %0, m0\n\ts_mov_b32 m0, %2\n\ts_nop 0\n\tglobal_load_lds_dwordx4 %1, off\n\ts_mov_b32 m0, %0":"=&s"(keep):"v"(gsrc),"s"(lds_dst):"memory");}
__device__ __forceinline__ float max3f(float a,float b,float c){float r;asm("v_max3_f32 %0, %1, %2, %3":"=v"(r):"v"(a),"v"(b),"v"(c));return r;}
__device__ __forceinline__ float max2f(float a,float b){float r;asm("v_max_f32_e32 %0, %1, %2":"=v"(r):"v"(a),"v"(b));return r;}
__device__ __forceinline__ float fadd_s(float a,float b){float r;asm("v_add_f32_e32 %0, %1, %2":"=v"(r):"v"(a),"v"(b));return r;}
__device__ __forceinline__ float fsub_s(float a,float b){float r;asm("v_sub_f32_e32 %0, %1, %2":"=v"(r):"v"(a),"v"(b));return r;}
typedef float f32x2_t __attribute__((ext_vector_type(2))); typedef __bf16 bf16x2_t __attribute__((ext_vector_type(2)));
__device__ __forceinline__ unsigned cvtpk_s(float lo,float hi){f32x2_t v={lo,hi};bf16x2_t b=__builtin_convertvector(v,bf16x2_t);return __builtin_bit_cast(unsigned,b);}
#define WAIT_BAR(N) asm volatile("s_waitcnt vmcnt(" #N ") lgkmcnt(0)\n\ts_barrier":::"memory")

__device__ __forceinline__ void qkt(f32x16&p0,f32x16&p1,const char*Kslot,const bf16x8*qr,const f32x16&negm,int r32,int hi){
  const char*kb=Kslot+hi*1024+r32*16;
  #pragma unroll
  for(int d0=0;d0<4;++d0){
    const bf16x8 b0=*reinterpret_cast<const bf16x8*>(kb+d0*2048);
    const bf16x8 b1=*reinterpret_cast<const bf16x8*>(kb+d0*2048+512);
    if(d0==0){p0=__builtin_amdgcn_mfma_f32_32x32x16_bf16(b0,qr[0],negm,0,0,0);p1=__builtin_amdgcn_mfma_f32_32x32x16_bf16(b1,qr[0],negm,0,0,0);}
    else{p0=__builtin_amdgcn_mfma_f32_32x32x16_bf16(b0,qr[d0],p0,0,0,0);p1=__builtin_amdgcn_mfma_f32_32x32x16_bf16(b1,qr[d0],p1,0,0,0);}}
}
typedef __attribute__((address_space(3))) const char* lds_cptr;
typedef short v4i16_t __attribute__((ext_vector_type(4)));
__device__ __forceinline__ void kload8(bf16x8*kf,lds_cptr kp){
  kf[0]=*(const __attribute__((address_space(3))) bf16x8*)(kp);      kf[1]=*(const __attribute__((address_space(3))) bf16x8*)(kp+512);
  kf[2]=*(const __attribute__((address_space(3))) bf16x8*)(kp+2048); kf[3]=*(const __attribute__((address_space(3))) bf16x8*)(kp+2560);
  kf[4]=*(const __attribute__((address_space(3))) bf16x8*)(kp+4096); kf[5]=*(const __attribute__((address_space(3))) bf16x8*)(kp+4608);
  kf[6]=*(const __attribute__((address_space(3))) bf16x8*)(kp+6144); kf[7]=*(const __attribute__((address_space(3))) bf16x8*)(kp+6656);
}
__device__ __forceinline__ void kload2(bf16x8*kf,lds_cptr kp,int j){ kf[2*j]=*(const __attribute__((address_space(3))) bf16x8*)(kp+j*2048); kf[2*j+1]=*(const __attribute__((address_space(3))) bf16x8*)(kp+j*2048+512); }
__device__ __forceinline__ s16x4 vtr(lds_cptr p){ return __builtin_bit_cast(s16x4,__builtin_amdgcn_ds_read_tr16_b64_v4i16((__attribute__((address_space(3))) v4i16_t*)p)); }
__device__ __forceinline__ float rowmax(const f32x16&p0,const f32x16&p1){
  float a=max3f(p0[0],p0[1],p1[0]),b=max3f(p0[2],p0[3],p1[1]);a=max3f(a,p1[2],p1[3]);
  #pragma unroll
  for(int r=4;r<16;r+=4){a=max3f(a,p0[r],p0[r+1]);b=max3f(b,p0[r+2],p0[r+3]);a=max3f(a,p1[r],p1[r+1]);b=max3f(b,p1[r+2],p1[r+3]);}
  const float m=max2f(a,b);
  auto rr=__builtin_amdgcn_permlane32_swap(__float_as_uint(m),__float_as_uint(m),false,false);
  return max2f(__uint_as_float(rr[0]),__uint_as_float(rr[1]));
}
__device__ __forceinline__ void pv(f32x16*o,int vb,bf16x8 pa0,bf16x8 pa1,bf16x8 pa2,bf16x8 pa3){
  #pragma unroll
  for(int d0=0;d0<2;++d0){s16x4 lo[4],hi[4];
    #pragma unroll
    for(int ks=0;ks<4;++ks){
      asm volatile("ds_read_b64_tr_b16 %0,%1 offset:%c2":"=&v"(lo[ks]):"v"(vb),"i"(d0*4096+ks*1024):"memory");
      asm volatile("ds_read_b64_tr_b16 %0,%1 offset:%c2":"=&v"(hi[ks]):"v"(vb),"i"(d0*4096+ks*1024+512):"memory");}
    asm volatile("s_waitcnt lgkmcnt(0)":::"memory");SBAR();
    #define PK(k) (bf16x8){lo[k][0],lo[k][1],lo[k][2],lo[k][3],hi[k][0],hi[k][1],hi[k][2],hi[k][3]}
    o[d0]=__builtin_amdgcn_mfma_f32_32x32x16_bf16(pa0,PK(0),o[d0],0,0,0);
    o[d0]=__builtin_amdgcn_mfma_f32_32x32x16_bf16(pa1,PK(1),o[d0],0,0,0);
    o[d0]=__builtin_amdgcn_mfma_f32_32x32x16_bf16(pa2,PK(2),o[d0],0,0,0);
    o[d0]=__builtin_amdgcn_mfma_f32_32x32x16_bf16(pa3,PK(3),o[d0],0,0,0);
    #undef PK
  }
}

#ifndef ATTN_STORE16
#define ATTN_STORE16(p,v) (*(u32x4*)(p)=(v))
#endif
template<int THRL> __device__ __forceinline__ void attn_unit(int b,int vh,int qb,const bf16*Q,const bf16*__restrict__ K,const bf16*__restrict__ V,bf16*O,char*shm,const __attribute__((address_space(3))) float*tball,const int tid){
  const int lane=tid&63,r32=lane&31,hi=lane>>5; const int wid=__builtin_amdgcn_readfirstlane(tid>>6);
  const long rowbase=(long)b*SEQ; const int q0=qb*QB;
  const int hh=vh>>2, qcol=hh*128+((vh>>1)&1)*64, vcol=hh*128+(vh&1)*64;
  const __attribute__((address_space(3))) float*tb=tball+hh*128;
  const bf16*Qw=Q+(rowbase+q0+wid*QBLK)*PQ+qcol;
  const bf16*Kh=K+rowbase*PQ+qcol,*Vh=V+rowbase*PQ+vcol;
  const unsigned lds0=(unsigned)(uintptr_t)shm;
  float*wsf=(float*)(shm+LDS_WS)+wid*64;
  const bf16*ksrc=Kh+(long)lane*PQ+wid*8;
  const bf16*vsrc=Vh+(long)(16*(wid&3)+(lane>>2))*PQ+(wid>>2)*32+(lane&3)*8;
  const unsigned kdst=lds0+LDS_K+wid*1024, vdst=lds0+LDS_V+wid*1024;
  #define DMA_K(t,slot) glds16(ksrc+(long)(t)*KVBLK*PQ,(unsigned)__builtin_amdgcn_readfirstlane(kdst+(slot)))
  #define DMA_V(t,slot) glds16(vsrc+(long)(t)*KVBLK*PQ,(unsigned)__builtin_amdgcn_readfirstlane(vdst+(slot)))
  const int vb0=(int)(lds0+LDS_V)+((lane>>4)&1)*32+(lane&3)*8+(4*hi+((lane&15)>>2))*64;
  const char*Kbase=shm+LDS_K; bf16x8 kf[8];
  const lds_cptr shm3=(lds_cptr)shm; const lds_cptr kp0=shm3+LDS_K+hi*1024+r32*16; const lds_cptr vp0=shm3+LDS_V+((lane>>4)&1)*32+(lane&3)*8+(4*hi+((lane&15)>>2))*64;
  const int NT=(q0+QB)/KVBLK;
  DMA_K(0,0);DMA_V(0,0);DMA_K(1,SLOTB);
  bf16x8 qr[4];
  #pragma unroll
  for(int d0=0;d0<4;++d0)qr[d0]=*reinterpret_cast<const bf16x8*>(&Qw[(long)r32*PQ+d0*16+hi*8]);
  float mhat=0.f,l_reg=0.f;f32x16 o[2];o[0]=f32x16{};o[1]=f32x16{};f32x16 negm=f32x16{};asm volatile("":"+v"(negm));
  const int qrel=wid*QBLK+r32;
  #define CMASK(P0,P1,t) do{int jb_=(t)-(NT-4); if(jb_>=-2){cbias(P0,P1,jb_,qrel,hi,tb); if(jb_>=0)cmask(P0,P1,jb_,qrel,hi);}}while(0)
  bool resc=false;
  #define START(P0,P1) do{ const float rm=rowmax(P0,P1); resc=false; \
    { const float dl=rm; mhat=fadd_s(mhat,dl); \
      _Pragma("unroll") for(int r=0;r<16;++r){P0[r]=fsub_s(P0[r],dl);P1[r]=fsub_s(P1[r],dl);} \
      _Pragma("unroll") for(int r=0;r<16;++r)negm[r]=-mhat; asm volatile("":"+v"(negm)); } \
    _Pragma("unroll") for(int r=0;r<16;++r)P0[r]=__builtin_amdgcn_exp2f(P0[r]); }while(0)
  #define RESC() do{ if(resc){ asm volatile("s_waitcnt lgkmcnt(0)":::"memory"); \
      _Pragma("unroll") for(int d_=0;d_<2;++d_) _Pragma("unroll") for(int r=0;r<16;++r)o[d_][r]*=wsf[crow(r,hi)]; } }while(0)
  f32x16 pA0,pA1,pB0,pB1;
  int sl_prev=0,sl_cur=0,sl_next=SLOTB;
  #define ROT() do{sl_prev=sl_cur;sl_cur=sl_next;sl_next=(sl_next==(NSLOT-1)*SLOTB)?0:sl_next+SLOTB;}while(0)
  DMA_K(2,2*SLOTB);
  WAIT_BAR(3);
  qkt(pA0,pA1,Kbase,qr,negm,r32,hi);asm volatile("s_nop 15\n\ts_nop 7":"+v"(pA0),"+v"(pA1));CMASK(pA0,pA1,0);
  START(pA0,pA1);
  _Pragma("unroll") for(int r=0;r<16;++r)pA1[r]=__builtin_amdgcn_exp2f(pA1[r]);
  WAIT_BAR(0);
  DMA_K(3,0);DMA_V(1,SLOTB);
  ROT();
  kload8(kf,kp0+sl_cur);
  WAIT_BAR(2);
  s16x4 vlo[8],vhi[8]; u32x4 pw0,pw1,pw2,pw3;
  #define PKW(P,B) cvtpk_s(P[B],P[B+1])
  #define PAF(k) __builtin_bit_cast(bf16x8,pw##k)
  #define VFR(i) (bf16x8){vlo[i][0],vlo[i][1],vlo[i][2],vlo[i][3],vhi[i][0],vhi[i][1],vhi[i][2],vhi[i][3]}
  #define PIN(x) asm volatile("":"+v"(x))
  #define MX3(a,b,c) __builtin_fmaxf(__builtin_fmaxf((a),(b)),(c))
  #define GAPA(MF,A0,A1,A2,A3,W0,W1,PW) do{ MF; sacc+=A0; sacc+=A1; sacc+=A2; sacc+=A3; PIN(sacc); W0; W1; PIN(PW); SBAR(); }while(0)
  #define EX(v) __builtin_amdgcn_exp2f(v)
  #define GAPB(MF,X,B) do{ MF; X[B]=EX(X[B]); X[B+1]=EX(X[B+1]); X[B+2]=EX(X[B+2]); X[B+3]=EX(X[B+3]); PIN(X); SBAR(); }while(0)
  #define VRD(i) do{ vlo[i]=vtr(vp_+(((i)>>2)*4096+((i)&3)*1024)); vhi[i]=vtr(vp_+(((i)>>2)*4096+((i)&3)*1024+512)); }while(0)
  #define KRD(G,j) do{ if(G){ kload2(kf,kp0+sl_next,j); SBAR(); } }while(0)
  #define STEP(C0,C1,P0,P1,t,GK,GV,GL) do{ SBAR(); \
    const lds_cptr vp_=vp0+sl_prev; \
    VRD(0); SBAR(); float sacc=(P0[0]+P0[1]); \
    GAPA(C0=__builtin_amdgcn_mfma_f32_32x32x16_bf16(kf[0],qr[0],negm,0,0,0), P0[2],P0[3],P0[4],P0[5],     pw0[0]=PKW(P0,0), pw0[1]=PKW(P0,2), pw0); \
    VRD(4); SBAR(); GAPA(C1=__builtin_amdgcn_mfma_f32_32x32x16_bf16(kf[1],qr[0],negm,0,0,0), P0[6],P0[7],P0[8],P0[9],     pw0[2]=PKW(P0,4), pw0[3]=PKW(P0,6), pw0); \
    VRD(1); SBAR(); GAPA(C0=__builtin_amdgcn_mfma_f32_32x32x16_bf16(kf[2],qr[1],C0,0,0,0),   P0[10],P0[11],P0[12],P0[13], pw1[0]=PKW(P0,8), pw1[1]=PKW(P0,10), pw1); \
    VRD(5); SBAR(); GAPA(C1=__builtin_amdgcn_mfma_f32_32x32x16_bf16(kf[3],qr[1],C1,0,0,0),   P0[14],P0[15],P1[0],P1[1],   pw1[2]=PKW(P0,12),pw1[3]=PKW(P0,14), pw1); \
    VRD(2); SBAR(); GAPA(C0=__builtin_amdgcn_mfma_f32_32x32x16_bf16(kf[4],qr[2],C0,0,0,0),   P1[2],P1[3],P1[4],P1[5],     pw2[0]=PKW(P1,0), pw2[1]=PKW(P1,2), pw2); \
    VRD(6); SBAR(); GAPA(C1=__builtin_amdgcn_mfma_f32_32x32x16_bf16(kf[5],qr[2],C1,0,0,0),   P1[6],P1[7],P1[8],P1[9],     pw2[2]=PKW(P1,4), pw2[3]=PKW(P1,6), pw2); \
    VRD(3); SBAR(); GAPA(C0=__builtin_amdgcn_mfma_f32_32x32x16_bf16(kf[6],qr[3],C0,0,0,0),   P1[10],P1[11],P1[12],P1[13], pw3[0]=PKW(P1,8), pw3[1]=PKW(P1,10), pw3); \
    VRD(7); SBAR(); GAPA(C1=__builtin_amdgcn_mfma_f32_32x32x16_bf16(kf[7],qr[3],C1,0,0,0),   P1[14],P1[15],0.f,0.f,       pw3[2]=PKW(P1,12),pw3[3]=PKW(P1,14), pw3); \
    l_reg+=sacc; \
    if(GK){DMA_K((t)+3,sl_cur);} if(GV){DMA_V((t)+1,sl_next);} \
    CMASK(C0,C1,t); \
    { float a=MX3(C0[0],C0[1],C1[0]),b=MX3(C0[2],C0[3],C1[1]); a=MX3(a,C1[2],C1[3]); \
      _Pragma("unroll") for(int r=4;r<16;r+=4){a=MX3(a,C0[r],C0[r+1]);b=MX3(b,C0[r+2],C0[r+3]);a=MX3(a,C1[r],C1[r+1]);b=MX3(b,C1[r+2],C1[r+3]);} \
      float rm=__builtin_fmaxf(a,b); { auto rr=__builtin_amdgcn_permlane32_swap(__float_as_uint(rm),__float_as_uint(rm),false,false); rm=__builtin_fmaxf(__uint_as_float(rr[0]),__uint_as_float(rr[1])); } \
      resc=false; \
      if(__builtin_expect(__any(rm>(float)THRL),0)){ const float dl=__builtin_fmaxf(rm,0.f); mhat+=dl; \
        _Pragma("unroll") for(int r=0;r<16;++r){C0[r]-=dl;C1[r]-=dl;} \
        _Pragma("unroll") for(int r=0;r<16;++r)negm[r]=-mhat; asm volatile("":"+v"(negm)); \
        const float f=__builtin_amdgcn_exp2f(-dl); l_reg*=f; if(hi==0)wsf[r32]=f; resc=true; } } \
    SBAR(); \
    GAPB(o[0]=__builtin_amdgcn_mfma_f32_32x32x16_bf16(PAF(0),VFR(0),o[0],0,0,0), C0,0); \
    GAPB(o[1]=__builtin_amdgcn_mfma_f32_32x32x16_bf16(PAF(0),VFR(4),o[1],0,0,0), C0,4); \
    KRD(GL,0); GAPB(o[0]=__builtin_amdgcn_mfma_f32_32x32x16_bf16(PAF(1),VFR(1),o[0],0,0,0), C0,8); \
    KRD(GL,1); GAPB(o[1]=__builtin_amdgcn_mfma_f32_32x32x16_bf16(PAF(1),VFR(5),o[1],0,0,0), C0,12); \
    KRD(GL,2); GAPB(o[0]=__builtin_amdgcn_mfma_f32_32x32x16_bf16(PAF(2),VFR(2),o[0],0,0,0), C1,0); \
    KRD(GL,3); GAPB(o[1]=__builtin_amdgcn_mfma_f32_32x32x16_bf16(PAF(2),VFR(6),o[1],0,0,0), C1,4); \
    GAPB(o[0]=__builtin_amdgcn_mfma_f32_32x32x16_bf16(PAF(3),VFR(3),o[0],0,0,0), C1,8); \
    GAPB(o[1]=__builtin_amdgcn_mfma_f32_32x32x16_bf16(PAF(3),VFR(7),o[1],0,0,0), C1,12); \
    }while(0)
  int t=1;
  #undef CMASK
  #define CMASK(P0,P1,t) do{}while(0)
  for(;t+7<NT;t+=2){
    STEP(pB0,pB1,pA0,pA1,t,true,true,true);     WAIT_BAR(2); RESC(); ROT();
    STEP(pA0,pA1,pB0,pB1,t+1,true,true,true);   WAIT_BAR(2); RESC(); ROT();
  }
  #undef CMASK
  #define CMASK(P0,P1,t) do{int jb_=(t)-(NT-4); if(jb_>=-2){cbias(P0,P1,jb_,qrel,hi,tb); if(jb_>=0)cmask(P0,P1,jb_,qrel,hi);}}while(0)
  #define ENDW(tt) do{ if((tt)+3<NT){WAIT_BAR(2);} else if((tt)+2<NT){WAIT_BAR(1);} else {WAIT_BAR(0);} }while(0)
  for(;t+1<NT;t+=2){
    STEP(pB0,pB1,pA0,pA1,t,(t+3<NT),(t+1<NT),(t+1<NT));       ENDW(t);   RESC(); ROT();
    STEP(pA0,pA1,pB0,pB1,t+1,(t+4<NT),(t+2<NT),(t+2<NT));     ENDW(t+1); RESC(); ROT();
  }
  STEP(pB0,pB1,pA0,pA1,NT-1,false,false,false); RESC();
  { float sacc=pB0[0]+pB0[1]; _Pragma("unroll") for(int r=2;r<16;++r)sacc+=pB0[r]; _Pragma("unroll") for(int r=0;r<16;++r)sacc+=pB1[r]; l_reg+=sacc;
    pw0=(u32x4){PKW(pB0,0),PKW(pB0,2),PKW(pB0,4),PKW(pB0,6)};pw1=(u32x4){PKW(pB0,8),PKW(pB0,10),PKW(pB0,12),PKW(pB0,14)};pw2=(u32x4){PKW(pB1,0),PKW(pB1,2),PKW(pB1,4),PKW(pB1,6)};pw3=(u32x4){PKW(pB1,8),PKW(pB1,10),PKW(pB1,12),PKW(pB1,14)};
    SBAR(); pv(o,vb0+sl_cur,PAF(0),PAF(1),PAF(2),PAF(3)); }
  #undef PKW
  #undef PAF
  #undef VFR
  #undef PIN
  #undef MX3
  #undef GAPA
  #undef GAPB
  #undef EX
  #undef VRD
  #undef KRD
  #undef STEP
  #undef ENDW
  {auto rr=__builtin_amdgcn_permlane32_swap(__float_as_uint(l_reg),__float_as_uint(l_reg),false,false);l_reg=__uint_as_float(rr[0])+__uint_as_float(rr[1]);}
  if(hi==0)wsf[32+r32]=l_reg;asm volatile("s_waitcnt lgkmcnt(0)":::"memory");
  float rli[16];
  #pragma unroll
  for(int r=0;r<16;++r)rli[r]=__builtin_amdgcn_rcpf(wsf[32+crow(r,hi)]);
  bf16*Ow=O+(rowbase+q0+wid*QBLK)*PO+vh*D;
  { bf16*stg=(bf16*)(shm+LDS_OST)+wid*2048;
    #pragma unroll
    for(int r=0;r<16;++r){const int orow=crow(r,hi);
      #pragma unroll
      for(int d0=0;d0<2;++d0)stg[orow*64+d0*32+r32]=__float2bfloat16(o[d0][r]*rli[r]);}
    asm volatile("s_waitcnt lgkmcnt(0)":::"memory");
    #pragma unroll
    for(int i=0;i<4;++i){const int row=i*8+(lane>>3),ch=lane&7; const u32x4 v=*(const u32x4*)(stg+row*64+ch*8); ATTN_STORE16(Ow+(long)row*PO+ch*8,v);} }
  asm volatile("s_waitcnt lgkmcnt(0)\n\ts_barrier":::"memory");
  #undef DMA_K
  #undef DMA_V
  #undef CMASK
  #undef START
  #undef RESC
  #undef ROT
}
constexpr int ATTN_LDS_BYTES=LDS_BYTES;
struct AttnTensors { const bf16* Q; const bf16* K; const bf16* V; bf16* O; };
struct AttnUnit { int bh; int qb; };
__device__ __forceinline__ bool attn_next(int vcu,int i,AttnUnit&u){ if(i>=16)return false; const int s=vcu&7, j=i&3; u.bh=(vcu>>3)+32*(i>>2); u.qb=(j==0)?s:(j==1)?15-s:(j==2)?16+s:31-s; return true; }
template<int THRL=8> __device__ __forceinline__ void attn_phase(char*lds,const AttnTensors&T,int vcu,const __attribute__((address_space(3))) float*tball,const int tid){
  AttnUnit u;
  for(int i=0;attn_next(vcu,i,u);++i){ attn_unit<THRL>(u.bh/NHEAD,u.bh%NHEAD,u.qb,T.Q,T.K,T.V,T.O,lds,tball,tid); }
}
#undef SBAR
#undef WAIT_BAR
}

#define XB_TMO      128
#define XB_XCNT(j)  (256  + 64 * (j))
#define XB_XSUB(j)  (1280 + 64 * (j))
#define XB_XGEN(j)  (2304 + 64 * (j))
#define XB_TOP      3328
#define XB_TOPGEN   3392
#define XCD_BAR_WORDS 3456
#define XB_SPIN_CAP (1u << 18)

__device__ __forceinline__ unsigned xb_ld(unsigned* p)              { return __hip_atomic_load(p, __ATOMIC_RELAXED, __HIP_MEMORY_SCOPE_AGENT); }
__device__ __forceinline__ unsigned xb_add(unsigned* p, unsigned v) { return __hip_atomic_fetch_add(p, v, __ATOMIC_RELAXED, __HIP_MEMORY_SCOPE_AGENT); }
__device__ __forceinline__ unsigned xb_xcc_id() { return (unsigned)__builtin_amdgcn_s_getreg((3 << 11) | 20) & 0xFu; }
#define XB_SPIN(cond, bar) do { unsigned _sp = 0; while (cond) { __builtin_amdgcn_s_sleep(1); \
    if ((++_sp & 255u) == 0u) { if (xb_ld(&(bar)[XB_TMO])) break; if (_sp > XB_SPIN_CAP) { atomicAdd(&(bar)[XB_TMO], 1u); break; } } } } while (0)

struct XcdBarrier {
    unsigned* bar; unsigned x;
    volatile LAS unsigned* st;
};

__device__ __forceinline__ XcdBarrier xcd_barrier_post(unsigned* bar, volatile LAS unsigned* st, const bool leader  ) {
    XcdBarrier b; b.bar = bar; b.x = xb_xcc_id(); b.st = st;
    if (leader) (void)xb_add(&bar[XB_XCNT(b.x)], 1u);
    return b;
}
__device__ __forceinline__ void xcd_barrier_complete(unsigned* bar, unsigned x, unsigned& nloc, unsigned& nx) {
    const unsigned G = gridDim.x * gridDim.y * gridDim.z;
    unsigned sum, cnt, mine, sp = 0u;
    for (;;) {
        sum = 0u; cnt = 0u; mine = 0u;
#pragma unroll
        for (unsigned j = 0; j < 16; ++j) { const unsigned c = xb_ld(&bar[XB_XCNT(j)]); sum += c; cnt += (c > 0u) ? 1u : 0u; mine = (j == x) ? c : mine; }
        if (sum == G) break;
        __builtin_amdgcn_s_sleep(1);
        if ((++sp & 255u) == 0u) { if (xb_ld(&bar[XB_TMO])) break; if (sp > XB_SPIN_CAP) { atomicAdd(&bar[XB_TMO], 1u); break; } }
    }
    nloc = mine > 0u ? mine : 1u; nx = cnt > 0u ? cnt : 1u;
}

__device__ __forceinline__ void xcd_barrier(const XcdBarrier& b, const bool leader  ) {
    asm volatile("s_waitcnt vmcnt(0)" ::: "memory");
    __syncthreads();
    if (leader) {
        unsigned* bar = b.bar;
        __builtin_amdgcn_s_waitcnt(0);
        unsigned nloc = b.st[0], nx = b.st[1];
        if (nloc == 0u) { xcd_barrier_complete(bar, b.x, nloc, nx); b.st[0] = nloc; b.st[1] = nx; }
        const unsigned old = xb_add(&bar[XB_XSUB(b.x)], 1u);
        const unsigned gen = old / nloc;
        if (old + 1u == (gen + 1u) * nloc) {
            __builtin_amdgcn_fence(__ATOMIC_RELEASE, "agent");
            asm volatile("s_waitcnt vmcnt(0)" ::: "memory");
            const unsigned og = xb_add(&bar[XB_TOP], 1u);
            const unsigned tg = og / nx;
            if (og + 1u == (tg + 1u) * nx) xb_add(&bar[XB_TOPGEN], 1u);
            else XB_SPIN(xb_ld(&bar[XB_TOPGEN]) == tg, bar);
            __builtin_amdgcn_fence(__ATOMIC_ACQUIRE, "agent");
            xb_add(&bar[XB_XGEN(b.x)], 1u);
            asm volatile("s_waitcnt vmcnt(0)" ::: "memory");
        } else {
            XB_SPIN(xb_ld(&bar[XB_XGEN(b.x)]) == gen, bar);
            __builtin_amdgcn_fence(__ATOMIC_ACQUIRE, "agent");
            asm volatile("s_waitcnt vmcnt(0)" ::: "memory");
        }
    }
    __syncthreads();
}

constexpr size_t MiB = 1u << 20;
constexpr size_t WS_CTL = 0, CTL_ZERO_BYTES = 1 * MiB;
constexpr size_t WS_WIN = 2 * MiB;
constexpr size_t WS_WOUT = 7 * MiB;
constexpr size_t WS_PGATE = 9 * MiB;
constexpr size_t WS_PPROJ = 13 * MiB;
constexpr size_t WS_RCAT = 14 * MiB;
constexpr size_t WS_RL1 = 20 * MiB;
constexpr size_t WS_RS2 = 28 * MiB;
constexpr size_t WS_RWO = 30 * MiB;
constexpr size_t WS_ROUT = 32 * MiB;
constexpr size_t WS_LRUAGG = 33 * MiB;
constexpr size_t WS_MGU = 38 * MiB;
constexpr size_t WS_MDN = 102 * MiB;
constexpr size_t WS_PB = 134 * MiB;
constexpr size_t WS_ACT = 166 * MiB;
constexpr size_t WS_H0 = WS_ACT;
constexpr size_t WS_QKV = WS_ACT + 128 * MiB;
constexpr size_t WS_O = WS_ACT + 448 * MiB;
constexpr size_t WS_HL = WS_ACT + 576 * MiB, WS_CA = WS_ACT + 640 * MiB;
constexpr size_t WS_H2 = WS_ACT;
constexpr size_t WS_LOG = WS_ACT + 128 * MiB;
constexpr size_t WS_ROUTE = WS_ACT + 144 * MiB;
constexpr size_t WS_HID = WS_ACT + 152 * MiB;
constexpr size_t WS_YS = WS_ACT + 288 * MiB;
constexpr size_t WS_PP = WS_HID;
constexpr size_t WS_HCAT = WS_ACT;
constexpr size_t WS_XR = WS_ACT + 256 * MiB, WS_XK = WS_ACT + 384 * MiB, WS_XV = WS_ACT + 512 * MiB;
constexpr size_t WS_R = WS_ACT + 640 * MiB, WS_K = WS_XR, WS_V = WS_XK;
constexpr size_t WS_MID = WS_ACT + 768 * MiB;
constexpr size_t WS_EW = WS_ACT;
constexpr size_t WS_AA = WS_ACT + 128 * MiB;
constexpr size_t WS_Y = WS_XV;
constexpr size_t WS_END = WS_ACT + 832 * MiB;
static_assert(WS_END <= 1024 * MiB, "workspace map");
constexpr size_t RT_EID = 0, RT_POS = 1 * MiB, RT_GATE = 2 * MiB, RT_ROWTOK = 3 * MiB, RT_ROWGATE = 4 * MiB, RT_SLOT = 5 * MiB;
constexpr int CW_BAR = 4096;
constexpr int CW_PROG = 32768, CW_GDONE = 36864;
constexpr int CW_CNT0 = 16384, CW_CNT1 = 16384 + 64;

constexpr int RING_BYTES = 131072;
constexpr int LDSCTL_OFF = RING_BYTES, MISC_OFF = LDSCTL_OFF + 320;
constexpr int TB_OFF = RING_BYTES + 1024;
constexpr int RTE_OFF = TB_OFF + 2048;
constexpr int LDS_BYTES = 147456;

constexpr int NWAVES = 8;
__device__ __forceinline__ int lane_id_() { int l; asm volatile("v_mbcnt_lo_u32_b32 %0, -1, 0\n\tv_mbcnt_hi_u32_b32 %0, -1, %0" : "=v"(l)); return l; }
#define TID_ (F.wave * 64 + lane_id_())
#define LANE_ (lane_id_())
struct Frame {
    LAS unsigned char* lds; volatile LAS unsigned* MISC; gu32* ctl;
    int wave, vcu, G;
};

__device__ __forceinline__ void load_row4(const float* xrow, int lane, f32x4 (&v)[4]) { const f32x4* p = (const f32x4*)xrow + lane;
#pragma unroll
    for (int j = 0; j < 4; ++j) v[j] = p[64 * j]; }
__device__ __forceinline__ float row_rstd(const f32x4 (&v)[4], float eps) { float s = 0.f;
#pragma unroll
    for (int j = 0; j < 4; ++j) s += (v[j].x * v[j].x + v[j].y * v[j].y) + (v[j].z * v[j].z + v[j].w * v[j].w);
    return 1.0f / sqrtf(wave_sum(s) * (1.0f / 1024.0f) + eps); }
__device__ __forceinline__ void load_row4_bf(const bf16* xrow, int lane, f32x4 (&v)[4]) { const v2u* p = (const v2u*)xrow + lane;
#pragma unroll
    for (int j = 0; j < 4; ++j) { const v2u w = p[64 * j]; v[j] = (f32x4){bflo(w.x), bfhi(w.x), bflo(w.y), bfhi(w.y)}; } }
__device__ __forceinline__ void store_row4_bf(bf16* xrow, int lane, const f32x4 (&v)[4]) { v2u* p = (v2u*)xrow + lane;
#pragma unroll
    for (int j = 0; j < 4; ++j) { v2u o; o.x = pk2(v[j].x, v[j].y); o.y = pk2(v[j].z, v[j].w); p[64 * j] = o; } }
__device__ __forceinline__ void store_row_bf16(bf16* orow, int lane, const f32x4 (&v)[4], float rstd, const float* g) {
    unsigned long long* o8 = (unsigned long long*)orow + lane;
#pragma unroll
    for (int j = 0; j < 4; ++j) { const f32x4 gg = ((const f32x4*)g)[lane + 64 * j];
        o8[64 * j] = (unsigned long long)pk2(v[j].x * rstd * gg.x, v[j].y * rstd * gg.y) | ((unsigned long long)pk2(v[j].z * rstd * gg.z, v[j].w * rstd * gg.w) << 32); }
}

template <int MODE>
__device__ __forceinline__ void transpose_item(const float* W, int K, int N, bf16* WT, int ldo, int row_off, const float* mu, LAS float* scr, int item, int lane) {
    const int nblk = N / 32, kb = item / nblk, nb = item % nblk, k0 = 64 * kb, n0 = 32 * nb;
    float ld[32];
#pragma unroll
    for (int i = 0; i < 32; ++i) { const int kk = 2 * i + (lane >> 5); ld[i] = W[(size_t)(k0 + kk) * N + n0 + (lane & 31)]; }
#pragma unroll
    for (int i = 0; i < 32; ++i) { const int kk = 2 * i + (lane >> 5); scr[kk * 33 + (lane & 31)] = ld[i]; }
    LDS_WAIT(); asm volatile("" ::: "memory");
    const int c = lane & 7;
    int rbase = row_off + n0;
    if (MODE == 2) { rbase = row_off + ((n0 < 512) ? ((n0 >> 7) * 256 + (n0 & 127)) : (((n0 - 512) >> 7) * 256 + 128 + ((n0 - 512) & 127))); }
    float m[8];
    if (MODE == 1) {
#pragma unroll
        for (int e = 0; e < 8; ++e) m[e] = mu[k0 + 8 * c + e]; }
#pragma unroll
    for (int j = 0; j < 4; ++j) { const int n = (lane >> 3) + 8 * j; const LAS float* s = scr + (8 * c) * 33 + n;
        float v[8];
#pragma unroll
        for (int e = 0; e < 8; ++e) v[e] = s[e * 33];
        bf16* dst = WT + (size_t)(rbase + n) * ldo + k0 + 8 * c;
        if (MODE == 1) {
            v4u o, o2;
            o.x = pk2(v[0] * (1.f - m[0]), v[1] * (1.f - m[1])); o.y = pk2(v[2] * (1.f - m[2]), v[3] * (1.f - m[3])); o.z = pk2(v[4] * (1.f - m[4]), v[5] * (1.f - m[5])); o.w = pk2(v[6] * (1.f - m[6]), v[7] * (1.f - m[7]));
            o2.x = pk2(v[0] * m[0], v[1] * m[1]); o2.y = pk2(v[2] * m[2], v[3] * m[3]); o2.z = pk2(v[4] * m[4], v[5] * m[5]); o2.w = pk2(v[6] * m[6], v[7] * m[7]);
            *(GAS v4u*)dst = o; *(GAS v4u*)(dst + 1024) = o2;
        } else {
            v4u o; o.x = pk2(v[0], v[1]); o.y = pk2(v[2], v[3]); o.z = pk2(v[4], v[5]); o.w = pk2(v[6], v[7]);
            *(GAS v4u*)dst = o; }
    }
    LDS_WAIT(); asm volatile("" ::: "memory");
}

struct In {
    const float *x, *p, *rel_bias, *norm_mix, *ab_w_in, *ab_w_out, *lam_q1, *lam_k1, *lam_q2, *lam_k2, *sub_g, *conv_w, *conv_b, *lru_wa, *lru_ba, *lru_wx, *lru_bx, *lru_lambda,
        *rwkv_mu, *rwkv_wr, *rwkv_wk, *rwkv_wv, *rwkv_wo, *rwkv_w0, *rwkv_w1, *rwkv_w2, *rwkv_a0, *rwkv_a1, *rwkv_a2, *rwkv_g1, *rwkv_g2, *rwkv_kk, *rwkv_ka, *rwkv_rk, *rwkv_ln_g, *rwkv_ln_b,
        *norm_ffn, *moe_wc, *moe_bc, *moe_wf, *moe_bf, *moe_w_gu, *moe_w_down, *ple_norm, *ple_gate, *ple_proj, *final_norm;
};

__device__ __forceinline__ void prep_dense_weights(Frame& F, const In& I, unsigned char* ws) {
    LAS float* scr = (LAS float*)(F.lds + F.wave * 16384);
    const int gw = F.vcu * NWAVES + F.wave, NGW = F.G * NWAVES;
    bf16* WIN = (bf16*)(ws + WS_WIN); bf16* WOUT = (bf16*)(ws + WS_WOUT); bf16* PG = (bf16*)(ws + WS_PGATE); bf16* PPJ = (bf16*)(ws + WS_PPROJ);
    bf16* RCAT = (bf16*)(ws + WS_RCAT); bf16* RL1 = (bf16*)(ws + WS_RL1); bf16* RWO = (bf16*)(ws + WS_RWO);
    constexpr int I_IN = (1024 / 64) * (2560 / 32), I_SQ = (1024 / 64) * (1024 / 32), I_PJ = (256 / 64) * (1024 / 32), I_L64 = (1024 / 64) * (64 / 32), I_L160 = (1024 / 64) * (160 / 32);
    int st = gw;
#define TJOB(MODE, NITEMS, W, K, N, WT, LDO, ROFF, MU) do { for (int it = st; it < (NITEMS); it += NGW) transpose_item<MODE>(W, K, N, WT, LDO, ROFF, MU, scr, it, LANE_); \
        st = (st + NGW - ((NITEMS) % NGW)) % NGW; asm volatile("" : "+s"(st)); } while (0)
    TJOB(0, I_IN, I.ab_w_in, 1024, 2560, WIN, 1024, 0, nullptr);
    TJOB(0, I_SQ, I.ab_w_out, 1024, 1024, WOUT, 1024, 0, nullptr);
    TJOB(0, I_SQ, I.ple_gate, 1024, 1024, PG, 1024, 0, nullptr);
    TJOB(0, I_SQ, I.ple_gate + 1024 * 1024, 1024, 1024, PG + 1024 * 1024, 1024, 0, nullptr);
    TJOB(0, I_SQ, I.rwkv_wo, 1024, 1024, RWO, 1024, 0, nullptr);
    TJOB(0, I_SQ, I.rwkv_wr, 1024, 1024, RCAT, 1024, 0, nullptr);
    TJOB(0, I_SQ, I.rwkv_wk, 1024, 1024, RCAT, 1024, 1024, nullptr);
    TJOB(0, I_SQ, I.rwkv_wv, 1024, 1024, RCAT, 1024, 2048, nullptr);
    TJOB(0, I_PJ, I.ple_proj, 256, 1024, PPJ, 256, 0, nullptr);
    TJOB(0, I_PJ, I.ple_proj + 256 * 1024, 256, 1024, PPJ + 1024 * 256, 256, 0, nullptr);
    TJOB(1, I_L64, I.rwkv_w1, 1024, 64, RL1, 2048, 0, I.rwkv_mu + 1 * 1024);
    TJOB(1, I_L64, I.rwkv_a1, 1024, 64, RL1, 2048, 64, I.rwkv_mu + 4 * 1024);
    TJOB(1, I_L160, I.rwkv_g1, 1024, 160, RL1, 2048, 256, I.rwkv_mu + 5 * 1024);
#undef TJOB
    const int gt = F.vcu * 512 + TID_, NGT = F.G * 512;
    { v4u z = {0u, 0u, 0u, 0u}; const int per_row = 2048 / 8;
      for (int i = gt; i < (128 + 96) * per_row; i += NGT) { int rr = i / per_row, cc = i % per_row; rr = (rr < 128) ? (128 + rr) : (416 + rr - 128); *(GAS v4u*)(RL1 + (size_t)rr * 2048 + cc * 8) = z; } }
    { bf16* S2 = (bf16*)(ws + WS_RS2);
      for (int i = gt; i < 3 * 1024 * 256; i += NGT) { const int ty = i / (1024 * 256), n = (i / 256) & 1023, k = i & 255; float v = 0.f;
          if (ty == 0) { if (k < 64) v = I.rwkv_w2[k * 1024 + n]; } else if (ty == 1) { if (k >= 64 && k < 128) v = I.rwkv_a2[(k - 64) * 1024 + n]; } else { if (k < 160) v = I.rwkv_g2[k * 1024 + n]; }
          S2[i] = (bf16)f2bf(v); } }
    { bf16* RT = (bf16*)(ws + WS_ROUT);
      for (int i = gt; i < 2 * 256 * 1024; i += NGT) { const int l = i / (256 * 1024), n = (i / 1024) & 255, k = i & 1023; float v = 0.f;
          if (n < 4) v = I.moe_wc[(size_t)l * 1024 * 4 + k * 4 + n]; else if (n < 36) v = I.moe_wf[(size_t)l * 1024 * 32 + k * 32 + (n - 4)];
          RT[i] = (bf16)f2bf(v); } }
}
__device__ __forceinline__ void prep_layer_weights(Frame& F, const In& I, unsigned char* ws, int layer) {
    LAS float* scr = (LAS float*)(F.lds + F.wave * 16384);
    const int gw = F.vcu * NWAVES + F.wave, NGW = F.G * NWAVES;
    bf16* MGU = (bf16*)(ws + WS_MGU); bf16* MDN = (bf16*)(ws + WS_MDN);
    const float* wgu = I.moe_w_gu + (size_t)layer * NEXP * 1024 * 1024; const float* wdn = I.moe_w_down + (size_t)layer * NEXP * 512 * 1024;
    constexpr int I_GU = (1024 / 64) * (1024 / 32), I_DN = (512 / 64) * (1024 / 32);
    for (int it = gw; it < NEXP * (I_GU + I_DN); it += NGW) {
        const int e = it / (I_GU + I_DN); int r = it % (I_GU + I_DN);
        if (r < I_GU) transpose_item<2>(wgu + (size_t)e * 1024 * 1024, 1024, 1024, MGU + (size_t)e * 1024 * 1024, 1024, 0, nullptr, scr, r, LANE_);
        else transpose_item<0>(wdn + (size_t)e * 512 * 1024, 512, 1024, MDN + (size_t)e * 1024 * 512, 512, 0, nullptr, scr, r - I_GU, LANE_);
    }
    const int gt = F.vcu * 512 + TID_, NGT = F.G * 512;
    const f32x4* ps = (const f32x4*)(I.p + (size_t)layer * T * PLE); v2u* pd = (v2u*)(ws + WS_PB);
    for (int i = gt; i < T * PLE / 4; i += 4 * NGT) { f32x4 v[4];
#pragma unroll
        for (int r = 0; r < 4; ++r) v[r] = ps[i + r * NGT];
#pragma unroll
        for (int r = 0; r < 4; ++r) { v2u o; o.x = pk2(v[r].x, v[r].y); o.y = pk2(v[r].z, v[r].w); pd[i + r * NGT] = o; } }
}

template <bool XBF>
__device__ __forceinline__ void norm_pass(Frame& F, const void* x, const float* g, bf16* out) {
    const int gw = F.vcu * NWAVES + F.wave, NGW = F.G * NWAVES; const int lane = LANE_;
    for (int t = 4 * gw; t < T; t += 4 * NGW) {
        f32x4 v[4][4];
#pragma unroll
        for (int r = 0; r < 4; ++r) { if (XBF) load_row4_bf((const bf16*)x + (size_t)(t + r) * D, lane, v[r]); else load_row4((const float*)x + (size_t)(t + r) * D, lane, v[r]); }
#pragma unroll
        for (int r = 0; r < 4; ++r) { const float rs = row_rstd(v[r], 1e-6f); store_row_bf16(out + (size_t)(t + r) * D, lane, v[r], rs, g); }
    }
}
__device__ __forceinline__ void rwkv_input_pass(Frame& F, const bf16* x, const float* g, const float* mu, bf16* HCAT, bf16* XR, bf16* XK, bf16* XV) {
    const int gw = F.vcu * NWAVES + F.wave, NGW = F.G * NWAVES; const int lane = LANE_;
    f32x4 gg[4], mr[4], mk[4], mv[4];
#pragma unroll
    for (int j = 0; j < 4; ++j) { gg[j] = ((const f32x4*)g)[lane + 64 * j]; mr[j] = ((const f32x4*)(mu + 0 * 1024))[lane + 64 * j]; mk[j] = ((const f32x4*)(mu + 2 * 1024))[lane + 64 * j]; mv[j] = ((const f32x4*)(mu + 3 * 1024))[lane + 64 * j]; }
    for (int blk = gw; blk < T / 32; blk += NGW) {
        const int t0 = blk * 32; f32x4 hp[4];
        if ((t0 & (SEQ - 1)) == 0) {
#pragma unroll
            for (int j = 0; j < 4; ++j) hp[j] = (f32x4){0.f, 0.f, 0.f, 0.f};
        } else { f32x4 v[4]; load_row4_bf(x + (size_t)(t0 - 1) * D, lane, v); const float rstd = row_rstd(v, 1e-6f);
#pragma unroll
            for (int j = 0; j < 4; ++j) hp[j] = v[j] * rstd * gg[j]; }
        f32x4 vn[4]; load_row4_bf(x + (size_t)t0 * D, lane, vn);
        for (int t = t0; t < t0 + 32; ++t) {
            f32x4 v[4];
#pragma unroll
            for (int j = 0; j < 4; ++j) v[j] = vn[j];
            if (t + 1 < t0 + 32) load_row4_bf(x + (size_t)(t + 1) * D, lane, vn);
            const float rstd = row_rstd(v, 1e-6f);
            unsigned long long* oh = (unsigned long long*)(HCAT + (size_t)t * 2048) + lane; unsigned long long* or_ = (unsigned long long*)(XR + (size_t)t * 1024) + lane;
            unsigned long long* ok = (unsigned long long*)(XK + (size_t)t * 1024) + lane; unsigned long long* ov = (unsigned long long*)(XV + (size_t)t * 1024) + lane;
#pragma unroll
            for (int j = 0; j < 4; ++j) { const f32x4 h = v[j] * rstd * gg[j], dd = hp[j] - h;
                oh[64 * j] = (unsigned long long)pk2(h.x, h.y) | ((unsigned long long)pk2(h.z, h.w) << 32);
                oh[256 + 64 * j] = (unsigned long long)pk2(hp[j].x, hp[j].y) | ((unsigned long long)pk2(hp[j].z, hp[j].w) << 32);
                const f32x4 a = h + dd * mr[j], b = h + dd * mk[j], c = h + dd * mv[j];
                or_[64 * j] = (unsigned long long)pk2(a.x, a.y) | ((unsigned long long)pk2(a.z, a.w) << 32);
                ok[64 * j] = (unsigned long long)pk2(b.x, b.y) | ((unsigned long long)pk2(b.z, b.w) << 32);
                ov[64 * j] = (unsigned long long)pk2(c.x, c.y) | ((unsigned long long)pk2(c.z, c.w) << 32);
                hp[j] = h; }
        }
    }
}
__device__ __forceinline__ void combine_norm_pass(Frame& F, const bf16* xin, bf16* xout, const bf16* YS, const int* slot, const float* g, bf16* out) {
    const int gw = F.vcu * NWAVES + F.wave, NGW = F.G * NWAVES; const int lane = LANE_;
    for (int t = 2 * gw; t < T; t += 2 * NGW) {
        f32x4 v[2][4]; v2u ya[2][4], yb[2][4];
#pragma unroll
        for (int r = 0; r < 2; ++r) { load_row4_bf(xin + (size_t)(t + r) * D, lane, v[r]);
            const int s0 = slot[2 * (t + r)], s1 = slot[2 * (t + r) + 1];
            const v2u* y0 = (const v2u*)(YS + (size_t)s0 * D) + lane; const v2u* y1 = (const v2u*)(YS + (size_t)s1 * D) + lane;
#pragma unroll
            for (int j = 0; j < 4; ++j) { ya[r][j] = y0[64 * j]; yb[r][j] = y1[64 * j]; } }
#pragma unroll
        for (int r = 0; r < 2; ++r) {
#pragma unroll
            for (int j = 0; j < 4; ++j) { const v2u a = ya[r][j], b = yb[r][j];
                v[r][j].x += bflo(a.x) + bflo(b.x); v[r][j].y += bfhi(a.x) + bfhi(b.x); v[r][j].z += bflo(a.y) + bflo(b.y); v[r][j].w += bfhi(a.y) + bfhi(b.y); }
            store_row4_bf(xout + (size_t)(t + r) * D, lane, v[r]);
            const float rstd = row_rstd(v[r], 1e-6f);
            store_row_bf16(out + (size_t)(t + r) * D, lane, v[r], rstd, g); }
    }
}
__device__ __forceinline__ void final_norm_pass(Frame& F, const bf16* x, float* out, const float* g) {
    const int gw = F.vcu * NWAVES + F.wave, NGW = F.G * NWAVES; const int lane = LANE_;
    for (int t = 4 * gw; t < T; t += 4 * NGW) {
        f32x4 v[4][4];
#pragma unroll
        for (int r = 0; r < 4; ++r) load_row4_bf(x + (size_t)(t + r) * D, lane, v[r]);
#pragma unroll
        for (int r = 0; r < 4; ++r) { const float rs = row_rstd(v[r], 1e-6f); f32x4* xo = (f32x4*)(out + (size_t)(t + r) * D) + lane;
#pragma unroll
            for (int j = 0; j < 4; ++j) { const f32x4 gg = ((const f32x4*)g)[lane + 64 * j]; xo[64 * j] = v[r][j] * rs * gg; } }
    }
}

__device__ __forceinline__ void diff_combine_pass(Frame& F, const In& I, const bf16* O, bf16* YCAT) {
    const int gw = F.vcu * NWAVES + F.wave, NGW = F.G * NWAVES;
    const float lam_init = 0.2f;
    const float d1 = wave_sum(I.lam_q1[LANE_] * I.lam_k1[LANE_]), d2 = wave_sum(I.lam_q2[LANE_] * I.lam_k2[LANE_]);
    const float lam = expf(d1) - expf(d2) + lam_init;
    const int h = LANE_ >> 4, q = LANE_ & 15;
    float sg[8];
#pragma unroll
    for (int e = 0; e < 8; ++e) sg[e] = I.sub_g[q * 8 + e] * (1.0f - lam_init);
    for (int t0 = 4 * gw; t0 < T; t0 += 4 * NGW) {
        v4u av[4], bv[4];
#pragma unroll
        for (int r = 0; r < 4; ++r) { av[r] = *(const v4u*)(O + (size_t)(t0 + r) * 1024 + h * 256 + q * 8); bv[r] = *(const v4u*)(O + (size_t)(t0 + r) * 1024 + h * 256 + 128 + q * 8); }
#pragma unroll
        for (int r = 0; r < 4; ++r) { const v4u a = av[r], b = bv[r]; const int t = t0 + r;
        float o[8];
        o[0] = bflo(a.x) - lam * bflo(b.x); o[1] = bfhi(a.x) - lam * bfhi(b.x); o[2] = bflo(a.y) - lam * bflo(b.y); o[3] = bfhi(a.y) - lam * bfhi(b.y);
        o[4] = bflo(a.z) - lam * bflo(b.z); o[5] = bfhi(a.z) - lam * bfhi(b.z); o[6] = bflo(a.w) - lam * bflo(b.w); o[7] = bfhi(a.w) - lam * bfhi(b.w);
        float s = 0.f;
#pragma unroll
        for (int e = 0; e < 8; ++e) s += o[e] * o[e];
        s += __shfl_xor(s, 1); s += __shfl_xor(s, 2); s += __shfl_xor(s, 4); s += __shfl_xor(s, 8);
        const float rstd = 1.0f / sqrtf(s * (1.0f / 128.0f) + 1e-5f);
        v4u w; w.x = pk2(o[0] * rstd * sg[0], o[1] * rstd * sg[1]); w.y = pk2(o[2] * rstd * sg[2], o[3] * rstd * sg[3]); w.z = pk2(o[4] * rstd * sg[4], o[5] * rstd * sg[5]); w.w = pk2(o[6] * rstd * sg[6], o[7] * rstd * sg[7]);
        *(v4u*)(YCAT + (size_t)t * 1024 + h * 128 + q * 8) = w; }
    }
}

constexpr int LCT = 64, LNCH = SEQ / LCT;
__device__ __forceinline__ float gelu_tanh(float x) { const float u = 0.7978845608028654f * (x + 0.044715f * x * x * x); return x * sigmoidf_(2.0f * u); }
template <bool FINAL>
__device__ __forceinline__ void lru_phase(Frame& F, const In& I, const bf16* XB, const bf16* GB, f32x2* AGG, bf16* YCAT, bf16* HLp, bf16* CAp) {
    const int ch = TID_, n = ch >> 6, d = ch & 63;
    LAS float* U = (LAS float*)F.lds;
    f32x2 wg[64];
#pragma unroll
    for (int c = 0; c < 64; ++c) { wg[c].x = I.lru_wa[n * 4096 + c * 64 + d]; wg[c].y = I.lru_wx[n * 4096 + c * 64 + d]; }
    const float cw0 = I.conv_w[0 * 512 + ch], cw1 = I.conv_w[1 * 512 + ch], cw2 = I.conv_w[2 * 512 + ch], cw3 = I.conv_w[3 * 512 + ch], cb = I.conv_b[ch];
    const float ba = I.lru_ba[ch], bx = I.lru_bx[ch];
    const float lam = I.lru_lambda[ch]; const float sp = (lam > 15.f) ? expf(-lam) : log1pf(expf(-lam));
    const float m8sp = -8.0f * sp;
    for (int un = blockIdx.x; un < NB * LNCH; un += F.G) {
        const int b = un / LNCH, c = un % LNCH; const size_t row0 = (size_t)b * SEQ + (size_t)c * LCT;
        unsigned short xraw[LCT + 3];
        if (c > 0) { xraw[0] = XB[(row0 - 3) * 512 + ch]; xraw[1] = XB[(row0 - 2) * 512 + ch]; xraw[2] = XB[(row0 - 1) * 512 + ch]; } else { xraw[0] = 0; xraw[1] = 0; xraw[2] = 0; }
#pragma unroll
        for (int tk = 0; tk < LCT; ++tk) xraw[3 + tk] = XB[(row0 + tk) * 512 + ch];
        float h = 0.f, Ap = 1.f;
        if (FINAL) { for (int j = 0; j < c; ++j) { const f32x2 ag = AGG[((size_t)b * LNCH + j) * 512 + ch]; h = ag.x * h + ag.y; } }
#pragma unroll
        for (int tk = 0; tk < LCT; ++tk) U[tk * 512 + ch] = cw0 * bf1(xraw[tk]) + cw1 * bf1(xraw[tk + 1]) + cw2 * bf1(xraw[tk + 2]) + cw3 * bf1(xraw[tk + 3]) + cb;
        __syncthreads();
        unsigned short gcur[8], gnxt[8];
        if (FINAL) {
#pragma unroll
            for (int j = 0; j < 8; ++j) gcur[j] = GB[(row0 + j) * 512 + ch]; }
#pragma unroll 1
        for (int tg = 0; tg < LCT / 8; ++tg) {
            if (FINAL) { const int tn = (tg + 1 < LCT / 8) ? (tg + 1) * 8 : tg * 8;
#pragma unroll
                for (int j = 0; j < 8; ++j) gnxt[j] = GB[(row0 + tn + j) * 512 + ch]; }
#pragma unroll
            for (int j = 0; j < 8; ++j) { const int tk = tg * 8 + j;
                const LAS f32x4* up = (const LAS f32x4*)(U + tk * 512 + n * 64);
                f32x2 acc = {ba, bx};
#pragma unroll
                for (int c4 = 0; c4 < 16; ++c4) { const f32x4 uu = up[c4];
                    acc += wg[4 * c4 + 0] * uu.x; acc += wg[4 * c4 + 1] * uu.y; acc += wg[4 * c4 + 2] * uu.z; acc += wg[4 * c4 + 3] * uu.w; }
                const float r = sigmoidf_(acc.x), ig = sigmoidf_(acc.y);
                const float la = r * m8sp; const float a = __expf(la); const float t2 = 2.0f * la; const float om = (t2 > -0.02f) ? -t2 * (1.0f + t2 * (0.5f + t2 * (0.16666667f + t2 * 0.041666668f))) : 1.0f - a * a; const float bb = __builtin_amdgcn_sqrtf(om) * (ig * U[tk * 512 + ch]);
                h = a * h + bb;
                if (FINAL) { YCAT[(row0 + tk) * 1024 + 512 + ch] = (bf16)f2bf(h * gelu_tanh(bf1(gcur[j]))); }
                else { Ap *= a; HLp[(row0 + tk) * 512 + ch] = (bf16)f2bf(h); CAp[(row0 + tk) * 512 + ch] = (bf16)f2bf(Ap); } }
            if (FINAL) {
#pragma unroll
                for (int j = 0; j < 8; ++j) gcur[j] = gnxt[j]; }
        }
        if (!FINAL) { f32x2 ag; ag.x = Ap; ag.y = h; AGG[((size_t)b * LNCH + c) * 512 + ch] = ag; }
        __syncthreads();
    }
}

__device__ __forceinline__ void lru_agg_mfma(Frame& F, const In& I, const bf16* XB, f32x2* AGG, bf16* HLp, bf16* CAp) {
    const int tid = TID_, lane = tid & 63, fr = lane & 15, fq = lane >> 4, n = F.wave, ch = tid;
    constexpr int UP = 520;
    LAS bf16* U = (LAS bf16*)F.lds;
    bf16x8 Wr[4][2], Wi[4][2];
#pragma unroll
    for (int dd = 0; dd < 4; ++dd)
#pragma unroll
        for (int kh = 0; kh < 2; ++kh) { unsigned pr_[4], pi_[4];
#pragma unroll
            for (int j = 0; j < 4; ++j) { const int c0 = 32 * kh + 8 * fq + 2 * j, d = 16 * dd + fr;
                pr_[j] = pk2(I.lru_wa[n * 4096 + c0 * 64 + d], I.lru_wa[n * 4096 + (c0 + 1) * 64 + d]); pi_[j] = pk2(I.lru_wx[n * 4096 + c0 * 64 + d], I.lru_wx[n * 4096 + (c0 + 1) * 64 + d]); }
            Wr[dd][kh] = __builtin_bit_cast(bf16x8, (v4u){pr_[0], pr_[1], pr_[2], pr_[3]}); Wi[dd][kh] = __builtin_bit_cast(bf16x8, (v4u){pi_[0], pi_[1], pi_[2], pi_[3]}); }
    float cba[4], cbx[4], cm8[4];
#pragma unroll
    for (int dd = 0; dd < 4; ++dd) { const int chd = 64 * n + 16 * dd + fr; cba[dd] = I.lru_ba[chd]; cbx[dd] = I.lru_bx[chd];
        const float lam = I.lru_lambda[chd]; cm8[dd] = -8.0f * ((lam > 15.f) ? expf(-lam) : log1pf(expf(-lam))); }
    const float cw0 = I.conv_w[0 * 512 + ch], cw1 = I.conv_w[1 * 512 + ch], cw2 = I.conv_w[2 * 512 + ch], cw3 = I.conv_w[3 * 512 + ch], cb = I.conv_b[ch];
    for (int un = blockIdx.x; un < NB * LNCH; un += F.G) {
        const int b = un / LNCH, c = un % LNCH; const size_t row0 = (size_t)b * SEQ + (size_t)c * LCT;
        unsigned short xraw[LCT + 3];
        if (c > 0) { xraw[0] = XB[(row0 - 3) * 512 + ch]; xraw[1] = XB[(row0 - 2) * 512 + ch]; xraw[2] = XB[(row0 - 1) * 512 + ch]; } else { xraw[0] = 0; xraw[1] = 0; xraw[2] = 0; }
#pragma unroll
        for (int tk = 0; tk < LCT; ++tk) xraw[3 + tk] = XB[(row0 + tk) * 512 + ch];
#pragma unroll
        for (int tk = 0; tk < LCT; ++tk) U[tk * UP + ch] = (bf16)f2bf(cw0 * bf1(xraw[tk]) + cw1 * bf1(xraw[tk + 1]) + cw2 * bf1(xraw[tk + 2]) + cw3 * bf1(xraw[tk + 3]) + cb);
        __syncthreads();
        bf16x8 X[4][2];
#pragma unroll
        for (int tt = 0; tt < 4; ++tt)
#pragma unroll
            for (int kh = 0; kh < 2; ++kh) X[tt][kh] = *(const LAS bf16x8*)(U + (16 * tt + fr) * UP + 64 * n + 32 * kh + 8 * fq);
#pragma unroll 1
        for (int dd = 0; dd < 4; ++dd) {
            bf16x8 wr0, wr1, wi0, wi1; float kba, kbx, km8;
            if (dd == 0) { wr0 = Wr[0][0]; wr1 = Wr[0][1]; wi0 = Wi[0][0]; wi1 = Wi[0][1]; kba = cba[0]; kbx = cbx[0]; km8 = cm8[0]; }
            else if (dd == 1) { wr0 = Wr[1][0]; wr1 = Wr[1][1]; wi0 = Wi[1][0]; wi1 = Wi[1][1]; kba = cba[1]; kbx = cbx[1]; km8 = cm8[1]; }
            else if (dd == 2) { wr0 = Wr[2][0]; wr1 = Wr[2][1]; wi0 = Wi[2][0]; wi1 = Wi[2][1]; kba = cba[2]; kbx = cbx[2]; km8 = cm8[2]; }
            else { wr0 = Wr[3][0]; wr1 = Wr[3][1]; wi0 = Wi[3][0]; wi1 = Wi[3][1]; kba = cba[3]; kbx = cbx[3]; km8 = cm8[3]; }
            const int chd = 64 * n + 16 * dd + fr;
            float hc = 0.f, Ac = 1.f;
#pragma unroll
            for (int tt = 0; tt < 4; ++tt) {
                f32x4 pr = (f32x4){0.f, 0.f, 0.f, 0.f}, pi = pr;
                pr = __builtin_amdgcn_mfma_f32_16x16x32_bf16(X[tt][0], wr0, pr, 0, 0, 0); pr = __builtin_amdgcn_mfma_f32_16x16x32_bf16(X[tt][1], wr1, pr, 0, 0, 0);
                pi = __builtin_amdgcn_mfma_f32_16x16x32_bf16(X[tt][0], wi0, pi, 0, 0, 0); pi = __builtin_amdgcn_mfma_f32_16x16x32_bf16(X[tt][1], wi1, pi, 0, 0, 0);
                float a[4], bb[4];
#pragma unroll
                for (int e = 0; e < 4; ++e) { const int tok = 16 * tt + 4 * fq + e; const float u = bf1(U[tok * UP + chd]);
                    const float r = sigmoidf_(pr[e] + kba), ig = sigmoidf_(pi[e] + kbx); const float la = r * km8; a[e] = __expf(la); const float t2 = 2.0f * la;
                    const float om = (t2 > -0.02f) ? -t2 * (1.0f + t2 * (0.5f + t2 * (0.16666667f + t2 * 0.041666668f))) : 1.0f - a[e] * a[e]; bb[e] = __builtin_amdgcn_sqrtf(om) * (ig * u); }
                const float A4 = (a[0] * a[1]) * (a[2] * a[3]); const float B4 = ((bb[0] * a[1] + bb[1]) * a[2] + bb[2]) * a[3] + bb[3];
                float h = hc, Ap = Ac, hs = hc, As = Ac;
#pragma unroll
                for (int j = 0; j < 4; ++j) { const float Aj = __shfl(A4, fr + 16 * j), Bj = __shfl(B4, fr + 16 * j); if (j == fq) { hs = h; As = Ap; } h = Aj * h + Bj; Ap *= Aj; }
                hc = h; Ac = Ap; h = hs; Ap = As;
#pragma unroll
                for (int e = 0; e < 4; ++e) { h = a[e] * h + bb[e]; Ap *= a[e]; const size_t o = (row0 + 16 * tt + 4 * fq + e) * 512 + chd; HLp[o] = (bf16)f2bf(h); CAp[o] = (bf16)f2bf(Ap); }
            }
            if (fq == 0) { f32x2 ag; ag.x = Ac; ag.y = hc; AGG[((size_t)b * LNCH + c) * 512 + chd] = ag; }
        }
        __syncthreads();
    }
}

__device__ __forceinline__ void lru_final_pass(Frame& F, const bf16* HLp, const bf16* CAp, const bf16* GB, const f32x2* AGG, bf16* YCAT) {
    const int ch = TID_;
    for (int un = blockIdx.x; un < NB * LNCH; un += F.G) {
        const int b = un / LNCH, c = un % LNCH; const size_t row0 = (size_t)b * SEQ + (size_t)c * LCT;
        float carry = 0.f;
        for (int j = 0; j < c; ++j) { const f32x2 ag = AGG[((size_t)b * LNCH + j) * 512 + ch]; carry = ag.x * carry + ag.y; }
#pragma unroll 4
        for (int t8 = 0; t8 < LCT; t8 += 8) {
            bf16 hl[8], ca[8], gv[8];
#pragma unroll
            for (int j = 0; j < 8; ++j) { const size_t o = (row0 + t8 + j) * 512 + ch; hl[j] = HLp[o]; ca[j] = CAp[o]; gv[j] = GB[o]; }
#pragma unroll
            for (int j = 0; j < 8; ++j) { const float h = bf1(hl[j]) + bf1(ca[j]) * carry; YCAT[(row0 + t8 + j) * 1024 + 512 + ch] = (bf16)f2bf(h * gelu_tanh(bf1(gv[j]))); }
        }
    }
}

__device__ __forceinline__ void route_pass_a(Frame& F, const In& I, int layer, const float* LOG, unsigned char* rt, gu32* cnt) {
    LAS int* lcnt = (LAS int*)(F.lds + RTE_OFF); LAS int* lbase = lcnt + 32;
    int* EID = (int*)(rt + RT_EID); int* POS = (int*)(rt + RT_POS); float* GATE = (float*)(rt + RT_GATE);
    const float* bc = I.moe_bc + layer * 4; const float* bfb = I.moe_bf + layer * 32;
    for (int un = blockIdx.x; un < T / 512; un += F.G) {
        if (TID_ < 32) lcnt[TID_] = 0;
        __syncthreads();
        const int t = un * 512 + TID_; const float* lg = LOG + (size_t)t * 64;
        const f32x4 g4 = *(const f32x4*)lg;
        float gl[4] = {g4.x + bc[0], g4.y + bc[1], g4.z + bc[2], g4.w + bc[3]};
        int gi = 0; float gm = gl[0];
#pragma unroll
        for (int j = 1; j < 4; ++j) if (gl[j] > gm) { gm = gl[j]; gi = j; }
        float gs = 0.f;
#pragma unroll
        for (int j = 0; j < 4; ++j) gs += __expf(gl[j] - gm);
        const float gprob = 1.0f / gs;
        const f32x4 e0 = *(const f32x4*)(lg + 4 + gi * 8), e1 = *(const f32x4*)(lg + 8 + gi * 8);
        float el[8] = {e0.x, e0.y, e0.z, e0.w, e1.x, e1.y, e1.z, e1.w};
#pragma unroll
        for (int j = 0; j < 8; ++j) el[j] += bfb[gi * 8 + j];
        int i0 = 0; float m0 = el[0];
#pragma unroll
        for (int j = 1; j < 8; ++j) if (el[j] > m0) { m0 = el[j]; i0 = j; }
        int i1 = -1; float m1 = -INFINITY;
#pragma unroll
        for (int j = 0; j < 8; ++j) if (j != i0 && el[j] > m1) { m1 = el[j]; i1 = j; }
        const float r1 = __expf(m1 - m0); const float g0 = gprob / (1.0f + r1), g1 = gprob * r1 / (1.0f + r1);
        const int ex0 = gi * 8 + i0, ex1 = gi * 8 + i1;
        const int p0 = atomicAdd((int*)&lcnt[ex0], 1), p1 = atomicAdd((int*)&lcnt[ex1], 1);
        __syncthreads();
        if (TID_ < 32) lbase[TID_] = (int)__hip_atomic_fetch_add(cnt + TID_, (unsigned)lcnt[TID_], RLX_AGENT);
        __syncthreads();
        EID[2 * t] = ex0; EID[2 * t + 1] = ex1; POS[2 * t] = lbase[ex0] + p0; POS[2 * t + 1] = lbase[ex1] + p1; GATE[2 * t] = g0; GATE[2 * t + 1] = g1;
        __syncthreads();
    }
}
__device__ __forceinline__ void route_bases(Frame& F, gu32* cnt) {
    LAS int* eb = (LAS int*)(F.lds + RTE_OFF + 512);
    const int tid = TID_;
    if (tid < 64) {
        const int c = (tid < 32) ? (int)__hip_atomic_load(cnt + (tid & 31), RLX_AGENT) : 0; const int p = (c + 255) & ~255; int s = p;
#pragma unroll
        for (int o = 1; o < 32; o <<= 1) { const int t = __shfl_up(s, o); if ((tid & 63) >= o) s += t; }
        if (tid < 32) { eb[tid] = s - p; if (tid == 31) eb[32] = s; }
    }
    __syncthreads();
}
__device__ __forceinline__ void route_pass_b(Frame& F, unsigned char* rt, gu32* cnt) {
    route_bases(F, cnt);
    LAS int* eb = (LAS int*)(F.lds + RTE_OFF + 512);
    const int* EID = (const int*)(rt + RT_EID); const int* POS = (const int*)(rt + RT_POS); const float* GATE = (const float*)(rt + RT_GATE);
    int* ROWTOK = (int*)(rt + RT_ROWTOK); float* ROWGATE = (float*)(rt + RT_ROWGATE); int* SLOT = (int*)(rt + RT_SLOT);
    const int gt = F.vcu * 512 + TID_, NGT = F.G * 512;
    for (int i = gt; i < 2 * T; i += NGT) { const int dst = eb[EID[i]] + POS[i]; ROWTOK[dst] = i >> 1; ROWGATE[dst] = GATE[i]; SLOT[i] = dst; }
    for (int i = gt; i < 32 * 256; i += NGT) { const int e = i >> 8, j = i & 255; const int c = (int)__hip_atomic_load(cnt + e, RLX_AGENT); const int pad = ((c + 255) & ~255) - c;
        if (j < pad) { ROWTOK[eb[e] + c + j] = 0; ROWGATE[eb[e] + c + j] = 0.f; } }
    __syncthreads();
}
struct MoeOrder {
    int G, c, ntiles; const LAS int* eb; const char* A; const char* W; size_t astep, wexp, wtile; bool gather;
    __device__ bool next(int i, pg8::Unit& u) const {
        const int L = i * G + c; if (L >= ntiles * 4) return false;
        u.pm = L >> 2; u.pn = L & 3; const int s0 = u.pm * 256; int e = 0;
#pragma unroll 1
        for (int j = 1; j < 32; ++j) if (eb[j] <= s0) e = j;
        e = __builtin_amdgcn_readfirstlane(e); u.aux = e; u.A = gather ? A : A + (size_t)u.pm * astep; u.B = W + (size_t)e * wexp + (size_t)u.pn * wtile; return true;
    }
};

constexpr int RTC = 32, RNCH = SEQ / RTC, RTOK = 352;
#define LBAR() do { asm volatile("s_waitcnt lgkmcnt(0)" ::: "memory"); __builtin_amdgcn_s_barrier(); asm volatile("" ::: "memory"); } while (0)
template <int CTRL> __device__ __forceinline__ float dpp_f(float v) { return __builtin_bit_cast(float, __builtin_amdgcn_update_dpp(0, __builtin_bit_cast(int, v), CTRL, 0xf, 0xf, true)); }
__device__ __forceinline__ float red16(float v) { v += dpp_f<0xB1>(v); v += dpp_f<0x4E>(v); v += dpp_f<0x141>(v); v += dpp_f<0x140>(v); return v; }
__device__ __forceinline__ float red8(float v) { v += dpp_f<0xB1>(v); v += dpp_f<0x4E>(v); v += dpp_f<0x141>(v); return v; }
__device__ __forceinline__ void unpack8(const v4u w, float (&f)[8]) { f[0] = bflo(w.x); f[1] = bfhi(w.x); f[2] = bflo(w.y); f[3] = bfhi(w.y); f[4] = bflo(w.z); f[5] = bfhi(w.z); f[6] = bflo(w.w); f[7] = bfhi(w.w); }
__device__ __forceinline__ void rwkv_scan_phase(Frame& F, const In& I, const bf16* R, const bf16* Kt, const bf16* V, const bf16* AA, const bf16* EW, bf16* Y) {
    LAS float* buf = (LAS float*)F.lds;
    LAS float* ybuf = (LAS float*)(F.lds + 2 * RTC * RTOK * 4) + 32;
    const int tid = TID_, lane = tid & 63;
    const int seg = lane & 15, rl = F.wave * 4 + (lane >> 4);
    const int stk = tid >> 4, ssg = tid & 15;
    for (int un = blockIdx.x; un < NB * 16 * 2; un += F.G) {
        const int half = un & 1, h = (un >> 1) & 15, b = un >> 5;
        const size_t rowb = (size_t)b * SEQ;
        const int col = h * 64 + ssg * 4;
        const f32x4 kkw = *(const f32x4*)(I.rwkv_kk + col), kaw = *(const f32x4*)(I.rwkv_ka + col);
        v2u rr, kr, vr, ar, er;
#define RAW_LOAD(cc) do { const size_t off = (rowb + (size_t)(cc) * RTC + stk) * 1024 + col; rr = *(const v2u*)(R + off); kr = *(const v2u*)(Kt + off); vr = *(const v2u*)(V + off); ar = *(const v2u*)(AA + off); er = *(const v2u*)(EW + off); } while (0)
#define RAW_CONVERT(cc) do { LAS float* tp = buf + ((cc) & 1) * (RTC * RTOK) + stk * RTOK + ssg * 4; \
            const float r0 = bflo(rr.x), r1 = bfhi(rr.x), r2 = bflo(rr.y), r3 = bfhi(rr.y), k0 = bflo(kr.x), k1 = bfhi(kr.x), k2 = bflo(kr.y), k3 = bfhi(kr.y); \
            const float a0 = bflo(ar.x), a1 = bfhi(ar.x), a2 = bflo(ar.y), a3 = bfhi(ar.y); \
            const float x0 = k0 * kkw.x, x1 = k1 * kkw.y, x2 = k2 * kkw.z, x3 = k3 * kkw.w; \
            const float ss = red16((x0 * x0 + x1 * x1) + (x2 * x2 + x3 * x3)); const float inv = __builtin_amdgcn_rsqf(fmaxf(ss, 1e-24f)); \
            *(LAS f32x4*)(tp) = (f32x4){__expf(-bflo(er.x)), __expf(-bfhi(er.x)), __expf(-bflo(er.y)), __expf(-bfhi(er.y))}; \
            const f32x4 kkv = (f32x4){x0 * inv, x1 * inv, x2 * inv, x3 * inv}; *(LAS f32x4*)(tp + 64) = kkv; \
            *(LAS f32x4*)(tp + 128) = (f32x4){kkv.x * a0, kkv.y * a1, kkv.z * a2, kkv.w * a3}; \
            *(LAS f32x4*)(tp + 192) = (f32x4){k0 * (1.0f + (a0 - 1.0f) * kaw.x), k1 * (1.0f + (a1 - 1.0f) * kaw.y), k2 * (1.0f + (a2 - 1.0f) * kaw.z), k3 * (1.0f + (a3 - 1.0f) * kaw.w)}; \
            *(LAS f32x4*)(tp + 256) = (f32x4){r0, r1, r2, r3}; \
            if ((ssg >> 3) == half) *(LAS f32x4*)(buf + ((cc) & 1) * (RTC * RTOK) + stk * RTOK + 320 + (ssg & 7) * 4) = (f32x4){bflo(vr.x), bfhi(vr.x), bflo(vr.y), bfhi(vr.y)}; } while (0)
#define Y_WRITE(cc) do { const LAS f32x2* yp = (const LAS f32x2*)(ybuf + ((cc) & 1) * (RTC * 32 + 32) + stk * 32 + ssg * 2); const f32x2 yv = *yp; \
            *(unsigned*)(Y + (rowb + (size_t)(cc) * RTC + stk) * 1024 + h * 64 + half * 32 + ssg * 2) = pk2(yv.x, yv.y); } while (0)
        RAW_LOAD(0); RAW_CONVERT(0); RAW_LOAD(1);
        f32x2 S0 = (f32x2){0.f, 0.f}, S1 = (f32x2){0.f, 0.f};
        LBAR();
        for (int c = 0; c < RNCH; ++c) {
            if (c + 1 < RNCH) { RAW_CONVERT(c + 1); }
            if (c + 2 < RNCH) { RAW_LOAD(c + 2); }
            if (c >= 1) { Y_WRITE(c - 1); }
            const LAS float* cb = buf + (c & 1) * (RTC * RTOK); LAS float* yb = ybuf + (c & 1) * (RTC * 32 + 32);
            const LAS float* tp0 = cb + seg * 4; const LAS float* vp0 = cb + 320 + rl;
#define SV_DECL(X) f32x4 X##w, X##q, X##b, X##k, X##r; float X##v
#define SV_LOAD(X, tk) do { const LAS float* tp = tp0 + (tk) * RTOK; \
                X##w = *(const LAS f32x4*)(tp); X##q = *(const LAS f32x4*)(tp + 64); X##b = *(const LAS f32x4*)(tp + 128); X##k = *(const LAS f32x4*)(tp + 192); X##r = *(const LAS f32x4*)(tp + 256); X##v = vp0[(tk) * RTOK]; } while (0)
#define SV_STEP(X, tk) do { \
                const f32x2 d = S0 * (f32x2){X##q.x, X##q.y} + S1 * (f32x2){X##q.z, X##q.w}; \
                const f32x2 t0 = S0 * (f32x2){X##w.x, X##w.y} + (f32x2){X##k.x, X##k.y} * X##v, t1 = S1 * (f32x2){X##w.z, X##w.w} + (f32x2){X##k.z, X##k.w} * X##v; \
                float ra = d.x + d.y, rb = epend;                   \
                ra += dpp_f<0xB1>(ra); rb += dpp_f<0xB1>(rb); ra += dpp_f<0x4E>(ra); rb += dpp_f<0x4E>(rb); ra += dpp_f<0x141>(ra); rb += dpp_f<0x141>(rb); ra += dpp_f<0x140>(ra); rb += dpp_f<0x140>(rb); \
                if (seg == 0) yb[((tk) - 1) * 32 + rl] = rb;        \
                const float sa = -ra; \
                S0 = t0 + (f32x2){X##b.x, X##b.y} * sa; S1 = t1 + (f32x2){X##b.z, X##b.w} * sa; \
                const f32x2 e = S0 * (f32x2){X##r.x, X##r.y} + S1 * (f32x2){X##r.z, X##r.w}; epend = e.x + e.y; } while (0)
            SV_DECL(A_); SV_DECL(B_); float epend = 0.f;
            SV_LOAD(A_, 0);
#pragma unroll 1
            for (int tk = 0; tk < RTC; tk += 2) {
                SV_LOAD(B_, tk + 1);
                SV_STEP(A_, tk);
                { const int t2 = (tk + 2 < RTC) ? tk + 2 : RTC - 1; SV_LOAD(A_, t2); }
                SV_STEP(B_, tk + 1);
            }
#undef SV_DECL
#undef SV_LOAD
#undef SV_STEP
            { const float rb = red16(epend); if (seg == 0) yb[(RTC - 1) * 32 + rl] = rb; }
            LBAR();
        }
        Y_WRITE(RNCH - 1);
        LBAR();
#undef RAW_LOAD
#undef RAW_CONVERT
#undef Y_WRITE
    }
}
constexpr int GS_QT = 0, GS_RT = 2048, GS_BHT = 4096, GS_KHT = 6144, GS_VT = 8192, GS_TM = 10240, GS_TL = 10752, GS_MK = 11264, GS_NK = 11776, GS_NB = 12288, GS_DD = 12800, GS_SLOT = 13056;
constexpr int GS_KT = GS_KHT, GS_BT = GS_BHT, GS_MB = GS_TM;
#ifndef SCAN_NP
#define SCAN_NP 4
#endif
constexpr int CH_NP = SCAN_NP, CH_NS = 8 - CH_NP, CH_ROUNDS = (512 + CH_NP - 1) / CH_NP;
constexpr int CH_KTAB = 2 * CH_NP * GS_SLOT;
static_assert(CH_KTAB + 512 <= 131072, "chunked-scan LDS map");
template <int N> __device__ __forceinline__ float dpp_shr(float v) { return __builtin_bit_cast(float, __builtin_amdgcn_update_dpp(0, __builtin_bit_cast(int, v), 0x110 + N, 0xf, 0xf, true)); }
__device__ __forceinline__ bf16x8 mk8(v2u a, v2u b) { return __builtin_bit_cast(bf16x8, (v4u){a.x, a.y, b.x, b.y}); }
__device__ __forceinline__ bf16x8 mk8z(v2u a) { return __builtin_bit_cast(bf16x8, (v4u){a.x, a.y, 0u, 0u}); }
__device__ __forceinline__ bf16x8 cvt8z(f32x4 v) { return __builtin_bit_cast(bf16x8, (v4u){pk2(v.x, v.y), pk2(v.z, v.w), 0u, 0u}); }
__device__ __forceinline__ int tokoff(const int t, const int c) { return t * 128 + ((c ^ ((t >> 1) & 7)) << 4); }
__device__ __forceinline__ int tokoff2(const int t, const int c) { return t * 128 + ((c ^ (((t >> 1) & 3) << 1)) << 4); }
__device__ __forceinline__ v2u trld(const LAS unsigned char* p) { return __builtin_bit_cast(v2u, __builtin_amdgcn_ds_read_tr16_b64_v4i16((LAS attn_body::v4i16_t*)p)); }
struct ChOps { v4u q0, q1, r0, r1, mn, bt; };
struct ChOpsB { v2u kh[4], bh[4]; f32x4 dv[4]; };
__device__ __forceinline__ void chain_load(ChOps& O, const LAS unsigned char* C, const int fr, const int fq) {
    const int w8 = 8 * (fq & 1), c = fq >> 1;
    { const v2u a = *(const LAS v2u*)(C + GS_QT + tokoff(fr, c) + w8), b = *(const LAS v2u*)(C + GS_QT + tokoff(fr, 2 + c) + w8); O.q0 = (v4u){a.x, a.y, b.x, b.y}; }
    { const v2u a = *(const LAS v2u*)(C + GS_QT + tokoff(fr, 4 + c) + w8), b = *(const LAS v2u*)(C + GS_QT + tokoff(fr, 6 + c) + w8); O.q1 = (v4u){a.x, a.y, b.x, b.y}; }
    { const v2u a = *(const LAS v2u*)(C + GS_RT + tokoff(fr, c) + w8), b = *(const LAS v2u*)(C + GS_RT + tokoff(fr, 2 + c) + w8); O.r0 = (v4u){a.x, a.y, b.x, b.y}; }
    { const v2u a = *(const LAS v2u*)(C + GS_RT + tokoff(fr, 4 + c) + w8), b = *(const LAS v2u*)(C + GS_RT + tokoff(fr, 6 + c) + w8); O.r1 = (v4u){a.x, a.y, b.x, b.y}; }
    const int om = (fr * 16 + 4 * fq) * 2;
    { const v2u a = *(const LAS v2u*)(C + GS_MK + om), b = *(const LAS v2u*)(C + GS_NK + om); O.mn = (v4u){a.x, a.y, b.x, b.y}; }
    { const v2u a = *(const LAS v2u*)(C + GS_NB + om), b = *(const LAS v2u*)(C + GS_TM + om); O.bt = (v4u){a.x, a.y, b.x, b.y}; }
}
__device__ __forceinline__ void chain_load_b(ChOpsB& O, const LAS unsigned char* C, const int fr, const int fq) {
#pragma unroll
    for (int jt = 0; jt < 4; ++jt) { const int ok = tokoff2(4 * fq + (fr >> 2), 2 * jt + ((fr >> 1) & 1)) + 8 * (fr & 1); O.kh[jt] = trld(C + GS_KHT + ok); O.bh[jt] = trld(C + GS_BHT + ok); O.dv[jt] = *(const LAS f32x4*)(C + GS_DD + (16 * jt + 4 * fq) * 4); }
}
template <int NT>
__device__ __forceinline__ void chain_step(const ChOps& O, const LAS unsigned char* C, const v2u vq0, const v2u vq1, f32x4 (&Areg)[2][4], const int vt0, const int fr, const int fq, GAS bf16* yrow, LAS unsigned char* ys) {
    const f32x4 zero4 = (f32x4){0.f, 0.f, 0.f, 0.f};
    v2u kh0, kh1, kh2, kh3, bh0, bh1, bh2, bh3; f32x4 dv0, dv1, dv2, dv3;
    { const int okb = tokoff2(4 * fq + (fr >> 2), 0) + 8 * (fr & 1), xs = (((4 * fq + (fr >> 2)) >> 1) & 3) << 1, cb = (fr >> 1) & 1;
#define KB_(jt) (4 * fq + (fr >> 2)) * 128 + ((((2 * (jt) + cb) ^ xs)) << 4) + 8 * (fr & 1)
      kh0 = trld(C + GS_KHT + KB_(0)); kh1 = trld(C + GS_KHT + KB_(1)); kh2 = trld(C + GS_KHT + KB_(2)); kh3 = trld(C + GS_KHT + KB_(3));
      bh0 = trld(C + GS_BHT + KB_(0)); bh1 = trld(C + GS_BHT + KB_(1)); bh2 = trld(C + GS_BHT + KB_(2)); bh3 = trld(C + GS_BHT + KB_(3)); (void)okb;
#undef KB_
      dv0 = *(const LAS f32x4*)(C + GS_DD + (4 * fq) * 4); dv1 = *(const LAS f32x4*)(C + GS_DD + (16 + 4 * fq) * 4); dv2 = *(const LAS f32x4*)(C + GS_DD + (32 + 4 * fq) * 4); dv3 = *(const LAS f32x4*)(C + GS_DD + (48 + 4 * fq) * 4); }
    bf16x8 Aq[NT][2], Vq[NT], Uq[NT]; f32x4 X[NT], YA[NT], Z[NT], U[NT], Yv[NT], Yn[NT];
#pragma unroll
    for (int ti = 0; ti < NT; ++ti) {
#pragma unroll
        for (int kh = 0; kh < 2; ++kh) Aq[ti][kh] = __builtin_bit_cast(bf16x8, (v4u){pk2(Areg[ti][2 * kh].x, Areg[ti][2 * kh].y), pk2(Areg[ti][2 * kh].z, Areg[ti][2 * kh].w), pk2(Areg[ti][2 * kh + 1].x, Areg[ti][2 * kh + 1].y), pk2(Areg[ti][2 * kh + 1].z, Areg[ti][2 * kh + 1].w)});
        Vq[ti] = mk8z(ti == 0 ? vq0 : vq1); X[ti] = zero4; YA[ti] = zero4; }
#pragma unroll
    for (int kh = 0; kh < 2; ++kh) {
#pragma unroll
        for (int ti = 0; ti < NT; ++ti) { X[ti] = __builtin_amdgcn_mfma_f32_16x16x32_bf16(__builtin_bit_cast(bf16x8, kh == 0 ? O.q0 : O.q1), Aq[ti][kh], X[ti], 0, 0, 0); YA[ti] = __builtin_amdgcn_mfma_f32_16x16x32_bf16(__builtin_bit_cast(bf16x8, kh == 0 ? O.r0 : O.r1), Aq[ti][kh], YA[ti], 0, 0, 0); } }
#pragma unroll
    for (int ti = 0; ti < NT; ++ti) Z[ti] = __builtin_amdgcn_mfma_f32_16x16x32_bf16(__builtin_bit_cast(bf16x8, (v4u){O.mn.x, O.mn.y, 0u, 0u}), Vq[ti], X[ti], 0, 0, 0);
#pragma unroll
    for (int ti = 0; ti < NT; ++ti) Yv[ti] = __builtin_amdgcn_mfma_f32_16x16x32_bf16(__builtin_bit_cast(bf16x8, (v4u){O.mn.z, O.mn.w, 0u, 0u}), Vq[ti], YA[ti], 0, 0, 0);
#pragma unroll
    for (int ti = 0; ti < NT; ++ti) U[ti] = __builtin_amdgcn_mfma_f32_16x16x32_bf16(__builtin_bit_cast(bf16x8, (v4u){O.bt.z, O.bt.w, 0u, 0u}), cvt8z(Z[ti]), zero4, 0, 0, 0);
#pragma unroll
    for (int ti = 0; ti < NT; ++ti) Uq[ti] = cvt8z(U[ti]);
#pragma unroll
    for (int ti = 0; ti < NT; ++ti) Yn[ti] = __builtin_amdgcn_mfma_f32_16x16x32_bf16(__builtin_bit_cast(bf16x8, (v4u){O.bt.x, O.bt.y, 0u, 0u}), Uq[ti], zero4, 0, 0, 0);
#pragma unroll
    for (int jt = 0; jt < 4; ++jt) {
#pragma unroll
        for (int ti = 0; ti < NT; ++ti) { f32x4 acc = (jt == 0 ? dv0 : jt == 1 ? dv1 : jt == 2 ? dv2 : dv3) * Areg[ti][jt];
            acc = __builtin_amdgcn_mfma_f32_16x16x32_bf16(mk8z(jt == 0 ? kh0 : jt == 1 ? kh1 : jt == 2 ? kh2 : kh3), Vq[ti], acc, 0, 0, 0);
            const f32x4 nbu = __builtin_amdgcn_mfma_f32_16x16x32_bf16(mk8z(jt == 0 ? bh0 : jt == 1 ? bh1 : jt == 2 ? bh2 : bh3), Uq[ti], zero4, 0, 0, 0);
            Areg[ti][jt] = acc - nbu; } }
#pragma unroll
    for (int ti = 0; ti < NT; ++ti) { const f32x4 yy = Yv[ti] - Yn[ti]; *(LAS v2u*)(ys + ti * 512 + (fr * 16 + 4 * fq) * 2) = (v2u){pk2(yy[0], yy[1]), pk2(yy[2], yy[3])}; }
#pragma unroll
    for (int ti = 0; ti < NT; ++ti) { const v2u w = trld(ys + ti * 512 + ((4 * fq + (fr >> 2)) * 16 + 4 * (fr & 3)) * 2); __hip_atomic_store((GAS unsigned long long*)(yrow + (size_t)fr * 1024 + 16 * (vt0 + ti) + 4 * fq), __builtin_bit_cast(unsigned long long, w), __ATOMIC_RELAXED, __HIP_MEMORY_SCOPE_AGENT); }
}
#ifndef SCAN_WMAP
#define SCAN_WMAP 0x76543210u
#endif
__device__ __forceinline__ void rwkv_scan_chunked(Frame& F, const In& I, const bf16* R, const bf16* Kt, const bf16* V, const bf16* AA, const bf16* EW, bf16* Y, gu32* prog) {
    const int lane = LANE_, fr = lane & 15, fq = lane >> 4;
    const int lw = (int)((SCAN_WMAP >> (4 * F.wave)) & 7u);
    LAS unsigned char* L = F.lds;
    const f32x4 zero4 = (f32x4){0.f, 0.f, 0.f, 0.f};
    for (int un = blockIdx.x; un < NB * 16; un += F.G) {
        const int h = un & 15, b = un >> 4; const size_t rowb = (size_t)b * SEQ;
        if (lw == 0) { ((LAS float*)(L + CH_KTAB))[lane] = ((const GAS float*)I.rwkv_kk)[h * 64 + lane]; ((LAS float*)(L + CH_KTAB + 256))[lane] = ((const GAS float*)I.rwkv_ka)[h * 64 + lane]; }
        LBAR();
        if (lw >= CH_NS) {
            const int p = lw - CH_NS; const int colb = h * 64 + 16 * fq;
            v4u raw[10];
#define CK_LOAD(cidx) do { const size_t off = (rowb + (size_t)(cidx) * 16 + fr) * 1024 + colb; \
                raw[0] = *(const GAS v4u*)(R + off); raw[1] = *(const GAS v4u*)(R + off + 8); raw[2] = *(const GAS v4u*)(Kt + off); raw[3] = *(const GAS v4u*)(Kt + off + 8); raw[4] = *(const GAS v4u*)(V + off); raw[5] = *(const GAS v4u*)(V + off + 8); \
                raw[6] = *(const GAS v4u*)(AA + off); raw[7] = *(const GAS v4u*)(AA + off + 8); raw[8] = *(const GAS v4u*)(EW + off); raw[9] = *(const GAS v4u*)(EW + off + 8); } while (0)
#ifdef SCAN_STAMP
            unsigned long long st_[7] = {0, 0, 0, 0, 0, 0, 0};
#ifndef SCAN_STAMP_P
#define SCAN_STAMP_P 0
#endif
#ifndef SCAN_STAMP_RD
#define SCAN_STAMP_RD 20
#endif
#ifndef SCAN_STAMP_B
#define SCAN_STAMP_B 0
#endif
#define STAMP(i) do { if ((SCAN_STAMP_B < 0 || blockIdx.x == SCAN_STAMP_B) && p == SCAN_STAMP_P && rd == SCAN_STAMP_RD) st_[i] = __builtin_amdgcn_s_memtime(); } while (0)
#else
#define STAMP(i) do { } while (0)
#endif
            CK_LOAD(p);
#pragma unroll 2
            for (int rd = -1; rd < CH_ROUNDS - 1; ++rd) {
                const int cidx = CH_NP * (rd + 1) + p; LAS unsigned char* S = L + (((rd + 1) & 1) * CH_NP + p) * GS_SLOT;
                if (cidx < 512) {
                STAMP(0);
                float r[16], k[16], a[16], ew[16]; const v4u vraw0 = raw[4], vraw1 = raw[5];
                { float t8[8];
                  unpack8(raw[0], t8);
#pragma unroll
                  for (int e = 0; e < 8; ++e) r[e] = t8[e];
                  unpack8(raw[1], t8);
#pragma unroll
                  for (int e = 0; e < 8; ++e) r[8 + e] = t8[e];
                  unpack8(raw[2], t8);
#pragma unroll
                  for (int e = 0; e < 8; ++e) k[e] = t8[e];
                  unpack8(raw[3], t8);
#pragma unroll
                  for (int e = 0; e < 8; ++e) k[8 + e] = t8[e];
                  unpack8(raw[6], t8);
#pragma unroll
                  for (int e = 0; e < 8; ++e) a[e] = t8[e];
                  unpack8(raw[7], t8);
#pragma unroll
                  for (int e = 0; e < 8; ++e) a[8 + e] = t8[e];
                  unpack8(raw[8], t8);
#pragma unroll
                  for (int e = 0; e < 8; ++e) ew[e] = t8[e];
                  unpack8(raw[9], t8);
#pragma unroll
                  for (int e = 0; e < 8; ++e) ew[8 + e] = t8[e]; }
#if defined(SCAN_STAMP) && defined(SCAN_STAMP_LD)
                asm volatile("s_waitcnt vmcnt(0)" ::: "memory"); STAMP(1);
#endif
                if (cidx + CH_NP < 512) CK_LOAD(cidx + CH_NP);
                float kx[16], ss = 0.f;
#pragma unroll
                for (int e4 = 0; e4 < 4; ++e4) { const f32x4 c0_ = *(const LAS f32x4*)(L + CH_KTAB + (16 * fq + 4 * e4) * 4), c1_ = *(const LAS f32x4*)(L + CH_KTAB + 256 + (16 * fq + 4 * e4) * 4);
#pragma unroll
                    for (int z = 0; z < 4; ++z) { const int ee = 4 * e4 + z; kx[ee] = k[ee] * c0_[z]; ss += kx[ee] * kx[ee]; k[ee] = k[ee] * (1.0f + (a[ee] - 1.0f) * c1_[z]); } }
                ss += __shfl_xor(ss, 16); ss += __shfl_xor(ss, 32);
                const float inv = __builtin_amdgcn_rsqf(fmaxf(ss, 1e-24f));
                unsigned qtw[8], rtw[8], ktw[8], btw[8], bhw[8], khw[8];
                {
                    float li[16], e15[16], ep[16];
#pragma unroll
                    for (int e = 0; e < 16; ++e) li[e] = -ew[e];
#pragma unroll
                    for (int e = 0; e < 16; ++e) li[e] += dpp_shr<1>(li[e]);
#pragma unroll
                    for (int e = 0; e < 16; ++e) li[e] += dpp_shr<2>(li[e]);
#pragma unroll
                    for (int e = 0; e < 16; ++e) li[e] += dpp_shr<4>(li[e]);
#pragma unroll
                    for (int e = 0; e < 16; ++e) li[e] += dpp_shr<8>(li[e]);
#pragma unroll
                    for (int e = 0; e < 16; ++e) li[e] = __builtin_amdgcn_exp2f(li[e]);
#pragma unroll
                    for (int e = 0; e < 16; ++e) e15[e] = __shfl(li[e], (lane & 48) | 15);
#pragma unroll
                    for (int e = 0; e < 16; ++e) ep[e] = __builtin_bit_cast(float, __builtin_amdgcn_update_dpp(0x3f800000, __builtin_bit_cast(int, li[e]), 0x111, 0xf, 0xf, false));
                    if (fr == 15) {
#pragma unroll
                        for (int e4 = 0; e4 < 4; ++e4) *(LAS f32x4*)(S + GS_DD + (16 * fq + 4 * e4) * 4) = (f32x4){li[4 * e4], li[4 * e4 + 1], li[4 * e4 + 2], li[4 * e4 + 3]}; }
#pragma unroll
                    for (int e = 0; e < 16; e += 2) { float q2[2], r2[2], k2[2], b2[2], b2h[2], k2h[2];
#pragma unroll
                        for (int z = 0; z < 2; ++z) { const int ee = e + z;
                            const float Einv = __builtin_amdgcn_rcpf(li[ee]);
                            const float kk = kx[ee] * inv, bb = a[ee] * kk;
                            q2[z] = kk * ep[ee]; k2[z] = k[ee] * Einv; b2[z] = bb * Einv; r2[z] = r[ee] * li[ee];
                            b2h[z] = b2[z] * e15[ee]; k2h[z] = k2[z] * e15[ee]; }
                        qtw[e >> 1] = pk2(q2[0], q2[1]); rtw[e >> 1] = pk2(r2[0], r2[1]); ktw[e >> 1] = pk2(k2[0], k2[1]); btw[e >> 1] = pk2(b2[0], b2[1]); bhw[e >> 1] = pk2(b2h[0], b2h[1]); khw[e >> 1] = pk2(k2h[0], k2h[1]);
 } }
                { const int ov = tokoff2(fr, 2 * fq); *(LAS v4u*)(S + GS_VT + ov) = vraw0; *(LAS v4u*)(S + GS_VT + ov + 16) = vraw1; }
                { const int o = tokoff(fr, 2 * fq), o2 = o ^ 16;
                  *(LAS v4u*)(S + GS_QT + o) = (v4u){qtw[0], qtw[1], qtw[2], qtw[3]}; *(LAS v4u*)(S + GS_QT + o2) = (v4u){qtw[4], qtw[5], qtw[6], qtw[7]};
                  *(LAS v4u*)(S + GS_RT + o) = (v4u){rtw[0], rtw[1], rtw[2], rtw[3]}; *(LAS v4u*)(S + GS_RT + o2) = (v4u){rtw[4], rtw[5], rtw[6], rtw[7]};
                  *(LAS v4u*)(S + GS_KT + o) = (v4u){ktw[0], ktw[1], ktw[2], ktw[3]}; *(LAS v4u*)(S + GS_KT + o2) = (v4u){ktw[4], ktw[5], ktw[6], ktw[7]};
                  *(LAS v4u*)(S + GS_BT + o) = (v4u){btw[0], btw[1], btw[2], btw[3]}; *(LAS v4u*)(S + GS_BT + o2) = (v4u){btw[4], btw[5], btw[6], btw[7]}; }
                asm volatile("s_waitcnt lgkmcnt(0)" ::: "memory");
#if !defined(SCAN_STAMP_LD)
                STAMP(1);
#endif
                f32x4 mb = zero4, mbt = zero4, mkt = zero4, nbt = zero4, nkt = zero4;
#pragma unroll
                for (int kh = 0; kh < 2; ++kh) { const int o = tokoff(fr, 4 * kh + fq);
                    const bf16x8 Qf = *(const LAS bf16x8*)(S + GS_QT + o), Rf = *(const LAS bf16x8*)(S + GS_RT + o), Kf = *(const LAS bf16x8*)(S + GS_KT + o), Bf = *(const LAS bf16x8*)(S + GS_BT + o);
                    mb = __builtin_amdgcn_mfma_f32_16x16x32_bf16(Qf, Bf, mb, 0, 0, 0); mbt = __builtin_amdgcn_mfma_f32_16x16x32_bf16(Bf, Qf, mbt, 0, 0, 0);
                    mkt = __builtin_amdgcn_mfma_f32_16x16x32_bf16(Kf, Qf, mkt, 0, 0, 0);
                    nbt = __builtin_amdgcn_mfma_f32_16x16x32_bf16(Bf, Rf, nbt, 0, 0, 0); nkt = __builtin_amdgcn_mfma_f32_16x16x32_bf16(Kf, Rf, nkt, 0, 0, 0); }
                asm volatile("s_waitcnt lgkmcnt(0)" ::: "memory");
                STAMP(2);
                { const int oh = tokoff2(fr, 2 * fq);
                  *(LAS v4u*)(S + GS_BHT + oh) = (v4u){bhw[0], bhw[1], bhw[2], bhw[3]}; *(LAS v4u*)(S + GS_BHT + oh + 16) = (v4u){bhw[4], bhw[5], bhw[6], bhw[7]};
                  *(LAS v4u*)(S + GS_KHT + oh) = (v4u){khw[0], khw[1], khw[2], khw[3]}; *(LAS v4u*)(S + GS_KHT + oh + 16) = (v4u){khw[4], khw[5], khw[6], khw[7]}; }
                { f32x4 nAf, nDf, iD, mkm, nkm, nbm;
#pragma unroll
                  for (int e = 0; e < 4; ++e) { const int tt = 4 * fq + e; const bool lo = fr < tt, up = tt < fr, ue = tt <= fr;
                      nAf[e] = lo ? -mb[e] : 0.f; nDf[e] = up ? -mbt[e] : 0.f; iD[e] = (tt == fr) ? 1.0f : 0.0f;
                      mkm[e] = up ? mkt[e] : 0.f; nkm[e] = ue ? nkt[e] : 0.f; nbm[e] = ue ? nbt[e] : 0.f; }
                  const int om = (fr * 16 + 4 * fq) * 2;
                  *(LAS v2u*)(S + GS_MK + om) = (v2u){pk2(mkm[0], mkm[1]), pk2(mkm[2], mkm[3])}; *(LAS v2u*)(S + GS_NK + om) = (v2u){pk2(nkm[0], nkm[1]), pk2(nkm[2], nkm[3])};
                  *(LAS v2u*)(S + GS_NB + om) = (v2u){pk2(nbm[0], nbm[1]), pk2(nbm[2], nbm[3])};
                  STAMP(3);
                  const bf16x8 nA = cvt8z(nAf), nD = cvt8z(nDf);
                  const f32x4 n2D = __builtin_amdgcn_mfma_f32_16x16x32_bf16(nA, nD, zero4, 0, 0, 0), n2A = __builtin_amdgcn_mfma_f32_16x16x32_bf16(nD, nA, zero4, 0, 0, 0);
                  const bf16x8 n2Db = cvt8z(n2D), n2Ab = cvt8z(n2A);
                  const f32x4 n4D = __builtin_amdgcn_mfma_f32_16x16x32_bf16(n2Ab, n2Db, zero4, 0, 0, 0), n4A = __builtin_amdgcn_mfma_f32_16x16x32_bf16(n2Db, n2Ab, zero4, 0, 0, 0);
                  f32x4 Tt = __builtin_amdgcn_mfma_f32_16x16x32_bf16(nA, n2Db, iD + nDf + n2D, 0, 0, 0);
                  const bf16x8 n4Db = cvt8z(n4D), n4Ab = cvt8z(n4A);
                  const f32x4 n8A = __builtin_amdgcn_mfma_f32_16x16x32_bf16(n4Db, n4Ab, zero4, 0, 0, 0);
                  Tt = __builtin_amdgcn_mfma_f32_16x16x32_bf16(n4Ab, cvt8z(Tt), Tt, 0, 0, 0);
                  Tt = __builtin_amdgcn_mfma_f32_16x16x32_bf16(cvt8z(n8A), cvt8z(Tt), Tt, 0, 0, 0);
                  STAMP(4);
                  *(LAS v2u*)(S + GS_TM + om) = (v2u){pk2(Tt[0], Tt[1]), pk2(Tt[2], Tt[3])}; }
                STAMP(5);
                }
                LBAR();
                STAMP(6);
            }
            LBAR();
#ifdef SCAN_STAMP
            if ((SCAN_STAMP_B < 0 || blockIdx.x == SCAN_STAMP_B) && p == SCAN_STAMP_P) { const unsigned long long d_ = (SCAN_STAMP == 0) ? st_[6] - st_[0] : (SCAN_STAMP == 7) ? st_[5] - st_[0] : st_[SCAN_STAMP] - st_[SCAN_STAMP - 1]; const unsigned long long t0_ = __builtin_amdgcn_s_memtime();
                while (__builtin_amdgcn_s_memtime() - t0_ < d_ * 512ull) __builtin_amdgcn_s_sleep(8); }
#endif
#undef CK_LOAD
        } else {
            const int vtA = (CH_NS == 4) ? lw : ((lw == 0) ? 0 : lw + 1);
            f32x4 A2[2][4];
#ifdef SCAN_PRIO
            __builtin_amdgcn_s_setprio(SCAN_PRIO);
#endif
#pragma unroll
            for (int jt = 0; jt < 4; ++jt) { A2[0][jt] = zero4; A2[1][jt] = zero4; }
            const int trb = 4 * fq + (fr >> 2), trc = (fr >> 1) & 1, trl = 8 * (fr & 1);
            LAS unsigned char* ys = L + TB_OFF + lw * 1024;
#ifdef SCAN_SSTAMP
            unsigned long long ss0_ = 0, ss1_ = 0;
#endif
            LBAR();
            const int vt0 = (CH_NS == 3 && lw == 0) ? 0 : vtA; const bool two = (CH_NS == 3 && lw == 0);
            for (int rd = 0; rd < CH_ROUNDS; ++rd) {
                const int c0 = CH_NP * rd; const LAS unsigned char* C0 = L + ((rd & 1) * CH_NP) * GS_SLOT;
                ChOps opA, opB; v2u vA0, vA1, vB0, vB1;
#define CH_FETCH(OP, V0, V1, q_) do { const LAS unsigned char* C_ = C0 + (q_) * GS_SLOT; chain_load(OP, C_, fr, fq); V0 = trld(C_ + GS_VT + tokoff2(trb, 2 * vt0 + trc) + trl); \
                    if (two) V1 = trld(C_ + GS_VT + tokoff2(trb, 2 + trc) + trl); } while (0)
#define CH_ITER(q_, CUR, U0, U1, NXT, W0, W1) do { if ((q_) < CH_NP) { const int cidx = c0 + (q_); \
                    if ((q_) + 1 < CH_NP && cidx + 1 < 512) CH_FETCH(NXT, W0, W1, (q_) + 1); \
                    if (cidx < 512) { GAS bf16* yrow = (GAS bf16*)Y + (rowb + (size_t)cidx * 16) * 1024 + h * 64; \
                        if (two) chain_step<2>(CUR, C0 + (q_) * GS_SLOT, U0, U1, A2, 0, fr, fq, yrow, ys); \
                        else chain_step<1>(CUR, C0 + (q_) * GS_SLOT, U0, U0, A2, vtA, fr, fq, yrow, ys); } } } while (0)
                vA1 = (v2u){0u, 0u}; vB1 = (v2u){0u, 0u};
                if (c0 < 512) CH_FETCH(opA, vA0, vA1, 0);
                CH_ITER(0, opA, vA0, vA1, opB, vB0, vB1);
                CH_ITER(1, opB, vB0, vB1, opA, vA0, vA1);
                CH_ITER(2, opA, vA0, vA1, opB, vB0, vB1);
                CH_ITER(3, opB, vB0, vB1, opA, vA0, vA1);
                CH_ITER(4, opA, vA0, vA1, opB, vB0, vB1);
                CH_ITER(5, opB, vB0, vB1, opA, vA0, vA1);
#undef CH_ITER
#undef CH_FETCH
                asm volatile("s_waitcnt vmcnt(0)" ::: "memory");
                LBAR();
                if (lw == 0 && lane == 0) __hip_atomic_fetch_add((GAS unsigned*)(prog + b * CH_ROUNDS + rd), 1u, __ATOMIC_RELAXED, __HIP_MEMORY_SCOPE_AGENT);
            }
#ifdef SCAN_SSTAMP
            if (lw == SCAN_SSTAMP_W) { const unsigned long long d_ = (ss1_ - ss0_) * 512ull, t0_ = __builtin_amdgcn_s_memtime(); while (__builtin_amdgcn_s_memtime() - t0_ < d_) __builtin_amdgcn_s_sleep(8); }
#endif
#ifdef SCAN_PRIO
            __builtin_amdgcn_s_setprio(0);
#endif
        }
    }
}
__device__ __forceinline__ void rwkv_post_pass(Frame& F, const In& I, const bf16* R, const bf16* Kt, const bf16* V, const bf16* AA, const bf16* G, bf16* Y, const int tbeg, const int tend, const int tstep) {
    const int col = LANE_ * 16;
    for (int t0 = tbeg; t0 < tend; t0 += tstep) {
        v4u py[2][2], pr[2][2], pk[2][2], pv[2][2], pa[2][2], pg[2][2];
#pragma unroll
        for (int rw = 0; rw < 2; ++rw) { const size_t off = (size_t)(t0 + rw) * 1024 + col;
#pragma unroll
            for (int hf = 0; hf < 2; ++hf) { py[rw][hf] = *(const v4u*)(Y + off + hf * 8); pr[rw][hf] = *(const v4u*)(R + off + hf * 8); pk[rw][hf] = *(const v4u*)(Kt + off + hf * 8);
                pv[rw][hf] = *(const v4u*)(V + off + hf * 8); pa[rw][hf] = *(const v4u*)(AA + off + hf * 8); pg[rw][hf] = *(const v4u*)(G + off + hf * 8); } }
#pragma unroll
        for (int rw = 0; rw < 2; ++rw) { const size_t off = (size_t)(t0 + rw) * 1024 + col;
            float kaw[16], rkw[16], lng[16], lnb[16];
#pragma unroll
            for (int e4 = 0; e4 < 4; ++e4) { const f32x4 c0 = *(const GAS f32x4*)(I.rwkv_ka + col + 4 * e4), c1 = *(const GAS f32x4*)(I.rwkv_rk + col + 4 * e4), c2 = *(const GAS f32x4*)(I.rwkv_ln_g + col + 4 * e4), c3 = *(const GAS f32x4*)(I.rwkv_ln_b + col + 4 * e4);
#pragma unroll
                for (int e = 0; e < 4; ++e) { kaw[4 * e4 + e] = c0[e]; rkw[4 * e4 + e] = c1[e]; lng[4 * e4 + e] = c2[e]; lnb[4 * e4 + e] = c3[e]; } }
            float y[16], r[16], k[16], v[16], a[16], g[16];
#pragma unroll
            for (int hf = 0; hf < 2; ++hf) { float t8[8];
                unpack8(py[rw][hf], t8);
#pragma unroll
                for (int e = 0; e < 8; ++e) y[hf * 8 + e] = t8[e];
                unpack8(pr[rw][hf], t8);
#pragma unroll
                for (int e = 0; e < 8; ++e) r[hf * 8 + e] = t8[e];
                unpack8(pk[rw][hf], t8);
#pragma unroll
                for (int e = 0; e < 8; ++e) k[hf * 8 + e] = t8[e];
                unpack8(pv[rw][hf], t8);
#pragma unroll
                for (int e = 0; e < 8; ++e) v[hf * 8 + e] = t8[e];
                unpack8(pa[rw][hf], t8);
#pragma unroll
                for (int e = 0; e < 8; ++e) a[hf * 8 + e] = t8[e];
                unpack8(pg[rw][hf], t8);
#pragma unroll
                for (int e = 0; e < 8; ++e) g[hf * 8 + e] = t8[e]; }
            float s = 0.f, bs = 0.f;
#pragma unroll
            for (int e = 0; e < 16; ++e) { s += y[e]; const float kp = k[e] * (1.0f + (a[e] - 1.0f) * kaw[e]); bs += r[e] * kp * rkw[e]; }
            s += __shfl_xor(s, 1); s += __shfl_xor(s, 2); bs += __shfl_xor(bs, 1); bs += __shfl_xor(bs, 2);
            const float mean = s * (1.0f / 64.0f); float q = 0.f;
#pragma unroll
            for (int e = 0; e < 16; ++e) { const float dd = y[e] - mean; q += dd * dd; }
            q += __shfl_xor(q, 1); q += __shfl_xor(q, 2);
            const float rstd = 1.0f / sqrtf(q * (1.0f / 64.0f) + 64e-5f);
            float o[16];
#pragma unroll
            for (int e = 0; e < 16; ++e) o[e] = ((y[e] - mean) * rstd * lng[e] + lnb[e] + bs * v[e]) * g[e];
            v4u w0, w1; w0.x = pk2(o[0], o[1]); w0.y = pk2(o[2], o[3]); w0.z = pk2(o[4], o[5]); w0.w = pk2(o[6], o[7]); w1.x = pk2(o[8], o[9]); w1.y = pk2(o[10], o[11]); w1.z = pk2(o[12], o[13]); w1.w = pk2(o[14], o[15]);
            *(v4u*)(Y + off) = w0; *(v4u*)(Y + off + 8) = w1; }
    }
}

#ifndef DUP_K
#define DUP_K (-1)
#endif
#ifndef DUP_K2
#define DUP_K2 (-1)
#endif
#define KARGS ((const __attribute__((address_space(4))) Args*)__builtin_amdgcn_kernarg_segment_ptr())
#define WSPTRS \
    bf16* H0 = (bf16*)(ws + WS_H0); bf16* QKV = (bf16*)(ws + WS_QKV); bf16* OB = (bf16*)(ws + WS_O); f32x2* AGG = (f32x2*)(ws + WS_LRUAGG); \
    bf16* H2 = (bf16*)(ws + WS_H2); float* LOG = (float*)(ws + WS_LOG); unsigned char* RTE = ws + WS_ROUTE; bf16* HID = (bf16*)(ws + WS_HID); bf16* YS = (bf16*)(ws + WS_YS); bf16* PP = (bf16*)(ws + WS_PP); \
    bf16* HCAT = (bf16*)(ws + WS_HCAT); bf16* RB = (bf16*)(ws + WS_R); bf16* KB = (bf16*)(ws + WS_K); bf16* VB = (bf16*)(ws + WS_V); bf16* XRB = (bf16*)(ws + WS_XR); bf16* XKB = (bf16*)(ws + WS_XK); bf16* XVB = (bf16*)(ws + WS_XV); bf16* MID = (bf16*)(ws + WS_MID); bf16* EWB = (bf16*)(ws + WS_EW); bf16* AAB = (bf16*)(ws + WS_AA); bf16* YB = (bf16*)(ws + WS_Y); \
    const size_t TD = (size_t)T * 1024; (void)H0; (void)QKV; (void)OB; (void)AGG; (void)H2; (void)LOG; (void)RTE; (void)HID; (void)YS; (void)PP; (void)HCAT; (void)RB; (void)KB; (void)VB; (void)XRB; (void)XKB; (void)XVB; (void)MID; (void)EWB; (void)AAB; (void)YB; (void)TD;

struct Args { In in; float* out; unsigned char* ws; int ph_lo, ph_hi; };
constexpr int N_PHASES = 34;
__device__ __forceinline__ int nrep(int k) { int n = (k == DUP_K) ? 2 : 1; if (DUP_K >= 0) asm volatile("" : "+s"(n)); return n; }
#define REP_SYNC if (rep_) __syncthreads();
typedef const __attribute__((address_space(4))) unsigned long long* kp64;
__device__ __forceinline__ void load_in(In& I) { kp64 s = (kp64)__builtin_amdgcn_kernarg_segment_ptr(); unsigned long long* d = (unsigned long long*)&I;
#pragma unroll
    for (int i = 0; i < 47; ++i) d[i] = s[i]; }

__device__ __forceinline__ int t5_bucket(int n) { if (n < 16) return n; const float v = logf((float)n / 16.0f) / 2.0794415416798357f * 16.0f; const int l = 16 + (int)v; return l < 31 ? l : 31; }

template <class Epi>
__device__ __forceinline__ void dense_gemm(Frame& F, const void* A, int lda, const void* B, int K, int M, int N, const Epi& E) {
    pg8::DenseOrder S; S.init(A, lda, B, K, M, N, F.G, (int)blockIdx.x);
    pg8::gemm_phase<Epi, pg8::DenseOrder, true, false>(F.lds, K, lda, S, E, nullptr, TID_);
}

__global__ void __launch_bounds__(NWAVES * 64, 2) mk_fwd(Args args) {
    extern __shared__ __attribute__((aligned(16))) unsigned char lds[];
    Frame F;
    F.lds = (LAS unsigned char*)lds;
    F.MISC = (volatile LAS unsigned*)(F.lds + MISC_OFF);
    { int w_ = __builtin_amdgcn_readfirstlane((int)threadIdx.x >> 6); asm volatile("" : "+s"(w_)); F.wave = w_; }
    F.G = gridDim.x; { const int bx = blockIdx.x; F.vcu = (F.G % 8 == 0) ? (bx % 8) * (F.G / 8) + bx / 8 : bx; }
    F.ctl = (gu32*)(KARGS->ws + WS_CTL);
    for (int u = TID_; u < (LDS_BYTES - LDSCTL_OFF) / 4; u += NWAVES * 64) ((LAS unsigned*)(F.lds + LDSCTL_OFF))[u] = 0u;
    __syncthreads();
    {
        LAS float* tb = (LAS float*)(F.lds + TB_OFF); const int h = TID_ >> 7, i = TID_ & 127;
        const float* rb = KARGS->in.rel_bias;
        tb[h * 128 + i] = (rb[t5_bucket(i) * 4 + h] - rb[31 * 4 + h]) * 1.4426950408889634f;
    }
    __syncthreads();
    const int lo = KARGS->ph_lo, hi = KARGS->ph_hi;
    const bool multi = (hi - lo) > 1;
    XcdBarrier bar; bar.bar = (unsigned*)(F.ctl + CW_BAR); bar.x = 0; bar.st = nullptr;
    if (multi) bar = xcd_barrier_post((unsigned*)(F.ctl + CW_BAR), F.MISC + 8, TID_ == 0);
#define IN(k) (lo <= (k) && (k) < hi)
#define PH_BEGIN_ unsigned char* ws = KARGS->ws; bf16* X = (bf16*)KARGS->out; float* OUT = KARGS->out; (void)OUT; bf16* GB2 = (bf16*)KARGS->out + (size_t)T * 1024; (void)GB2; In I; load_in(I); (void)X; WSPTRS
#define SEAM(k) do { if (IN(k) && IN((k) + 1)) xcd_barrier(bar, TID_ == 0); } while (0)

    if (IN(0)) { PH_BEGIN_ prep_dense_weights(F, I, ws); prep_layer_weights(F, I, ws, 0); norm_pass<false>(F, I.x, I.norm_mix, H0);
#ifdef DUP_PREP
        __syncthreads(); prep_dense_weights(F, I, ws); prep_layer_weights(F, I, ws, 0);
#endif
    } SEAM(0);
    if (IN(1)) { PH_BEGIN_ pg8::EpiBf16 E{QKV, 512, 512, (size_t)T * 512, attn_body::C2}; dense_gemm(F, H0, 1024, ws + WS_WIN, 1024, T, AB_IN, E); } SEAM(1);
    if (IN(2)) { PH_BEGIN_ lru_agg_mfma(F, I, QKV + 3 * (size_t)T * 512, AGG, (bf16*)(ws + WS_HL), (bf16*)(ws + WS_CA)); } SEAM(2);
    if (IN(3)) { PH_BEGIN_
        const attn_body::AttnTensors AT{(const attn_body::bf16*)QKV, (const attn_body::bf16*)(QKV + (size_t)T * 512), (const attn_body::bf16*)(QKV + 2 * (size_t)T * 512), (attn_body::bf16*)OB};
        if (F.G == 256) attn_body::attn_phase<8>((char*)lds, AT, F.vcu, (const LAS float*)(F.lds + TB_OFF), (int)threadIdx.x);
#ifdef DUP_ATTN
        __syncthreads(); if (F.G == 256) attn_body::attn_phase<8>((char*)lds, AT, F.vcu, (const LAS float*)(F.lds + TB_OFF), (int)threadIdx.x);
#endif
        __syncthreads();
        lru_final_pass(F, (const bf16*)(ws + WS_HL), (const bf16*)(ws + WS_CA), QKV + 4 * (size_t)T * 512, AGG, H0);
    } SEAM(3);
    if (IN(4)) { PH_BEGIN_ diff_combine_pass(F, I, OB, H0); } SEAM(4);
    if (IN(5)) { PH_BEGIN_ pg8::EpiResX<false> E{I.x, X}; dense_gemm(F, H0, 1024, ws + WS_WOUT, 1024, T, 1024, E); } SEAM(5);

#define MOE_PLE_PHASES(P, L) \
    if (IN(P + 0)) { PH_BEGIN_ norm_pass<true>(F, X, I.norm_ffn + (L) * 1024, H2); } SEAM(P + 0); \
    if (IN(P + 1)) { PH_BEGIN_ pg8::EpiRouter E{LOG}; dense_gemm(F, H2, 1024, ws + WS_ROUT + (size_t)(L) * 256 * 1024 * 2, 1024, T, 256, E); } SEAM(P + 1); \
    if (IN(P + 2)) { PH_BEGIN_ route_pass_a(F, I, (L), LOG, RTE, F.ctl + ((L) ? CW_CNT1 : CW_CNT0)); } SEAM(P + 2); \
    if (IN(P + 3)) { PH_BEGIN_ route_pass_b(F, RTE, F.ctl + ((L) ? CW_CNT1 : CW_CNT0)); } SEAM(P + 3); \
    if (IN(P + 4)) { PH_BEGIN_ route_bases(F, F.ctl + ((L) ? CW_CNT1 : CW_CNT0)); const LAS int* eb = (const LAS int*)(F.lds + RTE_OFF + 512); \
        MoeOrder S{F.G, (int)blockIdx.x, __builtin_amdgcn_readfirstlane(eb[32] >> 8), eb, (const char*)H2, (const char*)(ws + WS_MGU), 0, (size_t)1024 * 1024 * 2, (size_t)256 * 1024 * 2, true}; pg8::EpiGU E{HID}; \
        pg8::gemm_phase<pg8::EpiGU, MoeOrder, true, true>(F.lds, 1024, 1024, S, E, (const int*)(RTE + RT_ROWTOK), TID_); } SEAM(P + 4); \
    if (IN(P + 5)) { PH_BEGIN_ route_bases(F, F.ctl + ((L) ? CW_CNT1 : CW_CNT0)); const LAS int* eb = (const LAS int*)(F.lds + RTE_OFF + 512); \
        MoeOrder S{F.G, (int)blockIdx.x, __builtin_amdgcn_readfirstlane(eb[32] >> 8), eb, (const char*)HID, (const char*)(ws + WS_MDN), (size_t)256 * 512 * 2, (size_t)1024 * 512 * 2, (size_t)256 * 512 * 2, false}; pg8::EpiDown E{YS, (const float*)(RTE + RT_ROWGATE)}; \
        pg8::gemm_phase<pg8::EpiDown, MoeOrder, true, false>(F.lds, 512, 512, S, E, nullptr, TID_); } SEAM(P + 5); \
    if (IN(P + 6)) { PH_BEGIN_ combine_norm_pass(F, X, X, YS, (const int*)(RTE + RT_SLOT), I.ple_norm + (L) * 1024, H2); __syncthreads(); \
          \
        { pg8::EpiBf16 E{PP, 1024, 0, 0, 1.f}; dense_gemm(F, ws + WS_PB, 256, ws + WS_PPROJ + (size_t)(L) * 1024 * 256 * 2, 256, T, 1024, E); } } SEAM(P + 6); \
    if (IN(P + 8)) { PH_BEGIN_ pg8::EpiPle E{X, (L) ? (bf16*)(ws + WS_YS) : X, PP}; dense_gemm(F, H2, 1024, ws + WS_PGATE + (size_t)(L) * 1024 * 1024 * 2, 1024, T, 1024, E); } SEAM(P + 8);

    MOE_PLE_PHASES(6, 0)
    if (IN(15)) { PH_BEGIN_ rwkv_input_pass(F, X, I.norm_mix + 1024, I.rwkv_mu, HCAT, XRB, XKB, XVB); } SEAM(15);
    if (IN(16)) { PH_BEGIN_ { pg8::EpiBf16 E{RB, 1024, 0, 0, 1.f}; dense_gemm(F, XRB, 1024, ws + WS_RCAT, 1024, T, 1024, E); }
        { pg8::EpiMid E{MID}; dense_gemm(F, HCAT, 2048, ws + WS_RL1, 2048, T, 512, E); } } SEAM(16);
    if (IN(17)) { PH_BEGIN_ pg8::EpiBf16 E{KB, 1024, 0, 0, 1.f}; dense_gemm(F, XKB, 1024, ws + WS_RCAT + (size_t)1024 * 1024 * 2, 1024, T, 1024, E); } SEAM(17);
    if (IN(18)) { PH_BEGIN_ pg8::EpiBf16 E{VB, 1024, 0, 0, 1.f}; dense_gemm(F, XVB, 1024, ws + WS_RCAT + (size_t)2 * 1024 * 1024 * 2, 1024, T, 1024, E); } SEAM(18);
    if (IN(19)) { PH_BEGIN_ pg8::EpiRwkv2 E{EWB, AAB, I.rwkv_w0, I.rwkv_a0, 0}; dense_gemm(F, MID, 512, ws + WS_RS2, 256, T, 2048, E); } SEAM(19);
    if (IN(20)) { PH_BEGIN_
        if (F.G == 256 && blockIdx.x >= 128) {
            Frame F2 = F; F2.G = 128; F2.vcu = (int)blockIdx.x - 128;
#ifdef HELP_STAMP
            const unsigned long long hs0_ = __builtin_amdgcn_s_memtime();
#endif
            prep_layer_weights(F2, I, ws, 1);
            __syncthreads();
            pg8::EpiRwkv2 E{GB2, GB2, nullptr, nullptr, 2}; pg8::DenseOrder S; S.init(MID + 256, 512, ws + WS_RS2 + (size_t)2 * 1024 * 256 * 2, 256, T, 1024, 128, (int)blockIdx.x - 128);
            pg8::gemm_phase<pg8::EpiRwkv2, pg8::DenseOrder, true, false>(F.lds, 256, 512, S, E, nullptr, TID_);
            static_assert(CH_NP == 4, "the y hand-off below counts 64-token rounds");
            asm volatile("s_waitcnt vmcnt(0)" ::: "memory"); __syncthreads();
            {
                const __attribute__((address_space(4))) Args* ka = KARGS; asm volatile("" : "+s"(ka));
                unsigned char* ws2 = ka->ws; bf16* G2 = (bf16*)ka->out + (size_t)T * 1024; gu32* ctl2 = (gu32*)(ws2 + WS_CTL);
                In I2; I2.rwkv_ka = ka->in.rwkv_ka; I2.rwkv_rk = ka->in.rwkv_rk; I2.rwkv_ln_g = ka->in.rwkv_ln_g; I2.rwkv_ln_b = ka->in.rwkv_ln_b;
                if (TID_ == 0) { __builtin_amdgcn_fence(__ATOMIC_RELEASE, "agent"); asm volatile("s_waitcnt vmcnt(0)" ::: "memory"); __hip_atomic_fetch_add(ctl2 + CW_GDONE, 1u, __ATOMIC_RELAXED, __HIP_MEMORY_SCOPE_AGENT);
                    while (__hip_atomic_load(ctl2 + CW_GDONE, __ATOMIC_RELAXED, __HIP_MEMORY_SCOPE_AGENT) < 128u) __builtin_amdgcn_s_sleep(8);
                    __builtin_amdgcn_fence(__ATOMIC_ACQUIRE, "agent"); }
                __syncthreads();
                const int hb = ((int)blockIdx.x - 128) >> 4, hs = ((int)blockIdx.x - 128) & 15;
                for (int rd = hs; rd < CH_ROUNDS; rd += 16) {
                    if (TID_ == 0) { const gu32* pw = ctl2 + CW_PROG + hb * CH_ROUNDS + rd;
                        while (__hip_atomic_load(pw, __ATOMIC_RELAXED, __HIP_MEMORY_SCOPE_AGENT) < 16u) __builtin_amdgcn_s_sleep(8);
                        __builtin_amdgcn_fence(__ATOMIC_ACQUIRE, "agent"); }
                    __syncthreads();
                    const int tb = hb * SEQ + rd * 64;
                    rwkv_post_pass(F, I2, (const bf16*)(ws2 + WS_R), (const bf16*)(ws2 + WS_K), (const bf16*)(ws2 + WS_V), (const bf16*)(ws2 + WS_AA), G2, (bf16*)(ws2 + WS_Y), tb + 2 * F.wave, tb + 64, 2 * NWAVES);
                    asm volatile("s_waitcnt vmcnt(0)" ::: "memory"); __syncthreads(); } }
        } else rwkv_scan_chunked(F, I, RB, KB, VB, AAB, EWB, YB, (gu32*)(ws + WS_CTL) + CW_PROG);
    } SEAM(20);
    if (IN(23)) { PH_BEGIN_ pg8::EpiResX<true> E{X, X}; dense_gemm(F, YB, 1024, ws + WS_RWO, 1024, T, 1024, E); } SEAM(23);
    MOE_PLE_PHASES(24, 1)
    if (IN(33)) { PH_BEGIN_ final_norm_pass(F, (const bf16*)(ws + WS_YS), OUT, I.final_norm); }
#undef IN
#undef SEAM
}

extern "C" void kernel_launch(void* const* d_in, const int* in_sizes, int n_in, void* d_out, int out_size, void* d_ws, size_t ws_size, hipStream_t stream) {
    static int ok = 0;
    if (ok == 0) {
        if (n_in != 47 || out_size != T * D || ws_size < WS_END) { fprintf(stderr, "kernel_launch: unexpected problem shape (n_in %d out %d ws %zu)\n", n_in, out_size, ws_size); ok = -1; return; }
        if (hipFuncSetAttribute((const void*)mk_fwd, hipFuncAttributeMaxDynamicSharedMemorySize, LDS_BYTES) != hipSuccess) { fprintf(stderr, "kernel_launch: hipFuncSetAttribute failed\n"); ok = -1; return; }
        int per_cu = 0;
        if (hipOccupancyMaxActiveBlocksPerMultiprocessor(&per_cu, (const void*)mk_fwd, NWAVES * 64, LDS_BYTES) != hipSuccess || per_cu < 1) fprintf(stderr, "kernel_launch: occupancy query reports %d\n", per_cu);
        (void)hipGetLastError();
        ok = 1;
    }
    if (ok < 0) return;
    (void)hipMemsetAsync((char*)d_ws + WS_CTL, 0, CTL_ZERO_BYTES, stream);
    Args a{};
    const float** ip = (const float**)&a.in;
    for (int i = 0; i < 47; ++i) ip[i] = (const float*)d_in[i];
    a.out = (float*)d_out; a.ws = (unsigned char*)d_ws;
    const int grid = 256;
#if MK_ONE_LAUNCH
    a.ph_lo = 0; a.ph_hi = N_PHASES;
    hipLaunchKernelGGL(mk_fwd, dim3(grid), dim3(NWAVES * 64), LDS_BYTES, stream, a);
#else
    for (int k = 0; k < N_PHASES; ++k) { a.ph_lo = k; a.ph_hi = k + 1; hipLaunchKernelGGL(mk_fwd, dim3(grid), dim3(NWAVES * 64), LDS_BYTES, stream, a);
        if (k == DUP_K || k == DUP_K2) hipLaunchKernelGGL(mk_fwd, dim3(grid), dim3(NWAVES * 64), LDS_BYTES, stream, a); }
#endif
}
```

```cpp
#include <hip/hip_runtime.h>
#include <hip/hip_bf16.h>
#include <cstdio>
#include <cstdint>
#include <cmath>

#ifndef MK_ONE_LAUNCH
#define MK_ONE_LAUNCH 1
#endif

#define GAS __attribute__((address_space(1)))
#define LAS __attribute__((address_space(3)))
typedef unsigned short bf16;
typedef unsigned v4u __attribute__((ext_vector_type(4)));
typedef unsigned v2u __attribute__((ext_vector_type(2)));
typedef float f32x4 __attribute__((ext_vector_type(4)));
typedef float f32x2 __attribute__((ext_vector_type(2)));
typedef short bf16x8 __attribute__((ext_vector_type(8)));
typedef GAS unsigned gu32;
#define RLX_AGENT __ATOMIC_RELAXED, __HIP_MEMORY_SCOPE_AGENT
#define LDS_WAIT() asm volatile("s_waitcnt lgkmcnt(0)" ::: "memory")
#define VM_WAIT() asm volatile("s_waitcnt vmcnt(0)" ::: "memory")
__device__ __forceinline__ unsigned f2bf(float f) { unsigned u = __builtin_bit_cast(unsigned, f); return (u + 0x7fffu + ((u >> 16) & 1u)) >> 16; }
typedef float f32x2_cv __attribute__((ext_vector_type(2))); typedef __bf16 bf16x2_cv __attribute__((ext_vector_type(2)));
__device__ __forceinline__ unsigned pk2(float lo, float hi) { const f32x2_cv v = {lo, hi}; const bf16x2_cv b = __builtin_convertvector(v, bf16x2_cv); return __builtin_bit_cast(unsigned, b); }
__device__ __forceinline__ float bflo(unsigned w) { return __uint_as_float(w << 16); }
__device__ __forceinline__ float bfhi(unsigned w) { return __uint_as_float(w & 0xffff0000u); }
__device__ __forceinline__ float bf1(bf16 h) { return __uint_as_float((unsigned)h << 16); }
__device__ __forceinline__ float sigmoidf_(float x) { return __builtin_amdgcn_rcpf(1.0f + __builtin_amdgcn_exp2f(-1.4426950408889634f * x)); }
__device__ __forceinline__ float tanhf_(float x) { return 1.0f - 2.0f * __builtin_amdgcn_rcpf(1.0f + __builtin_amdgcn_exp2f(2.885390081777927f * x)); }
__device__ __forceinline__ void fmac_(float& acc, float a, float b) { asm("v_fmac_f32 %0, %1, %2" : "+v"(acc) : "v"(a), "v"(b)); }
__device__ __forceinline__ float fma_(float a, float b, float c) { float r; asm("v_fma_f32 %0, %1, %2, %3" : "=v"(r) : "v"(a), "v"(b), "v"(c)); return r; }
__device__ __forceinline__ float mul_(float a, float b) { float r; asm("v_mul_f32 %0, %1, %2" : "=v"(r) : "v"(a), "v"(b)); return r; }
__device__ __forceinline__ float wave_sum(float v) {
#pragma unroll
    for (int o = 1; o < 64; o <<= 1) v += __shfl_xor(v, o);
    return v;
}

constexpr int NB = 8, SEQ = 8192, D = 1024, T = NB * SEQ;
constexpr int AB_IN = 2560, PLE = 256;
constexpr int NEXP = 32, EH = 512;
constexpr int MAXSLOT = 2 * T + NEXP * 256;
constexpr int MAXTILES = MAXSLOT / 256;

namespace pg8 {
#define PG8_LAS __attribute__((address_space(3)))
typedef unsigned short bf16_t;
typedef unsigned u32x4 __attribute__((ext_vector_type(4)));
typedef unsigned u32x2 __attribute__((ext_vector_type(2)));
constexpr int BM = 256, BK = 64, HALF = 128, HTB = HALF * BK * 2, STAGE_BYTES = 8 * HTB, NXCD = 8, WGM = 8;
__host__ __device__ __forceinline__ int lds_byte(int r, int c) { const int st = (r >> 4) * 2 + (c >> 5), rr = r & 15, cc = c & 31, ob = rr * 64 + cc * 2; return st * 1024 + (ob ^ (((ob >> 9) & 1) << 5)); }
__host__ __device__ __forceinline__ void stage_rc(int b, int& R, int& C) { const int st = b / 1024, sb = b % 1024, swz = sb ^ (((sb >> 9) & 1) << 5); R = (st >> 1) * 16 + swz / 64; C = (st & 1) * 32 + (swz % 64) / 2; }
__host__ __device__ __forceinline__ int perm32(int rho) { const int n = rho >> 4, i = rho & 15; return 8 * (i >> 2) + 4 * n + (i & 3); }

struct Unit { int pm, pn, aux; const char* A; const char* B; };

struct DenseOrder {
    int nM, nN, nwg, G, c; const char* A; const char* B; size_t astep, bstep;
    __device__ void init(const void* A_, int lda, const void* B_, int K, int M, int N, int G_, int c_) { nM = M / BM; nN = N / BM; nwg = nM * nN; G = G_; c = c_; A = (const char*)A_; B = (const char*)B_; astep = (size_t)BM * lda * 2; bstep = (size_t)BM * K * 2; }
    __device__ bool next(int i, Unit& u) const {
        const long L = (long)i * G + c; if (L >= nwg) return false;
        int wgid = (int)L; { const int q = nwg / NXCD, r = nwg % NXCD, xcd = wgid % NXCD, off = wgid / NXCD; wgid = (xcd < r ? xcd * (q + 1) : r * (q + 1) + (xcd - r) * q) + off; }
        const int nig = WGM * nN, gid = wgid / nig, fm = gid * WGM, gsz = (nM - fm) < WGM ? (nM - fm) : WGM;
        u.pm = fm + ((wgid % nig) % gsz); u.pn = (wgid % nig) / gsz; u.aux = 0; u.A = A + (size_t)u.pm * astep; u.B = B + (size_t)u.pn * bstep; return true;
    }
};

__device__ __forceinline__ unsigned cvt_pk_bf16(float lo, float hi) { unsigned r; asm volatile("v_cvt_pk_bf16_f32 %0, %1, %2" : "=v"(r) : "v"(lo), "v"(hi)); return r; }

typedef f32x4 Acc[2][2][4][2];

struct EpiBf16 {
    static constexpr bool PERM = true;
    bf16_t* O; int ldc; int split_cols; size_t split_stride; float scale0;
    __device__ __forceinline__ void operator()(const Acc& acc, const Unit& u, int wr, int wc, int fr, int fq) const {
        const int row0 = u.pm * BM + wr * 64 + fr; int colt = u.pn * BM; bf16_t* base = O;
        float sc = 1.f; if (split_cols) { const int t = colt / split_cols; base += (size_t)t * split_stride; colt -= t * split_cols; if (t == 0) sc = scale0; }
        const int col0 = colt + wc * 32 + 8 * fq;
#pragma unroll
        for (int ai = 0; ai < 2; ++ai)
#pragma unroll
            for (int m = 0; m < 4; ++m) { bf16_t* rowp = base + (size_t)(row0 + ai * HALF + m * 16) * ldc + col0;
#pragma unroll
                for (int bj = 0; bj < 2; ++bj) { f32x4 v0 = acc[ai][bj][m][0] * sc, v1 = acc[ai][bj][m][1] * sc;
                    u32x4 w; w.x = cvt_pk_bf16(v0[0], v0[1]); w.y = cvt_pk_bf16(v0[2], v0[3]); w.z = cvt_pk_bf16(v1[0], v1[1]); w.w = cvt_pk_bf16(v1[2], v1[3]);
                    *(u32x4*)(rowp + bj * HALF) = w; } }
    }
};
__device__ __forceinline__ void unpack8f(const u32x4 w, f32x4& lo, f32x4& hi) { lo = (f32x4){bflo(w.x), bfhi(w.x), bflo(w.y), bfhi(w.y)}; hi = (f32x4){bflo(w.z), bfhi(w.z), bflo(w.w), bfhi(w.w)}; }
template <bool BASE_BF16>
struct EpiResX {
    static constexpr bool PERM = true;
    const void* base; bf16_t* out;
    __device__ __forceinline__ void operator()(const Acc& acc, const Unit& u, int wr, int wc, int fr, int fq) const {
        const int col0 = u.pn * BM + wc * 32 + 8 * fq; GAS bf16_t* op = (GAS bf16_t*)out;
#pragma unroll
        for (int ai = 0; ai < 2; ++ai) {
            f32x4 b0[4][2], b1[4][2];
#pragma unroll
            for (int m = 0; m < 4; ++m) { const size_t off = (size_t)(u.pm * BM + ai * HALF + wr * 64 + m * 16 + fr) * 1024 + col0;
#pragma unroll
                for (int bj = 0; bj < 2; ++bj) {
                    if (BASE_BF16) { const u32x4 w = *(const GAS u32x4*)((const GAS bf16_t*)base + off + bj * HALF); unpack8f(w, b0[m][bj], b1[m][bj]); }
                    else { b0[m][bj] = *(const GAS f32x4*)((const GAS float*)base + off + bj * HALF); b1[m][bj] = *(const GAS f32x4*)((const GAS float*)base + off + bj * HALF + 4); } } }
            asm volatile("" ::: "memory");
#pragma unroll
            for (int m = 0; m < 4; ++m) { const size_t off = (size_t)(u.pm * BM + ai * HALF + wr * 64 + m * 16 + fr) * 1024 + col0;
#pragma unroll
                for (int bj = 0; bj < 2; ++bj) { const f32x4 v0 = b0[m][bj] + acc[ai][bj][m][0], v1 = b1[m][bj] + acc[ai][bj][m][1];
                    u32x4 w; w.x = cvt_pk_bf16(v0[0], v0[1]); w.y = cvt_pk_bf16(v0[2], v0[3]); w.z = cvt_pk_bf16(v1[0], v1[1]); w.w = cvt_pk_bf16(v1[2], v1[3]);
                    *(GAS u32x4*)(op + off + bj * HALF) = w; } }
            asm volatile("" ::: "memory");
        }
    }
};
struct EpiRouter {
    static constexpr bool PERM = false;
    float* out;
    __device__ __forceinline__ void operator()(const Acc& acc, const Unit& u, int wr, int wc, int fr, int fq) const {
        if (wc >= 2) return;
#pragma unroll
        for (int ai = 0; ai < 2; ++ai)
#pragma unroll
            for (int m = 0; m < 4; ++m) { const size_t off = (size_t)(u.pm * BM + ai * HALF + wr * 64 + m * 16 + fr) * 64 + wc * 32 + 4 * fq;
#pragma unroll
                for (int n = 0; n < 2; ++n) *(f32x4*)(out + off + n * 16) = acc[ai][0][m][n]; }
    }
};
struct EpiGU {
    static constexpr bool PERM = true;
    bf16_t* H;
    __device__ __forceinline__ void operator()(const Acc& acc, const Unit& u, int wr, int wc, int fr, int fq) const {
        const int col0 = u.pn * 128 + wc * 32 + 8 * fq;
#pragma unroll
        for (int ai = 0; ai < 2; ++ai)
#pragma unroll
            for (int m = 0; m < 4; ++m) { bf16_t* rowp = H + (size_t)(u.pm * BM + ai * HALF + wr * 64 + m * 16 + fr) * EH + col0;
                f32x4 g0 = acc[ai][0][m][0], g1 = acc[ai][0][m][1]; const f32x4 u0 = acc[ai][1][m][0], u1 = acc[ai][1][m][1];
#pragma unroll
                for (int e = 0; e < 4; ++e) { g0[e] = g0[e] * sigmoidf_(g0[e]) * u0[e]; g1[e] = g1[e] * sigmoidf_(g1[e]) * u1[e]; }
                u32x4 w; w.x = cvt_pk_bf16(g0[0], g0[1]); w.y = cvt_pk_bf16(g0[2], g0[3]); w.z = cvt_pk_bf16(g1[0], g1[1]); w.w = cvt_pk_bf16(g1[2], g1[3]);
                *(u32x4*)rowp = w; }
    }
};
struct EpiDown {
    static constexpr bool PERM = true;
    bf16_t* Y; const float* gate;
    __device__ __forceinline__ void operator()(const Acc& acc, const Unit& u, int wr, int wc, int fr, int fq) const {
        const int col0 = u.pn * BM + wc * 32 + 8 * fq;
#pragma unroll
        for (int ai = 0; ai < 2; ++ai)
#pragma unroll
            for (int m = 0; m < 4; ++m) { const int row = u.pm * BM + ai * HALF + wr * 64 + m * 16 + fr; const float sc = gate[row]; bf16_t* rowp = Y + (size_t)row * 1024 + col0;
#pragma unroll
                for (int bj = 0; bj < 2; ++bj) { const f32x4 v0 = acc[ai][bj][m][0] * sc, v1 = acc[ai][bj][m][1] * sc;
                    u32x4 w; w.x = cvt_pk_bf16(v0[0], v0[1]); w.y = cvt_pk_bf16(v0[2], v0[3]); w.z = cvt_pk_bf16(v1[0], v1[1]); w.w = cvt_pk_bf16(v1[2], v1[3]);
                    *(u32x4*)(rowp + bj * HALF) = w; } }
    }
};
struct EpiPle {
    static constexpr bool PERM = true;
    const bf16_t* xin; bf16_t* xout; const bf16_t* pp;
    __device__ __forceinline__ void operator()(const Acc& acc, const Unit& u, int wr, int wc, int fr, int fq) const {
        const int col0 = u.pn * BM + wc * 32 + 8 * fq;
        const GAS bf16_t* xp = (const GAS bf16_t*)xin; GAS bf16_t* op = (GAS bf16_t*)xout; const GAS bf16_t* pq = (const GAS bf16_t*)pp;
#pragma unroll
        for (int ai = 0; ai < 2; ++ai) {
            u32x4 xw[4][2], pw[4][2];
#pragma unroll
            for (int m = 0; m < 4; ++m) { const size_t off = (size_t)(u.pm * BM + ai * HALF + wr * 64 + m * 16 + fr) * 1024 + col0;
#pragma unroll
                for (int bj = 0; bj < 2; ++bj) { xw[m][bj] = *(const GAS u32x4*)(xp + off + bj * HALF); pw[m][bj] = *(const GAS u32x4*)(pq + off + bj * HALF); } }
            asm volatile("" ::: "memory");
#pragma unroll
            for (int m = 0; m < 4; ++m) { const size_t off = (size_t)(u.pm * BM + ai * HALF + wr * 64 + m * 16 + fr) * 1024 + col0;
#pragma unroll
                for (int bj = 0; bj < 2; ++bj) { f32x4 x0, x1, p0, p1; unpack8f(xw[m][bj], x0, x1); unpack8f(pw[m][bj], p0, p1); const f32x4 a0 = acc[ai][bj][m][0], a1 = acc[ai][bj][m][1];
#pragma unroll
                    for (int e = 0; e < 4; ++e) { x0[e] += p0[e] * sigmoidf_(a0[e]); x1[e] += p1[e] * sigmoidf_(a1[e]); }
                    u32x4 w; w.x = cvt_pk_bf16(x0[0], x0[1]); w.y = cvt_pk_bf16(x0[2], x0[3]); w.z = cvt_pk_bf16(x1[0], x1[1]); w.w = cvt_pk_bf16(x1[2], x1[3]);
                    *(GAS u32x4*)(op + off + bj * HALF) = w; } }
            asm volatile("" ::: "memory");
        }
    }
};
struct EpiMid {
    static constexpr bool PERM = true;
    bf16_t* MID;
    __device__ __forceinline__ void operator()(const Acc& acc, const Unit& u, int wr, int wc, int fr, int fq) const {
        const int row0 = u.pm * BM + wr * 64 + fr;
        const int mode = (u.pn == 1) ? 2 : 0; const int colbase = u.pn * 256;
#pragma unroll
        for (int ai = 0; ai < 2; ++ai)
#pragma unroll
            for (int m = 0; m < 4; ++m) { bf16_t* rowp = MID + (size_t)(row0 + ai * HALF + m * 16) * 512 + colbase;
#pragma unroll
                for (int bj = 0; bj < 2; ++bj) { const int lc = bj * HALF + wc * 32 + 8 * fq; f32x4 v0 = acc[ai][bj][m][0], v1 = acc[ai][bj][m][1];
#pragma unroll
                    for (int e = 0; e < 4; ++e) {
                        if (mode == 2) { v0[e] = sigmoidf_(v0[e]); v1[e] = sigmoidf_(v1[e]); }
                        else if (lc < 64) { v0[e] = tanhf_(v0[e]); v1[e] = tanhf_(v1[e]); } }
                    u32x4 w; w.x = cvt_pk_bf16(v0[0], v0[1]); w.y = cvt_pk_bf16(v0[2], v0[3]); w.z = cvt_pk_bf16(v1[0], v1[1]); w.w = cvt_pk_bf16(v1[2], v1[3]);
                    *(u32x4*)(rowp + lc) = w; } }
    }
};
struct EpiRwkv2 {
    static constexpr bool PERM = true;
    bf16_t* O0; bf16_t* O1; const float* bias0; const float* bias1; int tybase;
    __device__ __forceinline__ void operator()(const Acc& acc, const Unit& u, int wr, int wc, int fr, int fq) const {
        const int ty = tybase + (u.pn >> 2); const int row0 = u.pm * BM + wr * 64 + fr; const int colt = (u.pn & 3) * BM + wc * 32 + 8 * fq;
        bf16_t* base = (u.pn >> 2) ? O1 : O0; const float* bias = (u.pn >> 2) ? bias1 : bias0;
#pragma unroll
        for (int bj = 0; bj < 2; ++bj) {
            f32x4 b0 = (f32x4){0.f, 0.f, 0.f, 0.f}, b1 = b0;
            if (ty < 2) { b0 = *(const f32x4*)(bias + colt + bj * HALF); b1 = *(const f32x4*)(bias + colt + bj * HALF + 4); }
#pragma unroll
            for (int ai = 0; ai < 2; ++ai)
#pragma unroll
                for (int m = 0; m < 4; ++m) { bf16_t* rowp = base + (size_t)(row0 + ai * HALF + m * 16) * 1024 + colt + bj * HALF;
                    f32x4 v0 = acc[ai][bj][m][0] + b0, v1 = acc[ai][bj][m][1] + b1;
                    if (ty < 2) { const float s = (ty == 0) ? 0.6065306597126334f * 1.4426950408889634f : 1.0f;
#pragma unroll
                        for (int e = 0; e < 4; ++e) { v0[e] = s * sigmoidf_(v0[e]); v1[e] = s * sigmoidf_(v1[e]); } }
                    u32x4 w; w.x = cvt_pk_bf16(v0[0], v0[1]); w.y = cvt_pk_bf16(v0[2], v0[3]); w.z = cvt_pk_bf16(v1[0], v1[1]); w.w = cvt_pk_bf16(v1[2], v1[3]);
                    *(u32x4*)rowp = w; }
        }
    }
};

template <class Epi, class Sched, bool ALIGN_EPI, bool GATHER>
__device__ __forceinline__ void gemm_phase(PG8_LAS unsigned char* lds, const int K, const int lda, const Sched& S, const Epi& E, const int* __restrict__ rows, const int tid) {
    const int wid = __builtin_amdgcn_readfirstlane(tid >> 6), lane = tid & 63, wr = wid >> 2, wc = wid & 3, fr = lane & 15, fq = lane >> 4;
    const int nt = K / BK;
    unsigned voffA[2], voffB[2]; int RA[2];
#pragma unroll
    for (int i = 0; i < 2; ++i) { int R, C; stage_rc(tid * 16 + i * 8192, R, C); const int Rb = Epi::PERM ? ((R & ~31) + perm32(R & 31)) : R;
        RA[i] = R; voffA[i] = GATHER ? (unsigned)(C * 2) : (unsigned)(R * lda + C) * 2u; voffB[i] = (unsigned)(Rb * K + C) * 2u; }
    const size_t kstep = (size_t)(BK * 2);
    const size_t hstepA = GATHER ? 0 : (size_t)HALF * lda * 2, hstepB = (size_t)HALF * K * 2;
    const unsigned ldsw = (unsigned)wid * 1024u;
    const int aoff = lds_byte(wr * 64 + fr, fq * 8), boff = lds_byte(wc * 32 + fr, fq * 8);
#define PG8_SA(b, h) (((b) * 2 + (h)) * HTB)
#define PG8_SB(b, h) ((4 + (b) * 2 + (h)) * HTB)
#define PG8_ST2(bufoff, gbase, o0, o1) do { \
        __builtin_amdgcn_global_load_lds((const unsigned*)((const char*)(gbase) + (o0)), (PG8_LAS unsigned*)(lds + (bufoff) + ldsw), 16, 0, 0); \
        __builtin_amdgcn_global_load_lds((const unsigned*)((const char*)(gbase) + (o1)), (PG8_LAS unsigned*)(lds + (bufoff) + ldsw + 8192), 16, 0, 0); } while (0)
#define PG8_STB(bufoff, gbase) PG8_ST2(bufoff, gbase, voffB[0], voffB[1])
#define PG8_STA(bufoff, p, h, nx) do { if constexpr (GATHER) { const unsigned g0_ = (nx) ? gN[h][0] : gC[h][0], g1_ = (nx) ? gN[h][1] : gC[h][1]; PG8_ST2(bufoff, p, g0_, g1_); } \
        else { PG8_ST2(bufoff, (p) + (h) * hstepA, voffA[0], voffA[1]); } } while (0)
#define PG8_LDA(dst, b, h) do { _Pragma("unroll") for (int m = 0; m < 4; ++m) _Pragma("unroll") for (int k = 0; k < 2; ++k) dst[m][k] = *(const PG8_LAS bf16x8*)(lds + PG8_SA(b, h) + aoff + m * 2048 + k * 1024); } while (0)
#define PG8_LDB(dst, b, h) do { _Pragma("unroll") for (int n = 0; n < 2; ++n) _Pragma("unroll") for (int k = 0; k < 2; ++k) dst[n][k] = *(const PG8_LAS bf16x8*)(lds + PG8_SB(b, h) + boff + n * 2048 + k * 1024); } while (0)
#define PG8_MMA(ai, bj, At, Bt) do { __builtin_amdgcn_s_setprio(1); _Pragma("unroll") for (int m = 0; m < 4; ++m) _Pragma("unroll") for (int n = 0; n < 2; ++n) _Pragma("unroll") for (int k = 0; k < 2; ++k) \
        acc[ai][bj][m][n] = __builtin_amdgcn_mfma_f32_16x16x32_bf16(Bt[n][k], At[m][k], acc[ai][bj][m][n], 0, 0, 0); __builtin_amdgcn_s_setprio(0); } while (0)
#define PG8_WAIT_V(n) asm volatile("s_waitcnt vmcnt(" #n ")" ::: "memory")
#define PG8_WAIT_L(n) asm volatile("s_waitcnt lgkmcnt(" #n ")" ::: "memory")
#define PG8_BAR __builtin_amdgcn_s_barrier()
#define PG8_SCHED __builtin_amdgcn_sched_barrier(0)
#define PG8_GLOAD(dst, un) do { if constexpr (GATHER) { _Pragma("unroll") for (int h_ = 0; h_ < 2; ++h_) _Pragma("unroll") for (int i_ = 0; i_ < 2; ++i_) \
        dst[h_][i_] = (unsigned)rows[(un).pm * BM + h_ * HALF + RA[i_]] * (unsigned)(lda * 2) + voffA[i_]; } } while (0)
    Unit cur, nxt; int ui = 0;
    if (!S.next(0, cur)) return;
    unsigned gC[2][2] = {{0u, 0u}, {0u, 0u}}, gN[2][2] = {{0u, 0u}, {0u, 0u}};
    PG8_GLOAD(gC, cur);
    Acc acc;
#pragma unroll
    for (int a = 0; a < 2; ++a)
#pragma unroll
        for (int b = 0; b < 2; ++b)
#pragma unroll
            for (int m = 0; m < 4; ++m)
#pragma unroll
                for (int n = 0; n < 2; ++n) acc[a][b][m][n] = (f32x4){0.f, 0.f, 0.f, 0.f};
    bf16x8 At[4][2], B0[2][2], B1[2][2];
    const char* cA = cur.A; const char* cB = cur.B;
    PG8_STB(PG8_SB(0, 0), cB); PG8_STB(PG8_SB(0, 1), cB + hstepB); PG8_STA(PG8_SA(0, 0), cA, 0, false); PG8_STA(PG8_SA(0, 1), cA, 1, false);
    if (wr == 1) PG8_BAR;
    PG8_WAIT_V(2); PG8_BAR;
    PG8_STB(PG8_SB(1, 0), cB + kstep); PG8_STA(PG8_SA(1, 0), cA + kstep, 0, false); PG8_STB(PG8_SB(1, 1), cB + hstepB + kstep);
    PG8_WAIT_V(6); PG8_BAR;
    for (;;) {
        const bool has_next = S.next(ui + 1, nxt);
        if (has_next) { PG8_GLOAD(gN, nxt); }
        const char* nA = has_next ? nxt.A : cA; const char* nB = has_next ? nxt.B : cB;
#pragma unroll 1
        for (int t = 0; t < nt; t += 2) {
            const bool last = (t == nt - 2); const bool nx = last && has_next;
            const char* a1 = cA + (size_t)(t + 1) * kstep;
            const char* a2 = last ? nA : cA + (size_t)(t + 2) * kstep; const char* b2 = last ? nB : cB + (size_t)(t + 2) * kstep;
            const char* a3 = a2 + kstep; const char* b3 = b2 + kstep;
            PG8_LDB(B0, 0, 0); PG8_LDB(B1, 0, 1); PG8_SCHED; PG8_LDA(At, 0, 0); PG8_STA(PG8_SA(1, 1), a1, 1, false);
            PG8_WAIT_V(8); PG8_WAIT_L(0); PG8_BAR; PG8_MMA(0, 0, At, B0); PG8_MMA(0, 1, At, B1); PG8_BAR; PG8_SCHED;
            PG8_LDA(At, 0, 1); PG8_STB(PG8_SB(0, 0), b2); PG8_STB(PG8_SB(0, 1), b2 + hstepB); PG8_STA(PG8_SA(0, 0), a2, 0, nx);
            PG8_WAIT_V(8); PG8_WAIT_L(0); PG8_BAR; PG8_MMA(1, 0, At, B0); PG8_MMA(1, 1, At, B1); PG8_BAR; PG8_SCHED;
            PG8_LDB(B0, 1, 0); PG8_LDB(B1, 1, 1); PG8_SCHED; PG8_LDA(At, 1, 0); PG8_STA(PG8_SA(0, 1), a2, 1, nx);
            PG8_WAIT_V(8); PG8_WAIT_L(0); PG8_BAR; PG8_MMA(0, 0, At, B0); PG8_MMA(0, 1, At, B1); PG8_BAR; PG8_SCHED;
            PG8_LDA(At, 1, 1); PG8_STB(PG8_SB(1, 0), b3); PG8_STB(PG8_SB(1, 1), b3 + hstepB); PG8_STA(PG8_SA(1, 0), a3, 0, nx);
            PG8_WAIT_V(8); PG8_WAIT_L(0); PG8_BAR; PG8_MMA(1, 0, At, B0); PG8_MMA(1, 1, At, B1); PG8_BAR; PG8_SCHED;
        }
        if constexpr (ALIGN_EPI) { if (wr == 0) PG8_BAR; }
        E(acc, cur, wr, wc, fr, fq);
        if (!has_next) break;
#pragma unroll
        for (int a = 0; a < 2; ++a)
#pragma unroll
            for (int b = 0; b < 2; ++b)
#pragma unroll
                for (int m = 0; m < 4; ++m)
#pragma unroll
                    for (int n = 0; n < 2; ++n) acc[a][b][m][n] = (f32x4){0.f, 0.f, 0.f, 0.f};
        cur = nxt; cA = nA; cB = nB; ++ui;
        if constexpr (GATHER) {
#pragma unroll
            for (int h_ = 0; h_ < 2; ++h_)
#pragma unroll
                for (int i_ = 0; i_ < 2; ++i_) gC[h_][i_] = gN[h_][i_]; }
        if constexpr (ALIGN_EPI) { if (wr == 1) PG8_BAR; }
    }
    PG8_WAIT_V(0);
    if constexpr (!ALIGN_EPI) { if (wr == 0) PG8_BAR; }
    PG8_BAR;
#undef PG8_SA
#undef PG8_SB
#undef PG8_ST2
#undef PG8_STB
#undef PG8_STA
#undef PG8_LDA
#undef PG8_LDB
#undef PG8_MMA
#undef PG8_WAIT_V
#undef PG8_WAIT_L
#undef PG8_BAR
#undef PG8_SCHED
#undef PG8_GLOAD
}
}
namespace attn_body {
using bf16=__hip_bfloat16;
using bf16x8=__attribute__((ext_vector_type(8)))short;
using s16x4=__attribute__((ext_vector_type(4)))short;
using f32x16=__attribute__((ext_vector_type(16)))float;
using u32x4=__attribute__((ext_vector_type(4)))unsigned;
constexpr int BATCH=8,NHEAD=16,SEQ=8192,D=64,PQ=512,PO=1024;
constexpr int NW=8,QBLK=32,QB=QBLK*NW,KVBLK=64,NQB=SEQ/QB;
constexpr int ATTN_UNIT_ROWS=QB;
__device__ __forceinline__ int crow(int r,int hi){return (r&3)+8*(r>>2)+4*hi;}
#define SBAR() __builtin_amdgcn_sched_barrier(0)
__device__ __forceinline__ void cmask(f32x16&p0,f32x16&p1,int jb,int qrel,int hi){
  const float NEG=-INFINITY; int kb=64*jb+4*hi;
  #pragma unroll
  for(int r=0;r<16;++r){int kv=kb+(r&3)+8*(r>>2); if(kv>qrel)p0[r]=NEG; if(kv+32>qrel)p1[r]=NEG;}
}

__device__ __forceinline__ void cbias(f32x16&p0,f32x16&p1,int jb,int qrel,int hi,const __attribute__((address_space(3))) float*tb){
  const int kb=64*jb+4*hi;
  #pragma unroll
  for(int r=0;r<16;++r){const int rel=qrel-(kb+(r&3)+8*(r>>2)); const int i0=min(max(rel,0),127), i1=min(max(rel-32,0),127); p0[r]+=tb[i0]; p1[r]+=tb[i1];}
}
constexpr int NSLOT=3, SLOTB=8192;
constexpr int LDS_K=0, LDS_V=NSLOT*SLOTB, LDS_WS=2*NSLOT*SLOTB, LDS_OST=LDS_WS+NW*64*4, LDS_BYTES=LDS_OST+NW*4096;
constexpr float C2=0.125f*1.4426950408889634f;
__device__ __forceinline__ void glds16(const void*gsrc,unsigned lds_dst){unsigned keep;
  asm volatile("s_mov_b32 %0, m0\n\ts_mov_b32 m0, %2\n\ts_nop 0\n\tglobal_load_lds_dwordx4 %1, off\n\ts_mov_b32 m0, %0":"=&s"(keep):"v"(gsrc),"s"(lds_dst):"memory");}
__device__ __forceinline__ float max3f(float a,float b,float c){float r;asm("v_max3_f32 %0, %1, %2, %3":"=v"(r):"v"(a),"v"(b),"v"(c));return r;}
__device__ __forceinline__ float max2f(float a,float b){float r;asm("v_max_f32_e32 %0, %1, %2":"=v"(r):"v"(a),"v"(b));return r;}
__device__ __forceinline__ float fadd_s(float a,float b){float r;asm("v_add_f32_e32 %0, %1, %2":"=v"(r):"v"(a),"v"(b));return r;}
__device__ __forceinline__ float fsub_s(float a,float b){float r;asm("v_sub_f32_e32 %0, %1, %2":"=v"(r):"v"(a),"v"(b));return r;}
typedef float f32x2_t __attribute__((ext_vector_type(2))); typedef __bf16 bf16x2_t __attribute__((ext_vector_type(2)));
__device__ __forceinline__ unsigned cvtpk_s(float lo,float hi){f32x2_t v={lo,hi};bf16x2_t b=__builtin_convertvector(v,bf16x2_t);return __builtin_bit_cast(unsigned,b);}
#define WAIT_BAR(N) asm volatile("s_waitcnt vmcnt(" #N ") lgkmcnt(0)\n\ts_barrier":::"memory")

__device__ __forceinline__ void qkt(f32x16&p0,f32x16&p1,const char*Kslot,const bf16x8*qr,const f32x16&negm,int r32,int hi){
  const char*kb=Kslot+hi*1024+r32*16;
  #pragma unroll
  for(int d0=0;d0<4;++d0){
    const bf16x8 b0=*reinterpret_cast<const bf16x8*>(kb+d0*2048);
    const bf16x8 b1=*reinterpret_cast<const bf16x8*>(kb+d0*2048+512);
    if(d0==0){p0=__builtin_amdgcn_mfma_f32_32x32x16_bf16(b0,qr[0],negm,0,0,0);p1=__builtin_amdgcn_mfma_f32_32x32x16_bf16(b1,qr[0],negm,0,0,0);}
    else{p0=__builtin_amdgcn_mfma_f32_32x32x16_bf16(b0,qr[d0],p0,0,0,0);p1=__builtin_amdgcn_mfma_f32_32x32x16_bf16(b1,qr[d0],p1,0,0,0);}}
}
typedef __attribute__((address_space(3))) const char* lds_cptr;
typedef short v4i16_t __attribute__((ext_vector_type(4)));
__device__ __forceinline__ void kload8(bf16x8*kf,lds_cptr kp){
  kf[0]=*(const __attribute__((address_space(3))) bf16x8*)(kp);      kf[1]=*(const __attribute__((address_space(3))) bf16x8*)(kp+512);
  kf[2]=*(const __attribute__((address_space(3))) bf16x8*)(kp+2048); kf[3]=*(const __attribute__((address_space(3))) bf16x8*)(kp+2560);
  kf[4]=*(const __attribute__((address_space(3))) bf16x8*)(kp+4096); kf[5]=*(const __attribute__((address_space(3))) bf16x8*)(kp+4608);
  kf[6]=*(const __attribute__((address_space(3))) bf16x8*)(kp+6144); kf[7]=*(const __attribute__((address_space(3))) bf16x8*)(kp+6656);
}
__device__ __forceinline__ void kload2(bf16x8*kf,lds_cptr kp,int j){ kf[2*j]=*(const __attribute__((address_space(3))) bf16x8*)(kp+j*2048); kf[2*j+1]=*(const __attribute__((address_space(3))) bf16x8*)(kp+j*2048+512); }
__device__ __forceinline__ s16x4 vtr(lds_cptr p){ return __builtin_bit_cast(s16x4,__builtin_amdgcn_ds_read_tr16_b64_v4i16((__attribute__((address_space(3))) v4i16_t*)p)); }
__device__ __forceinline__ float rowmax(const f32x16&p0,const f32x16&p1){
  float a=max3f(p0[0],p0[1],p1[0]),b=max3f(p0[2],p0[3],p1[1]);a=max3f(a,p1[2],p1[3]);
  #pragma unroll
  for(int r=4;r<16;r+=4){a=max3f(a,p0[r],p0[r+1]);b=max3f(b,p0[r+2],p0[r+3]);a=max3f(a,p1[r],p1[r+1]);b=max3f(b,p1[r+2],p1[r+3]);}
  const float m=max2f(a,b);
  auto rr=__builtin_amdgcn_permlane32_swap(__float_as_uint(m),__float_as_uint(m),false,false);
  return max2f(__uint_as_float(rr[0]),__uint_as_float(rr[1]));
}
__device__ __forceinline__ void pv(f32x16*o,int vb,bf16x8 pa0,bf16x8 pa1,bf16x8 pa2,bf16x8 pa3){
  #pragma unroll
  for(int d0=0;d0<2;++d0){s16x4 lo[4],hi[4];
    #pragma unroll
    for(int ks=0;ks<4;++ks){
      asm volatile("ds_read_b64_tr_b16 %0,%1 offset:%c2":"=&v"(lo[ks]):"v"(vb),"i"(d0*4096+ks*1024):"memory");
      asm volatile("ds_read_b64_tr_b16 %0,%1 offset:%c2":"=&v"(hi[ks]):"v"(vb),"i"(d0*4096+ks*1024+512):"memory");}
    asm volatile("s_waitcnt lgkmcnt(0)":::"memory");SBAR();
    #define PK(k) (bf16x8){lo[k][0],lo[k][1],lo[k][2],lo[k][3],hi[k][0],hi[k][1],hi[k][2],hi[k][3]}
    o[d0]=__builtin_amdgcn_mfma_f32_32x32x16_bf16(pa0,PK(0),o[d0],0,0,0);
    o[d0]=__builtin_amdgcn_mfma_f32_32x32x16_bf16(pa1,PK(1),o[d0],0,0,0);
    o[d0]=__builtin_amdgcn_mfma_f32_32x32x16_bf16(pa2,PK(2),o[d0],0,0,0);
    o[d0]=__builtin_amdgcn_mfma_f32_32x32x16_bf16(pa3,PK(3),o[d0],0,0,0);
    #undef PK
  }
}

#ifndef ATTN_STORE16
#define ATTN_STORE16(p,v) (*(u32x4*)(p)=(v))
#endif
template<int THRL> __device__ __forceinline__ void attn_unit(int b,int vh,int qb,const bf16*Q,const bf16*__restrict__ K,const bf16*__restrict__ V,bf16*O,char*shm,const __attribute__((address_space(3))) float*tball,const int tid){
  const int lane=tid&63,r32=lane&31,hi=lane>>5; const int wid=__builtin_amdgcn_readfirstlane(tid>>6);
  const long rowbase=(long)b*SEQ; const int q0=qb*QB;
  const int hh=vh>>2, qcol=hh*128+((vh>>1)&1)*64, vcol=hh*128+(vh&1)*64;
  const __attribute__((address_space(3))) float*tb=tball+hh*128;
  const bf16*Qw=Q+(rowbase+q0+wid*QBLK)*PQ+qcol;
  const bf16*Kh=K+rowbase*PQ+qcol,*Vh=V+rowbase*PQ+vcol;
  const unsigned lds0=(unsigned)(uintptr_t)shm;
  float*wsf=(float*)(shm+LDS_WS)+wid*64;
  const bf16*ksrc=Kh+(long)lane*PQ+wid*8;
  const bf16*vsrc=Vh+(long)(16*(wid&3)+(lane>>2))*PQ+(wid>>2)*32+(lane&3)*8;
  const unsigned kdst=lds0+LDS_K+wid*1024, vdst=lds0+LDS_V+wid*1024;
  #define DMA_K(t,slot) glds16(ksrc+(long)(t)*KVBLK*PQ,(unsigned)__builtin_amdgcn_readfirstlane(kdst+(slot)))
  #define DMA_V(t,slot) glds16(vsrc+(long)(t)*KVBLK*PQ,(unsigned)__builtin_amdgcn_readfirstlane(vdst+(slot)))
  const int vb0=(int)(lds0+LDS_V)+((lane>>4)&1)*32+(lane&3)*8+(4*hi+((lane&15)>>2))*64;
  const char*Kbase=shm+LDS_K; bf16x8 kf[8];
  const lds_cptr shm3=(lds_cptr)shm; const lds_cptr kp0=shm3+LDS_K+hi*1024+r32*16; const lds_cptr vp0=shm3+LDS_V+((lane>>4)&1)*32+(lane&3)*8+(4*hi+((lane&15)>>2))*64;
  const int NT=(q0+QB)/KVBLK;
  DMA_K(0,0);DMA_V(0,0);DMA_K(1,SLOTB);
  bf16x8 qr[4];
  #pragma unroll
  for(int d0=0;d0<4;++d0)qr[d0]=*reinterpret_cast<const bf16x8*>(&Qw[(long)r32*PQ+d0*16+hi*8]);
  float mhat=0.f,l_reg=0.f;f32x16 o[2];o[0]=f32x16{};o[1]=f32x16{};f32x16 negm=f32x16{};asm volatile("":"+v"(negm));
  const int qrel=wid*QBLK+r32;
  #define CMASK(P0,P1,t) do{int jb_=(t)-(NT-4); if(jb_>=-2){cbias(P0,P1,jb_,qrel,hi,tb); if(jb_>=0)cmask(P0,P1,jb_,qrel,hi);}}while(0)
  bool resc=false;
  #define START(P0,P1) do{ const float rm=rowmax(P0,P1); resc=false; \
    { const float dl=rm; mhat=fadd_s(mhat,dl); \
      _Pragma("unroll") for(int r=0;r<16;++r){P0[r]=fsub_s(P0[r],dl);P1[r]=fsub_s(P1[r],dl);} \
      _Pragma("unroll") for(int r=0;r<16;++r)negm[r]=-mhat; asm volatile("":"+v"(negm)); } \
    _Pragma("unroll") for(int r=0;r<16;++r)P0[r]=__builtin_amdgcn_exp2f(P0[r]); }while(0)
  #define RESC() do{ if(resc){ asm volatile("s_waitcnt lgkmcnt(0)":::"memory"); \
      _Pragma("unroll") for(int d_=0;d_<2;++d_) _Pragma("unroll") for(int r=0;r<16;++r)o[d_][r]*=wsf[crow(r,hi)]; } }while(0)
  f32x16 pA0,pA1,pB0,pB1;
  int sl_prev=0,sl_cur=0,sl_next=SLOTB;
  #define ROT() do{sl_prev=sl_cur;sl_cur=sl_next;sl_next=(sl_next==(NSLOT-1)*SLOTB)?0:sl_next+SLOTB;}while(0)
  DMA_K(2,2*SLOTB);
  WAIT_BAR(3);
  qkt(pA0,pA1,Kbase,qr,negm,r32,hi);asm volatile("s_nop 15\n\ts_nop 7":"+v"(pA0),"+v"(pA1));CMASK(pA0,pA1,0);
  START(pA0,pA1);
  _Pragma("unroll") for(int r=0;r<16;++r)pA1[r]=__builtin_amdgcn_exp2f(pA1[r]);
  WAIT_BAR(0);
  DMA_K(3,0);DMA_V(1,SLOTB);
  ROT();
  kload8(kf,kp0+sl_cur);
  WAIT_BAR(2);
  s16x4 vlo[8],vhi[8]; u32x4 pw0,pw1,pw2,pw3;
  #define PKW(P,B) cvtpk_s(P[B],P[B+1])
  #define PAF(k) __builtin_bit_cast(bf16x8,pw##k)
  #define VFR(i) (bf16x8){vlo[i][0],vlo[i][1],vlo[i][2],vlo[i][3],vhi[i][0],vhi[i][1],vhi[i][2],vhi[i][3]}
  #define PIN(x) asm volatile("":"+v"(x))
  #define MX3(a,b,c) __builtin_fmaxf(__builtin_fmaxf((a),(b)),(c))
  #define GAPA(MF,A0,A1,A2,A3,W0,W1,PW) do{ MF; sacc+=A0; sacc+=A1; sacc+=A2; sacc+=A3; PIN(sacc); W0; W1; PIN(PW); SBAR(); }while(0)
  #define EX(v) __builtin_amdgcn_exp2f(v)
  #define GAPB(MF,X,B) do{ MF; X[B]=EX(X[B]); X[B+1]=EX(X[B+1]); X[B+2]=EX(X[B+2]); X[B+3]=EX(X[B+3]); PIN(X); SBAR(); }while(0)
  #define VRD(i) do{ vlo[i]=vtr(vp_+(((i)>>2)*4096+((i)&3)*1024)); vhi[i]=vtr(vp_+(((i)>>2)*4096+((i)&3)*1024+512)); }while(0)
  #define KRD(G,j) do{ if(G){ kload2(kf,kp0+sl_next,j); SBAR(); } }while(0)
  #define STEP(C0,C1,P0,P1,t,GK,GV,GL) do{ SBAR(); \
    const lds_cptr vp_=vp0+sl_prev; \
    VRD(0); SBAR(); float sacc=(P0[0]+P0[1]); \
    GAPA(C0=__builtin_amdgcn_mfma_f32_32x32x16_bf16(kf[0],qr[0],negm,0,0,0), P0[2],P0[3],P0[4],P0[5],     pw0[0]=PKW(P0,0), pw0[1]=PKW(P0,2), pw0); \
    VRD(4); SBAR(); GAPA(C1=__builtin_amdgcn_mfma_f32_32x32x16_bf16(kf[1],qr[0],negm,0,0,0), P0[6],P0[7],P0[8],P0[9],     pw0[2]=PKW(P0,4), pw0[3]=PKW(P0,6), pw0); \
    VRD(1); SBAR(); GAPA(C0=__builtin_amdgcn_mfma_f32_32x32x16_bf16(kf[2],qr[1],C0,0,0,0),   P0[10],P0[11],P0[12],P0[13], pw1[0]=PKW(P0,8), pw1[1]=PKW(P0,10), pw1); \
    VRD(5); SBAR(); GAPA(C1=__builtin_amdgcn_mfma_f32_32x32x16_bf16(kf[3],qr[1],C1,0,0,0),   P0[14],P0[15],P1[0],P1[1],   pw1[2]=PKW(P0,12),pw1[3]=PKW(P0,14), pw1); \
    VRD(2); SBAR(); GAPA(C0=__builtin_amdgcn_mfma_f32_32x32x16_bf16(kf[4],qr[2],C0,0,0,0),   P1[2],P1[3],P1[4],P1[5],     pw2[0]=PKW(P1,0), pw2[1]=PKW(P1,2), pw2); \
    VRD(6); SBAR(); GAPA(C1=__builtin_amdgcn_mfma_f32_32x32x16_bf16(kf[5],qr[2],C1,0,0,0),   P1[6],P1[7],P1[8],P1[9],     pw2[2]=PKW(P1,4), pw2[3]=PKW(P1,6), pw2); \
    VRD(3); SBAR(); GAPA(C0=__builtin_amdgcn_mfma_f32_32x32x16_bf16(kf[6],qr[3],C0,0,0,0),   P1[10],P1[11],P1[12],P1[13], pw3[0]=PKW(P1,8), pw3[1]=PKW(P1,10), pw3); \
    VRD(7); SBAR(); GAPA(C1=__builtin_amdgcn_mfma_f32_32x32x16_bf16(kf[7],qr[3],C1,0,0,0),   P1[14],P1[15],0.f,0.f,       pw3[2]=PKW(P1,12),pw3[3]=PKW(P1,14), pw3); \
    l_reg+=sacc; \
    if(GK){DMA_K((t)+3,sl_cur);} if(GV){DMA_V((t)+1,sl_next);} \
    CMASK(C0,C1,t); \
    { float a=MX3(C0[0],C0[1],C1[0]),b=MX3(C0[2],C0[3],C1[1]); a=MX3(a,C1[2],C1[3]); \
      _Pragma("unroll") for(int r=4;r<16;r+=4){a=MX3(a,C0[r],C0[r+1]);b=MX3(b,C0[r+2],C0[r+3]);a=MX3(a,C1[r],C1[r+1]);b=MX3(b,C1[r+2],C1[r+3]);} \
      float rm=__builtin_fmaxf(a,b); { auto rr=__builtin_amdgcn_permlane32_swap(__float_as_uint(rm),__float_as_uint(rm),false,false); rm=__builtin_fmaxf(__uint_as_float(rr[0]),__uint_as_float(rr[1])); } \
      resc=false; \
      if(__builtin_expect(__any(rm>(float)THRL),0)){ const float dl=__builtin_fmaxf(rm,0.f); mhat+=dl; \
        _Pragma("unroll") for(int r=0;r<16;++r){C0[r]-=dl;C1[r]-=dl;} \
        _Pragma("unroll") for(int r=0;r<16;++r)negm[r]=-mhat; asm volatile("":"+v"(negm)); \
        const float f=__builtin_amdgcn_exp2f(-dl); l_reg*=f; if(hi==0)wsf[r32]=f; resc=true; } } \
    SBAR(); \
    GAPB(o[0]=__builtin_amdgcn_mfma_f32_32x32x16_bf16(PAF(0),VFR(0),o[0],0,0,0), C0,0); \
    GAPB(o[1]=__builtin_amdgcn_mfma_f32_32x32x16_bf16(PAF(0),VFR(4),o[1],0,0,0), C0,4); \
    KRD(GL,0); GAPB(o[0]=__builtin_amdgcn_mfma_f32_32x32x16_bf16(PAF(1),VFR(1),o[0],0,0,0), C0,8); \
    KRD(GL,1); GAPB(o[1]=__builtin_amdgcn_mfma_f32_32x32x16_bf16(PAF(1),VFR(5),o[1],0,0,0), C0,12); \
    KRD(GL,2); GAPB(o[0]=__builtin_amdgcn_mfma_f32_32x32x16_bf16(PAF(2),VFR(2),o[0],0,0,0), C1,0); \
    KRD(GL,3); GAPB(o[1]=__builtin_amdgcn_mfma_f32_32x32x16_bf16(PAF(2),VFR(6),o[1],0,0,0), C1,4); \
    GAPB(o[0]=__builtin_amdgcn_mfma_f32_32x32x16_bf16(PAF(3),VFR(3),o[0],0,0,0), C1,8); \
    GAPB(o[1]=__builtin_amdgcn_mfma_f32_32x32x16_bf16(PAF(3),VFR(7),o[1],0,0,0), C1,12); \
    }while(0)
  int t=1;
  #undef CMASK
  #define CMASK(P0,P1,t) do{}while(0)
  for(;t+7<NT;t+=2){
    STEP(pB0,pB1,pA0,pA1,t,true,true,true);     WAIT_BAR(2); RESC(); ROT();
    STEP(pA0,pA1,pB0,pB1,t+1,true,true,true);   WAIT_BAR(2); RESC(); ROT();
  }
  #undef CMASK
  #define CMASK(P0,P1,t) do{int jb_=(t)-(NT-4); if(jb_>=-2){cbias(P0,P1,jb_,qrel,hi,tb); if(jb_>=0)cmask(P0,P1,jb_,qrel,hi);}}while(0)
  #define ENDW(tt) do{ if((tt)+3<NT){WAIT_BAR(2);} else if((tt)+2<NT){WAIT_BAR(1);} else {WAIT_BAR(0);} }while(0)
  for(;t+1<NT;t+=2){
    STEP(pB0,pB1,pA0,pA1,t,(t+3<NT),(t+1<NT),(t+1<NT));       ENDW(t);   RESC(); ROT();
    STEP(pA0,pA1,pB0,pB1,t+1,(t+4<NT),(t+2<NT),(t+2<NT));     ENDW(t+1); RESC(); ROT();
  }
  STEP(pB0,pB1,pA0,pA1,NT-1,false,false,false); RESC();
  { float sacc=pB0[0]+pB0[1]; _Pragma("unroll") for(int r=2;r<16;++r)sacc+=pB0[r]; _Pragma("unroll") for(int r=0;r<16;++r)sacc+=pB1[r]; l_reg+=sacc;
    pw0=(u32x4){PKW(pB0,0),PKW(pB0,2),PKW(pB0,4),PKW(pB0,6)};pw1=(u32x4){PKW(pB0,8),PKW(pB0,10),PKW(pB0,12),PKW(pB0,14)};pw2=(u32x4){PKW(pB1,0),PKW(pB1,2),PKW(pB1,4),PKW(pB1,6)};pw3=(u32x4){PKW(pB1,8),PKW(pB1,10),PKW(pB1,12),PKW(pB1,14)};
    SBAR(); pv(o,vb0+sl_cur,PAF(0),PAF(1),PAF(2),PAF(3)); }
  #undef PKW
  #undef PAF
  #undef VFR
  #undef PIN
  #undef MX3
  #undef GAPA
  #undef GAPB
  #undef EX
  #undef VRD
  #undef KRD
  #undef STEP
  #undef ENDW
  {auto rr=__builtin_amdgcn_permlane32_swap(__float_as_uint(l_reg),__float_as_uint(l_reg),false,false);l_reg=__uint_as_float(rr[0])+__uint_as_float(rr[1]);}
  if(hi==0)wsf[32+r32]=l_reg;asm volatile("s_waitcnt lgkmcnt(0)":::"memory");
  float rli[16];
  #pragma unroll
  for(int r=0;r<16;++r)rli[r]=__builtin_amdgcn_rcpf(wsf[32+crow(r,hi)]);
  bf16*Ow=O+(rowbase+q0+wid*QBLK)*PO+vh*D;
  { bf16*stg=(bf16*)(shm+LDS_OST)+wid*2048;
    #pragma unroll
    for(int r=0;r<16;++r){const int orow=crow(r,hi);
      #pragma unroll
      for(int d0=0;d0<2;++d0)stg[orow*64+d0*32+r32]=__float2bfloat16(o[d0][r]*rli[r]);}
    asm volatile("s_waitcnt lgkmcnt(0)":::"memory");
    #pragma unroll
    for(int i=0;i<4;++i){const int row=i*8+(lane>>3),ch=lane&7; const u32x4 v=*(const u32x4*)(stg+row*64+ch*8); ATTN_STORE16(Ow+(long)row*PO+ch*8,v);} }
  asm volatile("s_waitcnt lgkmcnt(0)\n\ts_barrier":::"memory");
  #undef DMA_K
  #undef DMA_V
  #undef CMASK
  #undef START
  #undef RESC
  #undef ROT
}
constexpr int ATTN_LDS_BYTES=LDS_BYTES;
struct AttnTensors { const bf16* Q; const bf16* K; const bf16* V; bf16* O; };
struct AttnUnit { int bh; int qb; };
__device__ __forceinline__ bool attn_next(int vcu,int i,AttnUnit&u){ if(i>=16)return false; const int s=vcu&7, j=i&3; u.bh=(vcu>>3)+32*(i>>2); u.qb=(j==0)?s:(j==1)?15-s:(j==2)?16+s:31-s; return true; }
template<int THRL=8> __device__ __forceinline__ void attn_phase(char*lds,const AttnTensors&T,int vcu,const __attribute__((address_space(3))) float*tball,const int tid){
  AttnUnit u;
  for(int i=0;attn_next(vcu,i,u);++i){ attn_unit<THRL>(u.bh/NHEAD,u.bh%NHEAD,u.qb,T.Q,T.K,T.V,T.O,lds,tball,tid); }
}
#undef SBAR
#undef WAIT_BAR
}

#define XB_TMO      128
#define XB_XCNT(j)  (256  + 64 * (j))
#define XB_XSUB(j)  (1280 + 64 * (j))
#define XB_XGEN(j)  (2304 + 64 * (j))
#define XB_TOP      3328
#define XB_TOPGEN   3392
#define XCD_BAR_WORDS 3456
#define XB_SPIN_CAP (1u << 18)

__device__ __forceinline__ unsigned xb_ld(unsigned* p)              { return __hip_atomic_load(p, __ATOMIC_RELAXED, __HIP_MEMORY_SCOPE_AGENT); }
__device__ __forceinline__ unsigned xb_add(unsigned* p, unsigned v) { return __hip_atomic_fetch_add(p, v, __ATOMIC_RELAXED, __HIP_MEMORY_SCOPE_AGENT); }
__device__ __forceinline__ unsigned xb_xcc_id() { return (unsigned)__builtin_amdgcn_s_getreg((3 << 11) | 20) & 0xFu; }
#define XB_SPIN(cond, bar) do { unsigned _sp = 0; while (cond) { __builtin_amdgcn_s_sleep(1); \
    if ((++_sp & 255u) == 0u) { if (xb_ld(&(bar)[XB_TMO])) break; if (_sp > XB_SPIN_CAP) { atomicAdd(&(bar)[XB_TMO], 1u); break; } } } } while (0)

struct XcdBarrier {
    unsigned* bar; unsigned x;
    volatile LAS unsigned* st;
};

__device__ __forceinline__ XcdBarrier xcd_barrier_post(unsigned* bar, volatile LAS unsigned* st, const bool leader  ) {
    XcdBarrier b; b.bar = bar; b.x = xb_xcc_id(); b.st = st;
    if (leader) (void)xb_add(&bar[XB_XCNT(b.x)], 1u);
    return b;
}
__device__ __forceinline__ void xcd_barrier_complete(unsigned* bar, unsigned x, unsigned& nloc, unsigned& nx) {
    const unsigned G = gridDim.x * gridDim.y * gridDim.z;
    unsigned sum, cnt, mine, sp = 0u;
    for (;;) {
        sum = 0u; cnt = 0u; mine = 0u;
#pragma unroll
        for (unsigned j = 0; j < 16; ++j) { const unsigned c = xb_ld(&bar[XB_XCNT(j)]); sum += c; cnt += (c > 0u) ? 1u : 0u; mine = (j == x) ? c : mine; }
        if (sum == G) break;
        __builtin_amdgcn_s_sleep(1);
        if ((++sp & 255u) == 0u) { if (xb_ld(&bar[XB_TMO])) break; if (sp > XB_SPIN_CAP) { atomicAdd(&bar[XB_TMO], 1u); break; } }
    }
    nloc = mine > 0u ? mine : 1u; nx = cnt > 0u ? cnt : 1u;
}

__device__ __forceinline__ void xcd_barrier(const XcdBarrier& b, const bool leader  ) {
    asm volatile("s_waitcnt vmcnt(0)" ::: "memory");
    __syncthreads();
    if (leader) {
        unsigned* bar = b.bar;
        __builtin_amdgcn_s_waitcnt(0);
        unsigned nloc = b.st[0], nx = b.st[1];
        if (nloc == 0u) { xcd_barrier_complete(bar, b.x, nloc, nx); b.st[0] = nloc; b.st[1] = nx; }
        const unsigned old = xb_add(&bar[XB_XSUB(b.x)], 1u);
        const unsigned gen = old / nloc;
        if (old + 1u == (gen + 1u) * nloc) {
            __builtin_amdgcn_fence(__ATOMIC_RELEASE, "agent");
            asm volatile("s_waitcnt vmcnt(0)" ::: "memory");
            const unsigned og = xb_add(&bar[XB_TOP], 1u);
            const unsigned tg = og / nx;
            if (og + 1u == (tg + 1u) * nx) xb_add(&bar[XB_TOPGEN], 1u);
            else XB_SPIN(xb_ld(&bar[XB_TOPGEN]) == tg, bar);
            __builtin_amdgcn_fence(__ATOMIC_ACQUIRE, "agent");
            xb_add(&bar[XB_XGEN(b.x)], 1u);
            asm volatile("s_waitcnt vmcnt(0)" ::: "memory");
        } else {
            XB_SPIN(xb_ld(&bar[XB_XGEN(b.x)]) == gen, bar);
            __builtin_amdgcn_fence(__ATOMIC_ACQUIRE, "agent");
            asm volatile("s_waitcnt vmcnt(0)" ::: "memory");
        }
    }
    __syncthreads();
}

constexpr size_t MiB = 1u << 20;
constexpr size_t WS_CTL = 0, CTL_ZERO_BYTES = 1 * MiB;
constexpr size_t WS_WIN = 2 * MiB;
constexpr size_t WS_WOUT = 7 * MiB;
constexpr size_t WS_PGATE = 9 * MiB;
constexpr size_t WS_PPROJ = 13 * MiB;
constexpr size_t WS_RCAT = 14 * MiB;
constexpr size_t WS_RL1 = 20 * MiB;
constexpr size_t WS_RS2 = 28 * MiB;
constexpr size_t WS_RWO = 30 * MiB;
constexpr size_t WS_ROUT = 32 * MiB;
constexpr size_t WS_LRUAGG = 33 * MiB;
constexpr size_t WS_MGU = 38 * MiB;
constexpr size_t WS_MDN = 102 * MiB;
constexpr size_t WS_PB = 134 * MiB;
constexpr size_t WS_ACT = 166 * MiB;
constexpr size_t WS_H0 = WS_ACT;
constexpr size_t WS_QKV = WS_ACT + 128 * MiB;
constexpr size_t WS_O = WS_ACT + 448 * MiB;
constexpr size_t WS_HL = WS_ACT + 576 * MiB, WS_CA = WS_ACT + 640 * MiB;
constexpr size_t WS_H2 = WS_ACT;
constexpr size_t WS_LOG = WS_ACT + 128 * MiB;
constexpr size_t WS_ROUTE = WS_ACT + 144 * MiB;
constexpr size_t WS_HID = WS_ACT + 152 * MiB;
constexpr size_t WS_YS = WS_ACT + 288 * MiB;
constexpr size_t WS_PP = WS_HID;
constexpr size_t WS_HCAT = WS_ACT;
constexpr size_t WS_XR = WS_ACT + 256 * MiB, WS_XK = WS_ACT + 384 * MiB, WS_XV = WS_ACT + 512 * MiB;
constexpr size_t WS_R = WS_ACT + 640 * MiB, WS_K = WS_XR, WS_V = WS_XK;
constexpr size_t WS_MID = WS_ACT + 768 * MiB;
constexpr size_t WS_EW = WS_ACT;
constexpr size_t WS_AA = WS_ACT + 128 * MiB;
constexpr size_t WS_Y = WS_XV;
constexpr size_t WS_END = WS_ACT + 832 * MiB;
static_assert(WS_END <= 1024 * MiB, "workspace map");
constexpr size_t RT_EID = 0, RT_POS = 1 * MiB, RT_GATE = 2 * MiB, RT_ROWTOK = 3 * MiB, RT_ROWGATE = 4 * MiB, RT_SLOT = 5 * MiB;
constexpr int CW_BAR = 4096;
constexpr int CW_PROG = 32768, CW_GDONE = 36864;
constexpr int CW_CNT0 = 16384, CW_CNT1 = 16384 + 64;

constexpr int RING_BYTES = 131072;
constexpr int LDSCTL_OFF = RING_BYTES, MISC_OFF = LDSCTL_OFF + 320;
constexpr int TB_OFF = RING_BYTES + 1024;
constexpr int RTE_OFF = TB_OFF + 2048;
constexpr int LDS_BYTES = 147456;

constexpr int NWAVES = 8;
__device__ __forceinline__ int lane_id_() { int l; asm volatile("v_mbcnt_lo_u32_b32 %0, -1, 0\n\tv_mbcnt_hi_u32_b32 %0, -1, %0" : "=v"(l)); return l; }
#define TID_ (F.wave * 64 + lane_id_())
#define LANE_ (lane_id_())
struct Frame {
    LAS unsigned char* lds; volatile LAS unsigned* MISC; gu32* ctl;
    int wave, vcu, G;
};

__device__ __forceinline__ void load_row4(const float* xrow, int lane, f32x4 (&v)[4]) { const f32x4* p = (const f32x4*)xrow + lane;
#pragma unroll
    for (int j = 0; j < 4; ++j) v[j] = p[64 * j]; }
__device__ __forceinline__ float row_rstd(const f32x4 (&v)[4], float eps) { float s = 0.f;
#pragma unroll
    for (int j = 0; j < 4; ++j) s += (v[j].x * v[j].x + v[j].y * v[j].y) + (v[j].z * v[j].z + v[j].w * v[j].w);
    return 1.0f / sqrtf(wave_sum(s) * (1.0f / 1024.0f) + eps); }
__device__ __forceinline__ void load_row4_bf(const bf16* xrow, int lane, f32x4 (&v)[4]) { const v2u* p = (const v2u*)xrow + lane;
#pragma unroll
    for (int j = 0; j < 4; ++j) { const v2u w = p[64 * j]; v[j] = (f32x4){bflo(w.x), bfhi(w.x), bflo(w.y), bfhi(w.y)}; } }
__device__ __forceinline__ void store_row4_bf(bf16* xrow, int lane, const f32x4 (&v)[4]) { v2u* p = (v2u*)xrow + lane;
#pragma unroll
    for (int j = 0; j < 4; ++j) { v2u o; o.x = pk2(v[j].x, v[j].y); o.y = pk2(v[j].z, v[j].w); p[64 * j] = o; } }
__device__ __forceinline__ void store_row_bf16(bf16* orow, int lane, const f32x4 (&v)[4], float rstd, const float* g) {
    unsigned long long* o8 = (unsigned long long*)orow + lane;
#pragma unroll
    for (int j = 0; j < 4; ++j) { const f32x4 gg = ((const f32x4*)g)[lane + 64 * j];
        o8[64 * j] = (unsigned long long)pk2(v[j].x * rstd * gg.x, v[j].y * rstd * gg.y) | ((unsigned long long)pk2(v[j].z * rstd * gg.z, v[j].w * rstd * gg.w) << 32); }
}

template <int MODE>
__device__ __forceinline__ void transpose_item(const float* W, int K, int N, bf16* WT, int ldo, int row_off, const float* mu, LAS float* scr, int item, int lane) {
    const int nblk = N / 32, kb = item / nblk, nb = item % nblk, k0 = 64 * kb, n0 = 32 * nb;
    float ld[32];
#pragma unroll
    for (int i = 0; i < 32; ++i) { const int kk = 2 * i + (lane >> 5); ld[i] = W[(size_t)(k0 + kk) * N + n0 + (lane & 31)]; }
#pragma unroll
    for (int i = 0; i < 32; ++i) { const int kk = 2 * i + (lane >> 5); scr[kk * 33 + (lane & 31)] = ld[i]; }
    LDS_WAIT(); asm volatile("" ::: "memory");
    const int c = lane & 7;
    int rbase = row_off + n0;
    if (MODE == 2) { rbase = row_off + ((n0 < 512) ? ((n0 >> 7) * 256 + (n0 & 127)) : (((n0 - 512) >> 7) * 256 + 128 + ((n0 - 512) & 127))); }
    float m[8];
    if (MODE == 1) {
#pragma unroll
        for (int e = 0; e < 8; ++e) m[e] = mu[k0 + 8 * c + e]; }
#pragma unroll
    for (int j = 0; j < 4; ++j) { const int n = (lane >> 3) + 8 * j; const LAS float* s = scr + (8 * c) * 33 + n;
        float v[8];
#pragma unroll
        for (int e = 0; e < 8; ++e) v[e] = s[e * 33];
        bf16* dst = WT + (size_t)(rbase + n) * ldo + k0 + 8 * c;
        if (MODE == 1) {
            v4u o, o2;
            o.x = pk2(v[0] * (1.f - m[0]), v[1] * (1.f - m[1])); o.y = pk2(v[2] * (1.f - m[2]), v[3] * (1.f - m[3])); o.z = pk2(v[4] * (1.f - m[4]), v[5] * (1.f - m[5])); o.w = pk2(v[6] * (1.f - m[6]), v[7] * (1.f - m[7]));
            o2.x = pk2(v[0] * m[0], v[1] * m[1]); o2.y = pk2(v[2] * m[2], v[3] * m[3]); o2.z = pk2(v[4] * m[4], v[5] * m[5]); o2.w = pk2(v[6] * m[6], v[7] * m[7]);
            *(GAS v4u*)dst = o; *(GAS v4u*)(dst + 1024) = o2;
        } else {
            v4u o; o.x = pk2(v[0], v[1]); o.y = pk2(v[2], v[3]); o.z = pk2(v[4], v[5]); o.w = pk2(v[6], v[7]);
            *(GAS v4u*)dst = o; }
    }
    LDS_WAIT(); asm volatile("" ::: "memory");
}

struct In {
    const float *x, *p, *rel_bias, *norm_mix, *ab_w_in, *ab_w_out, *lam_q1, *lam_k1, *lam_q2, *lam_k2, *sub_g, *conv_w, *conv_b, *lru_wa, *lru_ba, *lru_wx, *lru_bx, *lru_lambda,
        *rwkv_mu, *rwkv_wr, *rwkv_wk, *rwkv_wv, *rwkv_wo, *rwkv_w0, *rwkv_w1, *rwkv_w2, *rwkv_a0, *rwkv_a1, *rwkv_a2, *rwkv_g1, *rwkv_g2, *rwkv_kk, *rwkv_ka, *rwkv_rk, *rwkv_ln_g, *rwkv_ln_b,
        *norm_ffn, *moe_wc, *moe_bc, *moe_wf, *moe_bf, *moe_w_gu, *moe_w_down, *ple_norm, *ple_gate, *ple_proj, *final_norm;
};

__device__ __forceinline__ void prep_dense_weights(Frame& F, const In& I, unsigned char* ws) {
    LAS float* scr = (LAS float*)(F.lds + F.wave * 16384);
    const int gw = F.vcu * NWAVES + F.wave, NGW = F.G * NWAVES;
    bf16* WIN = (bf16*)(ws + WS_WIN); bf16* WOUT = (bf16*)(ws + WS_WOUT); bf16* PG = (bf16*)(ws + WS_PGATE); bf16* PPJ = (bf16*)(ws + WS_PPROJ);
    bf16* RCAT = (bf16*)(ws + WS_RCAT); bf16* RL1 = (bf16*)(ws + WS_RL1); bf16* RWO = (bf16*)(ws + WS_RWO);
    constexpr int I_IN = (1024 / 64) * (2560 / 32), I_SQ = (1024 / 64) * (1024 / 32), I_PJ = (256 / 64) * (1024 / 32), I_L64 = (1024 / 64) * (64 / 32), I_L160 = (1024 / 64) * (160 / 32);
    int st = gw;
#define TJOB(MODE, NITEMS, W, K, N, WT, LDO, ROFF, MU) do { for (int it = st; it < (NITEMS); it += NGW) transpose_item<MODE>(W, K, N, WT, LDO, ROFF, MU, scr, it, LANE_); \
        st = (st + NGW - ((NITEMS) % NGW)) % NGW; asm volatile("" : "+s"(st)); } while (0)
    TJOB(0, I_IN, I.ab_w_in, 1024, 2560, WIN, 1024, 0, nullptr);
    TJOB(0, I_SQ, I.ab_w_out, 1024, 1024, WOUT, 1024, 0, nullptr);
    TJOB(0, I_SQ, I.ple_gate, 1024, 1024, PG, 1024, 0, nullptr);
    TJOB(0, I_SQ, I.ple_gate + 1024 * 1024, 1024, 1024, PG + 1024 * 1024, 1024, 0, nullptr);
    TJOB(0, I_SQ, I.rwkv_wo, 1024, 1024, RWO, 1024, 0, nullptr);
    TJOB(0, I_SQ, I.rwkv_wr, 1024, 1024, RCAT, 1024, 0, nullptr);
    TJOB(0, I_SQ, I.rwkv_wk, 1024, 1024, RCAT, 1024, 1024, nullptr);
    TJOB(0, I_SQ, I.rwkv_wv, 1024, 1024, RCAT, 1024, 2048, nullptr);
    TJOB(0, I_PJ, I.ple_proj, 256, 1024, PPJ, 256, 0, nullptr);
    TJOB(0, I_PJ, I.ple_proj + 256 * 1024, 256, 1024, PPJ + 1024 * 256, 256, 0, nullptr);
    TJOB(1, I_L64, I.rwkv_w1, 1024, 64, RL1, 2048, 0, I.rwkv_mu + 1 * 1024);
    TJOB(1, I_L64, I.rwkv_a1, 1024, 64, RL1, 2048, 64, I.rwkv_mu + 4 * 1024);
    TJOB(1, I_L160, I.rwkv_g1, 1024, 160, RL1, 2048, 256, I.rwkv_mu + 5 * 1024);
#undef TJOB
    const int gt = F.vcu * 512 + TID_, NGT = F.G * 512;
    { v4u z = {0u, 0u, 0u, 0u}; const int per_row = 2048 / 8;
      for (int i = gt; i < (128 + 96) * per_row; i += NGT) { int rr = i / per_row, cc = i % per_row; rr = (rr < 128) ? (128 + rr) : (416 + rr - 128); *(GAS v4u*)(RL1 + (size_t)rr * 2048 + cc * 8) = z; } }
    { bf16* S2 = (bf16*)(ws + WS_RS2);
      for (int i = gt; i < 3 * 1024 * 256; i += NGT) { const int ty = i / (1024 * 256), n = (i / 256) & 1023, k = i & 255; float v = 0.f;
          if (ty == 0) { if (k < 64) v = I.rwkv_w2[k * 1024 + n]; } else if (ty == 1) { if (k >= 64 && k < 128) v = I.rwkv_a2[(k - 64) * 1024 + n]; } else { if (k < 160) v = I.rwkv_g2[k * 1024 + n]; }
          S2[i] = (bf16)f2bf(v); } }
    { bf16* RT = (bf16*)(ws + WS_ROUT);
      for (int i = gt; i < 2 * 256 * 1024; i += NGT) { const int l = i / (256 * 1024), n = (i / 1024) & 255, k = i & 1023; float v = 0.f;
          if (n < 4) v = I.moe_wc[(size_t)l * 1024 * 4 + k * 4 + n]; else if (n < 36) v = I.moe_wf[(size_t)l * 1024 * 32 + k * 32 + (n - 4)];
          RT[i] = (bf16)f2bf(v); } }
}
__device__ __forceinline__ void prep_layer_weights(Frame& F, const In& I, unsigned char* ws, int layer) {
    LAS float* scr = (LAS float*)(F.lds + F.wave * 16384);
    const int gw = F.vcu * NWAVES + F.wave, NGW = F.G * NWAVES;
    bf16* MGU = (bf16*)(ws + WS_MGU); bf16* MDN = (bf16*)(ws + WS_MDN);
    const float* wgu = I.moe_w_gu + (size_t)layer * NEXP * 1024 * 1024; const float* wdn = I.moe_w_down + (size_t)layer * NEXP * 512 * 1024;
    constexpr int I_GU = (1024 / 64) * (1024 / 32), I_DN = (512 / 64) * (1024 / 32);
    for (int it = gw; it < NEXP * (I_GU + I_DN); it += NGW) {
        const int e = it / (I_GU + I_DN); int r = it % (I_GU + I_DN);
        if (r < I_GU) transpose_item<2>(wgu + (size_t)e * 1024 * 1024, 1024, 1024, MGU + (size_t)e * 1024 * 1024, 1024, 0, nullptr, scr, r, LANE_);
        else transpose_item<0>(wdn + (size_t)e * 512 * 1024, 512, 1024, MDN + (size_t)e * 1024 * 512, 512, 0, nullptr, scr, r - I_GU, LANE_);
    }
    const int gt = F.vcu * 512 + TID_, NGT = F.G * 512;
    const f32x4* ps = (const f32x4*)(I.p + (size_t)layer * T * PLE); v2u* pd = (v2u*)(ws + WS_PB);
    for (int i = gt; i < T * PLE / 4; i += 4 * NGT) { f32x4 v[4];
#pragma unroll
        for (int r = 0; r < 4; ++r) v[r] = ps[i + r * NGT];
#pragma unroll
        for (int r = 0; r < 4; ++r) { v2u o; o.x = pk2(v[r].x, v[r].y); o.y = pk2(v[r].z, v[r].w); pd[i + r * NGT] = o; } }
}

template <bool XBF>
__device__ __forceinline__ void norm_pass(Frame& F, const void* x, const float* g, bf16* out) {
    const int gw = F.vcu * NWAVES + F.wave, NGW = F.G * NWAVES; const int lane = LANE_;
    for (int t = 4 * gw; t < T; t += 4 * NGW) {
        f32x4 v[4][4];
#pragma unroll
        for (int r = 0; r < 4; ++r) { if (XBF) load_row4_bf((const bf16*)x + (size_t)(t + r) * D, lane, v[r]); else load_row4((const float*)x + (size_t)(t + r) * D, lane, v[r]); }
#pragma unroll
        for (int r = 0; r < 4; ++r) { const float rs = row_rstd(v[r], 1e-6f); store_row_bf16(out + (size_t)(t + r) * D, lane, v[r], rs, g); }
    }
}
__device__ __forceinline__ void rwkv_input_pass(Frame& F, const bf16* x, const float* g, const float* mu, bf16* HCAT, bf16* XR, bf16* XK, bf16* XV) {
    const int gw = F.vcu * NWAVES + F.wave, NGW = F.G * NWAVES; const int lane = LANE_;
    f32x4 gg[4], mr[4], mk[4], mv[4];
#pragma unroll
    for (int j = 0; j < 4; ++j) { gg[j] = ((const f32x4*)g)[lane + 64 * j]; mr[j] = ((const f32x4*)(mu + 0 * 1024))[lane + 64 * j]; mk[j] = ((const f32x4*)(mu + 2 * 1024))[lane + 64 * j]; mv[j] = ((const f32x4*)(mu + 3 * 1024))[lane + 64 * j]; }
    for (int blk = gw; blk < T / 32; blk += NGW) {
        const int t0 = blk * 32; f32x4 hp[4];
        if ((t0 & (SEQ - 1)) == 0) {
#pragma unroll
            for (int j = 0; j < 4; ++j) hp[j] = (f32x4){0.f, 0.f, 0.f, 0.f};
        } else { f32x4 v[4]; load_row4_bf(x + (size_t)(t0 - 1) * D, lane, v); const float rstd = row_rstd(v, 1e-6f);
#pragma unroll
            for (int j = 0; j < 4; ++j) hp[j] = v[j] * rstd * gg[j]; }
        f32x4 vn[4]; load_row4_bf(x + (size_t)t0 * D, lane, vn);
        for (int t = t0; t < t0 + 32; ++t) {
            f32x4 v[4];
#pragma unroll
            for (int j = 0; j < 4; ++j) v[j] = vn[j];
            if (t + 1 < t0 + 32) load_row4_bf(x + (size_t)(t + 1) * D, lane, vn);
            const float rstd = row_rstd(v, 1e-6f);
            unsigned long long* oh = (unsigned long long*)(HCAT + (size_t)t * 2048) + lane; unsigned long long* or_ = (unsigned long long*)(XR + (size_t)t * 1024) + lane;
            unsigned long long* ok = (unsigned long long*)(XK + (size_t)t * 1024) + lane; unsigned long long* ov = (unsigned long long*)(XV + (size_t)t * 1024) + lane;
#pragma unroll
            for (int j = 0; j < 4; ++j) { const f32x4 h = v[j] * rstd * gg[j], dd = hp[j] - h;
                oh[64 * j] = (unsigned long long)pk2(h.x, h.y) | ((unsigned long long)pk2(h.z, h.w) << 32);
                oh[256 + 64 * j] = (unsigned long long)pk2(hp[j].x, hp[j].y) | ((unsigned long long)pk2(hp[j].z, hp[j].w) << 32);
                const f32x4 a = h + dd * mr[j], b = h + dd * mk[j], c = h + dd * mv[j];
                or_[64 * j] = (unsigned long long)pk2(a.x, a.y) | ((unsigned long long)pk2(a.z, a.w) << 32);
                ok[64 * j] = (unsigned long long)pk2(b.x, b.y) | ((unsigned long long)pk2(b.z, b.w) << 32);
                ov[64 * j] = (unsigned long long)pk2(c.x, c.y) | ((unsigned long long)pk2(c.z, c.w) << 32);
                hp[j] = h; }
        }
    }
}
__device__ __forceinline__ void combine_norm_pass(Frame& F, const bf16* xin, bf16* xout, const bf16* YS, const int* slot, const float* g, bf16* out) {
    const int gw = F.vcu * NWAVES + F.wave, NGW = F.G * NWAVES; const int lane = LANE_;
    for (int t = 2 * gw; t < T; t += 2 * NGW) {
        f32x4 v[2][4]; v2u ya[2][4], yb[2][4];
#pragma unroll
        for (int r = 0; r < 2; ++r) { load_row4_bf(xin + (size_t)(t + r) * D, lane, v[r]);
            const int s0 = slot[2 * (t + r)], s1 = slot[2 * (t + r) + 1];
            const v2u* y0 = (const v2u*)(YS + (size_t)s0 * D) + lane; const v2u* y1 = (const v2u*)(YS + (size_t)s1 * D) + lane;
#pragma unroll
            for (int j = 0; j < 4; ++j) { ya[r][j] = y0[64 * j]; yb[r][j] = y1[64 * j]; } }
#pragma unroll
        for (int r = 0; r < 2; ++r) {
#pragma unroll
            for (int j = 0; j < 4; ++j) { const v2u a = ya[r][j], b = yb[r][j];
                v[r][j].x += bflo(a.x) + bflo(b.x); v[r][j].y += bfhi(a.x) + bfhi(b.x); v[r][j].z += bflo(a.y) + bflo(b.y); v[r][j].w += bfhi(a.y) + bfhi(b.y); }
            store_row4_bf(xout + (size_t)(t + r) * D, lane, v[r]);
            const float rstd = row_rstd(v[r], 1e-6f);
            store_row_bf16(out + (size_t)(t + r) * D, lane, v[r], rstd, g); }
    }
}
__device__ __forceinline__ void final_norm_pass(Frame& F, const bf16* x, float* out, const float* g) {
    const int gw = F.vcu * NWAVES + F.wave, NGW = F.G * NWAVES; const int lane = LANE_;
    for (int t = 4 * gw; t < T; t += 4 * NGW) {
        f32x4 v[4][4];
#pragma unroll
        for (int r = 0; r < 4; ++r) load_row4_bf(x + (size_t)(t + r) * D, lane, v[r]);
#pragma unroll
        for (int r = 0; r < 4; ++r) { const float rs = row_rstd(v[r], 1e-6f); f32x4* xo = (f32x4*)(out + (size_t)(t + r) * D) + lane;
#pragma unroll
            for (int j = 0; j < 4; ++j) { const f32x4 gg = ((const f32x4*)g)[lane + 64 * j]; xo[64 * j] = v[r][j] * rs * gg; } }
    }
}

__device__ __forceinline__ void diff_combine_pass(Frame& F, const In& I, const bf16* O, bf16* YCAT) {
    const int gw = F.vcu * NWAVES + F.wave, NGW = F.G * NWAVES;
    const float lam_init = 0.2f;
    const float d1 = wave_sum(I.lam_q1[LANE_] * I.lam_k1[LANE_]), d2 = wave_sum(I.lam_q2[LANE_] * I.lam_k2[LANE_]);
    const float lam = expf(d1) - expf(d2) + lam_init;
    const int h = LANE_ >> 4, q = LANE_ & 15;
    float sg[8];
#pragma unroll
    for (int e = 0; e < 8; ++e) sg[e] = I.sub_g[q * 8 + e] * (1.0f - lam_init);
    for (int t0 = 4 * gw; t0 < T; t0 += 4 * NGW) {
        v4u av[4], bv[4];
#pragma unroll
        for (int r = 0; r < 4; ++r) { av[r] = *(const v4u*)(O + (size_t)(t0 + r) * 1024 + h * 256 + q * 8); bv[r] = *(const v4u*)(O + (size_t)(t0 + r) * 1024 + h * 256 + 128 + q * 8); }
#pragma unroll
        for (int r = 0; r < 4; ++r) { const v4u a = av[r], b = bv[r]; const int t = t0 + r;
        float o[8];
        o[0] = bflo(a.x) - lam * bflo(b.x); o[1] = bfhi(a.x) - lam * bfhi(b.x); o[2] = bflo(a.y) - lam * bflo(b.y); o[3] = bfhi(a.y) - lam * bfhi(b.y);
        o[4] = bflo(a.z) - lam * bflo(b.z); o[5] = bfhi(a.z) - lam * bfhi(b.z); o[6] = bflo(a.w) - lam * bflo(b.w); o[7] = bfhi(a.w) - lam * bfhi(b.w);
        float s = 0.f;
#pragma unroll
        for (int e = 0; e < 8; ++e) s += o[e] * o[e];
        s += __shfl_xor(s, 1); s += __shfl_xor(s, 2); s += __shfl_xor(s, 4); s += __shfl_xor(s, 8);
        const float rstd = 1.0f / sqrtf(s * (1.0f / 128.0f) + 1e-5f);
        v4u w; w.x = pk2(o[0] * rstd * sg[0], o[1] * rstd * sg[1]); w.y = pk2(o[2] * rstd * sg[2], o[3] * rstd * sg[3]); w.z = pk2(o[4] * rstd * sg[4], o[5] * rstd * sg[5]); w.w = pk2(o[6] * rstd * sg[6], o[7] * rstd * sg[7]);
        *(v4u*)(YCAT + (size_t)t * 1024 + h * 128 + q * 8) = w; }
    }
}

constexpr int LCT = 64, LNCH = SEQ / LCT;
__device__ __forceinline__ float gelu_tanh(float x) { const float u = 0.7978845608028654f * (x + 0.044715f * x * x * x); return x * sigmoidf_(2.0f * u); }
template <bool FINAL>
__device__ __forceinline__ void lru_phase(Frame& F, const In& I, const bf16* XB, const bf16* GB, f32x2* AGG, bf16* YCAT, bf16* HLp, bf16* CAp) {
    const int ch = TID_, n = ch >> 6, d = ch & 63;
    LAS float* U = (LAS float*)F.lds;
    f32x2 wg[64];
#pragma unroll
    for (int c = 0; c < 64; ++c) { wg[c].x = I.lru_wa[n * 4096 + c * 64 + d]; wg[c].y = I.lru_wx[n * 4096 + c * 64 + d]; }
    const float cw0 = I.conv_w[0 * 512 + ch], cw1 = I.conv_w[1 * 512 + ch], cw2 = I.conv_w[2 * 512 + ch], cw3 = I.conv_w[3 * 512 + ch], cb = I.conv_b[ch];
    const float ba = I.lru_ba[ch], bx = I.lru_bx[ch];
    const float lam = I.lru_lambda[ch]; const float sp = (lam > 15.f) ? expf(-lam) : log1pf(expf(-lam));
    const float m8sp = -8.0f * sp;
    for (int un = blockIdx.x; un < NB * LNCH; un += F.G) {
        const int b = un / LNCH, c = un % LNCH; const size_t row0 = (size_t)b * SEQ + (size_t)c * LCT;
        unsigned short xraw[LCT + 3];
        if (c > 0) { xraw[0] = XB[(row0 - 3) * 512 + ch]; xraw[1] = XB[(row0 - 2) * 512 + ch]; xraw[2] = XB[(row0 - 1) * 512 + ch]; } else { xraw[0] = 0; xraw[1] = 0; xraw[2] = 0; }
#pragma unroll
        for (int tk = 0; tk < LCT; ++tk) xraw[3 + tk] = XB[(row0 + tk) * 512 + ch];
        float h = 0.f, Ap = 1.f;
        if (FINAL) { for (int j = 0; j < c; ++j) { const f32x2 ag = AGG[((size_t)b * LNCH + j) * 512 + ch]; h = ag.x * h + ag.y; } }
#pragma unroll
        for (int tk = 0; tk < LCT; ++tk) U[tk * 512 + ch] = cw0 * bf1(xraw[tk]) + cw1 * bf1(xraw[tk + 1]) + cw2 * bf1(xraw[tk + 2]) + cw3 * bf1(xraw[tk + 3]) + cb;
        __syncthreads();
        unsigned short gcur[8], gnxt[8];
        if (FINAL) {
#pragma unroll
            for (int j = 0; j < 8; ++j) gcur[j] = GB[(row0 + j) * 512 + ch]; }
#pragma unroll 1
        for (int tg = 0; tg < LCT / 8; ++tg) {
            if (FINAL) { const int tn = (tg + 1 < LCT / 8) ? (tg + 1) * 8 : tg * 8;
#pragma unroll
                for (int j = 0; j < 8; ++j) gnxt[j] = GB[(row0 + tn + j) * 512 + ch]; }
#pragma unroll
            for (int j = 0; j < 8; ++j) { const int tk = tg * 8 + j;
                const LAS f32x4* up = (const LAS f32x4*)(U + tk * 512 + n * 64);
                f32x2 acc = {ba, bx};
#pragma unroll
                for (int c4 = 0; c4 < 16; ++c4) { const f32x4 uu = up[c4];
                    acc += wg[4 * c4 + 0] * uu.x; acc += wg[4 * c4 + 1] * uu.y; acc += wg[4 * c4 + 2] * uu.z; acc += wg[4 * c4 + 3] * uu.w; }
                const float r = sigmoidf_(acc.x), ig = sigmoidf_(acc.y);
                const float la = r * m8sp; const float a = __expf(la); const float t2 = 2.0f * la; const float om = (t2 > -0.02f) ? -t2 * (1.0f + t2 * (0.5f + t2 * (0.16666667f + t2 * 0.041666668f))) : 1.0f - a * a; const float bb = __builtin_amdgcn_sqrtf(om) * (ig * U[tk * 512 + ch]);
                h = a * h + bb;
                if (FINAL) { YCAT[(row0 + tk) * 1024 + 512 + ch] = (bf16)f2bf(h * gelu_tanh(bf1(gcur[j]))); }
                else { Ap *= a; HLp[(row0 + tk) * 512 + ch] = (bf16)f2bf(h); CAp[(row0 + tk) * 512 + ch] = (bf16)f2bf(Ap); } }
            if (FINAL) {
#pragma unroll
                for (int j = 0; j < 8; ++j) gcur[j] = gnxt[j]; }
        }
        if (!FINAL) { f32x2 ag; ag.x = Ap; ag.y = h; AGG[((size_t)b * LNCH + c) * 512 + ch] = ag; }
        __syncthreads();
    }
}

__device__ __forceinline__ void lru_agg_mfma(Frame& F, const In& I, const bf16* XB, f32x2* AGG, bf16* HLp, bf16* CAp) {
    const int tid = TID_, lane = tid & 63, fr = lane & 15, fq = lane >> 4, n = F.wave, ch = tid;
    constexpr int UP = 520;
    LAS bf16* U = (LAS bf16*)F.lds;
    bf16x8 Wr[4][2], Wi[4][2];
#pragma unroll
    for (int dd = 0; dd < 4; ++dd)
#pragma unroll
        for (int kh = 0; kh < 2; ++kh) { unsigned pr_[4], pi_[4];
#pragma unroll
            for (int j = 0; j < 4; ++j) { const int c0 = 32 * kh + 8 * fq + 2 * j, d = 16 * dd + fr;
                pr_[j] = pk2(I.lru_wa[n * 4096 + c0 * 64 + d], I.lru_wa[n * 4096 + (c0 + 1) * 64 + d]); pi_[j] = pk2(I.lru_wx[n * 4096 + c0 * 64 + d], I.lru_wx[n * 4096 + (c0 + 1) * 64 + d]); }
            Wr[dd][kh] = __builtin_bit_cast(bf16x8, (v4u){pr_[0], pr_[1], pr_[2], pr_[3]}); Wi[dd][kh] = __builtin_bit_cast(bf16x8, (v4u){pi_[0], pi_[1], pi_[2], pi_[3]}); }
    float cba[4], cbx[4], cm8[4];
#pragma unroll
    for (int dd = 0; dd < 4; ++dd) { const int chd = 64 * n + 16 * dd + fr; cba[dd] = I.lru_ba[chd]; cbx[dd] = I.lru_bx[chd];
        const float lam = I.lru_lambda[chd]; cm8[dd] = -8.0f * ((lam > 15.f) ? expf(-lam) : log1pf(expf(-lam))); }
    const float cw0 = I.conv_w[0 * 512 + ch], cw1 = I.conv_w[1 * 512 + ch], cw2 = I.conv_w[2 * 512 + ch], cw3 = I.conv_w[3 * 512 + ch], cb = I.conv_b[ch];
    for (int un = blockIdx.x; un < NB * LNCH; un += F.G) {
        const int b = un / LNCH, c = un % LNCH; const size_t row0 = (size_t)b * SEQ + (size_t)c * LCT;
        unsigned short xraw[LCT + 3];
        if (c > 0) { xraw[0] = XB[(row0 - 3) * 512 + ch]; xraw[1] = XB[(row0 - 2) * 512 + ch]; xraw[2] = XB[(row0 - 1) * 512 + ch]; } else { xraw[0] = 0; xraw[1] = 0; xraw[2] = 0; }
#pragma unroll
        for (int tk = 0; tk < LCT; ++tk) xraw[3 + tk] = XB[(row0 + tk) * 512 + ch];
#pragma unroll
        for (int tk = 0; tk < LCT; ++tk) U[tk * UP + ch] = (bf16)f2bf(cw0 * bf1(xraw[tk]) + cw1 * bf1(xraw[tk + 1]) + cw2 * bf1(xraw[tk + 2]) + cw3 * bf1(xraw[tk + 3]) + cb);
        __syncthreads();
        bf16x8 X[4][2];
#pragma unroll
        for (int tt = 0; tt < 4; ++tt)
#pragma unroll
            for (int kh = 0; kh < 2; ++kh) X[tt][kh] = *(const LAS bf16x8*)(U + (16 * tt + fr) * UP + 64 * n + 32 * kh + 8 * fq);
#pragma unroll 1
        for (int dd = 0; dd < 4; ++dd) {
            bf16x8 wr0, wr1, wi0, wi1; float kba, kbx, km8;
            if (dd == 0) { wr0 = Wr[0][0]; wr1 = Wr[0][1]; wi0 = Wi[0][0]; wi1 = Wi[0][1]; kba = cba[0]; kbx = cbx[0]; km8 = cm8[0]; }
            else if (dd == 1) { wr0 = Wr[1][0]; wr1 = Wr[1][1]; wi0 = Wi[1][0]; wi1 = Wi[1][1]; kba = cba[1]; kbx = cbx[1]; km8 = cm8[1]; }
            else if (dd == 2) { wr0 = Wr[2][0]; wr1 = Wr[2][1]; wi0 = Wi[2][0]; wi1 = Wi[2][1]; kba = cba[2]; kbx = cbx[2]; km8 = cm8[2]; }
            else { wr0 = Wr[3][0]; wr1 = Wr[3][1]; wi0 = Wi[3][0]; wi1 = Wi[3][1]; kba = cba[3]; kbx = cbx[3]; km8 = cm8[3]; }
            const int chd = 64 * n + 16 * dd + fr;
            float hc = 0.f, Ac = 1.f;
#pragma unroll
            for (int tt = 0; tt < 4; ++tt) {
                f32x4 pr = (f32x4){0.f, 0.f, 0.f, 0.f}, pi = pr;
                pr = __builtin_amdgcn_mfma_f32_16x16x32_bf16(X[tt][0], wr0, pr, 0, 0, 0); pr = __builtin_amdgcn_mfma_f32_16x16x32_bf16(X[tt][1], wr1, pr, 0, 0, 0);
                pi = __builtin_amdgcn_mfma_f32_16x16x32_bf16(X[tt][0], wi0, pi, 0, 0, 0); pi = __builtin_amdgcn_mfma_f32_16x16x32_bf16(X[tt][1], wi1, pi, 0, 0, 0);
                float a[4], bb[4];
#pragma unroll
                for (int e = 0; e < 4; ++e) { const int tok = 16 * tt + 4 * fq + e; const float u = bf1(U[tok * UP + chd]);
                    const float r = sigmoidf_(pr[e] + kba), ig = sigmoidf_(pi[e] + kbx); const float la = r * km8; a[e] = __expf(la); const float t2 = 2.0f * la;
                    const float om = (t2 > -0.02f) ? -t2 * (1.0f + t2 * (0.5f + t2 * (0.16666667f + t2 * 0.041666668f))) : 1.0f - a[e] * a[e]; bb[e] = __builtin_amdgcn_sqrtf(om) * (ig * u); }
                const float A4 = (a[0] * a[1]) * (a[2] * a[3]); const float B4 = ((bb[0] * a[1] + bb[1]) * a[2] + bb[2]) * a[3] + bb[3];
                float h = hc, Ap = Ac, hs = hc, As = Ac;
#pragma unroll
                for (int j = 0; j < 4; ++j) { const float Aj = __shfl(A4, fr + 16 * j), Bj = __shfl(B4, fr + 16 * j); if (j == fq) { hs = h; As = Ap; } h = Aj * h + Bj; Ap *= Aj; }
                hc = h; Ac = Ap; h = hs; Ap = As;
#pragma unroll
                for (int e = 0; e < 4; ++e) { h = a[e] * h + bb[e]; Ap *= a[e]; const size_t o = (row0 + 16 * tt + 4 * fq + e) * 512 + chd; HLp[o] = (bf16)f2bf(h); CAp[o] = (bf16)f2bf(Ap); }
            }
            if (fq == 0) { f32x2 ag; ag.x = Ac; ag.y = hc; AGG[((size_t)b * LNCH + c) * 512 + chd] = ag; }
        }
        __syncthreads();
    }
}

__device__ __forceinline__ void lru_final_pass(Frame& F, const bf16* HLp, const bf16* CAp, const bf16* GB, const f32x2* AGG, bf16* YCAT) {
    const int ch = TID_;
    for (int un = blockIdx.x; un < NB * LNCH; un += F.G) {
        const int b = un / LNCH, c = un % LNCH; const size_t row0 = (size_t)b * SEQ + (size_t)c * LCT;
        float carry = 0.f;
        for (int j = 0; j < c; ++j) { const f32x2 ag = AGG[((size_t)b * LNCH + j) * 512 + ch]; carry = ag.x * carry + ag.y; }
#pragma unroll 4
        for (int t8 = 0; t8 < LCT; t8 += 8) {
            bf16 hl[8], ca[8], gv[8];
#pragma unroll
            for (int j = 0; j < 8; ++j) { const size_t o = (row0 + t8 + j) * 512 + ch; hl[j] = HLp[o]; ca[j] = CAp[o]; gv[j] = GB[o]; }
#pragma unroll
            for (int j = 0; j < 8; ++j) { const float h = bf1(hl[j]) + bf1(ca[j]) * carry; YCAT[(row0 + t8 + j) * 1024 + 512 + ch] = (bf16)f2bf(h * gelu_tanh(bf1(gv[j]))); }
        }
    }
}

__device__ __forceinline__ void route_pass_a(Frame& F, const In& I, int layer, const float* LOG, unsigned char* rt, gu32* cnt) {
    LAS int* lcnt = (LAS int*)(F.lds + RTE_OFF); LAS int* lbase = lcnt + 32;
    int* EID = (int*)(rt + RT_EID); int* POS = (int*)(rt + RT_POS); float* GATE = (float*)(rt + RT_GATE);
    const float* bc = I.moe_bc + layer * 4; const float* bfb = I.moe_bf + layer * 32;
    for (int un = blockIdx.x; un < T / 512; un += F.G) {
        if (TID_ < 32) lcnt[TID_] = 0;
        __syncthreads();
        const int t = un * 512 + TID_; const float* lg = LOG + (size_t)t * 64;
        const f32x4 g4 = *(const f32x4*)lg;
        float gl[4] = {g4.x + bc[0], g4.y + bc[1], g4.z + bc[2], g4.w + bc[3]};
        int gi = 0; float gm = gl[0];
#pragma unroll
        for (int j = 1; j < 4; ++j) if (gl[j] > gm) { gm = gl[j]; gi = j; }
        float gs = 0.f;
#pragma unroll
        for (int j = 0; j < 4; ++j) gs += __expf(gl[j] - gm);
        const float gprob = 1.0f / gs;
        const f32x4 e0 = *(const f32x4*)(lg + 4 + gi * 8), e1 = *(const f32x4*)(lg + 8 + gi * 8);
        float el[8] = {e0.x, e0.y, e0.z, e0.w, e1.x, e1.y, e1.z, e1.w};
#pragma unroll
        for (int j = 0; j < 8; ++j) el[j] += bfb[gi * 8 + j];
        int i0 = 0; float m0 = el[0];
#pragma unroll
        for (int j = 1; j < 8; ++j) if (el[j] > m0) { m0 = el[j]; i0 = j; }
        int i1 = -1; float m1 = -INFINITY;
#pragma unroll
        for (int j = 0; j < 8; ++j) if (j != i0 && el[j] > m1) { m1 = el[j]; i1 = j; }
        const float r1 = __expf(m1 - m0); const float g0 = gprob / (1.0f + r1), g1 = gprob * r1 / (1.0f + r1);
        const int ex0 = gi * 8 + i0, ex1 = gi * 8 + i1;
        const int p0 = atomicAdd((int*)&lcnt[ex0], 1), p1 = atomicAdd((int*)&lcnt[ex1], 1);
        __syncthreads();
        if (TID_ < 32) lbase[TID_] = (int)__hip_atomic_fetch_add(cnt + TID_, (unsigned)lcnt[TID_], RLX_AGENT);
        __syncthreads();
        EID[2 * t] = ex0; EID[2 * t + 1] = ex1; POS[2 * t] = lbase[ex0] + p0; POS[2 * t + 1] = lbase[ex1] + p1; GATE[2 * t] = g0; GATE[2 * t + 1] = g1;
        __syncthreads();
    }
}
__device__ __forceinline__ void route_bases(Frame& F, gu32* cnt) {
    LAS int* eb = (LAS int*)(F.lds + RTE_OFF + 512);
    const int tid = TID_;
    if (tid < 64) {
        const int c = (tid < 32) ? (int)__hip_atomic_load(cnt + (tid & 31), RLX_AGENT) : 0; const int p = (c + 255) & ~255; int s = p;
#pragma unroll
        for (int o = 1; o < 32; o <<= 1) { const int t = __shfl_up(s, o); if ((tid & 63) >= o) s += t; }
        if (tid < 32) { eb[tid] = s - p; if (tid == 31) eb[32] = s; }
    }
    __syncthreads();
}
__device__ __forceinline__ void route_pass_b(Frame& F, unsigned char* rt, gu32* cnt) {
    route_bases(F, cnt);
    LAS int* eb = (LAS int*)(F.lds + RTE_OFF + 512);
    const int* EID = (const int*)(rt + RT_EID); const int* POS = (const int*)(rt + RT_POS); const float* GATE = (const float*)(rt + RT_GATE);
    int* ROWTOK = (int*)(rt + RT_ROWTOK); float* ROWGATE = (float*)(rt + RT_ROWGATE); int* SLOT = (int*)(rt + RT_SLOT);
    const int gt = F.vcu * 512 + TID_, NGT = F.G * 512;
    for (int i = gt; i < 2 * T; i += NGT) { const int dst = eb[EID[i]] + POS[i]; ROWTOK[dst] = i >> 1; ROWGATE[dst] = GATE[i]; SLOT[i] = dst; }
    for (int i = gt; i < 32 * 256; i += NGT) { const int e = i >> 8, j = i & 255; const int c = (int)__hip_atomic_load(cnt + e, RLX_AGENT); const int pad = ((c + 255) & ~255) - c;
        if (j < pad) { ROWTOK[eb[e] + c + j] = 0; ROWGATE[eb[e] + c + j] = 0.f; } }
    __syncthreads();
}
struct MoeOrder {
    int G, c, ntiles; const LAS int* eb; const char* A; const char* W; size_t astep, wexp, wtile; bool gather;
    __device__ bool next(int i, pg8::Unit& u) const {
        const int L = i * G + c; if (L >= ntiles * 4) return false;
        u.pm = L >> 2; u.pn = L & 3; const int s0 = u.pm * 256; int e = 0;
#pragma unroll 1
        for (int j = 1; j < 32; ++j) if (eb[j] <= s0) e = j;
        e = __builtin_amdgcn_readfirstlane(e); u.aux = e; u.A = gather ? A : A + (size_t)u.pm * astep; u.B = W + (size_t)e * wexp + (size_t)u.pn * wtile; return true;
    }
};

constexpr int RTC = 32, RNCH = SEQ / RTC, RTOK = 352;
#define LBAR() do { asm volatile("s_waitcnt lgkmcnt(0)" ::: "memory"); __builtin_amdgcn_s_barrier(); asm volatile("" ::: "memory"); } while (0)
template <int CTRL> __device__ __forceinline__ float dpp_f(float v) { return __builtin_bit_cast(float, __builtin_amdgcn_update_dpp(0, __builtin_bit_cast(int, v), CTRL, 0xf, 0xf, true)); }
__device__ __forceinline__ float red16(float v) { v += dpp_f<0xB1>(v); v += dpp_f<0x4E>(v); v += dpp_f<0x141>(v); v += dpp_f<0x140>(v); return v; }
__device__ __forceinline__ float red8(float v) { v += dpp_f<0xB1>(v); v += dpp_f<0x4E>(v); v += dpp_f<0x141>(v); return v; }
__device__ __forceinline__ void unpack8(const v4u w, float (&f)[8]) { f[0] = bflo(w.x); f[1] = bfhi(w.x); f[2] = bflo(w.y); f[3] = bfhi(w.y); f[4] = bflo(w.z); f[5] = bfhi(w.z); f[6] = bflo(w.w); f[7] = bfhi(w.w); }
__device__ __forceinline__ void rwkv_scan_phase(Frame& F, const In& I, const bf16* R, const bf16* Kt, const bf16* V, const bf16* AA, const bf16* EW, bf16* Y) {
    LAS float* buf = (LAS float*)F.lds;
    LAS float* ybuf = (LAS float*)(F.lds + 2 * RTC * RTOK * 4) + 32;
    const int tid = TID_, lane = tid & 63;
    const int seg = lane & 15, rl = F.wave * 4 + (lane >> 4);
    const int stk = tid >> 4, ssg = tid & 15;
    for (int un = blockIdx.x; un < NB * 16 * 2; un += F.G) {
        const int half = un & 1, h = (un >> 1) & 15, b = un >> 5;
        const size_t rowb = (size_t)b * SEQ;
        const int col = h * 64 + ssg * 4;
        const f32x4 kkw = *(const f32x4*)(I.rwkv_kk + col), kaw = *(const f32x4*)(I.rwkv_ka + col);
        v2u rr, kr, vr, ar, er;
#define RAW_LOAD(cc) do { const size_t off = (rowb + (size_t)(cc) * RTC + stk) * 1024 + col; rr = *(const v2u*)(R + off); kr = *(const v2u*)(Kt + off); vr = *(const v2u*)(V + off); ar = *(const v2u*)(AA + off); er = *(const v2u*)(EW + off); } while (0)
#define RAW_CONVERT(cc) do { LAS float* tp = buf + ((cc) & 1) * (RTC * RTOK) + stk * RTOK + ssg * 4; \
            const float r0 = bflo(rr.x), r1 = bfhi(rr.x), r2 = bflo(rr.y), r3 = bfhi(rr.y), k0 = bflo(kr.x), k1 = bfhi(kr.x), k2 = bflo(kr.y), k3 = bfhi(kr.y); \
            const float a0 = bflo(ar.x), a1 = bfhi(ar.x), a2 = bflo(ar.y), a3 = bfhi(ar.y); \
            const float x0 = k0 * kkw.x, x1 = k1 * kkw.y, x2 = k2 * kkw.z, x3 = k3 * kkw.w; \
            const float ss = red16((x0 * x0 + x1 * x1) + (x2 * x2 + x3 * x3)); const float inv = __builtin_amdgcn_rsqf(fmaxf(ss, 1e-24f)); \
            *(LAS f32x4*)(tp) = (f32x4){__expf(-bflo(er.x)), __expf(-bfhi(er.x)), __expf(-bflo(er.y)), __expf(-bfhi(er.y))}; \
            const f32x4 kkv = (f32x4){x0 * inv, x1 * inv, x2 * inv, x3 * inv}; *(LAS f32x4*)(tp + 64) = kkv; \
            *(LAS f32x4*)(tp + 128) = (f32x4){kkv.x * a0, kkv.y * a1, kkv.z * a2, kkv.w * a3}; \
            *(LAS f32x4*)(tp + 192) = (f32x4){k0 * (1.0f + (a0 - 1.0f) * kaw.x), k1 * (1.0f + (a1 - 1.0f) * kaw.y), k2 * (1.0f + (a2 - 1.0f) * kaw.z), k3 * (1.0f + (a3 - 1.0f) * kaw.w)}; \
            *(LAS f32x4*)(tp + 256) = (f32x4){r0, r1, r2, r3}; \
            if ((ssg >> 3) == half) *(LAS f32x4*)(buf + ((cc) & 1) * (RTC * RTOK) + stk * RTOK + 320 + (ssg & 7) * 4) = (f32x4){bflo(vr.x), bfhi(vr.x), bflo(vr.y), bfhi(vr.y)}; } while (0)
#define Y_WRITE(cc) do { const LAS f32x2* yp = (const LAS f32x2*)(ybuf + ((cc) & 1) * (RTC * 32 + 32) + stk * 32 + ssg * 2); const f32x2 yv = *yp; \
            *(unsigned*)(Y + (rowb + (size_t)(cc) * RTC + stk) * 1024 + h * 64 + half * 32 + ssg * 2) = pk2(yv.x, yv.y); } while (0)
        RAW_LOAD(0); RAW_CONVERT(0); RAW_LOAD(1);
        f32x2 S0 = (f32x2){0.f, 0.f}, S1 = (f32x2){0.f, 0.f};
        LBAR();
        for (int c = 0; c < RNCH; ++c) {
            if (c + 1 < RNCH) { RAW_CONVERT(c + 1); }
            if (c + 2 < RNCH) { RAW_LOAD(c + 2); }
            if (c >= 1) { Y_WRITE(c - 1); }
            const LAS float* cb = buf + (c & 1) * (RTC * RTOK); LAS float* yb = ybuf + (c & 1) * (RTC * 32 + 32);
            const LAS float* tp0 = cb + seg * 4; const LAS float* vp0 = cb + 320 + rl;
#define SV_DECL(X) f32x4 X##w, X##q, X##b, X##k, X##r; float X##v
#define SV_LOAD(X, tk) do { const LAS float* tp = tp0 + (tk) * RTOK; \
                X##w = *(const LAS f32x4*)(tp); X##q = *(const LAS f32x4*)(tp + 64); X##b = *(const LAS f32x4*)(tp + 128); X##k = *(const LAS f32x4*)(tp + 192); X##r = *(const LAS f32x4*)(tp + 256); X##v = vp0[(tk) * RTOK]; } while (0)
#define SV_STEP(X, tk) do { \
                const f32x2 d = S0 * (f32x2){X##q.x, X##q.y} + S1 * (f32x2){X##q.z, X##q.w}; \
                const f32x2 t0 = S0 * (f32x2){X##w.x, X##w.y} + (f32x2){X##k.x, X##k.y} * X##v, t1 = S1 * (f32x2){X##w.z, X##w.w} + (f32x2){X##k.z, X##k.w} * X##v; \
                float ra = d.x + d.y, rb = epend;                   \
                ra += dpp_f<0xB1>(ra); rb += dpp_f<0xB1>(rb); ra += dpp_f<0x4E>(ra); rb += dpp_f<0x4E>(rb); ra += dpp_f<0x141>(ra); rb += dpp_f<0x141>(rb); ra += dpp_f<0x140>(ra); rb += dpp_f<0x140>(rb); \
                if (seg == 0) yb[((tk) - 1) * 32 + rl] = rb;        \
                const float sa = -ra; \
                S0 = t0 + (f32x2){X##b.x, X##b.y} * sa; S1 = t1 + (f32x2){X##b.z, X##b.w} * sa; \
                const f32x2 e = S0 * (f32x2){X##r.x, X##r.y} + S1 * (f32x2){X##r.z, X##r.w}; epend = e.x + e.y; } while (0)
            SV_DECL(A_); SV_DECL(B_); float epend = 0.f;
            SV_LOAD(A_, 0);
#pragma unroll 1
            for (int tk = 0; tk < RTC; tk += 2) {
                SV_LOAD(B_, tk + 1);
                SV_STEP(A_, tk);
                { const int t2 = (tk + 2 < RTC) ? tk + 2 : RTC - 1; SV_LOAD(A_, t2); }
                SV_STEP(B_, tk + 1);
            }
#undef SV_DECL
#undef SV_LOAD
#undef SV_STEP
            { const float rb = red16(epend); if (seg == 0) yb[(RTC - 1) * 32 + rl] = rb; }
            LBAR();
        }
        Y_WRITE(RNCH - 1);
        LBAR();
#undef RAW_LOAD
#undef RAW_CONVERT
#undef Y_WRITE
    }
}
constexpr int GS_QT = 0, GS_RT = 2048, GS_BHT = 4096, GS_KHT = 6144, GS_VT = 8192, GS_TM = 10240, GS_TL = 10752, GS_MK = 11264, GS_NK = 11776, GS_NB = 12288, GS_DD = 12800, GS_SLOT = 13056;
constexpr int GS_KT = GS_KHT, GS_BT = GS_BHT, GS_MB = GS_TM;
#ifndef SCAN_NP
#define SCAN_NP 4
#endif
constexpr int CH_NP = SCAN_NP, CH_NS = 8 - CH_NP, CH_ROUNDS = (512 + CH_NP - 1) / CH_NP;
constexpr int CH_KTAB = 2 * CH_NP * GS_SLOT;
static_assert(CH_KTAB + 512 <= 131072, "chunked-scan LDS map");
template <int N> __device__ __forceinline__ float dpp_shr(float v) { return __builtin_bit_cast(float, __builtin_amdgcn_update_dpp(0, __builtin_bit_cast(int, v), 0x110 + N, 0xf, 0xf, true)); }
__device__ __forceinline__ bf16x8 mk8(v2u a, v2u b) { return __builtin_bit_cast(bf16x8, (v4u){a.x, a.y, b.x, b.y}); }
__device__ __forceinline__ bf16x8 mk8z(v2u a) { return __builtin_bit_cast(bf16x8, (v4u){a.x, a.y, 0u, 0u}); }
__device__ __forceinline__ bf16x8 cvt8z(f32x4 v) { return __builtin_bit_cast(bf16x8, (v4u){pk2(v.x, v.y), pk2(v.z, v.w), 0u, 0u}); }
__device__ __forceinline__ int tokoff(const int t, const int c) { return t * 128 + ((c ^ ((t >> 1) & 7)) << 4); }
__device__ __forceinline__ int tokoff2(const int t, const int c) { return t * 128 + ((c ^ (((t >> 1) & 3) << 1)) << 4); }
__device__ __forceinline__ v2u trld(const LAS unsigned char* p) { return __builtin_bit_cast(v2u, __builtin_amdgcn_ds_read_tr16_b64_v4i16((LAS attn_body::v4i16_t*)p)); }
struct ChOps { v4u q0, q1, r0, r1, mn, bt; };
struct ChOpsB { v2u kh[4], bh[4]; f32x4 dv[4]; };
__device__ __forceinline__ void chain_load(ChOps& O, const LAS unsigned char* C, const int fr, const int fq) {
    const int w8 = 8 * (fq & 1), c = fq >> 1;
    { const v2u a = *(const LAS v2u*)(C + GS_QT + tokoff(fr, c) + w8), b = *(const LAS v2u*)(C + GS_QT + tokoff(fr, 2 + c) + w8); O.q0 = (v4u){a.x, a.y, b.x, b.y}; }
    { const v2u a = *(const LAS v2u*)(C + GS_QT + tokoff(fr, 4 + c) + w8), b = *(const LAS v2u*)(C + GS_QT + tokoff(fr, 6 + c) + w8); O.q1 = (v4u){a.x, a.y, b.x, b.y}; }
    { const v2u a = *(const LAS v2u*)(C + GS_RT + tokoff(fr, c) + w8), b = *(const LAS v2u*)(C + GS_RT + tokoff(fr, 2 + c) + w8); O.r0 = (v4u){a.x, a.y, b.x, b.y}; }
    { const v2u a = *(const LAS v2u*)(C + GS_RT + tokoff(fr, 4 + c) + w8), b = *(const LAS v2u*)(C + GS_RT + tokoff(fr, 6 + c) + w8); O.r1 = (v4u){a.x, a.y, b.x, b.y}; }
    const int om = (fr * 16 + 4 * fq) * 2;
    { const v2u a = *(const LAS v2u*)(C + GS_MK + om), b = *(const LAS v2u*)(C + GS_NK + om); O.mn = (v4u){a.x, a.y, b.x, b.y}; }
    { const v2u a = *(const LAS v2u*)(C + GS_NB + om), b = *(const LAS v2u*)(C + GS_TM + om); O.bt = (v4u){a.x, a.y, b.x, b.y}; }
}
__device__ __forceinline__ void chain_load_b(ChOpsB& O, const LAS unsigned char* C, const int fr, const int fq) {
#pragma unroll
    for (int jt = 0; jt < 4; ++jt) { const int ok = tokoff2(4 * fq + (fr >> 2), 2 * jt + ((fr >> 1) & 1)) + 8 * (fr & 1); O.kh[jt] = trld(C + GS_KHT + ok); O.bh[jt] = trld(C + GS_BHT + ok); O.dv[jt] = *(const LAS f32x4*)(C + GS_DD + (16 * jt + 4 * fq) * 4); }
}
template <int NT>
__device__ __forceinline__ void chain_step(const ChOps& O, const LAS unsigned char* C, const v2u vq0, const v2u vq1, f32x4 (&Areg)[2][4], const int vt0, const int fr, const int fq, GAS bf16* yrow, LAS unsigned char* ys) {
    const f32x4 zero4 = (f32x4){0.f, 0.f, 0.f, 0.f};
    v2u kh0, kh1, kh2, kh3, bh0, bh1, bh2, bh3; f32x4 dv0, dv1, dv2, dv3;
    { const int okb = tokoff2(4 * fq + (fr >> 2), 0) + 8 * (fr & 1), xs = (((4 * fq + (fr >> 2)) >> 1) & 3) << 1, cb = (fr >> 1) & 1;
#define KB_(jt) (4 * fq + (fr >> 2)) * 128 + ((((2 * (jt) + cb) ^ xs)) << 4) + 8 * (fr & 1)
      kh0 = trld(C + GS_KHT + KB_(0)); kh1 = trld(C + GS_KHT + KB_(1)); kh2 = trld(C + GS_KHT + KB_(2)); kh3 = trld(C + GS_KHT + KB_(3));
      bh0 = trld(C + GS_BHT + KB_(0)); bh1 = trld(C + GS_BHT + KB_(1)); bh2 = trld(C + GS_BHT + KB_(2)); bh3 = trld(C + GS_BHT + KB_(3)); (void)okb;
#undef KB_
      dv0 = *(const LAS f32x4*)(C + GS_DD + (4 * fq) * 4); dv1 = *(const LAS f32x4*)(C + GS_DD + (16 + 4 * fq) * 4); dv2 = *(const LAS f32x4*)(C + GS_DD + (32 + 4 * fq) * 4); dv3 = *(const LAS f32x4*)(C + GS_DD + (48 + 4 * fq) * 4); }
    bf16x8 Aq[NT][2], Vq[NT], Uq[NT]; f32x4 X[NT], YA[NT], Z[NT], U[NT], Yv[NT], Yn[NT];
#pragma unroll
    for (int ti = 0; ti < NT; ++ti) {
#pragma unroll
        for (int kh = 0; kh < 2; ++kh) Aq[ti][kh] = __builtin_bit_cast(bf16x8, (v4u){pk2(Areg[ti][2 * kh].x, Areg[ti][2 * kh].y), pk2(Areg[ti][2 * kh].z, Areg[ti][2 * kh].w), pk2(Areg[ti][2 * kh + 1].x, Areg[ti][2 * kh + 1].y), pk2(Areg[ti][2 * kh + 1].z, Areg[ti][2 * kh + 1].w)});
        Vq[ti] = mk8z(ti == 0 ? vq0 : vq1); X[ti] = zero4; YA[ti] = zero4; }
#pragma unroll
    for (int kh = 0; kh < 2; ++kh) {
#pragma unroll
        for (int ti = 0; ti < NT; ++ti) { X[ti] = __builtin_amdgcn_mfma_f32_16x16x32_bf16(__builtin_bit_cast(bf16x8, kh == 0 ? O.q0 : O.q1), Aq[ti][kh], X[ti], 0, 0, 0); YA[ti] = __builtin_amdgcn_mfma_f32_16x16x32_bf16(__builtin_bit_cast(bf16x8, kh == 0 ? O.r0 : O.r1), Aq[ti][kh], YA[ti], 0, 0, 0); } }
#pragma unroll
    for (int ti = 0; ti < NT; ++ti) Z[ti] = __builtin_amdgcn_mfma_f32_16x16x32_bf16(__builtin_bit_cast(bf16x8, (v4u){O.mn.x, O.mn.y, 0u, 0u}), Vq[ti], X[ti], 0, 0, 0);
#pragma unroll
    for (int ti = 0; ti < NT; ++ti) Yv[ti] = __builtin_amdgcn_mfma_f32_16x16x32_bf16(__builtin_bit_cast(bf16x8, (v4u){O.mn.z, O.mn.w, 0u, 0u}), Vq[ti], YA[ti], 0, 0, 0);
#pragma unroll
    for (int ti = 0; ti < NT; ++ti) U[ti] = __builtin_amdgcn_mfma_f32_16x16x32_bf16(__builtin_bit_cast(bf16x8, (v4u){O.bt.z, O.bt.w, 0u, 0u}), cvt8z(Z[ti]), zero4, 0, 0, 0);
#pragma unroll
    for (int ti = 0; ti < NT; ++ti) Uq[ti] = cvt8z(U[ti]);
#pragma unroll
    for (int ti = 0; ti < NT; ++ti) Yn[ti] = __builtin_amdgcn_mfma_f32_16x16x32_bf16(__builtin_bit_cast(bf16x8, (v4u){O.bt.x, O.bt.y, 0u, 0u}), Uq[ti], zero4, 0, 0, 0);
#pragma unroll
    for (int jt = 0; jt < 4; ++jt) {
#pragma unroll
        for (int ti = 0; ti < NT; ++ti) { f32x4 acc = (jt == 0 ? dv0 : jt == 1 ? dv1 : jt == 2 ? dv2 : dv3) * Areg[ti][jt];
            acc = __builtin_amdgcn_mfma_f32_16x16x32_bf16(mk8z(jt == 0 ? kh0 : jt == 1 ? kh1 : jt == 2 ? kh2 : kh3), Vq[ti], acc, 0, 0, 0);
            const f32x4 nbu = __builtin_amdgcn_mfma_f32_16x16x32_bf16(mk8z(jt == 0 ? bh0 : jt == 1 ? bh1 : jt == 2 ? bh2 : bh3), Uq[ti], zero4, 0, 0, 0);
            Areg[ti][jt] = acc - nbu; } }
#pragma unroll
    for (int ti = 0; ti < NT; ++ti) { const f32x4 yy = Yv[ti] - Yn[ti]; *(LAS v2u*)(ys + ti * 512 + (fr * 16 + 4 * fq) * 2) = (v2u){pk2(yy[0], yy[1]), pk2(yy[2], yy[3])}; }
#pragma unroll
    for (int ti = 0; ti < NT; ++ti) { const v2u w = trld(ys + ti * 512 + ((4 * fq + (fr >> 2)) * 16 + 4 * (fr & 3)) * 2); __hip_atomic_store((GAS unsigned long long*)(yrow + (size_t)fr * 1024 + 16 * (vt0 + ti) + 4 * fq), __builtin_bit_cast(unsigned long long, w), __ATOMIC_RELAXED, __HIP_MEMORY_SCOPE_AGENT); }
}
#ifndef SCAN_WMAP
#define SCAN_WMAP 0x76543210u
#endif
__device__ __forceinline__ void rwkv_scan_chunked(Frame& F, const In& I, const bf16* R, const bf16* Kt, const bf16* V, const bf16* AA, const bf16* EW, bf16* Y, gu32* prog) {
    const int lane = LANE_, fr = lane & 15, fq = lane >> 4;
    const int lw = (int)((SCAN_WMAP >> (4 * F.wave)) & 7u);
    LAS unsigned char* L = F.lds;
    const f32x4 zero4 = (f32x4){0.f, 0.f, 0.f, 0.f};
    for (int un = blockIdx.x; un < NB * 16; un += F.G) {
        const int h = un & 15, b = un >> 4; const size_t rowb = (size_t)b * SEQ;
        if (lw == 0) { ((LAS float*)(L + CH_KTAB))[lane] = ((const GAS float*)I.rwkv_kk)[h * 64 + lane]; ((LAS float*)(L + CH_KTAB + 256))[lane] = ((const GAS float*)I.rwkv_ka)[h * 64 + lane]; }
        LBAR();
        if (lw >= CH_NS) {
            const int p = lw - CH_NS; const int colb = h * 64 + 16 * fq;
            v4u raw[10];
#define CK_LOAD(cidx) do { const size_t off = (rowb + (size_t)(cidx) * 16 + fr) * 1024 + colb; \
                raw[0] = *(const GAS v4u*)(R + off); raw[1] = *(const GAS v4u*)(R + off + 8); raw[2] = *(const GAS v4u*)(Kt + off); raw[3] = *(const GAS v4u*)(Kt + off + 8); raw[4] = *(const GAS v4u*)(V + off); raw[5] = *(const GAS v4u*)(V + off + 8); \
                raw[6] = *(const GAS v4u*)(AA + off); raw[7] = *(const GAS v4u*)(AA + off + 8); raw[8] = *(const GAS v4u*)(EW + off); raw[9] = *(const GAS v4u*)(EW + off + 8); } while (0)
#ifdef SCAN_STAMP
            unsigned long long st_[7] = {0, 0, 0, 0, 0, 0, 0};
#ifndef SCAN_STAMP_P
#define SCAN_STAMP_P 0
#endif
#ifndef SCAN_STAMP_RD
#define SCAN_STAMP_RD 20
#endif
#ifndef SCAN_STAMP_B
#define SCAN_STAMP_B 0
#endif
#define STAMP(i) do { if ((SCAN_STAMP_B < 0 || blockIdx.x == SCAN_STAMP_B) && p == SCAN_STAMP_P && rd == SCAN_STAMP_RD) st_[i] = __builtin_amdgcn_s_memtime(); } while (0)
#else
#define STAMP(i) do { } while (0)
#endif
            CK_LOAD(p);
#pragma unroll 2
            for (int rd = -1; rd < CH_ROUNDS - 1; ++rd) {
                const int cidx = CH_NP * (rd + 1) + p; LAS unsigned char* S = L + (((rd + 1) & 1) * CH_NP + p) * GS_SLOT;
                if (cidx < 512) {
                STAMP(0);
                float r[16], k[16], a[16], ew[16]; const v4u vraw0 = raw[4], vraw1 = raw[5];
                { float t8[8];
                  unpack8(raw[0], t8);
#pragma unroll
                  for (int e = 0; e < 8; ++e) r[e] = t8[e];
                  unpack8(raw[1], t8);
#pragma unroll
                  for (int e = 0; e < 8; ++e) r[8 + e] = t8[e];
                  unpack8(raw[2], t8);
#pragma unroll
                  for (int e = 0; e < 8; ++e) k[e] = t8[e];
                  unpack8(raw[3], t8);
#pragma unroll
                  for (int e = 0; e < 8; ++e) k[8 + e] = t8[e];
                  unpack8(raw[6], t8);
#pragma unroll
                  for (int e = 0; e < 8; ++e) a[e] = t8[e];
                  unpack8(raw[7], t8);
#pragma unroll
                  for (int e = 0; e < 8; ++e) a[8 + e] = t8[e];
                  unpack8(raw[8], t8);
#pragma unroll
                  for (int e = 0; e < 8; ++e) ew[e] = t8[e];
                  unpack8(raw[9], t8);
#pragma unroll
                  for (int e = 0; e < 8; ++e) ew[8 + e] = t8[e]; }
#if defined(SCAN_STAMP) && defined(SCAN_STAMP_LD)
                asm volatile("s_waitcnt vmcnt(0)" ::: "memory"); STAMP(1);
#endif
                if (cidx + CH_NP < 512) CK_LOAD(cidx + CH_NP);
                float kx[16], ss = 0.f;
#pragma unroll
                for (int e4 = 0; e4 < 4; ++e4) { const f32x4 c0_ = *(const LAS f32x4*)(L + CH_KTAB + (16 * fq + 4 * e4) * 4), c1_ = *(const LAS f32x4*)(L + CH_KTAB + 256 + (16 * fq + 4 * e4) * 4);
#pragma unroll
                    for (int z = 0; z < 4; ++z) { const int ee = 4 * e4 + z; kx[ee] = k[ee] * c0_[z]; ss += kx[ee] * kx[ee]; k[ee] = k[ee] * (1.0f + (a[ee] - 1.0f) * c1_[z]); } }
                ss += __shfl_xor(ss, 16); ss += __shfl_xor(ss, 32);
                const float inv = __builtin_amdgcn_rsqf(fmaxf(ss, 1e-24f));
                unsigned qtw[8], rtw[8], ktw[8], btw[8], bhw[8], khw[8];
                {
                    float li[16], e15[16], ep[16];
#pragma unroll
                    for (int e = 0; e < 16; ++e) li[e] = -ew[e];
#pragma unroll
                    for (int e = 0; e < 16; ++e) li[e] += dpp_shr<1>(li[e]);
#pragma unroll
                    for (int e = 0; e < 16; ++e) li[e] += dpp_shr<2>(li[e]);
#pragma unroll
                    for (int e = 0; e < 16; ++e) li[e] += dpp_shr<4>(li[e]);
#pragma unroll
                    for (int e = 0; e < 16; ++e) li[e] += dpp_shr<8>(li[e]);
#pragma unroll
                    for (int e = 0; e < 16; ++e) li[e] = __builtin_amdgcn_exp2f(li[e]);
#pragma unroll
                    for (int e = 0; e < 16; ++e) e15[e] = __shfl(li[e], (lane & 48) | 15);
#pragma unroll
                    for (int e = 0; e < 16; ++e) ep[e] = __builtin_bit_cast(float, __builtin_amdgcn_update_dpp(0x3f800000, __builtin_bit_cast(int, li[e]), 0x111, 0xf, 0xf, false));
                    if (fr == 15) {
#pragma unroll
                        for (int e4 = 0; e4 < 4; ++e4) *(LAS f32x4*)(S + GS_DD + (16 * fq + 4 * e4) * 4) = (f32x4){li[4 * e4], li[4 * e4 + 1], li[4 * e4 + 2], li[4 * e4 + 3]}; }
#pragma unroll
                    for (int e = 0; e < 16; e += 2) { float q2[2], r2[2], k2[2], b2[2], b2h[2], k2h[2];
#pragma unroll
                        for (int z = 0; z < 2; ++z) { const int ee = e + z;
                            const float Einv = __builtin_amdgcn_rcpf(li[ee]);
                            const float kk = kx[ee] * inv, bb = a[ee] * kk;
                            q2[z] = kk * ep[ee]; k2[z] = k[ee] * Einv; b2[z] = bb * Einv; r2[z] = r[ee] * li[ee];
                            b2h[z] = b2[z] * e15[ee]; k2h[z] = k2[z] * e15[ee]; }
                        qtw[e >> 1] = pk2(q2[0], q2[1]); rtw[e >> 1] = pk2(r2[0], r2[1]); ktw[e >> 1] = pk2(k2[0], k2[1]); btw[e >> 1] = pk2(b2[0], b2[1]); bhw[e >> 1] = pk2(b2h[0], b2h[1]); khw[e >> 1] = pk2(k2h[0], k2h[1]);
 } }
                { const int ov = tokoff2(fr, 2 * fq); *(LAS v4u*)(S + GS_VT + ov) = vraw0; *(LAS v4u*)(S + GS_VT + ov + 16) = vraw1; }
                { const int o = tokoff(fr, 2 * fq), o2 = o ^ 16;
                  *(LAS v4u*)(S + GS_QT + o) = (v4u){qtw[0], qtw[1], qtw[2], qtw[3]}; *(LAS v4u*)(S + GS_QT + o2) = (v4u){qtw[4], qtw[5], qtw[6], qtw[7]};
                  *(LAS v4u*)(S + GS_RT + o) = (v4u){rtw[0], rtw[1], rtw[2], rtw[3]}; *(LAS v4u*)(S + GS_RT + o2) = (v4u){rtw[4], rtw[5], rtw[6], rtw[7]};
                  *(LAS v4u*)(S + GS_KT + o) = (v4u){ktw[0], ktw[1], ktw[2], ktw[3]}; *(LAS v4u*)(S + GS_KT + o2) = (v4u){ktw[4], ktw[5], ktw[6], ktw[7]};
                  *(LAS v4u*)(S + GS_BT + o) = (v4u){btw[0], btw[1], btw[2], btw[3]}; *(LAS v4u*)(S + GS_BT + o2) = (v4u){btw[4], btw[5], btw[6], btw[7]}; }
                asm volatile("s_waitcnt lgkmcnt(0)" ::: "memory");
#if !defined(SCAN_STAMP_LD)
                STAMP(1);
#endif
                f32x4 mb = zero4, mbt = zero4, mkt = zero4, nbt = zero4, nkt = zero4;
#pragma unroll
                for (int kh = 0; kh < 2; ++kh) { const int o = tokoff(fr, 4 * kh + fq);
                    const bf16x8 Qf = *(const LAS bf16x8*)(S + GS_QT + o), Rf = *(const LAS bf16x8*)(S + GS_RT + o), Kf = *(const LAS bf16x8*)(S + GS_KT + o), Bf = *(const LAS bf16x8*)(S + GS_BT + o);
                    mb = __builtin_amdgcn_mfma_f32_16x16x32_bf16(Qf, Bf, mb, 0, 0, 0); mbt = __builtin_amdgcn_mfma_f32_16x16x32_bf16(Bf, Qf, mbt, 0, 0, 0);
                    mkt = __builtin_amdgcn_mfma_f32_16x16x32_bf16(Kf, Qf, mkt, 0, 0, 0);
                    nbt = __builtin_amdgcn_mfma_f32_16x16x32_bf16(Bf, Rf, nbt, 0, 0, 0); nkt = __builtin_amdgcn_mfma_f32_16x16x32_bf16(Kf, Rf, nkt, 0, 0, 0); }
                asm volatile("s_waitcnt lgkmcnt(0)" ::: "memory");
                STAMP(2);
                { const int oh = tokoff2(fr, 2 * fq);
                  *(LAS v4u*)(S + GS_BHT + oh) = (v4u){bhw[0], bhw[1], bhw[2], bhw[3]}; *(LAS v4u*)(S + GS_BHT + oh + 16) = (v4u){bhw[4], bhw[5], bhw[6], bhw[7]};
                  *(LAS v4u*)(S + GS_KHT + oh) = (v4u){khw[0], khw[1], khw[2], khw[3]}; *(LAS v4u*)(S + GS_KHT + oh + 16) = (v4u){khw[4], khw[5], khw[6], khw[7]}; }
                { f32x4 nAf, nDf, iD, mkm, nkm, nbm;
#pragma unroll
                  for (int e = 0; e < 4; ++e) { const int tt = 4 * fq + e; const bool lo = fr < tt, up = tt < fr, ue = tt <= fr;
                      nAf[e] = lo ? -mb[e] : 0.f; nDf[e] = up ? -mbt[e] : 0.f; iD[e] = (tt == fr) ? 1.0f : 0.0f;
                      mkm[e] = up ? mkt[e] : 0.f; nkm[e] = ue ? nkt[e] : 0.f; nbm[e] = ue ? nbt[e] : 0.f; }
                  const int om = (fr * 16 + 4 * fq) * 2;
                  *(LAS v2u*)(S + GS_MK + om) = (v2u){pk2(mkm[0], mkm[1]), pk2(mkm[2], mkm[3])}; *(LAS v2u*)(S + GS_NK + om) = (v2u){pk2(nkm[0], nkm[1]), pk2(nkm[2], nkm[3])};
                  *(LAS v2u*)(S + GS_NB + om) = (v2u){pk2(nbm[0], nbm[1]), pk2(nbm[2], nbm[3])};
                  STAMP(3);
                  const bf16x8 nA = cvt8z(nAf), nD = cvt8z(nDf);
                  const f32x4 n2D = __builtin_amdgcn_mfma_f32_16x16x32_bf16(nA, nD, zero4, 0, 0, 0), n2A = __builtin_amdgcn_mfma_f32_16x16x32_bf16(nD, nA, zero4, 0, 0, 0);
                  const bf16x8 n2Db = cvt8z(n2D), n2Ab = cvt8z(n2A);
                  const f32x4 n4D = __builtin_amdgcn_mfma_f32_16x16x32_bf16(n2Ab, n2Db, zero4, 0, 0, 0), n4A = __builtin_amdgcn_mfma_f32_16x16x32_bf16(n2Db, n2Ab, zero4, 0, 0, 0);
                  f32x4 Tt = __builtin_amdgcn_mfma_f32_16x16x32_bf16(nA, n2Db, iD + nDf + n2D, 0, 0, 0);
                  const bf16x8 n4Db = cvt8z(n4D), n4Ab = cvt8z(n4A);
                  const f32x4 n8A = __builtin_amdgcn_mfma_f32_16x16x32_bf16(n4Db, n4Ab, zero4, 0, 0, 0);
                  Tt = __builtin_amdgcn_mfma_f32_16x16x32_bf16(n4Ab, cvt8z(Tt), Tt, 0, 0, 0);
                  Tt = __builtin_amdgcn_mfma_f32_16x16x32_bf16(cvt8z(n8A), cvt8z(Tt), Tt, 0, 0, 0);
                  STAMP(4);
                  *(LAS v2u*)(S + GS_TM + om) = (v2u){pk2(Tt[0], Tt[1]), pk2(Tt[2], Tt[3])}; }
                STAMP(5);
                }
                LBAR();
                STAMP(6);
            }
            LBAR();
#ifdef SCAN_STAMP
            if ((SCAN_STAMP_B < 0 || blockIdx.x == SCAN_STAMP_B) && p == SCAN_STAMP_P) { const unsigned long long d_ = (SCAN_STAMP == 0) ? st_[6] - st_[0] : (SCAN_STAMP == 7) ? st_[5] - st_[0] : st_[SCAN_STAMP] - st_[SCAN_STAMP - 1]; const unsigned long long t0_ = __builtin_amdgcn_s_memtime();
                while (__builtin_amdgcn_s_memtime() - t0_ < d_ * 512ull) __builtin_amdgcn_s_sleep(8); }
#endif
#undef CK_LOAD
        } else {
            const int vtA = (CH_NS == 4) ? lw : ((lw == 0) ? 0 : lw + 1);
            f32x4 A2[2][4];
#ifdef SCAN_PRIO
            __builtin_amdgcn_s_setprio(SCAN_PRIO);
#endif
#pragma unroll
            for (int jt = 0; jt < 4; ++jt) { A2[0][jt] = zero4; A2[1][jt] = zero4; }
            const int trb = 4 * fq + (fr >> 2), trc = (fr >> 1) & 1, trl = 8 * (fr & 1);
            LAS unsigned char* ys = L + TB_OFF + lw * 1024;
#ifdef SCAN_SSTAMP
            unsigned long long ss0_ = 0, ss1_ = 0;
#endif
            LBAR();
            const int vt0 = (CH_NS == 3 && lw == 0) ? 0 : vtA; const bool two = (CH_NS == 3 && lw == 0);
            for (int rd = 0; rd < CH_ROUNDS; ++rd) {
                const int c0 = CH_NP * rd; const LAS unsigned char* C0 = L + ((rd & 1) * CH_NP) * GS_SLOT;
                ChOps opA, opB; v2u vA0, vA1, vB0, vB1;
#define CH_FETCH(OP, V0, V1, q_) do { const LAS unsigned char* C_ = C0 + (q_) * GS_SLOT; chain_load(OP, C_, fr, fq); V0 = trld(C_ + GS_VT + tokoff2(trb, 2 * vt0 + trc) + trl); \
                    if (two) V1 = trld(C_ + GS_VT + tokoff2(trb, 2 + trc) + trl); } while (0)
#define CH_ITER(q_, CUR, U0, U1, NXT, W0, W1) do { if ((q_) < CH_NP) { const int cidx = c0 + (q_); \
                    if ((q_) + 1 < CH_NP && cidx + 1 < 512) CH_FETCH(NXT, W0, W1, (q_) + 1); \
                    if (cidx < 512) { GAS bf16* yrow = (GAS bf16*)Y + (rowb + (size_t)cidx * 16) * 1024 + h * 64; \
                        if (two) chain_step<2>(CUR, C0 + (q_) * GS_SLOT, U0, U1, A2, 0, fr, fq, yrow, ys); \
                        else chain_step<1>(CUR, C0 + (q_) * GS_SLOT, U0, U0, A2, vtA, fr, fq, yrow, ys); } } } while (0)
                vA1 = (v2u){0u, 0u}; vB1 = (v2u){0u, 0u};
                if (c0 < 512) CH_FETCH(opA, vA0, vA1, 0);
                CH_ITER(0, opA, vA0, vA1, opB, vB0, vB1);
                CH_ITER(1, opB, vB0, vB1, opA, vA0, vA1);
                CH_ITER(2, opA, vA0, vA1, opB, vB0, vB1);
                CH_ITER(3, opB, vB0, vB1, opA, vA0, vA1);
                CH_ITER(4, opA, vA0, vA1, opB, vB0, vB1);
                CH_ITER(5, opB, vB0, vB1, opA, vA0, vA1);
#undef CH_ITER
#undef CH_FETCH
                asm volatile("s_waitcnt vmcnt(0)" ::: "memory");
                LBAR();
                if (lw == 0 && lane == 0) __hip_atomic_fetch_add((GAS unsigned*)(prog + b * CH_ROUNDS + rd), 1u, __ATOMIC_RELAXED, __HIP_MEMORY_SCOPE_AGENT);
            }
#ifdef SCAN_SSTAMP
            if (lw == SCAN_SSTAMP_W) { const unsigned long long d_ = (ss1_ - ss0_) * 512ull, t0_ = __builtin_amdgcn_s_memtime(); while (__builtin_amdgcn_s_memtime() - t0_ < d_) __builtin_amdgcn_s_sleep(8); }
#endif
#ifdef SCAN_PRIO
            __builtin_amdgcn_s_setprio(0);
#endif
        }
    }
}
__device__ __forceinline__ void rwkv_post_pass(Frame& F, const In& I, const bf16* R, const bf16* Kt, const bf16* V, const bf16* AA, const bf16* G, bf16* Y, const int tbeg, const int tend, const int tstep) {
    const int col = LANE_ * 16;
    for (int t0 = tbeg; t0 < tend; t0 += tstep) {
        v4u py[2][2], pr[2][2], pk[2][2], pv[2][2], pa[2][2], pg[2][2];
#pragma unroll
        for (int rw = 0; rw < 2; ++rw) { const size_t off = (size_t)(t0 + rw) * 1024 + col;
#pragma unroll
            for (int hf = 0; hf < 2; ++hf) { py[rw][hf] = *(const v4u*)(Y + off + hf * 8); pr[rw][hf] = *(const v4u*)(R + off + hf * 8); pk[rw][hf] = *(const v4u*)(Kt + off + hf * 8);
                pv[rw][hf] = *(const v4u*)(V + off + hf * 8); pa[rw][hf] = *(const v4u*)(AA + off + hf * 8); pg[rw][hf] = *(const v4u*)(G + off + hf * 8); } }
#pragma unroll
        for (int rw = 0; rw < 2; ++rw) { const size_t off = (size_t)(t0 + rw) * 1024 + col;
            float kaw[16], rkw[16], lng[16], lnb[16];
#pragma unroll
            for (int e4 = 0; e4 < 4; ++e4) { const f32x4 c0 = *(const GAS f32x4*)(I.rwkv_ka + col + 4 * e4), c1 = *(const GAS f32x4*)(I.rwkv_rk + col + 4 * e4), c2 = *(const GAS f32x4*)(I.rwkv_ln_g + col + 4 * e4), c3 = *(const GAS f32x4*)(I.rwkv_ln_b + col + 4 * e4);
#pragma unroll
                for (int e = 0; e < 4; ++e) { kaw[4 * e4 + e] = c0[e]; rkw[4 * e4 + e] = c1[e]; lng[4 * e4 + e] = c2[e]; lnb[4 * e4 + e] = c3[e]; } }
            float y[16], r[16], k[16], v[16], a[16], g[16];
#pragma unroll
            for (int hf = 0; hf < 2; ++hf) { float t8[8];
                unpack8(py[rw][hf], t8);
#pragma unroll
                for (int e = 0; e < 8; ++e) y[hf * 8 + e] = t8[e];
                unpack8(pr[rw][hf], t8);
#pragma unroll
                for (int e = 0; e < 8; ++e) r[hf * 8 + e] = t8[e];
                unpack8(pk[rw][hf], t8);
#pragma unroll
                for (int e = 0; e < 8; ++e) k[hf * 8 + e] = t8[e];
                unpack8(pv[rw][hf], t8);
#pragma unroll
                for (int e = 0; e < 8; ++e) v[hf * 8 + e] = t8[e];
                unpack8(pa[rw][hf], t8);
#pragma unroll
                for (int e = 0; e < 8; ++e) a[hf * 8 + e] = t8[e];
                unpack8(pg[rw][hf], t8);
#pragma unroll
                for (int e = 0; e < 8; ++e) g[hf * 8 + e] = t8[e]; }
            float s = 0.f, bs = 0.f;
#pragma unroll
            for (int e = 0; e < 16; ++e) { s += y[e]; const float kp = k[e] * (1.0f + (a[e] - 1.0f) * kaw[e]); bs += r[e] * kp * rkw[e]; }
            s += __shfl_xor(s, 1); s += __shfl_xor(s, 2); bs += __shfl_xor(bs, 1); bs += __shfl_xor(bs, 2);
            const float mean = s * (1.0f / 64.0f); float q = 0.f;
#pragma unroll
            for (int e = 0; e < 16; ++e) { const float dd = y[e] - mean; q += dd * dd; }
            q += __shfl_xor(q, 1); q += __shfl_xor(q, 2);
            const float rstd = 1.0f / sqrtf(q * (1.0f / 64.0f) + 64e-5f);
            float o[16];
#pragma unroll
            for (int e = 0; e < 16; ++e) o[e] = ((y[e] - mean) * rstd * lng[e] + lnb[e] + bs * v[e]) * g[e];
            v4u w0, w1; w0.x = pk2(o[0], o[1]); w0.y = pk2(o[2], o[3]); w0.z = pk2(o[4], o[5]); w0.w = pk2(o[6], o[7]); w1.x = pk2(o[8], o[9]); w1.y = pk2(o[10], o[11]); w1.z = pk2(o[12], o[13]); w1.w = pk2(o[14], o[15]);
            *(v4u*)(Y + off) = w0; *(v4u*)(Y + off + 8) = w1; }
    }
}

#ifndef DUP_K
#define DUP_K (-1)
#endif
#ifndef DUP_K2
#define DUP_K2 (-1)
#endif
#define KARGS ((const __attribute__((address_space(4))) Args*)__builtin_amdgcn_kernarg_segment_ptr())
#define WSPTRS \
    bf16* H0 = (bf16*)(ws + WS_H0); bf16* QKV = (bf16*)(ws + WS_QKV); bf16* OB = (bf16*)(ws + WS_O); f32x2* AGG = (f32x2*)(ws + WS_LRUAGG); \
    bf16* H2 = (bf16*)(ws + WS_H2); float* LOG = (float*)(ws + WS_LOG); unsigned char* RTE = ws + WS_ROUTE; bf16* HID = (bf16*)(ws + WS_HID); bf16* YS = (bf16*)(ws + WS_YS); bf16* PP = (bf16*)(ws + WS_PP); \
    bf16* HCAT = (bf16*)(ws + WS_HCAT); bf16* RB = (bf16*)(ws + WS_R); bf16* KB = (bf16*)(ws + WS_K); bf16* VB = (bf16*)(ws + WS_V); bf16* XRB = (bf16*)(ws + WS_XR); bf16* XKB = (bf16*)(ws + WS_XK); bf16* XVB = (bf16*)(ws + WS_XV); bf16* MID = (bf16*)(ws + WS_MID); bf16* EWB = (bf16*)(ws + WS_EW); bf16* AAB = (bf16*)(ws + WS_AA); bf16* YB = (bf16*)(ws + WS_Y); \
    const size_t TD = (size_t)T * 1024; (void)H0; (void)QKV; (void)OB; (void)AGG; (void)H2; (void)LOG; (void)RTE; (void)HID; (void)YS; (void)PP; (void)HCAT; (void)RB; (void)KB; (void)VB; (void)XRB; (void)XKB; (void)XVB; (void)MID; (void)EWB; (void)AAB; (void)YB; (void)TD;

struct Args { In in; float* out; unsigned char* ws; int ph_lo, ph_hi; };
constexpr int N_PHASES = 34;
__device__ __forceinline__ int nrep(int k) { int n = (k == DUP_K) ? 2 : 1; if (DUP_K >= 0) asm volatile("" : "+s"(n)); return n; }
#define REP_SYNC if (rep_) __syncthreads();
typedef const __attribute__((address_space(4))) unsigned long long* kp64;
__device__ __forceinline__ void load_in(In& I) { kp64 s = (kp64)__builtin_amdgcn_kernarg_segment_ptr(); unsigned long long* d = (unsigned long long*)&I;
#pragma unroll
    for (int i = 0; i < 47; ++i) d[i] = s[i]; }

__device__ __forceinline__ int t5_bucket(int n) { if (n < 16) return n; const float v = logf((float)n / 16.0f) / 2.0794415416798357f * 16.0f; const int l = 16 + (int)v; return l < 31 ? l : 31; }

template <class Epi>
__device__ __forceinline__ void dense_gemm(Frame& F, const void* A, int lda, const void* B, int K, int M, int N, const Epi& E) {
    pg8::DenseOrder S; S.init(A, lda, B, K, M, N, F.G, (int)blockIdx.x);
    pg8::gemm_phase<Epi, pg8::DenseOrder, true, false>(F.lds, K, lda, S, E, nullptr, TID_);
}

__global__ void __launch_bounds__(NWAVES * 64, 2) mk_fwd(Args args) {
    extern __shared__ __attribute__((aligned(16))) unsigned char lds[];
    Frame F;
    F.lds = (LAS unsigned char*)lds;
    F.MISC = (volatile LAS unsigned*)(F.lds + MISC_OFF);
    { int w_ = __builtin_amdgcn_readfirstlane((int)threadIdx.x >> 6); asm volatile("" : "+s"(w_)); F.wave = w_; }
    F.G = gridDim.x; { const int bx = blockIdx.x; F.vcu = (F.G % 8 == 0) ? (bx % 8) * (F.G / 8) + bx / 8 : bx; }
    F.ctl = (gu32*)(KARGS->ws + WS_CTL);
    for (int u = TID_; u < (LDS_BYTES - LDSCTL_OFF) / 4; u += NWAVES * 64) ((LAS unsigned*)(F.lds + LDSCTL_OFF))[u] = 0u;
    __syncthreads();
    {
        LAS float* tb = (LAS float*)(F.lds + TB_OFF); const int h = TID_ >> 7, i = TID_ & 127;
        const float* rb = KARGS->in.rel_bias;
        tb[h * 128 + i] = (rb[t5_bucket(i) * 4 + h] - rb[31 * 4 + h]) * 1.4426950408889634f;
    }
    __syncthreads();
    const int lo = KARGS->ph_lo, hi = KARGS->ph_hi;
    const bool multi = (hi - lo) > 1;
    XcdBarrier bar; bar.bar = (unsigned*)(F.ctl + CW_BAR); bar.x = 0; bar.st = nullptr;
    if (multi) bar = xcd_barrier_post((unsigned*)(F.ctl + CW_BAR), F.MISC + 8, TID_ == 0);
#define IN(k) (lo <= (k) && (k) < hi)
#define PH_BEGIN_ unsigned char* ws = KARGS->ws; bf16* X = (bf16*)KARGS->out; float* OUT = KARGS->out; (void)OUT; bf16* GB2 = (bf16*)KARGS->out + (size_t)T * 1024; (void)GB2; In I; load_in(I); (void)X; WSPTRS
#define SEAM(k) do { if (IN(k) && IN((k) + 1)) xcd_barrier(bar, TID_ == 0); } while (0)

    if (IN(0)) { PH_BEGIN_ prep_dense_weights(F, I, ws); prep_layer_weights(F, I, ws, 0); norm_pass<false>(F, I.x, I.norm_mix, H0);
#ifdef DUP_PREP
        __syncthreads(); prep_dense_weights(F, I, ws); prep_layer_weights(F, I, ws, 0);
#endif
    } SEAM(0);
    if (IN(1)) { PH_BEGIN_ pg8::EpiBf16 E{QKV, 512, 512, (size_t)T * 512, attn_body::C2}; dense_gemm(F, H0, 1024, ws + WS_WIN, 1024, T, AB_IN, E); } SEAM(1);
    if (IN(2)) { PH_BEGIN_ lru_agg_mfma(F, I, QKV + 3 * (size_t)T * 512, AGG, (bf16*)(ws + WS_HL), (bf16*)(ws + WS_CA)); } SEAM(2);
    if (IN(3)) { PH_BEGIN_
        const attn_body::AttnTensors AT{(const attn_body::bf16*)QKV, (const attn_body::bf16*)(QKV + (size_t)T * 512), (const attn_body::bf16*)(QKV + 2 * (size_t)T * 512), (attn_body::bf16*)OB};
        if (F.G == 256) attn_body::attn_phase<8>((char*)lds, AT, F.vcu, (const LAS float*)(F.lds + TB_OFF), (int)threadIdx.x);
#ifdef DUP_ATTN
        __syncthreads(); if (F.G == 256) attn_body::attn_phase<8>((char*)lds, AT, F.vcu, (const LAS float*)(F.lds + TB_OFF), (int)threadIdx.x);
#endif
        __syncthreads();
        lru_final_pass(F, (const bf16*)(ws + WS_HL), (const bf16*)(ws + WS_CA), QKV + 4 * (size_t)T * 512, AGG, H0);
    } SEAM(3);
    if (IN(4)) { PH_BEGIN_ diff_combine_pass(F, I, OB, H0); } SEAM(4);
    if (IN(5)) { PH_BEGIN_ pg8::EpiResX<false> E{I.x, X}; dense_gemm(F, H0, 1024, ws + WS_WOUT, 1024, T, 1024, E); } SEAM(5);

#define MOE_PLE_PHASES(P, L) \
    if (IN(P + 0)) { PH_BEGIN_ norm_pass<true>(F, X, I.norm_ffn + (L) * 1024, H2); } SEAM(P + 0); \
    if (IN(P + 1)) { PH_BEGIN_ pg8::EpiRouter E{LOG}; dense_gemm(F, H2, 1024, ws + WS_ROUT + (size_t)(L) * 256 * 1024 * 2, 1024, T, 256, E); } SEAM(P + 1); \
    if (IN(P + 2)) { PH_BEGIN_ route_pass_a(F, I, (L), LOG, RTE, F.ctl + ((L) ? CW_CNT1 : CW_CNT0)); } SEAM(P + 2); \
    if (IN(P + 3)) { PH_BEGIN_ route_pass_b(F, RTE, F.ctl + ((L) ? CW_CNT1 : CW_CNT0)); } SEAM(P + 3); \
    if (IN(P + 4)) { PH_BEGIN_ route_bases(F, F.ctl + ((L) ? CW_CNT1 : CW_CNT0)); const LAS int* eb = (const LAS int*)(F.lds + RTE_OFF + 512); \
        MoeOrder S{F.G, (int)blockIdx.x, __builtin_amdgcn_readfirstlane(eb[32] >> 8), eb, (const char*)H2, (const char*)(ws + WS_MGU), 0, (size_t)1024 * 1024 * 2, (size_t)256 * 1024 * 2, true}; pg8::EpiGU E{HID}; \
        pg8::gemm_phase<pg8::EpiGU, MoeOrder, true, true>(F.lds, 1024, 1024, S, E, (const int*)(RTE + RT_ROWTOK), TID_); } SEAM(P + 4); \
    if (IN(P + 5)) { PH_BEGIN_ route_bases(F, F.ctl + ((L) ? CW_CNT1 : CW_CNT0)); const LAS int* eb = (const LAS int*)(F.lds + RTE_OFF + 512); \
        MoeOrder S{F.G, (int)blockIdx.x, __builtin_amdgcn_readfirstlane(eb[32] >> 8), eb, (const char*)HID, (const char*)(ws + WS_MDN), (size_t)256 * 512 * 2, (size_t)1024 * 512 * 2, (size_t)256 * 512 * 2, false}; pg8::EpiDown E{YS, (const float*)(RTE + RT_ROWGATE)}; \
        pg8::gemm_phase<pg8::EpiDown, MoeOrder, true, false>(F.lds, 512, 512, S, E, nullptr, TID_); } SEAM(P + 5); \
    if (IN(P + 6)) { PH_BEGIN_ combine_norm_pass(F, X, X, YS, (const int*)(RTE + RT_SLOT), I.ple_norm + (L) * 1024, H2); __syncthreads(); \
          \
        { pg8::EpiBf16 E{PP, 1024, 0, 0, 1.f}; dense_gemm(F, ws + WS_PB, 256, ws + WS_PPROJ + (size_t)(L) * 1024 * 256 * 2, 256, T, 1024, E); } } SEAM(P + 6); \
    if (IN(P + 8)) { PH_BEGIN_ pg8::EpiPle E{X, (L) ? (bf16*)(ws + WS_YS) : X, PP}; dense_gemm(F, H2, 1024, ws + WS_PGATE + (size_t)(L) * 1024 * 1024 * 2, 1024, T, 1024, E); } SEAM(P + 8);

    MOE_PLE_PHASES(6, 0)
    if (IN(15)) { PH_BEGIN_ rwkv_input_pass(F, X, I.norm_mix + 1024, I.rwkv_mu, HCAT, XRB, XKB, XVB); } SEAM(15);
    if (IN(16)) { PH_BEGIN_ { pg8::EpiBf16 E{RB, 1024, 0, 0, 1.f}; dense_gemm(F, XRB, 1024, ws + WS_RCAT, 1024, T, 1024, E); }
        { pg8::EpiMid E{MID}; dense_gemm(F, HCAT, 2048, ws + WS_RL1, 2048, T, 512, E); } } SEAM(16);
    if (IN(17)) { PH_BEGIN_ { pg8::EpiBf16 E{KB, 1024, 0, 0, 1.f}; dense_gemm(F, XKB, 1024, ws + WS_RCAT + (size_t)1024 * 1024 * 2, 1024, T, 1024, E); }
        { pg8::EpiRwkv2 E{EWB, AAB, I.rwkv_w0, I.rwkv_a0, 0}; dense_gemm(F, MID, 512, ws + WS_RS2, 256, T, 2048, E); } } SEAM(17);
    if (IN(18)) { PH_BEGIN_ pg8::EpiBf16 E{VB, 1024, 0, 0, 1.f}; dense_gemm(F, XVB, 1024, ws + WS_RCAT + (size_t)2 * 1024 * 1024 * 2, 1024, T, 1024, E); } SEAM(18);
    if (IN(20)) { PH_BEGIN_
        if (F.G == 256 && blockIdx.x >= 128) {
            Frame F2 = F; F2.G = 128; F2.vcu = (int)blockIdx.x - 128;
#ifdef HELP_STAMP
            const unsigned long long hs0_ = __builtin_amdgcn_s_memtime();
#endif
            prep_layer_weights(F2, I, ws, 1);
            __syncthreads();
            pg8::EpiRwkv2 E{GB2, GB2, nullptr, nullptr, 2}; pg8::DenseOrder S; S.init(MID + 256, 512, ws + WS_RS2 + (size_t)2 * 1024 * 256 * 2, 256, T, 1024, 128, (int)blockIdx.x - 128);
            pg8::gemm_phase<pg8::EpiRwkv2, pg8::DenseOrder, true, false>(F.lds, 256, 512, S, E, nullptr, TID_);
            static_assert(CH_NP == 4, "the y hand-off below counts 64-token rounds");
            asm volatile("s_waitcnt vmcnt(0)" ::: "memory"); __syncthreads();
            {
                const __attribute__((address_space(4))) Args* ka = KARGS; asm volatile("" : "+s"(ka));
                unsigned char* ws2 = ka->ws; bf16* G2 = (bf16*)ka->out + (size_t)T * 1024; gu32* ctl2 = (gu32*)(ws2 + WS_CTL);
                In I2; I2.rwkv_ka = ka->in.rwkv_ka; I2.rwkv_rk = ka->in.rwkv_rk; I2.rwkv_ln_g = ka->in.rwkv_ln_g; I2.rwkv_ln_b = ka->in.rwkv_ln_b;
                if (TID_ == 0) { __builtin_amdgcn_fence(__ATOMIC_RELEASE, "agent"); asm volatile("s_waitcnt vmcnt(0)" ::: "memory"); __hip_atomic_fetch_add(ctl2 + CW_GDONE, 1u, __ATOMIC_RELAXED, __HIP_MEMORY_SCOPE_AGENT);
                    while (__hip_atomic_load(ctl2 + CW_GDONE, __ATOMIC_RELAXED, __HIP_MEMORY_SCOPE_AGENT) < 128u) __builtin_amdgcn_s_sleep(8);
                    __builtin_amdgcn_fence(__ATOMIC_ACQUIRE, "agent"); }
                __syncthreads();
                const int hb = ((int)blockIdx.x - 128) >> 4, hs = ((int)blockIdx.x - 128) & 15;
                for (int rd = hs; rd < CH_ROUNDS; rd += 16) {
                    if (TID_ == 0) { const gu32* pw = ctl2 + CW_PROG + hb * CH_ROUNDS + rd;
                        while (__hip_atomic_load(pw, __ATOMIC_RELAXED, __HIP_MEMORY_SCOPE_AGENT) < 16u) __builtin_amdgcn_s_sleep(8);
                        __builtin_amdgcn_fence(__ATOMIC_ACQUIRE, "agent"); }
                    __syncthreads();
                    const int tb = hb * SEQ + rd * 64;
                    rwkv_post_pass(F, I2, (const bf16*)(ws2 + WS_R), (const bf16*)(ws2 + WS_K), (const bf16*)(ws2 + WS_V), (const bf16*)(ws2 + WS_AA), G2, (bf16*)(ws2 + WS_Y), tb + 2 * F.wave, tb + 64, 2 * NWAVES);
                    asm volatile("s_waitcnt vmcnt(0)" ::: "memory"); __syncthreads(); } }
        } else rwkv_scan_chunked(F, I, RB, KB, VB, AAB, EWB, YB, (gu32*)(ws + WS_CTL) + CW_PROG);
    } SEAM(20);
    if (IN(23)) { PH_BEGIN_ pg8::EpiResX<true> E{X, X}; dense_gemm(F, YB, 1024, ws + WS_RWO, 1024, T, 1024, E); } SEAM(23);
    MOE_PLE_PHASES(24, 1)
    if (IN(33)) { PH_BEGIN_ final_norm_pass(F, (const bf16*)(ws + WS_YS), OUT, I.final_norm); }
#undef IN
#undef SEAM
}

extern "C" void kernel_launch(void* const* d_in, const int* in_sizes, int n_in, void* d_out, int out_size, void* d_ws, size_t ws_size, hipStream_t stream) {
    static int ok = 0;
    if (ok == 0) {
        if (n_in != 47 || out_size != T * D || ws_size < WS_END) { fprintf(stderr, "kernel_launch: unexpected problem shape (n_in %d out %d ws %zu)\n", n_in, out_size, ws_size); ok = -1; return; }
        if (hipFuncSetAttribute((const void*)mk_fwd, hipFuncAttributeMaxDynamicSharedMemorySize, LDS_BYTES) != hipSuccess) { fprintf(stderr, "kernel_launch: hipFuncSetAttribute failed\n"); ok = -1; return; }
        int per_cu = 0;
        if (hipOccupancyMaxActiveBlocksPerMultiprocessor(&per_cu, (const void*)mk_fwd, NWAVES * 64, LDS_BYTES) != hipSuccess || per_cu < 1) fprintf(stderr, "kernel_launch: occupancy query reports %d\n", per_cu);
        (void)hipGetLastError();
        ok = 1;
    }
    if (ok < 0) return;
    (void)hipMemsetAsync((char*)d_ws + WS_CTL, 0, CTL_ZERO_BYTES, stream);
    Args a{};
    const float** ip = (const float**)&a.in;
    for (int i = 0; i < 47; ++i) ip[i] = (const float*)d_in[i];
    a.out = (float*)d_out; a.ws = (unsigned char*)d_ws;
    const int grid = 256;
#if MK_ONE_LAUNCH
    a.ph_lo = 0; a.ph_hi = N_PHASES;
    hipLaunchKernelGGL(mk_fwd, dim3(grid), dim3(NWAVES * 64), LDS_BYTES, stream, a);
#else
    for (int k = 0; k < N_PHASES; ++k) { a.ph_lo = k; a.ph_hi = k + 1; hipLaunchKernelGGL(mk_fwd, dim3(grid), dim3(NWAVES * 64), LDS_BYTES, stream, a);
        if (k == DUP_K || k == DUP_K2) hipLaunchKernelGGL(mk_fwd, dim3(grid), dim3(NWAVES * 64), LDS_BYTES, stream, a); }
#endif
}
```

```cpp
#include <hip/hip_runtime.h>
#include <hip/hip_bf16.h>
#include <cstdio>
#include <cstdint>
#include <cmath>

#ifndef MK_ONE_LAUNCH
#define MK_ONE_LAUNCH 1
#endif

#define GAS __attribute__((address_space(1)))
#define LAS __attribute__((address_space(3)))
typedef unsigned short bf16;
typedef unsigned v4u __attribute__((ext_vector_type(4)));
typedef unsigned v2u __attribute__((ext_vector_type(2)));
typedef float f32x4 __attribute__((ext_vector_type(4)));
typedef float f32x2 __attribute__((ext_vector_type(2)));
typedef short bf16x8 __attribute__((ext_vector_type(8)));
typedef GAS unsigned gu32;
#define RLX_AGENT __ATOMIC_RELAXED, __HIP_MEMORY_SCOPE_AGENT
#define LDS_WAIT() asm volatile("s_waitcnt lgkmcnt(0)" ::: "memory")
#define VM_WAIT() asm volatile("s_waitcnt vmcnt(0)" ::: "memory")
__device__ __forceinline__ unsigned f2bf(float f) { unsigned u = __builtin_bit_cast(unsigned, f); return (u + 0x7fffu + ((u >> 16) & 1u)) >> 16; }
typedef float f32x2_cv __attribute__((ext_vector_type(2))); typedef __bf16 bf16x2_cv __attribute__((ext_vector_type(2)));
__device__ __forceinline__ unsigned pk2(float lo, float hi) { const f32x2_cv v = {lo, hi}; const bf16x2_cv b = __builtin_convertvector(v, bf16x2_cv); return __builtin_bit_cast(unsigned, b); }
__device__ __forceinline__ float bflo(unsigned w) { return __uint_as_float(w << 16); }
__device__ __forceinline__ float bfhi(unsigned w) { return __uint_as_float(w & 0xffff0000u); }
__device__ __forceinline__ float bf1(bf16 h) { return __uint_as_float((unsigned)h << 16); }
__device__ __forceinline__ float sigmoidf_(float x) { return __builtin_amdgcn_rcpf(1.0f + __builtin_amdgcn_exp2f(-1.4426950408889634f * x)); }
__device__ __forceinline__ float tanhf_(float x) { return 1.0f - 2.0f * __builtin_amdgcn_rcpf(1.0f + __builtin_amdgcn_exp2f(2.885390081777927f * x)); }
__device__ __forceinline__ void fmac_(float& acc, float a, float b) { asm("v_fmac_f32 %0, %1, %2" : "+v"(acc) : "v"(a), "v"(b)); }
__device__ __forceinline__ float fma_(float a, float b, float c) { float r; asm("v_fma_f32 %0, %1, %2, %3" : "=v"(r) : "v"(a), "v"(b), "v"(c)); return r; }
__device__ __forceinline__ float mul_(float a, float b) { float r; asm("v_mul_f32 %0, %1, %2" : "=v"(r) : "v"(a), "v"(b)); return r; }
__device__ __forceinline__ float wave_sum(float v) {
#pragma unroll
    for (int o = 1; o < 64; o <<= 1) v += __shfl_xor(v, o);
    return v;
}

constexpr int NB = 8, SEQ = 8192, D = 1024, T = NB * SEQ;
constexpr int AB_IN = 2560, PLE = 256;
constexpr int NEXP = 32, EH = 512;
constexpr int MAXSLOT = 2 * T + NEXP * 256;
constexpr int MAXTILES = MAXSLOT / 256;

namespace pg8 {
#define PG8_LAS __attribute__((address_space(3)))
typedef unsigned short bf16_t;
typedef unsigned u32x4 __attribute__((ext_vector_type(4)));
typedef unsigned u32x2 __attribute__((ext_vector_type(2)));
constexpr int BM = 256, BK = 64, HALF = 128, HTB = HALF * BK * 2, STAGE_BYTES = 8 * HTB, NXCD = 8, WGM = 8;
__host__ __device__ __forceinline__ int lds_byte(int r, int c) { const int st = (r >> 4) * 2 + (c >> 5), rr = r & 15, cc = c & 31, ob = rr * 64 + cc * 2; return st * 1024 + (ob ^ (((ob >> 9) & 1) << 5)); }
__host__ __device__ __forceinline__ void stage_rc(int b, int& R, int& C) { const int st = b / 1024, sb = b % 1024, swz = sb ^ (((sb >> 9) & 1) << 5); R = (st >> 1) * 16 + swz / 64; C = (st & 1) * 32 + (swz % 64) / 2; }
__host__ __device__ __forceinline__ int perm32(int rho) { const int n = rho >> 4, i = rho & 15; return 8 * (i >> 2) + 4 * n + (i & 3); }

struct Unit { int pm, pn, aux; const char* A; const char* B; };

struct DenseOrder {
    int nM, nN, nwg, G, c; const char* A; const char* B; size_t astep, bstep;
    __device__ void init(const void* A_, int lda, const void* B_, int K, int M, int N, int G_, int c_) { nM = M / BM; nN = N / BM; nwg = nM * nN; G = G_; c = c_; A = (const char*)A_; B = (const char*)B_; astep = (size_t)BM * lda * 2; bstep = (size_t)BM * K * 2; }
    __device__ bool next(int i, Unit& u) const {
        const long L = (long)i * G + c; if (L >= nwg) return false;
        int wgid = (int)L; { const int q = nwg / NXCD, r = nwg % NXCD, xcd = wgid % NXCD, off = wgid / NXCD; wgid = (xcd < r ? xcd * (q + 1) : r * (q + 1) + (xcd - r) * q) + off; }
        const int nig = WGM * nN, gid = wgid / nig, fm = gid * WGM, gsz = (nM - fm) < WGM ? (nM - fm) : WGM;
        u.pm = fm + ((wgid % nig) % gsz); u.pn = (wgid % nig) / gsz; u.aux = 0; u.A = A + (size_t)u.pm * astep; u.B = B + (size_t)u.pn * bstep; return true;
    }
};

__device__ __forceinline__ unsigned cvt_pk_bf16(float lo, float hi) { unsigned r; asm volatile("v_cvt_pk_bf16_f32 %0, %1, %2" : "=v"(r) : "v"(lo), "v"(hi)); return r; }

typedef f32x4 Acc[2][2][4][2];

struct EpiBf16 {
    static constexpr bool PERM = true;
    bf16_t* O; int ldc; int split_cols; size_t split_stride; float scale0;
    __device__ __forceinline__ void operator()(const Acc& acc, const Unit& u, int wr, int wc, int fr, int fq) const {
        const int row0 = u.pm * BM + wr * 64 + fr; int colt = u.pn * BM; bf16_t* base = O;
        float sc = 1.f; if (split_cols) { const int t = colt / split_cols; base += (size_t)t * split_stride; colt -= t * split_cols; if (t == 0) sc = scale0; }
        const int col0 = colt + wc * 32 + 8 * fq;
#pragma unroll
        for (int ai = 0; ai < 2; ++ai)
#pragma unroll
            for (int m = 0; m < 4; ++m) { bf16_t* rowp = base + (size_t)(row0 + ai * HALF + m * 16) * ldc + col0;
#pragma unroll
                for (int bj = 0; bj < 2; ++bj) { f32x4 v0 = acc[ai][bj][m][0] * sc, v1 = acc[ai][bj][m][1] * sc;
                    u32x4 w; w.x = cvt_pk_bf16(v0[0], v0[1]); w.y = cvt_pk_bf16(v0[2], v0[3]); w.z = cvt_pk_bf16(v1[0], v1[1]); w.w = cvt_pk_bf16(v1[2], v1[3]);
                    *(u32x4*)(rowp + bj * HALF) = w; } }
    }
};
__device__ __forceinline__ void unpack8f(const u32x4 w, f32x4& lo, f32x4& hi) { lo = (f32x4){bflo(w.x), bfhi(w.x), bflo(w.y), bfhi(w.y)}; hi = (f32x4){bflo(w.z), bfhi(w.z), bflo(w.w), bfhi(w.w)}; }
template <bool BASE_BF16>
struct EpiResX {
    static constexpr bool PERM = true;
    const void* base; bf16_t* out; float* ss;
    __device__ __forceinline__ void operator()(const Acc& acc, const Unit& u, int wr, int wc, int fr, int fq) const {
        const int col0 = u.pn * BM + wc * 32 + 8 * fq; GAS bf16_t* op = (GAS bf16_t*)out;
#pragma unroll
        for (int ai = 0; ai < 2; ++ai) {
            f32x4 b0[4][2], b1[4][2];
#pragma unroll
            for (int m = 0; m < 4; ++m) { const size_t off = (size_t)(u.pm * BM + ai * HALF + wr * 64 + m * 16 + fr) * 1024 + col0;
#pragma unroll
                for (int bj = 0; bj < 2; ++bj) {
                    if (BASE_BF16) { const u32x4 w = *(const GAS u32x4*)((const GAS bf16_t*)base + off + bj * HALF); unpack8f(w, b0[m][bj], b1[m][bj]); }
                    else { b0[m][bj] = *(const GAS f32x4*)((const GAS float*)base + off + bj * HALF); b1[m][bj] = *(const GAS f32x4*)((const GAS float*)base + off + bj * HALF + 4); } } }
            asm volatile("" ::: "memory");
#pragma unroll
            for (int m = 0; m < 4; ++m) { const int row = u.pm * BM + ai * HALF + wr * 64 + m * 16 + fr; const size_t off = (size_t)row * 1024 + col0; float sq = 0.f;
#pragma unroll
                for (int bj = 0; bj < 2; ++bj) { const f32x4 v0 = b0[m][bj] + acc[ai][bj][m][0], v1 = b1[m][bj] + acc[ai][bj][m][1];
#pragma unroll
                    for (int e = 0; e < 4; ++e) sq += v0[e] * v0[e] + v1[e] * v1[e];
                    u32x4 w; w.x = cvt_pk_bf16(v0[0], v0[1]); w.y = cvt_pk_bf16(v0[2], v0[3]); w.z = cvt_pk_bf16(v1[0], v1[1]); w.w = cvt_pk_bf16(v1[2], v1[3]);
                    *(GAS u32x4*)(op + off + bj * HALF) = w; }
                sq += __shfl_xor(sq, 16); sq += __shfl_xor(sq, 32);
                if (fq == 0) ((GAS float*)ss)[(size_t)row * 16 + u.pn * 4 + wc] = sq; }
            asm volatile("" ::: "memory");
        }
    }
};
struct EpiRouter {
    static constexpr bool PERM = false;
    float* out;
    __device__ __forceinline__ void operator()(const Acc& acc, const Unit& u, int wr, int wc, int fr, int fq) const {
        if (wc >= 2) return;
#pragma unroll
        for (int ai = 0; ai < 2; ++ai)
#pragma unroll
            for (int m = 0; m < 4; ++m) { const size_t off = (size_t)(u.pm * BM + ai * HALF + wr * 64 + m * 16 + fr) * 64 + wc * 32 + 4 * fq;
#pragma unroll
                for (int n = 0; n < 2; ++n) *(f32x4*)(out + off + n * 16) = acc[ai][0][m][n]; }
    }
};
struct EpiGU {
    static constexpr bool PERM = true;
    bf16_t* H; const float* rstd;
    __device__ __forceinline__ void operator()(const Acc& acc, const Unit& u, int wr, int wc, int fr, int fq) const {
        const int col0 = u.pn * 128 + wc * 32 + 8 * fq;
#pragma unroll
        for (int ai = 0; ai < 2; ++ai)
#pragma unroll
            for (int m = 0; m < 4; ++m) { const int row = u.pm * BM + ai * HALF + wr * 64 + m * 16 + fr; const float rs = rstd[row]; bf16_t* rowp = H + (size_t)row * EH + col0;
                f32x4 g0 = acc[ai][0][m][0] * rs, g1 = acc[ai][0][m][1] * rs; const f32x4 u0 = acc[ai][1][m][0] * rs, u1 = acc[ai][1][m][1] * rs;
#pragma unroll
                for (int e = 0; e < 4; ++e) { g0[e] = g0[e] * sigmoidf_(g0[e]) * u0[e]; g1[e] = g1[e] * sigmoidf_(g1[e]) * u1[e]; }
                u32x4 w; w.x = cvt_pk_bf16(g0[0], g0[1]); w.y = cvt_pk_bf16(g0[2], g0[3]); w.z = cvt_pk_bf16(g1[0], g1[1]); w.w = cvt_pk_bf16(g1[2], g1[3]);
                *(u32x4*)rowp = w; }
    }
};
struct EpiDown {
    static constexpr bool PERM = true;
    bf16_t* Y; const float* gate;
    __device__ __forceinline__ void operator()(const Acc& acc, const Unit& u, int wr, int wc, int fr, int fq) const {
        const int col0 = u.pn * BM + wc * 32 + 8 * fq;
#pragma unroll
        for (int ai = 0; ai < 2; ++ai)
#pragma unroll
            for (int m = 0; m < 4; ++m) { const int row = u.pm * BM + ai * HALF + wr * 64 + m * 16 + fr; const float sc = gate[row]; bf16_t* rowp = Y + (size_t)row * 1024 + col0;
#pragma unroll
                for (int bj = 0; bj < 2; ++bj) { const f32x4 v0 = acc[ai][bj][m][0] * sc, v1 = acc[ai][bj][m][1] * sc;
                    u32x4 w; w.x = cvt_pk_bf16(v0[0], v0[1]); w.y = cvt_pk_bf16(v0[2], v0[3]); w.z = cvt_pk_bf16(v1[0], v1[1]); w.w = cvt_pk_bf16(v1[2], v1[3]);
                    *(u32x4*)(rowp + bj * HALF) = w; } }
    }
};
struct EpiPle {
    static constexpr bool PERM = true;
    const bf16_t* xin; bf16_t* xout; const bf16_t* pp;
    __device__ __forceinline__ void operator()(const Acc& acc, const Unit& u, int wr, int wc, int fr, int fq) const {
        const int col0 = u.pn * BM + wc * 32 + 8 * fq;
        const GAS bf16_t* xp = (const GAS bf16_t*)xin; GAS bf16_t* op = (GAS bf16_t*)xout; const GAS bf16_t* pq = (const GAS bf16_t*)pp;
#pragma unroll
        for (int ai = 0; ai < 2; ++ai) {
            u32x4 xw[4][2], pw[4][2];
#pragma unroll
            for (int m = 0; m < 4; ++m) { const size_t off = (size_t)(u.pm * BM + ai * HALF + wr * 64 + m * 16 + fr) * 1024 + col0;
#pragma unroll
                for (int bj = 0; bj < 2; ++bj) { xw[m][bj] = *(const GAS u32x4*)(xp + off + bj * HALF); pw[m][bj] = *(const GAS u32x4*)(pq + off + bj * HALF); } }
            asm volatile("" ::: "memory");
#pragma unroll
            for (int m = 0; m < 4; ++m) { const size_t off = (size_t)(u.pm * BM + ai * HALF + wr * 64 + m * 16 + fr) * 1024 + col0;
#pragma unroll
                for (int bj = 0; bj < 2; ++bj) { f32x4 x0, x1, p0, p1; unpack8f(xw[m][bj], x0, x1); unpack8f(pw[m][bj], p0, p1); const f32x4 a0 = acc[ai][bj][m][0], a1 = acc[ai][bj][m][1];
#pragma unroll
                    for (int e = 0; e < 4; ++e) { x0[e] += p0[e] * sigmoidf_(a0[e]); x1[e] += p1[e] * sigmoidf_(a1[e]); }
                    u32x4 w; w.x = cvt_pk_bf16(x0[0], x0[1]); w.y = cvt_pk_bf16(x0[2], x0[3]); w.z = cvt_pk_bf16(x1[0], x1[1]); w.w = cvt_pk_bf16(x1[2], x1[3]);
                    *(GAS u32x4*)(op + off + bj * HALF) = w; } }
            asm volatile("" ::: "memory");
        }
    }
};
struct EpiMid {
    static constexpr bool PERM = true;
    bf16_t* MID;
    __device__ __forceinline__ void operator()(const Acc& acc, const Unit& u, int wr, int wc, int fr, int fq) const {
        const int row0 = u.pm * BM + wr * 64 + fr;
        const int mode = (u.pn == 1) ? 2 : 0; const int colbase = u.pn * 256;
#pragma unroll
        for (int ai = 0; ai < 2; ++ai)
#pragma unroll
            for (int m = 0; m < 4; ++m) { bf16_t* rowp = MID + (size_t)(row0 + ai * HALF + m * 16) * 512 + colbase;
#pragma unroll
                for (int bj = 0; bj < 2; ++bj) { const int lc = bj * HALF + wc * 32 + 8 * fq; f32x4 v0 = acc[ai][bj][m][0], v1 = acc[ai][bj][m][1];
#pragma unroll
                    for (int e = 0; e < 4; ++e) {
                        if (mode == 2) { v0[e] = sigmoidf_(v0[e]); v1[e] = sigmoidf_(v1[e]); }
                        else if (lc < 64) { v0[e] = tanhf_(v0[e]); v1[e] = tanhf_(v1[e]); } }
                    u32x4 w; w.x = cvt_pk_bf16(v0[0], v0[1]); w.y = cvt_pk_bf16(v0[2], v0[3]); w.z = cvt_pk_bf16(v1[0], v1[1]); w.w = cvt_pk_bf16(v1[2], v1[3]);
                    *(u32x4*)(rowp + lc) = w; } }
    }
};
struct EpiRwkv2 {
    static constexpr bool PERM = true;
    bf16_t* O0; bf16_t* O1; const float* bias0; const float* bias1; int tybase;
    __device__ __forceinline__ void operator()(const Acc& acc, const Unit& u, int wr, int wc, int fr, int fq) const {
        const int ty = tybase + (u.pn >> 2); const int row0 = u.pm * BM + wr * 64 + fr; const int colt = (u.pn & 3) * BM + wc * 32 + 8 * fq;
        bf16_t* base = (u.pn >> 2) ? O1 : O0; const float* bias = (u.pn >> 2) ? bias1 : bias0;
#pragma unroll
        for (int bj = 0; bj < 2; ++bj) {
            f32x4 b0 = (f32x4){0.f, 0.f, 0.f, 0.f}, b1 = b0;
            if (ty < 2) { b0 = *(const f32x4*)(bias + colt + bj * HALF); b1 = *(const f32x4*)(bias + colt + bj * HALF + 4); }
#pragma unroll
            for (int ai = 0; ai < 2; ++ai)
#pragma unroll
                for (int m = 0; m < 4; ++m) { bf16_t* rowp = base + (size_t)(row0 + ai * HALF + m * 16) * 1024 + colt + bj * HALF;
                    f32x4 v0 = acc[ai][bj][m][0] + b0, v1 = acc[ai][bj][m][1] + b1;
                    if (ty < 2) { const float s = (ty == 0) ? 0.6065306597126334f * 1.4426950408889634f : 1.0f;
#pragma unroll
                        for (int e = 0; e < 4; ++e) { v0[e] = s * sigmoidf_(v0[e]); v1[e] = s * sigmoidf_(v1[e]); } }
                    u32x4 w; w.x = cvt_pk_bf16(v0[0], v0[1]); w.y = cvt_pk_bf16(v0[2], v0[3]); w.z = cvt_pk_bf16(v1[0], v1[1]); w.w = cvt_pk_bf16(v1[2], v1[3]);
                    *(u32x4*)rowp = w; }
        }
    }
};

template <class Epi, class Sched, bool ALIGN_EPI, bool GATHER>
__device__ __forceinline__ void gemm_phase(PG8_LAS unsigned char* lds, const int K, const int lda, const Sched& S, const Epi& E, const int* __restrict__ rows, const int tid) {
    const int wid = __builtin_amdgcn_readfirstlane(tid >> 6), lane = tid & 63, wr = wid >> 2, wc = wid & 3, fr = lane & 15, fq = lane >> 4;
    const int nt = K / BK;
    unsigned voffA[2], voffB[2]; int RA[2];
#pragma unroll
    for (int i = 0; i < 2; ++i) { int R, C; stage_rc(tid * 16 + i * 8192, R, C); const int Rb = Epi::PERM ? ((R & ~31) + perm32(R & 31)) : R;
        RA[i] = R; voffA[i] = GATHER ? (unsigned)(C * 2) : (unsigned)(R * lda + C) * 2u; voffB[i] = (unsigned)(Rb * K + C) * 2u; }
    const size_t kstep = (size_t)(BK * 2);
    const size_t hstepA = GATHER ? 0 : (size_t)HALF * lda * 2, hstepB = (size_t)HALF * K * 2;
    const unsigned ldsw = (unsigned)wid * 1024u;
    const int aoff = lds_byte(wr * 64 + fr, fq * 8), boff = lds_byte(wc * 32 + fr, fq * 8);
#define PG8_SA(b, h) (((b) * 2 + (h)) * HTB)
#define PG8_SB(b, h) ((4 + (b) * 2 + (h)) * HTB)
#define PG8_ST2(bufoff, gbase, o0, o1) do { \
        __builtin_amdgcn_global_load_lds((const unsigned*)((const char*)(gbase) + (o0)), (PG8_LAS unsigned*)(lds + (bufoff) + ldsw), 16, 0, 0); \
        __builtin_amdgcn_global_load_lds((const unsigned*)((const char*)(gbase) + (o1)), (PG8_LAS unsigned*)(lds + (bufoff) + ldsw + 8192), 16, 0, 0); } while (0)
#define PG8_STB(bufoff, gbase) PG8_ST2(bufoff, gbase, voffB[0], voffB[1])
#define PG8_STA(bufoff, p, h, nx) do { if constexpr (GATHER) { const unsigned g0_ = (nx) ? gN[h][0] : gC[h][0], g1_ = (nx) ? gN[h][1] : gC[h][1]; PG8_ST2(bufoff, p, g0_, g1_); } \
        else { PG8_ST2(bufoff, (p) + (h) * hstepA, voffA[0], voffA[1]); } } while (0)
#define PG8_LDA(dst, b, h) do { _Pragma("unroll") for (int m = 0; m < 4; ++m) _Pragma("unroll") for (int k = 0; k < 2; ++k) dst[m][k] = *(const PG8_LAS bf16x8*)(lds + PG8_SA(b, h) + aoff + m * 2048 + k * 1024); } while (0)
#define PG8_LDB(dst, b, h) do { _Pragma("unroll") for (int n = 0; n < 2; ++n) _Pragma("unroll") for (int k = 0; k < 2; ++k) dst[n][k] = *(const PG8_LAS bf16x8*)(lds + PG8_SB(b, h) + boff + n * 2048 + k * 1024); } while (0)
#define PG8_MMA(ai, bj, At, Bt) do { __builtin_amdgcn_s_setprio(1); _Pragma("unroll") for (int m = 0; m < 4; ++m) _Pragma("unroll") for (int n = 0; n < 2; ++n) _Pragma("unroll") for (int k = 0; k < 2; ++k) \
        acc[ai][bj][m][n] = __builtin_amdgcn_mfma_f32_16x16x32_bf16(Bt[n][k], At[m][k], acc[ai][bj][m][n], 0, 0, 0); __builtin_amdgcn_s_setprio(0); } while (0)
#define PG8_WAIT_V(n) asm volatile("s_waitcnt vmcnt(" #n ")" ::: "memory")
#define PG8_WAIT_L(n) asm volatile("s_waitcnt lgkmcnt(" #n ")" ::: "memory")
#define PG8_BAR __builtin_amdgcn_s_barrier()
#define PG8_SCHED __builtin_amdgcn_sched_barrier(0)
#define PG8_GLOAD(dst, un) do { if constexpr (GATHER) { _Pragma("unroll") for (int h_ = 0; h_ < 2; ++h_) _Pragma("unroll") for (int i_ = 0; i_ < 2; ++i_) \
        dst[h_][i_] = (unsigned)rows[(un).pm * BM + h_ * HALF + RA[i_]] * (unsigned)(lda * 2) + voffA[i_]; } } while (0)
    Unit cur, nxt; int ui = 0;
    if (!S.next(0, cur)) return;
    unsigned gC[2][2] = {{0u, 0u}, {0u, 0u}}, gN[2][2] = {{0u, 0u}, {0u, 0u}};
    PG8_GLOAD(gC, cur);
    Acc acc;
#pragma unroll
    for (int a = 0; a < 2; ++a)
#pragma unroll
        for (int b = 0; b < 2; ++b)
#pragma unroll
            for (int m = 0; m < 4; ++m)
#pragma unroll
                for (int n = 0; n < 2; ++n) acc[a][b][m][n] = (f32x4){0.f, 0.f, 0.f, 0.f};
    bf16x8 At[4][2], B0[2][2], B1[2][2];
    const char* cA = cur.A; const char* cB = cur.B;
    PG8_STB(PG8_SB(0, 0), cB); PG8_STB(PG8_SB(0, 1), cB + hstepB); PG8_STA(PG8_SA(0, 0), cA, 0, false); PG8_STA(PG8_SA(0, 1), cA, 1, false);
    if (wr == 1) PG8_BAR;
    PG8_WAIT_V(2); PG8_BAR;
    PG8_STB(PG8_SB(1, 0), cB + kstep); PG8_STA(PG8_SA(1, 0), cA + kstep, 0, false); PG8_STB(PG8_SB(1, 1), cB + hstepB + kstep);
    PG8_WAIT_V(6); PG8_BAR;
    for (;;) {
        const bool has_next = S.next(ui + 1, nxt);
        if (has_next) { PG8_GLOAD(gN, nxt); }
        const char* nA = has_next ? nxt.A : cA; const char* nB = has_next ? nxt.B : cB;
#pragma unroll 1
        for (int t = 0; t < nt; t += 2) {
            const bool last = (t == nt - 2); const bool nx = last && has_next;
            const char* a1 = cA + (size_t)(t + 1) * kstep;
            const char* a2 = last ? nA : cA + (size_t)(t + 2) * kstep; const char* b2 = last ? nB : cB + (size_t)(t + 2) * kstep;
            const char* a3 = a2 + kstep; const char* b3 = b2 + kstep;
            PG8_LDB(B0, 0, 0); PG8_LDB(B1, 0, 1); PG8_SCHED; PG8_LDA(At, 0, 0); PG8_STA(PG8_SA(1, 1), a1, 1, false);
            PG8_WAIT_V(8); PG8_WAIT_L(0); PG8_BAR; PG8_MMA(0, 0, At, B0); PG8_MMA(0, 1, At, B1); PG8_BAR; PG8_SCHED;
            PG8_LDA(At, 0, 1); PG8_STB(PG8_SB(0, 0), b2); PG8_STB(PG8_SB(0, 1), b2 + hstepB); PG8_STA(PG8_SA(0, 0), a2, 0, nx);
            PG8_WAIT_V(8); PG8_WAIT_L(0); PG8_BAR; PG8_MMA(1, 0, At, B0); PG8_MMA(1, 1, At, B1); PG8_BAR; PG8_SCHED;
            PG8_LDB(B0, 1, 0); PG8_LDB(B1, 1, 1); PG8_SCHED; PG8_LDA(At, 1, 0); PG8_STA(PG8_SA(0, 1), a2, 1, nx);
            PG8_WAIT_V(8); PG8_WAIT_L(0); PG8_BAR; PG8_MMA(0, 0, At, B0); PG8_MMA(0, 1, At, B1); PG8_BAR; PG8_SCHED;
            PG8_LDA(At, 1, 1); PG8_STB(PG8_SB(1, 0), b3); PG8_STB(PG8_SB(1, 1), b3 + hstepB); PG8_STA(PG8_SA(1, 0), a3, 0, nx);
            PG8_WAIT_V(8); PG8_WAIT_L(0); PG8_BAR; PG8_MMA(1, 0, At, B0); PG8_MMA(1, 1, At, B1); PG8_BAR; PG8_SCHED;
        }
        if constexpr (ALIGN_EPI) { if (wr == 0) PG8_BAR; }
        E(acc, cur, wr, wc, fr, fq);
        if (!has_next) break;
#pragma unroll
        for (int a = 0; a < 2; ++a)
#pragma unroll
            for (int b = 0; b < 2; ++b)
#pragma unroll
                for (int m = 0; m < 4; ++m)
#pragma unroll
                    for (int n = 0; n < 2; ++n) acc[a][b][m][n] = (f32x4){0.f, 0.f, 0.f, 0.f};
        cur = nxt; cA = nA; cB = nB; ++ui;
        if constexpr (GATHER) {
#pragma unroll
            for (int h_ = 0; h_ < 2; ++h_)
#pragma unroll
                for (int i_ = 0; i_ < 2; ++i_) gC[h_][i_] = gN[h_][i_]; }
        if constexpr (ALIGN_EPI) { if (wr == 1) PG8_BAR; }
    }
    PG8_WAIT_V(0);
    if constexpr (!ALIGN_EPI) { if (wr == 0) PG8_BAR; }
    PG8_BAR;
#undef PG8_SA
#undef PG8_SB
#undef PG8_ST2
#undef PG8_STB
#undef PG8_STA
#undef PG8_LDA
#undef PG8_LDB
#undef PG8_MMA
#undef PG8_WAIT_V
#undef PG8_WAIT_L
#undef PG8_BAR
#undef PG8_SCHED
#undef PG8_GLOAD
}
}
namespace attn_body {
using bf16=__hip_bfloat16;
using bf16x8=__attribute__((ext_vector_type(8)))short;
using s16x4=__attribute__((ext_vector_type(4)))short;
using f32x16=__attribute__((ext_vector_type(16)))float;
using u32x4=__attribute__((ext_vector_type(4)))unsigned;
constexpr int BATCH=8,NHEAD=16,SEQ=8192,D=64,PQ=512,PO=1024;
constexpr int NW=8,QBLK=32,QB=QBLK*NW,KVBLK=64,NQB=SEQ/QB;
constexpr int ATTN_UNIT_ROWS=QB;
__device__ __forceinline__ int crow(int r,int hi){return (r&3)+8*(r>>2)+4*hi;}
#define SBAR() __builtin_amdgcn_sched_barrier(0)
__device__ __forceinline__ void cmask(f32x16&p0,f32x16&p1,int jb,int qrel,int hi){
  const float NEG=-INFINITY; int kb=64*jb+4*hi;
  #pragma unroll
  for(int r=0;r<16;++r){int kv=kb+(r&3)+8*(r>>2); if(kv>qrel)p0[r]=NEG; if(kv+32>qrel)p1[r]=NEG;}
}

__device__ __forceinline__ void cbias(f32x16&p0,f32x16&p1,int jb,int qrel,int hi,const __attribute__((address_space(3))) float*tb){
  const int kb=64*jb+4*hi;
  #pragma unroll
  for(int r=0;r<16;++r){const int rel=qrel-(kb+(r&3)+8*(r>>2)); const int i0=min(max(rel,0),127), i1=min(max(rel-32,0),127); p0[r]+=tb[i0]; p1[r]+=tb[i1];}
}
constexpr int NSLOT=3, SLOTB=8192;
constexpr int LDS_K=0, LDS_V=NSLOT*SLOTB, LDS_WS=2*NSLOT*SLOTB, LDS_OST=LDS_WS+NW*64*4, LDS_BYTES=LDS_OST+NW*4096;
constexpr float C2=0.125f*1.4426950408889634f;
__device__ __forceinline__ void glds16(const void*gsrc,unsigned lds_dst){unsigned keep;
  asm volatile("s_mov_b32 %0, m0\n\ts_mov_b32 m0, %2\n\ts_nop 0\n\tglobal_load_lds_dwordx4 %1, off\n\ts_mov_b32 m0, %0":"=&s"(keep):"v"(gsrc),"s"(lds_dst):"memory");}
__device__ __forceinline__ float max3f(float a,float b,float c){float r;asm("v_max3_f32 %0, %1, %2, %3":"=v"(r):"v"(a),"v"(b),"v"(c));return r;}
__device__ __forceinline__ float max2f(float a,float b){float r;asm("v_max_f32_e32 %0, %1, %2":"=v"(r):"v"(a),"v"(b));return r;}
__device__ __forceinline__ float fadd_s(float a,float b){float r;asm("v_add_f32_e32 %0, %1, %2":"=v"(r):"v"(a),"v"(b));return r;}
__device__ __forceinline__ float fsub_s(float a,float b){float r;asm("v_sub_f32_e32 %0, %1, %2":"=v"(r):"v"(a),"v"(b));return r;}
typedef float f32x2_t __attribute__((ext_vector_type(2))); typedef __bf16 bf16x2_t __attribute__((ext_vector_type(2)));
__device__ __forceinline__ unsigned cvtpk_s(float lo,float hi){f32x2_t v={lo,hi};bf16x2_t b=__builtin_convertvector(v,bf16x2_t);return __builtin_bit_cast(unsigned,b);}
#define WAIT_BAR(N) asm volatile("s_waitcnt vmcnt(" #N ") lgkmcnt(0)\n\ts_barrier":::"memory")

__device__ __forceinline__ void qkt(f32x16&p0,f32x16&p1,const char*Kslot,const bf16x8*qr,const f32x16&negm,int r32,int hi){
  const char*kb=Kslot+hi*1024+r32*16;
  #pragma unroll
  for(int d0=0;d0<4;++d0){
    const bf16x8 b0=*reinterpret_cast<const bf16x8*>(kb+d0*2048);
    const bf16x8 b1=*reinterpret_cast<const bf16x8*>(kb+d0*2048+512);
    if(d0==0){p0=__builtin_amdgcn_mfma_f32_32x32x16_bf16(b0,qr[0],negm,0,0,0);p1=__builtin_amdgcn_mfma_f32_32x32x16_bf16(b1,qr[0],negm,0,0,0);}
    else{p0=__builtin_amdgcn_mfma_f32_32x32x16_bf16(b0,qr[d0],p0,0,0,0);p1=__builtin_amdgcn_mfma_f32_32x32x16_bf16(b1,qr[d0],p1,0,0,0);}}
}
typedef __attribute__((address_space(3))) const char* lds_cptr;
typedef short v4i16_t __attribute__((ext_vector_type(4)));
__device__ __forceinline__ void kload8(bf16x8*kf,lds_cptr kp){
  kf[0]=*(const __attribute__((address_space(3))) bf16x8*)(kp);      kf[1]=*(const __attribute__((address_space(3))) bf16x8*)(kp+512);
  kf[2]=*(const __attribute__((address_space(3))) bf16x8*)(kp+2048); kf[3]=*(const __attribute__((address_space(3))) bf16x8*)(kp+2560);
  kf[4]=*(const __attribute__((address_space(3))) bf16x8*)(kp+4096); kf[5]=*(const __attribute__((address_space(3))) bf16x8*)(kp+4608);
  kf[6]=*(const __attribute__((address_space(3))) bf16x8*)(kp+6144); kf[7]=*(const __attribute__((address_space(3))) bf16x8*)(kp+6656);
}
__device__ __forceinline__ void kload2(bf16x8*kf,lds_cptr kp,int j){ kf[2*j]=*(const __attribute__((address_space(3))) bf16x8*)(kp+j*2048); kf[2*j+1]=*(const __attribute__((address_space(3))) bf16x8*)(kp+j*2048+512); }
__device__ __forceinline__ s16x4 vtr(lds_cptr p){ return __builtin_bit_cast(s16x4,__builtin_amdgcn_ds_read_tr16_b64_v4i16((__attribute__((address_space(3))) v4i16_t*)p)); }
__device__ __forceinline__ float rowmax(const f32x16&p0,const f32x16&p1){
  float a=max3f(p0[0],p0[1],p1[0]),b=max3f(p0[2],p0[3],p1[1]);a=max3f(a,p1[2],p1[3]);
  #pragma unroll
  for(int r=4;r<16;r+=4){a=max3f(a,p0[r],p0[r+1]);b=max3f(b,p0[r+2],p0[r+3]);a=max3f(a,p1[r],p1[r+1]);b=max3f(b,p1[r+2],p1[r+3]);}
  const float m=max2f(a,b);
  auto rr=__builtin_amdgcn_permlane32_swap(__float_as_uint(m),__float_as_uint(m),false,false);
  return max2f(__uint_as_float(rr[0]),__uint_as_float(rr[1]));
}
__device__ __forceinline__ void pv(f32x16*o,int vb,bf16x8 pa0,bf16x8 pa1,bf16x8 pa2,bf16x8 pa3){
  #pragma unroll
  for(int d0=0;d0<2;++d0){s16x4 lo[4],hi[4];
    #pragma unroll
    for(int ks=0;ks<4;++ks){
      asm volatile("ds_read_b64_tr_b16 %0,%1 offset:%c2":"=&v"(lo[ks]):"v"(vb),"i"(d0*4096+ks*1024):"memory");
      asm volatile("ds_read_b64_tr_b16 %0,%1 offset:%c2":"=&v"(hi[ks]):"v"(vb),"i"(d0*4096+ks*1024+512):"memory");}
    asm volatile("s_waitcnt lgkmcnt(0)":::"memory");SBAR();
    #define PK(k) (bf16x8){lo[k][0],lo[k][1],lo[k][2],lo[k][3],hi[k][0],hi[k][1],hi[k][2],hi[k][3]}
    o[d0]=__builtin_amdgcn_mfma_f32_32x32x16_bf16(pa0,PK(0),o[d0],0,0,0);
    o[d0]=__builtin_amdgcn_mfma_f32_32x32x16_bf16(pa1,PK(1),o[d0],0,0,0);
    o[d0]=__builtin_amdgcn_mfma_f32_32x32x16_bf16(pa2,PK(2),o[d0],0,0,0);
    o[d0]=__builtin_amdgcn_mfma_f32_32x32x16_bf16(pa3,PK(3),o[d0],0,0,0);
    #undef PK
  }
}

#ifndef ATTN_STORE16
#define ATTN_STORE16(p,v) (*(u32x4*)(p)=(v))
#endif
template<int THRL> __device__ __forceinline__ void attn_unit(int b,int vh,int qb,const bf16*Q,const bf16*__restrict__ K,const bf16*__restrict__ V,bf16*O,char*shm,const __attribute__((address_space(3))) float*tball,const int tid){
  const int lane=tid&63,r32=lane&31,hi=lane>>5; const int wid=__builtin_amdgcn_readfirstlane(tid>>6);
  const long rowbase=(long)b*SEQ; const int q0=qb*QB;
  const int hh=vh>>2, qcol=hh*128+((vh>>1)&1)*64, vcol=hh*128+(vh&1)*64;
  const __attribute__((address_space(3))) float*tb=tball+hh*128;
  const bf16*Qw=Q+(rowbase+q0+wid*QBLK)*PQ+qcol;
  const bf16*Kh=K+rowbase*PQ+qcol,*Vh=V+rowbase*PQ+vcol;
  const unsigned lds0=(unsigned)(uintptr_t)shm;
  float*wsf=(float*)(shm+LDS_WS)+wid*64;
  const bf16*ksrc=Kh+(long)lane*PQ+wid*8;
  const bf16*vsrc=Vh+(long)(16*(wid&3)+(lane>>2))*PQ+(wid>>2)*32+(lane&3)*8;
  const unsigned kdst=lds0+LDS_K+wid*1024, vdst=lds0+LDS_V+wid*1024;
  #define DMA_K(t,slot) glds16(ksrc+(long)(t)*KVBLK*PQ,(unsigned)__builtin_amdgcn_readfirstlane(kdst+(slot)))
  #define DMA_V(t,slot) glds16(vsrc+(long)(t)*KVBLK*PQ,(unsigned)__builtin_amdgcn_readfirstlane(vdst+(slot)))
  const int vb0=(int)(lds0+LDS_V)+((lane>>4)&1)*32+(lane&3)*8+(4*hi+((lane&15)>>2))*64;
  const char*Kbase=shm+LDS_K; bf16x8 kf[8];
  const lds_cptr shm3=(lds_cptr)shm; const lds_cptr kp0=shm3+LDS_K+hi*1024+r32*16; const lds_cptr vp0=shm3+LDS_V+((lane>>4)&1)*32+(lane&3)*8+(4*hi+((lane&15)>>2))*64;
  const int NT=(q0+QB)/KVBLK;
  DMA_K(0,0);DMA_V(0,0);DMA_K(1,SLOTB);
  bf16x8 qr[4];
  #pragma unroll
  for(int d0=0;d0<4;++d0)qr[d0]=*reinterpret_cast<const bf16x8*>(&Qw[(long)r32*PQ+d0*16+hi*8]);
  float mhat=0.f,l_reg=0.f;f32x16 o[2];o[0]=f32x16{};o[1]=f32x16{};f32x16 negm=f32x16{};asm volatile("":"+v"(negm));
  const int qrel=wid*QBLK+r32;
  #define CMASK(P0,P1,t) do{int jb_=(t)-(NT-4); if(jb_>=-2){cbias(P0,P1,jb_,qrel,hi,tb); if(jb_>=0)cmask(P0,P1,jb_,qrel,hi);}}while(0)
  bool resc=false;
  #define START(P0,P1) do{ const float rm=rowmax(P0,P1); resc=false; \
    { const float dl=rm; mhat=fadd_s(mhat,dl); \
      _Pragma("unroll") for(int r=0;r<16;++r){P0[r]=fsub_s(P0[r],dl);P1[r]=fsub_s(P1[r],dl);} \
      _Pragma("unroll") for(int r=0;r<16;++r)negm[r]=-mhat; asm volatile("":"+v"(negm)); } \
    _Pragma("unroll") for(int r=0;r<16;++r)P0[r]=__builtin_amdgcn_exp2f(P0[r]); }while(0)
  #define RESC() do{ if(resc){ asm volatile("s_waitcnt lgkmcnt(0)":::"memory"); \
      _Pragma("unroll") for(int d_=0;d_<2;++d_) _Pragma("unroll") for(int r=0;r<16;++r)o[d_][r]*=wsf[crow(r,hi)]; } }while(0)
  f32x16 pA0,pA1,pB0,pB1;
  int sl_prev=0,sl_cur=0,sl_next=SLOTB;
  #define ROT() do{sl_prev=sl_cur;sl_cur=sl_next;sl_next=(sl_next==(NSLOT-1)*SLOTB)?0:sl_next+SLOTB;}while(0)
  DMA_K(2,2*SLOTB);
  WAIT_BAR(3);
  qkt(pA0,pA1,Kbase,qr,negm,r32,hi);asm volatile("s_nop 15\n\ts_nop 7":"+v"(pA0),"+v"(pA1));CMASK(pA0,pA1,0);
  START(pA0,pA1);
  _Pragma("unroll") for(int r=0;r<16;++r)pA1[r]=__builtin_amdgcn_exp2f(pA1[r]);
  WAIT_BAR(0);
  DMA_K(3,0);DMA_V(1,SLOTB);
  ROT();
  kload8(kf,kp0+sl_cur);
  WAIT_BAR(2);
  s16x4 vlo[8],vhi[8]; u32x4 pw0,pw1,pw2,pw3;
  #define PKW(P,B) cvtpk_s(P[B],P[B+1])
  #define PAF(k) __builtin_bit_cast(bf16x8,pw##k)
  #define VFR(i) (bf16x8){vlo[i][0],vlo[i][1],vlo[i][2],vlo[i][3],vhi[i][0],vhi[i][1],vhi[i][2],vhi[i][3]}
  #define PIN(x) asm volatile("":"+v"(x))
  #define MX3(a,b,c) __builtin_fmaxf(__builtin_fmaxf((a),(b)),(c))
  #define GAPA(MF,A0,A1,A2,A3,W0,W1,PW) do{ MF; sacc+=A0; sacc+=A1; sacc+=A2; sacc+=A3; PIN(sacc); W0; W1; PIN(PW); SBAR(); }while(0)
  #define EX(v) __builtin_amdgcn_exp2f(v)
  #define GAPB(MF,X,B) do{ MF; X[B]=EX(X[B]); X[B+1]=EX(X[B+1]); X[B+2]=EX(X[B+2]); X[B+3]=EX(X[B+3]); PIN(X); SBAR(); }while(0)
  #define VRD(i) do{ vlo[i]=vtr(vp_+(((i)>>2)*4096+((i)&3)*1024)); vhi[i]=vtr(vp_+(((i)>>2)*4096+((i)&3)*1024+512)); }while(0)
  #define KRD(G,j) do{ if(G){ kload2(kf,kp0+sl_next,j); SBAR(); } }while(0)
  #define STEP(C0,C1,P0,P1,t,GK,GV,GL) do{ SBAR(); \
    const lds_cptr vp_=vp0+sl_prev; \
    VRD(0); SBAR(); float sacc=(P0[0]+P0[1]); \
    GAPA(C0=__builtin_amdgcn_mfma_f32_32x32x16_bf16(kf[0],qr[0],negm,0,0,0), P0[2],P0[3],P0[4],P0[5],     pw0[0]=PKW(P0,0), pw0[1]=PKW(P0,2), pw0); \
    VRD(4); SBAR(); GAPA(C1=__builtin_amdgcn_mfma_f32_32x32x16_bf16(kf[1],qr[0],negm,0,0,0), P0[6],P0[7],P0[8],P0[9],     pw0[2]=PKW(P0,4), pw0[3]=PKW(P0,6), pw0); \
    VRD(1); SBAR(); GAPA(C0=__builtin_amdgcn_mfma_f32_32x32x16_bf16(kf[2],qr[1],C0,0,0,0),   P0[10],P0[11],P0[12],P0[13], pw1[0]=PKW(P0,8), pw1[1]=PKW(P0,10), pw1); \
    VRD(5); SBAR(); GAPA(C1=__builtin_amdgcn_mfma_f32_32x32x16_bf16(kf[3],qr[1],C1,0,0,0),   P0[14],P0[15],P1[0],P1[1],   pw1[2]=PKW(P0,12),pw1[3]=PKW(P0,14), pw1); \
    VRD(2); SBAR(); GAPA(C0=__builtin_amdgcn_mfma_f32_32x32x16_bf16(kf[4],qr[2],C0,0,0,0),   P1[2],P1[3],P1[4],P1[5],     pw2[0]=PKW(P1,0), pw2[1]=PKW(P1,2), pw2); \
    VRD(6); SBAR(); GAPA(C1=__builtin_amdgcn_mfma_f32_32x32x16_bf16(kf[5],qr[2],C1,0,0,0),   P1[6],P1[7],P1[8],P1[9],     pw2[2]=PKW(P1,4), pw2[3]=PKW(P1,6), pw2); \
    VRD(3); SBAR(); GAPA(C0=__builtin_amdgcn_mfma_f32_32x32x16_bf16(kf[6],qr[3],C0,0,0,0),   P1[10],P1[11],P1[12],P1[13], pw3[0]=PKW(P1,8), pw3[1]=PKW(P1,10), pw3); \
    VRD(7); SBAR(); GAPA(C1=__builtin_amdgcn_mfma_f32_32x32x16_bf16(kf[7],qr[3],C1,0,0,0),   P1[14],P1[15],0.f,0.f,       pw3[2]=PKW(P1,12),pw3[3]=PKW(P1,14), pw3); \
    l_reg+=sacc; \
    if(GK){DMA_K((t)+3,sl_cur);} if(GV){DMA_V((t)+1,sl_next);} \
    CMASK(C0,C1,t); \
    { float a=MX3(C0[0],C0[1],C1[0]),b=MX3(C0[2],C0[3],C1[1]); a=MX3(a,C1[2],C1[3]); \
      _Pragma("unroll") for(int r=4;r<16;r+=4){a=MX3(a,C0[r],C0[r+1]);b=MX3(b,C0[r+2],C0[r+3]);a=MX3(a,C1[r],C1[r+1]);b=MX3(b,C1[r+2],C1[r+3]);} \
      float rm=__builtin_fmaxf(a,b); { auto rr=__builtin_amdgcn_permlane32_swap(__float_as_uint(rm),__float_as_uint(rm),false,false); rm=__builtin_fmaxf(__uint_as_float(rr[0]),__uint_as_float(rr[1])); } \
      resc=false; \
      if(__builtin_expect(__any(rm>(float)THRL),0)){ const float dl=__builtin_fmaxf(rm,0.f); mhat+=dl; \
        _Pragma("unroll") for(int r=0;r<16;++r){C0[r]-=dl;C1[r]-=dl;} \
        _Pragma("unroll") for(int r=0;r<16;++r)negm[r]=-mhat; asm volatile("":"+v"(negm)); \
        const float f=__builtin_amdgcn_exp2f(-dl); l_reg*=f; if(hi==0)wsf[r32]=f; resc=true; } } \
    SBAR(); \
    GAPB(o[0]=__builtin_amdgcn_mfma_f32_32x32x16_bf16(PAF(0),VFR(0),o[0],0,0,0), C0,0); \
    GAPB(o[1]=__builtin_amdgcn_mfma_f32_32x32x16_bf16(PAF(0),VFR(4),o[1],0,0,0), C0,4); \
    KRD(GL,0); GAPB(o[0]=__builtin_amdgcn_mfma_f32_32x32x16_bf16(PAF(1),VFR(1),o[0],0,0,0), C0,8); \
    KRD(GL,1); GAPB(o[1]=__builtin_amdgcn_mfma_f32_32x32x16_bf16(PAF(1),VFR(5),o[1],0,0,0), C0,12); \
    KRD(GL,2); GAPB(o[0]=__builtin_amdgcn_mfma_f32_32x32x16_bf16(PAF(2),VFR(2),o[0],0,0,0), C1,0); \
    KRD(GL,3); GAPB(o[1]=__builtin_amdgcn_mfma_f32_32x32x16_bf16(PAF(2),VFR(6),o[1],0,0,0), C1,4); \
    GAPB(o[0]=__builtin_amdgcn_mfma_f32_32x32x16_bf16(PAF(3),VFR(3),o[0],0,0,0), C1,8); \
    GAPB(o[1]=__builtin_amdgcn_mfma_f32_32x32x16_bf16(PAF(3),VFR(7),o[1],0,0,0), C1,12); \
    }while(0)
  int t=1;
  #undef CMASK
  #define CMASK(P0,P1,t) do{}while(0)
  for(;t+7<NT;t+=2){
    STEP(pB0,pB1,pA0,pA1,t,true,true,true);     WAIT_BAR(2); RESC(); ROT();
    STEP(pA0,pA1,pB0,pB1,t+1,true,true,true);   WAIT_BAR(2); RESC(); ROT();
  }
  #undef CMASK
  #define CMASK(P0,P1,t) do{int jb_=(t)-(NT-4); if(jb_>=-2){cbias(P0,P1,jb_,qrel,hi,tb); if(jb_>=0)cmask(P0,P1,jb_,qrel,hi);}}while(0)
  #define ENDW(tt) do{ if((tt)+3<NT){WAIT_BAR(2);} else if((tt)+2<NT){WAIT_BAR(1);} else {WAIT_BAR(0);} }while(0)
  for(;t+1<NT;t+=2){
    STEP(pB0,pB1,pA0,pA1,t,(t+3<NT),(t+1<NT),(t+1<NT));       ENDW(t);   RESC(); ROT();
    STEP(pA0,pA1,pB0,pB1,t+1,(t+4<NT),(t+2<NT),(t+2<NT));     ENDW(t+1); RESC(); ROT();
  }
  STEP(pB0,pB1,pA0,pA1,NT-1,false,false,false); RESC();
  { float sacc=pB0[0]+pB0[1]; _Pragma("unroll") for(int r=2;r<16;++r)sacc+=pB0[r]; _Pragma("unroll") for(int r=0;r<16;++r)sacc+=pB1[r]; l_reg+=sacc;
    pw0=(u32x4){PKW(pB0,0),PKW(pB0,2),PKW(pB0,4),PKW(pB0,6)};pw1=(u32x4){PKW(pB0,8),PKW(pB0,10),PKW(pB0,12),PKW(pB0,14)};pw2=(u32x4){PKW(pB1,0),PKW(pB1,2),PKW(pB1,4),PKW(pB1,6)};pw3=(u32x4){PKW(pB1,8),PKW(pB1,10),PKW(pB1,12),PKW(pB1,14)};
    SBAR(); pv(o,vb0+sl_cur,PAF(0),PAF(1),PAF(2),PAF(3)); }
  #undef PKW
  #undef PAF
  #undef VFR
  #undef PIN
  #undef MX3
  #undef GAPA
  #undef GAPB
  #undef EX
  #undef VRD
  #undef KRD
  #undef STEP
  #undef ENDW
  {auto rr=__builtin_amdgcn_permlane32_swap(__float_as_uint(l_reg),__float_as_uint(l_reg),false,false);l_reg=__uint_as_float(rr[0])+__uint_as_float(rr[1]);}
  if(hi==0)wsf[32+r32]=l_reg;asm volatile("s_waitcnt lgkmcnt(0)":::"memory");
  float rli[16];
  #pragma unroll
  for(int r=0;r<16;++r)rli[r]=__builtin_amdgcn_rcpf(wsf[32+crow(r,hi)]);
  bf16*Ow=O+(rowbase+q0+wid*QBLK)*PO+vh*D;
  { bf16*stg=(bf16*)(shm+LDS_OST)+wid*2048;
    #pragma unroll
    for(int r=0;r<16;++r){const int orow=crow(r,hi);
      #pragma unroll
      for(int d0=0;d0<2;++d0)stg[orow*64+d0*32+r32]=__float2bfloat16(o[d0][r]*rli[r]);}
    asm volatile("s_waitcnt lgkmcnt(0)":::"memory");
    #pragma unroll
    for(int i=0;i<4;++i){const int row=i*8+(lane>>3),ch=lane&7; const u32x4 v=*(const u32x4*)(stg+row*64+ch*8); ATTN_STORE16(Ow+(long)row*PO+ch*8,v);} }
  asm volatile("s_waitcnt lgkmcnt(0)\n\ts_barrier":::"memory");
  #undef DMA_K
  #undef DMA_V
  #undef CMASK
  #undef START
  #undef RESC
  #undef ROT
}
constexpr int ATTN_LDS_BYTES=LDS_BYTES;
struct AttnTensors { const bf16* Q; const bf16* K; const bf16* V; bf16* O; };
struct AttnUnit { int bh; int qb; };
__device__ __forceinline__ bool attn_next(int vcu,int i,AttnUnit&u){ if(i>=16)return false; const int s=vcu&7, j=i&3; u.bh=(vcu>>3)+32*(i>>2); u.qb=(j==0)?s:(j==1)?15-s:(j==2)?16+s:31-s; return true; }
template<int THRL=8> __device__ __forceinline__ void attn_phase(char*lds,const AttnTensors&T,int vcu,const __attribute__((address_space(3))) float*tball,const int tid){
  AttnUnit u;
  for(int i=0;attn_next(vcu,i,u);++i){ attn_unit<THRL>(u.bh/NHEAD,u.bh%NHEAD,u.qb,T.Q,T.K,T.V,T.O,lds,tball,tid); }
}
#undef SBAR
#undef WAIT_BAR
}

#define XB_TMO      128
#define XB_XCNT(j)  (256  + 64 * (j))
#define XB_XSUB(j)  (1280 + 64 * (j))
#define XB_XGEN(j)  (2304 + 64 * (j))
#define XB_TOP      3328
#define XB_TOPGEN   3392
#define XCD_BAR_WORDS 3456
#define XB_SPIN_CAP (1u << 18)

__device__ __forceinline__ unsigned xb_ld(unsigned* p)              { return __hip_atomic_load(p, __ATOMIC_RELAXED, __HIP_MEMORY_SCOPE_AGENT); }
__device__ __forceinline__ unsigned xb_add(unsigned* p, unsigned v) { return __hip_atomic_fetch_add(p, v, __ATOMIC_RELAXED, __HIP_MEMORY_SCOPE_AGENT); }
__device__ __forceinline__ unsigned xb_xcc_id() { return (unsigned)__builtin_amdgcn_s_getreg((3 << 11) | 20) & 0xFu; }
#define XB_SPIN(cond, bar) do { unsigned _sp = 0; while (cond) { __builtin_amdgcn_s_sleep(1); \
    if ((++_sp & 255u) == 0u) { if (xb_ld(&(bar)[XB_TMO])) break; if (_sp > XB_SPIN_CAP) { atomicAdd(&(bar)[XB_TMO], 1u); break; } } } } while (0)

struct XcdBarrier {
    unsigned* bar; unsigned x;
    volatile LAS unsigned* st;
};

__device__ __forceinline__ XcdBarrier xcd_barrier_post(unsigned* bar, volatile LAS unsigned* st, const bool leader  ) {
    XcdBarrier b; b.bar = bar; b.x = xb_xcc_id(); b.st = st;
    if (leader) (void)xb_add(&bar[XB_XCNT(b.x)], 1u);
    return b;
}
__device__ __forceinline__ void xcd_barrier_complete(unsigned* bar, unsigned x, unsigned& nloc, unsigned& nx) {
    const unsigned G = gridDim.x * gridDim.y * gridDim.z;
    unsigned sum, cnt, mine, sp = 0u;
    for (;;) {
        sum = 0u; cnt = 0u; mine = 0u;
#pragma unroll
        for (unsigned j = 0; j < 16; ++j) { const unsigned c = xb_ld(&bar[XB_XCNT(j)]); sum += c; cnt += (c > 0u) ? 1u : 0u; mine = (j == x) ? c : mine; }
        if (sum == G) break;
        __builtin_amdgcn_s_sleep(1);
        if ((++sp & 255u) == 0u) { if (xb_ld(&bar[XB_TMO])) break; if (sp > XB_SPIN_CAP) { atomicAdd(&bar[XB_TMO], 1u); break; } }
    }
    nloc = mine > 0u ? mine : 1u; nx = cnt > 0u ? cnt : 1u;
}

__device__ __forceinline__ void xcd_barrier(const XcdBarrier& b, const bool leader  ) {
    asm volatile("s_waitcnt vmcnt(0)" ::: "memory");
    __syncthreads();
    if (leader) {
        unsigned* bar = b.bar;
        __builtin_amdgcn_s_waitcnt(0);
        unsigned nloc = b.st[0], nx = b.st[1];
        if (nloc == 0u) { xcd_barrier_complete(bar, b.x, nloc, nx); b.st[0] = nloc; b.st[1] = nx; }
        const unsigned old = xb_add(&bar[XB_XSUB(b.x)], 1u);
        const unsigned gen = old / nloc;
        if (old + 1u == (gen + 1u) * nloc) {
            __builtin_amdgcn_fence(__ATOMIC_RELEASE, "agent");
            asm volatile("s_waitcnt vmcnt(0)" ::: "memory");
            const unsigned og = xb_add(&bar[XB_TOP], 1u);
            const unsigned tg = og / nx;
            if (og + 1u == (tg + 1u) * nx) xb_add(&bar[XB_TOPGEN], 1u);
            else XB_SPIN(xb_ld(&bar[XB_TOPGEN]) == tg, bar);
            __builtin_amdgcn_fence(__ATOMIC_ACQUIRE, "agent");
            xb_add(&bar[XB_XGEN(b.x)], 1u);
            asm volatile("s_waitcnt vmcnt(0)" ::: "memory");
        } else {
            XB_SPIN(xb_ld(&bar[XB_XGEN(b.x)]) == gen, bar);
            __builtin_amdgcn_fence(__ATOMIC_ACQUIRE, "agent");
            asm volatile("s_waitcnt vmcnt(0)" ::: "memory");
        }
    }
    __syncthreads();
}

constexpr size_t MiB = 1u << 20;
constexpr size_t WS_CTL = 0, CTL_ZERO_BYTES = 1 * MiB;
constexpr size_t WS_WIN = 2 * MiB;
constexpr size_t WS_WOUT = 7 * MiB;
constexpr size_t WS_PGATE = 9 * MiB;
constexpr size_t WS_PPROJ = 13 * MiB;
constexpr size_t WS_RCAT = 14 * MiB;
constexpr size_t WS_RL1 = 20 * MiB;
constexpr size_t WS_RS2 = 28 * MiB;
constexpr size_t WS_RWO = 30 * MiB;
constexpr size_t WS_ROUT = 32 * MiB;
constexpr size_t WS_LRUAGG = 33 * MiB;
constexpr size_t WS_MGU = 38 * MiB;
constexpr size_t WS_MDN = 102 * MiB;
constexpr size_t WS_PB = 134 * MiB;
constexpr size_t WS_ACT = 166 * MiB;
constexpr size_t WS_H0 = WS_ACT;
constexpr size_t WS_QKV = WS_ACT + 128 * MiB;
constexpr size_t WS_O = WS_ACT + 448 * MiB;
constexpr size_t WS_HL = WS_ACT + 576 * MiB, WS_CA = WS_ACT + 640 * MiB;
constexpr size_t WS_H2 = WS_ACT;
constexpr size_t WS_LOG = WS_ACT + 128 * MiB;
constexpr size_t WS_ROUTE = WS_ACT + 144 * MiB;
constexpr size_t WS_HID = WS_ACT + 152 * MiB;
constexpr size_t WS_YS = WS_ACT + 288 * MiB;
constexpr size_t WS_PP = WS_HID;
constexpr size_t WS_HCAT = WS_ACT;
constexpr size_t WS_XR = WS_ACT + 256 * MiB, WS_XK = WS_ACT + 384 * MiB, WS_XV = WS_ACT + 512 * MiB;
constexpr size_t WS_R = WS_ACT + 640 * MiB, WS_K = WS_XR, WS_V = WS_XK;
constexpr size_t WS_MID = WS_ACT + 768 * MiB;
constexpr size_t WS_EW = WS_ACT;
constexpr size_t WS_AA = WS_ACT + 128 * MiB;
constexpr size_t WS_Y = WS_XV;
constexpr size_t WS_END = WS_ACT + 832 * MiB;
static_assert(WS_END <= 1024 * MiB, "workspace map");
constexpr size_t RT_EID = 0, RT_POS = 1 * MiB, RT_GATE = 2 * MiB, RT_ROWTOK = 3 * MiB, RT_ROWGATE = 4 * MiB, RT_SLOT = 5 * MiB, RT_ROWRSTD = 6 * MiB, RT_RSTD = 7 * MiB;
constexpr size_t WS_SS = WS_HID;
constexpr int CW_BAR = 4096;
constexpr int CW_PROG = 32768, CW_GDONE = 36864;
constexpr int CW_CNT0 = 16384, CW_CNT1 = 16384 + 64;

constexpr int RING_BYTES = 131072;
constexpr int LDSCTL_OFF = RING_BYTES, MISC_OFF = LDSCTL_OFF + 320;
constexpr int TB_OFF = RING_BYTES + 1024;
constexpr int RTE_OFF = TB_OFF + 2048;
constexpr int LDS_BYTES = 147456;

constexpr int NWAVES = 8;
__device__ __forceinline__ int lane_id_() { int l; asm volatile("v_mbcnt_lo_u32_b32 %0, -1, 0\n\tv_mbcnt_hi_u32_b32 %0, -1, %0" : "=v"(l)); return l; }
#define TID_ (F.wave * 64 + lane_id_())
#define LANE_ (lane_id_())
struct Frame {
    LAS unsigned char* lds; volatile LAS unsigned* MISC; gu32* ctl;
    int wave, vcu, G;
};

__device__ __forceinline__ void load_row4(const float* xrow, int lane, f32x4 (&v)[4]) { const f32x4* p = (const f32x4*)xrow + lane;
#pragma unroll
    for (int j = 0; j < 4; ++j) v[j] = p[64 * j]; }
__device__ __forceinline__ float row_rstd(const f32x4 (&v)[4], float eps) { float s = 0.f;
#pragma unroll
    for (int j = 0; j < 4; ++j) s += (v[j].x * v[j].x + v[j].y * v[j].y) + (v[j].z * v[j].z + v[j].w * v[j].w);
    return 1.0f / sqrtf(wave_sum(s) * (1.0f / 1024.0f) + eps); }
__device__ __forceinline__ void load_row4_bf(const bf16* xrow, int lane, f32x4 (&v)[4]) { const v2u* p = (const v2u*)xrow + lane;
#pragma unroll
    for (int j = 0; j < 4; ++j) { const v2u w = p[64 * j]; v[j] = (f32x4){bflo(w.x), bfhi(w.x), bflo(w.y), bfhi(w.y)}; } }
__device__ __forceinline__ void store_row4_bf(bf16* xrow, int lane, const f32x4 (&v)[4]) { v2u* p = (v2u*)xrow + lane;
#pragma unroll
    for (int j = 0; j < 4; ++j) { v2u o; o.x = pk2(v[j].x, v[j].y); o.y = pk2(v[j].z, v[j].w); p[64 * j] = o; } }
__device__ __forceinline__ void store_row_bf16(bf16* orow, int lane, const f32x4 (&v)[4], float rstd, const float* g) {
    unsigned long long* o8 = (unsigned long long*)orow + lane;
#pragma unroll
    for (int j = 0; j < 4; ++j) { const f32x4 gg = ((const f32x4*)g)[lane + 64 * j];
        o8[64 * j] = (unsigned long long)pk2(v[j].x * rstd * gg.x, v[j].y * rstd * gg.y) | ((unsigned long long)pk2(v[j].z * rstd * gg.z, v[j].w * rstd * gg.w) << 32); }
}

template <int MODE>
__device__ __forceinline__ void transpose_item(const float* W, int K, int N, bf16* WT, int ldo, int row_off, const float* mu, LAS float* scr, int item, int lane) {
    const int nblk = N / 32, kb = item / nblk, nb = item % nblk, k0 = 64 * kb, n0 = 32 * nb;
    float ld[32];
#pragma unroll
    for (int i = 0; i < 32; ++i) { const int kk = 2 * i + (lane >> 5); ld[i] = W[(size_t)(k0 + kk) * N + n0 + (lane & 31)]; }
#pragma unroll
    for (int i = 0; i < 32; ++i) { const int kk = 2 * i + (lane >> 5); scr[kk * 33 + (lane & 31)] = ld[i]; }
    LDS_WAIT(); asm volatile("" ::: "memory");
    const int c = lane & 7;
    int rbase = row_off + n0;
    if (MODE == 2) { rbase = row_off + ((n0 < 512) ? ((n0 >> 7) * 256 + (n0 & 127)) : (((n0 - 512) >> 7) * 256 + 128 + ((n0 - 512) & 127))); }
    float m[8];
    if (MODE == 1 || MODE == 2) {
#pragma unroll
        for (int e = 0; e < 8; ++e) m[e] = mu[k0 + 8 * c + e]; }
#pragma unroll
    for (int j = 0; j < 4; ++j) { const int n = (lane >> 3) + 8 * j; const LAS float* s = scr + (8 * c) * 33 + n;
        float v[8];
#pragma unroll
        for (int e = 0; e < 8; ++e) v[e] = s[e * 33];
        bf16* dst = WT + (size_t)(rbase + n) * ldo + k0 + 8 * c;
        if (MODE == 1) {
            v4u o, o2;
            o.x = pk2(v[0] * (1.f - m[0]), v[1] * (1.f - m[1])); o.y = pk2(v[2] * (1.f - m[2]), v[3] * (1.f - m[3])); o.z = pk2(v[4] * (1.f - m[4]), v[5] * (1.f - m[5])); o.w = pk2(v[6] * (1.f - m[6]), v[7] * (1.f - m[7]));
            o2.x = pk2(v[0] * m[0], v[1] * m[1]); o2.y = pk2(v[2] * m[2], v[3] * m[3]); o2.z = pk2(v[4] * m[4], v[5] * m[5]); o2.w = pk2(v[6] * m[6], v[7] * m[7]);
            *(GAS v4u*)dst = o; *(GAS v4u*)(dst + 1024) = o2;
        } else {
            if (MODE == 2) {
#pragma unroll
                for (int e = 0; e < 8; ++e) v[e] *= m[e]; }
            v4u o; o.x = pk2(v[0], v[1]); o.y = pk2(v[2], v[3]); o.z = pk2(v[4], v[5]); o.w = pk2(v[6], v[7]);
            *(GAS v4u*)dst = o; }
    }
    LDS_WAIT(); asm volatile("" ::: "memory");
}

struct In {
    const float *x, *p, *rel_bias, *norm_mix, *ab_w_in, *ab_w_out, *lam_q1, *lam_k1, *lam_q2, *lam_k2, *sub_g, *conv_w, *conv_b, *lru_wa, *lru_ba, *lru_wx, *lru_bx, *lru_lambda,
        *rwkv_mu, *rwkv_wr, *rwkv_wk, *rwkv_wv, *rwkv_wo, *rwkv_w0, *rwkv_w1, *rwkv_w2, *rwkv_a0, *rwkv_a1, *rwkv_a2, *rwkv_g1, *rwkv_g2, *rwkv_kk, *rwkv_ka, *rwkv_rk, *rwkv_ln_g, *rwkv_ln_b,
        *norm_ffn, *moe_wc, *moe_bc, *moe_wf, *moe_bf, *moe_w_gu, *moe_w_down, *ple_norm, *ple_gate, *ple_proj, *final_norm;
};

__device__ __forceinline__ void prep_dense_weights(Frame& F, const In& I, unsigned char* ws) {
    LAS float* scr = (LAS float*)(F.lds + F.wave * 16384);
    const int gw = F.vcu * NWAVES + F.wave, NGW = F.G * NWAVES;
    bf16* WIN = (bf16*)(ws + WS_WIN); bf16* WOUT = (bf16*)(ws + WS_WOUT); bf16* PG = (bf16*)(ws + WS_PGATE); bf16* PPJ = (bf16*)(ws + WS_PPROJ);
    bf16* RCAT = (bf16*)(ws + WS_RCAT); bf16* RL1 = (bf16*)(ws + WS_RL1); bf16* RWO = (bf16*)(ws + WS_RWO);
    constexpr int I_IN = (1024 / 64) * (2560 / 32), I_SQ = (1024 / 64) * (1024 / 32), I_PJ = (256 / 64) * (1024 / 32), I_L64 = (1024 / 64) * (64 / 32), I_L160 = (1024 / 64) * (160 / 32);
    int st = gw;
#define TJOB(MODE, NITEMS, W, K, N, WT, LDO, ROFF, MU) do { for (int it = st; it < (NITEMS); it += NGW) transpose_item<MODE>(W, K, N, WT, LDO, ROFF, MU, scr, it, LANE_); \
        st = (st + NGW - ((NITEMS) % NGW)) % NGW; asm volatile("" : "+s"(st)); } while (0)
    TJOB(0, I_IN, I.ab_w_in, 1024, 2560, WIN, 1024, 0, nullptr);
    TJOB(0, I_SQ, I.ab_w_out, 1024, 1024, WOUT, 1024, 0, nullptr);
    TJOB(0, I_SQ, I.ple_gate, 1024, 1024, PG, 1024, 0, nullptr);
    TJOB(0, I_SQ, I.ple_gate + 1024 * 1024, 1024, 1024, PG + 1024 * 1024, 1024, 0, nullptr);
    TJOB(0, I_SQ, I.rwkv_wo, 1024, 1024, RWO, 1024, 0, nullptr);
    TJOB(0, I_SQ, I.rwkv_wr, 1024, 1024, RCAT, 1024, 0, nullptr);
    TJOB(0, I_SQ, I.rwkv_wk, 1024, 1024, RCAT, 1024, 1024, nullptr);
    TJOB(0, I_SQ, I.rwkv_wv, 1024, 1024, RCAT, 1024, 2048, nullptr);
    TJOB(0, I_PJ, I.ple_proj, 256, 1024, PPJ, 256, 0, nullptr);
    TJOB(0, I_PJ, I.ple_proj + 256 * 1024, 256, 1024, PPJ + 1024 * 256, 256, 0, nullptr);
    TJOB(1, I_L64, I.rwkv_w1, 1024, 64, RL1, 2048, 0, I.rwkv_mu + 1 * 1024);
    TJOB(1, I_L64, I.rwkv_a1, 1024, 64, RL1, 2048, 64, I.rwkv_mu + 4 * 1024);
    TJOB(1, I_L160, I.rwkv_g1, 1024, 160, RL1, 2048, 256, I.rwkv_mu + 5 * 1024);
#undef TJOB
    const int gt = F.vcu * 512 + TID_, NGT = F.G * 512;
    { v4u z = {0u, 0u, 0u, 0u}; const int per_row = 2048 / 8;
      for (int i = gt; i < (128 + 96) * per_row; i += NGT) { int rr = i / per_row, cc = i % per_row; rr = (rr < 128) ? (128 + rr) : (416 + rr - 128); *(GAS v4u*)(RL1 + (size_t)rr * 2048 + cc * 8) = z; } }
    { bf16* S2 = (bf16*)(ws + WS_RS2);
      for (int i = gt; i < 3 * 1024 * 256; i += NGT) { const int ty = i / (1024 * 256), n = (i / 256) & 1023, k = i & 255; float v = 0.f;
          if (ty == 0) { if (k < 64) v = I.rwkv_w2[k * 1024 + n]; } else if (ty == 1) { if (k >= 64 && k < 128) v = I.rwkv_a2[(k - 64) * 1024 + n]; } else { if (k < 160) v = I.rwkv_g2[k * 1024 + n]; }
          S2[i] = (bf16)f2bf(v); } }
    { bf16* RT = (bf16*)(ws + WS_ROUT);
      for (int i = gt; i < 2 * 256 * 1024; i += NGT) { const int l = i / (256 * 1024), n = (i / 1024) & 255, k = i & 1023; float v = 0.f;
          if (n < 4) v = I.moe_wc[(size_t)l * 1024 * 4 + k * 4 + n]; else if (n < 36) v = I.moe_wf[(size_t)l * 1024 * 32 + k * 32 + (n - 4)];
          RT[i] = (bf16)f2bf(v * I.norm_ffn[l * 1024 + k]); } }
}
__device__ __forceinline__ void prep_layer_weights(Frame& F, const In& I, unsigned char* ws, int layer) {
    LAS float* scr = (LAS float*)(F.lds + F.wave * 16384);
    const int gw = F.vcu * NWAVES + F.wave, NGW = F.G * NWAVES;
    bf16* MGU = (bf16*)(ws + WS_MGU); bf16* MDN = (bf16*)(ws + WS_MDN);
    const float* wgu = I.moe_w_gu + (size_t)layer * NEXP * 1024 * 1024; const float* wdn = I.moe_w_down + (size_t)layer * NEXP * 512 * 1024;
    constexpr int I_GU = (1024 / 64) * (1024 / 32), I_DN = (512 / 64) * (1024 / 32);
    for (int it = gw; it < NEXP * (I_GU + I_DN); it += NGW) {
        const int e = it / (I_GU + I_DN); int r = it % (I_GU + I_DN);
        if (r < I_GU) transpose_item<2>(wgu + (size_t)e * 1024 * 1024, 1024, 1024, MGU + (size_t)e * 1024 * 1024, 1024, 0, I.norm_ffn + layer * 1024, scr, r, LANE_);
        else transpose_item<0>(wdn + (size_t)e * 512 * 1024, 512, 1024, MDN + (size_t)e * 1024 * 512, 512, 0, nullptr, scr, r - I_GU, LANE_);
    }
    const int gt = F.vcu * 512 + TID_, NGT = F.G * 512;
    const f32x4* ps = (const f32x4*)(I.p + (size_t)layer * T * PLE); v2u* pd = (v2u*)(ws + WS_PB);
    for (int i = gt; i < T * PLE / 4; i += 4 * NGT) { f32x4 v[4];
#pragma unroll
        for (int r = 0; r < 4; ++r) v[r] = ps[i + r * NGT];
#pragma unroll
        for (int r = 0; r < 4; ++r) { v2u o; o.x = pk2(v[r].x, v[r].y); o.y = pk2(v[r].z, v[r].w); pd[i + r * NGT] = o; } }
}

template <bool XBF>
__device__ __forceinline__ void norm_pass(Frame& F, const void* x, const float* g, bf16* out) {
    const int gw = F.vcu * NWAVES + F.wave, NGW = F.G * NWAVES; const int lane = LANE_;
    for (int t = 4 * gw; t < T; t += 4 * NGW) {
        f32x4 v[4][4];
#pragma unroll
        for (int r = 0; r < 4; ++r) { if (XBF) load_row4_bf((const bf16*)x + (size_t)(t + r) * D, lane, v[r]); else load_row4((const float*)x + (size_t)(t + r) * D, lane, v[r]); }
#pragma unroll
        for (int r = 0; r < 4; ++r) { const float rs = row_rstd(v[r], 1e-6f); store_row_bf16(out + (size_t)(t + r) * D, lane, v[r], rs, g); }
    }
}
__device__ __forceinline__ void rwkv_input_pass(Frame& F, const bf16* x, const float* g, const float* mu, bf16* HCAT, bf16* XR, bf16* XK, bf16* XV) {
    const int gw = F.vcu * NWAVES + F.wave, NGW = F.G * NWAVES; const int lane = LANE_;
    f32x4 gg[4], mr[4], mk[4], mv[4];
#pragma unroll
    for (int j = 0; j < 4; ++j) { gg[j] = ((const f32x4*)g)[lane + 64 * j]; mr[j] = ((const f32x4*)(mu + 0 * 1024))[lane + 64 * j]; mk[j] = ((const f32x4*)(mu + 2 * 1024))[lane + 64 * j]; mv[j] = ((const f32x4*)(mu + 3 * 1024))[lane + 64 * j]; }
    for (int blk = gw; blk < T / 32; blk += NGW) {
        const int t0 = blk * 32; f32x4 hp[4];
        if ((t0 & (SEQ - 1)) == 0) {
#pragma unroll
            for (int j = 0; j < 4; ++j) hp[j] = (f32x4){0.f, 0.f, 0.f, 0.f};
        } else { f32x4 v[4]; load_row4_bf(x + (size_t)(t0 - 1) * D, lane, v); const float rstd = row_rstd(v, 1e-6f);
#pragma unroll
            for (int j = 0; j < 4; ++j) hp[j] = v[j] * rstd * gg[j]; }
        f32x4 vn[4]; load_row4_bf(x + (size_t)t0 * D, lane, vn);
        for (int t = t0; t < t0 + 32; ++t) {
            f32x4 v[4];
#pragma unroll
            for (int j = 0; j < 4; ++j) v[j] = vn[j];
            if (t + 1 < t0 + 32) load_row4_bf(x + (size_t)(t + 1) * D, lane, vn);
            const float rstd = row_rstd(v, 1e-6f);
            unsigned long long* oh = (unsigned long long*)(HCAT + (size_t)t * 2048) + lane; unsigned long long* or_ = (unsigned long long*)(XR + (size_t)t * 1024) + lane;
            unsigned long long* ok = (unsigned long long*)(XK + (size_t)t * 1024) + lane; unsigned long long* ov = (unsigned long long*)(XV + (size_t)t * 1024) + lane;
#pragma unroll
            for (int j = 0; j < 4; ++j) { const f32x4 h = v[j] * rstd * gg[j], dd = hp[j] - h;
                oh[64 * j] = (unsigned long long)pk2(h.x, h.y) | ((unsigned long long)pk2(h.z, h.w) << 32);
                oh[256 + 64 * j] = (unsigned long long)pk2(hp[j].x, hp[j].y) | ((unsigned long long)pk2(hp[j].z, hp[j].w) << 32);
                const f32x4 a = h + dd * mr[j], b = h + dd * mk[j], c = h + dd * mv[j];
                or_[64 * j] = (unsigned long long)pk2(a.x, a.y) | ((unsigned long long)pk2(a.z, a.w) << 32);
                ok[64 * j] = (unsigned long long)pk2(b.x, b.y) | ((unsigned long long)pk2(b.z, b.w) << 32);
                ov[64 * j] = (unsigned long long)pk2(c.x, c.y) | ((unsigned long long)pk2(c.z, c.w) << 32);
                hp[j] = h; }
        }
    }
}
__device__ __forceinline__ void combine_norm_pass(Frame& F, const bf16* xin, bf16* xout, const bf16* YS, const int* slot, const float* g, bf16* out) {
    const int gw = F.vcu * NWAVES + F.wave, NGW = F.G * NWAVES; const int lane = LANE_;
    for (int t = 2 * gw; t < T; t += 2 * NGW) {
        f32x4 v[2][4]; v2u ya[2][4], yb[2][4];
#pragma unroll
        for (int r = 0; r < 2; ++r) { load_row4_bf(xin + (size_t)(t + r) * D, lane, v[r]);
            const int s0 = slot[2 * (t + r)], s1 = slot[2 * (t + r) + 1];
            const v2u* y0 = (const v2u*)(YS + (size_t)s0 * D) + lane; const v2u* y1 = (const v2u*)(YS + (size_t)s1 * D) + lane;
#pragma unroll
            for (int j = 0; j < 4; ++j) { ya[r][j] = y0[64 * j]; yb[r][j] = y1[64 * j]; } }
#pragma unroll
        for (int r = 0; r < 2; ++r) {
#pragma unroll
            for (int j = 0; j < 4; ++j) { const v2u a = ya[r][j], b = yb[r][j];
                v[r][j].x += bflo(a.x) + bflo(b.x); v[r][j].y += bfhi(a.x) + bfhi(b.x); v[r][j].z += bflo(a.y) + bflo(b.y); v[r][j].w += bfhi(a.y) + bfhi(b.y); }
            store_row4_bf(xout + (size_t)(t + r) * D, lane, v[r]);
            const float rstd = row_rstd(v[r], 1e-6f);
            store_row_bf16(out + (size_t)(t + r) * D, lane, v[r], rstd, g); }
    }
}
__device__ __forceinline__ void final_norm_pass(Frame& F, const bf16* x, float* out, const float* g) {
    const int gw = F.vcu * NWAVES + F.wave, NGW = F.G * NWAVES; const int lane = LANE_;
    for (int t = 4 * gw; t < T; t += 4 * NGW) {
        f32x4 v[4][4];
#pragma unroll
        for (int r = 0; r < 4; ++r) load_row4_bf(x + (size_t)(t + r) * D, lane, v[r]);
#pragma unroll
        for (int r = 0; r < 4; ++r) { const float rs = row_rstd(v[r], 1e-6f); f32x4* xo = (f32x4*)(out + (size_t)(t + r) * D) + lane;
#pragma unroll
            for (int j = 0; j < 4; ++j) { const f32x4 gg = ((const f32x4*)g)[lane + 64 * j]; xo[64 * j] = v[r][j] * rs * gg; } }
    }
}

__device__ __forceinline__ void diff_combine_pass(Frame& F, const In& I, const bf16* O, bf16* YCAT) {
    const int gw = F.vcu * NWAVES + F.wave, NGW = F.G * NWAVES;
    const float lam_init = 0.2f;
    const float d1 = wave_sum(I.lam_q1[LANE_] * I.lam_k1[LANE_]), d2 = wave_sum(I.lam_q2[LANE_] * I.lam_k2[LANE_]);
    const float lam = expf(d1) - expf(d2) + lam_init;
    const int h = LANE_ >> 4, q = LANE_ & 15;
    float sg[8];
#pragma unroll
    for (int e = 0; e < 8; ++e) sg[e] = I.sub_g[q * 8 + e] * (1.0f - lam_init);
    for (int t0 = 4 * gw; t0 < T; t0 += 4 * NGW) {
        v4u av[4], bv[4];
#pragma unroll
        for (int r = 0; r < 4; ++r) { av[r] = *(const v4u*)(O + (size_t)(t0 + r) * 1024 + h * 256 + q * 8); bv[r] = *(const v4u*)(O + (size_t)(t0 + r) * 1024 + h * 256 + 128 + q * 8); }
#pragma unroll
        for (int r = 0; r < 4; ++r) { const v4u a = av[r], b = bv[r]; const int t = t0 + r;
        float o[8];
        o[0] = bflo(a.x) - lam * bflo(b.x); o[1] = bfhi(a.x) - lam * bfhi(b.x); o[2] = bflo(a.y) - lam * bflo(b.y); o[3] = bfhi(a.y) - lam * bfhi(b.y);
        o[4] = bflo(a.z) - lam * bflo(b.z); o[5] = bfhi(a.z) - lam * bfhi(b.z); o[6] = bflo(a.w) - lam * bflo(b.w); o[7] = bfhi(a.w) - lam * bfhi(b.w);
        float s = 0.f;
#pragma unroll
        for (int e = 0; e < 8; ++e) s += o[e] * o[e];
        s += __shfl_xor(s, 1); s += __shfl_xor(s, 2); s += __shfl_xor(s, 4); s += __shfl_xor(s, 8);
        const float rstd = 1.0f / sqrtf(s * (1.0f / 128.0f) + 1e-5f);
        v4u w; w.x = pk2(o[0] * rstd * sg[0], o[1] * rstd * sg[1]); w.y = pk2(o[2] * rstd * sg[2], o[3] * rstd * sg[3]); w.z = pk2(o[4] * rstd * sg[4], o[5] * rstd * sg[5]); w.w = pk2(o[6] * rstd * sg[6], o[7] * rstd * sg[7]);
        *(v4u*)(YCAT + (size_t)t * 1024 + h * 128 + q * 8) = w; }
    }
}

constexpr int LCT = 64, LNCH = SEQ / LCT;
__device__ __forceinline__ float gelu_tanh(float x) { const float u = 0.7978845608028654f * (x + 0.044715f * x * x * x); return x * sigmoidf_(2.0f * u); }
template <bool FINAL>
__device__ __forceinline__ void lru_phase(Frame& F, const In& I, const bf16* XB, const bf16* GB, f32x2* AGG, bf16* YCAT, bf16* HLp, bf16* CAp) {
    const int ch = TID_, n = ch >> 6, d = ch & 63;
    LAS float* U = (LAS float*)F.lds;
    f32x2 wg[64];
#pragma unroll
    for (int c = 0; c < 64; ++c) { wg[c].x = I.lru_wa[n * 4096 + c * 64 + d]; wg[c].y = I.lru_wx[n * 4096 + c * 64 + d]; }
    const float cw0 = I.conv_w[0 * 512 + ch], cw1 = I.conv_w[1 * 512 + ch], cw2 = I.conv_w[2 * 512 + ch], cw3 = I.conv_w[3 * 512 + ch], cb = I.conv_b[ch];
    const float ba = I.lru_ba[ch], bx = I.lru_bx[ch];
    const float lam = I.lru_lambda[ch]; const float sp = (lam > 15.f) ? expf(-lam) : log1pf(expf(-lam));
    const float m8sp = -8.0f * sp;
    for (int un = blockIdx.x; un < NB * LNCH; un += F.G) {
        const int b = un / LNCH, c = un % LNCH; const size_t row0 = (size_t)b * SEQ + (size_t)c * LCT;
        unsigned short xraw[LCT + 3];
        if (c > 0) { xraw[0] = XB[(row0 - 3) * 512 + ch]; xraw[1] = XB[(row0 - 2) * 512 + ch]; xraw[2] = XB[(row0 - 1) * 512 + ch]; } else { xraw[0] = 0; xraw[1] = 0; xraw[2] = 0; }
#pragma unroll
        for (int tk = 0; tk < LCT; ++tk) xraw[3 + tk] = XB[(row0 + tk) * 512 + ch];
        float h = 0.f, Ap = 1.f;
        if (FINAL) { for (int j = 0; j < c; ++j) { const f32x2 ag = AGG[((size_t)b * LNCH + j) * 512 + ch]; h = ag.x * h + ag.y; } }
#pragma unroll
        for (int tk = 0; tk < LCT; ++tk) U[tk * 512 + ch] = cw0 * bf1(xraw[tk]) + cw1 * bf1(xraw[tk + 1]) + cw2 * bf1(xraw[tk + 2]) + cw3 * bf1(xraw[tk + 3]) + cb;
        __syncthreads();
        unsigned short gcur[8], gnxt[8];
        if (FINAL) {
#pragma unroll
            for (int j = 0; j < 8; ++j) gcur[j] = GB[(row0 + j) * 512 + ch]; }
#pragma unroll 1
        for (int tg = 0; tg < LCT / 8; ++tg) {
            if (FINAL) { const int tn = (tg + 1 < LCT / 8) ? (tg + 1) * 8 : tg * 8;
#pragma unroll
                for (int j = 0; j < 8; ++j) gnxt[j] = GB[(row0 + tn + j) * 512 + ch]; }
#pragma unroll
            for (int j = 0; j < 8; ++j) { const int tk = tg * 8 + j;
                const LAS f32x4* up = (const LAS f32x4*)(U + tk * 512 + n * 64);
                f32x2 acc = {ba, bx};
#pragma unroll
                for (int c4 = 0; c4 < 16; ++c4) { const f32x4 uu = up[c4];
                    acc += wg[4 * c4 + 0] * uu.x; acc += wg[4 * c4 + 1] * uu.y; acc += wg[4 * c4 + 2] * uu.z; acc += wg[4 * c4 + 3] * uu.w; }
                const float r = sigmoidf_(acc.x), ig = sigmoidf_(acc.y);
                const float la = r * m8sp; const float a = __expf(la); const float t2 = 2.0f * la; const float om = (t2 > -0.02f) ? -t2 * (1.0f + t2 * (0.5f + t2 * (0.16666667f + t2 * 0.041666668f))) : 1.0f - a * a; const float bb = __builtin_amdgcn_sqrtf(om) * (ig * U[tk * 512 + ch]);
                h = a * h + bb;
                if (FINAL) { YCAT[(row0 + tk) * 1024 + 512 + ch] = (bf16)f2bf(h * gelu_tanh(bf1(gcur[j]))); }
                else { Ap *= a; HLp[(row0 + tk) * 512 + ch] = (bf16)f2bf(h); CAp[(row0 + tk) * 512 + ch] = (bf16)f2bf(Ap); } }
            if (FINAL) {
#pragma unroll
                for (int j = 0; j < 8; ++j) gcur[j] = gnxt[j]; }
        }
        if (!FINAL) { f32x2 ag; ag.x = Ap; ag.y = h; AGG[((size_t)b * LNCH + c) * 512 + ch] = ag; }
        __syncthreads();
    }
}

__device__ __forceinline__ void lru_agg_mfma(Frame& F, const In& I, const bf16* XB, f32x2* AGG, bf16* HLp, bf16* CAp) {
    const int tid = TID_, lane = tid & 63, fr = lane & 15, fq = lane >> 4, n = F.wave, ch = tid;
    constexpr int UP = 520;
    LAS bf16* U = (LAS bf16*)F.lds;
    bf16x8 Wr[4][2], Wi[4][2];
#pragma unroll
    for (int dd = 0; dd < 4; ++dd)
#pragma unroll
        for (int kh = 0; kh < 2; ++kh) { unsigned pr_[4], pi_[4];
#pragma unroll
            for (int j = 0; j < 4; ++j) { const int c0 = 32 * kh + 8 * fq + 2 * j, d = 16 * dd + fr;
                pr_[j] = pk2(I.lru_wa[n * 4096 + c0 * 64 + d], I.lru_wa[n * 4096 + (c0 + 1) * 64 + d]); pi_[j] = pk2(I.lru_wx[n * 4096 + c0 * 64 + d], I.lru_wx[n * 4096 + (c0 + 1) * 64 + d]); }
            Wr[dd][kh] = __builtin_bit_cast(bf16x8, (v4u){pr_[0], pr_[1], pr_[2], pr_[3]}); Wi[dd][kh] = __builtin_bit_cast(bf16x8, (v4u){pi_[0], pi_[1], pi_[2], pi_[3]}); }
    float cba[4], cbx[4], cm8[4];
#pragma unroll
    for (int dd = 0; dd < 4; ++dd) { const int chd = 64 * n + 16 * dd + fr; cba[dd] = I.lru_ba[chd]; cbx[dd] = I.lru_bx[chd];
        const float lam = I.lru_lambda[chd]; cm8[dd] = -8.0f * ((lam > 15.f) ? expf(-lam) : log1pf(expf(-lam))); }
    const float cw0 = I.conv_w[0 * 512 + ch], cw1 = I.conv_w[1 * 512 + ch], cw2 = I.conv_w[2 * 512 + ch], cw3 = I.conv_w[3 * 512 + ch], cb = I.conv_b[ch];
    for (int un = blockIdx.x; un < NB * LNCH; un += F.G) {
        const int b = un / LNCH, c = un % LNCH; const size_t row0 = (size_t)b * SEQ + (size_t)c * LCT;
        unsigned short xraw[LCT + 3];
        if (c > 0) { xraw[0] = XB[(row0 - 3) * 512 + ch]; xraw[1] = XB[(row0 - 2) * 512 + ch]; xraw[2] = XB[(row0 - 1) * 512 + ch]; } else { xraw[0] = 0; xraw[1] = 0; xraw[2] = 0; }
#pragma unroll
        for (int tk = 0; tk < LCT; ++tk) xraw[3 + tk] = XB[(row0 + tk) * 512 + ch];
#pragma unroll
        for (int tk = 0; tk < LCT; ++tk) U[tk * UP + ch] = (bf16)f2bf(cw0 * bf1(xraw[tk]) + cw1 * bf1(xraw[tk + 1]) + cw2 * bf1(xraw[tk + 2]) + cw3 * bf1(xraw[tk + 3]) + cb);
        __syncthreads();
        bf16x8 X[4][2];
#pragma unroll
        for (int tt = 0; tt < 4; ++tt)
#pragma unroll
            for (int kh = 0; kh < 2; ++kh) X[tt][kh] = *(const LAS bf16x8*)(U + (16 * tt + fr) * UP + 64 * n + 32 * kh + 8 * fq);
#pragma unroll 1
        for (int dd = 0; dd < 4; ++dd) {
            bf16x8 wr0, wr1, wi0, wi1; float kba, kbx, km8;
            if (dd == 0) { wr0 = Wr[0][0]; wr1 = Wr[0][1]; wi0 = Wi[0][0]; wi1 = Wi[0][1]; kba = cba[0]; kbx = cbx[0]; km8 = cm8[0]; }
            else if (dd == 1) { wr0 = Wr[1][0]; wr1 = Wr[1][1]; wi0 = Wi[1][0]; wi1 = Wi[1][1]; kba = cba[1]; kbx = cbx[1]; km8 = cm8[1]; }
            else if (dd == 2) { wr0 = Wr[2][0]; wr1 = Wr[2][1]; wi0 = Wi[2][0]; wi1 = Wi[2][1]; kba = cba[2]; kbx = cbx[2]; km8 = cm8[2]; }
            else { wr0 = Wr[3][0]; wr1 = Wr[3][1]; wi0 = Wi[3][0]; wi1 = Wi[3][1]; kba = cba[3]; kbx = cbx[3]; km8 = cm8[3]; }
            const int chd = 64 * n + 16 * dd + fr;
            float hc = 0.f, Ac = 1.f;
#pragma unroll
            for (int tt = 0; tt < 4; ++tt) {
                f32x4 pr = (f32x4){0.f, 0.f, 0.f, 0.f}, pi = pr;
                pr = __builtin_amdgcn_mfma_f32_16x16x32_bf16(X[tt][0], wr0, pr, 0, 0, 0); pr = __builtin_amdgcn_mfma_f32_16x16x32_bf16(X[tt][1], wr1, pr, 0, 0, 0);
                pi = __builtin_amdgcn_mfma_f32_16x16x32_bf16(X[tt][0], wi0, pi, 0, 0, 0); pi = __builtin_amdgcn_mfma_f32_16x16x32_bf16(X[tt][1], wi1, pi, 0, 0, 0);
                float a[4], bb[4];
#pragma unroll
                for (int e = 0; e < 4; ++e) { const int tok = 16 * tt + 4 * fq + e; const float u = bf1(U[tok * UP + chd]);
                    const float r = sigmoidf_(pr[e] + kba), ig = sigmoidf_(pi[e] + kbx); const float la = r * km8; a[e] = __expf(la); const float t2 = 2.0f * la;
                    const float om = (t2 > -0.02f) ? -t2 * (1.0f + t2 * (0.5f + t2 * (0.16666667f + t2 * 0.041666668f))) : 1.0f - a[e] * a[e]; bb[e] = __builtin_amdgcn_sqrtf(om) * (ig * u); }
                const float A4 = (a[0] * a[1]) * (a[2] * a[3]); const float B4 = ((bb[0] * a[1] + bb[1]) * a[2] + bb[2]) * a[3] + bb[3];
                float h = hc, Ap = Ac, hs = hc, As = Ac;
#pragma unroll
                for (int j = 0; j < 4; ++j) { const float Aj = __shfl(A4, fr + 16 * j), Bj = __shfl(B4, fr + 16 * j); if (j == fq) { hs = h; As = Ap; } h = Aj * h + Bj; Ap *= Aj; }
                hc = h; Ac = Ap; h = hs; Ap = As;
#pragma unroll
                for (int e = 0; e < 4; ++e) { h = a[e] * h + bb[e]; Ap *= a[e]; const size_t o = (row0 + 16 * tt + 4 * fq + e) * 512 + chd; HLp[o] = (bf16)f2bf(h); CAp[o] = (bf16)f2bf(Ap); }
            }
            if (fq == 0) { f32x2 ag; ag.x = Ac; ag.y = hc; AGG[((size_t)b * LNCH + c) * 512 + chd] = ag; }
        }
        __syncthreads();
    }
}

__device__ __forceinline__ void lru_final_pass(Frame& F, const bf16* HLp, const bf16* CAp, const bf16* GB, const f32x2* AGG, bf16* YCAT) {
    const int ch = TID_;
    for (int un = blockIdx.x; un < NB * LNCH; un += F.G) {
        const int b = un / LNCH, c = un % LNCH; const size_t row0 = (size_t)b * SEQ + (size_t)c * LCT;
        float carry = 0.f;
        for (int j = 0; j < c; ++j) { const f32x2 ag = AGG[((size_t)b * LNCH + j) * 512 + ch]; carry = ag.x * carry + ag.y; }
#pragma unroll 4
        for (int t8 = 0; t8 < LCT; t8 += 8) {
            bf16 hl[8], ca[8], gv[8];
#pragma unroll
            for (int j = 0; j < 8; ++j) { const size_t o = (row0 + t8 + j) * 512 + ch; hl[j] = HLp[o]; ca[j] = CAp[o]; gv[j] = GB[o]; }
#pragma unroll
            for (int j = 0; j < 8; ++j) { const float h = bf1(hl[j]) + bf1(ca[j]) * carry; YCAT[(row0 + t8 + j) * 1024 + 512 + ch] = (bf16)f2bf(h * gelu_tanh(bf1(gv[j]))); }
        }
    }
}

__device__ __forceinline__ void route_pass_a(Frame& F, const In& I, int layer, const float* LOG, unsigned char* rt, gu32* cnt, const float* SS) {
    LAS int* lcnt = (LAS int*)(F.lds + RTE_OFF); LAS int* lbase = lcnt + 32;
    int* EID = (int*)(rt + RT_EID); int* POS = (int*)(rt + RT_POS); float* GATE = (float*)(rt + RT_GATE);
    const float* bc = I.moe_bc + layer * 4; const float* bfb = I.moe_bf + layer * 32;
    for (int un = blockIdx.x; un < T / 512; un += F.G) {
        if (TID_ < 32) lcnt[TID_] = 0;
        __syncthreads();
        const int t = un * 512 + TID_; const float* lg = LOG + (size_t)t * 64;
        float rs; { const f32x4* sp = (const f32x4*)(SS + (size_t)t * 16); const f32x4 a0 = sp[0], a1 = sp[1], a2 = sp[2], a3 = sp[3]; const f32x4 a = (a0 + a1) + (a2 + a3);
            rs = 1.0f / sqrtf(((a.x + a.y) + (a.z + a.w)) * (1.0f / 1024.0f) + 1e-6f); ((float*)(rt + RT_RSTD))[t] = rs; }
        const f32x4 g4 = *(const f32x4*)lg;
        float gl[4] = {g4.x * rs + bc[0], g4.y * rs + bc[1], g4.z * rs + bc[2], g4.w * rs + bc[3]};
        int gi = 0; float gm = gl[0];
#pragma unroll
        for (int j = 1; j < 4; ++j) if (gl[j] > gm) { gm = gl[j]; gi = j; }
        float gs = 0.f;
#pragma unroll
        for (int j = 0; j < 4; ++j) gs += __expf(gl[j] - gm);
        const float gprob = 1.0f / gs;
        const f32x4 e0 = *(const f32x4*)(lg + 4 + gi * 8), e1 = *(const f32x4*)(lg + 8 + gi * 8);
        float el[8] = {e0.x, e0.y, e0.z, e0.w, e1.x, e1.y, e1.z, e1.w};
#pragma unroll
        for (int j = 0; j < 8; ++j) el[j] = el[j] * rs + bfb[gi * 8 + j];
        int i0 = 0; float m0 = el[0];
#pragma unroll
        for (int j = 1; j < 8; ++j) if (el[j] > m0) { m0 = el[j]; i0 = j; }
        int i1 = -1; float m1 = -INFINITY;
#pragma unroll
        for (int j = 0; j < 8; ++j) if (j != i0 && el[j] > m1) { m1 = el[j]; i1 = j; }
        const float r1 = __expf(m1 - m0); const float g0 = gprob / (1.0f + r1), g1 = gprob * r1 / (1.0f + r1);
        const int ex0 = gi * 8 + i0, ex1 = gi * 8 + i1;
        const int p0 = atomicAdd((int*)&lcnt[ex0], 1), p1 = atomicAdd((int*)&lcnt[ex1], 1);
        __syncthreads();
        if (TID_ < 32) lbase[TID_] = (int)__hip_atomic_fetch_add(cnt + TID_, (unsigned)lcnt[TID_], RLX_AGENT);
        __syncthreads();
        EID[2 * t] = ex0; EID[2 * t + 1] = ex1; POS[2 * t] = lbase[ex0] + p0; POS[2 * t + 1] = lbase[ex1] + p1; GATE[2 * t] = g0; GATE[2 * t + 1] = g1;
        __syncthreads();
    }
}
__device__ __forceinline__ void route_bases(Frame& F, gu32* cnt) {
    LAS int* eb = (LAS int*)(F.lds + RTE_OFF + 512);
    const int tid = TID_;
    if (tid < 64) {
        const int c = (tid < 32) ? (int)__hip_atomic_load(cnt + (tid & 31), RLX_AGENT) : 0; const int p = (c + 255) & ~255; int s = p;
#pragma unroll
        for (int o = 1; o < 32; o <<= 1) { const int t = __shfl_up(s, o); if ((tid & 63) >= o) s += t; }
        if (tid < 32) { eb[tid] = s - p; if (tid == 31) eb[32] = s; }
    }
    __syncthreads();
}
__device__ __forceinline__ void route_pass_b(Frame& F, unsigned char* rt, gu32* cnt) {
    route_bases(F, cnt);
    LAS int* eb = (LAS int*)(F.lds + RTE_OFF + 512);
    const int* EID = (const int*)(rt + RT_EID); const int* POS = (const int*)(rt + RT_POS); const float* GATE = (const float*)(rt + RT_GATE);
    int* ROWTOK = (int*)(rt + RT_ROWTOK); float* ROWGATE = (float*)(rt + RT_ROWGATE); int* SLOT = (int*)(rt + RT_SLOT); float* ROWRSTD = (float*)(rt + RT_ROWRSTD); const float* RSTD = (const float*)(rt + RT_RSTD);
    const int gt = F.vcu * 512 + TID_, NGT = F.G * 512;
    for (int i = gt; i < 2 * T; i += NGT) { const int dst = eb[EID[i]] + POS[i]; ROWTOK[dst] = i >> 1; ROWGATE[dst] = GATE[i]; ROWRSTD[dst] = RSTD[i >> 1]; SLOT[i] = dst; }
    for (int i = gt; i < 32 * 256; i += NGT) { const int e = i >> 8, j = i & 255; const int c = (int)__hip_atomic_load(cnt + e, RLX_AGENT); const int pad = ((c + 255) & ~255) - c;
        if (j < pad) { ROWTOK[eb[e] + c + j] = 0; ROWGATE[eb[e] + c + j] = 0.f; ROWRSTD[eb[e] + c + j] = 0.f; } }
    __syncthreads();
}
struct MoeOrder {
    int G, c, ntiles; const LAS int* eb; const char* A; const char* W; size_t astep, wexp, wtile; bool gather;
    __device__ bool next(int i, pg8::Unit& u) const {
        const int L = i * G + c; if (L >= ntiles * 4) return false;
        u.pm = L >> 2; u.pn = L & 3; const int s0 = u.pm * 256; int e = 0;
#pragma unroll 1
        for (int j = 1; j < 32; ++j) if (eb[j] <= s0) e = j;
        e = __builtin_amdgcn_readfirstlane(e); u.aux = e; u.A = gather ? A : A + (size_t)u.pm * astep; u.B = W + (size_t)e * wexp + (size_t)u.pn * wtile; return true;
    }
};

constexpr int RTC = 32, RNCH = SEQ / RTC, RTOK = 352;
#define LBAR() do { asm volatile("s_waitcnt lgkmcnt(0)" ::: "memory"); __builtin_amdgcn_s_barrier(); asm volatile("" ::: "memory"); } while (0)
template <int CTRL> __device__ __forceinline__ float dpp_f(float v) { return __builtin_bit_cast(float, __builtin_amdgcn_update_dpp(0, __builtin_bit_cast(int, v), CTRL, 0xf, 0xf, true)); }
__device__ __forceinline__ float red16(float v) { v += dpp_f<0xB1>(v); v += dpp_f<0x4E>(v); v += dpp_f<0x141>(v); v += dpp_f<0x140>(v); return v; }
__device__ __forceinline__ float red8(float v) { v += dpp_f<0xB1>(v); v += dpp_f<0x4E>(v); v += dpp_f<0x141>(v); return v; }
__device__ __forceinline__ void unpack8(const v4u w, float (&f)[8]) { f[0] = bflo(w.x); f[1] = bfhi(w.x); f[2] = bflo(w.y); f[3] = bfhi(w.y); f[4] = bflo(w.z); f[5] = bfhi(w.z); f[6] = bflo(w.w); f[7] = bfhi(w.w); }
__device__ __forceinline__ void rwkv_scan_phase(Frame& F, const In& I, const bf16* R, const bf16* Kt, const bf16* V, const bf16* AA, const bf16* EW, bf16* Y) {
    LAS float* buf = (LAS float*)F.lds;
    LAS float* ybuf = (LAS float*)(F.lds + 2 * RTC * RTOK * 4) + 32;
    const int tid = TID_, lane = tid & 63;
    const int seg = lane & 15, rl = F.wave * 4 + (lane >> 4);
    const int stk = tid >> 4, ssg = tid & 15;
    for (int un = blockIdx.x; un < NB * 16 * 2; un += F.G) {
        const int half = un & 1, h = (un >> 1) & 15, b = un >> 5;
        const size_t rowb = (size_t)b * SEQ;
        const int col = h * 64 + ssg * 4;
        const f32x4 kkw = *(const f32x4*)(I.rwkv_kk + col), kaw = *(const f32x4*)(I.rwkv_ka + col);
        v2u rr, kr, vr, ar, er;
#define RAW_LOAD(cc) do { const size_t off = (rowb + (size_t)(cc) * RTC + stk) * 1024 + col; rr = *(const v2u*)(R + off); kr = *(const v2u*)(Kt + off); vr = *(const v2u*)(V + off); ar = *(const v2u*)(AA + off); er = *(const v2u*)(EW + off); } while (0)
#define RAW_CONVERT(cc) do { LAS float* tp = buf + ((cc) & 1) * (RTC * RTOK) + stk * RTOK + ssg * 4; \
            const float r0 = bflo(rr.x), r1 = bfhi(rr.x), r2 = bflo(rr.y), r3 = bfhi(rr.y), k0 = bflo(kr.x), k1 = bfhi(kr.x), k2 = bflo(kr.y), k3 = bfhi(kr.y); \
            const float a0 = bflo(ar.x), a1 = bfhi(ar.x), a2 = bflo(ar.y), a3 = bfhi(ar.y); \
            const float x0 = k0 * kkw.x, x1 = k1 * kkw.y, x2 = k2 * kkw.z, x3 = k3 * kkw.w; \
            const float ss = red16((x0 * x0 + x1 * x1) + (x2 * x2 + x3 * x3)); const float inv = __builtin_amdgcn_rsqf(fmaxf(ss, 1e-24f)); \
            *(LAS f32x4*)(tp) = (f32x4){__expf(-bflo(er.x)), __expf(-bfhi(er.x)), __expf(-bflo(er.y)), __expf(-bfhi(er.y))}; \
            const f32x4 kkv = (f32x4){x0 * inv, x1 * inv, x2 * inv, x3 * inv}; *(LAS f32x4*)(tp + 64) = kkv; \
            *(LAS f32x4*)(tp + 128) = (f32x4){kkv.x * a0, kkv.y * a1, kkv.z * a2, kkv.w * a3}; \
            *(LAS f32x4*)(tp + 192) = (f32x4){k0 * (1.0f + (a0 - 1.0f) * kaw.x), k1 * (1.0f + (a1 - 1.0f) * kaw.y), k2 * (1.0f + (a2 - 1.0f) * kaw.z), k3 * (1.0f + (a3 - 1.0f) * kaw.w)}; \
            *(LAS f32x4*)(tp + 256) = (f32x4){r0, r1, r2, r3}; \
            if ((ssg >> 3) == half) *(LAS f32x4*)(buf + ((cc) & 1) * (RTC * RTOK) + stk * RTOK + 320 + (ssg & 7) * 4) = (f32x4){bflo(vr.x), bfhi(vr.x), bflo(vr.y), bfhi(vr.y)}; } while (0)
#define Y_WRITE(cc) do { const LAS f32x2* yp = (const LAS f32x2*)(ybuf + ((cc) & 1) * (RTC * 32 + 32) + stk * 32 + ssg * 2); const f32x2 yv = *yp; \
            *(unsigned*)(Y + (rowb + (size_t)(cc) * RTC + stk) * 1024 + h * 64 + half * 32 + ssg * 2) = pk2(yv.x, yv.y); } while (0)
        RAW_LOAD(0); RAW_CONVERT(0); RAW_LOAD(1);
        f32x2 S0 = (f32x2){0.f, 0.f}, S1 = (f32x2){0.f, 0.f};
        LBAR();
        for (int c = 0; c < RNCH; ++c) {
            if (c + 1 < RNCH) { RAW_CONVERT(c + 1); }
            if (c + 2 < RNCH) { RAW_LOAD(c + 2); }
            if (c >= 1) { Y_WRITE(c - 1); }
            const LAS float* cb = buf + (c & 1) * (RTC * RTOK); LAS float* yb = ybuf + (c & 1) * (RTC * 32 + 32);
            const LAS float* tp0 = cb + seg * 4; const LAS float* vp0 = cb + 320 + rl;
#define SV_DECL(X) f32x4 X##w, X##q, X##b, X##k, X##r; float X##v
#define SV_LOAD(X, tk) do { const LAS float* tp = tp0 + (tk) * RTOK; \
                X##w = *(const LAS f32x4*)(tp); X##q = *(const LAS f32x4*)(tp + 64); X##b = *(const LAS f32x4*)(tp + 128); X##k = *(const LAS f32x4*)(tp + 192); X##r = *(const LAS f32x4*)(tp + 256); X##v = vp0[(tk) * RTOK]; } while (0)
#define SV_STEP(X, tk) do { \
                const f32x2 d = S0 * (f32x2){X##q.x, X##q.y} + S1 * (f32x2){X##q.z, X##q.w}; \
                const f32x2 t0 = S0 * (f32x2){X##w.x, X##w.y} + (f32x2){X##k.x, X##k.y} * X##v, t1 = S1 * (f32x2){X##w.z, X##w.w} + (f32x2){X##k.z, X##k.w} * X##v; \
                float ra = d.x + d.y, rb = epend;                   \
                ra += dpp_f<0xB1>(ra); rb += dpp_f<0xB1>(rb); ra += dpp_f<0x4E>(ra); rb += dpp_f<0x4E>(rb); ra += dpp_f<0x141>(ra); rb += dpp_f<0x141>(rb); ra += dpp_f<0x140>(ra); rb += dpp_f<0x140>(rb); \
                if (seg == 0) yb[((tk) - 1) * 32 + rl] = rb;        \
                const float sa = -ra; \
                S0 = t0 + (f32x2){X##b.x, X##b.y} * sa; S1 = t1 + (f32x2){X##b.z, X##b.w} * sa; \
                const f32x2 e = S0 * (f32x2){X##r.x, X##r.y} + S1 * (f32x2){X##r.z, X##r.w}; epend = e.x + e.y; } while (0)
            SV_DECL(A_); SV_DECL(B_); float epend = 0.f;
            SV_LOAD(A_, 0);
#pragma unroll 1
            for (int tk = 0; tk < RTC; tk += 2) {
                SV_LOAD(B_, tk + 1);
                SV_STEP(A_, tk);
                { const int t2 = (tk + 2 < RTC) ? tk + 2 : RTC - 1; SV_LOAD(A_, t2); }
                SV_STEP(B_, tk + 1);
            }
#undef SV_DECL
#undef SV_LOAD
#undef SV_STEP
            { const float rb = red16(epend); if (seg == 0) yb[(RTC - 1) * 32 + rl] = rb; }
            LBAR();
        }
        Y_WRITE(RNCH - 1);
        LBAR();
#undef RAW_LOAD
#undef RAW_CONVERT
#undef Y_WRITE
    }
}
constexpr int GS_QT = 0, GS_RT = 2048, GS_BHT = 4096, GS_KHT = 6144, GS_VT = 8192, GS_TM = 10240, GS_TL = 10752, GS_MK = 11264, GS_NK = 11776, GS_NB = 12288, GS_DD = 12800, GS_SLOT = 13056;
constexpr int GS_KT = GS_KHT, GS_BT = GS_BHT, GS_MB = GS_TM;
#ifndef SCAN_NP
#define SCAN_NP 4
#endif
constexpr int CH_NP = SCAN_NP, CH_NS = 8 - CH_NP, CH_ROUNDS = (512 + CH_NP - 1) / CH_NP;
constexpr int CH_KTAB = 2 * CH_NP * GS_SLOT;
static_assert(CH_KTAB + 512 <= 131072, "chunked-scan LDS map");
template <int N> __device__ __forceinline__ float dpp_shr(float v) { return __builtin_bit_cast(float, __builtin_amdgcn_update_dpp(0, __builtin_bit_cast(int, v), 0x110 + N, 0xf, 0xf, true)); }
__device__ __forceinline__ bf16x8 mk8(v2u a, v2u b) { return __builtin_bit_cast(bf16x8, (v4u){a.x, a.y, b.x, b.y}); }
__device__ __forceinline__ bf16x8 mk8z(v2u a) { return __builtin_bit_cast(bf16x8, (v4u){a.x, a.y, 0u, 0u}); }
__device__ __forceinline__ bf16x8 cvt8z(f32x4 v) { return __builtin_bit_cast(bf16x8, (v4u){pk2(v.x, v.y), pk2(v.z, v.w), 0u, 0u}); }
__device__ __forceinline__ int tokoff(const int t, const int c) { return t * 128 + ((c ^ ((t >> 1) & 7)) << 4); }
__device__ __forceinline__ int tokoff2(const int t, const int c) { return t * 128 + ((c ^ (((t >> 1) & 3) << 1)) << 4); }
__device__ __forceinline__ v2u trld(const LAS unsigned char* p) { return __builtin_bit_cast(v2u, __builtin_amdgcn_ds_read_tr16_b64_v4i16((LAS attn_body::v4i16_t*)p)); }
struct ChOps { v4u q0, q1, r0, r1, mn, bt; };
struct ChOpsB { v2u kh[4], bh[4]; f32x4 dv[4]; };
__device__ __forceinline__ void chain_load(ChOps& O, const LAS unsigned char* C, const int fr, const int fq) {
    const int w8 = 8 * (fq & 1), c = fq >> 1;
    { const v2u a = *(const LAS v2u*)(C + GS_QT + tokoff(fr, c) + w8), b = *(const LAS v2u*)(C + GS_QT + tokoff(fr, 2 + c) + w8); O.q0 = (v4u){a.x, a.y, b.x, b.y}; }
    { const v2u a = *(const LAS v2u*)(C + GS_QT + tokoff(fr, 4 + c) + w8), b = *(const LAS v2u*)(C + GS_QT + tokoff(fr, 6 + c) + w8); O.q1 = (v4u){a.x, a.y, b.x, b.y}; }
    { const v2u a = *(const LAS v2u*)(C + GS_RT + tokoff(fr, c) + w8), b = *(const LAS v2u*)(C + GS_RT + tokoff(fr, 2 + c) + w8); O.r0 = (v4u){a.x, a.y, b.x, b.y}; }
    { const v2u a = *(const LAS v2u*)(C + GS_RT + tokoff(fr, 4 + c) + w8), b = *(const LAS v2u*)(C + GS_RT + tokoff(fr, 6 + c) + w8); O.r1 = (v4u){a.x, a.y, b.x, b.y}; }
    const int om = (fr * 16 + 4 * fq) * 2;
    { const v2u a = *(const LAS v2u*)(C + GS_MK + om), b = *(const LAS v2u*)(C + GS_NK + om); O.mn = (v4u){a.x, a.y, b.x, b.y}; }
    { const v2u a = *(const LAS v2u*)(C + GS_NB + om), b = *(const LAS v2u*)(C + GS_TM + om); O.bt = (v4u){a.x, a.y, b.x, b.y}; }
}
__device__ __forceinline__ void chain_load_b(ChOpsB& O, const LAS unsigned char* C, const int fr, const int fq) {
#pragma unroll
    for (int jt = 0; jt < 4; ++jt) { const int ok = tokoff2(4 * fq + (fr >> 2), 2 * jt + ((fr >> 1) & 1)) + 8 * (fr & 1); O.kh[jt] = trld(C + GS_KHT + ok); O.bh[jt] = trld(C + GS_BHT + ok); O.dv[jt] = *(const LAS f32x4*)(C + GS_DD + (16 * jt + 4 * fq) * 4); }
}
template <int NT>
__device__ __forceinline__ void chain_step(const ChOps& O, const LAS unsigned char* C, const v2u vq0, const v2u vq1, f32x4 (&Areg)[2][4], const int vt0, const int fr, const int fq, GAS bf16* yrow, LAS unsigned char* ys) {
    const f32x4 zero4 = (f32x4){0.f, 0.f, 0.f, 0.f};
    v2u kh0, kh1, kh2, kh3, bh0, bh1, bh2, bh3; f32x4 dv0, dv1, dv2, dv3;
    { const int okb = tokoff2(4 * fq + (fr >> 2), 0) + 8 * (fr & 1), xs = (((4 * fq + (fr >> 2)) >> 1) & 3) << 1, cb = (fr >> 1) & 1;
#define KB_(jt) (4 * fq + (fr >> 2)) * 128 + ((((2 * (jt) + cb) ^ xs)) << 4) + 8 * (fr & 1)
      kh0 = trld(C + GS_KHT + KB_(0)); kh1 = trld(C + GS_KHT + KB_(1)); kh2 = trld(C + GS_KHT + KB_(2)); kh3 = trld(C + GS_KHT + KB_(3));
      bh0 = trld(C + GS_BHT + KB_(0)); bh1 = trld(C + GS_BHT + KB_(1)); bh2 = trld(C + GS_BHT + KB_(2)); bh3 = trld(C + GS_BHT + KB_(3)); (void)okb;
#undef KB_
      dv0 = *(const LAS f32x4*)(C + GS_DD + (4 * fq) * 4); dv1 = *(const LAS f32x4*)(C + GS_DD + (16 + 4 * fq) * 4); dv2 = *(const LAS f32x4*)(C + GS_DD + (32 + 4 * fq) * 4); dv3 = *(const LAS f32x4*)(C + GS_DD + (48 + 4 * fq) * 4); }
    bf16x8 Aq[NT][2], Vq[NT], Uq[NT]; f32x4 X[NT], YA[NT], Z[NT], U[NT], Yv[NT], Yn[NT];
#pragma unroll
    for (int ti = 0; ti < NT; ++ti) {
#pragma unroll
        for (int kh = 0; kh < 2; ++kh) Aq[ti][kh] = __builtin_bit_cast(bf16x8, (v4u){pk2(Areg[ti][2 * kh].x, Areg[ti][2 * kh].y), pk2(Areg[ti][2 * kh].z, Areg[ti][2 * kh].w), pk2(Areg[ti][2 * kh + 1].x, Areg[ti][2 * kh + 1].y), pk2(Areg[ti][2 * kh + 1].z, Areg[ti][2 * kh + 1].w)});
        Vq[ti] = mk8z(ti == 0 ? vq0 : vq1); X[ti] = zero4; YA[ti] = zero4; }
#pragma unroll
    for (int kh = 0; kh < 2; ++kh) {
#pragma unroll
        for (int ti = 0; ti < NT; ++ti) { X[ti] = __builtin_amdgcn_mfma_f32_16x16x32_bf16(__builtin_bit_cast(bf16x8, kh == 0 ? O.q0 : O.q1), Aq[ti][kh], X[ti], 0, 0, 0); YA[ti] = __builtin_amdgcn_mfma_f32_16x16x32_bf16(__builtin_bit_cast(bf16x8, kh == 0 ? O.r0 : O.r1), Aq[ti][kh], YA[ti], 0, 0, 0); } }
#pragma unroll
    for (int ti = 0; ti < NT; ++ti) Z[ti] = __builtin_amdgcn_mfma_f32_16x16x32_bf16(__builtin_bit_cast(bf16x8, (v4u){O.mn.x, O.mn.y, 0u, 0u}), Vq[ti], X[ti], 0, 0, 0);
#pragma unroll
    for (int ti = 0; ti < NT; ++ti) Yv[ti] = __builtin_amdgcn_mfma_f32_16x16x32_bf16(__builtin_bit_cast(bf16x8, (v4u){O.mn.z, O.mn.w, 0u, 0u}), Vq[ti], YA[ti], 0, 0, 0);
#pragma unroll
    for (int ti = 0; ti < NT; ++ti) U[ti] = __builtin_amdgcn_mfma_f32_16x16x32_bf16(__builtin_bit_cast(bf16x8, (v4u){O.bt.z, O.bt.w, 0u, 0u}), cvt8z(Z[ti]), zero4, 0, 0, 0);
#pragma unroll
    for (int ti = 0; ti < NT; ++ti) Uq[ti] = cvt8z(U[ti]);
#pragma unroll
    for (int ti = 0; ti < NT; ++ti) Yn[ti] = __builtin_amdgcn_mfma_f32_16x16x32_bf16(__builtin_bit_cast(bf16x8, (v4u){O.bt.x, O.bt.y, 0u, 0u}), Uq[ti], zero4, 0, 0, 0);
#pragma unroll
    for (int jt = 0; jt < 4; ++jt) {
#pragma unroll
        for (int ti = 0; ti < NT; ++ti) { f32x4 acc = (jt == 0 ? dv0 : jt == 1 ? dv1 : jt == 2 ? dv2 : dv3) * Areg[ti][jt];
            acc = __builtin_amdgcn_mfma_f32_16x16x32_bf16(mk8z(jt == 0 ? kh0 : jt == 1 ? kh1 : jt == 2 ? kh2 : kh3), Vq[ti], acc, 0, 0, 0);
            const f32x4 nbu = __builtin_amdgcn_mfma_f32_16x16x32_bf16(mk8z(jt == 0 ? bh0 : jt == 1 ? bh1 : jt == 2 ? bh2 : bh3), Uq[ti], zero4, 0, 0, 0);
            Areg[ti][jt] = acc - nbu; } }
#pragma unroll
    for (int ti = 0; ti < NT; ++ti) { const f32x4 yy = Yv[ti] - Yn[ti]; *(LAS v2u*)(ys + ti * 512 + (fr * 16 + 4 * fq) * 2) = (v2u){pk2(yy[0], yy[1]), pk2(yy[2], yy[3])}; }
#pragma unroll
    for (int ti = 0; ti < NT; ++ti) { const v2u w = trld(ys + ti * 512 + ((4 * fq + (fr >> 2)) * 16 + 4 * (fr & 3)) * 2); __hip_atomic_store((GAS unsigned long long*)(yrow + (size_t)fr * 1024 + 16 * (vt0 + ti) + 4 * fq), __builtin_bit_cast(unsigned long long, w), __ATOMIC_RELAXED, __HIP_MEMORY_SCOPE_AGENT); }
}
#ifndef SCAN_WMAP
#define SCAN_WMAP 0x76543210u
#endif
__device__ __forceinline__ void rwkv_scan_chunked(Frame& F, const In& I, const bf16* R, const bf16* Kt, const bf16* V, const bf16* AA, const bf16* EW, bf16* Y, gu32* prog) {
    const int lane = LANE_, fr = lane & 15, fq = lane >> 4;
    const int lw = (int)((SCAN_WMAP >> (4 * F.wave)) & 7u);
    LAS unsigned char* L = F.lds;
    const f32x4 zero4 = (f32x4){0.f, 0.f, 0.f, 0.f};
    for (int un = blockIdx.x; un < NB * 16; un += F.G) {
        const int h = un & 15, b = un >> 4; const size_t rowb = (size_t)b * SEQ;
        if (lw == 0) { ((LAS float*)(L + CH_KTAB))[lane] = ((const GAS float*)I.rwkv_kk)[h * 64 + lane]; ((LAS float*)(L + CH_KTAB + 256))[lane] = ((const GAS float*)I.rwkv_ka)[h * 64 + lane]; }
        LBAR();
        if (lw >= CH_NS) {
            const int p = lw - CH_NS; const int colb = h * 64 + 16 * fq;
            v4u raw[10];
#define CK_LOAD(cidx) do { const size_t off = (rowb + (size_t)(cidx) * 16 + fr) * 1024 + colb; \
                raw[0] = *(const GAS v4u*)(R + off); raw[1] = *(const GAS v4u*)(R + off + 8); raw[2] = *(const GAS v4u*)(Kt + off); raw[3] = *(const GAS v4u*)(Kt + off + 8); raw[4] = *(const GAS v4u*)(V + off); raw[5] = *(const GAS v4u*)(V + off + 8); \
                raw[6] = *(const GAS v4u*)(AA + off); raw[7] = *(const GAS v4u*)(AA + off + 8); raw[8] = *(const GAS v4u*)(EW + off); raw[9] = *(const GAS v4u*)(EW + off + 8); } while (0)
#ifdef SCAN_STAMP
            unsigned long long st_[7] = {0, 0, 0, 0, 0, 0, 0};
#ifndef SCAN_STAMP_P
#define SCAN_STAMP_P 0
#endif
#ifndef SCAN_STAMP_RD
#define SCAN_STAMP_RD 20
#endif
#ifndef SCAN_STAMP_B
#define SCAN_STAMP_B 0
#endif
#define STAMP(i) do { if ((SCAN_STAMP_B < 0 || blockIdx.x == SCAN_STAMP_B) && p == SCAN_STAMP_P && rd == SCAN_STAMP_RD) st_[i] = __builtin_amdgcn_s_memtime(); } while (0)
#else
#define STAMP(i) do { } while (0)
#endif
            CK_LOAD(p);
#pragma unroll 2
            for (int rd = -1; rd < CH_ROUNDS - 1; ++rd) {
                const int cidx = CH_NP * (rd + 1) + p; LAS unsigned char* S = L + (((rd + 1) & 1) * CH_NP + p) * GS_SLOT;
                if (cidx < 512) {
                STAMP(0);
                float r[16], k[16], a[16], ew[16]; const v4u vraw0 = raw[4], vraw1 = raw[5];
                { float t8[8];
                  unpack8(raw[0], t8);
#pragma unroll
                  for (int e = 0; e < 8; ++e) r[e] = t8[e];
                  unpack8(raw[1], t8);
#pragma unroll
                  for (int e = 0; e < 8; ++e) r[8 + e] = t8[e];
                  unpack8(raw[2], t8);
#pragma unroll
                  for (int e = 0; e < 8; ++e) k[e] = t8[e];
                  unpack8(raw[3], t8);
#pragma unroll
                  for (int e = 0; e < 8; ++e) k[8 + e] = t8[e];
                  unpack8(raw[6], t8);
#pragma unroll
                  for (int e = 0; e < 8; ++e) a[e] = t8[e];
                  unpack8(raw[7], t8);
#pragma unroll
                  for (int e = 0; e < 8; ++e) a[8 + e] = t8[e];
                  unpack8(raw[8], t8);
#pragma unroll
                  for (int e = 0; e < 8; ++e) ew[e] = t8[e];
                  unpack8(raw[9], t8);
#pragma unroll
                  for (int e = 0; e < 8; ++e) ew[8 + e] = t8[e]; }
#if defined(SCAN_STAMP) && defined(SCAN_STAMP_LD)
                asm volatile("s_waitcnt vmcnt(0)" ::: "memory"); STAMP(1);
#endif
                if (cidx + CH_NP < 512) CK_LOAD(cidx + CH_NP);
                float kx[16], ss = 0.f;
#pragma unroll
                for (int e4 = 0; e4 < 4; ++e4) { const f32x4 c0_ = *(const LAS f32x4*)(L + CH_KTAB + (16 * fq + 4 * e4) * 4), c1_ = *(const LAS f32x4*)(L + CH_KTAB + 256 + (16 * fq + 4 * e4) * 4);
#pragma unroll
                    for (int z = 0; z < 4; ++z) { const int ee = 4 * e4 + z; kx[ee] = k[ee] * c0_[z]; ss += kx[ee] * kx[ee]; k[ee] = k[ee] * (1.0f + (a[ee] - 1.0f) * c1_[z]); } }
                ss += __shfl_xor(ss, 16); ss += __shfl_xor(ss, 32);
                const float inv = __builtin_amdgcn_rsqf(fmaxf(ss, 1e-24f));
                unsigned qtw[8], rtw[8], ktw[8], btw[8], bhw[8], khw[8];
                {
                    float li[16], e15[16], ep[16];
#pragma unroll
                    for (int e = 0; e < 16; ++e) li[e] = -ew[e];
#pragma unroll
                    for (int e = 0; e < 16; ++e) li[e] += dpp_shr<1>(li[e]);
#pragma unroll
                    for (int e = 0; e < 16; ++e) li[e] += dpp_shr<2>(li[e]);
#pragma unroll
                    for (int e = 0; e < 16; ++e) li[e] += dpp_shr<4>(li[e]);
#pragma unroll
                    for (int e = 0; e < 16; ++e) li[e] += dpp_shr<8>(li[e]);
#pragma unroll
                    for (int e = 0; e < 16; ++e) li[e] = __builtin_amdgcn_exp2f(li[e]);
#pragma unroll
                    for (int e = 0; e < 16; ++e) e15[e] = __shfl(li[e], (lane & 48) | 15);
#pragma unroll
                    for (int e = 0; e < 16; ++e) ep[e] = __builtin_bit_cast(float, __builtin_amdgcn_update_dpp(0x3f800000, __builtin_bit_cast(int, li[e]), 0x111, 0xf, 0xf, false));
                    if (fr == 15) {
#pragma unroll
                        for (int e4 = 0; e4 < 4; ++e4) *(LAS f32x4*)(S + GS_DD + (16 * fq + 4 * e4) * 4) = (f32x4){li[4 * e4], li[4 * e4 + 1], li[4 * e4 + 2], li[4 * e4 + 3]}; }
#pragma unroll
                    for (int e = 0; e < 16; e += 2) { float q2[2], r2[2], k2[2], b2[2], b2h[2], k2h[2];
#pragma unroll
                        for (int z = 0; z < 2; ++z) { const int ee = e + z;
                            const float Einv = __builtin_amdgcn_rcpf(li[ee]);
                            const float kk = kx[ee] * inv, bb = a[ee] * kk;
                            q2[z] = kk * ep[ee]; k2[z] = k[ee] * Einv; b2[z] = bb * Einv; r2[z] = r[ee] * li[ee];
                            b2h[z] = b2[z] * e15[ee]; k2h[z] = k2[z] * e15[ee]; }
                        qtw[e >> 1] = pk2(q2[0], q2[1]); rtw[e >> 1] = pk2(r2[0], r2[1]); ktw[e >> 1] = pk2(k2[0], k2[1]); btw[e >> 1] = pk2(b2[0], b2[1]); bhw[e >> 1] = pk2(b2h[0], b2h[1]); khw[e >> 1] = pk2(k2h[0], k2h[1]);
 } }
                { const int ov = tokoff2(fr, 2 * fq); *(LAS v4u*)(S + GS_VT + ov) = vraw0; *(LAS v4u*)(S + GS_VT + ov + 16) = vraw1; }
                { const int o = tokoff(fr, 2 * fq), o2 = o ^ 16;
                  *(LAS v4u*)(S + GS_QT + o) = (v4u){qtw[0], qtw[1], qtw[2], qtw[3]}; *(LAS v4u*)(S + GS_QT + o2) = (v4u){qtw[4], qtw[5], qtw[6], qtw[7]};
                  *(LAS v4u*)(S + GS_RT + o) = (v4u){rtw[0], rtw[1], rtw[2], rtw[3]}; *(LAS v4u*)(S + GS_RT + o2) = (v4u){rtw[4], rtw[5], rtw[6], rtw[7]};
                  *(LAS v4u*)(S + GS_KT + o) = (v4u){ktw[0], ktw[1], ktw[2], ktw[3]}; *(LAS v4u*)(S + GS_KT + o2) = (v4u){ktw[4], ktw[5], ktw[6], ktw[7]};
                  *(LAS v4u*)(S + GS_BT + o) = (v4u){btw[0], btw[1], btw[2], btw[3]}; *(LAS v4u*)(S + GS_BT + o2) = (v4u){btw[4], btw[5], btw[6], btw[7]}; }
                asm volatile("s_waitcnt lgkmcnt(0)" ::: "memory");
#if !defined(SCAN_STAMP_LD)
                STAMP(1);
#endif
                f32x4 mb = zero4, mbt = zero4, mkt = zero4, nbt = zero4, nkt = zero4;
#pragma unroll
                for (int kh = 0; kh < 2; ++kh) { const int o = tokoff(fr, 4 * kh + fq);
                    const bf16x8 Qf = *(const LAS bf16x8*)(S + GS_QT + o), Rf = *(const LAS bf16x8*)(S + GS_RT + o), Kf = *(const LAS bf16x8*)(S + GS_KT + o), Bf = *(const LAS bf16x8*)(S + GS_BT + o);
                    mb = __builtin_amdgcn_mfma_f32_16x16x32_bf16(Qf, Bf, mb, 0, 0, 0); mbt = __builtin_amdgcn_mfma_f32_16x16x32_bf16(Bf, Qf, mbt, 0, 0, 0);
                    mkt = __builtin_amdgcn_mfma_f32_16x16x32_bf16(Kf, Qf, mkt, 0, 0, 0);
                    nbt = __builtin_amdgcn_mfma_f32_16x16x32_bf16(Bf, Rf, nbt, 0, 0, 0); nkt = __builtin_amdgcn_mfma_f32_16x16x32_bf16(Kf, Rf, nkt, 0, 0, 0); }
                asm volatile("s_waitcnt lgkmcnt(0)" ::: "memory");
                STAMP(2);
                { const int oh = tokoff2(fr, 2 * fq);
                  *(LAS v4u*)(S + GS_BHT + oh) = (v4u){bhw[0], bhw[1], bhw[2], bhw[3]}; *(LAS v4u*)(S + GS_BHT + oh + 16) = (v4u){bhw[4], bhw[5], bhw[6], bhw[7]};
                  *(LAS v4u*)(S + GS_KHT + oh) = (v4u){khw[0], khw[1], khw[2], khw[3]}; *(LAS v4u*)(S + GS_KHT + oh + 16) = (v4u){khw[4], khw[5], khw[6], khw[7]}; }
                { f32x4 nAf, nDf, iD, mkm, nkm, nbm;
#pragma unroll
                  for (int e = 0; e < 4; ++e) { const int tt = 4 * fq + e; const bool lo = fr < tt, up = tt < fr, ue = tt <= fr;
                      nAf[e] = lo ? -mb[e] : 0.f; nDf[e] = up ? -mbt[e] : 0.f; iD[e] = (tt == fr) ? 1.0f : 0.0f;
                      mkm[e] = up ? mkt[e] : 0.f; nkm[e] = ue ? nkt[e] : 0.f; nbm[e] = ue ? nbt[e] : 0.f; }
                  const int om = (fr * 16 + 4 * fq) * 2;
                  *(LAS v2u*)(S + GS_MK + om) = (v2u){pk2(mkm[0], mkm[1]), pk2(mkm[2], mkm[3])}; *(LAS v2u*)(S + GS_NK + om) = (v2u){pk2(nkm[0], nkm[1]), pk2(nkm[2], nkm[3])};
                  *(LAS v2u*)(S + GS_NB + om) = (v2u){pk2(nbm[0], nbm[1]), pk2(nbm[2], nbm[3])};
                  STAMP(3);
                  const bf16x8 nA = cvt8z(nAf), nD = cvt8z(nDf);
                  const f32x4 n2D = __builtin_amdgcn_mfma_f32_16x16x32_bf16(nA, nD, zero4, 0, 0, 0), n2A = __builtin_amdgcn_mfma_f32_16x16x32_bf16(nD, nA, zero4, 0, 0, 0);
                  const bf16x8 n2Db = cvt8z(n2D), n2Ab = cvt8z(n2A);
                  const f32x4 n4D = __builtin_amdgcn_mfma_f32_16x16x32_bf16(n2Ab, n2Db, zero4, 0, 0, 0), n4A = __builtin_amdgcn_mfma_f32_16x16x32_bf16(n2Db, n2Ab, zero4, 0, 0, 0);
                  f32x4 Tt = __builtin_amdgcn_mfma_f32_16x16x32_bf16(nA, n2Db, iD + nDf + n2D, 0, 0, 0);
                  const bf16x8 n4Db = cvt8z(n4D), n4Ab = cvt8z(n4A);
                  const f32x4 n8A = __builtin_amdgcn_mfma_f32_16x16x32_bf16(n4Db, n4Ab, zero4, 0, 0, 0);
                  Tt = __builtin_amdgcn_mfma_f32_16x16x32_bf16(n4Ab, cvt8z(Tt), Tt, 0, 0, 0);
                  Tt = __builtin_amdgcn_mfma_f32_16x16x32_bf16(cvt8z(n8A), cvt8z(Tt), Tt, 0, 0, 0);
                  STAMP(4);
                  *(LAS v2u*)(S + GS_TM + om) = (v2u){pk2(Tt[0], Tt[1]), pk2(Tt[2], Tt[3])}; }
                STAMP(5);
                }
                LBAR();
                STAMP(6);
            }
            LBAR();
#ifdef SCAN_STAMP
            if ((SCAN_STAMP_B < 0 || blockIdx.x == SCAN_STAMP_B) && p == SCAN_STAMP_P) { const unsigned long long d_ = (SCAN_STAMP == 0) ? st_[6] - st_[0] : (SCAN_STAMP == 7) ? st_[5] - st_[0] : st_[SCAN_STAMP] - st_[SCAN_STAMP - 1]; const unsigned long long t0_ = __builtin_amdgcn_s_memtime();
                while (__builtin_amdgcn_s_memtime() - t0_ < d_ * 512ull) __builtin_amdgcn_s_sleep(8); }
#endif
#undef CK_LOAD
        } else {
            const int vtA = (CH_NS == 4) ? lw : ((lw == 0) ? 0 : lw + 1);
            f32x4 A2[2][4];
#ifdef SCAN_PRIO
            __builtin_amdgcn_s_setprio(SCAN_PRIO);
#endif
#pragma unroll
            for (int jt = 0; jt < 4; ++jt) { A2[0][jt] = zero4; A2[1][jt] = zero4; }
            const int trb = 4 * fq + (fr >> 2), trc = (fr >> 1) & 1, trl = 8 * (fr & 1);
            LAS unsigned char* ys = L + TB_OFF + lw * 1024;
#ifdef SCAN_SSTAMP
            unsigned long long ss0_ = 0, ss1_ = 0;
#endif
            LBAR();
            const int vt0 = (CH_NS == 3 && lw == 0) ? 0 : vtA; const bool two = (CH_NS == 3 && lw == 0);
            for (int rd = 0; rd < CH_ROUNDS; ++rd) {
                const int c0 = CH_NP * rd; const LAS unsigned char* C0 = L + ((rd & 1) * CH_NP) * GS_SLOT;
                ChOps opA, opB; v2u vA0, vA1, vB0, vB1;
#define CH_FETCH(OP, V0, V1, q_) do { const LAS unsigned char* C_ = C0 + (q_) * GS_SLOT; chain_load(OP, C_, fr, fq); V0 = trld(C_ + GS_VT + tokoff2(trb, 2 * vt0 + trc) + trl); \
                    if (two) V1 = trld(C_ + GS_VT + tokoff2(trb, 2 + trc) + trl); } while (0)
#define CH_ITER(q_, CUR, U0, U1, NXT, W0, W1) do { if ((q_) < CH_NP) { const int cidx = c0 + (q_); \
                    if ((q_) + 1 < CH_NP && cidx + 1 < 512) CH_FETCH(NXT, W0, W1, (q_) + 1); \
                    if (cidx < 512) { GAS bf16* yrow = (GAS bf16*)Y + (rowb + (size_t)cidx * 16) * 1024 + h * 64; \
                        if (two) chain_step<2>(CUR, C0 + (q_) * GS_SLOT, U0, U1, A2, 0, fr, fq, yrow, ys); \
                        else chain_step<1>(CUR, C0 + (q_) * GS_SLOT, U0, U0, A2, vtA, fr, fq, yrow, ys); } } } while (0)
                vA1 = (v2u){0u, 0u}; vB1 = (v2u){0u, 0u};
                if (c0 < 512) CH_FETCH(opA, vA0, vA1, 0);
                CH_ITER(0, opA, vA0, vA1, opB, vB0, vB1);
                CH_ITER(1, opB, vB0, vB1, opA, vA0, vA1);
                CH_ITER(2, opA, vA0, vA1, opB, vB0, vB1);
                CH_ITER(3, opB, vB0, vB1, opA, vA0, vA1);
                CH_ITER(4, opA, vA0, vA1, opB, vB0, vB1);
                CH_ITER(5, opB, vB0, vB1, opA, vA0, vA1);
#undef CH_ITER
#undef CH_FETCH
                asm volatile("s_waitcnt vmcnt(0)" ::: "memory");
                LBAR();
                if (lw == 0 && lane == 0) __hip_atomic_fetch_add((GAS unsigned*)(prog + b * CH_ROUNDS + rd), 1u, __ATOMIC_RELAXED, __HIP_MEMORY_SCOPE_AGENT);
            }
#ifdef SCAN_SSTAMP
            if (lw == SCAN_SSTAMP_W) { const unsigned long long d_ = (ss1_ - ss0_) * 512ull, t0_ = __builtin_amdgcn_s_memtime(); while (__builtin_amdgcn_s_memtime() - t0_ < d_) __builtin_amdgcn_s_sleep(8); }
#endif
#ifdef SCAN_PRIO
            __builtin_amdgcn_s_setprio(0);
#endif
        }
    }
}
__device__ __forceinline__ void rwkv_post_pass(Frame& F, const In& I, const bf16* R, const bf16* Kt, const bf16* V, const bf16* AA, const bf16* G, bf16* Y, const int tbeg, const int tend, const int tstep) {
    const int col = LANE_ * 16;
    for (int t0 = tbeg; t0 < tend; t0 += tstep) {
        v4u py[2][2], pr[2][2], pk[2][2], pv[2][2], pa[2][2], pg[2][2];
#pragma unroll
        for (int rw = 0; rw < 2; ++rw) { const size_t off = (size_t)(t0 + rw) * 1024 + col;
#pragma unroll
            for (int hf = 0; hf < 2; ++hf) { py[rw][hf] = *(const v4u*)(Y + off + hf * 8); pr[rw][hf] = *(const v4u*)(R + off + hf * 8); pk[rw][hf] = *(const v4u*)(Kt + off + hf * 8);
                pv[rw][hf] = *(const v4u*)(V + off + hf * 8); pa[rw][hf] = *(const v4u*)(AA + off + hf * 8); pg[rw][hf] = *(const v4u*)(G + off + hf * 8); } }
#pragma unroll
        for (int rw = 0; rw < 2; ++rw) { const size_t off = (size_t)(t0 + rw) * 1024 + col;
            float kaw[16], rkw[16], lng[16], lnb[16];
#pragma unroll
            for (int e4 = 0; e4 < 4; ++e4) { const f32x4 c0 = *(const GAS f32x4*)(I.rwkv_ka + col + 4 * e4), c1 = *(const GAS f32x4*)(I.rwkv_rk + col + 4 * e4), c2 = *(const GAS f32x4*)(I.rwkv_ln_g + col + 4 * e4), c3 = *(const GAS f32x4*)(I.rwkv_ln_b + col + 4 * e4);
#pragma unroll
                for (int e = 0; e < 4; ++e) { kaw[4 * e4 + e] = c0[e]; rkw[4 * e4 + e] = c1[e]; lng[4 * e4 + e] = c2[e]; lnb[4 * e4 + e] = c3[e]; } }
            float y[16], r[16], k[16], v[16], a[16], g[16];
#pragma unroll
            for (int hf = 0; hf < 2; ++hf) { float t8[8];
                unpack8(py[rw][hf], t8);
#pragma unroll
                for (int e = 0; e < 8; ++e) y[hf * 8 + e] = t8[e];
                unpack8(pr[rw][hf], t8);
#pragma unroll
                for (int e = 0; e < 8; ++e) r[hf * 8 + e] = t8[e];
                unpack8(pk[rw][hf], t8);
#pragma unroll
                for (int e = 0; e < 8; ++e) k[hf * 8 + e] = t8[e];
                unpack8(pv[rw][hf], t8);
#pragma unroll
                for (int e = 0; e < 8; ++e) v[hf * 8 + e] = t8[e];
                unpack8(pa[rw][hf], t8);
#pragma unroll
                for (int e = 0; e < 8; ++e) a[hf * 8 + e] = t8[e];
                unpack8(pg[rw][hf], t8);
#pragma unroll
                for (int e = 0; e < 8; ++e) g[hf * 8 + e] = t8[e]; }
            float s = 0.f, bs = 0.f;
#pragma unroll
            for (int e = 0; e < 16; ++e) { s += y[e]; const float kp = k[e] * (1.0f + (a[e] - 1.0f) * kaw[e]); bs += r[e] * kp * rkw[e]; }
            s += __shfl_xor(s, 1); s += __shfl_xor(s, 2); bs += __shfl_xor(bs, 1); bs += __shfl_xor(bs, 2);
            const float mean = s * (1.0f / 64.0f); float q = 0.f;
#pragma unroll
            for (int e = 0; e < 16; ++e) { const float dd = y[e] - mean; q += dd * dd; }
            q += __shfl_xor(q, 1); q += __shfl_xor(q, 2);
            const float rstd = 1.0f / sqrtf(q * (1.0f / 64.0f) + 64e-5f);
            float o[16];
#pragma unroll
            for (int e = 0; e < 16; ++e) o[e] = ((y[e] - mean) * rstd * lng[e] + lnb[e] + bs * v[e]) * g[e];
            v4u w0, w1; w0.x = pk2(o[0], o[1]); w0.y = pk2(o[2], o[3]); w0.z = pk2(o[4], o[5]); w0.w = pk2(o[6], o[7]); w1.x = pk2(o[8], o[9]); w1.y = pk2(o[10], o[11]); w1.z = pk2(o[12], o[13]); w1.w = pk2(o[14], o[15]);
            *(v4u*)(Y + off) = w0; *(v4u*)(Y + off + 8) = w1; }
    }
}

#ifndef DUP_K
#define DUP_K (-1)
#endif
#ifndef DUP_K2
#define DUP_K2 (-1)
#endif
#define KARGS ((const __attribute__((address_space(4))) Args*)__builtin_amdgcn_kernarg_segment_ptr())
#define WSPTRS \
    bf16* H0 = (bf16*)(ws + WS_H0); bf16* QKV = (bf16*)(ws + WS_QKV); bf16* OB = (bf16*)(ws + WS_O); f32x2* AGG = (f32x2*)(ws + WS_LRUAGG); \
    bf16* H2 = (bf16*)(ws + WS_H2); float* LOG = (float*)(ws + WS_LOG); unsigned char* RTE = ws + WS_ROUTE; bf16* HID = (bf16*)(ws + WS_HID); bf16* YS = (bf16*)(ws + WS_YS); bf16* PP = (bf16*)(ws + WS_PP); \
    bf16* HCAT = (bf16*)(ws + WS_HCAT); bf16* RB = (bf16*)(ws + WS_R); bf16* KB = (bf16*)(ws + WS_K); bf16* VB = (bf16*)(ws + WS_V); bf16* XRB = (bf16*)(ws + WS_XR); bf16* XKB = (bf16*)(ws + WS_XK); bf16* XVB = (bf16*)(ws + WS_XV); bf16* MID = (bf16*)(ws + WS_MID); bf16* EWB = (bf16*)(ws + WS_EW); bf16* AAB = (bf16*)(ws + WS_AA); bf16* YB = (bf16*)(ws + WS_Y); \
    const size_t TD = (size_t)T * 1024; (void)H0; (void)QKV; (void)OB; (void)AGG; (void)H2; (void)LOG; (void)RTE; (void)HID; (void)YS; (void)PP; (void)HCAT; (void)RB; (void)KB; (void)VB; (void)XRB; (void)XKB; (void)XVB; (void)MID; (void)EWB; (void)AAB; (void)YB; (void)TD;

struct Args { In in; float* out; unsigned char* ws; int ph_lo, ph_hi; };
constexpr int N_PHASES = 34;
__device__ __forceinline__ int nrep(int k) { int n = (k == DUP_K) ? 2 : 1; if (DUP_K >= 0) asm volatile("" : "+s"(n)); return n; }
#define REP_SYNC if (rep_) __syncthreads();
typedef const __attribute__((address_space(4))) unsigned long long* kp64;
__device__ __forceinline__ void load_in(In& I) { kp64 s = (kp64)__builtin_amdgcn_kernarg_segment_ptr(); unsigned long long* d = (unsigned long long*)&I;
#pragma unroll
    for (int i = 0; i < 47; ++i) d[i] = s[i]; }

__device__ __forceinline__ int t5_bucket(int n) { if (n < 16) return n; const float v = logf((float)n / 16.0f) / 2.0794415416798357f * 16.0f; const int l = 16 + (int)v; return l < 31 ? l : 31; }

template <class Epi>
__device__ __forceinline__ void dense_gemm(Frame& F, const void* A, int lda, const void* B, int K, int M, int N, const Epi& E) {
    pg8::DenseOrder S; S.init(A, lda, B, K, M, N, F.G, (int)blockIdx.x);
    pg8::gemm_phase<Epi, pg8::DenseOrder, true, false>(F.lds, K, lda, S, E, nullptr, TID_);
}

__global__ void __launch_bounds__(NWAVES * 64, 2) mk_fwd(Args args) {
    extern __shared__ __attribute__((aligned(16))) unsigned char lds[];
    Frame F;
    F.lds = (LAS unsigned char*)lds;
    F.MISC = (volatile LAS unsigned*)(F.lds + MISC_OFF);
    { int w_ = __builtin_amdgcn_readfirstlane((int)threadIdx.x >> 6); asm volatile("" : "+s"(w_)); F.wave = w_; }
    F.G = gridDim.x; { const int bx = blockIdx.x; F.vcu = (F.G % 8 == 0) ? (bx % 8) * (F.G / 8) + bx / 8 : bx; }
    F.ctl = (gu32*)(KARGS->ws + WS_CTL);
    for (int u = TID_; u < (LDS_BYTES - LDSCTL_OFF) / 4; u += NWAVES * 64) ((LAS unsigned*)(F.lds + LDSCTL_OFF))[u] = 0u;
    __syncthreads();
    {
        LAS float* tb = (LAS float*)(F.lds + TB_OFF); const int h = TID_ >> 7, i = TID_ & 127;
        const float* rb = KARGS->in.rel_bias;
        tb[h * 128 + i] = (rb[t5_bucket(i) * 4 + h] - rb[31 * 4 + h]) * 1.4426950408889634f;
    }
    __syncthreads();
    const int lo = KARGS->ph_lo, hi = KARGS->ph_hi;
    const bool multi = (hi - lo) > 1;
    XcdBarrier bar; bar.bar = (unsigned*)(F.ctl + CW_BAR); bar.x = 0; bar.st = nullptr;
    if (multi) bar = xcd_barrier_post((unsigned*)(F.ctl + CW_BAR), F.MISC + 8, TID_ == 0);
#define IN(k) (lo <= (k) && (k) < hi)
#define PH_BEGIN_ unsigned char* ws = KARGS->ws; bf16* X = (bf16*)KARGS->out; float* OUT = KARGS->out; (void)OUT; bf16* GB2 = (bf16*)KARGS->out + (size_t)T * 1024; (void)GB2; In I; load_in(I); (void)X; WSPTRS
#define SEAM(k) do { if (IN(k) && IN((k) + 1)) xcd_barrier(bar, TID_ == 0); } while (0)

    if (IN(0)) { PH_BEGIN_ prep_dense_weights(F, I, ws); prep_layer_weights(F, I, ws, 0); norm_pass<false>(F, I.x, I.norm_mix, H0);
#ifdef DUP_PREP
        __syncthreads(); prep_dense_weights(F, I, ws); prep_layer_weights(F, I, ws, 0);
#endif
    } SEAM(0);
    if (IN(1)) { PH_BEGIN_ pg8::EpiBf16 E{QKV, 512, 512, (size_t)T * 512, attn_body::C2}; dense_gemm(F, H0, 1024, ws + WS_WIN, 1024, T, AB_IN, E); } SEAM(1);
    if (IN(2)) { PH_BEGIN_ lru_agg_mfma(F, I, QKV + 3 * (size_t)T * 512, AGG, (bf16*)(ws + WS_HL), (bf16*)(ws + WS_CA)); } SEAM(2);
    if (IN(3)) { PH_BEGIN_
        const attn_body::AttnTensors AT{(const attn_body::bf16*)QKV, (const attn_body::bf16*)(QKV + (size_t)T * 512), (const attn_body::bf16*)(QKV + 2 * (size_t)T * 512), (attn_body::bf16*)OB};
        if (F.G == 256) attn_body::attn_phase<8>((char*)lds, AT, F.vcu, (const LAS float*)(F.lds + TB_OFF), (int)threadIdx.x);
#ifdef DUP_ATTN
        __syncthreads(); if (F.G == 256) attn_body::attn_phase<8>((char*)lds, AT, F.vcu, (const LAS float*)(F.lds + TB_OFF), (int)threadIdx.x);
#endif
        __syncthreads();
        lru_final_pass(F, (const bf16*)(ws + WS_HL), (const bf16*)(ws + WS_CA), QKV + 4 * (size_t)T * 512, AGG, H0);
    } SEAM(3);
    if (IN(4)) { PH_BEGIN_ diff_combine_pass(F, I, OB, H0); } SEAM(4);
    if (IN(5)) { PH_BEGIN_ pg8::EpiResX<false> E{I.x, X, (float*)(ws + WS_SS)}; dense_gemm(F, H0, 1024, ws + WS_WOUT, 1024, T, 1024, E); } SEAM(5);

#define MOE_PLE_PHASES(P, L) \
      \
    if (IN(P + 1)) { PH_BEGIN_ pg8::EpiRouter E{LOG}; dense_gemm(F, X, 1024, ws + WS_ROUT + (size_t)(L) * 256 * 1024 * 2, 1024, T, 256, E); } SEAM(P + 1); \
    if (IN(P + 2)) { PH_BEGIN_ route_pass_a(F, I, (L), LOG, RTE, F.ctl + ((L) ? CW_CNT1 : CW_CNT0), (const float*)(ws + WS_SS)); } SEAM(P + 2); \
    if (IN(P + 3)) { PH_BEGIN_ route_pass_b(F, RTE, F.ctl + ((L) ? CW_CNT1 : CW_CNT0)); } SEAM(P + 3); \
    if (IN(P + 4)) { PH_BEGIN_ route_bases(F, F.ctl + ((L) ? CW_CNT1 : CW_CNT0)); const LAS int* eb = (const LAS int*)(F.lds + RTE_OFF + 512); \
        MoeOrder S{F.G, (int)blockIdx.x, __builtin_amdgcn_readfirstlane(eb[32] >> 8), eb, (const char*)X, (const char*)(ws + WS_MGU), 0, (size_t)1024 * 1024 * 2, (size_t)256 * 1024 * 2, true}; pg8::EpiGU E{HID, (const float*)(RTE + RT_ROWRSTD)}; \
        pg8::gemm_phase<pg8::EpiGU, MoeOrder, true, true>(F.lds, 1024, 1024, S, E, (const int*)(RTE + RT_ROWTOK), TID_); } SEAM(P + 4); \
    if (IN(P + 5)) { PH_BEGIN_ route_bases(F, F.ctl + ((L) ? CW_CNT1 : CW_CNT0)); const LAS int* eb = (const LAS int*)(F.lds + RTE_OFF + 512); \
        MoeOrder S{F.G, (int)blockIdx.x, __builtin_amdgcn_readfirstlane(eb[32] >> 8), eb, (const char*)HID, (const char*)(ws + WS_MDN), (size_t)256 * 512 * 2, (size_t)1024 * 512 * 2, (size_t)256 * 512 * 2, false}; pg8::EpiDown E{YS, (const float*)(RTE + RT_ROWGATE)}; \
        pg8::gemm_phase<pg8::EpiDown, MoeOrder, true, false>(F.lds, 512, 512, S, E, nullptr, TID_); } SEAM(P + 5); \
    if (IN(P + 6)) { PH_BEGIN_ combine_norm_pass(F, X, X, YS, (const int*)(RTE + RT_SLOT), I.ple_norm + (L) * 1024, H2); __syncthreads(); \
          \
        { pg8::EpiBf16 E{PP, 1024, 0, 0, 1.f}; dense_gemm(F, ws + WS_PB, 256, ws + WS_PPROJ + (size_t)(L) * 1024 * 256 * 2, 256, T, 1024, E); } } SEAM(P + 6); \
    if (IN(P + 8)) { PH_BEGIN_ pg8::EpiPle E{X, (L) ? (bf16*)(ws + WS_YS) : X, PP}; dense_gemm(F, H2, 1024, ws + WS_PGATE + (size_t)(L) * 1024 * 1024 * 2, 1024, T, 1024, E); } SEAM(P + 8);

    MOE_PLE_PHASES(6, 0)
    if (IN(15)) { PH_BEGIN_ rwkv_input_pass(F, X, I.norm_mix + 1024, I.rwkv_mu, HCAT, XRB, XKB, XVB); } SEAM(15);
    if (IN(16)) { PH_BEGIN_ { pg8::EpiBf16 E{RB, 1024, 0, 0, 1.f}; dense_gemm(F, XRB, 1024, ws + WS_RCAT, 1024, T, 1024, E); }
        { pg8::EpiMid E{MID}; dense_gemm(F, HCAT, 2048, ws + WS_RL1, 2048, T, 512, E); } } SEAM(16);
    if (IN(17)) { PH_BEGIN_ { pg8::EpiBf16 E{KB, 1024, 0, 0, 1.f}; dense_gemm(F, XKB, 1024, ws + WS_RCAT + (size_t)1024 * 1024 * 2, 1024, T, 1024, E); }
        { pg8::EpiRwkv2 E{EWB, AAB, I.rwkv_w0, I.rwkv_a0, 0}; dense_gemm(F, MID, 512, ws + WS_RS2, 256, T, 2048, E); } } SEAM(17);
    if (IN(18)) { PH_BEGIN_ pg8::EpiBf16 E{VB, 1024, 0, 0, 1.f}; dense_gemm(F, XVB, 1024, ws + WS_RCAT + (size_t)2 * 1024 * 1024 * 2, 1024, T, 1024, E); } SEAM(18);
    if (IN(20)) { PH_BEGIN_
        if (F.G == 256 && blockIdx.x >= 128) {
            Frame F2 = F; F2.G = 128; F2.vcu = (int)blockIdx.x - 128;
#ifdef HELP_STAMP
            const unsigned long long hs0_ = __builtin_amdgcn_s_memtime();
#endif
            prep_layer_weights(F2, I, ws, 1);
            __syncthreads();
            pg8::EpiRwkv2 E{GB2, GB2, nullptr, nullptr, 2}; pg8::DenseOrder S; S.init(MID + 256, 512, ws + WS_RS2 + (size_t)2 * 1024 * 256 * 2, 256, T, 1024, 128, (int)blockIdx.x - 128);
            pg8::gemm_phase<pg8::EpiRwkv2, pg8::DenseOrder, true, false>(F.lds, 256, 512, S, E, nullptr, TID_);
            static_assert(CH_NP == 4, "the y hand-off below counts 64-token rounds");
            asm volatile("s_waitcnt vmcnt(0)" ::: "memory"); __syncthreads();
            {
                const __attribute__((address_space(4))) Args* ka = KARGS; asm volatile("" : "+s"(ka));
                unsigned char* ws2 = ka->ws; bf16* G2 = (bf16*)ka->out + (size_t)T * 1024; gu32* ctl2 = (gu32*)(ws2 + WS_CTL);
                In I2; I2.rwkv_ka = ka->in.rwkv_ka; I2.rwkv_rk = ka->in.rwkv_rk; I2.rwkv_ln_g = ka->in.rwkv_ln_g; I2.rwkv_ln_b = ka->in.rwkv_ln_b;
                if (TID_ == 0) { __builtin_amdgcn_fence(__ATOMIC_RELEASE, "agent"); asm volatile("s_waitcnt vmcnt(0)" ::: "memory"); __hip_atomic_fetch_add(ctl2 + CW_GDONE, 1u, __ATOMIC_RELAXED, __HIP_MEMORY_SCOPE_AGENT);
                    while (__hip_atomic_load(ctl2 + CW_GDONE, __ATOMIC_RELAXED, __HIP_MEMORY_SCOPE_AGENT) < 128u) __builtin_amdgcn_s_sleep(8);
                    __builtin_amdgcn_fence(__ATOMIC_ACQUIRE, "agent"); }
                __syncthreads();
                const int hb = ((int)blockIdx.x - 128) >> 4, hs = ((int)blockIdx.x - 128) & 15;
                for (int rd = hs; rd < CH_ROUNDS; rd += 16) {
                    if (TID_ == 0) { const gu32* pw = ctl2 + CW_PROG + hb * CH_ROUNDS + rd;
                        while (__hip_atomic_load(pw, __ATOMIC_RELAXED, __HIP_MEMORY_SCOPE_AGENT) < 16u) __builtin_amdgcn_s_sleep(8);
                        __builtin_amdgcn_fence(__ATOMIC_ACQUIRE, "agent"); }
                    __syncthreads();
                    const int tb = hb * SEQ + rd * 64;
                    rwkv_post_pass(F, I2, (const bf16*)(ws2 + WS_R), (const bf16*)(ws2 + WS_K), (const bf16*)(ws2 + WS_V), (const bf16*)(ws2 + WS_AA), G2, (bf16*)(ws2 + WS_Y), tb + 2 * F.wave, tb + 64, 2 * NWAVES);
                    asm volatile("s_waitcnt vmcnt(0)" ::: "memory"); __syncthreads(); } }
        } else rwkv_scan_chunked(F, I, RB, KB, VB, AAB, EWB, YB, (gu32*)(ws + WS_CTL) + CW_PROG);
    } SEAM(20);
    if (IN(23)) { PH_BEGIN_ pg8::EpiResX<true> E{X, X, (float*)(ws + WS_SS)}; dense_gemm(F, YB, 1024, ws + WS_RWO, 1024, T, 1024, E); } SEAM(23);
    MOE_PLE_PHASES(24, 1)
    if (IN(33)) { PH_BEGIN_ final_norm_pass(F, (const bf16*)(ws + WS_YS), OUT, I.final_norm); }
#undef IN
#undef SEAM
}

extern "C" void kernel_launch(void* const* d_in, const int* in_sizes, int n_in, void* d_out, int out_size, void* d_ws, size_t ws_size, hipStream_t stream) {
    static int ok = 0;
    if (ok == 0) {
        if (n_in != 47 || out_size != T * D || ws_size < WS_END) { fprintf(stderr, "kernel_launch: unexpected problem shape (n_in %d out %d ws %zu)\n", n_in, out_size, ws_size); ok = -1; return; }
        if (hipFuncSetAttribute((const void*)mk_fwd, hipFuncAttributeMaxDynamicSharedMemorySize, LDS_BYTES) != hipSuccess) { fprintf(stderr, "kernel_launch: hipFuncSetAttribute failed\n"); ok = -1; return; }
        int per_cu = 0;
        if (hipOccupancyMaxActiveBlocksPerMultiprocessor(&per_cu, (const void*)mk_fwd, NWAVES * 64, LDS_BYTES) != hipSuccess || per_cu < 1) fprintf(stderr, "kernel_launch: occupancy query reports %d\n", per_cu);
        (void)hipGetLastError();
        ok = 1;
    }
    if (ok < 0) return;
    (void)hipMemsetAsync((char*)d_ws + WS_CTL, 0, CTL_ZERO_BYTES, stream);
    Args a{};
    const float** ip = (const float**)&a.in;
    for (int i = 0; i < 47; ++i) ip[i] = (const float*)d_in[i];
    a.out = (float*)d_out; a.ws = (unsigned char*)d_ws;
    const int grid = 256;
#if MK_ONE_LAUNCH
    a.ph_lo = 0; a.ph_hi = N_PHASES;
    hipLaunchKernelGGL(mk_fwd, dim3(grid), dim3(NWAVES * 64), LDS_BYTES, stream, a);
#else
    for (int k = 0; k < N_PHASES; ++k) { a.ph_lo = k; a.ph_hi = k + 1; hipLaunchKernelGGL(mk_fwd, dim3(grid), dim3(NWAVES * 64), LDS_BYTES, stream, a);
        if (k == DUP_K || k == DUP_K2) hipLaunchKernelGGL(mk_fwd, dim3(grid), dim3(NWAVES * 64), LDS_BYTES, stream, a); }
#endif
}
```
